# Optimizing an MI355X kernel written in HIP

```python
import jax, jax.numpy as jnp
from jax import lax
import numpy as np

D_MODEL = 2048
BATCH = 2
SEQ = 4096
DEPTH = 1

CONV_WIDTH = 1024
CONV_K = 3
N_HEADS = 8
HEAD_DIM = 128
ATTN_WIDTH = N_HEADS * HEAD_DIM
ROT_DIM = HEAD_DIM // 4
ROPE_THETA = 500000.0
MOBA_BLOCK = 256
MOBA_TOPK = 3
Q_CHUNK = 32
PEER_HEADS = 8
PEER_NKEYS = 128
PEER_N_EXPERTS = PEER_NKEYS * PEER_NKEYS
PEER_KEY_DIM = 256
PEER_HALF = PEER_KEY_DIM // 2
PEER_TOPK = 16
TOK_CHUNK = 128
RMS_EPS = 1e-6
IN_SIZES = (CONV_WIDTH, CONV_WIDTH, CONV_WIDTH, ATTN_WIDTH, ATTN_WIDTH, ATTN_WIDTH, D_MODEL, D_MODEL)
IN_WIDTH = sum(IN_SIZES)
IN_SPLITS = tuple(int(s) for s in np.cumsum(IN_SIZES)[:-1])

kernel_name = "hybrid_conv_moba_peer_block"


def rms_norm(x, g):
    x32 = x.astype(jnp.float32)
    y = x32 * lax.rsqrt(jnp.mean(x32 * x32, axis=-1, keepdims=True) + RMS_EPS)
    return y.astype(x.dtype) * g


def partial_rotary(x, positions):
    half = ROT_DIM // 2
    inv_freq = 1.0 / (ROPE_THETA ** (jnp.arange(0, ROT_DIM, 2, dtype=jnp.float32) / ROT_DIM))
    ang = positions.astype(jnp.float32)[:, :, None] * inv_freq
    cos = jnp.cos(ang)[:, :, None, :]
    sin = jnp.sin(ang)[:, :, None, :]
    x32 = x.astype(jnp.float32)
    x1 = x32[..., :half]
    x2 = x32[..., half:ROT_DIM]
    rot = jnp.concatenate([x1 * cos - x2 * sin, x2 * cos + x1 * sin], axis=-1)
    return jnp.concatenate([rot.astype(x.dtype), x[..., ROT_DIM:]], axis=-1)


def short_conv_mixer(b_gate, c_gate, xc, conv_w):
    z = c_gate * xc
    s = z.shape[1]
    zp = jnp.pad(z, ((0, 0), (CONV_K - 1, 0), (0, 0)))
    conv = sum(conv_w[j] * zp[:, j:j + s] for j in range(CONV_K))
    return b_gate * conv


def moba_attention(q, k, v):
    b, s, h, hd = q.shape
    bh = b * h
    nb = -(-s // MOBA_BLOCK)
    s_pad = nb * MOBA_BLOCK
    n_sel = min(MOBA_TOPK, nb)
    scale = hd ** -0.5
    qh = q.transpose(0, 2, 1, 3).reshape(bh, s, hd)
    kp = jnp.pad(k.transpose(0, 2, 1, 3).reshape(bh, s, hd), ((0, 0), (0, s_pad - s), (0, 0)))
    vp = jnp.pad(v.transpose(0, 2, 1, 3).reshape(bh, s, hd), ((0, 0), (0, s_pad - s), (0, 0)))
    kb = kp.reshape(bh, nb, MOBA_BLOCK, hd)
    vb = vp.reshape(bh, nb, MOBA_BLOCK, hd)
    kmean = jnp.mean(kb.astype(jnp.float32), axis=2)

    def one_chunk(c):
        q0 = c * Q_CHUNK
        blk = q0 // MOBA_BLOCK
        qc = lax.dynamic_slice_in_dim(qh, q0, Q_CHUNK, axis=1)
        gate = jnp.einsum('nqd,nbd->nqb', qc.astype(jnp.float32), kmean)
        gate = jnp.where(jnp.arange(nb)[None, None, :] < blk, gate, -jnp.inf)
        _, top_i = lax.top_k(gate, n_sel)
        valid = jnp.arange(n_sel) < blk
        k_sel = jax.vmap(lambda kbn, idx: kbn[idx])(kb, top_i)
        v_sel = jax.vmap(lambda vbn, idx: vbn[idx])(vb, top_i)
        s_sel = jnp.einsum('nqd,nqjkd->nqjk', qc, k_sel).astype(jnp.float32) * scale
        s_sel = jnp.where(valid[None, None, :, None], s_sel, -jnp.inf)
        s_sel = s_sel.reshape(bh, Q_CHUNK, n_sel * MOBA_BLOCK)
        k_own = lax.dynamic_slice_in_dim(kp, blk * MOBA_BLOCK, MOBA_BLOCK, axis=1)
        v_own = lax.dynamic_slice_in_dim(vp, blk * MOBA_BLOCK, MOBA_BLOCK, axis=1)
        s_own = jnp.einsum('nqd,nkd->nqk', qc, k_own).astype(jnp.float32) * scale
        q_pos = q0 + jnp.arange(Q_CHUNK)
        k_pos = blk * MOBA_BLOCK + jnp.arange(MOBA_BLOCK)
        s_own = jnp.where(k_pos[None, None, :] <= q_pos[None, :, None], s_own, -jnp.inf)
        p = jax.nn.softmax(jnp.concatenate([s_sel, s_own], axis=-1), axis=-1)
        p_sel = p[..., :n_sel * MOBA_BLOCK].reshape(bh, Q_CHUNK, n_sel, MOBA_BLOCK).astype(v.dtype)
        p_own = p[..., n_sel * MOBA_BLOCK:].astype(v.dtype)
        return (jnp.einsum('nqjk,nqjkd->nqd', p_sel, v_sel)
                + jnp.einsum('nqk,nkd->nqd', p_own, v_own))

    out = lax.map(one_chunk, jnp.arange(s // Q_CHUNK))
    out = out.transpose(1, 0, 2, 3).reshape(b, h, s, hd)
    return out.transpose(0, 2, 1, 3).reshape(b, s, h * hd)


def peer_ffn(xn, w_pq, sub_keys, expert_u, expert_v):
    b, s, d = xn.shape
    t = b * s
    xt = xn.reshape(t, d)
    qp = (xt @ w_pq).reshape(t, PEER_HEADS, 2, PEER_HALF)
    sc = jnp.einsum('thpd,hpnd->thpn', qp, sub_keys).astype(jnp.float32)
    s_top, i_top = lax.top_k(sc, PEER_TOPK)
    cand = s_top[:, :, 0, :, None] + s_top[:, :, 1, None, :]
    cand_idx = i_top[:, :, 0, :, None] * PEER_NKEYS + i_top[:, :, 1, None, :]
    best_s, best_pos = lax.top_k(cand.reshape(t, PEER_HEADS, PEER_TOPK * PEER_TOPK), PEER_TOPK)
    experts = jnp.take_along_axis(cand_idx.reshape(t, PEER_HEADS, PEER_TOPK * PEER_TOPK), best_pos, axis=-1)
    gates = jax.nn.softmax(best_s, axis=-1)
    n_chunks = t // TOK_CHUNK

    def one_chunk(args):
        xc, idx, g = args
        u = expert_u[idx]
        v = expert_v[idx]
        a = jnp.einsum('thkd,td->thk', u, xc)
        act = (jax.nn.gelu(a.astype(jnp.float32)) * g).astype(xc.dtype)
        return jnp.einsum('thk,thkd->td', act, v)

    y = lax.map(one_chunk, (xt.reshape(n_chunks, TOK_CHUNK, d),
                            experts.reshape(n_chunks, TOK_CHUNK, PEER_HEADS, PEER_TOPK),
                            gates.reshape(n_chunks, TOK_CHUNK, PEER_HEADS, PEER_TOPK)))
    return y.reshape(b, s, d)


def setup_inputs(seed: int = 0) -> dict:
    key = jax.random.key(seed)
    ks = jax.random.split(key, 16)
    f32 = jnp.float32
    nrm = lambda k, shape, sc: jax.random.normal(k, shape, f32) * sc
    x = nrm(ks[0], (BATCH, SEQ, D_MODEL), 1.0)
    offset = jax.random.randint(ks[1], (BATCH, 1), 0, 4096, dtype=jnp.int32)
    positions = offset + jnp.arange(SEQ, dtype=jnp.int32)[None, :]
    return {
        "x": x,
        "positions": positions,
        "attn_norm_g": 1.0 + nrm(ks[2], (DEPTH, D_MODEL), 0.02),
        "w_in": nrm(ks[3], (DEPTH, D_MODEL, IN_WIDTH), D_MODEL ** -0.5),
        "gate_bias": nrm(ks[4], (DEPTH, 2 * D_MODEL), 0.01),
        "conv_w": nrm(ks[5], (DEPTH, CONV_K, CONV_WIDTH), CONV_K ** -0.5),
        "w_branch_conv": nrm(ks[6], (DEPTH, CONV_WIDTH, D_MODEL), CONV_WIDTH ** -0.5),
        "w_branch_attn": nrm(ks[7], (DEPTH, ATTN_WIDTH, D_MODEL), ATTN_WIDTH ** -0.5),
        "w_out": nrm(ks[8], (DEPTH, D_MODEL, D_MODEL), D_MODEL ** -0.5),
        "ffn_norm_g": 1.0 + nrm(ks[9], (DEPTH, D_MODEL), 0.02),
        "w_peer_query": nrm(ks[10], (DEPTH, D_MODEL, PEER_HEADS * PEER_KEY_DIM), D_MODEL ** -0.5),
        "peer_sub_keys": nrm(ks[11], (DEPTH, PEER_HEADS, 2, PEER_NKEYS, PEER_HALF), PEER_HALF ** -0.5),
        "peer_u": nrm(ks[12], (DEPTH, PEER_N_EXPERTS, D_MODEL), D_MODEL ** -0.5),
        "peer_v": nrm(ks[13], (DEPTH, PEER_N_EXPERTS, D_MODEL), PEER_HEADS ** -0.5),
        "final_norm_g": 1.0 + nrm(ks[14], (D_MODEL,), 0.02),
    }


def reference(x, positions, attn_norm_g, w_in, gate_bias, conv_w, w_branch_conv, w_branch_attn,
              w_out, ffn_norm_g, w_peer_query, peer_sub_keys, peer_u, peer_v, final_norm_g):
    b, s, _ = x.shape
    for l in range(DEPTH):
        h = rms_norm(x, attn_norm_g[l])
        proj = h @ w_in[l]
        cb, cc, cx, q, k, v, g_conv, g_attn = jnp.split(proj, IN_SPLITS, axis=-1)
        y_conv = short_conv_mixer(cb, cc, cx, conv_w[l]) @ w_branch_conv[l]
        q = partial_rotary(q.reshape(b, s, N_HEADS, HEAD_DIM), positions)
        k = partial_rotary(k.reshape(b, s, N_HEADS, HEAD_DIM), positions)
        v = v.reshape(b, s, N_HEADS, HEAD_DIM)
        y_attn = moba_attention(q, k, v) @ w_branch_attn[l]
        gb = gate_bias[l]
        gate_a = jax.nn.sigmoid(g_conv + gb[:D_MODEL])
        gate_b = jax.nn.sigmoid(g_attn + gb[D_MODEL:])
        x = x + (gate_a * y_conv + gate_b * y_attn) @ w_out[l]
        x = x + peer_ffn(rms_norm(x, ffn_norm_g[l]), w_peer_query[l], peer_sub_keys[l], peer_u[l], peer_v[l])
    return rms_norm(x, final_norm_g)
```

```cpp
#include <hip/hip_runtime.h>
#include <cstdio>
#include <cstdint>
#include <cmath>
namespace pg8 {
#define PG8_LAS __attribute__((address_space(3)))
typedef unsigned short bf16_t;
typedef short bf16x8 __attribute__((ext_vector_type(8)));
typedef float f32x4 __attribute__((ext_vector_type(4)));
typedef unsigned u32x4 __attribute__((ext_vector_type(4)));
constexpr int BM = 256, BK = 64, HALF = 128, HTB = HALF * BK * 2  , STAGE_BYTES = 8 * HTB, NXCD = 8, WGM = 8;

__host__ __device__ __forceinline__ int lds_byte(int r, int c) { const int st = (r >> 4) * 2 + (c >> 5), rr = r & 15, cc = c & 31, ob = rr * 64 + cc * 2; return st * 1024 + (ob ^ (((ob >> 9) & 1) << 5)); }
__host__ __device__ __forceinline__ void stage_rc(int b, int& R, int& C) { const int st = b / 1024, sb = b % 1024, swz = sb ^ (((sb >> 9) & 1) << 5); R = (st >> 1) * 16 + swz / 64; C = (st & 1) * 32 + (swz % 64) / 2; }
__host__ __device__ __forceinline__ int perm32(int rho) { const int n = rho >> 4, i = rho & 15; return 8 * (i >> 2) + 4 * n + (i & 3); }

struct Unit { int pm, pn; };
struct Gemm { const bf16_t* A; const bf16_t* Bt; int M, N, K; };

struct StaticOrder {
    int nM, nN, nwg, G, c;
    __host__ __device__ void init(int M, int N, int G_, int c_) { nM = M / BM; nN = N / BM; nwg = nM * nN; G = G_; c = c_; }
    __host__ __device__ bool next(int i, Unit& u) const {
        const long L = (long)i * G + c; if (L >= nwg) return false;
        int wgid = (int)L; { const int q = nwg / NXCD, r = nwg % NXCD, xcd = wgid % NXCD, off = wgid / NXCD; wgid = (xcd < r ? xcd * (q + 1) : r * (q + 1) + (xcd - r) * q) + off; }
        const int nig = WGM * nN, gid = wgid / nig, fm = gid * WGM, gsz = (nM - fm) < WGM ? (nM - fm) : WGM;
        u.pm = fm + ((wgid % nig) % gsz); u.pn = (wgid % nig) / gsz; return true;
    }
    __device__ __forceinline__ void a_ready(const Unit&) const {}
    __device__ __forceinline__ void done(const Unit&) const {}
};


typedef float f32x2c __attribute__((ext_vector_type(2))); typedef __bf16 bf16x2c __attribute__((ext_vector_type(2)));
__device__ __forceinline__ unsigned cvt_pk_bf16(float lo, float hi) { const f32x2c v = {lo, hi}; const bf16x2c b = __builtin_convertvector(v, bf16x2c); return __builtin_bit_cast(unsigned, b); }
__device__ __forceinline__ u32x4 pack8(f32x4 a, f32x4 b) { u32x4 w; w.x = cvt_pk_bf16(a[0], a[1]); w.y = cvt_pk_bf16(a[2], a[3]); w.z = cvt_pk_bf16(b[0], b[1]); w.w = cvt_pk_bf16(b[2], b[3]); return w; }
__device__ __forceinline__ f32x4 shx(f32x4 v, int o) { f32x4 r; r[0] = __shfl_xor(v[0], o); r[1] = __shfl_xor(v[1], o); r[2] = __shfl_xor(v[2], o); r[3] = __shfl_xor(v[3], o); return r; }
__device__ __forceinline__ f32x4 bf4lo(unsigned a, unsigned b) { f32x4 r; r[0] = __uint_as_float(a << 16); r[1] = __uint_as_float(a & 0xffff0000u); r[2] = __uint_as_float(b << 16); r[3] = __uint_as_float(b & 0xffff0000u); return r; }
__device__ __forceinline__ f32x4 sigm4(f32x4 v) { f32x4 r;
#pragma unroll
    for (int i = 0; i < 4; ++i) r[i] = __builtin_amdgcn_rcpf(1.0f + __expf(-v[i])); return r; }
constexpr float QSCALE = 0.08838834764831845f * 1.4426950408889634f;

struct EpiIn {
    static constexpr bool PERM = true, AFTER_DRAIN = false;
    bf16_t* T6; bf16_t* GAB; const float* gbias; const float* cs; float* ksum;
    __device__ __forceinline__ void operator()(const f32x4 (&acc)[2][2][4][2], const Unit& u, int wr, int wc, int fr, int fq) const {
        const int row0 = u.pm * BM + wr * 64 + fr, pn = u.pn, colw = wc * 32 + 8 * fq;
        if (pn < 24) {
            const int t = pn >> 2;
            bf16_t* base = T6 + (size_t)t * ((size_t)8192 * 1024) + (pn & 3) * 256 + colw;
            const bool rot = (t == 3 || t == 4) && (wc == 0), isk = (t == 4);
            const float qs = (t == 3) ? QSCALE : 1.0f;
            f32x4 ks[2][2];
#pragma unroll
            for (int bj = 0; bj < 2; ++bj) { ks[bj][0] = (f32x4){0.f, 0.f, 0.f, 0.f}; ks[bj][1] = (f32x4){0.f, 0.f, 0.f, 0.f}; }
#pragma unroll
            for (int ai = 0; ai < 2; ++ai)
#pragma unroll
                for (int m = 0; m < 4; ++m) {
                    const int row = row0 + ai * HALF + m * 16;
                    f32x4 c0 = (f32x4){1.f, 1.f, 1.f, 1.f}, c1 = c0, s0 = (f32x4){0.f, 0.f, 0.f, 0.f}, s1 = s0;
                    if (rot) { const float* cp = cs + (size_t)row * 32 + 8 * (fq & 1); c0 = *(const f32x4*)cp; c1 = *(const f32x4*)(cp + 4); s0 = *(const f32x4*)(cp + 16); s1 = *(const f32x4*)(cp + 20);
                        if (fq < 2) { s0 = -s0; s1 = -s1; } }
#pragma unroll
                    for (int bj = 0; bj < 2; ++bj) {
                        f32x4 v0 = acc[ai][bj][m][0], v1 = acc[ai][bj][m][1];
                        if (rot) { const f32x4 p0 = shx(v0, 32), p1 = shx(v1, 32); v0 = v0 * c0 + p0 * s0; v1 = v1 * c1 + p1 * s1; }
                        if (isk) { ks[bj][0] += v0; ks[bj][1] += v1; }
                        v0 = v0 * qs; v1 = v1 * qs;
                        *(u32x4*)(base + (size_t)row * 1024 + bj * HALF) = pack8(v0, v1);
                    }
                }
            if (isk) {
#pragma unroll
                for (int bj = 0; bj < 2; ++bj)
#pragma unroll
                    for (int n = 0; n < 2; ++n) { f32x4 v = ks[bj][n]; v += shx(v, 1); v += shx(v, 2); v += shx(v, 4); v += shx(v, 8);
                        if (fr == 0) { float* kp = ksum + (size_t)u.pm * 1024 + (pn & 3) * 256 + bj * HALF + colw + 4 * n;
                            unsafeAtomicAdd(kp + 0, v[0]); unsafeAtomicAdd(kp + 1, v[1]); unsafeAtomicAdd(kp + 2, v[2]); unsafeAtomicAdd(kp + 3, v[3]); } }
            }
        } else {
            const int t = (pn - 24) >> 3, colg = ((pn - 24) & 7) * 256 + colw;
            bf16_t* base = GAB + (size_t)t * ((size_t)8192 * 2048) + colg;
            const float* bp = gbias + t * 2048 + colg;
            f32x4 bv[2][2];
#pragma unroll
            for (int bj = 0; bj < 2; ++bj) { bv[bj][0] = *(const f32x4*)(bp + bj * HALF); bv[bj][1] = *(const f32x4*)(bp + bj * HALF + 4); }
#pragma unroll
            for (int ai = 0; ai < 2; ++ai)
#pragma unroll
                for (int m = 0; m < 4; ++m) { const int row = row0 + ai * HALF + m * 16;
#pragma unroll
                    for (int bj = 0; bj < 2; ++bj) *(u32x4*)(base + (size_t)row * 2048 + bj * HALF) = pack8(sigm4(acc[ai][bj][m][0] + bv[bj][0]), sigm4(acc[ai][bj][m][1] + bv[bj][1])); }
        }
    }
};
struct EpiTmp {
    static constexpr bool PERM = true, AFTER_DRAIN = false;
    const bf16_t* G; bf16_t* O;
    __device__ __forceinline__ void operator()(const f32x4 (&acc)[2][2][4][2], const Unit& u, int wr, int wc, int fr, int fq) const {
        const int row0 = u.pm * BM + wr * 64 + fr, col0 = u.pn * BM + wc * 32 + 8 * fq;
#pragma unroll
        for (int ai = 0; ai < 2; ++ai)
#pragma unroll
            for (int m = 0; m < 4; ++m) { const size_t off = (size_t)(row0 + ai * HALF + m * 16) * 2048 + col0;
#pragma unroll
                for (int bj = 0; bj < 2; ++bj) { const u32x4 g = *(const u32x4*)(G + off + bj * HALF);
                    *(u32x4*)(O + off + bj * HALF) = pack8(acc[ai][bj][m][0] * bf4lo(g.x, g.y), acc[ai][bj][m][1] * bf4lo(g.z, g.w)); } }
    }
};
struct EpiMerge {
    static constexpr bool PERM = true, AFTER_DRAIN = false;
    const bf16_t* G; const bf16_t* TMP; bf16_t* O;
    __device__ __forceinline__ void operator()(const f32x4 (&acc)[2][2][4][2], const Unit& u, int wr, int wc, int fr, int fq) const {
        const int row0 = u.pm * BM + wr * 64 + fr, col0 = u.pn * BM + wc * 32 + 8 * fq;
#pragma unroll
        for (int ai = 0; ai < 2; ++ai)
#pragma unroll
            for (int m = 0; m < 4; ++m) { const size_t off = (size_t)(row0 + ai * HALF + m * 16) * 2048 + col0;
#pragma unroll
                for (int bj = 0; bj < 2; ++bj) { const u32x4 g = *(const u32x4*)(G + off + bj * HALF), t = *(const u32x4*)(TMP + off + bj * HALF);
                    *(u32x4*)(O + off + bj * HALF) = pack8(bf4lo(t.x, t.y) + acc[ai][bj][m][0] * bf4lo(g.x, g.y), bf4lo(t.z, t.w) + acc[ai][bj][m][1] * bf4lo(g.z, g.w)); } }
    }
};
struct EpiX1 {
    static constexpr bool PERM = true, AFTER_DRAIN = false;
    const float* X; float* X1; bf16_t* X1B; unsigned long long* SS;
    __device__ __forceinline__ void operator()(const f32x4 (&acc)[2][2][4][2], const Unit& u, int wr, int wc, int fr, int fq) const {
        const int row0 = u.pm * BM + wr * 64 + fr, col0 = u.pn * BM + wc * 32 + 8 * fq;
#pragma unroll
        for (int ai = 0; ai < 2; ++ai)
#pragma unroll
            for (int m = 0; m < 4; ++m) { const int row = row0 + ai * HALF + m * 16; const size_t off = (size_t)row * 2048 + col0; float sq = 0.f;
#pragma unroll
                for (int bj = 0; bj < 2; ++bj) { const f32x4 v0 = acc[ai][bj][m][0] + *(const f32x4*)(X + off + bj * HALF), v1 = acc[ai][bj][m][1] + *(const f32x4*)(X + off + bj * HALF + 4);
                    *(f32x4*)(X1 + off + bj * HALF) = v0; *(f32x4*)(X1 + off + bj * HALF + 4) = v1; *(u32x4*)(X1B + off + bj * HALF) = pack8(v0, v1);
                    sq += (v0[0] * v0[0] + v0[1] * v0[1]) + (v0[2] * v0[2] + v0[3] * v0[3]) + (v1[0] * v1[0] + v1[1] * v1[1]) + (v1[2] * v1[2] + v1[3] * v1[3]); }
                sq += __shfl_xor(sq, 16); sq += __shfl_xor(sq, 32);
                if (fq == 0) atomicAdd(SS + row, (unsigned long long)(sq * 4294967296.0f)); }
    }
};
__device__ __forceinline__ float rinv_from_ss(unsigned long long s) { return 1.0f / sqrtf((float)((double)s * (1.0 / 4294967296.0) * (1.0 / 2048.0)) + 1e-6f); }
struct EpiQP {
    static constexpr bool PERM = true, AFTER_DRAIN = false;
    const unsigned long long* SS; bf16_t* O;
    __device__ __forceinline__ void operator()(const f32x4 (&acc)[2][2][4][2], const Unit& u, int wr, int wc, int fr, int fq) const {
        const int row0 = u.pm * BM + wr * 64 + fr, col0 = u.pn * BM + wc * 32 + 8 * fq;
#pragma unroll
        for (int ai = 0; ai < 2; ++ai)
#pragma unroll
            for (int m = 0; m < 4; ++m) { const int row = row0 + ai * HALF + m * 16; const size_t off = (size_t)row * 2048 + col0; const float rv = rinv_from_ss(SS[row]);
#pragma unroll
                for (int bj = 0; bj < 2; ++bj) *(u32x4*)(O + off + bj * HALF) = pack8(acc[ai][bj][m][0] * rv, acc[ai][bj][m][1] * rv); }
    }
};

template <class Epi, class Sched, bool ALIGN_EPI = false, bool SP2 = false>
__device__ __forceinline__ void gemm_phase(PG8_LAS unsigned char* lds, const Gemm g, const Sched& S, const Epi& E) {
    const int tid = threadIdx.x, wid = __builtin_amdgcn_readfirstlane(tid >> 6), lane = tid & 63, wr = wid >> 2, wc = wid & 3, fr = lane & 15, fq = lane >> 4;
    const int K = g.K, nt = K / BK;
    unsigned voffA[2], voffB[2];
#pragma unroll
    for (int i = 0; i < 2; ++i) { int R, C; stage_rc(tid * 16 + i * 8192, R, C); const int Rb = Epi::PERM ? ((R & ~31) + perm32(R & 31)) : R;
        voffA[i] = (unsigned)(R * K + C) * 2u; voffB[i] = (unsigned)(Rb * K + C) * 2u; }
    const size_t kstep = (size_t)(BK * 2);
    const size_t hstep = (size_t)HALF * K * 2;
    const size_t tstep = 2 * hstep;
    const unsigned ldsw = (unsigned)wid * 1024u;
    const int aoff = lds_byte(wr * 64 + fr, fq * 8), boff = lds_byte(wc * 32 + fr, fq * 8);
#define PG8_SA(b, h) (((b) * 2 + (h)) * HTB)
#define PG8_SB(b, h) ((4 + (b) * 2 + (h)) * HTB)
#define PG8_STAGE(bufoff, gbase, voff) do { _Pragma("unroll") for (int _i = 0; _i < 2; ++_i) \
        __builtin_amdgcn_global_load_lds((const unsigned*)((const char*)(gbase) + (voff)[_i]), (PG8_LAS unsigned*)(lds + (bufoff) + ldsw + _i * 8192), 16, 0, 0); } while (0)
#define PG8_LDA(dst, b, h) do { _Pragma("unroll") for (int m = 0; m < 4; ++m) _Pragma("unroll") for (int k = 0; k < 2; ++k) dst[m][k] = *(const PG8_LAS bf16x8*)(lds + PG8_SA(b, h) + aoff + m * 2048 + k * 1024); } while (0)
#define PG8_LDB(dst, b, h) do { _Pragma("unroll") for (int n = 0; n < 2; ++n) _Pragma("unroll") for (int k = 0; k < 2; ++k) dst[n][k] = *(const PG8_LAS bf16x8*)(lds + PG8_SB(b, h) + boff + n * 2048 + k * 1024); } while (0)
#define PG8_MMA(ai, bj, At, Bt) do { __builtin_amdgcn_s_setprio(1); _Pragma("unroll") for (int m = 0; m < 4; ++m) _Pragma("unroll") for (int n = 0; n < 2; ++n) _Pragma("unroll") for (int k = 0; k < 2; ++k) \
        acc[ai][bj][m][n] = __builtin_amdgcn_mfma_f32_16x16x32_bf16(Bt[n][k], At[m][k], acc[ai][bj][m][n], 0, 0, 0); __builtin_amdgcn_s_setprio(0); } while (0)
#define PG8_WAIT_V(n) asm volatile("s_waitcnt vmcnt(" #n ")" ::: "memory")
#define PG8_WAIT_L(n) asm volatile("s_waitcnt lgkmcnt(" #n ")" ::: "memory")
#define PG8_BAR __builtin_amdgcn_s_barrier()
#define PG8_SCHED __builtin_amdgcn_sched_barrier(0)
    Unit cur, nxt; int ui = 0;
    if (!S.next(0, cur)) return;
    f32x4 acc[2][2][4][2];
#pragma unroll
    for (int a = 0; a < 2; ++a)
#pragma unroll
        for (int b = 0; b < 2; ++b)
#pragma unroll
            for (int m = 0; m < 4; ++m)
#pragma unroll
                for (int n = 0; n < 2; ++n) acc[a][b][m][n] = (f32x4){0.f, 0.f, 0.f, 0.f};
    bf16x8 At[4][2], B0[2][2], B1[2][2];
    const char* cA = (const char*)g.A + (size_t)cur.pm * tstep; const char* cB = (const char*)g.Bt + (size_t)cur.pn * tstep;
    S.a_ready(cur);
    if constexpr (SP2) {
        PG8_STAGE(PG8_SB(0, 0), cB, voffB); PG8_STAGE(PG8_SB(0, 1), cB + hstep, voffB); PG8_STAGE(PG8_SA(0, 0), cA, voffA); PG8_STAGE(PG8_SA(0, 1), cA + hstep, voffA);
        if (wr == 1) PG8_BAR;
        PG8_WAIT_V(2); PG8_BAR;
        PG8_STAGE(PG8_SB(1, 0), cB + kstep, voffB); PG8_STAGE(PG8_SA(1, 0), cA + kstep, voffA); PG8_STAGE(PG8_SB(1, 1), cB + hstep + kstep, voffB);
        PG8_WAIT_V(6); PG8_BAR;
    } else {
        PG8_STAGE(PG8_SB(0, 0), cB, voffB); PG8_STAGE(PG8_SA(0, 0), cA, voffA); PG8_STAGE(PG8_SB(0, 1), cB + hstep, voffB); PG8_STAGE(PG8_SA(0, 1), cA + hstep, voffA);
        if (wr == 1) PG8_BAR;
        PG8_WAIT_V(4); PG8_BAR;
        PG8_STAGE(PG8_SB(1, 0), cB + kstep, voffB); PG8_STAGE(PG8_SA(1, 0), cA + kstep, voffA); PG8_STAGE(PG8_SB(1, 1), cB + hstep + kstep, voffB);
        PG8_WAIT_V(6); PG8_BAR;
    }
    for (;;) {
        const bool has_next = S.next(ui + 1, nxt);
        const char* nA = has_next ? (const char*)g.A + (size_t)nxt.pm * tstep : cA; const char* nB = has_next ? (const char*)g.Bt + (size_t)nxt.pn * tstep : cB;
        for (int t = 0; t < nt; t += 2) {
            const bool last = (t == nt - 2);
            const char* a1 = cA + (size_t)(t + 1) * kstep;
            const char* a2 = last ? nA : cA + (size_t)(t + 2) * kstep; const char* b2 = last ? nB : cB + (size_t)(t + 2) * kstep;
            const char* a3 = a2 + kstep; const char* b3 = b2 + kstep;
            if (last && has_next) S.a_ready(nxt);
            if constexpr (SP2) {
            PG8_LDB(B0, 0, 0); PG8_LDB(B1, 0, 1); PG8_SCHED; PG8_LDA(At, 0, 0); PG8_STAGE(PG8_SA(1, 1), a1 + hstep, voffA);
            PG8_WAIT_V(8); PG8_WAIT_L(0); PG8_BAR; PG8_MMA(0, 0, At, B0); PG8_MMA(0, 1, At, B1); PG8_BAR; PG8_SCHED;
            PG8_LDA(At, 0, 1); PG8_STAGE(PG8_SB(0, 0), b2, voffB); PG8_STAGE(PG8_SB(0, 1), b2 + hstep, voffB); PG8_STAGE(PG8_SA(0, 0), a2, voffA);
            PG8_WAIT_V(8); PG8_WAIT_L(0); PG8_BAR; PG8_MMA(1, 0, At, B0); PG8_MMA(1, 1, At, B1); PG8_BAR; PG8_SCHED;
            PG8_LDB(B0, 1, 0); PG8_LDB(B1, 1, 1); PG8_SCHED; PG8_LDA(At, 1, 0); PG8_STAGE(PG8_SA(0, 1), a2 + hstep, voffA);
            PG8_WAIT_V(8); PG8_WAIT_L(0); PG8_BAR; PG8_MMA(0, 0, At, B0); PG8_MMA(0, 1, At, B1); PG8_BAR; PG8_SCHED;
            PG8_LDA(At, 1, 1); PG8_STAGE(PG8_SB(1, 0), b3, voffB); PG8_STAGE(PG8_SB(1, 1), b3 + hstep, voffB); PG8_STAGE(PG8_SA(1, 0), a3, voffA);
            PG8_WAIT_V(8); PG8_WAIT_L(0); PG8_BAR; PG8_MMA(1, 0, At, B0); PG8_MMA(1, 1, At, B1); PG8_BAR; PG8_SCHED;
            } else {
            PG8_LDB(B0, 0, 0); PG8_SCHED; PG8_LDA(At, 0, 0); PG8_STAGE(PG8_SA(1, 1), a1 + hstep, voffA);
            PG8_WAIT_L(8); PG8_BAR; PG8_WAIT_L(0); PG8_MMA(0, 0, At, B0); PG8_BAR; PG8_SCHED;
            PG8_LDB(B1, 0, 1); PG8_STAGE(PG8_SB(0, 0), b2, voffB);
            PG8_BAR; PG8_WAIT_L(0); PG8_MMA(0, 1, At, B1); PG8_BAR;
            PG8_LDA(At, 0, 1); PG8_STAGE(PG8_SA(0, 0), a2, voffA);
            PG8_BAR; PG8_WAIT_L(0); PG8_MMA(1, 0, At, B0); PG8_BAR; PG8_SCHED;
            PG8_STAGE(PG8_SB(0, 1), b2 + hstep, voffB);
            PG8_WAIT_V(6); PG8_BAR; PG8_MMA(1, 1, At, B1); PG8_BAR;
            PG8_LDB(B0, 1, 0); PG8_SCHED; PG8_LDA(At, 1, 0); PG8_STAGE(PG8_SA(0, 1), a2 + hstep, voffA);
            PG8_WAIT_L(8); PG8_BAR; PG8_WAIT_L(0); PG8_MMA(0, 0, At, B0); PG8_BAR; PG8_SCHED;
            PG8_LDB(B1, 1, 1); PG8_STAGE(PG8_SB(1, 0), b3, voffB);
            PG8_BAR; PG8_WAIT_L(0); PG8_MMA(0, 1, At, B1); PG8_BAR;
            PG8_LDA(At, 1, 1); PG8_STAGE(PG8_SA(1, 0), a3, voffA);
            PG8_BAR; PG8_WAIT_L(0); PG8_MMA(1, 0, At, B0); PG8_BAR; PG8_SCHED;
            PG8_STAGE(PG8_SB(1, 1), b3 + hstep, voffB);
            PG8_WAIT_V(6); PG8_BAR; PG8_MMA(1, 1, At, B1); PG8_BAR;
            }
        }
        if constexpr (ALIGN_EPI) { if (wr == 0) PG8_BAR; }
        if constexpr (!Epi::AFTER_DRAIN) { E(acc, cur, wr, wc, fr, fq); S.done(cur); }
        if (!has_next) break;
#pragma unroll
        for (int a = 0; a < 2; ++a)
#pragma unroll
            for (int b = 0; b < 2; ++b)
#pragma unroll
                for (int m = 0; m < 4; ++m)
#pragma unroll
                    for (int n = 0; n < 2; ++n) acc[a][b][m][n] = (f32x4){0.f, 0.f, 0.f, 0.f};
        cur = nxt; cA = nA; cB = nB; ++ui;
        if constexpr (ALIGN_EPI) { if (wr == 1) PG8_BAR; }
    }
    PG8_WAIT_V(0);
    if constexpr (!ALIGN_EPI) { if (wr == 0) PG8_BAR; }
    PG8_BAR;
    if constexpr (Epi::AFTER_DRAIN) { E.fused(acc, cur, wr, wc, fr, fq, lds, wid, lane); S.done(cur); }
#undef PG8_SA
#undef PG8_SB
#undef PG8_STAGE
#undef PG8_LDA
#undef PG8_LDB
#undef PG8_MMA
#undef PG8_WAIT_V
#undef PG8_WAIT_L
#undef PG8_BAR
#undef PG8_SCHED
}
}

constexpr int NWAVES = 8;
#ifndef MK_N_LAUNCHES
#define MK_N_LAUNCHES 1
#endif
constexpr int PER_PHASE = 9;
#ifndef MK_LAST_PHASE
#define MK_LAST_PHASE 9
#endif
constexpr int N_LAUNCHES = MK_N_LAUNCHES;
constexpr int M = 8192, SEQ = 4096, DM = 2048, INW = 10240, NEXP = 16384;
constexpr float RMS_EPS = 1e-6f;
constexpr size_t MiB = 1u << 20;
constexpr size_t WS_CTL = 0, CTL_ZERO_BYTES = 1 * MiB;
constexpr size_t WS_SS = 256 * 1024, WS_KSUM = 512 * 1024;
constexpr size_t WS_WIN = 2 * MiB, WS_WBC = 42 * MiB, WS_WBA = 46 * MiB, WS_WOUT = 50 * MiB, WS_WPQ = 58 * MiB, WS_KEYS = 66 * MiB, WS_CS = 67 * MiB;
constexpr size_t WS_UB = 70 * MiB, WS_VB = 134 * MiB;
constexpr size_t WS_XB = 198 * MiB;
constexpr size_t WS_T6 = 230 * MiB;
constexpr size_t WS_GAB = 326 * MiB;
constexpr size_t WS_UC = 390 * MiB, WS_AO = 406 * MiB;
constexpr size_t WS_EXP = 422 * MiB, WS_GATE = 426 * MiB;
constexpr size_t WS_END = 430 * MiB;
constexpr size_t WS_TMP = WS_XB, WS_MB = WS_T6, WS_X1B = WS_T6 + 48 * MiB, WS_QP = WS_GAB;
constexpr int CW_BAR = 4096;
constexpr int RING_OFF = 0, RING_BYTES = 131072;
constexpr int LDSCTL_OFF = RING_BYTES, MISC_OFF = LDSCTL_OFF + 320;
constexpr int LDS_BYTES = 147456;

#define GAS __attribute__((address_space(1)))
#define LAS __attribute__((address_space(3)))
typedef unsigned short bf16;
typedef unsigned v4u __attribute__((ext_vector_type(4)));
typedef float f32x4 __attribute__((ext_vector_type(4)));
typedef short bf16x8 __attribute__((ext_vector_type(8)));
typedef GAS unsigned gu32;
typedef GAS unsigned long long gu64;
#define RLX_AGENT __ATOMIC_RELAXED, __HIP_MEMORY_SCOPE_AGENT
#define LDS_WAIT() asm volatile("s_waitcnt lgkmcnt(0)" ::: "memory")
#define VM_WAIT() asm volatile("s_waitcnt vmcnt(0)" ::: "memory")
__device__ __forceinline__ unsigned long long rt() { return __builtin_amdgcn_s_memrealtime(); }
__device__ __forceinline__ unsigned f2bf(float f) { unsigned u = __builtin_bit_cast(unsigned, f); return (u + 0x7fffu + ((u >> 16) & 1u)) >> 16; }
__device__ __forceinline__ unsigned pk2(float lo, float hi) { return f2bf(lo) | (f2bf(hi) << 16); }

#define XB_TMO      128
#define XB_XCNT(j)  (256  + 64 * (j))
#define XB_XSUB(j)  (1280 + 64 * (j))
#define XB_XGEN(j)  (2304 + 64 * (j))
#define XB_TOP      3328
#define XB_TOPGEN   3392
#define XCD_BAR_WORDS 3456
#define XB_SPIN_CAP (1u << 18)

__device__ __forceinline__ unsigned xb_ld(unsigned* p)              { return __hip_atomic_load(p, __ATOMIC_RELAXED, __HIP_MEMORY_SCOPE_AGENT); }
__device__ __forceinline__ unsigned xb_add(unsigned* p, unsigned v) { return __hip_atomic_fetch_add(p, v, __ATOMIC_RELAXED, __HIP_MEMORY_SCOPE_AGENT); }
__device__ __forceinline__ unsigned xb_xcc_id() { return (unsigned)__builtin_amdgcn_s_getreg((3 << 11) | 20) & 0xFu; }
#define XB_SPIN(cond, bar) do { unsigned _sp = 0; while (cond) { __builtin_amdgcn_s_sleep(1); \
    if ((++_sp & 255u) == 0u) { if (xb_ld(&(bar)[XB_TMO])) break; if (_sp > XB_SPIN_CAP) { atomicAdd(&(bar)[XB_TMO], 1u); break; } } } } while (0)

struct XcdBarrier {
    unsigned* bar; unsigned x;
    volatile LAS unsigned* st;
};

__device__ __forceinline__ XcdBarrier xcd_barrier_post(unsigned* bar, volatile LAS unsigned* st) {
    XcdBarrier b; b.bar = bar; b.x = xb_xcc_id(); b.st = st;
    if (threadIdx.x == 0) (void)xb_add(&bar[XB_XCNT(b.x)], 1u);
    return b;
}
__device__ __forceinline__ void xcd_barrier_complete(unsigned* bar, unsigned x, unsigned& nloc, unsigned& nx) {
    const unsigned G = gridDim.x * gridDim.y * gridDim.z;
    unsigned sum, cnt, mine, sp = 0u;
    for (;;) {
        sum = 0u; cnt = 0u; mine = 0u;
#pragma unroll
        for (unsigned j = 0; j < 16; ++j) { const unsigned c = xb_ld(&bar[XB_XCNT(j)]); sum += c; cnt += (c > 0u) ? 1u : 0u; mine = (j == x) ? c : mine; }
        if (sum == G) break;
        __builtin_amdgcn_s_sleep(1);
        if ((++sp & 255u) == 0u) { if (xb_ld(&bar[XB_TMO])) break; if (sp > XB_SPIN_CAP) { atomicAdd(&bar[XB_TMO], 1u); break; } }
    }
    nloc = mine > 0u ? mine : 1u; nx = cnt > 0u ? cnt : 1u;
}

__device__ __forceinline__ void xcd_barrier(const XcdBarrier& b) {
    asm volatile("s_waitcnt vmcnt(0)" ::: "memory");
    __syncthreads();
    if (threadIdx.x == 0) {
        unsigned* bar = b.bar;
        __builtin_amdgcn_s_waitcnt(0);
        unsigned nloc = b.st[0], nx = b.st[1];
        if (nloc == 0u) { xcd_barrier_complete(bar, b.x, nloc, nx); b.st[0] = nloc; b.st[1] = nx; }
        const unsigned old = xb_add(&bar[XB_XSUB(b.x)], 1u);
        const unsigned gen = old / nloc;
        if (old + 1u == (gen + 1u) * nloc) {
            __builtin_amdgcn_fence(__ATOMIC_RELEASE, "agent");
            asm volatile("s_waitcnt vmcnt(0)" ::: "memory");
            const unsigned og = xb_add(&bar[XB_TOP], 1u);
            const unsigned tg = og / nx;
            if (og + 1u == (tg + 1u) * nx) xb_add(&bar[XB_TOPGEN], 1u);
            else XB_SPIN(xb_ld(&bar[XB_TOPGEN]) == tg, bar);
            __builtin_amdgcn_fence(__ATOMIC_ACQUIRE, "agent");
            xb_add(&bar[XB_XGEN(b.x)], 1u);
            asm volatile("s_waitcnt vmcnt(0)" ::: "memory");
        } else {
            XB_SPIN(xb_ld(&bar[XB_XGEN(b.x)]) == gen, bar);
            __builtin_amdgcn_fence(__ATOMIC_ACQUIRE, "agent");
            asm volatile("s_waitcnt vmcnt(0)" ::: "memory");
        }
    }
    __syncthreads();
}

typedef __bf16 bf16x2v __attribute__((ext_vector_type(2)));
typedef float f32x16 __attribute__((ext_vector_type(16)));
__device__ __forceinline__ float bflo(unsigned w) { return __uint_as_float(w << 16); }
__device__ __forceinline__ float bfhi(unsigned w) { return __uint_as_float(w & 0xffff0000u); }
__device__ __forceinline__ float dot2bf(unsigned a, unsigned b, float c) { return __builtin_amdgcn_fdot2_f32_bf16(__builtin_bit_cast(bf16x2v, a), __builtin_bit_cast(bf16x2v, b), c, false); }
__device__ __forceinline__ float wave_sum(float v) {
#pragma unroll
    for (int o = 1; o < 64; o <<= 1) v += __shfl_xor(v, o);
    return v; }
__device__ __forceinline__ float wave_max(float v) {
#pragma unroll
    for (int o = 1; o < 64; o <<= 1) v = fmaxf(v, __shfl_xor(v, o));
    return v; }
__device__ __forceinline__ float rdlane(float v, int l) { return __int_as_float(__builtin_amdgcn_readlane(__float_as_int(v), l)); }
__device__ __forceinline__ float gelu_tanh(float x) { const float z = 0.7978845608028654f * (x + 0.044715f * x * x * x); const float e = __expf(2.0f * z); const float th = 1.0f - 2.0f * __builtin_amdgcn_rcpf(1.0f + e); return 0.5f * x * (1.0f + th); }

struct Ctx { LAS unsigned char* lds; int tid, lane, wave, vcu, G; };

__device__ __forceinline__ void p0_transpose_item(const float* W, int K, int N, bf16* WT, const float* gk, LAS float* scr, int item, int lane) {
    const int nblk = N / 32, kb = item / nblk, nb = item % nblk, k0 = 64 * kb, n0 = 32 * nb;
#pragma unroll 8
    for (int i = 0; i < 32; ++i) { const int kk = 2 * i + (lane >> 5); float v = W[(size_t)(k0 + kk) * N + n0 + (lane & 31)]; if (gk) v *= gk[k0 + kk]; scr[kk * 33 + (lane & 31)] = v; }
    LDS_WAIT(); asm volatile("" ::: "memory");
    const int c = lane & 7;
#pragma unroll
    for (int j = 0; j < 4; ++j) { const int n = (lane >> 3) + 8 * j; const LAS float* s = scr + (8 * c) * 33 + n;
        v4u o; o.x = pk2(s[0 * 33], s[1 * 33]); o.y = pk2(s[2 * 33], s[3 * 33]); o.z = pk2(s[4 * 33], s[5 * 33]); o.w = pk2(s[6 * 33], s[7 * 33]);
        *(GAS v4u*)(WT + (size_t)(n0 + n) * K + k0 + 8 * c) = o; }
    LDS_WAIT(); asm volatile("" ::: "memory");
}
__device__ __forceinline__ void p0_prologue(const Ctx& F, const float* const* in, unsigned char* ws, const double* invf) {
    const float* x = in[0]; const int* pos = (const int*)in[1]; const float* g1 = in[2]; const float* w_in = in[3];
    const float* w_bc = in[6]; const float* w_ba = in[7]; const float* w_out = in[8]; const float* g2 = in[9]; const float* w_pq = in[10];
    const float* keys = in[11]; const float* pu = in[12]; const float* pv = in[13];
    LAS float* scr = (LAS float*)(F.lds + RING_OFF + F.wave * 16384);
    const int gw = F.vcu * NWAVES + F.wave, NGW = F.G * NWAVES;
    const int gt = gw * 64 + F.lane, NT = NGW * 64;
    for (int i = gt; i < 8192; i += NT) ((GAS unsigned long long*)(ws + WS_SS))[i] = 0ull;
    for (int i = gt; i < 32 * 1024; i += NT) ((GAS float*)(ws + WS_KSUM))[i] = 0.f;
    constexpr int I_IN = 32 * 320, I_BC = 16 * 64, I_OUT = 32 * 64;
    constexpr int NITEMS = I_IN + 2 * I_BC + 2 * I_OUT;
    for (int it = gw; it < NITEMS; it += NGW) {
        int r = it;
        if (r < I_IN) { p0_transpose_item(w_in, 2048, INW, (bf16*)(ws + WS_WIN), g1, scr, r, F.lane); continue; } r -= I_IN;
        if (r < I_BC) { p0_transpose_item(w_bc, 1024, 2048, (bf16*)(ws + WS_WBC), nullptr, scr, r, F.lane); continue; } r -= I_BC;
        if (r < I_BC) { p0_transpose_item(w_ba, 1024, 2048, (bf16*)(ws + WS_WBA), nullptr, scr, r, F.lane); continue; } r -= I_BC;
        if (r < I_OUT) { p0_transpose_item(w_out, 2048, 2048, (bf16*)(ws + WS_WOUT), nullptr, scr, r, F.lane); continue; } r -= I_OUT;
        p0_transpose_item(w_pq, 2048, 2048, (bf16*)(ws + WS_WPQ), g2, scr, r, F.lane);
    }
    for (int i = gt; i < 16 * 128 * 128 / 8; i += NT) { const f32x4 a = ((const GAS f32x4*)keys)[2 * i], b = ((const GAS f32x4*)keys)[2 * i + 1];
        v4u o; o.x = pk2(a[0], a[1]); o.y = pk2(a[2], a[3]); o.z = pk2(b[0], b[1]); o.w = pk2(b[2], b[3]); ((GAS v4u*)(ws + WS_KEYS))[i] = o; }
    for (int i = gt; i < NEXP * 2048 / 8; i += NT) { const int c8 = (i & 255) * 8;
        f32x4 a = ((const GAS f32x4*)pu)[2 * i], b = ((const GAS f32x4*)pu)[2 * i + 1]; a = a * *(const GAS f32x4*)(g2 + c8); b = b * *(const GAS f32x4*)(g2 + c8 + 4);
        v4u o; o.x = pk2(a[0], a[1]); o.y = pk2(a[2], a[3]); o.z = pk2(b[0], b[1]); o.w = pk2(b[2], b[3]); ((GAS v4u*)(ws + WS_UB))[i] = o;
        a = ((const GAS f32x4*)pv)[2 * i]; b = ((const GAS f32x4*)pv)[2 * i + 1];
        o.x = pk2(a[0], a[1]); o.y = pk2(a[2], a[3]); o.z = pk2(b[0], b[1]); o.w = pk2(b[2], b[3]); ((GAS v4u*)(ws + WS_VB))[i] = o; }
    for (int m = gw; m < M; m += NGW) { const GAS f32x4* xr = (const GAS f32x4*)(x + (size_t)m * DM);
        f32x4 v[8]; float s = 0.f;
#pragma unroll
        for (int i = 0; i < 4; ++i) { v[2 * i] = xr[i * 128 + 2 * F.lane]; v[2 * i + 1] = xr[i * 128 + 2 * F.lane + 1]; }
#pragma unroll
        for (int i = 0; i < 8; ++i) s += (v[i][0] * v[i][0] + v[i][1] * v[i][1]) + (v[i][2] * v[i][2] + v[i][3] * v[i][3]);
        const float rinv = 1.0f / sqrtf(wave_sum(s) * (1.0f / DM) + RMS_EPS);
        GAS v4u* o = (GAS v4u*)(ws + WS_XB + (size_t)m * DM * 2);
#pragma unroll
        for (int i = 0; i < 4; ++i) { const f32x4 a = v[2 * i] * rinv, b = v[2 * i + 1] * rinv; v4u w; w.x = pk2(a[0], a[1]); w.y = pk2(a[2], a[3]); w.z = pk2(b[0], b[1]); w.w = pk2(b[2], b[3]); o[i * 64 + F.lane] = w; } }
    for (int i = gt; i < M * 16; i += NT) { const int row = i >> 4, f = i & 15; const double ang = (double)pos[row] * invf[f];
        const double k = __builtin_rint(ang * 0.15915494309189535); const float r = (float)(ang - k * 6.283185307179586);
        float* cs = (float*)(ws + WS_CS); cs[row * 32 + f] = __cosf(r); cs[row * 32 + 16 + f] = __sinf(r); }
}

__device__ __forceinline__ void attn_simple(const Ctx& F, const bf16* Q, const bf16* K, const bf16* V, const float* ksum, bf16* AO) {
    LAS float* qf = (LAS float*)(F.lds + RING_OFF + F.wave * 512);
    const int gw = F.vcu * NWAVES + F.wave, NGW = F.G * NWAVES, lane = F.lane;
    for (int item = gw; item < 16 * SEQ; item += NGW) {
        const int bh = item >> 12, t = item & 4095, b = bh >> 3, h = bh & 7, blk = t >> 8;
        const size_t row = (size_t)b * SEQ + t;
        { const unsigned qq = *(const GAS unsigned*)(Q + row * 1024 + h * 128 + 2 * lane); qf[2 * lane] = bflo(qq); qf[2 * lane + 1] = bfhi(qq); }
        LDS_WAIT(); asm volatile("" ::: "memory");
        float g = -INFINITY;
        if (lane < blk) { const GAS f32x4* km = (const GAS f32x4*)(ksum + (size_t)(b * 16 + lane) * 1024 + h * 128); float a = 0.f;
            for (int d = 0; d < 32; ++d) { const f32x4 kv = km[d]; const f32x4 qv = *(const LAS f32x4*)(qf + 4 * d); a += (kv[0] * qv[0] + kv[1] * qv[1]) + (kv[2] * qv[2] + kv[3] * qv[3]); }
            g = a; }
        int sel[3];
#pragma unroll
        for (int i = 0; i < 3; ++i) { const float mx = wave_max(g); const unsigned long long bal = __ballot(g == mx && lane < blk); const int idx = bal ? (__ffsll((long long)bal) - 1) : 0; sel[i] = idx; if (lane == idx) g = -INFINITY; }
        const int nsel = blk < 3 ? blk : 3;
        float sc[4][4]; float mx = -INFINITY;
#pragma unroll
        for (int slot = 0; slot < 4; ++slot) {
            const bool valid = (slot == 3) || (slot < nsel);
            const int kb = (slot == 3) ? blk : sel[slot < 3 ? slot : 0];
#pragma unroll
            for (int r = 0; r < 4; ++r) {
                float s = -INFINITY; const int key0 = kb * 256 + r * 64;
                if (valid && (slot < 3 || key0 <= t)) {
                    const int key = key0 + lane; const GAS v4u* kp = (const GAS v4u*)(K + ((size_t)b * SEQ + key) * 1024 + h * 128); float a = 0.f;
#pragma unroll 4
                    for (int d = 0; d < 16; ++d) { const v4u kk = kp[d]; const f32x4 q0 = *(const LAS f32x4*)(qf + 8 * d), q1 = *(const LAS f32x4*)(qf + 8 * d + 4);
                        a += (bflo(kk.x) * q0[0] + bfhi(kk.x) * q0[1]) + (bflo(kk.y) * q0[2] + bfhi(kk.y) * q0[3]) + (bflo(kk.z) * q1[0] + bfhi(kk.z) * q1[1]) + (bflo(kk.w) * q1[2] + bfhi(kk.w) * q1[3]); }
                    s = (slot < 3 || key <= t) ? a : -INFINITY; }
                sc[slot][r] = s; mx = fmaxf(mx, s); } }
        mx = wave_max(mx);
        float sum = 0.f;
#pragma unroll
        for (int slot = 0; slot < 4; ++slot)
#pragma unroll
            for (int r = 0; r < 4; ++r) { sc[slot][r] = exp2f(sc[slot][r] - mx); sum += sc[slot][r]; }
        sum = wave_sum(sum);
        float o0 = 0.f, o1 = 0.f;
#pragma unroll
        for (int slot = 0; slot < 4; ++slot) {
            const bool valid = (slot == 3) || (slot < nsel);
            const int kb = (slot == 3) ? blk : sel[slot < 3 ? slot : 0];
#pragma unroll
            for (int r = 0; r < 4; ++r) { const int key0 = kb * 256 + r * 64;
                if (valid && (slot < 3 || key0 <= t)) { const float pr = sc[slot][r]; const GAS unsigned* vp = (const GAS unsigned*)(V + ((size_t)b * SEQ + key0) * 1024 + h * 128) + lane;
                    for (int kk = 0; kk < 64; ++kk) { const float pk = rdlane(pr, kk); const unsigned vv = vp[(size_t)kk * 512]; o0 += pk * bflo(vv); o1 += pk * bfhi(vv); } } } }
        const float ri = 1.0f / sum;
        *(GAS unsigned*)(AO + row * 1024 + h * 128 + 2 * lane) = pk2(o0 * ri, o1 * ri);
    }
}
__device__ __forceinline__ void up8(const v4u w, float (&f)[8]) { f[0] = bflo(w.x); f[1] = bfhi(w.x); f[2] = bflo(w.y); f[3] = bfhi(w.y); f[4] = bflo(w.z); f[5] = bfhi(w.z); f[6] = bflo(w.w); f[7] = bfhi(w.w); }
__device__ __forceinline__ void conv_phase(const Ctx& F, const bf16* CB, const bf16* CC, const bf16* CX, const float* cw, bf16* UC) {
    const int gt = (F.vcu * NWAVES + F.wave) * 64 + F.lane, NT = F.G * NWAVES * 64;
    for (int idx = gt; idx < M * 128; idx += NT) {
        const int row = idx >> 7, c8 = (idx & 127) << 3, t = row & (SEQ - 1); const size_t off = (size_t)row * 1024 + c8;
        float cb[8], a[8], x[8], z0[8], z1[8], z2[8];
        up8(*(const GAS v4u*)(CB + off), cb); up8(*(const GAS v4u*)(CC + off), a); up8(*(const GAS v4u*)(CX + off), x);
#pragma unroll
        for (int j = 0; j < 8; ++j) z0[j] = a[j] * x[j];
        if (t >= 1) { up8(*(const GAS v4u*)(CC + off - 1024), a); up8(*(const GAS v4u*)(CX + off - 1024), x);
#pragma unroll
            for (int j = 0; j < 8; ++j) z1[j] = a[j] * x[j]; } else {
#pragma unroll
            for (int j = 0; j < 8; ++j) z1[j] = 0.f; }
        if (t >= 2) { up8(*(const GAS v4u*)(CC + off - 2048), a); up8(*(const GAS v4u*)(CX + off - 2048), x);
#pragma unroll
            for (int j = 0; j < 8; ++j) z2[j] = a[j] * x[j]; } else {
#pragma unroll
            for (int j = 0; j < 8; ++j) z2[j] = 0.f; }
        float o[8];
#pragma unroll
        for (int j = 0; j < 8; ++j) o[j] = cb[j] * (cw[c8 + j] * z2[j] + cw[1024 + c8 + j] * z1[j] + cw[2048 + c8 + j] * z0[j]);
        v4u w; w.x = pk2(o[0], o[1]); w.y = pk2(o[2], o[3]); w.z = pk2(o[4], o[5]); w.w = pk2(o[6], o[7]); *(GAS v4u*)(UC + off) = w;
    }
}

__device__ const unsigned char CAND50[64] = {
    0x00,0x01,0x02,0x03,0x04,0x05,0x06,0x07,0x08,0x09,0x0a,0x0b,0x0c,0x0d,0x0e,0x0f,
    0x10,0x11,0x12,0x13,0x14,0x15,0x16,0x17, 0x20,0x21,0x22,0x23,0x24, 0x30,0x31,0x32,0x33, 0x40,0x41,0x42, 0x50,0x51, 0x60,0x61, 0x70,0x71,
    0x80,0x90,0xa0,0xb0,0xc0,0xd0,0xe0,0xf0, 0xff,0xff,0xff,0xff,0xff,0xff,0xff,0xff,0xff,0xff,0xff,0xff,0xff,0xff};
__device__ __forceinline__ int ord_key(float f) { const int u = __float_as_int(f); return u >= 0 ? u : (u ^ 0x7fffffff); }
__device__ __forceinline__ float ord_val(int k) { return __int_as_float(k >= 0 ? k : (k ^ 0x7fffffff)); }
__device__ __forceinline__ int hmax32(int v) {
#pragma unroll
    for (int o = 1; o < 32; o <<= 1) { const int w = __shfl_xor(v, o); v = v > w ? v : w; }
    return v; }
__device__ __forceinline__ void topk_phase(const Ctx& F, const bf16* QP, const bf16* KEYS, int* EXP, float* GATE) {
    const int gw = F.vcu * NWAVES + F.wave, NGW = F.G * NWAVES, lane = F.lane, l31 = lane & 31, hi = lane >> 5;
    const int IMIN = (int)0x80000000;
    for (int item = gw; item < 256 * 8; item += NGW) {
        const int tt = item >> 3, h = item & 7, tok0 = tt * 32;
        int tops[2][16];
#pragma unroll
        for (int p = 0; p < 2; ++p) {
            f32x16 sc[4];
#pragma unroll
            for (int nt = 0; nt < 4; ++nt)
#pragma unroll
                for (int r = 0; r < 16; ++r) sc[nt][r] = 0.f;
#pragma unroll
            for (int s = 0; s < 8; ++s) {
                const bf16x8 a = *(const GAS bf16x8*)(QP + (size_t)(tok0 + l31) * 2048 + h * 256 + p * 128 + 16 * s + 8 * hi);
#pragma unroll
                for (int nt = 0; nt < 4; ++nt) { const bf16x8 bb = *(const GAS bf16x8*)(KEYS + (size_t)((h * 2 + p) * 128 + 32 * nt + l31) * 128 + 16 * s + 8 * hi);
                    sc[nt] = __builtin_amdgcn_mfma_f32_32x32x16_bf16(a, bb, sc[nt], 0, 0, 0); }
            }
#pragma unroll
            for (int r = 0; r < 16; ++r) {
                int k0 = (ord_key(sc[0][r]) & ~127) | (127 - l31), k1 = (ord_key(sc[1][r]) & ~127) | (95 - l31), k2 = (ord_key(sc[2][r]) & ~127) | (63 - l31), k3 = (ord_key(sc[3][r]) & ~127) | (31 - l31);
                int mytop = IMIN;
#pragma unroll 1
                for (int i = 0; i < 16; ++i) { int m = k0 > k1 ? k0 : k1; const int m2 = k2 > k3 ? k2 : k3; m = m > m2 ? m : m2; m = hmax32(m);
                    if (l31 == i) mytop = m;
                    k0 = (k0 == m) ? IMIN : k0; k1 = (k1 == m) ? IMIN : k1; k2 = (k2 == m) ? IMIN : k2; k3 = (k3 == m) ? IMIN : k3; }
                tops[p][r] = mytop;
            }
        }
        const int cd0 = CAND50[l31], cd1 = CAND50[32 + l31];
#pragma unroll
        for (int r = 0; r < 16; ++r) {
            const int ta = tops[0][r], tb = tops[1][r], base = 32 * hi;
            const int a0 = __shfl(ta, base + (cd0 >> 4)), b0 = __shfl(tb, base + (cd0 & 15)), a1 = __shfl(ta, base + ((cd1 >> 4) & 15)), b1 = __shfl(tb, base + (cd1 & 15));
            const float s0 = ord_val(a0 & ~127) + ord_val(b0 & ~127), s1 = ord_val(a1 & ~127) + ord_val(b1 & ~127);
            int c0 = (ord_key(s0) & ~255) | (255 - cd0), c1 = (cd1 == 0xff) ? IMIN : ((ord_key(s1) & ~255) | (255 - cd1));
            int best = IMIN;
#pragma unroll 1
            for (int i = 0; i < 16; ++i) { int m = c0 > c1 ? c0 : c1; m = hmax32(m); if (l31 == i) best = m; c0 = (c0 == m) ? IMIN : c0; c1 = (c1 == m) ? IMIN : c1; }
            const int posn = 255 - (best & 255), bi = (posn >> 4) & 15, bj = posn & 15;
            const int n1 = 127 - (__shfl(ta, base + bi) & 127), n2 = 127 - (__shfl(tb, base + bj) & 127);
            const float sv = ord_val(best & ~255), smax = __shfl(sv, base);
            float e = (l31 < 16) ? __expf(sv - smax) : 0.f; float es = e;
#pragma unroll
            for (int o = 1; o < 32; o <<= 1) es += __shfl_xor(es, o);
            const int token = tok0 + (r & 3) + 8 * (r >> 2) + 4 * hi;
            if (l31 < 16) { EXP[(size_t)token * 128 + h * 16 + l31] = n1 * 128 + n2; GATE[(size_t)token * 128 + h * 16 + l31] = e / es; }
        }
    }
}

template <int D> __device__ __forceinline__ void tr_step(float (&part)[64], int lane) {
    const bool up_ = (lane & D) != 0;
#pragma unroll
    for (int i = 0; i < D; ++i) { const float a = part[i], b = part[i + D]; const float send = up_ ? a : b, keep = up_ ? b : a; part[i] = keep + __shfl_xor(send, D); }
}
__device__ __forceinline__ void peer_phase(const Ctx& F, const bf16* UB, const bf16* VB, const bf16* X1B, const int* EXP, const float* GATE, const unsigned long long* SS, const float* gfin, float* X1) {
    const int gw = F.vcu * NWAVES + F.wave, NGW = F.G * NWAVES, lane = F.lane;
    constexpr int NPF = 4;
    for (int t = gw; t < M; t += NGW) {
        const int e01[2] = { EXP[(size_t)t * 128 + lane], EXP[(size_t)t * 128 + 64 + lane] };
        const float g01[2] = { GATE[(size_t)t * 128 + lane], GATE[(size_t)t * 128 + 64 + lane] };
        const float rinv2 = pg8::rinv_from_ss(SS[t]);
        v4u xq[4];
#pragma unroll
        for (int i = 0; i < 4; ++i) xq[i] = *(const GAS v4u*)(X1B + (size_t)t * DM + i * 512 + lane * 8);
        float act[2];
#pragma unroll
        for (int hf = 0; hf < 2; ++hf) {
            const int ev = e01[hf];
            float part[64]; v4u ub[NPF][4];
#pragma unroll
            for (int k = 0; k < NPF; ++k) { const GAS v4u* up = (const GAS v4u*)(UB + (size_t)__builtin_amdgcn_readlane(ev, k) * DM) + lane;
#pragma unroll
                for (int i = 0; i < 4; ++i) ub[k][i] = up[i * 64]; }
#pragma unroll
            for (int k = 0; k < 64; ++k) {
                float p0 = 0.f, p1 = 0.f;
#pragma unroll
                for (int i = 0; i < 4; ++i) { const v4u w = ub[k % NPF][i]; p0 = dot2bf(w.x, xq[i].x, p0); p1 = dot2bf(w.y, xq[i].y, p1); p0 = dot2bf(w.z, xq[i].z, p0); p1 = dot2bf(w.w, xq[i].w, p1); }
                part[k] = p0 + p1;
                if (k + NPF < 64) { const GAS v4u* up = (const GAS v4u*)(UB + (size_t)__builtin_amdgcn_readlane(ev, k + NPF) * DM) + lane;
#pragma unroll
                    for (int i = 0; i < 4; ++i) ub[k % NPF][i] = up[i * 64]; }
            }
            tr_step<32>(part, lane); tr_step<16>(part, lane); tr_step<8>(part, lane); tr_step<4>(part, lane); tr_step<2>(part, lane); tr_step<1>(part, lane);
            act[hf] = gelu_tanh(part[0] * rinv2) * g01[hf];
        }
        float y[32];
#pragma unroll
        for (int j = 0; j < 32; ++j) y[j] = 0.f;
#pragma unroll
        for (int hf = 0; hf < 2; ++hf) {
            const int ev = e01[hf]; const float av = act[hf];
            v4u vb[NPF][4];
#pragma unroll
            for (int k = 0; k < NPF; ++k) { const GAS v4u* vp = (const GAS v4u*)(VB + (size_t)__builtin_amdgcn_readlane(ev, k) * DM) + lane;
#pragma unroll
                for (int i = 0; i < 4; ++i) vb[k][i] = vp[i * 64]; }
#pragma unroll
            for (int k = 0; k < 64; ++k) {
                const float s = rdlane(av, k);
#pragma unroll
                for (int i = 0; i < 4; ++i) { const v4u w = vb[k % NPF][i];
                    y[8 * i + 0] += s * bflo(w.x); y[8 * i + 1] += s * bfhi(w.x); y[8 * i + 2] += s * bflo(w.y); y[8 * i + 3] += s * bfhi(w.y);
                    y[8 * i + 4] += s * bflo(w.z); y[8 * i + 5] += s * bfhi(w.z); y[8 * i + 6] += s * bflo(w.w); y[8 * i + 7] += s * bfhi(w.w); }
                if (k + NPF < 64) { const GAS v4u* vp = (const GAS v4u*)(VB + (size_t)__builtin_amdgcn_readlane(ev, k + NPF) * DM) + lane;
#pragma unroll
                    for (int i = 0; i < 4; ++i) vb[k % NPF][i] = vp[i * 64]; }
            }
        }
        GAS f32x4* xr = (GAS f32x4*)(X1 + (size_t)t * DM); float ss = 0.f;
#pragma unroll
        for (int i = 0; i < 4; ++i) { const f32x4 a = xr[i * 128 + 2 * lane], b = xr[i * 128 + 2 * lane + 1];
            y[8 * i + 0] += a[0]; y[8 * i + 1] += a[1]; y[8 * i + 2] += a[2]; y[8 * i + 3] += a[3]; y[8 * i + 4] += b[0]; y[8 * i + 5] += b[1]; y[8 * i + 6] += b[2]; y[8 * i + 7] += b[3]; }
#pragma unroll
        for (int j = 0; j < 32; ++j) ss += y[j] * y[j];
        const float r3 = 1.0f / sqrtf(wave_sum(ss) * (1.0f / DM) + RMS_EPS);
#pragma unroll
        for (int i = 0; i < 4; ++i) { const f32x4 ga = *(const GAS f32x4*)(gfin + i * 512 + lane * 8), gb = *(const GAS f32x4*)(gfin + i * 512 + lane * 8 + 4);
            xr[i * 128 + 2 * lane] = (f32x4){y[8 * i + 0] * r3 * ga[0], y[8 * i + 1] * r3 * ga[1], y[8 * i + 2] * r3 * ga[2], y[8 * i + 3] * r3 * ga[3]};
            xr[i * 128 + 2 * lane + 1] = (f32x4){y[8 * i + 4] * r3 * gb[0], y[8 * i + 5] * r3 * gb[1], y[8 * i + 6] * r3 * gb[2], y[8 * i + 7] * r3 * gb[3]}; }
    }
}
struct Args { const float* in[15]; float* out; unsigned char* ws; double invf[16]; int ph_lo, ph_hi, li, pad; };
__global__ void __launch_bounds__(NWAVES * 64, 2) mk_fwd(Args args) {
    extern __shared__ __attribute__((aligned(16))) unsigned char lds[];
    Ctx F;
    F.lds = (LAS unsigned char*)lds;
    volatile LAS unsigned* MISC = (volatile LAS unsigned*)(F.lds + MISC_OFF);
    F.tid = threadIdx.x; F.lane = F.tid & 63; F.wave = __builtin_amdgcn_readfirstlane(F.tid >> 6);
    F.G = gridDim.x; { const int bx = blockIdx.x; F.vcu = (F.G % 8 == 0) ? (bx % 8) * (F.G / 8) + bx / 8 : bx; }
    unsigned char* ws = args.ws;
    gu32* ctl = (gu32*)(ws + WS_CTL);
    for (int u = F.tid; u < (LDS_BYTES - LDSCTL_OFF) / 4; u += NWAVES * 64) ((LAS unsigned*)(F.lds + LDSCTL_OFF))[u] = 0u;
    __syncthreads();
    XcdBarrier bar; bar.bar = (unsigned*)(ctl + CW_BAR); bar.x = 0; bar.st = nullptr;
    if (N_LAUNCHES != PER_PHASE) bar = xcd_barrier_post((unsigned*)(ctl + CW_BAR), MISC + 8);
#define GRID_BAR() do { if (N_LAUNCHES != PER_PHASE) xcd_barrier(bar); } while (0)
    const int lo = args.ph_lo, hi = args.ph_hi;
#define IN(k) (lo <= (k) && (k) < hi)
#define BOTH(k) (IN(k) && IN((k) + 1))
    bf16* WinT = (bf16*)(ws + WS_WIN); bf16* WbcT = (bf16*)(ws + WS_WBC); bf16* WbaT = (bf16*)(ws + WS_WBA); bf16* WoutT = (bf16*)(ws + WS_WOUT); bf16* WpqT = (bf16*)(ws + WS_WPQ);
    bf16* KEYS = (bf16*)(ws + WS_KEYS); float* CS = (float*)(ws + WS_CS); bf16* UB = (bf16*)(ws + WS_UB); bf16* VB = (bf16*)(ws + WS_VB);
    bf16* XB = (bf16*)(ws + WS_XB); bf16* T6 = (bf16*)(ws + WS_T6); bf16* GAB = (bf16*)(ws + WS_GAB); bf16* UC = (bf16*)(ws + WS_UC); bf16* AO = (bf16*)(ws + WS_AO);
    bf16* TMP = (bf16*)(ws + WS_TMP); bf16* MB = (bf16*)(ws + WS_MB); bf16* X1B = (bf16*)(ws + WS_X1B); bf16* QP = (bf16*)(ws + WS_QP);
    int* EXP = (int*)(ws + WS_EXP); float* GATE = (float*)(ws + WS_GATE);
    unsigned long long* SS = (unsigned long long*)(ws + WS_SS); float* KSUM = (float*)(ws + WS_KSUM);
    constexpr size_t TS = (size_t)M * 1024;

    if (IN(0)) { p0_prologue(F, args.in, ws, args.invf); if (BOTH(0)) GRID_BAR(); }
    if (IN(1)) {
        pg8::Gemm g{XB, WinT, M, INW, DM}; pg8::StaticOrder S; S.init(M, INW, F.G, (int)blockIdx.x);
        pg8::EpiIn E{T6, GAB, args.in[4], CS, KSUM};
        pg8::gemm_phase<pg8::EpiIn, pg8::StaticOrder, true, true>(F.lds + RING_OFF, g, S, E);
        if (BOTH(1)) GRID_BAR();
    }
    if (IN(2)) {
        attn_simple(F, T6 + 3 * TS, T6 + 4 * TS, T6 + 5 * TS, KSUM, AO);
        conv_phase(F, T6, T6 + TS, T6 + 2 * TS, args.in[5], UC);
        if (BOTH(2)) GRID_BAR();
    }
    if (IN(3)) {
        pg8::Gemm g{UC, WbcT, M, DM, 1024}; pg8::StaticOrder S; S.init(M, DM, F.G, (int)blockIdx.x);
        pg8::EpiTmp E{GAB, TMP};
        pg8::gemm_phase<pg8::EpiTmp, pg8::StaticOrder, true, true>(F.lds + RING_OFF, g, S, E);
        if (BOTH(3)) GRID_BAR();
    }
    if (IN(4)) {
        pg8::Gemm g{AO, WbaT, M, DM, 1024}; pg8::StaticOrder S; S.init(M, DM, F.G, (int)blockIdx.x);
        pg8::EpiMerge E{GAB + (size_t)M * DM, TMP, MB};
        pg8::gemm_phase<pg8::EpiMerge, pg8::StaticOrder, true, true>(F.lds + RING_OFF, g, S, E);
        if (BOTH(4)) GRID_BAR();
    }
    if (IN(5)) {
        pg8::Gemm g{MB, WoutT, M, DM, DM}; pg8::StaticOrder S; S.init(M, DM, F.G, (int)blockIdx.x);
        pg8::EpiX1 E{args.in[0], args.out, X1B, SS};
        pg8::gemm_phase<pg8::EpiX1, pg8::StaticOrder, true, true>(F.lds + RING_OFF, g, S, E);
        if (BOTH(5)) GRID_BAR();
    }
    if (IN(6)) {
        pg8::Gemm g{X1B, WpqT, M, DM, DM}; pg8::StaticOrder S; S.init(M, DM, F.G, (int)blockIdx.x);
        pg8::EpiQP E{SS, QP};
        pg8::gemm_phase<pg8::EpiQP, pg8::StaticOrder, true, true>(F.lds + RING_OFF, g, S, E);
        if (BOTH(6)) GRID_BAR();
    }
    if (IN(7)) { topk_phase(F, QP, KEYS, EXP, GATE); if (BOTH(7)) GRID_BAR(); }
    if (IN(8)) { peer_phase(F, UB, VB, X1B, EXP, GATE, SS, args.in[14], args.out); }
#undef IN
#undef BOTH
#undef GRID_BAR
}

#ifndef MK_DUMP_OFF
#define MK_DUMP_OFF WS_GAB
#endif
__global__ void dump_f32(const float* src, float* dst, int n, int nsrc) { for (int i = blockIdx.x * blockDim.x + threadIdx.x; i < n; i += gridDim.x * blockDim.x) dst[i] = src[i % nsrc]; }
__global__ void dump_bf16(const unsigned short* src, float* dst, int n) { for (int i = blockIdx.x * blockDim.x + threadIdx.x; i < n; i += gridDim.x * blockDim.x) dst[i] = __uint_as_float((unsigned)src[i] << 16); }
extern "C" void kernel_launch(void* const* d_in, const int* in_sizes, int n_in, void* d_out, int out_size, void* d_ws, size_t ws_size, hipStream_t stream) {
    static int grid = 0;
    if (grid == 0) {
        if (n_in != 15 || in_sizes[0] != M * DM || out_size != M * DM || ws_size < WS_END) { fprintf(stderr, "kernel_launch: unexpected shapes (n_in %d, in0 %d, out %d, ws %zu)\n", n_in, n_in > 0 ? in_sizes[0] : -1, out_size, ws_size); grid = -1; return; }
        int dev = 0, cus = 0, per_cu = 0;
        if (hipGetDevice(&dev) != hipSuccess || hipDeviceGetAttribute(&cus, hipDeviceAttributeMultiprocessorCount, dev) != hipSuccess) { grid = -1; return; }
        if (hipFuncSetAttribute((const void*)mk_fwd, hipFuncAttributeMaxDynamicSharedMemorySize, LDS_BYTES) != hipSuccess) { fprintf(stderr, "kernel_launch: hipFuncSetAttribute failed\n"); grid = -1; return; }
        if (hipOccupancyMaxActiveBlocksPerMultiprocessor(&per_cu, (const void*)mk_fwd, NWAVES * 64, LDS_BYTES) != hipSuccess || per_cu < 1) fprintf(stderr, "kernel_launch: occupancy query reports %d\n", per_cu);
        (void)hipGetLastError();
        grid = cus;
    }
    if (grid < 0) return;
    if (hipMemsetAsync((char*)d_ws + WS_CTL, 0, CTL_ZERO_BYTES, stream) != hipSuccess) { fprintf(stderr, "kernel_launch: memset failed\n"); return; }
    Args a{};
    for (int i = 0; i < 15; ++i) a.in[i] = (const float*)d_in[i];
    a.out = (float*)d_out; a.ws = (unsigned char*)d_ws;
    for (int f = 0; f < 16; ++f) a.invf[f] = pow(500000.0, -(double)(2 * f) / 32.0);
    for (int li = 0; li < N_LAUNCHES && li < MK_LAST_PHASE; ++li) {
        a.ph_lo = (N_LAUNCHES == PER_PHASE) ? li : 0; a.ph_hi = (N_LAUNCHES == PER_PHASE) ? li + 1 : PER_PHASE; a.li = li;
        hipLaunchKernelGGL(mk_fwd, dim3(grid), dim3(NWAVES * 64), LDS_BYTES, stream, a);
        const hipError_t le = hipPeekAtLastError();
        if (le != hipSuccess) { fprintf(stderr, "kernel_launch: launch %d failed: %s\n", li, hipGetErrorName(le)); break; }
    }
    if (MK_LAST_PHASE < 6) hipLaunchKernelGGL(dump_f32, dim3(2048), dim3(256), 0, stream, (const float*)d_in[4], (float*)d_out, M * DM, 4096);
    if (0) hipLaunchKernelGGL(dump_bf16, dim3(2048), dim3(256), 0, stream, (const unsigned short*)((const char*)d_ws + MK_DUMP_OFF), (float*)d_out, M * DM);
}
```

```cpp
#include <hip/hip_runtime.h>
#include <cstdio>
#include <cstdint>
#include <cmath>
namespace pg8 {
#define PG8_LAS __attribute__((address_space(3)))
typedef unsigned short bf16_t;
typedef short bf16x8 __attribute__((ext_vector_type(8)));
typedef float f32x4 __attribute__((ext_vector_type(4)));
typedef unsigned u32x4 __attribute__((ext_vector_type(4)));
constexpr int BM = 256, BK = 64, HALF = 128, HTB = HALF * BK * 2  , STAGE_BYTES = 8 * HTB, NXCD = 8, WGM = 8;

__host__ __device__ __forceinline__ int lds_byte(int r, int c) { const int st = (r >> 4) * 2 + (c >> 5), rr = r & 15, cc = c & 31, ob = rr * 64 + cc * 2; return st * 1024 + (ob ^ (((ob >> 9) & 1) << 5)); }
__host__ __device__ __forceinline__ void stage_rc(int b, int& R, int& C) { const int st = b / 1024, sb = b % 1024, swz = sb ^ (((sb >> 9) & 1) << 5); R = (st >> 1) * 16 + swz / 64; C = (st & 1) * 32 + (swz % 64) / 2; }
__host__ __device__ __forceinline__ int perm32(int rho) { const int n = rho >> 4, i = rho & 15; return 8 * (i >> 2) + 4 * n + (i & 3); }

struct Unit { int pm, pn; };
struct Gemm { const bf16_t* A; const bf16_t* Bt; int M, N, K; };

struct StaticOrder {
    int nM, nN, nwg, G, c;
    __host__ __device__ void init(int M, int N, int G_, int c_) { nM = M / BM; nN = N / BM; nwg = nM * nN; G = G_; c = c_; }
    __host__ __device__ bool next(int i, Unit& u) const {
        const long L = (long)i * G + c; if (L >= nwg) return false;
        int wgid = (int)L; { const int q = nwg / NXCD, r = nwg % NXCD, xcd = wgid % NXCD, off = wgid / NXCD; wgid = (xcd < r ? xcd * (q + 1) : r * (q + 1) + (xcd - r) * q) + off; }
        const int nig = WGM * nN, gid = wgid / nig, fm = gid * WGM, gsz = (nM - fm) < WGM ? (nM - fm) : WGM;
        u.pm = fm + ((wgid % nig) % gsz); u.pn = (wgid % nig) / gsz; return true;
    }
    __device__ __forceinline__ void a_ready(const Unit&) const {}
    __device__ __forceinline__ void done(const Unit&) const {}
};


typedef float f32x2c __attribute__((ext_vector_type(2))); typedef __bf16 bf16x2c __attribute__((ext_vector_type(2)));
__device__ __forceinline__ unsigned cvt_pk_bf16(float lo, float hi) { const f32x2c v = {lo, hi}; const bf16x2c b = __builtin_convertvector(v, bf16x2c); return __builtin_bit_cast(unsigned, b); }
__device__ __forceinline__ u32x4 pack8(f32x4 a, f32x4 b) { u32x4 w; w.x = cvt_pk_bf16(a[0], a[1]); w.y = cvt_pk_bf16(a[2], a[3]); w.z = cvt_pk_bf16(b[0], b[1]); w.w = cvt_pk_bf16(b[2], b[3]); return w; }
__device__ __forceinline__ f32x4 shx(f32x4 v, int o) { f32x4 r; r[0] = __shfl_xor(v[0], o); r[1] = __shfl_xor(v[1], o); r[2] = __shfl_xor(v[2], o); r[3] = __shfl_xor(v[3], o); return r; }
__device__ __forceinline__ f32x4 bf4lo(unsigned a, unsigned b) { f32x4 r; r[0] = __uint_as_float(a << 16); r[1] = __uint_as_float(a & 0xffff0000u); r[2] = __uint_as_float(b << 16); r[3] = __uint_as_float(b & 0xffff0000u); return r; }
__device__ __forceinline__ f32x4 sigm4(f32x4 v) { f32x4 r;
#pragma unroll
    for (int i = 0; i < 4; ++i) r[i] = __builtin_amdgcn_rcpf(1.0f + __expf(-v[i])); return r; }
constexpr float QSCALE = 0.08838834764831845f * 1.4426950408889634f;

struct EpiIn {
    static constexpr bool PERM = true, AFTER_DRAIN = false;
    bf16_t* T6; bf16_t* GAB; const float* gbias; const float* cs; float* ksum;
    __device__ __forceinline__ void operator()(const f32x4 (&acc)[2][2][4][2], const Unit& u, int wr, int wc, int fr, int fq) const {
        const int row0 = u.pm * BM + wr * 64 + fr, pn = u.pn, colw = wc * 32 + 8 * fq;
        if (pn < 24) {
            const int t = pn >> 2;
            bf16_t* base = T6 + (size_t)t * ((size_t)8192 * 1024) + (pn & 3) * 256 + colw;
            const bool rot = (t == 3 || t == 4) && (wc == 0), isk = (t == 4);
            const float qs = (t == 3) ? QSCALE : 1.0f;
            f32x4 ks[2][2];
#pragma unroll
            for (int bj = 0; bj < 2; ++bj) { ks[bj][0] = (f32x4){0.f, 0.f, 0.f, 0.f}; ks[bj][1] = (f32x4){0.f, 0.f, 0.f, 0.f}; }
#pragma unroll
            for (int ai = 0; ai < 2; ++ai)
#pragma unroll
                for (int m = 0; m < 4; ++m) {
                    const int row = row0 + ai * HALF + m * 16;
                    f32x4 c0 = (f32x4){1.f, 1.f, 1.f, 1.f}, c1 = c0, s0 = (f32x4){0.f, 0.f, 0.f, 0.f}, s1 = s0;
                    if (rot) { const float* cp = cs + (size_t)row * 32 + 8 * (fq & 1); c0 = *(const f32x4*)cp; c1 = *(const f32x4*)(cp + 4); s0 = *(const f32x4*)(cp + 16); s1 = *(const f32x4*)(cp + 20);
                        if (fq < 2) { s0 = -s0; s1 = -s1; } }
#pragma unroll
                    for (int bj = 0; bj < 2; ++bj) {
                        f32x4 v0 = acc[ai][bj][m][0], v1 = acc[ai][bj][m][1];
                        if (rot) { const f32x4 p0 = shx(v0, 32), p1 = shx(v1, 32); v0 = v0 * c0 + p0 * s0; v1 = v1 * c1 + p1 * s1; }
                        if (isk) { ks[bj][0] += v0; ks[bj][1] += v1; }
                        v0 = v0 * qs; v1 = v1 * qs;
                        *(u32x4*)(base + (size_t)row * 1024 + bj * HALF) = pack8(v0, v1);
                    }
                }
            if (isk) {
#pragma unroll
                for (int bj = 0; bj < 2; ++bj)
#pragma unroll
                    for (int n = 0; n < 2; ++n) { f32x4 v = ks[bj][n]; v += shx(v, 1); v += shx(v, 2); v += shx(v, 4); v += shx(v, 8);
                        if (fr == 0) { float* kp = ksum + (size_t)u.pm * 1024 + (pn & 3) * 256 + bj * HALF + colw + 4 * n;
                            unsafeAtomicAdd(kp + 0, v[0]); unsafeAtomicAdd(kp + 1, v[1]); unsafeAtomicAdd(kp + 2, v[2]); unsafeAtomicAdd(kp + 3, v[3]); } }
            }
        } else {
            const int t = (pn - 24) >> 3, colg = ((pn - 24) & 7) * 256 + colw;
            bf16_t* base = GAB + (size_t)t * ((size_t)8192 * 2048) + colg;
            const float* bp = gbias + t * 2048 + colg;
            f32x4 bv[2][2];
#pragma unroll
            for (int bj = 0; bj < 2; ++bj) { bv[bj][0] = *(const f32x4*)(bp + bj * HALF); bv[bj][1] = *(const f32x4*)(bp + bj * HALF + 4); }
#pragma unroll
            for (int ai = 0; ai < 2; ++ai)
#pragma unroll
                for (int m = 0; m < 4; ++m) { const int row = row0 + ai * HALF + m * 16;
#pragma unroll
                    for (int bj = 0; bj < 2; ++bj) *(u32x4*)(base + (size_t)row * 2048 + bj * HALF) = pack8(sigm4(acc[ai][bj][m][0] + bv[bj][0]), sigm4(acc[ai][bj][m][1] + bv[bj][1])); }
        }
    }
};
struct EpiTmp {
    static constexpr bool PERM = true, AFTER_DRAIN = false;
    const bf16_t* G; bf16_t* O;
    __device__ __forceinline__ void operator()(const f32x4 (&acc)[2][2][4][2], const Unit& u, int wr, int wc, int fr, int fq) const {
        const int row0 = u.pm * BM + wr * 64 + fr, col0 = u.pn * BM + wc * 32 + 8 * fq;
#pragma unroll
        for (int ai = 0; ai < 2; ++ai)
#pragma unroll
            for (int m = 0; m < 4; ++m) { const size_t off = (size_t)(row0 + ai * HALF + m * 16) * 2048 + col0;
#pragma unroll
                for (int bj = 0; bj < 2; ++bj) { const u32x4 g = *(const u32x4*)(G + off + bj * HALF);
                    *(u32x4*)(O + off + bj * HALF) = pack8(acc[ai][bj][m][0] * bf4lo(g.x, g.y), acc[ai][bj][m][1] * bf4lo(g.z, g.w)); } }
    }
};
struct EpiMerge {
    static constexpr bool PERM = true, AFTER_DRAIN = false;
    const bf16_t* G; const bf16_t* TMP; bf16_t* O;
    __device__ __forceinline__ void operator()(const f32x4 (&acc)[2][2][4][2], const Unit& u, int wr, int wc, int fr, int fq) const {
        const int row0 = u.pm * BM + wr * 64 + fr, col0 = u.pn * BM + wc * 32 + 8 * fq;
#pragma unroll
        for (int ai = 0; ai < 2; ++ai)
#pragma unroll
            for (int m = 0; m < 4; ++m) { const size_t off = (size_t)(row0 + ai * HALF + m * 16) * 2048 + col0;
#pragma unroll
                for (int bj = 0; bj < 2; ++bj) { const u32x4 g = *(const u32x4*)(G + off + bj * HALF), t = *(const u32x4*)(TMP + off + bj * HALF);
                    *(u32x4*)(O + off + bj * HALF) = pack8(bf4lo(t.x, t.y) + acc[ai][bj][m][0] * bf4lo(g.x, g.y), bf4lo(t.z, t.w) + acc[ai][bj][m][1] * bf4lo(g.z, g.w)); } }
    }
};
struct EpiX1 {
    static constexpr bool PERM = true, AFTER_DRAIN = false;
    const float* X; float* X1; bf16_t* X1B; unsigned long long* SS;
    __device__ __forceinline__ void operator()(const f32x4 (&acc)[2][2][4][2], const Unit& u, int wr, int wc, int fr, int fq) const {
        const int row0 = u.pm * BM + wr * 64 + fr, col0 = u.pn * BM + wc * 32 + 8 * fq;
#pragma unroll
        for (int ai = 0; ai < 2; ++ai)
#pragma unroll
            for (int m = 0; m < 4; ++m) { const int row = row0 + ai * HALF + m * 16; const size_t off = (size_t)row * 2048 + col0; float sq = 0.f;
#pragma unroll
                for (int bj = 0; bj < 2; ++bj) { const f32x4 v0 = acc[ai][bj][m][0] + *(const f32x4*)(X + off + bj * HALF), v1 = acc[ai][bj][m][1] + *(const f32x4*)(X + off + bj * HALF + 4);
                    *(f32x4*)(X1 + off + bj * HALF) = v0; *(f32x4*)(X1 + off + bj * HALF + 4) = v1; *(u32x4*)(X1B + off + bj * HALF) = pack8(v0, v1);
                    sq += (v0[0] * v0[0] + v0[1] * v0[1]) + (v0[2] * v0[2] + v0[3] * v0[3]) + (v1[0] * v1[0] + v1[1] * v1[1]) + (v1[2] * v1[2] + v1[3] * v1[3]); }
                sq += __shfl_xor(sq, 16); sq += __shfl_xor(sq, 32);
                if (fq == 0) atomicAdd(SS + row, (unsigned long long)(sq * 4294967296.0f)); }
    }
};
__device__ __forceinline__ float rinv_from_ss(unsigned long long s) { return 1.0f / sqrtf((float)((double)s * (1.0 / 4294967296.0) * (1.0 / 2048.0)) + 1e-6f); }
struct EpiQP {
    static constexpr bool PERM = true, AFTER_DRAIN = false;
    const unsigned long long* SS; bf16_t* O;
    __device__ __forceinline__ void operator()(const f32x4 (&acc)[2][2][4][2], const Unit& u, int wr, int wc, int fr, int fq) const {
        const int row0 = u.pm * BM + wr * 64 + fr, col0 = u.pn * BM + wc * 32 + 8 * fq;
#pragma unroll
        for (int ai = 0; ai < 2; ++ai)
#pragma unroll
            for (int m = 0; m < 4; ++m) { const int row = row0 + ai * HALF + m * 16; const size_t off = (size_t)row * 2048 + col0; const float rv = rinv_from_ss(SS[row]);
#pragma unroll
                for (int bj = 0; bj < 2; ++bj) *(u32x4*)(O + off + bj * HALF) = pack8(acc[ai][bj][m][0] * rv, acc[ai][bj][m][1] * rv); }
    }
};

template <class Epi, class Sched, bool ALIGN_EPI = false, bool SP2 = false>
__device__ __forceinline__ void gemm_phase(PG8_LAS unsigned char* lds, const Gemm g, const Sched& S, const Epi& E) {
    const int tid = threadIdx.x, wid = __builtin_amdgcn_readfirstlane(tid >> 6), lane = tid & 63, wr = wid >> 2, wc = wid & 3, fr = lane & 15, fq = lane >> 4;
    const int K = g.K, nt = K / BK;
    unsigned voffA[2], voffB[2];
#pragma unroll
    for (int i = 0; i < 2; ++i) { int R, C; stage_rc(tid * 16 + i * 8192, R, C); const int Rb = Epi::PERM ? ((R & ~31) + perm32(R & 31)) : R;
        voffA[i] = (unsigned)(R * K + C) * 2u; voffB[i] = (unsigned)(Rb * K + C) * 2u; }
    const size_t kstep = (size_t)(BK * 2);
    const size_t hstep = (size_t)HALF * K * 2;
    const size_t tstep = 2 * hstep;
    const unsigned ldsw = (unsigned)wid * 1024u;
    const int aoff = lds_byte(wr * 64 + fr, fq * 8), boff = lds_byte(wc * 32 + fr, fq * 8);
#define PG8_SA(b, h) (((b) * 2 + (h)) * HTB)
#define PG8_SB(b, h) ((4 + (b) * 2 + (h)) * HTB)
#define PG8_STAGE(bufoff, gbase, voff) do { _Pragma("unroll") for (int _i = 0; _i < 2; ++_i) \
        __builtin_amdgcn_global_load_lds((const unsigned*)((const char*)(gbase) + (voff)[_i]), (PG8_LAS unsigned*)(lds + (bufoff) + ldsw + _i * 8192), 16, 0, 0); } while (0)
#define PG8_LDA(dst, b, h) do { _Pragma("unroll") for (int m = 0; m < 4; ++m) _Pragma("unroll") for (int k = 0; k < 2; ++k) dst[m][k] = *(const PG8_LAS bf16x8*)(lds + PG8_SA(b, h) + aoff + m * 2048 + k * 1024); } while (0)
#define PG8_LDB(dst, b, h) do { _Pragma("unroll") for (int n = 0; n < 2; ++n) _Pragma("unroll") for (int k = 0; k < 2; ++k) dst[n][k] = *(const PG8_LAS bf16x8*)(lds + PG8_SB(b, h) + boff + n * 2048 + k * 1024); } while (0)
#define PG8_MMA(ai, bj, At, Bt) do { __builtin_amdgcn_s_setprio(1); _Pragma("unroll") for (int m = 0; m < 4; ++m) _Pragma("unroll") for (int n = 0; n < 2; ++n) _Pragma("unroll") for (int k = 0; k < 2; ++k) \
        acc[ai][bj][m][n] = __builtin_amdgcn_mfma_f32_16x16x32_bf16(Bt[n][k], At[m][k], acc[ai][bj][m][n], 0, 0, 0); __builtin_amdgcn_s_setprio(0); } while (0)
#define PG8_WAIT_V(n) asm volatile("s_waitcnt vmcnt(" #n ")" ::: "memory")
#define PG8_WAIT_L(n) asm volatile("s_waitcnt lgkmcnt(" #n ")" ::: "memory")
#define PG8_BAR __builtin_amdgcn_s_barrier()
#define PG8_SCHED __builtin_amdgcn_sched_barrier(0)
    Unit cur, nxt; int ui = 0;
    if (!S.next(0, cur)) return;
    f32x4 acc[2][2][4][2];
#pragma unroll
    for (int a = 0; a < 2; ++a)
#pragma unroll
        for (int b = 0; b < 2; ++b)
#pragma unroll
            for (int m = 0; m < 4; ++m)
#pragma unroll
                for (int n = 0; n < 2; ++n) acc[a][b][m][n] = (f32x4){0.f, 0.f, 0.f, 0.f};
    bf16x8 At[4][2], B0[2][2], B1[2][2];
    const char* cA = (const char*)g.A + (size_t)cur.pm * tstep; const char* cB = (const char*)g.Bt + (size_t)cur.pn * tstep;
    S.a_ready(cur);
    if constexpr (SP2) {
        PG8_STAGE(PG8_SB(0, 0), cB, voffB); PG8_STAGE(PG8_SB(0, 1), cB + hstep, voffB); PG8_STAGE(PG8_SA(0, 0), cA, voffA); PG8_STAGE(PG8_SA(0, 1), cA + hstep, voffA);
        if (wr == 1) PG8_BAR;
        PG8_WAIT_V(2); PG8_BAR;
        PG8_STAGE(PG8_SB(1, 0), cB + kstep, voffB); PG8_STAGE(PG8_SA(1, 0), cA + kstep, voffA); PG8_STAGE(PG8_SB(1, 1), cB + hstep + kstep, voffB);
        PG8_WAIT_V(6); PG8_BAR;
    } else {
        PG8_STAGE(PG8_SB(0, 0), cB, voffB); PG8_STAGE(PG8_SA(0, 0), cA, voffA); PG8_STAGE(PG8_SB(0, 1), cB + hstep, voffB); PG8_STAGE(PG8_SA(0, 1), cA + hstep, voffA);
        if (wr == 1) PG8_BAR;
        PG8_WAIT_V(4); PG8_BAR;
        PG8_STAGE(PG8_SB(1, 0), cB + kstep, voffB); PG8_STAGE(PG8_SA(1, 0), cA + kstep, voffA); PG8_STAGE(PG8_SB(1, 1), cB + hstep + kstep, voffB);
        PG8_WAIT_V(6); PG8_BAR;
    }
    for (;;) {
        const bool has_next = S.next(ui + 1, nxt);
        const char* nA = has_next ? (const char*)g.A + (size_t)nxt.pm * tstep : cA; const char* nB = has_next ? (const char*)g.Bt + (size_t)nxt.pn * tstep : cB;
        for (int t = 0; t < nt; t += 2) {
            const bool last = (t == nt - 2);
            const char* a1 = cA + (size_t)(t + 1) * kstep;
            const char* a2 = last ? nA : cA + (size_t)(t + 2) * kstep; const char* b2 = last ? nB : cB + (size_t)(t + 2) * kstep;
            const char* a3 = a2 + kstep; const char* b3 = b2 + kstep;
            if (last && has_next) S.a_ready(nxt);
            if constexpr (SP2) {
            PG8_LDB(B0, 0, 0); PG8_LDB(B1, 0, 1); PG8_SCHED; PG8_LDA(At, 0, 0); PG8_STAGE(PG8_SA(1, 1), a1 + hstep, voffA);
            PG8_WAIT_V(8); PG8_WAIT_L(0); PG8_BAR; PG8_MMA(0, 0, At, B0); PG8_MMA(0, 1, At, B1); PG8_BAR; PG8_SCHED;
            PG8_LDA(At, 0, 1); PG8_STAGE(PG8_SB(0, 0), b2, voffB); PG8_STAGE(PG8_SB(0, 1), b2 + hstep, voffB); PG8_STAGE(PG8_SA(0, 0), a2, voffA);
            PG8_WAIT_V(8); PG8_WAIT_L(0); PG8_BAR; PG8_MMA(1, 0, At, B0); PG8_MMA(1, 1, At, B1); PG8_BAR; PG8_SCHED;
            PG8_LDB(B0, 1, 0); PG8_LDB(B1, 1, 1); PG8_SCHED; PG8_LDA(At, 1, 0); PG8_STAGE(PG8_SA(0, 1), a2 + hstep, voffA);
            PG8_WAIT_V(8); PG8_WAIT_L(0); PG8_BAR; PG8_MMA(0, 0, At, B0); PG8_MMA(0, 1, At, B1); PG8_BAR; PG8_SCHED;
            PG8_LDA(At, 1, 1); PG8_STAGE(PG8_SB(1, 0), b3, voffB); PG8_STAGE(PG8_SB(1, 1), b3 + hstep, voffB); PG8_STAGE(PG8_SA(1, 0), a3, voffA);
            PG8_WAIT_V(8); PG8_WAIT_L(0); PG8_BAR; PG8_MMA(1, 0, At, B0); PG8_MMA(1, 1, At, B1); PG8_BAR; PG8_SCHED;
            } else {
            PG8_LDB(B0, 0, 0); PG8_SCHED; PG8_LDA(At, 0, 0); PG8_STAGE(PG8_SA(1, 1), a1 + hstep, voffA);
            PG8_WAIT_L(8); PG8_BAR; PG8_WAIT_L(0); PG8_MMA(0, 0, At, B0); PG8_BAR; PG8_SCHED;
            PG8_LDB(B1, 0, 1); PG8_STAGE(PG8_SB(0, 0), b2, voffB);
            PG8_BAR; PG8_WAIT_L(0); PG8_MMA(0, 1, At, B1); PG8_BAR;
            PG8_LDA(At, 0, 1); PG8_STAGE(PG8_SA(0, 0), a2, voffA);
            PG8_BAR; PG8_WAIT_L(0); PG8_MMA(1, 0, At, B0); PG8_BAR; PG8_SCHED;
            PG8_STAGE(PG8_SB(0, 1), b2 + hstep, voffB);
            PG8_WAIT_V(6); PG8_BAR; PG8_MMA(1, 1, At, B1); PG8_BAR;
            PG8_LDB(B0, 1, 0); PG8_SCHED; PG8_LDA(At, 1, 0); PG8_STAGE(PG8_SA(0, 1), a2 + hstep, voffA);
            PG8_WAIT_L(8); PG8_BAR; PG8_WAIT_L(0); PG8_MMA(0, 0, At, B0); PG8_BAR; PG8_SCHED;
            PG8_LDB(B1, 1, 1); PG8_STAGE(PG8_SB(1, 0), b3, voffB);
            PG8_BAR; PG8_WAIT_L(0); PG8_MMA(0, 1, At, B1); PG8_BAR;
            PG8_LDA(At, 1, 1); PG8_STAGE(PG8_SA(1, 0), a3, voffA);
            PG8_BAR; PG8_WAIT_L(0); PG8_MMA(1, 0, At, B0); PG8_BAR; PG8_SCHED;
            PG8_STAGE(PG8_SB(1, 1), b3 + hstep, voffB);
            PG8_WAIT_V(6); PG8_BAR; PG8_MMA(1, 1, At, B1); PG8_BAR;
            }
        }
        if constexpr (ALIGN_EPI) { if (wr == 0) PG8_BAR; }
        if constexpr (!Epi::AFTER_DRAIN) { E(acc, cur, wr, wc, fr, fq); S.done(cur); }
        if (!has_next) break;
#pragma unroll
        for (int a = 0; a < 2; ++a)
#pragma unroll
            for (int b = 0; b < 2; ++b)
#pragma unroll
                for (int m = 0; m < 4; ++m)
#pragma unroll
                    for (int n = 0; n < 2; ++n) acc[a][b][m][n] = (f32x4){0.f, 0.f, 0.f, 0.f};
        cur = nxt; cA = nA; cB = nB; ++ui;
        if constexpr (ALIGN_EPI) { if (wr == 1) PG8_BAR; }
    }
    PG8_WAIT_V(0);
    if constexpr (!ALIGN_EPI) { if (wr == 0) PG8_BAR; }
    PG8_BAR;
    if constexpr (Epi::AFTER_DRAIN) { E.fused(acc, cur, wr, wc, fr, fq, lds, wid, lane); S.done(cur); }
#undef PG8_SA
#undef PG8_SB
#undef PG8_STAGE
#undef PG8_LDA
#undef PG8_LDB
#undef PG8_MMA
#undef PG8_WAIT_V
#undef PG8_WAIT_L
#undef PG8_BAR
#undef PG8_SCHED
}
}

constexpr int NWAVES = 8;
#ifndef MK_N_LAUNCHES
#define MK_N_LAUNCHES 1
#endif
constexpr int PER_PHASE = 9;
#ifndef MK_LAST_PHASE
#define MK_LAST_PHASE 9
#endif
constexpr int N_LAUNCHES = MK_N_LAUNCHES;
constexpr int M = 8192, SEQ = 4096, DM = 2048, INW = 10240, NEXP = 16384;
constexpr float RMS_EPS = 1e-6f;
constexpr size_t MiB = 1u << 20;
constexpr size_t WS_CTL = 0, CTL_ZERO_BYTES = 1 * MiB;
constexpr size_t WS_SS = 256 * 1024, WS_KSUM = 512 * 1024;
constexpr size_t WS_WIN = 2 * MiB, WS_WBC = 42 * MiB, WS_WBA = 46 * MiB, WS_WOUT = 50 * MiB, WS_WPQ = 58 * MiB, WS_KEYS = 66 * MiB, WS_CS = 67 * MiB;
constexpr size_t WS_UB = 70 * MiB, WS_VB = 134 * MiB;
constexpr size_t WS_XB = 198 * MiB;
constexpr size_t WS_T6 = 230 * MiB;
constexpr size_t WS_GAB = 326 * MiB;
constexpr size_t WS_UC = 390 * MiB, WS_AO = 406 * MiB;
constexpr size_t WS_EXP = 422 * MiB, WS_GATE = 426 * MiB;
constexpr size_t WS_END = 430 * MiB;
constexpr size_t WS_TMP = WS_XB, WS_MB = WS_T6, WS_X1B = WS_T6 + 48 * MiB, WS_QP = WS_GAB;
constexpr int CW_BAR = 4096;
constexpr int RING_OFF = 0, RING_BYTES = 131072;
constexpr int LDSCTL_OFF = RING_BYTES, MISC_OFF = LDSCTL_OFF + 320;
constexpr int LDS_BYTES = 147456;

#define GAS __attribute__((address_space(1)))
#define LAS __attribute__((address_space(3)))
typedef unsigned short bf16;
typedef unsigned v4u __attribute__((ext_vector_type(4)));
typedef float f32x4 __attribute__((ext_vector_type(4)));
typedef short bf16x8 __attribute__((ext_vector_type(8)));
typedef GAS unsigned gu32;
typedef GAS unsigned long long gu64;
#define RLX_AGENT __ATOMIC_RELAXED, __HIP_MEMORY_SCOPE_AGENT
#define LDS_WAIT() asm volatile("s_waitcnt lgkmcnt(0)" ::: "memory")
#define VM_WAIT() asm volatile("s_waitcnt vmcnt(0)" ::: "memory")
__device__ __forceinline__ unsigned long long rt() { return __builtin_amdgcn_s_memrealtime(); }
__device__ __forceinline__ unsigned f2bf(float f) { unsigned u = __builtin_bit_cast(unsigned, f); return (u + 0x7fffu + ((u >> 16) & 1u)) >> 16; }
__device__ __forceinline__ unsigned pk2(float lo, float hi) { return f2bf(lo) | (f2bf(hi) << 16); }

#define XB_TMO      128
#define XB_XCNT(j)  (256  + 64 * (j))
#define XB_XSUB(j)  (1280 + 64 * (j))
#define XB_XGEN(j)  (2304 + 64 * (j))
#define XB_TOP      3328
#define XB_TOPGEN   3392
#define XCD_BAR_WORDS 3456
#define XB_SPIN_CAP (1u << 18)

__device__ __forceinline__ unsigned xb_ld(unsigned* p)              { return __hip_atomic_load(p, __ATOMIC_RELAXED, __HIP_MEMORY_SCOPE_AGENT); }
__device__ __forceinline__ unsigned xb_add(unsigned* p, unsigned v) { return __hip_atomic_fetch_add(p, v, __ATOMIC_RELAXED, __HIP_MEMORY_SCOPE_AGENT); }
__device__ __forceinline__ unsigned xb_xcc_id() { return (unsigned)__builtin_amdgcn_s_getreg((3 << 11) | 20) & 0xFu; }
#define XB_SPIN(cond, bar) do { unsigned _sp = 0; while (cond) { __builtin_amdgcn_s_sleep(1); \
    if ((++_sp & 255u) == 0u) { if (xb_ld(&(bar)[XB_TMO])) break; if (_sp > XB_SPIN_CAP) { atomicAdd(&(bar)[XB_TMO], 1u); break; } } } } while (0)

struct XcdBarrier {
    unsigned* bar; unsigned x;
    volatile LAS unsigned* st;
};

__device__ __forceinline__ XcdBarrier xcd_barrier_post(unsigned* bar, volatile LAS unsigned* st) {
    XcdBarrier b; b.bar = bar; b.x = xb_xcc_id(); b.st = st;
    if (threadIdx.x == 0) (void)xb_add(&bar[XB_XCNT(b.x)], 1u);
    return b;
}
__device__ __forceinline__ void xcd_barrier_complete(unsigned* bar, unsigned x, unsigned& nloc, unsigned& nx) {
    const unsigned G = gridDim.x * gridDim.y * gridDim.z;
    unsigned sum, cnt, mine, sp = 0u;
    for (;;) {
        sum = 0u; cnt = 0u; mine = 0u;
#pragma unroll
        for (unsigned j = 0; j < 16; ++j) { const unsigned c = xb_ld(&bar[XB_XCNT(j)]); sum += c; cnt += (c > 0u) ? 1u : 0u; mine = (j == x) ? c : mine; }
        if (sum == G) break;
        __builtin_amdgcn_s_sleep(1);
        if ((++sp & 255u) == 0u) { if (xb_ld(&bar[XB_TMO])) break; if (sp > XB_SPIN_CAP) { atomicAdd(&bar[XB_TMO], 1u); break; } }
    }
    nloc = mine > 0u ? mine : 1u; nx = cnt > 0u ? cnt : 1u;
}

__device__ __forceinline__ void xcd_barrier(const XcdBarrier& b) {
    asm volatile("s_waitcnt vmcnt(0)" ::: "memory");
    __syncthreads();
    if (threadIdx.x == 0) {
        unsigned* bar = b.bar;
        __builtin_amdgcn_s_waitcnt(0);
        unsigned nloc = b.st[0], nx = b.st[1];
        if (nloc == 0u) { xcd_barrier_complete(bar, b.x, nloc, nx); b.st[0] = nloc; b.st[1] = nx; }
        const unsigned old = xb_add(&bar[XB_XSUB(b.x)], 1u);
        const unsigned gen = old / nloc;
        if (old + 1u == (gen + 1u) * nloc) {
            __builtin_amdgcn_fence(__ATOMIC_RELEASE, "agent");
            asm volatile("s_waitcnt vmcnt(0)" ::: "memory");
            const unsigned og = xb_add(&bar[XB_TOP], 1u);
            const unsigned tg = og / nx;
            if (og + 1u == (tg + 1u) * nx) xb_add(&bar[XB_TOPGEN], 1u);
            else XB_SPIN(xb_ld(&bar[XB_TOPGEN]) == tg, bar);
            __builtin_amdgcn_fence(__ATOMIC_ACQUIRE, "agent");
            xb_add(&bar[XB_XGEN(b.x)], 1u);
            asm volatile("s_waitcnt vmcnt(0)" ::: "memory");
        } else {
            XB_SPIN(xb_ld(&bar[XB_XGEN(b.x)]) == gen, bar);
            __builtin_amdgcn_fence(__ATOMIC_ACQUIRE, "agent");
            asm volatile("s_waitcnt vmcnt(0)" ::: "memory");
        }
    }
    __syncthreads();
}

typedef __bf16 bf16x2v __attribute__((ext_vector_type(2)));
typedef float f32x16 __attribute__((ext_vector_type(16)));
__device__ __forceinline__ float bflo(unsigned w) { return __uint_as_float(w << 16); }
__device__ __forceinline__ float bfhi(unsigned w) { return __uint_as_float(w & 0xffff0000u); }
__device__ __forceinline__ float dot2bf(unsigned a, unsigned b, float c) { return __builtin_amdgcn_fdot2_f32_bf16(__builtin_bit_cast(bf16x2v, a), __builtin_bit_cast(bf16x2v, b), c, false); }
__device__ __forceinline__ float wave_sum(float v) {
#pragma unroll
    for (int o = 1; o < 64; o <<= 1) v += __shfl_xor(v, o);
    return v; }
__device__ __forceinline__ float wave_max(float v) {
#pragma unroll
    for (int o = 1; o < 64; o <<= 1) v = fmaxf(v, __shfl_xor(v, o));
    return v; }
__device__ __forceinline__ float rdlane(float v, int l) { return __int_as_float(__builtin_amdgcn_readlane(__float_as_int(v), l)); }
__device__ __forceinline__ float gelu_tanh(float x) { const float z = 0.7978845608028654f * (x + 0.044715f * x * x * x); const float e = __expf(2.0f * z); const float th = 1.0f - 2.0f * __builtin_amdgcn_rcpf(1.0f + e); return 0.5f * x * (1.0f + th); }

struct Ctx { LAS unsigned char* lds; int tid, lane, wave, vcu, G; };

__device__ __forceinline__ void p0_transpose_item(const float* W, int K, int N, bf16* WT, const float* gk, LAS float* scr, int item, int lane) {
    const int nblk = N / 32, kb = item / nblk, nb = item % nblk, k0 = 64 * kb, n0 = 32 * nb;
#pragma unroll 8
    for (int i = 0; i < 32; ++i) { const int kk = 2 * i + (lane >> 5); float v = W[(size_t)(k0 + kk) * N + n0 + (lane & 31)]; if (gk) v *= gk[k0 + kk]; scr[kk * 33 + (lane & 31)] = v; }
    LDS_WAIT(); asm volatile("" ::: "memory");
    const int c = lane & 7;
#pragma unroll
    for (int j = 0; j < 4; ++j) { const int n = (lane >> 3) + 8 * j; const LAS float* s = scr + (8 * c) * 33 + n;
        v4u o; o.x = pk2(s[0 * 33], s[1 * 33]); o.y = pk2(s[2 * 33], s[3 * 33]); o.z = pk2(s[4 * 33], s[5 * 33]); o.w = pk2(s[6 * 33], s[7 * 33]);
        *(GAS v4u*)(WT + (size_t)(n0 + n) * K + k0 + 8 * c) = o; }
    LDS_WAIT(); asm volatile("" ::: "memory");
}
__device__ __forceinline__ void p0_prologue(const Ctx& F, const float* const* in, unsigned char* ws, const double* invf) {
    const float* x = in[0]; const int* pos = (const int*)in[1]; const float* g1 = in[2]; const float* w_in = in[3];
    const float* w_bc = in[6]; const float* w_ba = in[7]; const float* w_out = in[8]; const float* g2 = in[9]; const float* w_pq = in[10];
    const float* keys = in[11]; const float* pu = in[12]; const float* pv = in[13];
    LAS float* scr = (LAS float*)(F.lds + RING_OFF + F.wave * 16384);
    const int gw = F.vcu * NWAVES + F.wave, NGW = F.G * NWAVES;
    const int gt = gw * 64 + F.lane, NT = NGW * 64;
    for (int i = gt; i < 8192; i += NT) ((GAS unsigned long long*)(ws + WS_SS))[i] = 0ull;
    for (int i = gt; i < 32 * 1024; i += NT) ((GAS float*)(ws + WS_KSUM))[i] = 0.f;
    constexpr int I_IN = 32 * 320, I_BC = 16 * 64, I_OUT = 32 * 64;
    constexpr int NITEMS = I_IN + 2 * I_BC + 2 * I_OUT;
    for (int it = gw; it < NITEMS; it += NGW) {
        int r = it;
        if (r < I_IN) { p0_transpose_item(w_in, 2048, INW, (bf16*)(ws + WS_WIN), g1, scr, r, F.lane); continue; } r -= I_IN;
        if (r < I_BC) { p0_transpose_item(w_bc, 1024, 2048, (bf16*)(ws + WS_WBC), nullptr, scr, r, F.lane); continue; } r -= I_BC;
        if (r < I_BC) { p0_transpose_item(w_ba, 1024, 2048, (bf16*)(ws + WS_WBA), nullptr, scr, r, F.lane); continue; } r -= I_BC;
        if (r < I_OUT) { p0_transpose_item(w_out, 2048, 2048, (bf16*)(ws + WS_WOUT), nullptr, scr, r, F.lane); continue; } r -= I_OUT;
        p0_transpose_item(w_pq, 2048, 2048, (bf16*)(ws + WS_WPQ), g2, scr, r, F.lane);
    }
    for (int i = gt; i < 16 * 128 * 128 / 8; i += NT) { const f32x4 a = ((const GAS f32x4*)keys)[2 * i], b = ((const GAS f32x4*)keys)[2 * i + 1];
        v4u o; o.x = pk2(a[0], a[1]); o.y = pk2(a[2], a[3]); o.z = pk2(b[0], b[1]); o.w = pk2(b[2], b[3]); ((GAS v4u*)(ws + WS_KEYS))[i] = o; }
    for (int i = gt; i < NEXP * 2048 / 8; i += NT) { const int c8 = (i & 255) * 8;
        f32x4 a = ((const GAS f32x4*)pu)[2 * i], b = ((const GAS f32x4*)pu)[2 * i + 1]; a = a * *(const GAS f32x4*)(g2 + c8); b = b * *(const GAS f32x4*)(g2 + c8 + 4);
        v4u o; o.x = pk2(a[0], a[1]); o.y = pk2(a[2], a[3]); o.z = pk2(b[0], b[1]); o.w = pk2(b[2], b[3]); ((GAS v4u*)(ws + WS_UB))[i] = o;
        a = ((const GAS f32x4*)pv)[2 * i]; b = ((const GAS f32x4*)pv)[2 * i + 1];
        o.x = pk2(a[0], a[1]); o.y = pk2(a[2], a[3]); o.z = pk2(b[0], b[1]); o.w = pk2(b[2], b[3]); ((GAS v4u*)(ws + WS_VB))[i] = o; }
    for (int m = gw; m < M; m += NGW) { const GAS f32x4* xr = (const GAS f32x4*)(x + (size_t)m * DM);
        f32x4 v[8]; float s = 0.f;
#pragma unroll
        for (int i = 0; i < 4; ++i) { v[2 * i] = xr[i * 128 + 2 * F.lane]; v[2 * i + 1] = xr[i * 128 + 2 * F.lane + 1]; }
#pragma unroll
        for (int i = 0; i < 8; ++i) s += (v[i][0] * v[i][0] + v[i][1] * v[i][1]) + (v[i][2] * v[i][2] + v[i][3] * v[i][3]);
        const float rinv = 1.0f / sqrtf(wave_sum(s) * (1.0f / DM) + RMS_EPS);
        GAS v4u* o = (GAS v4u*)(ws + WS_XB + (size_t)m * DM * 2);
#pragma unroll
        for (int i = 0; i < 4; ++i) { const f32x4 a = v[2 * i] * rinv, b = v[2 * i + 1] * rinv; v4u w; w.x = pk2(a[0], a[1]); w.y = pk2(a[2], a[3]); w.z = pk2(b[0], b[1]); w.w = pk2(b[2], b[3]); o[i * 64 + F.lane] = w; } }
    for (int i = gt; i < M * 16; i += NT) { const int row = i >> 4, f = i & 15; const double ang = (double)pos[row] * invf[f];
        const double k = __builtin_rint(ang * 0.15915494309189535); const float r = (float)(ang - k * 6.283185307179586);
        float* cs = (float*)(ws + WS_CS); cs[row * 32 + f] = __cosf(r); cs[row * 32 + 16 + f] = __sinf(r); }
}

__device__ __forceinline__ void attn_simple(const Ctx& F, const bf16* Q, const bf16* K, const bf16* V, const float* ksum, bf16* AO) {
    LAS float* qf = (LAS float*)(F.lds + RING_OFF + F.wave * 512);
    const int gw = F.vcu * NWAVES + F.wave, NGW = F.G * NWAVES, lane = F.lane;
    for (int item = gw; item < 16 * SEQ; item += NGW) {
        const int bh = item >> 12, t = item & 4095, b = bh >> 3, h = bh & 7, blk = t >> 8;
        const size_t row = (size_t)b * SEQ + t;
        { const unsigned qq = *(const GAS unsigned*)(Q + row * 1024 + h * 128 + 2 * lane); qf[2 * lane] = bflo(qq); qf[2 * lane + 1] = bfhi(qq); }
        LDS_WAIT(); asm volatile("" ::: "memory");
        float g = -INFINITY;
        if (lane < blk) { const GAS f32x4* km = (const GAS f32x4*)(ksum + (size_t)(b * 16 + lane) * 1024 + h * 128); float a = 0.f;
            for (int d = 0; d < 32; ++d) { const f32x4 kv = km[d]; const f32x4 qv = *(const LAS f32x4*)(qf + 4 * d); a += (kv[0] * qv[0] + kv[1] * qv[1]) + (kv[2] * qv[2] + kv[3] * qv[3]); }
            g = a; }
        int sel[3];
#pragma unroll
        for (int i = 0; i < 3; ++i) { const float mx = wave_max(g); const unsigned long long bal = __ballot(g == mx && lane < blk); const int idx = bal ? (__ffsll((long long)bal) - 1) : 0; sel[i] = idx; if (lane == idx) g = -INFINITY; }
        const int nsel = blk < 3 ? blk : 3;
        float sc[4][4]; float mx = -INFINITY;
#pragma unroll
        for (int slot = 0; slot < 4; ++slot) {
            const bool valid = (slot == 3) || (slot < nsel);
            const int kb = (slot == 3) ? blk : sel[slot < 3 ? slot : 0];
#pragma unroll
            for (int r = 0; r < 4; ++r) {
                float s = -INFINITY; const int key0 = kb * 256 + r * 64;
                if (valid && (slot < 3 || key0 <= t)) {
                    const int key = key0 + lane; const GAS v4u* kp = (const GAS v4u*)(K + ((size_t)b * SEQ + key) * 1024 + h * 128); float a = 0.f;
#pragma unroll 4
                    for (int d = 0; d < 16; ++d) { const v4u kk = kp[d]; const f32x4 q0 = *(const LAS f32x4*)(qf + 8 * d), q1 = *(const LAS f32x4*)(qf + 8 * d + 4);
                        a += (bflo(kk.x) * q0[0] + bfhi(kk.x) * q0[1]) + (bflo(kk.y) * q0[2] + bfhi(kk.y) * q0[3]) + (bflo(kk.z) * q1[0] + bfhi(kk.z) * q1[1]) + (bflo(kk.w) * q1[2] + bfhi(kk.w) * q1[3]); }
                    s = (slot < 3 || key <= t) ? a : -INFINITY; }
                sc[slot][r] = s; mx = fmaxf(mx, s); } }
        mx = wave_max(mx);
        float sum = 0.f;
#pragma unroll
        for (int slot = 0; slot < 4; ++slot)
#pragma unroll
            for (int r = 0; r < 4; ++r) { sc[slot][r] = exp2f(sc[slot][r] - mx); sum += sc[slot][r]; }
        sum = wave_sum(sum);
        float o0 = 0.f, o1 = 0.f;
#pragma unroll
        for (int slot = 0; slot < 4; ++slot) {
            const bool valid = (slot == 3) || (slot < nsel);
            const int kb = (slot == 3) ? blk : sel[slot < 3 ? slot : 0];
#pragma unroll
            for (int r = 0; r < 4; ++r) { const int key0 = kb * 256 + r * 64;
                if (valid && (slot < 3 || key0 <= t)) { const float pr = sc[slot][r]; const GAS unsigned* vp = (const GAS unsigned*)(V + ((size_t)b * SEQ + key0) * 1024 + h * 128) + lane;
                    for (int kk = 0; kk < 64; ++kk) { const float pk = rdlane(pr, kk); const unsigned vv = vp[(size_t)kk * 512]; o0 += pk * bflo(vv); o1 += pk * bfhi(vv); } } } }
        const float ri = 1.0f / sum;
        *(GAS unsigned*)(AO + row * 1024 + h * 128 + 2 * lane) = pk2(o0 * ri, o1 * ri);
    }
}
typedef short v4i16_t __attribute__((ext_vector_type(4))); typedef unsigned u32x2v __attribute__((ext_vector_type(2)));
__device__ __forceinline__ v4i16_t vtr16(unsigned addr) { return __builtin_amdgcn_ds_read_tr16_b64_v4i16((LAS v4i16_t*)(uintptr_t)addr); }
__device__ __forceinline__ int crow16(int r, int hh) { return (r & 3) + 8 * (r >> 2) + 4 * hh; }
__device__ __forceinline__ void attn_dma_step(const bf16* K, const bf16* V, LAS unsigned char* lds, int b, int h, int qb, int n_own, int st, int wave, int lane) {
    const int buf = st & 1;
#pragma unroll
    for (int img = 0; img < 4; ++img) {
        const int T = 2 * st + (img >> 1); const bool isV = img & 1;
        const int blk = (T < n_own) ? qb : ((T - n_own) >> 2), kt = (T < n_own) ? T : ((T - n_own) & 3);
        const bf16* base = (isV ? V : K) + ((size_t)b * SEQ + 256 * blk + 64 * kt) * 1024 + h * 128;
#pragma unroll
        for (int i = 0; i < 2; ++i) { const int pc = wave + 8 * i, row = 4 * pc + (lane >> 4), cp = lane & 15;
            const int c = isV ? ((((cp >> 2) ^ (row & 3)) << 2) | (cp & 3)) : (cp ^ (row & 15));
            __builtin_amdgcn_global_load_lds((const unsigned*)(base + (size_t)row * 1024 + 8 * c), (LAS unsigned*)(lds + buf * 65536 + img * 16384 + pc * 1024), 16, 0, 0); }
    }
}
__device__ __forceinline__ void attn_mfma(const Ctx& F, const bf16* Q, const bf16* K, const bf16* V, const float* ksum, bf16* AO) {
    const int lane = F.lane, wave = F.wave, q31 = lane & 31, hh = lane >> 5, wq = wave & 3, kvh = wave >> 2, l16 = lane & 15, G4 = lane >> 4;
    LAS unsigned char* lds = F.lds + RING_OFF;
    const unsigned lds0 = (unsigned)(uintptr_t)lds;
    for (int pr = F.vcu; pr < 256; pr += F.G)
#pragma unroll 1
    for (int pi = 0; pi < 2; ++pi) {
        const int bh = pr >> 4, s_ = pr & 15, u128 = pi ? 31 - s_ : s_, b = bh >> 3, h = bh & 7, qb = u128 >> 1, half = u128 & 1;
        const int n_own = half ? 4 : 2, nstep = (n_own + 4 * qb) >> 1;
        const size_t rowq = (size_t)b * SEQ + 256 * qb + 128 * half + 32 * wq + q31;
        asm volatile("s_waitcnt vmcnt(0) lgkmcnt(0)" ::: "memory"); __builtin_amdgcn_s_barrier(); asm volatile("" ::: "memory");
        attn_dma_step(K, V, lds, b, h, qb, n_own, 0, wave, lane);
        bf16x8 qf[8];
#pragma unroll
        for (int s = 0; s < 8; ++s) qf[s] = *(const GAS bf16x8*)(Q + rowq * 1024 + h * 128 + 16 * s + 8 * hh);
        unsigned selmask;
        {
            float qv[64];
#pragma unroll
            for (int s = 0; s < 8; ++s)
#pragma unroll
                for (int e = 0; e < 8; ++e) qv[8 * s + e] = __uint_as_float((unsigned)(unsigned short)qf[s][e] << 16);
            float v0 = -INFINITY, v1 = -INFINITY, v2 = -INFINITY; int i0 = 0, i1 = 0, i2 = 0;
#pragma unroll 1
            for (int j = 0; j < qb; ++j) {
                const GAS f32x4* kp = (const GAS f32x4*)(ksum + (size_t)(b * 16 + j) * 1024 + h * 128 + 8 * hh); float a = 0.f;
#pragma unroll
                for (int s = 0; s < 8; ++s) { const f32x4 k0 = kp[4 * s], k1 = kp[4 * s + 1];
                    a += (qv[8 * s] * k0[0] + qv[8 * s + 1] * k0[1]) + (qv[8 * s + 2] * k0[2] + qv[8 * s + 3] * k0[3]) + (qv[8 * s + 4] * k1[0] + qv[8 * s + 5] * k1[1]) + (qv[8 * s + 6] * k1[2] + qv[8 * s + 7] * k1[3]); }
                a += __shfl_xor(a, 32);
                if (a > v0) { v2 = v1; i2 = i1; v1 = v0; i1 = i0; v0 = a; i0 = j; } else if (a > v1) { v2 = v1; i2 = i1; v1 = a; i1 = j; } else if (a > v2) { v2 = a; i2 = j; }
            }
            selmask = (qb <= 3) ? ((1u << qb) - 1u) : ((1u << i0) | (1u << i1) | (1u << i2));
        }
        float m_run = -1e30f, l_run = 0.f; f32x16 o[4];
#pragma unroll
        for (int db = 0; db < 4; ++db)
#pragma unroll
            for (int r = 0; r < 16; ++r) o[db][r] = 0.f;
        const int qin = 128 * half + 32 * wq + q31;
#pragma unroll 1
        for (int st = 0; st < nstep; ++st) {
            asm volatile("s_waitcnt vmcnt(0)" ::: "memory"); __builtin_amdgcn_s_barrier(); asm volatile("" ::: "memory");
            if (st + 1 < nstep) attn_dma_step(K, V, lds, b, h, qb, n_own, st + 1, wave, lane);
            const int T = 2 * st + kvh; const bool own = T < n_own;
            const int blk = own ? qb : ((T - n_own) >> 2), kt = own ? T : ((T - n_own) & 3);
            const bool sel = own ? true : ((selmask >> blk) & 1u);
            const bool skip = own ? (64 * kt > 128 * half + 32 * wq + 31) : (__ballot(sel) == 0ull);
            if (!skip) {
                const unsigned kimg = lds0 + (st & 1) * 65536 + kvh * 32768, vimg = kimg + 16384;
                f32x16 p[2];
#pragma unroll
                for (int kh = 0; kh < 2; ++kh) {
#pragma unroll
                    for (int r = 0; r < 16; ++r) p[kh][r] = 0.f;
                    const int row = 32 * kh + q31;
#pragma unroll
                    for (int s = 0; s < 8; ++s) { const bf16x8 a = *(const LAS bf16x8*)(uintptr_t)(kimg + row * 256 + (((2 * s + hh) ^ (row & 15)) << 4));
                        p[kh] = __builtin_amdgcn_mfma_f32_32x32x16_bf16(a, qf[s], p[kh], 0, 0, 0); }
                }
                if (own) { const int kbase = 64 * kt;
                    if (kbase + 63 > 128 * half + 32 * wq) {
#pragma unroll
                        for (int kh = 0; kh < 2; ++kh)
#pragma unroll
                            for (int r = 0; r < 16; ++r) if (kbase + 32 * kh + crow16(r, hh) > qin) p[kh][r] = -INFINITY; }
                } else if (!sel) {
#pragma unroll
                    for (int kh = 0; kh < 2; ++kh)
#pragma unroll
                        for (int r = 0; r < 16; ++r) p[kh][r] = -INFINITY; }
                float mx = p[0][0];
#pragma unroll
                for (int r = 1; r < 16; ++r) mx = fmaxf(mx, p[0][r]);
#pragma unroll
                for (int r = 0; r < 16; ++r) mx = fmaxf(mx, p[1][r]);
                mx = fmaxf(mx, __shfl_xor(mx, 32));
                const float m_new = fmaxf(m_run, mx), scl = exp2f(m_run - m_new); m_run = m_new;
                float rs = 0.f;
#pragma unroll
                for (int kh = 0; kh < 2; ++kh)
#pragma unroll
                    for (int r = 0; r < 16; ++r) { p[kh][r] = exp2f(p[kh][r] - m_new); rs += p[kh][r]; }
                l_run = l_run * scl + rs;
#pragma unroll
                for (int db = 0; db < 4; ++db)
#pragma unroll
                    for (int r = 0; r < 16; ++r) o[db][r] *= scl;
#pragma unroll
                for (int kh = 0; kh < 2; ++kh)
#pragma unroll
                    for (int s2 = 0; s2 < 2; ++s2) {
                        v4u pw; pw.x = pg8::cvt_pk_bf16(p[kh][8 * s2], p[kh][8 * s2 + 1]); pw.y = pg8::cvt_pk_bf16(p[kh][8 * s2 + 2], p[kh][8 * s2 + 3]);
                        pw.z = pg8::cvt_pk_bf16(p[kh][8 * s2 + 4], p[kh][8 * s2 + 5]); pw.w = pg8::cvt_pk_bf16(p[kh][8 * s2 + 6], p[kh][8 * s2 + 7]);
                        const bf16x8 pb = __builtin_bit_cast(bf16x8, pw);
                        const int key0 = 32 * kh + 16 * s2 + 4 * (G4 >> 1) + (l16 >> 2);
#pragma unroll
                        for (int db = 0; db < 4; ++db) {
                            const int dsub = 16 * (G4 & 1) + 4 * (l16 & 3);
                            const unsigned a0 = vimg + key0 * 256 + ((db ^ (key0 & 3)) << 6) + dsub * 2;
                            const v4i16_t lo = vtr16(a0), hi_ = vtr16(a0 + 8 * 256);
                            const bf16x8 av = {lo[0], lo[1], lo[2], lo[3], hi_[0], hi_[1], hi_[2], hi_[3]};
                            o[db] = __builtin_amdgcn_mfma_f32_32x32x16_bf16(av, pb, o[db], 0, 0, 0);
                        }
                    }
            }
        }
        l_run += __shfl_xor(l_run, 32);
        asm volatile("s_waitcnt vmcnt(0) lgkmcnt(0)" ::: "memory"); __builtin_amdgcn_s_barrier(); asm volatile("" ::: "memory");
        LAS float* xs = (LAS float*)lds + (size_t)wq * 66 * 64 + lane;
        if (kvh == 1) {
            xs[0] = m_run; xs[64] = l_run;
#pragma unroll
            for (int db = 0; db < 4; ++db)
#pragma unroll
                for (int r = 0; r < 16; ++r) xs[(2 + 16 * db + r) * 64] = o[db][r];
        }
        asm volatile("s_waitcnt lgkmcnt(0)" ::: "memory"); __builtin_amdgcn_s_barrier(); asm volatile("" ::: "memory");
        if (kvh == 0) {
            const float m2 = xs[0], l2 = xs[64], mt = fmaxf(m_run, m2), a1 = exp2f(m_run - mt), a2 = exp2f(m2 - mt);
            const float inv = 1.0f / (l_run * a1 + l2 * a2), c1 = a1 * inv, c2 = a2 * inv;
            bf16* orow = AO + rowq * 1024 + h * 128 + 4 * hh;
#pragma unroll
            for (int db = 0; db < 4; ++db)
#pragma unroll
                for (int g = 0; g < 4; ++g) {
                    float t[4];
#pragma unroll
                    for (int e = 0; e < 4; ++e) t[e] = o[db][4 * g + e] * c1 + xs[(2 + 16 * db + 4 * g + e) * 64] * c2;
                    u32x2v w; w.x = pg8::cvt_pk_bf16(t[0], t[1]); w.y = pg8::cvt_pk_bf16(t[2], t[3]);
                    *(GAS u32x2v*)(orow + 32 * db + 8 * g) = w;
                }
        }
    }
    asm volatile("s_waitcnt vmcnt(0) lgkmcnt(0)" ::: "memory"); __builtin_amdgcn_s_barrier(); asm volatile("" ::: "memory");
}
__device__ __forceinline__ void up8(const v4u w, float (&f)[8]) { f[0] = bflo(w.x); f[1] = bfhi(w.x); f[2] = bflo(w.y); f[3] = bfhi(w.y); f[4] = bflo(w.z); f[5] = bfhi(w.z); f[6] = bflo(w.w); f[7] = bfhi(w.w); }
__device__ __forceinline__ void conv_phase(const Ctx& F, const bf16* CB, const bf16* CC, const bf16* CX, const float* cw, bf16* UC) {
    const int gt = (F.vcu * NWAVES + F.wave) * 64 + F.lane, NT = F.G * NWAVES * 64;
    for (int idx = gt; idx < M * 128; idx += NT) {
        const int row = idx >> 7, c8 = (idx & 127) << 3, t = row & (SEQ - 1); const size_t off = (size_t)row * 1024 + c8;
        float cb[8], a[8], x[8], z0[8], z1[8], z2[8];
        up8(*(const GAS v4u*)(CB + off), cb); up8(*(const GAS v4u*)(CC + off), a); up8(*(const GAS v4u*)(CX + off), x);
#pragma unroll
        for (int j = 0; j < 8; ++j) z0[j] = a[j] * x[j];
        if (t >= 1) { up8(*(const GAS v4u*)(CC + off - 1024), a); up8(*(const GAS v4u*)(CX + off - 1024), x);
#pragma unroll
            for (int j = 0; j < 8; ++j) z1[j] = a[j] * x[j]; } else {
#pragma unroll
            for (int j = 0; j < 8; ++j) z1[j] = 0.f; }
        if (t >= 2) { up8(*(const GAS v4u*)(CC + off - 2048), a); up8(*(const GAS v4u*)(CX + off - 2048), x);
#pragma unroll
            for (int j = 0; j < 8; ++j) z2[j] = a[j] * x[j]; } else {
#pragma unroll
            for (int j = 0; j < 8; ++j) z2[j] = 0.f; }
        float o[8];
#pragma unroll
        for (int j = 0; j < 8; ++j) o[j] = cb[j] * (cw[c8 + j] * z2[j] + cw[1024 + c8 + j] * z1[j] + cw[2048 + c8 + j] * z0[j]);
        v4u w; w.x = pk2(o[0], o[1]); w.y = pk2(o[2], o[3]); w.z = pk2(o[4], o[5]); w.w = pk2(o[6], o[7]); *(GAS v4u*)(UC + off) = w;
    }
}

__device__ const unsigned char CAND50[64] = {
    0x00,0x01,0x02,0x03,0x04,0x05,0x06,0x07,0x08,0x09,0x0a,0x0b,0x0c,0x0d,0x0e,0x0f,
    0x10,0x11,0x12,0x13,0x14,0x15,0x16,0x17, 0x20,0x21,0x22,0x23,0x24, 0x30,0x31,0x32,0x33, 0x40,0x41,0x42, 0x50,0x51, 0x60,0x61, 0x70,0x71,
    0x80,0x90,0xa0,0xb0,0xc0,0xd0,0xe0,0xf0, 0xff,0xff,0xff,0xff,0xff,0xff,0xff,0xff,0xff,0xff,0xff,0xff,0xff,0xff};
__device__ __forceinline__ int ord_key(float f) { const int u = __float_as_int(f); return u >= 0 ? u : (u ^ 0x7fffffff); }
__device__ __forceinline__ float ord_val(int k) { return __int_as_float(k >= 0 ? k : (k ^ 0x7fffffff)); }
__device__ __forceinline__ int hmax32(int v) {
#pragma unroll
    for (int o = 1; o < 32; o <<= 1) { const int w = __shfl_xor(v, o); v = v > w ? v : w; }
    return v; }
__device__ __forceinline__ void topk_phase(const Ctx& F, const bf16* QP, const bf16* KEYS, int* EXP, float* GATE) {
    const int gw = F.vcu * NWAVES + F.wave, NGW = F.G * NWAVES, lane = F.lane, l31 = lane & 31, hi = lane >> 5;
    const int IMIN = (int)0x80000000;
    for (int item = gw; item < 256 * 8; item += NGW) {
        const int tt = item >> 3, h = item & 7, tok0 = tt * 32;
        int tops[2][16];
#pragma unroll
        for (int p = 0; p < 2; ++p) {
            f32x16 sc[4];
#pragma unroll
            for (int nt = 0; nt < 4; ++nt)
#pragma unroll
                for (int r = 0; r < 16; ++r) sc[nt][r] = 0.f;
#pragma unroll
            for (int s = 0; s < 8; ++s) {
                const bf16x8 a = *(const GAS bf16x8*)(QP + (size_t)(tok0 + l31) * 2048 + h * 256 + p * 128 + 16 * s + 8 * hi);
#pragma unroll
                for (int nt = 0; nt < 4; ++nt) { const bf16x8 bb = *(const GAS bf16x8*)(KEYS + (size_t)((h * 2 + p) * 128 + 32 * nt + l31) * 128 + 16 * s + 8 * hi);
                    sc[nt] = __builtin_amdgcn_mfma_f32_32x32x16_bf16(a, bb, sc[nt], 0, 0, 0); }
            }
#pragma unroll
            for (int r = 0; r < 16; ++r) {
                int k0 = (ord_key(sc[0][r]) & ~127) | (127 - l31), k1 = (ord_key(sc[1][r]) & ~127) | (95 - l31), k2 = (ord_key(sc[2][r]) & ~127) | (63 - l31), k3 = (ord_key(sc[3][r]) & ~127) | (31 - l31);
                int mytop = IMIN;
#pragma unroll 1
                for (int i = 0; i < 16; ++i) { int m = k0 > k1 ? k0 : k1; const int m2 = k2 > k3 ? k2 : k3; m = m > m2 ? m : m2; m = hmax32(m);
                    if (l31 == i) mytop = m;
                    k0 = (k0 == m) ? IMIN : k0; k1 = (k1 == m) ? IMIN : k1; k2 = (k2 == m) ? IMIN : k2; k3 = (k3 == m) ? IMIN : k3; }
                tops[p][r] = mytop;
            }
        }
        const int cd0 = CAND50[l31], cd1 = CAND50[32 + l31];
#pragma unroll
        for (int r = 0; r < 16; ++r) {
            const int ta = tops[0][r], tb = tops[1][r], base = 32 * hi;
            const int a0 = __shfl(ta, base + (cd0 >> 4)), b0 = __shfl(tb, base + (cd0 & 15)), a1 = __shfl(ta, base + ((cd1 >> 4) & 15)), b1 = __shfl(tb, base + (cd1 & 15));
            const float s0 = ord_val(a0 & ~127) + ord_val(b0 & ~127), s1 = ord_val(a1 & ~127) + ord_val(b1 & ~127);
            int c0 = (ord_key(s0) & ~255) | (255 - cd0), c1 = (cd1 == 0xff) ? IMIN : ((ord_key(s1) & ~255) | (255 - cd1));
            int best = IMIN;
#pragma unroll 1
            for (int i = 0; i < 16; ++i) { int m = c0 > c1 ? c0 : c1; m = hmax32(m); if (l31 == i) best = m; c0 = (c0 == m) ? IMIN : c0; c1 = (c1 == m) ? IMIN : c1; }
            const int posn = 255 - (best & 255), bi = (posn >> 4) & 15, bj = posn & 15;
            const int n1 = 127 - (__shfl(ta, base + bi) & 127), n2 = 127 - (__shfl(tb, base + bj) & 127);
            const float sv = ord_val(best & ~255), smax = __shfl(sv, base);
            float e = (l31 < 16) ? __expf(sv - smax) : 0.f; float es = e;
#pragma unroll
            for (int o = 1; o < 32; o <<= 1) es += __shfl_xor(es, o);
            const int token = tok0 + (r & 3) + 8 * (r >> 2) + 4 * hi;
            if (l31 < 16) { EXP[(size_t)token * 128 + h * 16 + l31] = n1 * 128 + n2; GATE[(size_t)token * 128 + h * 16 + l31] = e / es; }
        }
    }
}

template <int D> __device__ __forceinline__ void tr_step(float (&part)[64], int lane) {
    const bool up_ = (lane & D) != 0;
#pragma unroll
    for (int i = 0; i < D; ++i) { const float a = part[i], b = part[i + D]; const float send = up_ ? a : b, keep = up_ ? b : a; part[i] = keep + __shfl_xor(send, D); }
}
__device__ __forceinline__ void peer_phase(const Ctx& F, const bf16* UB, const bf16* VB, const bf16* X1B, const int* EXP, const float* GATE, const unsigned long long* SS, const float* gfin, float* X1) {
    const int gw = F.vcu * NWAVES + F.wave, NGW = F.G * NWAVES, lane = F.lane;
    constexpr int NPF = 4;
    for (int t = gw; t < M; t += NGW) {
        const int e01[2] = { EXP[(size_t)t * 128 + lane], EXP[(size_t)t * 128 + 64 + lane] };
        const float g01[2] = { GATE[(size_t)t * 128 + lane], GATE[(size_t)t * 128 + 64 + lane] };
        const float rinv2 = pg8::rinv_from_ss(SS[t]);
        v4u xq[4];
#pragma unroll
        for (int i = 0; i < 4; ++i) xq[i] = *(const GAS v4u*)(X1B + (size_t)t * DM + i * 512 + lane * 8);
        float act[2];
#pragma unroll
        for (int hf = 0; hf < 2; ++hf) {
            const int ev = e01[hf];
            float part[64]; v4u ub[NPF][4];
#pragma unroll
            for (int k = 0; k < NPF; ++k) { const GAS v4u* up = (const GAS v4u*)(UB + (size_t)__builtin_amdgcn_readlane(ev, k) * DM) + lane;
#pragma unroll
                for (int i = 0; i < 4; ++i) ub[k][i] = up[i * 64]; }
#pragma unroll
            for (int k = 0; k < 64; ++k) {
                float p0 = 0.f, p1 = 0.f;
#pragma unroll
                for (int i = 0; i < 4; ++i) { const v4u w = ub[k % NPF][i]; p0 = dot2bf(w.x, xq[i].x, p0); p1 = dot2bf(w.y, xq[i].y, p1); p0 = dot2bf(w.z, xq[i].z, p0); p1 = dot2bf(w.w, xq[i].w, p1); }
                part[k] = p0 + p1;
                if (k + NPF < 64) { const GAS v4u* up = (const GAS v4u*)(UB + (size_t)__builtin_amdgcn_readlane(ev, k + NPF) * DM) + lane;
#pragma unroll
                    for (int i = 0; i < 4; ++i) ub[k % NPF][i] = up[i * 64]; }
            }
            tr_step<32>(part, lane); tr_step<16>(part, lane); tr_step<8>(part, lane); tr_step<4>(part, lane); tr_step<2>(part, lane); tr_step<1>(part, lane);
            act[hf] = gelu_tanh(part[0] * rinv2) * g01[hf];
        }
        float y[32];
#pragma unroll
        for (int j = 0; j < 32; ++j) y[j] = 0.f;
#pragma unroll
        for (int hf = 0; hf < 2; ++hf) {
            const int ev = e01[hf]; const float av = act[hf];
            v4u vb[NPF][4];
#pragma unroll
            for (int k = 0; k < NPF; ++k) { const GAS v4u* vp = (const GAS v4u*)(VB + (size_t)__builtin_amdgcn_readlane(ev, k) * DM) + lane;
#pragma unroll
                for (int i = 0; i < 4; ++i) vb[k][i] = vp[i * 64]; }
#pragma unroll
            for (int k = 0; k < 64; ++k) {
                const float s = rdlane(av, k);
#pragma unroll
                for (int i = 0; i < 4; ++i) { const v4u w = vb[k % NPF][i];
                    y[8 * i + 0] += s * bflo(w.x); y[8 * i + 1] += s * bfhi(w.x); y[8 * i + 2] += s * bflo(w.y); y[8 * i + 3] += s * bfhi(w.y);
                    y[8 * i + 4] += s * bflo(w.z); y[8 * i + 5] += s * bfhi(w.z); y[8 * i + 6] += s * bflo(w.w); y[8 * i + 7] += s * bfhi(w.w); }
                if (k + NPF < 64) { const GAS v4u* vp = (const GAS v4u*)(VB + (size_t)__builtin_amdgcn_readlane(ev, k + NPF) * DM) + lane;
#pragma unroll
                    for (int i = 0; i < 4; ++i) vb[k % NPF][i] = vp[i * 64]; }
            }
        }
        GAS f32x4* xr = (GAS f32x4*)(X1 + (size_t)t * DM); float ss = 0.f;
#pragma unroll
        for (int i = 0; i < 4; ++i) { const f32x4 a = xr[i * 128 + 2 * lane], b = xr[i * 128 + 2 * lane + 1];
            y[8 * i + 0] += a[0]; y[8 * i + 1] += a[1]; y[8 * i + 2] += a[2]; y[8 * i + 3] += a[3]; y[8 * i + 4] += b[0]; y[8 * i + 5] += b[1]; y[8 * i + 6] += b[2]; y[8 * i + 7] += b[3]; }
#pragma unroll
        for (int j = 0; j < 32; ++j) ss += y[j] * y[j];
        const float r3 = 1.0f / sqrtf(wave_sum(ss) * (1.0f / DM) + RMS_EPS);
#pragma unroll
        for (int i = 0; i < 4; ++i) { const f32x4 ga = *(const GAS f32x4*)(gfin + i * 512 + lane * 8), gb = *(const GAS f32x4*)(gfin + i * 512 + lane * 8 + 4);
            xr[i * 128 + 2 * lane] = (f32x4){y[8 * i + 0] * r3 * ga[0], y[8 * i + 1] * r3 * ga[1], y[8 * i + 2] * r3 * ga[2], y[8 * i + 3] * r3 * ga[3]};
            xr[i * 128 + 2 * lane + 1] = (f32x4){y[8 * i + 4] * r3 * gb[0], y[8 * i + 5] * r3 * gb[1], y[8 * i + 6] * r3 * gb[2], y[8 * i + 7] * r3 * gb[3]}; }
    }
}
struct Args { const float* in[15]; float* out; unsigned char* ws; double invf[16]; int ph_lo, ph_hi, li, pad; };
__global__ void __launch_bounds__(NWAVES * 64, 2) mk_fwd(Args args) {
    extern __shared__ __attribute__((aligned(16))) unsigned char lds[];
    Ctx F;
    F.lds = (LAS unsigned char*)lds;
    volatile LAS unsigned* MISC = (volatile LAS unsigned*)(F.lds + MISC_OFF);
    F.tid = threadIdx.x; F.lane = F.tid & 63; F.wave = __builtin_amdgcn_readfirstlane(F.tid >> 6);
    F.G = gridDim.x; { const int bx = blockIdx.x; F.vcu = (F.G % 8 == 0) ? (bx % 8) * (F.G / 8) + bx / 8 : bx; }
    unsigned char* ws = args.ws;
    gu32* ctl = (gu32*)(ws + WS_CTL);
    for (int u = F.tid; u < (LDS_BYTES - LDSCTL_OFF) / 4; u += NWAVES * 64) ((LAS unsigned*)(F.lds + LDSCTL_OFF))[u] = 0u;
    __syncthreads();
    XcdBarrier bar; bar.bar = (unsigned*)(ctl + CW_BAR); bar.x = 0; bar.st = nullptr;
    if (N_LAUNCHES != PER_PHASE) bar = xcd_barrier_post((unsigned*)(ctl + CW_BAR), MISC + 8);
#define GRID_BAR() do { if (N_LAUNCHES != PER_PHASE) xcd_barrier(bar); } while (0)
    const int lo = args.ph_lo, hi = args.ph_hi;
#define IN(k) (lo <= (k) && (k) < hi)
#define BOTH(k) (IN(k) && IN((k) + 1))
    bf16* WinT = (bf16*)(ws + WS_WIN); bf16* WbcT = (bf16*)(ws + WS_WBC); bf16* WbaT = (bf16*)(ws + WS_WBA); bf16* WoutT = (bf16*)(ws + WS_WOUT); bf16* WpqT = (bf16*)(ws + WS_WPQ);
    bf16* KEYS = (bf16*)(ws + WS_KEYS); float* CS = (float*)(ws + WS_CS); bf16* UB = (bf16*)(ws + WS_UB); bf16* VB = (bf16*)(ws + WS_VB);
    bf16* XB = (bf16*)(ws + WS_XB); bf16* T6 = (bf16*)(ws + WS_T6); bf16* GAB = (bf16*)(ws + WS_GAB); bf16* UC = (bf16*)(ws + WS_UC); bf16* AO = (bf16*)(ws + WS_AO);
    bf16* TMP = (bf16*)(ws + WS_TMP); bf16* MB = (bf16*)(ws + WS_MB); bf16* X1B = (bf16*)(ws + WS_X1B); bf16* QP = (bf16*)(ws + WS_QP);
    int* EXP = (int*)(ws + WS_EXP); float* GATE = (float*)(ws + WS_GATE);
    unsigned long long* SS = (unsigned long long*)(ws + WS_SS); float* KSUM = (float*)(ws + WS_KSUM);
    constexpr size_t TS = (size_t)M * 1024;

    if (IN(0)) { p0_prologue(F, args.in, ws, args.invf); if (BOTH(0)) GRID_BAR(); }
    if (IN(1)) {
        pg8::Gemm g{XB, WinT, M, INW, DM}; pg8::StaticOrder S; S.init(M, INW, F.G, (int)blockIdx.x);
        pg8::EpiIn E{T6, GAB, args.in[4], CS, KSUM};
        pg8::gemm_phase<pg8::EpiIn, pg8::StaticOrder, true, true>(F.lds + RING_OFF, g, S, E);
        if (BOTH(1)) GRID_BAR();
    }
    if (IN(2)) {
        attn_mfma(F, T6 + 3 * TS, T6 + 4 * TS, T6 + 5 * TS, KSUM, AO);
        conv_phase(F, T6, T6 + TS, T6 + 2 * TS, args.in[5], UC);
        if (BOTH(2)) GRID_BAR();
    }
    if (IN(3)) {
        pg8::Gemm g{UC, WbcT, M, DM, 1024}; pg8::StaticOrder S; S.init(M, DM, F.G, (int)blockIdx.x);
        pg8::EpiTmp E{GAB, TMP};
        pg8::gemm_phase<pg8::EpiTmp, pg8::StaticOrder, true, true>(F.lds + RING_OFF, g, S, E);
        if (BOTH(3)) GRID_BAR();
    }
    if (IN(4)) {
        pg8::Gemm g{AO, WbaT, M, DM, 1024}; pg8::StaticOrder S; S.init(M, DM, F.G, (int)blockIdx.x);
        pg8::EpiMerge E{GAB + (size_t)M * DM, TMP, MB};
        pg8::gemm_phase<pg8::EpiMerge, pg8::StaticOrder, true, true>(F.lds + RING_OFF, g, S, E);
        if (BOTH(4)) GRID_BAR();
    }
    if (IN(5)) {
        pg8::Gemm g{MB, WoutT, M, DM, DM}; pg8::StaticOrder S; S.init(M, DM, F.G, (int)blockIdx.x);
        pg8::EpiX1 E{args.in[0], args.out, X1B, SS};
        pg8::gemm_phase<pg8::EpiX1, pg8::StaticOrder, true, true>(F.lds + RING_OFF, g, S, E);
        if (BOTH(5)) GRID_BAR();
    }
    if (IN(6)) {
        pg8::Gemm g{X1B, WpqT, M, DM, DM}; pg8::StaticOrder S; S.init(M, DM, F.G, (int)blockIdx.x);
        pg8::EpiQP E{SS, QP};
        pg8::gemm_phase<pg8::EpiQP, pg8::StaticOrder, true, true>(F.lds + RING_OFF, g, S, E);
        if (BOTH(6)) GRID_BAR();
    }
    if (IN(7)) { topk_phase(F, QP, KEYS, EXP, GATE); if (BOTH(7)) GRID_BAR(); }
    if (IN(8)) { peer_phase(F, UB, VB, X1B, EXP, GATE, SS, args.in[14], args.out); }
#undef IN
#undef BOTH
#undef GRID_BAR
}

#ifndef MK_DUMP_OFF
#define MK_DUMP_OFF WS_GAB
#endif
__global__ void dump_f32(const float* src, float* dst, int n, int nsrc) { for (int i = blockIdx.x * blockDim.x + threadIdx.x; i < n; i += gridDim.x * blockDim.x) dst[i] = src[i % nsrc]; }
__global__ void dump_bf16(const unsigned short* src, float* dst, int n) { for (int i = blockIdx.x * blockDim.x + threadIdx.x; i < n; i += gridDim.x * blockDim.x) dst[i] = __uint_as_float((unsigned)src[i] << 16); }
extern "C" void kernel_launch(void* const* d_in, const int* in_sizes, int n_in, void* d_out, int out_size, void* d_ws, size_t ws_size, hipStream_t stream) {
    static int grid = 0;
    if (grid == 0) {
        if (n_in != 15 || in_sizes[0] != M * DM || out_size != M * DM || ws_size < WS_END) { fprintf(stderr, "kernel_launch: unexpected shapes (n_in %d, in0 %d, out %d, ws %zu)\n", n_in, n_in > 0 ? in_sizes[0] : -1, out_size, ws_size); grid = -1; return; }
        int dev = 0, cus = 0, per_cu = 0;
        if (hipGetDevice(&dev) != hipSuccess || hipDeviceGetAttribute(&cus, hipDeviceAttributeMultiprocessorCount, dev) != hipSuccess) { grid = -1; return; }
        if (hipFuncSetAttribute((const void*)mk_fwd, hipFuncAttributeMaxDynamicSharedMemorySize, LDS_BYTES) != hipSuccess) { fprintf(stderr, "kernel_launch: hipFuncSetAttribute failed\n"); grid = -1; return; }
        if (hipOccupancyMaxActiveBlocksPerMultiprocessor(&per_cu, (const void*)mk_fwd, NWAVES * 64, LDS_BYTES) != hipSuccess || per_cu < 1) fprintf(stderr, "kernel_launch: occupancy query reports %d\n", per_cu);
        (void)hipGetLastError();
        grid = cus;
    }
    if (grid < 0) return;
    if (hipMemsetAsync((char*)d_ws + WS_CTL, 0, CTL_ZERO_BYTES, stream) != hipSuccess) { fprintf(stderr, "kernel_launch: memset failed\n"); return; }
    Args a{};
    for (int i = 0; i < 15; ++i) a.in[i] = (const float*)d_in[i];
    a.out = (float*)d_out; a.ws = (unsigned char*)d_ws;
    for (int f = 0; f < 16; ++f) a.invf[f] = pow(500000.0, -(double)(2 * f) / 32.0);
    for (int li = 0; li < N_LAUNCHES && li < MK_LAST_PHASE; ++li) {
        a.ph_lo = (N_LAUNCHES == PER_PHASE) ? li : 0; a.ph_hi = (N_LAUNCHES == PER_PHASE) ? li + 1 : PER_PHASE; a.li = li;
        hipLaunchKernelGGL(mk_fwd, dim3(grid), dim3(NWAVES * 64), LDS_BYTES, stream, a);
        const hipError_t le = hipPeekAtLastError();
        if (le != hipSuccess) { fprintf(stderr, "kernel_launch: launch %d failed: %s\n", li, hipGetErrorName(le)); break; }
    }
    if (MK_LAST_PHASE < 6) hipLaunchKernelGGL(dump_f32, dim3(2048), dim3(256), 0, stream, (const float*)d_in[4], (float*)d_out, M * DM, 4096);
    if (0) hipLaunchKernelGGL(dump_bf16, dim3(2048), dim3(256), 0, stream, (const unsigned short*)((const char*)d_ws + MK_DUMP_OFF), (float*)d_out, M * DM);
}
```

```cpp
#include <hip/hip_runtime.h>
#include <cstdio>
#include <cstdint>
#include <cmath>
namespace pg8 {
#define PG8_LAS __attribute__((address_space(3)))
typedef unsigned short bf16_t;
typedef short bf16x8 __attribute__((ext_vector_type(8)));
typedef float f32x4 __attribute__((ext_vector_type(4)));
typedef unsigned u32x4 __attribute__((ext_vector_type(4)));
constexpr int BM = 256, BK = 64, HALF = 128, HTB = HALF * BK * 2  , STAGE_BYTES = 8 * HTB, NXCD = 8, WGM = 8;

__host__ __device__ __forceinline__ int lds_byte(int r, int c) { const int st = (r >> 4) * 2 + (c >> 5), rr = r & 15, cc = c & 31, ob = rr * 64 + cc * 2; return st * 1024 + (ob ^ (((ob >> 9) & 1) << 5)); }
__host__ __device__ __forceinline__ void stage_rc(int b, int& R, int& C) { const int st = b / 1024, sb = b % 1024, swz = sb ^ (((sb >> 9) & 1) << 5); R = (st >> 1) * 16 + swz / 64; C = (st & 1) * 32 + (swz % 64) / 2; }
__host__ __device__ __forceinline__ int perm32(int rho) { const int n = rho >> 4, i = rho & 15; return 8 * (i >> 2) + 4 * n + (i & 3); }

struct Unit { int pm, pn; };
struct Gemm { const bf16_t* A; const bf16_t* Bt; int M, N, K; };

struct StaticOrder {
    int nM, nN, nwg, G, c;
    __host__ __device__ void init(int M, int N, int G_, int c_) { nM = M / BM; nN = N / BM; nwg = nM * nN; G = G_; c = c_; }
    __host__ __device__ bool next(int i, Unit& u) const {
        const long L = (long)i * G + c; if (L >= nwg) return false;
        int wgid = (int)L; { const int q = nwg / NXCD, r = nwg % NXCD, xcd = wgid % NXCD, off = wgid / NXCD; wgid = (xcd < r ? xcd * (q + 1) : r * (q + 1) + (xcd - r) * q) + off; }
        const int nig = WGM * nN, gid = wgid / nig, fm = gid * WGM, gsz = (nM - fm) < WGM ? (nM - fm) : WGM;
        u.pm = fm + ((wgid % nig) % gsz); u.pn = (wgid % nig) / gsz; return true;
    }
    __device__ __forceinline__ void a_ready(const Unit&) const {}
    __device__ __forceinline__ void done(const Unit&) const {}
};


typedef float f32x2c __attribute__((ext_vector_type(2))); typedef __bf16 bf16x2c __attribute__((ext_vector_type(2)));
__device__ __forceinline__ unsigned cvt_pk_bf16(float lo, float hi) { const f32x2c v = {lo, hi}; const bf16x2c b = __builtin_convertvector(v, bf16x2c); return __builtin_bit_cast(unsigned, b); }
__device__ __forceinline__ u32x4 pack8(f32x4 a, f32x4 b) { u32x4 w; w.x = cvt_pk_bf16(a[0], a[1]); w.y = cvt_pk_bf16(a[2], a[3]); w.z = cvt_pk_bf16(b[0], b[1]); w.w = cvt_pk_bf16(b[2], b[3]); return w; }
__device__ __forceinline__ f32x4 shx(f32x4 v, int o) { f32x4 r; r[0] = __shfl_xor(v[0], o); r[1] = __shfl_xor(v[1], o); r[2] = __shfl_xor(v[2], o); r[3] = __shfl_xor(v[3], o); return r; }
__device__ __forceinline__ f32x4 bf4lo(unsigned a, unsigned b) { f32x4 r; r[0] = __uint_as_float(a << 16); r[1] = __uint_as_float(a & 0xffff0000u); r[2] = __uint_as_float(b << 16); r[3] = __uint_as_float(b & 0xffff0000u); return r; }
__device__ __forceinline__ f32x4 sigm4(f32x4 v) { f32x4 r;
#pragma unroll
    for (int i = 0; i < 4; ++i) r[i] = __builtin_amdgcn_rcpf(1.0f + __expf(-v[i])); return r; }
constexpr float QSCALE = 0.08838834764831845f * 1.4426950408889634f;

struct EpiIn {
    static constexpr bool PERM = true, AFTER_DRAIN = false;
    bf16_t* T6; bf16_t* GAB; const float* gbias; const float* cs; float* ksum;
    __device__ __forceinline__ void operator()(const f32x4 (&acc)[2][2][4][2], const Unit& u, int wr, int wc, int fr, int fq) const {
        const int row0 = u.pm * BM + wr * 64 + fr, pn = u.pn, colw = wc * 32 + 8 * fq;
        if (pn < 24) {
            const int t = pn >> 2;
            bf16_t* base = T6 + (size_t)t * ((size_t)8192 * 1024) + (pn & 3) * 256 + colw;
            const bool rot = (t == 3 || t == 4) && (wc == 0), isk = (t == 4);
            const float qs = (t == 3) ? QSCALE : 1.0f;
            f32x4 ks[2][2];
#pragma unroll
            for (int bj = 0; bj < 2; ++bj) { ks[bj][0] = (f32x4){0.f, 0.f, 0.f, 0.f}; ks[bj][1] = (f32x4){0.f, 0.f, 0.f, 0.f}; }
#pragma unroll
            for (int ai = 0; ai < 2; ++ai)
#pragma unroll
                for (int m = 0; m < 4; ++m) {
                    const int row = row0 + ai * HALF + m * 16;
                    f32x4 c0 = (f32x4){1.f, 1.f, 1.f, 1.f}, c1 = c0, s0 = (f32x4){0.f, 0.f, 0.f, 0.f}, s1 = s0;
                    if (rot) { const float* cp = cs + (size_t)row * 32 + 8 * (fq & 1); c0 = *(const f32x4*)cp; c1 = *(const f32x4*)(cp + 4); s0 = *(const f32x4*)(cp + 16); s1 = *(const f32x4*)(cp + 20);
                        if (fq < 2) { s0 = -s0; s1 = -s1; } }
#pragma unroll
                    for (int bj = 0; bj < 2; ++bj) {
                        f32x4 v0 = acc[ai][bj][m][0], v1 = acc[ai][bj][m][1];
                        if (rot) { const f32x4 p0 = shx(v0, 32), p1 = shx(v1, 32); v0 = v0 * c0 + p0 * s0; v1 = v1 * c1 + p1 * s1; }
                        if (isk) { ks[bj][0] += v0; ks[bj][1] += v1; }
                        v0 = v0 * qs; v1 = v1 * qs;
                        *(u32x4*)(base + (size_t)row * 1024 + bj * HALF) = pack8(v0, v1);
                    }
                }
            if (isk) {
#pragma unroll
                for (int bj = 0; bj < 2; ++bj)
#pragma unroll
                    for (int n = 0; n < 2; ++n) { f32x4 v = ks[bj][n]; v += shx(v, 1); v += shx(v, 2); v += shx(v, 4); v += shx(v, 8);
                        if (fr == 0) { float* kp = ksum + (size_t)u.pm * 1024 + (pn & 3) * 256 + bj * HALF + colw + 4 * n;
                            unsafeAtomicAdd(kp + 0, v[0]); unsafeAtomicAdd(kp + 1, v[1]); unsafeAtomicAdd(kp + 2, v[2]); unsafeAtomicAdd(kp + 3, v[3]); } }
            }
        } else {
            const int t = (pn - 24) >> 3, colg = ((pn - 24) & 7) * 256 + colw;
            bf16_t* base = GAB + (size_t)t * ((size_t)8192 * 2048) + colg;
            const float* bp = gbias + t * 2048 + colg;
            f32x4 bv[2][2];
#pragma unroll
            for (int bj = 0; bj < 2; ++bj) { bv[bj][0] = *(const f32x4*)(bp + bj * HALF); bv[bj][1] = *(const f32x4*)(bp + bj * HALF + 4); }
#pragma unroll
            for (int ai = 0; ai < 2; ++ai)
#pragma unroll
                for (int m = 0; m < 4; ++m) { const int row = row0 + ai * HALF + m * 16;
#pragma unroll
                    for (int bj = 0; bj < 2; ++bj) *(u32x4*)(base + (size_t)row * 2048 + bj * HALF) = pack8(sigm4(acc[ai][bj][m][0] + bv[bj][0]), sigm4(acc[ai][bj][m][1] + bv[bj][1])); }
        }
    }
};
struct EpiTmp {
    static constexpr bool PERM = true, AFTER_DRAIN = false;
    const bf16_t* G; bf16_t* O;
    __device__ __forceinline__ void operator()(const f32x4 (&acc)[2][2][4][2], const Unit& u, int wr, int wc, int fr, int fq) const {
        const int row0 = u.pm * BM + wr * 64 + fr, col0 = u.pn * BM + wc * 32 + 8 * fq;
#pragma unroll
        for (int ai = 0; ai < 2; ++ai)
#pragma unroll
            for (int m = 0; m < 4; ++m) { const size_t off = (size_t)(row0 + ai * HALF + m * 16) * 2048 + col0;
#pragma unroll
                for (int bj = 0; bj < 2; ++bj) { const u32x4 g = *(const u32x4*)(G + off + bj * HALF);
                    *(u32x4*)(O + off + bj * HALF) = pack8(acc[ai][bj][m][0] * bf4lo(g.x, g.y), acc[ai][bj][m][1] * bf4lo(g.z, g.w)); } }
    }
};
struct EpiMerge {
    static constexpr bool PERM = true, AFTER_DRAIN = false;
    const bf16_t* G; const bf16_t* TMP; bf16_t* O;
    __device__ __forceinline__ void operator()(const f32x4 (&acc)[2][2][4][2], const Unit& u, int wr, int wc, int fr, int fq) const {
        const int row0 = u.pm * BM + wr * 64 + fr, col0 = u.pn * BM + wc * 32 + 8 * fq;
#pragma unroll
        for (int ai = 0; ai < 2; ++ai)
#pragma unroll
            for (int m = 0; m < 4; ++m) { const size_t off = (size_t)(row0 + ai * HALF + m * 16) * 2048 + col0;
#pragma unroll
                for (int bj = 0; bj < 2; ++bj) { const u32x4 g = *(const u32x4*)(G + off + bj * HALF), t = *(const u32x4*)(TMP + off + bj * HALF);
                    *(u32x4*)(O + off + bj * HALF) = pack8(bf4lo(t.x, t.y) + acc[ai][bj][m][0] * bf4lo(g.x, g.y), bf4lo(t.z, t.w) + acc[ai][bj][m][1] * bf4lo(g.z, g.w)); } }
    }
};
struct EpiX1 {
    static constexpr bool PERM = true, AFTER_DRAIN = false;
    const float* X; float* X1; bf16_t* X1B; unsigned long long* SS;
    __device__ __forceinline__ void operator()(const f32x4 (&acc)[2][2][4][2], const Unit& u, int wr, int wc, int fr, int fq) const {
        const int row0 = u.pm * BM + wr * 64 + fr, col0 = u.pn * BM + wc * 32 + 8 * fq;
#pragma unroll
        for (int ai = 0; ai < 2; ++ai)
#pragma unroll
            for (int m = 0; m < 4; ++m) { const int row = row0 + ai * HALF + m * 16; const size_t off = (size_t)row * 2048 + col0; float sq = 0.f;
#pragma unroll
                for (int bj = 0; bj < 2; ++bj) { const f32x4 v0 = acc[ai][bj][m][0] + *(const f32x4*)(X + off + bj * HALF), v1 = acc[ai][bj][m][1] + *(const f32x4*)(X + off + bj * HALF + 4);
                    *(f32x4*)(X1 + off + bj * HALF) = v0; *(f32x4*)(X1 + off + bj * HALF + 4) = v1; *(u32x4*)(X1B + off + bj * HALF) = pack8(v0, v1);
                    sq += (v0[0] * v0[0] + v0[1] * v0[1]) + (v0[2] * v0[2] + v0[3] * v0[3]) + (v1[0] * v1[0] + v1[1] * v1[1]) + (v1[2] * v1[2] + v1[3] * v1[3]); }
                sq += __shfl_xor(sq, 16); sq += __shfl_xor(sq, 32);
                if (fq == 0) atomicAdd(SS + row, (unsigned long long)(sq * 4294967296.0f)); }
    }
};
__device__ __forceinline__ float rinv_from_ss(unsigned long long s) { return 1.0f / sqrtf((float)((double)s * (1.0 / 4294967296.0) * (1.0 / 2048.0)) + 1e-6f); }
struct EpiQP {
    static constexpr bool PERM = true, AFTER_DRAIN = false;
    const unsigned long long* SS; bf16_t* O;
    __device__ __forceinline__ void operator()(const f32x4 (&acc)[2][2][4][2], const Unit& u, int wr, int wc, int fr, int fq) const {
        const int row0 = u.pm * BM + wr * 64 + fr, col0 = u.pn * BM + wc * 32 + 8 * fq;
#pragma unroll
        for (int ai = 0; ai < 2; ++ai)
#pragma unroll
            for (int m = 0; m < 4; ++m) { const int row = row0 + ai * HALF + m * 16; const size_t off = (size_t)row * 2048 + col0; const float rv = rinv_from_ss(SS[row]);
#pragma unroll
                for (int bj = 0; bj < 2; ++bj) *(u32x4*)(O + off + bj * HALF) = pack8(acc[ai][bj][m][0] * rv, acc[ai][bj][m][1] * rv); }
    }
};

template <class Epi, class Sched, bool ALIGN_EPI = false, bool SP2 = false>
__device__ __forceinline__ void gemm_phase(PG8_LAS unsigned char* lds, const Gemm g, const Sched& S, const Epi& E) {
    const int tid = threadIdx.x, wid = __builtin_amdgcn_readfirstlane(tid >> 6), lane = tid & 63, wr = wid >> 2, wc = wid & 3, fr = lane & 15, fq = lane >> 4;
    const int K = g.K, nt = K / BK;
    unsigned voffA[2], voffB[2];
#pragma unroll
    for (int i = 0; i < 2; ++i) { int R, C; stage_rc(tid * 16 + i * 8192, R, C); const int Rb = Epi::PERM ? ((R & ~31) + perm32(R & 31)) : R;
        voffA[i] = (unsigned)(R * K + C) * 2u; voffB[i] = (unsigned)(Rb * K + C) * 2u; }
    const size_t kstep = (size_t)(BK * 2);
    const size_t hstep = (size_t)HALF * K * 2;
    const size_t tstep = 2 * hstep;
    const unsigned ldsw = (unsigned)wid * 1024u;
    const int aoff = lds_byte(wr * 64 + fr, fq * 8), boff = lds_byte(wc * 32 + fr, fq * 8);
#define PG8_SA(b, h) (((b) * 2 + (h)) * HTB)
#define PG8_SB(b, h) ((4 + (b) * 2 + (h)) * HTB)
#define PG8_STAGE(bufoff, gbase, voff) do { _Pragma("unroll") for (int _i = 0; _i < 2; ++_i) \
        __builtin_amdgcn_global_load_lds((const unsigned*)((const char*)(gbase) + (voff)[_i]), (PG8_LAS unsigned*)(lds + (bufoff) + ldsw + _i * 8192), 16, 0, 0); } while (0)
#define PG8_LDA(dst, b, h) do { _Pragma("unroll") for (int m = 0; m < 4; ++m) _Pragma("unroll") for (int k = 0; k < 2; ++k) dst[m][k] = *(const PG8_LAS bf16x8*)(lds + PG8_SA(b, h) + aoff + m * 2048 + k * 1024); } while (0)
#define PG8_LDB(dst, b, h) do { _Pragma("unroll") for (int n = 0; n < 2; ++n) _Pragma("unroll") for (int k = 0; k < 2; ++k) dst[n][k] = *(const PG8_LAS bf16x8*)(lds + PG8_SB(b, h) + boff + n * 2048 + k * 1024); } while (0)
#define PG8_MMA(ai, bj, At, Bt) do { __builtin_amdgcn_s_setprio(1); _Pragma("unroll") for (int m = 0; m < 4; ++m) _Pragma("unroll") for (int n = 0; n < 2; ++n) _Pragma("unroll") for (int k = 0; k < 2; ++k) \
        acc[ai][bj][m][n] = __builtin_amdgcn_mfma_f32_16x16x32_bf16(Bt[n][k], At[m][k], acc[ai][bj][m][n], 0, 0, 0); __builtin_amdgcn_s_setprio(0); } while (0)
#define PG8_WAIT_V(n) asm volatile("s_waitcnt vmcnt(" #n ")" ::: "memory")
#define PG8_WAIT_L(n) asm volatile("s_waitcnt lgkmcnt(" #n ")" ::: "memory")
#define PG8_BAR __builtin_amdgcn_s_barrier()
#define PG8_SCHED __builtin_amdgcn_sched_barrier(0)
    Unit cur, nxt; int ui = 0;
    if (!S.next(0, cur)) return;
    f32x4 acc[2][2][4][2];
#pragma unroll
    for (int a = 0; a < 2; ++a)
#pragma unroll
        for (int b = 0; b < 2; ++b)
#pragma unroll
            for (int m = 0; m < 4; ++m)
#pragma unroll
                for (int n = 0; n < 2; ++n) acc[a][b][m][n] = (f32x4){0.f, 0.f, 0.f, 0.f};
    bf16x8 At[4][2], B0[2][2], B1[2][2];
    const char* cA = (const char*)g.A + (size_t)cur.pm * tstep; const char* cB = (const char*)g.Bt + (size_t)cur.pn * tstep;
    S.a_ready(cur);
    if constexpr (SP2) {
        PG8_STAGE(PG8_SB(0, 0), cB, voffB); PG8_STAGE(PG8_SB(0, 1), cB + hstep, voffB); PG8_STAGE(PG8_SA(0, 0), cA, voffA); PG8_STAGE(PG8_SA(0, 1), cA + hstep, voffA);
        if (wr == 1) PG8_BAR;
        PG8_WAIT_V(2); PG8_BAR;
        PG8_STAGE(PG8_SB(1, 0), cB + kstep, voffB); PG8_STAGE(PG8_SA(1, 0), cA + kstep, voffA); PG8_STAGE(PG8_SB(1, 1), cB + hstep + kstep, voffB);
        PG8_WAIT_V(6); PG8_BAR;
    } else {
        PG8_STAGE(PG8_SB(0, 0), cB, voffB); PG8_STAGE(PG8_SA(0, 0), cA, voffA); PG8_STAGE(PG8_SB(0, 1), cB + hstep, voffB); PG8_STAGE(PG8_SA(0, 1), cA + hstep, voffA);
        if (wr == 1) PG8_BAR;
        PG8_WAIT_V(4); PG8_BAR;
        PG8_STAGE(PG8_SB(1, 0), cB + kstep, voffB); PG8_STAGE(PG8_SA(1, 0), cA + kstep, voffA); PG8_STAGE(PG8_SB(1, 1), cB + hstep + kstep, voffB);
        PG8_WAIT_V(6); PG8_BAR;
    }
    for (;;) {
        const bool has_next = S.next(ui + 1, nxt);
        const char* nA = has_next ? (const char*)g.A + (size_t)nxt.pm * tstep : cA; const char* nB = has_next ? (const char*)g.Bt + (size_t)nxt.pn * tstep : cB;
        for (int t = 0; t < nt; t += 2) {
            const bool last = (t == nt - 2);
            const char* a1 = cA + (size_t)(t + 1) * kstep;
            const char* a2 = last ? nA : cA + (size_t)(t + 2) * kstep; const char* b2 = last ? nB : cB + (size_t)(t + 2) * kstep;
            const char* a3 = a2 + kstep; const char* b3 = b2 + kstep;
            if (last && has_next) S.a_ready(nxt);
            if constexpr (SP2) {
            PG8_LDB(B0, 0, 0); PG8_LDB(B1, 0, 1); PG8_SCHED; PG8_LDA(At, 0, 0); PG8_STAGE(PG8_SA(1, 1), a1 + hstep, voffA);
            PG8_WAIT_V(8); PG8_WAIT_L(0); PG8_BAR; PG8_MMA(0, 0, At, B0); PG8_MMA(0, 1, At, B1); PG8_BAR; PG8_SCHED;
            PG8_LDA(At, 0, 1); PG8_STAGE(PG8_SB(0, 0), b2, voffB); PG8_STAGE(PG8_SB(0, 1), b2 + hstep, voffB); PG8_STAGE(PG8_SA(0, 0), a2, voffA);
            PG8_WAIT_V(8); PG8_WAIT_L(0); PG8_BAR; PG8_MMA(1, 0, At, B0); PG8_MMA(1, 1, At, B1); PG8_BAR; PG8_SCHED;
            PG8_LDB(B0, 1, 0); PG8_LDB(B1, 1, 1); PG8_SCHED; PG8_LDA(At, 1, 0); PG8_STAGE(PG8_SA(0, 1), a2 + hstep, voffA);
            PG8_WAIT_V(8); PG8_WAIT_L(0); PG8_BAR; PG8_MMA(0, 0, At, B0); PG8_MMA(0, 1, At, B1); PG8_BAR; PG8_SCHED;
            PG8_LDA(At, 1, 1); PG8_STAGE(PG8_SB(1, 0), b3, voffB); PG8_STAGE(PG8_SB(1, 1), b3 + hstep, voffB); PG8_STAGE(PG8_SA(1, 0), a3, voffA);
            PG8_WAIT_V(8); PG8_WAIT_L(0); PG8_BAR; PG8_MMA(1, 0, At, B0); PG8_MMA(1, 1, At, B1); PG8_BAR; PG8_SCHED;
            } else {
            PG8_LDB(B0, 0, 0); PG8_SCHED; PG8_LDA(At, 0, 0); PG8_STAGE(PG8_SA(1, 1), a1 + hstep, voffA);
            PG8_WAIT_L(8); PG8_BAR; PG8_WAIT_L(0); PG8_MMA(0, 0, At, B0); PG8_BAR; PG8_SCHED;
            PG8_LDB(B1, 0, 1); PG8_STAGE(PG8_SB(0, 0), b2, voffB);
            PG8_BAR; PG8_WAIT_L(0); PG8_MMA(0, 1, At, B1); PG8_BAR;
            PG8_LDA(At, 0, 1); PG8_STAGE(PG8_SA(0, 0), a2, voffA);
            PG8_BAR; PG8_WAIT_L(0); PG8_MMA(1, 0, At, B0); PG8_BAR; PG8_SCHED;
            PG8_STAGE(PG8_SB(0, 1), b2 + hstep, voffB);
            PG8_WAIT_V(6); PG8_BAR; PG8_MMA(1, 1, At, B1); PG8_BAR;
            PG8_LDB(B0, 1, 0); PG8_SCHED; PG8_LDA(At, 1, 0); PG8_STAGE(PG8_SA(0, 1), a2 + hstep, voffA);
            PG8_WAIT_L(8); PG8_BAR; PG8_WAIT_L(0); PG8_MMA(0, 0, At, B0); PG8_BAR; PG8_SCHED;
            PG8_LDB(B1, 1, 1); PG8_STAGE(PG8_SB(1, 0), b3, voffB);
            PG8_BAR; PG8_WAIT_L(0); PG8_MMA(0, 1, At, B1); PG8_BAR;
            PG8_LDA(At, 1, 1); PG8_STAGE(PG8_SA(1, 0), a3, voffA);
            PG8_BAR; PG8_WAIT_L(0); PG8_MMA(1, 0, At, B0); PG8_BAR; PG8_SCHED;
            PG8_STAGE(PG8_SB(1, 1), b3 + hstep, voffB);
            PG8_WAIT_V(6); PG8_BAR; PG8_MMA(1, 1, At, B1); PG8_BAR;
            }
        }
        if constexpr (ALIGN_EPI) { if (wr == 0) PG8_BAR; }
        if constexpr (!Epi::AFTER_DRAIN) { E(acc, cur, wr, wc, fr, fq); S.done(cur); }
        if (!has_next) break;
#pragma unroll
        for (int a = 0; a < 2; ++a)
#pragma unroll
            for (int b = 0; b < 2; ++b)
#pragma unroll
                for (int m = 0; m < 4; ++m)
#pragma unroll
                    for (int n = 0; n < 2; ++n) acc[a][b][m][n] = (f32x4){0.f, 0.f, 0.f, 0.f};
        cur = nxt; cA = nA; cB = nB; ++ui;
        if constexpr (ALIGN_EPI) { if (wr == 1) PG8_BAR; }
    }
    PG8_WAIT_V(0);
    if constexpr (!ALIGN_EPI) { if (wr == 0) PG8_BAR; }
    PG8_BAR;
    if constexpr (Epi::AFTER_DRAIN) { E.fused(acc, cur, wr, wc, fr, fq, lds, wid, lane); S.done(cur); }
#undef PG8_SA
#undef PG8_SB
#undef PG8_STAGE
#undef PG8_LDA
#undef PG8_LDB
#undef PG8_MMA
#undef PG8_WAIT_V
#undef PG8_WAIT_L
#undef PG8_BAR
#undef PG8_SCHED
}
}

constexpr int NWAVES = 8;
#ifndef MK_N_LAUNCHES
#define MK_N_LAUNCHES 1
#endif
constexpr int PER_PHASE = 9;
#ifndef MK_REP_PHASE
#define MK_REP_PHASE -1
#endif
#define NREP(k) (((k) == MK_REP_PHASE) ? 2 : 1)
constexpr int N_LAUNCHES = MK_N_LAUNCHES;
constexpr int M = 8192, SEQ = 4096, DM = 2048, INW = 10240, NEXP = 16384;
constexpr float RMS_EPS = 1e-6f;
constexpr size_t MiB = 1u << 20;
constexpr size_t WS_CTL = 0, CTL_ZERO_BYTES = 1 * MiB;
constexpr size_t WS_SS = 256 * 1024, WS_KSUM = 512 * 1024;
constexpr size_t WS_WIN = 2 * MiB, WS_WBC = 42 * MiB, WS_WBA = 46 * MiB, WS_WOUT = 50 * MiB, WS_WPQ = 58 * MiB, WS_KEYS = 66 * MiB, WS_CS = 67 * MiB;
constexpr size_t WS_UB = 70 * MiB, WS_VB = 134 * MiB;
constexpr size_t WS_XB = 198 * MiB;
constexpr size_t WS_T6 = 230 * MiB;
constexpr size_t WS_GAB = 326 * MiB;
constexpr size_t WS_UC = 390 * MiB, WS_AO = 406 * MiB;
constexpr size_t WS_EXP = 422 * MiB, WS_GATE = 426 * MiB;
constexpr size_t WS_END = 430 * MiB;
constexpr size_t WS_TMP = WS_XB, WS_MB = WS_T6, WS_X1B = WS_T6 + 48 * MiB, WS_QP = WS_GAB;
constexpr int CW_BAR = 4096;
constexpr int RING_OFF = 0, RING_BYTES = 131072;
constexpr int LDSCTL_OFF = RING_BYTES, MISC_OFF = LDSCTL_OFF + 320;
constexpr int LDS_BYTES = 147456;

#define GAS __attribute__((address_space(1)))
#define LAS __attribute__((address_space(3)))
typedef unsigned short bf16;
typedef unsigned v4u __attribute__((ext_vector_type(4)));
typedef float f32x4 __attribute__((ext_vector_type(4)));
typedef short bf16x8 __attribute__((ext_vector_type(8)));
typedef GAS unsigned gu32;
typedef GAS unsigned long long gu64;
#define RLX_AGENT __ATOMIC_RELAXED, __HIP_MEMORY_SCOPE_AGENT
#define LDS_WAIT() asm volatile("s_waitcnt lgkmcnt(0)" ::: "memory")
#define VM_WAIT() asm volatile("s_waitcnt vmcnt(0)" ::: "memory")
__device__ __forceinline__ unsigned long long rt() { return __builtin_amdgcn_s_memrealtime(); }
__device__ __forceinline__ unsigned f2bf(float f) { unsigned u = __builtin_bit_cast(unsigned, f); return (u + 0x7fffu + ((u >> 16) & 1u)) >> 16; }
__device__ __forceinline__ unsigned pk2(float lo, float hi) { return f2bf(lo) | (f2bf(hi) << 16); }

#define XB_TMO      128
#define XB_XCNT(j)  (256  + 64 * (j))
#define XB_XSUB(j)  (1280 + 64 * (j))
#define XB_XGEN(j)  (2304 + 64 * (j))
#define XB_TOP      3328
#define XB_TOPGEN   3392
#define XCD_BAR_WORDS 3456
#define XB_SPIN_CAP (1u << 18)

__device__ __forceinline__ unsigned xb_ld(unsigned* p)              { return __hip_atomic_load(p, __ATOMIC_RELAXED, __HIP_MEMORY_SCOPE_AGENT); }
__device__ __forceinline__ unsigned xb_add(unsigned* p, unsigned v) { return __hip_atomic_fetch_add(p, v, __ATOMIC_RELAXED, __HIP_MEMORY_SCOPE_AGENT); }
__device__ __forceinline__ unsigned xb_xcc_id() { return (unsigned)__builtin_amdgcn_s_getreg((3 << 11) | 20) & 0xFu; }
#define XB_SPIN(cond, bar) do { unsigned _sp = 0; while (cond) { __builtin_amdgcn_s_sleep(1); \
    if ((++_sp & 255u) == 0u) { if (xb_ld(&(bar)[XB_TMO])) break; if (_sp > XB_SPIN_CAP) { atomicAdd(&(bar)[XB_TMO], 1u); break; } } } } while (0)

struct XcdBarrier {
    unsigned* bar; unsigned x;
    volatile LAS unsigned* st;
};

__device__ __forceinline__ XcdBarrier xcd_barrier_post(unsigned* bar, volatile LAS unsigned* st) {
    XcdBarrier b; b.bar = bar; b.x = xb_xcc_id(); b.st = st;
    if (threadIdx.x == 0) (void)xb_add(&bar[XB_XCNT(b.x)], 1u);
    return b;
}
__device__ __forceinline__ void xcd_barrier_complete(unsigned* bar, unsigned x, unsigned& nloc, unsigned& nx) {
    const unsigned G = gridDim.x * gridDim.y * gridDim.z;
    unsigned sum, cnt, mine, sp = 0u;
    for (;;) {
        sum = 0u; cnt = 0u; mine = 0u;
#pragma unroll
        for (unsigned j = 0; j < 16; ++j) { const unsigned c = xb_ld(&bar[XB_XCNT(j)]); sum += c; cnt += (c > 0u) ? 1u : 0u; mine = (j == x) ? c : mine; }
        if (sum == G) break;
        __builtin_amdgcn_s_sleep(1);
        if ((++sp & 255u) == 0u) { if (xb_ld(&bar[XB_TMO])) break; if (sp > XB_SPIN_CAP) { atomicAdd(&bar[XB_TMO], 1u); break; } }
    }
    nloc = mine > 0u ? mine : 1u; nx = cnt > 0u ? cnt : 1u;
}

__device__ __forceinline__ void xcd_barrier(const XcdBarrier& b) {
    asm volatile("s_waitcnt vmcnt(0)" ::: "memory");
    __syncthreads();
    if (threadIdx.x == 0) {
        unsigned* bar = b.bar;
        __builtin_amdgcn_s_waitcnt(0);
        unsigned nloc = b.st[0], nx = b.st[1];
        if (nloc == 0u) { xcd_barrier_complete(bar, b.x, nloc, nx); b.st[0] = nloc; b.st[1] = nx; }
        const unsigned old = xb_add(&bar[XB_XSUB(b.x)], 1u);
        const unsigned gen = old / nloc;
        if (old + 1u == (gen + 1u) * nloc) {
            __builtin_amdgcn_fence(__ATOMIC_RELEASE, "agent");
            asm volatile("s_waitcnt vmcnt(0)" ::: "memory");
            const unsigned og = xb_add(&bar[XB_TOP], 1u);
            const unsigned tg = og / nx;
            if (og + 1u == (tg + 1u) * nx) xb_add(&bar[XB_TOPGEN], 1u);
            else XB_SPIN(xb_ld(&bar[XB_TOPGEN]) == tg, bar);
            __builtin_amdgcn_fence(__ATOMIC_ACQUIRE, "agent");
            xb_add(&bar[XB_XGEN(b.x)], 1u);
            asm volatile("s_waitcnt vmcnt(0)" ::: "memory");
        } else {
            XB_SPIN(xb_ld(&bar[XB_XGEN(b.x)]) == gen, bar);
            __builtin_amdgcn_fence(__ATOMIC_ACQUIRE, "agent");
            asm volatile("s_waitcnt vmcnt(0)" ::: "memory");
        }
    }
    __syncthreads();
}

typedef __bf16 bf16x2v __attribute__((ext_vector_type(2)));
typedef float f32x16 __attribute__((ext_vector_type(16)));
__device__ __forceinline__ float bflo(unsigned w) { return __uint_as_float(w << 16); }
__device__ __forceinline__ float bfhi(unsigned w) { return __uint_as_float(w & 0xffff0000u); }
__device__ __forceinline__ float dot2bf(unsigned a, unsigned b, float c) { return __builtin_amdgcn_fdot2_f32_bf16(__builtin_bit_cast(bf16x2v, a), __builtin_bit_cast(bf16x2v, b), c, false); }
__device__ __forceinline__ float wave_sum(float v) {
#pragma unroll
    for (int o = 1; o < 64; o <<= 1) v += __shfl_xor(v, o);
    return v; }
__device__ __forceinline__ float wave_max(float v) {
#pragma unroll
    for (int o = 1; o < 64; o <<= 1) v = fmaxf(v, __shfl_xor(v, o));
    return v; }
__device__ __forceinline__ float rdlane(float v, int l) { return __int_as_float(__builtin_amdgcn_readlane(__float_as_int(v), l)); }
__device__ __forceinline__ float gelu_tanh(float x) { const float z = 0.7978845608028654f * (x + 0.044715f * x * x * x); const float e = __expf(2.0f * z); const float th = 1.0f - 2.0f * __builtin_amdgcn_rcpf(1.0f + e); return 0.5f * x * (1.0f + th); }

struct Ctx { LAS unsigned char* lds; int tid, lane, wave, vcu, G; };

__device__ __forceinline__ void p0_transpose_item(const float* W, int K, int N, bf16* WT, const float* gk, LAS float* scr, int item, int lane) {
    const int nblk = N / 32, kb = item / nblk, nb = item % nblk, k0 = 64 * kb, n0 = 32 * nb;
#pragma unroll 8
    for (int i = 0; i < 32; ++i) { const int kk = 2 * i + (lane >> 5); float v = W[(size_t)(k0 + kk) * N + n0 + (lane & 31)]; if (gk) v *= gk[k0 + kk]; scr[kk * 33 + (lane & 31)] = v; }
    LDS_WAIT(); asm volatile("" ::: "memory");
    const int c = lane & 7;
#pragma unroll
    for (int j = 0; j < 4; ++j) { const int n = (lane >> 3) + 8 * j; const LAS float* s = scr + (8 * c) * 33 + n;
        v4u o; o.x = pk2(s[0 * 33], s[1 * 33]); o.y = pk2(s[2 * 33], s[3 * 33]); o.z = pk2(s[4 * 33], s[5 * 33]); o.w = pk2(s[6 * 33], s[7 * 33]);
        *(GAS v4u*)(WT + (size_t)(n0 + n) * K + k0 + 8 * c) = o; }
    LDS_WAIT(); asm volatile("" ::: "memory");
}
__device__ __forceinline__ void p0_prologue(const Ctx& F, const float* const* in, unsigned char* ws, const double* invf) {
    const float* x = in[0]; const int* pos = (const int*)in[1]; const float* g1 = in[2]; const float* w_in = in[3];
    const float* w_bc = in[6]; const float* w_ba = in[7]; const float* w_out = in[8]; const float* g2 = in[9]; const float* w_pq = in[10];
    const float* keys = in[11]; const float* pu = in[12]; const float* pv = in[13];
    LAS float* scr = (LAS float*)(F.lds + RING_OFF + F.wave * 16384);
    const int gw = F.vcu * NWAVES + F.wave, NGW = F.G * NWAVES;
    const int gt = gw * 64 + F.lane, NT = NGW * 64;
    for (int i = gt; i < 8192; i += NT) ((GAS unsigned long long*)(ws + WS_SS))[i] = 0ull;
    for (int i = gt; i < 32 * 1024; i += NT) ((GAS float*)(ws + WS_KSUM))[i] = 0.f;
    constexpr int I_IN = 32 * 320, I_BC = 16 * 64, I_OUT = 32 * 64;
    constexpr int NITEMS = I_IN + 2 * I_BC + 2 * I_OUT;
    for (int it = gw; it < NITEMS; it += NGW) {
        int r = it;
        if (r < I_IN) { p0_transpose_item(w_in, 2048, INW, (bf16*)(ws + WS_WIN), g1, scr, r, F.lane); continue; } r -= I_IN;
        if (r < I_BC) { p0_transpose_item(w_bc, 1024, 2048, (bf16*)(ws + WS_WBC), nullptr, scr, r, F.lane); continue; } r -= I_BC;
        if (r < I_BC) { p0_transpose_item(w_ba, 1024, 2048, (bf16*)(ws + WS_WBA), nullptr, scr, r, F.lane); continue; } r -= I_BC;
        if (r < I_OUT) { p0_transpose_item(w_out, 2048, 2048, (bf16*)(ws + WS_WOUT), nullptr, scr, r, F.lane); continue; } r -= I_OUT;
        p0_transpose_item(w_pq, 2048, 2048, (bf16*)(ws + WS_WPQ), g2, scr, r, F.lane);
    }
    for (int i = gt; i < 16 * 128 * 128 / 8; i += NT) { const f32x4 a = ((const GAS f32x4*)keys)[2 * i], b = ((const GAS f32x4*)keys)[2 * i + 1];
        v4u o; o.x = pk2(a[0], a[1]); o.y = pk2(a[2], a[3]); o.z = pk2(b[0], b[1]); o.w = pk2(b[2], b[3]); ((GAS v4u*)(ws + WS_KEYS))[i] = o; }
    for (int i = gt; i < NEXP * 2048 / 8; i += NT) { const int c8 = (i & 255) * 8;
        f32x4 a = ((const GAS f32x4*)pu)[2 * i], b = ((const GAS f32x4*)pu)[2 * i + 1]; a = a * *(const GAS f32x4*)(g2 + c8); b = b * *(const GAS f32x4*)(g2 + c8 + 4);
        v4u o; o.x = pk2(a[0], a[1]); o.y = pk2(a[2], a[3]); o.z = pk2(b[0], b[1]); o.w = pk2(b[2], b[3]); ((GAS v4u*)(ws + WS_UB))[i] = o;
        a = ((const GAS f32x4*)pv)[2 * i]; b = ((const GAS f32x4*)pv)[2 * i + 1];
        o.x = pk2(a[0], a[1]); o.y = pk2(a[2], a[3]); o.z = pk2(b[0], b[1]); o.w = pk2(b[2], b[3]); ((GAS v4u*)(ws + WS_VB))[i] = o; }
    for (int m = gw; m < M; m += NGW) { const GAS f32x4* xr = (const GAS f32x4*)(x + (size_t)m * DM);
        f32x4 v[8]; float s = 0.f;
#pragma unroll
        for (int i = 0; i < 4; ++i) { v[2 * i] = xr[i * 128 + 2 * F.lane]; v[2 * i + 1] = xr[i * 128 + 2 * F.lane + 1]; }
#pragma unroll
        for (int i = 0; i < 8; ++i) s += (v[i][0] * v[i][0] + v[i][1] * v[i][1]) + (v[i][2] * v[i][2] + v[i][3] * v[i][3]);
        const float rinv = 1.0f / sqrtf(wave_sum(s) * (1.0f / DM) + RMS_EPS);
        GAS v4u* o = (GAS v4u*)(ws + WS_XB + (size_t)m * DM * 2);
#pragma unroll
        for (int i = 0; i < 4; ++i) { const f32x4 a = v[2 * i] * rinv, b = v[2 * i + 1] * rinv; v4u w; w.x = pk2(a[0], a[1]); w.y = pk2(a[2], a[3]); w.z = pk2(b[0], b[1]); w.w = pk2(b[2], b[3]); o[i * 64 + F.lane] = w; } }
    for (int i = gt; i < M * 16; i += NT) { const int row = i >> 4, f = i & 15; const double ang = (double)pos[row] * invf[f];
        const double k = __builtin_rint(ang * 0.15915494309189535); const float r = (float)(ang - k * 6.283185307179586);
        float* cs = (float*)(ws + WS_CS); cs[row * 32 + f] = __cosf(r); cs[row * 32 + 16 + f] = __sinf(r); }
}

__device__ __forceinline__ void attn_simple(const Ctx& F, const bf16* Q, const bf16* K, const bf16* V, const float* ksum, bf16* AO) {
    LAS float* qf = (LAS float*)(F.lds + RING_OFF + F.wave * 512);
    const int gw = F.vcu * NWAVES + F.wave, NGW = F.G * NWAVES, lane = F.lane;
    for (int item = gw; item < 16 * SEQ; item += NGW) {
        const int bh = item >> 12, t = item & 4095, b = bh >> 3, h = bh & 7, blk = t >> 8;
        const size_t row = (size_t)b * SEQ + t;
        { const unsigned qq = *(const GAS unsigned*)(Q + row * 1024 + h * 128 + 2 * lane); qf[2 * lane] = bflo(qq); qf[2 * lane + 1] = bfhi(qq); }
        LDS_WAIT(); asm volatile("" ::: "memory");
        float g = -INFINITY;
        if (lane < blk) { const GAS f32x4* km = (const GAS f32x4*)(ksum + (size_t)(b * 16 + lane) * 1024 + h * 128); float a = 0.f;
            for (int d = 0; d < 32; ++d) { const f32x4 kv = km[d]; const f32x4 qv = *(const LAS f32x4*)(qf + 4 * d); a += (kv[0] * qv[0] + kv[1] * qv[1]) + (kv[2] * qv[2] + kv[3] * qv[3]); }
            g = a; }
        int sel[3];
#pragma unroll
        for (int i = 0; i < 3; ++i) { const float mx = wave_max(g); const unsigned long long bal = __ballot(g == mx && lane < blk); const int idx = bal ? (__ffsll((long long)bal) - 1) : 0; sel[i] = idx; if (lane == idx) g = -INFINITY; }
        const int nsel = blk < 3 ? blk : 3;
        float sc[4][4]; float mx = -INFINITY;
#pragma unroll
        for (int slot = 0; slot < 4; ++slot) {
            const bool valid = (slot == 3) || (slot < nsel);
            const int kb = (slot == 3) ? blk : sel[slot < 3 ? slot : 0];
#pragma unroll
            for (int r = 0; r < 4; ++r) {
                float s = -INFINITY; const int key0 = kb * 256 + r * 64;
                if (valid && (slot < 3 || key0 <= t)) {
                    const int key = key0 + lane; const GAS v4u* kp = (const GAS v4u*)(K + ((size_t)b * SEQ + key) * 1024 + h * 128); float a = 0.f;
#pragma unroll 4
                    for (int d = 0; d < 16; ++d) { const v4u kk = kp[d]; const f32x4 q0 = *(const LAS f32x4*)(qf + 8 * d), q1 = *(const LAS f32x4*)(qf + 8 * d + 4);
                        a += (bflo(kk.x) * q0[0] + bfhi(kk.x) * q0[1]) + (bflo(kk.y) * q0[2] + bfhi(kk.y) * q0[3]) + (bflo(kk.z) * q1[0] + bfhi(kk.z) * q1[1]) + (bflo(kk.w) * q1[2] + bfhi(kk.w) * q1[3]); }
                    s = (slot < 3 || key <= t) ? a : -INFINITY; }
                sc[slot][r] = s; mx = fmaxf(mx, s); } }
        mx = wave_max(mx);
        float sum = 0.f;
#pragma unroll
        for (int slot = 0; slot < 4; ++slot)
#pragma unroll
            for (int r = 0; r < 4; ++r) { sc[slot][r] = exp2f(sc[slot][r] - mx); sum += sc[slot][r]; }
        sum = wave_sum(sum);
        float o0 = 0.f, o1 = 0.f;
#pragma unroll
        for (int slot = 0; slot < 4; ++slot) {
            const bool valid = (slot == 3) || (slot < nsel);
            const int kb = (slot == 3) ? blk : sel[slot < 3 ? slot : 0];
#pragma unroll
            for (int r = 0; r < 4; ++r) { const int key0 = kb * 256 + r * 64;
                if (valid && (slot < 3 || key0 <= t)) { const float pr = sc[slot][r]; const GAS unsigned* vp = (const GAS unsigned*)(V + ((size_t)b * SEQ + key0) * 1024 + h * 128) + lane;
                    for (int kk = 0; kk < 64; ++kk) { const float pk = rdlane(pr, kk); const unsigned vv = vp[(size_t)kk * 512]; o0 += pk * bflo(vv); o1 += pk * bfhi(vv); } } } }
        const float ri = 1.0f / sum;
        *(GAS unsigned*)(AO + row * 1024 + h * 128 + 2 * lane) = pk2(o0 * ri, o1 * ri);
    }
}
typedef short v4i16_t __attribute__((ext_vector_type(4))); typedef unsigned u32x2v __attribute__((ext_vector_type(2)));
__device__ __forceinline__ v4i16_t vtr16(unsigned addr) { return __builtin_amdgcn_ds_read_tr16_b64_v4i16((LAS v4i16_t*)(uintptr_t)addr); }
__device__ __forceinline__ int crow16(int r, int hh) { return (r & 3) + 8 * (r >> 2) + 4 * hh; }
__device__ __forceinline__ void attn_dma_step(const bf16* K, const bf16* V, LAS unsigned char* lds, int b, int h, int qb, int n_own, int st, int wave, int lane) {
    const int buf = st & 1;
#pragma unroll
    for (int img = 0; img < 4; ++img) {
        const int T = 2 * st + (img >> 1); const bool isV = img & 1;
        const int blk = (T < n_own) ? qb : ((T - n_own) >> 2), kt = (T < n_own) ? T : ((T - n_own) & 3);
        const bf16* base = (isV ? V : K) + ((size_t)b * SEQ + 256 * blk + 64 * kt) * 1024 + h * 128;
#pragma unroll
        for (int i = 0; i < 2; ++i) { const int pc = wave + 8 * i, row = 4 * pc + (lane >> 4), cp = lane & 15;
            const int c = isV ? ((((cp >> 2) ^ (row & 3)) << 2) | (cp & 3)) : (cp ^ (row & 15));
            __builtin_amdgcn_global_load_lds((const unsigned*)(base + (size_t)row * 1024 + 8 * c), (LAS unsigned*)(lds + buf * 65536 + img * 16384 + pc * 1024), 16, 0, 0); }
    }
}
__device__ __forceinline__ void attn_mfma(const Ctx& F, const bf16* Q, const bf16* K, const bf16* V, const float* ksum, bf16* AO) {
    const int lane = F.lane, wave = F.wave, q31 = lane & 31, hh = lane >> 5, wq = wave & 3, kvh = wave >> 2, l16 = lane & 15, G4 = lane >> 4;
    LAS unsigned char* lds = F.lds + RING_OFF;
    const unsigned lds0 = (unsigned)(uintptr_t)lds;
    for (int pr = F.vcu; pr < 256; pr += F.G)
#pragma unroll 1
    for (int pi = 0; pi < 2; ++pi) {
        const int bh = pr >> 4, s_ = pr & 15, u128 = pi ? 31 - s_ : s_, b = bh >> 3, h = bh & 7, qb = u128 >> 1, half = u128 & 1;
        const int n_own = half ? 4 : 2, nstep = (n_own + 4 * qb) >> 1;
        const size_t rowq = (size_t)b * SEQ + 256 * qb + 128 * half + 32 * wq + q31;
        asm volatile("s_waitcnt vmcnt(0) lgkmcnt(0)" ::: "memory"); __builtin_amdgcn_s_barrier(); asm volatile("" ::: "memory");
        attn_dma_step(K, V, lds, b, h, qb, n_own, 0, wave, lane);
        bf16x8 qf[8];
#pragma unroll
        for (int s = 0; s < 8; ++s) qf[s] = *(const GAS bf16x8*)(Q + rowq * 1024 + h * 128 + 16 * s + 8 * hh);
        unsigned selmask;
        {
            float qv[64];
#pragma unroll
            for (int s = 0; s < 8; ++s)
#pragma unroll
                for (int e = 0; e < 8; ++e) qv[8 * s + e] = __uint_as_float((unsigned)(unsigned short)qf[s][e] << 16);
            float v0 = -INFINITY, v1 = -INFINITY, v2 = -INFINITY; int i0 = 0, i1 = 0, i2 = 0;
#pragma unroll 1
            for (int j = 0; j < qb; ++j) {
                const GAS f32x4* kp = (const GAS f32x4*)(ksum + (size_t)(b * 16 + j) * 1024 + h * 128 + 8 * hh); float a = 0.f;
#pragma unroll
                for (int s = 0; s < 8; ++s) { const f32x4 k0 = kp[4 * s], k1 = kp[4 * s + 1];
                    a += (qv[8 * s] * k0[0] + qv[8 * s + 1] * k0[1]) + (qv[8 * s + 2] * k0[2] + qv[8 * s + 3] * k0[3]) + (qv[8 * s + 4] * k1[0] + qv[8 * s + 5] * k1[1]) + (qv[8 * s + 6] * k1[2] + qv[8 * s + 7] * k1[3]); }
                a += __shfl_xor(a, 32);
                if (a > v0) { v2 = v1; i2 = i1; v1 = v0; i1 = i0; v0 = a; i0 = j; } else if (a > v1) { v2 = v1; i2 = i1; v1 = a; i1 = j; } else if (a > v2) { v2 = a; i2 = j; }
            }
            selmask = (qb <= 3) ? ((1u << qb) - 1u) : ((1u << i0) | (1u << i1) | (1u << i2));
        }
        float m_run = -1e30f, l_run = 0.f; f32x16 o[4];
#pragma unroll
        for (int db = 0; db < 4; ++db)
#pragma unroll
            for (int r = 0; r < 16; ++r) o[db][r] = 0.f;
        const int qin = 128 * half + 32 * wq + q31;
#pragma unroll 1
        for (int st = 0; st < nstep; ++st) {
            asm volatile("s_waitcnt vmcnt(0)" ::: "memory"); __builtin_amdgcn_s_barrier(); asm volatile("" ::: "memory");
            if (st + 1 < nstep) attn_dma_step(K, V, lds, b, h, qb, n_own, st + 1, wave, lane);
            const int T = 2 * st + kvh; const bool own = T < n_own;
            const int blk = own ? qb : ((T - n_own) >> 2), kt = own ? T : ((T - n_own) & 3);
            const bool sel = own ? true : ((selmask >> blk) & 1u);
            const bool skip = own ? (64 * kt > 128 * half + 32 * wq + 31) : (__ballot(sel) == 0ull);
            if (!skip) {
                const unsigned kimg = lds0 + (st & 1) * 65536 + kvh * 32768, vimg = kimg + 16384;
                f32x16 p[2];
#pragma unroll
                for (int kh = 0; kh < 2; ++kh) {
#pragma unroll
                    for (int r = 0; r < 16; ++r) p[kh][r] = 0.f;
                    const int row = 32 * kh + q31;
#pragma unroll
                    for (int s = 0; s < 8; ++s) { const bf16x8 a = *(const LAS bf16x8*)(uintptr_t)(kimg + row * 256 + (((2 * s + hh) ^ (row & 15)) << 4));
                        p[kh] = __builtin_amdgcn_mfma_f32_32x32x16_bf16(a, qf[s], p[kh], 0, 0, 0); }
                }
                if (own) { const int kbase = 64 * kt;
                    if (kbase + 63 > 128 * half + 32 * wq) {
#pragma unroll
                        for (int kh = 0; kh < 2; ++kh)
#pragma unroll
                            for (int r = 0; r < 16; ++r) if (kbase + 32 * kh + crow16(r, hh) > qin) p[kh][r] = -INFINITY; }
                } else if (!sel) {
#pragma unroll
                    for (int kh = 0; kh < 2; ++kh)
#pragma unroll
                        for (int r = 0; r < 16; ++r) p[kh][r] = -INFINITY; }
                float mx = p[0][0];
#pragma unroll
                for (int r = 1; r < 16; ++r) mx = fmaxf(mx, p[0][r]);
#pragma unroll
                for (int r = 0; r < 16; ++r) mx = fmaxf(mx, p[1][r]);
                mx = fmaxf(mx, __shfl_xor(mx, 32));
                const float m_new = fmaxf(m_run, mx), scl = exp2f(m_run - m_new); m_run = m_new;
                float rs = 0.f;
#pragma unroll
                for (int kh = 0; kh < 2; ++kh)
#pragma unroll
                    for (int r = 0; r < 16; ++r) { p[kh][r] = exp2f(p[kh][r] - m_new); rs += p[kh][r]; }
                l_run = l_run * scl + rs;
#pragma unroll
                for (int db = 0; db < 4; ++db)
#pragma unroll
                    for (int r = 0; r < 16; ++r) o[db][r] *= scl;
#pragma unroll
                for (int kh = 0; kh < 2; ++kh)
#pragma unroll
                    for (int s2 = 0; s2 < 2; ++s2) {
                        v4u pw; pw.x = pg8::cvt_pk_bf16(p[kh][8 * s2], p[kh][8 * s2 + 1]); pw.y = pg8::cvt_pk_bf16(p[kh][8 * s2 + 2], p[kh][8 * s2 + 3]);
                        pw.z = pg8::cvt_pk_bf16(p[kh][8 * s2 + 4], p[kh][8 * s2 + 5]); pw.w = pg8::cvt_pk_bf16(p[kh][8 * s2 + 6], p[kh][8 * s2 + 7]);
                        const bf16x8 pb = __builtin_bit_cast(bf16x8, pw);
                        const int key0 = 32 * kh + 16 * s2 + 4 * (G4 >> 1) + (l16 >> 2);
#pragma unroll
                        for (int db = 0; db < 4; ++db) {
                            const int dsub = 16 * (G4 & 1) + 4 * (l16 & 3);
                            const unsigned a0 = vimg + key0 * 256 + ((db ^ (key0 & 3)) << 6) + dsub * 2;
                            const v4i16_t lo = vtr16(a0), hi_ = vtr16(a0 + 8 * 256);
                            const bf16x8 av = {lo[0], lo[1], lo[2], lo[3], hi_[0], hi_[1], hi_[2], hi_[3]};
                            o[db] = __builtin_amdgcn_mfma_f32_32x32x16_bf16(av, pb, o[db], 0, 0, 0);
                        }
                    }
            }
        }
        l_run += __shfl_xor(l_run, 32);
        asm volatile("s_waitcnt vmcnt(0) lgkmcnt(0)" ::: "memory"); __builtin_amdgcn_s_barrier(); asm volatile("" ::: "memory");
        LAS float* xs = (LAS float*)lds + (size_t)wq * 66 * 64 + lane;
        if (kvh == 1) {
            xs[0] = m_run; xs[64] = l_run;
#pragma unroll
            for (int db = 0; db < 4; ++db)
#pragma unroll
                for (int r = 0; r < 16; ++r) xs[(2 + 16 * db + r) * 64] = o[db][r];
        }
        asm volatile("s_waitcnt lgkmcnt(0)" ::: "memory"); __builtin_amdgcn_s_barrier(); asm volatile("" ::: "memory");
        if (kvh == 0) {
            const float m2 = xs[0], l2 = xs[64], mt = fmaxf(m_run, m2), a1 = exp2f(m_run - mt), a2 = exp2f(m2 - mt);
            const float inv = 1.0f / (l_run * a1 + l2 * a2), c1 = a1 * inv, c2 = a2 * inv;
            bf16* orow = AO + rowq * 1024 + h * 128 + 4 * hh;
#pragma unroll
            for (int db = 0; db < 4; ++db)
#pragma unroll
                for (int g = 0; g < 4; ++g) {
                    float t[4];
#pragma unroll
                    for (int e = 0; e < 4; ++e) t[e] = o[db][4 * g + e] * c1 + xs[(2 + 16 * db + 4 * g + e) * 64] * c2;
                    u32x2v w; w.x = pg8::cvt_pk_bf16(t[0], t[1]); w.y = pg8::cvt_pk_bf16(t[2], t[3]);
                    *(GAS u32x2v*)(orow + 32 * db + 8 * g) = w;
                }
        }
    }
    asm volatile("s_waitcnt vmcnt(0) lgkmcnt(0)" ::: "memory"); __builtin_amdgcn_s_barrier(); asm volatile("" ::: "memory");
}
__device__ __forceinline__ void up8(const v4u w, float (&f)[8]) { f[0] = bflo(w.x); f[1] = bfhi(w.x); f[2] = bflo(w.y); f[3] = bfhi(w.y); f[4] = bflo(w.z); f[5] = bfhi(w.z); f[6] = bflo(w.w); f[7] = bfhi(w.w); }
__device__ __forceinline__ void conv_phase(const Ctx& F, const bf16* CB, const bf16* CC, const bf16* CX, const float* cw, bf16* UC) {
    const int gt = (F.vcu * NWAVES + F.wave) * 64 + F.lane, NT = F.G * NWAVES * 64;
    for (int idx = gt; idx < M * 128; idx += NT) {
        const int row = idx >> 7, c8 = (idx & 127) << 3, t = row & (SEQ - 1); const size_t off = (size_t)row * 1024 + c8;
        float cb[8], a[8], x[8], z0[8], z1[8], z2[8];
        up8(*(const GAS v4u*)(CB + off), cb); up8(*(const GAS v4u*)(CC + off), a); up8(*(const GAS v4u*)(CX + off), x);
#pragma unroll
        for (int j = 0; j < 8; ++j) z0[j] = a[j] * x[j];
        if (t >= 1) { up8(*(const GAS v4u*)(CC + off - 1024), a); up8(*(const GAS v4u*)(CX + off - 1024), x);
#pragma unroll
            for (int j = 0; j < 8; ++j) z1[j] = a[j] * x[j]; } else {
#pragma unroll
            for (int j = 0; j < 8; ++j) z1[j] = 0.f; }
        if (t >= 2) { up8(*(const GAS v4u*)(CC + off - 2048), a); up8(*(const GAS v4u*)(CX + off - 2048), x);
#pragma unroll
            for (int j = 0; j < 8; ++j) z2[j] = a[j] * x[j]; } else {
#pragma unroll
            for (int j = 0; j < 8; ++j) z2[j] = 0.f; }
        float o[8];
#pragma unroll
        for (int j = 0; j < 8; ++j) o[j] = cb[j] * (cw[c8 + j] * z2[j] + cw[1024 + c8 + j] * z1[j] + cw[2048 + c8 + j] * z0[j]);
        v4u w; w.x = pk2(o[0], o[1]); w.y = pk2(o[2], o[3]); w.z = pk2(o[4], o[5]); w.w = pk2(o[6], o[7]); *(GAS v4u*)(UC + off) = w;
    }
}

__device__ const unsigned char CAND50[64] = {
    0x00,0x01,0x02,0x03,0x04,0x05,0x06,0x07,0x08,0x09,0x0a,0x0b,0x0c,0x0d,0x0e,0x0f,
    0x10,0x11,0x12,0x13,0x14,0x15,0x16,0x17, 0x20,0x21,0x22,0x23,0x24, 0x30,0x31,0x32,0x33, 0x40,0x41,0x42, 0x50,0x51, 0x60,0x61, 0x70,0x71,
    0x80,0x90,0xa0,0xb0,0xc0,0xd0,0xe0,0xf0, 0xff,0xff,0xff,0xff,0xff,0xff,0xff,0xff,0xff,0xff,0xff,0xff,0xff,0xff};
__device__ __forceinline__ int ord_key(float f) { const int u = __float_as_int(f); return u >= 0 ? u : (u ^ 0x7fffffff); }
__device__ __forceinline__ float ord_val(int k) { return __int_as_float(k >= 0 ? k : (k ^ 0x7fffffff)); }
template <int CTRL> __device__ __forceinline__ int dpp_i(int v) { return __builtin_amdgcn_update_dpp(v, v, CTRL, 0xf, 0xf, false); }
__device__ __forceinline__ int imax(int a, int b) { return a > b ? a : b; }
__device__ __forceinline__ int hmax32(int v) {
    v = imax(v, dpp_i<0xB1>(v)); v = imax(v, dpp_i<0x4E>(v)); v = imax(v, dpp_i<0x141>(v)); v = imax(v, dpp_i<0x140>(v));
    const auto r = __builtin_amdgcn_permlane16_swap((unsigned)v, (unsigned)v, false, false); return imax((int)r[0], (int)r[1]); }
__device__ __forceinline__ float hsum32(float v) {
    v += __int_as_float(dpp_i<0xB1>(__float_as_int(v))); v += __int_as_float(dpp_i<0x4E>(__float_as_int(v))); v += __int_as_float(dpp_i<0x141>(__float_as_int(v))); v += __int_as_float(dpp_i<0x140>(__float_as_int(v)));
    const auto r = __builtin_amdgcn_permlane16_swap(__float_as_uint(v), __float_as_uint(v), false, false); return __uint_as_float(r[0]) + __uint_as_float(r[1]); }
__device__ __forceinline__ void topk_phase(const Ctx& F, const bf16* QP, const bf16* KEYS, int* EXP, float* GATE) {
    const int gw = F.vcu * NWAVES + F.wave, NGW = F.G * NWAVES, lane = F.lane, l31 = lane & 31, hi = lane >> 5;
    const int IMIN = (int)0x80000000;
    for (int item = gw; item < 256 * 8; item += NGW) {
        const int tt = item >> 3, h = item & 7, tok0 = tt * 32;
        int tops[2][16];
#pragma unroll
        for (int p = 0; p < 2; ++p) {
            f32x16 sc[4];
#pragma unroll
            for (int nt = 0; nt < 4; ++nt)
#pragma unroll
                for (int r = 0; r < 16; ++r) sc[nt][r] = 0.f;
#pragma unroll
            for (int s = 0; s < 8; ++s) {
                const bf16x8 a = *(const GAS bf16x8*)(QP + (size_t)(tok0 + l31) * 2048 + h * 256 + p * 128 + 16 * s + 8 * hi);
#pragma unroll
                for (int nt = 0; nt < 4; ++nt) { const bf16x8 bb = *(const GAS bf16x8*)(KEYS + (size_t)((h * 2 + p) * 128 + 32 * nt + l31) * 128 + 16 * s + 8 * hi);
                    sc[nt] = __builtin_amdgcn_mfma_f32_32x32x16_bf16(a, bb, sc[nt], 0, 0, 0); }
            }
            int kk[4][16];
#pragma unroll
            for (int nt = 0; nt < 4; ++nt)
#pragma unroll
                for (int r = 0; r < 16; ++r) kk[nt][r] = (ord_key(sc[nt][r]) & ~127) | (127 - 32 * nt - l31);
#pragma unroll
            for (int r = 0; r < 16; ++r) tops[p][r] = IMIN;
#pragma unroll 1
            for (int i = 0; i < 16; ++i) {
#pragma unroll
                for (int r = 0; r < 16; ++r) {
                    const int m = hmax32(imax(imax(kk[0][r], kk[1][r]), imax(kk[2][r], kk[3][r])));
                    if (l31 == i) tops[p][r] = m;
#pragma unroll
                    for (int nt = 0; nt < 4; ++nt) kk[nt][r] = (kk[nt][r] == m) ? IMIN : kk[nt][r];
                }
            }
        }
        const int cd0 = CAND50[l31], cd1 = CAND50[32 + l31], base = 32 * hi;
        int c0[16], c1[16], best[16];
#pragma unroll
        for (int r = 0; r < 16; ++r) {
            const int ta = tops[0][r], tb = tops[1][r];
            const int a0 = __shfl(ta, base + (cd0 >> 4)), b0 = __shfl(tb, base + (cd0 & 15)), a1 = __shfl(ta, base + ((cd1 >> 4) & 15)), b1 = __shfl(tb, base + (cd1 & 15));
            const float s0 = ord_val(a0 & ~127) + ord_val(b0 & ~127), s1 = ord_val(a1 & ~127) + ord_val(b1 & ~127);
            c0[r] = (ord_key(s0) & ~255) | (255 - cd0); c1[r] = (cd1 == 0xff) ? IMIN : ((ord_key(s1) & ~255) | (255 - cd1)); best[r] = IMIN;
        }
#pragma unroll 1
        for (int i = 0; i < 16; ++i) {
#pragma unroll
            for (int r = 0; r < 16; ++r) { const int m = hmax32(imax(c0[r], c1[r])); if (l31 == i) best[r] = m; c0[r] = (c0[r] == m) ? IMIN : c0[r]; c1[r] = (c1[r] == m) ? IMIN : c1[r]; }
        }
#pragma unroll
        for (int r = 0; r < 16; ++r) {
            const int posn = 255 - (best[r] & 255), bi = (posn >> 4) & 15, bj = posn & 15;
            const int n1 = 127 - (__shfl(tops[0][r], base + bi) & 127), n2 = 127 - (__shfl(tops[1][r], base + bj) & 127);
            const float sv = ord_val(best[r] & ~255), smax = ord_val(hmax32(best[r]) & ~255);
            const float e = (l31 < 16) ? __expf(sv - smax) : 0.f; const float es = hsum32(e);
            const int token = tok0 + (r & 3) + 8 * (r >> 2) + 4 * hi;
            if (l31 < 16) { EXP[(size_t)token * 128 + h * 16 + l31] = n1 * 128 + n2; GATE[(size_t)token * 128 + h * 16 + l31] = e / es; }
        }
    }
}

template <int D> __device__ __forceinline__ void tr_step(float (&part)[64], int lane) {
    const bool up_ = (lane & D) != 0;
#pragma unroll
    for (int i = 0; i < D; ++i) { const float a = part[i], b = part[i + D]; const float send = up_ ? a : b, keep = up_ ? b : a; part[i] = keep + __shfl_xor(send, D); }
}
__device__ __forceinline__ void peer_phase(const Ctx& F, const bf16* UB, const bf16* VB, const bf16* X1B, const int* EXP, const float* GATE, const unsigned long long* SS, const float* gfin, const float* X1, float* OUT) {
    const int gw = F.vcu * NWAVES + F.wave, NGW = F.G * NWAVES, lane = F.lane;
    constexpr int NPF = 4;
    for (int t = gw; t < M; t += NGW) {
        const int e01[2] = { EXP[(size_t)t * 128 + lane], EXP[(size_t)t * 128 + 64 + lane] };
        const float g01[2] = { GATE[(size_t)t * 128 + lane], GATE[(size_t)t * 128 + 64 + lane] };
        const float rinv2 = pg8::rinv_from_ss(SS[t]);
        v4u xq[4];
#pragma unroll
        for (int i = 0; i < 4; ++i) xq[i] = *(const GAS v4u*)(X1B + (size_t)t * DM + i * 512 + lane * 8);
        float act[2];
#pragma unroll
        for (int hf = 0; hf < 2; ++hf) {
            const int ev = e01[hf];
            float part[64]; v4u ub[NPF][4];
#pragma unroll
            for (int k = 0; k < NPF; ++k) { const GAS v4u* up = (const GAS v4u*)(UB + (size_t)__builtin_amdgcn_readlane(ev, k) * DM) + lane;
#pragma unroll
                for (int i = 0; i < 4; ++i) ub[k][i] = up[i * 64]; }
#pragma unroll
            for (int k = 0; k < 64; ++k) {
                float p0 = 0.f, p1 = 0.f;
#pragma unroll
                for (int i = 0; i < 4; ++i) { const v4u w = ub[k % NPF][i]; p0 = dot2bf(w.x, xq[i].x, p0); p1 = dot2bf(w.y, xq[i].y, p1); p0 = dot2bf(w.z, xq[i].z, p0); p1 = dot2bf(w.w, xq[i].w, p1); }
                part[k] = p0 + p1;
                if (k + NPF < 64) { const GAS v4u* up = (const GAS v4u*)(UB + (size_t)__builtin_amdgcn_readlane(ev, k + NPF) * DM) + lane;
#pragma unroll
                    for (int i = 0; i < 4; ++i) ub[k % NPF][i] = up[i * 64]; }
            }
            tr_step<32>(part, lane); tr_step<16>(part, lane); tr_step<8>(part, lane); tr_step<4>(part, lane); tr_step<2>(part, lane); tr_step<1>(part, lane);
            act[hf] = gelu_tanh(part[0] * rinv2) * g01[hf];
        }
        float y[32];
#pragma unroll
        for (int j = 0; j < 32; ++j) y[j] = 0.f;
#pragma unroll
        for (int hf = 0; hf < 2; ++hf) {
            const int ev = e01[hf]; const float av = act[hf];
            v4u vb[NPF][4];
#pragma unroll
            for (int k = 0; k < NPF; ++k) { const GAS v4u* vp = (const GAS v4u*)(VB + (size_t)__builtin_amdgcn_readlane(ev, k) * DM) + lane;
#pragma unroll
                for (int i = 0; i < 4; ++i) vb[k][i] = vp[i * 64]; }
#pragma unroll
            for (int k = 0; k < 64; ++k) {
                const float s = rdlane(av, k);
#pragma unroll
                for (int i = 0; i < 4; ++i) { const v4u w = vb[k % NPF][i];
                    y[8 * i + 0] += s * bflo(w.x); y[8 * i + 1] += s * bfhi(w.x); y[8 * i + 2] += s * bflo(w.y); y[8 * i + 3] += s * bfhi(w.y);
                    y[8 * i + 4] += s * bflo(w.z); y[8 * i + 5] += s * bfhi(w.z); y[8 * i + 6] += s * bflo(w.w); y[8 * i + 7] += s * bfhi(w.w); }
                if (k + NPF < 64) { const GAS v4u* vp = (const GAS v4u*)(VB + (size_t)__builtin_amdgcn_readlane(ev, k + NPF) * DM) + lane;
#pragma unroll
                    for (int i = 0; i < 4; ++i) vb[k % NPF][i] = vp[i * 64]; }
            }
        }
        const GAS f32x4* xr = (const GAS f32x4*)(X1 + (size_t)t * DM); GAS f32x4* orw = (GAS f32x4*)(OUT + (size_t)t * DM); float ss = 0.f;
#pragma unroll
        for (int i = 0; i < 4; ++i) { const f32x4 a = xr[i * 128 + 2 * lane], b = xr[i * 128 + 2 * lane + 1];
            y[8 * i + 0] += a[0]; y[8 * i + 1] += a[1]; y[8 * i + 2] += a[2]; y[8 * i + 3] += a[3]; y[8 * i + 4] += b[0]; y[8 * i + 5] += b[1]; y[8 * i + 6] += b[2]; y[8 * i + 7] += b[3]; }
#pragma unroll
        for (int j = 0; j < 32; ++j) ss += y[j] * y[j];
        const float r3 = 1.0f / sqrtf(wave_sum(ss) * (1.0f / DM) + RMS_EPS);
#pragma unroll
        for (int i = 0; i < 4; ++i) { const f32x4 ga = *(const GAS f32x4*)(gfin + i * 512 + lane * 8), gb = *(const GAS f32x4*)(gfin + i * 512 + lane * 8 + 4);
            orw[i * 128 + 2 * lane] = (f32x4){y[8 * i + 0] * r3 * ga[0], y[8 * i + 1] * r3 * ga[1], y[8 * i + 2] * r3 * ga[2], y[8 * i + 3] * r3 * ga[3]};
            orw[i * 128 + 2 * lane + 1] = (f32x4){y[8 * i + 4] * r3 * gb[0], y[8 * i + 5] * r3 * gb[1], y[8 * i + 6] * r3 * gb[2], y[8 * i + 7] * r3 * gb[3]}; }
    }
}
struct Args { const float* in[15]; float* out; unsigned char* ws; double invf[16]; int ph_lo, ph_hi, li, pad; };
__global__ void __launch_bounds__(NWAVES * 64, 2) mk_fwd(Args args) {
    extern __shared__ __attribute__((aligned(16))) unsigned char lds[];
    Ctx F;
    F.lds = (LAS unsigned char*)lds;
    volatile LAS unsigned* MISC = (volatile LAS unsigned*)(F.lds + MISC_OFF);
    F.tid = threadIdx.x; F.lane = F.tid & 63; F.wave = __builtin_amdgcn_readfirstlane(F.tid >> 6);
    F.G = gridDim.x; { const int bx = blockIdx.x; F.vcu = (F.G % 8 == 0) ? (bx % 8) * (F.G / 8) + bx / 8 : bx; }
    unsigned char* ws = args.ws;
    gu32* ctl = (gu32*)(ws + WS_CTL);
    for (int u = F.tid; u < (LDS_BYTES - LDSCTL_OFF) / 4; u += NWAVES * 64) ((LAS unsigned*)(F.lds + LDSCTL_OFF))[u] = 0u;
    __syncthreads();
    XcdBarrier bar; bar.bar = (unsigned*)(ctl + CW_BAR); bar.x = 0; bar.st = nullptr;
    if (N_LAUNCHES != PER_PHASE) bar = xcd_barrier_post((unsigned*)(ctl + CW_BAR), MISC + 8);
#define GRID_BAR() do { if (N_LAUNCHES != PER_PHASE) xcd_barrier(bar); } while (0)
    const int lo = args.ph_lo, hi = args.ph_hi;
#define IN(k) (lo <= (k) && (k) < hi)
#define BOTH(k) (IN(k) && IN((k) + 1))
    bf16* WinT = (bf16*)(ws + WS_WIN); bf16* WbcT = (bf16*)(ws + WS_WBC); bf16* WbaT = (bf16*)(ws + WS_WBA); bf16* WoutT = (bf16*)(ws + WS_WOUT); bf16* WpqT = (bf16*)(ws + WS_WPQ);
    bf16* KEYS = (bf16*)(ws + WS_KEYS); float* CS = (float*)(ws + WS_CS); bf16* UB = (bf16*)(ws + WS_UB); bf16* VB = (bf16*)(ws + WS_VB);
    bf16* XB = (bf16*)(ws + WS_XB); bf16* T6 = (bf16*)(ws + WS_T6); bf16* GAB = (bf16*)(ws + WS_GAB); bf16* UC = (bf16*)(ws + WS_UC); bf16* AO = (bf16*)(ws + WS_AO);
    bf16* TMP = (bf16*)(ws + WS_TMP); bf16* MB = (bf16*)(ws + WS_MB); bf16* X1B = (bf16*)(ws + WS_X1B); bf16* QP = (bf16*)(ws + WS_QP);
    int* EXP = (int*)(ws + WS_EXP); float* GATE = (float*)(ws + WS_GATE);
    unsigned long long* SS = (unsigned long long*)(ws + WS_SS); float* KSUM = (float*)(ws + WS_KSUM);
    constexpr size_t TS = (size_t)M * 1024;

    if (IN(0)) { for (int rep = 0; rep < NREP(0); ++rep) { p0_prologue(F, args.in, ws, args.invf); if (rep + 1 < NREP(0)) GRID_BAR(); } if (BOTH(0)) GRID_BAR(); }
    if (IN(1)) {
        for (int rep = 0; rep < NREP(1); ++rep) {
        pg8::Gemm g{XB, WinT, M, INW, DM}; pg8::StaticOrder S; S.init(M, INW, F.G, (int)blockIdx.x);
        pg8::EpiIn E{T6, GAB, args.in[4], CS, KSUM};
        pg8::gemm_phase<pg8::EpiIn, pg8::StaticOrder, true, true>(F.lds + RING_OFF, g, S, E);
        if (rep + 1 < NREP(1)) GRID_BAR(); }
        if (BOTH(1)) GRID_BAR();
    }
    if (IN(2)) {
        for (int rep = 0; rep < NREP(2); ++rep) {
        attn_mfma(F, T6 + 3 * TS, T6 + 4 * TS, T6 + 5 * TS, KSUM, AO);
        conv_phase(F, T6, T6 + TS, T6 + 2 * TS, args.in[5], UC);
        if (rep + 1 < NREP(2)) GRID_BAR(); }
        if (BOTH(2)) GRID_BAR();
    }
    if (IN(3)) {
        for (int rep = 0; rep < NREP(3); ++rep) {
        pg8::Gemm g{UC, WbcT, M, DM, 1024}; pg8::StaticOrder S; S.init(M, DM, F.G, (int)blockIdx.x);
        pg8::EpiTmp E{GAB, TMP};
        pg8::gemm_phase<pg8::EpiTmp, pg8::StaticOrder, true, true>(F.lds + RING_OFF, g, S, E);
        if (rep + 1 < NREP(3)) GRID_BAR(); }
        if (BOTH(3)) GRID_BAR();
    }
    if (IN(4)) {
        for (int rep = 0; rep < NREP(4); ++rep) {
        pg8::Gemm g{AO, WbaT, M, DM, 1024}; pg8::StaticOrder S; S.init(M, DM, F.G, (int)blockIdx.x);
        pg8::EpiMerge E{GAB + (size_t)M * DM, TMP, MB};
        pg8::gemm_phase<pg8::EpiMerge, pg8::StaticOrder, true, true>(F.lds + RING_OFF, g, S, E);
        if (rep + 1 < NREP(4)) GRID_BAR(); }
        if (BOTH(4)) GRID_BAR();
    }
    if (IN(5)) {
        for (int rep = 0; rep < NREP(5); ++rep) {
        pg8::Gemm g{MB, WoutT, M, DM, DM}; pg8::StaticOrder S; S.init(M, DM, F.G, (int)blockIdx.x);
        pg8::EpiX1 E{args.in[0], args.out, X1B, (rep + 1 < NREP(5)) ? (unsigned long long*)(ws + 768 * 1024) : SS};
        pg8::gemm_phase<pg8::EpiX1, pg8::StaticOrder, true, true>(F.lds + RING_OFF, g, S, E);
        if (rep + 1 < NREP(5)) GRID_BAR(); }
        if (BOTH(5)) GRID_BAR();
    }
    if (IN(6)) {
        for (int rep = 0; rep < NREP(6); ++rep) {
        pg8::Gemm g{X1B, WpqT, M, DM, DM}; pg8::StaticOrder S; S.init(M, DM, F.G, (int)blockIdx.x);
        pg8::EpiQP E{SS, QP};
        pg8::gemm_phase<pg8::EpiQP, pg8::StaticOrder, true, true>(F.lds + RING_OFF, g, S, E);
        if (rep + 1 < NREP(6)) GRID_BAR(); }
        if (BOTH(6)) GRID_BAR();
    }
    if (IN(7)) { for (int rep = 0; rep < NREP(7); ++rep) { topk_phase(F, QP, KEYS, EXP, GATE); if (rep + 1 < NREP(7)) GRID_BAR(); } if (BOTH(7)) GRID_BAR(); }
    if (IN(8)) { for (int rep = 0; rep < NREP(8); ++rep) { peer_phase(F, UB, VB, X1B, EXP, GATE, SS, args.in[14], args.out, (rep + 1 < NREP(8)) ? (float*)(ws + WS_END) : args.out); if (rep + 1 < NREP(8)) GRID_BAR(); } }
#undef IN
#undef BOTH
#undef GRID_BAR
}

extern "C" void kernel_launch(void* const* d_in, const int* in_sizes, int n_in, void* d_out, int out_size, void* d_ws, size_t ws_size, hipStream_t stream) {
    static int grid = 0;
    if (grid == 0) {
        if (n_in != 15 || in_sizes[0] != M * DM || out_size != M * DM || ws_size < WS_END) { fprintf(stderr, "kernel_launch: unexpected shapes (n_in %d, in0 %d, out %d, ws %zu)\n", n_in, n_in > 0 ? in_sizes[0] : -1, out_size, ws_size); grid = -1; return; }
        int dev = 0, cus = 0, per_cu = 0;
        if (hipGetDevice(&dev) != hipSuccess || hipDeviceGetAttribute(&cus, hipDeviceAttributeMultiprocessorCount, dev) != hipSuccess) { grid = -1; return; }
        if (hipFuncSetAttribute((const void*)mk_fwd, hipFuncAttributeMaxDynamicSharedMemorySize, LDS_BYTES) != hipSuccess) { fprintf(stderr, "kernel_launch: hipFuncSetAttribute failed\n"); grid = -1; return; }
        if (hipOccupancyMaxActiveBlocksPerMultiprocessor(&per_cu, (const void*)mk_fwd, NWAVES * 64, LDS_BYTES) != hipSuccess || per_cu < 1) fprintf(stderr, "kernel_launch: occupancy query reports %d\n", per_cu);
        (void)hipGetLastError();
        grid = cus;
    }
    if (grid < 0) return;
    if (hipMemsetAsync((char*)d_ws + WS_CTL, 0, CTL_ZERO_BYTES, stream) != hipSuccess) { fprintf(stderr, "kernel_launch: memset failed\n"); return; }
    Args a{};
    for (int i = 0; i < 15; ++i) a.in[i] = (const float*)d_in[i];
    a.out = (float*)d_out; a.ws = (unsigned char*)d_ws;
    for (int f = 0; f < 16; ++f) a.invf[f] = pow(500000.0, -(double)(2 * f) / 32.0);
    for (int li = 0; li < N_LAUNCHES; ++li) {
        a.ph_lo = (N_LAUNCHES == PER_PHASE) ? li : 0; a.ph_hi = (N_LAUNCHES == PER_PHASE) ? li + 1 : PER_PHASE; a.li = li;
        hipLaunchKernelGGL(mk_fwd, dim3(grid), dim3(NWAVES * 64), LDS_BYTES, stream, a);
        const hipError_t le = hipPeekAtLastError();
        if (le != hipSuccess) { fprintf(stderr, "kernel_launch: launch %d failed: %s\n", li, hipGetErrorName(le)); break; }
    }
}
```

```cpp
#include <hip/hip_runtime.h>
#include <cstdio>
#include <cstdint>
#include <cmath>
namespace pg8 {
#define PG8_LAS __attribute__((address_space(3)))
typedef unsigned short bf16_t;
typedef short bf16x8 __attribute__((ext_vector_type(8)));
typedef float f32x4 __attribute__((ext_vector_type(4)));
typedef unsigned u32x4 __attribute__((ext_vector_type(4)));
constexpr int BM = 256, BK = 64, HALF = 128, HTB = HALF * BK * 2  , STAGE_BYTES = 8 * HTB, NXCD = 8, WGM = 8;

__host__ __device__ __forceinline__ int lds_byte(int r, int c) { const int st = (r >> 4) * 2 + (c >> 5), rr = r & 15, cc = c & 31, ob = rr * 64 + cc * 2; return st * 1024 + (ob ^ (((ob >> 9) & 1) << 5)); }
__host__ __device__ __forceinline__ void stage_rc(int b, int& R, int& C) { const int st = b / 1024, sb = b % 1024, swz = sb ^ (((sb >> 9) & 1) << 5); R = (st >> 1) * 16 + swz / 64; C = (st & 1) * 32 + (swz % 64) / 2; }
__host__ __device__ __forceinline__ int perm32(int rho) { const int n = rho >> 4, i = rho & 15; return 8 * (i >> 2) + 4 * n + (i & 3); }

struct Unit { int pm, pn; };
struct Gemm { const bf16_t* A; const bf16_t* Bt; int M, N, K; };

struct StaticOrder {
    int nM, nN, nwg, G, c;
    __host__ __device__ void init(int M, int N, int G_, int c_) { nM = M / BM; nN = N / BM; nwg = nM * nN; G = G_; c = c_; }
    __host__ __device__ bool next(int i, Unit& u) const {
        const long L = (long)i * G + c; if (L >= nwg) return false;
        int wgid = (int)L; { const int q = nwg / NXCD, r = nwg % NXCD, xcd = wgid % NXCD, off = wgid / NXCD; wgid = (xcd < r ? xcd * (q + 1) : r * (q + 1) + (xcd - r) * q) + off; }
        const int nig = WGM * nN, gid = wgid / nig, fm = gid * WGM, gsz = (nM - fm) < WGM ? (nM - fm) : WGM;
        u.pm = fm + ((wgid % nig) % gsz); u.pn = (wgid % nig) / gsz; return true;
    }
    __device__ __forceinline__ void a_ready(const Unit&) const {}
    __device__ __forceinline__ void done(const Unit&) const {}
};


typedef float f32x2c __attribute__((ext_vector_type(2))); typedef __bf16 bf16x2c __attribute__((ext_vector_type(2)));
__device__ __forceinline__ unsigned cvt_pk_bf16(float lo, float hi) { const f32x2c v = {lo, hi}; const bf16x2c b = __builtin_convertvector(v, bf16x2c); return __builtin_bit_cast(unsigned, b); }
__device__ __forceinline__ u32x4 pack8(f32x4 a, f32x4 b) { u32x4 w; w.x = cvt_pk_bf16(a[0], a[1]); w.y = cvt_pk_bf16(a[2], a[3]); w.z = cvt_pk_bf16(b[0], b[1]); w.w = cvt_pk_bf16(b[2], b[3]); return w; }
__device__ __forceinline__ f32x4 shx(f32x4 v, int o) { f32x4 r; r[0] = __shfl_xor(v[0], o); r[1] = __shfl_xor(v[1], o); r[2] = __shfl_xor(v[2], o); r[3] = __shfl_xor(v[3], o); return r; }
__device__ __forceinline__ f32x4 bf4lo(unsigned a, unsigned b) { f32x4 r; r[0] = __uint_as_float(a << 16); r[1] = __uint_as_float(a & 0xffff0000u); r[2] = __uint_as_float(b << 16); r[3] = __uint_as_float(b & 0xffff0000u); return r; }
__device__ __forceinline__ f32x4 sigm4(f32x4 v) { f32x4 r;
#pragma unroll
    for (int i = 0; i < 4; ++i) r[i] = __builtin_amdgcn_rcpf(1.0f + __expf(-v[i])); return r; }
constexpr float QSCALE = 0.08838834764831845f * 1.4426950408889634f;

struct EpiIn {
    static constexpr bool PERM = true, AFTER_DRAIN = false;
    bf16_t* T6; bf16_t* GAB; const float* gbias; const float* cs; float* ksum;
    __device__ __forceinline__ void operator()(const f32x4 (&acc)[2][2][4][2], const Unit& u, int wr, int wc, int fr, int fq) const {
        const int row0 = u.pm * BM + wr * 64 + fr, pn = u.pn, colw = wc * 32 + 8 * fq;
        if (pn < 24) {
            const int t = pn >> 2;
            bf16_t* base = T6 + (size_t)t * ((size_t)8192 * 1024) + (pn & 3) * 256 + colw;
            const bool rot = (t == 3 || t == 4) && (wc == 0), isk = (t == 4);
            const float qs = (t == 3) ? QSCALE : 1.0f;
            f32x4 ks[2][2];
#pragma unroll
            for (int bj = 0; bj < 2; ++bj) { ks[bj][0] = (f32x4){0.f, 0.f, 0.f, 0.f}; ks[bj][1] = (f32x4){0.f, 0.f, 0.f, 0.f}; }
#pragma unroll
            for (int ai = 0; ai < 2; ++ai)
#pragma unroll
                for (int m = 0; m < 4; ++m) {
                    const int row = row0 + ai * HALF + m * 16;
                    f32x4 c0 = (f32x4){1.f, 1.f, 1.f, 1.f}, c1 = c0, s0 = (f32x4){0.f, 0.f, 0.f, 0.f}, s1 = s0;
                    if (rot) { const float* cp = cs + (size_t)row * 32 + 8 * (fq & 1); c0 = *(const f32x4*)cp; c1 = *(const f32x4*)(cp + 4); s0 = *(const f32x4*)(cp + 16); s1 = *(const f32x4*)(cp + 20);
                        if (fq < 2) { s0 = -s0; s1 = -s1; } }
#pragma unroll
                    for (int bj = 0; bj < 2; ++bj) {
                        f32x4 v0 = acc[ai][bj][m][0], v1 = acc[ai][bj][m][1];
                        if (rot) { const f32x4 p0 = shx(v0, 32), p1 = shx(v1, 32); v0 = v0 * c0 + p0 * s0; v1 = v1 * c1 + p1 * s1; }
                        if (isk) { ks[bj][0] += v0; ks[bj][1] += v1; }
                        v0 = v0 * qs; v1 = v1 * qs;
                        *(u32x4*)(base + (size_t)row * 1024 + bj * HALF) = pack8(v0, v1);
                    }
                }
            if (isk) {
#pragma unroll
                for (int bj = 0; bj < 2; ++bj)
#pragma unroll
                    for (int n = 0; n < 2; ++n) { f32x4 v = ks[bj][n]; v += shx(v, 1); v += shx(v, 2); v += shx(v, 4); v += shx(v, 8);
                        if (fr == 0) { float* kp = ksum + (size_t)u.pm * 1024 + (pn & 3) * 256 + bj * HALF + colw + 4 * n;
                            unsafeAtomicAdd(kp + 0, v[0]); unsafeAtomicAdd(kp + 1, v[1]); unsafeAtomicAdd(kp + 2, v[2]); unsafeAtomicAdd(kp + 3, v[3]); } }
            }
        } else {
            const int t = (pn - 24) >> 3, colg = ((pn - 24) & 7) * 256 + colw;
            bf16_t* base = GAB + (size_t)t * ((size_t)8192 * 2048) + colg;
            const float* bp = gbias + t * 2048 + colg;
            f32x4 bv[2][2];
#pragma unroll
            for (int bj = 0; bj < 2; ++bj) { bv[bj][0] = *(const f32x4*)(bp + bj * HALF); bv[bj][1] = *(const f32x4*)(bp + bj * HALF + 4); }
#pragma unroll
            for (int ai = 0; ai < 2; ++ai)
#pragma unroll
                for (int m = 0; m < 4; ++m) { const int row = row0 + ai * HALF + m * 16;
#pragma unroll
                    for (int bj = 0; bj < 2; ++bj) *(u32x4*)(base + (size_t)row * 2048 + bj * HALF) = pack8(sigm4(acc[ai][bj][m][0] + bv[bj][0]), sigm4(acc[ai][bj][m][1] + bv[bj][1])); }
        }
    }
};
struct EpiTmp {
    static constexpr bool PERM = true, AFTER_DRAIN = false;
    const bf16_t* G; bf16_t* O;
    __device__ __forceinline__ void operator()(const f32x4 (&acc)[2][2][4][2], const Unit& u, int wr, int wc, int fr, int fq) const {
        const int row0 = u.pm * BM + wr * 64 + fr, col0 = u.pn * BM + wc * 32 + 8 * fq;
#pragma unroll
        for (int ai = 0; ai < 2; ++ai)
#pragma unroll
            for (int m = 0; m < 4; ++m) { const size_t off = (size_t)(row0 + ai * HALF + m * 16) * 2048 + col0;
#pragma unroll
                for (int bj = 0; bj < 2; ++bj) { const u32x4 g = *(const u32x4*)(G + off + bj * HALF);
                    *(u32x4*)(O + off + bj * HALF) = pack8(acc[ai][bj][m][0] * bf4lo(g.x, g.y), acc[ai][bj][m][1] * bf4lo(g.z, g.w)); } }
    }
};
struct EpiMerge {
    static constexpr bool PERM = true, AFTER_DRAIN = false;
    const bf16_t* G; const bf16_t* TMP; bf16_t* O;
    __device__ __forceinline__ void operator()(const f32x4 (&acc)[2][2][4][2], const Unit& u, int wr, int wc, int fr, int fq) const {
        const int row0 = u.pm * BM + wr * 64 + fr, col0 = u.pn * BM + wc * 32 + 8 * fq;
#pragma unroll
        for (int ai = 0; ai < 2; ++ai)
#pragma unroll
            for (int m = 0; m < 4; ++m) { const size_t off = (size_t)(row0 + ai * HALF + m * 16) * 2048 + col0;
#pragma unroll
                for (int bj = 0; bj < 2; ++bj) { const u32x4 g = *(const u32x4*)(G + off + bj * HALF), t = *(const u32x4*)(TMP + off + bj * HALF);
                    *(u32x4*)(O + off + bj * HALF) = pack8(bf4lo(t.x, t.y) + acc[ai][bj][m][0] * bf4lo(g.x, g.y), bf4lo(t.z, t.w) + acc[ai][bj][m][1] * bf4lo(g.z, g.w)); } }
    }
};
struct EpiX1 {
    static constexpr bool PERM = true, AFTER_DRAIN = false;
    const float* X; float* X1; bf16_t* X1B; unsigned long long* SS;
    __device__ __forceinline__ void operator()(const f32x4 (&acc)[2][2][4][2], const Unit& u, int wr, int wc, int fr, int fq) const {
        const int row0 = u.pm * BM + wr * 64 + fr, col0 = u.pn * BM + wc * 32 + 8 * fq;
#pragma unroll
        for (int ai = 0; ai < 2; ++ai)
#pragma unroll
            for (int m = 0; m < 4; ++m) { const int row = row0 + ai * HALF + m * 16; const size_t off = (size_t)row * 2048 + col0; float sq = 0.f;
#pragma unroll
                for (int bj = 0; bj < 2; ++bj) { const f32x4 v0 = acc[ai][bj][m][0] + *(const f32x4*)(X + off + bj * HALF), v1 = acc[ai][bj][m][1] + *(const f32x4*)(X + off + bj * HALF + 4);
                    *(f32x4*)(X1 + off + bj * HALF) = v0; *(f32x4*)(X1 + off + bj * HALF + 4) = v1; *(u32x4*)(X1B + off + bj * HALF) = pack8(v0, v1);
                    sq += (v0[0] * v0[0] + v0[1] * v0[1]) + (v0[2] * v0[2] + v0[3] * v0[3]) + (v1[0] * v1[0] + v1[1] * v1[1]) + (v1[2] * v1[2] + v1[3] * v1[3]); }
                sq += __shfl_xor(sq, 16); sq += __shfl_xor(sq, 32);
                if (fq == 0) atomicAdd(SS + row, (unsigned long long)(sq * 4294967296.0f)); }
    }
};
__device__ __forceinline__ float rinv_from_ss(unsigned long long s) { return 1.0f / sqrtf((float)((double)s * (1.0 / 4294967296.0) * (1.0 / 2048.0)) + 1e-6f); }
struct EpiQP {
    static constexpr bool PERM = true, AFTER_DRAIN = false;
    const unsigned long long* SS; bf16_t* O;
    __device__ __forceinline__ void operator()(const f32x4 (&acc)[2][2][4][2], const Unit& u, int wr, int wc, int fr, int fq) const {
        const int row0 = u.pm * BM + wr * 64 + fr, col0 = u.pn * BM + wc * 32 + 8 * fq;
#pragma unroll
        for (int ai = 0; ai < 2; ++ai)
#pragma unroll
            for (int m = 0; m < 4; ++m) { const int row = row0 + ai * HALF + m * 16; const size_t off = (size_t)row * 2048 + col0; const float rv = rinv_from_ss(SS[row]);
#pragma unroll
                for (int bj = 0; bj < 2; ++bj) *(u32x4*)(O + off + bj * HALF) = pack8(acc[ai][bj][m][0] * rv, acc[ai][bj][m][1] * rv); }
    }
};

template <class Epi, class Sched, bool ALIGN_EPI = false, bool SP2 = false>
__device__ __forceinline__ void gemm_phase(PG8_LAS unsigned char* lds, const Gemm g, const Sched& S, const Epi& E) {
    const int tid = threadIdx.x, wid = __builtin_amdgcn_readfirstlane(tid >> 6), lane = tid & 63, wr = wid >> 2, wc = wid & 3, fr = lane & 15, fq = lane >> 4;
    const int K = g.K, nt = K / BK;
    unsigned voffA[2], voffB[2];
#pragma unroll
    for (int i = 0; i < 2; ++i) { int R, C; stage_rc(tid * 16 + i * 8192, R, C); const int Rb = Epi::PERM ? ((R & ~31) + perm32(R & 31)) : R;
        voffA[i] = (unsigned)(R * K + C) * 2u; voffB[i] = (unsigned)(Rb * K + C) * 2u; }
    const size_t kstep = (size_t)(BK * 2);
    const size_t hstep = (size_t)HALF * K * 2;
    const size_t tstep = 2 * hstep;
    const unsigned ldsw = (unsigned)wid * 1024u;
    const int aoff = lds_byte(wr * 64 + fr, fq * 8), boff = lds_byte(wc * 32 + fr, fq * 8);
#define PG8_SA(b, h) (((b) * 2 + (h)) * HTB)
#define PG8_SB(b, h) ((4 + (b) * 2 + (h)) * HTB)
#define PG8_STAGE(bufoff, gbase, voff) do { _Pragma("unroll") for (int _i = 0; _i < 2; ++_i) \
        __builtin_amdgcn_global_load_lds((const unsigned*)((const char*)(gbase) + (voff)[_i]), (PG8_LAS unsigned*)(lds + (bufoff) + ldsw + _i * 8192), 16, 0, 0); } while (0)
#define PG8_LDA(dst, b, h) do { _Pragma("unroll") for (int m = 0; m < 4; ++m) _Pragma("unroll") for (int k = 0; k < 2; ++k) dst[m][k] = *(const PG8_LAS bf16x8*)(lds + PG8_SA(b, h) + aoff + m * 2048 + k * 1024); } while (0)
#define PG8_LDB(dst, b, h) do { _Pragma("unroll") for (int n = 0; n < 2; ++n) _Pragma("unroll") for (int k = 0; k < 2; ++k) dst[n][k] = *(const PG8_LAS bf16x8*)(lds + PG8_SB(b, h) + boff + n * 2048 + k * 1024); } while (0)
#define PG8_MMA(ai, bj, At, Bt) do { __builtin_amdgcn_s_setprio(1); _Pragma("unroll") for (int m = 0; m < 4; ++m) _Pragma("unroll") for (int n = 0; n < 2; ++n) _Pragma("unroll") for (int k = 0; k < 2; ++k) \
        acc[ai][bj][m][n] = __builtin_amdgcn_mfma_f32_16x16x32_bf16(Bt[n][k], At[m][k], acc[ai][bj][m][n], 0, 0, 0); __builtin_amdgcn_s_setprio(0); } while (0)
#define PG8_WAIT_V(n) asm volatile("s_waitcnt vmcnt(" #n ")" ::: "memory")
#define PG8_WAIT_L(n) asm volatile("s_waitcnt lgkmcnt(" #n ")" ::: "memory")
#define PG8_BAR __builtin_amdgcn_s_barrier()
#define PG8_SCHED __builtin_amdgcn_sched_barrier(0)
    Unit cur, nxt; int ui = 0;
    if (!S.next(0, cur)) return;
    f32x4 acc[2][2][4][2];
#pragma unroll
    for (int a = 0; a < 2; ++a)
#pragma unroll
        for (int b = 0; b < 2; ++b)
#pragma unroll
            for (int m = 0; m < 4; ++m)
#pragma unroll
                for (int n = 0; n < 2; ++n) acc[a][b][m][n] = (f32x4){0.f, 0.f, 0.f, 0.f};
    bf16x8 At[4][2], B0[2][2], B1[2][2];
    const char* cA = (const char*)g.A + (size_t)cur.pm * tstep; const char* cB = (const char*)g.Bt + (size_t)cur.pn * tstep;
    S.a_ready(cur);
    if constexpr (SP2) {
        PG8_STAGE(PG8_SB(0, 0), cB, voffB); PG8_STAGE(PG8_SB(0, 1), cB + hstep, voffB); PG8_STAGE(PG8_SA(0, 0), cA, voffA); PG8_STAGE(PG8_SA(0, 1), cA + hstep, voffA);
        if (wr == 1) PG8_BAR;
        PG8_WAIT_V(2); PG8_BAR;
        PG8_STAGE(PG8_SB(1, 0), cB + kstep, voffB); PG8_STAGE(PG8_SA(1, 0), cA + kstep, voffA); PG8_STAGE(PG8_SB(1, 1), cB + hstep + kstep, voffB);
        PG8_WAIT_V(6); PG8_BAR;
    } else {
        PG8_STAGE(PG8_SB(0, 0), cB, voffB); PG8_STAGE(PG8_SA(0, 0), cA, voffA); PG8_STAGE(PG8_SB(0, 1), cB + hstep, voffB); PG8_STAGE(PG8_SA(0, 1), cA + hstep, voffA);
        if (wr == 1) PG8_BAR;
        PG8_WAIT_V(4); PG8_BAR;
        PG8_STAGE(PG8_SB(1, 0), cB + kstep, voffB); PG8_STAGE(PG8_SA(1, 0), cA + kstep, voffA); PG8_STAGE(PG8_SB(1, 1), cB + hstep + kstep, voffB);
        PG8_WAIT_V(6); PG8_BAR;
    }
    for (;;) {
        const bool has_next = S.next(ui + 1, nxt);
        const char* nA = has_next ? (const char*)g.A + (size_t)nxt.pm * tstep : cA; const char* nB = has_next ? (const char*)g.Bt + (size_t)nxt.pn * tstep : cB;
        for (int t = 0; t < nt; t += 2) {
            const bool last = (t == nt - 2);
            const char* a1 = cA + (size_t)(t + 1) * kstep;
            const char* a2 = last ? nA : cA + (size_t)(t + 2) * kstep; const char* b2 = last ? nB : cB + (size_t)(t + 2) * kstep;
            const char* a3 = a2 + kstep; const char* b3 = b2 + kstep;
            if (last && has_next) S.a_ready(nxt);
            if constexpr (SP2) {
            PG8_LDB(B0, 0, 0); PG8_LDB(B1, 0, 1); PG8_SCHED; PG8_LDA(At, 0, 0); PG8_STAGE(PG8_SA(1, 1), a1 + hstep, voffA);
            PG8_WAIT_V(8); PG8_WAIT_L(0); PG8_BAR; PG8_MMA(0, 0, At, B0); PG8_MMA(0, 1, At, B1); PG8_BAR; PG8_SCHED;
            PG8_LDA(At, 0, 1); PG8_STAGE(PG8_SB(0, 0), b2, voffB); PG8_STAGE(PG8_SB(0, 1), b2 + hstep, voffB); PG8_STAGE(PG8_SA(0, 0), a2, voffA);
            PG8_WAIT_V(8); PG8_WAIT_L(0); PG8_BAR; PG8_MMA(1, 0, At, B0); PG8_MMA(1, 1, At, B1); PG8_BAR; PG8_SCHED;
            PG8_LDB(B0, 1, 0); PG8_LDB(B1, 1, 1); PG8_SCHED; PG8_LDA(At, 1, 0); PG8_STAGE(PG8_SA(0, 1), a2 + hstep, voffA);
            PG8_WAIT_V(8); PG8_WAIT_L(0); PG8_BAR; PG8_MMA(0, 0, At, B0); PG8_MMA(0, 1, At, B1); PG8_BAR; PG8_SCHED;
            PG8_LDA(At, 1, 1); PG8_STAGE(PG8_SB(1, 0), b3, voffB); PG8_STAGE(PG8_SB(1, 1), b3 + hstep, voffB); PG8_STAGE(PG8_SA(1, 0), a3, voffA);
            PG8_WAIT_V(8); PG8_WAIT_L(0); PG8_BAR; PG8_MMA(1, 0, At, B0); PG8_MMA(1, 1, At, B1); PG8_BAR; PG8_SCHED;
            } else {
            PG8_LDB(B0, 0, 0); PG8_SCHED; PG8_LDA(At, 0, 0); PG8_STAGE(PG8_SA(1, 1), a1 + hstep, voffA);
            PG8_WAIT_L(8); PG8_BAR; PG8_WAIT_L(0); PG8_MMA(0, 0, At, B0); PG8_BAR; PG8_SCHED;
            PG8_LDB(B1, 0, 1); PG8_STAGE(PG8_SB(0, 0), b2, voffB);
            PG8_BAR; PG8_WAIT_L(0); PG8_MMA(0, 1, At, B1); PG8_BAR;
            PG8_LDA(At, 0, 1); PG8_STAGE(PG8_SA(0, 0), a2, voffA);
            PG8_BAR; PG8_WAIT_L(0); PG8_MMA(1, 0, At, B0); PG8_BAR; PG8_SCHED;
            PG8_STAGE(PG8_SB(0, 1), b2 + hstep, voffB);
            PG8_WAIT_V(6); PG8_BAR; PG8_MMA(1, 1, At, B1); PG8_BAR;
            PG8_LDB(B0, 1, 0); PG8_SCHED; PG8_LDA(At, 1, 0); PG8_STAGE(PG8_SA(0, 1), a2 + hstep, voffA);
            PG8_WAIT_L(8); PG8_BAR; PG8_WAIT_L(0); PG8_MMA(0, 0, At, B0); PG8_BAR; PG8_SCHED;
            PG8_LDB(B1, 1, 1); PG8_STAGE(PG8_SB(1, 0), b3, voffB);
            PG8_BAR; PG8_WAIT_L(0); PG8_MMA(0, 1, At, B1); PG8_BAR;
            PG8_LDA(At, 1, 1); PG8_STAGE(PG8_SA(1, 0), a3, voffA);
            PG8_BAR; PG8_WAIT_L(0); PG8_MMA(1, 0, At, B0); PG8_BAR; PG8_SCHED;
            PG8_STAGE(PG8_SB(1, 1), b3 + hstep, voffB);
            PG8_WAIT_V(6); PG8_BAR; PG8_MMA(1, 1, At, B1); PG8_BAR;
            }
        }
        if constexpr (ALIGN_EPI) { if (wr == 0) PG8_BAR; }
        if constexpr (!Epi::AFTER_DRAIN) { E(acc, cur, wr, wc, fr, fq); S.done(cur); }
        if (!has_next) break;
#pragma unroll
        for (int a = 0; a < 2; ++a)
#pragma unroll
            for (int b = 0; b < 2; ++b)
#pragma unroll
                for (int m = 0; m < 4; ++m)
#pragma unroll
                    for (int n = 0; n < 2; ++n) acc[a][b][m][n] = (f32x4){0.f, 0.f, 0.f, 0.f};
        cur = nxt; cA = nA; cB = nB; ++ui;
        if constexpr (ALIGN_EPI) { if (wr == 1) PG8_BAR; }
    }
    PG8_WAIT_V(0);
    if constexpr (!ALIGN_EPI) { if (wr == 0) PG8_BAR; }
    PG8_BAR;
    if constexpr (Epi::AFTER_DRAIN) { E.fused(acc, cur, wr, wc, fr, fq, lds, wid, lane); S.done(cur); }
#undef PG8_SA
#undef PG8_SB
#undef PG8_STAGE
#undef PG8_LDA
#undef PG8_LDB
#undef PG8_MMA
#undef PG8_WAIT_V
#undef PG8_WAIT_L
#undef PG8_BAR
#undef PG8_SCHED
}
}

constexpr int NWAVES = 8;
#ifndef MK_N_LAUNCHES
#define MK_N_LAUNCHES 1
#endif
constexpr int PER_PHASE = 9;
#ifndef MK_REP_PHASE
#define MK_REP_PHASE -1
#endif
#define NREP(k) (((k) == MK_REP_PHASE) ? 2 : 1)
constexpr int N_LAUNCHES = MK_N_LAUNCHES;
constexpr int M = 8192, SEQ = 4096, DM = 2048, INW = 10240, NEXP = 16384;
constexpr float RMS_EPS = 1e-6f;
constexpr size_t MiB = 1u << 20;
constexpr size_t WS_CTL = 0, CTL_ZERO_BYTES = 1 * MiB;
constexpr size_t WS_SS = 256 * 1024, WS_KSUM = 512 * 1024;
constexpr size_t WS_WIN = 2 * MiB, WS_WBC = 42 * MiB, WS_WBA = 46 * MiB, WS_WOUT = 50 * MiB, WS_WPQ = 58 * MiB, WS_KEYS = 66 * MiB, WS_CS = 67 * MiB;
constexpr size_t WS_UB = 70 * MiB, WS_VB = 102 * MiB;
constexpr size_t WS_XB = 198 * MiB;
constexpr size_t WS_T6 = 230 * MiB;
constexpr size_t WS_GAB = 326 * MiB;
constexpr size_t WS_UC = 390 * MiB, WS_AO = 406 * MiB;
constexpr size_t WS_EXP = 422 * MiB, WS_GATE = 426 * MiB;
constexpr size_t WS_END = 430 * MiB;
constexpr size_t WS_TMP = WS_XB, WS_MB = WS_T6, WS_X1B = WS_T6 + 48 * MiB, WS_QP = WS_GAB;
constexpr int CW_BAR = 4096;
constexpr int RING_OFF = 0, RING_BYTES = 131072;
constexpr int LDSCTL_OFF = RING_BYTES, MISC_OFF = LDSCTL_OFF + 320;
constexpr int LDS_BYTES = 147456;

#define GAS __attribute__((address_space(1)))
#define LAS __attribute__((address_space(3)))
typedef unsigned short bf16;
typedef unsigned v4u __attribute__((ext_vector_type(4)));
typedef float f32x4 __attribute__((ext_vector_type(4)));
typedef short bf16x8 __attribute__((ext_vector_type(8)));
typedef GAS unsigned gu32;
typedef GAS unsigned long long gu64;
#define RLX_AGENT __ATOMIC_RELAXED, __HIP_MEMORY_SCOPE_AGENT
#define LDS_WAIT() asm volatile("s_waitcnt lgkmcnt(0)" ::: "memory")
#define VM_WAIT() asm volatile("s_waitcnt vmcnt(0)" ::: "memory")
__device__ __forceinline__ unsigned long long rt() { return __builtin_amdgcn_s_memrealtime(); }
__device__ __forceinline__ unsigned f2bf(float f) { unsigned u = __builtin_bit_cast(unsigned, f); return (u + 0x7fffu + ((u >> 16) & 1u)) >> 16; }
__device__ __forceinline__ unsigned pk2(float lo, float hi) { return f2bf(lo) | (f2bf(hi) << 16); }

#define XB_TMO      128
#define XB_XCNT(j)  (256  + 64 * (j))
#define XB_XSUB(j)  (1280 + 64 * (j))
#define XB_XGEN(j)  (2304 + 64 * (j))
#define XB_TOP      3328
#define XB_TOPGEN   3392
#define XCD_BAR_WORDS 3456
#define XB_SPIN_CAP (1u << 18)

__device__ __forceinline__ unsigned xb_ld(unsigned* p)              { return __hip_atomic_load(p, __ATOMIC_RELAXED, __HIP_MEMORY_SCOPE_AGENT); }
__device__ __forceinline__ unsigned xb_add(unsigned* p, unsigned v) { return __hip_atomic_fetch_add(p, v, __ATOMIC_RELAXED, __HIP_MEMORY_SCOPE_AGENT); }
__device__ __forceinline__ unsigned xb_xcc_id() { return (unsigned)__builtin_amdgcn_s_getreg((3 << 11) | 20) & 0xFu; }
#define XB_SPIN(cond, bar) do { unsigned _sp = 0; while (cond) { __builtin_amdgcn_s_sleep(1); \
    if ((++_sp & 255u) == 0u) { if (xb_ld(&(bar)[XB_TMO])) break; if (_sp > XB_SPIN_CAP) { atomicAdd(&(bar)[XB_TMO], 1u); break; } } } } while (0)

struct XcdBarrier {
    unsigned* bar; unsigned x;
    volatile LAS unsigned* st;
};

__device__ __forceinline__ XcdBarrier xcd_barrier_post(unsigned* bar, volatile LAS unsigned* st) {
    XcdBarrier b; b.bar = bar; b.x = xb_xcc_id(); b.st = st;
    if (threadIdx.x == 0) (void)xb_add(&bar[XB_XCNT(b.x)], 1u);
    return b;
}
__device__ __forceinline__ void xcd_barrier_complete(unsigned* bar, unsigned x, unsigned& nloc, unsigned& nx) {
    const unsigned G = gridDim.x * gridDim.y * gridDim.z;
    unsigned sum, cnt, mine, sp = 0u;
    for (;;) {
        sum = 0u; cnt = 0u; mine = 0u;
#pragma unroll
        for (unsigned j = 0; j < 16; ++j) { const unsigned c = xb_ld(&bar[XB_XCNT(j)]); sum += c; cnt += (c > 0u) ? 1u : 0u; mine = (j == x) ? c : mine; }
        if (sum == G) break;
        __builtin_amdgcn_s_sleep(1);
        if ((++sp & 255u) == 0u) { if (xb_ld(&bar[XB_TMO])) break; if (sp > XB_SPIN_CAP) { atomicAdd(&bar[XB_TMO], 1u); break; } }
    }
    nloc = mine > 0u ? mine : 1u; nx = cnt > 0u ? cnt : 1u;
}

__device__ __forceinline__ void xcd_barrier(const XcdBarrier& b) {
    asm volatile("s_waitcnt vmcnt(0)" ::: "memory");
    __syncthreads();
    if (threadIdx.x == 0) {
        unsigned* bar = b.bar;
        __builtin_amdgcn_s_waitcnt(0);
        unsigned nloc = b.st[0], nx = b.st[1];
        if (nloc == 0u) { xcd_barrier_complete(bar, b.x, nloc, nx); b.st[0] = nloc; b.st[1] = nx; }
        const unsigned old = xb_add(&bar[XB_XSUB(b.x)], 1u);
        const unsigned gen = old / nloc;
        if (old + 1u == (gen + 1u) * nloc) {
            __builtin_amdgcn_fence(__ATOMIC_RELEASE, "agent");
            asm volatile("s_waitcnt vmcnt(0)" ::: "memory");
            const unsigned og = xb_add(&bar[XB_TOP], 1u);
            const unsigned tg = og / nx;
            if (og + 1u == (tg + 1u) * nx) xb_add(&bar[XB_TOPGEN], 1u);
            else XB_SPIN(xb_ld(&bar[XB_TOPGEN]) == tg, bar);
            __builtin_amdgcn_fence(__ATOMIC_ACQUIRE, "agent");
            xb_add(&bar[XB_XGEN(b.x)], 1u);
            asm volatile("s_waitcnt vmcnt(0)" ::: "memory");
        } else {
            XB_SPIN(xb_ld(&bar[XB_XGEN(b.x)]) == gen, bar);
            __builtin_amdgcn_fence(__ATOMIC_ACQUIRE, "agent");
            asm volatile("s_waitcnt vmcnt(0)" ::: "memory");
        }
    }
    __syncthreads();
}

typedef __bf16 bf16x2v __attribute__((ext_vector_type(2)));
typedef float f32x16 __attribute__((ext_vector_type(16)));
__device__ __forceinline__ float bflo(unsigned w) { return __uint_as_float(w << 16); }
__device__ __forceinline__ float bfhi(unsigned w) { return __uint_as_float(w & 0xffff0000u); }
__device__ __forceinline__ float dot2bf(unsigned a, unsigned b, float c) { return __builtin_amdgcn_fdot2_f32_bf16(__builtin_bit_cast(bf16x2v, a), __builtin_bit_cast(bf16x2v, b), c, false); }
__device__ __forceinline__ float wave_sum(float v) {
#pragma unroll
    for (int o = 1; o < 64; o <<= 1) v += __shfl_xor(v, o);
    return v; }
__device__ __forceinline__ float wave_max(float v) {
#pragma unroll
    for (int o = 1; o < 64; o <<= 1) v = fmaxf(v, __shfl_xor(v, o));
    return v; }
__device__ __forceinline__ float rdlane(float v, int l) { return __int_as_float(__builtin_amdgcn_readlane(__float_as_int(v), l)); }
__device__ __forceinline__ float gelu_tanh(float x) { const float z = 0.7978845608028654f * (x + 0.044715f * x * x * x); const float e = __expf(2.0f * z); const float th = 1.0f - 2.0f * __builtin_amdgcn_rcpf(1.0f + e); return 0.5f * x * (1.0f + th); }

struct Ctx { LAS unsigned char* lds; int tid, lane, wave, vcu, G; };

__device__ __forceinline__ void p0_transpose_item(const float* W, int K, int N, bf16* WT, const float* gk, LAS float* scr, int item, int lane) {
    const int nblk = N / 32, kb = item / nblk, nb = item % nblk, k0 = 64 * kb, n0 = 32 * nb;
#pragma unroll 8
    for (int i = 0; i < 32; ++i) { const int kk = 2 * i + (lane >> 5); float v = W[(size_t)(k0 + kk) * N + n0 + (lane & 31)]; if (gk) v *= gk[k0 + kk]; scr[kk * 33 + (lane & 31)] = v; }
    LDS_WAIT(); asm volatile("" ::: "memory");
    const int c = lane & 7;
#pragma unroll
    for (int j = 0; j < 4; ++j) { const int n = (lane >> 3) + 8 * j; const LAS float* s = scr + (8 * c) * 33 + n;
        v4u o; o.x = pk2(s[0 * 33], s[1 * 33]); o.y = pk2(s[2 * 33], s[3 * 33]); o.z = pk2(s[4 * 33], s[5 * 33]); o.w = pk2(s[6 * 33], s[7 * 33]);
        *(GAS v4u*)(WT + (size_t)(n0 + n) * K + k0 + 8 * c) = o; }
    LDS_WAIT(); asm volatile("" ::: "memory");
}
__device__ __forceinline__ void p0_prologue(const Ctx& F, const float* const* in, unsigned char* ws, const double* invf) {
    const float* x = in[0]; const int* pos = (const int*)in[1]; const float* g1 = in[2]; const float* w_in = in[3];
    const float* w_bc = in[6]; const float* w_ba = in[7]; const float* w_out = in[8]; const float* g2 = in[9]; const float* w_pq = in[10];
    const float* keys = in[11]; const float* pu = in[12]; const float* pv = in[13];
    LAS float* scr = (LAS float*)(F.lds + RING_OFF + F.wave * 16384);
    const int gw = F.vcu * NWAVES + F.wave, NGW = F.G * NWAVES;
    const int gt = gw * 64 + F.lane, NT = NGW * 64;
    for (int i = gt; i < 8192; i += NT) ((GAS unsigned long long*)(ws + WS_SS))[i] = 0ull;
    for (int i = gt; i < 32 * 1024; i += NT) ((GAS float*)(ws + WS_KSUM))[i] = 0.f;
    constexpr int I_IN = 32 * 320, I_BC = 16 * 64, I_OUT = 32 * 64;
    constexpr int NITEMS = I_IN + 2 * I_BC + 2 * I_OUT;
    for (int it = gw; it < NITEMS; it += NGW) {
        int r = it;
        if (r < I_IN) { p0_transpose_item(w_in, 2048, INW, (bf16*)(ws + WS_WIN), g1, scr, r, F.lane); continue; } r -= I_IN;
        if (r < I_BC) { p0_transpose_item(w_bc, 1024, 2048, (bf16*)(ws + WS_WBC), nullptr, scr, r, F.lane); continue; } r -= I_BC;
        if (r < I_BC) { p0_transpose_item(w_ba, 1024, 2048, (bf16*)(ws + WS_WBA), nullptr, scr, r, F.lane); continue; } r -= I_BC;
        if (r < I_OUT) { p0_transpose_item(w_out, 2048, 2048, (bf16*)(ws + WS_WOUT), nullptr, scr, r, F.lane); continue; } r -= I_OUT;
        p0_transpose_item(w_pq, 2048, 2048, (bf16*)(ws + WS_WPQ), g2, scr, r, F.lane);
    }
    for (int i = gt; i < 16 * 128 * 128 / 8; i += NT) { const f32x4 a = ((const GAS f32x4*)keys)[2 * i], b = ((const GAS f32x4*)keys)[2 * i + 1];
        v4u o; o.x = pk2(a[0], a[1]); o.y = pk2(a[2], a[3]); o.z = pk2(b[0], b[1]); o.w = pk2(b[2], b[3]); ((GAS v4u*)(ws + WS_KEYS))[i] = o; }
    for (int i = gt; i < NEXP * 2048 / 16; i += NT) { const int c16 = (i & 127) * 16; v4u ou, ov;
#pragma unroll
        for (int q = 0; q < 4; ++q) { f32x4 a = ((const GAS f32x4*)pu)[4 * i + q]; a = a * *(const GAS f32x4*)(g2 + c16 + 4 * q) * 512.0f; const f32x4 b = ((const GAS f32x4*)pv)[4 * i + q] * 32.0f;
            int wu = 0, wv = 0; wu = __builtin_amdgcn_cvt_pk_fp8_f32(a[0], a[1], wu, false); wu = __builtin_amdgcn_cvt_pk_fp8_f32(a[2], a[3], wu, true);
            wv = __builtin_amdgcn_cvt_pk_fp8_f32(b[0], b[1], wv, false); wv = __builtin_amdgcn_cvt_pk_fp8_f32(b[2], b[3], wv, true); ou[q] = (unsigned)wu; ov[q] = (unsigned)wv; }
        ((GAS v4u*)(ws + WS_UB))[i] = ou; ((GAS v4u*)(ws + WS_VB))[i] = ov; }
    for (int m = gw; m < M; m += NGW) { const GAS f32x4* xr = (const GAS f32x4*)(x + (size_t)m * DM);
        f32x4 v[8]; float s = 0.f;
#pragma unroll
        for (int i = 0; i < 4; ++i) { v[2 * i] = xr[i * 128 + 2 * F.lane]; v[2 * i + 1] = xr[i * 128 + 2 * F.lane + 1]; }
#pragma unroll
        for (int i = 0; i < 8; ++i) s += (v[i][0] * v[i][0] + v[i][1] * v[i][1]) + (v[i][2] * v[i][2] + v[i][3] * v[i][3]);
        const float rinv = 1.0f / sqrtf(wave_sum(s) * (1.0f / DM) + RMS_EPS);
        GAS v4u* o = (GAS v4u*)(ws + WS_XB + (size_t)m * DM * 2);
#pragma unroll
        for (int i = 0; i < 4; ++i) { const f32x4 a = v[2 * i] * rinv, b = v[2 * i + 1] * rinv; v4u w; w.x = pk2(a[0], a[1]); w.y = pk2(a[2], a[3]); w.z = pk2(b[0], b[1]); w.w = pk2(b[2], b[3]); o[i * 64 + F.lane] = w; } }
    for (int i = gt; i < M * 16; i += NT) { const int row = i >> 4, f = i & 15; const double ang = (double)pos[row] * invf[f];
        const double k = __builtin_rint(ang * 0.15915494309189535); const float r = (float)(ang - k * 6.283185307179586);
        float* cs = (float*)(ws + WS_CS); cs[row * 32 + f] = __cosf(r); cs[row * 32 + 16 + f] = __sinf(r); }
}

__device__ __forceinline__ void attn_simple(const Ctx& F, const bf16* Q, const bf16* K, const bf16* V, const float* ksum, bf16* AO) {
    LAS float* qf = (LAS float*)(F.lds + RING_OFF + F.wave * 512);
    const int gw = F.vcu * NWAVES + F.wave, NGW = F.G * NWAVES, lane = F.lane;
    for (int item = gw; item < 16 * SEQ; item += NGW) {
        const int bh = item >> 12, t = item & 4095, b = bh >> 3, h = bh & 7, blk = t >> 8;
        const size_t row = (size_t)b * SEQ + t;
        { const unsigned qq = *(const GAS unsigned*)(Q + row * 1024 + h * 128 + 2 * lane); qf[2 * lane] = bflo(qq); qf[2 * lane + 1] = bfhi(qq); }
        LDS_WAIT(); asm volatile("" ::: "memory");
        float g = -INFINITY;
        if (lane < blk) { const GAS f32x4* km = (const GAS f32x4*)(ksum + (size_t)(b * 16 + lane) * 1024 + h * 128); float a = 0.f;
            for (int d = 0; d < 32; ++d) { const f32x4 kv = km[d]; const f32x4 qv = *(const LAS f32x4*)(qf + 4 * d); a += (kv[0] * qv[0] + kv[1] * qv[1]) + (kv[2] * qv[2] + kv[3] * qv[3]); }
            g = a; }
        int sel[3];
#pragma unroll
        for (int i = 0; i < 3; ++i) { const float mx = wave_max(g); const unsigned long long bal = __ballot(g == mx && lane < blk); const int idx = bal ? (__ffsll((long long)bal) - 1) : 0; sel[i] = idx; if (lane == idx) g = -INFINITY; }
        const int nsel = blk < 3 ? blk : 3;
        float sc[4][4]; float mx = -INFINITY;
#pragma unroll
        for (int slot = 0; slot < 4; ++slot) {
            const bool valid = (slot == 3) || (slot < nsel);
            const int kb = (slot == 3) ? blk : sel[slot < 3 ? slot : 0];
#pragma unroll
            for (int r = 0; r < 4; ++r) {
                float s = -INFINITY; const int key0 = kb * 256 + r * 64;
                if (valid && (slot < 3 || key0 <= t)) {
                    const int key = key0 + lane; const GAS v4u* kp = (const GAS v4u*)(K + ((size_t)b * SEQ + key) * 1024 + h * 128); float a = 0.f;
#pragma unroll 4
                    for (int d = 0; d < 16; ++d) { const v4u kk = kp[d]; const f32x4 q0 = *(const LAS f32x4*)(qf + 8 * d), q1 = *(const LAS f32x4*)(qf + 8 * d + 4);
                        a += (bflo(kk.x) * q0[0] + bfhi(kk.x) * q0[1]) + (bflo(kk.y) * q0[2] + bfhi(kk.y) * q0[3]) + (bflo(kk.z) * q1[0] + bfhi(kk.z) * q1[1]) + (bflo(kk.w) * q1[2] + bfhi(kk.w) * q1[3]); }
                    s = (slot < 3 || key <= t) ? a : -INFINITY; }
                sc[slot][r] = s; mx = fmaxf(mx, s); } }
        mx = wave_max(mx);
        float sum = 0.f;
#pragma unroll
        for (int slot = 0; slot < 4; ++slot)
#pragma unroll
            for (int r = 0; r < 4; ++r) { sc[slot][r] = exp2f(sc[slot][r] - mx); sum += sc[slot][r]; }
        sum = wave_sum(sum);
        float o0 = 0.f, o1 = 0.f;
#pragma unroll
        for (int slot = 0; slot < 4; ++slot) {
            const bool valid = (slot == 3) || (slot < nsel);
            const int kb = (slot == 3) ? blk : sel[slot < 3 ? slot : 0];
#pragma unroll
            for (int r = 0; r < 4; ++r) { const int key0 = kb * 256 + r * 64;
                if (valid && (slot < 3 || key0 <= t)) { const float pr = sc[slot][r]; const GAS unsigned* vp = (const GAS unsigned*)(V + ((size_t)b * SEQ + key0) * 1024 + h * 128) + lane;
                    for (int kk = 0; kk < 64; ++kk) { const float pk = rdlane(pr, kk); const unsigned vv = vp[(size_t)kk * 512]; o0 += pk * bflo(vv); o1 += pk * bfhi(vv); } } } }
        const float ri = 1.0f / sum;
        *(GAS unsigned*)(AO + row * 1024 + h * 128 + 2 * lane) = pk2(o0 * ri, o1 * ri);
    }
}
typedef short v4i16_t __attribute__((ext_vector_type(4))); typedef unsigned u32x2v __attribute__((ext_vector_type(2)));
__device__ __forceinline__ v4i16_t vtr16(unsigned addr) { return __builtin_amdgcn_ds_read_tr16_b64_v4i16((LAS v4i16_t*)(uintptr_t)addr); }
__device__ __forceinline__ int crow16(int r, int hh) { return (r & 3) + 8 * (r >> 2) + 4 * hh; }
__device__ __forceinline__ void attn_dma_step(const bf16* K, const bf16* V, LAS unsigned char* lds, int b, int h, int qb, int n_own, int st, int wave, int lane) {
    const int buf = st & 1;
#pragma unroll
    for (int img = 0; img < 4; ++img) {
        const int T = 2 * st + (img >> 1); const bool isV = img & 1;
        const int blk = (T < n_own) ? qb : ((T - n_own) >> 2), kt = (T < n_own) ? T : ((T - n_own) & 3);
        const bf16* base = (isV ? V : K) + ((size_t)b * SEQ + 256 * blk + 64 * kt) * 1024 + h * 128;
#pragma unroll
        for (int i = 0; i < 2; ++i) { const int pc = wave + 8 * i, row = 4 * pc + (lane >> 4), cp = lane & 15;
            const int c = isV ? ((((cp >> 2) ^ (row & 3)) << 2) | (cp & 3)) : (cp ^ (row & 15));
            __builtin_amdgcn_global_load_lds((const unsigned*)(base + (size_t)row * 1024 + 8 * c), (LAS unsigned*)(lds + buf * 65536 + img * 16384 + pc * 1024), 16, 0, 0); }
    }
}
__device__ __forceinline__ void attn_mfma(const Ctx& F, const bf16* Q, const bf16* K, const bf16* V, const float* ksum, bf16* AO) {
    const int lane = F.lane, wave = F.wave, q31 = lane & 31, hh = lane >> 5, wq = wave & 3, kvh = wave >> 2, l16 = lane & 15, G4 = lane >> 4;
    LAS unsigned char* lds = F.lds + RING_OFF;
    const unsigned lds0 = (unsigned)(uintptr_t)lds;
    for (int pr = F.vcu; pr < 256; pr += F.G)
#pragma unroll 1
    for (int pi = 0; pi < 2; ++pi) {
        const int bh = pr >> 4, s_ = pr & 15, u128 = pi ? 31 - s_ : s_, b = bh >> 3, h = bh & 7, qb = u128 >> 1, half = u128 & 1;
        const int n_own = half ? 4 : 2, nstep = (n_own + 4 * qb) >> 1;
        const size_t rowq = (size_t)b * SEQ + 256 * qb + 128 * half + 32 * wq + q31;
        asm volatile("s_waitcnt vmcnt(0) lgkmcnt(0)" ::: "memory"); __builtin_amdgcn_s_barrier(); asm volatile("" ::: "memory");
        attn_dma_step(K, V, lds, b, h, qb, n_own, 0, wave, lane);
        bf16x8 qf[8];
#pragma unroll
        for (int s = 0; s < 8; ++s) qf[s] = *(const GAS bf16x8*)(Q + rowq * 1024 + h * 128 + 16 * s + 8 * hh);
        unsigned selmask;
        {
            float qv[64];
#pragma unroll
            for (int s = 0; s < 8; ++s)
#pragma unroll
                for (int e = 0; e < 8; ++e) qv[8 * s + e] = __uint_as_float((unsigned)(unsigned short)qf[s][e] << 16);
            float v0 = -INFINITY, v1 = -INFINITY, v2 = -INFINITY; int i0 = 0, i1 = 0, i2 = 0;
#pragma unroll 1
            for (int j = 0; j < qb; ++j) {
                const GAS f32x4* kp = (const GAS f32x4*)(ksum + (size_t)(b * 16 + j) * 1024 + h * 128 + 8 * hh); float a = 0.f;
#pragma unroll
                for (int s = 0; s < 8; ++s) { const f32x4 k0 = kp[4 * s], k1 = kp[4 * s + 1];
                    a += (qv[8 * s] * k0[0] + qv[8 * s + 1] * k0[1]) + (qv[8 * s + 2] * k0[2] + qv[8 * s + 3] * k0[3]) + (qv[8 * s + 4] * k1[0] + qv[8 * s + 5] * k1[1]) + (qv[8 * s + 6] * k1[2] + qv[8 * s + 7] * k1[3]); }
                a += __shfl_xor(a, 32);
                if (a > v0) { v2 = v1; i2 = i1; v1 = v0; i1 = i0; v0 = a; i0 = j; } else if (a > v1) { v2 = v1; i2 = i1; v1 = a; i1 = j; } else if (a > v2) { v2 = a; i2 = j; }
            }
            selmask = (qb <= 3) ? ((1u << qb) - 1u) : ((1u << i0) | (1u << i1) | (1u << i2));
        }
        float m_run = -1e30f, l_run = 0.f; f32x16 o[4];
#pragma unroll
        for (int db = 0; db < 4; ++db)
#pragma unroll
            for (int r = 0; r < 16; ++r) o[db][r] = 0.f;
        const int qin = 128 * half + 32 * wq + q31;
#pragma unroll 1
        for (int st = 0; st < nstep; ++st) {
            asm volatile("s_waitcnt vmcnt(0)" ::: "memory"); __builtin_amdgcn_s_barrier(); asm volatile("" ::: "memory");
            if (st + 1 < nstep) attn_dma_step(K, V, lds, b, h, qb, n_own, st + 1, wave, lane);
            const int T = 2 * st + kvh; const bool own = T < n_own;
            const int blk = own ? qb : ((T - n_own) >> 2), kt = own ? T : ((T - n_own) & 3);
            const bool sel = own ? true : ((selmask >> blk) & 1u);
            const bool skip = own ? (64 * kt > 128 * half + 32 * wq + 31) : (__ballot(sel) == 0ull);
            if (!skip) {
                const unsigned kimg = lds0 + (st & 1) * 65536 + kvh * 32768, vimg = kimg + 16384;
                f32x16 p[2];
#pragma unroll
                for (int kh = 0; kh < 2; ++kh) {
#pragma unroll
                    for (int r = 0; r < 16; ++r) p[kh][r] = 0.f;
                    const int row = 32 * kh + q31;
#pragma unroll
                    for (int s = 0; s < 8; ++s) { const bf16x8 a = *(const LAS bf16x8*)(uintptr_t)(kimg + row * 256 + (((2 * s + hh) ^ (row & 15)) << 4));
                        p[kh] = __builtin_amdgcn_mfma_f32_32x32x16_bf16(a, qf[s], p[kh], 0, 0, 0); }
                }
                if (own) { const int kbase = 64 * kt;
                    if (kbase + 63 > 128 * half + 32 * wq) {
#pragma unroll
                        for (int kh = 0; kh < 2; ++kh)
#pragma unroll
                            for (int r = 0; r < 16; ++r) if (kbase + 32 * kh + crow16(r, hh) > qin) p[kh][r] = -INFINITY; }
                } else if (!sel) {
#pragma unroll
                    for (int kh = 0; kh < 2; ++kh)
#pragma unroll
                        for (int r = 0; r < 16; ++r) p[kh][r] = -INFINITY; }
                float mx = p[0][0];
#pragma unroll
                for (int r = 1; r < 16; ++r) mx = fmaxf(mx, p[0][r]);
#pragma unroll
                for (int r = 0; r < 16; ++r) mx = fmaxf(mx, p[1][r]);
                mx = fmaxf(mx, __shfl_xor(mx, 32));
                const float m_new = fmaxf(m_run, mx), scl = exp2f(m_run - m_new); m_run = m_new;
                float rs = 0.f;
#pragma unroll
                for (int kh = 0; kh < 2; ++kh)
#pragma unroll
                    for (int r = 0; r < 16; ++r) { p[kh][r] = exp2f(p[kh][r] - m_new); rs += p[kh][r]; }
                l_run = l_run * scl + rs;
#pragma unroll
                for (int db = 0; db < 4; ++db)
#pragma unroll
                    for (int r = 0; r < 16; ++r) o[db][r] *= scl;
#pragma unroll
                for (int kh = 0; kh < 2; ++kh)
#pragma unroll
                    for (int s2 = 0; s2 < 2; ++s2) {
                        v4u pw; pw.x = pg8::cvt_pk_bf16(p[kh][8 * s2], p[kh][8 * s2 + 1]); pw.y = pg8::cvt_pk_bf16(p[kh][8 * s2 + 2], p[kh][8 * s2 + 3]);
                        pw.z = pg8::cvt_pk_bf16(p[kh][8 * s2 + 4], p[kh][8 * s2 + 5]); pw.w = pg8::cvt_pk_bf16(p[kh][8 * s2 + 6], p[kh][8 * s2 + 7]);
                        const bf16x8 pb = __builtin_bit_cast(bf16x8, pw);
                        const int key0 = 32 * kh + 16 * s2 + 4 * (G4 >> 1) + (l16 >> 2);
#pragma unroll
                        for (int db = 0; db < 4; ++db) {
                            const int dsub = 16 * (G4 & 1) + 4 * (l16 & 3);
                            const unsigned a0 = vimg + key0 * 256 + ((db ^ (key0 & 3)) << 6) + dsub * 2;
                            const v4i16_t lo = vtr16(a0), hi_ = vtr16(a0 + 8 * 256);
                            const bf16x8 av = {lo[0], lo[1], lo[2], lo[3], hi_[0], hi_[1], hi_[2], hi_[3]};
                            o[db] = __builtin_amdgcn_mfma_f32_32x32x16_bf16(av, pb, o[db], 0, 0, 0);
                        }
                    }
            }
        }
        l_run += __shfl_xor(l_run, 32);
        asm volatile("s_waitcnt vmcnt(0) lgkmcnt(0)" ::: "memory"); __builtin_amdgcn_s_barrier(); asm volatile("" ::: "memory");
        LAS float* xs = (LAS float*)lds + (size_t)wq * 66 * 64 + lane;
        if (kvh == 1) {
            xs[0] = m_run; xs[64] = l_run;
#pragma unroll
            for (int db = 0; db < 4; ++db)
#pragma unroll
                for (int r = 0; r < 16; ++r) xs[(2 + 16 * db + r) * 64] = o[db][r];
        }
        asm volatile("s_waitcnt lgkmcnt(0)" ::: "memory"); __builtin_amdgcn_s_barrier(); asm volatile("" ::: "memory");
        if (kvh == 0) {
            const float m2 = xs[0], l2 = xs[64], mt = fmaxf(m_run, m2), a1 = exp2f(m_run - mt), a2 = exp2f(m2 - mt);
            const float inv = 1.0f / (l_run * a1 + l2 * a2), c1 = a1 * inv, c2 = a2 * inv;
            bf16* orow = AO + rowq * 1024 + h * 128 + 4 * hh;
#pragma unroll
            for (int db = 0; db < 4; ++db)
#pragma unroll
                for (int g = 0; g < 4; ++g) {
                    float t[4];
#pragma unroll
                    for (int e = 0; e < 4; ++e) t[e] = o[db][4 * g + e] * c1 + xs[(2 + 16 * db + 4 * g + e) * 64] * c2;
                    u32x2v w; w.x = pg8::cvt_pk_bf16(t[0], t[1]); w.y = pg8::cvt_pk_bf16(t[2], t[3]);
                    *(GAS u32x2v*)(orow + 32 * db + 8 * g) = w;
                }
        }
    }
    asm volatile("s_waitcnt vmcnt(0) lgkmcnt(0)" ::: "memory"); __builtin_amdgcn_s_barrier(); asm volatile("" ::: "memory");
}
__device__ __forceinline__ void up8(const v4u w, float (&f)[8]) { f[0] = bflo(w.x); f[1] = bfhi(w.x); f[2] = bflo(w.y); f[3] = bfhi(w.y); f[4] = bflo(w.z); f[5] = bfhi(w.z); f[6] = bflo(w.w); f[7] = bfhi(w.w); }
__device__ __forceinline__ void conv_phase(const Ctx& F, const bf16* CB, const bf16* CC, const bf16* CX, const float* cw, bf16* UC) {
    const int gt = (F.vcu * NWAVES + F.wave) * 64 + F.lane, NT = F.G * NWAVES * 64;
    for (int idx = gt; idx < M * 128; idx += NT) {
        const int row = idx >> 7, c8 = (idx & 127) << 3, t = row & (SEQ - 1); const size_t off = (size_t)row * 1024 + c8;
        float cb[8], a[8], x[8], z0[8], z1[8], z2[8];
        up8(*(const GAS v4u*)(CB + off), cb); up8(*(const GAS v4u*)(CC + off), a); up8(*(const GAS v4u*)(CX + off), x);
#pragma unroll
        for (int j = 0; j < 8; ++j) z0[j] = a[j] * x[j];
        if (t >= 1) { up8(*(const GAS v4u*)(CC + off - 1024), a); up8(*(const GAS v4u*)(CX + off - 1024), x);
#pragma unroll
            for (int j = 0; j < 8; ++j) z1[j] = a[j] * x[j]; } else {
#pragma unroll
            for (int j = 0; j < 8; ++j) z1[j] = 0.f; }
        if (t >= 2) { up8(*(const GAS v4u*)(CC + off - 2048), a); up8(*(const GAS v4u*)(CX + off - 2048), x);
#pragma unroll
            for (int j = 0; j < 8; ++j) z2[j] = a[j] * x[j]; } else {
#pragma unroll
            for (int j = 0; j < 8; ++j) z2[j] = 0.f; }
        float o[8];
#pragma unroll
        for (int j = 0; j < 8; ++j) o[j] = cb[j] * (cw[c8 + j] * z2[j] + cw[1024 + c8 + j] * z1[j] + cw[2048 + c8 + j] * z0[j]);
        v4u w; w.x = pk2(o[0], o[1]); w.y = pk2(o[2], o[3]); w.z = pk2(o[4], o[5]); w.w = pk2(o[6], o[7]); *(GAS v4u*)(UC + off) = w;
    }
}

__device__ const unsigned char CAND50[64] = {
    0x00,0x01,0x02,0x03,0x04,0x05,0x06,0x07,0x08,0x09,0x0a,0x0b,0x0c,0x0d,0x0e,0x0f,
    0x10,0x11,0x12,0x13,0x14,0x15,0x16,0x17, 0x20,0x21,0x22,0x23,0x24, 0x30,0x31,0x32,0x33, 0x40,0x41,0x42, 0x50,0x51, 0x60,0x61, 0x70,0x71,
    0x80,0x90,0xa0,0xb0,0xc0,0xd0,0xe0,0xf0, 0xff,0xff,0xff,0xff,0xff,0xff,0xff,0xff,0xff,0xff,0xff,0xff,0xff,0xff};
__device__ __forceinline__ int ord_key(float f) { const int u = __float_as_int(f); return u >= 0 ? u : (u ^ 0x7fffffff); }
__device__ __forceinline__ float ord_val(int k) { return __int_as_float(k >= 0 ? k : (k ^ 0x7fffffff)); }
template <int CTRL> __device__ __forceinline__ int dpp_i(int v) { return __builtin_amdgcn_update_dpp(v, v, CTRL, 0xf, 0xf, false); }
__device__ __forceinline__ int imax(int a, int b) { return a > b ? a : b; }
__device__ __forceinline__ int hmax32(int v) {
    v = imax(v, dpp_i<0xB1>(v)); v = imax(v, dpp_i<0x4E>(v)); v = imax(v, dpp_i<0x141>(v)); v = imax(v, dpp_i<0x140>(v));
    const auto r = __builtin_amdgcn_permlane16_swap((unsigned)v, (unsigned)v, false, false); return imax((int)r[0], (int)r[1]); }
__device__ __forceinline__ float hsum32(float v) {
    v += __int_as_float(dpp_i<0xB1>(__float_as_int(v))); v += __int_as_float(dpp_i<0x4E>(__float_as_int(v))); v += __int_as_float(dpp_i<0x141>(__float_as_int(v))); v += __int_as_float(dpp_i<0x140>(__float_as_int(v)));
    const auto r = __builtin_amdgcn_permlane16_swap(__float_as_uint(v), __float_as_uint(v), false, false); return __uint_as_float(r[0]) + __uint_as_float(r[1]); }
__device__ __forceinline__ void topk_phase(const Ctx& F, const bf16* QP, const bf16* KEYS, int* EXP, float* GATE) {
    const int gw = F.vcu * NWAVES + F.wave, NGW = F.G * NWAVES, lane = F.lane, l31 = lane & 31, hi = lane >> 5;
    const int IMIN = (int)0x80000000;
    for (int item = gw; item < 256 * 8; item += NGW) {
        const int tt = item >> 3, h = item & 7, tok0 = tt * 32;
        int tops[2][16];
#pragma unroll
        for (int p = 0; p < 2; ++p) {
            f32x16 sc[4];
#pragma unroll
            for (int nt = 0; nt < 4; ++nt)
#pragma unroll
                for (int r = 0; r < 16; ++r) sc[nt][r] = 0.f;
#pragma unroll
            for (int s = 0; s < 8; ++s) {
                const bf16x8 a = *(const GAS bf16x8*)(QP + (size_t)(tok0 + l31) * 2048 + h * 256 + p * 128 + 16 * s + 8 * hi);
#pragma unroll
                for (int nt = 0; nt < 4; ++nt) { const bf16x8 bb = *(const GAS bf16x8*)(KEYS + (size_t)((h * 2 + p) * 128 + 32 * nt + l31) * 128 + 16 * s + 8 * hi);
                    sc[nt] = __builtin_amdgcn_mfma_f32_32x32x16_bf16(a, bb, sc[nt], 0, 0, 0); }
            }
            int kk[4][16];
#pragma unroll
            for (int nt = 0; nt < 4; ++nt)
#pragma unroll
                for (int r = 0; r < 16; ++r) kk[nt][r] = (ord_key(sc[nt][r]) & ~127) | (127 - 32 * nt - l31);
#pragma unroll
            for (int r = 0; r < 16; ++r) tops[p][r] = IMIN;
#pragma unroll 1
            for (int i = 0; i < 16; ++i) {
#pragma unroll
                for (int r = 0; r < 16; ++r) {
                    const int m = hmax32(imax(imax(kk[0][r], kk[1][r]), imax(kk[2][r], kk[3][r])));
                    if (l31 == i) tops[p][r] = m;
#pragma unroll
                    for (int nt = 0; nt < 4; ++nt) kk[nt][r] = (kk[nt][r] == m) ? IMIN : kk[nt][r];
                }
            }
        }
        const int cd0 = CAND50[l31], cd1 = CAND50[32 + l31], base = 32 * hi;
        int c0[16], c1[16], best[16];
#pragma unroll
        for (int r = 0; r < 16; ++r) {
            const int ta = tops[0][r], tb = tops[1][r];
            const int a0 = __shfl(ta, base + (cd0 >> 4)), b0 = __shfl(tb, base + (cd0 & 15)), a1 = __shfl(ta, base + ((cd1 >> 4) & 15)), b1 = __shfl(tb, base + (cd1 & 15));
            const float s0 = ord_val(a0 & ~127) + ord_val(b0 & ~127), s1 = ord_val(a1 & ~127) + ord_val(b1 & ~127);
            c0[r] = (ord_key(s0) & ~255) | (255 - cd0); c1[r] = (cd1 == 0xff) ? IMIN : ((ord_key(s1) & ~255) | (255 - cd1)); best[r] = IMIN;
        }
#pragma unroll 1
        for (int i = 0; i < 16; ++i) {
#pragma unroll
            for (int r = 0; r < 16; ++r) { const int m = hmax32(imax(c0[r], c1[r])); if (l31 == i) best[r] = m; c0[r] = (c0[r] == m) ? IMIN : c0[r]; c1[r] = (c1[r] == m) ? IMIN : c1[r]; }
        }
#pragma unroll
        for (int r = 0; r < 16; ++r) {
            const int posn = 255 - (best[r] & 255), bi = (posn >> 4) & 15, bj = posn & 15;
            const int n1 = 127 - (__shfl(tops[0][r], base + bi) & 127), n2 = 127 - (__shfl(tops[1][r], base + bj) & 127);
            const float sv = ord_val(best[r] & ~255), smax = ord_val(hmax32(best[r]) & ~255);
            const float e = (l31 < 16) ? __expf(sv - smax) : 0.f; const float es = hsum32(e);
            const int token = tok0 + (r & 3) + 8 * (r >> 2) + 4 * hi;
            if (l31 < 16) { EXP[(size_t)token * 128 + h * 16 + l31] = n1 * 128 + n2; GATE[(size_t)token * 128 + h * 16 + l31] = e / es; }
        }
    }
}

typedef float f32x2 __attribute__((ext_vector_type(2)));
constexpr float PEER_SU = 512.0f, PEER_SV = 32.0f;
template <int D> __device__ __forceinline__ void tr_step(float (&part)[64], int lane) {
    const bool up_ = (lane & D) != 0;
#pragma unroll
    for (int i = 0; i < D; ++i) { const float a = part[i], b = part[i + D]; const float send = up_ ? a : b, keep = up_ ? b : a; part[i] = keep + __shfl_xor(send, D); }
}
__device__ __forceinline__ void peer_phase(const Ctx& F, const unsigned char* U8, const unsigned char* V8, const bf16* X1B, const int* EXP, const float* GATE, const unsigned long long* SS, const float* gfin, const float* X1, float* OUT) {
    const int gw = F.vcu * NWAVES + F.wave, NGW = F.G * NWAVES, lane = F.lane;
    constexpr int NPF = 8;
    for (int t = gw; t < M; t += NGW) {
        const int e01[2] = { EXP[(size_t)t * 128 + lane], EXP[(size_t)t * 128 + 64 + lane] };
        const float g01[2] = { GATE[(size_t)t * 128 + lane], GATE[(size_t)t * 128 + 64 + lane] };
        const float rinv2 = pg8::rinv_from_ss(SS[t]) * (1.0f / PEER_SU);
        f32x2 xv[16];
#pragma unroll
        for (int i = 0; i < 2; ++i)
#pragma unroll
            for (int hv = 0; hv < 2; ++hv) { const v4u w = *(const GAS v4u*)(X1B + (size_t)t * DM + i * 1024 + lane * 16 + 8 * hv);
                xv[8 * i + 4 * hv + 0] = (f32x2){bflo(w.x), bfhi(w.x)}; xv[8 * i + 4 * hv + 1] = (f32x2){bflo(w.y), bfhi(w.y)}; xv[8 * i + 4 * hv + 2] = (f32x2){bflo(w.z), bfhi(w.z)}; xv[8 * i + 4 * hv + 3] = (f32x2){bflo(w.w), bfhi(w.w)}; }
        float act[2];
#pragma unroll
        for (int hf = 0; hf < 2; ++hf) {
            const int ev = e01[hf];
            float part[64]; v4u ub[NPF][2];
#pragma unroll
            for (int k = 0; k < NPF; ++k) { const GAS v4u* up = (const GAS v4u*)(U8 + (size_t)__builtin_amdgcn_readlane(ev, k) * 2048) + lane; ub[k][0] = up[0]; ub[k][1] = up[64]; }
#pragma unroll
            for (int k = 0; k < 64; ++k) {
                f32x2 p0 = {0.f, 0.f}, p1 = {0.f, 0.f};
#pragma unroll
                for (int i = 0; i < 2; ++i) { const v4u w = ub[k % NPF][i];
                    p0 += __builtin_amdgcn_cvt_pk_f32_fp8((int)w.x, false) * xv[8 * i + 0]; p1 += __builtin_amdgcn_cvt_pk_f32_fp8((int)w.x, true) * xv[8 * i + 1];
                    p0 += __builtin_amdgcn_cvt_pk_f32_fp8((int)w.y, false) * xv[8 * i + 2]; p1 += __builtin_amdgcn_cvt_pk_f32_fp8((int)w.y, true) * xv[8 * i + 3];
                    p0 += __builtin_amdgcn_cvt_pk_f32_fp8((int)w.z, false) * xv[8 * i + 4]; p1 += __builtin_amdgcn_cvt_pk_f32_fp8((int)w.z, true) * xv[8 * i + 5];
                    p0 += __builtin_amdgcn_cvt_pk_f32_fp8((int)w.w, false) * xv[8 * i + 6]; p1 += __builtin_amdgcn_cvt_pk_f32_fp8((int)w.w, true) * xv[8 * i + 7]; }
                part[k] = (p0[0] + p0[1]) + (p1[0] + p1[1]);
                if (k + NPF < 64) { const GAS v4u* up = (const GAS v4u*)(U8 + (size_t)__builtin_amdgcn_readlane(ev, k + NPF) * 2048) + lane; ub[k % NPF][0] = up[0]; ub[k % NPF][1] = up[64]; }
            }
            tr_step<32>(part, lane); tr_step<16>(part, lane); tr_step<8>(part, lane); tr_step<4>(part, lane); tr_step<2>(part, lane); tr_step<1>(part, lane);
            act[hf] = gelu_tanh(part[0] * rinv2) * g01[hf] * (1.0f / PEER_SV);
        }
        f32x2 y[16];
#pragma unroll
        for (int j = 0; j < 16; ++j) y[j] = (f32x2){0.f, 0.f};
#pragma unroll
        for (int hf = 0; hf < 2; ++hf) {
            const int ev = e01[hf]; const float av = act[hf];
            v4u vb[NPF][2];
#pragma unroll
            for (int k = 0; k < NPF; ++k) { const GAS v4u* vp = (const GAS v4u*)(V8 + (size_t)__builtin_amdgcn_readlane(ev, k) * 2048) + lane; vb[k][0] = vp[0]; vb[k][1] = vp[64]; }
#pragma unroll
            for (int k = 0; k < 64; ++k) {
                const float s = rdlane(av, k); const f32x2 s2 = {s, s};
#pragma unroll
                for (int i = 0; i < 2; ++i) { const v4u w = vb[k % NPF][i];
                    y[8 * i + 0] += s2 * __builtin_amdgcn_cvt_pk_f32_fp8((int)w.x, false); y[8 * i + 1] += s2 * __builtin_amdgcn_cvt_pk_f32_fp8((int)w.x, true);
                    y[8 * i + 2] += s2 * __builtin_amdgcn_cvt_pk_f32_fp8((int)w.y, false); y[8 * i + 3] += s2 * __builtin_amdgcn_cvt_pk_f32_fp8((int)w.y, true);
                    y[8 * i + 4] += s2 * __builtin_amdgcn_cvt_pk_f32_fp8((int)w.z, false); y[8 * i + 5] += s2 * __builtin_amdgcn_cvt_pk_f32_fp8((int)w.z, true);
                    y[8 * i + 6] += s2 * __builtin_amdgcn_cvt_pk_f32_fp8((int)w.w, false); y[8 * i + 7] += s2 * __builtin_amdgcn_cvt_pk_f32_fp8((int)w.w, true); }
                if (k + NPF < 64) { const GAS v4u* vp = (const GAS v4u*)(V8 + (size_t)__builtin_amdgcn_readlane(ev, k + NPF) * 2048) + lane; vb[k % NPF][0] = vp[0]; vb[k % NPF][1] = vp[64]; }
            }
        }
        const GAS f32x4* xr = (const GAS f32x4*)(X1 + (size_t)t * DM); GAS f32x4* orw = (GAS f32x4*)(OUT + (size_t)t * DM); float ss = 0.f;
#pragma unroll
        for (int i = 0; i < 2; ++i)
#pragma unroll
            for (int q = 0; q < 4; ++q) { const f32x4 a = xr[i * 256 + 4 * lane + q]; y[8 * i + 2 * q] += (f32x2){a[0], a[1]}; y[8 * i + 2 * q + 1] += (f32x2){a[2], a[3]}; }
#pragma unroll
        for (int j = 0; j < 16; ++j) ss += y[j][0] * y[j][0] + y[j][1] * y[j][1];
        const float r3 = 1.0f / sqrtf(wave_sum(ss) * (1.0f / DM) + RMS_EPS);
#pragma unroll
        for (int i = 0; i < 2; ++i)
#pragma unroll
            for (int q = 0; q < 4; ++q) { const f32x4 ga = *(const GAS f32x4*)(gfin + i * 1024 + lane * 16 + 4 * q);
                orw[i * 256 + 4 * lane + q] = (f32x4){y[8 * i + 2 * q][0] * r3 * ga[0], y[8 * i + 2 * q][1] * r3 * ga[1], y[8 * i + 2 * q + 1][0] * r3 * ga[2], y[8 * i + 2 * q + 1][1] * r3 * ga[3]}; }
    }
}

struct Args { const float* in[15]; float* out; unsigned char* ws; double invf[16]; int ph_lo, ph_hi, li, pad; };
__global__ void __launch_bounds__(NWAVES * 64, 2) mk_fwd(Args args) {
    extern __shared__ __attribute__((aligned(16))) unsigned char lds[];
    Ctx F;
    F.lds = (LAS unsigned char*)lds;
    volatile LAS unsigned* MISC = (volatile LAS unsigned*)(F.lds + MISC_OFF);
    F.tid = threadIdx.x; F.lane = F.tid & 63; F.wave = __builtin_amdgcn_readfirstlane(F.tid >> 6);
    F.G = gridDim.x; { const int bx = blockIdx.x; F.vcu = (F.G % 8 == 0) ? (bx % 8) * (F.G / 8) + bx / 8 : bx; }
    unsigned char* ws = args.ws;
    gu32* ctl = (gu32*)(ws + WS_CTL);
    for (int u = F.tid; u < (LDS_BYTES - LDSCTL_OFF) / 4; u += NWAVES * 64) ((LAS unsigned*)(F.lds + LDSCTL_OFF))[u] = 0u;
    __syncthreads();
    XcdBarrier bar; bar.bar = (unsigned*)(ctl + CW_BAR); bar.x = 0; bar.st = nullptr;
    if (N_LAUNCHES != PER_PHASE) bar = xcd_barrier_post((unsigned*)(ctl + CW_BAR), MISC + 8);
#define GRID_BAR() do { if (N_LAUNCHES != PER_PHASE) xcd_barrier(bar); } while (0)
    const int lo = args.ph_lo, hi = args.ph_hi;
#define IN(k) (lo <= (k) && (k) < hi)
#define BOTH(k) (IN(k) && IN((k) + 1))
    bf16* WinT = (bf16*)(ws + WS_WIN); bf16* WbcT = (bf16*)(ws + WS_WBC); bf16* WbaT = (bf16*)(ws + WS_WBA); bf16* WoutT = (bf16*)(ws + WS_WOUT); bf16* WpqT = (bf16*)(ws + WS_WPQ);
    bf16* KEYS = (bf16*)(ws + WS_KEYS); float* CS = (float*)(ws + WS_CS); const unsigned char* UB = ws + WS_UB; const unsigned char* VB = ws + WS_VB;
    bf16* XB = (bf16*)(ws + WS_XB); bf16* T6 = (bf16*)(ws + WS_T6); bf16* GAB = (bf16*)(ws + WS_GAB); bf16* UC = (bf16*)(ws + WS_UC); bf16* AO = (bf16*)(ws + WS_AO);
    bf16* TMP = (bf16*)(ws + WS_TMP); bf16* MB = (bf16*)(ws + WS_MB); bf16* X1B = (bf16*)(ws + WS_X1B); bf16* QP = (bf16*)(ws + WS_QP);
    int* EXP = (int*)(ws + WS_EXP); float* GATE = (float*)(ws + WS_GATE);
    unsigned long long* SS = (unsigned long long*)(ws + WS_SS); float* KSUM = (float*)(ws + WS_KSUM);
    constexpr size_t TS = (size_t)M * 1024;

    if (IN(0)) { for (int rep = 0; rep < NREP(0); ++rep) { p0_prologue(F, args.in, ws, args.invf); if (rep + 1 < NREP(0)) GRID_BAR(); } if (BOTH(0)) GRID_BAR(); }
    if (IN(1)) {
        for (int rep = 0; rep < NREP(1); ++rep) {
        pg8::Gemm g{XB, WinT, M, INW, DM}; pg8::StaticOrder S; S.init(M, INW, F.G, (int)blockIdx.x);
        pg8::EpiIn E{T6, GAB, args.in[4], CS, KSUM};
        pg8::gemm_phase<pg8::EpiIn, pg8::StaticOrder, true, true>(F.lds + RING_OFF, g, S, E);
        if (rep + 1 < NREP(1)) GRID_BAR(); }
        if (BOTH(1)) GRID_BAR();
    }
    if (IN(2)) {
        for (int rep = 0; rep < NREP(2); ++rep) {
        attn_mfma(F, T6 + 3 * TS, T6 + 4 * TS, T6 + 5 * TS, KSUM, AO);
        conv_phase(F, T6, T6 + TS, T6 + 2 * TS, args.in[5], UC);
        if (rep + 1 < NREP(2)) GRID_BAR(); }
        if (BOTH(2)) GRID_BAR();
    }
    if (IN(3)) {
        for (int rep = 0; rep < NREP(3); ++rep) {
        pg8::Gemm g{UC, WbcT, M, DM, 1024}; pg8::StaticOrder S; S.init(M, DM, F.G, (int)blockIdx.x);
        pg8::EpiTmp E{GAB, TMP};
        pg8::gemm_phase<pg8::EpiTmp, pg8::StaticOrder, true, true>(F.lds + RING_OFF, g, S, E);
        if (rep + 1 < NREP(3)) GRID_BAR(); }
        if (BOTH(3)) GRID_BAR();
    }
    if (IN(4)) {
        for (int rep = 0; rep < NREP(4); ++rep) {
        pg8::Gemm g{AO, WbaT, M, DM, 1024}; pg8::StaticOrder S; S.init(M, DM, F.G, (int)blockIdx.x);
        pg8::EpiMerge E{GAB + (size_t)M * DM, TMP, MB};
        pg8::gemm_phase<pg8::EpiMerge, pg8::StaticOrder, true, true>(F.lds + RING_OFF, g, S, E);
        if (rep + 1 < NREP(4)) GRID_BAR(); }
        if (BOTH(4)) GRID_BAR();
    }
    if (IN(5)) {
        for (int rep = 0; rep < NREP(5); ++rep) {
        pg8::Gemm g{MB, WoutT, M, DM, DM}; pg8::StaticOrder S; S.init(M, DM, F.G, (int)blockIdx.x);
        pg8::EpiX1 E{args.in[0], args.out, X1B, (rep + 1 < NREP(5)) ? (unsigned long long*)(ws + 768 * 1024) : SS};
        pg8::gemm_phase<pg8::EpiX1, pg8::StaticOrder, true, true>(F.lds + RING_OFF, g, S, E);
        if (rep + 1 < NREP(5)) GRID_BAR(); }
        if (BOTH(5)) GRID_BAR();
    }
    if (IN(6)) {
        for (int rep = 0; rep < NREP(6); ++rep) {
        pg8::Gemm g{X1B, WpqT, M, DM, DM}; pg8::StaticOrder S; S.init(M, DM, F.G, (int)blockIdx.x);
        pg8::EpiQP E{SS, QP};
        pg8::gemm_phase<pg8::EpiQP, pg8::StaticOrder, true, true>(F.lds + RING_OFF, g, S, E);
        if (rep + 1 < NREP(6)) GRID_BAR(); }
        if (BOTH(6)) GRID_BAR();
    }
    if (IN(7)) { for (int rep = 0; rep < NREP(7); ++rep) { topk_phase(F, QP, KEYS, EXP, GATE); if (rep + 1 < NREP(7)) GRID_BAR(); } if (BOTH(7)) GRID_BAR(); }
    if (IN(8)) { for (int rep = 0; rep < NREP(8); ++rep) { peer_phase(F, UB, VB, X1B, EXP, GATE, SS, args.in[14], args.out, (rep + 1 < NREP(8)) ? (float*)(ws + WS_END) : args.out); if (rep + 1 < NREP(8)) GRID_BAR(); } }
#undef IN
#undef BOTH
#undef GRID_BAR
}

extern "C" void kernel_launch(void* const* d_in, const int* in_sizes, int n_in, void* d_out, int out_size, void* d_ws, size_t ws_size, hipStream_t stream) {
    static int grid = 0;
    if (grid == 0) {
        if (n_in != 15 || in_sizes[0] != M * DM || out_size != M * DM || ws_size < WS_END) { fprintf(stderr, "kernel_launch: unexpected shapes (n_in %d, in0 %d, out %d, ws %zu)\n", n_in, n_in > 0 ? in_sizes[0] : -1, out_size, ws_size); grid = -1; return; }
        int dev = 0, cus = 0, per_cu = 0;
        if (hipGetDevice(&dev) != hipSuccess || hipDeviceGetAttribute(&cus, hipDeviceAttributeMultiprocessorCount, dev) != hipSuccess) { grid = -1; return; }
        if (hipFuncSetAttribute((const void*)mk_fwd, hipFuncAttributeMaxDynamicSharedMemorySize, LDS_BYTES) != hipSuccess) { fprintf(stderr, "kernel_launch: hipFuncSetAttribute failed\n"); grid = -1; return; }
        if (hipOccupancyMaxActiveBlocksPerMultiprocessor(&per_cu, (const void*)mk_fwd, NWAVES * 64, LDS_BYTES) != hipSuccess || per_cu < 1) fprintf(stderr, "kernel_launch: occupancy query reports %d\n", per_cu);
        (void)hipGetLastError();
        grid = cus;
    }
    if (grid < 0) return;
    if (hipMemsetAsync((char*)d_ws + WS_CTL, 0, CTL_ZERO_BYTES, stream) != hipSuccess) { fprintf(stderr, "kernel_launch: memset failed\n"); return; }
    Args a{};
    for (int i = 0; i < 15; ++i) a.in[i] = (const float*)d_in[i];
    a.out = (float*)d_out; a.ws = (unsigned char*)d_ws;
    for (int f = 0; f < 16; ++f) a.invf[f] = pow(500000.0, -(double)(2 * f) / 32.0);
    for (int li = 0; li < N_LAUNCHES; ++li) {
        a.ph_lo = (N_LAUNCHES == PER_PHASE) ? li : 0; a.ph_hi = (N_LAUNCHES == PER_PHASE) ? li + 1 : PER_PHASE; a.li = li;
        hipLaunchKernelGGL(mk_fwd, dim3(grid), dim3(NWAVES * 64), LDS_BYTES, stream, a);
        const hipError_t le = hipPeekAtLastError();
        if (le != hipSuccess) { fprintf(stderr, "kernel_launch: launch %d failed: %s\n", li, hipGetErrorName(le)); break; }
    }
}
```

```cpp
#include <hip/hip_runtime.h>
#include <cstdio>
#include <cstdint>
#include <cmath>
namespace pg8 {
#define PG8_LAS __attribute__((address_space(3)))
typedef unsigned short bf16_t;
typedef short bf16x8 __attribute__((ext_vector_type(8)));
typedef float f32x4 __attribute__((ext_vector_type(4)));
typedef unsigned u32x4 __attribute__((ext_vector_type(4)));
constexpr int BM = 256, BK = 64, HALF = 128, HTB = HALF * BK * 2  , STAGE_BYTES = 8 * HTB, NXCD = 8, WGM = 8;

__host__ __device__ __forceinline__ int lds_byte(int r, int c) { const int st = (r >> 4) * 2 + (c >> 5), rr = r & 15, cc = c & 31, ob = rr * 64 + cc * 2; return st * 1024 + (ob ^ (((ob >> 9) & 1) << 5)); }
__host__ __device__ __forceinline__ void stage_rc(int b, int& R, int& C) { const int st = b / 1024, sb = b % 1024, swz = sb ^ (((sb >> 9) & 1) << 5); R = (st >> 1) * 16 + swz / 64; C = (st & 1) * 32 + (swz % 64) / 2; }
__host__ __device__ __forceinline__ int perm32(int rho) { const int n = rho >> 4, i = rho & 15; return 8 * (i >> 2) + 4 * n + (i & 3); }

struct Unit { int pm, pn; };
struct Gemm { const bf16_t* A; const bf16_t* Bt; int M, N, K; };

struct StaticOrder {
    int nM, nN, nwg, G, c;
    __host__ __device__ void init(int M, int N, int G_, int c_) { nM = M / BM; nN = N / BM; nwg = nM * nN; G = G_; c = c_; }
    __host__ __device__ bool next(int i, Unit& u) const {
        const long L = (long)i * G + c; if (L >= nwg) return false;
        int wgid = (int)L; { const int q = nwg / NXCD, r = nwg % NXCD, xcd = wgid % NXCD, off = wgid / NXCD; wgid = (xcd < r ? xcd * (q + 1) : r * (q + 1) + (xcd - r) * q) + off; }
        const int nig = WGM * nN, gid = wgid / nig, fm = gid * WGM, gsz = (nM - fm) < WGM ? (nM - fm) : WGM;
        u.pm = fm + ((wgid % nig) % gsz); u.pn = (wgid % nig) / gsz; return true;
    }
    __device__ __forceinline__ void a_ready(const Unit&) const {}
    __device__ __forceinline__ void done(const Unit&) const {}
};


typedef float f32x2c __attribute__((ext_vector_type(2))); typedef __bf16 bf16x2c __attribute__((ext_vector_type(2)));
__device__ __forceinline__ unsigned cvt_pk_bf16(float lo, float hi) { const f32x2c v = {lo, hi}; const bf16x2c b = __builtin_convertvector(v, bf16x2c); return __builtin_bit_cast(unsigned, b); }
__device__ __forceinline__ u32x4 pack8(f32x4 a, f32x4 b) { u32x4 w; w.x = cvt_pk_bf16(a[0], a[1]); w.y = cvt_pk_bf16(a[2], a[3]); w.z = cvt_pk_bf16(b[0], b[1]); w.w = cvt_pk_bf16(b[2], b[3]); return w; }
__device__ __forceinline__ f32x4 shx(f32x4 v, int o) { f32x4 r; r[0] = __shfl_xor(v[0], o); r[1] = __shfl_xor(v[1], o); r[2] = __shfl_xor(v[2], o); r[3] = __shfl_xor(v[3], o); return r; }
__device__ __forceinline__ f32x4 bf4lo(unsigned a, unsigned b) { f32x4 r; r[0] = __uint_as_float(a << 16); r[1] = __uint_as_float(a & 0xffff0000u); r[2] = __uint_as_float(b << 16); r[3] = __uint_as_float(b & 0xffff0000u); return r; }
__device__ __forceinline__ f32x4 sigm4(f32x4 v) { f32x4 r;
#pragma unroll
    for (int i = 0; i < 4; ++i) r[i] = __builtin_amdgcn_rcpf(1.0f + __expf(-v[i])); return r; }
constexpr float QSCALE = 0.08838834764831845f * 1.4426950408889634f;

struct EpiIn {
    static constexpr bool PERM = true, AFTER_DRAIN = false;
    bf16_t* T6; bf16_t* GAB; const float* gbias; const float* cs; float* ksum;
    __device__ __forceinline__ void operator()(const f32x4 (&acc)[2][2][4][2], const Unit& u, int wr, int wc, int fr, int fq) const {
        const int row0 = u.pm * BM + wr * 64 + fr, pn = u.pn, colw = wc * 32 + 8 * fq;
        if (pn < 24) {
            const int t = pn >> 2;
            bf16_t* base = T6 + (size_t)t * ((size_t)8192 * 1024) + (pn & 3) * 256 + colw;
            const bool rot = (t == 3 || t == 4) && (wc == 0), isk = (t == 4);
            const float qs = (t == 3) ? QSCALE : 1.0f;
            f32x4 ks[2][2];
#pragma unroll
            for (int bj = 0; bj < 2; ++bj) { ks[bj][0] = (f32x4){0.f, 0.f, 0.f, 0.f}; ks[bj][1] = (f32x4){0.f, 0.f, 0.f, 0.f}; }
#pragma unroll
            for (int ai = 0; ai < 2; ++ai)
#pragma unroll
                for (int m = 0; m < 4; ++m) {
                    const int row = row0 + ai * HALF + m * 16;
                    f32x4 c0 = (f32x4){1.f, 1.f, 1.f, 1.f}, c1 = c0, s0 = (f32x4){0.f, 0.f, 0.f, 0.f}, s1 = s0;
                    if (rot) { const float* cp = cs + (size_t)row * 32 + 8 * (fq & 1); c0 = *(const f32x4*)cp; c1 = *(const f32x4*)(cp + 4); s0 = *(const f32x4*)(cp + 16); s1 = *(const f32x4*)(cp + 20);
                        if (fq < 2) { s0 = -s0; s1 = -s1; } }
#pragma unroll
                    for (int bj = 0; bj < 2; ++bj) {
                        f32x4 v0 = acc[ai][bj][m][0], v1 = acc[ai][bj][m][1];
                        if (rot) { const f32x4 p0 = shx(v0, 32), p1 = shx(v1, 32); v0 = v0 * c0 + p0 * s0; v1 = v1 * c1 + p1 * s1; }
                        if (isk) { ks[bj][0] += v0; ks[bj][1] += v1; }
                        v0 = v0 * qs; v1 = v1 * qs;
                        *(u32x4*)(base + (size_t)row * 1024 + bj * HALF) = pack8(v0, v1);
                    }
                }
            if (isk) {
#pragma unroll
                for (int bj = 0; bj < 2; ++bj)
#pragma unroll
                    for (int n = 0; n < 2; ++n) { f32x4 v = ks[bj][n]; v += shx(v, 1); v += shx(v, 2); v += shx(v, 4); v += shx(v, 8);
                        if (fr == 0) { float* kp = ksum + (size_t)u.pm * 1024 + (pn & 3) * 256 + bj * HALF + colw + 4 * n;
                            unsafeAtomicAdd(kp + 0, v[0]); unsafeAtomicAdd(kp + 1, v[1]); unsafeAtomicAdd(kp + 2, v[2]); unsafeAtomicAdd(kp + 3, v[3]); } }
            }
        } else {
            const int t = (pn - 24) >> 3, colg = ((pn - 24) & 7) * 256 + colw;
            bf16_t* base = GAB + (size_t)t * ((size_t)8192 * 2048) + colg;
            const float* bp = gbias + t * 2048 + colg;
            f32x4 bv[2][2];
#pragma unroll
            for (int bj = 0; bj < 2; ++bj) { bv[bj][0] = *(const f32x4*)(bp + bj * HALF); bv[bj][1] = *(const f32x4*)(bp + bj * HALF + 4); }
#pragma unroll
            for (int ai = 0; ai < 2; ++ai)
#pragma unroll
                for (int m = 0; m < 4; ++m) { const int row = row0 + ai * HALF + m * 16;
#pragma unroll
                    for (int bj = 0; bj < 2; ++bj) *(u32x4*)(base + (size_t)row * 2048 + bj * HALF) = pack8(sigm4(acc[ai][bj][m][0] + bv[bj][0]), sigm4(acc[ai][bj][m][1] + bv[bj][1])); }
        }
    }
};
struct EpiTmp {
    static constexpr bool PERM = true, AFTER_DRAIN = false;
    const bf16_t* G; bf16_t* O;
    __device__ __forceinline__ void operator()(const f32x4 (&acc)[2][2][4][2], const Unit& u, int wr, int wc, int fr, int fq) const {
        const int row0 = u.pm * BM + wr * 64 + fr, col0 = u.pn * BM + wc * 32 + 8 * fq;
#pragma unroll
        for (int ai = 0; ai < 2; ++ai)
#pragma unroll
            for (int m = 0; m < 4; ++m) { const size_t off = (size_t)(row0 + ai * HALF + m * 16) * 2048 + col0;
#pragma unroll
                for (int bj = 0; bj < 2; ++bj) { const u32x4 g = *(const u32x4*)(G + off + bj * HALF);
                    *(u32x4*)(O + off + bj * HALF) = pack8(acc[ai][bj][m][0] * bf4lo(g.x, g.y), acc[ai][bj][m][1] * bf4lo(g.z, g.w)); } }
    }
};
struct EpiMerge {
    static constexpr bool PERM = true, AFTER_DRAIN = false;
    const bf16_t* G; const bf16_t* TMP; bf16_t* O;
    __device__ __forceinline__ void operator()(const f32x4 (&acc)[2][2][4][2], const Unit& u, int wr, int wc, int fr, int fq) const {
        const int row0 = u.pm * BM + wr * 64 + fr, col0 = u.pn * BM + wc * 32 + 8 * fq;
#pragma unroll
        for (int ai = 0; ai < 2; ++ai)
#pragma unroll
            for (int m = 0; m < 4; ++m) { const size_t off = (size_t)(row0 + ai * HALF + m * 16) * 2048 + col0;
#pragma unroll
                for (int bj = 0; bj < 2; ++bj) { const u32x4 g = *(const u32x4*)(G + off + bj * HALF), t = *(const u32x4*)(TMP + off + bj * HALF);
                    *(u32x4*)(O + off + bj * HALF) = pack8(bf4lo(t.x, t.y) + acc[ai][bj][m][0] * bf4lo(g.x, g.y), bf4lo(t.z, t.w) + acc[ai][bj][m][1] * bf4lo(g.z, g.w)); } }
    }
};
struct EpiX1 {
    static constexpr bool PERM = true, AFTER_DRAIN = false;
    const float* X; float* X1; bf16_t* X1B; unsigned long long* SS;
    __device__ __forceinline__ void operator()(const f32x4 (&acc)[2][2][4][2], const Unit& u, int wr, int wc, int fr, int fq) const {
        const int row0 = u.pm * BM + wr * 64 + fr, col0 = u.pn * BM + wc * 32 + 8 * fq;
#pragma unroll
        for (int ai = 0; ai < 2; ++ai)
#pragma unroll
            for (int m = 0; m < 4; ++m) { const int row = row0 + ai * HALF + m * 16; const size_t off = (size_t)row * 2048 + col0; float sq = 0.f;
#pragma unroll
                for (int bj = 0; bj < 2; ++bj) { const f32x4 v0 = acc[ai][bj][m][0] + *(const f32x4*)(X + off + bj * HALF), v1 = acc[ai][bj][m][1] + *(const f32x4*)(X + off + bj * HALF + 4);
                    *(f32x4*)(X1 + off + bj * HALF) = v0; *(f32x4*)(X1 + off + bj * HALF + 4) = v1; *(u32x4*)(X1B + off + bj * HALF) = pack8(v0, v1);
                    sq += (v0[0] * v0[0] + v0[1] * v0[1]) + (v0[2] * v0[2] + v0[3] * v0[3]) + (v1[0] * v1[0] + v1[1] * v1[1]) + (v1[2] * v1[2] + v1[3] * v1[3]); }
                sq += __shfl_xor(sq, 16); sq += __shfl_xor(sq, 32);
                if (fq == 0) atomicAdd(SS + row, (unsigned long long)(sq * 4294967296.0f)); }
    }
};
__device__ __forceinline__ float rinv_from_ss(unsigned long long s) { return 1.0f / sqrtf((float)((double)s * (1.0 / 4294967296.0) * (1.0 / 2048.0)) + 1e-6f); }
struct EpiQP {
    static constexpr bool PERM = true, AFTER_DRAIN = false;
    const unsigned long long* SS; bf16_t* O;
    __device__ __forceinline__ void operator()(const f32x4 (&acc)[2][2][4][2], const Unit& u, int wr, int wc, int fr, int fq) const {
        const int row0 = u.pm * BM + wr * 64 + fr, col0 = u.pn * BM + wc * 32 + 8 * fq;
#pragma unroll
        for (int ai = 0; ai < 2; ++ai)
#pragma unroll
            for (int m = 0; m < 4; ++m) { const int row = row0 + ai * HALF + m * 16; const size_t off = (size_t)row * 2048 + col0; const float rv = rinv_from_ss(SS[row]);
#pragma unroll
                for (int bj = 0; bj < 2; ++bj) *(u32x4*)(O + off + bj * HALF) = pack8(acc[ai][bj][m][0] * rv, acc[ai][bj][m][1] * rv); }
    }
};

template <class Epi, class Sched, bool ALIGN_EPI = false, bool SP2 = false>
__device__ __forceinline__ void gemm_phase(PG8_LAS unsigned char* lds, const Gemm g, const Sched& S, const Epi& E) {
    const int tid = threadIdx.x, wid = __builtin_amdgcn_readfirstlane(tid >> 6), lane = tid & 63, wr = wid >> 2, wc = wid & 3, fr = lane & 15, fq = lane >> 4;
    const int K = g.K, nt = K / BK;
    unsigned voffA[2], voffB[2];
#pragma unroll
    for (int i = 0; i < 2; ++i) { int R, C; stage_rc(tid * 16 + i * 8192, R, C); const int Rb = Epi::PERM ? ((R & ~31) + perm32(R & 31)) : R;
        voffA[i] = (unsigned)(R * K + C) * 2u; voffB[i] = (unsigned)(Rb * K + C) * 2u; }
    const size_t kstep = (size_t)(BK * 2);
    const size_t hstep = (size_t)HALF * K * 2;
    const size_t tstep = 2 * hstep;
    const unsigned ldsw = (unsigned)wid * 1024u;
    const int aoff = lds_byte(wr * 64 + fr, fq * 8), boff = lds_byte(wc * 32 + fr, fq * 8);
#define PG8_SA(b, h) (((b) * 2 + (h)) * HTB)
#define PG8_SB(b, h) ((4 + (b) * 2 + (h)) * HTB)
#define PG8_STAGE(bufoff, gbase, voff) do { _Pragma("unroll") for (int _i = 0; _i < 2; ++_i) \
        __builtin_amdgcn_global_load_lds((const unsigned*)((const char*)(gbase) + (voff)[_i]), (PG8_LAS unsigned*)(lds + (bufoff) + ldsw + _i * 8192), 16, 0, 0); } while (0)
#define PG8_LDA(dst, b, h) do { _Pragma("unroll") for (int m = 0; m < 4; ++m) _Pragma("unroll") for (int k = 0; k < 2; ++k) dst[m][k] = *(const PG8_LAS bf16x8*)(lds + PG8_SA(b, h) + aoff + m * 2048 + k * 1024); } while (0)
#define PG8_LDB(dst, b, h) do { _Pragma("unroll") for (int n = 0; n < 2; ++n) _Pragma("unroll") for (int k = 0; k < 2; ++k) dst[n][k] = *(const PG8_LAS bf16x8*)(lds + PG8_SB(b, h) + boff + n * 2048 + k * 1024); } while (0)
#define PG8_MMA(ai, bj, At, Bt) do { __builtin_amdgcn_s_setprio(1); _Pragma("unroll") for (int m = 0; m < 4; ++m) _Pragma("unroll") for (int n = 0; n < 2; ++n) _Pragma("unroll") for (int k = 0; k < 2; ++k) \
        acc[ai][bj][m][n] = __builtin_amdgcn_mfma_f32_16x16x32_bf16(Bt[n][k], At[m][k], acc[ai][bj][m][n], 0, 0, 0); __builtin_amdgcn_s_setprio(0); } while (0)
#define PG8_WAIT_V(n) asm volatile("s_waitcnt vmcnt(" #n ")" ::: "memory")
#define PG8_WAIT_L(n) asm volatile("s_waitcnt lgkmcnt(" #n ")" ::: "memory")
#define PG8_BAR __builtin_amdgcn_s_barrier()
#define PG8_SCHED __builtin_amdgcn_sched_barrier(0)
    Unit cur, nxt; int ui = 0;
    if (!S.next(0, cur)) return;
    f32x4 acc[2][2][4][2];
#pragma unroll
    for (int a = 0; a < 2; ++a)
#pragma unroll
        for (int b = 0; b < 2; ++b)
#pragma unroll
            for (int m = 0; m < 4; ++m)
#pragma unroll
                for (int n = 0; n < 2; ++n) acc[a][b][m][n] = (f32x4){0.f, 0.f, 0.f, 0.f};
    bf16x8 At[4][2], B0[2][2], B1[2][2];
    const char* cA = (const char*)g.A + (size_t)cur.pm * tstep; const char* cB = (const char*)g.Bt + (size_t)cur.pn * tstep;
    S.a_ready(cur);
    if constexpr (SP2) {
        PG8_STAGE(PG8_SB(0, 0), cB, voffB); PG8_STAGE(PG8_SB(0, 1), cB + hstep, voffB); PG8_STAGE(PG8_SA(0, 0), cA, voffA); PG8_STAGE(PG8_SA(0, 1), cA + hstep, voffA);
        if (wr == 1) PG8_BAR;
        PG8_WAIT_V(2); PG8_BAR;
        PG8_STAGE(PG8_SB(1, 0), cB + kstep, voffB); PG8_STAGE(PG8_SA(1, 0), cA + kstep, voffA); PG8_STAGE(PG8_SB(1, 1), cB + hstep + kstep, voffB);
        PG8_WAIT_V(6); PG8_BAR;
    } else {
        PG8_STAGE(PG8_SB(0, 0), cB, voffB); PG8_STAGE(PG8_SA(0, 0), cA, voffA); PG8_STAGE(PG8_SB(0, 1), cB + hstep, voffB); PG8_STAGE(PG8_SA(0, 1), cA + hstep, voffA);
        if (wr == 1) PG8_BAR;
        PG8_WAIT_V(4); PG8_BAR;
        PG8_STAGE(PG8_SB(1, 0), cB + kstep, voffB); PG8_STAGE(PG8_SA(1, 0), cA + kstep, voffA); PG8_STAGE(PG8_SB(1, 1), cB + hstep + kstep, voffB);
        PG8_WAIT_V(6); PG8_BAR;
    }
    for (;;) {
        const bool has_next = S.next(ui + 1, nxt);
        const char* nA = has_next ? (const char*)g.A + (size_t)nxt.pm * tstep : cA; const char* nB = has_next ? (const char*)g.Bt + (size_t)nxt.pn * tstep : cB;
        for (int t = 0; t < nt; t += 2) {
            const bool last = (t == nt - 2);
            const char* a1 = cA + (size_t)(t + 1) * kstep;
            const char* a2 = last ? nA : cA + (size_t)(t + 2) * kstep; const char* b2 = last ? nB : cB + (size_t)(t + 2) * kstep;
            const char* a3 = a2 + kstep; const char* b3 = b2 + kstep;
            if (last && has_next) S.a_ready(nxt);
            if constexpr (SP2) {
            PG8_LDB(B0, 0, 0); PG8_LDB(B1, 0, 1); PG8_SCHED; PG8_LDA(At, 0, 0); PG8_STAGE(PG8_SA(1, 1), a1 + hstep, voffA);
            PG8_WAIT_V(8); PG8_WAIT_L(0); PG8_BAR; PG8_MMA(0, 0, At, B0); PG8_MMA(0, 1, At, B1); PG8_BAR; PG8_SCHED;
            PG8_LDA(At, 0, 1); PG8_STAGE(PG8_SB(0, 0), b2, voffB); PG8_STAGE(PG8_SB(0, 1), b2 + hstep, voffB); PG8_STAGE(PG8_SA(0, 0), a2, voffA);
            PG8_WAIT_V(8); PG8_WAIT_L(0); PG8_BAR; PG8_MMA(1, 0, At, B0); PG8_MMA(1, 1, At, B1); PG8_BAR; PG8_SCHED;
            PG8_LDB(B0, 1, 0); PG8_LDB(B1, 1, 1); PG8_SCHED; PG8_LDA(At, 1, 0); PG8_STAGE(PG8_SA(0, 1), a2 + hstep, voffA);
            PG8_WAIT_V(8); PG8_WAIT_L(0); PG8_BAR; PG8_MMA(0, 0, At, B0); PG8_MMA(0, 1, At, B1); PG8_BAR; PG8_SCHED;
            PG8_LDA(At, 1, 1); PG8_STAGE(PG8_SB(1, 0), b3, voffB); PG8_STAGE(PG8_SB(1, 1), b3 + hstep, voffB); PG8_STAGE(PG8_SA(1, 0), a3, voffA);
            PG8_WAIT_V(8); PG8_WAIT_L(0); PG8_BAR; PG8_MMA(1, 0, At, B0); PG8_MMA(1, 1, At, B1); PG8_BAR; PG8_SCHED;
            } else {
            PG8_LDB(B0, 0, 0); PG8_SCHED; PG8_LDA(At, 0, 0); PG8_STAGE(PG8_SA(1, 1), a1 + hstep, voffA);
            PG8_WAIT_L(8); PG8_BAR; PG8_WAIT_L(0); PG8_MMA(0, 0, At, B0); PG8_BAR; PG8_SCHED;
            PG8_LDB(B1, 0, 1); PG8_STAGE(PG8_SB(0, 0), b2, voffB);
            PG8_BAR; PG8_WAIT_L(0); PG8_MMA(0, 1, At, B1); PG8_BAR;
            PG8_LDA(At, 0, 1); PG8_STAGE(PG8_SA(0, 0), a2, voffA);
            PG8_BAR; PG8_WAIT_L(0); PG8_MMA(1, 0, At, B0); PG8_BAR; PG8_SCHED;
            PG8_STAGE(PG8_SB(0, 1), b2 + hstep, voffB);
            PG8_WAIT_V(6); PG8_BAR; PG8_MMA(1, 1, At, B1); PG8_BAR;
            PG8_LDB(B0, 1, 0); PG8_SCHED; PG8_LDA(At, 1, 0); PG8_STAGE(PG8_SA(0, 1), a2 + hstep, voffA);
            PG8_WAIT_L(8); PG8_BAR; PG8_WAIT_L(0); PG8_MMA(0, 0, At, B0); PG8_BAR; PG8_SCHED;
            PG8_LDB(B1, 1, 1); PG8_STAGE(PG8_SB(1, 0), b3, voffB);
            PG8_BAR; PG8_WAIT_L(0); PG8_MMA(0, 1, At, B1); PG8_BAR;
            PG8_LDA(At, 1, 1); PG8_STAGE(PG8_SA(1, 0), a3, voffA);
            PG8_BAR; PG8_WAIT_L(0); PG8_MMA(1, 0, At, B0); PG8_BAR; PG8_SCHED;
            PG8_STAGE(PG8_SB(1, 1), b3 + hstep, voffB);
            PG8_WAIT_V(6); PG8_BAR; PG8_MMA(1, 1, At, B1); PG8_BAR;
            }
        }
        if constexpr (ALIGN_EPI) { if (wr == 0) PG8_BAR; }
        if constexpr (!Epi::AFTER_DRAIN) { E(acc, cur, wr, wc, fr, fq); S.done(cur); }
        if (!has_next) break;
#pragma unroll
        for (int a = 0; a < 2; ++a)
#pragma unroll
            for (int b = 0; b < 2; ++b)
#pragma unroll
                for (int m = 0; m < 4; ++m)
#pragma unroll
                    for (int n = 0; n < 2; ++n) acc[a][b][m][n] = (f32x4){0.f, 0.f, 0.f, 0.f};
        cur = nxt; cA = nA; cB = nB; ++ui;
        if constexpr (ALIGN_EPI) { if (wr == 1) PG8_BAR; }
    }
    PG8_WAIT_V(0);
    if constexpr (!ALIGN_EPI) { if (wr == 0) PG8_BAR; }
    PG8_BAR;
    if constexpr (Epi::AFTER_DRAIN) { E.fused(acc, cur, wr, wc, fr, fq, lds, wid, lane); S.done(cur); }
#undef PG8_SA
#undef PG8_SB
#undef PG8_STAGE
#undef PG8_LDA
#undef PG8_LDB
#undef PG8_MMA
#undef PG8_WAIT_V
#undef PG8_WAIT_L
#undef PG8_BAR
#undef PG8_SCHED
}
}

constexpr int NWAVES = 8;
#ifndef MK_N_LAUNCHES
#define MK_N_LAUNCHES 1
#endif
constexpr int PER_PHASE = 9;
#ifndef MK_REP_PHASE
#define MK_REP_PHASE -1
#endif
#define NREP(k) (((k) == MK_REP_PHASE) ? 2 : 1)
constexpr int N_LAUNCHES = MK_N_LAUNCHES;
constexpr int M = 8192, SEQ = 4096, DM = 2048, INW = 10240, NEXP = 16384;
constexpr float RMS_EPS = 1e-6f;
constexpr size_t MiB = 1u << 20;
constexpr size_t WS_CTL = 0, CTL_ZERO_BYTES = 1 * MiB;
constexpr size_t WS_SS = 256 * 1024, WS_KSUM = 512 * 1024;
constexpr size_t WS_WIN = 2 * MiB, WS_WBC = 42 * MiB, WS_WBA = 46 * MiB, WS_WOUT = 50 * MiB, WS_WPQ = 58 * MiB, WS_KEYS = 66 * MiB, WS_CS = 67 * MiB;
constexpr size_t WS_UB = 70 * MiB, WS_VB = 102 * MiB;
constexpr size_t WS_XB = 198 * MiB;
constexpr size_t WS_T6 = 230 * MiB;
constexpr size_t WS_GAB = 326 * MiB;
constexpr size_t WS_UC = 390 * MiB, WS_AO = 406 * MiB;
constexpr size_t WS_EXP = 422 * MiB, WS_GATE = 426 * MiB;
constexpr size_t WS_END = 430 * MiB;
constexpr size_t WS_TMP = WS_XB, WS_MB = WS_T6, WS_X1B = WS_T6 + 48 * MiB, WS_QP = WS_GAB;
constexpr int CW_BAR = 4096;
constexpr int RING_OFF = 0, RING_BYTES = 131072;
constexpr int LDSCTL_OFF = RING_BYTES, MISC_OFF = LDSCTL_OFF + 320;
constexpr int LDS_BYTES = 147456;

#define GAS __attribute__((address_space(1)))
#define LAS __attribute__((address_space(3)))
typedef unsigned short bf16;
typedef unsigned v4u __attribute__((ext_vector_type(4)));
typedef float f32x4 __attribute__((ext_vector_type(4)));
typedef short bf16x8 __attribute__((ext_vector_type(8)));
typedef GAS unsigned gu32;
typedef GAS unsigned long long gu64;
#define RLX_AGENT __ATOMIC_RELAXED, __HIP_MEMORY_SCOPE_AGENT
#define LDS_WAIT() asm volatile("s_waitcnt lgkmcnt(0)" ::: "memory")
#define VM_WAIT() asm volatile("s_waitcnt vmcnt(0)" ::: "memory")
__device__ __forceinline__ unsigned long long rt() { return __builtin_amdgcn_s_memrealtime(); }
__device__ __forceinline__ unsigned f2bf(float f) { unsigned u = __builtin_bit_cast(unsigned, f); return (u + 0x7fffu + ((u >> 16) & 1u)) >> 16; }
__device__ __forceinline__ unsigned pk2(float lo, float hi) { return f2bf(lo) | (f2bf(hi) << 16); }

#define XB_TMO      128
#define XB_XCNT(j)  (256  + 64 * (j))
#define XB_XSUB(j)  (1280 + 64 * (j))
#define XB_XGEN(j)  (2304 + 64 * (j))
#define XB_TOP      3328
#define XB_TOPGEN   3392
#define XCD_BAR_WORDS 3456
#define XB_SPIN_CAP (1u << 18)

__device__ __forceinline__ unsigned xb_ld(unsigned* p)              { return __hip_atomic_load(p, __ATOMIC_RELAXED, __HIP_MEMORY_SCOPE_AGENT); }
__device__ __forceinline__ unsigned xb_add(unsigned* p, unsigned v) { return __hip_atomic_fetch_add(p, v, __ATOMIC_RELAXED, __HIP_MEMORY_SCOPE_AGENT); }
__device__ __forceinline__ unsigned xb_xcc_id() { return (unsigned)__builtin_amdgcn_s_getreg((3 << 11) | 20) & 0xFu; }
#define XB_SPIN(cond, bar) do { unsigned _sp = 0; while (cond) { __builtin_amdgcn_s_sleep(1); \
    if ((++_sp & 255u) == 0u) { if (xb_ld(&(bar)[XB_TMO])) break; if (_sp > XB_SPIN_CAP) { atomicAdd(&(bar)[XB_TMO], 1u); break; } } } } while (0)

struct XcdBarrier {
    unsigned* bar; unsigned x;
    volatile LAS unsigned* st;
};

__device__ __forceinline__ XcdBarrier xcd_barrier_post(unsigned* bar, volatile LAS unsigned* st) {
    XcdBarrier b; b.bar = bar; b.x = xb_xcc_id(); b.st = st;
    if (threadIdx.x == 0) (void)xb_add(&bar[XB_XCNT(b.x)], 1u);
    return b;
}
__device__ __forceinline__ void xcd_barrier_complete(unsigned* bar, unsigned x, unsigned& nloc, unsigned& nx) {
    const unsigned G = gridDim.x * gridDim.y * gridDim.z;
    unsigned sum, cnt, mine, sp = 0u;
    for (;;) {
        sum = 0u; cnt = 0u; mine = 0u;
#pragma unroll
        for (unsigned j = 0; j < 16; ++j) { const unsigned c = xb_ld(&bar[XB_XCNT(j)]); sum += c; cnt += (c > 0u) ? 1u : 0u; mine = (j == x) ? c : mine; }
        if (sum == G) break;
        __builtin_amdgcn_s_sleep(1);
        if ((++sp & 255u) == 0u) { if (xb_ld(&bar[XB_TMO])) break; if (sp > XB_SPIN_CAP) { atomicAdd(&bar[XB_TMO], 1u); break; } }
    }
    nloc = mine > 0u ? mine : 1u; nx = cnt > 0u ? cnt : 1u;
}

__device__ __forceinline__ void xcd_barrier(const XcdBarrier& b) {
    asm volatile("s_waitcnt vmcnt(0)" ::: "memory");
    __syncthreads();
    if (threadIdx.x == 0) {
        unsigned* bar = b.bar;
        __builtin_amdgcn_s_waitcnt(0);
        unsigned nloc = b.st[0], nx = b.st[1];
        if (nloc == 0u) { xcd_barrier_complete(bar, b.x, nloc, nx); b.st[0] = nloc; b.st[1] = nx; }
        const unsigned old = xb_add(&bar[XB_XSUB(b.x)], 1u);
        const unsigned gen = old / nloc;
        if (old + 1u == (gen + 1u) * nloc) {
            __builtin_amdgcn_fence(__ATOMIC_RELEASE, "agent");
            asm volatile("s_waitcnt vmcnt(0)" ::: "memory");
            const unsigned og = xb_add(&bar[XB_TOP], 1u);
            const unsigned tg = og / nx;
            if (og + 1u == (tg + 1u) * nx) xb_add(&bar[XB_TOPGEN], 1u);
            else XB_SPIN(xb_ld(&bar[XB_TOPGEN]) == tg, bar);
            __builtin_amdgcn_fence(__ATOMIC_ACQUIRE, "agent");
            xb_add(&bar[XB_XGEN(b.x)], 1u);
            asm volatile("s_waitcnt vmcnt(0)" ::: "memory");
        } else {
            XB_SPIN(xb_ld(&bar[XB_XGEN(b.x)]) == gen, bar);
            __builtin_amdgcn_fence(__ATOMIC_ACQUIRE, "agent");
            asm volatile("s_waitcnt vmcnt(0)" ::: "memory");
        }
    }
    __syncthreads();
}

typedef __bf16 bf16x2v __attribute__((ext_vector_type(2)));
typedef float f32x16 __attribute__((ext_vector_type(16)));
__device__ __forceinline__ float bflo(unsigned w) { return __uint_as_float(w << 16); }
__device__ __forceinline__ float bfhi(unsigned w) { return __uint_as_float(w & 0xffff0000u); }
__device__ __forceinline__ float dot2bf(unsigned a, unsigned b, float c) { return __builtin_amdgcn_fdot2_f32_bf16(__builtin_bit_cast(bf16x2v, a), __builtin_bit_cast(bf16x2v, b), c, false); }
__device__ __forceinline__ float wave_sum(float v) {
#pragma unroll
    for (int o = 1; o < 64; o <<= 1) v += __shfl_xor(v, o);
    return v; }
__device__ __forceinline__ float wave_max(float v) {
#pragma unroll
    for (int o = 1; o < 64; o <<= 1) v = fmaxf(v, __shfl_xor(v, o));
    return v; }
__device__ __forceinline__ float rdlane(float v, int l) { return __int_as_float(__builtin_amdgcn_readlane(__float_as_int(v), l)); }
__device__ __forceinline__ float gelu_tanh(float x) { const float z = 0.7978845608028654f * (x + 0.044715f * x * x * x); const float e = __expf(2.0f * z); const float th = 1.0f - 2.0f * __builtin_amdgcn_rcpf(1.0f + e); return 0.5f * x * (1.0f + th); }

struct Ctx { LAS unsigned char* lds; int tid, lane, wave, vcu, G; };

__device__ __forceinline__ void p0_transpose_item(const float* W, int K, int N, bf16* WT, const float* gk, LAS float* scr, int item, int lane) {
    const int nblk = N / 32, kb = item / nblk, nb = item % nblk, k0 = 64 * kb, n0 = 32 * nb;
#pragma unroll 8
    for (int i = 0; i < 32; ++i) { const int kk = 2 * i + (lane >> 5); float v = W[(size_t)(k0 + kk) * N + n0 + (lane & 31)]; if (gk) v *= gk[k0 + kk]; scr[kk * 33 + (lane & 31)] = v; }
    LDS_WAIT(); asm volatile("" ::: "memory");
    const int c = lane & 7;
#pragma unroll
    for (int j = 0; j < 4; ++j) { const int n = (lane >> 3) + 8 * j; const LAS float* s = scr + (8 * c) * 33 + n;
        v4u o; o.x = pk2(s[0 * 33], s[1 * 33]); o.y = pk2(s[2 * 33], s[3 * 33]); o.z = pk2(s[4 * 33], s[5 * 33]); o.w = pk2(s[6 * 33], s[7 * 33]);
        *(GAS v4u*)(WT + (size_t)(n0 + n) * K + k0 + 8 * c) = o; }
    LDS_WAIT(); asm volatile("" ::: "memory");
}
__device__ __forceinline__ void convert_tables(const Ctx& F, const float* pu, const float* pv, const float* g2, unsigned char* ws) {
    const int gt = (F.vcu * NWAVES + F.wave) * 64 + F.lane, NT = F.G * NWAVES * 64;
    for (int i = gt; i < NEXP * 2048 / 16; i += NT) { const int c16 = (i & 127) * 16; v4u ou, ov;
#pragma unroll
        for (int q = 0; q < 4; ++q) { f32x4 a = ((const GAS f32x4*)pu)[4 * i + q]; a = a * *(const GAS f32x4*)(g2 + c16 + 4 * q) * 512.0f; const f32x4 b = ((const GAS f32x4*)pv)[4 * i + q] * 32.0f;
            int wu = 0, wv = 0; wu = __builtin_amdgcn_cvt_pk_fp8_f32(a[0], a[1], wu, false); wu = __builtin_amdgcn_cvt_pk_fp8_f32(a[2], a[3], wu, true);
            wv = __builtin_amdgcn_cvt_pk_fp8_f32(b[0], b[1], wv, false); wv = __builtin_amdgcn_cvt_pk_fp8_f32(b[2], b[3], wv, true); ou[q] = (unsigned)wu; ov[q] = (unsigned)wv; }
        ((GAS v4u*)(ws + WS_UB))[i] = ou; ((GAS v4u*)(ws + WS_VB))[i] = ov; }
}
__device__ __forceinline__ void p0_prologue(const Ctx& F, const float* const* in, unsigned char* ws, const double* invf) {
    const float* x = in[0]; const int* pos = (const int*)in[1]; const float* g1 = in[2]; const float* w_in = in[3];
    const float* w_bc = in[6]; const float* w_ba = in[7]; const float* w_out = in[8]; const float* g2 = in[9]; const float* w_pq = in[10];
    const float* keys = in[11]; const float* pu = in[12]; const float* pv = in[13];
    LAS float* scr = (LAS float*)(F.lds + RING_OFF + F.wave * 16384);
    const int gw = F.vcu * NWAVES + F.wave, NGW = F.G * NWAVES;
    const int gt = gw * 64 + F.lane, NT = NGW * 64;
    for (int i = gt; i < 8192; i += NT) ((GAS unsigned long long*)(ws + WS_SS))[i] = 0ull;
    for (int i = gt; i < 32 * 1024; i += NT) ((GAS float*)(ws + WS_KSUM))[i] = 0.f;
    constexpr int I_IN = 32 * 320, I_BC = 16 * 64, I_OUT = 32 * 64;
    constexpr int NITEMS = I_IN + 2 * I_BC + 2 * I_OUT;
    for (int it = gw; it < NITEMS; it += NGW) {
        int r = it;
        if (r < I_IN) { p0_transpose_item(w_in, 2048, INW, (bf16*)(ws + WS_WIN), g1, scr, r, F.lane); continue; } r -= I_IN;
        if (r < I_BC) { p0_transpose_item(w_bc, 1024, 2048, (bf16*)(ws + WS_WBC), nullptr, scr, r, F.lane); continue; } r -= I_BC;
        if (r < I_BC) { p0_transpose_item(w_ba, 1024, 2048, (bf16*)(ws + WS_WBA), nullptr, scr, r, F.lane); continue; } r -= I_BC;
        if (r < I_OUT) { p0_transpose_item(w_out, 2048, 2048, (bf16*)(ws + WS_WOUT), nullptr, scr, r, F.lane); continue; } r -= I_OUT;
        p0_transpose_item(w_pq, 2048, 2048, (bf16*)(ws + WS_WPQ), g2, scr, r, F.lane);
    }
    for (int i = gt; i < 16 * 128 * 128 / 8; i += NT) { const f32x4 a = ((const GAS f32x4*)keys)[2 * i], b = ((const GAS f32x4*)keys)[2 * i + 1];
        v4u o; o.x = pk2(a[0], a[1]); o.y = pk2(a[2], a[3]); o.z = pk2(b[0], b[1]); o.w = pk2(b[2], b[3]); ((GAS v4u*)(ws + WS_KEYS))[i] = o; }
    for (int m = gw; m < M; m += NGW) { const GAS f32x4* xr = (const GAS f32x4*)(x + (size_t)m * DM);
        f32x4 v[8]; float s = 0.f;
#pragma unroll
        for (int i = 0; i < 4; ++i) { v[2 * i] = xr[i * 128 + 2 * F.lane]; v[2 * i + 1] = xr[i * 128 + 2 * F.lane + 1]; }
#pragma unroll
        for (int i = 0; i < 8; ++i) s += (v[i][0] * v[i][0] + v[i][1] * v[i][1]) + (v[i][2] * v[i][2] + v[i][3] * v[i][3]);
        const float rinv = 1.0f / sqrtf(wave_sum(s) * (1.0f / DM) + RMS_EPS);
        GAS v4u* o = (GAS v4u*)(ws + WS_XB + (size_t)m * DM * 2);
#pragma unroll
        for (int i = 0; i < 4; ++i) { const f32x4 a = v[2 * i] * rinv, b = v[2 * i + 1] * rinv; v4u w; w.x = pk2(a[0], a[1]); w.y = pk2(a[2], a[3]); w.z = pk2(b[0], b[1]); w.w = pk2(b[2], b[3]); o[i * 64 + F.lane] = w; } }
    for (int i = gt; i < M * 16; i += NT) { const int row = i >> 4, f = i & 15; const double ang = (double)pos[row] * invf[f];
        const double k = __builtin_rint(ang * 0.15915494309189535); const float r = (float)(ang - k * 6.283185307179586);
        float* cs = (float*)(ws + WS_CS); cs[row * 32 + f] = __cosf(r); cs[row * 32 + 16 + f] = __sinf(r); }
}

__device__ __forceinline__ void attn_simple(const Ctx& F, const bf16* Q, const bf16* K, const bf16* V, const float* ksum, bf16* AO) {
    LAS float* qf = (LAS float*)(F.lds + RING_OFF + F.wave * 512);
    const int gw = F.vcu * NWAVES + F.wave, NGW = F.G * NWAVES, lane = F.lane;
    for (int item = gw; item < 16 * SEQ; item += NGW) {
        const int bh = item >> 12, t = item & 4095, b = bh >> 3, h = bh & 7, blk = t >> 8;
        const size_t row = (size_t)b * SEQ + t;
        { const unsigned qq = *(const GAS unsigned*)(Q + row * 1024 + h * 128 + 2 * lane); qf[2 * lane] = bflo(qq); qf[2 * lane + 1] = bfhi(qq); }
        LDS_WAIT(); asm volatile("" ::: "memory");
        float g = -INFINITY;
        if (lane < blk) { const GAS f32x4* km = (const GAS f32x4*)(ksum + (size_t)(b * 16 + lane) * 1024 + h * 128); float a = 0.f;
            for (int d = 0; d < 32; ++d) { const f32x4 kv = km[d]; const f32x4 qv = *(const LAS f32x4*)(qf + 4 * d); a += (kv[0] * qv[0] + kv[1] * qv[1]) + (kv[2] * qv[2] + kv[3] * qv[3]); }
            g = a; }
        int sel[3];
#pragma unroll
        for (int i = 0; i < 3; ++i) { const float mx = wave_max(g); const unsigned long long bal = __ballot(g == mx && lane < blk); const int idx = bal ? (__ffsll((long long)bal) - 1) : 0; sel[i] = idx; if (lane == idx) g = -INFINITY; }
        const int nsel = blk < 3 ? blk : 3;
        float sc[4][4]; float mx = -INFINITY;
#pragma unroll
        for (int slot = 0; slot < 4; ++slot) {
            const bool valid = (slot == 3) || (slot < nsel);
            const int kb = (slot == 3) ? blk : sel[slot < 3 ? slot : 0];
#pragma unroll
            for (int r = 0; r < 4; ++r) {
                float s = -INFINITY; const int key0 = kb * 256 + r * 64;
                if (valid && (slot < 3 || key0 <= t)) {
                    const int key = key0 + lane; const GAS v4u* kp = (const GAS v4u*)(K + ((size_t)b * SEQ + key) * 1024 + h * 128); float a = 0.f;
#pragma unroll 4
                    for (int d = 0; d < 16; ++d) { const v4u kk = kp[d]; const f32x4 q0 = *(const LAS f32x4*)(qf + 8 * d), q1 = *(const LAS f32x4*)(qf + 8 * d + 4);
                        a += (bflo(kk.x) * q0[0] + bfhi(kk.x) * q0[1]) + (bflo(kk.y) * q0[2] + bfhi(kk.y) * q0[3]) + (bflo(kk.z) * q1[0] + bfhi(kk.z) * q1[1]) + (bflo(kk.w) * q1[2] + bfhi(kk.w) * q1[3]); }
                    s = (slot < 3 || key <= t) ? a : -INFINITY; }
                sc[slot][r] = s; mx = fmaxf(mx, s); } }
        mx = wave_max(mx);
        float sum = 0.f;
#pragma unroll
        for (int slot = 0; slot < 4; ++slot)
#pragma unroll
            for (int r = 0; r < 4; ++r) { sc[slot][r] = exp2f(sc[slot][r] - mx); sum += sc[slot][r]; }
        sum = wave_sum(sum);
        float o0 = 0.f, o1 = 0.f;
#pragma unroll
        for (int slot = 0; slot < 4; ++slot) {
            const bool valid = (slot == 3) || (slot < nsel);
            const int kb = (slot == 3) ? blk : sel[slot < 3 ? slot : 0];
#pragma unroll
            for (int r = 0; r < 4; ++r) { const int key0 = kb * 256 + r * 64;
                if (valid && (slot < 3 || key0 <= t)) { const float pr = sc[slot][r]; const GAS unsigned* vp = (const GAS unsigned*)(V + ((size_t)b * SEQ + key0) * 1024 + h * 128) + lane;
                    for (int kk = 0; kk < 64; ++kk) { const float pk = rdlane(pr, kk); const unsigned vv = vp[(size_t)kk * 512]; o0 += pk * bflo(vv); o1 += pk * bfhi(vv); } } } }
        const float ri = 1.0f / sum;
        *(GAS unsigned*)(AO + row * 1024 + h * 128 + 2 * lane) = pk2(o0 * ri, o1 * ri);
    }
}
typedef short v4i16_t __attribute__((ext_vector_type(4))); typedef unsigned u32x2v __attribute__((ext_vector_type(2)));
__device__ __forceinline__ v4i16_t vtr16(unsigned addr) { return __builtin_amdgcn_ds_read_tr16_b64_v4i16((LAS v4i16_t*)(uintptr_t)addr); }
__device__ __forceinline__ int crow16(int r, int hh) { return (r & 3) + 8 * (r >> 2) + 4 * hh; }
__device__ __forceinline__ void attn_dma_step(const bf16* K, const bf16* V, LAS unsigned char* lds, int b, int h, int qb, int n_own, int st, int wave, int lane) {
    const int buf = st & 1;
#pragma unroll
    for (int img = 0; img < 4; ++img) {
        const int T = 2 * st + (img >> 1); const bool isV = img & 1;
        const int blk = (T < n_own) ? qb : ((T - n_own) >> 2), kt = (T < n_own) ? T : ((T - n_own) & 3);
        const bf16* base = (isV ? V : K) + ((size_t)b * SEQ + 256 * blk + 64 * kt) * 1024 + h * 128;
#pragma unroll
        for (int i = 0; i < 2; ++i) { const int pc = wave + 8 * i, row = 4 * pc + (lane >> 4), cp = lane & 15;
            const int c = isV ? ((((cp >> 2) ^ (row & 3)) << 2) | (cp & 3)) : (cp ^ (row & 15));
            __builtin_amdgcn_global_load_lds((const unsigned*)(base + (size_t)row * 1024 + 8 * c), (LAS unsigned*)(lds + buf * 65536 + img * 16384 + pc * 1024), 16, 0, 0); }
    }
}
__device__ __forceinline__ void attn_mfma(const Ctx& F, const bf16* Q, const bf16* K, const bf16* V, const float* ksum, bf16* AO) {
    const int lane = F.lane, wave = F.wave, q31 = lane & 31, hh = lane >> 5, wq = wave & 3, kvh = wave >> 2, l16 = lane & 15, G4 = lane >> 4;
    LAS unsigned char* lds = F.lds + RING_OFF;
    const unsigned lds0 = (unsigned)(uintptr_t)lds;
    for (int pr = F.vcu; pr < 256; pr += F.G)
#pragma unroll 1
    for (int pi = 0; pi < 2; ++pi) {
        const int bh = pr >> 4, s_ = pr & 15, u128 = pi ? 31 - s_ : s_, b = bh >> 3, h = bh & 7, qb = u128 >> 1, half = u128 & 1;
        const int n_own = half ? 4 : 2, nstep = (n_own + 4 * qb) >> 1;
        const size_t rowq = (size_t)b * SEQ + 256 * qb + 128 * half + 32 * wq + q31;
        asm volatile("s_waitcnt vmcnt(0) lgkmcnt(0)" ::: "memory"); __builtin_amdgcn_s_barrier(); asm volatile("" ::: "memory");
        attn_dma_step(K, V, lds, b, h, qb, n_own, 0, wave, lane);
        bf16x8 qf[8];
#pragma unroll
        for (int s = 0; s < 8; ++s) qf[s] = *(const GAS bf16x8*)(Q + rowq * 1024 + h * 128 + 16 * s + 8 * hh);
        unsigned selmask;
        {
            float qv[64];
#pragma unroll
            for (int s = 0; s < 8; ++s)
#pragma unroll
                for (int e = 0; e < 8; ++e) qv[8 * s + e] = __uint_as_float((unsigned)(unsigned short)qf[s][e] << 16);
            float v0 = -INFINITY, v1 = -INFINITY, v2 = -INFINITY; int i0 = 0, i1 = 0, i2 = 0;
#pragma unroll 1
            for (int j = 0; j < qb; ++j) {
                const GAS f32x4* kp = (const GAS f32x4*)(ksum + (size_t)(b * 16 + j) * 1024 + h * 128 + 8 * hh); float a = 0.f;
#pragma unroll
                for (int s = 0; s < 8; ++s) { const f32x4 k0 = kp[4 * s], k1 = kp[4 * s + 1];
                    a += (qv[8 * s] * k0[0] + qv[8 * s + 1] * k0[1]) + (qv[8 * s + 2] * k0[2] + qv[8 * s + 3] * k0[3]) + (qv[8 * s + 4] * k1[0] + qv[8 * s + 5] * k1[1]) + (qv[8 * s + 6] * k1[2] + qv[8 * s + 7] * k1[3]); }
                a += __shfl_xor(a, 32);
                if (a > v0) { v2 = v1; i2 = i1; v1 = v0; i1 = i0; v0 = a; i0 = j; } else if (a > v1) { v2 = v1; i2 = i1; v1 = a; i1 = j; } else if (a > v2) { v2 = a; i2 = j; }
            }
            selmask = (qb <= 3) ? ((1u << qb) - 1u) : ((1u << i0) | (1u << i1) | (1u << i2));
        }
        float m_run = -1e30f, l_run = 0.f; f32x16 o[4];
#pragma unroll
        for (int db = 0; db < 4; ++db)
#pragma unroll
            for (int r = 0; r < 16; ++r) o[db][r] = 0.f;
        const int qin = 128 * half + 32 * wq + q31;
#pragma unroll 1
        for (int st = 0; st < nstep; ++st) {
            asm volatile("s_waitcnt vmcnt(0)" ::: "memory"); __builtin_amdgcn_s_barrier(); asm volatile("" ::: "memory");
            if (st + 1 < nstep) attn_dma_step(K, V, lds, b, h, qb, n_own, st + 1, wave, lane);
            const int T = 2 * st + kvh; const bool own = T < n_own;
            const int blk = own ? qb : ((T - n_own) >> 2), kt = own ? T : ((T - n_own) & 3);
            const bool sel = own ? true : ((selmask >> blk) & 1u);
            const bool skip = own ? (64 * kt > 128 * half + 32 * wq + 31) : (__ballot(sel) == 0ull);
            if (!skip) {
                const unsigned kimg = lds0 + (st & 1) * 65536 + kvh * 32768, vimg = kimg + 16384;
                f32x16 p[2];
#pragma unroll
                for (int kh = 0; kh < 2; ++kh) {
#pragma unroll
                    for (int r = 0; r < 16; ++r) p[kh][r] = 0.f;
                    const int row = 32 * kh + q31;
#pragma unroll
                    for (int s = 0; s < 8; ++s) { const bf16x8 a = *(const LAS bf16x8*)(uintptr_t)(kimg + row * 256 + (((2 * s + hh) ^ (row & 15)) << 4));
                        p[kh] = __builtin_amdgcn_mfma_f32_32x32x16_bf16(a, qf[s], p[kh], 0, 0, 0); }
                }
                if (own) { const int kbase = 64 * kt;
                    if (kbase + 63 > 128 * half + 32 * wq) {
#pragma unroll
                        for (int kh = 0; kh < 2; ++kh)
#pragma unroll
                            for (int r = 0; r < 16; ++r) if (kbase + 32 * kh + crow16(r, hh) > qin) p[kh][r] = -INFINITY; }
                } else if (!sel) {
#pragma unroll
                    for (int kh = 0; kh < 2; ++kh)
#pragma unroll
                        for (int r = 0; r < 16; ++r) p[kh][r] = -INFINITY; }
                float mx = p[0][0];
#pragma unroll
                for (int r = 1; r < 16; ++r) mx = fmaxf(mx, p[0][r]);
#pragma unroll
                for (int r = 0; r < 16; ++r) mx = fmaxf(mx, p[1][r]);
                mx = fmaxf(mx, __shfl_xor(mx, 32));
                const float m_new = fmaxf(m_run, mx), scl = exp2f(m_run - m_new); m_run = m_new;
                float rs = 0.f;
#pragma unroll
                for (int kh = 0; kh < 2; ++kh)
#pragma unroll
                    for (int r = 0; r < 16; ++r) { p[kh][r] = exp2f(p[kh][r] - m_new); rs += p[kh][r]; }
                l_run = l_run * scl + rs;
#pragma unroll
                for (int db = 0; db < 4; ++db)
#pragma unroll
                    for (int r = 0; r < 16; ++r) o[db][r] *= scl;
#pragma unroll
                for (int kh = 0; kh < 2; ++kh)
#pragma unroll
                    for (int s2 = 0; s2 < 2; ++s2) {
                        v4u pw; pw.x = pg8::cvt_pk_bf16(p[kh][8 * s2], p[kh][8 * s2 + 1]); pw.y = pg8::cvt_pk_bf16(p[kh][8 * s2 + 2], p[kh][8 * s2 + 3]);
                        pw.z = pg8::cvt_pk_bf16(p[kh][8 * s2 + 4], p[kh][8 * s2 + 5]); pw.w = pg8::cvt_pk_bf16(p[kh][8 * s2 + 6], p[kh][8 * s2 + 7]);
                        const bf16x8 pb = __builtin_bit_cast(bf16x8, pw);
                        const int key0 = 32 * kh + 16 * s2 + 4 * (G4 >> 1) + (l16 >> 2);
#pragma unroll
                        for (int db = 0; db < 4; ++db) {
                            const int dsub = 16 * (G4 & 1) + 4 * (l16 & 3);
                            const unsigned a0 = vimg + key0 * 256 + ((db ^ (key0 & 3)) << 6) + dsub * 2;
                            const v4i16_t lo = vtr16(a0), hi_ = vtr16(a0 + 8 * 256);
                            const bf16x8 av = {lo[0], lo[1], lo[2], lo[3], hi_[0], hi_[1], hi_[2], hi_[3]};
                            o[db] = __builtin_amdgcn_mfma_f32_32x32x16_bf16(av, pb, o[db], 0, 0, 0);
                        }
                    }
            }
        }
        l_run += __shfl_xor(l_run, 32);
        asm volatile("s_waitcnt vmcnt(0) lgkmcnt(0)" ::: "memory"); __builtin_amdgcn_s_barrier(); asm volatile("" ::: "memory");
        LAS float* xs = (LAS float*)lds + (size_t)wq * 66 * 64 + lane;
        if (kvh == 1) {
            xs[0] = m_run; xs[64] = l_run;
#pragma unroll
            for (int db = 0; db < 4; ++db)
#pragma unroll
                for (int r = 0; r < 16; ++r) xs[(2 + 16 * db + r) * 64] = o[db][r];
        }
        asm volatile("s_waitcnt lgkmcnt(0)" ::: "memory"); __builtin_amdgcn_s_barrier(); asm volatile("" ::: "memory");
        if (kvh == 0) {
            const float m2 = xs[0], l2 = xs[64], mt = fmaxf(m_run, m2), a1 = exp2f(m_run - mt), a2 = exp2f(m2 - mt);
            const float inv = 1.0f / (l_run * a1 + l2 * a2), c1 = a1 * inv, c2 = a2 * inv;
            bf16* orow = AO + rowq * 1024 + h * 128 + 4 * hh;
#pragma unroll
            for (int db = 0; db < 4; ++db)
#pragma unroll
                for (int g = 0; g < 4; ++g) {
                    float t[4];
#pragma unroll
                    for (int e = 0; e < 4; ++e) t[e] = o[db][4 * g + e] * c1 + xs[(2 + 16 * db + 4 * g + e) * 64] * c2;
                    u32x2v w; w.x = pg8::cvt_pk_bf16(t[0], t[1]); w.y = pg8::cvt_pk_bf16(t[2], t[3]);
                    *(GAS u32x2v*)(orow + 32 * db + 8 * g) = w;
                }
        }
    }
    asm volatile("s_waitcnt vmcnt(0) lgkmcnt(0)" ::: "memory"); __builtin_amdgcn_s_barrier(); asm volatile("" ::: "memory");
}
__device__ __forceinline__ void up8(const v4u w, float (&f)[8]) { f[0] = bflo(w.x); f[1] = bfhi(w.x); f[2] = bflo(w.y); f[3] = bfhi(w.y); f[4] = bflo(w.z); f[5] = bfhi(w.z); f[6] = bflo(w.w); f[7] = bfhi(w.w); }
__device__ __forceinline__ void conv_phase(const Ctx& F, const bf16* CB, const bf16* CC, const bf16* CX, const float* cw, bf16* UC) {
    const int gt = (F.vcu * NWAVES + F.wave) * 64 + F.lane, NT = F.G * NWAVES * 64;
    for (int idx = gt; idx < M * 128; idx += NT) {
        const int row = idx >> 7, c8 = (idx & 127) << 3, t = row & (SEQ - 1); const size_t off = (size_t)row * 1024 + c8;
        float cb[8], a[8], x[8], z0[8], z1[8], z2[8];
        up8(*(const GAS v4u*)(CB + off), cb); up8(*(const GAS v4u*)(CC + off), a); up8(*(const GAS v4u*)(CX + off), x);
#pragma unroll
        for (int j = 0; j < 8; ++j) z0[j] = a[j] * x[j];
        if (t >= 1) { up8(*(const GAS v4u*)(CC + off - 1024), a); up8(*(const GAS v4u*)(CX + off - 1024), x);
#pragma unroll
            for (int j = 0; j < 8; ++j) z1[j] = a[j] * x[j]; } else {
#pragma unroll
            for (int j = 0; j < 8; ++j) z1[j] = 0.f; }
        if (t >= 2) { up8(*(const GAS v4u*)(CC + off - 2048), a); up8(*(const GAS v4u*)(CX + off - 2048), x);
#pragma unroll
            for (int j = 0; j < 8; ++j) z2[j] = a[j] * x[j]; } else {
#pragma unroll
            for (int j = 0; j < 8; ++j) z2[j] = 0.f; }
        float o[8];
#pragma unroll
        for (int j = 0; j < 8; ++j) o[j] = cb[j] * (cw[c8 + j] * z2[j] + cw[1024 + c8 + j] * z1[j] + cw[2048 + c8 + j] * z0[j]);
        v4u w; w.x = pk2(o[0], o[1]); w.y = pk2(o[2], o[3]); w.z = pk2(o[4], o[5]); w.w = pk2(o[6], o[7]); *(GAS v4u*)(UC + off) = w;
    }
}

__device__ const unsigned char CAND50[64] = {
    0x00,0x01,0x02,0x03,0x04,0x05,0x06,0x07,0x08,0x09,0x0a,0x0b,0x0c,0x0d,0x0e,0x0f,
    0x10,0x11,0x12,0x13,0x14,0x15,0x16,0x17, 0x20,0x21,0x22,0x23,0x24, 0x30,0x31,0x32,0x33, 0x40,0x41,0x42, 0x50,0x51, 0x60,0x61, 0x70,0x71,
    0x80,0x90,0xa0,0xb0,0xc0,0xd0,0xe0,0xf0, 0xff,0xff,0xff,0xff,0xff,0xff,0xff,0xff,0xff,0xff,0xff,0xff,0xff,0xff};
__device__ __forceinline__ int ord_key(float f) { const int u = __float_as_int(f); return u >= 0 ? u : (u ^ 0x7fffffff); }
__device__ __forceinline__ float ord_val(int k) { return __int_as_float(k >= 0 ? k : (k ^ 0x7fffffff)); }
template <int CTRL> __device__ __forceinline__ int dpp_i(int v) { return __builtin_amdgcn_update_dpp(v, v, CTRL, 0xf, 0xf, false); }
__device__ __forceinline__ int imax(int a, int b) { return a > b ? a : b; }
__device__ __forceinline__ int hmax32(int v) {
    v = imax(v, dpp_i<0xB1>(v)); v = imax(v, dpp_i<0x4E>(v)); v = imax(v, dpp_i<0x141>(v)); v = imax(v, dpp_i<0x140>(v));
    const auto r = __builtin_amdgcn_permlane16_swap((unsigned)v, (unsigned)v, false, false); return imax((int)r[0], (int)r[1]); }
__device__ __forceinline__ float hsum32(float v) {
    v += __int_as_float(dpp_i<0xB1>(__float_as_int(v))); v += __int_as_float(dpp_i<0x4E>(__float_as_int(v))); v += __int_as_float(dpp_i<0x141>(__float_as_int(v))); v += __int_as_float(dpp_i<0x140>(__float_as_int(v)));
    const auto r = __builtin_amdgcn_permlane16_swap(__float_as_uint(v), __float_as_uint(v), false, false); return __uint_as_float(r[0]) + __uint_as_float(r[1]); }
__device__ __forceinline__ void topk_phase(const Ctx& F, const bf16* QP, const bf16* KEYS, int* EXP, float* GATE) {
    const int gw = F.vcu * NWAVES + F.wave, NGW = F.G * NWAVES, lane = F.lane, l31 = lane & 31, hi = lane >> 5;
    const int IMIN = (int)0x80000000;
    for (int item = gw; item < 256 * 8; item += NGW) {
        const int tt = item >> 3, h = item & 7, tok0 = tt * 32;
        int tops[2][16];
#pragma unroll
        for (int p = 0; p < 2; ++p) {
            f32x16 sc[4];
#pragma unroll
            for (int nt = 0; nt < 4; ++nt)
#pragma unroll
                for (int r = 0; r < 16; ++r) sc[nt][r] = 0.f;
#pragma unroll
            for (int s = 0; s < 8; ++s) {
                const bf16x8 a = *(const GAS bf16x8*)(QP + (size_t)(tok0 + l31) * 2048 + h * 256 + p * 128 + 16 * s + 8 * hi);
#pragma unroll
                for (int nt = 0; nt < 4; ++nt) { const bf16x8 bb = *(const GAS bf16x8*)(KEYS + (size_t)((h * 2 + p) * 128 + 32 * nt + l31) * 128 + 16 * s + 8 * hi);
                    sc[nt] = __builtin_amdgcn_mfma_f32_32x32x16_bf16(a, bb, sc[nt], 0, 0, 0); }
            }
            int kk[4][16];
#pragma unroll
            for (int nt = 0; nt < 4; ++nt)
#pragma unroll
                for (int r = 0; r < 16; ++r) kk[nt][r] = (ord_key(sc[nt][r]) & ~127) | (127 - 32 * nt - l31);
#pragma unroll
            for (int r = 0; r < 16; ++r) tops[p][r] = IMIN;
#pragma unroll 1
            for (int i = 0; i < 16; ++i) {
#pragma unroll
                for (int r = 0; r < 16; ++r) {
                    const int m = hmax32(imax(imax(kk[0][r], kk[1][r]), imax(kk[2][r], kk[3][r])));
                    if (l31 == i) tops[p][r] = m;
#pragma unroll
                    for (int nt = 0; nt < 4; ++nt) kk[nt][r] = (kk[nt][r] == m) ? IMIN : kk[nt][r];
                }
            }
        }
        const int cd0 = CAND50[l31], cd1 = CAND50[32 + l31], base = 32 * hi;
        int c0[16], c1[16], best[16];
#pragma unroll
        for (int r = 0; r < 16; ++r) {
            const int ta = tops[0][r], tb = tops[1][r];
            const int a0 = __shfl(ta, base + (cd0 >> 4)), b0 = __shfl(tb, base + (cd0 & 15)), a1 = __shfl(ta, base + ((cd1 >> 4) & 15)), b1 = __shfl(tb, base + (cd1 & 15));
            const float s0 = ord_val(a0 & ~127) + ord_val(b0 & ~127), s1 = ord_val(a1 & ~127) + ord_val(b1 & ~127);
            c0[r] = (ord_key(s0) & ~255) | (255 - cd0); c1[r] = (cd1 == 0xff) ? IMIN : ((ord_key(s1) & ~255) | (255 - cd1)); best[r] = IMIN;
        }
#pragma unroll 1
        for (int i = 0; i < 16; ++i) {
#pragma unroll
            for (int r = 0; r < 16; ++r) { const int m = hmax32(imax(c0[r], c1[r])); if (l31 == i) best[r] = m; c0[r] = (c0[r] == m) ? IMIN : c0[r]; c1[r] = (c1[r] == m) ? IMIN : c1[r]; }
        }
#pragma unroll
        for (int r = 0; r < 16; ++r) {
            const int posn = 255 - (best[r] & 255), bi = (posn >> 4) & 15, bj = posn & 15;
            const int n1 = 127 - (__shfl(tops[0][r], base + bi) & 127), n2 = 127 - (__shfl(tops[1][r], base + bj) & 127);
            const float sv = ord_val(best[r] & ~255), smax = ord_val(hmax32(best[r]) & ~255);
            const float e = (l31 < 16) ? __expf(sv - smax) : 0.f; const float es = hsum32(e);
            const int token = tok0 + (r & 3) + 8 * (r >> 2) + 4 * hi;
            if (l31 < 16) { EXP[(size_t)token * 128 + h * 16 + l31] = n1 * 128 + n2; GATE[(size_t)token * 128 + h * 16 + l31] = e / es; }
        }
    }
}

typedef float f32x2 __attribute__((ext_vector_type(2)));
constexpr float PEER_SU = 512.0f, PEER_SV = 32.0f;
template <int D> __device__ __forceinline__ void tr_step(float (&part)[64], int lane) {
    const bool up_ = (lane & D) != 0;
#pragma unroll
    for (int i = 0; i < D; ++i) { const float a = part[i], b = part[i + D]; const float send = up_ ? a : b, keep = up_ ? b : a; part[i] = keep + __shfl_xor(send, D); }
}
__device__ __forceinline__ void peer_phase(const Ctx& F, const unsigned char* U8, const unsigned char* V8, const bf16* X1B, const int* EXP, const float* GATE, const unsigned long long* SS, const float* gfin, const float* X1, float* OUT) {
    const int gw = F.vcu * NWAVES + F.wave, NGW = F.G * NWAVES, lane = F.lane;
    constexpr int NPF = 8;
    for (int t = gw; t < M; t += NGW) {
        const int e01[2] = { EXP[(size_t)t * 128 + lane], EXP[(size_t)t * 128 + 64 + lane] };
        const float g01[2] = { GATE[(size_t)t * 128 + lane], GATE[(size_t)t * 128 + 64 + lane] };
        const float rinv2 = pg8::rinv_from_ss(SS[t]) * (1.0f / PEER_SU);
        f32x2 xv[16];
#pragma unroll
        for (int i = 0; i < 2; ++i)
#pragma unroll
            for (int hv = 0; hv < 2; ++hv) { const v4u w = *(const GAS v4u*)(X1B + (size_t)t * DM + i * 1024 + lane * 16 + 8 * hv);
                xv[8 * i + 4 * hv + 0] = (f32x2){bflo(w.x), bfhi(w.x)}; xv[8 * i + 4 * hv + 1] = (f32x2){bflo(w.y), bfhi(w.y)}; xv[8 * i + 4 * hv + 2] = (f32x2){bflo(w.z), bfhi(w.z)}; xv[8 * i + 4 * hv + 3] = (f32x2){bflo(w.w), bfhi(w.w)}; }
        float act[2];
#pragma unroll
        for (int hf = 0; hf < 2; ++hf) {
            const int ev = e01[hf];
            float part[64]; v4u ub[NPF][2];
#pragma unroll
            for (int k = 0; k < NPF; ++k) { const GAS v4u* up = (const GAS v4u*)(U8 + (size_t)__builtin_amdgcn_readlane(ev, k) * 2048) + lane; ub[k][0] = up[0]; ub[k][1] = up[64]; }
#pragma unroll
            for (int k = 0; k < 64; ++k) {
                f32x2 p0 = {0.f, 0.f}, p1 = {0.f, 0.f};
#pragma unroll
                for (int i = 0; i < 2; ++i) { const v4u w = ub[k % NPF][i];
                    p0 += __builtin_amdgcn_cvt_pk_f32_fp8((int)w.x, false) * xv[8 * i + 0]; p1 += __builtin_amdgcn_cvt_pk_f32_fp8((int)w.x, true) * xv[8 * i + 1];
                    p0 += __builtin_amdgcn_cvt_pk_f32_fp8((int)w.y, false) * xv[8 * i + 2]; p1 += __builtin_amdgcn_cvt_pk_f32_fp8((int)w.y, true) * xv[8 * i + 3];
                    p0 += __builtin_amdgcn_cvt_pk_f32_fp8((int)w.z, false) * xv[8 * i + 4]; p1 += __builtin_amdgcn_cvt_pk_f32_fp8((int)w.z, true) * xv[8 * i + 5];
                    p0 += __builtin_amdgcn_cvt_pk_f32_fp8((int)w.w, false) * xv[8 * i + 6]; p1 += __builtin_amdgcn_cvt_pk_f32_fp8((int)w.w, true) * xv[8 * i + 7]; }
                part[k] = (p0[0] + p0[1]) + (p1[0] + p1[1]);
                if (k + NPF < 64) { const GAS v4u* up = (const GAS v4u*)(U8 + (size_t)__builtin_amdgcn_readlane(ev, k + NPF) * 2048) + lane; ub[k % NPF][0] = up[0]; ub[k % NPF][1] = up[64]; }
            }
            tr_step<32>(part, lane); tr_step<16>(part, lane); tr_step<8>(part, lane); tr_step<4>(part, lane); tr_step<2>(part, lane); tr_step<1>(part, lane);
            act[hf] = gelu_tanh(part[0] * rinv2) * g01[hf] * (1.0f / PEER_SV);
        }
        f32x2 y[16];
#pragma unroll
        for (int j = 0; j < 16; ++j) y[j] = (f32x2){0.f, 0.f};
#pragma unroll
        for (int hf = 0; hf < 2; ++hf) {
            const int ev = e01[hf]; const float av = act[hf];
            v4u vb[NPF][2];
#pragma unroll
            for (int k = 0; k < NPF; ++k) { const GAS v4u* vp = (const GAS v4u*)(V8 + (size_t)__builtin_amdgcn_readlane(ev, k) * 2048) + lane; vb[k][0] = vp[0]; vb[k][1] = vp[64]; }
#pragma unroll
            for (int k = 0; k < 64; ++k) {
                const float s = rdlane(av, k); const f32x2 s2 = {s, s};
#pragma unroll
                for (int i = 0; i < 2; ++i) { const v4u w = vb[k % NPF][i];
                    y[8 * i + 0] += s2 * __builtin_amdgcn_cvt_pk_f32_fp8((int)w.x, false); y[8 * i + 1] += s2 * __builtin_amdgcn_cvt_pk_f32_fp8((int)w.x, true);
                    y[8 * i + 2] += s2 * __builtin_amdgcn_cvt_pk_f32_fp8((int)w.y, false); y[8 * i + 3] += s2 * __builtin_amdgcn_cvt_pk_f32_fp8((int)w.y, true);
                    y[8 * i + 4] += s2 * __builtin_amdgcn_cvt_pk_f32_fp8((int)w.z, false); y[8 * i + 5] += s2 * __builtin_amdgcn_cvt_pk_f32_fp8((int)w.z, true);
                    y[8 * i + 6] += s2 * __builtin_amdgcn_cvt_pk_f32_fp8((int)w.w, false); y[8 * i + 7] += s2 * __builtin_amdgcn_cvt_pk_f32_fp8((int)w.w, true); }
                if (k + NPF < 64) { const GAS v4u* vp = (const GAS v4u*)(V8 + (size_t)__builtin_amdgcn_readlane(ev, k + NPF) * 2048) + lane; vb[k % NPF][0] = vp[0]; vb[k % NPF][1] = vp[64]; }
            }
        }
        const GAS f32x4* xr = (const GAS f32x4*)(X1 + (size_t)t * DM); GAS f32x4* orw = (GAS f32x4*)(OUT + (size_t)t * DM); float ss = 0.f;
#pragma unroll
        for (int i = 0; i < 2; ++i)
#pragma unroll
            for (int q = 0; q < 4; ++q) { const f32x4 a = xr[i * 256 + 4 * lane + q]; y[8 * i + 2 * q] += (f32x2){a[0], a[1]}; y[8 * i + 2 * q + 1] += (f32x2){a[2], a[3]}; }
#pragma unroll
        for (int j = 0; j < 16; ++j) ss += y[j][0] * y[j][0] + y[j][1] * y[j][1];
        const float r3 = 1.0f / sqrtf(wave_sum(ss) * (1.0f / DM) + RMS_EPS);
#pragma unroll
        for (int i = 0; i < 2; ++i)
#pragma unroll
            for (int q = 0; q < 4; ++q) { const f32x4 ga = *(const GAS f32x4*)(gfin + i * 1024 + lane * 16 + 4 * q);
                orw[i * 256 + 4 * lane + q] = (f32x4){y[8 * i + 2 * q][0] * r3 * ga[0], y[8 * i + 2 * q][1] * r3 * ga[1], y[8 * i + 2 * q + 1][0] * r3 * ga[2], y[8 * i + 2 * q + 1][1] * r3 * ga[3]}; }
    }
}

struct Args { const float* in[15]; float* out; unsigned char* ws; double invf[16]; int ph_lo, ph_hi, li, pad; };
__global__ void __launch_bounds__(NWAVES * 64, 2) mk_fwd(Args args) {
    extern __shared__ __attribute__((aligned(16))) unsigned char lds[];
    Ctx F;
    F.lds = (LAS unsigned char*)lds;
    volatile LAS unsigned* MISC = (volatile LAS unsigned*)(F.lds + MISC_OFF);
    F.tid = threadIdx.x; F.lane = F.tid & 63; F.wave = __builtin_amdgcn_readfirstlane(F.tid >> 6);
    F.G = gridDim.x; { const int bx = blockIdx.x; F.vcu = (F.G % 8 == 0) ? (bx % 8) * (F.G / 8) + bx / 8 : bx; }
    unsigned char* ws = args.ws;
    gu32* ctl = (gu32*)(ws + WS_CTL);
    for (int u = F.tid; u < (LDS_BYTES - LDSCTL_OFF) / 4; u += NWAVES * 64) ((LAS unsigned*)(F.lds + LDSCTL_OFF))[u] = 0u;
    __syncthreads();
    XcdBarrier bar; bar.bar = (unsigned*)(ctl + CW_BAR); bar.x = 0; bar.st = nullptr;
    if (N_LAUNCHES != PER_PHASE) bar = xcd_barrier_post((unsigned*)(ctl + CW_BAR), MISC + 8);
#define GRID_BAR() do { if (N_LAUNCHES != PER_PHASE) xcd_barrier(bar); } while (0)
    const int lo = args.ph_lo, hi = args.ph_hi;
#define IN(k) (lo <= (k) && (k) < hi)
#define BOTH(k) (IN(k) && IN((k) + 1))
    bf16* WinT = (bf16*)(ws + WS_WIN); bf16* WbcT = (bf16*)(ws + WS_WBC); bf16* WbaT = (bf16*)(ws + WS_WBA); bf16* WoutT = (bf16*)(ws + WS_WOUT); bf16* WpqT = (bf16*)(ws + WS_WPQ);
    bf16* KEYS = (bf16*)(ws + WS_KEYS); float* CS = (float*)(ws + WS_CS); const unsigned char* UB = ws + WS_UB; const unsigned char* VB = ws + WS_VB;
    bf16* XB = (bf16*)(ws + WS_XB); bf16* T6 = (bf16*)(ws + WS_T6); bf16* GAB = (bf16*)(ws + WS_GAB); bf16* UC = (bf16*)(ws + WS_UC); bf16* AO = (bf16*)(ws + WS_AO);
    bf16* TMP = (bf16*)(ws + WS_TMP); bf16* MB = (bf16*)(ws + WS_MB); bf16* X1B = (bf16*)(ws + WS_X1B); bf16* QP = (bf16*)(ws + WS_QP);
    int* EXP = (int*)(ws + WS_EXP); float* GATE = (float*)(ws + WS_GATE);
    unsigned long long* SS = (unsigned long long*)(ws + WS_SS); float* KSUM = (float*)(ws + WS_KSUM);
    constexpr size_t TS = (size_t)M * 1024;

    if (IN(0)) { for (int rep = 0; rep < NREP(0); ++rep) { p0_prologue(F, args.in, ws, args.invf); if (rep + 1 < NREP(0)) GRID_BAR(); } if (BOTH(0)) GRID_BAR(); }
    if (IN(1)) {
        for (int rep = 0; rep < NREP(1); ++rep) {
        pg8::Gemm g{XB, WinT, M, INW, DM}; pg8::StaticOrder S; S.init(M, INW, F.G, (int)blockIdx.x);
        pg8::EpiIn E{T6, GAB, args.in[4], CS, KSUM};
        pg8::gemm_phase<pg8::EpiIn, pg8::StaticOrder, true, true>(F.lds + RING_OFF, g, S, E);
        if (rep + 1 < NREP(1)) GRID_BAR(); }
        if (BOTH(1)) GRID_BAR();
    }
    if (IN(2)) {
        for (int rep = 0; rep < NREP(2); ++rep) {
        attn_mfma(F, T6 + 3 * TS, T6 + 4 * TS, T6 + 5 * TS, KSUM, AO);
        conv_phase(F, T6, T6 + TS, T6 + 2 * TS, args.in[5], UC);
        if (rep + 1 < NREP(2)) GRID_BAR(); }
        if (BOTH(2)) GRID_BAR();
    }
    if (IN(3)) {
        for (int rep = 0; rep < NREP(3); ++rep) {
        pg8::Gemm g{UC, WbcT, M, DM, 1024}; pg8::StaticOrder S; S.init(M, DM, F.G, (int)blockIdx.x);
        pg8::EpiTmp E{GAB, TMP};
        pg8::gemm_phase<pg8::EpiTmp, pg8::StaticOrder, true, true>(F.lds + RING_OFF, g, S, E);
        if (rep + 1 < NREP(3)) GRID_BAR(); }
        if (BOTH(3)) GRID_BAR();
    }
    if (IN(4)) {
        for (int rep = 0; rep < NREP(4); ++rep) {
        pg8::Gemm g{AO, WbaT, M, DM, 1024}; pg8::StaticOrder S; S.init(M, DM, F.G, (int)blockIdx.x);
        pg8::EpiMerge E{GAB + (size_t)M * DM, TMP, MB};
        pg8::gemm_phase<pg8::EpiMerge, pg8::StaticOrder, true, true>(F.lds + RING_OFF, g, S, E);
        if (rep + 1 < NREP(4)) GRID_BAR(); }
        if (BOTH(4)) GRID_BAR();
    }
    if (IN(5)) {
        for (int rep = 0; rep < NREP(5); ++rep) {
        pg8::Gemm g{MB, WoutT, M, DM, DM}; pg8::StaticOrder S; S.init(M, DM, F.G, (int)blockIdx.x);
        pg8::EpiX1 E{args.in[0], args.out, X1B, (rep + 1 < NREP(5)) ? (unsigned long long*)(ws + 768 * 1024) : SS};
        pg8::gemm_phase<pg8::EpiX1, pg8::StaticOrder, true, true>(F.lds + RING_OFF, g, S, E);
        if (rep + 1 < NREP(5)) GRID_BAR(); }
        if (BOTH(5)) GRID_BAR();
    }
    if (IN(6)) {
        for (int rep = 0; rep < NREP(6); ++rep) {
        pg8::Gemm g{X1B, WpqT, M, DM, DM}; pg8::StaticOrder S; S.init(M, DM, F.G, (int)blockIdx.x);
        pg8::EpiQP E{SS, QP};
        pg8::gemm_phase<pg8::EpiQP, pg8::StaticOrder, true, true>(F.lds + RING_OFF, g, S, E);
        if (rep + 1 < NREP(6)) GRID_BAR(); }
        if (BOTH(6)) GRID_BAR();
    }
    if (IN(7)) { for (int rep = 0; rep < NREP(7); ++rep) {
        if (F.wave >= 4) convert_tables(F, args.in[12], args.in[13], args.in[9], ws);
        topk_phase(F, QP, KEYS, EXP, GATE);
        if (F.wave < 4) convert_tables(F, args.in[12], args.in[13], args.in[9], ws);
        if (rep + 1 < NREP(7)) GRID_BAR(); } if (BOTH(7)) GRID_BAR(); }
    if (IN(8)) { for (int rep = 0; rep < NREP(8); ++rep) { peer_phase(F, UB, VB, X1B, EXP, GATE, SS, args.in[14], args.out, (rep + 1 < NREP(8)) ? (float*)(ws + WS_END) : args.out); if (rep + 1 < NREP(8)) GRID_BAR(); } }
#undef IN
#undef BOTH
#undef GRID_BAR
}

extern "C" void kernel_launch(void* const* d_in, const int* in_sizes, int n_in, void* d_out, int out_size, void* d_ws, size_t ws_size, hipStream_t stream) {
    static int grid = 0;
    if (grid == 0) {
        if (n_in != 15 || in_sizes[0] != M * DM || out_size != M * DM || ws_size < WS_END) { fprintf(stderr, "kernel_launch: unexpected shapes (n_in %d, in0 %d, out %d, ws %zu)\n", n_in, n_in > 0 ? in_sizes[0] : -1, out_size, ws_size); grid = -1; return; }
        int dev = 0, cus = 0, per_cu = 0;
        if (hipGetDevice(&dev) != hipSuccess || hipDeviceGetAttribute(&cus, hipDeviceAttributeMultiprocessorCount, dev) != hipSuccess) { grid = -1; return; }
        if (hipFuncSetAttribute((const void*)mk_fwd, hipFuncAttributeMaxDynamicSharedMemorySize, LDS_BYTES) != hipSuccess) { fprintf(stderr, "kernel_launch: hipFuncSetAttribute failed\n"); grid = -1; return; }
        if (hipOccupancyMaxActiveBlocksPerMultiprocessor(&per_cu, (const void*)mk_fwd, NWAVES * 64, LDS_BYTES) != hipSuccess || per_cu < 1) fprintf(stderr, "kernel_launch: occupancy query reports %d\n", per_cu);
        (void)hipGetLastError();
        grid = cus;
    }
    if (grid < 0) return;
    if (hipMemsetAsync((char*)d_ws + WS_CTL, 0, CTL_ZERO_BYTES, stream) != hipSuccess) { fprintf(stderr, "kernel_launch: memset failed\n"); return; }
    Args a{};
    for (int i = 0; i < 15; ++i) a.in[i] = (const float*)d_in[i];
    a.out = (float*)d_out; a.ws = (unsigned char*)d_ws;
    for (int f = 0; f < 16; ++f) a.invf[f] = pow(500000.0, -(double)(2 * f) / 32.0);
    for (int li = 0; li < N_LAUNCHES; ++li) {
        a.ph_lo = (N_LAUNCHES == PER_PHASE) ? li : 0; a.ph_hi = (N_LAUNCHES == PER_PHASE) ? li + 1 : PER_PHASE; a.li = li;
        hipLaunchKernelGGL(mk_fwd, dim3(grid), dim3(NWAVES * 64), LDS_BYTES, stream, a);
        const hipError_t le = hipPeekAtLastError();
        if (le != hipSuccess) { fprintf(stderr, "kernel_launch: launch %d failed: %s\n", li, hipGetErrorName(le)); break; }
    }
}
```

```cpp
#include <hip/hip_runtime.h>
#include <cstdio>
#include <cstdint>
#include <cmath>
namespace pg8 {
#define PG8_LAS __attribute__((address_space(3)))
typedef unsigned short bf16_t;
typedef short bf16x8 __attribute__((ext_vector_type(8)));
typedef float f32x4 __attribute__((ext_vector_type(4)));
typedef unsigned u32x4 __attribute__((ext_vector_type(4)));
constexpr int BM = 256, BK = 64, HALF = 128, HTB = HALF * BK * 2  , STAGE_BYTES = 8 * HTB, NXCD = 8, WGM = 8;

__host__ __device__ __forceinline__ int lds_byte(int r, int c) { const int st = (r >> 4) * 2 + (c >> 5), rr = r & 15, cc = c & 31, ob = rr * 64 + cc * 2; return st * 1024 + (ob ^ (((ob >> 9) & 1) << 5)); }
__host__ __device__ __forceinline__ void stage_rc(int b, int& R, int& C) { const int st = b / 1024, sb = b % 1024, swz = sb ^ (((sb >> 9) & 1) << 5); R = (st >> 1) * 16 + swz / 64; C = (st & 1) * 32 + (swz % 64) / 2; }
__host__ __device__ __forceinline__ int perm32(int rho) { const int n = rho >> 4, i = rho & 15; return 8 * (i >> 2) + 4 * n + (i & 3); }

struct Unit { int pm, pn; };
struct Gemm { const bf16_t* A; const bf16_t* Bt; int M, N, K; };

struct StaticOrder {
    int nM, nN, nwg, G, c;
    __host__ __device__ void init(int M, int N, int G_, int c_) { nM = M / BM; nN = N / BM; nwg = nM * nN; G = G_; c = c_; }
    __host__ __device__ bool next(int i, Unit& u) const {
        const long L = (long)i * G + c; if (L >= nwg) return false;
        int wgid = (int)L; { const int q = nwg / NXCD, r = nwg % NXCD, xcd = wgid % NXCD, off = wgid / NXCD; wgid = (xcd < r ? xcd * (q + 1) : r * (q + 1) + (xcd - r) * q) + off; }
        const int nig = WGM * nN, gid = wgid / nig, fm = gid * WGM, gsz = (nM - fm) < WGM ? (nM - fm) : WGM;
        u.pm = fm + ((wgid % nig) % gsz); u.pn = (wgid % nig) / gsz; return true;
    }
    __device__ __forceinline__ void a_ready(const Unit&) const {}
    __device__ __forceinline__ void done(const Unit&) const {}
};


typedef float f32x2c __attribute__((ext_vector_type(2))); typedef __bf16 bf16x2c __attribute__((ext_vector_type(2)));
__device__ __forceinline__ unsigned cvt_pk_bf16(float lo, float hi) { const f32x2c v = {lo, hi}; const bf16x2c b = __builtin_convertvector(v, bf16x2c); return __builtin_bit_cast(unsigned, b); }
__device__ __forceinline__ u32x4 pack8(f32x4 a, f32x4 b) { u32x4 w; w.x = cvt_pk_bf16(a[0], a[1]); w.y = cvt_pk_bf16(a[2], a[3]); w.z = cvt_pk_bf16(b[0], b[1]); w.w = cvt_pk_bf16(b[2], b[3]); return w; }
__device__ __forceinline__ f32x4 shx(f32x4 v, int o) { f32x4 r; r[0] = __shfl_xor(v[0], o); r[1] = __shfl_xor(v[1], o); r[2] = __shfl_xor(v[2], o); r[3] = __shfl_xor(v[3], o); return r; }
__device__ __forceinline__ f32x4 bf4lo(unsigned a, unsigned b) { f32x4 r; r[0] = __uint_as_float(a << 16); r[1] = __uint_as_float(a & 0xffff0000u); r[2] = __uint_as_float(b << 16); r[3] = __uint_as_float(b & 0xffff0000u); return r; }
__device__ __forceinline__ f32x4 sigm4(f32x4 v) { f32x4 r;
#pragma unroll
    for (int i = 0; i < 4; ++i) r[i] = __builtin_amdgcn_rcpf(1.0f + __expf(-v[i])); return r; }
constexpr float QSCALE = 0.08838834764831845f * 1.4426950408889634f;

struct EpiIn {
    static constexpr bool PERM = true, AFTER_DRAIN = false;
    bf16_t* T6; bf16_t* GAB; const float* gbias; const float* cs; float* ksum;
    __device__ __forceinline__ void operator()(const f32x4 (&acc)[2][2][4][2], const Unit& u, int wr, int wc, int fr, int fq) const {
        const int row0 = u.pm * BM + wr * 64 + fr, pn = u.pn, colw = wc * 32 + 8 * fq;
        if (pn < 24) {
            const int t = pn >> 2;
            bf16_t* base = T6 + (size_t)t * ((size_t)8192 * 1024) + (pn & 3) * 256 + colw;
            const bool rot = (t == 3 || t == 4) && (wc == 0), isk = (t == 4);
            const float qs = (t == 3) ? QSCALE : 1.0f;
            f32x4 ks[2][2];
#pragma unroll
            for (int bj = 0; bj < 2; ++bj) { ks[bj][0] = (f32x4){0.f, 0.f, 0.f, 0.f}; ks[bj][1] = (f32x4){0.f, 0.f, 0.f, 0.f}; }
#pragma unroll
            for (int ai = 0; ai < 2; ++ai)
#pragma unroll
                for (int m = 0; m < 4; ++m) {
                    const int row = row0 + ai * HALF + m * 16;
                    f32x4 c0 = (f32x4){1.f, 1.f, 1.f, 1.f}, c1 = c0, s0 = (f32x4){0.f, 0.f, 0.f, 0.f}, s1 = s0;
                    if (rot) { const float* cp = cs + (size_t)row * 32 + 8 * (fq & 1); c0 = *(const f32x4*)cp; c1 = *(const f32x4*)(cp + 4); s0 = *(const f32x4*)(cp + 16); s1 = *(const f32x4*)(cp + 20);
                        if (fq < 2) { s0 = -s0; s1 = -s1; } }
#pragma unroll
                    for (int bj = 0; bj < 2; ++bj) {
                        f32x4 v0 = acc[ai][bj][m][0], v1 = acc[ai][bj][m][1];
                        if (rot) { const f32x4 p0 = shx(v0, 32), p1 = shx(v1, 32); v0 = v0 * c0 + p0 * s0; v1 = v1 * c1 + p1 * s1; }
                        if (isk) { ks[bj][0] += v0; ks[bj][1] += v1; }
                        v0 = v0 * qs; v1 = v1 * qs;
                        *(u32x4*)(base + (size_t)row * 1024 + bj * HALF) = pack8(v0, v1);
                    }
                }
            if (isk) {
#pragma unroll
                for (int bj = 0; bj < 2; ++bj)
#pragma unroll
                    for (int n = 0; n < 2; ++n) { f32x4 v = ks[bj][n]; v += shx(v, 1); v += shx(v, 2); v += shx(v, 4); v += shx(v, 8);
                        if (fr == 0) { float* kp = ksum + (size_t)u.pm * 1024 + (pn & 3) * 256 + bj * HALF + colw + 4 * n;
                            unsafeAtomicAdd(kp + 0, v[0]); unsafeAtomicAdd(kp + 1, v[1]); unsafeAtomicAdd(kp + 2, v[2]); unsafeAtomicAdd(kp + 3, v[3]); } }
            }
        } else {
            const int t = (pn - 24) >> 3, colg = ((pn - 24) & 7) * 256 + colw;
            bf16_t* base = GAB + (size_t)t * ((size_t)8192 * 2048) + colg;
            const float* bp = gbias + t * 2048 + colg;
            f32x4 bv[2][2];
#pragma unroll
            for (int bj = 0; bj < 2; ++bj) { bv[bj][0] = *(const f32x4*)(bp + bj * HALF); bv[bj][1] = *(const f32x4*)(bp + bj * HALF + 4); }
#pragma unroll
            for (int ai = 0; ai < 2; ++ai)
#pragma unroll
                for (int m = 0; m < 4; ++m) { const int row = row0 + ai * HALF + m * 16;
#pragma unroll
                    for (int bj = 0; bj < 2; ++bj) *(u32x4*)(base + (size_t)row * 2048 + bj * HALF) = pack8(sigm4(acc[ai][bj][m][0] + bv[bj][0]), sigm4(acc[ai][bj][m][1] + bv[bj][1])); }
        }
    }
};
struct EpiTmp {
    static constexpr bool PERM = true, AFTER_DRAIN = false;
    const bf16_t* G; bf16_t* O;
    __device__ __forceinline__ void operator()(const f32x4 (&acc)[2][2][4][2], const Unit& u, int wr, int wc, int fr, int fq) const {
        const int row0 = u.pm * BM + wr * 64 + fr, col0 = u.pn * BM + wc * 32 + 8 * fq;
#pragma unroll
        for (int ai = 0; ai < 2; ++ai)
#pragma unroll
            for (int m = 0; m < 4; ++m) { const size_t off = (size_t)(row0 + ai * HALF + m * 16) * 2048 + col0;
#pragma unroll
                for (int bj = 0; bj < 2; ++bj) { const u32x4 g = *(const u32x4*)(G + off + bj * HALF);
                    *(u32x4*)(O + off + bj * HALF) = pack8(acc[ai][bj][m][0] * bf4lo(g.x, g.y), acc[ai][bj][m][1] * bf4lo(g.z, g.w)); } }
    }
};
struct EpiMerge {
    static constexpr bool PERM = true, AFTER_DRAIN = false;
    const bf16_t* G; const bf16_t* TMP; bf16_t* O;
    __device__ __forceinline__ void operator()(const f32x4 (&acc)[2][2][4][2], const Unit& u, int wr, int wc, int fr, int fq) const {
        const int row0 = u.pm * BM + wr * 64 + fr, col0 = u.pn * BM + wc * 32 + 8 * fq;
#pragma unroll
        for (int ai = 0; ai < 2; ++ai)
#pragma unroll
            for (int m = 0; m < 4; ++m) { const size_t off = (size_t)(row0 + ai * HALF + m * 16) * 2048 + col0;
#pragma unroll
                for (int bj = 0; bj < 2; ++bj) { const u32x4 g = *(const u32x4*)(G + off + bj * HALF), t = *(const u32x4*)(TMP + off + bj * HALF);
                    *(u32x4*)(O + off + bj * HALF) = pack8(bf4lo(t.x, t.y) + acc[ai][bj][m][0] * bf4lo(g.x, g.y), bf4lo(t.z, t.w) + acc[ai][bj][m][1] * bf4lo(g.z, g.w)); } }
    }
};
struct EpiX1 {
    static constexpr bool PERM = true, AFTER_DRAIN = false;
    const float* X; float* X1; bf16_t* X1B; unsigned long long* SS;
    __device__ __forceinline__ void operator()(const f32x4 (&acc)[2][2][4][2], const Unit& u, int wr, int wc, int fr, int fq) const {
        const int row0 = u.pm * BM + wr * 64 + fr, col0 = u.pn * BM + wc * 32 + 8 * fq;
#pragma unroll
        for (int ai = 0; ai < 2; ++ai)
#pragma unroll
            for (int m = 0; m < 4; ++m) { const int row = row0 + ai * HALF + m * 16; const size_t off = (size_t)row * 2048 + col0; float sq = 0.f;
#pragma unroll
                for (int bj = 0; bj < 2; ++bj) { const f32x4 v0 = acc[ai][bj][m][0] + *(const f32x4*)(X + off + bj * HALF), v1 = acc[ai][bj][m][1] + *(const f32x4*)(X + off + bj * HALF + 4);
                    *(f32x4*)(X1 + off + bj * HALF) = v0; *(f32x4*)(X1 + off + bj * HALF + 4) = v1; *(u32x4*)(X1B + off + bj * HALF) = pack8(v0, v1);
                    sq += (v0[0] * v0[0] + v0[1] * v0[1]) + (v0[2] * v0[2] + v0[3] * v0[3]) + (v1[0] * v1[0] + v1[1] * v1[1]) + (v1[2] * v1[2] + v1[3] * v1[3]); }
                sq += __shfl_xor(sq, 16); sq += __shfl_xor(sq, 32);
                if (fq == 0) atomicAdd(SS + row, (unsigned long long)(sq * 4294967296.0f)); }
    }
};
__device__ __forceinline__ float rinv_from_ss(unsigned long long s) { return 1.0f / sqrtf((float)((double)s * (1.0 / 4294967296.0) * (1.0 / 2048.0)) + 1e-6f); }
struct EpiQP {
    static constexpr bool PERM = true, AFTER_DRAIN = false;
    const unsigned long long* SS; bf16_t* O;
    __device__ __forceinline__ void operator()(const f32x4 (&acc)[2][2][4][2], const Unit& u, int wr, int wc, int fr, int fq) const {
        const int row0 = u.pm * BM + wr * 64 + fr, col0 = u.pn * BM + wc * 32 + 8 * fq;
#pragma unroll
        for (int ai = 0; ai < 2; ++ai)
#pragma unroll
            for (int m = 0; m < 4; ++m) { const int row = row0 + ai * HALF + m * 16; const size_t off = (size_t)row * 2048 + col0; const float rv = rinv_from_ss(SS[row]);
#pragma unroll
                for (int bj = 0; bj < 2; ++bj) *(u32x4*)(O + off + bj * HALF) = pack8(acc[ai][bj][m][0] * rv, acc[ai][bj][m][1] * rv); }
    }
};

template <class Epi, class Sched, bool ALIGN_EPI = false, bool SP2 = false>
__device__ __forceinline__ void gemm_phase(PG8_LAS unsigned char* lds, const Gemm g, const Sched& S, const Epi& E) {
    const int tid = threadIdx.x, wid = __builtin_amdgcn_readfirstlane(tid >> 6), lane = tid & 63, wr = wid >> 2, wc = wid & 3, fr = lane & 15, fq = lane >> 4;
    const int K = g.K, nt = K / BK;
    unsigned voffA[2], voffB[2];
#pragma unroll
    for (int i = 0; i < 2; ++i) { int R, C; stage_rc(tid * 16 + i * 8192, R, C); const int Rb = Epi::PERM ? ((R & ~31) + perm32(R & 31)) : R;
        voffA[i] = (unsigned)(R * K + C) * 2u; voffB[i] = (unsigned)(Rb * K + C) * 2u; }
    const size_t kstep = (size_t)(BK * 2);
    const size_t hstep = (size_t)HALF * K * 2;
    const size_t tstep = 2 * hstep;
    const unsigned ldsw = (unsigned)wid * 1024u;
    const int aoff = lds_byte(wr * 64 + fr, fq * 8), boff = lds_byte(wc * 32 + fr, fq * 8);
#define PG8_SA(b, h) (((b) * 2 + (h)) * HTB)
#define PG8_SB(b, h) ((4 + (b) * 2 + (h)) * HTB)
#define PG8_STAGE(bufoff, gbase, voff) do { _Pragma("unroll") for (int _i = 0; _i < 2; ++_i) \
        __builtin_amdgcn_global_load_lds((const unsigned*)((const char*)(gbase) + (voff)[_i]), (PG8_LAS unsigned*)(lds + (bufoff) + ldsw + _i * 8192), 16, 0, 0); } while (0)
#define PG8_LDA(dst, b, h) do { _Pragma("unroll") for (int m = 0; m < 4; ++m) _Pragma("unroll") for (int k = 0; k < 2; ++k) dst[m][k] = *(const PG8_LAS bf16x8*)(lds + PG8_SA(b, h) + aoff + m * 2048 + k * 1024); } while (0)
#define PG8_LDB(dst, b, h) do { _Pragma("unroll") for (int n = 0; n < 2; ++n) _Pragma("unroll") for (int k = 0; k < 2; ++k) dst[n][k] = *(const PG8_LAS bf16x8*)(lds + PG8_SB(b, h) + boff + n * 2048 + k * 1024); } while (0)
#define PG8_MMA(ai, bj, At, Bt) do { __builtin_amdgcn_s_setprio(1); _Pragma("unroll") for (int m = 0; m < 4; ++m) _Pragma("unroll") for (int n = 0; n < 2; ++n) _Pragma("unroll") for (int k = 0; k < 2; ++k) \
        acc[ai][bj][m][n] = __builtin_amdgcn_mfma_f32_16x16x32_bf16(Bt[n][k], At[m][k], acc[ai][bj][m][n], 0, 0, 0); __builtin_amdgcn_s_setprio(0); } while (0)
#define PG8_WAIT_V(n) asm volatile("s_waitcnt vmcnt(" #n ")" ::: "memory")
#define PG8_WAIT_L(n) asm volatile("s_waitcnt lgkmcnt(" #n ")" ::: "memory")
#define PG8_BAR __builtin_amdgcn_s_barrier()
#define PG8_SCHED __builtin_amdgcn_sched_barrier(0)
    Unit cur, nxt; int ui = 0;
    if (!S.next(0, cur)) return;
    f32x4 acc[2][2][4][2];
#pragma unroll
    for (int a = 0; a < 2; ++a)
#pragma unroll
        for (int b = 0; b < 2; ++b)
#pragma unroll
            for (int m = 0; m < 4; ++m)
#pragma unroll
                for (int n = 0; n < 2; ++n) acc[a][b][m][n] = (f32x4){0.f, 0.f, 0.f, 0.f};
    bf16x8 At[4][2], B0[2][2], B1[2][2];
    const char* cA = (const char*)g.A + (size_t)cur.pm * tstep; const char* cB = (const char*)g.Bt + (size_t)cur.pn * tstep;
    S.a_ready(cur);
    if constexpr (SP2) {
        PG8_STAGE(PG8_SB(0, 0), cB, voffB); PG8_STAGE(PG8_SB(0, 1), cB + hstep, voffB); PG8_STAGE(PG8_SA(0, 0), cA, voffA); PG8_STAGE(PG8_SA(0, 1), cA + hstep, voffA);
        if (wr == 1) PG8_BAR;
        PG8_WAIT_V(2); PG8_BAR;
        PG8_STAGE(PG8_SB(1, 0), cB + kstep, voffB); PG8_STAGE(PG8_SA(1, 0), cA + kstep, voffA); PG8_STAGE(PG8_SB(1, 1), cB + hstep + kstep, voffB);
        PG8_WAIT_V(6); PG8_BAR;
    } else {
        PG8_STAGE(PG8_SB(0, 0), cB, voffB); PG8_STAGE(PG8_SA(0, 0), cA, voffA); PG8_STAGE(PG8_SB(0, 1), cB + hstep, voffB); PG8_STAGE(PG8_SA(0, 1), cA + hstep, voffA);
        if (wr == 1) PG8_BAR;
        PG8_WAIT_V(4); PG8_BAR;
        PG8_STAGE(PG8_SB(1, 0), cB + kstep, voffB); PG8_STAGE(PG8_SA(1, 0), cA + kstep, voffA); PG8_STAGE(PG8_SB(1, 1), cB + hstep + kstep, voffB);
        PG8_WAIT_V(6); PG8_BAR;
    }
    for (;;) {
        const bool has_next = S.next(ui + 1, nxt);
        const char* nA = has_next ? (const char*)g.A + (size_t)nxt.pm * tstep : cA; const char* nB = has_next ? (const char*)g.Bt + (size_t)nxt.pn * tstep : cB;
        for (int t = 0; t < nt; t += 2) {
            const bool last = (t == nt - 2);
            const char* a1 = cA + (size_t)(t + 1) * kstep;
            const char* a2 = last ? nA : cA + (size_t)(t + 2) * kstep; const char* b2 = last ? nB : cB + (size_t)(t + 2) * kstep;
            const char* a3 = a2 + kstep; const char* b3 = b2 + kstep;
            if (last && has_next) S.a_ready(nxt);
            if constexpr (SP2) {
            PG8_LDB(B0, 0, 0); PG8_LDB(B1, 0, 1); PG8_SCHED; PG8_LDA(At, 0, 0); PG8_STAGE(PG8_SA(1, 1), a1 + hstep, voffA);
            PG8_WAIT_V(8); PG8_WAIT_L(0); PG8_BAR; PG8_MMA(0, 0, At, B0); PG8_MMA(0, 1, At, B1); PG8_BAR; PG8_SCHED;
            PG8_LDA(At, 0, 1); PG8_STAGE(PG8_SB(0, 0), b2, voffB); PG8_STAGE(PG8_SB(0, 1), b2 + hstep, voffB); PG8_STAGE(PG8_SA(0, 0), a2, voffA);
            PG8_WAIT_V(8); PG8_WAIT_L(0); PG8_BAR; PG8_MMA(1, 0, At, B0); PG8_MMA(1, 1, At, B1); PG8_BAR; PG8_SCHED;
            PG8_LDB(B0, 1, 0); PG8_LDB(B1, 1, 1); PG8_SCHED; PG8_LDA(At, 1, 0); PG8_STAGE(PG8_SA(0, 1), a2 + hstep, voffA);
            PG8_WAIT_V(8); PG8_WAIT_L(0); PG8_BAR; PG8_MMA(0, 0, At, B0); PG8_MMA(0, 1, At, B1); PG8_BAR; PG8_SCHED;
            PG8_LDA(At, 1, 1); PG8_STAGE(PG8_SB(1, 0), b3, voffB); PG8_STAGE(PG8_SB(1, 1), b3 + hstep, voffB); PG8_STAGE(PG8_SA(1, 0), a3, voffA);
            PG8_WAIT_V(8); PG8_WAIT_L(0); PG8_BAR; PG8_MMA(1, 0, At, B0); PG8_MMA(1, 1, At, B1); PG8_BAR; PG8_SCHED;
            } else {
            PG8_LDB(B0, 0, 0); PG8_SCHED; PG8_LDA(At, 0, 0); PG8_STAGE(PG8_SA(1, 1), a1 + hstep, voffA);
            PG8_WAIT_L(8); PG8_BAR; PG8_WAIT_L(0); PG8_MMA(0, 0, At, B0); PG8_BAR; PG8_SCHED;
            PG8_LDB(B1, 0, 1); PG8_STAGE(PG8_SB(0, 0), b2, voffB);
            PG8_BAR; PG8_WAIT_L(0); PG8_MMA(0, 1, At, B1); PG8_BAR;
            PG8_LDA(At, 0, 1); PG8_STAGE(PG8_SA(0, 0), a2, voffA);
            PG8_BAR; PG8_WAIT_L(0); PG8_MMA(1, 0, At, B0); PG8_BAR; PG8_SCHED;
            PG8_STAGE(PG8_SB(0, 1), b2 + hstep, voffB);
            PG8_WAIT_V(6); PG8_BAR; PG8_MMA(1, 1, At, B1); PG8_BAR;
            PG8_LDB(B0, 1, 0); PG8_SCHED; PG8_LDA(At, 1, 0); PG8_STAGE(PG8_SA(0, 1), a2 + hstep, voffA);
            PG8_WAIT_L(8); PG8_BAR; PG8_WAIT_L(0); PG8_MMA(0, 0, At, B0); PG8_BAR; PG8_SCHED;
            PG8_LDB(B1, 1, 1); PG8_STAGE(PG8_SB(1, 0), b3, voffB);
            PG8_BAR; PG8_WAIT_L(0); PG8_MMA(0, 1, At, B1); PG8_BAR;
            PG8_LDA(At, 1, 1); PG8_STAGE(PG8_SA(1, 0), a3, voffA);
            PG8_BAR; PG8_WAIT_L(0); PG8_MMA(1, 0, At, B0); PG8_BAR; PG8_SCHED;
            PG8_STAGE(PG8_SB(1, 1), b3 + hstep, voffB);
            PG8_WAIT_V(6); PG8_BAR; PG8_MMA(1, 1, At, B1); PG8_BAR;
            }
        }
        if constexpr (ALIGN_EPI) { if (wr == 0) PG8_BAR; }
        if constexpr (!Epi::AFTER_DRAIN) { E(acc, cur, wr, wc, fr, fq); S.done(cur); }
        if (!has_next) break;
#pragma unroll
        for (int a = 0; a < 2; ++a)
#pragma unroll
            for (int b = 0; b < 2; ++b)
#pragma unroll
                for (int m = 0; m < 4; ++m)
#pragma unroll
                    for (int n = 0; n < 2; ++n) acc[a][b][m][n] = (f32x4){0.f, 0.f, 0.f, 0.f};
        cur = nxt; cA = nA; cB = nB; ++ui;
        if constexpr (ALIGN_EPI) { if (wr == 1) PG8_BAR; }
    }
    PG8_WAIT_V(0);
    if constexpr (!ALIGN_EPI) { if (wr == 0) PG8_BAR; }
    PG8_BAR;
    if constexpr (Epi::AFTER_DRAIN) { E.fused(acc, cur, wr, wc, fr, fq, lds, wid, lane); S.done(cur); }
#undef PG8_SA
#undef PG8_SB
#undef PG8_STAGE
#undef PG8_LDA
#undef PG8_LDB
#undef PG8_MMA
#undef PG8_WAIT_V
#undef PG8_WAIT_L
#undef PG8_BAR
#undef PG8_SCHED
}
}

constexpr int NWAVES = 8;
#ifndef MK_N_LAUNCHES
#define MK_N_LAUNCHES 1
#endif
constexpr int PER_PHASE = 9;
#ifndef MK_REP_PHASE
#define MK_REP_PHASE -1
#endif
#define NREP(k) (((k) == MK_REP_PHASE) ? 2 : 1)
constexpr int N_LAUNCHES = MK_N_LAUNCHES;
constexpr int M = 8192, SEQ = 4096, DM = 2048, INW = 10240, NEXP = 16384;
constexpr float RMS_EPS = 1e-6f;
constexpr size_t MiB = 1u << 20;
constexpr size_t WS_CTL = 0, CTL_ZERO_BYTES = 1 * MiB;
constexpr size_t WS_SS = 256 * 1024, WS_KSUM = 512 * 1024;
constexpr size_t WS_WIN = 2 * MiB, WS_WBC = 42 * MiB, WS_WBA = 46 * MiB, WS_WOUT = 50 * MiB, WS_WPQ = 58 * MiB, WS_KEYS = 66 * MiB, WS_CS = 67 * MiB;
constexpr size_t WS_UB = 70 * MiB, WS_VB = 102 * MiB;
constexpr size_t WS_XB = 198 * MiB;
constexpr size_t WS_T6 = 230 * MiB;
constexpr size_t WS_GAB = 326 * MiB;
constexpr size_t WS_UC = 390 * MiB, WS_AO = 406 * MiB;
constexpr size_t WS_EXP = 422 * MiB, WS_GATE = 426 * MiB;
constexpr size_t WS_END = 430 * MiB;
constexpr size_t WS_TMP = WS_XB, WS_MB = WS_T6, WS_X1B = WS_T6 + 48 * MiB, WS_QP = WS_GAB;
constexpr int CW_BAR = 4096;
constexpr int RING_OFF = 0, RING_BYTES = 131072;
constexpr int LDSCTL_OFF = RING_BYTES, MISC_OFF = LDSCTL_OFF + 320;
constexpr int LDS_BYTES = 147456;

#define GAS __attribute__((address_space(1)))
#define LAS __attribute__((address_space(3)))
typedef unsigned short bf16;
typedef unsigned v4u __attribute__((ext_vector_type(4)));
typedef float f32x4 __attribute__((ext_vector_type(4)));
typedef short bf16x8 __attribute__((ext_vector_type(8)));
typedef GAS unsigned gu32;
typedef GAS unsigned long long gu64;
#define RLX_AGENT __ATOMIC_RELAXED, __HIP_MEMORY_SCOPE_AGENT
#define LDS_WAIT() asm volatile("s_waitcnt lgkmcnt(0)" ::: "memory")
#define VM_WAIT() asm volatile("s_waitcnt vmcnt(0)" ::: "memory")
__device__ __forceinline__ unsigned long long rt() { return __builtin_amdgcn_s_memrealtime(); }
__device__ __forceinline__ unsigned f2bf(float f) { unsigned u = __builtin_bit_cast(unsigned, f); return (u + 0x7fffu + ((u >> 16) & 1u)) >> 16; }
__device__ __forceinline__ unsigned pk2(float lo, float hi) { return f2bf(lo) | (f2bf(hi) << 16); }

#define XB_TMO      128
#define XB_XCNT(j)  (256  + 64 * (j))
#define XB_XSUB(j)  (1280 + 64 * (j))
#define XB_XGEN(j)  (2304 + 64 * (j))
#define XB_TOP      3328
#define XB_TOPGEN   3392
#define XCD_BAR_WORDS 3456
#define XB_SPIN_CAP (1u << 18)

__device__ __forceinline__ unsigned xb_ld(unsigned* p)              { return __hip_atomic_load(p, __ATOMIC_RELAXED, __HIP_MEMORY_SCOPE_AGENT); }
__device__ __forceinline__ unsigned xb_add(unsigned* p, unsigned v) { return __hip_atomic_fetch_add(p, v, __ATOMIC_RELAXED, __HIP_MEMORY_SCOPE_AGENT); }
__device__ __forceinline__ unsigned xb_xcc_id() { return (unsigned)__builtin_amdgcn_s_getreg((3 << 11) | 20) & 0xFu; }
#define XB_SPIN(cond, bar) do { unsigned _sp = 0; while (cond) { __builtin_amdgcn_s_sleep(1); \
    if ((++_sp & 255u) == 0u) { if (xb_ld(&(bar)[XB_TMO])) break; if (_sp > XB_SPIN_CAP) { atomicAdd(&(bar)[XB_TMO], 1u); break; } } } } while (0)

struct XcdBarrier {
    unsigned* bar; unsigned x;
    volatile LAS unsigned* st;
};

__device__ __forceinline__ XcdBarrier xcd_barrier_post(unsigned* bar, volatile LAS unsigned* st) {
    XcdBarrier b; b.bar = bar; b.x = xb_xcc_id(); b.st = st;
    if (threadIdx.x == 0) (void)xb_add(&bar[XB_XCNT(b.x)], 1u);
    return b;
}
__device__ __forceinline__ void xcd_barrier_complete(unsigned* bar, unsigned x, unsigned& nloc, unsigned& nx) {
    const unsigned G = gridDim.x * gridDim.y * gridDim.z;
    unsigned sum, cnt, mine, sp = 0u;
    for (;;) {
        sum = 0u; cnt = 0u; mine = 0u;
#pragma unroll
        for (unsigned j = 0; j < 16; ++j) { const unsigned c = xb_ld(&bar[XB_XCNT(j)]); sum += c; cnt += (c > 0u) ? 1u : 0u; mine = (j == x) ? c : mine; }
        if (sum == G) break;
        __builtin_amdgcn_s_sleep(1);
        if ((++sp & 255u) == 0u) { if (xb_ld(&bar[XB_TMO])) break; if (sp > XB_SPIN_CAP) { atomicAdd(&bar[XB_TMO], 1u); break; } }
    }
    nloc = mine > 0u ? mine : 1u; nx = cnt > 0u ? cnt : 1u;
}

__device__ __forceinline__ void xcd_barrier(const XcdBarrier& b) {
    asm volatile("s_waitcnt vmcnt(0)" ::: "memory");
    __syncthreads();
    if (threadIdx.x == 0) {
        unsigned* bar = b.bar;
        __builtin_amdgcn_s_waitcnt(0);
        unsigned nloc = b.st[0], nx = b.st[1];
        if (nloc == 0u) { xcd_barrier_complete(bar, b.x, nloc, nx); b.st[0] = nloc; b.st[1] = nx; }
        const unsigned old = xb_add(&bar[XB_XSUB(b.x)], 1u);
        const unsigned gen = old / nloc;
        if (old + 1u == (gen + 1u) * nloc) {
            __builtin_amdgcn_fence(__ATOMIC_RELEASE, "agent");
            asm volatile("s_waitcnt vmcnt(0)" ::: "memory");
            const unsigned og = xb_add(&bar[XB_TOP], 1u);
            const unsigned tg = og / nx;
            if (og + 1u == (tg + 1u) * nx) xb_add(&bar[XB_TOPGEN], 1u);
            else XB_SPIN(xb_ld(&bar[XB_TOPGEN]) == tg, bar);
            __builtin_amdgcn_fence(__ATOMIC_ACQUIRE, "agent");
            xb_add(&bar[XB_XGEN(b.x)], 1u);
            asm volatile("s_waitcnt vmcnt(0)" ::: "memory");
        } else {
            XB_SPIN(xb_ld(&bar[XB_XGEN(b.x)]) == gen, bar);
            __builtin_amdgcn_fence(__ATOMIC_ACQUIRE, "agent");
            asm volatile("s_waitcnt vmcnt(0)" ::: "memory");
        }
    }
    __syncthreads();
}

typedef __bf16 bf16x2v __attribute__((ext_vector_type(2)));
typedef float f32x16 __attribute__((ext_vector_type(16)));
__device__ __forceinline__ float bflo(unsigned w) { return __uint_as_float(w << 16); }
__device__ __forceinline__ float bfhi(unsigned w) { return __uint_as_float(w & 0xffff0000u); }
__device__ __forceinline__ float dot2bf(unsigned a, unsigned b, float c) { return __builtin_amdgcn_fdot2_f32_bf16(__builtin_bit_cast(bf16x2v, a), __builtin_bit_cast(bf16x2v, b), c, false); }
__device__ __forceinline__ float wave_sum(float v) {
#pragma unroll
    for (int o = 1; o < 64; o <<= 1) v += __shfl_xor(v, o);
    return v; }
__device__ __forceinline__ float wave_max(float v) {
#pragma unroll
    for (int o = 1; o < 64; o <<= 1) v = fmaxf(v, __shfl_xor(v, o));
    return v; }
__device__ __forceinline__ float rdlane(float v, int l) { return __int_as_float(__builtin_amdgcn_readlane(__float_as_int(v), l)); }
__device__ __forceinline__ float gelu_tanh(float x) { const float z = 0.7978845608028654f * (x + 0.044715f * x * x * x); const float e = __expf(2.0f * z); const float th = 1.0f - 2.0f * __builtin_amdgcn_rcpf(1.0f + e); return 0.5f * x * (1.0f + th); }

struct Ctx { LAS unsigned char* lds; int tid, lane, wave, vcu, G; };

__device__ __forceinline__ void p0_transpose_item(const float* W, int K, int N, bf16* WT, const float* gk, LAS float* scr, int item, int lane) {
    const int nblk = N / 32, kb = item / nblk, nb = item % nblk, k0 = 64 * kb, n0 = 32 * nb;
#pragma unroll 8
    for (int i = 0; i < 32; ++i) { const int kk = 2 * i + (lane >> 5); float v = W[(size_t)(k0 + kk) * N + n0 + (lane & 31)]; if (gk) v *= gk[k0 + kk]; scr[kk * 33 + (lane & 31)] = v; }
    LDS_WAIT(); asm volatile("" ::: "memory");
    const int c = lane & 7;
#pragma unroll
    for (int j = 0; j < 4; ++j) { const int n = (lane >> 3) + 8 * j; const LAS float* s = scr + (8 * c) * 33 + n;
        v4u o; o.x = pk2(s[0 * 33], s[1 * 33]); o.y = pk2(s[2 * 33], s[3 * 33]); o.z = pk2(s[4 * 33], s[5 * 33]); o.w = pk2(s[6 * 33], s[7 * 33]);
        *(GAS v4u*)(WT + (size_t)(n0 + n) * K + k0 + 8 * c) = o; }
    LDS_WAIT(); asm volatile("" ::: "memory");
}
__device__ __forceinline__ void convert_tables(const Ctx& F, const float* pu, const float* pv, const float* g2, unsigned char* ws) {
    const int gt = (F.vcu * NWAVES + F.wave) * 64 + F.lane, NT = F.G * NWAVES * 64;
    for (int i = gt; i < NEXP * 2048 / 16; i += NT) { const int c16 = (i & 127) * 16; v4u ou, ov;
#pragma unroll
        for (int q = 0; q < 4; ++q) { f32x4 a = ((const GAS f32x4*)pu)[4 * i + q]; a = a * *(const GAS f32x4*)(g2 + c16 + 4 * q) * 512.0f; const f32x4 b = ((const GAS f32x4*)pv)[4 * i + q] * 32.0f;
            int wu = 0, wv = 0; wu = __builtin_amdgcn_cvt_pk_fp8_f32(a[0], a[1], wu, false); wu = __builtin_amdgcn_cvt_pk_fp8_f32(a[2], a[3], wu, true);
            wv = __builtin_amdgcn_cvt_pk_fp8_f32(b[0], b[1], wv, false); wv = __builtin_amdgcn_cvt_pk_fp8_f32(b[2], b[3], wv, true); ou[q] = (unsigned)wu; ov[q] = (unsigned)wv; }
        ((GAS v4u*)(ws + WS_UB))[i] = ou; ((GAS v4u*)(ws + WS_VB))[i] = ov; }
}
__device__ __forceinline__ void p0_prologue(const Ctx& F, const float* const* in, unsigned char* ws, const double* invf) {
    const float* x = in[0]; const int* pos = (const int*)in[1]; const float* g1 = in[2]; const float* w_in = in[3];
    const float* w_bc = in[6]; const float* w_ba = in[7]; const float* w_out = in[8]; const float* g2 = in[9]; const float* w_pq = in[10];
    const float* keys = in[11]; const float* pu = in[12]; const float* pv = in[13];
    LAS float* scr = (LAS float*)(F.lds + RING_OFF + F.wave * 16384);
    const int gw = F.vcu * NWAVES + F.wave, NGW = F.G * NWAVES;
    const int gt = gw * 64 + F.lane, NT = NGW * 64;
    for (int i = gt; i < 8192; i += NT) ((GAS unsigned long long*)(ws + WS_SS))[i] = 0ull;
    for (int i = gt; i < 32 * 1024; i += NT) ((GAS float*)(ws + WS_KSUM))[i] = 0.f;
    constexpr int I_IN = 32 * 320, I_BC = 16 * 64, I_OUT = 32 * 64;
    constexpr int NITEMS = I_IN + 2 * I_BC + 2 * I_OUT;
    for (int it = gw; it < NITEMS; it += NGW) {
        int r = it;
        if (r < I_IN) { p0_transpose_item(w_in, 2048, INW, (bf16*)(ws + WS_WIN), g1, scr, r, F.lane); continue; } r -= I_IN;
        if (r < I_BC) { p0_transpose_item(w_bc, 1024, 2048, (bf16*)(ws + WS_WBC), nullptr, scr, r, F.lane); continue; } r -= I_BC;
        if (r < I_BC) { p0_transpose_item(w_ba, 1024, 2048, (bf16*)(ws + WS_WBA), nullptr, scr, r, F.lane); continue; } r -= I_BC;
        if (r < I_OUT) { p0_transpose_item(w_out, 2048, 2048, (bf16*)(ws + WS_WOUT), nullptr, scr, r, F.lane); continue; } r -= I_OUT;
        p0_transpose_item(w_pq, 2048, 2048, (bf16*)(ws + WS_WPQ), g2, scr, r, F.lane);
    }
    for (int i = gt; i < 16 * 128 * 128 / 8; i += NT) { const f32x4 a = ((const GAS f32x4*)keys)[2 * i], b = ((const GAS f32x4*)keys)[2 * i + 1];
        v4u o; o.x = pk2(a[0], a[1]); o.y = pk2(a[2], a[3]); o.z = pk2(b[0], b[1]); o.w = pk2(b[2], b[3]); ((GAS v4u*)(ws + WS_KEYS))[i] = o; }
    for (int m = gw; m < M; m += NGW) { const GAS f32x4* xr = (const GAS f32x4*)(x + (size_t)m * DM);
        f32x4 v[8]; float s = 0.f;
#pragma unroll
        for (int i = 0; i < 4; ++i) { v[2 * i] = xr[i * 128 + 2 * F.lane]; v[2 * i + 1] = xr[i * 128 + 2 * F.lane + 1]; }
#pragma unroll
        for (int i = 0; i < 8; ++i) s += (v[i][0] * v[i][0] + v[i][1] * v[i][1]) + (v[i][2] * v[i][2] + v[i][3] * v[i][3]);
        const float rinv = 1.0f / sqrtf(wave_sum(s) * (1.0f / DM) + RMS_EPS);
        GAS v4u* o = (GAS v4u*)(ws + WS_XB + (size_t)m * DM * 2);
#pragma unroll
        for (int i = 0; i < 4; ++i) { const f32x4 a = v[2 * i] * rinv, b = v[2 * i + 1] * rinv; v4u w; w.x = pk2(a[0], a[1]); w.y = pk2(a[2], a[3]); w.z = pk2(b[0], b[1]); w.w = pk2(b[2], b[3]); o[i * 64 + F.lane] = w; } }
    for (int i = gt; i < M * 16; i += NT) { const int row = i >> 4, f = i & 15; const double ang = (double)pos[row] * invf[f];
        const double k = __builtin_rint(ang * 0.15915494309189535); const float r = (float)(ang - k * 6.283185307179586);
        float* cs = (float*)(ws + WS_CS); cs[row * 32 + f] = __cosf(r); cs[row * 32 + 16 + f] = __sinf(r); }
}

__device__ __forceinline__ void attn_simple(const Ctx& F, const bf16* Q, const bf16* K, const bf16* V, const float* ksum, bf16* AO) {
    LAS float* qf = (LAS float*)(F.lds + RING_OFF + F.wave * 512);
    const int gw = F.vcu * NWAVES + F.wave, NGW = F.G * NWAVES, lane = F.lane;
    for (int item = gw; item < 16 * SEQ; item += NGW) {
        const int bh = item >> 12, t = item & 4095, b = bh >> 3, h = bh & 7, blk = t >> 8;
        const size_t row = (size_t)b * SEQ + t;
        { const unsigned qq = *(const GAS unsigned*)(Q + row * 1024 + h * 128 + 2 * lane); qf[2 * lane] = bflo(qq); qf[2 * lane + 1] = bfhi(qq); }
        LDS_WAIT(); asm volatile("" ::: "memory");
        float g = -INFINITY;
        if (lane < blk) { const GAS f32x4* km = (const GAS f32x4*)(ksum + (size_t)(b * 16 + lane) * 1024 + h * 128); float a = 0.f;
            for (int d = 0; d < 32; ++d) { const f32x4 kv = km[d]; const f32x4 qv = *(const LAS f32x4*)(qf + 4 * d); a += (kv[0] * qv[0] + kv[1] * qv[1]) + (kv[2] * qv[2] + kv[3] * qv[3]); }
            g = a; }
        int sel[3];
#pragma unroll
        for (int i = 0; i < 3; ++i) { const float mx = wave_max(g); const unsigned long long bal = __ballot(g == mx && lane < blk); const int idx = bal ? (__ffsll((long long)bal) - 1) : 0; sel[i] = idx; if (lane == idx) g = -INFINITY; }
        const int nsel = blk < 3 ? blk : 3;
        float sc[4][4]; float mx = -INFINITY;
#pragma unroll
        for (int slot = 0; slot < 4; ++slot) {
            const bool valid = (slot == 3) || (slot < nsel);
            const int kb = (slot == 3) ? blk : sel[slot < 3 ? slot : 0];
#pragma unroll
            for (int r = 0; r < 4; ++r) {
                float s = -INFINITY; const int key0 = kb * 256 + r * 64;
                if (valid && (slot < 3 || key0 <= t)) {
                    const int key = key0 + lane; const GAS v4u* kp = (const GAS v4u*)(K + ((size_t)b * SEQ + key) * 1024 + h * 128); float a = 0.f;
#pragma unroll 4
                    for (int d = 0; d < 16; ++d) { const v4u kk = kp[d]; const f32x4 q0 = *(const LAS f32x4*)(qf + 8 * d), q1 = *(const LAS f32x4*)(qf + 8 * d + 4);
                        a += (bflo(kk.x) * q0[0] + bfhi(kk.x) * q0[1]) + (bflo(kk.y) * q0[2] + bfhi(kk.y) * q0[3]) + (bflo(kk.z) * q1[0] + bfhi(kk.z) * q1[1]) + (bflo(kk.w) * q1[2] + bfhi(kk.w) * q1[3]); }
                    s = (slot < 3 || key <= t) ? a : -INFINITY; }
                sc[slot][r] = s; mx = fmaxf(mx, s); } }
        mx = wave_max(mx);
        float sum = 0.f;
#pragma unroll
        for (int slot = 0; slot < 4; ++slot)
#pragma unroll
            for (int r = 0; r < 4; ++r) { sc[slot][r] = exp2f(sc[slot][r] - mx); sum += sc[slot][r]; }
        sum = wave_sum(sum);
        float o0 = 0.f, o1 = 0.f;
#pragma unroll
        for (int slot = 0; slot < 4; ++slot) {
            const bool valid = (slot == 3) || (slot < nsel);
            const int kb = (slot == 3) ? blk : sel[slot < 3 ? slot : 0];
#pragma unroll
            for (int r = 0; r < 4; ++r) { const int key0 = kb * 256 + r * 64;
                if (valid && (slot < 3 || key0 <= t)) { const float pr = sc[slot][r]; const GAS unsigned* vp = (const GAS unsigned*)(V + ((size_t)b * SEQ + key0) * 1024 + h * 128) + lane;
                    for (int kk = 0; kk < 64; ++kk) { const float pk = rdlane(pr, kk); const unsigned vv = vp[(size_t)kk * 512]; o0 += pk * bflo(vv); o1 += pk * bfhi(vv); } } } }
        const float ri = 1.0f / sum;
        *(GAS unsigned*)(AO + row * 1024 + h * 128 + 2 * lane) = pk2(o0 * ri, o1 * ri);
    }
}
typedef short v4i16_t __attribute__((ext_vector_type(4))); typedef unsigned u32x2v __attribute__((ext_vector_type(2)));
__device__ __forceinline__ v4i16_t vtr16(unsigned addr) { return __builtin_amdgcn_ds_read_tr16_b64_v4i16((LAS v4i16_t*)(uintptr_t)addr); }
__device__ __forceinline__ int crow16(int r, int hh) { return (r & 3) + 8 * (r >> 2) + 4 * hh; }
__device__ __forceinline__ void attn_dma_step(const bf16* K, const bf16* V, LAS unsigned char* lds, int b, int h, int qb, int n_own, int st, int wave, int lane) {
    const int buf = st & 1;
#pragma unroll
    for (int img = 0; img < 4; ++img) {
        const int T = 2 * st + (img >> 1); const bool isV = img & 1;
        const int blk = (T < n_own) ? qb : ((T - n_own) >> 2), kt = (T < n_own) ? T : ((T - n_own) & 3);
        const bf16* base = (isV ? V : K) + ((size_t)b * SEQ + 256 * blk + 64 * kt) * 1024 + h * 128;
#pragma unroll
        for (int i = 0; i < 2; ++i) { const int pc = wave + 8 * i, row = 4 * pc + (lane >> 4), cp = lane & 15;
            const int c = isV ? ((((cp >> 2) ^ (row & 3)) << 2) | (cp & 3)) : (cp ^ (row & 15));
            __builtin_amdgcn_global_load_lds((const unsigned*)(base + (size_t)row * 1024 + 8 * c), (LAS unsigned*)(lds + buf * 65536 + img * 16384 + pc * 1024), 16, 0, 0); }
    }
}
__device__ __forceinline__ void attn_mfma(const Ctx& F, const bf16* Q, const bf16* K, const bf16* V, const float* ksum, bf16* AO) {
    const int lane = F.lane, wave = F.wave, q31 = lane & 31, hh = lane >> 5, wq = wave & 3, kvh = wave >> 2, l16 = lane & 15, G4 = lane >> 4;
    LAS unsigned char* lds = F.lds + RING_OFF;
    const unsigned lds0 = (unsigned)(uintptr_t)lds;
    for (int pr = F.vcu; pr < 256; pr += F.G)
#pragma unroll 1
    for (int pi = 0; pi < 2; ++pi) {
        const int bh = pr >> 4, s_ = pr & 15, u128 = pi ? 31 - s_ : s_, b = bh >> 3, h = bh & 7, qb = u128 >> 1, half = u128 & 1;
        const int n_own = half ? 4 : 2, nstep = (n_own + 4 * qb) >> 1;
        const size_t rowq = (size_t)b * SEQ + 256 * qb + 128 * half + 32 * wq + q31;
        asm volatile("s_waitcnt vmcnt(0) lgkmcnt(0)" ::: "memory"); __builtin_amdgcn_s_barrier(); asm volatile("" ::: "memory");
        attn_dma_step(K, V, lds, b, h, qb, n_own, 0, wave, lane);
        bf16x8 qf[8];
#pragma unroll
        for (int s = 0; s < 8; ++s) qf[s] = *(const GAS bf16x8*)(Q + rowq * 1024 + h * 128 + 16 * s + 8 * hh);
        unsigned selmask;
        {
            float qv[64];
#pragma unroll
            for (int s = 0; s < 8; ++s)
#pragma unroll
                for (int e = 0; e < 8; ++e) qv[8 * s + e] = __uint_as_float((unsigned)(unsigned short)qf[s][e] << 16);
            float v0 = -INFINITY, v1 = -INFINITY, v2 = -INFINITY; int i0 = 0, i1 = 0, i2 = 0;
#pragma unroll 1
            for (int j = 0; j < qb; ++j) {
                const GAS f32x4* kp = (const GAS f32x4*)(ksum + (size_t)(b * 16 + j) * 1024 + h * 128 + 8 * hh); float a = 0.f;
#pragma unroll
                for (int s = 0; s < 8; ++s) { const f32x4 k0 = kp[4 * s], k1 = kp[4 * s + 1];
                    a += (qv[8 * s] * k0[0] + qv[8 * s + 1] * k0[1]) + (qv[8 * s + 2] * k0[2] + qv[8 * s + 3] * k0[3]) + (qv[8 * s + 4] * k1[0] + qv[8 * s + 5] * k1[1]) + (qv[8 * s + 6] * k1[2] + qv[8 * s + 7] * k1[3]); }
                a += __shfl_xor(a, 32);
                if (a > v0) { v2 = v1; i2 = i1; v1 = v0; i1 = i0; v0 = a; i0 = j; } else if (a > v1) { v2 = v1; i2 = i1; v1 = a; i1 = j; } else if (a > v2) { v2 = a; i2 = j; }
            }
            selmask = (qb <= 3) ? ((1u << qb) - 1u) : ((1u << i0) | (1u << i1) | (1u << i2));
        }
        float m_run = -1e30f, l_run = 0.f; f32x16 o[4];
#pragma unroll
        for (int db = 0; db < 4; ++db)
#pragma unroll
            for (int r = 0; r < 16; ++r) o[db][r] = 0.f;
        const int qin = 128 * half + 32 * wq + q31;
#pragma unroll 1
        for (int st = 0; st < nstep; ++st) {
            asm volatile("s_waitcnt vmcnt(0)" ::: "memory"); __builtin_amdgcn_s_barrier(); asm volatile("" ::: "memory");
            if (st + 1 < nstep) attn_dma_step(K, V, lds, b, h, qb, n_own, st + 1, wave, lane);
            const int T = 2 * st + kvh; const bool own = T < n_own;
            const int blk = own ? qb : ((T - n_own) >> 2), kt = own ? T : ((T - n_own) & 3);
            const bool sel = own ? true : ((selmask >> blk) & 1u);
            const bool skip = own ? (64 * kt > 128 * half + 32 * wq + 31) : (__ballot(sel) == 0ull);
            if (!skip) {
                const unsigned kimg = lds0 + (st & 1) * 65536 + kvh * 32768, vimg = kimg + 16384;
                f32x16 p[2];
#pragma unroll
                for (int kh = 0; kh < 2; ++kh) {
#pragma unroll
                    for (int r = 0; r < 16; ++r) p[kh][r] = 0.f;
                    const int row = 32 * kh + q31;
#pragma unroll
                    for (int s = 0; s < 8; ++s) { const bf16x8 a = *(const LAS bf16x8*)(uintptr_t)(kimg + row * 256 + (((2 * s + hh) ^ (row & 15)) << 4));
                        p[kh] = __builtin_amdgcn_mfma_f32_32x32x16_bf16(a, qf[s], p[kh], 0, 0, 0); }
                }
                if (own) { const int kbase = 64 * kt;
                    if (kbase + 63 > 128 * half + 32 * wq) {
#pragma unroll
                        for (int kh = 0; kh < 2; ++kh)
#pragma unroll
                            for (int r = 0; r < 16; ++r) if (kbase + 32 * kh + crow16(r, hh) > qin) p[kh][r] = -INFINITY; }
                } else if (!sel) {
#pragma unroll
                    for (int kh = 0; kh < 2; ++kh)
#pragma unroll
                        for (int r = 0; r < 16; ++r) p[kh][r] = -INFINITY; }
                float mx = p[0][0];
#pragma unroll
                for (int r = 1; r < 16; ++r) mx = fmaxf(mx, p[0][r]);
#pragma unroll
                for (int r = 0; r < 16; ++r) mx = fmaxf(mx, p[1][r]);
                mx = fmaxf(mx, __shfl_xor(mx, 32));
                const float m_new = fmaxf(m_run, mx), scl = exp2f(m_run - m_new); m_run = m_new;
                float rs = 0.f;
#pragma unroll
                for (int kh = 0; kh < 2; ++kh)
#pragma unroll
                    for (int r = 0; r < 16; ++r) { p[kh][r] = exp2f(p[kh][r] - m_new); rs += p[kh][r]; }
                l_run = l_run * scl + rs;
#pragma unroll
                for (int db = 0; db < 4; ++db)
#pragma unroll
                    for (int r = 0; r < 16; ++r) o[db][r] *= scl;
#pragma unroll
                for (int kh = 0; kh < 2; ++kh)
#pragma unroll
                    for (int s2 = 0; s2 < 2; ++s2) {
                        v4u pw; pw.x = pg8::cvt_pk_bf16(p[kh][8 * s2], p[kh][8 * s2 + 1]); pw.y = pg8::cvt_pk_bf16(p[kh][8 * s2 + 2], p[kh][8 * s2 + 3]);
                        pw.z = pg8::cvt_pk_bf16(p[kh][8 * s2 + 4], p[kh][8 * s2 + 5]); pw.w = pg8::cvt_pk_bf16(p[kh][8 * s2 + 6], p[kh][8 * s2 + 7]);
                        const bf16x8 pb = __builtin_bit_cast(bf16x8, pw);
                        const int key0 = 32 * kh + 16 * s2 + 4 * (G4 >> 1) + (l16 >> 2);
#pragma unroll
                        for (int db = 0; db < 4; ++db) {
                            const int dsub = 16 * (G4 & 1) + 4 * (l16 & 3);
                            const unsigned a0 = vimg + key0 * 256 + ((db ^ (key0 & 3)) << 6) + dsub * 2;
                            const v4i16_t lo = vtr16(a0), hi_ = vtr16(a0 + 8 * 256);
                            const bf16x8 av = {lo[0], lo[1], lo[2], lo[3], hi_[0], hi_[1], hi_[2], hi_[3]};
                            o[db] = __builtin_amdgcn_mfma_f32_32x32x16_bf16(av, pb, o[db], 0, 0, 0);
                        }
                    }
            }
        }
        l_run += __shfl_xor(l_run, 32);
        asm volatile("s_waitcnt vmcnt(0) lgkmcnt(0)" ::: "memory"); __builtin_amdgcn_s_barrier(); asm volatile("" ::: "memory");
        LAS float* xs = (LAS float*)lds + (size_t)wq * 66 * 64 + lane;
        if (kvh == 1) {
            xs[0] = m_run; xs[64] = l_run;
#pragma unroll
            for (int db = 0; db < 4; ++db)
#pragma unroll
                for (int r = 0; r < 16; ++r) xs[(2 + 16 * db + r) * 64] = o[db][r];
        }
        asm volatile("s_waitcnt lgkmcnt(0)" ::: "memory"); __builtin_amdgcn_s_barrier(); asm volatile("" ::: "memory");
        if (kvh == 0) {
            const float m2 = xs[0], l2 = xs[64], mt = fmaxf(m_run, m2), a1 = exp2f(m_run - mt), a2 = exp2f(m2 - mt);
            const float inv = 1.0f / (l_run * a1 + l2 * a2), c1 = a1 * inv, c2 = a2 * inv;
            bf16* orow = AO + rowq * 1024 + h * 128 + 4 * hh;
#pragma unroll
            for (int db = 0; db < 4; ++db)
#pragma unroll
                for (int g = 0; g < 4; ++g) {
                    float t[4];
#pragma unroll
                    for (int e = 0; e < 4; ++e) t[e] = o[db][4 * g + e] * c1 + xs[(2 + 16 * db + 4 * g + e) * 64] * c2;
                    u32x2v w; w.x = pg8::cvt_pk_bf16(t[0], t[1]); w.y = pg8::cvt_pk_bf16(t[2], t[3]);
                    *(GAS u32x2v*)(orow + 32 * db + 8 * g) = w;
                }
        }
    }
    asm volatile("s_waitcnt vmcnt(0) lgkmcnt(0)" ::: "memory"); __builtin_amdgcn_s_barrier(); asm volatile("" ::: "memory");
}
__device__ __forceinline__ void up8(const v4u w, float (&f)[8]) { f[0] = bflo(w.x); f[1] = bfhi(w.x); f[2] = bflo(w.y); f[3] = bfhi(w.y); f[4] = bflo(w.z); f[5] = bfhi(w.z); f[6] = bflo(w.w); f[7] = bfhi(w.w); }
__device__ __forceinline__ void conv_phase(const Ctx& F, const bf16* CB, const bf16* CC, const bf16* CX, const float* cw, bf16* UC) {
    const int gt = (F.vcu * NWAVES + F.wave) * 64 + F.lane, NT = F.G * NWAVES * 64;
    for (int idx = gt; idx < M * 128; idx += NT) {
        const int row = idx >> 7, c8 = (idx & 127) << 3, t = row & (SEQ - 1); const size_t off = (size_t)row * 1024 + c8;
        float cb[8], a[8], x[8], z0[8], z1[8], z2[8];
        up8(*(const GAS v4u*)(CB + off), cb); up8(*(const GAS v4u*)(CC + off), a); up8(*(const GAS v4u*)(CX + off), x);
#pragma unroll
        for (int j = 0; j < 8; ++j) z0[j] = a[j] * x[j];
        if (t >= 1) { up8(*(const GAS v4u*)(CC + off - 1024), a); up8(*(const GAS v4u*)(CX + off - 1024), x);
#pragma unroll
            for (int j = 0; j < 8; ++j) z1[j] = a[j] * x[j]; } else {
#pragma unroll
            for (int j = 0; j < 8; ++j) z1[j] = 0.f; }
        if (t >= 2) { up8(*(const GAS v4u*)(CC + off - 2048), a); up8(*(const GAS v4u*)(CX + off - 2048), x);
#pragma unroll
            for (int j = 0; j < 8; ++j) z2[j] = a[j] * x[j]; } else {
#pragma unroll
            for (int j = 0; j < 8; ++j) z2[j] = 0.f; }
        float o[8];
#pragma unroll
        for (int j = 0; j < 8; ++j) o[j] = cb[j] * (cw[c8 + j] * z2[j] + cw[1024 + c8 + j] * z1[j] + cw[2048 + c8 + j] * z0[j]);
        v4u w; w.x = pk2(o[0], o[1]); w.y = pk2(o[2], o[3]); w.z = pk2(o[4], o[5]); w.w = pk2(o[6], o[7]); *(GAS v4u*)(UC + off) = w;
    }
}

__device__ __forceinline__ int imax(int a, int b) { return a > b ? a : b; }
__device__ __forceinline__ int imin(int a, int b) { return a < b ? a : b; }
__device__ __forceinline__ void ce(int& a, int& b) { const int t = imax(a, b); b = imin(a, b); a = t; }
__device__ __forceinline__ void sort16(int (&x)[16]) {
#pragma unroll
    for (int kk = 1; kk <= 4; ++kk)
#pragma unroll
        for (int jj = kk - 1; jj >= 0; --jj)
#pragma unroll
            for (int i = 0; i < 16; ++i) { const int k = 1 << kk, j = 1 << jj, l = i ^ j; if (l > i) { if ((i & k) == 0) ce(x[i], x[l]); else ce(x[l], x[i]); } }
}
__device__ __forceinline__ void bmerge16(int (&a)[16]) {
#pragma unroll
    for (int jj = 3; jj >= 0; --jj)
#pragma unroll
        for (int i = 0; i < 16; ++i) { const int j = 1 << jj, l = i ^ j; if (l > i) ce(a[i], a[l]); }
}
__device__ __forceinline__ void merge16(int (&a)[16], const int (&b)[16]) {
#pragma unroll
    for (int i = 0; i < 16; ++i) a[i] = imax(a[i], b[15 - i]);
    bmerge16(a);
}
__device__ __forceinline__ void xmerge16(int (&a)[16], int hh) {
    int pv[16];
#pragma unroll
    for (int i = 0; i < 16; ++i) { const auto r = __builtin_amdgcn_permlane32_swap((unsigned)a[15 - i], (unsigned)a[15 - i], false, false); pv[i] = hh ? (int)r[0] : (int)r[1]; }
#pragma unroll
    for (int i = 0; i < 16; ++i) a[i] = imax(a[i], pv[i]);
    bmerge16(a);
}
__device__ __forceinline__ int ord_key(float f) { const int u = __float_as_int(f); return u >= 0 ? u : (u ^ 0x7fffffff); }
__device__ __forceinline__ float ord_val(int k) { return __int_as_float(k >= 0 ? k : (k ^ 0x7fffffff)); }
__device__ __forceinline__ unsigned byte16(const unsigned (&t)[4], int idx) {
    const unsigned sel = 0x0c0c0c00u | (unsigned)(idx & 7);
    const unsigned lo = __builtin_amdgcn_perm(t[1], t[0], sel), hi_ = __builtin_amdgcn_perm(t[3], t[2], sel);
    return (idx & 8) ? hi_ : lo;
}
__device__ __forceinline__ void topk_stage_keys(const Ctx& F, const bf16* KEYS, int h) {
    for (int pc = F.wave; pc < 64; pc += 8) { const int pp = pc >> 5, row = 4 * (pc & 31) + (F.lane >> 4), cp = F.lane & 15, c = cp ^ (row & 15);
        __builtin_amdgcn_global_load_lds((const unsigned*)(KEYS + (size_t)((h * 2 + pp) * 128 + row) * 128 + 8 * c), (LAS unsigned*)(F.lds + RING_OFF + pc * 1024), 16, 0, 0); }
    asm volatile("s_waitcnt vmcnt(0)" ::: "memory"); __builtin_amdgcn_s_barrier(); asm volatile("" ::: "memory");
}
__device__ __forceinline__ void topk_phase(const Ctx& F, int bitem, const bf16* QP, int* EXP, float* GATE) {
    const int lane = F.lane, l31 = lane & 31, hh = lane >> 5;
    const int IMIN = (int)0x80000000;
    const unsigned lds0 = (unsigned)(uintptr_t)(F.lds + RING_OFF);
    {
        const int h = bitem & 7, tt = (bitem >> 3) * 8 + F.wave, tok0 = tt * 32;
        int top[2][16];
#pragma unroll
        for (int p = 0; p < 2; ++p) {
            f32x16 sc[4];
#pragma unroll
            for (int nt = 0; nt < 4; ++nt)
#pragma unroll
                for (int r = 0; r < 16; ++r) sc[nt][r] = 0.f;
            bf16x8 qa[8];
#pragma unroll
            for (int s = 0; s < 8; ++s) qa[s] = *(const GAS bf16x8*)(QP + (size_t)(tok0 + l31) * 2048 + h * 256 + p * 128 + 16 * s + 8 * hh);
#pragma unroll
            for (int s = 0; s < 8; ++s) {
#pragma unroll
                for (int nt = 0; nt < 4; ++nt) { const int n = 32 * nt + l31; const bf16x8 kb = *(const LAS bf16x8*)(uintptr_t)(lds0 + p * 32768 + n * 256 + (((2 * s + hh) ^ (n & 15)) << 4));
                    sc[nt] = __builtin_amdgcn_mfma_f32_32x32x16_bf16(kb, qa[s], sc[nt], 0, 0, 0); }
            }
            int x[4][16];
#pragma unroll
            for (int nt = 0; nt < 4; ++nt)
#pragma unroll
                for (int r = 0; r < 16; ++r) x[nt][r] = (ord_key(sc[nt][r]) & ~127) | ((127 - 32 * nt - (r & 3) - 8 * (r >> 2)) - 4 * hh);
            sort16(x[0]); sort16(x[1]); sort16(x[2]); sort16(x[3]);
            merge16(x[0], x[1]); merge16(x[2], x[3]); merge16(x[0], x[2]);
            xmerge16(x[0], hh);
#pragma unroll
            for (int i = 0; i < 16; ++i) top[p][i] = x[0][i];
        }
        float fa[16], fb[16];
#pragma unroll
        for (int i = 0; i < 16; ++i) { const int A = hh ? top[1][i] : top[0][i], B = hh ? top[0][i] : top[1][i]; fa[i] = ord_val(A & ~127); fb[i] = ord_val(B & ~127); }
        int c0[16], c1[16];
#pragma unroll
        for (int q = 0; q < 32; ++q) {
            int key = IMIN;
            if (q < 27) { const int i = (q < 16) ? 0 : (q < 23) ? 1 : (q < 26) ? 2 : 3, j = (q < 16) ? q : (q < 23) ? q - 15 : (q < 26) ? q - 21 : 3; const float sv = fa[i] + fb[j]; const int low = hh ? (255 - (j * 16 + i)) : (255 - (i * 16 + j));
                key = (ord_key(sv) & ~255) | low; if (i == j && hh) key = IMIN; }
            if (q < 16) c0[q] = key; else c1[q - 16] = key;
        }
        sort16(c0); sort16(c1); merge16(c0, c1); xmerge16(c0, hh);
        unsigned na[4], nb[4];
#pragma unroll
        for (int d = 0; d < 4; ++d) { na[d] = 0u; nb[d] = 0u;
#pragma unroll
            for (int e = 0; e < 4; ++e) { na[d] |= (unsigned)(127 - (top[0][4 * d + e] & 127)) << (8 * e); nb[d] |= (unsigned)(127 - (top[1][4 * d + e] & 127)) << (8 * e); } }
        int ex[16]; float ev[16]; float es = 0.f; const float smax = ord_val(c0[0] & ~255);
#pragma unroll
        for (int q = 0; q < 16; ++q) { const int posn = 255 - (c0[q] & 255); const unsigned n1 = byte16(na, posn >> 4) & 255u, n2 = byte16(nb, posn & 15) & 255u;
            ex[q] = (int)(n1 * 128u + n2); ev[q] = __expf(ord_val(c0[q] & ~255) - smax); es += ev[q]; }
        const float ri = 1.0f / es; const size_t ob = (size_t)(tok0 + l31) * 128 + h * 16;
        if (hh == 0) {
#pragma unroll
            for (int d = 0; d < 4; ++d) { v4u w; w.x = (unsigned)ex[4 * d]; w.y = (unsigned)ex[4 * d + 1]; w.z = (unsigned)ex[4 * d + 2]; w.w = (unsigned)ex[4 * d + 3]; *(GAS v4u*)(EXP + ob + 4 * d) = w; }
        } else {
#pragma unroll
            for (int d = 0; d < 4; ++d) *(GAS f32x4*)(GATE + ob + 4 * d) = (f32x4){ev[4 * d] * ri, ev[4 * d + 1] * ri, ev[4 * d + 2] * ri, ev[4 * d + 3] * ri};
        }
    }
}

typedef float f32x2 __attribute__((ext_vector_type(2)));
constexpr float PEER_SU = 512.0f, PEER_SV = 32.0f;
template <int D> __device__ __forceinline__ void tr_step(float (&part)[64], int lane) {
    const bool up_ = (lane & D) != 0;
#pragma unroll
    for (int i = 0; i < D; ++i) { const float a = part[i], b = part[i + D]; const float send = up_ ? a : b, keep = up_ ? b : a; part[i] = keep + __shfl_xor(send, D); }
}
__device__ __forceinline__ void peer_phase(const Ctx& F, const unsigned char* U8, const unsigned char* V8, const bf16* X1B, const int* EXP, const float* GATE, const unsigned long long* SS, const float* gfin, const float* X1, float* OUT) {
    const int gw = F.vcu * NWAVES + F.wave, NGW = F.G * NWAVES, lane = F.lane;
    constexpr int NPF = 8;
    for (int t = gw; t < M; t += NGW) {
        const int e01[2] = { EXP[(size_t)t * 128 + lane], EXP[(size_t)t * 128 + 64 + lane] };
        const float g01[2] = { GATE[(size_t)t * 128 + lane], GATE[(size_t)t * 128 + 64 + lane] };
        const float rinv2 = pg8::rinv_from_ss(SS[t]) * (1.0f / PEER_SU);
        f32x2 xv[16];
#pragma unroll
        for (int i = 0; i < 2; ++i)
#pragma unroll
            for (int hv = 0; hv < 2; ++hv) { const v4u w = *(const GAS v4u*)(X1B + (size_t)t * DM + i * 1024 + lane * 16 + 8 * hv);
                xv[8 * i + 4 * hv + 0] = (f32x2){bflo(w.x), bfhi(w.x)}; xv[8 * i + 4 * hv + 1] = (f32x2){bflo(w.y), bfhi(w.y)}; xv[8 * i + 4 * hv + 2] = (f32x2){bflo(w.z), bfhi(w.z)}; xv[8 * i + 4 * hv + 3] = (f32x2){bflo(w.w), bfhi(w.w)}; }
        float act[2];
#pragma unroll
        for (int hf = 0; hf < 2; ++hf) {
            const int ev = e01[hf];
            float part[64]; v4u ub[NPF][2];
#pragma unroll
            for (int k = 0; k < NPF; ++k) { const GAS v4u* up = (const GAS v4u*)(U8 + (size_t)__builtin_amdgcn_readlane(ev, k) * 2048) + lane; ub[k][0] = up[0]; ub[k][1] = up[64]; }
#pragma unroll
            for (int k = 0; k < 64; ++k) {
                f32x2 p0 = {0.f, 0.f}, p1 = {0.f, 0.f};
#pragma unroll
                for (int i = 0; i < 2; ++i) { const v4u w = ub[k % NPF][i];
                    p0 += __builtin_amdgcn_cvt_pk_f32_fp8((int)w.x, false) * xv[8 * i + 0]; p1 += __builtin_amdgcn_cvt_pk_f32_fp8((int)w.x, true) * xv[8 * i + 1];
                    p0 += __builtin_amdgcn_cvt_pk_f32_fp8((int)w.y, false) * xv[8 * i + 2]; p1 += __builtin_amdgcn_cvt_pk_f32_fp8((int)w.y, true) * xv[8 * i + 3];
                    p0 += __builtin_amdgcn_cvt_pk_f32_fp8((int)w.z, false) * xv[8 * i + 4]; p1 += __builtin_amdgcn_cvt_pk_f32_fp8((int)w.z, true) * xv[8 * i + 5];
                    p0 += __builtin_amdgcn_cvt_pk_f32_fp8((int)w.w, false) * xv[8 * i + 6]; p1 += __builtin_amdgcn_cvt_pk_f32_fp8((int)w.w, true) * xv[8 * i + 7]; }
                part[k] = (p0[0] + p0[1]) + (p1[0] + p1[1]);
                if (k + NPF < 64) { const GAS v4u* up = (const GAS v4u*)(U8 + (size_t)__builtin_amdgcn_readlane(ev, k + NPF) * 2048) + lane; ub[k % NPF][0] = up[0]; ub[k % NPF][1] = up[64]; }
            }
            tr_step<32>(part, lane); tr_step<16>(part, lane); tr_step<8>(part, lane); tr_step<4>(part, lane); tr_step<2>(part, lane); tr_step<1>(part, lane);
            act[hf] = gelu_tanh(part[0] * rinv2) * g01[hf] * (1.0f / PEER_SV);
        }
        f32x2 y[16];
#pragma unroll
        for (int j = 0; j < 16; ++j) y[j] = (f32x2){0.f, 0.f};
#pragma unroll
        for (int hf = 0; hf < 2; ++hf) {
            const int ev = e01[hf]; const float av = act[hf];
            v4u vb[NPF][2];
#pragma unroll
            for (int k = 0; k < NPF; ++k) { const GAS v4u* vp = (const GAS v4u*)(V8 + (size_t)__builtin_amdgcn_readlane(ev, k) * 2048) + lane; vb[k][0] = vp[0]; vb[k][1] = vp[64]; }
#pragma unroll
            for (int k = 0; k < 64; ++k) {
                const float s = rdlane(av, k); const f32x2 s2 = {s, s};
#pragma unroll
                for (int i = 0; i < 2; ++i) { const v4u w = vb[k % NPF][i];
                    y[8 * i + 0] += s2 * __builtin_amdgcn_cvt_pk_f32_fp8((int)w.x, false); y[8 * i + 1] += s2 * __builtin_amdgcn_cvt_pk_f32_fp8((int)w.x, true);
                    y[8 * i + 2] += s2 * __builtin_amdgcn_cvt_pk_f32_fp8((int)w.y, false); y[8 * i + 3] += s2 * __builtin_amdgcn_cvt_pk_f32_fp8((int)w.y, true);
                    y[8 * i + 4] += s2 * __builtin_amdgcn_cvt_pk_f32_fp8((int)w.z, false); y[8 * i + 5] += s2 * __builtin_amdgcn_cvt_pk_f32_fp8((int)w.z, true);
                    y[8 * i + 6] += s2 * __builtin_amdgcn_cvt_pk_f32_fp8((int)w.w, false); y[8 * i + 7] += s2 * __builtin_amdgcn_cvt_pk_f32_fp8((int)w.w, true); }
                if (k + NPF < 64) { const GAS v4u* vp = (const GAS v4u*)(V8 + (size_t)__builtin_amdgcn_readlane(ev, k + NPF) * 2048) + lane; vb[k % NPF][0] = vp[0]; vb[k % NPF][1] = vp[64]; }
            }
        }
        const GAS f32x4* xr = (const GAS f32x4*)(X1 + (size_t)t * DM); GAS f32x4* orw = (GAS f32x4*)(OUT + (size_t)t * DM); float ss = 0.f;
#pragma unroll
        for (int i = 0; i < 2; ++i)
#pragma unroll
            for (int q = 0; q < 4; ++q) { const f32x4 a = xr[i * 256 + 4 * lane + q]; y[8 * i + 2 * q] += (f32x2){a[0], a[1]}; y[8 * i + 2 * q + 1] += (f32x2){a[2], a[3]}; }
#pragma unroll
        for (int j = 0; j < 16; ++j) ss += y[j][0] * y[j][0] + y[j][1] * y[j][1];
        const float r3 = 1.0f / sqrtf(wave_sum(ss) * (1.0f / DM) + RMS_EPS);
#pragma unroll
        for (int i = 0; i < 2; ++i)
#pragma unroll
            for (int q = 0; q < 4; ++q) { const f32x4 ga = *(const GAS f32x4*)(gfin + i * 1024 + lane * 16 + 4 * q);
                orw[i * 256 + 4 * lane + q] = (f32x4){y[8 * i + 2 * q][0] * r3 * ga[0], y[8 * i + 2 * q][1] * r3 * ga[1], y[8 * i + 2 * q + 1][0] * r3 * ga[2], y[8 * i + 2 * q + 1][1] * r3 * ga[3]}; }
    }
}

struct Args { const float* in[15]; float* out; unsigned char* ws; double invf[16]; int ph_lo, ph_hi, li, pad; };
__global__ void __launch_bounds__(NWAVES * 64, 2) mk_fwd(Args args) {
    extern __shared__ __attribute__((aligned(16))) unsigned char lds[];
    Ctx F;
    F.lds = (LAS unsigned char*)lds;
    volatile LAS unsigned* MISC = (volatile LAS unsigned*)(F.lds + MISC_OFF);
    F.tid = threadIdx.x; F.lane = F.tid & 63; F.wave = __builtin_amdgcn_readfirstlane(F.tid >> 6);
    F.G = gridDim.x; { const int bx = blockIdx.x; F.vcu = (F.G % 8 == 0) ? (bx % 8) * (F.G / 8) + bx / 8 : bx; }
    unsigned char* ws = args.ws;
    gu32* ctl = (gu32*)(ws + WS_CTL);
    for (int u = F.tid; u < (LDS_BYTES - LDSCTL_OFF) / 4; u += NWAVES * 64) ((LAS unsigned*)(F.lds + LDSCTL_OFF))[u] = 0u;
    __syncthreads();
    XcdBarrier bar; bar.bar = (unsigned*)(ctl + CW_BAR); bar.x = 0; bar.st = nullptr;
    if (N_LAUNCHES != PER_PHASE) bar = xcd_barrier_post((unsigned*)(ctl + CW_BAR), MISC + 8);
#define GRID_BAR() do { if (N_LAUNCHES != PER_PHASE) xcd_barrier(bar); } while (0)
    const int lo = args.ph_lo, hi = args.ph_hi;
#define IN(k) (lo <= (k) && (k) < hi)
#define BOTH(k) (IN(k) && IN((k) + 1))
    bf16* WinT = (bf16*)(ws + WS_WIN); bf16* WbcT = (bf16*)(ws + WS_WBC); bf16* WbaT = (bf16*)(ws + WS_WBA); bf16* WoutT = (bf16*)(ws + WS_WOUT); bf16* WpqT = (bf16*)(ws + WS_WPQ);
    bf16* KEYS = (bf16*)(ws + WS_KEYS); float* CS = (float*)(ws + WS_CS); const unsigned char* UB = ws + WS_UB; const unsigned char* VB = ws + WS_VB;
    bf16* XB = (bf16*)(ws + WS_XB); bf16* T6 = (bf16*)(ws + WS_T6); bf16* GAB = (bf16*)(ws + WS_GAB); bf16* UC = (bf16*)(ws + WS_UC); bf16* AO = (bf16*)(ws + WS_AO);
    bf16* TMP = (bf16*)(ws + WS_TMP); bf16* MB = (bf16*)(ws + WS_MB); bf16* X1B = (bf16*)(ws + WS_X1B); bf16* QP = (bf16*)(ws + WS_QP);
    int* EXP = (int*)(ws + WS_EXP); float* GATE = (float*)(ws + WS_GATE);
    unsigned long long* SS = (unsigned long long*)(ws + WS_SS); float* KSUM = (float*)(ws + WS_KSUM);
    constexpr size_t TS = (size_t)M * 1024;

    if (IN(0)) { for (int rep = 0; rep < NREP(0); ++rep) { p0_prologue(F, args.in, ws, args.invf); if (rep + 1 < NREP(0)) GRID_BAR(); } if (BOTH(0)) GRID_BAR(); }
    if (IN(1)) {
        for (int rep = 0; rep < NREP(1); ++rep) {
        pg8::Gemm g{XB, WinT, M, INW, DM}; pg8::StaticOrder S; S.init(M, INW, F.G, (int)blockIdx.x);
        pg8::EpiIn E{T6, GAB, args.in[4], CS, KSUM};
        pg8::gemm_phase<pg8::EpiIn, pg8::StaticOrder, true, true>(F.lds + RING_OFF, g, S, E);
        if (rep + 1 < NREP(1)) GRID_BAR(); }
        if (BOTH(1)) GRID_BAR();
    }
    if (IN(2)) {
        for (int rep = 0; rep < NREP(2); ++rep) {
        attn_mfma(F, T6 + 3 * TS, T6 + 4 * TS, T6 + 5 * TS, KSUM, AO);
        conv_phase(F, T6, T6 + TS, T6 + 2 * TS, args.in[5], UC);
        if (rep + 1 < NREP(2)) GRID_BAR(); }
        if (BOTH(2)) GRID_BAR();
    }
    if (IN(3)) {
        for (int rep = 0; rep < NREP(3); ++rep) {
        pg8::Gemm g{UC, WbcT, M, DM, 1024}; pg8::StaticOrder S; S.init(M, DM, F.G, (int)blockIdx.x);
        pg8::EpiTmp E{GAB, TMP};
        pg8::gemm_phase<pg8::EpiTmp, pg8::StaticOrder, true, true>(F.lds + RING_OFF, g, S, E);
        if (rep + 1 < NREP(3)) GRID_BAR(); }
        if (BOTH(3)) GRID_BAR();
    }
    if (IN(4)) {
        for (int rep = 0; rep < NREP(4); ++rep) {
        pg8::Gemm g{AO, WbaT, M, DM, 1024}; pg8::StaticOrder S; S.init(M, DM, F.G, (int)blockIdx.x);
        pg8::EpiMerge E{GAB + (size_t)M * DM, TMP, MB};
        pg8::gemm_phase<pg8::EpiMerge, pg8::StaticOrder, true, true>(F.lds + RING_OFF, g, S, E);
        if (rep + 1 < NREP(4)) GRID_BAR(); }
        if (BOTH(4)) GRID_BAR();
    }
    if (IN(5)) {
        for (int rep = 0; rep < NREP(5); ++rep) {
        pg8::Gemm g{MB, WoutT, M, DM, DM}; pg8::StaticOrder S; S.init(M, DM, F.G, (int)blockIdx.x);
        pg8::EpiX1 E{args.in[0], args.out, X1B, (rep + 1 < NREP(5)) ? (unsigned long long*)(ws + 768 * 1024) : SS};
        pg8::gemm_phase<pg8::EpiX1, pg8::StaticOrder, true, true>(F.lds + RING_OFF, g, S, E);
        if (rep + 1 < NREP(5)) GRID_BAR(); }
        if (BOTH(5)) GRID_BAR();
    }
    if (IN(6)) {
        for (int rep = 0; rep < NREP(6); ++rep) {
        pg8::Gemm g{X1B, WpqT, M, DM, DM}; pg8::StaticOrder S; S.init(M, DM, F.G, (int)blockIdx.x);
        pg8::EpiQP E{SS, QP};
        pg8::gemm_phase<pg8::EpiQP, pg8::StaticOrder, true, true>(F.lds + RING_OFF, g, S, E);
        if (rep + 1 < NREP(6)) GRID_BAR(); }
        if (BOTH(6)) GRID_BAR();
    }
    if (IN(7)) { for (int rep = 0; rep < NREP(7); ++rep) {
        for (int bitem = F.vcu; bitem < 256; bitem += F.G) {
            topk_stage_keys(F, KEYS, bitem & 7);
            if (F.wave >= 4 && bitem == F.vcu) convert_tables(F, args.in[12], args.in[13], args.in[9], ws);
            topk_phase(F, bitem, QP, EXP, GATE);
            if (F.wave < 4 && bitem == F.vcu) convert_tables(F, args.in[12], args.in[13], args.in[9], ws);
            asm volatile("s_waitcnt lgkmcnt(0)" ::: "memory"); __builtin_amdgcn_s_barrier(); asm volatile("" ::: "memory");
        }
        if (rep + 1 < NREP(7)) GRID_BAR(); } if (BOTH(7)) GRID_BAR(); }
    if (IN(8)) { for (int rep = 0; rep < NREP(8); ++rep) { peer_phase(F, UB, VB, X1B, EXP, GATE, SS, args.in[14], args.out, (rep + 1 < NREP(8)) ? (float*)(ws + WS_END) : args.out); if (rep + 1 < NREP(8)) GRID_BAR(); } }
#undef IN
#undef BOTH
#undef GRID_BAR
}

extern "C" void kernel_launch(void* const* d_in, const int* in_sizes, int n_in, void* d_out, int out_size, void* d_ws, size_t ws_size, hipStream_t stream) {
    static int grid = 0;
    if (grid == 0) {
        if (n_in != 15 || in_sizes[0] != M * DM || out_size != M * DM || ws_size < WS_END) { fprintf(stderr, "kernel_launch: unexpected shapes (n_in %d, in0 %d, out %d, ws %zu)\n", n_in, n_in > 0 ? in_sizes[0] : -1, out_size, ws_size); grid = -1; return; }
        int dev = 0, cus = 0, per_cu = 0;
        if (hipGetDevice(&dev) != hipSuccess || hipDeviceGetAttribute(&cus, hipDeviceAttributeMultiprocessorCount, dev) != hipSuccess) { grid = -1; return; }
        if (hipFuncSetAttribute((const void*)mk_fwd, hipFuncAttributeMaxDynamicSharedMemorySize, LDS_BYTES) != hipSuccess) { fprintf(stderr, "kernel_launch: hipFuncSetAttribute failed\n"); grid = -1; return; }
        if (hipOccupancyMaxActiveBlocksPerMultiprocessor(&per_cu, (const void*)mk_fwd, NWAVES * 64, LDS_BYTES) != hipSuccess || per_cu < 1) fprintf(stderr, "kernel_launch: occupancy query reports %d\n", per_cu);
        (void)hipGetLastError();
        grid = cus;
    }
    if (grid < 0) return;
    if (hipMemsetAsync((char*)d_ws + WS_CTL, 0, CTL_ZERO_BYTES, stream) != hipSuccess) { fprintf(stderr, "kernel_launch: memset failed\n"); return; }
    Args a{};
    for (int i = 0; i < 15; ++i) a.in[i] = (const float*)d_in[i];
    a.out = (float*)d_out; a.ws = (unsigned char*)d_ws;
    for (int f = 0; f < 16; ++f) a.invf[f] = pow(500000.0, -(double)(2 * f) / 32.0);
    for (int li = 0; li < N_LAUNCHES; ++li) {
        a.ph_lo = (N_LAUNCHES == PER_PHASE) ? li : 0; a.ph_hi = (N_LAUNCHES == PER_PHASE) ? li + 1 : PER_PHASE; a.li = li;
        hipLaunchKernelGGL(mk_fwd, dim3(grid), dim3(NWAVES * 64), LDS_BYTES, stream, a);
        const hipError_t le = hipPeekAtLastError();
        if (le != hipSuccess) { fprintf(stderr, "kernel_launch: launch %d failed: %s\n", li, hipGetErrorName(le)); break; }
    }
}
```

```cpp
#include <hip/hip_runtime.h>
#include <cstdio>
#include <cstdint>
#include <cmath>
namespace pg8 {
#define PG8_LAS __attribute__((address_space(3)))
typedef unsigned short bf16_t;
typedef short bf16x8 __attribute__((ext_vector_type(8)));
typedef float f32x4 __attribute__((ext_vector_type(4)));
typedef unsigned u32x4 __attribute__((ext_vector_type(4)));
constexpr int BM = 256, BK = 64, HALF = 128, HTB = HALF * BK * 2  , STAGE_BYTES = 8 * HTB, NXCD = 8, WGM = 8;

__host__ __device__ __forceinline__ int lds_byte(int r, int c) { const int st = (r >> 4) * 2 + (c >> 5), rr = r & 15, cc = c & 31, ob = rr * 64 + cc * 2; return st * 1024 + (ob ^ (((ob >> 9) & 1) << 5)); }
__host__ __device__ __forceinline__ void stage_rc(int b, int& R, int& C) { const int st = b / 1024, sb = b % 1024, swz = sb ^ (((sb >> 9) & 1) << 5); R = (st >> 1) * 16 + swz / 64; C = (st & 1) * 32 + (swz % 64) / 2; }
__host__ __device__ __forceinline__ int perm32(int rho) { const int n = rho >> 4, i = rho & 15; return 8 * (i >> 2) + 4 * n + (i & 3); }

struct Unit { int pm, pn; };
struct Gemm { const bf16_t* A; const bf16_t* Bt; int M, N, K; };

struct StaticOrder {
    int nM, nN, nwg, G, c;
    __host__ __device__ void init(int M, int N, int G_, int c_) { nM = M / BM; nN = N / BM; nwg = nM * nN; G = G_; c = c_; }
    __host__ __device__ bool next(int i, Unit& u) const {
        const long L = (long)i * G + c; if (L >= nwg) return false;
        int wgid = (int)L; { const int q = nwg / NXCD, r = nwg % NXCD, xcd = wgid % NXCD, off = wgid / NXCD; wgid = (xcd < r ? xcd * (q + 1) : r * (q + 1) + (xcd - r) * q) + off; }
        const int nig = WGM * nN, gid = wgid / nig, fm = gid * WGM, gsz = (nM - fm) < WGM ? (nM - fm) : WGM;
        u.pm = fm + ((wgid % nig) % gsz); u.pn = (wgid % nig) / gsz; return true;
    }
    __device__ __forceinline__ void a_ready(const Unit&) const {}
    __device__ __forceinline__ void done(const Unit&) const {}
};


typedef float f32x2c __attribute__((ext_vector_type(2))); typedef __bf16 bf16x2c __attribute__((ext_vector_type(2)));
__device__ __forceinline__ unsigned cvt_pk_bf16(float lo, float hi) { const f32x2c v = {lo, hi}; const bf16x2c b = __builtin_convertvector(v, bf16x2c); return __builtin_bit_cast(unsigned, b); }
__device__ __forceinline__ u32x4 pack8(f32x4 a, f32x4 b) { u32x4 w; w.x = cvt_pk_bf16(a[0], a[1]); w.y = cvt_pk_bf16(a[2], a[3]); w.z = cvt_pk_bf16(b[0], b[1]); w.w = cvt_pk_bf16(b[2], b[3]); return w; }
__device__ __forceinline__ f32x4 shx(f32x4 v, int o) { f32x4 r; r[0] = __shfl_xor(v[0], o); r[1] = __shfl_xor(v[1], o); r[2] = __shfl_xor(v[2], o); r[3] = __shfl_xor(v[3], o); return r; }
__device__ __forceinline__ f32x4 bf4lo(unsigned a, unsigned b) { f32x4 r; r[0] = __uint_as_float(a << 16); r[1] = __uint_as_float(a & 0xffff0000u); r[2] = __uint_as_float(b << 16); r[3] = __uint_as_float(b & 0xffff0000u); return r; }
__device__ __forceinline__ f32x4 sigm4(f32x4 v) { f32x4 r;
#pragma unroll
    for (int i = 0; i < 4; ++i) r[i] = __builtin_amdgcn_rcpf(1.0f + __expf(-v[i])); return r; }
constexpr float QSCALE = 0.08838834764831845f * 1.4426950408889634f;

struct EpiIn {
    static constexpr bool PERM = true, AFTER_DRAIN = false;
    bf16_t* T6; bf16_t* GAB; const float* gbias; const float* cs; float* ksum;
    __device__ __forceinline__ void operator()(const f32x4 (&acc)[2][2][4][2], const Unit& u, int wr, int wc, int fr, int fq) const {
        const int row0 = u.pm * BM + wr * 64 + fr, pn = u.pn, colw = wc * 32 + 8 * fq;
        if (pn < 24) {
            const int t = pn >> 2;
            bf16_t* base = T6 + (size_t)t * ((size_t)8192 * 1024) + (pn & 3) * 256 + colw;
            const bool rot = (t == 3 || t == 4) && (wc == 0), isk = (t == 4);
            const float qs = (t == 3) ? QSCALE : 1.0f;
            f32x4 ks[2][2];
#pragma unroll
            for (int bj = 0; bj < 2; ++bj) { ks[bj][0] = (f32x4){0.f, 0.f, 0.f, 0.f}; ks[bj][1] = (f32x4){0.f, 0.f, 0.f, 0.f}; }
#pragma unroll
            for (int ai = 0; ai < 2; ++ai)
#pragma unroll
                for (int m = 0; m < 4; ++m) {
                    const int row = row0 + ai * HALF + m * 16;
                    f32x4 c0 = (f32x4){1.f, 1.f, 1.f, 1.f}, c1 = c0, s0 = (f32x4){0.f, 0.f, 0.f, 0.f}, s1 = s0;
                    if (rot) { const float* cp = cs + (size_t)row * 32 + 8 * (fq & 1); c0 = *(const f32x4*)cp; c1 = *(const f32x4*)(cp + 4); s0 = *(const f32x4*)(cp + 16); s1 = *(const f32x4*)(cp + 20);
                        if (fq < 2) { s0 = -s0; s1 = -s1; } }
#pragma unroll
                    for (int bj = 0; bj < 2; ++bj) {
                        f32x4 v0 = acc[ai][bj][m][0], v1 = acc[ai][bj][m][1];
                        if (rot) { const f32x4 p0 = shx(v0, 32), p1 = shx(v1, 32); v0 = v0 * c0 + p0 * s0; v1 = v1 * c1 + p1 * s1; }
                        if (isk) { ks[bj][0] += v0; ks[bj][1] += v1; }
                        v0 = v0 * qs; v1 = v1 * qs;
                        *(u32x4*)(base + (size_t)row * 1024 + bj * HALF) = pack8(v0, v1);
                    }
                }
            if (isk) {
#pragma unroll
                for (int bj = 0; bj < 2; ++bj)
#pragma unroll
                    for (int n = 0; n < 2; ++n) { f32x4 v = ks[bj][n]; v += shx(v, 1); v += shx(v, 2); v += shx(v, 4); v += shx(v, 8);
                        if (fr == 0) { float* kp = ksum + (size_t)u.pm * 1024 + (pn & 3) * 256 + bj * HALF + colw + 4 * n;
                            unsafeAtomicAdd(kp + 0, v[0]); unsafeAtomicAdd(kp + 1, v[1]); unsafeAtomicAdd(kp + 2, v[2]); unsafeAtomicAdd(kp + 3, v[3]); } }
            }
        } else {
            const int t = (pn - 24) >> 3, colg = ((pn - 24) & 7) * 256 + colw;
            bf16_t* base = GAB + (size_t)t * ((size_t)8192 * 2048) + colg;
            const float* bp = gbias + t * 2048 + colg;
            f32x4 bv[2][2];
#pragma unroll
            for (int bj = 0; bj < 2; ++bj) { bv[bj][0] = *(const f32x4*)(bp + bj * HALF); bv[bj][1] = *(const f32x4*)(bp + bj * HALF + 4); }
#pragma unroll
            for (int ai = 0; ai < 2; ++ai)
#pragma unroll
                for (int m = 0; m < 4; ++m) { const int row = row0 + ai * HALF + m * 16;
#pragma unroll
                    for (int bj = 0; bj < 2; ++bj) *(u32x4*)(base + (size_t)row * 2048 + bj * HALF) = pack8(sigm4(acc[ai][bj][m][0] + bv[bj][0]), sigm4(acc[ai][bj][m][1] + bv[bj][1])); }
        }
    }
};
struct EpiTmp {
    static constexpr bool PERM = true, AFTER_DRAIN = false;
    const bf16_t* G; bf16_t* O;
    __device__ __forceinline__ void operator()(const f32x4 (&acc)[2][2][4][2], const Unit& u, int wr, int wc, int fr, int fq) const {
        const int row0 = u.pm * BM + wr * 64 + fr, col0 = u.pn * BM + wc * 32 + 8 * fq;
#pragma unroll
        for (int ai = 0; ai < 2; ++ai)
#pragma unroll
            for (int m = 0; m < 4; ++m) { const size_t off = (size_t)(row0 + ai * HALF + m * 16) * 2048 + col0;
#pragma unroll
                for (int bj = 0; bj < 2; ++bj) { const u32x4 g = *(const u32x4*)(G + off + bj * HALF);
                    *(u32x4*)(O + off + bj * HALF) = pack8(acc[ai][bj][m][0] * bf4lo(g.x, g.y), acc[ai][bj][m][1] * bf4lo(g.z, g.w)); } }
    }
};
struct EpiMerge {
    static constexpr bool PERM = true, AFTER_DRAIN = false;
    const bf16_t* G; const bf16_t* TMP; bf16_t* O;
    __device__ __forceinline__ void operator()(const f32x4 (&acc)[2][2][4][2], const Unit& u, int wr, int wc, int fr, int fq) const {
        const int row0 = u.pm * BM + wr * 64 + fr, col0 = u.pn * BM + wc * 32 + 8 * fq;
#pragma unroll
        for (int ai = 0; ai < 2; ++ai)
#pragma unroll
            for (int m = 0; m < 4; ++m) { const size_t off = (size_t)(row0 + ai * HALF + m * 16) * 2048 + col0;
#pragma unroll
                for (int bj = 0; bj < 2; ++bj) { const u32x4 g = *(const u32x4*)(G + off + bj * HALF), t = *(const u32x4*)(TMP + off + bj * HALF);
                    *(u32x4*)(O + off + bj * HALF) = pack8(bf4lo(t.x, t.y) + acc[ai][bj][m][0] * bf4lo(g.x, g.y), bf4lo(t.z, t.w) + acc[ai][bj][m][1] * bf4lo(g.z, g.w)); } }
    }
};
struct EpiX1 {
    static constexpr bool PERM = true, AFTER_DRAIN = false;
    const float* X; float* X1; bf16_t* X1B; unsigned long long* SS;
    __device__ __forceinline__ void operator()(const f32x4 (&acc)[2][2][4][2], const Unit& u, int wr, int wc, int fr, int fq) const {
        const int row0 = u.pm * BM + wr * 64 + fr, col0 = u.pn * BM + wc * 32 + 8 * fq;
#pragma unroll
        for (int ai = 0; ai < 2; ++ai)
#pragma unroll
            for (int m = 0; m < 4; ++m) { const int row = row0 + ai * HALF + m * 16; const size_t off = (size_t)row * 2048 + col0; float sq = 0.f;
#pragma unroll
                for (int bj = 0; bj < 2; ++bj) { const f32x4 v0 = acc[ai][bj][m][0] + *(const f32x4*)(X + off + bj * HALF), v1 = acc[ai][bj][m][1] + *(const f32x4*)(X + off + bj * HALF + 4);
                    *(f32x4*)(X1 + off + bj * HALF) = v0; *(f32x4*)(X1 + off + bj * HALF + 4) = v1; *(u32x4*)(X1B + off + bj * HALF) = pack8(v0, v1);
                    sq += (v0[0] * v0[0] + v0[1] * v0[1]) + (v0[2] * v0[2] + v0[3] * v0[3]) + (v1[0] * v1[0] + v1[1] * v1[1]) + (v1[2] * v1[2] + v1[3] * v1[3]); }
                sq += __shfl_xor(sq, 16); sq += __shfl_xor(sq, 32);
                if (fq == 0) atomicAdd(SS + row, (unsigned long long)(sq * 4294967296.0f)); }
    }
};
__device__ __forceinline__ float rinv_from_ss(unsigned long long s) { return 1.0f / sqrtf((float)((double)s * (1.0 / 4294967296.0) * (1.0 / 2048.0)) + 1e-6f); }
struct EpiQP {
    static constexpr bool PERM = true, AFTER_DRAIN = false;
    const unsigned long long* SS; bf16_t* O;
    __device__ __forceinline__ void operator()(const f32x4 (&acc)[2][2][4][2], const Unit& u, int wr, int wc, int fr, int fq) const {
        const int row0 = u.pm * BM + wr * 64 + fr, col0 = u.pn * BM + wc * 32 + 8 * fq;
#pragma unroll
        for (int ai = 0; ai < 2; ++ai)
#pragma unroll
            for (int m = 0; m < 4; ++m) { const int row = row0 + ai * HALF + m * 16; const size_t off = (size_t)row * 2048 + col0; const float rv = rinv_from_ss(SS[row]);
#pragma unroll
                for (int bj = 0; bj < 2; ++bj) *(u32x4*)(O + off + bj * HALF) = pack8(acc[ai][bj][m][0] * rv, acc[ai][bj][m][1] * rv); }
    }
};

template <class Epi, class Sched, bool ALIGN_EPI = false, bool SP2 = false>
__device__ __forceinline__ void gemm_phase(PG8_LAS unsigned char* lds, const Gemm g, const Sched& S, const Epi& E) {
    const int tid = threadIdx.x, wid = __builtin_amdgcn_readfirstlane(tid >> 6), lane = tid & 63, wr = wid >> 2, wc = wid & 3, fr = lane & 15, fq = lane >> 4;
    const int K = g.K, nt = K / BK;
    unsigned voffA[2], voffB[2];
#pragma unroll
    for (int i = 0; i < 2; ++i) { int R, C; stage_rc(tid * 16 + i * 8192, R, C); const int Rb = Epi::PERM ? ((R & ~31) + perm32(R & 31)) : R;
        voffA[i] = (unsigned)(R * K + C) * 2u; voffB[i] = (unsigned)(Rb * K + C) * 2u; }
    const size_t kstep = (size_t)(BK * 2);
    const size_t hstep = (size_t)HALF * K * 2;
    const size_t tstep = 2 * hstep;
    const unsigned ldsw = (unsigned)wid * 1024u;
    const int aoff = lds_byte(wr * 64 + fr, fq * 8), boff = lds_byte(wc * 32 + fr, fq * 8);
#define PG8_SA(b, h) (((b) * 2 + (h)) * HTB)
#define PG8_SB(b, h) ((4 + (b) * 2 + (h)) * HTB)
#define PG8_STAGE(bufoff, gbase, voff) do { _Pragma("unroll") for (int _i = 0; _i < 2; ++_i) \
        __builtin_amdgcn_global_load_lds((const unsigned*)((const char*)(gbase) + (voff)[_i]), (PG8_LAS unsigned*)(lds + (bufoff) + ldsw + _i * 8192), 16, 0, 0); } while (0)
#define PG8_LDA(dst, b, h) do { _Pragma("unroll") for (int m = 0; m < 4; ++m) _Pragma("unroll") for (int k = 0; k < 2; ++k) dst[m][k] = *(const PG8_LAS bf16x8*)(lds + PG8_SA(b, h) + aoff + m * 2048 + k * 1024); } while (0)
#define PG8_LDB(dst, b, h) do { _Pragma("unroll") for (int n = 0; n < 2; ++n) _Pragma("unroll") for (int k = 0; k < 2; ++k) dst[n][k] = *(const PG8_LAS bf16x8*)(lds + PG8_SB(b, h) + boff + n * 2048 + k * 1024); } while (0)
#define PG8_MMA(ai, bj, At, Bt) do { __builtin_amdgcn_s_setprio(1); _Pragma("unroll") for (int m = 0; m < 4; ++m) _Pragma("unroll") for (int n = 0; n < 2; ++n) _Pragma("unroll") for (int k = 0; k < 2; ++k) \
        acc[ai][bj][m][n] = __builtin_amdgcn_mfma_f32_16x16x32_bf16(Bt[n][k], At[m][k], acc[ai][bj][m][n], 0, 0, 0); __builtin_amdgcn_s_setprio(0); } while (0)
#define PG8_WAIT_V(n) asm volatile("s_waitcnt vmcnt(" #n ")" ::: "memory")
#define PG8_WAIT_L(n) asm volatile("s_waitcnt lgkmcnt(" #n ")" ::: "memory")
#define PG8_BAR __builtin_amdgcn_s_barrier()
#define PG8_SCHED __builtin_amdgcn_sched_barrier(0)
    Unit cur, nxt; int ui = 0;
    if (!S.next(0, cur)) return;
    f32x4 acc[2][2][4][2];
#pragma unroll
    for (int a = 0; a < 2; ++a)
#pragma unroll
        for (int b = 0; b < 2; ++b)
#pragma unroll
            for (int m = 0; m < 4; ++m)
#pragma unroll
                for (int n = 0; n < 2; ++n) acc[a][b][m][n] = (f32x4){0.f, 0.f, 0.f, 0.f};
    bf16x8 At[4][2], B0[2][2], B1[2][2];
    const char* cA = (const char*)g.A + (size_t)cur.pm * tstep; const char* cB = (const char*)g.Bt + (size_t)cur.pn * tstep;
    S.a_ready(cur);
    if constexpr (SP2) {
        PG8_STAGE(PG8_SB(0, 0), cB, voffB); PG8_STAGE(PG8_SB(0, 1), cB + hstep, voffB); PG8_STAGE(PG8_SA(0, 0), cA, voffA); PG8_STAGE(PG8_SA(0, 1), cA + hstep, voffA);
        if (wr == 1) PG8_BAR;
        PG8_WAIT_V(2); PG8_BAR;
        PG8_STAGE(PG8_SB(1, 0), cB + kstep, voffB); PG8_STAGE(PG8_SA(1, 0), cA + kstep, voffA); PG8_STAGE(PG8_SB(1, 1), cB + hstep + kstep, voffB);
        PG8_WAIT_V(6); PG8_BAR;
    } else {
        PG8_STAGE(PG8_SB(0, 0), cB, voffB); PG8_STAGE(PG8_SA(0, 0), cA, voffA); PG8_STAGE(PG8_SB(0, 1), cB + hstep, voffB); PG8_STAGE(PG8_SA(0, 1), cA + hstep, voffA);
        if (wr == 1) PG8_BAR;
        PG8_WAIT_V(4); PG8_BAR;
        PG8_STAGE(PG8_SB(1, 0), cB + kstep, voffB); PG8_STAGE(PG8_SA(1, 0), cA + kstep, voffA); PG8_STAGE(PG8_SB(1, 1), cB + hstep + kstep, voffB);
        PG8_WAIT_V(6); PG8_BAR;
    }
    for (;;) {
        const bool has_next = S.next(ui + 1, nxt);
        const char* nA = has_next ? (const char*)g.A + (size_t)nxt.pm * tstep : cA; const char* nB = has_next ? (const char*)g.Bt + (size_t)nxt.pn * tstep : cB;
        for (int t = 0; t < nt; t += 2) {
            const bool last = (t == nt - 2);
            const char* a1 = cA + (size_t)(t + 1) * kstep;
            const char* a2 = last ? nA : cA + (size_t)(t + 2) * kstep; const char* b2 = last ? nB : cB + (size_t)(t + 2) * kstep;
            const char* a3 = a2 + kstep; const char* b3 = b2 + kstep;
            if (last && has_next) S.a_ready(nxt);
            if constexpr (SP2) {
            PG8_LDB(B0, 0, 0); PG8_LDB(B1, 0, 1); PG8_SCHED; PG8_LDA(At, 0, 0); PG8_STAGE(PG8_SA(1, 1), a1 + hstep, voffA);
            PG8_WAIT_V(8); PG8_WAIT_L(0); PG8_BAR; PG8_MMA(0, 0, At, B0); PG8_MMA(0, 1, At, B1); PG8_BAR; PG8_SCHED;
            PG8_LDA(At, 0, 1); PG8_STAGE(PG8_SB(0, 0), b2, voffB); PG8_STAGE(PG8_SB(0, 1), b2 + hstep, voffB); PG8_STAGE(PG8_SA(0, 0), a2, voffA);
            PG8_WAIT_V(8); PG8_WAIT_L(0); PG8_BAR; PG8_MMA(1, 0, At, B0); PG8_MMA(1, 1, At, B1); PG8_BAR; PG8_SCHED;
            PG8_LDB(B0, 1, 0); PG8_LDB(B1, 1, 1); PG8_SCHED; PG8_LDA(At, 1, 0); PG8_STAGE(PG8_SA(0, 1), a2 + hstep, voffA);
            PG8_WAIT_V(8); PG8_WAIT_L(0); PG8_BAR; PG8_MMA(0, 0, At, B0); PG8_MMA(0, 1, At, B1); PG8_BAR; PG8_SCHED;
            PG8_LDA(At, 1, 1); PG8_STAGE(PG8_SB(1, 0), b3, voffB); PG8_STAGE(PG8_SB(1, 1), b3 + hstep, voffB); PG8_STAGE(PG8_SA(1, 0), a3, voffA);
            PG8_WAIT_V(8); PG8_WAIT_L(0); PG8_BAR; PG8_MMA(1, 0, At, B0); PG8_MMA(1, 1, At, B1); PG8_BAR; PG8_SCHED;
            } else {
            PG8_LDB(B0, 0, 0); PG8_SCHED; PG8_LDA(At, 0, 0); PG8_STAGE(PG8_SA(1, 1), a1 + hstep, voffA);
            PG8_WAIT_L(8); PG8_BAR; PG8_WAIT_L(0); PG8_MMA(0, 0, At, B0); PG8_BAR; PG8_SCHED;
            PG8_LDB(B1, 0, 1); PG8_STAGE(PG8_SB(0, 0), b2, voffB);
            PG8_BAR; PG8_WAIT_L(0); PG8_MMA(0, 1, At, B1); PG8_BAR;
            PG8_LDA(At, 0, 1); PG8_STAGE(PG8_SA(0, 0), a2, voffA);
            PG8_BAR; PG8_WAIT_L(0); PG8_MMA(1, 0, At, B0); PG8_BAR; PG8_SCHED;
            PG8_STAGE(PG8_SB(0, 1), b2 + hstep, voffB);
            PG8_WAIT_V(6); PG8_BAR; PG8_MMA(1, 1, At, B1); PG8_BAR;
            PG8_LDB(B0, 1, 0); PG8_SCHED; PG8_LDA(At, 1, 0); PG8_STAGE(PG8_SA(0, 1), a2 + hstep, voffA);
            PG8_WAIT_L(8); PG8_BAR; PG8_WAIT_L(0); PG8_MMA(0, 0, At, B0); PG8_BAR; PG8_SCHED;
            PG8_LDB(B1, 1, 1); PG8_STAGE(PG8_SB(1, 0), b3, voffB);
            PG8_BAR; PG8_WAIT_L(0); PG8_MMA(0, 1, At, B1); PG8_BAR;
            PG8_LDA(At, 1, 1); PG8_STAGE(PG8_SA(1, 0), a3, voffA);
            PG8_BAR; PG8_WAIT_L(0); PG8_MMA(1, 0, At, B0); PG8_BAR; PG8_SCHED;
            PG8_STAGE(PG8_SB(1, 1), b3 + hstep, voffB);
            PG8_WAIT_V(6); PG8_BAR; PG8_MMA(1, 1, At, B1); PG8_BAR;
            }
        }
        if constexpr (ALIGN_EPI) { if (wr == 0) PG8_BAR; }
        if constexpr (!Epi::AFTER_DRAIN) { E(acc, cur, wr, wc, fr, fq); S.done(cur); }
        if (!has_next) break;
#pragma unroll
        for (int a = 0; a < 2; ++a)
#pragma unroll
            for (int b = 0; b < 2; ++b)
#pragma unroll
                for (int m = 0; m < 4; ++m)
#pragma unroll
                    for (int n = 0; n < 2; ++n) acc[a][b][m][n] = (f32x4){0.f, 0.f, 0.f, 0.f};
        cur = nxt; cA = nA; cB = nB; ++ui;
        if constexpr (ALIGN_EPI) { if (wr == 1) PG8_BAR; }
    }
    PG8_WAIT_V(0);
    if constexpr (!ALIGN_EPI) { if (wr == 0) PG8_BAR; }
    PG8_BAR;
    if constexpr (Epi::AFTER_DRAIN) { E.fused(acc, cur, wr, wc, fr, fq, lds, wid, lane); S.done(cur); }
#undef PG8_SA
#undef PG8_SB
#undef PG8_STAGE
#undef PG8_LDA
#undef PG8_LDB
#undef PG8_MMA
#undef PG8_WAIT_V
#undef PG8_WAIT_L
#undef PG8_BAR
#undef PG8_SCHED
}
}

constexpr int NWAVES = 8;
#ifndef MK_N_LAUNCHES
#define MK_N_LAUNCHES 1
#endif
constexpr int PER_PHASE = 9;
#ifndef MK_REP_PHASE
#define MK_REP_PHASE -1
#endif
#define NREP(k) (((k) == MK_REP_PHASE) ? 2 : 1)
constexpr int N_LAUNCHES = MK_N_LAUNCHES;
constexpr int M = 8192, SEQ = 4096, DM = 2048, INW = 10240, NEXP = 16384;
constexpr float RMS_EPS = 1e-6f;
constexpr size_t MiB = 1u << 20;
constexpr size_t WS_CTL = 0, CTL_ZERO_BYTES = 1 * MiB;
constexpr size_t WS_SS = 256 * 1024, WS_KSUM = 512 * 1024;
constexpr size_t WS_WIN = 2 * MiB, WS_WBC = 42 * MiB, WS_WBA = 46 * MiB, WS_WOUT = 50 * MiB, WS_WPQ = 58 * MiB, WS_KEYS = 66 * MiB, WS_CS = 67 * MiB;
constexpr size_t WS_UB = 70 * MiB, WS_VB = 102 * MiB;
constexpr size_t WS_XB = 198 * MiB;
constexpr size_t WS_T6 = 230 * MiB;
constexpr size_t WS_GAB = 326 * MiB;
constexpr size_t WS_UC = 390 * MiB, WS_AO = 406 * MiB;
constexpr size_t WS_EXP = 422 * MiB, WS_GATE = 426 * MiB;
constexpr size_t WS_END = 430 * MiB;
constexpr size_t WS_TMP = WS_XB, WS_MB = WS_T6, WS_X1B = WS_T6 + 48 * MiB, WS_QP = WS_GAB;
constexpr int CW_BAR = 4096;
constexpr int RING_OFF = 0, RING_BYTES = 131072;
constexpr int LDSCTL_OFF = RING_BYTES, MISC_OFF = LDSCTL_OFF + 320;
constexpr int LDS_BYTES = 147456;

#define GAS __attribute__((address_space(1)))
#define LAS __attribute__((address_space(3)))
typedef unsigned short bf16;
typedef unsigned v4u __attribute__((ext_vector_type(4)));
typedef float f32x4 __attribute__((ext_vector_type(4)));
typedef short bf16x8 __attribute__((ext_vector_type(8)));
typedef GAS unsigned gu32;
typedef GAS unsigned long long gu64;
#define RLX_AGENT __ATOMIC_RELAXED, __HIP_MEMORY_SCOPE_AGENT
#define LDS_WAIT() asm volatile("s_waitcnt lgkmcnt(0)" ::: "memory")
#define VM_WAIT() asm volatile("s_waitcnt vmcnt(0)" ::: "memory")
__device__ __forceinline__ unsigned long long rt() { return __builtin_amdgcn_s_memrealtime(); }
__device__ __forceinline__ unsigned f2bf(float f) { unsigned u = __builtin_bit_cast(unsigned, f); return (u + 0x7fffu + ((u >> 16) & 1u)) >> 16; }
__device__ __forceinline__ unsigned pk2(float lo, float hi) { return f2bf(lo) | (f2bf(hi) << 16); }

#define XB_TMO      128
#define XB_XCNT(j)  (256  + 64 * (j))
#define XB_XSUB(j)  (1280 + 64 * (j))
#define XB_XGEN(j)  (2304 + 64 * (j))
#define XB_TOP      3328
#define XB_TOPGEN   3392
#define XCD_BAR_WORDS 3456
#define XB_SPIN_CAP (1u << 18)

__device__ __forceinline__ unsigned xb_ld(unsigned* p)              { return __hip_atomic_load(p, __ATOMIC_RELAXED, __HIP_MEMORY_SCOPE_AGENT); }
__device__ __forceinline__ unsigned xb_add(unsigned* p, unsigned v) { return __hip_atomic_fetch_add(p, v, __ATOMIC_RELAXED, __HIP_MEMORY_SCOPE_AGENT); }
__device__ __forceinline__ unsigned xb_xcc_id() { return (unsigned)__builtin_amdgcn_s_getreg((3 << 11) | 20) & 0xFu; }
#define XB_SPIN(cond, bar) do { unsigned _sp = 0; while (cond) { __builtin_amdgcn_s_sleep(1); \
    if ((++_sp & 255u) == 0u) { if (xb_ld(&(bar)[XB_TMO])) break; if (_sp > XB_SPIN_CAP) { atomicAdd(&(bar)[XB_TMO], 1u); break; } } } } while (0)

struct XcdBarrier {
    unsigned* bar; unsigned x;
    volatile LAS unsigned* st;
};

__device__ __forceinline__ XcdBarrier xcd_barrier_post(unsigned* bar, volatile LAS unsigned* st) {
    XcdBarrier b; b.bar = bar; b.x = xb_xcc_id(); b.st = st;
    if (threadIdx.x == 0) (void)xb_add(&bar[XB_XCNT(b.x)], 1u);
    return b;
}
__device__ __forceinline__ void xcd_barrier_complete(unsigned* bar, unsigned x, unsigned& nloc, unsigned& nx) {
    const unsigned G = gridDim.x * gridDim.y * gridDim.z;
    unsigned sum, cnt, mine, sp = 0u;
    for (;;) {
        sum = 0u; cnt = 0u; mine = 0u;
#pragma unroll
        for (unsigned j = 0; j < 16; ++j) { const unsigned c = xb_ld(&bar[XB_XCNT(j)]); sum += c; cnt += (c > 0u) ? 1u : 0u; mine = (j == x) ? c : mine; }
        if (sum == G) break;
        __builtin_amdgcn_s_sleep(1);
        if ((++sp & 255u) == 0u) { if (xb_ld(&bar[XB_TMO])) break; if (sp > XB_SPIN_CAP) { atomicAdd(&bar[XB_TMO], 1u); break; } }
    }
    nloc = mine > 0u ? mine : 1u; nx = cnt > 0u ? cnt : 1u;
}

__device__ __forceinline__ void xcd_barrier(const XcdBarrier& b) {
    asm volatile("s_waitcnt vmcnt(0)" ::: "memory");
    __syncthreads();
    if (threadIdx.x == 0) {
        unsigned* bar = b.bar;
        __builtin_amdgcn_s_waitcnt(0);
        unsigned nloc = b.st[0], nx = b.st[1];
        if (nloc == 0u) { xcd_barrier_complete(bar, b.x, nloc, nx); b.st[0] = nloc; b.st[1] = nx; }
        const unsigned old = xb_add(&bar[XB_XSUB(b.x)], 1u);
        const unsigned gen = old / nloc;
        if (old + 1u == (gen + 1u) * nloc) {
            __builtin_amdgcn_fence(__ATOMIC_RELEASE, "agent");
            asm volatile("s_waitcnt vmcnt(0)" ::: "memory");
            const unsigned og = xb_add(&bar[XB_TOP], 1u);
            const unsigned tg = og / nx;
            if (og + 1u == (tg + 1u) * nx) xb_add(&bar[XB_TOPGEN], 1u);
            else XB_SPIN(xb_ld(&bar[XB_TOPGEN]) == tg, bar);
            __builtin_amdgcn_fence(__ATOMIC_ACQUIRE, "agent");
            xb_add(&bar[XB_XGEN(b.x)], 1u);
            asm volatile("s_waitcnt vmcnt(0)" ::: "memory");
        } else {
            XB_SPIN(xb_ld(&bar[XB_XGEN(b.x)]) == gen, bar);
            __builtin_amdgcn_fence(__ATOMIC_ACQUIRE, "agent");
            asm volatile("s_waitcnt vmcnt(0)" ::: "memory");
        }
    }
    __syncthreads();
}

typedef __bf16 bf16x2v __attribute__((ext_vector_type(2)));
typedef float f32x16 __attribute__((ext_vector_type(16)));
__device__ __forceinline__ float bflo(unsigned w) { return __uint_as_float(w << 16); }
__device__ __forceinline__ float bfhi(unsigned w) { return __uint_as_float(w & 0xffff0000u); }
__device__ __forceinline__ float dot2bf(unsigned a, unsigned b, float c) { return __builtin_amdgcn_fdot2_f32_bf16(__builtin_bit_cast(bf16x2v, a), __builtin_bit_cast(bf16x2v, b), c, false); }
__device__ __forceinline__ float wave_sum(float v) {
#pragma unroll
    for (int o = 1; o < 64; o <<= 1) v += __shfl_xor(v, o);
    return v; }
__device__ __forceinline__ float wave_max(float v) {
#pragma unroll
    for (int o = 1; o < 64; o <<= 1) v = fmaxf(v, __shfl_xor(v, o));
    return v; }
__device__ __forceinline__ float rdlane(float v, int l) { return __int_as_float(__builtin_amdgcn_readlane(__float_as_int(v), l)); }
__device__ __forceinline__ float gelu_tanh(float x) { const float z = 0.7978845608028654f * (x + 0.044715f * x * x * x); const float e = __expf(2.0f * z); const float th = 1.0f - 2.0f * __builtin_amdgcn_rcpf(1.0f + e); return 0.5f * x * (1.0f + th); }

struct Ctx { LAS unsigned char* lds; int tid, lane, wave, vcu, G; };

__device__ __forceinline__ void p0_transpose_item(const float* W, int K, int N, bf16* WT, const float* gk, LAS float* scr, int item, int lane) {
    const int nblk = N / 32, kb = item / nblk, nb = item % nblk, k0 = 64 * kb, n0 = 32 * nb;
#pragma unroll 8
    for (int i = 0; i < 32; ++i) { const int kk = 2 * i + (lane >> 5); float v = W[(size_t)(k0 + kk) * N + n0 + (lane & 31)]; if (gk) v *= gk[k0 + kk]; scr[kk * 33 + (lane & 31)] = v; }
    LDS_WAIT(); asm volatile("" ::: "memory");
    const int c = lane & 7;
#pragma unroll
    for (int j = 0; j < 4; ++j) { const int n = (lane >> 3) + 8 * j; const LAS float* s = scr + (8 * c) * 33 + n;
        v4u o; o.x = pk2(s[0 * 33], s[1 * 33]); o.y = pk2(s[2 * 33], s[3 * 33]); o.z = pk2(s[4 * 33], s[5 * 33]); o.w = pk2(s[6 * 33], s[7 * 33]);
        *(GAS v4u*)(WT + (size_t)(n0 + n) * K + k0 + 8 * c) = o; }
    LDS_WAIT(); asm volatile("" ::: "memory");
}
__device__ __forceinline__ void convert_tables(const Ctx& F, const float* pu, const float* pv, const float* g2, unsigned char* ws) {
    const int gt = (F.vcu * NWAVES + F.wave) * 64 + F.lane, NT = F.G * NWAVES * 64;
    for (int i = gt; i < NEXP * 2048 / 16; i += NT) { const int c16 = (i & 127) * 16; v4u ou, ov;
#pragma unroll
        for (int q = 0; q < 4; ++q) { f32x4 a = ((const GAS f32x4*)pu)[4 * i + q]; a = a * *(const GAS f32x4*)(g2 + c16 + 4 * q) * 512.0f; const f32x4 b = ((const GAS f32x4*)pv)[4 * i + q] * 32.0f;
            int wu = 0, wv = 0; wu = __builtin_amdgcn_cvt_pk_fp8_f32(a[0], a[1], wu, false); wu = __builtin_amdgcn_cvt_pk_fp8_f32(a[2], a[3], wu, true);
            wv = __builtin_amdgcn_cvt_pk_fp8_f32(b[0], b[1], wv, false); wv = __builtin_amdgcn_cvt_pk_fp8_f32(b[2], b[3], wv, true); ou[q] = (unsigned)wu; ov[q] = (unsigned)wv; }
        ((GAS v4u*)(ws + WS_UB))[i] = ou; ((GAS v4u*)(ws + WS_VB))[i] = ov; }
}
__device__ __forceinline__ void p0_prologue(const Ctx& F, const float* const* in, unsigned char* ws, const double* invf) {
    const float* x = in[0]; const int* pos = (const int*)in[1]; const float* g1 = in[2]; const float* w_in = in[3];
    const float* w_bc = in[6]; const float* w_ba = in[7]; const float* w_out = in[8]; const float* g2 = in[9]; const float* w_pq = in[10];
    const float* keys = in[11]; const float* pu = in[12]; const float* pv = in[13];
    LAS float* scr = (LAS float*)(F.lds + RING_OFF + F.wave * 16384);
    const int gw = F.vcu * NWAVES + F.wave, NGW = F.G * NWAVES;
    const int gt = gw * 64 + F.lane, NT = NGW * 64;
    for (int i = gt; i < 8192; i += NT) ((GAS unsigned long long*)(ws + WS_SS))[i] = 0ull;
    for (int i = gt; i < 32 * 1024; i += NT) ((GAS float*)(ws + WS_KSUM))[i] = 0.f;
    constexpr int I_IN = 32 * 320, I_BC = 16 * 64, I_OUT = 32 * 64;
    constexpr int NITEMS = I_IN + 2 * I_BC + 2 * I_OUT;
    for (int it = gw; it < NITEMS; it += NGW) {
        int r = it;
        if (r < I_IN) { p0_transpose_item(w_in, 2048, INW, (bf16*)(ws + WS_WIN), g1, scr, r, F.lane); continue; } r -= I_IN;
        if (r < I_BC) { p0_transpose_item(w_bc, 1024, 2048, (bf16*)(ws + WS_WBC), nullptr, scr, r, F.lane); continue; } r -= I_BC;
        if (r < I_BC) { p0_transpose_item(w_ba, 1024, 2048, (bf16*)(ws + WS_WBA), nullptr, scr, r, F.lane); continue; } r -= I_BC;
        if (r < I_OUT) { p0_transpose_item(w_out, 2048, 2048, (bf16*)(ws + WS_WOUT), nullptr, scr, r, F.lane); continue; } r -= I_OUT;
        p0_transpose_item(w_pq, 2048, 2048, (bf16*)(ws + WS_WPQ), g2, scr, r, F.lane);
    }
    for (int i = gt; i < 16 * 128 * 128 / 8; i += NT) { const f32x4 a = ((const GAS f32x4*)keys)[2 * i], b = ((const GAS f32x4*)keys)[2 * i + 1];
        v4u o; o.x = pk2(a[0], a[1]); o.y = pk2(a[2], a[3]); o.z = pk2(b[0], b[1]); o.w = pk2(b[2], b[3]); ((GAS v4u*)(ws + WS_KEYS))[i] = o; }
    for (int m = gw; m < M; m += NGW) { const GAS f32x4* xr = (const GAS f32x4*)(x + (size_t)m * DM);
        f32x4 v[8]; float s = 0.f;
#pragma unroll
        for (int i = 0; i < 4; ++i) { v[2 * i] = xr[i * 128 + 2 * F.lane]; v[2 * i + 1] = xr[i * 128 + 2 * F.lane + 1]; }
#pragma unroll
        for (int i = 0; i < 8; ++i) s += (v[i][0] * v[i][0] + v[i][1] * v[i][1]) + (v[i][2] * v[i][2] + v[i][3] * v[i][3]);
        const float rinv = 1.0f / sqrtf(wave_sum(s) * (1.0f / DM) + RMS_EPS);
        GAS v4u* o = (GAS v4u*)(ws + WS_XB + (size_t)m * DM * 2);
#pragma unroll
        for (int i = 0; i < 4; ++i) { const f32x4 a = v[2 * i] * rinv, b = v[2 * i + 1] * rinv; v4u w; w.x = pk2(a[0], a[1]); w.y = pk2(a[2], a[3]); w.z = pk2(b[0], b[1]); w.w = pk2(b[2], b[3]); o[i * 64 + F.lane] = w; } }
    for (int i = gt; i < M * 16; i += NT) { const int row = i >> 4, f = i & 15; const double ang = (double)pos[row] * invf[f];
        const double k = __builtin_rint(ang * 0.15915494309189535); const float r = (float)(ang - k * 6.283185307179586);
        float* cs = (float*)(ws + WS_CS); cs[row * 32 + f] = __cosf(r); cs[row * 32 + 16 + f] = __sinf(r); }
}

__device__ __forceinline__ void attn_simple(const Ctx& F, const bf16* Q, const bf16* K, const bf16* V, const float* ksum, bf16* AO) {
    LAS float* qf = (LAS float*)(F.lds + RING_OFF + F.wave * 512);
    const int gw = F.vcu * NWAVES + F.wave, NGW = F.G * NWAVES, lane = F.lane;
    for (int item = gw; item < 16 * SEQ; item += NGW) {
        const int bh = item >> 12, t = item & 4095, b = bh >> 3, h = bh & 7, blk = t >> 8;
        const size_t row = (size_t)b * SEQ + t;
        { const unsigned qq = *(const GAS unsigned*)(Q + row * 1024 + h * 128 + 2 * lane); qf[2 * lane] = bflo(qq); qf[2 * lane + 1] = bfhi(qq); }
        LDS_WAIT(); asm volatile("" ::: "memory");
        float g = -INFINITY;
        if (lane < blk) { const GAS f32x4* km = (const GAS f32x4*)(ksum + (size_t)(b * 16 + lane) * 1024 + h * 128); float a = 0.f;
            for (int d = 0; d < 32; ++d) { const f32x4 kv = km[d]; const f32x4 qv = *(const LAS f32x4*)(qf + 4 * d); a += (kv[0] * qv[0] + kv[1] * qv[1]) + (kv[2] * qv[2] + kv[3] * qv[3]); }
            g = a; }
        int sel[3];
#pragma unroll
        for (int i = 0; i < 3; ++i) { const float mx = wave_max(g); const unsigned long long bal = __ballot(g == mx && lane < blk); const int idx = bal ? (__ffsll((long long)bal) - 1) : 0; sel[i] = idx; if (lane == idx) g = -INFINITY; }
        const int nsel = blk < 3 ? blk : 3;
        float sc[4][4]; float mx = -INFINITY;
#pragma unroll
        for (int slot = 0; slot < 4; ++slot) {
            const bool valid = (slot == 3) || (slot < nsel);
            const int kb = (slot == 3) ? blk : sel[slot < 3 ? slot : 0];
#pragma unroll
            for (int r = 0; r < 4; ++r) {
                float s = -INFINITY; const int key0 = kb * 256 + r * 64;
                if (valid && (slot < 3 || key0 <= t)) {
                    const int key = key0 + lane; const GAS v4u* kp = (const GAS v4u*)(K + ((size_t)b * SEQ + key) * 1024 + h * 128); float a = 0.f;
#pragma unroll 4
                    for (int d = 0; d < 16; ++d) { const v4u kk = kp[d]; const f32x4 q0 = *(const LAS f32x4*)(qf + 8 * d), q1 = *(const LAS f32x4*)(qf + 8 * d + 4);
                        a += (bflo(kk.x) * q0[0] + bfhi(kk.x) * q0[1]) + (bflo(kk.y) * q0[2] + bfhi(kk.y) * q0[3]) + (bflo(kk.z) * q1[0] + bfhi(kk.z) * q1[1]) + (bflo(kk.w) * q1[2] + bfhi(kk.w) * q1[3]); }
                    s = (slot < 3 || key <= t) ? a : -INFINITY; }
                sc[slot][r] = s; mx = fmaxf(mx, s); } }
        mx = wave_max(mx);
        float sum = 0.f;
#pragma unroll
        for (int slot = 0; slot < 4; ++slot)
#pragma unroll
            for (int r = 0; r < 4; ++r) { sc[slot][r] = exp2f(sc[slot][r] - mx); sum += sc[slot][r]; }
        sum = wave_sum(sum);
        float o0 = 0.f, o1 = 0.f;
#pragma unroll
        for (int slot = 0; slot < 4; ++slot) {
            const bool valid = (slot == 3) || (slot < nsel);
            const int kb = (slot == 3) ? blk : sel[slot < 3 ? slot : 0];
#pragma unroll
            for (int r = 0; r < 4; ++r) { const int key0 = kb * 256 + r * 64;
                if (valid && (slot < 3 || key0 <= t)) { const float pr = sc[slot][r]; const GAS unsigned* vp = (const GAS unsigned*)(V + ((size_t)b * SEQ + key0) * 1024 + h * 128) + lane;
                    for (int kk = 0; kk < 64; ++kk) { const float pk = rdlane(pr, kk); const unsigned vv = vp[(size_t)kk * 512]; o0 += pk * bflo(vv); o1 += pk * bfhi(vv); } } } }
        const float ri = 1.0f / sum;
        *(GAS unsigned*)(AO + row * 1024 + h * 128 + 2 * lane) = pk2(o0 * ri, o1 * ri);
    }
}
typedef short v4i16_t __attribute__((ext_vector_type(4))); typedef unsigned u32x2v __attribute__((ext_vector_type(2)));
__device__ __forceinline__ v4i16_t vtr16(unsigned addr) { return __builtin_amdgcn_ds_read_tr16_b64_v4i16((LAS v4i16_t*)(uintptr_t)addr); }
__device__ __forceinline__ int crow16(int r, int hh) { return (r & 3) + 8 * (r >> 2) + 4 * hh; }
__device__ __forceinline__ void attn_dma_step(const bf16* K, const bf16* V, LAS unsigned char* lds, int b, int h, int qb, int n_own, int st, int wave, int lane) {
    const int buf = st & 1;
#pragma unroll
    for (int img = 0; img < 4; ++img) {
        const int T = 2 * st + (img >> 1); const bool isV = img & 1;
        const int blk = (T < n_own) ? qb : ((T - n_own) >> 2), kt = (T < n_own) ? T : ((T - n_own) & 3);
        const bf16* base = (isV ? V : K) + ((size_t)b * SEQ + 256 * blk + 64 * kt) * 1024 + h * 128;
#pragma unroll
        for (int i = 0; i < 2; ++i) { const int pc = wave + 8 * i, row = 4 * pc + (lane >> 4), cp = lane & 15;
            const int c = isV ? ((((cp >> 2) ^ (row & 3)) << 2) | (cp & 3)) : (cp ^ (row & 15));
            __builtin_amdgcn_global_load_lds((const unsigned*)(base + (size_t)row * 1024 + 8 * c), (LAS unsigned*)(lds + buf * 65536 + img * 16384 + pc * 1024), 16, 0, 0); }
    }
}
__device__ __forceinline__ void attn_mfma(const Ctx& F, const bf16* Q, const bf16* K, const bf16* V, const float* ksum, bf16* AO) {
    const int lane = F.lane, wave = F.wave, q31 = lane & 31, hh = lane >> 5, wq = wave & 3, kvh = wave >> 2, l16 = lane & 15, G4 = lane >> 4;
    LAS unsigned char* lds = F.lds + RING_OFF;
    const unsigned lds0 = (unsigned)(uintptr_t)lds;
    for (int pr = F.vcu; pr < 256; pr += F.G)
#pragma unroll 1
    for (int pi = 0; pi < 2; ++pi) {
        const int bh = pr >> 4, s_ = pr & 15, u128 = pi ? 31 - s_ : s_, b = bh >> 3, h = bh & 7, qb = u128 >> 1, half = u128 & 1;
        const int n_own = half ? 4 : 2, nstep = (n_own + 4 * qb) >> 1;
        const size_t rowq = (size_t)b * SEQ + 256 * qb + 128 * half + 32 * wq + q31;
        asm volatile("s_waitcnt vmcnt(0) lgkmcnt(0)" ::: "memory"); __builtin_amdgcn_s_barrier(); asm volatile("" ::: "memory");
        attn_dma_step(K, V, lds, b, h, qb, n_own, 0, wave, lane);
        bf16x8 qf[8];
#pragma unroll
        for (int s = 0; s < 8; ++s) qf[s] = *(const GAS bf16x8*)(Q + rowq * 1024 + h * 128 + 16 * s + 8 * hh);
        unsigned selmask;
        {
            float qv[64];
#pragma unroll
            for (int s = 0; s < 8; ++s)
#pragma unroll
                for (int e = 0; e < 8; ++e) qv[8 * s + e] = __uint_as_float((unsigned)(unsigned short)qf[s][e] << 16);
            float v0 = -INFINITY, v1 = -INFINITY, v2 = -INFINITY; int i0 = 0, i1 = 0, i2 = 0;
#pragma unroll 1
            for (int j = 0; j < qb; ++j) {
                const GAS f32x4* kp = (const GAS f32x4*)(ksum + (size_t)(b * 16 + j) * 1024 + h * 128 + 8 * hh); float a = 0.f;
#pragma unroll
                for (int s = 0; s < 8; ++s) { const f32x4 k0 = kp[4 * s], k1 = kp[4 * s + 1];
                    a += (qv[8 * s] * k0[0] + qv[8 * s + 1] * k0[1]) + (qv[8 * s + 2] * k0[2] + qv[8 * s + 3] * k0[3]) + (qv[8 * s + 4] * k1[0] + qv[8 * s + 5] * k1[1]) + (qv[8 * s + 6] * k1[2] + qv[8 * s + 7] * k1[3]); }
                a += __shfl_xor(a, 32);
                if (a > v0) { v2 = v1; i2 = i1; v1 = v0; i1 = i0; v0 = a; i0 = j; } else if (a > v1) { v2 = v1; i2 = i1; v1 = a; i1 = j; } else if (a > v2) { v2 = a; i2 = j; }
            }
            selmask = (qb <= 3) ? ((1u << qb) - 1u) : ((1u << i0) | (1u << i1) | (1u << i2));
        }
        float m_run = -1e30f, l_run = 0.f; f32x16 o[4];
#pragma unroll
        for (int db = 0; db < 4; ++db)
#pragma unroll
            for (int r = 0; r < 16; ++r) o[db][r] = 0.f;
        const int qin = 128 * half + 32 * wq + q31;
#pragma unroll 1
        for (int st = 0; st < nstep; ++st) {
            asm volatile("s_waitcnt vmcnt(0)" ::: "memory"); __builtin_amdgcn_s_barrier(); asm volatile("" ::: "memory");
            if (st + 1 < nstep) attn_dma_step(K, V, lds, b, h, qb, n_own, st + 1, wave, lane);
            const int T = 2 * st + kvh; const bool own = T < n_own;
            const int blk = own ? qb : ((T - n_own) >> 2), kt = own ? T : ((T - n_own) & 3);
            const bool sel = own ? true : ((selmask >> blk) & 1u);
            const bool skip = own ? (64 * kt > 128 * half + 32 * wq + 31) : (__ballot(sel) == 0ull);
            if (!skip) {
                const unsigned kimg = lds0 + (st & 1) * 65536 + kvh * 32768, vimg = kimg + 16384;
                f32x16 p[2];
#pragma unroll
                for (int kh = 0; kh < 2; ++kh) {
#pragma unroll
                    for (int r = 0; r < 16; ++r) p[kh][r] = 0.f;
                    const int row = 32 * kh + q31;
#pragma unroll
                    for (int s = 0; s < 8; ++s) { const bf16x8 a = *(const LAS bf16x8*)(uintptr_t)(kimg + row * 256 + (((2 * s + hh) ^ (row & 15)) << 4));
                        p[kh] = __builtin_amdgcn_mfma_f32_32x32x16_bf16(a, qf[s], p[kh], 0, 0, 0); }
                }
                if (own) { const int kbase = 64 * kt;
                    if (kbase + 63 > 128 * half + 32 * wq) {
#pragma unroll
                        for (int kh = 0; kh < 2; ++kh)
#pragma unroll
                            for (int r = 0; r < 16; ++r) if (kbase + 32 * kh + crow16(r, hh) > qin) p[kh][r] = -INFINITY; }
                } else if (!sel) {
#pragma unroll
                    for (int kh = 0; kh < 2; ++kh)
#pragma unroll
                        for (int r = 0; r < 16; ++r) p[kh][r] = -INFINITY; }
                float mx = p[0][0];
#pragma unroll
                for (int r = 1; r < 16; ++r) mx = fmaxf(mx, p[0][r]);
#pragma unroll
                for (int r = 0; r < 16; ++r) mx = fmaxf(mx, p[1][r]);
                mx = fmaxf(mx, __shfl_xor(mx, 32));
                const float m_new = fmaxf(m_run, mx), scl = exp2f(m_run - m_new); m_run = m_new;
                float rs = 0.f;
#pragma unroll
                for (int kh = 0; kh < 2; ++kh)
#pragma unroll
                    for (int r = 0; r < 16; ++r) { p[kh][r] = exp2f(p[kh][r] - m_new); rs += p[kh][r]; }
                l_run = l_run * scl + rs;
#pragma unroll
                for (int db = 0; db < 4; ++db)
#pragma unroll
                    for (int r = 0; r < 16; ++r) o[db][r] *= scl;
#pragma unroll
                for (int kh = 0; kh < 2; ++kh)
#pragma unroll
                    for (int s2 = 0; s2 < 2; ++s2) {
                        v4u pw; pw.x = pg8::cvt_pk_bf16(p[kh][8 * s2], p[kh][8 * s2 + 1]); pw.y = pg8::cvt_pk_bf16(p[kh][8 * s2 + 2], p[kh][8 * s2 + 3]);
                        pw.z = pg8::cvt_pk_bf16(p[kh][8 * s2 + 4], p[kh][8 * s2 + 5]); pw.w = pg8::cvt_pk_bf16(p[kh][8 * s2 + 6], p[kh][8 * s2 + 7]);
                        const bf16x8 pb = __builtin_bit_cast(bf16x8, pw);
                        const int key0 = 32 * kh + 16 * s2 + 4 * (G4 >> 1) + (l16 >> 2);
#pragma unroll
                        for (int db = 0; db < 4; ++db) {
                            const int dsub = 16 * (G4 & 1) + 4 * (l16 & 3);
                            const unsigned a0 = vimg + key0 * 256 + ((db ^ (key0 & 3)) << 6) + dsub * 2;
                            const v4i16_t lo = vtr16(a0), hi_ = vtr16(a0 + 8 * 256);
                            const bf16x8 av = {lo[0], lo[1], lo[2], lo[3], hi_[0], hi_[1], hi_[2], hi_[3]};
                            o[db] = __builtin_amdgcn_mfma_f32_32x32x16_bf16(av, pb, o[db], 0, 0, 0);
                        }
                    }
            }
        }
        l_run += __shfl_xor(l_run, 32);
        asm volatile("s_waitcnt vmcnt(0) lgkmcnt(0)" ::: "memory"); __builtin_amdgcn_s_barrier(); asm volatile("" ::: "memory");
        LAS float* xs = (LAS float*)lds + (size_t)wq * 66 * 64 + lane;
        if (kvh == 1) {
            xs[0] = m_run; xs[64] = l_run;
#pragma unroll
            for (int db = 0; db < 4; ++db)
#pragma unroll
                for (int r = 0; r < 16; ++r) xs[(2 + 16 * db + r) * 64] = o[db][r];
        }
        asm volatile("s_waitcnt lgkmcnt(0)" ::: "memory"); __builtin_amdgcn_s_barrier(); asm volatile("" ::: "memory");
        if (kvh == 0) {
            const float m2 = xs[0], l2 = xs[64], mt = fmaxf(m_run, m2), a1 = exp2f(m_run - mt), a2 = exp2f(m2 - mt);
            const float inv = 1.0f / (l_run * a1 + l2 * a2), c1 = a1 * inv, c2 = a2 * inv;
            bf16* orow = AO + rowq * 1024 + h * 128 + 4 * hh;
#pragma unroll
            for (int db = 0; db < 4; ++db)
#pragma unroll
                for (int g = 0; g < 4; ++g) {
                    float t[4];
#pragma unroll
                    for (int e = 0; e < 4; ++e) t[e] = o[db][4 * g + e] * c1 + xs[(2 + 16 * db + 4 * g + e) * 64] * c2;
                    u32x2v w; w.x = pg8::cvt_pk_bf16(t[0], t[1]); w.y = pg8::cvt_pk_bf16(t[2], t[3]);
                    *(GAS u32x2v*)(orow + 32 * db + 8 * g) = w;
                }
        }
    }
    asm volatile("s_waitcnt vmcnt(0) lgkmcnt(0)" ::: "memory"); __builtin_amdgcn_s_barrier(); asm volatile("" ::: "memory");
}
__device__ __forceinline__ void up8(const v4u w, float (&f)[8]) { f[0] = bflo(w.x); f[1] = bfhi(w.x); f[2] = bflo(w.y); f[3] = bfhi(w.y); f[4] = bflo(w.z); f[5] = bfhi(w.z); f[6] = bflo(w.w); f[7] = bfhi(w.w); }
__device__ __forceinline__ void conv_phase(const Ctx& F, const bf16* CB, const bf16* CC, const bf16* CX, const float* cw, bf16* UC) {
    const int gt = (F.vcu * NWAVES + F.wave) * 64 + F.lane, NT = F.G * NWAVES * 64;
    for (int idx = gt; idx < M * 128; idx += NT) {
        const int row = idx >> 7, c8 = (idx & 127) << 3, t = row & (SEQ - 1); const size_t off = (size_t)row * 1024 + c8;
        float cb[8], a[8], x[8], z0[8], z1[8], z2[8];
        up8(*(const GAS v4u*)(CB + off), cb); up8(*(const GAS v4u*)(CC + off), a); up8(*(const GAS v4u*)(CX + off), x);
#pragma unroll
        for (int j = 0; j < 8; ++j) z0[j] = a[j] * x[j];
        if (t >= 1) { up8(*(const GAS v4u*)(CC + off - 1024), a); up8(*(const GAS v4u*)(CX + off - 1024), x);
#pragma unroll
            for (int j = 0; j < 8; ++j) z1[j] = a[j] * x[j]; } else {
#pragma unroll
            for (int j = 0; j < 8; ++j) z1[j] = 0.f; }
        if (t >= 2) { up8(*(const GAS v4u*)(CC + off - 2048), a); up8(*(const GAS v4u*)(CX + off - 2048), x);
#pragma unroll
            for (int j = 0; j < 8; ++j) z2[j] = a[j] * x[j]; } else {
#pragma unroll
            for (int j = 0; j < 8; ++j) z2[j] = 0.f; }
        float o[8];
#pragma unroll
        for (int j = 0; j < 8; ++j) o[j] = cb[j] * (cw[c8 + j] * z2[j] + cw[1024 + c8 + j] * z1[j] + cw[2048 + c8 + j] * z0[j]);
        v4u w; w.x = pk2(o[0], o[1]); w.y = pk2(o[2], o[3]); w.z = pk2(o[4], o[5]); w.w = pk2(o[6], o[7]); *(GAS v4u*)(UC + off) = w;
    }
}

__device__ __forceinline__ int imax(int a, int b) { return a > b ? a : b; }
__device__ __forceinline__ int imin(int a, int b) { return a < b ? a : b; }
__device__ __forceinline__ void ce(int& a, int& b) { const int t = imax(a, b); b = imin(a, b); a = t; }
__device__ __forceinline__ void sort16(int (&x)[16]) {
#pragma unroll
    for (int kk = 1; kk <= 4; ++kk)
#pragma unroll
        for (int jj = kk - 1; jj >= 0; --jj)
#pragma unroll
            for (int i = 0; i < 16; ++i) { const int k = 1 << kk, j = 1 << jj, l = i ^ j; if (l > i) { if ((i & k) == 0) ce(x[i], x[l]); else ce(x[l], x[i]); } }
}
__device__ __forceinline__ void bmerge16(int (&a)[16]) {
#pragma unroll
    for (int jj = 3; jj >= 0; --jj)
#pragma unroll
        for (int i = 0; i < 16; ++i) { const int j = 1 << jj, l = i ^ j; if (l > i) ce(a[i], a[l]); }
}
__device__ __forceinline__ void merge16(int (&a)[16], const int (&b)[16]) {
#pragma unroll
    for (int i = 0; i < 16; ++i) a[i] = imax(a[i], b[15 - i]);
    bmerge16(a);
}
__device__ __forceinline__ void xmerge16(int (&a)[16], int hh) {
    int pv[16];
#pragma unroll
    for (int i = 0; i < 16; ++i) { const auto r = __builtin_amdgcn_permlane32_swap((unsigned)a[15 - i], (unsigned)a[15 - i], false, false); pv[i] = hh ? (int)r[0] : (int)r[1]; }
#pragma unroll
    for (int i = 0; i < 16; ++i) a[i] = imax(a[i], pv[i]);
    bmerge16(a);
}
__device__ __forceinline__ int ord_key(float f) { const int u = __float_as_int(f); return u >= 0 ? u : (u ^ 0x7fffffff); }
__device__ __forceinline__ float ord_val(int k) { return __int_as_float(k >= 0 ? k : (k ^ 0x7fffffff)); }
__device__ __forceinline__ unsigned byte16(const unsigned (&t)[4], int idx) {
    const unsigned sel = 0x0c0c0c00u | (unsigned)(idx & 7);
    const unsigned lo = __builtin_amdgcn_perm(t[1], t[0], sel), hi_ = __builtin_amdgcn_perm(t[3], t[2], sel);
    return (idx & 8) ? hi_ : lo;
}
__device__ __forceinline__ void topk_stage_keys(const Ctx& F, const bf16* KEYS, int h) {
    for (int pc = F.wave; pc < 64; pc += 8) { const int pp = pc >> 5, row = 4 * (pc & 31) + (F.lane >> 4), cp = F.lane & 15, c = cp ^ (row & 15);
        __builtin_amdgcn_global_load_lds((const unsigned*)(KEYS + (size_t)((h * 2 + pp) * 128 + row) * 128 + 8 * c), (LAS unsigned*)(F.lds + RING_OFF + pc * 1024), 16, 0, 0); }
    asm volatile("s_waitcnt vmcnt(0)" ::: "memory"); __builtin_amdgcn_s_barrier(); asm volatile("" ::: "memory");
}
__device__ __forceinline__ void topk_phase(const Ctx& F, int bitem, const bf16* QP, int* EXP, float* GATE) {
    const int lane = F.lane, l31 = lane & 31, hh = lane >> 5;
    const int IMIN = (int)0x80000000;
    const unsigned lds0 = (unsigned)(uintptr_t)(F.lds + RING_OFF);
    {
        const int h = bitem & 7, tt = (bitem >> 3) * 8 + F.wave, tok0 = tt * 32;
        int top[2][16];
#pragma unroll
        for (int p = 0; p < 2; ++p) {
            bf16x8 qa[8];
#pragma unroll
            for (int s = 0; s < 8; ++s) qa[s] = *(const GAS bf16x8*)(QP + (size_t)(tok0 + l31) * 2048 + h * 256 + p * 128 + 16 * s + 8 * hh);
            int x[2][16];
#pragma unroll
            for (int pq = 0; pq < 2; ++pq) {
                f32x16 sc[2];
#pragma unroll
                for (int nt = 0; nt < 2; ++nt)
#pragma unroll
                    for (int r = 0; r < 16; ++r) sc[nt][r] = 0.f;
#pragma unroll
                for (int s = 0; s < 8; ++s) {
#pragma unroll
                    for (int nt = 0; nt < 2; ++nt) { const int n = 64 * pq + 32 * nt + l31; const bf16x8 kb = *(const LAS bf16x8*)(uintptr_t)(lds0 + p * 32768 + n * 256 + (((2 * s + hh) ^ (n & 15)) << 4));
                        sc[nt] = __builtin_amdgcn_mfma_f32_32x32x16_bf16(kb, qa[s], sc[nt], 0, 0, 0); }
                }
                int y[16];
#pragma unroll
                for (int r = 0; r < 16; ++r) { x[pq][r] = (ord_key(sc[0][r]) & ~127) | ((127 - 64 * pq - (r & 3) - 8 * (r >> 2)) - 4 * hh); y[r] = (ord_key(sc[1][r]) & ~127) | ((127 - 64 * pq - 32 - (r & 3) - 8 * (r >> 2)) - 4 * hh); }
                sort16(x[pq]); sort16(y); merge16(x[pq], y);
                asm volatile("" ::: "memory");
            }
            merge16(x[0], x[1]);
            xmerge16(x[0], hh);
#pragma unroll
            for (int i = 0; i < 16; ++i) top[p][i] = x[0][i];
        }
        float fa[16], fb[16];
#pragma unroll
        for (int i = 0; i < 16; ++i) { const int A = hh ? top[1][i] : top[0][i], B = hh ? top[0][i] : top[1][i]; fa[i] = ord_val(A & ~127); fb[i] = ord_val(B & ~127); }
        int c0[16], c1[16];
#pragma unroll
        for (int q = 0; q < 32; ++q) {
            int key = IMIN;
            if (q < 27) { const int i = (q < 16) ? 0 : (q < 23) ? 1 : (q < 26) ? 2 : 3, j = (q < 16) ? q : (q < 23) ? q - 15 : (q < 26) ? q - 21 : 3; const float sv = fa[i] + fb[j]; const int low = hh ? (255 - (j * 16 + i)) : (255 - (i * 16 + j));
                key = (ord_key(sv) & ~255) | low; if (i == j && hh) key = IMIN; }
            if (q < 16) c0[q] = key; else c1[q - 16] = key;
        }
        sort16(c0); sort16(c1); merge16(c0, c1); xmerge16(c0, hh);
        unsigned na[4], nb[4];
#pragma unroll
        for (int d = 0; d < 4; ++d) { na[d] = 0u; nb[d] = 0u;
#pragma unroll
            for (int e = 0; e < 4; ++e) { na[d] |= (unsigned)(127 - (top[0][4 * d + e] & 127)) << (8 * e); nb[d] |= (unsigned)(127 - (top[1][4 * d + e] & 127)) << (8 * e); } }
        int ex[16]; float ev[16]; float es = 0.f; const float smax = ord_val(c0[0] & ~255);
#pragma unroll
        for (int q = 0; q < 16; ++q) { const int posn = 255 - (c0[q] & 255); const unsigned n1 = byte16(na, posn >> 4) & 255u, n2 = byte16(nb, posn & 15) & 255u;
            ex[q] = (int)(n1 * 128u + n2); ev[q] = __expf(ord_val(c0[q] & ~255) - smax); es += ev[q]; }
        const float ri = 1.0f / es; const size_t ob = (size_t)(tok0 + l31) * 128 + h * 16;
        if (hh == 0) {
#pragma unroll
            for (int d = 0; d < 4; ++d) { v4u w; w.x = (unsigned)ex[4 * d]; w.y = (unsigned)ex[4 * d + 1]; w.z = (unsigned)ex[4 * d + 2]; w.w = (unsigned)ex[4 * d + 3]; *(GAS v4u*)(EXP + ob + 4 * d) = w; }
        } else {
#pragma unroll
            for (int d = 0; d < 4; ++d) *(GAS f32x4*)(GATE + ob + 4 * d) = (f32x4){ev[4 * d] * ri, ev[4 * d + 1] * ri, ev[4 * d + 2] * ri, ev[4 * d + 3] * ri};
        }
    }
}

typedef float f32x2 __attribute__((ext_vector_type(2)));
constexpr float PEER_SU = 512.0f, PEER_SV = 32.0f;
template <int D> __device__ __forceinline__ void tr_step(float (&part)[64], int lane) {
    const bool up_ = (lane & D) != 0;
#pragma unroll
    for (int i = 0; i < D; ++i) { const float a = part[i], b = part[i + D]; const float send = up_ ? a : b, keep = up_ ? b : a; part[i] = keep + __shfl_xor(send, D); }
}
template <int CTRL> __device__ __forceinline__ int dpp_i(int v) { return __builtin_amdgcn_update_dpp(v, v, CTRL, 0xf, 0xf, false); }
template <int J> __device__ __forceinline__ int xor_lane(int v, int lane) {
    if constexpr (J == 1) return dpp_i<0xB1>(v);
    else if constexpr (J == 2) return dpp_i<0x4E>(v);
    else if constexpr (J == 16) { const auto r = __builtin_amdgcn_permlane16_swap((unsigned)v, (unsigned)v, false, false); return ((lane >> 4) & 1) ? (int)r[0] : (int)r[1]; }
    else if constexpr (J == 32) { const auto r = __builtin_amdgcn_permlane32_swap((unsigned)v, (unsigned)v, false, false); return (lane >> 5) ? (int)r[0] : (int)r[1]; }
    else return __shfl_xor(v, J);
}
template <int KK, int JJ> __device__ __forceinline__ void sort128_step(int& x0, int& x1, int lane) {
    constexpr int k = 1 << KK, j = 1 << JJ;
    if constexpr (j == 64) { const int lo = imin(x0, x1), hi_ = imax(x0, x1); x0 = lo; x1 = hi_; }
    else {
        const int y0 = xor_lane<j>(x0, lane), y1 = xor_lane<j>(x1, lane);
        const bool lower = (lane & j) == 0;
        const bool asc0 = (k >= 128) ? true : (k == 64) ? true : ((lane & k) == 0);
        const bool asc1 = (k >= 128) ? true : (k == 64) ? false : ((lane & k) == 0);
        x0 = (lower == asc0) ? imin(x0, y0) : imax(x0, y0);
        x1 = (lower == asc1) ? imin(x1, y1) : imax(x1, y1);
    }
}
template <int KK, int JJ> __device__ __forceinline__ void sort128_stage(int& x0, int& x1, int lane) { sort128_step<KK, JJ>(x0, x1, lane); if constexpr (JJ > 0) sort128_stage<KK, JJ - 1>(x0, x1, lane); }
__device__ __forceinline__ void sort128(int& x0, int& x1, int lane) {
    sort128_stage<1, 0>(x0, x1, lane); sort128_stage<2, 1>(x0, x1, lane); sort128_stage<3, 2>(x0, x1, lane); sort128_stage<4, 3>(x0, x1, lane);
    sort128_stage<5, 4>(x0, x1, lane); sort128_stage<6, 5>(x0, x1, lane); sort128_stage<7, 6>(x0, x1, lane);
}
__device__ __forceinline__ void peer_phase(const Ctx& F, const unsigned char* U8, const unsigned char* V8, const bf16* X1B, const int* EXP, const float* GATE, const unsigned long long* SS, const float* gfin, const float* X1, float* OUT) {
    const int gw = F.vcu * NWAVES + F.wave, NGW = F.G * NWAVES, lane = F.lane;
    constexpr int NPF = 8;
    for (int t = gw; t < M; t += NGW) {
        int k0 = (EXP[(size_t)t * 128 + lane] << 7) | lane, k1 = (EXP[(size_t)t * 128 + 64 + lane] << 7) | (64 + lane);
        const float gl0 = GATE[(size_t)t * 128 + lane], gl1 = GATE[(size_t)t * 128 + 64 + lane];
        sort128(k0, k1, lane);
        const int e01[2] = { k0 >> 7, k1 >> 7 };
        const float ga0 = __shfl(gl0, k0 & 63), gb0 = __shfl(gl1, k0 & 63), ga1 = __shfl(gl0, k1 & 63), gb1 = __shfl(gl1, k1 & 63);
        const float g01[2] = { (k0 & 64) ? gb0 : ga0, (k1 & 64) ? gb1 : ga1 };
        const float rinv2 = pg8::rinv_from_ss(SS[t]) * (1.0f / PEER_SU);
        f32x2 xv[16];
#pragma unroll
        for (int i = 0; i < 2; ++i)
#pragma unroll
            for (int hv = 0; hv < 2; ++hv) { const v4u w = *(const GAS v4u*)(X1B + (size_t)t * DM + i * 1024 + lane * 16 + 8 * hv);
                xv[8 * i + 4 * hv + 0] = (f32x2){bflo(w.x), bfhi(w.x)}; xv[8 * i + 4 * hv + 1] = (f32x2){bflo(w.y), bfhi(w.y)}; xv[8 * i + 4 * hv + 2] = (f32x2){bflo(w.z), bfhi(w.z)}; xv[8 * i + 4 * hv + 3] = (f32x2){bflo(w.w), bfhi(w.w)}; }
        float act[2];
#pragma unroll
        for (int hf = 0; hf < 2; ++hf) {
            const int ev = e01[hf];
            float part[64]; v4u ub[NPF][2];
#pragma unroll
            for (int k = 0; k < NPF; ++k) { const GAS v4u* up = (const GAS v4u*)(U8 + (size_t)__builtin_amdgcn_readlane(ev, k) * 2048) + lane; ub[k][0] = up[0]; ub[k][1] = up[64]; }
#pragma unroll
            for (int k = 0; k < 64; ++k) {
                f32x2 p0 = {0.f, 0.f}, p1 = {0.f, 0.f};
#pragma unroll
                for (int i = 0; i < 2; ++i) { const v4u w = ub[k % NPF][i];
                    p0 += __builtin_amdgcn_cvt_pk_f32_fp8((int)w.x, false) * xv[8 * i + 0]; p1 += __builtin_amdgcn_cvt_pk_f32_fp8((int)w.x, true) * xv[8 * i + 1];
                    p0 += __builtin_amdgcn_cvt_pk_f32_fp8((int)w.y, false) * xv[8 * i + 2]; p1 += __builtin_amdgcn_cvt_pk_f32_fp8((int)w.y, true) * xv[8 * i + 3];
                    p0 += __builtin_amdgcn_cvt_pk_f32_fp8((int)w.z, false) * xv[8 * i + 4]; p1 += __builtin_amdgcn_cvt_pk_f32_fp8((int)w.z, true) * xv[8 * i + 5];
                    p0 += __builtin_amdgcn_cvt_pk_f32_fp8((int)w.w, false) * xv[8 * i + 6]; p1 += __builtin_amdgcn_cvt_pk_f32_fp8((int)w.w, true) * xv[8 * i + 7]; }
                part[k] = (p0[0] + p0[1]) + (p1[0] + p1[1]);
                if (k + NPF < 64) { const GAS v4u* up = (const GAS v4u*)(U8 + (size_t)__builtin_amdgcn_readlane(ev, k + NPF) * 2048) + lane; ub[k % NPF][0] = up[0]; ub[k % NPF][1] = up[64]; }
            }
            tr_step<32>(part, lane); tr_step<16>(part, lane); tr_step<8>(part, lane); tr_step<4>(part, lane); tr_step<2>(part, lane); tr_step<1>(part, lane);
            act[hf] = gelu_tanh(part[0] * rinv2) * g01[hf] * (1.0f / PEER_SV);
        }
        f32x2 y[16];
#pragma unroll
        for (int j = 0; j < 16; ++j) y[j] = (f32x2){0.f, 0.f};
#pragma unroll
        for (int hf = 0; hf < 2; ++hf) {
            const int ev = e01[hf]; const float av = act[hf];
            v4u vb[NPF][2];
#pragma unroll
            for (int k = 0; k < NPF; ++k) { const GAS v4u* vp = (const GAS v4u*)(V8 + (size_t)__builtin_amdgcn_readlane(ev, k) * 2048) + lane; vb[k][0] = vp[0]; vb[k][1] = vp[64]; }
#pragma unroll
            for (int k = 0; k < 64; ++k) {
                const float s = rdlane(av, k); const f32x2 s2 = {s, s};
#pragma unroll
                for (int i = 0; i < 2; ++i) { const v4u w = vb[k % NPF][i];
                    y[8 * i + 0] += s2 * __builtin_amdgcn_cvt_pk_f32_fp8((int)w.x, false); y[8 * i + 1] += s2 * __builtin_amdgcn_cvt_pk_f32_fp8((int)w.x, true);
                    y[8 * i + 2] += s2 * __builtin_amdgcn_cvt_pk_f32_fp8((int)w.y, false); y[8 * i + 3] += s2 * __builtin_amdgcn_cvt_pk_f32_fp8((int)w.y, true);
                    y[8 * i + 4] += s2 * __builtin_amdgcn_cvt_pk_f32_fp8((int)w.z, false); y[8 * i + 5] += s2 * __builtin_amdgcn_cvt_pk_f32_fp8((int)w.z, true);
                    y[8 * i + 6] += s2 * __builtin_amdgcn_cvt_pk_f32_fp8((int)w.w, false); y[8 * i + 7] += s2 * __builtin_amdgcn_cvt_pk_f32_fp8((int)w.w, true); }
                if (k + NPF < 64) { const GAS v4u* vp = (const GAS v4u*)(V8 + (size_t)__builtin_amdgcn_readlane(ev, k + NPF) * 2048) + lane; vb[k % NPF][0] = vp[0]; vb[k % NPF][1] = vp[64]; }
            }
        }
        const GAS f32x4* xr = (const GAS f32x4*)(X1 + (size_t)t * DM); GAS f32x4* orw = (GAS f32x4*)(OUT + (size_t)t * DM); float ss = 0.f;
#pragma unroll
        for (int i = 0; i < 2; ++i)
#pragma unroll
            for (int q = 0; q < 4; ++q) { const f32x4 a = xr[i * 256 + 4 * lane + q]; y[8 * i + 2 * q] += (f32x2){a[0], a[1]}; y[8 * i + 2 * q + 1] += (f32x2){a[2], a[3]}; }
#pragma unroll
        for (int j = 0; j < 16; ++j) ss += y[j][0] * y[j][0] + y[j][1] * y[j][1];
        const float r3 = 1.0f / sqrtf(wave_sum(ss) * (1.0f / DM) + RMS_EPS);
#pragma unroll
        for (int i = 0; i < 2; ++i)
#pragma unroll
            for (int q = 0; q < 4; ++q) { const f32x4 ga = *(const GAS f32x4*)(gfin + i * 1024 + lane * 16 + 4 * q);
                orw[i * 256 + 4 * lane + q] = (f32x4){y[8 * i + 2 * q][0] * r3 * ga[0], y[8 * i + 2 * q][1] * r3 * ga[1], y[8 * i + 2 * q + 1][0] * r3 * ga[2], y[8 * i + 2 * q + 1][1] * r3 * ga[3]}; }
    }
}

struct Args { const float* in[15]; float* out; unsigned char* ws; double invf[16]; int ph_lo, ph_hi, li, pad; };
__global__ void __launch_bounds__(NWAVES * 64, 2) mk_fwd(Args args) {
    extern __shared__ __attribute__((aligned(16))) unsigned char lds[];
    Ctx F;
    F.lds = (LAS unsigned char*)lds;
    volatile LAS unsigned* MISC = (volatile LAS unsigned*)(F.lds + MISC_OFF);
    F.tid = threadIdx.x; F.lane = F.tid & 63; F.wave = __builtin_amdgcn_readfirstlane(F.tid >> 6);
    F.G = gridDim.x; { const int bx = blockIdx.x; F.vcu = (F.G % 8 == 0) ? (bx % 8) * (F.G / 8) + bx / 8 : bx; }
    unsigned char* ws = args.ws;
    gu32* ctl = (gu32*)(ws + WS_CTL);
    for (int u = F.tid; u < (LDS_BYTES - LDSCTL_OFF) / 4; u += NWAVES * 64) ((LAS unsigned*)(F.lds + LDSCTL_OFF))[u] = 0u;
    __syncthreads();
    XcdBarrier bar; bar.bar = (unsigned*)(ctl + CW_BAR); bar.x = 0; bar.st = nullptr;
    if (N_LAUNCHES != PER_PHASE) bar = xcd_barrier_post((unsigned*)(ctl + CW_BAR), MISC + 8);
#define GRID_BAR() do { if (N_LAUNCHES != PER_PHASE) xcd_barrier(bar); } while (0)
    const int lo = args.ph_lo, hi = args.ph_hi;
#define IN(k) (lo <= (k) && (k) < hi)
#define BOTH(k) (IN(k) && IN((k) + 1))
    bf16* WinT = (bf16*)(ws + WS_WIN); bf16* WbcT = (bf16*)(ws + WS_WBC); bf16* WbaT = (bf16*)(ws + WS_WBA); bf16* WoutT = (bf16*)(ws + WS_WOUT); bf16* WpqT = (bf16*)(ws + WS_WPQ);
    bf16* KEYS = (bf16*)(ws + WS_KEYS); float* CS = (float*)(ws + WS_CS); const unsigned char* UB = ws + WS_UB; const unsigned char* VB = ws + WS_VB;
    bf16* XB = (bf16*)(ws + WS_XB); bf16* T6 = (bf16*)(ws + WS_T6); bf16* GAB = (bf16*)(ws + WS_GAB); bf16* UC = (bf16*)(ws + WS_UC); bf16* AO = (bf16*)(ws + WS_AO);
    bf16* TMP = (bf16*)(ws + WS_TMP); bf16* MB = (bf16*)(ws + WS_MB); bf16* X1B = (bf16*)(ws + WS_X1B); bf16* QP = (bf16*)(ws + WS_QP);
    int* EXP = (int*)(ws + WS_EXP); float* GATE = (float*)(ws + WS_GATE);
    unsigned long long* SS = (unsigned long long*)(ws + WS_SS); float* KSUM = (float*)(ws + WS_KSUM);
    constexpr size_t TS = (size_t)M * 1024;

    if (IN(0)) { for (int rep = 0; rep < NREP(0); ++rep) { p0_prologue(F, args.in, ws, args.invf); if (rep + 1 < NREP(0)) GRID_BAR(); } if (BOTH(0)) GRID_BAR(); }
    if (IN(1)) {
        for (int rep = 0; rep < NREP(1); ++rep) {
        pg8::Gemm g{XB, WinT, M, INW, DM}; pg8::StaticOrder S; S.init(M, INW, F.G, (int)blockIdx.x);
        pg8::EpiIn E{T6, GAB, args.in[4], CS, KSUM};
        pg8::gemm_phase<pg8::EpiIn, pg8::StaticOrder, true, true>(F.lds + RING_OFF, g, S, E);
        if (rep + 1 < NREP(1)) GRID_BAR(); }
        if (BOTH(1)) GRID_BAR();
    }
    if (IN(2)) {
        for (int rep = 0; rep < NREP(2); ++rep) {
        attn_mfma(F, T6 + 3 * TS, T6 + 4 * TS, T6 + 5 * TS, KSUM, AO);
        conv_phase(F, T6, T6 + TS, T6 + 2 * TS, args.in[5], UC);
        if (rep + 1 < NREP(2)) GRID_BAR(); }
        if (BOTH(2)) GRID_BAR();
    }
    if (IN(3)) {
        for (int rep = 0; rep < NREP(3); ++rep) {
        pg8::Gemm g{UC, WbcT, M, DM, 1024}; pg8::StaticOrder S; S.init(M, DM, F.G, (int)blockIdx.x);
        pg8::EpiTmp E{GAB, TMP};
        pg8::gemm_phase<pg8::EpiTmp, pg8::StaticOrder, true, true>(F.lds + RING_OFF, g, S, E);
        if (rep + 1 < NREP(3)) GRID_BAR(); }
        if (BOTH(3)) GRID_BAR();
    }
    if (IN(4)) {
        for (int rep = 0; rep < NREP(4); ++rep) {
        pg8::Gemm g{AO, WbaT, M, DM, 1024}; pg8::StaticOrder S; S.init(M, DM, F.G, (int)blockIdx.x);
        pg8::EpiMerge E{GAB + (size_t)M * DM, TMP, MB};
        pg8::gemm_phase<pg8::EpiMerge, pg8::StaticOrder, true, true>(F.lds + RING_OFF, g, S, E);
        if (rep + 1 < NREP(4)) GRID_BAR(); }
        if (BOTH(4)) GRID_BAR();
    }
    if (IN(5)) {
        for (int rep = 0; rep < NREP(5); ++rep) {
        pg8::Gemm g{MB, WoutT, M, DM, DM}; pg8::StaticOrder S; S.init(M, DM, F.G, (int)blockIdx.x);
        pg8::EpiX1 E{args.in[0], args.out, X1B, (rep + 1 < NREP(5)) ? (unsigned long long*)(ws + 768 * 1024) : SS};
        pg8::gemm_phase<pg8::EpiX1, pg8::StaticOrder, true, true>(F.lds + RING_OFF, g, S, E);
        if (rep + 1 < NREP(5)) GRID_BAR(); }
        if (BOTH(5)) GRID_BAR();
    }
    if (IN(6)) {
        for (int rep = 0; rep < NREP(6); ++rep) {
        pg8::Gemm g{X1B, WpqT, M, DM, DM}; pg8::StaticOrder S; S.init(M, DM, F.G, (int)blockIdx.x);
        pg8::EpiQP E{SS, QP};
        pg8::gemm_phase<pg8::EpiQP, pg8::StaticOrder, true, true>(F.lds + RING_OFF, g, S, E);
        if (rep + 1 < NREP(6)) GRID_BAR(); }
        if (BOTH(6)) GRID_BAR();
    }
    if (IN(7)) { for (int rep = 0; rep < NREP(7); ++rep) {
        for (int bitem = F.vcu; bitem < 256; bitem += F.G) {
            topk_stage_keys(F, KEYS, bitem & 7);
            if (F.wave >= 4 && bitem == F.vcu) convert_tables(F, args.in[12], args.in[13], args.in[9], ws);
            topk_phase(F, bitem, QP, EXP, GATE);
            if (F.wave < 4 && bitem == F.vcu) convert_tables(F, args.in[12], args.in[13], args.in[9], ws);
            asm volatile("s_waitcnt lgkmcnt(0)" ::: "memory"); __builtin_amdgcn_s_barrier(); asm volatile("" ::: "memory");
        }
        if (rep + 1 < NREP(7)) GRID_BAR(); } if (BOTH(7)) GRID_BAR(); }
    if (IN(8)) { for (int rep = 0; rep < NREP(8); ++rep) { peer_phase(F, UB, VB, X1B, EXP, GATE, SS, args.in[14], args.out, (rep + 1 < NREP(8)) ? (float*)(ws + WS_END) : args.out); if (rep + 1 < NREP(8)) GRID_BAR(); } }
#undef IN
#undef BOTH
#undef GRID_BAR
}

extern "C" void kernel_launch(void* const* d_in, const int* in_sizes, int n_in, void* d_out, int out_size, void* d_ws, size_t ws_size, hipStream_t stream) {
    static int grid = 0;
    if (grid == 0) {
        if (n_in != 15 || in_sizes[0] != M * DM || out_size != M * DM || ws_size < WS_END) { fprintf(stderr, "kernel_launch: unexpected shapes (n_in %d, in0 %d, out %d, ws %zu)\n", n_in, n_in > 0 ? in_sizes[0] : -1, out_size, ws_size); grid = -1; return; }
        int dev = 0, cus = 0, per_cu = 0;
        if (hipGetDevice(&dev) != hipSuccess || hipDeviceGetAttribute(&cus, hipDeviceAttributeMultiprocessorCount, dev) != hipSuccess) { grid = -1; return; }
        if (hipFuncSetAttribute((const void*)mk_fwd, hipFuncAttributeMaxDynamicSharedMemorySize, LDS_BYTES) != hipSuccess) { fprintf(stderr, "kernel_launch: hipFuncSetAttribute failed\n"); grid = -1; return; }
        if (hipOccupancyMaxActiveBlocksPerMultiprocessor(&per_cu, (const void*)mk_fwd, NWAVES * 64, LDS_BYTES) != hipSuccess || per_cu < 1) fprintf(stderr, "kernel_launch: occupancy query reports %d\n", per_cu);
        (void)hipGetLastError();
        grid = cus;
    }
    if (grid < 0) return;
    if (hipMemsetAsync((char*)d_ws + WS_CTL, 0, CTL_ZERO_BYTES, stream) != hipSuccess) { fprintf(stderr, "kernel_launch: memset failed\n"); return; }
    Args a{};
    for (int i = 0; i < 15; ++i) a.in[i] = (const float*)d_in[i];
    a.out = (float*)d_out; a.ws = (unsigned char*)d_ws;
    for (int f = 0; f < 16; ++f) a.invf[f] = pow(500000.0, -(double)(2 * f) / 32.0);
    for (int li = 0; li < N_LAUNCHES; ++li) {
        a.ph_lo = (N_LAUNCHES == PER_PHASE) ? li : 0; a.ph_hi = (N_LAUNCHES == PER_PHASE) ? li + 1 : PER_PHASE; a.li = li;
        hipLaunchKernelGGL(mk_fwd, dim3(grid), dim3(NWAVES * 64), LDS_BYTES, stream, a);
        const hipError_t le = hipPeekAtLastError();
        if (le != hipSuccess) { fprintf(stderr, "kernel_launch: launch %d failed: %s\n", li, hipGetErrorName(le)); break; }
    }
}
```

```cpp
#include <hip/hip_runtime.h>
#include <cstdio>
#include <cstdint>
#include <cmath>
namespace pg8 {
#define PG8_LAS __attribute__((address_space(3)))
typedef unsigned short bf16_t;
typedef short bf16x8 __attribute__((ext_vector_type(8)));
typedef float f32x4 __attribute__((ext_vector_type(4)));
typedef unsigned u32x4 __attribute__((ext_vector_type(4)));
constexpr int BM = 256, BK = 64, HALF = 128, HTB = HALF * BK * 2  , STAGE_BYTES = 8 * HTB, NXCD = 8, WGM = 8;

__host__ __device__ __forceinline__ int lds_byte(int r, int c) { const int st = (r >> 4) * 2 + (c >> 5), rr = r & 15, cc = c & 31, ob = rr * 64 + cc * 2; return st * 1024 + (ob ^ (((ob >> 9) & 1) << 5)); }
__host__ __device__ __forceinline__ void stage_rc(int b, int& R, int& C) { const int st = b / 1024, sb = b % 1024, swz = sb ^ (((sb >> 9) & 1) << 5); R = (st >> 1) * 16 + swz / 64; C = (st & 1) * 32 + (swz % 64) / 2; }
__host__ __device__ __forceinline__ int perm32(int rho) { const int n = rho >> 4, i = rho & 15; return 8 * (i >> 2) + 4 * n + (i & 3); }

struct Unit { int pm, pn; };
struct Gemm { const bf16_t* A; const bf16_t* Bt; int M, N, K; };

struct StaticOrder {
    int nM, nN, nwg, G, c;
    __host__ __device__ void init(int M, int N, int G_, int c_) { nM = M / BM; nN = N / BM; nwg = nM * nN; G = G_; c = c_; }
    __host__ __device__ bool next(int i, Unit& u) const {
        const long L = (long)i * G + c; if (L >= nwg) return false;
        int wgid = (int)L; { const int q = nwg / NXCD, r = nwg % NXCD, xcd = wgid % NXCD, off = wgid / NXCD; wgid = (xcd < r ? xcd * (q + 1) : r * (q + 1) + (xcd - r) * q) + off; }
        const int nig = WGM * nN, gid = wgid / nig, fm = gid * WGM, gsz = (nM - fm) < WGM ? (nM - fm) : WGM;
        u.pm = fm + ((wgid % nig) % gsz); u.pn = (wgid % nig) / gsz; return true;
    }
    __device__ __forceinline__ void a_ready(const Unit&) const {}
    __device__ __forceinline__ void done(const Unit&) const {}
};


typedef float f32x2c __attribute__((ext_vector_type(2))); typedef __bf16 bf16x2c __attribute__((ext_vector_type(2)));
__device__ __forceinline__ unsigned cvt_pk_bf16(float lo, float hi) { const f32x2c v = {lo, hi}; const bf16x2c b = __builtin_convertvector(v, bf16x2c); return __builtin_bit_cast(unsigned, b); }
__device__ __forceinline__ u32x4 pack8(f32x4 a, f32x4 b) { u32x4 w; w.x = cvt_pk_bf16(a[0], a[1]); w.y = cvt_pk_bf16(a[2], a[3]); w.z = cvt_pk_bf16(b[0], b[1]); w.w = cvt_pk_bf16(b[2], b[3]); return w; }
__device__ __forceinline__ f32x4 shx(f32x4 v, int o) { f32x4 r; r[0] = __shfl_xor(v[0], o); r[1] = __shfl_xor(v[1], o); r[2] = __shfl_xor(v[2], o); r[3] = __shfl_xor(v[3], o); return r; }
__device__ __forceinline__ f32x4 bf4lo(unsigned a, unsigned b) { f32x4 r; r[0] = __uint_as_float(a << 16); r[1] = __uint_as_float(a & 0xffff0000u); r[2] = __uint_as_float(b << 16); r[3] = __uint_as_float(b & 0xffff0000u); return r; }
__device__ __forceinline__ f32x4 sigm4(f32x4 v) { f32x4 r;
#pragma unroll
    for (int i = 0; i < 4; ++i) r[i] = __builtin_amdgcn_rcpf(1.0f + __expf(-v[i])); return r; }
constexpr float QSCALE = 0.08838834764831845f * 1.4426950408889634f;

struct EpiIn {
    static constexpr bool PERM = true, AFTER_DRAIN = false;
    bf16_t* T6; bf16_t* GAB; const float* gbias; const float* cs; float* ksum;
    __device__ __forceinline__ void operator()(const f32x4 (&acc)[2][2][4][2], const Unit& u, int wr, int wc, int fr, int fq) const {
        const int row0 = u.pm * BM + wr * 64 + fr, pn = u.pn, colw = wc * 32 + 8 * fq;
        if (pn < 24) {
            const int t = pn >> 2;
            bf16_t* base = T6 + (size_t)t * ((size_t)8192 * 1024) + (pn & 3) * 256 + colw;
            const bool rot = (t == 3 || t == 4) && (wc == 0), isk = (t == 4);
            const float qs = (t == 3) ? QSCALE : 1.0f;
            f32x4 ks[2][2];
#pragma unroll
            for (int bj = 0; bj < 2; ++bj) { ks[bj][0] = (f32x4){0.f, 0.f, 0.f, 0.f}; ks[bj][1] = (f32x4){0.f, 0.f, 0.f, 0.f}; }
#pragma unroll
            for (int ai = 0; ai < 2; ++ai)
#pragma unroll
                for (int m = 0; m < 4; ++m) {
                    const int row = row0 + ai * HALF + m * 16;
                    f32x4 c0 = (f32x4){1.f, 1.f, 1.f, 1.f}, c1 = c0, s0 = (f32x4){0.f, 0.f, 0.f, 0.f}, s1 = s0;
                    if (rot) { const float* cp = cs + (size_t)row * 32 + 8 * (fq & 1); c0 = *(const f32x4*)cp; c1 = *(const f32x4*)(cp + 4); s0 = *(const f32x4*)(cp + 16); s1 = *(const f32x4*)(cp + 20);
                        if (fq < 2) { s0 = -s0; s1 = -s1; } }
#pragma unroll
                    for (int bj = 0; bj < 2; ++bj) {
                        f32x4 v0 = acc[ai][bj][m][0], v1 = acc[ai][bj][m][1];
                        if (rot) { const f32x4 p0 = shx(v0, 32), p1 = shx(v1, 32); v0 = v0 * c0 + p0 * s0; v1 = v1 * c1 + p1 * s1; }
                        if (isk) { ks[bj][0] += v0; ks[bj][1] += v1; }
                        v0 = v0 * qs; v1 = v1 * qs;
                        *(u32x4*)(base + (size_t)row * 1024 + bj * HALF) = pack8(v0, v1);
                    }
                }
            if (isk) {
#pragma unroll
                for (int bj = 0; bj < 2; ++bj)
#pragma unroll
                    for (int n = 0; n < 2; ++n) { f32x4 v = ks[bj][n]; v += shx(v, 1); v += shx(v, 2); v += shx(v, 4); v += shx(v, 8);
                        if (fr == 0) { float* kp = ksum + (size_t)u.pm * 1024 + (pn & 3) * 256 + bj * HALF + colw + 4 * n;
                            unsafeAtomicAdd(kp + 0, v[0]); unsafeAtomicAdd(kp + 1, v[1]); unsafeAtomicAdd(kp + 2, v[2]); unsafeAtomicAdd(kp + 3, v[3]); } }
            }
        } else {
            const int t = (pn - 24) >> 3, colg = ((pn - 24) & 7) * 256 + colw;
            bf16_t* base = GAB + (size_t)t * ((size_t)8192 * 2048) + colg;
            const float* bp = gbias + t * 2048 + colg;
            f32x4 bv[2][2];
#pragma unroll
            for (int bj = 0; bj < 2; ++bj) { bv[bj][0] = *(const f32x4*)(bp + bj * HALF); bv[bj][1] = *(const f32x4*)(bp + bj * HALF + 4); }
#pragma unroll
            for (int ai = 0; ai < 2; ++ai)
#pragma unroll
                for (int m = 0; m < 4; ++m) { const int row = row0 + ai * HALF + m * 16;
#pragma unroll
                    for (int bj = 0; bj < 2; ++bj) *(u32x4*)(base + (size_t)row * 2048 + bj * HALF) = pack8(sigm4(acc[ai][bj][m][0] + bv[bj][0]), sigm4(acc[ai][bj][m][1] + bv[bj][1])); }
        }
    }
};
struct EpiTmp {
    static constexpr bool PERM = true, AFTER_DRAIN = false;
    const bf16_t* G; bf16_t* O;
    __device__ __forceinline__ void operator()(const f32x4 (&acc)[2][2][4][2], const Unit& u, int wr, int wc, int fr, int fq) const {
        const int row0 = u.pm * BM + wr * 64 + fr, col0 = u.pn * BM + wc * 32 + 8 * fq;
#pragma unroll
        for (int ai = 0; ai < 2; ++ai)
#pragma unroll
            for (int m = 0; m < 4; ++m) { const size_t off = (size_t)(row0 + ai * HALF + m * 16) * 2048 + col0;
#pragma unroll
                for (int bj = 0; bj < 2; ++bj) { const u32x4 g = *(const u32x4*)(G + off + bj * HALF);
                    *(u32x4*)(O + off + bj * HALF) = pack8(acc[ai][bj][m][0] * bf4lo(g.x, g.y), acc[ai][bj][m][1] * bf4lo(g.z, g.w)); } }
    }
};
struct EpiMerge {
    static constexpr bool PERM = true, AFTER_DRAIN = false;
    const bf16_t* G; const bf16_t* TMP; bf16_t* O;
    __device__ __forceinline__ void operator()(const f32x4 (&acc)[2][2][4][2], const Unit& u, int wr, int wc, int fr, int fq) const {
        const int row0 = u.pm * BM + wr * 64 + fr, col0 = u.pn * BM + wc * 32 + 8 * fq;
#pragma unroll
        for (int ai = 0; ai < 2; ++ai)
#pragma unroll
            for (int m = 0; m < 4; ++m) { const size_t off = (size_t)(row0 + ai * HALF + m * 16) * 2048 + col0;
#pragma unroll
                for (int bj = 0; bj < 2; ++bj) { const u32x4 g = *(const u32x4*)(G + off + bj * HALF), t = *(const u32x4*)(TMP + off + bj * HALF);
                    *(u32x4*)(O + off + bj * HALF) = pack8(bf4lo(t.x, t.y) + acc[ai][bj][m][0] * bf4lo(g.x, g.y), bf4lo(t.z, t.w) + acc[ai][bj][m][1] * bf4lo(g.z, g.w)); } }
    }
};
struct EpiX1 {
    static constexpr bool PERM = true, AFTER_DRAIN = false;
    const float* X; float* X1; bf16_t* X1B; unsigned long long* SS;
    __device__ __forceinline__ void operator()(const f32x4 (&acc)[2][2][4][2], const Unit& u, int wr, int wc, int fr, int fq) const {
        const int row0 = u.pm * BM + wr * 64 + fr, col0 = u.pn * BM + wc * 32 + 8 * fq;
#pragma unroll
        for (int ai = 0; ai < 2; ++ai)
#pragma unroll
            for (int m = 0; m < 4; ++m) { const int row = row0 + ai * HALF + m * 16; const size_t off = (size_t)row * 2048 + col0; float sq = 0.f;
#pragma unroll
                for (int bj = 0; bj < 2; ++bj) { const f32x4 v0 = acc[ai][bj][m][0] + *(const f32x4*)(X + off + bj * HALF), v1 = acc[ai][bj][m][1] + *(const f32x4*)(X + off + bj * HALF + 4);
                    *(f32x4*)(X1 + off + bj * HALF) = v0; *(f32x4*)(X1 + off + bj * HALF + 4) = v1; *(u32x4*)(X1B + off + bj * HALF) = pack8(v0, v1);
                    sq += (v0[0] * v0[0] + v0[1] * v0[1]) + (v0[2] * v0[2] + v0[3] * v0[3]) + (v1[0] * v1[0] + v1[1] * v1[1]) + (v1[2] * v1[2] + v1[3] * v1[3]); }
                sq += __shfl_xor(sq, 16); sq += __shfl_xor(sq, 32);
                if (fq == 0) atomicAdd(SS + row, (unsigned long long)(sq * 4294967296.0f)); }
    }
};
__device__ __forceinline__ float rinv_from_ss(unsigned long long s) { return 1.0f / sqrtf((float)((double)s * (1.0 / 4294967296.0) * (1.0 / 2048.0)) + 1e-6f); }
struct EpiQP {
    static constexpr bool PERM = true, AFTER_DRAIN = false;
    const unsigned long long* SS; bf16_t* O;
    __device__ __forceinline__ void operator()(const f32x4 (&acc)[2][2][4][2], const Unit& u, int wr, int wc, int fr, int fq) const {
        const int row0 = u.pm * BM + wr * 64 + fr, col0 = u.pn * BM + wc * 32 + 8 * fq;
#pragma unroll
        for (int ai = 0; ai < 2; ++ai)
#pragma unroll
            for (int m = 0; m < 4; ++m) { const int row = row0 + ai * HALF + m * 16; const size_t off = (size_t)row * 2048 + col0; const float rv = rinv_from_ss(SS[row]);
#pragma unroll
                for (int bj = 0; bj < 2; ++bj) *(u32x4*)(O + off + bj * HALF) = pack8(acc[ai][bj][m][0] * rv, acc[ai][bj][m][1] * rv); }
    }
};

template <class Epi, class Sched, bool ALIGN_EPI = false, bool SP2 = false>
__device__ __forceinline__ void gemm_phase(PG8_LAS unsigned char* lds, const Gemm g, const Sched& S, const Epi& E) {
    const int tid = threadIdx.x, wid = __builtin_amdgcn_readfirstlane(tid >> 6), lane = tid & 63, wr = wid >> 2, wc = wid & 3, fr = lane & 15, fq = lane >> 4;
    const int K = g.K, nt = K / BK;
    unsigned voffA[2], voffB[2];
#pragma unroll
    for (int i = 0; i < 2; ++i) { int R, C; stage_rc(tid * 16 + i * 8192, R, C); const int Rb = Epi::PERM ? ((R & ~31) + perm32(R & 31)) : R;
        voffA[i] = (unsigned)(R * K + C) * 2u; voffB[i] = (unsigned)(Rb * K + C) * 2u; }
    const size_t kstep = (size_t)(BK * 2);
    const size_t hstep = (size_t)HALF * K * 2;
    const size_t tstep = 2 * hstep;
    const unsigned ldsw = (unsigned)wid * 1024u;
    const int aoff = lds_byte(wr * 64 + fr, fq * 8), boff = lds_byte(wc * 32 + fr, fq * 8);
#define PG8_SA(b, h) (((b) * 2 + (h)) * HTB)
#define PG8_SB(b, h) ((4 + (b) * 2 + (h)) * HTB)
#define PG8_STAGE(bufoff, gbase, voff) do { _Pragma("unroll") for (int _i = 0; _i < 2; ++_i) \
        __builtin_amdgcn_global_load_lds((const unsigned*)((const char*)(gbase) + (voff)[_i]), (PG8_LAS unsigned*)(lds + (bufoff) + ldsw + _i * 8192), 16, 0, 0); } while (0)
#define PG8_LDA(dst, b, h) do { _Pragma("unroll") for (int m = 0; m < 4; ++m) _Pragma("unroll") for (int k = 0; k < 2; ++k) dst[m][k] = *(const PG8_LAS bf16x8*)(lds + PG8_SA(b, h) + aoff + m * 2048 + k * 1024); } while (0)
#define PG8_LDB(dst, b, h) do { _Pragma("unroll") for (int n = 0; n < 2; ++n) _Pragma("unroll") for (int k = 0; k < 2; ++k) dst[n][k] = *(const PG8_LAS bf16x8*)(lds + PG8_SB(b, h) + boff + n * 2048 + k * 1024); } while (0)
#define PG8_MMA(ai, bj, At, Bt) do { __builtin_amdgcn_s_setprio(1); _Pragma("unroll") for (int m = 0; m < 4; ++m) _Pragma("unroll") for (int n = 0; n < 2; ++n) _Pragma("unroll") for (int k = 0; k < 2; ++k) \
        acc[ai][bj][m][n] = __builtin_amdgcn_mfma_f32_16x16x32_bf16(Bt[n][k], At[m][k], acc[ai][bj][m][n], 0, 0, 0); __builtin_amdgcn_s_setprio(0); } while (0)
#define PG8_WAIT_V(n) asm volatile("s_waitcnt vmcnt(" #n ")" ::: "memory")
#define PG8_WAIT_L(n) asm volatile("s_waitcnt lgkmcnt(" #n ")" ::: "memory")
#define PG8_BAR __builtin_amdgcn_s_barrier()
#define PG8_SCHED __builtin_amdgcn_sched_barrier(0)
    Unit cur, nxt; int ui = 0;
    if (!S.next(0, cur)) return;
    f32x4 acc[2][2][4][2];
#pragma unroll
    for (int a = 0; a < 2; ++a)
#pragma unroll
        for (int b = 0; b < 2; ++b)
#pragma unroll
            for (int m = 0; m < 4; ++m)
#pragma unroll
                for (int n = 0; n < 2; ++n) acc[a][b][m][n] = (f32x4){0.f, 0.f, 0.f, 0.f};
    bf16x8 At[4][2], B0[2][2], B1[2][2];
    const char* cA = (const char*)g.A + (size_t)cur.pm * tstep; const char* cB = (const char*)g.Bt + (size_t)cur.pn * tstep;
    S.a_ready(cur);
    if constexpr (SP2) {
        PG8_STAGE(PG8_SB(0, 0), cB, voffB); PG8_STAGE(PG8_SB(0, 1), cB + hstep, voffB); PG8_STAGE(PG8_SA(0, 0), cA, voffA); PG8_STAGE(PG8_SA(0, 1), cA + hstep, voffA);
        if (wr == 1) PG8_BAR;
        PG8_WAIT_V(2); PG8_BAR;
        PG8_STAGE(PG8_SB(1, 0), cB + kstep, voffB); PG8_STAGE(PG8_SA(1, 0), cA + kstep, voffA); PG8_STAGE(PG8_SB(1, 1), cB + hstep + kstep, voffB);
        PG8_WAIT_V(6); PG8_BAR;
    } else {
        PG8_STAGE(PG8_SB(0, 0), cB, voffB); PG8_STAGE(PG8_SA(0, 0), cA, voffA); PG8_STAGE(PG8_SB(0, 1), cB + hstep, voffB); PG8_STAGE(PG8_SA(0, 1), cA + hstep, voffA);
        if (wr == 1) PG8_BAR;
        PG8_WAIT_V(4); PG8_BAR;
        PG8_STAGE(PG8_SB(1, 0), cB + kstep, voffB); PG8_STAGE(PG8_SA(1, 0), cA + kstep, voffA); PG8_STAGE(PG8_SB(1, 1), cB + hstep + kstep, voffB);
        PG8_WAIT_V(6); PG8_BAR;
    }
    for (;;) {
        const bool has_next = S.next(ui + 1, nxt);
        const char* nA = has_next ? (const char*)g.A + (size_t)nxt.pm * tstep : cA; const char* nB = has_next ? (const char*)g.Bt + (size_t)nxt.pn * tstep : cB;
        for (int t = 0; t < nt; t += 2) {
            const bool last = (t == nt - 2);
            const char* a1 = cA + (size_t)(t + 1) * kstep;
            const char* a2 = last ? nA : cA + (size_t)(t + 2) * kstep; const char* b2 = last ? nB : cB + (size_t)(t + 2) * kstep;
            const char* a3 = a2 + kstep; const char* b3 = b2 + kstep;
            if (last && has_next) S.a_ready(nxt);
            if constexpr (SP2) {
            PG8_LDB(B0, 0, 0); PG8_LDB(B1, 0, 1); PG8_SCHED; PG8_LDA(At, 0, 0); PG8_STAGE(PG8_SA(1, 1), a1 + hstep, voffA);
            PG8_WAIT_V(8); PG8_WAIT_L(0); PG8_BAR; PG8_MMA(0, 0, At, B0); PG8_MMA(0, 1, At, B1); PG8_BAR; PG8_SCHED;
            PG8_LDA(At, 0, 1); PG8_STAGE(PG8_SB(0, 0), b2, voffB); PG8_STAGE(PG8_SB(0, 1), b2 + hstep, voffB); PG8_STAGE(PG8_SA(0, 0), a2, voffA);
            PG8_WAIT_V(8); PG8_WAIT_L(0); PG8_BAR; PG8_MMA(1, 0, At, B0); PG8_MMA(1, 1, At, B1); PG8_BAR; PG8_SCHED;
            PG8_LDB(B0, 1, 0); PG8_LDB(B1, 1, 1); PG8_SCHED; PG8_LDA(At, 1, 0); PG8_STAGE(PG8_SA(0, 1), a2 + hstep, voffA);
            PG8_WAIT_V(8); PG8_WAIT_L(0); PG8_BAR; PG8_MMA(0, 0, At, B0); PG8_MMA(0, 1, At, B1); PG8_BAR; PG8_SCHED;
            PG8_LDA(At, 1, 1); PG8_STAGE(PG8_SB(1, 0), b3, voffB); PG8_STAGE(PG8_SB(1, 1), b3 + hstep, voffB); PG8_STAGE(PG8_SA(1, 0), a3, voffA);
            PG8_WAIT_V(8); PG8_WAIT_L(0); PG8_BAR; PG8_MMA(1, 0, At, B0); PG8_MMA(1, 1, At, B1); PG8_BAR; PG8_SCHED;
            } else {
            PG8_LDB(B0, 0, 0); PG8_SCHED; PG8_LDA(At, 0, 0); PG8_STAGE(PG8_SA(1, 1), a1 + hstep, voffA);
            PG8_WAIT_L(8); PG8_BAR; PG8_WAIT_L(0); PG8_MMA(0, 0, At, B0); PG8_BAR; PG8_SCHED;
            PG8_LDB(B1, 0, 1); PG8_STAGE(PG8_SB(0, 0), b2, voffB);
            PG8_BAR; PG8_WAIT_L(0); PG8_MMA(0, 1, At, B1); PG8_BAR;
            PG8_LDA(At, 0, 1); PG8_STAGE(PG8_SA(0, 0), a2, voffA);
            PG8_BAR; PG8_WAIT_L(0); PG8_MMA(1, 0, At, B0); PG8_BAR; PG8_SCHED;
            PG8_STAGE(PG8_SB(0, 1), b2 + hstep, voffB);
            PG8_WAIT_V(6); PG8_BAR; PG8_MMA(1, 1, At, B1); PG8_BAR;
            PG8_LDB(B0, 1, 0); PG8_SCHED; PG8_LDA(At, 1, 0); PG8_STAGE(PG8_SA(0, 1), a2 + hstep, voffA);
            PG8_WAIT_L(8); PG8_BAR; PG8_WAIT_L(0); PG8_MMA(0, 0, At, B0); PG8_BAR; PG8_SCHED;
            PG8_LDB(B1, 1, 1); PG8_STAGE(PG8_SB(1, 0), b3, voffB);
            PG8_BAR; PG8_WAIT_L(0); PG8_MMA(0, 1, At, B1); PG8_BAR;
            PG8_LDA(At, 1, 1); PG8_STAGE(PG8_SA(1, 0), a3, voffA);
            PG8_BAR; PG8_WAIT_L(0); PG8_MMA(1, 0, At, B0); PG8_BAR; PG8_SCHED;
            PG8_STAGE(PG8_SB(1, 1), b3 + hstep, voffB);
            PG8_WAIT_V(6); PG8_BAR; PG8_MMA(1, 1, At, B1); PG8_BAR;
            }
        }
        if constexpr (ALIGN_EPI) { if (wr == 0) PG8_BAR; }
        if constexpr (!Epi::AFTER_DRAIN) { E(acc, cur, wr, wc, fr, fq); S.done(cur); }
        if (!has_next) break;
#pragma unroll
        for (int a = 0; a < 2; ++a)
#pragma unroll
            for (int b = 0; b < 2; ++b)
#pragma unroll
                for (int m = 0; m < 4; ++m)
#pragma unroll
                    for (int n = 0; n < 2; ++n) acc[a][b][m][n] = (f32x4){0.f, 0.f, 0.f, 0.f};
        cur = nxt; cA = nA; cB = nB; ++ui;
        if constexpr (ALIGN_EPI) { if (wr == 1) PG8_BAR; }
    }
    PG8_WAIT_V(0);
    if constexpr (!ALIGN_EPI) { if (wr == 0) PG8_BAR; }
    PG8_BAR;
    if constexpr (Epi::AFTER_DRAIN) { E.fused(acc, cur, wr, wc, fr, fq, lds, wid, lane); S.done(cur); }
#undef PG8_SA
#undef PG8_SB
#undef PG8_STAGE
#undef PG8_LDA
#undef PG8_LDB
#undef PG8_MMA
#undef PG8_WAIT_V
#undef PG8_WAIT_L
#undef PG8_BAR
#undef PG8_SCHED
}
}

constexpr int NWAVES = 8;
#ifndef MK_N_LAUNCHES
#define MK_N_LAUNCHES 1
#endif
constexpr int PER_PHASE = 9;
#ifndef MK_REP_PHASE
#define MK_REP_PHASE -1
#endif
#define NREP(k) (((k) == MK_REP_PHASE) ? 2 : 1)
constexpr int N_LAUNCHES = MK_N_LAUNCHES;
constexpr int M = 8192, SEQ = 4096, DM = 2048, INW = 10240, NEXP = 16384;
constexpr float RMS_EPS = 1e-6f;
constexpr size_t MiB = 1u << 20;
constexpr size_t WS_CTL = 0, CTL_ZERO_BYTES = 1 * MiB;
constexpr size_t WS_SS = 256 * 1024, WS_KSUM = 512 * 1024;
constexpr size_t WS_WIN = 2 * MiB, WS_WBC = 42 * MiB, WS_WBA = 46 * MiB, WS_WOUT = 50 * MiB, WS_WPQ = 58 * MiB, WS_KEYS = 66 * MiB, WS_CS = 67 * MiB;
constexpr size_t WS_UB = 70 * MiB, WS_VB = 102 * MiB;
constexpr size_t WS_XB = 198 * MiB;
constexpr size_t WS_T6 = 230 * MiB;
constexpr size_t WS_GAB = 326 * MiB;
constexpr size_t WS_UC = 390 * MiB, WS_AO = 406 * MiB;
constexpr size_t WS_EXP = 422 * MiB, WS_GATE = 426 * MiB;
constexpr size_t WS_END = 430 * MiB;
constexpr size_t WS_TMP = WS_XB, WS_MB = WS_T6, WS_X1B = WS_T6 + 48 * MiB, WS_QP = WS_GAB;
constexpr int CW_BAR = 4096;
constexpr int RING_OFF = 0, RING_BYTES = 131072;
constexpr int LDSCTL_OFF = RING_BYTES, MISC_OFF = LDSCTL_OFF + 320;
constexpr int LDS_BYTES = 147456;

#define GAS __attribute__((address_space(1)))
#define LAS __attribute__((address_space(3)))
typedef unsigned short bf16;
typedef unsigned v4u __attribute__((ext_vector_type(4)));
typedef float f32x4 __attribute__((ext_vector_type(4)));
typedef short bf16x8 __attribute__((ext_vector_type(8)));
typedef GAS unsigned gu32;
typedef GAS unsigned long long gu64;
#define RLX_AGENT __ATOMIC_RELAXED, __HIP_MEMORY_SCOPE_AGENT
#define LDS_WAIT() asm volatile("s_waitcnt lgkmcnt(0)" ::: "memory")
#define VM_WAIT() asm volatile("s_waitcnt vmcnt(0)" ::: "memory")
__device__ __forceinline__ unsigned long long rt() { return __builtin_amdgcn_s_memrealtime(); }
__device__ __forceinline__ unsigned f2bf(float f) { unsigned u = __builtin_bit_cast(unsigned, f); return (u + 0x7fffu + ((u >> 16) & 1u)) >> 16; }
__device__ __forceinline__ unsigned pk2(float lo, float hi) { return f2bf(lo) | (f2bf(hi) << 16); }

#define XB_TMO      128
#define XB_XCNT(j)  (256  + 64 * (j))
#define XB_XSUB(j)  (1280 + 64 * (j))
#define XB_XGEN(j)  (2304 + 64 * (j))
#define XB_TOP      3328
#define XB_TOPGEN   3392
#define XCD_BAR_WORDS 3456
#define XB_SPIN_CAP (1u << 18)

__device__ __forceinline__ unsigned xb_ld(unsigned* p)              { return __hip_atomic_load(p, __ATOMIC_RELAXED, __HIP_MEMORY_SCOPE_AGENT); }
__device__ __forceinline__ unsigned xb_add(unsigned* p, unsigned v) { return __hip_atomic_fetch_add(p, v, __ATOMIC_RELAXED, __HIP_MEMORY_SCOPE_AGENT); }
__device__ __forceinline__ unsigned xb_xcc_id() { return (unsigned)__builtin_amdgcn_s_getreg((3 << 11) | 20) & 0xFu; }
#define XB_SPIN(cond, bar) do { unsigned _sp = 0; while (cond) { __builtin_amdgcn_s_sleep(1); \
    if ((++_sp & 255u) == 0u) { if (xb_ld(&(bar)[XB_TMO])) break; if (_sp > XB_SPIN_CAP) { atomicAdd(&(bar)[XB_TMO], 1u); break; } } } } while (0)

struct XcdBarrier {
    unsigned* bar; unsigned x;
    volatile LAS unsigned* st;
};

__device__ __forceinline__ XcdBarrier xcd_barrier_post(unsigned* bar, volatile LAS unsigned* st) {
    XcdBarrier b; b.bar = bar; b.x = xb_xcc_id(); b.st = st;
    if (threadIdx.x == 0) (void)xb_add(&bar[XB_XCNT(b.x)], 1u);
    return b;
}
__device__ __forceinline__ void xcd_barrier_complete(unsigned* bar, unsigned x, unsigned& nloc, unsigned& nx) {
    const unsigned G = gridDim.x * gridDim.y * gridDim.z;
    unsigned sum, cnt, mine, sp = 0u;
    for (;;) {
        sum = 0u; cnt = 0u; mine = 0u;
#pragma unroll
        for (unsigned j = 0; j < 16; ++j) { const unsigned c = xb_ld(&bar[XB_XCNT(j)]); sum += c; cnt += (c > 0u) ? 1u : 0u; mine = (j == x) ? c : mine; }
        if (sum == G) break;
        __builtin_amdgcn_s_sleep(1);
        if ((++sp & 255u) == 0u) { if (xb_ld(&bar[XB_TMO])) break; if (sp > XB_SPIN_CAP) { atomicAdd(&bar[XB_TMO], 1u); break; } }
    }
    nloc = mine > 0u ? mine : 1u; nx = cnt > 0u ? cnt : 1u;
}

__device__ __forceinline__ void xcd_barrier(const XcdBarrier& b) {
    asm volatile("s_waitcnt vmcnt(0)" ::: "memory");
    __syncthreads();
    if (threadIdx.x == 0) {
        unsigned* bar = b.bar;
        __builtin_amdgcn_s_waitcnt(0);
        unsigned nloc = b.st[0], nx = b.st[1];
        if (nloc == 0u) { xcd_barrier_complete(bar, b.x, nloc, nx); b.st[0] = nloc; b.st[1] = nx; }
        const unsigned old = xb_add(&bar[XB_XSUB(b.x)], 1u);
        const unsigned gen = old / nloc;
        if (old + 1u == (gen + 1u) * nloc) {
            __builtin_amdgcn_fence(__ATOMIC_RELEASE, "agent");
            asm volatile("s_waitcnt vmcnt(0)" ::: "memory");
            const unsigned og = xb_add(&bar[XB_TOP], 1u);
            const unsigned tg = og / nx;
            if (og + 1u == (tg + 1u) * nx) xb_add(&bar[XB_TOPGEN], 1u);
            else XB_SPIN(xb_ld(&bar[XB_TOPGEN]) == tg, bar);
            __builtin_amdgcn_fence(__ATOMIC_ACQUIRE, "agent");
            xb_add(&bar[XB_XGEN(b.x)], 1u);
            asm volatile("s_waitcnt vmcnt(0)" ::: "memory");
        } else {
            XB_SPIN(xb_ld(&bar[XB_XGEN(b.x)]) == gen, bar);
            __builtin_amdgcn_fence(__ATOMIC_ACQUIRE, "agent");
            asm volatile("s_waitcnt vmcnt(0)" ::: "memory");
        }
    }
    __syncthreads();
}

typedef __bf16 bf16x2v __attribute__((ext_vector_type(2)));
typedef float f32x16 __attribute__((ext_vector_type(16)));
__device__ __forceinline__ float bflo(unsigned w) { return __uint_as_float(w << 16); }
__device__ __forceinline__ float bfhi(unsigned w) { return __uint_as_float(w & 0xffff0000u); }
__device__ __forceinline__ float dot2bf(unsigned a, unsigned b, float c) { return __builtin_amdgcn_fdot2_f32_bf16(__builtin_bit_cast(bf16x2v, a), __builtin_bit_cast(bf16x2v, b), c, false); }
__device__ __forceinline__ float wave_sum(float v) {
#pragma unroll
    for (int o = 1; o < 64; o <<= 1) v += __shfl_xor(v, o);
    return v; }
__device__ __forceinline__ float wave_max(float v) {
#pragma unroll
    for (int o = 1; o < 64; o <<= 1) v = fmaxf(v, __shfl_xor(v, o));
    return v; }
__device__ __forceinline__ float rdlane(float v, int l) { return __int_as_float(__builtin_amdgcn_readlane(__float_as_int(v), l)); }
__device__ __forceinline__ float gelu_tanh(float x) { const float z = 0.7978845608028654f * (x + 0.044715f * x * x * x); const float e = __expf(2.0f * z); const float th = 1.0f - 2.0f * __builtin_amdgcn_rcpf(1.0f + e); return 0.5f * x * (1.0f + th); }

struct Ctx { LAS unsigned char* lds; int tid, lane, wave, vcu, G; };

__device__ __forceinline__ void p0_transpose_item(const float* W, int K, int N, bf16* WT, const float* gk, LAS float* scr, int item, int lane) {
    const int nblk = N / 32, kb = item / nblk, nb = item % nblk, k0 = 64 * kb, n0 = 32 * nb;
#pragma unroll
    for (int i = 0; i < 8; ++i) { const int kk = 8 * i + (lane >> 3), nn = 4 * (lane & 7); f32x4 v = *(const GAS f32x4*)(W + (size_t)(k0 + kk) * N + n0 + nn); if (gk) v = v * gk[k0 + kk];
        scr[kk * 33 + nn] = v[0]; scr[kk * 33 + nn + 1] = v[1]; scr[kk * 33 + nn + 2] = v[2]; scr[kk * 33 + nn + 3] = v[3]; }
    LDS_WAIT(); asm volatile("" ::: "memory");
    const int c = lane & 7;
#pragma unroll
    for (int j = 0; j < 4; ++j) { const int n = (lane >> 3) + 8 * j; const LAS float* s = scr + (8 * c) * 33 + n;
        v4u o; o.x = pk2(s[0 * 33], s[1 * 33]); o.y = pk2(s[2 * 33], s[3 * 33]); o.z = pk2(s[4 * 33], s[5 * 33]); o.w = pk2(s[6 * 33], s[7 * 33]);
        *(GAS v4u*)(WT + (size_t)(n0 + n) * K + k0 + 8 * c) = o; }
    LDS_WAIT(); asm volatile("" ::: "memory");
}
__device__ __forceinline__ void convert_tables(const Ctx& F, const float* pu, const float* pv, const float* g2, unsigned char* ws) {
    const int gt = (F.vcu * NWAVES + F.wave) * 64 + F.lane, NT = F.G * NWAVES * 64;
    for (int i = gt; i < NEXP * 2048 / 16; i += NT) { const int c16 = (i & 127) * 16; v4u ou, ov;
#pragma unroll
        for (int q = 0; q < 4; ++q) { f32x4 a = ((const GAS f32x4*)pu)[4 * i + q]; a = a * *(const GAS f32x4*)(g2 + c16 + 4 * q) * 512.0f; const f32x4 b = ((const GAS f32x4*)pv)[4 * i + q] * 32.0f;
            int wu = 0, wv = 0; wu = __builtin_amdgcn_cvt_pk_fp8_f32(a[0], a[1], wu, false); wu = __builtin_amdgcn_cvt_pk_fp8_f32(a[2], a[3], wu, true);
            wv = __builtin_amdgcn_cvt_pk_fp8_f32(b[0], b[1], wv, false); wv = __builtin_amdgcn_cvt_pk_fp8_f32(b[2], b[3], wv, true); ou[q] = (unsigned)wu; ov[q] = (unsigned)wv; }
        ((GAS v4u*)(ws + WS_UB))[i] = ou; ((GAS v4u*)(ws + WS_VB))[i] = ov; }
}
__device__ __forceinline__ void p0_prologue(const Ctx& F, const float* const* in, unsigned char* ws, const double* invf) {
    const float* x = in[0]; const int* pos = (const int*)in[1]; const float* g1 = in[2]; const float* w_in = in[3];
    const float* w_bc = in[6]; const float* w_ba = in[7]; const float* w_out = in[8]; const float* g2 = in[9]; const float* w_pq = in[10];
    const float* keys = in[11]; const float* pu = in[12]; const float* pv = in[13];
    LAS float* scr = (LAS float*)(F.lds + RING_OFF + F.wave * 16384);
    const int gw = F.vcu * NWAVES + F.wave, NGW = F.G * NWAVES;
    const int gt = gw * 64 + F.lane, NT = NGW * 64;
    for (int i = gt; i < 8192; i += NT) ((GAS unsigned long long*)(ws + WS_SS))[i] = 0ull;
    for (int i = gt; i < 32 * 1024; i += NT) ((GAS float*)(ws + WS_KSUM))[i] = 0.f;
    constexpr int I_IN = 32 * 320, I_BC = 16 * 64, I_OUT = 32 * 64;
    constexpr int NITEMS = I_IN + 2 * I_BC + 2 * I_OUT;
    for (int it = gw; it < NITEMS; it += NGW) {
        int r = it;
        if (r < I_IN) { p0_transpose_item(w_in, 2048, INW, (bf16*)(ws + WS_WIN), g1, scr, r, F.lane); continue; } r -= I_IN;
        if (r < I_BC) { p0_transpose_item(w_bc, 1024, 2048, (bf16*)(ws + WS_WBC), nullptr, scr, r, F.lane); continue; } r -= I_BC;
        if (r < I_BC) { p0_transpose_item(w_ba, 1024, 2048, (bf16*)(ws + WS_WBA), nullptr, scr, r, F.lane); continue; } r -= I_BC;
        if (r < I_OUT) { p0_transpose_item(w_out, 2048, 2048, (bf16*)(ws + WS_WOUT), nullptr, scr, r, F.lane); continue; } r -= I_OUT;
        p0_transpose_item(w_pq, 2048, 2048, (bf16*)(ws + WS_WPQ), g2, scr, r, F.lane);
    }
    for (int i = gt; i < 16 * 128 * 128 / 8; i += NT) { const f32x4 a = ((const GAS f32x4*)keys)[2 * i], b = ((const GAS f32x4*)keys)[2 * i + 1];
        v4u o; o.x = pk2(a[0], a[1]); o.y = pk2(a[2], a[3]); o.z = pk2(b[0], b[1]); o.w = pk2(b[2], b[3]); ((GAS v4u*)(ws + WS_KEYS))[i] = o; }
    for (int m = gw; m < M; m += NGW) { const GAS f32x4* xr = (const GAS f32x4*)(x + (size_t)m * DM);
        f32x4 v[8]; float s = 0.f;
#pragma unroll
        for (int i = 0; i < 4; ++i) { v[2 * i] = xr[i * 128 + 2 * F.lane]; v[2 * i + 1] = xr[i * 128 + 2 * F.lane + 1]; }
#pragma unroll
        for (int i = 0; i < 8; ++i) s += (v[i][0] * v[i][0] + v[i][1] * v[i][1]) + (v[i][2] * v[i][2] + v[i][3] * v[i][3]);
        const float rinv = 1.0f / sqrtf(wave_sum(s) * (1.0f / DM) + RMS_EPS);
        GAS v4u* o = (GAS v4u*)(ws + WS_XB + (size_t)m * DM * 2);
#pragma unroll
        for (int i = 0; i < 4; ++i) { const f32x4 a = v[2 * i] * rinv, b = v[2 * i + 1] * rinv; v4u w; w.x = pk2(a[0], a[1]); w.y = pk2(a[2], a[3]); w.z = pk2(b[0], b[1]); w.w = pk2(b[2], b[3]); o[i * 64 + F.lane] = w; } }
    for (int i = gt; i < M * 16; i += NT) { const int row = i >> 4, f = i & 15; const double ang = (double)pos[row] * invf[f];
        const double k = __builtin_rint(ang * 0.15915494309189535); const float r = (float)(ang - k * 6.283185307179586);
        float* cs = (float*)(ws + WS_CS); cs[row * 32 + f] = __cosf(r); cs[row * 32 + 16 + f] = __sinf(r); }
}

__device__ __forceinline__ void attn_simple(const Ctx& F, const bf16* Q, const bf16* K, const bf16* V, const float* ksum, bf16* AO) {
    LAS float* qf = (LAS float*)(F.lds + RING_OFF + F.wave * 512);
    const int gw = F.vcu * NWAVES + F.wave, NGW = F.G * NWAVES, lane = F.lane;
    for (int item = gw; item < 16 * SEQ; item += NGW) {
        const int bh = item >> 12, t = item & 4095, b = bh >> 3, h = bh & 7, blk = t >> 8;
        const size_t row = (size_t)b * SEQ + t;
        { const unsigned qq = *(const GAS unsigned*)(Q + row * 1024 + h * 128 + 2 * lane); qf[2 * lane] = bflo(qq); qf[2 * lane + 1] = bfhi(qq); }
        LDS_WAIT(); asm volatile("" ::: "memory");
        float g = -INFINITY;
        if (lane < blk) { const GAS f32x4* km = (const GAS f32x4*)(ksum + (size_t)(b * 16 + lane) * 1024 + h * 128); float a = 0.f;
            for (int d = 0; d < 32; ++d) { const f32x4 kv = km[d]; const f32x4 qv = *(const LAS f32x4*)(qf + 4 * d); a += (kv[0] * qv[0] + kv[1] * qv[1]) + (kv[2] * qv[2] + kv[3] * qv[3]); }
            g = a; }
        int sel[3];
#pragma unroll
        for (int i = 0; i < 3; ++i) { const float mx = wave_max(g); const unsigned long long bal = __ballot(g == mx && lane < blk); const int idx = bal ? (__ffsll((long long)bal) - 1) : 0; sel[i] = idx; if (lane == idx) g = -INFINITY; }
        const int nsel = blk < 3 ? blk : 3;
        float sc[4][4]; float mx = -INFINITY;
#pragma unroll
        for (int slot = 0; slot < 4; ++slot) {
            const bool valid = (slot == 3) || (slot < nsel);
            const int kb = (slot == 3) ? blk : sel[slot < 3 ? slot : 0];
#pragma unroll
            for (int r = 0; r < 4; ++r) {
                float s = -INFINITY; const int key0 = kb * 256 + r * 64;
                if (valid && (slot < 3 || key0 <= t)) {
                    const int key = key0 + lane; const GAS v4u* kp = (const GAS v4u*)(K + ((size_t)b * SEQ + key) * 1024 + h * 128); float a = 0.f;
#pragma unroll 4
                    for (int d = 0; d < 16; ++d) { const v4u kk = kp[d]; const f32x4 q0 = *(const LAS f32x4*)(qf + 8 * d), q1 = *(const LAS f32x4*)(qf + 8 * d + 4);
                        a += (bflo(kk.x) * q0[0] + bfhi(kk.x) * q0[1]) + (bflo(kk.y) * q0[2] + bfhi(kk.y) * q0[3]) + (bflo(kk.z) * q1[0] + bfhi(kk.z) * q1[1]) + (bflo(kk.w) * q1[2] + bfhi(kk.w) * q1[3]); }
                    s = (slot < 3 || key <= t) ? a : -INFINITY; }
                sc[slot][r] = s; mx = fmaxf(mx, s); } }
        mx = wave_max(mx);
        float sum = 0.f;
#pragma unroll
        for (int slot = 0; slot < 4; ++slot)
#pragma unroll
            for (int r = 0; r < 4; ++r) { sc[slot][r] = exp2f(sc[slot][r] - mx); sum += sc[slot][r]; }
        sum = wave_sum(sum);
        float o0 = 0.f, o1 = 0.f;
#pragma unroll
        for (int slot = 0; slot < 4; ++slot) {
            const bool valid = (slot == 3) || (slot < nsel);
            const int kb = (slot == 3) ? blk : sel[slot < 3 ? slot : 0];
#pragma unroll
            for (int r = 0; r < 4; ++r) { const int key0 = kb * 256 + r * 64;
                if (valid && (slot < 3 || key0 <= t)) { const float pr = sc[slot][r]; const GAS unsigned* vp = (const GAS unsigned*)(V + ((size_t)b * SEQ + key0) * 1024 + h * 128) + lane;
                    for (int kk = 0; kk < 64; ++kk) { const float pk = rdlane(pr, kk); const unsigned vv = vp[(size_t)kk * 512]; o0 += pk * bflo(vv); o1 += pk * bfhi(vv); } } } }
        const float ri = 1.0f / sum;
        *(GAS unsigned*)(AO + row * 1024 + h * 128 + 2 * lane) = pk2(o0 * ri, o1 * ri);
    }
}
typedef short v4i16_t __attribute__((ext_vector_type(4))); typedef unsigned u32x2v __attribute__((ext_vector_type(2)));
__device__ __forceinline__ v4i16_t vtr16(unsigned addr) { return __builtin_amdgcn_ds_read_tr16_b64_v4i16((LAS v4i16_t*)(uintptr_t)addr); }
__device__ __forceinline__ int crow16(int r, int hh) { return (r & 3) + 8 * (r >> 2) + 4 * hh; }
__device__ __forceinline__ void attn_dma_step(const bf16* K, const bf16* V, LAS unsigned char* lds, int b, int h, int qb, int n_own, int st, int wave, int lane) {
    const int buf = st & 1;
#pragma unroll
    for (int img = 0; img < 4; ++img) {
        const int T = 2 * st + (img >> 1); const bool isV = img & 1;
        const int blk = (T < n_own) ? qb : ((T - n_own) >> 2), kt = (T < n_own) ? T : ((T - n_own) & 3);
        const bf16* base = (isV ? V : K) + ((size_t)b * SEQ + 256 * blk + 64 * kt) * 1024 + h * 128;
#pragma unroll
        for (int i = 0; i < 2; ++i) { const int pc = wave + 8 * i, row = 4 * pc + (lane >> 4), cp = lane & 15;
            const int c = isV ? ((((cp >> 2) ^ (row & 3)) << 2) | (cp & 3)) : (cp ^ (row & 15));
            __builtin_amdgcn_global_load_lds((const unsigned*)(base + (size_t)row * 1024 + 8 * c), (LAS unsigned*)(lds + buf * 65536 + img * 16384 + pc * 1024), 16, 0, 0); }
    }
}
__device__ __forceinline__ void attn_mfma(const Ctx& F, const bf16* Q, const bf16* K, const bf16* V, const float* ksum, bf16* AO) {
    const int lane = F.lane, wave = F.wave, q31 = lane & 31, hh = lane >> 5, wq = wave & 3, kvh = wave >> 2, l16 = lane & 15, G4 = lane >> 4;
    LAS unsigned char* lds = F.lds + RING_OFF;
    const unsigned lds0 = (unsigned)(uintptr_t)lds;
    for (int pr = F.vcu; pr < 256; pr += F.G)
#pragma unroll 1
    for (int pi = 0; pi < 2; ++pi) {
        const int bh = pr >> 4, s_ = pr & 15, u128 = pi ? 31 - s_ : s_, b = bh >> 3, h = bh & 7, qb = u128 >> 1, half = u128 & 1;
        const int n_own = half ? 4 : 2, nstep = (n_own + 4 * qb) >> 1;
        const size_t rowq = (size_t)b * SEQ + 256 * qb + 128 * half + 32 * wq + q31;
        asm volatile("s_waitcnt vmcnt(0) lgkmcnt(0)" ::: "memory"); __builtin_amdgcn_s_barrier(); asm volatile("" ::: "memory");
        attn_dma_step(K, V, lds, b, h, qb, n_own, 0, wave, lane);
        bf16x8 qf[8];
#pragma unroll
        for (int s = 0; s < 8; ++s) qf[s] = *(const GAS bf16x8*)(Q + rowq * 1024 + h * 128 + 16 * s + 8 * hh);
        unsigned selmask;
        {
            float qv[64];
#pragma unroll
            for (int s = 0; s < 8; ++s)
#pragma unroll
                for (int e = 0; e < 8; ++e) qv[8 * s + e] = __uint_as_float((unsigned)(unsigned short)qf[s][e] << 16);
            float v0 = -INFINITY, v1 = -INFINITY, v2 = -INFINITY; int i0 = 0, i1 = 0, i2 = 0;
#pragma unroll 1
            for (int j = 0; j < qb; ++j) {
                const GAS f32x4* kp = (const GAS f32x4*)(ksum + (size_t)(b * 16 + j) * 1024 + h * 128 + 8 * hh); float a = 0.f;
#pragma unroll
                for (int s = 0; s < 8; ++s) { const f32x4 k0 = kp[4 * s], k1 = kp[4 * s + 1];
                    a += (qv[8 * s] * k0[0] + qv[8 * s + 1] * k0[1]) + (qv[8 * s + 2] * k0[2] + qv[8 * s + 3] * k0[3]) + (qv[8 * s + 4] * k1[0] + qv[8 * s + 5] * k1[1]) + (qv[8 * s + 6] * k1[2] + qv[8 * s + 7] * k1[3]); }
                a += __shfl_xor(a, 32);
                if (a > v0) { v2 = v1; i2 = i1; v1 = v0; i1 = i0; v0 = a; i0 = j; } else if (a > v1) { v2 = v1; i2 = i1; v1 = a; i1 = j; } else if (a > v2) { v2 = a; i2 = j; }
            }
            selmask = (qb <= 3) ? ((1u << qb) - 1u) : ((1u << i0) | (1u << i1) | (1u << i2));
        }
        float m_run = -1e30f, l_run = 0.f; f32x16 o[4];
#pragma unroll
        for (int db = 0; db < 4; ++db)
#pragma unroll
            for (int r = 0; r < 16; ++r) o[db][r] = 0.f;
        const int qin = 128 * half + 32 * wq + q31;
#pragma unroll 1
        for (int st = 0; st < nstep; ++st) {
            asm volatile("s_waitcnt vmcnt(0)" ::: "memory"); __builtin_amdgcn_s_barrier(); asm volatile("" ::: "memory");
            if (st + 1 < nstep) attn_dma_step(K, V, lds, b, h, qb, n_own, st + 1, wave, lane);
            const int T = 2 * st + kvh; const bool own = T < n_own;
            const int blk = own ? qb : ((T - n_own) >> 2), kt = own ? T : ((T - n_own) & 3);
            const bool sel = own ? true : ((selmask >> blk) & 1u);
            const bool skip = own ? (64 * kt > 128 * half + 32 * wq + 31) : (__ballot(sel) == 0ull);
            if (!skip) {
                const unsigned kimg = lds0 + (st & 1) * 65536 + kvh * 32768, vimg = kimg + 16384;
                f32x16 p[2];
#pragma unroll
                for (int kh = 0; kh < 2; ++kh) {
#pragma unroll
                    for (int r = 0; r < 16; ++r) p[kh][r] = 0.f;
                    const int row = 32 * kh + q31;
#pragma unroll
                    for (int s = 0; s < 8; ++s) { const bf16x8 a = *(const LAS bf16x8*)(uintptr_t)(kimg + row * 256 + (((2 * s + hh) ^ (row & 15)) << 4));
                        p[kh] = __builtin_amdgcn_mfma_f32_32x32x16_bf16(a, qf[s], p[kh], 0, 0, 0); }
                }
                if (own) { const int kbase = 64 * kt;
                    if (kbase + 63 > 128 * half + 32 * wq) {
#pragma unroll
                        for (int kh = 0; kh < 2; ++kh)
#pragma unroll
                            for (int r = 0; r < 16; ++r) if (kbase + 32 * kh + crow16(r, hh) > qin) p[kh][r] = -INFINITY; }
                }
                float mx = p[0][0];
#pragma unroll
                for (int r = 1; r < 16; ++r) mx = fmaxf(mx, p[0][r]);
#pragma unroll
                for (int r = 0; r < 16; ++r) mx = fmaxf(mx, p[1][r]);
                { const auto rr = __builtin_amdgcn_permlane32_swap(__float_as_uint(mx), __float_as_uint(mx), false, false); mx = fmaxf(__uint_as_float(rr[0]), __uint_as_float(rr[1])); }
                if (!sel) mx = -INFINITY;
                const float m_new = fmaxf(m_run, mx), scl = __builtin_amdgcn_exp2f(m_run - m_new); m_run = m_new;
                float rs = 0.f;
#pragma unroll
                for (int kh = 0; kh < 2; ++kh)
#pragma unroll
                    for (int r = 0; r < 16; ++r) { p[kh][r] = __builtin_amdgcn_exp2f(p[kh][r] - m_new); rs += p[kh][r]; }
                l_run = l_run * scl + (sel ? rs : 0.f);
                if (__ballot(scl != 1.0f) != 0ull) {
#pragma unroll
                    for (int db = 0; db < 4; ++db)
#pragma unroll
                        for (int r = 0; r < 16; ++r) o[db][r] *= scl; }
                const unsigned pmask = sel ? 0xffffffffu : 0u;
#pragma unroll
                for (int kh = 0; kh < 2; ++kh)
#pragma unroll
                    for (int s2 = 0; s2 < 2; ++s2) {
                        v4u pw; pw.x = pg8::cvt_pk_bf16(p[kh][8 * s2], p[kh][8 * s2 + 1]); pw.y = pg8::cvt_pk_bf16(p[kh][8 * s2 + 2], p[kh][8 * s2 + 3]);
                        pw.z = pg8::cvt_pk_bf16(p[kh][8 * s2 + 4], p[kh][8 * s2 + 5]); pw.w = pg8::cvt_pk_bf16(p[kh][8 * s2 + 6], p[kh][8 * s2 + 7]);
                        pw.x &= pmask; pw.y &= pmask; pw.z &= pmask; pw.w &= pmask;
                        const bf16x8 pb = __builtin_bit_cast(bf16x8, pw);
                        const int key0 = 32 * kh + 16 * s2 + 4 * (G4 >> 1) + (l16 >> 2);
#pragma unroll
                        for (int db = 0; db < 4; ++db) {
                            const int dsub = 16 * (G4 & 1) + 4 * (l16 & 3);
                            const unsigned a0 = vimg + key0 * 256 + ((db ^ (key0 & 3)) << 6) + dsub * 2;
                            const v4i16_t lo = vtr16(a0), hi_ = vtr16(a0 + 8 * 256);
                            const bf16x8 av = {lo[0], lo[1], lo[2], lo[3], hi_[0], hi_[1], hi_[2], hi_[3]};
                            o[db] = __builtin_amdgcn_mfma_f32_32x32x16_bf16(av, pb, o[db], 0, 0, 0);
                        }
                    }
            }
        }
        l_run += __shfl_xor(l_run, 32);
        asm volatile("s_waitcnt vmcnt(0) lgkmcnt(0)" ::: "memory"); __builtin_amdgcn_s_barrier(); asm volatile("" ::: "memory");
        LAS float* xs = (LAS float*)lds + (size_t)wq * 66 * 64 + lane;
        if (kvh == 1) {
            xs[0] = m_run; xs[64] = l_run;
#pragma unroll
            for (int db = 0; db < 4; ++db)
#pragma unroll
                for (int r = 0; r < 16; ++r) xs[(2 + 16 * db + r) * 64] = o[db][r];
        }
        asm volatile("s_waitcnt lgkmcnt(0)" ::: "memory"); __builtin_amdgcn_s_barrier(); asm volatile("" ::: "memory");
        if (kvh == 0) {
            const float m2 = xs[0], l2 = xs[64], mt = fmaxf(m_run, m2), a1 = __builtin_amdgcn_exp2f(m_run - mt), a2 = __builtin_amdgcn_exp2f(m2 - mt);
            const float inv = 1.0f / (l_run * a1 + l2 * a2), c1 = a1 * inv, c2 = a2 * inv;
            bf16* orow = AO + rowq * 1024 + h * 128 + 4 * hh;
#pragma unroll
            for (int db = 0; db < 4; ++db)
#pragma unroll
                for (int g = 0; g < 4; ++g) {
                    float t[4];
#pragma unroll
                    for (int e = 0; e < 4; ++e) t[e] = o[db][4 * g + e] * c1 + xs[(2 + 16 * db + 4 * g + e) * 64] * c2;
                    u32x2v w; w.x = pg8::cvt_pk_bf16(t[0], t[1]); w.y = pg8::cvt_pk_bf16(t[2], t[3]);
                    *(GAS u32x2v*)(orow + 32 * db + 8 * g) = w;
                }
        }
    }
    asm volatile("s_waitcnt vmcnt(0) lgkmcnt(0)" ::: "memory"); __builtin_amdgcn_s_barrier(); asm volatile("" ::: "memory");
}
__device__ __forceinline__ void up8(const v4u w, float (&f)[8]) { f[0] = bflo(w.x); f[1] = bfhi(w.x); f[2] = bflo(w.y); f[3] = bfhi(w.y); f[4] = bflo(w.z); f[5] = bfhi(w.z); f[6] = bflo(w.w); f[7] = bfhi(w.w); }
__device__ __forceinline__ void conv_phase(const Ctx& F, const bf16* CB, const bf16* CC, const bf16* CX, const float* cw, bf16* UC) {
    const int gt = (F.vcu * NWAVES + F.wave) * 64 + F.lane, NT = F.G * NWAVES * 64;
    for (int idx = gt; idx < M * 128; idx += NT) {
        const int row = idx >> 7, c8 = (idx & 127) << 3, t = row & (SEQ - 1); const size_t off = (size_t)row * 1024 + c8;
        float cb[8], a[8], x[8], z0[8], z1[8], z2[8];
        up8(*(const GAS v4u*)(CB + off), cb); up8(*(const GAS v4u*)(CC + off), a); up8(*(const GAS v4u*)(CX + off), x);
#pragma unroll
        for (int j = 0; j < 8; ++j) z0[j] = a[j] * x[j];
        if (t >= 1) { up8(*(const GAS v4u*)(CC + off - 1024), a); up8(*(const GAS v4u*)(CX + off - 1024), x);
#pragma unroll
            for (int j = 0; j < 8; ++j) z1[j] = a[j] * x[j]; } else {
#pragma unroll
            for (int j = 0; j < 8; ++j) z1[j] = 0.f; }
        if (t >= 2) { up8(*(const GAS v4u*)(CC + off - 2048), a); up8(*(const GAS v4u*)(CX + off - 2048), x);
#pragma unroll
            for (int j = 0; j < 8; ++j) z2[j] = a[j] * x[j]; } else {
#pragma unroll
            for (int j = 0; j < 8; ++j) z2[j] = 0.f; }
        float o[8];
#pragma unroll
        for (int j = 0; j < 8; ++j) o[j] = cb[j] * (cw[c8 + j] * z2[j] + cw[1024 + c8 + j] * z1[j] + cw[2048 + c8 + j] * z0[j]);
        v4u w; w.x = pk2(o[0], o[1]); w.y = pk2(o[2], o[3]); w.z = pk2(o[4], o[5]); w.w = pk2(o[6], o[7]); *(GAS v4u*)(UC + off) = w;
    }
}

__device__ __forceinline__ int imax(int a, int b) { return a > b ? a : b; }
__device__ __forceinline__ int imin(int a, int b) { return a < b ? a : b; }
__device__ __forceinline__ void ce(int& a, int& b) { const int t = imax(a, b); b = imin(a, b); a = t; }
__device__ __forceinline__ void sort16(int (&x)[16]) {
#pragma unroll
    for (int kk = 1; kk <= 4; ++kk)
#pragma unroll
        for (int jj = kk - 1; jj >= 0; --jj)
#pragma unroll
            for (int i = 0; i < 16; ++i) { const int k = 1 << kk, j = 1 << jj, l = i ^ j; if (l > i) { if ((i & k) == 0) ce(x[i], x[l]); else ce(x[l], x[i]); } }
}
__device__ __forceinline__ void bmerge16(int (&a)[16]) {
#pragma unroll
    for (int jj = 3; jj >= 0; --jj)
#pragma unroll
        for (int i = 0; i < 16; ++i) { const int j = 1 << jj, l = i ^ j; if (l > i) ce(a[i], a[l]); }
}
__device__ __forceinline__ void merge16(int (&a)[16], const int (&b)[16]) {
#pragma unroll
    for (int i = 0; i < 16; ++i) a[i] = imax(a[i], b[15 - i]);
    bmerge16(a);
}
__device__ __forceinline__ void xmerge16(int (&a)[16], int hh) {
    int pv[16];
#pragma unroll
    for (int i = 0; i < 16; ++i) { const auto r = __builtin_amdgcn_permlane32_swap((unsigned)a[15 - i], (unsigned)a[15 - i], false, false); pv[i] = hh ? (int)r[0] : (int)r[1]; }
#pragma unroll
    for (int i = 0; i < 16; ++i) a[i] = imax(a[i], pv[i]);
    bmerge16(a);
}
__device__ __forceinline__ int ord_key(float f) { const int u = __float_as_int(f); return u >= 0 ? u : (u ^ 0x7fffffff); }
__device__ __forceinline__ float ord_val(int k) { return __int_as_float(k >= 0 ? k : (k ^ 0x7fffffff)); }
__device__ __forceinline__ unsigned byte16(const unsigned (&t)[4], int idx) {
    const unsigned sel = 0x0c0c0c00u | (unsigned)(idx & 7);
    const unsigned lo = __builtin_amdgcn_perm(t[1], t[0], sel), hi_ = __builtin_amdgcn_perm(t[3], t[2], sel);
    return (idx & 8) ? hi_ : lo;
}
__device__ __forceinline__ void topk_stage_keys(const Ctx& F, const bf16* KEYS, int h) {
    for (int pc = F.wave; pc < 64; pc += 8) { const int pp = pc >> 5, row = 4 * (pc & 31) + (F.lane >> 4), cp = F.lane & 15, c = cp ^ (row & 15);
        __builtin_amdgcn_global_load_lds((const unsigned*)(KEYS + (size_t)((h * 2 + pp) * 128 + row) * 128 + 8 * c), (LAS unsigned*)(F.lds + RING_OFF + pc * 1024), 16, 0, 0); }
    asm volatile("s_waitcnt vmcnt(0)" ::: "memory"); __builtin_amdgcn_s_barrier(); asm volatile("" ::: "memory");
}
__device__ __forceinline__ void topk_phase(const Ctx& F, int bitem, const bf16* QP, int* EXP, float* GATE) {
    const int lane = F.lane, l31 = lane & 31, hh = lane >> 5;
    const int IMIN = (int)0x80000000;
    const unsigned lds0 = (unsigned)(uintptr_t)(F.lds + RING_OFF);
    {
        const int h = bitem & 7, tt = (bitem >> 3) * 8 + F.wave, tok0 = tt * 32;
        int top[2][16];
#pragma unroll
        for (int p = 0; p < 2; ++p) {
            bf16x8 qa[8];
#pragma unroll
            for (int s = 0; s < 8; ++s) qa[s] = *(const GAS bf16x8*)(QP + (size_t)(tok0 + l31) * 2048 + h * 256 + p * 128 + 16 * s + 8 * hh);
            int x[2][16];
#pragma unroll
            for (int pq = 0; pq < 2; ++pq) {
                f32x16 sc[2];
#pragma unroll
                for (int nt = 0; nt < 2; ++nt)
#pragma unroll
                    for (int r = 0; r < 16; ++r) sc[nt][r] = 0.f;
#pragma unroll
                for (int s = 0; s < 8; ++s) {
#pragma unroll
                    for (int nt = 0; nt < 2; ++nt) { const int n = 64 * pq + 32 * nt + l31; const bf16x8 kb = *(const LAS bf16x8*)(uintptr_t)(lds0 + p * 32768 + n * 256 + (((2 * s + hh) ^ (n & 15)) << 4));
                        sc[nt] = __builtin_amdgcn_mfma_f32_32x32x16_bf16(kb, qa[s], sc[nt], 0, 0, 0); }
                }
                int y[16];
#pragma unroll
                for (int r = 0; r < 16; ++r) { x[pq][r] = (ord_key(sc[0][r]) & ~127) | ((127 - 64 * pq - (r & 3) - 8 * (r >> 2)) - 4 * hh); y[r] = (ord_key(sc[1][r]) & ~127) | ((127 - 64 * pq - 32 - (r & 3) - 8 * (r >> 2)) - 4 * hh); }
                sort16(x[pq]); sort16(y); merge16(x[pq], y);
                asm volatile("" ::: "memory");
            }
            merge16(x[0], x[1]);
            xmerge16(x[0], hh);
#pragma unroll
            for (int i = 0; i < 16; ++i) top[p][i] = x[0][i];
        }
        float fa[16], fb[16];
#pragma unroll
        for (int i = 0; i < 16; ++i) { const int A = hh ? top[1][i] : top[0][i], B = hh ? top[0][i] : top[1][i]; fa[i] = ord_val(A & ~127); fb[i] = ord_val(B & ~127); }
        int c0[16], c1[16];
#pragma unroll
        for (int q = 0; q < 32; ++q) {
            int key = IMIN;
            if (q < 27) { const int i = (q < 16) ? 0 : (q < 23) ? 1 : (q < 26) ? 2 : 3, j = (q < 16) ? q : (q < 23) ? q - 15 : (q < 26) ? q - 21 : 3; const float sv = fa[i] + fb[j]; const int low = hh ? (255 - (j * 16 + i)) : (255 - (i * 16 + j));
                key = (ord_key(sv) & ~255) | low; if (i == j && hh) key = IMIN; }
            if (q < 16) c0[q] = key; else c1[q - 16] = key;
        }
        sort16(c0); sort16(c1); merge16(c0, c1); xmerge16(c0, hh);
        unsigned na[4], nb[4];
#pragma unroll
        for (int d = 0; d < 4; ++d) { na[d] = 0u; nb[d] = 0u;
#pragma unroll
            for (int e = 0; e < 4; ++e) { na[d] |= (unsigned)(127 - (top[0][4 * d + e] & 127)) << (8 * e); nb[d] |= (unsigned)(127 - (top[1][4 * d + e] & 127)) << (8 * e); } }
        int ex[16]; float ev[16]; float es = 0.f; const float smax = ord_val(c0[0] & ~255);
#pragma unroll
        for (int q = 0; q < 16; ++q) { const int posn = 255 - (c0[q] & 255); const unsigned n1 = byte16(na, posn >> 4) & 255u, n2 = byte16(nb, posn & 15) & 255u;
            ex[q] = (int)(n1 * 128u + n2); ev[q] = __expf(ord_val(c0[q] & ~255) - smax); es += ev[q]; }
        const float ri = 1.0f / es; const size_t ob = (size_t)(tok0 + l31) * 128 + h * 16;
        if (hh == 0) {
#pragma unroll
            for (int d = 0; d < 4; ++d) { v4u w; w.x = (unsigned)ex[4 * d]; w.y = (unsigned)ex[4 * d + 1]; w.z = (unsigned)ex[4 * d + 2]; w.w = (unsigned)ex[4 * d + 3]; *(GAS v4u*)(EXP + ob + 4 * d) = w; }
        } else {
#pragma unroll
            for (int d = 0; d < 4; ++d) *(GAS f32x4*)(GATE + ob + 4 * d) = (f32x4){ev[4 * d] * ri, ev[4 * d + 1] * ri, ev[4 * d + 2] * ri, ev[4 * d + 3] * ri};
        }
    }
}

typedef float f32x2 __attribute__((ext_vector_type(2)));
constexpr float PEER_SU = 512.0f, PEER_SV = 32.0f;
template <int D> __device__ __forceinline__ void tr_step(float (&part)[64], int lane) {
    const bool up_ = (lane & D) != 0;
#pragma unroll
    for (int i = 0; i < D; ++i) { const float a = part[i], b = part[i + D]; const float send = up_ ? a : b, keep = up_ ? b : a; part[i] = keep + __shfl_xor(send, D); }
}
template <int CTRL> __device__ __forceinline__ int dpp_i(int v) { return __builtin_amdgcn_update_dpp(v, v, CTRL, 0xf, 0xf, false); }
template <int J> __device__ __forceinline__ int xor_lane(int v, int lane) {
    if constexpr (J == 1) return dpp_i<0xB1>(v);
    else if constexpr (J == 2) return dpp_i<0x4E>(v);
    else if constexpr (J == 16) { const auto r = __builtin_amdgcn_permlane16_swap((unsigned)v, (unsigned)v, false, false); return ((lane >> 4) & 1) ? (int)r[0] : (int)r[1]; }
    else if constexpr (J == 32) { const auto r = __builtin_amdgcn_permlane32_swap((unsigned)v, (unsigned)v, false, false); return (lane >> 5) ? (int)r[0] : (int)r[1]; }
    else return __shfl_xor(v, J);
}
template <int KK, int JJ> __device__ __forceinline__ void sort128_step(int& x0, int& x1, int lane) {
    constexpr int k = 1 << KK, j = 1 << JJ;
    if constexpr (j == 64) { const int lo = imin(x0, x1), hi_ = imax(x0, x1); x0 = lo; x1 = hi_; }
    else {
        const int y0 = xor_lane<j>(x0, lane), y1 = xor_lane<j>(x1, lane);
        const bool lower = (lane & j) == 0;
        const bool asc0 = (k >= 128) ? true : (k == 64) ? true : ((lane & k) == 0);
        const bool asc1 = (k >= 128) ? true : (k == 64) ? false : ((lane & k) == 0);
        x0 = (lower == asc0) ? imin(x0, y0) : imax(x0, y0);
        x1 = (lower == asc1) ? imin(x1, y1) : imax(x1, y1);
    }
}
template <int KK, int JJ> __device__ __forceinline__ void sort128_stage(int& x0, int& x1, int lane) { sort128_step<KK, JJ>(x0, x1, lane); if constexpr (JJ > 0) sort128_stage<KK, JJ - 1>(x0, x1, lane); }
__device__ __forceinline__ void sort128(int& x0, int& x1, int lane) {
    sort128_stage<1, 0>(x0, x1, lane); sort128_stage<2, 1>(x0, x1, lane); sort128_stage<3, 2>(x0, x1, lane); sort128_stage<4, 3>(x0, x1, lane);
    sort128_stage<5, 4>(x0, x1, lane); sort128_stage<6, 5>(x0, x1, lane); sort128_stage<7, 6>(x0, x1, lane);
}
__device__ __forceinline__ void peer_phase(const Ctx& F, const unsigned char* U8, const unsigned char* V8, const bf16* X1B, const int* EXP, const float* GATE, const unsigned long long* SS, const float* gfin, const float* X1, float* OUT) {
    const int gw = F.vcu * NWAVES + F.wave, NGW = F.G * NWAVES, lane = F.lane;
    constexpr int NPF = 8;
    for (int t = gw; t < M; t += NGW) {
        int k0 = (EXP[(size_t)t * 128 + lane] << 7) | lane, k1 = (EXP[(size_t)t * 128 + 64 + lane] << 7) | (64 + lane);
        const float gl0 = GATE[(size_t)t * 128 + lane], gl1 = GATE[(size_t)t * 128 + 64 + lane];
        sort128(k0, k1, lane);
        const int e01[2] = { k0 >> 7, k1 >> 7 };
        const float ga0 = __shfl(gl0, k0 & 63), gb0 = __shfl(gl1, k0 & 63), ga1 = __shfl(gl0, k1 & 63), gb1 = __shfl(gl1, k1 & 63);
        const float g01[2] = { (k0 & 64) ? gb0 : ga0, (k1 & 64) ? gb1 : ga1 };
        const float rinv2 = pg8::rinv_from_ss(SS[t]) * (1.0f / PEER_SU);
        f32x2 xv[16];
#pragma unroll
        for (int i = 0; i < 2; ++i)
#pragma unroll
            for (int hv = 0; hv < 2; ++hv) { const v4u w = *(const GAS v4u*)(X1B + (size_t)t * DM + i * 1024 + lane * 16 + 8 * hv);
                xv[8 * i + 4 * hv + 0] = (f32x2){bflo(w.x), bfhi(w.x)}; xv[8 * i + 4 * hv + 1] = (f32x2){bflo(w.y), bfhi(w.y)}; xv[8 * i + 4 * hv + 2] = (f32x2){bflo(w.z), bfhi(w.z)}; xv[8 * i + 4 * hv + 3] = (f32x2){bflo(w.w), bfhi(w.w)}; }
        float act[2];
#pragma unroll
        for (int hf = 0; hf < 2; ++hf) {
            const int ev = e01[hf];
            float part[64]; v4u ub[NPF][2];
#pragma unroll
            for (int k = 0; k < NPF; ++k) { const GAS v4u* up = (const GAS v4u*)(U8 + (size_t)__builtin_amdgcn_readlane(ev, k) * 2048) + lane; ub[k][0] = up[0]; ub[k][1] = up[64]; }
#pragma unroll
            for (int k = 0; k < 64; ++k) {
                f32x2 p0 = {0.f, 0.f}, p1 = {0.f, 0.f};
#pragma unroll
                for (int i = 0; i < 2; ++i) { const v4u w = ub[k % NPF][i];
                    p0 += __builtin_amdgcn_cvt_pk_f32_fp8((int)w.x, false) * xv[8 * i + 0]; p1 += __builtin_amdgcn_cvt_pk_f32_fp8((int)w.x, true) * xv[8 * i + 1];
                    p0 += __builtin_amdgcn_cvt_pk_f32_fp8((int)w.y, false) * xv[8 * i + 2]; p1 += __builtin_amdgcn_cvt_pk_f32_fp8((int)w.y, true) * xv[8 * i + 3];
                    p0 += __builtin_amdgcn_cvt_pk_f32_fp8((int)w.z, false) * xv[8 * i + 4]; p1 += __builtin_amdgcn_cvt_pk_f32_fp8((int)w.z, true) * xv[8 * i + 5];
                    p0 += __builtin_amdgcn_cvt_pk_f32_fp8((int)w.w, false) * xv[8 * i + 6]; p1 += __builtin_amdgcn_cvt_pk_f32_fp8((int)w.w, true) * xv[8 * i + 7]; }
                part[k] = (p0[0] + p0[1]) + (p1[0] + p1[1]);
                if (k + NPF < 64) { const GAS v4u* up = (const GAS v4u*)(U8 + (size_t)__builtin_amdgcn_readlane(ev, k + NPF) * 2048) + lane; ub[k % NPF][0] = up[0]; ub[k % NPF][1] = up[64]; }
            }
            tr_step<32>(part, lane); tr_step<16>(part, lane); tr_step<8>(part, lane); tr_step<4>(part, lane); tr_step<2>(part, lane); tr_step<1>(part, lane);
            act[hf] = gelu_tanh(part[0] * rinv2) * g01[hf] * (1.0f / PEER_SV);
        }
        f32x2 y[16];
#pragma unroll
        for (int j = 0; j < 16; ++j) y[j] = (f32x2){0.f, 0.f};
#pragma unroll
        for (int hf = 0; hf < 2; ++hf) {
            const int ev = e01[hf]; const float av = act[hf];
            v4u vb[NPF][2];
#pragma unroll
            for (int k = 0; k < NPF; ++k) { const GAS v4u* vp = (const GAS v4u*)(V8 + (size_t)__builtin_amdgcn_readlane(ev, k) * 2048) + lane; vb[k][0] = vp[0]; vb[k][1] = vp[64]; }
#pragma unroll
            for (int k = 0; k < 64; ++k) {
                const float s = rdlane(av, k); const f32x2 s2 = {s, s};
#pragma unroll
                for (int i = 0; i < 2; ++i) { const v4u w = vb[k % NPF][i];
                    y[8 * i + 0] += s2 * __builtin_amdgcn_cvt_pk_f32_fp8((int)w.x, false); y[8 * i + 1] += s2 * __builtin_amdgcn_cvt_pk_f32_fp8((int)w.x, true);
                    y[8 * i + 2] += s2 * __builtin_amdgcn_cvt_pk_f32_fp8((int)w.y, false); y[8 * i + 3] += s2 * __builtin_amdgcn_cvt_pk_f32_fp8((int)w.y, true);
                    y[8 * i + 4] += s2 * __builtin_amdgcn_cvt_pk_f32_fp8((int)w.z, false); y[8 * i + 5] += s2 * __builtin_amdgcn_cvt_pk_f32_fp8((int)w.z, true);
                    y[8 * i + 6] += s2 * __builtin_amdgcn_cvt_pk_f32_fp8((int)w.w, false); y[8 * i + 7] += s2 * __builtin_amdgcn_cvt_pk_f32_fp8((int)w.w, true); }
                if (k + NPF < 64) { const GAS v4u* vp = (const GAS v4u*)(V8 + (size_t)__builtin_amdgcn_readlane(ev, k + NPF) * 2048) + lane; vb[k % NPF][0] = vp[0]; vb[k % NPF][1] = vp[64]; }
            }
        }
        const GAS f32x4* xr = (const GAS f32x4*)(X1 + (size_t)t * DM); GAS f32x4* orw = (GAS f32x4*)(OUT + (size_t)t * DM); float ss = 0.f;
#pragma unroll
        for (int i = 0; i < 2; ++i)
#pragma unroll
            for (int q = 0; q < 4; ++q) { const f32x4 a = xr[i * 256 + 4 * lane + q]; y[8 * i + 2 * q] += (f32x2){a[0], a[1]}; y[8 * i + 2 * q + 1] += (f32x2){a[2], a[3]}; }
#pragma unroll
        for (int j = 0; j < 16; ++j) ss += y[j][0] * y[j][0] + y[j][1] * y[j][1];
        const float r3 = 1.0f / sqrtf(wave_sum(ss) * (1.0f / DM) + RMS_EPS);
#pragma unroll
        for (int i = 0; i < 2; ++i)
#pragma unroll
            for (int q = 0; q < 4; ++q) { const f32x4 ga = *(const GAS f32x4*)(gfin + i * 1024 + lane * 16 + 4 * q);
                orw[i * 256 + 4 * lane + q] = (f32x4){y[8 * i + 2 * q][0] * r3 * ga[0], y[8 * i + 2 * q][1] * r3 * ga[1], y[8 * i + 2 * q + 1][0] * r3 * ga[2], y[8 * i + 2 * q + 1][1] * r3 * ga[3]}; }
    }
}

struct Args { const float* in[15]; float* out; unsigned char* ws; double invf[16]; int ph_lo, ph_hi, li, pad; };
__global__ void __launch_bounds__(NWAVES * 64, 2) mk_fwd(Args args) {
    extern __shared__ __attribute__((aligned(16))) unsigned char lds[];
    Ctx F;
    F.lds = (LAS unsigned char*)lds;
    volatile LAS unsigned* MISC = (volatile LAS unsigned*)(F.lds + MISC_OFF);
    F.tid = threadIdx.x; F.lane = F.tid & 63; F.wave = __builtin_amdgcn_readfirstlane(F.tid >> 6);
    F.G = gridDim.x; { const int bx = blockIdx.x; F.vcu = (F.G % 8 == 0) ? (bx % 8) * (F.G / 8) + bx / 8 : bx; }
    unsigned char* ws = args.ws;
    gu32* ctl = (gu32*)(ws + WS_CTL);
    for (int u = F.tid; u < (LDS_BYTES - LDSCTL_OFF) / 4; u += NWAVES * 64) ((LAS unsigned*)(F.lds + LDSCTL_OFF))[u] = 0u;
    __syncthreads();
    XcdBarrier bar; bar.bar = (unsigned*)(ctl + CW_BAR); bar.x = 0; bar.st = nullptr;
    if (N_LAUNCHES != PER_PHASE) bar = xcd_barrier_post((unsigned*)(ctl + CW_BAR), MISC + 8);
#define GRID_BAR() do { if (N_LAUNCHES != PER_PHASE) xcd_barrier(bar); } while (0)
    const int lo = args.ph_lo, hi = args.ph_hi;
#define IN(k) (lo <= (k) && (k) < hi)
#define BOTH(k) (IN(k) && IN((k) + 1))
    bf16* WinT = (bf16*)(ws + WS_WIN); bf16* WbcT = (bf16*)(ws + WS_WBC); bf16* WbaT = (bf16*)(ws + WS_WBA); bf16* WoutT = (bf16*)(ws + WS_WOUT); bf16* WpqT = (bf16*)(ws + WS_WPQ);
    bf16* KEYS = (bf16*)(ws + WS_KEYS); float* CS = (float*)(ws + WS_CS); const unsigned char* UB = ws + WS_UB; const unsigned char* VB = ws + WS_VB;
    bf16* XB = (bf16*)(ws + WS_XB); bf16* T6 = (bf16*)(ws + WS_T6); bf16* GAB = (bf16*)(ws + WS_GAB); bf16* UC = (bf16*)(ws + WS_UC); bf16* AO = (bf16*)(ws + WS_AO);
    bf16* TMP = (bf16*)(ws + WS_TMP); bf16* MB = (bf16*)(ws + WS_MB); bf16* X1B = (bf16*)(ws + WS_X1B); bf16* QP = (bf16*)(ws + WS_QP);
    int* EXP = (int*)(ws + WS_EXP); float* GATE = (float*)(ws + WS_GATE);
    unsigned long long* SS = (unsigned long long*)(ws + WS_SS); float* KSUM = (float*)(ws + WS_KSUM);
    constexpr size_t TS = (size_t)M * 1024;

    if (IN(0)) { for (int rep = 0; rep < NREP(0); ++rep) { p0_prologue(F, args.in, ws, args.invf); if (rep + 1 < NREP(0)) GRID_BAR(); } if (BOTH(0)) GRID_BAR(); }
    if (IN(1)) {
        for (int rep = 0; rep < NREP(1); ++rep) {
        pg8::Gemm g{XB, WinT, M, INW, DM}; pg8::StaticOrder S; S.init(M, INW, F.G, (int)blockIdx.x);
        pg8::EpiIn E{T6, GAB, args.in[4], CS, KSUM};
        pg8::gemm_phase<pg8::EpiIn, pg8::StaticOrder, true, true>(F.lds + RING_OFF, g, S, E);
        if (rep + 1 < NREP(1)) GRID_BAR(); }
        if (BOTH(1)) GRID_BAR();
    }
    if (IN(2)) {
        for (int rep = 0; rep < NREP(2); ++rep) {
        attn_mfma(F, T6 + 3 * TS, T6 + 4 * TS, T6 + 5 * TS, KSUM, AO);
        conv_phase(F, T6, T6 + TS, T6 + 2 * TS, args.in[5], UC);
        if (rep + 1 < NREP(2)) GRID_BAR(); }
        if (BOTH(2)) GRID_BAR();
    }
    if (IN(3)) {
        for (int rep = 0; rep < NREP(3); ++rep) {
        pg8::Gemm g{UC, WbcT, M, DM, 1024}; pg8::StaticOrder S; S.init(M, DM, F.G, (int)blockIdx.x);
        pg8::EpiTmp E{GAB, TMP};
        pg8::gemm_phase<pg8::EpiTmp, pg8::StaticOrder, true, true>(F.lds + RING_OFF, g, S, E);
        if (rep + 1 < NREP(3)) GRID_BAR(); }
        if (BOTH(3)) GRID_BAR();
    }
    if (IN(4)) {
        for (int rep = 0; rep < NREP(4); ++rep) {
        pg8::Gemm g{AO, WbaT, M, DM, 1024}; pg8::StaticOrder S; S.init(M, DM, F.G, (int)blockIdx.x);
        pg8::EpiMerge E{GAB + (size_t)M * DM, TMP, MB};
        pg8::gemm_phase<pg8::EpiMerge, pg8::StaticOrder, true, true>(F.lds + RING_OFF, g, S, E);
        if (rep + 1 < NREP(4)) GRID_BAR(); }
        if (BOTH(4)) GRID_BAR();
    }
    if (IN(5)) {
        for (int rep = 0; rep < NREP(5); ++rep) {
        pg8::Gemm g{MB, WoutT, M, DM, DM}; pg8::StaticOrder S; S.init(M, DM, F.G, (int)blockIdx.x);
        pg8::EpiX1 E{args.in[0], args.out, X1B, (rep + 1 < NREP(5)) ? (unsigned long long*)(ws + 768 * 1024) : SS};
        pg8::gemm_phase<pg8::EpiX1, pg8::StaticOrder, true, true>(F.lds + RING_OFF, g, S, E);
        if (rep + 1 < NREP(5)) GRID_BAR(); }
        if (BOTH(5)) GRID_BAR();
    }
    if (IN(6)) {
        for (int rep = 0; rep < NREP(6); ++rep) {
        pg8::Gemm g{X1B, WpqT, M, DM, DM}; pg8::StaticOrder S; S.init(M, DM, F.G, (int)blockIdx.x);
        pg8::EpiQP E{SS, QP};
        pg8::gemm_phase<pg8::EpiQP, pg8::StaticOrder, true, true>(F.lds + RING_OFF, g, S, E);
        if (rep + 1 < NREP(6)) GRID_BAR(); }
        if (BOTH(6)) GRID_BAR();
    }
    if (IN(7)) { for (int rep = 0; rep < NREP(7); ++rep) {
        for (int bitem = F.vcu; bitem < 256; bitem += F.G) {
            topk_stage_keys(F, KEYS, bitem & 7);
            if (F.wave >= 4 && bitem == F.vcu) convert_tables(F, args.in[12], args.in[13], args.in[9], ws);
            topk_phase(F, bitem, QP, EXP, GATE);
            if (F.wave < 4 && bitem == F.vcu) convert_tables(F, args.in[12], args.in[13], args.in[9], ws);
            asm volatile("s_waitcnt lgkmcnt(0)" ::: "memory"); __builtin_amdgcn_s_barrier(); asm volatile("" ::: "memory");
        }
        if (rep + 1 < NREP(7)) GRID_BAR(); } if (BOTH(7)) GRID_BAR(); }
    if (IN(8)) { for (int rep = 0; rep < NREP(8); ++rep) { peer_phase(F, UB, VB, X1B, EXP, GATE, SS, args.in[14], args.out, (rep + 1 < NREP(8)) ? (float*)(ws + WS_END) : args.out); if (rep + 1 < NREP(8)) GRID_BAR(); } }
#undef IN
#undef BOTH
#undef GRID_BAR
}

extern "C" void kernel_launch(void* const* d_in, const int* in_sizes, int n_in, void* d_out, int out_size, void* d_ws, size_t ws_size, hipStream_t stream) {
    static int grid = 0;
    if (grid == 0) {
        if (n_in != 15 || in_sizes[0] != M * DM || out_size != M * DM || ws_size < WS_END) { fprintf(stderr, "kernel_launch: unexpected shapes (n_in %d, in0 %d, out %d, ws %zu)\n", n_in, n_in > 0 ? in_sizes[0] : -1, out_size, ws_size); grid = -1; return; }
        int dev = 0, cus = 0, per_cu = 0;
        if (hipGetDevice(&dev) != hipSuccess || hipDeviceGetAttribute(&cus, hipDeviceAttributeMultiprocessorCount, dev) != hipSuccess) { grid = -1; return; }
        if (hipFuncSetAttribute((const void*)mk_fwd, hipFuncAttributeMaxDynamicSharedMemorySize, LDS_BYTES) != hipSuccess) { fprintf(stderr, "kernel_launch: hipFuncSetAttribute failed\n"); grid = -1; return; }
        if (hipOccupancyMaxActiveBlocksPerMultiprocessor(&per_cu, (const void*)mk_fwd, NWAVES * 64, LDS_BYTES) != hipSuccess || per_cu < 1) fprintf(stderr, "kernel_launch: occupancy query reports %d\n", per_cu);
        (void)hipGetLastError();
        grid = cus;
    }
    if (grid < 0) return;
    if (hipMemsetAsync((char*)d_ws + WS_CTL, 0, CTL_ZERO_BYTES, stream) != hipSuccess) { fprintf(stderr, "kernel_launch: memset failed\n"); return; }
    Args a{};
    for (int i = 0; i < 15; ++i) a.in[i] = (const float*)d_in[i];
    a.out = (float*)d_out; a.ws = (unsigned char*)d_ws;
    for (int f = 0; f < 16; ++f) a.invf[f] = pow(500000.0, -(double)(2 * f) / 32.0);
    for (int li = 0; li < N_LAUNCHES; ++li) {
        a.ph_lo = (N_LAUNCHES == PER_PHASE) ? li : 0; a.ph_hi = (N_LAUNCHES == PER_PHASE) ? li + 1 : PER_PHASE; a.li = li;
        hipLaunchKernelGGL(mk_fwd, dim3(grid), dim3(NWAVES * 64), LDS_BYTES, stream, a);
        const hipError_t le = hipPeekAtLastError();
        if (le != hipSuccess) { fprintf(stderr, "kernel_launch: launch %d failed: %s\n", li, hipGetErrorName(le)); break; }
    }
}
```

```cpp
#include <hip/hip_runtime.h>
#include <cstdio>
#include <cstdint>
#include <cmath>
namespace pg8 {
#define PG8_LAS __attribute__((address_space(3)))
typedef unsigned short bf16_t;
typedef short bf16x8 __attribute__((ext_vector_type(8)));
typedef float f32x4 __attribute__((ext_vector_type(4)));
typedef unsigned u32x4 __attribute__((ext_vector_type(4)));
constexpr int BM = 256, BK = 64, HALF = 128, HTB = HALF * BK * 2  , STAGE_BYTES = 8 * HTB, NXCD = 8, WGM = 8;

__host__ __device__ __forceinline__ int lds_byte(int r, int c) { const int st = (r >> 4) * 2 + (c >> 5), rr = r & 15, cc = c & 31, ob = rr * 64 + cc * 2; return st * 1024 + (ob ^ (((ob >> 9) & 1) << 5)); }
__host__ __device__ __forceinline__ void stage_rc(int b, int& R, int& C) { const int st = b / 1024, sb = b % 1024, swz = sb ^ (((sb >> 9) & 1) << 5); R = (st >> 1) * 16 + swz / 64; C = (st & 1) * 32 + (swz % 64) / 2; }
__host__ __device__ __forceinline__ int perm32(int rho) { const int n = rho >> 4, i = rho & 15; return 8 * (i >> 2) + 4 * n + (i & 3); }

struct Unit { int pm, pn, seg; };
struct Gemm { const bf16_t* A; const bf16_t* Bt; int M, N, K; const bf16_t* A2; const bf16_t* Bt2; };

struct StaticOrder {
    int nM, nN, nwg, G, c;
    __host__ __device__ void init(int M, int N, int G_, int c_) { nM = M / BM; nN = N / BM; nwg = nM * nN; G = G_; c = c_; }
    __host__ __device__ bool next(int i, Unit& u) const {
        const long L = (long)i * G + c; if (L >= nwg) return false;
        int wgid = (int)L; { const int q = nwg / NXCD, r = nwg % NXCD, xcd = wgid % NXCD, off = wgid / NXCD; wgid = (xcd < r ? xcd * (q + 1) : r * (q + 1) + (xcd - r) * q) + off; }
        const int nig = WGM * nN, gid = wgid / nig, fm = gid * WGM, gsz = (nM - fm) < WGM ? (nM - fm) : WGM;
        u.pm = fm + ((wgid % nig) % gsz); u.pn = (wgid % nig) / gsz; u.seg = 0; return true;
    }
    __device__ __forceinline__ void a_ready(const Unit&) const {}
    __device__ __forceinline__ void done(const Unit&) const {}
};
struct TwoSegOrder {
    StaticOrder so;
    __host__ __device__ void init(int M, int N, int G_, int c_) { so.init(M, N, G_, c_); }
    __host__ __device__ bool next(int i, Unit& u) const { if (!so.next(i >> 1, u)) return false; u.seg = i & 1; return true; }
    __device__ __forceinline__ void a_ready(const Unit&) const {}
    __device__ __forceinline__ void done(const Unit&) const {}
};


typedef float f32x2c __attribute__((ext_vector_type(2))); typedef __bf16 bf16x2c __attribute__((ext_vector_type(2)));
__device__ __forceinline__ unsigned cvt_pk_bf16(float lo, float hi) { const f32x2c v = {lo, hi}; const bf16x2c b = __builtin_convertvector(v, bf16x2c); return __builtin_bit_cast(unsigned, b); }
__device__ __forceinline__ u32x4 pack8(f32x4 a, f32x4 b) { u32x4 w; w.x = cvt_pk_bf16(a[0], a[1]); w.y = cvt_pk_bf16(a[2], a[3]); w.z = cvt_pk_bf16(b[0], b[1]); w.w = cvt_pk_bf16(b[2], b[3]); return w; }
__device__ __forceinline__ f32x4 shx(f32x4 v, int o) { f32x4 r; r[0] = __shfl_xor(v[0], o); r[1] = __shfl_xor(v[1], o); r[2] = __shfl_xor(v[2], o); r[3] = __shfl_xor(v[3], o); return r; }
__device__ __forceinline__ f32x4 bf4lo(unsigned a, unsigned b) { f32x4 r; r[0] = __uint_as_float(a << 16); r[1] = __uint_as_float(a & 0xffff0000u); r[2] = __uint_as_float(b << 16); r[3] = __uint_as_float(b & 0xffff0000u); return r; }
__device__ __forceinline__ f32x4 sigm4(f32x4 v) { f32x4 r;
#pragma unroll
    for (int i = 0; i < 4; ++i) r[i] = __builtin_amdgcn_rcpf(1.0f + __expf(-v[i])); return r; }
constexpr float QSCALE = 0.08838834764831845f * 1.4426950408889634f;

struct EpiIn {
    static constexpr bool PERM = true, AFTER_DRAIN = false, KEEP_SEG0 = false;
    bf16_t* T6; bf16_t* GAB; const float* gbias; const float* cs; float* ksum;
    __device__ __forceinline__ void operator()(const f32x4 (&acc)[2][2][4][2], const Unit& u, int wr, int wc, int fr, int fq) const {
        const int row0 = u.pm * BM + wr * 64 + fr, pn = u.pn, colw = wc * 32 + 8 * fq;
        if (pn < 24) {
            const int t = pn >> 2;
            bf16_t* base = T6 + (size_t)t * ((size_t)8192 * 1024) + (pn & 3) * 256 + colw;
            const bool rot = (t == 3 || t == 4) && (wc == 0), isk = (t == 4);
            const float qs = (t == 3) ? QSCALE : 1.0f;
            f32x4 ks[2][2];
#pragma unroll
            for (int bj = 0; bj < 2; ++bj) { ks[bj][0] = (f32x4){0.f, 0.f, 0.f, 0.f}; ks[bj][1] = (f32x4){0.f, 0.f, 0.f, 0.f}; }
#pragma unroll
            for (int ai = 0; ai < 2; ++ai)
#pragma unroll
                for (int m = 0; m < 4; ++m) {
                    const int row = row0 + ai * HALF + m * 16;
                    f32x4 c0 = (f32x4){1.f, 1.f, 1.f, 1.f}, c1 = c0, s0 = (f32x4){0.f, 0.f, 0.f, 0.f}, s1 = s0;
                    if (rot) { const float* cp = cs + (size_t)row * 32 + 8 * (fq & 1); c0 = *(const f32x4*)cp; c1 = *(const f32x4*)(cp + 4); s0 = *(const f32x4*)(cp + 16); s1 = *(const f32x4*)(cp + 20);
                        if (fq < 2) { s0 = -s0; s1 = -s1; } }
#pragma unroll
                    for (int bj = 0; bj < 2; ++bj) {
                        f32x4 v0 = acc[ai][bj][m][0], v1 = acc[ai][bj][m][1];
                        if (rot) { const f32x4 p0 = shx(v0, 32), p1 = shx(v1, 32); v0 = v0 * c0 + p0 * s0; v1 = v1 * c1 + p1 * s1; }
                        if (isk) { ks[bj][0] += v0; ks[bj][1] += v1; }
                        v0 = v0 * qs; v1 = v1 * qs;
                        *(u32x4*)(base + (size_t)row * 1024 + bj * HALF) = pack8(v0, v1);
                    }
                }
            if (isk) {
#pragma unroll
                for (int bj = 0; bj < 2; ++bj)
#pragma unroll
                    for (int n = 0; n < 2; ++n) { f32x4 v = ks[bj][n]; v += shx(v, 1); v += shx(v, 2); v += shx(v, 4); v += shx(v, 8);
                        if (fr == 0) { float* kp = ksum + (size_t)u.pm * 1024 + (pn & 3) * 256 + bj * HALF + colw + 4 * n;
                            unsafeAtomicAdd(kp + 0, v[0]); unsafeAtomicAdd(kp + 1, v[1]); unsafeAtomicAdd(kp + 2, v[2]); unsafeAtomicAdd(kp + 3, v[3]); } }
            }
        } else {
            const int t = (pn - 24) >> 3, colg = ((pn - 24) & 7) * 256 + colw;
            bf16_t* base = GAB + (size_t)t * ((size_t)8192 * 2048) + colg;
            const float* bp = gbias + t * 2048 + colg;
            f32x4 bv[2][2];
#pragma unroll
            for (int bj = 0; bj < 2; ++bj) { bv[bj][0] = *(const f32x4*)(bp + bj * HALF); bv[bj][1] = *(const f32x4*)(bp + bj * HALF + 4); }
#pragma unroll
            for (int ai = 0; ai < 2; ++ai)
#pragma unroll
                for (int m = 0; m < 4; ++m) { const int row = row0 + ai * HALF + m * 16;
#pragma unroll
                    for (int bj = 0; bj < 2; ++bj) *(u32x4*)(base + (size_t)row * 2048 + bj * HALF) = pack8(sigm4(acc[ai][bj][m][0] + bv[bj][0]), sigm4(acc[ai][bj][m][1] + bv[bj][1])); }
        }
    }
};
struct EpiMerge2 {
    static constexpr bool PERM = true, AFTER_DRAIN = false, KEEP_SEG0 = true;
    const bf16_t* GA; const bf16_t* GB; bf16_t* O;
    __device__ __forceinline__ void operator()(f32x4 (&acc)[2][2][4][2], const Unit& u, int wr, int wc, int fr, int fq) const {
        const int row0 = u.pm * BM + wr * 64 + fr, col0 = u.pn * BM + wc * 32 + 8 * fq;
        if (u.seg == 0) {
#pragma unroll
            for (int ai = 0; ai < 2; ++ai)
#pragma unroll
                for (int m = 0; m < 4; ++m) { const size_t off = (size_t)(row0 + ai * HALF + m * 16) * 2048 + col0;
#pragma unroll
                    for (int bj = 0; bj < 2; ++bj) { const u32x4 a = *(const u32x4*)(GA + off + bj * HALF), b = *(const u32x4*)(GB + off + bj * HALF);
                        const f32x4 b0 = bf4lo(b.x, b.y), b1 = bf4lo(b.z, b.w); f32x4 r0, r1;
#pragma unroll
                        for (int e = 0; e < 4; ++e) { r0[e] = __builtin_amdgcn_rcpf(fmaxf(b0[e], 1e-20f)); r1[e] = __builtin_amdgcn_rcpf(fmaxf(b1[e], 1e-20f)); }
                        acc[ai][bj][m][0] = acc[ai][bj][m][0] * (bf4lo(a.x, a.y) * r0); acc[ai][bj][m][1] = acc[ai][bj][m][1] * (bf4lo(a.z, a.w) * r1); } }
        } else {
#pragma unroll
            for (int ai = 0; ai < 2; ++ai)
#pragma unroll
                for (int m = 0; m < 4; ++m) { const size_t off = (size_t)(row0 + ai * HALF + m * 16) * 2048 + col0;
#pragma unroll
                    for (int bj = 0; bj < 2; ++bj) { const u32x4 b = *(const u32x4*)(GB + off + bj * HALF);
                        f32x4 b0 = bf4lo(b.x, b.y), b1 = bf4lo(b.z, b.w);
#pragma unroll
                        for (int e = 0; e < 4; ++e) { b0[e] = fmaxf(b0[e], 1e-20f); b1[e] = fmaxf(b1[e], 1e-20f); }
                        *(u32x4*)(O + off + bj * HALF) = pack8(acc[ai][bj][m][0] * b0, acc[ai][bj][m][1] * b1); } }
        }
    }
};
struct EpiX1 {
    static constexpr bool PERM = true, AFTER_DRAIN = false, KEEP_SEG0 = false;
    const float* X; float* X1; bf16_t* X1B; unsigned long long* SS;
    __device__ __forceinline__ void operator()(const f32x4 (&acc)[2][2][4][2], const Unit& u, int wr, int wc, int fr, int fq) const {
        const int row0 = u.pm * BM + wr * 64 + fr, col0 = u.pn * BM + wc * 32 + 8 * fq;
#pragma unroll
        for (int ai = 0; ai < 2; ++ai)
#pragma unroll
            for (int m = 0; m < 4; ++m) { const int row = row0 + ai * HALF + m * 16; const size_t off = (size_t)row * 2048 + col0; float sq = 0.f;
#pragma unroll
                for (int bj = 0; bj < 2; ++bj) { const f32x4 v0 = acc[ai][bj][m][0] + *(const f32x4*)(X + off + bj * HALF), v1 = acc[ai][bj][m][1] + *(const f32x4*)(X + off + bj * HALF + 4);
                    *(f32x4*)(X1 + off + bj * HALF) = v0; *(f32x4*)(X1 + off + bj * HALF + 4) = v1; *(u32x4*)(X1B + off + bj * HALF) = pack8(v0, v1);
                    sq += (v0[0] * v0[0] + v0[1] * v0[1]) + (v0[2] * v0[2] + v0[3] * v0[3]) + (v1[0] * v1[0] + v1[1] * v1[1]) + (v1[2] * v1[2] + v1[3] * v1[3]); }
                sq += __shfl_xor(sq, 16); sq += __shfl_xor(sq, 32);
                if (fq == 0) atomicAdd(SS + row, (unsigned long long)(sq * 4294967296.0f)); }
    }
};
__device__ __forceinline__ float rinv_from_ss(unsigned long long s) { return 1.0f / sqrtf((float)((double)s * (1.0 / 4294967296.0) * (1.0 / 2048.0)) + 1e-6f); }
struct EpiQP {
    static constexpr bool PERM = true, AFTER_DRAIN = false, KEEP_SEG0 = false;
    const unsigned long long* SS; bf16_t* O;
    __device__ __forceinline__ void operator()(const f32x4 (&acc)[2][2][4][2], const Unit& u, int wr, int wc, int fr, int fq) const {
        const int row0 = u.pm * BM + wr * 64 + fr, col0 = u.pn * BM + wc * 32 + 8 * fq;
#pragma unroll
        for (int ai = 0; ai < 2; ++ai)
#pragma unroll
            for (int m = 0; m < 4; ++m) { const int row = row0 + ai * HALF + m * 16; const size_t off = (size_t)row * 2048 + col0; const float rv = rinv_from_ss(SS[row]);
#pragma unroll
                for (int bj = 0; bj < 2; ++bj) *(u32x4*)(O + off + bj * HALF) = pack8(acc[ai][bj][m][0] * rv, acc[ai][bj][m][1] * rv); }
    }
};

template <class Epi, class Sched, bool ALIGN_EPI = false, bool SP2 = false>
__device__ __forceinline__ void gemm_phase(PG8_LAS unsigned char* lds, const Gemm g, const Sched& S, const Epi& E) {
    const int tid = threadIdx.x, wid = __builtin_amdgcn_readfirstlane(tid >> 6), lane = tid & 63, wr = wid >> 2, wc = wid & 3, fr = lane & 15, fq = lane >> 4;
    const int K = g.K, nt = K / BK;
    unsigned voffA[2], voffB[2];
#pragma unroll
    for (int i = 0; i < 2; ++i) { int R, C; stage_rc(tid * 16 + i * 8192, R, C); const int Rb = Epi::PERM ? ((R & ~31) + perm32(R & 31)) : R;
        voffA[i] = (unsigned)(R * K + C) * 2u; voffB[i] = (unsigned)(Rb * K + C) * 2u; }
    const size_t kstep = (size_t)(BK * 2);
    const size_t hstep = (size_t)HALF * K * 2;
    const size_t tstep = 2 * hstep;
    const unsigned ldsw = (unsigned)wid * 1024u;
    const int aoff = lds_byte(wr * 64 + fr, fq * 8), boff = lds_byte(wc * 32 + fr, fq * 8);
#define PG8_SA(b, h) (((b) * 2 + (h)) * HTB)
#define PG8_SB(b, h) ((4 + (b) * 2 + (h)) * HTB)
#define PG8_STAGE(bufoff, gbase, voff) do { _Pragma("unroll") for (int _i = 0; _i < 2; ++_i) \
        __builtin_amdgcn_global_load_lds((const unsigned*)((const char*)(gbase) + (voff)[_i]), (PG8_LAS unsigned*)(lds + (bufoff) + ldsw + _i * 8192), 16, 0, 0); } while (0)
#define PG8_LDA(dst, b, h) do { _Pragma("unroll") for (int m = 0; m < 4; ++m) _Pragma("unroll") for (int k = 0; k < 2; ++k) dst[m][k] = *(const PG8_LAS bf16x8*)(lds + PG8_SA(b, h) + aoff + m * 2048 + k * 1024); } while (0)
#define PG8_LDB(dst, b, h) do { _Pragma("unroll") for (int n = 0; n < 2; ++n) _Pragma("unroll") for (int k = 0; k < 2; ++k) dst[n][k] = *(const PG8_LAS bf16x8*)(lds + PG8_SB(b, h) + boff + n * 2048 + k * 1024); } while (0)
#define PG8_MMA(ai, bj, At, Bt) do { __builtin_amdgcn_s_setprio(1); _Pragma("unroll") for (int m = 0; m < 4; ++m) _Pragma("unroll") for (int n = 0; n < 2; ++n) _Pragma("unroll") for (int k = 0; k < 2; ++k) \
        acc[ai][bj][m][n] = __builtin_amdgcn_mfma_f32_16x16x32_bf16(Bt[n][k], At[m][k], acc[ai][bj][m][n], 0, 0, 0); __builtin_amdgcn_s_setprio(0); } while (0)
#define PG8_WAIT_V(n) asm volatile("s_waitcnt vmcnt(" #n ")" ::: "memory")
#define PG8_WAIT_L(n) asm volatile("s_waitcnt lgkmcnt(" #n ")" ::: "memory")
#define PG8_BAR __builtin_amdgcn_s_barrier()
#define PG8_SCHED __builtin_amdgcn_sched_barrier(0)
    Unit cur, nxt; int ui = 0;
    if (!S.next(0, cur)) return;
    f32x4 acc[2][2][4][2];
#pragma unroll
    for (int a = 0; a < 2; ++a)
#pragma unroll
        for (int b = 0; b < 2; ++b)
#pragma unroll
            for (int m = 0; m < 4; ++m)
#pragma unroll
                for (int n = 0; n < 2; ++n) acc[a][b][m][n] = (f32x4){0.f, 0.f, 0.f, 0.f};
    bf16x8 At[4][2], B0[2][2], B1[2][2];
    const char* cA = (const char*)(cur.seg ? g.A2 : g.A) + (size_t)cur.pm * tstep; const char* cB = (const char*)(cur.seg ? g.Bt2 : g.Bt) + (size_t)cur.pn * tstep;
    S.a_ready(cur);
    if constexpr (SP2) {
        PG8_STAGE(PG8_SB(0, 0), cB, voffB); PG8_STAGE(PG8_SB(0, 1), cB + hstep, voffB); PG8_STAGE(PG8_SA(0, 0), cA, voffA); PG8_STAGE(PG8_SA(0, 1), cA + hstep, voffA);
        if (wr == 1) PG8_BAR;
        PG8_WAIT_V(2); PG8_BAR;
        PG8_STAGE(PG8_SB(1, 0), cB + kstep, voffB); PG8_STAGE(PG8_SA(1, 0), cA + kstep, voffA); PG8_STAGE(PG8_SB(1, 1), cB + hstep + kstep, voffB);
        PG8_WAIT_V(6); PG8_BAR;
    } else {
        PG8_STAGE(PG8_SB(0, 0), cB, voffB); PG8_STAGE(PG8_SA(0, 0), cA, voffA); PG8_STAGE(PG8_SB(0, 1), cB + hstep, voffB); PG8_STAGE(PG8_SA(0, 1), cA + hstep, voffA);
        if (wr == 1) PG8_BAR;
        PG8_WAIT_V(4); PG8_BAR;
        PG8_STAGE(PG8_SB(1, 0), cB + kstep, voffB); PG8_STAGE(PG8_SA(1, 0), cA + kstep, voffA); PG8_STAGE(PG8_SB(1, 1), cB + hstep + kstep, voffB);
        PG8_WAIT_V(6); PG8_BAR;
    }
    for (;;) {
        const bool has_next = S.next(ui + 1, nxt);
        const char* nA = has_next ? (const char*)(nxt.seg ? g.A2 : g.A) + (size_t)nxt.pm * tstep : cA; const char* nB = has_next ? (const char*)(nxt.seg ? g.Bt2 : g.Bt) + (size_t)nxt.pn * tstep : cB;
        for (int t = 0; t < nt; t += 2) {
            const bool last = (t == nt - 2);
            const char* a1 = cA + (size_t)(t + 1) * kstep;
            const char* a2 = last ? nA : cA + (size_t)(t + 2) * kstep; const char* b2 = last ? nB : cB + (size_t)(t + 2) * kstep;
            const char* a3 = a2 + kstep; const char* b3 = b2 + kstep;
            if (last && has_next) S.a_ready(nxt);
            if constexpr (SP2) {
            PG8_LDB(B0, 0, 0); PG8_LDB(B1, 0, 1); PG8_SCHED; PG8_LDA(At, 0, 0); PG8_STAGE(PG8_SA(1, 1), a1 + hstep, voffA);
            PG8_WAIT_V(8); PG8_WAIT_L(0); PG8_BAR; PG8_MMA(0, 0, At, B0); PG8_MMA(0, 1, At, B1); PG8_BAR; PG8_SCHED;
            PG8_LDA(At, 0, 1); PG8_STAGE(PG8_SB(0, 0), b2, voffB); PG8_STAGE(PG8_SB(0, 1), b2 + hstep, voffB); PG8_STAGE(PG8_SA(0, 0), a2, voffA);
            PG8_WAIT_V(8); PG8_WAIT_L(0); PG8_BAR; PG8_MMA(1, 0, At, B0); PG8_MMA(1, 1, At, B1); PG8_BAR; PG8_SCHED;
            PG8_LDB(B0, 1, 0); PG8_LDB(B1, 1, 1); PG8_SCHED; PG8_LDA(At, 1, 0); PG8_STAGE(PG8_SA(0, 1), a2 + hstep, voffA);
            PG8_WAIT_V(8); PG8_WAIT_L(0); PG8_BAR; PG8_MMA(0, 0, At, B0); PG8_MMA(0, 1, At, B1); PG8_BAR; PG8_SCHED;
            PG8_LDA(At, 1, 1); PG8_STAGE(PG8_SB(1, 0), b3, voffB); PG8_STAGE(PG8_SB(1, 1), b3 + hstep, voffB); PG8_STAGE(PG8_SA(1, 0), a3, voffA);
            PG8_WAIT_V(8); PG8_WAIT_L(0); PG8_BAR; PG8_MMA(1, 0, At, B0); PG8_MMA(1, 1, At, B1); PG8_BAR; PG8_SCHED;
            } else {
            PG8_LDB(B0, 0, 0); PG8_SCHED; PG8_LDA(At, 0, 0); PG8_STAGE(PG8_SA(1, 1), a1 + hstep, voffA);
            PG8_WAIT_L(8); PG8_BAR; PG8_WAIT_L(0); PG8_MMA(0, 0, At, B0); PG8_BAR; PG8_SCHED;
            PG8_LDB(B1, 0, 1); PG8_STAGE(PG8_SB(0, 0), b2, voffB);
            PG8_BAR; PG8_WAIT_L(0); PG8_MMA(0, 1, At, B1); PG8_BAR;
            PG8_LDA(At, 0, 1); PG8_STAGE(PG8_SA(0, 0), a2, voffA);
            PG8_BAR; PG8_WAIT_L(0); PG8_MMA(1, 0, At, B0); PG8_BAR; PG8_SCHED;
            PG8_STAGE(PG8_SB(0, 1), b2 + hstep, voffB);
            PG8_WAIT_V(6); PG8_BAR; PG8_MMA(1, 1, At, B1); PG8_BAR;
            PG8_LDB(B0, 1, 0); PG8_SCHED; PG8_LDA(At, 1, 0); PG8_STAGE(PG8_SA(0, 1), a2 + hstep, voffA);
            PG8_WAIT_L(8); PG8_BAR; PG8_WAIT_L(0); PG8_MMA(0, 0, At, B0); PG8_BAR; PG8_SCHED;
            PG8_LDB(B1, 1, 1); PG8_STAGE(PG8_SB(1, 0), b3, voffB);
            PG8_BAR; PG8_WAIT_L(0); PG8_MMA(0, 1, At, B1); PG8_BAR;
            PG8_LDA(At, 1, 1); PG8_STAGE(PG8_SA(1, 0), a3, voffA);
            PG8_BAR; PG8_WAIT_L(0); PG8_MMA(1, 0, At, B0); PG8_BAR; PG8_SCHED;
            PG8_STAGE(PG8_SB(1, 1), b3 + hstep, voffB);
            PG8_WAIT_V(6); PG8_BAR; PG8_MMA(1, 1, At, B1); PG8_BAR;
            }
        }
        if constexpr (ALIGN_EPI) { if (wr == 0) PG8_BAR; }
        if constexpr (!Epi::AFTER_DRAIN) { E(acc, cur, wr, wc, fr, fq); S.done(cur); }
        if (!has_next) break;
        if (!(Epi::KEEP_SEG0 && cur.seg == 0)) {
#pragma unroll
        for (int a = 0; a < 2; ++a)
#pragma unroll
            for (int b = 0; b < 2; ++b)
#pragma unroll
                for (int m = 0; m < 4; ++m)
#pragma unroll
                    for (int n = 0; n < 2; ++n) acc[a][b][m][n] = (f32x4){0.f, 0.f, 0.f, 0.f};
        }
        cur = nxt; cA = nA; cB = nB; ++ui;
        if constexpr (ALIGN_EPI) { if (wr == 1) PG8_BAR; }
    }
    PG8_WAIT_V(0);
    if constexpr (!ALIGN_EPI) { if (wr == 0) PG8_BAR; }
    PG8_BAR;
    if constexpr (Epi::AFTER_DRAIN) { E.fused(acc, cur, wr, wc, fr, fq, lds, wid, lane); S.done(cur); }
#undef PG8_SA
#undef PG8_SB
#undef PG8_STAGE
#undef PG8_LDA
#undef PG8_LDB
#undef PG8_MMA
#undef PG8_WAIT_V
#undef PG8_WAIT_L
#undef PG8_BAR
#undef PG8_SCHED
}
}

constexpr int NWAVES = 8;
#ifndef MK_N_LAUNCHES
#define MK_N_LAUNCHES 1
#endif
constexpr int PER_PHASE = 9;
#ifndef MK_REP_PHASE
#define MK_REP_PHASE -1
#endif
#define NREP(k) (((k) == MK_REP_PHASE) ? 2 : 1)
constexpr int N_LAUNCHES = MK_N_LAUNCHES;
constexpr int M = 8192, SEQ = 4096, DM = 2048, INW = 10240, NEXP = 16384;
constexpr float RMS_EPS = 1e-6f;
constexpr size_t MiB = 1u << 20;
constexpr size_t WS_CTL = 0, CTL_ZERO_BYTES = 1 * MiB;
constexpr size_t WS_SS = 256 * 1024, WS_KSUM = 512 * 1024;
constexpr size_t WS_WIN = 2 * MiB, WS_WBC = 42 * MiB, WS_WBA = 46 * MiB, WS_WOUT = 50 * MiB, WS_WPQ = 58 * MiB, WS_KEYS = 66 * MiB, WS_CS = 67 * MiB;
constexpr size_t WS_UB = 70 * MiB, WS_VB = 102 * MiB;
constexpr size_t WS_XB = 198 * MiB;
constexpr size_t WS_T6 = 230 * MiB;
constexpr size_t WS_GAB = 326 * MiB;
constexpr size_t WS_UC = 390 * MiB, WS_AO = 406 * MiB;
constexpr size_t WS_EXP = 422 * MiB, WS_GATE = 426 * MiB;
constexpr size_t WS_END = 430 * MiB;
constexpr size_t WS_TMP = WS_XB, WS_MB = WS_T6, WS_X1B = WS_T6 + 48 * MiB, WS_QP = WS_GAB;
constexpr int CW_BAR = 4096;
constexpr int RING_OFF = 0, RING_BYTES = 131072;
constexpr int LDSCTL_OFF = RING_BYTES, MISC_OFF = LDSCTL_OFF + 320;
constexpr int LDS_BYTES = 147456;

#define GAS __attribute__((address_space(1)))
#define LAS __attribute__((address_space(3)))
typedef unsigned short bf16;
typedef unsigned v4u __attribute__((ext_vector_type(4)));
typedef float f32x4 __attribute__((ext_vector_type(4)));
typedef short bf16x8 __attribute__((ext_vector_type(8)));
typedef GAS unsigned gu32;
typedef GAS unsigned long long gu64;
#define RLX_AGENT __ATOMIC_RELAXED, __HIP_MEMORY_SCOPE_AGENT
#define LDS_WAIT() asm volatile("s_waitcnt lgkmcnt(0)" ::: "memory")
#define VM_WAIT() asm volatile("s_waitcnt vmcnt(0)" ::: "memory")
__device__ __forceinline__ unsigned long long rt() { return __builtin_amdgcn_s_memrealtime(); }
__device__ __forceinline__ unsigned f2bf(float f) { unsigned u = __builtin_bit_cast(unsigned, f); return (u + 0x7fffu + ((u >> 16) & 1u)) >> 16; }
__device__ __forceinline__ unsigned pk2(float lo, float hi) { return f2bf(lo) | (f2bf(hi) << 16); }

#define XB_TMO      128
#define XB_XCNT(j)  (256  + 64 * (j))
#define XB_XSUB(j)  (1280 + 64 * (j))
#define XB_XGEN(j)  (2304 + 64 * (j))
#define XB_TOP      3328
#define XB_TOPGEN   3392
#define XCD_BAR_WORDS 3456
#define XB_SPIN_CAP (1u << 18)

__device__ __forceinline__ unsigned xb_ld(unsigned* p)              { return __hip_atomic_load(p, __ATOMIC_RELAXED, __HIP_MEMORY_SCOPE_AGENT); }
__device__ __forceinline__ unsigned xb_add(unsigned* p, unsigned v) { return __hip_atomic_fetch_add(p, v, __ATOMIC_RELAXED, __HIP_MEMORY_SCOPE_AGENT); }
__device__ __forceinline__ unsigned xb_xcc_id() { return (unsigned)__builtin_amdgcn_s_getreg((3 << 11) | 20) & 0xFu; }
#define XB_SPIN(cond, bar) do { unsigned _sp = 0; while (cond) { __builtin_amdgcn_s_sleep(1); \
    if ((++_sp & 255u) == 0u) { if (xb_ld(&(bar)[XB_TMO])) break; if (_sp > XB_SPIN_CAP) { atomicAdd(&(bar)[XB_TMO], 1u); break; } } } } while (0)

struct XcdBarrier {
    unsigned* bar; unsigned x;
    volatile LAS unsigned* st;
};

__device__ __forceinline__ XcdBarrier xcd_barrier_post(unsigned* bar, volatile LAS unsigned* st) {
    XcdBarrier b; b.bar = bar; b.x = xb_xcc_id(); b.st = st;
    if (threadIdx.x == 0) (void)xb_add(&bar[XB_XCNT(b.x)], 1u);
    return b;
}
__device__ __forceinline__ void xcd_barrier_complete(unsigned* bar, unsigned x, unsigned& nloc, unsigned& nx) {
    const unsigned G = gridDim.x * gridDim.y * gridDim.z;
    unsigned sum, cnt, mine, sp = 0u;
    for (;;) {
        sum = 0u; cnt = 0u; mine = 0u;
#pragma unroll
        for (unsigned j = 0; j < 16; ++j) { const unsigned c = xb_ld(&bar[XB_XCNT(j)]); sum += c; cnt += (c > 0u) ? 1u : 0u; mine = (j == x) ? c : mine; }
        if (sum == G) break;
        __builtin_amdgcn_s_sleep(1);
        if ((++sp & 255u) == 0u) { if (xb_ld(&bar[XB_TMO])) break; if (sp > XB_SPIN_CAP) { atomicAdd(&bar[XB_TMO], 1u); break; } }
    }
    nloc = mine > 0u ? mine : 1u; nx = cnt > 0u ? cnt : 1u;
}

__device__ __forceinline__ void xcd_barrier(const XcdBarrier& b) {
    asm volatile("s_waitcnt vmcnt(0)" ::: "memory");
    __syncthreads();
    if (threadIdx.x == 0) {
        unsigned* bar = b.bar;
        __builtin_amdgcn_s_waitcnt(0);
        unsigned nloc = b.st[0], nx = b.st[1];
        if (nloc == 0u) { xcd_barrier_complete(bar, b.x, nloc, nx); b.st[0] = nloc; b.st[1] = nx; }
        const unsigned old = xb_add(&bar[XB_XSUB(b.x)], 1u);
        const unsigned gen = old / nloc;
        if (old + 1u == (gen + 1u) * nloc) {
            __builtin_amdgcn_fence(__ATOMIC_RELEASE, "agent");
            asm volatile("s_waitcnt vmcnt(0)" ::: "memory");
            const unsigned og = xb_add(&bar[XB_TOP], 1u);
            const unsigned tg = og / nx;
            if (og + 1u == (tg + 1u) * nx) xb_add(&bar[XB_TOPGEN], 1u);
            else XB_SPIN(xb_ld(&bar[XB_TOPGEN]) == tg, bar);
            __builtin_amdgcn_fence(__ATOMIC_ACQUIRE, "agent");
            xb_add(&bar[XB_XGEN(b.x)], 1u);
            asm volatile("s_waitcnt vmcnt(0)" ::: "memory");
        } else {
            XB_SPIN(xb_ld(&bar[XB_XGEN(b.x)]) == gen, bar);
            __builtin_amdgcn_fence(__ATOMIC_ACQUIRE, "agent");
            asm volatile("s_waitcnt vmcnt(0)" ::: "memory");
        }
    }
    __syncthreads();
}

typedef __bf16 bf16x2v __attribute__((ext_vector_type(2)));
typedef float f32x16 __attribute__((ext_vector_type(16)));
__device__ __forceinline__ float bflo(unsigned w) { return __uint_as_float(w << 16); }
__device__ __forceinline__ float bfhi(unsigned w) { return __uint_as_float(w & 0xffff0000u); }
__device__ __forceinline__ float dot2bf(unsigned a, unsigned b, float c) { return __builtin_amdgcn_fdot2_f32_bf16(__builtin_bit_cast(bf16x2v, a), __builtin_bit_cast(bf16x2v, b), c, false); }
__device__ __forceinline__ float wave_sum(float v) {
#pragma unroll
    for (int o = 1; o < 64; o <<= 1) v += __shfl_xor(v, o);
    return v; }
__device__ __forceinline__ float wave_max(float v) {
#pragma unroll
    for (int o = 1; o < 64; o <<= 1) v = fmaxf(v, __shfl_xor(v, o));
    return v; }
__device__ __forceinline__ float rdlane(float v, int l) { return __int_as_float(__builtin_amdgcn_readlane(__float_as_int(v), l)); }
__device__ __forceinline__ float gelu_tanh(float x) { const float z = 0.7978845608028654f * (x + 0.044715f * x * x * x); const float e = __expf(2.0f * z); const float th = 1.0f - 2.0f * __builtin_amdgcn_rcpf(1.0f + e); return 0.5f * x * (1.0f + th); }

struct Ctx { LAS unsigned char* lds; int tid, lane, wave, vcu, G; };

__device__ __forceinline__ void p0_transpose_item(const float* W, int K, int N, bf16* WT, const float* gk, LAS float* scr, int item, int lane) {
    const int nblk = N / 32, kb = item / nblk, nb = item % nblk, k0 = 64 * kb, n0 = 32 * nb;
#pragma unroll
    for (int i = 0; i < 8; ++i) { const int kk = 8 * i + (lane >> 3), nn = 4 * (lane & 7); f32x4 v = *(const GAS f32x4*)(W + (size_t)(k0 + kk) * N + n0 + nn); if (gk) v = v * gk[k0 + kk];
        scr[kk * 33 + nn] = v[0]; scr[kk * 33 + nn + 1] = v[1]; scr[kk * 33 + nn + 2] = v[2]; scr[kk * 33 + nn + 3] = v[3]; }
    LDS_WAIT(); asm volatile("" ::: "memory");
    const int c = lane & 7;
#pragma unroll
    for (int j = 0; j < 4; ++j) { const int n = (lane >> 3) + 8 * j; const LAS float* s = scr + (8 * c) * 33 + n;
        v4u o; o.x = pk2(s[0 * 33], s[1 * 33]); o.y = pk2(s[2 * 33], s[3 * 33]); o.z = pk2(s[4 * 33], s[5 * 33]); o.w = pk2(s[6 * 33], s[7 * 33]);
        *(GAS v4u*)(WT + (size_t)(n0 + n) * K + k0 + 8 * c) = o; }
    LDS_WAIT(); asm volatile("" ::: "memory");
}
__device__ __forceinline__ void convert_tables(const Ctx& F, const float* pu, const float* pv, const float* g2, unsigned char* ws) {
    const int gt = (F.vcu * NWAVES + F.wave) * 64 + F.lane, NT = F.G * NWAVES * 64;
    for (int i = gt; i < NEXP * 2048 / 16; i += NT) { const int c16 = (i & 127) * 16; v4u ou, ov;
#pragma unroll
        for (int q = 0; q < 4; ++q) { f32x4 a = ((const GAS f32x4*)pu)[4 * i + q]; a = a * *(const GAS f32x4*)(g2 + c16 + 4 * q) * 512.0f; const f32x4 b = ((const GAS f32x4*)pv)[4 * i + q] * 32.0f;
            int wu = 0, wv = 0; wu = __builtin_amdgcn_cvt_pk_fp8_f32(a[0], a[1], wu, false); wu = __builtin_amdgcn_cvt_pk_fp8_f32(a[2], a[3], wu, true);
            wv = __builtin_amdgcn_cvt_pk_fp8_f32(b[0], b[1], wv, false); wv = __builtin_amdgcn_cvt_pk_fp8_f32(b[2], b[3], wv, true); ou[q] = (unsigned)wu; ov[q] = (unsigned)wv; }
        ((GAS v4u*)(ws + WS_UB))[i] = ou; ((GAS v4u*)(ws + WS_VB))[i] = ov; }
}
__device__ __forceinline__ void p0_prologue(const Ctx& F, const float* const* in, unsigned char* ws, const double* invf) {
    const float* x = in[0]; const int* pos = (const int*)in[1]; const float* g1 = in[2]; const float* w_in = in[3];
    const float* w_bc = in[6]; const float* w_ba = in[7]; const float* w_out = in[8]; const float* g2 = in[9]; const float* w_pq = in[10];
    const float* keys = in[11]; const float* pu = in[12]; const float* pv = in[13];
    LAS float* scr = (LAS float*)(F.lds + RING_OFF + F.wave * 16384);
    const int gw = F.vcu * NWAVES + F.wave, NGW = F.G * NWAVES;
    const int gt = gw * 64 + F.lane, NT = NGW * 64;
    for (int i = gt; i < 8192; i += NT) ((GAS unsigned long long*)(ws + WS_SS))[i] = 0ull;
    for (int i = gt; i < 32 * 1024; i += NT) ((GAS float*)(ws + WS_KSUM))[i] = 0.f;
    constexpr int I_IN = 32 * 320, I_BC = 16 * 64, I_OUT = 32 * 64;
    constexpr int NITEMS = I_IN + 2 * I_BC + 2 * I_OUT;
    for (int it = gw; it < NITEMS; it += NGW) {
        int r = it;
        if (r < I_IN) { p0_transpose_item(w_in, 2048, INW, (bf16*)(ws + WS_WIN), g1, scr, r, F.lane); continue; } r -= I_IN;
        if (r < I_BC) { p0_transpose_item(w_bc, 1024, 2048, (bf16*)(ws + WS_WBC), nullptr, scr, r, F.lane); continue; } r -= I_BC;
        if (r < I_BC) { p0_transpose_item(w_ba, 1024, 2048, (bf16*)(ws + WS_WBA), nullptr, scr, r, F.lane); continue; } r -= I_BC;
        if (r < I_OUT) { p0_transpose_item(w_out, 2048, 2048, (bf16*)(ws + WS_WOUT), nullptr, scr, r, F.lane); continue; } r -= I_OUT;
        p0_transpose_item(w_pq, 2048, 2048, (bf16*)(ws + WS_WPQ), g2, scr, r, F.lane);
    }
    for (int i = gt; i < 16 * 128 * 128 / 8; i += NT) { const f32x4 a = ((const GAS f32x4*)keys)[2 * i], b = ((const GAS f32x4*)keys)[2 * i + 1];
        v4u o; o.x = pk2(a[0], a[1]); o.y = pk2(a[2], a[3]); o.z = pk2(b[0], b[1]); o.w = pk2(b[2], b[3]); ((GAS v4u*)(ws + WS_KEYS))[i] = o; }
    for (int m = gw; m < M; m += NGW) { const GAS f32x4* xr = (const GAS f32x4*)(x + (size_t)m * DM);
        f32x4 v[8]; float s = 0.f;
#pragma unroll
        for (int i = 0; i < 4; ++i) { v[2 * i] = xr[i * 128 + 2 * F.lane]; v[2 * i + 1] = xr[i * 128 + 2 * F.lane + 1]; }
#pragma unroll
        for (int i = 0; i < 8; ++i) s += (v[i][0] * v[i][0] + v[i][1] * v[i][1]) + (v[i][2] * v[i][2] + v[i][3] * v[i][3]);
        const float rinv = 1.0f / sqrtf(wave_sum(s) * (1.0f / DM) + RMS_EPS);
        GAS v4u* o = (GAS v4u*)(ws + WS_XB + (size_t)m * DM * 2);
#pragma unroll
        for (int i = 0; i < 4; ++i) { const f32x4 a = v[2 * i] * rinv, b = v[2 * i + 1] * rinv; v4u w; w.x = pk2(a[0], a[1]); w.y = pk2(a[2], a[3]); w.z = pk2(b[0], b[1]); w.w = pk2(b[2], b[3]); o[i * 64 + F.lane] = w; } }
    for (int i = gt; i < M * 16; i += NT) { const int row = i >> 4, f = i & 15; const double ang = (double)pos[row] * invf[f];
        const double k = __builtin_rint(ang * 0.15915494309189535); const float r = (float)(ang - k * 6.283185307179586);
        float* cs = (float*)(ws + WS_CS); cs[row * 32 + f] = __cosf(r); cs[row * 32 + 16 + f] = __sinf(r); }
}

__device__ __forceinline__ void attn_simple(const Ctx& F, const bf16* Q, const bf16* K, const bf16* V, const float* ksum, bf16* AO) {
    LAS float* qf = (LAS float*)(F.lds + RING_OFF + F.wave * 512);
    const int gw = F.vcu * NWAVES + F.wave, NGW = F.G * NWAVES, lane = F.lane;
    for (int item = gw; item < 16 * SEQ; item += NGW) {
        const int bh = item >> 12, t = item & 4095, b = bh >> 3, h = bh & 7, blk = t >> 8;
        const size_t row = (size_t)b * SEQ + t;
        { const unsigned qq = *(const GAS unsigned*)(Q + row * 1024 + h * 128 + 2 * lane); qf[2 * lane] = bflo(qq); qf[2 * lane + 1] = bfhi(qq); }
        LDS_WAIT(); asm volatile("" ::: "memory");
        float g = -INFINITY;
        if (lane < blk) { const GAS f32x4* km = (const GAS f32x4*)(ksum + (size_t)(b * 16 + lane) * 1024 + h * 128); float a = 0.f;
            for (int d = 0; d < 32; ++d) { const f32x4 kv = km[d]; const f32x4 qv = *(const LAS f32x4*)(qf + 4 * d); a += (kv[0] * qv[0] + kv[1] * qv[1]) + (kv[2] * qv[2] + kv[3] * qv[3]); }
            g = a; }
        int sel[3];
#pragma unroll
        for (int i = 0; i < 3; ++i) { const float mx = wave_max(g); const unsigned long long bal = __ballot(g == mx && lane < blk); const int idx = bal ? (__ffsll((long long)bal) - 1) : 0; sel[i] = idx; if (lane == idx) g = -INFINITY; }
        const int nsel = blk < 3 ? blk : 3;
        float sc[4][4]; float mx = -INFINITY;
#pragma unroll
        for (int slot = 0; slot < 4; ++slot) {
            const bool valid = (slot == 3) || (slot < nsel);
            const int kb = (slot == 3) ? blk : sel[slot < 3 ? slot : 0];
#pragma unroll
            for (int r = 0; r < 4; ++r) {
                float s = -INFINITY; const int key0 = kb * 256 + r * 64;
                if (valid && (slot < 3 || key0 <= t)) {
                    const int key = key0 + lane; const GAS v4u* kp = (const GAS v4u*)(K + ((size_t)b * SEQ + key) * 1024 + h * 128); float a = 0.f;
#pragma unroll 4
                    for (int d = 0; d < 16; ++d) { const v4u kk = kp[d]; const f32x4 q0 = *(const LAS f32x4*)(qf + 8 * d), q1 = *(const LAS f32x4*)(qf + 8 * d + 4);
                        a += (bflo(kk.x) * q0[0] + bfhi(kk.x) * q0[1]) + (bflo(kk.y) * q0[2] + bfhi(kk.y) * q0[3]) + (bflo(kk.z) * q1[0] + bfhi(kk.z) * q1[1]) + (bflo(kk.w) * q1[2] + bfhi(kk.w) * q1[3]); }
                    s = (slot < 3 || key <= t) ? a : -INFINITY; }
                sc[slot][r] = s; mx = fmaxf(mx, s); } }
        mx = wave_max(mx);
        float sum = 0.f;
#pragma unroll
        for (int slot = 0; slot < 4; ++slot)
#pragma unroll
            for (int r = 0; r < 4; ++r) { sc[slot][r] = exp2f(sc[slot][r] - mx); sum += sc[slot][r]; }
        sum = wave_sum(sum);
        float o0 = 0.f, o1 = 0.f;
#pragma unroll
        for (int slot = 0; slot < 4; ++slot) {
            const bool valid = (slot == 3) || (slot < nsel);
            const int kb = (slot == 3) ? blk : sel[slot < 3 ? slot : 0];
#pragma unroll
            for (int r = 0; r < 4; ++r) { const int key0 = kb * 256 + r * 64;
                if (valid && (slot < 3 || key0 <= t)) { const float pr = sc[slot][r]; const GAS unsigned* vp = (const GAS unsigned*)(V + ((size_t)b * SEQ + key0) * 1024 + h * 128) + lane;
                    for (int kk = 0; kk < 64; ++kk) { const float pk = rdlane(pr, kk); const unsigned vv = vp[(size_t)kk * 512]; o0 += pk * bflo(vv); o1 += pk * bfhi(vv); } } } }
        const float ri = 1.0f / sum;
        *(GAS unsigned*)(AO + row * 1024 + h * 128 + 2 * lane) = pk2(o0 * ri, o1 * ri);
    }
}
typedef short v4i16_t __attribute__((ext_vector_type(4))); typedef unsigned u32x2v __attribute__((ext_vector_type(2)));
__device__ __forceinline__ v4i16_t vtr16(unsigned addr) { return __builtin_amdgcn_ds_read_tr16_b64_v4i16((LAS v4i16_t*)(uintptr_t)addr); }
__device__ __forceinline__ int crow16(int r, int hh) { return (r & 3) + 8 * (r >> 2) + 4 * hh; }
__device__ __forceinline__ void attn_dma_step(const bf16* K, const bf16* V, LAS unsigned char* lds, int b, int h, int qb, int n_own, int st, int wave, int lane) {
    const int buf = st & 1;
#pragma unroll
    for (int img = 0; img < 4; ++img) {
        const int T = 2 * st + (img >> 1); const bool isV = img & 1;
        const int blk = (T < n_own) ? qb : ((T - n_own) >> 2), kt = (T < n_own) ? T : ((T - n_own) & 3);
        const bf16* base = (isV ? V : K) + ((size_t)b * SEQ + 256 * blk + 64 * kt) * 1024 + h * 128;
#pragma unroll
        for (int i = 0; i < 2; ++i) { const int pc = wave + 8 * i, row = 4 * pc + (lane >> 4), cp = lane & 15;
            const int c = isV ? ((((cp >> 2) ^ (row & 3)) << 2) | (cp & 3)) : (cp ^ (row & 15));
            __builtin_amdgcn_global_load_lds((const unsigned*)(base + (size_t)row * 1024 + 8 * c), (LAS unsigned*)(lds + buf * 65536 + img * 16384 + pc * 1024), 16, 0, 0); }
    }
}
__device__ __forceinline__ void attn_mfma(const Ctx& F, const bf16* Q, const bf16* K, const bf16* V, const float* ksum, bf16* AO) {
    const int lane = F.lane, wave = F.wave, q31 = lane & 31, hh = lane >> 5, wq = wave & 3, kvh = wave >> 2, l16 = lane & 15, G4 = lane >> 4;
    LAS unsigned char* lds = F.lds + RING_OFF;
    const unsigned lds0 = (unsigned)(uintptr_t)lds;
    for (int pr = F.vcu; pr < 256; pr += F.G)
#pragma unroll 1
    for (int pi = 0; pi < 2; ++pi) {
        const int bh = pr >> 4, s_ = pr & 15, u128 = pi ? 31 - s_ : s_, b = bh >> 3, h = bh & 7, qb = u128 >> 1, half = u128 & 1;
        const int n_own = half ? 4 : 2, nstep = (n_own + 4 * qb) >> 1;
        const size_t rowq = (size_t)b * SEQ + 256 * qb + 128 * half + 32 * wq + q31;
        asm volatile("s_waitcnt vmcnt(0) lgkmcnt(0)" ::: "memory"); __builtin_amdgcn_s_barrier(); asm volatile("" ::: "memory");
        attn_dma_step(K, V, lds, b, h, qb, n_own, 0, wave, lane);
        bf16x8 qf[8];
#pragma unroll
        for (int s = 0; s < 8; ++s) qf[s] = *(const GAS bf16x8*)(Q + rowq * 1024 + h * 128 + 16 * s + 8 * hh);
        unsigned selmask;
        {
            float qv[64];
#pragma unroll
            for (int s = 0; s < 8; ++s)
#pragma unroll
                for (int e = 0; e < 8; ++e) qv[8 * s + e] = __uint_as_float((unsigned)(unsigned short)qf[s][e] << 16);
            float v0 = -INFINITY, v1 = -INFINITY, v2 = -INFINITY; int i0 = 0, i1 = 0, i2 = 0;
#pragma unroll 1
            for (int j = 0; j < qb; ++j) {
                const GAS f32x4* kp = (const GAS f32x4*)(ksum + (size_t)(b * 16 + j) * 1024 + h * 128 + 8 * hh); float a = 0.f;
#pragma unroll
                for (int s = 0; s < 8; ++s) { const f32x4 k0 = kp[4 * s], k1 = kp[4 * s + 1];
                    a += (qv[8 * s] * k0[0] + qv[8 * s + 1] * k0[1]) + (qv[8 * s + 2] * k0[2] + qv[8 * s + 3] * k0[3]) + (qv[8 * s + 4] * k1[0] + qv[8 * s + 5] * k1[1]) + (qv[8 * s + 6] * k1[2] + qv[8 * s + 7] * k1[3]); }
                a += __shfl_xor(a, 32);
                if (a > v0) { v2 = v1; i2 = i1; v1 = v0; i1 = i0; v0 = a; i0 = j; } else if (a > v1) { v2 = v1; i2 = i1; v1 = a; i1 = j; } else if (a > v2) { v2 = a; i2 = j; }
            }
            selmask = (qb <= 3) ? ((1u << qb) - 1u) : ((1u << i0) | (1u << i1) | (1u << i2));
        }
        float m_run = -1e30f, l_run = 0.f; f32x16 o[4];
#pragma unroll
        for (int db = 0; db < 4; ++db)
#pragma unroll
            for (int r = 0; r < 16; ++r) o[db][r] = 0.f;
        const int qin = 128 * half + 32 * wq + q31;
#pragma unroll 1
        for (int st = 0; st < nstep; ++st) {
            asm volatile("s_waitcnt vmcnt(0)" ::: "memory"); __builtin_amdgcn_s_barrier(); asm volatile("" ::: "memory");
            if (st + 1 < nstep) attn_dma_step(K, V, lds, b, h, qb, n_own, st + 1, wave, lane);
            const int T = 2 * st + kvh; const bool own = T < n_own;
            const int blk = own ? qb : ((T - n_own) >> 2), kt = own ? T : ((T - n_own) & 3);
            const bool sel = own ? true : ((selmask >> blk) & 1u);
            const bool skip = own ? (64 * kt > 128 * half + 32 * wq + 31) : (__ballot(sel) == 0ull);
            if (!skip) {
                const unsigned kimg = lds0 + (st & 1) * 65536 + kvh * 32768, vimg = kimg + 16384;
                f32x16 p[2];
#pragma unroll
                for (int kh = 0; kh < 2; ++kh) {
#pragma unroll
                    for (int r = 0; r < 16; ++r) p[kh][r] = 0.f;
                    const int row = 32 * kh + q31;
#pragma unroll
                    for (int s = 0; s < 8; ++s) { const bf16x8 a = *(const LAS bf16x8*)(uintptr_t)(kimg + row * 256 + (((2 * s + hh) ^ (row & 15)) << 4));
                        p[kh] = __builtin_amdgcn_mfma_f32_32x32x16_bf16(a, qf[s], p[kh], 0, 0, 0); }
                }
                if (own) { const int kbase = 64 * kt;
                    if (kbase + 63 > 128 * half + 32 * wq) {
#pragma unroll
                        for (int kh = 0; kh < 2; ++kh)
#pragma unroll
                            for (int r = 0; r < 16; ++r) if (kbase + 32 * kh + crow16(r, hh) > qin) p[kh][r] = -INFINITY; }
                }
                float mx = p[0][0];
#pragma unroll
                for (int r = 1; r < 16; ++r) mx = fmaxf(mx, p[0][r]);
#pragma unroll
                for (int r = 0; r < 16; ++r) mx = fmaxf(mx, p[1][r]);
                { const auto rr = __builtin_amdgcn_permlane32_swap(__float_as_uint(mx), __float_as_uint(mx), false, false); mx = fmaxf(__uint_as_float(rr[0]), __uint_as_float(rr[1])); }
                if (!sel) mx = -INFINITY;
                const float m_new = fmaxf(m_run, mx), scl = __builtin_amdgcn_exp2f(m_run - m_new); m_run = m_new;
                float rs = 0.f;
#pragma unroll
                for (int kh = 0; kh < 2; ++kh)
#pragma unroll
                    for (int r = 0; r < 16; ++r) { p[kh][r] = __builtin_amdgcn_exp2f(p[kh][r] - m_new); rs += p[kh][r]; }
                l_run = l_run * scl + (sel ? rs : 0.f);
                if (__ballot(scl != 1.0f) != 0ull) {
#pragma unroll
                    for (int db = 0; db < 4; ++db)
#pragma unroll
                        for (int r = 0; r < 16; ++r) o[db][r] *= scl; }
                const unsigned pmask = sel ? 0xffffffffu : 0u;
#pragma unroll
                for (int kh = 0; kh < 2; ++kh)
#pragma unroll
                    for (int s2 = 0; s2 < 2; ++s2) {
                        v4u pw; pw.x = pg8::cvt_pk_bf16(p[kh][8 * s2], p[kh][8 * s2 + 1]); pw.y = pg8::cvt_pk_bf16(p[kh][8 * s2 + 2], p[kh][8 * s2 + 3]);
                        pw.z = pg8::cvt_pk_bf16(p[kh][8 * s2 + 4], p[kh][8 * s2 + 5]); pw.w = pg8::cvt_pk_bf16(p[kh][8 * s2 + 6], p[kh][8 * s2 + 7]);
                        pw.x &= pmask; pw.y &= pmask; pw.z &= pmask; pw.w &= pmask;
                        const bf16x8 pb = __builtin_bit_cast(bf16x8, pw);
                        const int key0 = 32 * kh + 16 * s2 + 4 * (G4 >> 1) + (l16 >> 2);
#pragma unroll
                        for (int db = 0; db < 4; ++db) {
                            const int dsub = 16 * (G4 & 1) + 4 * (l16 & 3);
                            const unsigned a0 = vimg + key0 * 256 + ((db ^ (key0 & 3)) << 6) + dsub * 2;
                            const v4i16_t lo = vtr16(a0), hi_ = vtr16(a0 + 8 * 256);
                            const bf16x8 av = {lo[0], lo[1], lo[2], lo[3], hi_[0], hi_[1], hi_[2], hi_[3]};
                            o[db] = __builtin_amdgcn_mfma_f32_32x32x16_bf16(av, pb, o[db], 0, 0, 0);
                        }
                    }
            }
        }
        l_run += __shfl_xor(l_run, 32);
        asm volatile("s_waitcnt vmcnt(0) lgkmcnt(0)" ::: "memory"); __builtin_amdgcn_s_barrier(); asm volatile("" ::: "memory");
        LAS float* xs = (LAS float*)lds + (size_t)wq * 66 * 64 + lane;
        if (kvh == 1) {
            xs[0] = m_run; xs[64] = l_run;
#pragma unroll
            for (int db = 0; db < 4; ++db)
#pragma unroll
                for (int r = 0; r < 16; ++r) xs[(2 + 16 * db + r) * 64] = o[db][r];
        }
        asm volatile("s_waitcnt lgkmcnt(0)" ::: "memory"); __builtin_amdgcn_s_barrier(); asm volatile("" ::: "memory");
        if (kvh == 0) {
            const float m2 = xs[0], l2 = xs[64], mt = fmaxf(m_run, m2), a1 = __builtin_amdgcn_exp2f(m_run - mt), a2 = __builtin_amdgcn_exp2f(m2 - mt);
            const float inv = 1.0f / (l_run * a1 + l2 * a2), c1 = a1 * inv, c2 = a2 * inv;
            bf16* orow = AO + rowq * 1024 + h * 128 + 4 * hh;
#pragma unroll
            for (int db = 0; db < 4; ++db)
#pragma unroll
                for (int g = 0; g < 4; ++g) {
                    float t[4];
#pragma unroll
                    for (int e = 0; e < 4; ++e) t[e] = o[db][4 * g + e] * c1 + xs[(2 + 16 * db + 4 * g + e) * 64] * c2;
                    u32x2v w; w.x = pg8::cvt_pk_bf16(t[0], t[1]); w.y = pg8::cvt_pk_bf16(t[2], t[3]);
                    *(GAS u32x2v*)(orow + 32 * db + 8 * g) = w;
                }
        }
    }
    asm volatile("s_waitcnt vmcnt(0) lgkmcnt(0)" ::: "memory"); __builtin_amdgcn_s_barrier(); asm volatile("" ::: "memory");
}
__device__ __forceinline__ void up8(const v4u w, float (&f)[8]) { f[0] = bflo(w.x); f[1] = bfhi(w.x); f[2] = bflo(w.y); f[3] = bfhi(w.y); f[4] = bflo(w.z); f[5] = bfhi(w.z); f[6] = bflo(w.w); f[7] = bfhi(w.w); }
__device__ __forceinline__ void conv_phase(const Ctx& F, const bf16* CB, const bf16* CC, const bf16* CX, const float* cw, bf16* UC) {
    const int gt = (F.vcu * NWAVES + F.wave) * 64 + F.lane, NT = F.G * NWAVES * 64;
    for (int idx = gt; idx < M * 128; idx += NT) {
        const int row = idx >> 7, c8 = (idx & 127) << 3, t = row & (SEQ - 1); const size_t off = (size_t)row * 1024 + c8;
        float cb[8], a[8], x[8], z0[8], z1[8], z2[8];
        up8(*(const GAS v4u*)(CB + off), cb); up8(*(const GAS v4u*)(CC + off), a); up8(*(const GAS v4u*)(CX + off), x);
#pragma unroll
        for (int j = 0; j < 8; ++j) z0[j] = a[j] * x[j];
        if (t >= 1) { up8(*(const GAS v4u*)(CC + off - 1024), a); up8(*(const GAS v4u*)(CX + off - 1024), x);
#pragma unroll
            for (int j = 0; j < 8; ++j) z1[j] = a[j] * x[j]; } else {
#pragma unroll
            for (int j = 0; j < 8; ++j) z1[j] = 0.f; }
        if (t >= 2) { up8(*(const GAS v4u*)(CC + off - 2048), a); up8(*(const GAS v4u*)(CX + off - 2048), x);
#pragma unroll
            for (int j = 0; j < 8; ++j) z2[j] = a[j] * x[j]; } else {
#pragma unroll
            for (int j = 0; j < 8; ++j) z2[j] = 0.f; }
        float o[8];
#pragma unroll
        for (int j = 0; j < 8; ++j) o[j] = cb[j] * (cw[c8 + j] * z2[j] + cw[1024 + c8 + j] * z1[j] + cw[2048 + c8 + j] * z0[j]);
        v4u w; w.x = pk2(o[0], o[1]); w.y = pk2(o[2], o[3]); w.z = pk2(o[4], o[5]); w.w = pk2(o[6], o[7]); *(GAS v4u*)(UC + off) = w;
    }
}

__device__ __forceinline__ int imax(int a, int b) { return a > b ? a : b; }
__device__ __forceinline__ int imin(int a, int b) { return a < b ? a : b; }
__device__ __forceinline__ void ce(int& a, int& b) { const int t = imax(a, b); b = imin(a, b); a = t; }
__device__ __forceinline__ void sort16(int (&x)[16]) {
#pragma unroll
    for (int kk = 1; kk <= 4; ++kk)
#pragma unroll
        for (int jj = kk - 1; jj >= 0; --jj)
#pragma unroll
            for (int i = 0; i < 16; ++i) { const int k = 1 << kk, j = 1 << jj, l = i ^ j; if (l > i) { if ((i & k) == 0) ce(x[i], x[l]); else ce(x[l], x[i]); } }
}
__device__ __forceinline__ void bmerge16(int (&a)[16]) {
#pragma unroll
    for (int jj = 3; jj >= 0; --jj)
#pragma unroll
        for (int i = 0; i < 16; ++i) { const int j = 1 << jj, l = i ^ j; if (l > i) ce(a[i], a[l]); }
}
__device__ __forceinline__ void merge16(int (&a)[16], const int (&b)[16]) {
#pragma unroll
    for (int i = 0; i < 16; ++i) a[i] = imax(a[i], b[15 - i]);
    bmerge16(a);
}
__device__ __forceinline__ void xmerge16(int (&a)[16], int hh) {
    int pv[16];
#pragma unroll
    for (int i = 0; i < 16; ++i) { const auto r = __builtin_amdgcn_permlane32_swap((unsigned)a[15 - i], (unsigned)a[15 - i], false, false); pv[i] = hh ? (int)r[0] : (int)r[1]; }
#pragma unroll
    for (int i = 0; i < 16; ++i) a[i] = imax(a[i], pv[i]);
    bmerge16(a);
}
__device__ __forceinline__ int ord_key(float f) { const int u = __float_as_int(f); return u >= 0 ? u : (u ^ 0x7fffffff); }
__device__ __forceinline__ float ord_val(int k) { return __int_as_float(k >= 0 ? k : (k ^ 0x7fffffff)); }
__device__ __forceinline__ unsigned byte16(const unsigned (&t)[4], int idx) {
    const unsigned sel = 0x0c0c0c00u | (unsigned)(idx & 7);
    const unsigned lo = __builtin_amdgcn_perm(t[1], t[0], sel), hi_ = __builtin_amdgcn_perm(t[3], t[2], sel);
    return (idx & 8) ? hi_ : lo;
}
__device__ __forceinline__ void topk_stage_keys(const Ctx& F, const bf16* KEYS, int h) {
    for (int pc = F.wave; pc < 64; pc += 8) { const int pp = pc >> 5, row = 4 * (pc & 31) + (F.lane >> 4), cp = F.lane & 15, c = cp ^ (row & 15);
        __builtin_amdgcn_global_load_lds((const unsigned*)(KEYS + (size_t)((h * 2 + pp) * 128 + row) * 128 + 8 * c), (LAS unsigned*)(F.lds + RING_OFF + pc * 1024), 16, 0, 0); }
    asm volatile("s_waitcnt vmcnt(0)" ::: "memory"); __builtin_amdgcn_s_barrier(); asm volatile("" ::: "memory");
}
__device__ __forceinline__ void topk_phase(const Ctx& F, int bitem, const bf16* QP, int* EXP, float* GATE) {
    const int lane = F.lane, l31 = lane & 31, hh = lane >> 5;
    const int IMIN = (int)0x80000000;
    const unsigned lds0 = (unsigned)(uintptr_t)(F.lds + RING_OFF);
    {
        const int h = bitem & 7, tt = (bitem >> 3) * 8 + F.wave, tok0 = tt * 32;
        int top[2][16];
#pragma unroll
        for (int p = 0; p < 2; ++p) {
            bf16x8 qa[8];
#pragma unroll
            for (int s = 0; s < 8; ++s) qa[s] = *(const GAS bf16x8*)(QP + (size_t)(tok0 + l31) * 2048 + h * 256 + p * 128 + 16 * s + 8 * hh);
            int x[2][16];
#pragma unroll
            for (int pq = 0; pq < 2; ++pq) {
                f32x16 sc[2];
#pragma unroll
                for (int nt = 0; nt < 2; ++nt)
#pragma unroll
                    for (int r = 0; r < 16; ++r) sc[nt][r] = 0.f;
#pragma unroll
                for (int s = 0; s < 8; ++s) {
#pragma unroll
                    for (int nt = 0; nt < 2; ++nt) { const int n = 64 * pq + 32 * nt + l31; const bf16x8 kb = *(const LAS bf16x8*)(uintptr_t)(lds0 + p * 32768 + n * 256 + (((2 * s + hh) ^ (n & 15)) << 4));
                        sc[nt] = __builtin_amdgcn_mfma_f32_32x32x16_bf16(kb, qa[s], sc[nt], 0, 0, 0); }
                }
                int y[16];
#pragma unroll
                for (int r = 0; r < 16; ++r) { x[pq][r] = (ord_key(sc[0][r]) & ~127) | ((127 - 64 * pq - (r & 3) - 8 * (r >> 2)) - 4 * hh); y[r] = (ord_key(sc[1][r]) & ~127) | ((127 - 64 * pq - 32 - (r & 3) - 8 * (r >> 2)) - 4 * hh); }
                sort16(x[pq]); sort16(y); merge16(x[pq], y);
                asm volatile("" ::: "memory");
            }
            merge16(x[0], x[1]);
            xmerge16(x[0], hh);
#pragma unroll
            for (int i = 0; i < 16; ++i) top[p][i] = x[0][i];
        }
        float fa[16], fb[16];
#pragma unroll
        for (int i = 0; i < 16; ++i) { const int A = hh ? top[1][i] : top[0][i], B = hh ? top[0][i] : top[1][i]; fa[i] = ord_val(A & ~127); fb[i] = ord_val(B & ~127); }
        int c0[16], c1[16];
#pragma unroll
        for (int q = 0; q < 32; ++q) {
            int key = IMIN;
            if (q < 27) { const int i = (q < 16) ? 0 : (q < 23) ? 1 : (q < 26) ? 2 : 3, j = (q < 16) ? q : (q < 23) ? q - 15 : (q < 26) ? q - 21 : 3; const float sv = fa[i] + fb[j]; const int low = hh ? (255 - (j * 16 + i)) : (255 - (i * 16 + j));
                key = (ord_key(sv) & ~255) | low; if (i == j && hh) key = IMIN; }
            if (q < 16) c0[q] = key; else c1[q - 16] = key;
        }
        sort16(c0); sort16(c1); merge16(c0, c1); xmerge16(c0, hh);
        unsigned na[4], nb[4];
#pragma unroll
        for (int d = 0; d < 4; ++d) { na[d] = 0u; nb[d] = 0u;
#pragma unroll
            for (int e = 0; e < 4; ++e) { na[d] |= (unsigned)(127 - (top[0][4 * d + e] & 127)) << (8 * e); nb[d] |= (unsigned)(127 - (top[1][4 * d + e] & 127)) << (8 * e); } }
        int ex[16]; float ev[16]; float es = 0.f; const float smax = ord_val(c0[0] & ~255);
#pragma unroll
        for (int q = 0; q < 16; ++q) { const int posn = 255 - (c0[q] & 255); const unsigned n1 = byte16(na, posn >> 4) & 255u, n2 = byte16(nb, posn & 15) & 255u;
            ex[q] = (int)(n1 * 128u + n2); ev[q] = __expf(ord_val(c0[q] & ~255) - smax); es += ev[q]; }
        const float ri = 1.0f / es; const size_t ob = (size_t)(tok0 + l31) * 128 + h * 16;
        if (hh == 0) {
#pragma unroll
            for (int d = 0; d < 4; ++d) { v4u w; w.x = (unsigned)ex[4 * d]; w.y = (unsigned)ex[4 * d + 1]; w.z = (unsigned)ex[4 * d + 2]; w.w = (unsigned)ex[4 * d + 3]; *(GAS v4u*)(EXP + ob + 4 * d) = w; }
        } else {
#pragma unroll
            for (int d = 0; d < 4; ++d) *(GAS f32x4*)(GATE + ob + 4 * d) = (f32x4){ev[4 * d] * ri, ev[4 * d + 1] * ri, ev[4 * d + 2] * ri, ev[4 * d + 3] * ri};
        }
    }
}

typedef float f32x2 __attribute__((ext_vector_type(2)));
constexpr float PEER_SU = 512.0f, PEER_SV = 32.0f;
template <int D> __device__ __forceinline__ void tr_step(float (&part)[64], int lane) {
    const bool up_ = (lane & D) != 0;
#pragma unroll
    for (int i = 0; i < D; ++i) { const float a = part[i], b = part[i + D]; const float send = up_ ? a : b, keep = up_ ? b : a; part[i] = keep + __shfl_xor(send, D); }
}
template <int CTRL> __device__ __forceinline__ int dpp_i(int v) { return __builtin_amdgcn_update_dpp(v, v, CTRL, 0xf, 0xf, false); }
template <int J> __device__ __forceinline__ int xor_lane(int v, int lane) {
    if constexpr (J == 1) return dpp_i<0xB1>(v);
    else if constexpr (J == 2) return dpp_i<0x4E>(v);
    else if constexpr (J == 16) { const auto r = __builtin_amdgcn_permlane16_swap((unsigned)v, (unsigned)v, false, false); return ((lane >> 4) & 1) ? (int)r[0] : (int)r[1]; }
    else if constexpr (J == 32) { const auto r = __builtin_amdgcn_permlane32_swap((unsigned)v, (unsigned)v, false, false); return (lane >> 5) ? (int)r[0] : (int)r[1]; }
    else return __shfl_xor(v, J);
}
template <int KK, int JJ> __device__ __forceinline__ void sort128_step(int& x0, int& x1, int lane) {
    constexpr int k = 1 << KK, j = 1 << JJ;
    if constexpr (j == 64) { const int lo = imin(x0, x1), hi_ = imax(x0, x1); x0 = lo; x1 = hi_; }
    else {
        const int y0 = xor_lane<j>(x0, lane), y1 = xor_lane<j>(x1, lane);
        const bool lower = (lane & j) == 0;
        const bool asc0 = (k >= 128) ? true : (k == 64) ? true : ((lane & k) == 0);
        const bool asc1 = (k >= 128) ? true : (k == 64) ? false : ((lane & k) == 0);
        x0 = (lower == asc0) ? imin(x0, y0) : imax(x0, y0);
        x1 = (lower == asc1) ? imin(x1, y1) : imax(x1, y1);
    }
}
template <int KK, int JJ> __device__ __forceinline__ void sort128_stage(int& x0, int& x1, int lane) { sort128_step<KK, JJ>(x0, x1, lane); if constexpr (JJ > 0) sort128_stage<KK, JJ - 1>(x0, x1, lane); }
__device__ __forceinline__ void sort128(int& x0, int& x1, int lane) {
    sort128_stage<1, 0>(x0, x1, lane); sort128_stage<2, 1>(x0, x1, lane); sort128_stage<3, 2>(x0, x1, lane); sort128_stage<4, 3>(x0, x1, lane);
    sort128_stage<5, 4>(x0, x1, lane); sort128_stage<6, 5>(x0, x1, lane); sort128_stage<7, 6>(x0, x1, lane);
}
__device__ __forceinline__ void peer_phase(const Ctx& F, const unsigned char* U8, const unsigned char* V8, const bf16* X1B, const int* EXP, const float* GATE, const unsigned long long* SS, const float* gfin, const float* X1, float* OUT) {
    const int gw = F.vcu * NWAVES + F.wave, NGW = F.G * NWAVES, lane = F.lane;
    constexpr int NPF = 8;
    for (int t = gw; t < M; t += NGW) {
        int k0 = (EXP[(size_t)t * 128 + lane] << 7) | lane, k1 = (EXP[(size_t)t * 128 + 64 + lane] << 7) | (64 + lane);
        const float gl0 = GATE[(size_t)t * 128 + lane], gl1 = GATE[(size_t)t * 128 + 64 + lane];
        sort128(k0, k1, lane);
        const int e01[2] = { k0 >> 7, k1 >> 7 };
        const float ga0 = __shfl(gl0, k0 & 63), gb0 = __shfl(gl1, k0 & 63), ga1 = __shfl(gl0, k1 & 63), gb1 = __shfl(gl1, k1 & 63);
        const float g01[2] = { (k0 & 64) ? gb0 : ga0, (k1 & 64) ? gb1 : ga1 };
        const float rinv2 = pg8::rinv_from_ss(SS[t]) * (1.0f / PEER_SU);
        f32x2 xv[16];
#pragma unroll
        for (int i = 0; i < 2; ++i)
#pragma unroll
            for (int hv = 0; hv < 2; ++hv) { const v4u w = *(const GAS v4u*)(X1B + (size_t)t * DM + i * 1024 + lane * 16 + 8 * hv);
                xv[8 * i + 4 * hv + 0] = (f32x2){bflo(w.x), bfhi(w.x)}; xv[8 * i + 4 * hv + 1] = (f32x2){bflo(w.y), bfhi(w.y)}; xv[8 * i + 4 * hv + 2] = (f32x2){bflo(w.z), bfhi(w.z)}; xv[8 * i + 4 * hv + 3] = (f32x2){bflo(w.w), bfhi(w.w)}; }
        float act[2];
#pragma unroll
        for (int hf = 0; hf < 2; ++hf) {
            const int ev = e01[hf];
            float part[64]; v4u ub[NPF][2];
#pragma unroll
            for (int k = 0; k < NPF; ++k) { const GAS v4u* up = (const GAS v4u*)(U8 + (size_t)__builtin_amdgcn_readlane(ev, k) * 2048) + lane; ub[k][0] = up[0]; ub[k][1] = up[64]; }
#pragma unroll
            for (int k = 0; k < 64; ++k) {
                f32x2 p0 = {0.f, 0.f}, p1 = {0.f, 0.f};
#pragma unroll
                for (int i = 0; i < 2; ++i) { const v4u w = ub[k % NPF][i];
                    p0 += __builtin_amdgcn_cvt_pk_f32_fp8((int)w.x, false) * xv[8 * i + 0]; p1 += __builtin_amdgcn_cvt_pk_f32_fp8((int)w.x, true) * xv[8 * i + 1];
                    p0 += __builtin_amdgcn_cvt_pk_f32_fp8((int)w.y, false) * xv[8 * i + 2]; p1 += __builtin_amdgcn_cvt_pk_f32_fp8((int)w.y, true) * xv[8 * i + 3];
                    p0 += __builtin_amdgcn_cvt_pk_f32_fp8((int)w.z, false) * xv[8 * i + 4]; p1 += __builtin_amdgcn_cvt_pk_f32_fp8((int)w.z, true) * xv[8 * i + 5];
                    p0 += __builtin_amdgcn_cvt_pk_f32_fp8((int)w.w, false) * xv[8 * i + 6]; p1 += __builtin_amdgcn_cvt_pk_f32_fp8((int)w.w, true) * xv[8 * i + 7]; }
                part[k] = (p0[0] + p0[1]) + (p1[0] + p1[1]);
                if (k + NPF < 64) { const GAS v4u* up = (const GAS v4u*)(U8 + (size_t)__builtin_amdgcn_readlane(ev, k + NPF) * 2048) + lane; ub[k % NPF][0] = up[0]; ub[k % NPF][1] = up[64]; }
            }
            tr_step<32>(part, lane); tr_step<16>(part, lane); tr_step<8>(part, lane); tr_step<4>(part, lane); tr_step<2>(part, lane); tr_step<1>(part, lane);
            act[hf] = gelu_tanh(part[0] * rinv2) * g01[hf] * (1.0f / PEER_SV);
        }
        f32x2 y[16];
#pragma unroll
        for (int j = 0; j < 16; ++j) y[j] = (f32x2){0.f, 0.f};
#pragma unroll
        for (int hf = 0; hf < 2; ++hf) {
            const int ev = e01[hf]; const float av = act[hf];
            v4u vb[NPF][2];
#pragma unroll
            for (int k = 0; k < NPF; ++k) { const GAS v4u* vp = (const GAS v4u*)(V8 + (size_t)__builtin_amdgcn_readlane(ev, k) * 2048) + lane; vb[k][0] = vp[0]; vb[k][1] = vp[64]; }
#pragma unroll
            for (int k = 0; k < 64; ++k) {
                const float s = rdlane(av, k); const f32x2 s2 = {s, s};
#pragma unroll
                for (int i = 0; i < 2; ++i) { const v4u w = vb[k % NPF][i];
                    y[8 * i + 0] += s2 * __builtin_amdgcn_cvt_pk_f32_fp8((int)w.x, false); y[8 * i + 1] += s2 * __builtin_amdgcn_cvt_pk_f32_fp8((int)w.x, true);
                    y[8 * i + 2] += s2 * __builtin_amdgcn_cvt_pk_f32_fp8((int)w.y, false); y[8 * i + 3] += s2 * __builtin_amdgcn_cvt_pk_f32_fp8((int)w.y, true);
                    y[8 * i + 4] += s2 * __builtin_amdgcn_cvt_pk_f32_fp8((int)w.z, false); y[8 * i + 5] += s2 * __builtin_amdgcn_cvt_pk_f32_fp8((int)w.z, true);
                    y[8 * i + 6] += s2 * __builtin_amdgcn_cvt_pk_f32_fp8((int)w.w, false); y[8 * i + 7] += s2 * __builtin_amdgcn_cvt_pk_f32_fp8((int)w.w, true); }
                if (k + NPF < 64) { const GAS v4u* vp = (const GAS v4u*)(V8 + (size_t)__builtin_amdgcn_readlane(ev, k + NPF) * 2048) + lane; vb[k % NPF][0] = vp[0]; vb[k % NPF][1] = vp[64]; }
            }
        }
        const GAS f32x4* xr = (const GAS f32x4*)(X1 + (size_t)t * DM); GAS f32x4* orw = (GAS f32x4*)(OUT + (size_t)t * DM); float ss = 0.f;
#pragma unroll
        for (int i = 0; i < 2; ++i)
#pragma unroll
            for (int q = 0; q < 4; ++q) { const f32x4 a = xr[i * 256 + 4 * lane + q]; y[8 * i + 2 * q] += (f32x2){a[0], a[1]}; y[8 * i + 2 * q + 1] += (f32x2){a[2], a[3]}; }
#pragma unroll
        for (int j = 0; j < 16; ++j) ss += y[j][0] * y[j][0] + y[j][1] * y[j][1];
        const float r3 = 1.0f / sqrtf(wave_sum(ss) * (1.0f / DM) + RMS_EPS);
#pragma unroll
        for (int i = 0; i < 2; ++i)
#pragma unroll
            for (int q = 0; q < 4; ++q) { const f32x4 ga = *(const GAS f32x4*)(gfin + i * 1024 + lane * 16 + 4 * q);
                orw[i * 256 + 4 * lane + q] = (f32x4){y[8 * i + 2 * q][0] * r3 * ga[0], y[8 * i + 2 * q][1] * r3 * ga[1], y[8 * i + 2 * q + 1][0] * r3 * ga[2], y[8 * i + 2 * q + 1][1] * r3 * ga[3]}; }
    }
}

struct Args { const float* in[15]; float* out; unsigned char* ws; double invf[16]; int ph_lo, ph_hi, li, pad; };
__global__ void __launch_bounds__(NWAVES * 64, 2) mk_fwd(Args args) {
    extern __shared__ __attribute__((aligned(16))) unsigned char lds[];
    Ctx F;
    F.lds = (LAS unsigned char*)lds;
    volatile LAS unsigned* MISC = (volatile LAS unsigned*)(F.lds + MISC_OFF);
    F.tid = threadIdx.x; F.lane = F.tid & 63; F.wave = __builtin_amdgcn_readfirstlane(F.tid >> 6);
    F.G = gridDim.x; { const int bx = blockIdx.x; F.vcu = (F.G % 8 == 0) ? (bx % 8) * (F.G / 8) + bx / 8 : bx; }
    unsigned char* ws = args.ws;
    gu32* ctl = (gu32*)(ws + WS_CTL);
    for (int u = F.tid; u < (LDS_BYTES - LDSCTL_OFF) / 4; u += NWAVES * 64) ((LAS unsigned*)(F.lds + LDSCTL_OFF))[u] = 0u;
    __syncthreads();
    XcdBarrier bar; bar.bar = (unsigned*)(ctl + CW_BAR); bar.x = 0; bar.st = nullptr;
    if (N_LAUNCHES != PER_PHASE) bar = xcd_barrier_post((unsigned*)(ctl + CW_BAR), MISC + 8);
#define GRID_BAR() do { if (N_LAUNCHES != PER_PHASE) xcd_barrier(bar); } while (0)
    const int lo = args.ph_lo, hi = args.ph_hi;
#define IN(k) (lo <= (k) && (k) < hi)
#define BOTH(k) (IN(k) && IN((k) + 1))
    bf16* WinT = (bf16*)(ws + WS_WIN); bf16* WbcT = (bf16*)(ws + WS_WBC); bf16* WbaT = (bf16*)(ws + WS_WBA); bf16* WoutT = (bf16*)(ws + WS_WOUT); bf16* WpqT = (bf16*)(ws + WS_WPQ);
    bf16* KEYS = (bf16*)(ws + WS_KEYS); float* CS = (float*)(ws + WS_CS); const unsigned char* UB = ws + WS_UB; const unsigned char* VB = ws + WS_VB;
    bf16* XB = (bf16*)(ws + WS_XB); bf16* T6 = (bf16*)(ws + WS_T6); bf16* GAB = (bf16*)(ws + WS_GAB); bf16* UC = (bf16*)(ws + WS_UC); bf16* AO = (bf16*)(ws + WS_AO);
    bf16* TMP = (bf16*)(ws + WS_TMP); bf16* MB = (bf16*)(ws + WS_MB); bf16* X1B = (bf16*)(ws + WS_X1B); bf16* QP = (bf16*)(ws + WS_QP);
    int* EXP = (int*)(ws + WS_EXP); float* GATE = (float*)(ws + WS_GATE);
    unsigned long long* SS = (unsigned long long*)(ws + WS_SS); float* KSUM = (float*)(ws + WS_KSUM);
    constexpr size_t TS = (size_t)M * 1024;

    if (IN(0)) { for (int rep = 0; rep < NREP(0); ++rep) { p0_prologue(F, args.in, ws, args.invf); if (rep + 1 < NREP(0)) GRID_BAR(); } if (BOTH(0)) GRID_BAR(); }
    if (IN(1)) {
        for (int rep = 0; rep < NREP(1); ++rep) {
        pg8::Gemm g{XB, WinT, M, INW, DM}; pg8::StaticOrder S; S.init(M, INW, F.G, (int)blockIdx.x);
        pg8::EpiIn E{T6, GAB, args.in[4], CS, KSUM};
        pg8::gemm_phase<pg8::EpiIn, pg8::StaticOrder, true, true>(F.lds + RING_OFF, g, S, E);
        if (rep + 1 < NREP(1)) GRID_BAR(); }
        if (BOTH(1)) GRID_BAR();
    }
    if (IN(2)) {
        for (int rep = 0; rep < NREP(2); ++rep) {
        attn_mfma(F, T6 + 3 * TS, T6 + 4 * TS, T6 + 5 * TS, KSUM, AO);
        conv_phase(F, T6, T6 + TS, T6 + 2 * TS, args.in[5], UC);
        if (rep + 1 < NREP(2)) GRID_BAR(); }
        if (BOTH(2)) GRID_BAR();
    }
    if (IN(3)) {
        for (int rep = 0; rep < NREP(3); ++rep) {
        pg8::Gemm g{UC, WbcT, M, DM, 1024, AO, WbaT}; pg8::TwoSegOrder S; S.init(M, DM, F.G, (int)blockIdx.x);
        pg8::EpiMerge2 E{GAB, GAB + (size_t)M * DM, MB};
        pg8::gemm_phase<pg8::EpiMerge2, pg8::TwoSegOrder, true, true>(F.lds + RING_OFF, g, S, E);
        if (rep + 1 < NREP(3)) GRID_BAR(); }
        if (BOTH(3)) GRID_BAR();
    }
    if (IN(5)) {
        for (int rep = 0; rep < NREP(5); ++rep) {
        pg8::Gemm g{MB, WoutT, M, DM, DM}; pg8::StaticOrder S; S.init(M, DM, F.G, (int)blockIdx.x);
        pg8::EpiX1 E{args.in[0], args.out, X1B, (rep + 1 < NREP(5)) ? (unsigned long long*)(ws + 768 * 1024) : SS};
        pg8::gemm_phase<pg8::EpiX1, pg8::StaticOrder, true, true>(F.lds + RING_OFF, g, S, E);
        if (rep + 1 < NREP(5)) GRID_BAR(); }
        if (BOTH(5)) GRID_BAR();
    }
    if (IN(6)) {
        for (int rep = 0; rep < NREP(6); ++rep) {
        pg8::Gemm g{X1B, WpqT, M, DM, DM}; pg8::StaticOrder S; S.init(M, DM, F.G, (int)blockIdx.x);
        pg8::EpiQP E{SS, QP};
        pg8::gemm_phase<pg8::EpiQP, pg8::StaticOrder, true, true>(F.lds + RING_OFF, g, S, E);
        if (rep + 1 < NREP(6)) GRID_BAR(); }
        if (BOTH(6)) GRID_BAR();
    }
    if (IN(7)) { for (int rep = 0; rep < NREP(7); ++rep) {
        for (int bitem = F.vcu; bitem < 256; bitem += F.G) {
            topk_stage_keys(F, KEYS, bitem & 7);
            if (F.wave >= 4 && bitem == F.vcu) convert_tables(F, args.in[12], args.in[13], args.in[9], ws);
            topk_phase(F, bitem, QP, EXP, GATE);
            if (F.wave < 4 && bitem == F.vcu) convert_tables(F, args.in[12], args.in[13], args.in[9], ws);
            asm volatile("s_waitcnt lgkmcnt(0)" ::: "memory"); __builtin_amdgcn_s_barrier(); asm volatile("" ::: "memory");
        }
        if (rep + 1 < NREP(7)) GRID_BAR(); } if (BOTH(7)) GRID_BAR(); }
    if (IN(8)) { for (int rep = 0; rep < NREP(8); ++rep) { peer_phase(F, UB, VB, X1B, EXP, GATE, SS, args.in[14], args.out, (rep + 1 < NREP(8)) ? (float*)(ws + WS_END) : args.out); if (rep + 1 < NREP(8)) GRID_BAR(); } }
#undef IN
#undef BOTH
#undef GRID_BAR
}

extern "C" void kernel_launch(void* const* d_in, const int* in_sizes, int n_in, void* d_out, int out_size, void* d_ws, size_t ws_size, hipStream_t stream) {
    static int grid = 0;
    if (grid == 0) {
        if (n_in != 15 || in_sizes[0] != M * DM || out_size != M * DM || ws_size < WS_END) { fprintf(stderr, "kernel_launch: unexpected shapes (n_in %d, in0 %d, out %d, ws %zu)\n", n_in, n_in > 0 ? in_sizes[0] : -1, out_size, ws_size); grid = -1; return; }
        int dev = 0, cus = 0, per_cu = 0;
        if (hipGetDevice(&dev) != hipSuccess || hipDeviceGetAttribute(&cus, hipDeviceAttributeMultiprocessorCount, dev) != hipSuccess) { grid = -1; return; }
        if (hipFuncSetAttribute((const void*)mk_fwd, hipFuncAttributeMaxDynamicSharedMemorySize, LDS_BYTES) != hipSuccess) { fprintf(stderr, "kernel_launch: hipFuncSetAttribute failed\n"); grid = -1; return; }
        if (hipOccupancyMaxActiveBlocksPerMultiprocessor(&per_cu, (const void*)mk_fwd, NWAVES * 64, LDS_BYTES) != hipSuccess || per_cu < 1) fprintf(stderr, "kernel_launch: occupancy query reports %d\n", per_cu);
        (void)hipGetLastError();
        grid = cus;
    }
    if (grid < 0) return;
    if (hipMemsetAsync((char*)d_ws + WS_CTL, 0, CTL_ZERO_BYTES, stream) != hipSuccess) { fprintf(stderr, "kernel_launch: memset failed\n"); return; }
    Args a{};
    for (int i = 0; i < 15; ++i) a.in[i] = (const float*)d_in[i];
    a.out = (float*)d_out; a.ws = (unsigned char*)d_ws;
    for (int f = 0; f < 16; ++f) a.invf[f] = pow(500000.0, -(double)(2 * f) / 32.0);
    for (int li = 0; li < N_LAUNCHES; ++li) {
        a.ph_lo = (N_LAUNCHES == PER_PHASE) ? li : 0; a.ph_hi = (N_LAUNCHES == PER_PHASE) ? li + 1 : PER_PHASE; a.li = li;
        hipLaunchKernelGGL(mk_fwd, dim3(grid), dim3(NWAVES * 64), LDS_BYTES, stream, a);
        const hipError_t le = hipPeekAtLastError();
        if (le != hipSuccess) { fprintf(stderr, "kernel_launch: launch %d failed: %s\n", li, hipGetErrorName(le)); break; }
    }
}
```

```cpp
#include <hip/hip_runtime.h>
#include <cstdio>
#include <cstdint>
#include <cmath>
namespace pg8 {
#define PG8_LAS __attribute__((address_space(3)))
typedef unsigned short bf16_t;
typedef short bf16x8 __attribute__((ext_vector_type(8)));
typedef float f32x4 __attribute__((ext_vector_type(4)));
typedef unsigned u32x4 __attribute__((ext_vector_type(4)));
constexpr int BM = 256, BK = 64, HALF = 128, HTB = HALF * BK * 2  , STAGE_BYTES = 8 * HTB, NXCD = 8, WGM = 8;

__host__ __device__ __forceinline__ int lds_byte(int r, int c) { const int st = (r >> 4) * 2 + (c >> 5), rr = r & 15, cc = c & 31, ob = rr * 64 + cc * 2; return st * 1024 + (ob ^ (((ob >> 9) & 1) << 5)); }
__host__ __device__ __forceinline__ void stage_rc(int b, int& R, int& C) { const int st = b / 1024, sb = b % 1024, swz = sb ^ (((sb >> 9) & 1) << 5); R = (st >> 1) * 16 + swz / 64; C = (st & 1) * 32 + (swz % 64) / 2; }
__host__ __device__ __forceinline__ int perm32(int rho) { const int n = rho >> 4, i = rho & 15; return 8 * (i >> 2) + 4 * n + (i & 3); }

struct Unit { int pm, pn, seg; };
struct Gemm { const bf16_t* A; const bf16_t* Bt; int M, N, K; const bf16_t* A2; const bf16_t* Bt2; };

struct StaticOrder {
    int nM, nN, nwg, G, c;
    __host__ __device__ void init(int M, int N, int G_, int c_) { nM = M / BM; nN = N / BM; nwg = nM * nN; G = G_; c = c_; }
    __host__ __device__ bool next(int i, Unit& u) const {
        const long L = (long)i * G + c; if (L >= nwg) return false;
        int wgid = (int)L; { const int q = nwg / NXCD, r = nwg % NXCD, xcd = wgid % NXCD, off = wgid / NXCD; wgid = (xcd < r ? xcd * (q + 1) : r * (q + 1) + (xcd - r) * q) + off; }
        const int nig = WGM * nN, gid = wgid / nig, fm = gid * WGM, gsz = (nM - fm) < WGM ? (nM - fm) : WGM;
        u.pm = fm + ((wgid % nig) % gsz); u.pn = (wgid % nig) / gsz; u.seg = 0; return true;
    }
    __device__ __forceinline__ void a_ready(const Unit&) const {}
    __device__ __forceinline__ void done(const Unit&) const {}
};
struct TwoSegOrder {
    StaticOrder so;
    __host__ __device__ void init(int M, int N, int G_, int c_) { so.init(M, N, G_, c_); }
    __host__ __device__ bool next(int i, Unit& u) const { if (!so.next(i >> 1, u)) return false; u.seg = i & 1; return true; }
    __device__ __forceinline__ void a_ready(const Unit&) const {}
    __device__ __forceinline__ void done(const Unit&) const {}
};


typedef float f32x2c __attribute__((ext_vector_type(2))); typedef __bf16 bf16x2c __attribute__((ext_vector_type(2)));
__device__ __forceinline__ unsigned cvt_pk_bf16(float lo, float hi) { const f32x2c v = {lo, hi}; const bf16x2c b = __builtin_convertvector(v, bf16x2c); return __builtin_bit_cast(unsigned, b); }
__device__ __forceinline__ u32x4 pack8(f32x4 a, f32x4 b) { u32x4 w; w.x = cvt_pk_bf16(a[0], a[1]); w.y = cvt_pk_bf16(a[2], a[3]); w.z = cvt_pk_bf16(b[0], b[1]); w.w = cvt_pk_bf16(b[2], b[3]); return w; }
__device__ __forceinline__ f32x4 shx(f32x4 v, int o) { f32x4 r; r[0] = __shfl_xor(v[0], o); r[1] = __shfl_xor(v[1], o); r[2] = __shfl_xor(v[2], o); r[3] = __shfl_xor(v[3], o); return r; }
__device__ __forceinline__ f32x4 bf4lo(unsigned a, unsigned b) { f32x4 r; r[0] = __uint_as_float(a << 16); r[1] = __uint_as_float(a & 0xffff0000u); r[2] = __uint_as_float(b << 16); r[3] = __uint_as_float(b & 0xffff0000u); return r; }
__device__ __forceinline__ f32x4 sigm4(f32x4 v) { f32x4 r;
#pragma unroll
    for (int i = 0; i < 4; ++i) r[i] = __builtin_amdgcn_rcpf(1.0f + __expf(-v[i])); return r; }
constexpr float QSCALE = 0.08838834764831845f * 1.4426950408889634f;

struct EpiIn {
    static constexpr bool PERM = true, AFTER_DRAIN = false, KEEP_SEG0 = false;
    bf16_t* T6; bf16_t* GAB; const float* gbias; const float* cs; float* ksum;
    __device__ __forceinline__ void operator()(const f32x4 (&acc)[2][2][4][2], const Unit& u, int wr, int wc, int fr, int fq) const {
        const int row0 = u.pm * BM + wr * 64 + fr, pn = u.pn, colw = wc * 32 + 8 * fq;
        if (pn < 24) {
            const int t = pn >> 2;
            bf16_t* base = T6 + (size_t)t * ((size_t)8192 * 1024) + (pn & 3) * 256 + colw;
            const bool rot = (t == 3 || t == 4) && (wc == 0), isk = (t == 4);
            const float qs = (t == 3) ? QSCALE : 1.0f;
            f32x4 ks[2][2];
#pragma unroll
            for (int bj = 0; bj < 2; ++bj) { ks[bj][0] = (f32x4){0.f, 0.f, 0.f, 0.f}; ks[bj][1] = (f32x4){0.f, 0.f, 0.f, 0.f}; }
#pragma unroll
            for (int ai = 0; ai < 2; ++ai)
#pragma unroll
                for (int m = 0; m < 4; ++m) {
                    const int row = row0 + ai * HALF + m * 16;
                    f32x4 c0 = (f32x4){1.f, 1.f, 1.f, 1.f}, c1 = c0, s0 = (f32x4){0.f, 0.f, 0.f, 0.f}, s1 = s0;
                    if (rot) { const float* cp = cs + (size_t)row * 32 + 8 * (fq & 1); c0 = *(const f32x4*)cp; c1 = *(const f32x4*)(cp + 4); s0 = *(const f32x4*)(cp + 16); s1 = *(const f32x4*)(cp + 20);
                        if (fq < 2) { s0 = -s0; s1 = -s1; } }
#pragma unroll
                    for (int bj = 0; bj < 2; ++bj) {
                        f32x4 v0 = acc[ai][bj][m][0], v1 = acc[ai][bj][m][1];
                        if (rot) { const f32x4 p0 = shx(v0, 32), p1 = shx(v1, 32); v0 = v0 * c0 + p0 * s0; v1 = v1 * c1 + p1 * s1; }
                        if (isk) { ks[bj][0] += v0; ks[bj][1] += v1; }
                        v0 = v0 * qs; v1 = v1 * qs;
                        *(u32x4*)(base + (size_t)row * 1024 + bj * HALF) = pack8(v0, v1);
                    }
                }
            if (isk) {
#pragma unroll
                for (int bj = 0; bj < 2; ++bj)
#pragma unroll
                    for (int n = 0; n < 2; ++n) { f32x4 v = ks[bj][n]; v += shx(v, 1); v += shx(v, 2); v += shx(v, 4); v += shx(v, 8);
                        if (fr == 0) { float* kp = ksum + (size_t)u.pm * 1024 + (pn & 3) * 256 + bj * HALF + colw + 4 * n;
                            unsafeAtomicAdd(kp + 0, v[0]); unsafeAtomicAdd(kp + 1, v[1]); unsafeAtomicAdd(kp + 2, v[2]); unsafeAtomicAdd(kp + 3, v[3]); } }
            }
        } else {
            const int t = (pn - 24) >> 3, colg = ((pn - 24) & 7) * 256 + colw;
            bf16_t* base = GAB + (size_t)t * ((size_t)8192 * 2048) + colg;
            const float* bp = gbias + t * 2048 + colg;
            f32x4 bv[2][2];
#pragma unroll
            for (int bj = 0; bj < 2; ++bj) { bv[bj][0] = *(const f32x4*)(bp + bj * HALF); bv[bj][1] = *(const f32x4*)(bp + bj * HALF + 4); }
#pragma unroll
            for (int ai = 0; ai < 2; ++ai)
#pragma unroll
                for (int m = 0; m < 4; ++m) { const int row = row0 + ai * HALF + m * 16;
#pragma unroll
                    for (int bj = 0; bj < 2; ++bj) *(u32x4*)(base + (size_t)row * 2048 + bj * HALF) = pack8(sigm4(acc[ai][bj][m][0] + bv[bj][0]), sigm4(acc[ai][bj][m][1] + bv[bj][1])); }
        }
    }
};
struct EpiMerge2 {
    static constexpr bool PERM = true, AFTER_DRAIN = false, KEEP_SEG0 = true;
    const bf16_t* GA; const bf16_t* GB; bf16_t* O;
    __device__ __forceinline__ void operator()(f32x4 (&acc)[2][2][4][2], const Unit& u, int wr, int wc, int fr, int fq) const {
        const int row0 = u.pm * BM + wr * 64 + fr, col0 = u.pn * BM + wc * 32 + 8 * fq;
        if (u.seg == 0) {
#pragma unroll
            for (int ai = 0; ai < 2; ++ai)
#pragma unroll
                for (int m = 0; m < 4; ++m) { const size_t off = (size_t)(row0 + ai * HALF + m * 16) * 2048 + col0;
#pragma unroll
                    for (int bj = 0; bj < 2; ++bj) { const u32x4 a = *(const u32x4*)(GA + off + bj * HALF), b = *(const u32x4*)(GB + off + bj * HALF);
                        const f32x4 b0 = bf4lo(b.x, b.y), b1 = bf4lo(b.z, b.w); f32x4 r0, r1;
#pragma unroll
                        for (int e = 0; e < 4; ++e) { r0[e] = __builtin_amdgcn_rcpf(fmaxf(b0[e], 1e-20f)); r1[e] = __builtin_amdgcn_rcpf(fmaxf(b1[e], 1e-20f)); }
                        acc[ai][bj][m][0] = acc[ai][bj][m][0] * (bf4lo(a.x, a.y) * r0); acc[ai][bj][m][1] = acc[ai][bj][m][1] * (bf4lo(a.z, a.w) * r1); } }
        } else {
#pragma unroll
            for (int ai = 0; ai < 2; ++ai)
#pragma unroll
                for (int m = 0; m < 4; ++m) { const size_t off = (size_t)(row0 + ai * HALF + m * 16) * 2048 + col0;
#pragma unroll
                    for (int bj = 0; bj < 2; ++bj) { const u32x4 b = *(const u32x4*)(GB + off + bj * HALF);
                        f32x4 b0 = bf4lo(b.x, b.y), b1 = bf4lo(b.z, b.w);
#pragma unroll
                        for (int e = 0; e < 4; ++e) { b0[e] = fmaxf(b0[e], 1e-20f); b1[e] = fmaxf(b1[e], 1e-20f); }
                        *(u32x4*)(O + off + bj * HALF) = pack8(acc[ai][bj][m][0] * b0, acc[ai][bj][m][1] * b1); } }
        }
    }
};
struct EpiX1 {
    static constexpr bool PERM = true, AFTER_DRAIN = false, KEEP_SEG0 = false;
    const float* X; float* X1; bf16_t* X1B; unsigned long long* SS;
    __device__ __forceinline__ void operator()(const f32x4 (&acc)[2][2][4][2], const Unit& u, int wr, int wc, int fr, int fq) const {
        const int row0 = u.pm * BM + wr * 64 + fr, col0 = u.pn * BM + wc * 32 + 8 * fq;
#pragma unroll
        for (int ai = 0; ai < 2; ++ai)
#pragma unroll
            for (int m = 0; m < 4; ++m) { const int row = row0 + ai * HALF + m * 16; const size_t off = (size_t)row * 2048 + col0; float sq = 0.f;
#pragma unroll
                for (int bj = 0; bj < 2; ++bj) { const f32x4 v0 = acc[ai][bj][m][0] + *(const f32x4*)(X + off + bj * HALF), v1 = acc[ai][bj][m][1] + *(const f32x4*)(X + off + bj * HALF + 4);
                    *(f32x4*)(X1 + off + bj * HALF) = v0; *(f32x4*)(X1 + off + bj * HALF + 4) = v1; *(u32x4*)(X1B + off + bj * HALF) = pack8(v0, v1);
                    sq += (v0[0] * v0[0] + v0[1] * v0[1]) + (v0[2] * v0[2] + v0[3] * v0[3]) + (v1[0] * v1[0] + v1[1] * v1[1]) + (v1[2] * v1[2] + v1[3] * v1[3]); }
                sq += __shfl_xor(sq, 16); sq += __shfl_xor(sq, 32);
                if (fq == 0) atomicAdd(SS + row, (unsigned long long)(sq * 4294967296.0f)); }
    }
};
__device__ __forceinline__ float rinv_from_ss(unsigned long long s) { return 1.0f / sqrtf((float)((double)s * (1.0 / 4294967296.0) * (1.0 / 2048.0)) + 1e-6f); }
struct EpiQP {
    static constexpr bool PERM = true, AFTER_DRAIN = false, KEEP_SEG0 = false;
    const unsigned long long* SS; bf16_t* O;
    __device__ __forceinline__ void operator()(const f32x4 (&acc)[2][2][4][2], const Unit& u, int wr, int wc, int fr, int fq) const {
        const int row0 = u.pm * BM + wr * 64 + fr, col0 = u.pn * BM + wc * 32 + 8 * fq;
#pragma unroll
        for (int ai = 0; ai < 2; ++ai)
#pragma unroll
            for (int m = 0; m < 4; ++m) { const int row = row0 + ai * HALF + m * 16; const size_t off = (size_t)row * 2048 + col0; const float rv = rinv_from_ss(SS[row]);
#pragma unroll
                for (int bj = 0; bj < 2; ++bj) *(u32x4*)(O + off + bj * HALF) = pack8(acc[ai][bj][m][0] * rv, acc[ai][bj][m][1] * rv); }
    }
};

template <class Epi, class Sched, bool ALIGN_EPI = false, bool SP2 = false>
__device__ __forceinline__ void gemm_phase(PG8_LAS unsigned char* lds, const Gemm g, const Sched& S, const Epi& E) {
    const int tid = threadIdx.x, wid = __builtin_amdgcn_readfirstlane(tid >> 6), lane = tid & 63, wr = wid >> 2, wc = wid & 3, fr = lane & 15, fq = lane >> 4;
    const int K = g.K, nt = K / BK;
    unsigned voffA[2], voffB[2];
#pragma unroll
    for (int i = 0; i < 2; ++i) { int R, C; stage_rc(tid * 16 + i * 8192, R, C); const int Rb = Epi::PERM ? ((R & ~31) + perm32(R & 31)) : R;
        voffA[i] = (unsigned)(R * K + C) * 2u; voffB[i] = (unsigned)(Rb * K + C) * 2u; }
    const size_t kstep = (size_t)(BK * 2);
    const size_t hstep = (size_t)HALF * K * 2;
    const size_t tstep = 2 * hstep;
    const unsigned ldsw = (unsigned)wid * 1024u;
    const int aoff = lds_byte(wr * 64 + fr, fq * 8), boff = lds_byte(wc * 32 + fr, fq * 8);
#define PG8_SA(b, h) (((b) * 2 + (h)) * HTB)
#define PG8_SB(b, h) ((4 + (b) * 2 + (h)) * HTB)
#define PG8_STAGE(bufoff, gbase, voff) do { _Pragma("unroll") for (int _i = 0; _i < 2; ++_i) \
        __builtin_amdgcn_global_load_lds((const unsigned*)((const char*)(gbase) + (voff)[_i]), (PG8_LAS unsigned*)(lds + (bufoff) + ldsw + _i * 8192), 16, 0, 0); } while (0)
#define PG8_LDA(dst, b, h) do { _Pragma("unroll") for (int m = 0; m < 4; ++m) _Pragma("unroll") for (int k = 0; k < 2; ++k) dst[m][k] = *(const PG8_LAS bf16x8*)(lds + PG8_SA(b, h) + aoff + m * 2048 + k * 1024); } while (0)
#define PG8_LDB(dst, b, h) do { _Pragma("unroll") for (int n = 0; n < 2; ++n) _Pragma("unroll") for (int k = 0; k < 2; ++k) dst[n][k] = *(const PG8_LAS bf16x8*)(lds + PG8_SB(b, h) + boff + n * 2048 + k * 1024); } while (0)
#define PG8_MMA(ai, bj, At, Bt) do { __builtin_amdgcn_s_setprio(1); _Pragma("unroll") for (int m = 0; m < 4; ++m) _Pragma("unroll") for (int n = 0; n < 2; ++n) _Pragma("unroll") for (int k = 0; k < 2; ++k) \
        acc[ai][bj][m][n] = __builtin_amdgcn_mfma_f32_16x16x32_bf16(Bt[n][k], At[m][k], acc[ai][bj][m][n], 0, 0, 0); __builtin_amdgcn_s_setprio(0); } while (0)
#define PG8_WAIT_V(n) asm volatile("s_waitcnt vmcnt(" #n ")" ::: "memory")
#define PG8_WAIT_L(n) asm volatile("s_waitcnt lgkmcnt(" #n ")" ::: "memory")
#define PG8_BAR __builtin_amdgcn_s_barrier()
#define PG8_SCHED __builtin_amdgcn_sched_barrier(0)
    Unit cur, nxt; int ui = 0;
    if (!S.next(0, cur)) return;
    f32x4 acc[2][2][4][2];
#pragma unroll
    for (int a = 0; a < 2; ++a)
#pragma unroll
        for (int b = 0; b < 2; ++b)
#pragma unroll
            for (int m = 0; m < 4; ++m)
#pragma unroll
                for (int n = 0; n < 2; ++n) acc[a][b][m][n] = (f32x4){0.f, 0.f, 0.f, 0.f};
    bf16x8 At[4][2], B0[2][2], B1[2][2];
    const char* cA = (const char*)(cur.seg ? g.A2 : g.A) + (size_t)cur.pm * tstep; const char* cB = (const char*)(cur.seg ? g.Bt2 : g.Bt) + (size_t)cur.pn * tstep;
    S.a_ready(cur);
    if constexpr (SP2) {
        PG8_STAGE(PG8_SB(0, 0), cB, voffB); PG8_STAGE(PG8_SB(0, 1), cB + hstep, voffB); PG8_STAGE(PG8_SA(0, 0), cA, voffA); PG8_STAGE(PG8_SA(0, 1), cA + hstep, voffA);
        if (wr == 1) PG8_BAR;
        PG8_WAIT_V(2); PG8_BAR;
        PG8_STAGE(PG8_SB(1, 0), cB + kstep, voffB); PG8_STAGE(PG8_SA(1, 0), cA + kstep, voffA); PG8_STAGE(PG8_SB(1, 1), cB + hstep + kstep, voffB);
        PG8_WAIT_V(6); PG8_BAR;
    } else {
        PG8_STAGE(PG8_SB(0, 0), cB, voffB); PG8_STAGE(PG8_SA(0, 0), cA, voffA); PG8_STAGE(PG8_SB(0, 1), cB + hstep, voffB); PG8_STAGE(PG8_SA(0, 1), cA + hstep, voffA);
        if (wr == 1) PG8_BAR;
        PG8_WAIT_V(4); PG8_BAR;
        PG8_STAGE(PG8_SB(1, 0), cB + kstep, voffB); PG8_STAGE(PG8_SA(1, 0), cA + kstep, voffA); PG8_STAGE(PG8_SB(1, 1), cB + hstep + kstep, voffB);
        PG8_WAIT_V(6); PG8_BAR;
    }
    for (;;) {
        const bool has_next = S.next(ui + 1, nxt);
        const char* nA = has_next ? (const char*)(nxt.seg ? g.A2 : g.A) + (size_t)nxt.pm * tstep : cA; const char* nB = has_next ? (const char*)(nxt.seg ? g.Bt2 : g.Bt) + (size_t)nxt.pn * tstep : cB;
        for (int t = 0; t < nt; t += 2) {
            const bool last = (t == nt - 2);
            const char* a1 = cA + (size_t)(t + 1) * kstep;
            const char* a2 = last ? nA : cA + (size_t)(t + 2) * kstep; const char* b2 = last ? nB : cB + (size_t)(t + 2) * kstep;
            const char* a3 = a2 + kstep; const char* b3 = b2 + kstep;
            if (last && has_next) S.a_ready(nxt);
            if constexpr (SP2) {
            PG8_LDB(B0, 0, 0); PG8_LDB(B1, 0, 1); PG8_SCHED; PG8_LDA(At, 0, 0); PG8_STAGE(PG8_SA(1, 1), a1 + hstep, voffA);
            PG8_WAIT_V(8); PG8_WAIT_L(0); PG8_BAR; PG8_MMA(0, 0, At, B0); PG8_MMA(0, 1, At, B1); PG8_BAR; PG8_SCHED;
            PG8_LDA(At, 0, 1); PG8_STAGE(PG8_SB(0, 0), b2, voffB); PG8_STAGE(PG8_SB(0, 1), b2 + hstep, voffB); PG8_STAGE(PG8_SA(0, 0), a2, voffA);
            PG8_WAIT_V(8); PG8_WAIT_L(0); PG8_BAR; PG8_MMA(1, 0, At, B0); PG8_MMA(1, 1, At, B1); PG8_BAR; PG8_SCHED;
            PG8_LDB(B0, 1, 0); PG8_LDB(B1, 1, 1); PG8_SCHED; PG8_LDA(At, 1, 0); PG8_STAGE(PG8_SA(0, 1), a2 + hstep, voffA);
            PG8_WAIT_V(8); PG8_WAIT_L(0); PG8_BAR; PG8_MMA(0, 0, At, B0); PG8_MMA(0, 1, At, B1); PG8_BAR; PG8_SCHED;
            PG8_LDA(At, 1, 1); PG8_STAGE(PG8_SB(1, 0), b3, voffB); PG8_STAGE(PG8_SB(1, 1), b3 + hstep, voffB); PG8_STAGE(PG8_SA(1, 0), a3, voffA);
            PG8_WAIT_V(8); PG8_WAIT_L(0); PG8_BAR; PG8_MMA(1, 0, At, B0); PG8_MMA(1, 1, At, B1); PG8_BAR; PG8_SCHED;
            } else {
            PG8_LDB(B0, 0, 0); PG8_SCHED; PG8_LDA(At, 0, 0); PG8_STAGE(PG8_SA(1, 1), a1 + hstep, voffA);
            PG8_WAIT_L(8); PG8_BAR; PG8_WAIT_L(0); PG8_MMA(0, 0, At, B0); PG8_BAR; PG8_SCHED;
            PG8_LDB(B1, 0, 1); PG8_STAGE(PG8_SB(0, 0), b2, voffB);
            PG8_BAR; PG8_WAIT_L(0); PG8_MMA(0, 1, At, B1); PG8_BAR;
            PG8_LDA(At, 0, 1); PG8_STAGE(PG8_SA(0, 0), a2, voffA);
            PG8_BAR; PG8_WAIT_L(0); PG8_MMA(1, 0, At, B0); PG8_BAR; PG8_SCHED;
            PG8_STAGE(PG8_SB(0, 1), b2 + hstep, voffB);
            PG8_WAIT_V(6); PG8_BAR; PG8_MMA(1, 1, At, B1); PG8_BAR;
            PG8_LDB(B0, 1, 0); PG8_SCHED; PG8_LDA(At, 1, 0); PG8_STAGE(PG8_SA(0, 1), a2 + hstep, voffA);
            PG8_WAIT_L(8); PG8_BAR; PG8_WAIT_L(0); PG8_MMA(0, 0, At, B0); PG8_BAR; PG8_SCHED;
            PG8_LDB(B1, 1, 1); PG8_STAGE(PG8_SB(1, 0), b3, voffB);
            PG8_BAR; PG8_WAIT_L(0); PG8_MMA(0, 1, At, B1); PG8_BAR;
            PG8_LDA(At, 1, 1); PG8_STAGE(PG8_SA(1, 0), a3, voffA);
            PG8_BAR; PG8_WAIT_L(0); PG8_MMA(1, 0, At, B0); PG8_BAR; PG8_SCHED;
            PG8_STAGE(PG8_SB(1, 1), b3 + hstep, voffB);
            PG8_WAIT_V(6); PG8_BAR; PG8_MMA(1, 1, At, B1); PG8_BAR;
            }
        }
        if constexpr (ALIGN_EPI) { if (wr == 0) PG8_BAR; }
        if constexpr (!Epi::AFTER_DRAIN) { E(acc, cur, wr, wc, fr, fq); S.done(cur); }
        if (!has_next) break;
        if (!(Epi::KEEP_SEG0 && cur.seg == 0)) {
#pragma unroll
        for (int a = 0; a < 2; ++a)
#pragma unroll
            for (int b = 0; b < 2; ++b)
#pragma unroll
                for (int m = 0; m < 4; ++m)
#pragma unroll
                    for (int n = 0; n < 2; ++n) acc[a][b][m][n] = (f32x4){0.f, 0.f, 0.f, 0.f};
        }
        cur = nxt; cA = nA; cB = nB; ++ui;
        if constexpr (ALIGN_EPI) { if (wr == 1) PG8_BAR; }
    }
    PG8_WAIT_V(0);
    if constexpr (!ALIGN_EPI) { if (wr == 0) PG8_BAR; }
    PG8_BAR;
    if constexpr (Epi::AFTER_DRAIN) { E.fused(acc, cur, wr, wc, fr, fq, lds, wid, lane); S.done(cur); }
#undef PG8_SA
#undef PG8_SB
#undef PG8_STAGE
#undef PG8_LDA
#undef PG8_LDB
#undef PG8_MMA
#undef PG8_WAIT_V
#undef PG8_WAIT_L
#undef PG8_BAR
#undef PG8_SCHED
}
}

constexpr int NWAVES = 8;
#ifndef MK_N_LAUNCHES
#define MK_N_LAUNCHES 1
#endif
constexpr int PER_PHASE = 9;
#ifndef MK_REP_PHASE
#define MK_REP_PHASE -1
#endif
#define NREP(k) (((k) == MK_REP_PHASE) ? 2 : 1)
constexpr int N_LAUNCHES = MK_N_LAUNCHES;
constexpr int M = 8192, SEQ = 4096, DM = 2048, INW = 10240, NEXP = 16384;
constexpr float RMS_EPS = 1e-6f;
constexpr size_t MiB = 1u << 20;
constexpr size_t WS_CTL = 0, CTL_ZERO_BYTES = 1 * MiB;
constexpr size_t WS_SS = 256 * 1024, WS_KSUM = 512 * 1024;
constexpr size_t WS_WIN = 2 * MiB, WS_WBC = 42 * MiB, WS_WBA = 46 * MiB, WS_WOUT = 50 * MiB, WS_WPQ = 58 * MiB, WS_KEYS = 66 * MiB, WS_CS = 67 * MiB;
constexpr size_t WS_UB = 70 * MiB, WS_VB = 102 * MiB;
constexpr size_t WS_XB = 198 * MiB;
constexpr size_t WS_T6 = 230 * MiB;
constexpr size_t WS_GAB = 326 * MiB;
constexpr size_t WS_UC = 390 * MiB, WS_AO = 406 * MiB;
constexpr size_t WS_EXP = 422 * MiB, WS_GATE = 426 * MiB;
constexpr size_t WS_END = 430 * MiB;
constexpr size_t WS_TMP = WS_XB, WS_MB = WS_T6, WS_X1B = WS_T6 + 48 * MiB, WS_QP = WS_GAB;
constexpr int CW_BAR = 4096;
constexpr int RING_OFF = 0, RING_BYTES = 131072;
constexpr int LDSCTL_OFF = RING_BYTES, MISC_OFF = LDSCTL_OFF + 320;
constexpr int LDS_BYTES = 147456;

#define GAS __attribute__((address_space(1)))
#define LAS __attribute__((address_space(3)))
typedef unsigned short bf16;
typedef unsigned v4u __attribute__((ext_vector_type(4)));
typedef float f32x4 __attribute__((ext_vector_type(4)));
typedef short bf16x8 __attribute__((ext_vector_type(8)));
typedef GAS unsigned gu32;
typedef GAS unsigned long long gu64;
#define RLX_AGENT __ATOMIC_RELAXED, __HIP_MEMORY_SCOPE_AGENT
#define LDS_WAIT() asm volatile("s_waitcnt lgkmcnt(0)" ::: "memory")
#define VM_WAIT() asm volatile("s_waitcnt vmcnt(0)" ::: "memory")
__device__ __forceinline__ unsigned long long rt() { return __builtin_amdgcn_s_memrealtime(); }
__device__ __forceinline__ unsigned f2bf(float f) { unsigned u = __builtin_bit_cast(unsigned, f); return (u + 0x7fffu + ((u >> 16) & 1u)) >> 16; }
__device__ __forceinline__ unsigned pk2(float lo, float hi) { return f2bf(lo) | (f2bf(hi) << 16); }

#define XB_TMO      128
#define XB_XCNT(j)  (256  + 64 * (j))
#define XB_XSUB(j)  (1280 + 64 * (j))
#define XB_XGEN(j)  (2304 + 64 * (j))
#define XB_TOP      3328
#define XB_TOPGEN   3392
#define XCD_BAR_WORDS 3456
#define XB_SPIN_CAP (1u << 18)

__device__ __forceinline__ unsigned xb_ld(unsigned* p)              { return __hip_atomic_load(p, __ATOMIC_RELAXED, __HIP_MEMORY_SCOPE_AGENT); }
__device__ __forceinline__ unsigned xb_add(unsigned* p, unsigned v) { return __hip_atomic_fetch_add(p, v, __ATOMIC_RELAXED, __HIP_MEMORY_SCOPE_AGENT); }
__device__ __forceinline__ unsigned xb_xcc_id() { return (unsigned)__builtin_amdgcn_s_getreg((3 << 11) | 20) & 0xFu; }
#define XB_SPIN(cond, bar) do { unsigned _sp = 0; while (cond) { __builtin_amdgcn_s_sleep(1); \
    if ((++_sp & 255u) == 0u) { if (xb_ld(&(bar)[XB_TMO])) break; if (_sp > XB_SPIN_CAP) { atomicAdd(&(bar)[XB_TMO], 1u); break; } } } } while (0)

struct XcdBarrier {
    unsigned* bar; unsigned x;
    volatile LAS unsigned* st;
};

__device__ __forceinline__ XcdBarrier xcd_barrier_post(unsigned* bar, volatile LAS unsigned* st) {
    XcdBarrier b; b.bar = bar; b.x = xb_xcc_id(); b.st = st;
    if (threadIdx.x == 0) (void)xb_add(&bar[XB_XCNT(b.x)], 1u);
    return b;
}
__device__ __forceinline__ void xcd_barrier_complete(unsigned* bar, unsigned x, unsigned& nloc, unsigned& nx) {
    const unsigned G = gridDim.x * gridDim.y * gridDim.z;
    unsigned sum, cnt, mine, sp = 0u;
    for (;;) {
        sum = 0u; cnt = 0u; mine = 0u;
#pragma unroll
        for (unsigned j = 0; j < 16; ++j) { const unsigned c = xb_ld(&bar[XB_XCNT(j)]); sum += c; cnt += (c > 0u) ? 1u : 0u; mine = (j == x) ? c : mine; }
        if (sum == G) break;
        __builtin_amdgcn_s_sleep(1);
        if ((++sp & 255u) == 0u) { if (xb_ld(&bar[XB_TMO])) break; if (sp > XB_SPIN_CAP) { atomicAdd(&bar[XB_TMO], 1u); break; } }
    }
    nloc = mine > 0u ? mine : 1u; nx = cnt > 0u ? cnt : 1u;
}

__device__ __forceinline__ void xcd_barrier(const XcdBarrier& b) {
    asm volatile("s_waitcnt vmcnt(0)" ::: "memory");
    __syncthreads();
    if (threadIdx.x == 0) {
        unsigned* bar = b.bar;
        __builtin_amdgcn_s_waitcnt(0);
        unsigned nloc = b.st[0], nx = b.st[1];
        if (nloc == 0u) { xcd_barrier_complete(bar, b.x, nloc, nx); b.st[0] = nloc; b.st[1] = nx; }
        const unsigned old = xb_add(&bar[XB_XSUB(b.x)], 1u);
        const unsigned gen = old / nloc;
        if (old + 1u == (gen + 1u) * nloc) {
            __builtin_amdgcn_fence(__ATOMIC_RELEASE, "agent");
            asm volatile("s_waitcnt vmcnt(0)" ::: "memory");
            const unsigned og = xb_add(&bar[XB_TOP], 1u);
            const unsigned tg = og / nx;
            if (og + 1u == (tg + 1u) * nx) xb_add(&bar[XB_TOPGEN], 1u);
            else XB_SPIN(xb_ld(&bar[XB_TOPGEN]) == tg, bar);
            __builtin_amdgcn_fence(__ATOMIC_ACQUIRE, "agent");
            xb_add(&bar[XB_XGEN(b.x)], 1u);
            asm volatile("s_waitcnt vmcnt(0)" ::: "memory");
        } else {
            XB_SPIN(xb_ld(&bar[XB_XGEN(b.x)]) == gen, bar);
            __builtin_amdgcn_fence(__ATOMIC_ACQUIRE, "agent");
            asm volatile("s_waitcnt vmcnt(0)" ::: "memory");
        }
    }
    __syncthreads();
}

typedef __bf16 bf16x2v __attribute__((ext_vector_type(2)));
typedef float f32x16 __attribute__((ext_vector_type(16)));
__device__ __forceinline__ float bflo(unsigned w) { return __uint_as_float(w << 16); }
__device__ __forceinline__ float bfhi(unsigned w) { return __uint_as_float(w & 0xffff0000u); }
__device__ __forceinline__ float dot2bf(unsigned a, unsigned b, float c) { return __builtin_amdgcn_fdot2_f32_bf16(__builtin_bit_cast(bf16x2v, a), __builtin_bit_cast(bf16x2v, b), c, false); }
__device__ __forceinline__ float wave_sum(float v) {
#pragma unroll
    for (int o = 1; o < 64; o <<= 1) v += __shfl_xor(v, o);
    return v; }
__device__ __forceinline__ float wave_max(float v) {
#pragma unroll
    for (int o = 1; o < 64; o <<= 1) v = fmaxf(v, __shfl_xor(v, o));
    return v; }
__device__ __forceinline__ float rdlane(float v, int l) { return __int_as_float(__builtin_amdgcn_readlane(__float_as_int(v), l)); }
__device__ __forceinline__ float gelu_tanh(float x) { const float z = 0.7978845608028654f * (x + 0.044715f * x * x * x); const float e = __expf(2.0f * z); const float th = 1.0f - 2.0f * __builtin_amdgcn_rcpf(1.0f + e); return 0.5f * x * (1.0f + th); }

struct Ctx { LAS unsigned char* lds; int tid, lane, wave, vcu, G; };

__device__ __forceinline__ void p0_transpose_item(const float* W, int K, int N, bf16* WT, const float* gk, LAS float* scr, int item, int lane) {
    const int nblk = N / 32, kb = item / nblk, nb = item % nblk, k0 = 64 * kb, n0 = 32 * nb;
#pragma unroll
    for (int i = 0; i < 8; ++i) { const int kk = 8 * i + (lane >> 3), nn = 4 * (lane & 7); f32x4 v = *(const GAS f32x4*)(W + (size_t)(k0 + kk) * N + n0 + nn); if (gk) v = v * gk[k0 + kk];
        scr[kk * 33 + nn] = v[0]; scr[kk * 33 + nn + 1] = v[1]; scr[kk * 33 + nn + 2] = v[2]; scr[kk * 33 + nn + 3] = v[3]; }
    LDS_WAIT(); asm volatile("" ::: "memory");
    const int c = lane & 7;
#pragma unroll
    for (int j = 0; j < 4; ++j) { const int n = (lane >> 3) + 8 * j; const LAS float* s = scr + (8 * c) * 33 + n;
        v4u o; o.x = pk2(s[0 * 33], s[1 * 33]); o.y = pk2(s[2 * 33], s[3 * 33]); o.z = pk2(s[4 * 33], s[5 * 33]); o.w = pk2(s[6 * 33], s[7 * 33]);
        *(GAS v4u*)(WT + (size_t)(n0 + n) * K + k0 + 8 * c) = o; }
    LDS_WAIT(); asm volatile("" ::: "memory");
}
__device__ __forceinline__ void convert_tables(const Ctx& F, const float* pu, const float* pv, const float* g2, unsigned char* ws) {
    const int gt = (F.vcu * NWAVES + F.wave) * 64 + F.lane, NT = F.G * NWAVES * 64;
    for (int i = gt; i < NEXP * 2048 / 16; i += NT) { const int c16 = (i & 127) * 16; v4u ou, ov;
#pragma unroll
        for (int q = 0; q < 4; ++q) { f32x4 a = ((const GAS f32x4*)pu)[4 * i + q]; a = a * *(const GAS f32x4*)(g2 + c16 + 4 * q) * 512.0f; const f32x4 b = ((const GAS f32x4*)pv)[4 * i + q] * 32.0f;
            int wu = 0, wv = 0; wu = __builtin_amdgcn_cvt_pk_fp8_f32(a[0], a[1], wu, false); wu = __builtin_amdgcn_cvt_pk_fp8_f32(a[2], a[3], wu, true);
            wv = __builtin_amdgcn_cvt_pk_fp8_f32(b[0], b[1], wv, false); wv = __builtin_amdgcn_cvt_pk_fp8_f32(b[2], b[3], wv, true); ou[q] = (unsigned)wu; ov[q] = (unsigned)wv; }
        ((GAS v4u*)(ws + WS_UB))[i] = ou; ((GAS v4u*)(ws + WS_VB))[i] = ov; }
}
__device__ __forceinline__ void p0_prologue(const Ctx& F, const float* const* in, unsigned char* ws, const double* invf) {
    const float* x = in[0]; const int* pos = (const int*)in[1]; const float* g1 = in[2]; const float* w_in = in[3];
    const float* w_bc = in[6]; const float* w_ba = in[7]; const float* w_out = in[8]; const float* g2 = in[9]; const float* w_pq = in[10];
    const float* keys = in[11]; const float* pu = in[12]; const float* pv = in[13];
    LAS float* scr = (LAS float*)(F.lds + RING_OFF + F.wave * 16384);
    const int gw = F.vcu * NWAVES + F.wave, NGW = F.G * NWAVES;
    const int gt = gw * 64 + F.lane, NT = NGW * 64;
    for (int i = gt; i < 8192; i += NT) ((GAS unsigned long long*)(ws + WS_SS))[i] = 0ull;
    for (int i = gt; i < 32 * 1024; i += NT) ((GAS float*)(ws + WS_KSUM))[i] = 0.f;
    constexpr int I_IN = 32 * 320, I_BC = 16 * 64, I_OUT = 32 * 64;
    constexpr int NITEMS = I_IN + 2 * I_BC + 2 * I_OUT;
    for (int it = gw; it < NITEMS; it += NGW) {
        int r = it;
        if (r < I_IN) { p0_transpose_item(w_in, 2048, INW, (bf16*)(ws + WS_WIN), g1, scr, r, F.lane); continue; } r -= I_IN;
        if (r < I_BC) { p0_transpose_item(w_bc, 1024, 2048, (bf16*)(ws + WS_WBC), nullptr, scr, r, F.lane); continue; } r -= I_BC;
        if (r < I_BC) { p0_transpose_item(w_ba, 1024, 2048, (bf16*)(ws + WS_WBA), nullptr, scr, r, F.lane); continue; } r -= I_BC;
        if (r < I_OUT) { p0_transpose_item(w_out, 2048, 2048, (bf16*)(ws + WS_WOUT), nullptr, scr, r, F.lane); continue; } r -= I_OUT;
        p0_transpose_item(w_pq, 2048, 2048, (bf16*)(ws + WS_WPQ), g2, scr, r, F.lane);
    }
    for (int i = gt; i < 16 * 128 * 128 / 8; i += NT) { const f32x4 a = ((const GAS f32x4*)keys)[2 * i], b = ((const GAS f32x4*)keys)[2 * i + 1];
        v4u o; o.x = pk2(a[0], a[1]); o.y = pk2(a[2], a[3]); o.z = pk2(b[0], b[1]); o.w = pk2(b[2], b[3]); ((GAS v4u*)(ws + WS_KEYS))[i] = o; }
    for (int m = gw; m < M; m += NGW) { const GAS f32x4* xr = (const GAS f32x4*)(x + (size_t)m * DM);
        f32x4 v[8]; float s = 0.f;
#pragma unroll
        for (int i = 0; i < 4; ++i) { v[2 * i] = xr[i * 128 + 2 * F.lane]; v[2 * i + 1] = xr[i * 128 + 2 * F.lane + 1]; }
#pragma unroll
        for (int i = 0; i < 8; ++i) s += (v[i][0] * v[i][0] + v[i][1] * v[i][1]) + (v[i][2] * v[i][2] + v[i][3] * v[i][3]);
        const float rinv = 1.0f / sqrtf(wave_sum(s) * (1.0f / DM) + RMS_EPS);
        GAS v4u* o = (GAS v4u*)(ws + WS_XB + (size_t)m * DM * 2);
#pragma unroll
        for (int i = 0; i < 4; ++i) { const f32x4 a = v[2 * i] * rinv, b = v[2 * i + 1] * rinv; v4u w; w.x = pk2(a[0], a[1]); w.y = pk2(a[2], a[3]); w.z = pk2(b[0], b[1]); w.w = pk2(b[2], b[3]); o[i * 64 + F.lane] = w; } }
    for (int i = gt; i < M * 16; i += NT) { const int row = i >> 4, f = i & 15; const double ang = (double)pos[row] * invf[f];
        const double k = __builtin_rint(ang * 0.15915494309189535); const float r = (float)(ang - k * 6.283185307179586);
        float* cs = (float*)(ws + WS_CS); cs[row * 32 + f] = __cosf(r); cs[row * 32 + 16 + f] = __sinf(r); }
}

__device__ __forceinline__ void attn_simple(const Ctx& F, const bf16* Q, const bf16* K, const bf16* V, const float* ksum, bf16* AO) {
    LAS float* qf = (LAS float*)(F.lds + RING_OFF + F.wave * 512);
    const int gw = F.vcu * NWAVES + F.wave, NGW = F.G * NWAVES, lane = F.lane;
    for (int item = gw; item < 16 * SEQ; item += NGW) {
        const int bh = item >> 12, t = item & 4095, b = bh >> 3, h = bh & 7, blk = t >> 8;
        const size_t row = (size_t)b * SEQ + t;
        { const unsigned qq = *(const GAS unsigned*)(Q + row * 1024 + h * 128 + 2 * lane); qf[2 * lane] = bflo(qq); qf[2 * lane + 1] = bfhi(qq); }
        LDS_WAIT(); asm volatile("" ::: "memory");
        float g = -INFINITY;
        if (lane < blk) { const GAS f32x4* km = (const GAS f32x4*)(ksum + (size_t)(b * 16 + lane) * 1024 + h * 128); float a = 0.f;
            for (int d = 0; d < 32; ++d) { const f32x4 kv = km[d]; const f32x4 qv = *(const LAS f32x4*)(qf + 4 * d); a += (kv[0] * qv[0] + kv[1] * qv[1]) + (kv[2] * qv[2] + kv[3] * qv[3]); }
            g = a; }
        int sel[3];
#pragma unroll
        for (int i = 0; i < 3; ++i) { const float mx = wave_max(g); const unsigned long long bal = __ballot(g == mx && lane < blk); const int idx = bal ? (__ffsll((long long)bal) - 1) : 0; sel[i] = idx; if (lane == idx) g = -INFINITY; }
        const int nsel = blk < 3 ? blk : 3;
        float sc[4][4]; float mx = -INFINITY;
#pragma unroll
        for (int slot = 0; slot < 4; ++slot) {
            const bool valid = (slot == 3) || (slot < nsel);
            const int kb = (slot == 3) ? blk : sel[slot < 3 ? slot : 0];
#pragma unroll
            for (int r = 0; r < 4; ++r) {
                float s = -INFINITY; const int key0 = kb * 256 + r * 64;
                if (valid && (slot < 3 || key0 <= t)) {
                    const int key = key0 + lane; const GAS v4u* kp = (const GAS v4u*)(K + ((size_t)b * SEQ + key) * 1024 + h * 128); float a = 0.f;
#pragma unroll 4
                    for (int d = 0; d < 16; ++d) { const v4u kk = kp[d]; const f32x4 q0 = *(const LAS f32x4*)(qf + 8 * d), q1 = *(const LAS f32x4*)(qf + 8 * d + 4);
                        a += (bflo(kk.x) * q0[0] + bfhi(kk.x) * q0[1]) + (bflo(kk.y) * q0[2] + bfhi(kk.y) * q0[3]) + (bflo(kk.z) * q1[0] + bfhi(kk.z) * q1[1]) + (bflo(kk.w) * q1[2] + bfhi(kk.w) * q1[3]); }
                    s = (slot < 3 || key <= t) ? a : -INFINITY; }
                sc[slot][r] = s; mx = fmaxf(mx, s); } }
        mx = wave_max(mx);
        float sum = 0.f;
#pragma unroll
        for (int slot = 0; slot < 4; ++slot)
#pragma unroll
            for (int r = 0; r < 4; ++r) { sc[slot][r] = exp2f(sc[slot][r] - mx); sum += sc[slot][r]; }
        sum = wave_sum(sum);
        float o0 = 0.f, o1 = 0.f;
#pragma unroll
        for (int slot = 0; slot < 4; ++slot) {
            const bool valid = (slot == 3) || (slot < nsel);
            const int kb = (slot == 3) ? blk : sel[slot < 3 ? slot : 0];
#pragma unroll
            for (int r = 0; r < 4; ++r) { const int key0 = kb * 256 + r * 64;
                if (valid && (slot < 3 || key0 <= t)) { const float pr = sc[slot][r]; const GAS unsigned* vp = (const GAS unsigned*)(V + ((size_t)b * SEQ + key0) * 1024 + h * 128) + lane;
                    for (int kk = 0; kk < 64; ++kk) { const float pk = rdlane(pr, kk); const unsigned vv = vp[(size_t)kk * 512]; o0 += pk * bflo(vv); o1 += pk * bfhi(vv); } } } }
        const float ri = 1.0f / sum;
        *(GAS unsigned*)(AO + row * 1024 + h * 128 + 2 * lane) = pk2(o0 * ri, o1 * ri);
    }
}
typedef short v4i16_t __attribute__((ext_vector_type(4))); typedef unsigned u32x2v __attribute__((ext_vector_type(2)));
__device__ __forceinline__ v4i16_t vtr16(unsigned addr) { return __builtin_amdgcn_ds_read_tr16_b64_v4i16((LAS v4i16_t*)(uintptr_t)addr); }
__device__ __forceinline__ int crow16(int r, int hh) { return (r & 3) + 8 * (r >> 2) + 4 * hh; }
__device__ __forceinline__ void attn_dma_step(const bf16* K, const bf16* V, LAS unsigned char* lds, int b, int h, int qb, int n_own, int st, int wave, int lane) {
    const int buf = st & 1;
#pragma unroll
    for (int img = 0; img < 4; ++img) {
        const int T = 2 * st + (img >> 1); const bool isV = img & 1;
        const int blk = (T < n_own) ? qb : ((T - n_own) >> 2), kt = (T < n_own) ? T : ((T - n_own) & 3);
        const bf16* base = (isV ? V : K) + ((size_t)b * SEQ + 256 * blk + 64 * kt) * 1024 + h * 128;
#pragma unroll
        for (int i = 0; i < 2; ++i) { const int pc = wave + 8 * i, row = 4 * pc + (lane >> 4), cp = lane & 15;
            const int c = isV ? ((((cp >> 2) ^ (row & 3)) << 2) | (cp & 3)) : (cp ^ (row & 15));
            __builtin_amdgcn_global_load_lds((const unsigned*)(base + (size_t)row * 1024 + 8 * c), (LAS unsigned*)(lds + buf * 65536 + img * 16384 + pc * 1024), 16, 0, 0); }
    }
}
__device__ __forceinline__ void attn_mfma(const Ctx& F, const bf16* Q, const bf16* K, const bf16* V, const float* ksum, bf16* AO) {
    const int lane = F.lane, wave = F.wave, q31 = lane & 31, hh = lane >> 5, wq = wave & 3, kvh = wave >> 2, l16 = lane & 15, G4 = lane >> 4;
    LAS unsigned char* lds = F.lds + RING_OFF;
    const unsigned lds0 = (unsigned)(uintptr_t)lds;
    for (int pr = F.vcu; pr < 256; pr += F.G)
#pragma unroll 1
    for (int pi = 0; pi < 2; ++pi) {
        const int bh = pr >> 4, s_ = pr & 15, u128 = pi ? 31 - s_ : s_, b = bh >> 3, h = bh & 7, qb = u128 >> 1, half = u128 & 1;
        const int n_own = half ? 4 : 2, nstep = (n_own + 4 * qb) >> 1;
        const size_t rowq = (size_t)b * SEQ + 256 * qb + 128 * half + 32 * wq + q31;
        asm volatile("s_waitcnt vmcnt(0) lgkmcnt(0)" ::: "memory"); __builtin_amdgcn_s_barrier(); asm volatile("" ::: "memory");
        attn_dma_step(K, V, lds, b, h, qb, n_own, 0, wave, lane);
        bf16x8 qf[8];
#pragma unroll
        for (int s = 0; s < 8; ++s) qf[s] = *(const GAS bf16x8*)(Q + rowq * 1024 + h * 128 + 16 * s + 8 * hh);
        unsigned selmask;
        {
            float qv[64];
#pragma unroll
            for (int s = 0; s < 8; ++s)
#pragma unroll
                for (int e = 0; e < 8; ++e) qv[8 * s + e] = __uint_as_float((unsigned)(unsigned short)qf[s][e] << 16);
            float v0 = -INFINITY, v1 = -INFINITY, v2 = -INFINITY; int i0 = 0, i1 = 0, i2 = 0;
#pragma unroll 1
            for (int j = 0; j < qb; ++j) {
                const GAS f32x4* kp = (const GAS f32x4*)(ksum + (size_t)(b * 16 + j) * 1024 + h * 128 + 8 * hh); float a = 0.f;
#pragma unroll
                for (int s = 0; s < 8; ++s) { const f32x4 k0 = kp[4 * s], k1 = kp[4 * s + 1];
                    a += (qv[8 * s] * k0[0] + qv[8 * s + 1] * k0[1]) + (qv[8 * s + 2] * k0[2] + qv[8 * s + 3] * k0[3]) + (qv[8 * s + 4] * k1[0] + qv[8 * s + 5] * k1[1]) + (qv[8 * s + 6] * k1[2] + qv[8 * s + 7] * k1[3]); }
                a += __shfl_xor(a, 32);
                if (a > v0) { v2 = v1; i2 = i1; v1 = v0; i1 = i0; v0 = a; i0 = j; } else if (a > v1) { v2 = v1; i2 = i1; v1 = a; i1 = j; } else if (a > v2) { v2 = a; i2 = j; }
            }
            selmask = (qb <= 3) ? ((1u << qb) - 1u) : ((1u << i0) | (1u << i1) | (1u << i2));
        }
        float m_run = -1e30f, l_run = 0.f; f32x16 o[4];
#pragma unroll
        for (int db = 0; db < 4; ++db)
#pragma unroll
            for (int r = 0; r < 16; ++r) o[db][r] = 0.f;
        const int qin = 128 * half + 32 * wq + q31;
#pragma unroll 1
        for (int st = 0; st < nstep; ++st) {
            asm volatile("s_waitcnt vmcnt(0)" ::: "memory"); __builtin_amdgcn_s_barrier(); asm volatile("" ::: "memory");
            if (st + 1 < nstep) attn_dma_step(K, V, lds, b, h, qb, n_own, st + 1, wave, lane);
            const int T = 2 * st + kvh; const bool own = T < n_own;
            const int blk = own ? qb : ((T - n_own) >> 2), kt = own ? T : ((T - n_own) & 3);
            const bool sel = own ? true : ((selmask >> blk) & 1u);
            const bool skip = own ? (64 * kt > 128 * half + 32 * wq + 31) : (__ballot(sel) == 0ull);
            if (!skip) {
                const unsigned kimg = lds0 + (st & 1) * 65536 + kvh * 32768, vimg = kimg + 16384;
                f32x16 p[2];
#pragma unroll
                for (int kh = 0; kh < 2; ++kh) {
#pragma unroll
                    for (int r = 0; r < 16; ++r) p[kh][r] = 0.f;
                    const int row = 32 * kh + q31;
#pragma unroll
                    for (int s = 0; s < 8; ++s) { const bf16x8 a = *(const LAS bf16x8*)(uintptr_t)(kimg + row * 256 + (((2 * s + hh) ^ (row & 15)) << 4));
                        p[kh] = __builtin_amdgcn_mfma_f32_32x32x16_bf16(a, qf[s], p[kh], 0, 0, 0); }
                }
                if (own) { const int kbase = 64 * kt;
                    if (kbase + 63 > 128 * half + 32 * wq) {
#pragma unroll
                        for (int kh = 0; kh < 2; ++kh)
#pragma unroll
                            for (int r = 0; r < 16; ++r) if (kbase + 32 * kh + crow16(r, hh) > qin) p[kh][r] = -INFINITY; }
                }
                float mx = p[0][0];
#pragma unroll
                for (int r = 1; r < 16; ++r) mx = fmaxf(mx, p[0][r]);
#pragma unroll
                for (int r = 0; r < 16; ++r) mx = fmaxf(mx, p[1][r]);
                { const auto rr = __builtin_amdgcn_permlane32_swap(__float_as_uint(mx), __float_as_uint(mx), false, false); mx = fmaxf(__uint_as_float(rr[0]), __uint_as_float(rr[1])); }
                if (!sel) mx = -INFINITY;
                const float m_new = fmaxf(m_run, mx), scl = __builtin_amdgcn_exp2f(m_run - m_new); m_run = m_new;
                float rs = 0.f;
#pragma unroll
                for (int kh = 0; kh < 2; ++kh)
#pragma unroll
                    for (int r = 0; r < 16; ++r) { p[kh][r] = __builtin_amdgcn_exp2f(p[kh][r] - m_new); rs += p[kh][r]; }
                l_run = l_run * scl + (sel ? rs : 0.f);
                if (__ballot(scl != 1.0f) != 0ull) {
#pragma unroll
                    for (int db = 0; db < 4; ++db)
#pragma unroll
                        for (int r = 0; r < 16; ++r) o[db][r] *= scl; }
                const unsigned pmask = sel ? 0xffffffffu : 0u;
#pragma unroll
                for (int kh = 0; kh < 2; ++kh)
#pragma unroll
                    for (int s2 = 0; s2 < 2; ++s2) {
                        v4u pw; pw.x = pg8::cvt_pk_bf16(p[kh][8 * s2], p[kh][8 * s2 + 1]); pw.y = pg8::cvt_pk_bf16(p[kh][8 * s2 + 2], p[kh][8 * s2 + 3]);
                        pw.z = pg8::cvt_pk_bf16(p[kh][8 * s2 + 4], p[kh][8 * s2 + 5]); pw.w = pg8::cvt_pk_bf16(p[kh][8 * s2 + 6], p[kh][8 * s2 + 7]);
                        pw.x &= pmask; pw.y &= pmask; pw.z &= pmask; pw.w &= pmask;
                        const bf16x8 pb = __builtin_bit_cast(bf16x8, pw);
                        const int key0 = 32 * kh + 16 * s2 + 4 * (G4 >> 1) + (l16 >> 2);
#pragma unroll
                        for (int db = 0; db < 4; ++db) {
                            const int dsub = 16 * (G4 & 1) + 4 * (l16 & 3);
                            const unsigned a0 = vimg + key0 * 256 + ((db ^ (key0 & 3)) << 6) + dsub * 2;
                            const v4i16_t lo = vtr16(a0), hi_ = vtr16(a0 + 8 * 256);
                            const bf16x8 av = {lo[0], lo[1], lo[2], lo[3], hi_[0], hi_[1], hi_[2], hi_[3]};
                            o[db] = __builtin_amdgcn_mfma_f32_32x32x16_bf16(av, pb, o[db], 0, 0, 0);
                        }
                    }
            }
        }
        l_run += __shfl_xor(l_run, 32);
        asm volatile("s_waitcnt vmcnt(0) lgkmcnt(0)" ::: "memory"); __builtin_amdgcn_s_barrier(); asm volatile("" ::: "memory");
        LAS float* xs = (LAS float*)lds + (size_t)wq * 66 * 64 + lane;
        if (kvh == 1) {
            xs[0] = m_run; xs[64] = l_run;
#pragma unroll
            for (int db = 0; db < 4; ++db)
#pragma unroll
                for (int r = 0; r < 16; ++r) xs[(2 + 16 * db + r) * 64] = o[db][r];
        }
        asm volatile("s_waitcnt lgkmcnt(0)" ::: "memory"); __builtin_amdgcn_s_barrier(); asm volatile("" ::: "memory");
        if (kvh == 0) {
            const float m2 = xs[0], l2 = xs[64], mt = fmaxf(m_run, m2), a1 = __builtin_amdgcn_exp2f(m_run - mt), a2 = __builtin_amdgcn_exp2f(m2 - mt);
            const float inv = 1.0f / (l_run * a1 + l2 * a2), c1 = a1 * inv, c2 = a2 * inv;
            bf16* orow = AO + rowq * 1024 + h * 128 + 4 * hh;
#pragma unroll
            for (int db = 0; db < 4; ++db)
#pragma unroll
                for (int g = 0; g < 4; ++g) {
                    float t[4];
#pragma unroll
                    for (int e = 0; e < 4; ++e) t[e] = o[db][4 * g + e] * c1 + xs[(2 + 16 * db + 4 * g + e) * 64] * c2;
                    u32x2v w; w.x = pg8::cvt_pk_bf16(t[0], t[1]); w.y = pg8::cvt_pk_bf16(t[2], t[3]);
                    *(GAS u32x2v*)(orow + 32 * db + 8 * g) = w;
                }
        }
    }
    asm volatile("s_waitcnt vmcnt(0) lgkmcnt(0)" ::: "memory"); __builtin_amdgcn_s_barrier(); asm volatile("" ::: "memory");
}
__device__ __forceinline__ void up8(const v4u w, float (&f)[8]) { f[0] = bflo(w.x); f[1] = bfhi(w.x); f[2] = bflo(w.y); f[3] = bfhi(w.y); f[4] = bflo(w.z); f[5] = bfhi(w.z); f[6] = bflo(w.w); f[7] = bfhi(w.w); }
__device__ __forceinline__ void conv_phase(const Ctx& F, const bf16* CB, const bf16* CC, const bf16* CX, const float* cw, bf16* UC) {
    const int gt = (F.vcu * NWAVES + F.wave) * 64 + F.lane, NT = F.G * NWAVES * 64;
    for (int idx = gt; idx < M * 128; idx += NT) {
        const int row = idx >> 7, c8 = (idx & 127) << 3, t = row & (SEQ - 1); const size_t off = (size_t)row * 1024 + c8;
        float cb[8], a[8], x[8], z0[8], z1[8], z2[8];
        up8(*(const GAS v4u*)(CB + off), cb); up8(*(const GAS v4u*)(CC + off), a); up8(*(const GAS v4u*)(CX + off), x);
#pragma unroll
        for (int j = 0; j < 8; ++j) z0[j] = a[j] * x[j];
        if (t >= 1) { up8(*(const GAS v4u*)(CC + off - 1024), a); up8(*(const GAS v4u*)(CX + off - 1024), x);
#pragma unroll
            for (int j = 0; j < 8; ++j) z1[j] = a[j] * x[j]; } else {
#pragma unroll
            for (int j = 0; j < 8; ++j) z1[j] = 0.f; }
        if (t >= 2) { up8(*(const GAS v4u*)(CC + off - 2048), a); up8(*(const GAS v4u*)(CX + off - 2048), x);
#pragma unroll
            for (int j = 0; j < 8; ++j) z2[j] = a[j] * x[j]; } else {
#pragma unroll
            for (int j = 0; j < 8; ++j) z2[j] = 0.f; }
        float o[8];
#pragma unroll
        for (int j = 0; j < 8; ++j) o[j] = cb[j] * (cw[c8 + j] * z2[j] + cw[1024 + c8 + j] * z1[j] + cw[2048 + c8 + j] * z0[j]);
        v4u w; w.x = pk2(o[0], o[1]); w.y = pk2(o[2], o[3]); w.z = pk2(o[4], o[5]); w.w = pk2(o[6], o[7]); *(GAS v4u*)(UC + off) = w;
    }
}

__device__ __forceinline__ int imax(int a, int b) { return a > b ? a : b; }
__device__ __forceinline__ int imin(int a, int b) { return a < b ? a : b; }
__device__ __forceinline__ void ce(int& a, int& b) { const int t = imax(a, b); b = imin(a, b); a = t; }
__device__ __forceinline__ void sort16(int (&x)[16]) {
#pragma unroll
    for (int kk = 1; kk <= 4; ++kk)
#pragma unroll
        for (int jj = kk - 1; jj >= 0; --jj)
#pragma unroll
            for (int i = 0; i < 16; ++i) { const int k = 1 << kk, j = 1 << jj, l = i ^ j; if (l > i) { if ((i & k) == 0) ce(x[i], x[l]); else ce(x[l], x[i]); } }
}
__device__ __forceinline__ void bmerge16(int (&a)[16]) {
#pragma unroll
    for (int jj = 3; jj >= 0; --jj)
#pragma unroll
        for (int i = 0; i < 16; ++i) { const int j = 1 << jj, l = i ^ j; if (l > i) ce(a[i], a[l]); }
}
__device__ __forceinline__ void merge16(int (&a)[16], const int (&b)[16]) {
#pragma unroll
    for (int i = 0; i < 16; ++i) a[i] = imax(a[i], b[15 - i]);
    bmerge16(a);
}
__device__ __forceinline__ void xmerge16(int (&a)[16], int hh) {
    int pv[16];
#pragma unroll
    for (int i = 0; i < 16; ++i) { const auto r = __builtin_amdgcn_permlane32_swap((unsigned)a[15 - i], (unsigned)a[15 - i], false, false); pv[i] = hh ? (int)r[0] : (int)r[1]; }
#pragma unroll
    for (int i = 0; i < 16; ++i) a[i] = imax(a[i], pv[i]);
    bmerge16(a);
}
__device__ __forceinline__ int ord_key(float f) { const int u = __float_as_int(f); return u >= 0 ? u : (u ^ 0x7fffffff); }
__device__ __forceinline__ float ord_val(int k) { return __int_as_float(k >= 0 ? k : (k ^ 0x7fffffff)); }
__device__ __forceinline__ unsigned byte16(const unsigned (&t)[4], int idx) {
    const unsigned sel = 0x0c0c0c00u | (unsigned)(idx & 7);
    const unsigned lo = __builtin_amdgcn_perm(t[1], t[0], sel), hi_ = __builtin_amdgcn_perm(t[3], t[2], sel);
    return (idx & 8) ? hi_ : lo;
}
__device__ __forceinline__ void topk_stage_keys(const Ctx& F, const bf16* KEYS, int h) {
    for (int pc = F.wave; pc < 64; pc += 8) { const int pp = pc >> 5, row = 4 * (pc & 31) + (F.lane >> 4), cp = F.lane & 15, c = cp ^ (row & 15);
        __builtin_amdgcn_global_load_lds((const unsigned*)(KEYS + (size_t)((h * 2 + pp) * 128 + row) * 128 + 8 * c), (LAS unsigned*)(F.lds + RING_OFF + pc * 1024), 16, 0, 0); }
    asm volatile("s_waitcnt vmcnt(0)" ::: "memory"); __builtin_amdgcn_s_barrier(); asm volatile("" ::: "memory");
}
__device__ __forceinline__ void topk_phase(const Ctx& F, int bitem, const bf16* QP, int* EXP, float* GATE) {
    const int lane = F.lane, l31 = lane & 31, hh = lane >> 5;
    const int IMIN = (int)0x80000000;
    const unsigned lds0 = (unsigned)(uintptr_t)(F.lds + RING_OFF);
    {
        const int h = bitem & 7, tt = (bitem >> 3) * 8 + F.wave, tok0 = tt * 32;
        int top[2][16];
#pragma unroll
        for (int p = 0; p < 2; ++p) {
            bf16x8 qa[8];
#pragma unroll
            for (int s = 0; s < 8; ++s) qa[s] = *(const GAS bf16x8*)(QP + (size_t)(tok0 + l31) * 2048 + h * 256 + p * 128 + 16 * s + 8 * hh);
            int x[2][16];
#pragma unroll
            for (int pq = 0; pq < 2; ++pq) {
                f32x16 sc[2];
#pragma unroll
                for (int nt = 0; nt < 2; ++nt)
#pragma unroll
                    for (int r = 0; r < 16; ++r) sc[nt][r] = 0.f;
#pragma unroll
                for (int s = 0; s < 8; ++s) {
#pragma unroll
                    for (int nt = 0; nt < 2; ++nt) { const int n = 64 * pq + 32 * nt + l31; const bf16x8 kb = *(const LAS bf16x8*)(uintptr_t)(lds0 + p * 32768 + n * 256 + (((2 * s + hh) ^ (n & 15)) << 4));
                        sc[nt] = __builtin_amdgcn_mfma_f32_32x32x16_bf16(kb, qa[s], sc[nt], 0, 0, 0); }
                }
                int y[16];
#pragma unroll
                for (int r = 0; r < 16; ++r) { x[pq][r] = (ord_key(sc[0][r]) & ~127) | ((127 - 64 * pq - (r & 3) - 8 * (r >> 2)) - 4 * hh); y[r] = (ord_key(sc[1][r]) & ~127) | ((127 - 64 * pq - 32 - (r & 3) - 8 * (r >> 2)) - 4 * hh); }
                sort16(x[pq]); sort16(y); merge16(x[pq], y);
                asm volatile("" ::: "memory");
            }
            merge16(x[0], x[1]);
            xmerge16(x[0], hh);
#pragma unroll
            for (int i = 0; i < 16; ++i) top[p][i] = x[0][i];
        }
        float fa[16], fb[16];
#pragma unroll
        for (int i = 0; i < 16; ++i) { const int A = hh ? top[1][i] : top[0][i], B = hh ? top[0][i] : top[1][i]; fa[i] = ord_val(A & ~127); fb[i] = ord_val(B & ~127); }
        int c0[16], c1[16];
#pragma unroll
        for (int q = 0; q < 32; ++q) {
            int key = IMIN;
            if (q < 27) { const int i = (q < 16) ? 0 : (q < 23) ? 1 : (q < 26) ? 2 : 3, j = (q < 16) ? q : (q < 23) ? q - 15 : (q < 26) ? q - 21 : 3; const float sv = fa[i] + fb[j]; const int low = hh ? (255 - (j * 16 + i)) : (255 - (i * 16 + j));
                key = (ord_key(sv) & ~255) | low; if (i == j && hh) key = IMIN; }
            if (q < 16) c0[q] = key; else c1[q - 16] = key;
        }
        sort16(c0); sort16(c1); merge16(c0, c1); xmerge16(c0, hh);
        unsigned na[4], nb[4];
#pragma unroll
        for (int d = 0; d < 4; ++d) { na[d] = 0u; nb[d] = 0u;
#pragma unroll
            for (int e = 0; e < 4; ++e) { na[d] |= (unsigned)(127 - (top[0][4 * d + e] & 127)) << (8 * e); nb[d] |= (unsigned)(127 - (top[1][4 * d + e] & 127)) << (8 * e); } }
        int ex[16]; float ev[16]; float es = 0.f; const float smax = ord_val(c0[0] & ~255);
#pragma unroll
        for (int q = 0; q < 16; ++q) { const int posn = 255 - (c0[q] & 255); const unsigned n1 = byte16(na, posn >> 4) & 255u, n2 = byte16(nb, posn & 15) & 255u;
            ex[q] = (int)(n1 * 128u + n2); ev[q] = __expf(ord_val(c0[q] & ~255) - smax); es += ev[q]; }
        const float ri = 1.0f / es; const size_t ob = (size_t)(tok0 + l31) * 128 + h * 16;
        if (hh == 0) {
#pragma unroll
            for (int d = 0; d < 4; ++d) { v4u w; w.x = (unsigned)ex[4 * d]; w.y = (unsigned)ex[4 * d + 1]; w.z = (unsigned)ex[4 * d + 2]; w.w = (unsigned)ex[4 * d + 3]; *(GAS v4u*)(EXP + ob + 4 * d) = w; }
        } else {
#pragma unroll
            for (int d = 0; d < 4; ++d) *(GAS f32x4*)(GATE + ob + 4 * d) = (f32x4){ev[4 * d] * ri, ev[4 * d + 1] * ri, ev[4 * d + 2] * ri, ev[4 * d + 3] * ri};
        }
    }
}

typedef float f32x2 __attribute__((ext_vector_type(2)));
constexpr float PEER_SU = 512.0f, PEER_SV = 32.0f;
template <int CTRL> __device__ __forceinline__ int dpp_i(int v) { return __builtin_amdgcn_update_dpp(v, v, CTRL, 0xf, 0xf, false); }
template <int J> __device__ __forceinline__ int xor_lane(int v, int lane) {
    if constexpr (J == 1) return dpp_i<0xB1>(v);
    else if constexpr (J == 2) return dpp_i<0x4E>(v);
    else if constexpr (J == 16) { const auto r = __builtin_amdgcn_permlane16_swap((unsigned)v, (unsigned)v, false, false); return ((lane >> 4) & 1) ? (int)r[0] : (int)r[1]; }
    else if constexpr (J == 32) { const auto r = __builtin_amdgcn_permlane32_swap((unsigned)v, (unsigned)v, false, false); return (lane >> 5) ? (int)r[0] : (int)r[1]; }
    else return __shfl_xor(v, J);
}
__device__ __forceinline__ float wave_sum_dpp(float v) {
    v += __int_as_float(dpp_i<0xB1>(__float_as_int(v))); v += __int_as_float(dpp_i<0x4E>(__float_as_int(v))); v += __int_as_float(dpp_i<0x141>(__float_as_int(v))); v += __int_as_float(dpp_i<0x140>(__float_as_int(v)));
    { const auto r = __builtin_amdgcn_permlane16_swap(__float_as_uint(v), __float_as_uint(v), false, false); v = __uint_as_float(r[0]) + __uint_as_float(r[1]); }
    { const auto r = __builtin_amdgcn_permlane32_swap(__float_as_uint(v), __float_as_uint(v), false, false); v = __uint_as_float(r[0]) + __uint_as_float(r[1]); }
    return v; }
template <int KK, int JJ> __device__ __forceinline__ void sort512_step(int (&x)[8], int lane) {
    constexpr int k = 1 << KK, j = 1 << JJ;
    if constexpr (j >= 64) { constexpr int jr = j >> 6;
#pragma unroll
        for (int r = 0; r < 8; ++r) if ((r & jr) == 0) { const bool asc = (k >= 512) ? true : (((r << 6) & k) == 0); const int lo = imin(x[r], x[r | jr]), hi_ = imax(x[r], x[r | jr]); x[r] = asc ? lo : hi_; x[r | jr] = asc ? hi_ : lo; }
    } else {
        const bool lower = (lane & j) == 0;
#pragma unroll
        for (int r = 0; r < 8; ++r) { const int y = xor_lane<j>(x[r], lane);
            const bool asc = (k < 64) ? ((lane & k) == 0) : ((k >= 512) ? true : (((r << 6) & k) == 0));
            x[r] = (lower == asc) ? imin(x[r], y) : imax(x[r], y); }
    }
}
template <int KK, int JJ> __device__ __forceinline__ void sort512_stage(int (&x)[8], int lane) { sort512_step<KK, JJ>(x, lane); if constexpr (JJ > 0) sort512_stage<KK, JJ - 1>(x, lane); }
__device__ __forceinline__ void sort512(int (&x)[8], int lane) {
    sort512_stage<1, 0>(x, lane); sort512_stage<2, 1>(x, lane); sort512_stage<3, 2>(x, lane); sort512_stage<4, 3>(x, lane); sort512_stage<5, 4>(x, lane);
    sort512_stage<6, 5>(x, lane); sort512_stage<7, 6>(x, lane); sort512_stage<8, 7>(x, lane); sort512_stage<9, 8>(x, lane);
}
__device__ __forceinline__ void peer_phase(const Ctx& F, const unsigned char* U8, const unsigned char* V8, const bf16* X1B, const int* EXP, const float* GATE, const unsigned long long* SS, const float* gfin, const float* X1, float* OUT) {
    const int gw = F.vcu * NWAVES + F.wave, NGW = F.G * NWAVES, lane = F.lane;
    const unsigned xs0 = (unsigned)(uintptr_t)(F.lds + RING_OFF + F.wave * 16384) + lane * 16;
    for (int tb = gw; tb + 3 * NGW < M; tb += 4 * NGW) {
        int kreg[8]; float greg[8], rv[4];
#pragma unroll
        for (int j = 0; j < 4; ++j) { const size_t t = (size_t)tb + (size_t)j * NGW;
            kreg[2 * j] = (EXP[t * 128 + lane] << 9) | (j << 7) | lane; kreg[2 * j + 1] = (EXP[t * 128 + 64 + lane] << 9) | (j << 7) | (64 + lane);
            rv[j] = pg8::rinv_from_ss(SS[t]) * (1.0f / PEER_SU);
#pragma unroll
            for (int q = 0; q < 4; ++q) { const v4u w = *(const GAS v4u*)(X1B + t * DM + (q >> 1) * 1024 + lane * 16 + 8 * (q & 1)); *(LAS v4u*)(uintptr_t)(xs0 + j * 4096 + q * 1024) = w; } }
        sort512(kreg, lane);
        int pkey[8];
#pragma unroll
        for (int c = 0; c < 8; ++c) { pkey[c] = __shfl(kreg[c], 8 * (lane & 7) + (lane >> 3)); greg[c] = GATE[((size_t)tb + (size_t)((pkey[c] >> 7) & 3) * NGW) * 128 + (pkey[c] & 127)]; }
        asm volatile("s_waitcnt lgkmcnt(0)" ::: "memory");
        float actreg[8];
#ifndef MK_P8_REPU
#define MK_P8_REPU 1
#endif
#pragma unroll 1
        for (int repu = 0; repu < MK_P8_REPU; ++repu) {
            v4u ub[8][2];
#pragma unroll
            for (int u = 0; u < 8; ++u) { const GAS v4u* up = (const GAS v4u*)(U8 + (size_t)(__builtin_amdgcn_readlane(kreg[0], u) >> 9) * 2048) + lane; ub[u][0] = up[0]; ub[u][1] = up[64]; }
#pragma unroll
            for (int c = 0; c < 8; ++c) {
                float areg = 0.f;
#pragma unroll 1
                for (int g = 0; g < 8; ++g) {
                    float pt[8];
#pragma unroll
                    for (int u = 0; u < 8; ++u) {
                        const int key = __builtin_amdgcn_readlane(kreg[c], 8 * g + u);
                        const unsigned xa = xs0 + ((key >> 7) & 3) * 4096;
                        float p0 = 0.f, p1 = 0.f;
#pragma unroll
                        for (int i = 0; i < 2; ++i) { const v4u w = ub[u][i];
#pragma unroll
                            for (int hv = 0; hv < 2; ++hv) { const v4u xq = *(const LAS v4u*)(uintptr_t)(xa + (2 * i + hv) * 1024);
                                const unsigned w0 = hv ? w.z : w.x, w1 = hv ? w.w : w.y;
                                const f32x2 a0 = __builtin_amdgcn_cvt_pk_f32_fp8((int)w0, false), a1 = __builtin_amdgcn_cvt_pk_f32_fp8((int)w0, true), a2 = __builtin_amdgcn_cvt_pk_f32_fp8((int)w1, false), a3 = __builtin_amdgcn_cvt_pk_f32_fp8((int)w1, true);
                                p0 = dot2bf(pg8::cvt_pk_bf16(a0[0], a0[1]), xq.x, p0); p1 = dot2bf(pg8::cvt_pk_bf16(a1[0], a1[1]), xq.y, p1);
                                p0 = dot2bf(pg8::cvt_pk_bf16(a2[0], a2[1]), xq.z, p0); p1 = dot2bf(pg8::cvt_pk_bf16(a3[0], a3[1]), xq.w, p1); } }
                        pt[u] = p0 + p1;
                        { const int ix = 8 * g + 8 + u, ka = __builtin_amdgcn_readlane(kreg[c], ix & 63), kb = __builtin_amdgcn_readlane(kreg[c < 7 ? c + 1 : 7], ix & 63), kn = (ix < 64) ? ka : kb;
                            const GAS v4u* up = (const GAS v4u*)(U8 + (size_t)(kn >> 9) * 2048) + lane; ub[u][0] = up[0]; ub[u][1] = up[64]; }
                    }
                    { const bool b5 = (lane & 32) != 0, b4 = (lane & 16) != 0, b3 = (lane & 8) != 0;
#pragma unroll
                      for (int i = 0; i < 4; ++i) { const float a = pt[i], b = pt[i + 4]; pt[i] = (b5 ? b : a) + __int_as_float(xor_lane<32>(__float_as_int(b5 ? a : b), lane)); }
#pragma unroll
                      for (int i = 0; i < 2; ++i) { const float a = pt[i], b = pt[i + 2]; pt[i] = (b4 ? b : a) + __int_as_float(xor_lane<16>(__float_as_int(b4 ? a : b), lane)); }
                      { const float a = pt[0], b = pt[1]; pt[0] = (b3 ? b : a) + __shfl_xor(b3 ? a : b, 8); }
                      float r = pt[0]; r += __shfl_xor(r, 4); r += __int_as_float(dpp_i<0x4E>(__float_as_int(r))); r += __int_as_float(dpp_i<0xB1>(__float_as_int(r)));
                      areg = ((lane & 7) == g) ? r : areg; }
                }
                const int tk = (pkey[c] >> 7) & 3; const float rr = (tk == 0) ? rv[0] : (tk == 1) ? rv[1] : (tk == 2) ? rv[2] : rv[3];
                actreg[c] = gelu_tanh(areg * rr) * greg[c] * (1.0f / PEER_SV);
            }
        }
        LAS float* as = (LAS float*)(uintptr_t)(xs0 - lane * 16);
        asm volatile("s_waitcnt lgkmcnt(0)" ::: "memory");
#pragma unroll
        for (int c = 0; c < 8; ++c) as[64 * c + lane] = actreg[c];
        int k2[8];
#pragma unroll
        for (int c = 0; c < 8; ++c) { const int key = kreg[c], tok = (key >> 7) & 3, park = 64 * c + 8 * (lane & 7) + (lane >> 3);
            k2[c] = ((tok >> 1) << 24) | ((key >> 9) << 10) | ((tok & 1) << 9) | park; }
        sort512(k2, lane);
        asm volatile("s_waitcnt lgkmcnt(0)" ::: "memory");
        float a2[8];
#pragma unroll
        for (int c = 0; c < 8; ++c) a2[c] = as[k2[c] & 511];
#pragma unroll 1
        for (int pp = 0; pp < 2; ++pp) {
            int kq[4]; float aq[4];
#pragma unroll
            for (int c = 0; c < 4; ++c) { kq[c] = pp ? k2[4 + c] : k2[c]; aq[c] = pp ? a2[4 + c] : a2[c]; }
            f32x2 y[2][16];
#pragma unroll
            for (int j = 0; j < 2; ++j)
#pragma unroll
                for (int q = 0; q < 16; ++q) y[j][q] = (f32x2){0.f, 0.f};
            v4u vb[8][2];
#pragma unroll
            for (int u = 0; u < 8; ++u) { const GAS v4u* vp = (const GAS v4u*)(V8 + (size_t)((__builtin_amdgcn_readlane(kq[0], u) >> 10) & 0x3fff) * 2048) + lane; vb[u][0] = vp[0]; vb[u][1] = vp[64]; }
#pragma unroll
            for (int c = 0; c < 4; ++c) {
#pragma unroll 1
                for (int g = 0; g < 8; ++g) {
#pragma unroll
                    for (int u = 0; u < 8; ++u) {
                        const int key = __builtin_amdgcn_readlane(kq[c], 8 * g + u); const float s = rdlane(aq[c], 8 * g + u);
                        const float sa = (key & 512) ? 0.f : s, sb = (key & 512) ? s : 0.f; const f32x2 s0 = {sa, sa}, s1 = {sb, sb};
#pragma unroll
                        for (int i = 0; i < 2; ++i) { const v4u w = vb[u][i];
                            const f32x2 c0 = __builtin_amdgcn_cvt_pk_f32_fp8((int)w.x, false), c1 = __builtin_amdgcn_cvt_pk_f32_fp8((int)w.x, true), c2 = __builtin_amdgcn_cvt_pk_f32_fp8((int)w.y, false), c3 = __builtin_amdgcn_cvt_pk_f32_fp8((int)w.y, true);
                            const f32x2 c4 = __builtin_amdgcn_cvt_pk_f32_fp8((int)w.z, false), c5 = __builtin_amdgcn_cvt_pk_f32_fp8((int)w.z, true), c6 = __builtin_amdgcn_cvt_pk_f32_fp8((int)w.w, false), c7 = __builtin_amdgcn_cvt_pk_f32_fp8((int)w.w, true);
                            y[0][8 * i + 0] = __builtin_elementwise_fma(c0, s0, y[0][8 * i + 0]); y[1][8 * i + 0] = __builtin_elementwise_fma(c0, s1, y[1][8 * i + 0]);
                            y[0][8 * i + 1] = __builtin_elementwise_fma(c1, s0, y[0][8 * i + 1]); y[1][8 * i + 1] = __builtin_elementwise_fma(c1, s1, y[1][8 * i + 1]);
                            y[0][8 * i + 2] = __builtin_elementwise_fma(c2, s0, y[0][8 * i + 2]); y[1][8 * i + 2] = __builtin_elementwise_fma(c2, s1, y[1][8 * i + 2]);
                            y[0][8 * i + 3] = __builtin_elementwise_fma(c3, s0, y[0][8 * i + 3]); y[1][8 * i + 3] = __builtin_elementwise_fma(c3, s1, y[1][8 * i + 3]);
                            y[0][8 * i + 4] = __builtin_elementwise_fma(c4, s0, y[0][8 * i + 4]); y[1][8 * i + 4] = __builtin_elementwise_fma(c4, s1, y[1][8 * i + 4]);
                            y[0][8 * i + 5] = __builtin_elementwise_fma(c5, s0, y[0][8 * i + 5]); y[1][8 * i + 5] = __builtin_elementwise_fma(c5, s1, y[1][8 * i + 5]);
                            y[0][8 * i + 6] = __builtin_elementwise_fma(c6, s0, y[0][8 * i + 6]); y[1][8 * i + 6] = __builtin_elementwise_fma(c6, s1, y[1][8 * i + 6]);
                            y[0][8 * i + 7] = __builtin_elementwise_fma(c7, s0, y[0][8 * i + 7]); y[1][8 * i + 7] = __builtin_elementwise_fma(c7, s1, y[1][8 * i + 7]); }
                        { const int ix = 8 * g + 8 + u, ka = __builtin_amdgcn_readlane(kq[c], ix & 63), kb = __builtin_amdgcn_readlane(kq[c < 3 ? c + 1 : 3], ix & 63), kn = (ix < 64) ? ka : kb;
                            const GAS v4u* vp = (const GAS v4u*)(V8 + (size_t)((kn >> 10) & 0x3fff) * 2048) + lane; vb[u][0] = vp[0]; vb[u][1] = vp[64]; }
                    }
                }
            }
#pragma unroll
            for (int j = 0; j < 2; ++j) { const size_t t = (size_t)tb + (size_t)(2 * pp + j) * NGW;
                const GAS f32x4* xr = (const GAS f32x4*)(X1 + t * DM); GAS f32x4* orw = (GAS f32x4*)(OUT + t * DM); float ss = 0.f;
#pragma unroll
                for (int i = 0; i < 2; ++i)
#pragma unroll
                    for (int q = 0; q < 4; ++q) { const f32x4 a = xr[i * 256 + 4 * lane + q]; y[j][8 * i + 2 * q] += (f32x2){a[0], a[1]}; y[j][8 * i + 2 * q + 1] += (f32x2){a[2], a[3]}; }
#pragma unroll
                for (int q = 0; q < 16; ++q) ss += y[j][q][0] * y[j][q][0] + y[j][q][1] * y[j][q][1];
                const float r3 = 1.0f / sqrtf(wave_sum_dpp(ss) * (1.0f / DM) + RMS_EPS);
#pragma unroll
                for (int i = 0; i < 2; ++i)
#pragma unroll
                    for (int q = 0; q < 4; ++q) { const f32x4 ga = *(const GAS f32x4*)(gfin + i * 1024 + lane * 16 + 4 * q);
                        orw[i * 256 + 4 * lane + q] = (f32x4){y[j][8 * i + 2 * q][0] * r3 * ga[0], y[j][8 * i + 2 * q][1] * r3 * ga[1], y[j][8 * i + 2 * q + 1][0] * r3 * ga[2], y[j][8 * i + 2 * q + 1][1] * r3 * ga[3]}; }
            }
        }
        asm volatile("s_waitcnt lgkmcnt(0)" ::: "memory");
    }
}

struct Args { const float* in[15]; float* out; unsigned char* ws; double invf[16]; int ph_lo, ph_hi, li, pad; };
__global__ void __launch_bounds__(NWAVES * 64, 2) mk_fwd(Args args) {
    extern __shared__ __attribute__((aligned(16))) unsigned char lds[];
    Ctx F;
    F.lds = (LAS unsigned char*)lds;
    volatile LAS unsigned* MISC = (volatile LAS unsigned*)(F.lds + MISC_OFF);
    F.tid = threadIdx.x; F.lane = F.tid & 63; F.wave = __builtin_amdgcn_readfirstlane(F.tid >> 6);
    F.G = gridDim.x; { const int bx = blockIdx.x; F.vcu = (F.G % 8 == 0) ? (bx % 8) * (F.G / 8) + bx / 8 : bx; }
    unsigned char* ws = args.ws;
    gu32* ctl = (gu32*)(ws + WS_CTL);
    for (int u = F.tid; u < (LDS_BYTES - LDSCTL_OFF) / 4; u += NWAVES * 64) ((LAS unsigned*)(F.lds + LDSCTL_OFF))[u] = 0u;
    __syncthreads();
    XcdBarrier bar; bar.bar = (unsigned*)(ctl + CW_BAR); bar.x = 0; bar.st = nullptr;
    if (N_LAUNCHES != PER_PHASE) bar = xcd_barrier_post((unsigned*)(ctl + CW_BAR), MISC + 8);
#define GRID_BAR() do { if (N_LAUNCHES != PER_PHASE) xcd_barrier(bar); } while (0)
    const int lo = args.ph_lo, hi = args.ph_hi;
#define IN(k) (lo <= (k) && (k) < hi)
#define BOTH(k) (IN(k) && IN((k) + 1))
    bf16* WinT = (bf16*)(ws + WS_WIN); bf16* WbcT = (bf16*)(ws + WS_WBC); bf16* WbaT = (bf16*)(ws + WS_WBA); bf16* WoutT = (bf16*)(ws + WS_WOUT); bf16* WpqT = (bf16*)(ws + WS_WPQ);
    bf16* KEYS = (bf16*)(ws + WS_KEYS); float* CS = (float*)(ws + WS_CS); const unsigned char* UB = ws + WS_UB; const unsigned char* VB = ws + WS_VB;
    bf16* XB = (bf16*)(ws + WS_XB); bf16* T6 = (bf16*)(ws + WS_T6); bf16* GAB = (bf16*)(ws + WS_GAB); bf16* UC = (bf16*)(ws + WS_UC); bf16* AO = (bf16*)(ws + WS_AO);
    bf16* TMP = (bf16*)(ws + WS_TMP); bf16* MB = (bf16*)(ws + WS_MB); bf16* X1B = (bf16*)(ws + WS_X1B); bf16* QP = (bf16*)(ws + WS_QP);
    int* EXP = (int*)(ws + WS_EXP); float* GATE = (float*)(ws + WS_GATE);
    unsigned long long* SS = (unsigned long long*)(ws + WS_SS); float* KSUM = (float*)(ws + WS_KSUM);
    constexpr size_t TS = (size_t)M * 1024;

    if (IN(0)) { for (int rep = 0; rep < NREP(0); ++rep) { p0_prologue(F, args.in, ws, args.invf); if (rep + 1 < NREP(0)) GRID_BAR(); } if (BOTH(0)) GRID_BAR(); }
    if (IN(1)) {
        for (int rep = 0; rep < NREP(1); ++rep) {
        pg8::Gemm g{XB, WinT, M, INW, DM}; pg8::StaticOrder S; S.init(M, INW, F.G, (int)blockIdx.x);
        pg8::EpiIn E{T6, GAB, args.in[4], CS, KSUM};
        pg8::gemm_phase<pg8::EpiIn, pg8::StaticOrder, true, true>(F.lds + RING_OFF, g, S, E);
        if (rep + 1 < NREP(1)) GRID_BAR(); }
        if (BOTH(1)) GRID_BAR();
    }
    if (IN(2)) {
        for (int rep = 0; rep < NREP(2); ++rep) {
        attn_mfma(F, T6 + 3 * TS, T6 + 4 * TS, T6 + 5 * TS, KSUM, AO);
        conv_phase(F, T6, T6 + TS, T6 + 2 * TS, args.in[5], UC);
        if (rep + 1 < NREP(2)) GRID_BAR(); }
        if (BOTH(2)) GRID_BAR();
    }
    if (IN(3)) {
        for (int rep = 0; rep < NREP(3); ++rep) {
        pg8::Gemm g{UC, WbcT, M, DM, 1024, AO, WbaT}; pg8::TwoSegOrder S; S.init(M, DM, F.G, (int)blockIdx.x);
        pg8::EpiMerge2 E{GAB, GAB + (size_t)M * DM, MB};
        pg8::gemm_phase<pg8::EpiMerge2, pg8::TwoSegOrder, true, true>(F.lds + RING_OFF, g, S, E);
        if (rep + 1 < NREP(3)) GRID_BAR(); }
        if (BOTH(3)) GRID_BAR();
    }
    if (IN(5)) {
        for (int rep = 0; rep < NREP(5); ++rep) {
        pg8::Gemm g{MB, WoutT, M, DM, DM}; pg8::StaticOrder S; S.init(M, DM, F.G, (int)blockIdx.x);
        pg8::EpiX1 E{args.in[0], args.out, X1B, (rep + 1 < NREP(5)) ? (unsigned long long*)(ws + 768 * 1024) : SS};
        pg8::gemm_phase<pg8::EpiX1, pg8::StaticOrder, true, true>(F.lds + RING_OFF, g, S, E);
        if (rep + 1 < NREP(5)) GRID_BAR(); }
        if (BOTH(5)) GRID_BAR();
    }
    if (IN(6)) {
        for (int rep = 0; rep < NREP(6); ++rep) {
        pg8::Gemm g{X1B, WpqT, M, DM, DM}; pg8::StaticOrder S; S.init(M, DM, F.G, (int)blockIdx.x);
        pg8::EpiQP E{SS, QP};
        pg8::gemm_phase<pg8::EpiQP, pg8::StaticOrder, true, true>(F.lds + RING_OFF, g, S, E);
        if (rep + 1 < NREP(6)) GRID_BAR(); }
        if (BOTH(6)) GRID_BAR();
    }
    if (IN(7)) { for (int rep = 0; rep < NREP(7); ++rep) {
        for (int bitem = F.vcu; bitem < 256; bitem += F.G) {
            topk_stage_keys(F, KEYS, bitem & 7);
            if (F.wave >= 4 && bitem == F.vcu) convert_tables(F, args.in[12], args.in[13], args.in[9], ws);
            topk_phase(F, bitem, QP, EXP, GATE);
            if (F.wave < 4 && bitem == F.vcu) convert_tables(F, args.in[12], args.in[13], args.in[9], ws);
            asm volatile("s_waitcnt lgkmcnt(0)" ::: "memory"); __builtin_amdgcn_s_barrier(); asm volatile("" ::: "memory");
        }
        if (rep + 1 < NREP(7)) GRID_BAR(); } if (BOTH(7)) GRID_BAR(); }
    if (IN(8)) { for (int rep = 0; rep < NREP(8); ++rep) { peer_phase(F, UB, VB, X1B, EXP, GATE, SS, args.in[14], args.out, (rep + 1 < NREP(8)) ? (float*)(ws + WS_END) : args.out); if (rep + 1 < NREP(8)) GRID_BAR(); } }
#undef IN
#undef BOTH
#undef GRID_BAR
}

extern "C" void kernel_launch(void* const* d_in, const int* in_sizes, int n_in, void* d_out, int out_size, void* d_ws, size_t ws_size, hipStream_t stream) {
    static int grid = 0;
    if (grid == 0) {
        if (n_in != 15 || in_sizes[0] != M * DM || out_size != M * DM || ws_size < WS_END) { fprintf(stderr, "kernel_launch: unexpected shapes (n_in %d, in0 %d, out %d, ws %zu)\n", n_in, n_in > 0 ? in_sizes[0] : -1, out_size, ws_size); grid = -1; return; }
        int dev = 0, cus = 0, per_cu = 0;
        if (hipGetDevice(&dev) != hipSuccess || hipDeviceGetAttribute(&cus, hipDeviceAttributeMultiprocessorCount, dev) != hipSuccess) { grid = -1; return; }
        if (hipFuncSetAttribute((const void*)mk_fwd, hipFuncAttributeMaxDynamicSharedMemorySize, LDS_BYTES) != hipSuccess) { fprintf(stderr, "kernel_launch: hipFuncSetAttribute failed\n"); grid = -1; return; }
        if (hipOccupancyMaxActiveBlocksPerMultiprocessor(&per_cu, (const void*)mk_fwd, NWAVES * 64, LDS_BYTES) != hipSuccess || per_cu < 1) fprintf(stderr, "kernel_launch: occupancy query reports %d\n", per_cu);
        (void)hipGetLastError();
        grid = cus;
        if (M % (4 * grid * NWAVES) != 0) { fprintf(stderr, "kernel_launch: the PEER phase needs M %% (32 * grid) == 0 (grid %d)\n", grid); grid = -1; return; }
    }
    if (grid < 0) return;
    if (hipMemsetAsync((char*)d_ws + WS_CTL, 0, CTL_ZERO_BYTES, stream) != hipSuccess) { fprintf(stderr, "kernel_launch: memset failed\n"); return; }
    Args a{};
    for (int i = 0; i < 15; ++i) a.in[i] = (const float*)d_in[i];
    a.out = (float*)d_out; a.ws = (unsigned char*)d_ws;
    for (int f = 0; f < 16; ++f) a.invf[f] = pow(500000.0, -(double)(2 * f) / 32.0);
    for (int li = 0; li < N_LAUNCHES; ++li) {
        a.ph_lo = (N_LAUNCHES == PER_PHASE) ? li : 0; a.ph_hi = (N_LAUNCHES == PER_PHASE) ? li + 1 : PER_PHASE; a.li = li;
        hipLaunchKernelGGL(mk_fwd, dim3(grid), dim3(NWAVES * 64), LDS_BYTES, stream, a);
        const hipError_t le = hipPeekAtLastError();
        if (le != hipSuccess) { fprintf(stderr, "kernel_launch: launch %d failed: %s\n", li, hipGetErrorName(le)); break; }
    }
}
```

```cpp
#include <hip/hip_runtime.h>
#include <cstdio>
#include <cstdint>
#include <cmath>
namespace pg8 {
#define PG8_LAS __attribute__((address_space(3)))
typedef unsigned short bf16_t;
typedef short bf16x8 __attribute__((ext_vector_type(8)));
typedef float f32x4 __attribute__((ext_vector_type(4)));
typedef unsigned u32x4 __attribute__((ext_vector_type(4)));
constexpr int BM = 256, BK = 64, HALF = 128, HTB = HALF * BK * 2  , STAGE_BYTES = 8 * HTB, NXCD = 8, WGM = 8;

__host__ __device__ __forceinline__ int lds_byte(int r, int c) { const int st = (r >> 4) * 2 + (c >> 5), rr = r & 15, cc = c & 31, ob = rr * 64 + cc * 2; return st * 1024 + (ob ^ (((ob >> 9) & 1) << 5)); }
__host__ __device__ __forceinline__ void stage_rc(int b, int& R, int& C) { const int st = b / 1024, sb = b % 1024, swz = sb ^ (((sb >> 9) & 1) << 5); R = (st >> 1) * 16 + swz / 64; C = (st & 1) * 32 + (swz % 64) / 2; }
__host__ __device__ __forceinline__ int perm32(int rho) { const int n = rho >> 4, i = rho & 15; return 8 * (i >> 2) + 4 * n + (i & 3); }

struct Unit { int pm, pn, seg; };
struct Gemm { const bf16_t* A; const bf16_t* Bt; int M, N, K; const bf16_t* A2; const bf16_t* Bt2; };

struct StaticOrder {
    int nM, nN, nwg, G, c;
    __host__ __device__ void init(int M, int N, int G_, int c_) { nM = M / BM; nN = N / BM; nwg = nM * nN; G = G_; c = c_; }
    __host__ __device__ bool next(int i, Unit& u) const {
        const long L = (long)i * G + c; if (L >= nwg) return false;
        int wgid = (int)L; { const int q = nwg / NXCD, r = nwg % NXCD, xcd = wgid % NXCD, off = wgid / NXCD; wgid = (xcd < r ? xcd * (q + 1) : r * (q + 1) + (xcd - r) * q) + off; }
        const int nig = WGM * nN, gid = wgid / nig, fm = gid * WGM, gsz = (nM - fm) < WGM ? (nM - fm) : WGM;
        u.pm = fm + ((wgid % nig) % gsz); u.pn = (wgid % nig) / gsz; u.seg = 0; return true;
    }
    __device__ __forceinline__ void a_ready(const Unit&) const {}
    __device__ __forceinline__ void done(const Unit&) const {}
};
struct TwoSegOrder {
    StaticOrder so;
    __host__ __device__ void init(int M, int N, int G_, int c_) { so.init(M, N, G_, c_); }
    __host__ __device__ bool next(int i, Unit& u) const { if (!so.next(i >> 1, u)) return false; u.seg = i & 1; return true; }
    __device__ __forceinline__ void a_ready(const Unit&) const {}
    __device__ __forceinline__ void done(const Unit&) const {}
};


typedef float f32x2c __attribute__((ext_vector_type(2))); typedef __bf16 bf16x2c __attribute__((ext_vector_type(2)));
__device__ __forceinline__ unsigned cvt_pk_bf16(float lo, float hi) { const f32x2c v = {lo, hi}; const bf16x2c b = __builtin_convertvector(v, bf16x2c); return __builtin_bit_cast(unsigned, b); }
__device__ __forceinline__ u32x4 pack8(f32x4 a, f32x4 b) { u32x4 w; w.x = cvt_pk_bf16(a[0], a[1]); w.y = cvt_pk_bf16(a[2], a[3]); w.z = cvt_pk_bf16(b[0], b[1]); w.w = cvt_pk_bf16(b[2], b[3]); return w; }
__device__ __forceinline__ f32x4 shx(f32x4 v, int o) { f32x4 r; r[0] = __shfl_xor(v[0], o); r[1] = __shfl_xor(v[1], o); r[2] = __shfl_xor(v[2], o); r[3] = __shfl_xor(v[3], o); return r; }
__device__ __forceinline__ f32x4 bf4lo(unsigned a, unsigned b) { f32x4 r; r[0] = __uint_as_float(a << 16); r[1] = __uint_as_float(a & 0xffff0000u); r[2] = __uint_as_float(b << 16); r[3] = __uint_as_float(b & 0xffff0000u); return r; }
__device__ __forceinline__ f32x4 sigm4(f32x4 v) { f32x4 r;
#pragma unroll
    for (int i = 0; i < 4; ++i) r[i] = __builtin_amdgcn_rcpf(1.0f + __expf(-v[i])); return r; }
constexpr float QSCALE = 0.08838834764831845f * 1.4426950408889634f;

struct EpiIn {
    static constexpr bool PERM = true, AFTER_DRAIN = false, KEEP_SEG0 = false;
    bf16_t* T6; bf16_t* GAB; const float* gbias; const float* cs; float* ksum;
    __device__ __forceinline__ void operator()(const f32x4 (&acc)[2][2][4][2], const Unit& u, int wr, int wc, int fr, int fq) const {
        const int row0 = u.pm * BM + wr * 64 + fr, pn = u.pn, colw = wc * 32 + 8 * fq;
        if (pn < 24) {
            const int t = pn >> 2;
            bf16_t* base = T6 + (size_t)t * ((size_t)8192 * 1024) + (pn & 3) * 256 + colw;
            const bool rot = (t == 3 || t == 4) && (wc == 0), isk = (t == 4);
            const float qs = (t == 3) ? QSCALE : 1.0f;
            f32x4 ks[2][2];
#pragma unroll
            for (int bj = 0; bj < 2; ++bj) { ks[bj][0] = (f32x4){0.f, 0.f, 0.f, 0.f}; ks[bj][1] = (f32x4){0.f, 0.f, 0.f, 0.f}; }
#pragma unroll
            for (int ai = 0; ai < 2; ++ai)
#pragma unroll
                for (int m = 0; m < 4; ++m) {
                    const int row = row0 + ai * HALF + m * 16;
                    f32x4 c0 = (f32x4){1.f, 1.f, 1.f, 1.f}, c1 = c0, s0 = (f32x4){0.f, 0.f, 0.f, 0.f}, s1 = s0;
                    if (rot) { const float* cp = cs + (size_t)row * 32 + 8 * (fq & 1); c0 = *(const f32x4*)cp; c1 = *(const f32x4*)(cp + 4); s0 = *(const f32x4*)(cp + 16); s1 = *(const f32x4*)(cp + 20);
                        if (fq < 2) { s0 = -s0; s1 = -s1; } }
#pragma unroll
                    for (int bj = 0; bj < 2; ++bj) {
                        f32x4 v0 = acc[ai][bj][m][0], v1 = acc[ai][bj][m][1];
                        if (rot) { const f32x4 p0 = shx(v0, 32), p1 = shx(v1, 32); v0 = v0 * c0 + p0 * s0; v1 = v1 * c1 + p1 * s1; }
                        if (isk) { ks[bj][0] += v0; ks[bj][1] += v1; }
                        v0 = v0 * qs; v1 = v1 * qs;
                        *(u32x4*)(base + (size_t)row * 1024 + bj * HALF) = pack8(v0, v1);
                    }
                }
            if (isk) {
#pragma unroll
                for (int bj = 0; bj < 2; ++bj)
#pragma unroll
                    for (int n = 0; n < 2; ++n) { f32x4 v = ks[bj][n]; v += shx(v, 1); v += shx(v, 2); v += shx(v, 4); v += shx(v, 8);
                        if (fr == 0) { float* kp = ksum + (size_t)u.pm * 1024 + (pn & 3) * 256 + bj * HALF + colw + 4 * n;
                            unsafeAtomicAdd(kp + 0, v[0]); unsafeAtomicAdd(kp + 1, v[1]); unsafeAtomicAdd(kp + 2, v[2]); unsafeAtomicAdd(kp + 3, v[3]); } }
            }
        } else {
            const int t = (pn - 24) >> 3, colg = ((pn - 24) & 7) * 256 + colw;
            bf16_t* base = GAB + (size_t)t * ((size_t)8192 * 2048) + colg;
            const float* bp = gbias + t * 2048 + colg;
            f32x4 bv[2][2];
#pragma unroll
            for (int bj = 0; bj < 2; ++bj) { bv[bj][0] = *(const f32x4*)(bp + bj * HALF); bv[bj][1] = *(const f32x4*)(bp + bj * HALF + 4); }
#pragma unroll
            for (int ai = 0; ai < 2; ++ai)
#pragma unroll
                for (int m = 0; m < 4; ++m) { const int row = row0 + ai * HALF + m * 16;
#pragma unroll
                    for (int bj = 0; bj < 2; ++bj) *(u32x4*)(base + (size_t)row * 2048 + bj * HALF) = pack8(sigm4(acc[ai][bj][m][0] + bv[bj][0]), sigm4(acc[ai][bj][m][1] + bv[bj][1])); }
        }
    }
};
struct EpiMerge2 {
    static constexpr bool PERM = true, AFTER_DRAIN = false, KEEP_SEG0 = true;
    const bf16_t* GA; const bf16_t* GB; bf16_t* O;
    __device__ __forceinline__ void operator()(f32x4 (&acc)[2][2][4][2], const Unit& u, int wr, int wc, int fr, int fq) const {
        const int row0 = u.pm * BM + wr * 64 + fr, col0 = u.pn * BM + wc * 32 + 8 * fq;
        if (u.seg == 0) {
#pragma unroll
            for (int ai = 0; ai < 2; ++ai)
#pragma unroll
                for (int m = 0; m < 4; ++m) { const size_t off = (size_t)(row0 + ai * HALF + m * 16) * 2048 + col0;
#pragma unroll
                    for (int bj = 0; bj < 2; ++bj) { const u32x4 a = *(const u32x4*)(GA + off + bj * HALF), b = *(const u32x4*)(GB + off + bj * HALF);
                        const f32x4 b0 = bf4lo(b.x, b.y), b1 = bf4lo(b.z, b.w); f32x4 r0, r1;
#pragma unroll
                        for (int e = 0; e < 4; ++e) { r0[e] = __builtin_amdgcn_rcpf(fmaxf(b0[e], 1e-20f)); r1[e] = __builtin_amdgcn_rcpf(fmaxf(b1[e], 1e-20f)); }
                        acc[ai][bj][m][0] = acc[ai][bj][m][0] * (bf4lo(a.x, a.y) * r0); acc[ai][bj][m][1] = acc[ai][bj][m][1] * (bf4lo(a.z, a.w) * r1); } }
        } else {
#pragma unroll
            for (int ai = 0; ai < 2; ++ai)
#pragma unroll
                for (int m = 0; m < 4; ++m) { const size_t off = (size_t)(row0 + ai * HALF + m * 16) * 2048 + col0;
#pragma unroll
                    for (int bj = 0; bj < 2; ++bj) { const u32x4 b = *(const u32x4*)(GB + off + bj * HALF);
                        f32x4 b0 = bf4lo(b.x, b.y), b1 = bf4lo(b.z, b.w);
#pragma unroll
                        for (int e = 0; e < 4; ++e) { b0[e] = fmaxf(b0[e], 1e-20f); b1[e] = fmaxf(b1[e], 1e-20f); }
                        *(u32x4*)(O + off + bj * HALF) = pack8(acc[ai][bj][m][0] * b0, acc[ai][bj][m][1] * b1); } }
        }
    }
};
struct EpiX1 {
    static constexpr bool PERM = true, AFTER_DRAIN = false, KEEP_SEG0 = false;
    const float* X; float* X1; bf16_t* X1B; unsigned long long* SS;
    __device__ __forceinline__ void operator()(const f32x4 (&acc)[2][2][4][2], const Unit& u, int wr, int wc, int fr, int fq) const {
        const int row0 = u.pm * BM + wr * 64 + fr, col0 = u.pn * BM + wc * 32 + 8 * fq;
#pragma unroll
        for (int ai = 0; ai < 2; ++ai)
#pragma unroll
            for (int m = 0; m < 4; ++m) { const int row = row0 + ai * HALF + m * 16; const size_t off = (size_t)row * 2048 + col0; float sq = 0.f;
#pragma unroll
                for (int bj = 0; bj < 2; ++bj) { const f32x4 v0 = acc[ai][bj][m][0] + *(const f32x4*)(X + off + bj * HALF), v1 = acc[ai][bj][m][1] + *(const f32x4*)(X + off + bj * HALF + 4);
                    *(u32x4*)(X1B + off + bj * HALF) = pack8(v0, v1);
                    sq += (v0[0] * v0[0] + v0[1] * v0[1]) + (v0[2] * v0[2] + v0[3] * v0[3]) + (v1[0] * v1[0] + v1[1] * v1[1]) + (v1[2] * v1[2] + v1[3] * v1[3]); }
                sq += __shfl_xor(sq, 16); sq += __shfl_xor(sq, 32);
                if (fq == 0) atomicAdd(SS + row, (unsigned long long)(sq * 4294967296.0f)); }
    }
};
__device__ __forceinline__ float rinv_from_ss(unsigned long long s) { return 1.0f / sqrtf((float)((double)s * (1.0 / 4294967296.0) * (1.0 / 2048.0)) + 1e-6f); }
struct EpiQP {
    static constexpr bool PERM = true, AFTER_DRAIN = false, KEEP_SEG0 = false;
    const unsigned long long* SS; bf16_t* O;
    __device__ __forceinline__ void operator()(const f32x4 (&acc)[2][2][4][2], const Unit& u, int wr, int wc, int fr, int fq) const {
        const int row0 = u.pm * BM + wr * 64 + fr, col0 = u.pn * BM + wc * 32 + 8 * fq;
#pragma unroll
        for (int ai = 0; ai < 2; ++ai)
#pragma unroll
            for (int m = 0; m < 4; ++m) { const int row = row0 + ai * HALF + m * 16; const size_t off = (size_t)row * 2048 + col0; const float rv = rinv_from_ss(SS[row]);
#pragma unroll
                for (int bj = 0; bj < 2; ++bj) *(u32x4*)(O + off + bj * HALF) = pack8(acc[ai][bj][m][0] * rv, acc[ai][bj][m][1] * rv); }
    }
};

template <class Epi, class Sched, bool ALIGN_EPI = false, bool SP2 = false>
__device__ __forceinline__ void gemm_phase(PG8_LAS unsigned char* lds, const Gemm g, const Sched& S, const Epi& E) {
    const int tid = threadIdx.x, wid = __builtin_amdgcn_readfirstlane(tid >> 6), lane = tid & 63, wr = wid >> 2, wc = wid & 3, fr = lane & 15, fq = lane >> 4;
    const int K = g.K, nt = K / BK;
    unsigned voffA[2], voffB[2];
#pragma unroll
    for (int i = 0; i < 2; ++i) { int R, C; stage_rc(tid * 16 + i * 8192, R, C); const int Rb = Epi::PERM ? ((R & ~31) + perm32(R & 31)) : R;
        voffA[i] = (unsigned)(R * K + C) * 2u; voffB[i] = (unsigned)(Rb * K + C) * 2u; }
    const size_t kstep = (size_t)(BK * 2);
    const size_t hstep = (size_t)HALF * K * 2;
    const size_t tstep = 2 * hstep;
    const unsigned ldsw = (unsigned)wid * 1024u;
    const int aoff = lds_byte(wr * 64 + fr, fq * 8), boff = lds_byte(wc * 32 + fr, fq * 8);
#define PG8_SA(b, h) (((b) * 2 + (h)) * HTB)
#define PG8_SB(b, h) ((4 + (b) * 2 + (h)) * HTB)
#define PG8_STAGE(bufoff, gbase, voff) do { _Pragma("unroll") for (int _i = 0; _i < 2; ++_i) \
        __builtin_amdgcn_global_load_lds((const unsigned*)((const char*)(gbase) + (voff)[_i]), (PG8_LAS unsigned*)(lds + (bufoff) + ldsw + _i * 8192), 16, 0, 0); } while (0)
#define PG8_LDA(dst, b, h) do { _Pragma("unroll") for (int m = 0; m < 4; ++m) _Pragma("unroll") for (int k = 0; k < 2; ++k) dst[m][k] = *(const PG8_LAS bf16x8*)(lds + PG8_SA(b, h) + aoff + m * 2048 + k * 1024); } while (0)
#define PG8_LDB(dst, b, h) do { _Pragma("unroll") for (int n = 0; n < 2; ++n) _Pragma("unroll") for (int k = 0; k < 2; ++k) dst[n][k] = *(const PG8_LAS bf16x8*)(lds + PG8_SB(b, h) + boff + n * 2048 + k * 1024); } while (0)
#define PG8_MMA(ai, bj, At, Bt) do { __builtin_amdgcn_s_setprio(1); _Pragma("unroll") for (int m = 0; m < 4; ++m) _Pragma("unroll") for (int n = 0; n < 2; ++n) _Pragma("unroll") for (int k = 0; k < 2; ++k) \
        acc[ai][bj][m][n] = __builtin_amdgcn_mfma_f32_16x16x32_bf16(Bt[n][k], At[m][k], acc[ai][bj][m][n], 0, 0, 0); __builtin_amdgcn_s_setprio(0); } while (0)
#define PG8_WAIT_V(n) asm volatile("s_waitcnt vmcnt(" #n ")" ::: "memory")
#define PG8_WAIT_L(n) asm volatile("s_waitcnt lgkmcnt(" #n ")" ::: "memory")
#define PG8_BAR __builtin_amdgcn_s_barrier()
#define PG8_SCHED __builtin_amdgcn_sched_barrier(0)
    Unit cur, nxt; int ui = 0;
    if (!S.next(0, cur)) return;
    f32x4 acc[2][2][4][2];
#pragma unroll
    for (int a = 0; a < 2; ++a)
#pragma unroll
        for (int b = 0; b < 2; ++b)
#pragma unroll
            for (int m = 0; m < 4; ++m)
#pragma unroll
                for (int n = 0; n < 2; ++n) acc[a][b][m][n] = (f32x4){0.f, 0.f, 0.f, 0.f};
    bf16x8 At[4][2], B0[2][2], B1[2][2];
    const char* cA = (const char*)(cur.seg ? g.A2 : g.A) + (size_t)cur.pm * tstep; const char* cB = (const char*)(cur.seg ? g.Bt2 : g.Bt) + (size_t)cur.pn * tstep;
    S.a_ready(cur);
    if constexpr (SP2) {
        PG8_STAGE(PG8_SB(0, 0), cB, voffB); PG8_STAGE(PG8_SB(0, 1), cB + hstep, voffB); PG8_STAGE(PG8_SA(0, 0), cA, voffA); PG8_STAGE(PG8_SA(0, 1), cA + hstep, voffA);
        if (wr == 1) PG8_BAR;
        PG8_WAIT_V(2); PG8_BAR;
        PG8_STAGE(PG8_SB(1, 0), cB + kstep, voffB); PG8_STAGE(PG8_SA(1, 0), cA + kstep, voffA); PG8_STAGE(PG8_SB(1, 1), cB + hstep + kstep, voffB);
        PG8_WAIT_V(6); PG8_BAR;
    } else {
        PG8_STAGE(PG8_SB(0, 0), cB, voffB); PG8_STAGE(PG8_SA(0, 0), cA, voffA); PG8_STAGE(PG8_SB(0, 1), cB + hstep, voffB); PG8_STAGE(PG8_SA(0, 1), cA + hstep, voffA);
        if (wr == 1) PG8_BAR;
        PG8_WAIT_V(4); PG8_BAR;
        PG8_STAGE(PG8_SB(1, 0), cB + kstep, voffB); PG8_STAGE(PG8_SA(1, 0), cA + kstep, voffA); PG8_STAGE(PG8_SB(1, 1), cB + hstep + kstep, voffB);
        PG8_WAIT_V(6); PG8_BAR;
    }
    for (;;) {
        const bool has_next = S.next(ui + 1, nxt);
        const char* nA = has_next ? (const char*)(nxt.seg ? g.A2 : g.A) + (size_t)nxt.pm * tstep : cA; const char* nB = has_next ? (const char*)(nxt.seg ? g.Bt2 : g.Bt) + (size_t)nxt.pn * tstep : cB;
        for (int t = 0; t < nt; t += 2) {
            const bool last = (t == nt - 2);
            const char* a1 = cA + (size_t)(t + 1) * kstep;
            const char* a2 = last ? nA : cA + (size_t)(t + 2) * kstep; const char* b2 = last ? nB : cB + (size_t)(t + 2) * kstep;
            const char* a3 = a2 + kstep; const char* b3 = b2 + kstep;
            if (last && has_next) S.a_ready(nxt);
            if constexpr (SP2) {
            PG8_LDB(B0, 0, 0); PG8_LDB(B1, 0, 1); PG8_SCHED; PG8_LDA(At, 0, 0); PG8_STAGE(PG8_SA(1, 1), a1 + hstep, voffA);
            PG8_WAIT_V(8); PG8_WAIT_L(0); PG8_BAR; PG8_MMA(0, 0, At, B0); PG8_MMA(0, 1, At, B1); PG8_BAR; PG8_SCHED;
            PG8_LDA(At, 0, 1); PG8_STAGE(PG8_SB(0, 0), b2, voffB); PG8_STAGE(PG8_SB(0, 1), b2 + hstep, voffB); PG8_STAGE(PG8_SA(0, 0), a2, voffA);
            PG8_WAIT_V(8); PG8_WAIT_L(0); PG8_BAR; PG8_MMA(1, 0, At, B0); PG8_MMA(1, 1, At, B1); PG8_BAR; PG8_SCHED;
            PG8_LDB(B0, 1, 0); PG8_LDB(B1, 1, 1); PG8_SCHED; PG8_LDA(At, 1, 0); PG8_STAGE(PG8_SA(0, 1), a2 + hstep, voffA);
            PG8_WAIT_V(8); PG8_WAIT_L(0); PG8_BAR; PG8_MMA(0, 0, At, B0); PG8_MMA(0, 1, At, B1); PG8_BAR; PG8_SCHED;
            PG8_LDA(At, 1, 1); PG8_STAGE(PG8_SB(1, 0), b3, voffB); PG8_STAGE(PG8_SB(1, 1), b3 + hstep, voffB); PG8_STAGE(PG8_SA(1, 0), a3, voffA);
            PG8_WAIT_V(8); PG8_WAIT_L(0); PG8_BAR; PG8_MMA(1, 0, At, B0); PG8_MMA(1, 1, At, B1); PG8_BAR; PG8_SCHED;
            } else {
            PG8_LDB(B0, 0, 0); PG8_SCHED; PG8_LDA(At, 0, 0); PG8_STAGE(PG8_SA(1, 1), a1 + hstep, voffA);
            PG8_WAIT_L(8); PG8_BAR; PG8_WAIT_L(0); PG8_MMA(0, 0, At, B0); PG8_BAR; PG8_SCHED;
            PG8_LDB(B1, 0, 1); PG8_STAGE(PG8_SB(0, 0), b2, voffB);
            PG8_BAR; PG8_WAIT_L(0); PG8_MMA(0, 1, At, B1); PG8_BAR;
            PG8_LDA(At, 0, 1); PG8_STAGE(PG8_SA(0, 0), a2, voffA);
            PG8_BAR; PG8_WAIT_L(0); PG8_MMA(1, 0, At, B0); PG8_BAR; PG8_SCHED;
            PG8_STAGE(PG8_SB(0, 1), b2 + hstep, voffB);
            PG8_WAIT_V(6); PG8_BAR; PG8_MMA(1, 1, At, B1); PG8_BAR;
            PG8_LDB(B0, 1, 0); PG8_SCHED; PG8_LDA(At, 1, 0); PG8_STAGE(PG8_SA(0, 1), a2 + hstep, voffA);
            PG8_WAIT_L(8); PG8_BAR; PG8_WAIT_L(0); PG8_MMA(0, 0, At, B0); PG8_BAR; PG8_SCHED;
            PG8_LDB(B1, 1, 1); PG8_STAGE(PG8_SB(1, 0), b3, voffB);
            PG8_BAR; PG8_WAIT_L(0); PG8_MMA(0, 1, At, B1); PG8_BAR;
            PG8_LDA(At, 1, 1); PG8_STAGE(PG8_SA(1, 0), a3, voffA);
            PG8_BAR; PG8_WAIT_L(0); PG8_MMA(1, 0, At, B0); PG8_BAR; PG8_SCHED;
            PG8_STAGE(PG8_SB(1, 1), b3 + hstep, voffB);
            PG8_WAIT_V(6); PG8_BAR; PG8_MMA(1, 1, At, B1); PG8_BAR;
            }
        }
        if constexpr (ALIGN_EPI) { if (wr == 0) PG8_BAR; }
        if constexpr (!Epi::AFTER_DRAIN) { E(acc, cur, wr, wc, fr, fq); S.done(cur); }
        if (!has_next) break;
        if (!(Epi::KEEP_SEG0 && cur.seg == 0)) {
#pragma unroll
        for (int a = 0; a < 2; ++a)
#pragma unroll
            for (int b = 0; b < 2; ++b)
#pragma unroll
                for (int m = 0; m < 4; ++m)
#pragma unroll
                    for (int n = 0; n < 2; ++n) acc[a][b][m][n] = (f32x4){0.f, 0.f, 0.f, 0.f};
        }
        cur = nxt; cA = nA; cB = nB; ++ui;
        if constexpr (ALIGN_EPI) { if (wr == 1) PG8_BAR; }
    }
    PG8_WAIT_V(0);
    if constexpr (!ALIGN_EPI) { if (wr == 0) PG8_BAR; }
    PG8_BAR;
    if constexpr (Epi::AFTER_DRAIN) { E.fused(acc, cur, wr, wc, fr, fq, lds, wid, lane); S.done(cur); }
#undef PG8_SA
#undef PG8_SB
#undef PG8_STAGE
#undef PG8_LDA
#undef PG8_LDB
#undef PG8_MMA
#undef PG8_WAIT_V
#undef PG8_WAIT_L
#undef PG8_BAR
#undef PG8_SCHED
}
}

constexpr int NWAVES = 8;
#ifndef MK_N_LAUNCHES
#define MK_N_LAUNCHES 1
#endif
constexpr int PER_PHASE = 9;
#ifndef MK_REP_PHASE
#define MK_REP_PHASE -1
#endif
#define NREP(k) (((k) == MK_REP_PHASE) ? 2 : 1)
constexpr int N_LAUNCHES = MK_N_LAUNCHES;
constexpr int M = 8192, SEQ = 4096, DM = 2048, INW = 10240, NEXP = 16384;
constexpr float RMS_EPS = 1e-6f;
constexpr size_t MiB = 1u << 20;
constexpr size_t WS_CTL = 0, CTL_ZERO_BYTES = 1 * MiB;
constexpr size_t WS_SS = 256 * 1024, WS_KSUM = 512 * 1024;
constexpr size_t WS_WIN = 2 * MiB, WS_WBC = 42 * MiB, WS_WBA = 46 * MiB, WS_WOUT = 50 * MiB, WS_WPQ = 58 * MiB, WS_KEYS = 66 * MiB, WS_CS = 67 * MiB;
constexpr size_t WS_UB = 70 * MiB, WS_VB = 102 * MiB;
constexpr size_t WS_XB = 198 * MiB;
constexpr size_t WS_T6 = 230 * MiB;
constexpr size_t WS_GAB = 326 * MiB;
constexpr size_t WS_UC = 390 * MiB, WS_AO = 406 * MiB;
constexpr size_t WS_EXP = 422 * MiB, WS_GATE = 426 * MiB;
constexpr size_t WS_END = 430 * MiB;
constexpr size_t WS_TMP = WS_XB, WS_MB = WS_T6, WS_X1B = WS_T6 + 48 * MiB, WS_QP = WS_GAB;
constexpr int CW_BAR = 4096;
constexpr int RING_OFF = 0, RING_BYTES = 131072;
constexpr int LDSCTL_OFF = RING_BYTES, MISC_OFF = LDSCTL_OFF + 320;
constexpr int LDS_BYTES = 147456;

#define GAS __attribute__((address_space(1)))
#define LAS __attribute__((address_space(3)))
typedef unsigned short bf16;
typedef unsigned v4u __attribute__((ext_vector_type(4)));
typedef float f32x4 __attribute__((ext_vector_type(4)));
typedef short bf16x8 __attribute__((ext_vector_type(8)));
typedef GAS unsigned gu32;
typedef GAS unsigned long long gu64;
#define RLX_AGENT __ATOMIC_RELAXED, __HIP_MEMORY_SCOPE_AGENT
#define LDS_WAIT() asm volatile("s_waitcnt lgkmcnt(0)" ::: "memory")
#define VM_WAIT() asm volatile("s_waitcnt vmcnt(0)" ::: "memory")
__device__ __forceinline__ unsigned long long rt() { return __builtin_amdgcn_s_memrealtime(); }
__device__ __forceinline__ unsigned f2bf(float f) { unsigned u = __builtin_bit_cast(unsigned, f); return (u + 0x7fffu + ((u >> 16) & 1u)) >> 16; }
__device__ __forceinline__ unsigned pk2(float lo, float hi) { return f2bf(lo) | (f2bf(hi) << 16); }

#define XB_TMO      128
#define XB_XCNT(j)  (256  + 64 * (j))
#define XB_XSUB(j)  (1280 + 64 * (j))
#define XB_XGEN(j)  (2304 + 64 * (j))
#define XB_TOP      3328
#define XB_TOPGEN   3392
#define XCD_BAR_WORDS 3456
#define XB_SPIN_CAP (1u << 18)

__device__ __forceinline__ unsigned xb_ld(unsigned* p)              { return __hip_atomic_load(p, __ATOMIC_RELAXED, __HIP_MEMORY_SCOPE_AGENT); }
__device__ __forceinline__ unsigned xb_add(unsigned* p, unsigned v) { return __hip_atomic_fetch_add(p, v, __ATOMIC_RELAXED, __HIP_MEMORY_SCOPE_AGENT); }
__device__ __forceinline__ unsigned xb_xcc_id() { return (unsigned)__builtin_amdgcn_s_getreg((3 << 11) | 20) & 0xFu; }
#define XB_SPIN(cond, bar) do { unsigned _sp = 0; while (cond) { __builtin_amdgcn_s_sleep(1); \
    if ((++_sp & 255u) == 0u) { if (xb_ld(&(bar)[XB_TMO])) break; if (_sp > XB_SPIN_CAP) { atomicAdd(&(bar)[XB_TMO], 1u); break; } } } } while (0)

struct XcdBarrier {
    unsigned* bar; unsigned x;
    volatile LAS unsigned* st;
};

__device__ __forceinline__ XcdBarrier xcd_barrier_post(unsigned* bar, volatile LAS unsigned* st) {
    XcdBarrier b; b.bar = bar; b.x = xb_xcc_id(); b.st = st;
    if (threadIdx.x == 0) (void)xb_add(&bar[XB_XCNT(b.x)], 1u);
    return b;
}
__device__ __forceinline__ void xcd_barrier_complete(unsigned* bar, unsigned x, unsigned& nloc, unsigned& nx) {
    const unsigned G = gridDim.x * gridDim.y * gridDim.z;
    unsigned sum, cnt, mine, sp = 0u;
    for (;;) {
        sum = 0u; cnt = 0u; mine = 0u;
#pragma unroll
        for (unsigned j = 0; j < 16; ++j) { const unsigned c = xb_ld(&bar[XB_XCNT(j)]); sum += c; cnt += (c > 0u) ? 1u : 0u; mine = (j == x) ? c : mine; }
        if (sum == G) break;
        __builtin_amdgcn_s_sleep(1);
        if ((++sp & 255u) == 0u) { if (xb_ld(&bar[XB_TMO])) break; if (sp > XB_SPIN_CAP) { atomicAdd(&bar[XB_TMO], 1u); break; } }
    }
    nloc = mine > 0u ? mine : 1u; nx = cnt > 0u ? cnt : 1u;
}

__device__ __forceinline__ void xcd_barrier(const XcdBarrier& b) {
    asm volatile("s_waitcnt vmcnt(0)" ::: "memory");
    __syncthreads();
    if (threadIdx.x == 0) {
        unsigned* bar = b.bar;
        __builtin_amdgcn_s_waitcnt(0);
        unsigned nloc = b.st[0], nx = b.st[1];
        if (nloc == 0u) { xcd_barrier_complete(bar, b.x, nloc, nx); b.st[0] = nloc; b.st[1] = nx; }
        const unsigned old = xb_add(&bar[XB_XSUB(b.x)], 1u);
        const unsigned gen = old / nloc;
        if (old + 1u == (gen + 1u) * nloc) {
            __builtin_amdgcn_fence(__ATOMIC_RELEASE, "agent");
            asm volatile("s_waitcnt vmcnt(0)" ::: "memory");
            const unsigned og = xb_add(&bar[XB_TOP], 1u);
            const unsigned tg = og / nx;
            if (og + 1u == (tg + 1u) * nx) xb_add(&bar[XB_TOPGEN], 1u);
            else XB_SPIN(xb_ld(&bar[XB_TOPGEN]) == tg, bar);
            __builtin_amdgcn_fence(__ATOMIC_ACQUIRE, "agent");
            xb_add(&bar[XB_XGEN(b.x)], 1u);
            asm volatile("s_waitcnt vmcnt(0)" ::: "memory");
        } else {
            XB_SPIN(xb_ld(&bar[XB_XGEN(b.x)]) == gen, bar);
            __builtin_amdgcn_fence(__ATOMIC_ACQUIRE, "agent");
            asm volatile("s_waitcnt vmcnt(0)" ::: "memory");
        }
    }
    __syncthreads();
}

typedef __bf16 bf16x2v __attribute__((ext_vector_type(2)));
typedef float f32x16 __attribute__((ext_vector_type(16)));
__device__ __forceinline__ float bflo(unsigned w) { return __uint_as_float(w << 16); }
__device__ __forceinline__ float bfhi(unsigned w) { return __uint_as_float(w & 0xffff0000u); }
__device__ __forceinline__ float dot2bf(unsigned a, unsigned b, float c) { return __builtin_amdgcn_fdot2_f32_bf16(__builtin_bit_cast(bf16x2v, a), __builtin_bit_cast(bf16x2v, b), c, false); }
__device__ __forceinline__ float wave_sum(float v) {
#pragma unroll
    for (int o = 1; o < 64; o <<= 1) v += __shfl_xor(v, o);
    return v; }
__device__ __forceinline__ float wave_max(float v) {
#pragma unroll
    for (int o = 1; o < 64; o <<= 1) v = fmaxf(v, __shfl_xor(v, o));
    return v; }
__device__ __forceinline__ float rdlane(float v, int l) { return __int_as_float(__builtin_amdgcn_readlane(__float_as_int(v), l)); }
__device__ __forceinline__ float gelu_tanh(float x) { const float z = 0.7978845608028654f * (x + 0.044715f * x * x * x); const float e = __expf(2.0f * z); const float th = 1.0f - 2.0f * __builtin_amdgcn_rcpf(1.0f + e); return 0.5f * x * (1.0f + th); }

struct Ctx { LAS unsigned char* lds; int tid, lane, wave, vcu, G; };

__device__ __forceinline__ void p0_transpose_item(const float* W, int K, int N, bf16* WT, const float* gk, LAS float* scr, int item, int lane) {
    const int nblk = N / 32, kb = item / nblk, nb = item % nblk, k0 = 64 * kb, n0 = 32 * nb;
#pragma unroll
    for (int i = 0; i < 8; ++i) { const int kk = 8 * i + (lane >> 3), nn = 4 * (lane & 7); f32x4 v = *(const GAS f32x4*)(W + (size_t)(k0 + kk) * N + n0 + nn); if (gk) v = v * gk[k0 + kk];
        scr[kk * 33 + nn] = v[0]; scr[kk * 33 + nn + 1] = v[1]; scr[kk * 33 + nn + 2] = v[2]; scr[kk * 33 + nn + 3] = v[3]; }
    LDS_WAIT(); asm volatile("" ::: "memory");
    const int c = lane & 7;
#pragma unroll
    for (int j = 0; j < 4; ++j) { const int n = (lane >> 3) + 8 * j; const LAS float* s = scr + (8 * c) * 33 + n;
        v4u o; o.x = pk2(s[0 * 33], s[1 * 33]); o.y = pk2(s[2 * 33], s[3 * 33]); o.z = pk2(s[4 * 33], s[5 * 33]); o.w = pk2(s[6 * 33], s[7 * 33]);
        *(GAS v4u*)(WT + (size_t)(n0 + n) * K + k0 + 8 * c) = o; }
    LDS_WAIT(); asm volatile("" ::: "memory");
}
__device__ __forceinline__ void convert_tables(const Ctx& F, const float* pu, const float* pv, const float* g2, unsigned char* ws) {
    const int gt = (F.vcu * NWAVES + F.wave) * 64 + F.lane, NT = F.G * NWAVES * 64;
    for (int i = gt; i < NEXP * 2048 / 16; i += NT) { const int c16 = (i & 127) * 16; v4u ou, ov;
#pragma unroll
        for (int q = 0; q < 4; ++q) { f32x4 a = ((const GAS f32x4*)pu)[4 * i + q]; a = a * *(const GAS f32x4*)(g2 + c16 + 4 * q) * 512.0f; const f32x4 b = ((const GAS f32x4*)pv)[4 * i + q] * 32.0f;
            int wu = 0, wv = 0; wu = __builtin_amdgcn_cvt_pk_fp8_f32(a[0], a[1], wu, false); wu = __builtin_amdgcn_cvt_pk_fp8_f32(a[2], a[3], wu, true);
            wv = __builtin_amdgcn_cvt_pk_fp8_f32(b[0], b[1], wv, false); wv = __builtin_amdgcn_cvt_pk_fp8_f32(b[2], b[3], wv, true); ou[q] = (unsigned)wu; ov[q] = (unsigned)wv; }
        ((GAS v4u*)(ws + WS_UB))[i] = ou; ((GAS v4u*)(ws + WS_VB))[i] = ov; }
}
__device__ __forceinline__ void p0_prologue(const Ctx& F, const float* const* in, unsigned char* ws, const double* invf) {
    const float* x = in[0]; const int* pos = (const int*)in[1]; const float* g1 = in[2]; const float* w_in = in[3];
    const float* w_bc = in[6]; const float* w_ba = in[7]; const float* w_out = in[8]; const float* g2 = in[9]; const float* w_pq = in[10];
    const float* keys = in[11]; const float* pu = in[12]; const float* pv = in[13];
    LAS float* scr = (LAS float*)(F.lds + RING_OFF + F.wave * 16384);
    const int gw = F.vcu * NWAVES + F.wave, NGW = F.G * NWAVES;
    const int gt = gw * 64 + F.lane, NT = NGW * 64;
    for (int i = gt; i < 8192; i += NT) ((GAS unsigned long long*)(ws + WS_SS))[i] = 0ull;
    for (int i = gt; i < 32 * 1024; i += NT) ((GAS float*)(ws + WS_KSUM))[i] = 0.f;
    constexpr int I_IN = 32 * 320, I_BC = 16 * 64, I_OUT = 32 * 64;
    constexpr int NITEMS = I_IN + 2 * I_BC + 2 * I_OUT;
    for (int it = gw; it < NITEMS; it += NGW) {
        int r = it;
        if (r < I_IN) { p0_transpose_item(w_in, 2048, INW, (bf16*)(ws + WS_WIN), g1, scr, r, F.lane); continue; } r -= I_IN;
        if (r < I_BC) { p0_transpose_item(w_bc, 1024, 2048, (bf16*)(ws + WS_WBC), nullptr, scr, r, F.lane); continue; } r -= I_BC;
        if (r < I_BC) { p0_transpose_item(w_ba, 1024, 2048, (bf16*)(ws + WS_WBA), nullptr, scr, r, F.lane); continue; } r -= I_BC;
        if (r < I_OUT) { p0_transpose_item(w_out, 2048, 2048, (bf16*)(ws + WS_WOUT), nullptr, scr, r, F.lane); continue; } r -= I_OUT;
        p0_transpose_item(w_pq, 2048, 2048, (bf16*)(ws + WS_WPQ), g2, scr, r, F.lane);
    }
    for (int i = gt; i < 16 * 128 * 128 / 8; i += NT) { const f32x4 a = ((const GAS f32x4*)keys)[2 * i], b = ((const GAS f32x4*)keys)[2 * i + 1];
        v4u o; o.x = pk2(a[0], a[1]); o.y = pk2(a[2], a[3]); o.z = pk2(b[0], b[1]); o.w = pk2(b[2], b[3]); ((GAS v4u*)(ws + WS_KEYS))[i] = o; }
    for (int m = gw; m < M; m += NGW) { const GAS f32x4* xr = (const GAS f32x4*)(x + (size_t)m * DM);
        f32x4 v[8]; float s = 0.f;
#pragma unroll
        for (int i = 0; i < 4; ++i) { v[2 * i] = xr[i * 128 + 2 * F.lane]; v[2 * i + 1] = xr[i * 128 + 2 * F.lane + 1]; }
#pragma unroll
        for (int i = 0; i < 8; ++i) s += (v[i][0] * v[i][0] + v[i][1] * v[i][1]) + (v[i][2] * v[i][2] + v[i][3] * v[i][3]);
        const float rinv = 1.0f / sqrtf(wave_sum(s) * (1.0f / DM) + RMS_EPS);
        GAS v4u* o = (GAS v4u*)(ws + WS_XB + (size_t)m * DM * 2);
#pragma unroll
        for (int i = 0; i < 4; ++i) { const f32x4 a = v[2 * i] * rinv, b = v[2 * i + 1] * rinv; v4u w; w.x = pk2(a[0], a[1]); w.y = pk2(a[2], a[3]); w.z = pk2(b[0], b[1]); w.w = pk2(b[2], b[3]); o[i * 64 + F.lane] = w; } }
    for (int i = gt; i < M * 16; i += NT) { const int row = i >> 4, f = i & 15; const double ang = (double)pos[row] * invf[f];
        const double k = __builtin_rint(ang * 0.15915494309189535); const float r = (float)(ang - k * 6.283185307179586);
        float* cs = (float*)(ws + WS_CS); cs[row * 32 + f] = __cosf(r); cs[row * 32 + 16 + f] = __sinf(r); }
}

__device__ __forceinline__ void attn_simple(const Ctx& F, const bf16* Q, const bf16* K, const bf16* V, const float* ksum, bf16* AO) {
    LAS float* qf = (LAS float*)(F.lds + RING_OFF + F.wave * 512);
    const int gw = F.vcu * NWAVES + F.wave, NGW = F.G * NWAVES, lane = F.lane;
    for (int item = gw; item < 16 * SEQ; item += NGW) {
        const int bh = item >> 12, t = item & 4095, b = bh >> 3, h = bh & 7, blk = t >> 8;
        const size_t row = (size_t)b * SEQ + t;
        { const unsigned qq = *(const GAS unsigned*)(Q + row * 1024 + h * 128 + 2 * lane); qf[2 * lane] = bflo(qq); qf[2 * lane + 1] = bfhi(qq); }
        LDS_WAIT(); asm volatile("" ::: "memory");
        float g = -INFINITY;
        if (lane < blk) { const GAS f32x4* km = (const GAS f32x4*)(ksum + (size_t)(b * 16 + lane) * 1024 + h * 128); float a = 0.f;
            for (int d = 0; d < 32; ++d) { const f32x4 kv = km[d]; const f32x4 qv = *(const LAS f32x4*)(qf + 4 * d); a += (kv[0] * qv[0] + kv[1] * qv[1]) + (kv[2] * qv[2] + kv[3] * qv[3]); }
            g = a; }
        int sel[3];
#pragma unroll
        for (int i = 0; i < 3; ++i) { const float mx = wave_max(g); const unsigned long long bal = __ballot(g == mx && lane < blk); const int idx = bal ? (__ffsll((long long)bal) - 1) : 0; sel[i] = idx; if (lane == idx) g = -INFINITY; }
        const int nsel = blk < 3 ? blk : 3;
        float sc[4][4]; float mx = -INFINITY;
#pragma unroll
        for (int slot = 0; slot < 4; ++slot) {
            const bool valid = (slot == 3) || (slot < nsel);
            const int kb = (slot == 3) ? blk : sel[slot < 3 ? slot : 0];
#pragma unroll
            for (int r = 0; r < 4; ++r) {
                float s = -INFINITY; const int key0 = kb * 256 + r * 64;
                if (valid && (slot < 3 || key0 <= t)) {
                    const int key = key0 + lane; const GAS v4u* kp = (const GAS v4u*)(K + ((size_t)b * SEQ + key) * 1024 + h * 128); float a = 0.f;
#pragma unroll 4
                    for (int d = 0; d < 16; ++d) { const v4u kk = kp[d]; const f32x4 q0 = *(const LAS f32x4*)(qf + 8 * d), q1 = *(const LAS f32x4*)(qf + 8 * d + 4);
                        a += (bflo(kk.x) * q0[0] + bfhi(kk.x) * q0[1]) + (bflo(kk.y) * q0[2] + bfhi(kk.y) * q0[3]) + (bflo(kk.z) * q1[0] + bfhi(kk.z) * q1[1]) + (bflo(kk.w) * q1[2] + bfhi(kk.w) * q1[3]); }
                    s = (slot < 3 || key <= t) ? a : -INFINITY; }
                sc[slot][r] = s; mx = fmaxf(mx, s); } }
        mx = wave_max(mx);
        float sum = 0.f;
#pragma unroll
        for (int slot = 0; slot < 4; ++slot)
#pragma unroll
            for (int r = 0; r < 4; ++r) { sc[slot][r] = exp2f(sc[slot][r] - mx); sum += sc[slot][r]; }
        sum = wave_sum(sum);
        float o0 = 0.f, o1 = 0.f;
#pragma unroll
        for (int slot = 0; slot < 4; ++slot) {
            const bool valid = (slot == 3) || (slot < nsel);
            const int kb = (slot == 3) ? blk : sel[slot < 3 ? slot : 0];
#pragma unroll
            for (int r = 0; r < 4; ++r) { const int key0 = kb * 256 + r * 64;
                if (valid && (slot < 3 || key0 <= t)) { const float pr = sc[slot][r]; const GAS unsigned* vp = (const GAS unsigned*)(V + ((size_t)b * SEQ + key0) * 1024 + h * 128) + lane;
                    for (int kk = 0; kk < 64; ++kk) { const float pk = rdlane(pr, kk); const unsigned vv = vp[(size_t)kk * 512]; o0 += pk * bflo(vv); o1 += pk * bfhi(vv); } } } }
        const float ri = 1.0f / sum;
        *(GAS unsigned*)(AO + row * 1024 + h * 128 + 2 * lane) = pk2(o0 * ri, o1 * ri);
    }
}
typedef short v4i16_t __attribute__((ext_vector_type(4))); typedef unsigned u32x2v __attribute__((ext_vector_type(2)));
__device__ __forceinline__ v4i16_t vtr16(unsigned addr) { return __builtin_amdgcn_ds_read_tr16_b64_v4i16((LAS v4i16_t*)(uintptr_t)addr); }
__device__ __forceinline__ int crow16(int r, int hh) { return (r & 3) + 8 * (r >> 2) + 4 * hh; }
__device__ __forceinline__ void attn_dma_step(const bf16* K, const bf16* V, LAS unsigned char* lds, int b, int h, int qb, int n_own, int st, int wave, int lane) {
    const int buf = st & 1;
#pragma unroll
    for (int img = 0; img < 4; ++img) {
        const int T = 2 * st + (img >> 1); const bool isV = img & 1;
        const int blk = (T < n_own) ? qb : ((T - n_own) >> 2), kt = (T < n_own) ? T : ((T - n_own) & 3);
        const bf16* base = (isV ? V : K) + ((size_t)b * SEQ + 256 * blk + 64 * kt) * 1024 + h * 128;
#pragma unroll
        for (int i = 0; i < 2; ++i) { const int pc = wave + 8 * i, row = 4 * pc + (lane >> 4), cp = lane & 15;
            const int c = isV ? ((((cp >> 2) ^ (row & 3)) << 2) | (cp & 3)) : (cp ^ (row & 15));
            __builtin_amdgcn_global_load_lds((const unsigned*)(base + (size_t)row * 1024 + 8 * c), (LAS unsigned*)(lds + buf * 65536 + img * 16384 + pc * 1024), 16, 0, 0); }
    }
}
__device__ __forceinline__ void attn_mfma(const Ctx& F, const bf16* Q, const bf16* K, const bf16* V, const float* ksum, bf16* AO) {
    const int lane = F.lane, wave = F.wave, q31 = lane & 31, hh = lane >> 5, wq = wave & 3, kvh = wave >> 2, l16 = lane & 15, G4 = lane >> 4;
    LAS unsigned char* lds = F.lds + RING_OFF;
    const unsigned lds0 = (unsigned)(uintptr_t)lds;
    for (int pr = F.vcu; pr < 256; pr += F.G)
#pragma unroll 1
    for (int pi = 0; pi < 2; ++pi) {
        const int bh = pr >> 4, s_ = pr & 15, u128 = pi ? 31 - s_ : s_, b = bh >> 3, h = bh & 7, qb = u128 >> 1, half = u128 & 1;
        const int n_own = half ? 4 : 2, nstep = (n_own + 4 * qb) >> 1;
        const size_t rowq = (size_t)b * SEQ + 256 * qb + 128 * half + 32 * wq + q31;
        asm volatile("s_waitcnt vmcnt(0) lgkmcnt(0)" ::: "memory"); __builtin_amdgcn_s_barrier(); asm volatile("" ::: "memory");
        attn_dma_step(K, V, lds, b, h, qb, n_own, 0, wave, lane);
        bf16x8 qf[8];
#pragma unroll
        for (int s = 0; s < 8; ++s) qf[s] = *(const GAS bf16x8*)(Q + rowq * 1024 + h * 128 + 16 * s + 8 * hh);
        unsigned selmask;
        {
            float qv[64];
#pragma unroll
            for (int s = 0; s < 8; ++s)
#pragma unroll
                for (int e = 0; e < 8; ++e) qv[8 * s + e] = __uint_as_float((unsigned)(unsigned short)qf[s][e] << 16);
            float v0 = -INFINITY, v1 = -INFINITY, v2 = -INFINITY; int i0 = 0, i1 = 0, i2 = 0;
#pragma unroll 1
            for (int j = 0; j < qb; ++j) {
                const GAS f32x4* kp = (const GAS f32x4*)(ksum + (size_t)(b * 16 + j) * 1024 + h * 128 + 8 * hh); float a = 0.f;
#pragma unroll
                for (int s = 0; s < 8; ++s) { const f32x4 k0 = kp[4 * s], k1 = kp[4 * s + 1];
                    a += (qv[8 * s] * k0[0] + qv[8 * s + 1] * k0[1]) + (qv[8 * s + 2] * k0[2] + qv[8 * s + 3] * k0[3]) + (qv[8 * s + 4] * k1[0] + qv[8 * s + 5] * k1[1]) + (qv[8 * s + 6] * k1[2] + qv[8 * s + 7] * k1[3]); }
                a += __shfl_xor(a, 32);
                if (a > v0) { v2 = v1; i2 = i1; v1 = v0; i1 = i0; v0 = a; i0 = j; } else if (a > v1) { v2 = v1; i2 = i1; v1 = a; i1 = j; } else if (a > v2) { v2 = a; i2 = j; }
            }
            selmask = (qb <= 3) ? ((1u << qb) - 1u) : ((1u << i0) | (1u << i1) | (1u << i2));
        }
        float m_run = -1e30f, l_run = 0.f; f32x16 o[4];
#pragma unroll
        for (int db = 0; db < 4; ++db)
#pragma unroll
            for (int r = 0; r < 16; ++r) o[db][r] = 0.f;
        const int qin = 128 * half + 32 * wq + q31;
#pragma unroll 1
        for (int st = 0; st < nstep; ++st) {
            asm volatile("s_waitcnt vmcnt(0)" ::: "memory"); __builtin_amdgcn_s_barrier(); asm volatile("" ::: "memory");
            if (st + 1 < nstep) attn_dma_step(K, V, lds, b, h, qb, n_own, st + 1, wave, lane);
            const int T = 2 * st + kvh; const bool own = T < n_own;
            const int blk = own ? qb : ((T - n_own) >> 2), kt = own ? T : ((T - n_own) & 3);
            const bool sel = own ? true : ((selmask >> blk) & 1u);
            const bool skip = own ? (64 * kt > 128 * half + 32 * wq + 31) : (__ballot(sel) == 0ull);
            if (!skip) {
                const unsigned kimg = lds0 + (st & 1) * 65536 + kvh * 32768, vimg = kimg + 16384;
                f32x16 p[2];
#pragma unroll
                for (int kh = 0; kh < 2; ++kh) {
#pragma unroll
                    for (int r = 0; r < 16; ++r) p[kh][r] = 0.f;
                    const int row = 32 * kh + q31;
#pragma unroll
                    for (int s = 0; s < 8; ++s) { const bf16x8 a = *(const LAS bf16x8*)(uintptr_t)(kimg + row * 256 + (((2 * s + hh) ^ (row & 15)) << 4));
                        p[kh] = __builtin_amdgcn_mfma_f32_32x32x16_bf16(a, qf[s], p[kh], 0, 0, 0); }
                }
                if (own) { const int kbase = 64 * kt;
                    if (kbase + 63 > 128 * half + 32 * wq) {
#pragma unroll
                        for (int kh = 0; kh < 2; ++kh)
#pragma unroll
                            for (int r = 0; r < 16; ++r) if (kbase + 32 * kh + crow16(r, hh) > qin) p[kh][r] = -INFINITY; }
                }
                float mx = p[0][0];
#pragma unroll
                for (int r = 1; r < 16; ++r) mx = fmaxf(mx, p[0][r]);
#pragma unroll
                for (int r = 0; r < 16; ++r) mx = fmaxf(mx, p[1][r]);
                { const auto rr = __builtin_amdgcn_permlane32_swap(__float_as_uint(mx), __float_as_uint(mx), false, false); mx = fmaxf(__uint_as_float(rr[0]), __uint_as_float(rr[1])); }
                if (!sel) mx = -INFINITY;
                const float m_new = fmaxf(m_run, mx), scl = __builtin_amdgcn_exp2f(m_run - m_new); m_run = m_new;
                float rs = 0.f;
#pragma unroll
                for (int kh = 0; kh < 2; ++kh)
#pragma unroll
                    for (int r = 0; r < 16; ++r) { p[kh][r] = __builtin_amdgcn_exp2f(p[kh][r] - m_new); rs += p[kh][r]; }
                l_run = l_run * scl + (sel ? rs : 0.f);
                if (__ballot(scl != 1.0f) != 0ull) {
#pragma unroll
                    for (int db = 0; db < 4; ++db)
#pragma unroll
                        for (int r = 0; r < 16; ++r) o[db][r] *= scl; }
                const unsigned pmask = sel ? 0xffffffffu : 0u;
#pragma unroll
                for (int kh = 0; kh < 2; ++kh)
#pragma unroll
                    for (int s2 = 0; s2 < 2; ++s2) {
                        v4u pw; pw.x = pg8::cvt_pk_bf16(p[kh][8 * s2], p[kh][8 * s2 + 1]); pw.y = pg8::cvt_pk_bf16(p[kh][8 * s2 + 2], p[kh][8 * s2 + 3]);
                        pw.z = pg8::cvt_pk_bf16(p[kh][8 * s2 + 4], p[kh][8 * s2 + 5]); pw.w = pg8::cvt_pk_bf16(p[kh][8 * s2 + 6], p[kh][8 * s2 + 7]);
                        pw.x &= pmask; pw.y &= pmask; pw.z &= pmask; pw.w &= pmask;
                        const bf16x8 pb = __builtin_bit_cast(bf16x8, pw);
                        const int key0 = 32 * kh + 16 * s2 + 4 * (G4 >> 1) + (l16 >> 2);
#pragma unroll
                        for (int db = 0; db < 4; ++db) {
                            const int dsub = 16 * (G4 & 1) + 4 * (l16 & 3);
                            const unsigned a0 = vimg + key0 * 256 + ((db ^ (key0 & 3)) << 6) + dsub * 2;
                            const v4i16_t lo = vtr16(a0), hi_ = vtr16(a0 + 8 * 256);
                            const bf16x8 av = {lo[0], lo[1], lo[2], lo[3], hi_[0], hi_[1], hi_[2], hi_[3]};
                            o[db] = __builtin_amdgcn_mfma_f32_32x32x16_bf16(av, pb, o[db], 0, 0, 0);
                        }
                    }
            }
        }
        l_run += __shfl_xor(l_run, 32);
        asm volatile("s_waitcnt vmcnt(0) lgkmcnt(0)" ::: "memory"); __builtin_amdgcn_s_barrier(); asm volatile("" ::: "memory");
        LAS float* xs = (LAS float*)lds + (size_t)wq * 66 * 64 + lane;
        if (kvh == 1) {
            xs[0] = m_run; xs[64] = l_run;
#pragma unroll
            for (int db = 0; db < 4; ++db)
#pragma unroll
                for (int r = 0; r < 16; ++r) xs[(2 + 16 * db + r) * 64] = o[db][r];
        }
        asm volatile("s_waitcnt lgkmcnt(0)" ::: "memory"); __builtin_amdgcn_s_barrier(); asm volatile("" ::: "memory");
        if (kvh == 0) {
            const float m2 = xs[0], l2 = xs[64], mt = fmaxf(m_run, m2), a1 = __builtin_amdgcn_exp2f(m_run - mt), a2 = __builtin_amdgcn_exp2f(m2 - mt);
            const float inv = 1.0f / (l_run * a1 + l2 * a2), c1 = a1 * inv, c2 = a2 * inv;
            bf16* orow = AO + rowq * 1024 + h * 128 + 4 * hh;
#pragma unroll
            for (int db = 0; db < 4; ++db)
#pragma unroll
                for (int g = 0; g < 4; ++g) {
                    float t[4];
#pragma unroll
                    for (int e = 0; e < 4; ++e) t[e] = o[db][4 * g + e] * c1 + xs[(2 + 16 * db + 4 * g + e) * 64] * c2;
                    u32x2v w; w.x = pg8::cvt_pk_bf16(t[0], t[1]); w.y = pg8::cvt_pk_bf16(t[2], t[3]);
                    *(GAS u32x2v*)(orow + 32 * db + 8 * g) = w;
                }
        }
    }
    asm volatile("s_waitcnt vmcnt(0) lgkmcnt(0)" ::: "memory"); __builtin_amdgcn_s_barrier(); asm volatile("" ::: "memory");
}
__device__ __forceinline__ void up8(const v4u w, float (&f)[8]) { f[0] = bflo(w.x); f[1] = bfhi(w.x); f[2] = bflo(w.y); f[3] = bfhi(w.y); f[4] = bflo(w.z); f[5] = bfhi(w.z); f[6] = bflo(w.w); f[7] = bfhi(w.w); }
__device__ __forceinline__ void conv_phase(const Ctx& F, const bf16* CB, const bf16* CC, const bf16* CX, const float* cw, bf16* UC) {
    const int gt = (F.vcu * NWAVES + F.wave) * 64 + F.lane, NT = F.G * NWAVES * 64;
    for (int idx = gt; idx < M * 128; idx += NT) {
        const int row = idx >> 7, c8 = (idx & 127) << 3, t = row & (SEQ - 1); const size_t off = (size_t)row * 1024 + c8;
        float cb[8], a[8], x[8], z0[8], z1[8], z2[8];
        up8(*(const GAS v4u*)(CB + off), cb); up8(*(const GAS v4u*)(CC + off), a); up8(*(const GAS v4u*)(CX + off), x);
#pragma unroll
        for (int j = 0; j < 8; ++j) z0[j] = a[j] * x[j];
        if (t >= 1) { up8(*(const GAS v4u*)(CC + off - 1024), a); up8(*(const GAS v4u*)(CX + off - 1024), x);
#pragma unroll
            for (int j = 0; j < 8; ++j) z1[j] = a[j] * x[j]; } else {
#pragma unroll
            for (int j = 0; j < 8; ++j) z1[j] = 0.f; }
        if (t >= 2) { up8(*(const GAS v4u*)(CC + off - 2048), a); up8(*(const GAS v4u*)(CX + off - 2048), x);
#pragma unroll
            for (int j = 0; j < 8; ++j) z2[j] = a[j] * x[j]; } else {
#pragma unroll
            for (int j = 0; j < 8; ++j) z2[j] = 0.f; }
        float o[8];
#pragma unroll
        for (int j = 0; j < 8; ++j) o[j] = cb[j] * (cw[c8 + j] * z2[j] + cw[1024 + c8 + j] * z1[j] + cw[2048 + c8 + j] * z0[j]);
        v4u w; w.x = pk2(o[0], o[1]); w.y = pk2(o[2], o[3]); w.z = pk2(o[4], o[5]); w.w = pk2(o[6], o[7]); *(GAS v4u*)(UC + off) = w;
    }
}

__device__ __forceinline__ int imax(int a, int b) { return a > b ? a : b; }
__device__ __forceinline__ int imin(int a, int b) { return a < b ? a : b; }
__device__ __forceinline__ void ce(int& a, int& b) { const int t = imax(a, b); b = imin(a, b); a = t; }
__device__ __forceinline__ void sort16(int (&x)[16]) {
#pragma unroll
    for (int kk = 1; kk <= 4; ++kk)
#pragma unroll
        for (int jj = kk - 1; jj >= 0; --jj)
#pragma unroll
            for (int i = 0; i < 16; ++i) { const int k = 1 << kk, j = 1 << jj, l = i ^ j; if (l > i) { if ((i & k) == 0) ce(x[i], x[l]); else ce(x[l], x[i]); } }
}
__device__ __forceinline__ void bmerge16(int (&a)[16]) {
#pragma unroll
    for (int jj = 3; jj >= 0; --jj)
#pragma unroll
        for (int i = 0; i < 16; ++i) { const int j = 1 << jj, l = i ^ j; if (l > i) ce(a[i], a[l]); }
}
__device__ __forceinline__ void merge16(int (&a)[16], const int (&b)[16]) {
#pragma unroll
    for (int i = 0; i < 16; ++i) a[i] = imax(a[i], b[15 - i]);
    bmerge16(a);
}
__device__ __forceinline__ void xmerge16(int (&a)[16], int hh) {
    int pv[16];
#pragma unroll
    for (int i = 0; i < 16; ++i) { const auto r = __builtin_amdgcn_permlane32_swap((unsigned)a[15 - i], (unsigned)a[15 - i], false, false); pv[i] = hh ? (int)r[0] : (int)r[1]; }
#pragma unroll
    for (int i = 0; i < 16; ++i) a[i] = imax(a[i], pv[i]);
    bmerge16(a);
}
__device__ __forceinline__ int ord_key(float f) { const int u = __float_as_int(f); return u >= 0 ? u : (u ^ 0x7fffffff); }
__device__ __forceinline__ float ord_val(int k) { return __int_as_float(k >= 0 ? k : (k ^ 0x7fffffff)); }
__device__ __forceinline__ unsigned byte16(const unsigned (&t)[4], int idx) {
    const unsigned sel = 0x0c0c0c00u | (unsigned)(idx & 7);
    const unsigned lo = __builtin_amdgcn_perm(t[1], t[0], sel), hi_ = __builtin_amdgcn_perm(t[3], t[2], sel);
    return (idx & 8) ? hi_ : lo;
}
__device__ __forceinline__ void topk_stage_keys(const Ctx& F, const bf16* KEYS, int h) {
    for (int pc = F.wave; pc < 64; pc += 8) { const int pp = pc >> 5, row = 4 * (pc & 31) + (F.lane >> 4), cp = F.lane & 15, c = cp ^ (row & 15);
        __builtin_amdgcn_global_load_lds((const unsigned*)(KEYS + (size_t)((h * 2 + pp) * 128 + row) * 128 + 8 * c), (LAS unsigned*)(F.lds + RING_OFF + pc * 1024), 16, 0, 0); }
    asm volatile("s_waitcnt vmcnt(0)" ::: "memory"); __builtin_amdgcn_s_barrier(); asm volatile("" ::: "memory");
}
__device__ __forceinline__ void topk_phase(const Ctx& F, int bitem, const bf16* QP, int* EXP, float* GATE) {
    const int lane = F.lane, l31 = lane & 31, hh = lane >> 5;
    const int IMIN = (int)0x80000000;
    const unsigned lds0 = (unsigned)(uintptr_t)(F.lds + RING_OFF);
    {
        const int h = bitem & 7, tt = (bitem >> 3) * 8 + F.wave, tok0 = tt * 32;
        int top[2][16];
#pragma unroll
        for (int p = 0; p < 2; ++p) {
            bf16x8 qa[8];
#pragma unroll
            for (int s = 0; s < 8; ++s) qa[s] = *(const GAS bf16x8*)(QP + (size_t)(tok0 + l31) * 2048 + h * 256 + p * 128 + 16 * s + 8 * hh);
            int x[2][16];
#pragma unroll
            for (int pq = 0; pq < 2; ++pq) {
                f32x16 sc[2];
#pragma unroll
                for (int nt = 0; nt < 2; ++nt)
#pragma unroll
                    for (int r = 0; r < 16; ++r) sc[nt][r] = 0.f;
#pragma unroll
                for (int s = 0; s < 8; ++s) {
#pragma unroll
                    for (int nt = 0; nt < 2; ++nt) { const int n = 64 * pq + 32 * nt + l31; const bf16x8 kb = *(const LAS bf16x8*)(uintptr_t)(lds0 + p * 32768 + n * 256 + (((2 * s + hh) ^ (n & 15)) << 4));
                        sc[nt] = __builtin_amdgcn_mfma_f32_32x32x16_bf16(kb, qa[s], sc[nt], 0, 0, 0); }
                }
                int y[16];
#pragma unroll
                for (int r = 0; r < 16; ++r) { x[pq][r] = (ord_key(sc[0][r]) & ~127) | ((127 - 64 * pq - (r & 3) - 8 * (r >> 2)) - 4 * hh); y[r] = (ord_key(sc[1][r]) & ~127) | ((127 - 64 * pq - 32 - (r & 3) - 8 * (r >> 2)) - 4 * hh); }
                sort16(x[pq]); sort16(y); merge16(x[pq], y);
                asm volatile("" ::: "memory");
            }
            merge16(x[0], x[1]);
            xmerge16(x[0], hh);
#pragma unroll
            for (int i = 0; i < 16; ++i) top[p][i] = x[0][i];
        }
        float fa[16], fb[16];
#pragma unroll
        for (int i = 0; i < 16; ++i) { const int A = hh ? top[1][i] : top[0][i], B = hh ? top[0][i] : top[1][i]; fa[i] = ord_val(A & ~127); fb[i] = ord_val(B & ~127); }
        int c0[16], c1[16];
#pragma unroll
        for (int q = 0; q < 32; ++q) {
            int key = IMIN;
            if (q < 27) { const int i = (q < 16) ? 0 : (q < 23) ? 1 : (q < 26) ? 2 : 3, j = (q < 16) ? q : (q < 23) ? q - 15 : (q < 26) ? q - 21 : 3; const float sv = fa[i] + fb[j]; const int low = hh ? (255 - (j * 16 + i)) : (255 - (i * 16 + j));
                key = (ord_key(sv) & ~255) | low; if (i == j && hh) key = IMIN; }
            if (q < 16) c0[q] = key; else c1[q - 16] = key;
        }
        sort16(c0); sort16(c1); merge16(c0, c1); xmerge16(c0, hh);
        unsigned na[4], nb[4];
#pragma unroll
        for (int d = 0; d < 4; ++d) { na[d] = 0u; nb[d] = 0u;
#pragma unroll
            for (int e = 0; e < 4; ++e) { na[d] |= (unsigned)(127 - (top[0][4 * d + e] & 127)) << (8 * e); nb[d] |= (unsigned)(127 - (top[1][4 * d + e] & 127)) << (8 * e); } }
        int ex[16]; float ev[16]; float es = 0.f; const float smax = ord_val(c0[0] & ~255);
#pragma unroll
        for (int q = 0; q < 16; ++q) { const int posn = 255 - (c0[q] & 255); const unsigned n1 = byte16(na, posn >> 4) & 255u, n2 = byte16(nb, posn & 15) & 255u;
            ex[q] = (int)(n1 * 128u + n2); ev[q] = __expf(ord_val(c0[q] & ~255) - smax); es += ev[q]; }
        const float ri = 1.0f / es; const size_t ob = (size_t)(tok0 + l31) * 128 + h * 16;
        if (hh == 0) {
#pragma unroll
            for (int d = 0; d < 4; ++d) { v4u w; w.x = (unsigned)ex[4 * d]; w.y = (unsigned)ex[4 * d + 1]; w.z = (unsigned)ex[4 * d + 2]; w.w = (unsigned)ex[4 * d + 3]; *(GAS v4u*)(EXP + ob + 4 * d) = w; }
        } else {
#pragma unroll
            for (int d = 0; d < 4; ++d) *(GAS f32x4*)(GATE + ob + 4 * d) = (f32x4){ev[4 * d] * ri, ev[4 * d + 1] * ri, ev[4 * d + 2] * ri, ev[4 * d + 3] * ri};
        }
    }
}

typedef float f32x2 __attribute__((ext_vector_type(2)));
constexpr float PEER_SU = 512.0f, PEER_SV = 32.0f;
template <int CTRL> __device__ __forceinline__ int dpp_i(int v) { return __builtin_amdgcn_update_dpp(v, v, CTRL, 0xf, 0xf, false); }
template <int J> __device__ __forceinline__ int xor_lane(int v, int lane) {
    if constexpr (J == 1) return dpp_i<0xB1>(v);
    else if constexpr (J == 2) return dpp_i<0x4E>(v);
    else if constexpr (J == 16) { const auto r = __builtin_amdgcn_permlane16_swap((unsigned)v, (unsigned)v, false, false); return ((lane >> 4) & 1) ? (int)r[0] : (int)r[1]; }
    else if constexpr (J == 32) { const auto r = __builtin_amdgcn_permlane32_swap((unsigned)v, (unsigned)v, false, false); return (lane >> 5) ? (int)r[0] : (int)r[1]; }
    else return __shfl_xor(v, J);
}
__device__ __forceinline__ float wave_sum_dpp(float v) {
    v += __int_as_float(dpp_i<0xB1>(__float_as_int(v))); v += __int_as_float(dpp_i<0x4E>(__float_as_int(v))); v += __int_as_float(dpp_i<0x141>(__float_as_int(v))); v += __int_as_float(dpp_i<0x140>(__float_as_int(v)));
    { const auto r = __builtin_amdgcn_permlane16_swap(__float_as_uint(v), __float_as_uint(v), false, false); v = __uint_as_float(r[0]) + __uint_as_float(r[1]); }
    { const auto r = __builtin_amdgcn_permlane32_swap(__float_as_uint(v), __float_as_uint(v), false, false); v = __uint_as_float(r[0]) + __uint_as_float(r[1]); }
    return v; }
template <int KK, int JJ> __device__ __forceinline__ void sort512_step(int (&x)[8], int lane) {
    constexpr int k = 1 << KK, j = 1 << JJ;
    if constexpr (j >= 64) { constexpr int jr = j >> 6;
#pragma unroll
        for (int r = 0; r < 8; ++r) if ((r & jr) == 0) { const bool asc = (k >= 512) ? true : (((r << 6) & k) == 0); const int lo = imin(x[r], x[r | jr]), hi_ = imax(x[r], x[r | jr]); x[r] = asc ? lo : hi_; x[r | jr] = asc ? hi_ : lo; }
    } else {
        const bool lower = (lane & j) == 0;
#pragma unroll
        for (int r = 0; r < 8; ++r) { const int y = xor_lane<j>(x[r], lane);
            const bool asc = (k < 64) ? ((lane & k) == 0) : ((k >= 512) ? true : (((r << 6) & k) == 0));
            x[r] = (lower == asc) ? imin(x[r], y) : imax(x[r], y); }
    }
}
template <int KK, int JJ> __device__ __forceinline__ void sort512_stage(int (&x)[8], int lane) { sort512_step<KK, JJ>(x, lane); if constexpr (JJ > 0) sort512_stage<KK, JJ - 1>(x, lane); }
__device__ __forceinline__ void sort512(int (&x)[8], int lane) {
    sort512_stage<1, 0>(x, lane); sort512_stage<2, 1>(x, lane); sort512_stage<3, 2>(x, lane); sort512_stage<4, 3>(x, lane); sort512_stage<5, 4>(x, lane);
    sort512_stage<6, 5>(x, lane); sort512_stage<7, 6>(x, lane); sort512_stage<8, 7>(x, lane); sort512_stage<9, 8>(x, lane);
}
__device__ __forceinline__ void peer_phase(const Ctx& F, const unsigned char* U8, const unsigned char* V8, const bf16* X1B, const int* EXP, const float* GATE, const unsigned long long* SS, const float* gfin, const float* X1, float* OUT) {
    const int gw = F.vcu * NWAVES + F.wave, NGW = F.G * NWAVES, lane = F.lane;
    const unsigned xs0 = (unsigned)(uintptr_t)(F.lds + RING_OFF + F.wave * 16384) + lane * 16;
    for (int tb = gw; tb + 3 * NGW < M; tb += 4 * NGW) {
        int kreg[8]; float greg[8], rv[4];
#pragma unroll
        for (int j = 0; j < 4; ++j) { const size_t t = (size_t)tb + (size_t)j * NGW;
            kreg[2 * j] = (EXP[t * 128 + lane] << 9) | (j << 7) | lane; kreg[2 * j + 1] = (EXP[t * 128 + 64 + lane] << 9) | (j << 7) | (64 + lane);
            rv[j] = pg8::rinv_from_ss(SS[t]) * (1.0f / PEER_SU);
#pragma unroll
            for (int q = 0; q < 4; ++q) { const v4u w = *(const GAS v4u*)(X1B + t * DM + (q >> 1) * 1024 + lane * 16 + 8 * (q & 1)); *(LAS v4u*)(uintptr_t)(xs0 + j * 4096 + q * 1024) = w; } }
        sort512(kreg, lane);
        int pkey[8];
#pragma unroll
        for (int c = 0; c < 8; ++c) { pkey[c] = __shfl(kreg[c], 8 * (lane & 7) + (lane >> 3)); greg[c] = GATE[((size_t)tb + (size_t)((pkey[c] >> 7) & 3) * NGW) * 128 + (pkey[c] & 127)]; }
        asm volatile("s_waitcnt lgkmcnt(0)" ::: "memory");
        float actreg[8];
#ifndef MK_P8_REPU
#define MK_P8_REPU 1
#endif
#pragma unroll 1
        for (int repu = 0; repu < MK_P8_REPU; ++repu) {
            v4u ub[8][2];
#pragma unroll
            for (int u = 0; u < 8; ++u) { const GAS v4u* up = (const GAS v4u*)(U8 + (size_t)(__builtin_amdgcn_readlane(kreg[0], u) >> 9) * 2048) + lane; ub[u][0] = up[0]; ub[u][1] = up[64]; }
#pragma unroll
            for (int c = 0; c < 8; ++c) {
                float areg = 0.f;
#pragma unroll 1
                for (int g = 0; g < 8; ++g) {
                    float pt[8];
#pragma unroll
                    for (int u = 0; u < 8; ++u) {
                        const int key = __builtin_amdgcn_readlane(kreg[c], 8 * g + u);
                        const unsigned xa = xs0 + ((key >> 7) & 3) * 4096;
                        float p0 = 0.f, p1 = 0.f;
#pragma unroll
                        for (int i = 0; i < 2; ++i) { const v4u w = ub[u][i];
#pragma unroll
                            for (int hv = 0; hv < 2; ++hv) { const v4u xq = *(const LAS v4u*)(uintptr_t)(xa + (2 * i + hv) * 1024);
                                const unsigned w0 = hv ? w.z : w.x, w1 = hv ? w.w : w.y;
                                const f32x2 a0 = __builtin_amdgcn_cvt_pk_f32_fp8((int)w0, false), a1 = __builtin_amdgcn_cvt_pk_f32_fp8((int)w0, true), a2 = __builtin_amdgcn_cvt_pk_f32_fp8((int)w1, false), a3 = __builtin_amdgcn_cvt_pk_f32_fp8((int)w1, true);
                                p0 = dot2bf(pg8::cvt_pk_bf16(a0[0], a0[1]), xq.x, p0); p1 = dot2bf(pg8::cvt_pk_bf16(a1[0], a1[1]), xq.y, p1);
                                p0 = dot2bf(pg8::cvt_pk_bf16(a2[0], a2[1]), xq.z, p0); p1 = dot2bf(pg8::cvt_pk_bf16(a3[0], a3[1]), xq.w, p1); } }
                        pt[u] = p0 + p1;
                        { const int ix = 8 * g + 8 + u, ka = __builtin_amdgcn_readlane(kreg[c], ix & 63), kb = __builtin_amdgcn_readlane(kreg[c < 7 ? c + 1 : 7], ix & 63), kn = (ix < 64) ? ka : kb;
                            const GAS v4u* up = (const GAS v4u*)(U8 + (size_t)(kn >> 9) * 2048) + lane; ub[u][0] = up[0]; ub[u][1] = up[64]; }
                    }
                    { const bool b5 = (lane & 32) != 0, b4 = (lane & 16) != 0, b3 = (lane & 8) != 0;
#pragma unroll
                      for (int i = 0; i < 4; ++i) { const float a = pt[i], b = pt[i + 4]; pt[i] = (b5 ? b : a) + __int_as_float(xor_lane<32>(__float_as_int(b5 ? a : b), lane)); }
#pragma unroll
                      for (int i = 0; i < 2; ++i) { const float a = pt[i], b = pt[i + 2]; pt[i] = (b4 ? b : a) + __int_as_float(xor_lane<16>(__float_as_int(b4 ? a : b), lane)); }
                      { const float a = pt[0], b = pt[1]; pt[0] = (b3 ? b : a) + __shfl_xor(b3 ? a : b, 8); }
                      float r = pt[0]; r += __shfl_xor(r, 4); r += __int_as_float(dpp_i<0x4E>(__float_as_int(r))); r += __int_as_float(dpp_i<0xB1>(__float_as_int(r)));
                      areg = ((lane & 7) == g) ? r : areg; }
                }
                const int tk = (pkey[c] >> 7) & 3; const float rr = (tk == 0) ? rv[0] : (tk == 1) ? rv[1] : (tk == 2) ? rv[2] : rv[3];
                actreg[c] = gelu_tanh(areg * rr) * greg[c] * (1.0f / PEER_SV);
            }
        }
        LAS float* as = (LAS float*)(uintptr_t)(xs0 - lane * 16);
        asm volatile("s_waitcnt lgkmcnt(0)" ::: "memory");
#pragma unroll
        for (int c = 0; c < 8; ++c) as[64 * c + lane] = actreg[c];
        int k2[8];
#pragma unroll
        for (int c = 0; c < 8; ++c) { const int key = kreg[c], tok = (key >> 7) & 3, park = 64 * c + 8 * (lane & 7) + (lane >> 3);
            k2[c] = ((tok >> 1) << 24) | ((key >> 9) << 10) | ((tok & 1) << 9) | park; }
        sort512(k2, lane);
        asm volatile("s_waitcnt lgkmcnt(0)" ::: "memory");
        float a2[8];
#pragma unroll
        for (int c = 0; c < 8; ++c) a2[c] = as[k2[c] & 511];
#pragma unroll 1
        for (int pp = 0; pp < 2; ++pp) {
            int kq[4]; float aq[4];
#pragma unroll
            for (int c = 0; c < 4; ++c) { kq[c] = pp ? k2[4 + c] : k2[c]; aq[c] = pp ? a2[4 + c] : a2[c]; }
            f32x2 y[2][16];
#pragma unroll
            for (int j = 0; j < 2; ++j)
#pragma unroll
                for (int q = 0; q < 16; ++q) y[j][q] = (f32x2){0.f, 0.f};
            v4u vb[8][2];
#pragma unroll
            for (int u = 0; u < 8; ++u) { const GAS v4u* vp = (const GAS v4u*)(V8 + (size_t)((__builtin_amdgcn_readlane(kq[0], u) >> 10) & 0x3fff) * 2048) + lane; vb[u][0] = vp[0]; vb[u][1] = vp[64]; }
#pragma unroll
            for (int c = 0; c < 4; ++c) {
#pragma unroll 1
                for (int g = 0; g < 8; ++g) {
#pragma unroll
                    for (int u = 0; u < 8; ++u) {
                        const int key = __builtin_amdgcn_readlane(kq[c], 8 * g + u); const float s = rdlane(aq[c], 8 * g + u);
                        const float sa = (key & 512) ? 0.f : s, sb = (key & 512) ? s : 0.f; const f32x2 s0 = {sa, sa}, s1 = {sb, sb};
#pragma unroll
                        for (int i = 0; i < 2; ++i) { const v4u w = vb[u][i];
                            const f32x2 c0 = __builtin_amdgcn_cvt_pk_f32_fp8((int)w.x, false), c1 = __builtin_amdgcn_cvt_pk_f32_fp8((int)w.x, true), c2 = __builtin_amdgcn_cvt_pk_f32_fp8((int)w.y, false), c3 = __builtin_amdgcn_cvt_pk_f32_fp8((int)w.y, true);
                            const f32x2 c4 = __builtin_amdgcn_cvt_pk_f32_fp8((int)w.z, false), c5 = __builtin_amdgcn_cvt_pk_f32_fp8((int)w.z, true), c6 = __builtin_amdgcn_cvt_pk_f32_fp8((int)w.w, false), c7 = __builtin_amdgcn_cvt_pk_f32_fp8((int)w.w, true);
                            y[0][8 * i + 0] = __builtin_elementwise_fma(c0, s0, y[0][8 * i + 0]); y[1][8 * i + 0] = __builtin_elementwise_fma(c0, s1, y[1][8 * i + 0]);
                            y[0][8 * i + 1] = __builtin_elementwise_fma(c1, s0, y[0][8 * i + 1]); y[1][8 * i + 1] = __builtin_elementwise_fma(c1, s1, y[1][8 * i + 1]);
                            y[0][8 * i + 2] = __builtin_elementwise_fma(c2, s0, y[0][8 * i + 2]); y[1][8 * i + 2] = __builtin_elementwise_fma(c2, s1, y[1][8 * i + 2]);
                            y[0][8 * i + 3] = __builtin_elementwise_fma(c3, s0, y[0][8 * i + 3]); y[1][8 * i + 3] = __builtin_elementwise_fma(c3, s1, y[1][8 * i + 3]);
                            y[0][8 * i + 4] = __builtin_elementwise_fma(c4, s0, y[0][8 * i + 4]); y[1][8 * i + 4] = __builtin_elementwise_fma(c4, s1, y[1][8 * i + 4]);
                            y[0][8 * i + 5] = __builtin_elementwise_fma(c5, s0, y[0][8 * i + 5]); y[1][8 * i + 5] = __builtin_elementwise_fma(c5, s1, y[1][8 * i + 5]);
                            y[0][8 * i + 6] = __builtin_elementwise_fma(c6, s0, y[0][8 * i + 6]); y[1][8 * i + 6] = __builtin_elementwise_fma(c6, s1, y[1][8 * i + 6]);
                            y[0][8 * i + 7] = __builtin_elementwise_fma(c7, s0, y[0][8 * i + 7]); y[1][8 * i + 7] = __builtin_elementwise_fma(c7, s1, y[1][8 * i + 7]); }
                        { const int ix = 8 * g + 8 + u, ka = __builtin_amdgcn_readlane(kq[c], ix & 63), kb = __builtin_amdgcn_readlane(kq[c < 3 ? c + 1 : 3], ix & 63), kn = (ix < 64) ? ka : kb;
                            const GAS v4u* vp = (const GAS v4u*)(V8 + (size_t)((kn >> 10) & 0x3fff) * 2048) + lane; vb[u][0] = vp[0]; vb[u][1] = vp[64]; }
                    }
                }
            }
#pragma unroll
            for (int j = 0; j < 2; ++j) { const size_t t = (size_t)tb + (size_t)(2 * pp + j) * NGW;
                GAS f32x4* orw = (GAS f32x4*)(OUT + t * DM); float ss = 0.f;
#pragma unroll
                for (int i = 0; i < 2; ++i)
#pragma unroll
                    for (int hv = 0; hv < 2; ++hv) { const v4u w = *(const GAS v4u*)(X1B + t * DM + i * 1024 + lane * 16 + 8 * hv);
                        y[j][8 * i + 4 * hv + 0] += (f32x2){bflo(w.x), bfhi(w.x)}; y[j][8 * i + 4 * hv + 1] += (f32x2){bflo(w.y), bfhi(w.y)}; y[j][8 * i + 4 * hv + 2] += (f32x2){bflo(w.z), bfhi(w.z)}; y[j][8 * i + 4 * hv + 3] += (f32x2){bflo(w.w), bfhi(w.w)}; }
#pragma unroll
                for (int q = 0; q < 16; ++q) ss += y[j][q][0] * y[j][q][0] + y[j][q][1] * y[j][q][1];
                const float r3 = 1.0f / sqrtf(wave_sum_dpp(ss) * (1.0f / DM) + RMS_EPS);
#pragma unroll
                for (int i = 0; i < 2; ++i)
#pragma unroll
                    for (int q = 0; q < 4; ++q) { const f32x4 ga = *(const GAS f32x4*)(gfin + i * 1024 + lane * 16 + 4 * q);
                        orw[i * 256 + 4 * lane + q] = (f32x4){y[j][8 * i + 2 * q][0] * r3 * ga[0], y[j][8 * i + 2 * q][1] * r3 * ga[1], y[j][8 * i + 2 * q + 1][0] * r3 * ga[2], y[j][8 * i + 2 * q + 1][1] * r3 * ga[3]}; }
            }
        }
        asm volatile("s_waitcnt lgkmcnt(0)" ::: "memory");
    }
}

struct Args { const float* in[15]; float* out; unsigned char* ws; double invf[16]; int ph_lo, ph_hi, li, pad; };
__global__ void __launch_bounds__(NWAVES * 64, 2) mk_fwd(Args args) {
    extern __shared__ __attribute__((aligned(16))) unsigned char lds[];
    Ctx F;
    F.lds = (LAS unsigned char*)lds;
    volatile LAS unsigned* MISC = (volatile LAS unsigned*)(F.lds + MISC_OFF);
    F.tid = threadIdx.x; F.lane = F.tid & 63; F.wave = __builtin_amdgcn_readfirstlane(F.tid >> 6);
    F.G = gridDim.x; { const int bx = blockIdx.x; F.vcu = (F.G % 8 == 0) ? (bx % 8) * (F.G / 8) + bx / 8 : bx; }
    unsigned char* ws = args.ws;
    gu32* ctl = (gu32*)(ws + WS_CTL);
    for (int u = F.tid; u < (LDS_BYTES - LDSCTL_OFF) / 4; u += NWAVES * 64) ((LAS unsigned*)(F.lds + LDSCTL_OFF))[u] = 0u;
    __syncthreads();
    XcdBarrier bar; bar.bar = (unsigned*)(ctl + CW_BAR); bar.x = 0; bar.st = nullptr;
    if (N_LAUNCHES != PER_PHASE) bar = xcd_barrier_post((unsigned*)(ctl + CW_BAR), MISC + 8);
#define GRID_BAR() do { if (N_LAUNCHES != PER_PHASE) xcd_barrier(bar); } while (0)
    const int lo = args.ph_lo, hi = args.ph_hi;
#define IN(k) (lo <= (k) && (k) < hi)
#define BOTH(k) (IN(k) && IN((k) + 1))
    bf16* WinT = (bf16*)(ws + WS_WIN); bf16* WbcT = (bf16*)(ws + WS_WBC); bf16* WbaT = (bf16*)(ws + WS_WBA); bf16* WoutT = (bf16*)(ws + WS_WOUT); bf16* WpqT = (bf16*)(ws + WS_WPQ);
    bf16* KEYS = (bf16*)(ws + WS_KEYS); float* CS = (float*)(ws + WS_CS); const unsigned char* UB = ws + WS_UB; const unsigned char* VB = ws + WS_VB;
    bf16* XB = (bf16*)(ws + WS_XB); bf16* T6 = (bf16*)(ws + WS_T6); bf16* GAB = (bf16*)(ws + WS_GAB); bf16* UC = (bf16*)(ws + WS_UC); bf16* AO = (bf16*)(ws + WS_AO);
    bf16* TMP = (bf16*)(ws + WS_TMP); bf16* MB = (bf16*)(ws + WS_MB); bf16* X1B = (bf16*)(ws + WS_X1B); bf16* QP = (bf16*)(ws + WS_QP);
    int* EXP = (int*)(ws + WS_EXP); float* GATE = (float*)(ws + WS_GATE);
    unsigned long long* SS = (unsigned long long*)(ws + WS_SS); float* KSUM = (float*)(ws + WS_KSUM);
    constexpr size_t TS = (size_t)M * 1024;

    if (IN(0)) { for (int rep = 0; rep < NREP(0); ++rep) { p0_prologue(F, args.in, ws, args.invf); if (rep + 1 < NREP(0)) GRID_BAR(); } if (BOTH(0)) GRID_BAR(); }
    if (IN(1)) {
        for (int rep = 0; rep < NREP(1); ++rep) {
        pg8::Gemm g{XB, WinT, M, INW, DM}; pg8::StaticOrder S; S.init(M, INW, F.G, (int)blockIdx.x);
        pg8::EpiIn E{T6, GAB, args.in[4], CS, KSUM};
        pg8::gemm_phase<pg8::EpiIn, pg8::StaticOrder, true, true>(F.lds + RING_OFF, g, S, E);
        if (rep + 1 < NREP(1)) GRID_BAR(); }
        if (BOTH(1)) GRID_BAR();
    }
    if (IN(2)) {
        for (int rep = 0; rep < NREP(2); ++rep) {
        attn_mfma(F, T6 + 3 * TS, T6 + 4 * TS, T6 + 5 * TS, KSUM, AO);
        conv_phase(F, T6, T6 + TS, T6 + 2 * TS, args.in[5], UC);
        if (rep + 1 < NREP(2)) GRID_BAR(); }
        if (BOTH(2)) GRID_BAR();
    }
    if (IN(3)) {
        for (int rep = 0; rep < NREP(3); ++rep) {
        pg8::Gemm g{UC, WbcT, M, DM, 1024, AO, WbaT}; pg8::TwoSegOrder S; S.init(M, DM, F.G, (int)blockIdx.x);
        pg8::EpiMerge2 E{GAB, GAB + (size_t)M * DM, MB};
        pg8::gemm_phase<pg8::EpiMerge2, pg8::TwoSegOrder, true, true>(F.lds + RING_OFF, g, S, E);
        if (rep + 1 < NREP(3)) GRID_BAR(); }
        if (BOTH(3)) GRID_BAR();
    }
    if (IN(5)) {
        for (int rep = 0; rep < NREP(5); ++rep) {
        pg8::Gemm g{MB, WoutT, M, DM, DM}; pg8::StaticOrder S; S.init(M, DM, F.G, (int)blockIdx.x);
        pg8::EpiX1 E{args.in[0], args.out, X1B, (rep + 1 < NREP(5)) ? (unsigned long long*)(ws + 768 * 1024) : SS};
        pg8::gemm_phase<pg8::EpiX1, pg8::StaticOrder, true, true>(F.lds + RING_OFF, g, S, E);
        if (rep + 1 < NREP(5)) GRID_BAR(); }
        if (BOTH(5)) GRID_BAR();
    }
    if (IN(6)) {
        for (int rep = 0; rep < NREP(6); ++rep) {
        pg8::Gemm g{X1B, WpqT, M, DM, DM}; pg8::StaticOrder S; S.init(M, DM, F.G, (int)blockIdx.x);
        pg8::EpiQP E{SS, QP};
        pg8::gemm_phase<pg8::EpiQP, pg8::StaticOrder, true, true>(F.lds + RING_OFF, g, S, E);
        if (rep + 1 < NREP(6)) GRID_BAR(); }
        if (BOTH(6)) GRID_BAR();
    }
    if (IN(7)) { for (int rep = 0; rep < NREP(7); ++rep) {
        for (int bitem = F.vcu; bitem < 256; bitem += F.G) {
            topk_stage_keys(F, KEYS, bitem & 7);
            if (F.wave >= 4 && bitem == F.vcu) convert_tables(F, args.in[12], args.in[13], args.in[9], ws);
            topk_phase(F, bitem, QP, EXP, GATE);
            if (F.wave < 4 && bitem == F.vcu) convert_tables(F, args.in[12], args.in[13], args.in[9], ws);
            asm volatile("s_waitcnt lgkmcnt(0)" ::: "memory"); __builtin_amdgcn_s_barrier(); asm volatile("" ::: "memory");
        }
        if (rep + 1 < NREP(7)) GRID_BAR(); } if (BOTH(7)) GRID_BAR(); }
    if (IN(8)) { for (int rep = 0; rep < NREP(8); ++rep) { peer_phase(F, UB, VB, X1B, EXP, GATE, SS, args.in[14], args.out, (rep + 1 < NREP(8)) ? (float*)(ws + WS_END) : args.out); if (rep + 1 < NREP(8)) GRID_BAR(); } }
#undef IN
#undef BOTH
#undef GRID_BAR
}

extern "C" void kernel_launch(void* const* d_in, const int* in_sizes, int n_in, void* d_out, int out_size, void* d_ws, size_t ws_size, hipStream_t stream) {
    static int grid = 0;
    if (grid == 0) {
        if (n_in != 15 || in_sizes[0] != M * DM || out_size != M * DM || ws_size < WS_END) { fprintf(stderr, "kernel_launch: unexpected shapes (n_in %d, in0 %d, out %d, ws %zu)\n", n_in, n_in > 0 ? in_sizes[0] : -1, out_size, ws_size); grid = -1; return; }
        int dev = 0, cus = 0, per_cu = 0;
        if (hipGetDevice(&dev) != hipSuccess || hipDeviceGetAttribute(&cus, hipDeviceAttributeMultiprocessorCount, dev) != hipSuccess) { grid = -1; return; }
        if (hipFuncSetAttribute((const void*)mk_fwd, hipFuncAttributeMaxDynamicSharedMemorySize, LDS_BYTES) != hipSuccess) { fprintf(stderr, "kernel_launch: hipFuncSetAttribute failed\n"); grid = -1; return; }
        if (hipOccupancyMaxActiveBlocksPerMultiprocessor(&per_cu, (const void*)mk_fwd, NWAVES * 64, LDS_BYTES) != hipSuccess || per_cu < 1) fprintf(stderr, "kernel_launch: occupancy query reports %d\n", per_cu);
        (void)hipGetLastError();
        grid = cus;
        if (M % (4 * grid * NWAVES) != 0) { fprintf(stderr, "kernel_launch: the PEER phase needs M %% (32 * grid) == 0 (grid %d)\n", grid); grid = -1; return; }
    }
    if (grid < 0) return;
    if (hipMemsetAsync((char*)d_ws + WS_CTL, 0, CTL_ZERO_BYTES, stream) != hipSuccess) { fprintf(stderr, "kernel_launch: memset failed\n"); return; }
    Args a{};
    for (int i = 0; i < 15; ++i) a.in[i] = (const float*)d_in[i];
    a.out = (float*)d_out; a.ws = (unsigned char*)d_ws;
    for (int f = 0; f < 16; ++f) a.invf[f] = pow(500000.0, -(double)(2 * f) / 32.0);
    for (int li = 0; li < N_LAUNCHES; ++li) {
        a.ph_lo = (N_LAUNCHES == PER_PHASE) ? li : 0; a.ph_hi = (N_LAUNCHES == PER_PHASE) ? li + 1 : PER_PHASE; a.li = li;
        hipLaunchKernelGGL(mk_fwd, dim3(grid), dim3(NWAVES * 64), LDS_BYTES, stream, a);
        const hipError_t le = hipPeekAtLastError();
        if (le != hipSuccess) { fprintf(stderr, "kernel_launch: launch %d failed: %s\n", li, hipGetErrorName(le)); break; }
    }
}
```

```cpp
#include <hip/hip_runtime.h>
#include <cstdio>
#include <cstdint>
#include <cmath>
namespace pg8 {
#define PG8_LAS __attribute__((address_space(3)))
typedef unsigned short bf16_t;
typedef short bf16x8 __attribute__((ext_vector_type(8)));
typedef float f32x4 __attribute__((ext_vector_type(4)));
typedef unsigned u32x4 __attribute__((ext_vector_type(4)));
constexpr int BM = 256, BK = 64, HALF = 128, HTB = HALF * BK * 2  , STAGE_BYTES = 8 * HTB, NXCD = 8, WGM = 8;

__host__ __device__ __forceinline__ int lds_byte(int r, int c) { const int st = (r >> 4) * 2 + (c >> 5), rr = r & 15, cc = c & 31, ob = rr * 64 + cc * 2; return st * 1024 + (ob ^ (((ob >> 9) & 1) << 5)); }
__host__ __device__ __forceinline__ void stage_rc(int b, int& R, int& C) { const int st = b / 1024, sb = b % 1024, swz = sb ^ (((sb >> 9) & 1) << 5); R = (st >> 1) * 16 + swz / 64; C = (st & 1) * 32 + (swz % 64) / 2; }
__host__ __device__ __forceinline__ int perm32(int rho) { const int n = rho >> 4, i = rho & 15; return 8 * (i >> 2) + 4 * n + (i & 3); }

struct Unit { int pm, pn, seg; };
struct Gemm { const bf16_t* A; const bf16_t* Bt; int M, N, K; const bf16_t* A2; const bf16_t* Bt2; };

struct StaticOrder {
    int nM, nN, nwg, G, c;
    __host__ __device__ void init(int M, int N, int G_, int c_) { nM = M / BM; nN = N / BM; nwg = nM * nN; G = G_; c = c_; }
    __host__ __device__ bool next(int i, Unit& u) const {
        const long L = (long)i * G + c; if (L >= nwg) return false;
        int wgid = (int)L; { const int q = nwg / NXCD, r = nwg % NXCD, xcd = wgid % NXCD, off = wgid / NXCD; wgid = (xcd < r ? xcd * (q + 1) : r * (q + 1) + (xcd - r) * q) + off; }
        const int nig = WGM * nN, gid = wgid / nig, fm = gid * WGM, gsz = (nM - fm) < WGM ? (nM - fm) : WGM;
        u.pm = fm + ((wgid % nig) % gsz); u.pn = (wgid % nig) / gsz; u.seg = 0; return true;
    }
    __device__ __forceinline__ void a_ready(const Unit&) const {}
    __device__ __forceinline__ void done(const Unit&) const {}
};
struct TwoSegOrder {
    StaticOrder so;
    __host__ __device__ void init(int M, int N, int G_, int c_) { so.init(M, N, G_, c_); }
    __host__ __device__ bool next(int i, Unit& u) const { if (!so.next(i >> 1, u)) return false; u.seg = i & 1; return true; }
    __device__ __forceinline__ void a_ready(const Unit&) const {}
    __device__ __forceinline__ void done(const Unit&) const {}
};


typedef float f32x2c __attribute__((ext_vector_type(2))); typedef __bf16 bf16x2c __attribute__((ext_vector_type(2)));
__device__ __forceinline__ unsigned cvt_pk_bf16(float lo, float hi) { const f32x2c v = {lo, hi}; const bf16x2c b = __builtin_convertvector(v, bf16x2c); return __builtin_bit_cast(unsigned, b); }
__device__ __forceinline__ u32x4 pack8(f32x4 a, f32x4 b) { u32x4 w; w.x = cvt_pk_bf16(a[0], a[1]); w.y = cvt_pk_bf16(a[2], a[3]); w.z = cvt_pk_bf16(b[0], b[1]); w.w = cvt_pk_bf16(b[2], b[3]); return w; }
__device__ __forceinline__ f32x4 shx(f32x4 v, int o) { f32x4 r; r[0] = __shfl_xor(v[0], o); r[1] = __shfl_xor(v[1], o); r[2] = __shfl_xor(v[2], o); r[3] = __shfl_xor(v[3], o); return r; }
__device__ __forceinline__ f32x4 bf4lo(unsigned a, unsigned b) { f32x4 r; r[0] = __uint_as_float(a << 16); r[1] = __uint_as_float(a & 0xffff0000u); r[2] = __uint_as_float(b << 16); r[3] = __uint_as_float(b & 0xffff0000u); return r; }
__device__ __forceinline__ f32x4 sigm4(f32x4 v) { f32x4 r;
#pragma unroll
    for (int i = 0; i < 4; ++i) r[i] = __builtin_amdgcn_rcpf(1.0f + __expf(-v[i])); return r; }
constexpr float QSCALE = 0.08838834764831845f * 1.4426950408889634f;

struct EpiIn {
    static constexpr bool PERM = true, AFTER_DRAIN = false, KEEP_SEG0 = false;
    bf16_t* T6; bf16_t* GAB; const float* gbias; const float* cs; float* ksum;
    __device__ __forceinline__ void operator()(const f32x4 (&acc)[2][2][4][2], const Unit& u, int wr, int wc, int fr, int fq) const {
        const int row0 = u.pm * BM + wr * 64 + fr, pn = u.pn, colw = wc * 32 + 8 * fq;
        if (pn < 24) {
            const int t = pn >> 2;
            bf16_t* base = T6 + (size_t)t * ((size_t)8192 * 1024) + (pn & 3) * 256 + colw;
            const bool rot = (t == 3 || t == 4) && (wc == 0), isk = (t == 4);
            const float qs = (t == 3) ? QSCALE : 1.0f;
            f32x4 ks[2][2];
#pragma unroll
            for (int bj = 0; bj < 2; ++bj) { ks[bj][0] = (f32x4){0.f, 0.f, 0.f, 0.f}; ks[bj][1] = (f32x4){0.f, 0.f, 0.f, 0.f}; }
#pragma unroll
            for (int ai = 0; ai < 2; ++ai)
#pragma unroll
                for (int m = 0; m < 4; ++m) {
                    const int row = row0 + ai * HALF + m * 16;
                    f32x4 c0 = (f32x4){1.f, 1.f, 1.f, 1.f}, c1 = c0, s0 = (f32x4){0.f, 0.f, 0.f, 0.f}, s1 = s0;
                    if (rot) { const float* cp = cs + (size_t)row * 32 + 8 * (fq & 1); c0 = *(const f32x4*)cp; c1 = *(const f32x4*)(cp + 4); s0 = *(const f32x4*)(cp + 16); s1 = *(const f32x4*)(cp + 20);
                        if (fq < 2) { s0 = -s0; s1 = -s1; } }
#pragma unroll
                    for (int bj = 0; bj < 2; ++bj) {
                        f32x4 v0 = acc[ai][bj][m][0], v1 = acc[ai][bj][m][1];
                        if (rot) { const f32x4 p0 = shx(v0, 32), p1 = shx(v1, 32); v0 = v0 * c0 + p0 * s0; v1 = v1 * c1 + p1 * s1; }
                        if (isk) { ks[bj][0] += v0; ks[bj][1] += v1; }
                        v0 = v0 * qs; v1 = v1 * qs;
                        *(u32x4*)(base + (size_t)row * 1024 + bj * HALF) = pack8(v0, v1);
                    }
                }
            if (isk) {
#pragma unroll
                for (int bj = 0; bj < 2; ++bj)
#pragma unroll
                    for (int n = 0; n < 2; ++n) { f32x4 v = ks[bj][n]; v += shx(v, 1); v += shx(v, 2); v += shx(v, 4); v += shx(v, 8);
                        if (fr == 0) { float* kp = ksum + (size_t)u.pm * 1024 + (pn & 3) * 256 + bj * HALF + colw + 4 * n;
                            unsafeAtomicAdd(kp + 0, v[0]); unsafeAtomicAdd(kp + 1, v[1]); unsafeAtomicAdd(kp + 2, v[2]); unsafeAtomicAdd(kp + 3, v[3]); } }
            }
        } else {
            const int t = (pn - 24) >> 3, colg = ((pn - 24) & 7) * 256 + colw;
            bf16_t* base = GAB + (size_t)t * ((size_t)8192 * 2048) + colg;
            const float* bp = gbias + t * 2048 + colg;
            f32x4 bv[2][2];
#pragma unroll
            for (int bj = 0; bj < 2; ++bj) { bv[bj][0] = *(const f32x4*)(bp + bj * HALF); bv[bj][1] = *(const f32x4*)(bp + bj * HALF + 4); }
#pragma unroll
            for (int ai = 0; ai < 2; ++ai)
#pragma unroll
                for (int m = 0; m < 4; ++m) { const int row = row0 + ai * HALF + m * 16;
#pragma unroll
                    for (int bj = 0; bj < 2; ++bj) *(u32x4*)(base + (size_t)row * 2048 + bj * HALF) = pack8(sigm4(acc[ai][bj][m][0] + bv[bj][0]), sigm4(acc[ai][bj][m][1] + bv[bj][1])); }
        }
    }
};
struct EpiMerge2 {
    static constexpr bool PERM = true, AFTER_DRAIN = false, KEEP_SEG0 = true;
    const bf16_t* GA; const bf16_t* GB; bf16_t* O;
    __device__ __forceinline__ void operator()(f32x4 (&acc)[2][2][4][2], const Unit& u, int wr, int wc, int fr, int fq) const {
        const int row0 = u.pm * BM + wr * 64 + fr, col0 = u.pn * BM + wc * 32 + 8 * fq;
        if (u.seg == 0) {
#pragma unroll
            for (int ai = 0; ai < 2; ++ai)
#pragma unroll
                for (int m = 0; m < 4; ++m) { const size_t off = (size_t)(row0 + ai * HALF + m * 16) * 2048 + col0;
#pragma unroll
                    for (int bj = 0; bj < 2; ++bj) { const u32x4 a = *(const u32x4*)(GA + off + bj * HALF), b = *(const u32x4*)(GB + off + bj * HALF);
                        const f32x4 b0 = bf4lo(b.x, b.y), b1 = bf4lo(b.z, b.w); f32x4 r0, r1;
#pragma unroll
                        for (int e = 0; e < 4; ++e) { r0[e] = __builtin_amdgcn_rcpf(fmaxf(b0[e], 1e-20f)); r1[e] = __builtin_amdgcn_rcpf(fmaxf(b1[e], 1e-20f)); }
                        acc[ai][bj][m][0] = acc[ai][bj][m][0] * (bf4lo(a.x, a.y) * r0); acc[ai][bj][m][1] = acc[ai][bj][m][1] * (bf4lo(a.z, a.w) * r1); } }
        } else {
#pragma unroll
            for (int ai = 0; ai < 2; ++ai)
#pragma unroll
                for (int m = 0; m < 4; ++m) { const size_t off = (size_t)(row0 + ai * HALF + m * 16) * 2048 + col0;
#pragma unroll
                    for (int bj = 0; bj < 2; ++bj) { const u32x4 b = *(const u32x4*)(GB + off + bj * HALF);
                        f32x4 b0 = bf4lo(b.x, b.y), b1 = bf4lo(b.z, b.w);
#pragma unroll
                        for (int e = 0; e < 4; ++e) { b0[e] = fmaxf(b0[e], 1e-20f); b1[e] = fmaxf(b1[e], 1e-20f); }
                        *(u32x4*)(O + off + bj * HALF) = pack8(acc[ai][bj][m][0] * b0, acc[ai][bj][m][1] * b1); } }
        }
    }
};
struct EpiX1 {
    static constexpr bool PERM = true, AFTER_DRAIN = false, KEEP_SEG0 = false;
    const float* X; float* X1; bf16_t* X1B; unsigned long long* SS;
    __device__ __forceinline__ void operator()(const f32x4 (&acc)[2][2][4][2], const Unit& u, int wr, int wc, int fr, int fq) const {
        const int row0 = u.pm * BM + wr * 64 + fr, col0 = u.pn * BM + wc * 32 + 8 * fq;
#pragma unroll
        for (int ai = 0; ai < 2; ++ai)
#pragma unroll
            for (int m = 0; m < 4; ++m) { const int row = row0 + ai * HALF + m * 16; const size_t off = (size_t)row * 2048 + col0; float sq = 0.f;
#pragma unroll
                for (int bj = 0; bj < 2; ++bj) { const f32x4 v0 = acc[ai][bj][m][0] + *(const f32x4*)(X + off + bj * HALF), v1 = acc[ai][bj][m][1] + *(const f32x4*)(X + off + bj * HALF + 4);
                    *(u32x4*)(X1B + off + bj * HALF) = pack8(v0, v1);
                    sq += (v0[0] * v0[0] + v0[1] * v0[1]) + (v0[2] * v0[2] + v0[3] * v0[3]) + (v1[0] * v1[0] + v1[1] * v1[1]) + (v1[2] * v1[2] + v1[3] * v1[3]); }
                sq += __shfl_xor(sq, 16); sq += __shfl_xor(sq, 32);
                if (fq == 0) atomicAdd(SS + row, (unsigned long long)(sq * 4294967296.0f)); }
    }
};
__device__ __forceinline__ float rinv_from_ss(unsigned long long s) { return 1.0f / sqrtf((float)((double)s * (1.0 / 4294967296.0) * (1.0 / 2048.0)) + 1e-6f); }
struct EpiQP {
    static constexpr bool PERM = true, AFTER_DRAIN = false, KEEP_SEG0 = false;
    const unsigned long long* SS; bf16_t* O;
    __device__ __forceinline__ void operator()(const f32x4 (&acc)[2][2][4][2], const Unit& u, int wr, int wc, int fr, int fq) const {
        const int row0 = u.pm * BM + wr * 64 + fr, col0 = u.pn * BM + wc * 32 + 8 * fq;
#pragma unroll
        for (int ai = 0; ai < 2; ++ai)
#pragma unroll
            for (int m = 0; m < 4; ++m) { const int row = row0 + ai * HALF + m * 16; const size_t off = (size_t)row * 2048 + col0; const float rv = rinv_from_ss(SS[row]);
#pragma unroll
                for (int bj = 0; bj < 2; ++bj) *(u32x4*)(O + off + bj * HALF) = pack8(acc[ai][bj][m][0] * rv, acc[ai][bj][m][1] * rv); }
    }
};

template <class Epi, class Sched, bool ALIGN_EPI = false, bool SP2 = false>
__device__ __forceinline__ void gemm_phase(PG8_LAS unsigned char* lds, const Gemm g, const Sched& S, const Epi& E) {
    const int tid = threadIdx.x, wid = __builtin_amdgcn_readfirstlane(tid >> 6), lane = tid & 63, wr = wid >> 2, wc = wid & 3, fr = lane & 15, fq = lane >> 4;
    const int K = g.K, nt = K / BK;
    unsigned voffA[2], voffB[2];
#pragma unroll
    for (int i = 0; i < 2; ++i) { int R, C; stage_rc(tid * 16 + i * 8192, R, C); const int Rb = Epi::PERM ? ((R & ~31) + perm32(R & 31)) : R;
        voffA[i] = (unsigned)(R * K + C) * 2u; voffB[i] = (unsigned)(Rb * K + C) * 2u; }
    const size_t kstep = (size_t)(BK * 2);
    const size_t hstep = (size_t)HALF * K * 2;
    const size_t tstep = 2 * hstep;
    const unsigned ldsw = (unsigned)wid * 1024u;
    const int aoff = lds_byte(wr * 64 + fr, fq * 8), boff = lds_byte(wc * 32 + fr, fq * 8);
#define PG8_SA(b, h) (((b) * 2 + (h)) * HTB)
#define PG8_SB(b, h) ((4 + (b) * 2 + (h)) * HTB)
#define PG8_STAGE(bufoff, gbase, voff) do { _Pragma("unroll") for (int _i = 0; _i < 2; ++_i) \
        __builtin_amdgcn_global_load_lds((const unsigned*)((const char*)(gbase) + (voff)[_i]), (PG8_LAS unsigned*)(lds + (bufoff) + ldsw + _i * 8192), 16, 0, 0); } while (0)
#define PG8_LDA(dst, b, h) do { _Pragma("unroll") for (int m = 0; m < 4; ++m) _Pragma("unroll") for (int k = 0; k < 2; ++k) dst[m][k] = *(const PG8_LAS bf16x8*)(lds + PG8_SA(b, h) + aoff + m * 2048 + k * 1024); } while (0)
#define PG8_LDB(dst, b, h) do { _Pragma("unroll") for (int n = 0; n < 2; ++n) _Pragma("unroll") for (int k = 0; k < 2; ++k) dst[n][k] = *(const PG8_LAS bf16x8*)(lds + PG8_SB(b, h) + boff + n * 2048 + k * 1024); } while (0)
#define PG8_MMA(ai, bj, At, Bt) do { __builtin_amdgcn_s_setprio(1); _Pragma("unroll") for (int m = 0; m < 4; ++m) _Pragma("unroll") for (int n = 0; n < 2; ++n) _Pragma("unroll") for (int k = 0; k < 2; ++k) \
        acc[ai][bj][m][n] = __builtin_amdgcn_mfma_f32_16x16x32_bf16(Bt[n][k], At[m][k], acc[ai][bj][m][n], 0, 0, 0); __builtin_amdgcn_s_setprio(0); } while (0)
#define PG8_WAIT_V(n) asm volatile("s_waitcnt vmcnt(" #n ")" ::: "memory")
#define PG8_WAIT_L(n) asm volatile("s_waitcnt lgkmcnt(" #n ")" ::: "memory")
#define PG8_BAR __builtin_amdgcn_s_barrier()
#define PG8_SCHED __builtin_amdgcn_sched_barrier(0)
    Unit cur, nxt; int ui = 0;
    if (!S.next(0, cur)) return;
    f32x4 acc[2][2][4][2];
#pragma unroll
    for (int a = 0; a < 2; ++a)
#pragma unroll
        for (int b = 0; b < 2; ++b)
#pragma unroll
            for (int m = 0; m < 4; ++m)
#pragma unroll
                for (int n = 0; n < 2; ++n) acc[a][b][m][n] = (f32x4){0.f, 0.f, 0.f, 0.f};
    bf16x8 At[4][2], B0[2][2], B1[2][2];
    const char* cA = (const char*)(cur.seg ? g.A2 : g.A) + (size_t)cur.pm * tstep; const char* cB = (const char*)(cur.seg ? g.Bt2 : g.Bt) + (size_t)cur.pn * tstep;
    S.a_ready(cur);
    if constexpr (SP2) {
        PG8_STAGE(PG8_SB(0, 0), cB, voffB); PG8_STAGE(PG8_SB(0, 1), cB + hstep, voffB); PG8_STAGE(PG8_SA(0, 0), cA, voffA); PG8_STAGE(PG8_SA(0, 1), cA + hstep, voffA);
        if (wr == 1) PG8_BAR;
        PG8_WAIT_V(2); PG8_BAR;
        PG8_STAGE(PG8_SB(1, 0), cB + kstep, voffB); PG8_STAGE(PG8_SA(1, 0), cA + kstep, voffA); PG8_STAGE(PG8_SB(1, 1), cB + hstep + kstep, voffB);
        PG8_WAIT_V(6); PG8_BAR;
    } else {
        PG8_STAGE(PG8_SB(0, 0), cB, voffB); PG8_STAGE(PG8_SA(0, 0), cA, voffA); PG8_STAGE(PG8_SB(0, 1), cB + hstep, voffB); PG8_STAGE(PG8_SA(0, 1), cA + hstep, voffA);
        if (wr == 1) PG8_BAR;
        PG8_WAIT_V(4); PG8_BAR;
        PG8_STAGE(PG8_SB(1, 0), cB + kstep, voffB); PG8_STAGE(PG8_SA(1, 0), cA + kstep, voffA); PG8_STAGE(PG8_SB(1, 1), cB + hstep + kstep, voffB);
        PG8_WAIT_V(6); PG8_BAR;
    }
    for (;;) {
        const bool has_next = S.next(ui + 1, nxt);
        const char* nA = has_next ? (const char*)(nxt.seg ? g.A2 : g.A) + (size_t)nxt.pm * tstep : cA; const char* nB = has_next ? (const char*)(nxt.seg ? g.Bt2 : g.Bt) + (size_t)nxt.pn * tstep : cB;
        for (int t = 0; t < nt; t += 2) {
            const bool last = (t == nt - 2);
            const char* a1 = cA + (size_t)(t + 1) * kstep;
            const char* a2 = last ? nA : cA + (size_t)(t + 2) * kstep; const char* b2 = last ? nB : cB + (size_t)(t + 2) * kstep;
            const char* a3 = a2 + kstep; const char* b3 = b2 + kstep;
            if (last && has_next) S.a_ready(nxt);
            if constexpr (SP2) {
            PG8_LDB(B0, 0, 0); PG8_LDB(B1, 0, 1); PG8_SCHED; PG8_LDA(At, 0, 0); PG8_STAGE(PG8_SA(1, 1), a1 + hstep, voffA);
            PG8_WAIT_V(8); PG8_WAIT_L(0); PG8_BAR; PG8_MMA(0, 0, At, B0); PG8_MMA(0, 1, At, B1); PG8_BAR; PG8_SCHED;
            PG8_LDA(At, 0, 1); PG8_STAGE(PG8_SB(0, 0), b2, voffB); PG8_STAGE(PG8_SB(0, 1), b2 + hstep, voffB); PG8_STAGE(PG8_SA(0, 0), a2, voffA);
            PG8_WAIT_V(8); PG8_WAIT_L(0); PG8_BAR; PG8_MMA(1, 0, At, B0); PG8_MMA(1, 1, At, B1); PG8_BAR; PG8_SCHED;
            PG8_LDB(B0, 1, 0); PG8_LDB(B1, 1, 1); PG8_SCHED; PG8_LDA(At, 1, 0); PG8_STAGE(PG8_SA(0, 1), a2 + hstep, voffA);
            PG8_WAIT_V(8); PG8_WAIT_L(0); PG8_BAR; PG8_MMA(0, 0, At, B0); PG8_MMA(0, 1, At, B1); PG8_BAR; PG8_SCHED;
            PG8_LDA(At, 1, 1); PG8_STAGE(PG8_SB(1, 0), b3, voffB); PG8_STAGE(PG8_SB(1, 1), b3 + hstep, voffB); PG8_STAGE(PG8_SA(1, 0), a3, voffA);
            PG8_WAIT_V(8); PG8_WAIT_L(0); PG8_BAR; PG8_MMA(1, 0, At, B0); PG8_MMA(1, 1, At, B1); PG8_BAR; PG8_SCHED;
            } else {
            PG8_LDB(B0, 0, 0); PG8_SCHED; PG8_LDA(At, 0, 0); PG8_STAGE(PG8_SA(1, 1), a1 + hstep, voffA);
            PG8_WAIT_L(8); PG8_BAR; PG8_WAIT_L(0); PG8_MMA(0, 0, At, B0); PG8_BAR; PG8_SCHED;
            PG8_LDB(B1, 0, 1); PG8_STAGE(PG8_SB(0, 0), b2, voffB);
            PG8_BAR; PG8_WAIT_L(0); PG8_MMA(0, 1, At, B1); PG8_BAR;
            PG8_LDA(At, 0, 1); PG8_STAGE(PG8_SA(0, 0), a2, voffA);
            PG8_BAR; PG8_WAIT_L(0); PG8_MMA(1, 0, At, B0); PG8_BAR; PG8_SCHED;
            PG8_STAGE(PG8_SB(0, 1), b2 + hstep, voffB);
            PG8_WAIT_V(6); PG8_BAR; PG8_MMA(1, 1, At, B1); PG8_BAR;
            PG8_LDB(B0, 1, 0); PG8_SCHED; PG8_LDA(At, 1, 0); PG8_STAGE(PG8_SA(0, 1), a2 + hstep, voffA);
            PG8_WAIT_L(8); PG8_BAR; PG8_WAIT_L(0); PG8_MMA(0, 0, At, B0); PG8_BAR; PG8_SCHED;
            PG8_LDB(B1, 1, 1); PG8_STAGE(PG8_SB(1, 0), b3, voffB);
            PG8_BAR; PG8_WAIT_L(0); PG8_MMA(0, 1, At, B1); PG8_BAR;
            PG8_LDA(At, 1, 1); PG8_STAGE(PG8_SA(1, 0), a3, voffA);
            PG8_BAR; PG8_WAIT_L(0); PG8_MMA(1, 0, At, B0); PG8_BAR; PG8_SCHED;
            PG8_STAGE(PG8_SB(1, 1), b3 + hstep, voffB);
            PG8_WAIT_V(6); PG8_BAR; PG8_MMA(1, 1, At, B1); PG8_BAR;
            }
        }
        if constexpr (ALIGN_EPI) { if (wr == 0) PG8_BAR; }
        if constexpr (!Epi::AFTER_DRAIN) { E(acc, cur, wr, wc, fr, fq); S.done(cur); }
        if (!has_next) break;
        if (!(Epi::KEEP_SEG0 && cur.seg == 0)) {
#pragma unroll
        for (int a = 0; a < 2; ++a)
#pragma unroll
            for (int b = 0; b < 2; ++b)
#pragma unroll
                for (int m = 0; m < 4; ++m)
#pragma unroll
                    for (int n = 0; n < 2; ++n) acc[a][b][m][n] = (f32x4){0.f, 0.f, 0.f, 0.f};
        }
        cur = nxt; cA = nA; cB = nB; ++ui;
        if constexpr (ALIGN_EPI) { if (wr == 1) PG8_BAR; }
    }
    PG8_WAIT_V(0);
    if constexpr (!ALIGN_EPI) { if (wr == 0) PG8_BAR; }
    PG8_BAR;
    if constexpr (Epi::AFTER_DRAIN) { E.fused(acc, cur, wr, wc, fr, fq, lds, wid, lane); S.done(cur); }
#undef PG8_SA
#undef PG8_SB
#undef PG8_STAGE
#undef PG8_LDA
#undef PG8_LDB
#undef PG8_MMA
#undef PG8_WAIT_V
#undef PG8_WAIT_L
#undef PG8_BAR
#undef PG8_SCHED
}
}

constexpr int NWAVES = 8;
#ifndef MK_N_LAUNCHES
#define MK_N_LAUNCHES 1
#endif
constexpr int PER_PHASE = 9;
#ifndef MK_REP_PHASE
#define MK_REP_PHASE -1
#endif
#define NREP(k) (((k) == MK_REP_PHASE) ? 2 : 1)
constexpr int N_LAUNCHES = MK_N_LAUNCHES;
constexpr int M = 8192, SEQ = 4096, DM = 2048, INW = 10240, NEXP = 16384;
constexpr float RMS_EPS = 1e-6f;
constexpr size_t MiB = 1u << 20;
constexpr size_t WS_CTL = 0, CTL_ZERO_BYTES = 64 * 1024;
constexpr size_t WS_SS = 256 * 1024, WS_KSUM = 512 * 1024;
constexpr size_t WS_WIN = 2 * MiB, WS_WBC = 42 * MiB, WS_WBA = 46 * MiB, WS_WOUT = 50 * MiB, WS_WPQ = 58 * MiB, WS_KEYS = 66 * MiB, WS_CS = 67 * MiB;
constexpr size_t WS_UB = 70 * MiB, WS_VB = 102 * MiB;
constexpr size_t WS_XB = 198 * MiB;
constexpr size_t WS_T6 = 230 * MiB;
constexpr size_t WS_GAB = 326 * MiB;
constexpr size_t WS_UC = 390 * MiB, WS_AO = 406 * MiB;
constexpr size_t WS_EXP = 422 * MiB, WS_GATE = 426 * MiB;
constexpr size_t WS_END = 430 * MiB;
constexpr size_t WS_TMP = WS_XB, WS_MB = WS_T6, WS_X1B = WS_T6 + 48 * MiB, WS_QP = WS_GAB;
constexpr int CW_BAR = 4096;
constexpr int RING_OFF = 0, RING_BYTES = 131072;
constexpr int LDSCTL_OFF = RING_BYTES, MISC_OFF = LDSCTL_OFF + 320;
constexpr int LDS_BYTES = 147456;

#define GAS __attribute__((address_space(1)))
#define LAS __attribute__((address_space(3)))
typedef unsigned short bf16;
typedef unsigned v4u __attribute__((ext_vector_type(4)));
typedef float f32x4 __attribute__((ext_vector_type(4)));
typedef short bf16x8 __attribute__((ext_vector_type(8)));
typedef GAS unsigned gu32;
typedef GAS unsigned long long gu64;
#define RLX_AGENT __ATOMIC_RELAXED, __HIP_MEMORY_SCOPE_AGENT
#define LDS_WAIT() asm volatile("s_waitcnt lgkmcnt(0)" ::: "memory")
#define VM_WAIT() asm volatile("s_waitcnt vmcnt(0)" ::: "memory")
__device__ __forceinline__ unsigned long long rt() { return __builtin_amdgcn_s_memrealtime(); }
__device__ __forceinline__ unsigned f2bf(float f) { unsigned u = __builtin_bit_cast(unsigned, f); return (u + 0x7fffu + ((u >> 16) & 1u)) >> 16; }
__device__ __forceinline__ unsigned pk2(float lo, float hi) { return f2bf(lo) | (f2bf(hi) << 16); }

#define XB_TMO      128
#define XB_XCNT(j)  (256  + 64 * (j))
#define XB_XSUB(j)  (1280 + 64 * (j))
#define XB_XGEN(j)  (2304 + 64 * (j))
#define XB_TOP      3328
#define XB_TOPGEN   3392
#define XCD_BAR_WORDS 3456
#define XB_SPIN_CAP (1u << 18)

__device__ __forceinline__ unsigned xb_ld(unsigned* p)              { return __hip_atomic_load(p, __ATOMIC_RELAXED, __HIP_MEMORY_SCOPE_AGENT); }
__device__ __forceinline__ unsigned xb_add(unsigned* p, unsigned v) { return __hip_atomic_fetch_add(p, v, __ATOMIC_RELAXED, __HIP_MEMORY_SCOPE_AGENT); }
__device__ __forceinline__ unsigned xb_xcc_id() { return (unsigned)__builtin_amdgcn_s_getreg((3 << 11) | 20) & 0xFu; }
#define XB_SPIN(cond, bar) do { unsigned _sp = 0; while (cond) { __builtin_amdgcn_s_sleep(1); \
    if ((++_sp & 255u) == 0u) { if (xb_ld(&(bar)[XB_TMO])) break; if (_sp > XB_SPIN_CAP) { atomicAdd(&(bar)[XB_TMO], 1u); break; } } } } while (0)

struct XcdBarrier {
    unsigned* bar; unsigned x;
    volatile LAS unsigned* st;
};

__device__ __forceinline__ XcdBarrier xcd_barrier_post(unsigned* bar, volatile LAS unsigned* st) {
    XcdBarrier b; b.bar = bar; b.x = xb_xcc_id(); b.st = st;
    if (threadIdx.x == 0) (void)xb_add(&bar[XB_XCNT(b.x)], 1u);
    return b;
}
__device__ __forceinline__ void xcd_barrier_complete(unsigned* bar, unsigned x, unsigned& nloc, unsigned& nx) {
    const unsigned G = gridDim.x * gridDim.y * gridDim.z;
    unsigned sum, cnt, mine, sp = 0u;
    for (;;) {
        sum = 0u; cnt = 0u; mine = 0u;
#pragma unroll
        for (unsigned j = 0; j < 16; ++j) { const unsigned c = xb_ld(&bar[XB_XCNT(j)]); sum += c; cnt += (c > 0u) ? 1u : 0u; mine = (j == x) ? c : mine; }
        if (sum == G) break;
        __builtin_amdgcn_s_sleep(1);
        if ((++sp & 255u) == 0u) { if (xb_ld(&bar[XB_TMO])) break; if (sp > XB_SPIN_CAP) { atomicAdd(&bar[XB_TMO], 1u); break; } }
    }
    nloc = mine > 0u ? mine : 1u; nx = cnt > 0u ? cnt : 1u;
}

__device__ __forceinline__ void xcd_barrier(const XcdBarrier& b) {
    asm volatile("s_waitcnt vmcnt(0)" ::: "memory");
    __syncthreads();
    if (threadIdx.x == 0) {
        unsigned* bar = b.bar;
        __builtin_amdgcn_s_waitcnt(0);
        unsigned nloc = b.st[0], nx = b.st[1];
        if (nloc == 0u) { xcd_barrier_complete(bar, b.x, nloc, nx); b.st[0] = nloc; b.st[1] = nx; }
        const unsigned old = xb_add(&bar[XB_XSUB(b.x)], 1u);
        const unsigned gen = old / nloc;
        if (old + 1u == (gen + 1u) * nloc) {
            __builtin_amdgcn_fence(__ATOMIC_RELEASE, "agent");
            asm volatile("s_waitcnt vmcnt(0)" ::: "memory");
            const unsigned og = xb_add(&bar[XB_TOP], 1u);
            const unsigned tg = og / nx;
            if (og + 1u == (tg + 1u) * nx) xb_add(&bar[XB_TOPGEN], 1u);
            else XB_SPIN(xb_ld(&bar[XB_TOPGEN]) == tg, bar);
            __builtin_amdgcn_fence(__ATOMIC_ACQUIRE, "agent");
            xb_add(&bar[XB_XGEN(b.x)], 1u);
            asm volatile("s_waitcnt vmcnt(0)" ::: "memory");
        } else {
            XB_SPIN(xb_ld(&bar[XB_XGEN(b.x)]) == gen, bar);
            __builtin_amdgcn_fence(__ATOMIC_ACQUIRE, "agent");
            asm volatile("s_waitcnt vmcnt(0)" ::: "memory");
        }
    }
    __syncthreads();
}

typedef __bf16 bf16x2v __attribute__((ext_vector_type(2)));
typedef float f32x16 __attribute__((ext_vector_type(16)));
__device__ __forceinline__ float bflo(unsigned w) { return __uint_as_float(w << 16); }
__device__ __forceinline__ float bfhi(unsigned w) { return __uint_as_float(w & 0xffff0000u); }
__device__ __forceinline__ float dot2bf(unsigned a, unsigned b, float c) { return __builtin_amdgcn_fdot2_f32_bf16(__builtin_bit_cast(bf16x2v, a), __builtin_bit_cast(bf16x2v, b), c, false); }
__device__ __forceinline__ float wave_sum(float v) {
#pragma unroll
    for (int o = 1; o < 64; o <<= 1) v += __shfl_xor(v, o);
    return v; }
__device__ __forceinline__ float wave_max(float v) {
#pragma unroll
    for (int o = 1; o < 64; o <<= 1) v = fmaxf(v, __shfl_xor(v, o));
    return v; }
__device__ __forceinline__ float rdlane(float v, int l) { return __int_as_float(__builtin_amdgcn_readlane(__float_as_int(v), l)); }
__device__ __forceinline__ float gelu_tanh(float x) { const float z = 0.7978845608028654f * (x + 0.044715f * x * x * x); const float e = __expf(2.0f * z); const float th = 1.0f - 2.0f * __builtin_amdgcn_rcpf(1.0f + e); return 0.5f * x * (1.0f + th); }

struct Ctx { LAS unsigned char* lds; int tid, lane, wave, vcu, G; };

__device__ __forceinline__ void p0_transpose_item(const float* W, int K, int N, bf16* WT, const float* gk, LAS float* scr, int item, int lane) {
    const int nblk = N / 32, kb = item / nblk, nb = item % nblk, k0 = 64 * kb, n0 = 32 * nb;
#pragma unroll
    for (int i = 0; i < 8; ++i) { const int kk = 8 * i + (lane >> 3), nn = 4 * (lane & 7); f32x4 v = *(const GAS f32x4*)(W + (size_t)(k0 + kk) * N + n0 + nn); if (gk) v = v * gk[k0 + kk];
        scr[kk * 33 + nn] = v[0]; scr[kk * 33 + nn + 1] = v[1]; scr[kk * 33 + nn + 2] = v[2]; scr[kk * 33 + nn + 3] = v[3]; }
    LDS_WAIT(); asm volatile("" ::: "memory");
    const int c = lane & 7;
#pragma unroll
    for (int j = 0; j < 4; ++j) { const int n = (lane >> 3) + 8 * j; const LAS float* s = scr + (8 * c) * 33 + n;
        v4u o; o.x = pk2(s[0 * 33], s[1 * 33]); o.y = pk2(s[2 * 33], s[3 * 33]); o.z = pk2(s[4 * 33], s[5 * 33]); o.w = pk2(s[6 * 33], s[7 * 33]);
        *(GAS v4u*)(WT + (size_t)(n0 + n) * K + k0 + 8 * c) = o; }
    LDS_WAIT(); asm volatile("" ::: "memory");
}
__device__ __forceinline__ void convert_tables(const Ctx& F, const float* pu, const float* pv, const float* g2, unsigned char* ws) {
    const int gt = (F.vcu * NWAVES + F.wave) * 64 + F.lane, NT = F.G * NWAVES * 64;
    for (int i = gt; i < NEXP * 2048 / 16; i += NT) { const int c16 = (i & 127) * 16; v4u ou, ov;
#pragma unroll
        for (int q = 0; q < 4; ++q) { f32x4 a = ((const GAS f32x4*)pu)[4 * i + q]; a = a * *(const GAS f32x4*)(g2 + c16 + 4 * q) * 512.0f; const f32x4 b = ((const GAS f32x4*)pv)[4 * i + q] * 32.0f;
            int wu = 0, wv = 0; wu = __builtin_amdgcn_cvt_pk_fp8_f32(a[0], a[1], wu, false); wu = __builtin_amdgcn_cvt_pk_fp8_f32(a[2], a[3], wu, true);
            wv = __builtin_amdgcn_cvt_pk_fp8_f32(b[0], b[1], wv, false); wv = __builtin_amdgcn_cvt_pk_fp8_f32(b[2], b[3], wv, true); ou[q] = (unsigned)wu; ov[q] = (unsigned)wv; }
        ((GAS v4u*)(ws + WS_UB))[i] = ou; ((GAS v4u*)(ws + WS_VB))[i] = ov; }
}
__device__ __forceinline__ void p0_prologue(const Ctx& F, const float* const* in, unsigned char* ws, const double* invf) {
    const float* x = in[0]; const int* pos = (const int*)in[1]; const float* g1 = in[2]; const float* w_in = in[3];
    const float* w_bc = in[6]; const float* w_ba = in[7]; const float* w_out = in[8]; const float* g2 = in[9]; const float* w_pq = in[10];
    const float* keys = in[11]; const float* pu = in[12]; const float* pv = in[13];
    LAS float* scr = (LAS float*)(F.lds + RING_OFF + F.wave * 16384);
    const int gw = F.vcu * NWAVES + F.wave, NGW = F.G * NWAVES;
    const int gt = gw * 64 + F.lane, NT = NGW * 64;
    for (int i = gt; i < 8192; i += NT) ((GAS unsigned long long*)(ws + WS_SS))[i] = 0ull;
    for (int i = gt; i < 32 * 1024; i += NT) ((GAS float*)(ws + WS_KSUM))[i] = 0.f;
    constexpr int I_IN = 32 * 320, I_BC = 16 * 64, I_OUT = 32 * 64;
    constexpr int NITEMS = I_IN + 2 * I_BC + 2 * I_OUT;
    for (int it = gw; it < NITEMS; it += NGW) {
        int r = it;
        if (r < I_IN) { p0_transpose_item(w_in, 2048, INW, (bf16*)(ws + WS_WIN), g1, scr, r, F.lane); continue; } r -= I_IN;
        if (r < I_BC) { p0_transpose_item(w_bc, 1024, 2048, (bf16*)(ws + WS_WBC), nullptr, scr, r, F.lane); continue; } r -= I_BC;
        if (r < I_BC) { p0_transpose_item(w_ba, 1024, 2048, (bf16*)(ws + WS_WBA), nullptr, scr, r, F.lane); continue; } r -= I_BC;
        if (r < I_OUT) { p0_transpose_item(w_out, 2048, 2048, (bf16*)(ws + WS_WOUT), nullptr, scr, r, F.lane); continue; } r -= I_OUT;
        p0_transpose_item(w_pq, 2048, 2048, (bf16*)(ws + WS_WPQ), g2, scr, r, F.lane);
    }
    for (int i = gt; i < 16 * 128 * 128 / 8; i += NT) { const f32x4 a = ((const GAS f32x4*)keys)[2 * i], b = ((const GAS f32x4*)keys)[2 * i + 1];
        v4u o; o.x = pk2(a[0], a[1]); o.y = pk2(a[2], a[3]); o.z = pk2(b[0], b[1]); o.w = pk2(b[2], b[3]); ((GAS v4u*)(ws + WS_KEYS))[i] = o; }
    for (int m = gw; m < M; m += NGW) { const GAS f32x4* xr = (const GAS f32x4*)(x + (size_t)m * DM);
        f32x4 v[8]; float s = 0.f;
#pragma unroll
        for (int i = 0; i < 4; ++i) { v[2 * i] = xr[i * 128 + 2 * F.lane]; v[2 * i + 1] = xr[i * 128 + 2 * F.lane + 1]; }
#pragma unroll
        for (int i = 0; i < 8; ++i) s += (v[i][0] * v[i][0] + v[i][1] * v[i][1]) + (v[i][2] * v[i][2] + v[i][3] * v[i][3]);
        const float rinv = 1.0f / sqrtf(wave_sum(s) * (1.0f / DM) + RMS_EPS);
        GAS v4u* o = (GAS v4u*)(ws + WS_XB + (size_t)m * DM * 2);
#pragma unroll
        for (int i = 0; i < 4; ++i) { const f32x4 a = v[2 * i] * rinv, b = v[2 * i + 1] * rinv; v4u w; w.x = pk2(a[0], a[1]); w.y = pk2(a[2], a[3]); w.z = pk2(b[0], b[1]); w.w = pk2(b[2], b[3]); o[i * 64 + F.lane] = w; } }
    for (int i = gt; i < M * 16; i += NT) { const int row = i >> 4, f = i & 15; const double ang = (double)pos[row] * invf[f];
        const double k = __builtin_rint(ang * 0.15915494309189535); const float r = (float)(ang - k * 6.283185307179586);
        float* cs = (float*)(ws + WS_CS); cs[row * 32 + f] = __cosf(r); cs[row * 32 + 16 + f] = __sinf(r); }
}

__device__ __forceinline__ void attn_simple(const Ctx& F, const bf16* Q, const bf16* K, const bf16* V, const float* ksum, bf16* AO) {
    LAS float* qf = (LAS float*)(F.lds + RING_OFF + F.wave * 512);
    const int gw = F.vcu * NWAVES + F.wave, NGW = F.G * NWAVES, lane = F.lane;
    for (int item = gw; item < 16 * SEQ; item += NGW) {
        const int bh = item >> 12, t = item & 4095, b = bh >> 3, h = bh & 7, blk = t >> 8;
        const size_t row = (size_t)b * SEQ + t;
        { const unsigned qq = *(const GAS unsigned*)(Q + row * 1024 + h * 128 + 2 * lane); qf[2 * lane] = bflo(qq); qf[2 * lane + 1] = bfhi(qq); }
        LDS_WAIT(); asm volatile("" ::: "memory");
        float g = -INFINITY;
        if (lane < blk) { const GAS f32x4* km = (const GAS f32x4*)(ksum + (size_t)(b * 16 + lane) * 1024 + h * 128); float a = 0.f;
            for (int d = 0; d < 32; ++d) { const f32x4 kv = km[d]; const f32x4 qv = *(const LAS f32x4*)(qf + 4 * d); a += (kv[0] * qv[0] + kv[1] * qv[1]) + (kv[2] * qv[2] + kv[3] * qv[3]); }
            g = a; }
        int sel[3];
#pragma unroll
        for (int i = 0; i < 3; ++i) { const float mx = wave_max(g); const unsigned long long bal = __ballot(g == mx && lane < blk); const int idx = bal ? (__ffsll((long long)bal) - 1) : 0; sel[i] = idx; if (lane == idx) g = -INFINITY; }
        const int nsel = blk < 3 ? blk : 3;
        float sc[4][4]; float mx = -INFINITY;
#pragma unroll
        for (int slot = 0; slot < 4; ++slot) {
            const bool valid = (slot == 3) || (slot < nsel);
            const int kb = (slot == 3) ? blk : sel[slot < 3 ? slot : 0];
#pragma unroll
            for (int r = 0; r < 4; ++r) {
                float s = -INFINITY; const int key0 = kb * 256 + r * 64;
                if (valid && (slot < 3 || key0 <= t)) {
                    const int key = key0 + lane; const GAS v4u* kp = (const GAS v4u*)(K + ((size_t)b * SEQ + key) * 1024 + h * 128); float a = 0.f;
#pragma unroll 4
                    for (int d = 0; d < 16; ++d) { const v4u kk = kp[d]; const f32x4 q0 = *(const LAS f32x4*)(qf + 8 * d), q1 = *(const LAS f32x4*)(qf + 8 * d + 4);
                        a += (bflo(kk.x) * q0[0] + bfhi(kk.x) * q0[1]) + (bflo(kk.y) * q0[2] + bfhi(kk.y) * q0[3]) + (bflo(kk.z) * q1[0] + bfhi(kk.z) * q1[1]) + (bflo(kk.w) * q1[2] + bfhi(kk.w) * q1[3]); }
                    s = (slot < 3 || key <= t) ? a : -INFINITY; }
                sc[slot][r] = s; mx = fmaxf(mx, s); } }
        mx = wave_max(mx);
        float sum = 0.f;
#pragma unroll
        for (int slot = 0; slot < 4; ++slot)
#pragma unroll
            for (int r = 0; r < 4; ++r) { sc[slot][r] = exp2f(sc[slot][r] - mx); sum += sc[slot][r]; }
        sum = wave_sum(sum);
        float o0 = 0.f, o1 = 0.f;
#pragma unroll
        for (int slot = 0; slot < 4; ++slot) {
            const bool valid = (slot == 3) || (slot < nsel);
            const int kb = (slot == 3) ? blk : sel[slot < 3 ? slot : 0];
#pragma unroll
            for (int r = 0; r < 4; ++r) { const int key0 = kb * 256 + r * 64;
                if (valid && (slot < 3 || key0 <= t)) { const float pr = sc[slot][r]; const GAS unsigned* vp = (const GAS unsigned*)(V + ((size_t)b * SEQ + key0) * 1024 + h * 128) + lane;
                    for (int kk = 0; kk < 64; ++kk) { const float pk = rdlane(pr, kk); const unsigned vv = vp[(size_t)kk * 512]; o0 += pk * bflo(vv); o1 += pk * bfhi(vv); } } } }
        const float ri = 1.0f / sum;
        *(GAS unsigned*)(AO + row * 1024 + h * 128 + 2 * lane) = pk2(o0 * ri, o1 * ri);
    }
}
typedef short v4i16_t __attribute__((ext_vector_type(4))); typedef unsigned u32x2v __attribute__((ext_vector_type(2)));
__device__ __forceinline__ v4i16_t vtr16(unsigned addr) { return __builtin_amdgcn_ds_read_tr16_b64_v4i16((LAS v4i16_t*)(uintptr_t)addr); }
__device__ __forceinline__ int crow16(int r, int hh) { return (r & 3) + 8 * (r >> 2) + 4 * hh; }
__device__ __forceinline__ void attn_dma_step(const bf16* K, const bf16* V, LAS unsigned char* lds, int b, int h, int qb, int n_own, int st, int wave, int lane) {
    const int buf = st & 1;
#pragma unroll
    for (int img = 0; img < 4; ++img) {
        const int T = 2 * st + (img >> 1); const bool isV = img & 1;
        const int blk = (T < n_own) ? qb : ((T - n_own) >> 2), kt = (T < n_own) ? T : ((T - n_own) & 3);
        const bf16* base = (isV ? V : K) + ((size_t)b * SEQ + 256 * blk + 64 * kt) * 1024 + h * 128;
#pragma unroll
        for (int i = 0; i < 2; ++i) { const int pc = wave + 8 * i, row = 4 * pc + (lane >> 4), cp = lane & 15;
            const int c = isV ? ((((cp >> 2) ^ (row & 3)) << 2) | (cp & 3)) : (cp ^ (row & 15));
            __builtin_amdgcn_global_load_lds((const unsigned*)(base + (size_t)row * 1024 + 8 * c), (LAS unsigned*)(lds + buf * 65536 + img * 16384 + pc * 1024), 16, 0, 0); }
    }
}
__device__ __forceinline__ void attn_mfma(const Ctx& F, const bf16* Q, const bf16* K, const bf16* V, const float* ksum, bf16* AO) {
    const int lane = F.lane, wave = F.wave, q31 = lane & 31, hh = lane >> 5, wq = wave & 3, kvh = wave >> 2, l16 = lane & 15, G4 = lane >> 4;
    LAS unsigned char* lds = F.lds + RING_OFF;
    const unsigned lds0 = (unsigned)(uintptr_t)lds;
    for (int pr = F.vcu; pr < 256; pr += F.G)
#pragma unroll 1
    for (int pi = 0; pi < 2; ++pi) {
        const int bh = pr >> 4, s_ = pr & 15, u128 = pi ? 31 - s_ : s_, b = bh >> 3, h = bh & 7, qb = u128 >> 1, half = u128 & 1;
        const int n_own = half ? 4 : 2, nstep = (n_own + 4 * qb) >> 1;
        const size_t rowq = (size_t)b * SEQ + 256 * qb + 128 * half + 32 * wq + q31;
        asm volatile("s_waitcnt vmcnt(0) lgkmcnt(0)" ::: "memory"); __builtin_amdgcn_s_barrier(); asm volatile("" ::: "memory");
        attn_dma_step(K, V, lds, b, h, qb, n_own, 0, wave, lane);
        bf16x8 qf[8];
#pragma unroll
        for (int s = 0; s < 8; ++s) qf[s] = *(const GAS bf16x8*)(Q + rowq * 1024 + h * 128 + 16 * s + 8 * hh);
        unsigned selmask;
        {
            f32x16 gt;
#pragma unroll
            for (int r = 0; r < 16; ++r) gt[r] = 0.f;
            const int jr = lane & 31; const bool jv = jr < qb;
            const GAS f32x4* kp = (const GAS f32x4*)(ksum + (size_t)(b * 16 + (jv ? jr : 0)) * 1024 + h * 128 + 8 * hh);
            f32x4 kf[16];
#pragma unroll
            for (int s = 0; s < 8; ++s) { kf[2 * s] = kp[4 * s]; kf[2 * s + 1] = kp[4 * s + 1]; }
#pragma unroll
            for (int s = 0; s < 8; ++s) { v4u w = pg8::pack8(kf[2 * s], kf[2 * s + 1]); if (!jv) { w.x = 0u; w.y = 0u; w.z = 0u; w.w = 0u; }
                gt = __builtin_amdgcn_mfma_f32_32x32x16_bf16(__builtin_bit_cast(bf16x8, w), qf[s], gt, 0, 0, 0); }
            float g16[16];
#pragma unroll
            for (int r = 0; r < 8; ++r) { const auto rr = __builtin_amdgcn_permlane32_swap(__float_as_uint(gt[r]), __float_as_uint(gt[r]), false, false);
                g16[(r & 3) + 8 * (r >> 2)] = __uint_as_float(rr[0]); g16[(r & 3) + 8 * (r >> 2) + 4] = __uint_as_float(rr[1]); }
            float v0 = -INFINITY, v1 = -INFINITY, v2 = -INFINITY; int i0 = 0, i1 = 0, i2 = 0;
#pragma unroll
            for (int j = 0; j < 16; ++j) { const float a = (j < qb) ? g16[j] : -INFINITY;
                if (a > v0) { v2 = v1; i2 = i1; v1 = v0; i1 = i0; v0 = a; i0 = j; } else if (a > v1) { v2 = v1; i2 = i1; v1 = a; i1 = j; } else if (a > v2) { v2 = a; i2 = j; } }
            selmask = (qb <= 3) ? ((1u << qb) - 1u) : ((1u << i0) | (1u << i1) | (1u << i2));
        }
        float m_run = -1e30f, l_run = 0.f; f32x16 o[4];
#pragma unroll
        for (int db = 0; db < 4; ++db)
#pragma unroll
            for (int r = 0; r < 16; ++r) o[db][r] = 0.f;
        const int qin = 128 * half + 32 * wq + q31;
#pragma unroll 1
        for (int st = 0; st < nstep; ++st) {
            asm volatile("s_waitcnt vmcnt(0)" ::: "memory"); __builtin_amdgcn_s_barrier(); asm volatile("" ::: "memory");
            if (st + 1 < nstep) attn_dma_step(K, V, lds, b, h, qb, n_own, st + 1, wave, lane);
            const int T = 2 * st + kvh; const bool own = T < n_own;
            const int blk = own ? qb : ((T - n_own) >> 2), kt = own ? T : ((T - n_own) & 3);
            const bool sel = own ? true : ((selmask >> blk) & 1u);
            const bool skip = own ? (64 * kt > 128 * half + 32 * wq + 31) : (__ballot(sel) == 0ull);
            if (!skip) {
                const unsigned kimg = lds0 + (st & 1) * 65536 + kvh * 32768, vimg = kimg + 16384;
                f32x16 p[2];
#pragma unroll
                for (int kh = 0; kh < 2; ++kh) {
#pragma unroll
                    for (int r = 0; r < 16; ++r) p[kh][r] = 0.f;
                    const int row = 32 * kh + q31;
#pragma unroll
                    for (int s = 0; s < 8; ++s) { const bf16x8 a = *(const LAS bf16x8*)(uintptr_t)(kimg + row * 256 + (((2 * s + hh) ^ (row & 15)) << 4));
                        p[kh] = __builtin_amdgcn_mfma_f32_32x32x16_bf16(a, qf[s], p[kh], 0, 0, 0); }
                }
                if (own) { const int kbase = 64 * kt;
                    if (kbase + 63 > 128 * half + 32 * wq) {
#pragma unroll
                        for (int kh = 0; kh < 2; ++kh)
#pragma unroll
                            for (int r = 0; r < 16; ++r) if (kbase + 32 * kh + crow16(r, hh) > qin) p[kh][r] = -INFINITY; }
                }
                float mx = p[0][0];
#pragma unroll
                for (int r = 1; r < 16; ++r) mx = fmaxf(mx, p[0][r]);
#pragma unroll
                for (int r = 0; r < 16; ++r) mx = fmaxf(mx, p[1][r]);
                { const auto rr = __builtin_amdgcn_permlane32_swap(__float_as_uint(mx), __float_as_uint(mx), false, false); mx = fmaxf(__uint_as_float(rr[0]), __uint_as_float(rr[1])); }
                if (!sel) mx = -INFINITY;
                const float m_new = fmaxf(m_run, mx), scl = __builtin_amdgcn_exp2f(m_run - m_new); m_run = m_new;
                float rs = 0.f;
#pragma unroll
                for (int kh = 0; kh < 2; ++kh)
#pragma unroll
                    for (int r = 0; r < 16; ++r) { p[kh][r] = __builtin_amdgcn_exp2f(p[kh][r] - m_new); rs += p[kh][r]; }
                l_run = l_run * scl + (sel ? rs : 0.f);
                if (__ballot(scl != 1.0f) != 0ull) {
#pragma unroll
                    for (int db = 0; db < 4; ++db)
#pragma unroll
                        for (int r = 0; r < 16; ++r) o[db][r] *= scl; }
                const unsigned pmask = sel ? 0xffffffffu : 0u;
#pragma unroll
                for (int kh = 0; kh < 2; ++kh)
#pragma unroll
                    for (int s2 = 0; s2 < 2; ++s2) {
                        v4u pw; pw.x = pg8::cvt_pk_bf16(p[kh][8 * s2], p[kh][8 * s2 + 1]); pw.y = pg8::cvt_pk_bf16(p[kh][8 * s2 + 2], p[kh][8 * s2 + 3]);
                        pw.z = pg8::cvt_pk_bf16(p[kh][8 * s2 + 4], p[kh][8 * s2 + 5]); pw.w = pg8::cvt_pk_bf16(p[kh][8 * s2 + 6], p[kh][8 * s2 + 7]);
                        pw.x &= pmask; pw.y &= pmask; pw.z &= pmask; pw.w &= pmask;
                        const bf16x8 pb = __builtin_bit_cast(bf16x8, pw);
                        const int key0 = 32 * kh + 16 * s2 + 4 * (G4 >> 1) + (l16 >> 2);
#pragma unroll
                        for (int db = 0; db < 4; ++db) {
                            const int dsub = 16 * (G4 & 1) + 4 * (l16 & 3);
                            const unsigned a0 = vimg + key0 * 256 + ((db ^ (key0 & 3)) << 6) + dsub * 2;
                            const v4i16_t lo = vtr16(a0), hi_ = vtr16(a0 + 8 * 256);
                            const bf16x8 av = {lo[0], lo[1], lo[2], lo[3], hi_[0], hi_[1], hi_[2], hi_[3]};
                            o[db] = __builtin_amdgcn_mfma_f32_32x32x16_bf16(av, pb, o[db], 0, 0, 0);
                        }
                    }
            }
        }
        l_run += __shfl_xor(l_run, 32);
        asm volatile("s_waitcnt vmcnt(0) lgkmcnt(0)" ::: "memory"); __builtin_amdgcn_s_barrier(); asm volatile("" ::: "memory");
        LAS float* xs = (LAS float*)lds + (size_t)wq * 66 * 64 + lane;
        if (kvh == 1) {
            xs[0] = m_run; xs[64] = l_run;
#pragma unroll
            for (int db = 0; db < 4; ++db)
#pragma unroll
                for (int r = 0; r < 16; ++r) xs[(2 + 16 * db + r) * 64] = o[db][r];
        }
        asm volatile("s_waitcnt lgkmcnt(0)" ::: "memory"); __builtin_amdgcn_s_barrier(); asm volatile("" ::: "memory");
        if (kvh == 0) {
            const float m2 = xs[0], l2 = xs[64], mt = fmaxf(m_run, m2), a1 = __builtin_amdgcn_exp2f(m_run - mt), a2 = __builtin_amdgcn_exp2f(m2 - mt);
            const float inv = 1.0f / (l_run * a1 + l2 * a2), c1 = a1 * inv, c2 = a2 * inv;
            bf16* orow = AO + rowq * 1024 + h * 128 + 4 * hh;
#pragma unroll
            for (int db = 0; db < 4; ++db)
#pragma unroll
                for (int g = 0; g < 4; ++g) {
                    float t[4];
#pragma unroll
                    for (int e = 0; e < 4; ++e) t[e] = o[db][4 * g + e] * c1 + xs[(2 + 16 * db + 4 * g + e) * 64] * c2;
                    u32x2v w; w.x = pg8::cvt_pk_bf16(t[0], t[1]); w.y = pg8::cvt_pk_bf16(t[2], t[3]);
                    *(GAS u32x2v*)(orow + 32 * db + 8 * g) = w;
                }
        }
    }
    asm volatile("s_waitcnt vmcnt(0) lgkmcnt(0)" ::: "memory"); __builtin_amdgcn_s_barrier(); asm volatile("" ::: "memory");
}
__device__ __forceinline__ void up8(const v4u w, float (&f)[8]) { f[0] = bflo(w.x); f[1] = bfhi(w.x); f[2] = bflo(w.y); f[3] = bfhi(w.y); f[4] = bflo(w.z); f[5] = bfhi(w.z); f[6] = bflo(w.w); f[7] = bfhi(w.w); }
__device__ __forceinline__ void conv_phase(const Ctx& F, const bf16* CB, const bf16* CC, const bf16* CX, const float* cw, bf16* UC) {
    const int gt = (F.vcu * NWAVES + F.wave) * 64 + F.lane, NT = F.G * NWAVES * 64;
    for (int idx = gt; idx < M * 128; idx += NT) {
        const int row = idx >> 7, c8 = (idx & 127) << 3, t = row & (SEQ - 1); const size_t off = (size_t)row * 1024 + c8;
        float cb[8], a[8], x[8], z0[8], z1[8], z2[8];
        up8(*(const GAS v4u*)(CB + off), cb); up8(*(const GAS v4u*)(CC + off), a); up8(*(const GAS v4u*)(CX + off), x);
#pragma unroll
        for (int j = 0; j < 8; ++j) z0[j] = a[j] * x[j];
        if (t >= 1) { up8(*(const GAS v4u*)(CC + off - 1024), a); up8(*(const GAS v4u*)(CX + off - 1024), x);
#pragma unroll
            for (int j = 0; j < 8; ++j) z1[j] = a[j] * x[j]; } else {
#pragma unroll
            for (int j = 0; j < 8; ++j) z1[j] = 0.f; }
        if (t >= 2) { up8(*(const GAS v4u*)(CC + off - 2048), a); up8(*(const GAS v4u*)(CX + off - 2048), x);
#pragma unroll
            for (int j = 0; j < 8; ++j) z2[j] = a[j] * x[j]; } else {
#pragma unroll
            for (int j = 0; j < 8; ++j) z2[j] = 0.f; }
        float o[8];
#pragma unroll
        for (int j = 0; j < 8; ++j) o[j] = cb[j] * (cw[c8 + j] * z2[j] + cw[1024 + c8 + j] * z1[j] + cw[2048 + c8 + j] * z0[j]);
        v4u w; w.x = pk2(o[0], o[1]); w.y = pk2(o[2], o[3]); w.z = pk2(o[4], o[5]); w.w = pk2(o[6], o[7]); *(GAS v4u*)(UC + off) = w;
    }
}

__device__ __forceinline__ int imax(int a, int b) { return a > b ? a : b; }
__device__ __forceinline__ int imin(int a, int b) { return a < b ? a : b; }
__device__ __forceinline__ void ce(int& a, int& b) { const int t = imax(a, b); b = imin(a, b); a = t; }
__device__ __forceinline__ void sort16(int (&x)[16]) {
#pragma unroll
    for (int kk = 1; kk <= 4; ++kk)
#pragma unroll
        for (int jj = kk - 1; jj >= 0; --jj)
#pragma unroll
            for (int i = 0; i < 16; ++i) { const int k = 1 << kk, j = 1 << jj, l = i ^ j; if (l > i) { if ((i & k) == 0) ce(x[i], x[l]); else ce(x[l], x[i]); } }
}
__device__ __forceinline__ void bmerge16(int (&a)[16]) {
#pragma unroll
    for (int jj = 3; jj >= 0; --jj)
#pragma unroll
        for (int i = 0; i < 16; ++i) { const int j = 1 << jj, l = i ^ j; if (l > i) ce(a[i], a[l]); }
}
__device__ __forceinline__ void merge16(int (&a)[16], const int (&b)[16]) {
#pragma unroll
    for (int i = 0; i < 16; ++i) a[i] = imax(a[i], b[15 - i]);
    bmerge16(a);
}
__device__ __forceinline__ void xmerge16(int (&a)[16], int hh) {
    int pv[16];
#pragma unroll
    for (int i = 0; i < 16; ++i) { const auto r = __builtin_amdgcn_permlane32_swap((unsigned)a[15 - i], (unsigned)a[15 - i], false, false); pv[i] = hh ? (int)r[0] : (int)r[1]; }
#pragma unroll
    for (int i = 0; i < 16; ++i) a[i] = imax(a[i], pv[i]);
    bmerge16(a);
}
__device__ __forceinline__ int ord_key(float f) { const int u = __float_as_int(f); return u >= 0 ? u : (u ^ 0x7fffffff); }
__device__ __forceinline__ float ord_val(int k) { return __int_as_float(k >= 0 ? k : (k ^ 0x7fffffff)); }
__device__ __forceinline__ unsigned byte16(const unsigned (&t)[4], int idx) {
    const unsigned sel = 0x0c0c0c00u | (unsigned)(idx & 7);
    const unsigned lo = __builtin_amdgcn_perm(t[1], t[0], sel), hi_ = __builtin_amdgcn_perm(t[3], t[2], sel);
    return (idx & 8) ? hi_ : lo;
}
__device__ __forceinline__ void topk_stage_keys(const Ctx& F, const bf16* KEYS, int h) {
    for (int pc = F.wave; pc < 64; pc += 8) { const int pp = pc >> 5, row = 4 * (pc & 31) + (F.lane >> 4), cp = F.lane & 15, c = cp ^ (row & 15);
        __builtin_amdgcn_global_load_lds((const unsigned*)(KEYS + (size_t)((h * 2 + pp) * 128 + row) * 128 + 8 * c), (LAS unsigned*)(F.lds + RING_OFF + pc * 1024), 16, 0, 0); }
    asm volatile("s_waitcnt vmcnt(0)" ::: "memory"); __builtin_amdgcn_s_barrier(); asm volatile("" ::: "memory");
}
__device__ __forceinline__ void topk_phase(const Ctx& F, int bitem, const bf16* QP, int* EXP, float* GATE) {
    const int lane = F.lane, l31 = lane & 31, hh = lane >> 5;
    const int IMIN = (int)0x80000000;
    const unsigned lds0 = (unsigned)(uintptr_t)(F.lds + RING_OFF);
    {
        const int h = bitem & 7, tt = (bitem >> 3) * 8 + F.wave, tok0 = tt * 32;
        int top[2][16];
#pragma unroll
        for (int p = 0; p < 2; ++p) {
            bf16x8 qa[8];
#pragma unroll
            for (int s = 0; s < 8; ++s) qa[s] = *(const GAS bf16x8*)(QP + (size_t)(tok0 + l31) * 2048 + h * 256 + p * 128 + 16 * s + 8 * hh);
            int x[2][16];
#pragma unroll
            for (int pq = 0; pq < 2; ++pq) {
                f32x16 sc[2];
#pragma unroll
                for (int nt = 0; nt < 2; ++nt)
#pragma unroll
                    for (int r = 0; r < 16; ++r) sc[nt][r] = 0.f;
#pragma unroll
                for (int s = 0; s < 8; ++s) {
#pragma unroll
                    for (int nt = 0; nt < 2; ++nt) { const int n = 64 * pq + 32 * nt + l31; const bf16x8 kb = *(const LAS bf16x8*)(uintptr_t)(lds0 + p * 32768 + n * 256 + (((2 * s + hh) ^ (n & 15)) << 4));
                        sc[nt] = __builtin_amdgcn_mfma_f32_32x32x16_bf16(kb, qa[s], sc[nt], 0, 0, 0); }
                }
                int y[16];
#pragma unroll
                for (int r = 0; r < 16; ++r) { x[pq][r] = (ord_key(sc[0][r]) & ~127) | ((127 - 64 * pq - (r & 3) - 8 * (r >> 2)) - 4 * hh); y[r] = (ord_key(sc[1][r]) & ~127) | ((127 - 64 * pq - 32 - (r & 3) - 8 * (r >> 2)) - 4 * hh); }
                sort16(x[pq]); sort16(y); merge16(x[pq], y);
                asm volatile("" ::: "memory");
            }
            merge16(x[0], x[1]);
            xmerge16(x[0], hh);
#pragma unroll
            for (int i = 0; i < 16; ++i) top[p][i] = x[0][i];
        }
        float fa[16], fb[16];
#pragma unroll
        for (int i = 0; i < 16; ++i) { const int A = hh ? top[1][i] : top[0][i], B = hh ? top[0][i] : top[1][i]; fa[i] = ord_val(A & ~127); fb[i] = ord_val(B & ~127); }
        int c0[16], c1[16];
#pragma unroll
        for (int q = 0; q < 32; ++q) {
            int key = IMIN;
            if (q < 27) { const int i = (q < 16) ? 0 : (q < 23) ? 1 : (q < 26) ? 2 : 3, j = (q < 16) ? q : (q < 23) ? q - 15 : (q < 26) ? q - 21 : 3; const float sv = fa[i] + fb[j]; const int low = hh ? (255 - (j * 16 + i)) : (255 - (i * 16 + j));
                key = (ord_key(sv) & ~255) | low; if (i == j && hh) key = IMIN; }
            if (q < 16) c0[q] = key; else c1[q - 16] = key;
        }
        sort16(c0); sort16(c1); merge16(c0, c1); xmerge16(c0, hh);
        unsigned na[4], nb[4];
#pragma unroll
        for (int d = 0; d < 4; ++d) { na[d] = 0u; nb[d] = 0u;
#pragma unroll
            for (int e = 0; e < 4; ++e) { na[d] |= (unsigned)(127 - (top[0][4 * d + e] & 127)) << (8 * e); nb[d] |= (unsigned)(127 - (top[1][4 * d + e] & 127)) << (8 * e); } }
        int ex[16]; float ev[16]; float es = 0.f; const float smax = ord_val(c0[0] & ~255);
#pragma unroll
        for (int q = 0; q < 16; ++q) { const int posn = 255 - (c0[q] & 255); const unsigned n1 = byte16(na, posn >> 4) & 255u, n2 = byte16(nb, posn & 15) & 255u;
            ex[q] = (int)(n1 * 128u + n2); ev[q] = __expf(ord_val(c0[q] & ~255) - smax); es += ev[q]; }
        const float ri = 1.0f / es; const size_t ob = (size_t)(tok0 + l31) * 128 + h * 16;
        if (hh == 0) {
#pragma unroll
            for (int d = 0; d < 4; ++d) { v4u w; w.x = (unsigned)ex[4 * d]; w.y = (unsigned)ex[4 * d + 1]; w.z = (unsigned)ex[4 * d + 2]; w.w = (unsigned)ex[4 * d + 3]; *(GAS v4u*)(EXP + ob + 4 * d) = w; }
        } else {
#pragma unroll
            for (int d = 0; d < 4; ++d) *(GAS f32x4*)(GATE + ob + 4 * d) = (f32x4){ev[4 * d] * ri, ev[4 * d + 1] * ri, ev[4 * d + 2] * ri, ev[4 * d + 3] * ri};
        }
    }
}

typedef float f32x2 __attribute__((ext_vector_type(2)));
constexpr float PEER_SU = 512.0f, PEER_SV = 32.0f;
template <int CTRL> __device__ __forceinline__ int dpp_i(int v) { return __builtin_amdgcn_update_dpp(v, v, CTRL, 0xf, 0xf, false); }
template <int J> __device__ __forceinline__ int xor_lane(int v, int lane) {
    if constexpr (J == 1) return dpp_i<0xB1>(v);
    else if constexpr (J == 2) return dpp_i<0x4E>(v);
    else if constexpr (J == 16) { const auto r = __builtin_amdgcn_permlane16_swap((unsigned)v, (unsigned)v, false, false); return ((lane >> 4) & 1) ? (int)r[0] : (int)r[1]; }
    else if constexpr (J == 32) { const auto r = __builtin_amdgcn_permlane32_swap((unsigned)v, (unsigned)v, false, false); return (lane >> 5) ? (int)r[0] : (int)r[1]; }
    else return __shfl_xor(v, J);
}
__device__ __forceinline__ float wave_sum_dpp(float v) {
    v += __int_as_float(dpp_i<0xB1>(__float_as_int(v))); v += __int_as_float(dpp_i<0x4E>(__float_as_int(v))); v += __int_as_float(dpp_i<0x141>(__float_as_int(v))); v += __int_as_float(dpp_i<0x140>(__float_as_int(v)));
    { const auto r = __builtin_amdgcn_permlane16_swap(__float_as_uint(v), __float_as_uint(v), false, false); v = __uint_as_float(r[0]) + __uint_as_float(r[1]); }
    { const auto r = __builtin_amdgcn_permlane32_swap(__float_as_uint(v), __float_as_uint(v), false, false); v = __uint_as_float(r[0]) + __uint_as_float(r[1]); }
    return v; }
template <int KK, int JJ> __device__ __forceinline__ void sort512_step(int (&x)[8], int lane) {
    constexpr int k = 1 << KK, j = 1 << JJ;
    if constexpr (j >= 64) { constexpr int jr = j >> 6;
#pragma unroll
        for (int r = 0; r < 8; ++r) if ((r & jr) == 0) { const bool asc = (k >= 512) ? true : (((r << 6) & k) == 0); const int lo = imin(x[r], x[r | jr]), hi_ = imax(x[r], x[r | jr]); x[r] = asc ? lo : hi_; x[r | jr] = asc ? hi_ : lo; }
    } else {
        const bool lower = (lane & j) == 0;
#pragma unroll
        for (int r = 0; r < 8; ++r) { const int y = xor_lane<j>(x[r], lane);
            const bool asc = (k < 64) ? ((lane & k) == 0) : ((k >= 512) ? true : (((r << 6) & k) == 0));
            x[r] = (lower == asc) ? imin(x[r], y) : imax(x[r], y); }
    }
}
template <int KK, int JJ> __device__ __forceinline__ void sort512_stage(int (&x)[8], int lane) { sort512_step<KK, JJ>(x, lane); if constexpr (JJ > 0) sort512_stage<KK, JJ - 1>(x, lane); }
__device__ __forceinline__ void sort512(int (&x)[8], int lane) {
    sort512_stage<1, 0>(x, lane); sort512_stage<2, 1>(x, lane); sort512_stage<3, 2>(x, lane); sort512_stage<4, 3>(x, lane); sort512_stage<5, 4>(x, lane);
    sort512_stage<6, 5>(x, lane); sort512_stage<7, 6>(x, lane); sort512_stage<8, 7>(x, lane); sort512_stage<9, 8>(x, lane);
}
__device__ __forceinline__ void peer_phase(const Ctx& F, const unsigned char* U8, const unsigned char* V8, const bf16* X1B, const int* EXP, const float* GATE, const unsigned long long* SS, const float* gfin, const float* X1, float* OUT) {
    const int gw = F.vcu * NWAVES + F.wave, NGW = F.G * NWAVES, lane = F.lane;
    const unsigned xs0 = (unsigned)(uintptr_t)(F.lds + RING_OFF + F.wave * 16384) + lane * 16;
    for (int tb = gw; tb + 3 * NGW < M; tb += 4 * NGW) {
        int kreg[8]; float greg[8], rv[4];
#pragma unroll
        for (int j = 0; j < 4; ++j) { const size_t t = (size_t)tb + (size_t)j * NGW;
            kreg[2 * j] = (EXP[t * 128 + lane] << 9) | (j << 7) | lane; kreg[2 * j + 1] = (EXP[t * 128 + 64 + lane] << 9) | (j << 7) | (64 + lane);
            rv[j] = pg8::rinv_from_ss(SS[t]) * (1.0f / PEER_SU);
#pragma unroll
            for (int q = 0; q < 4; ++q) { const v4u w = *(const GAS v4u*)(X1B + t * DM + (q >> 1) * 1024 + lane * 16 + 8 * (q & 1)); *(LAS v4u*)(uintptr_t)(xs0 + j * 4096 + q * 1024) = w; } }
        sort512(kreg, lane);
        int pkey[8];
#pragma unroll
        for (int c = 0; c < 8; ++c) { pkey[c] = __shfl(kreg[c], 8 * (lane & 7) + (lane >> 3)); greg[c] = GATE[((size_t)tb + (size_t)((pkey[c] >> 7) & 3) * NGW) * 128 + (pkey[c] & 127)]; }
        asm volatile("s_waitcnt lgkmcnt(0)" ::: "memory");
        float actreg[8];
#ifndef MK_P8_REPU
#define MK_P8_REPU 1
#endif
#pragma unroll 1
        for (int repu = 0; repu < MK_P8_REPU; ++repu) {
            v4u ub[8][2];
#pragma unroll
            for (int u = 0; u < 8; ++u) { const GAS v4u* up = (const GAS v4u*)(U8 + (size_t)(__builtin_amdgcn_readlane(kreg[0], u) >> 9) * 2048) + lane; ub[u][0] = up[0]; ub[u][1] = up[64]; }
#pragma unroll
            for (int c = 0; c < 8; ++c) {
                float areg = 0.f;
#pragma unroll 1
                for (int g = 0; g < 8; ++g) {
                    float pt[8];
#pragma unroll
                    for (int u = 0; u < 8; ++u) {
                        const int key = __builtin_amdgcn_readlane(kreg[c], 8 * g + u);
                        const unsigned xa = xs0 + ((key >> 7) & 3) * 4096;
                        float p0 = 0.f, p1 = 0.f;
#pragma unroll
                        for (int i = 0; i < 2; ++i) { const v4u w = ub[u][i];
#pragma unroll
                            for (int hv = 0; hv < 2; ++hv) { const v4u xq = *(const LAS v4u*)(uintptr_t)(xa + (2 * i + hv) * 1024);
                                const unsigned w0 = hv ? w.z : w.x, w1 = hv ? w.w : w.y;
                                const f32x2 a0 = __builtin_amdgcn_cvt_pk_f32_fp8((int)w0, false), a1 = __builtin_amdgcn_cvt_pk_f32_fp8((int)w0, true), a2 = __builtin_amdgcn_cvt_pk_f32_fp8((int)w1, false), a3 = __builtin_amdgcn_cvt_pk_f32_fp8((int)w1, true);
                                p0 = dot2bf(pg8::cvt_pk_bf16(a0[0], a0[1]), xq.x, p0); p1 = dot2bf(pg8::cvt_pk_bf16(a1[0], a1[1]), xq.y, p1);
                                p0 = dot2bf(pg8::cvt_pk_bf16(a2[0], a2[1]), xq.z, p0); p1 = dot2bf(pg8::cvt_pk_bf16(a3[0], a3[1]), xq.w, p1); } }
                        pt[u] = p0 + p1;
                        { const int ix = 8 * g + 8 + u, ka = __builtin_amdgcn_readlane(kreg[c], ix & 63), kb = __builtin_amdgcn_readlane(kreg[c < 7 ? c + 1 : 7], ix & 63), kn = (ix < 64) ? ka : kb;
                            const GAS v4u* up = (const GAS v4u*)(U8 + (size_t)(kn >> 9) * 2048) + lane; ub[u][0] = up[0]; ub[u][1] = up[64]; }
                    }
                    { const bool b5 = (lane & 32) != 0, b4 = (lane & 16) != 0, b3 = (lane & 8) != 0;
#pragma unroll
                      for (int i = 0; i < 4; ++i) { const float a = pt[i], b = pt[i + 4]; pt[i] = (b5 ? b : a) + __int_as_float(xor_lane<32>(__float_as_int(b5 ? a : b), lane)); }
#pragma unroll
                      for (int i = 0; i < 2; ++i) { const float a = pt[i], b = pt[i + 2]; pt[i] = (b4 ? b : a) + __int_as_float(xor_lane<16>(__float_as_int(b4 ? a : b), lane)); }
                      { const float a = pt[0], b = pt[1]; pt[0] = (b3 ? b : a) + __shfl_xor(b3 ? a : b, 8); }
                      float r = pt[0]; r += __shfl_xor(r, 4); r += __int_as_float(dpp_i<0x4E>(__float_as_int(r))); r += __int_as_float(dpp_i<0xB1>(__float_as_int(r)));
                      areg = ((lane & 7) == g) ? r : areg; }
                }
                const int tk = (pkey[c] >> 7) & 3; const float rr = (tk == 0) ? rv[0] : (tk == 1) ? rv[1] : (tk == 2) ? rv[2] : rv[3];
                actreg[c] = gelu_tanh(areg * rr) * greg[c] * (1.0f / PEER_SV);
            }
        }
        LAS float* as = (LAS float*)(uintptr_t)(xs0 - lane * 16);
        asm volatile("s_waitcnt lgkmcnt(0)" ::: "memory");
#pragma unroll
        for (int c = 0; c < 8; ++c) as[64 * c + lane] = actreg[c];
        int k2[8];
#pragma unroll
        for (int c = 0; c < 8; ++c) { const int key = kreg[c], tok = (key >> 7) & 3, park = 64 * c + 8 * (lane & 7) + (lane >> 3);
            k2[c] = ((tok >> 1) << 24) | ((key >> 9) << 10) | ((tok & 1) << 9) | park; }
        sort512(k2, lane);
        asm volatile("s_waitcnt lgkmcnt(0)" ::: "memory");
        float a2[8];
#pragma unroll
        for (int c = 0; c < 8; ++c) a2[c] = as[k2[c] & 511];
#pragma unroll 1
        for (int pp = 0; pp < 2; ++pp) {
            int kq[4]; float aq[4];
#pragma unroll
            for (int c = 0; c < 4; ++c) { kq[c] = pp ? k2[4 + c] : k2[c]; aq[c] = pp ? a2[4 + c] : a2[c]; }
            f32x2 y[2][16];
#pragma unroll
            for (int j = 0; j < 2; ++j)
#pragma unroll
                for (int q = 0; q < 16; ++q) y[j][q] = (f32x2){0.f, 0.f};
            v4u vb[8][2];
#pragma unroll
            for (int u = 0; u < 8; ++u) { const GAS v4u* vp = (const GAS v4u*)(V8 + (size_t)((__builtin_amdgcn_readlane(kq[0], u) >> 10) & 0x3fff) * 2048) + lane; vb[u][0] = vp[0]; vb[u][1] = vp[64]; }
#pragma unroll
            for (int c = 0; c < 4; ++c) {
#pragma unroll 1
                for (int g = 0; g < 8; ++g) {
#pragma unroll
                    for (int u = 0; u < 8; ++u) {
                        const int key = __builtin_amdgcn_readlane(kq[c], 8 * g + u); const float s = rdlane(aq[c], 8 * g + u);
                        const float sa = (key & 512) ? 0.f : s, sb = (key & 512) ? s : 0.f; const f32x2 s0 = {sa, sa}, s1 = {sb, sb};
#pragma unroll
                        for (int i = 0; i < 2; ++i) { const v4u w = vb[u][i];
                            const f32x2 c0 = __builtin_amdgcn_cvt_pk_f32_fp8((int)w.x, false), c1 = __builtin_amdgcn_cvt_pk_f32_fp8((int)w.x, true), c2 = __builtin_amdgcn_cvt_pk_f32_fp8((int)w.y, false), c3 = __builtin_amdgcn_cvt_pk_f32_fp8((int)w.y, true);
                            const f32x2 c4 = __builtin_amdgcn_cvt_pk_f32_fp8((int)w.z, false), c5 = __builtin_amdgcn_cvt_pk_f32_fp8((int)w.z, true), c6 = __builtin_amdgcn_cvt_pk_f32_fp8((int)w.w, false), c7 = __builtin_amdgcn_cvt_pk_f32_fp8((int)w.w, true);
                            y[0][8 * i + 0] = __builtin_elementwise_fma(c0, s0, y[0][8 * i + 0]); y[1][8 * i + 0] = __builtin_elementwise_fma(c0, s1, y[1][8 * i + 0]);
                            y[0][8 * i + 1] = __builtin_elementwise_fma(c1, s0, y[0][8 * i + 1]); y[1][8 * i + 1] = __builtin_elementwise_fma(c1, s1, y[1][8 * i + 1]);
                            y[0][8 * i + 2] = __builtin_elementwise_fma(c2, s0, y[0][8 * i + 2]); y[1][8 * i + 2] = __builtin_elementwise_fma(c2, s1, y[1][8 * i + 2]);
                            y[0][8 * i + 3] = __builtin_elementwise_fma(c3, s0, y[0][8 * i + 3]); y[1][8 * i + 3] = __builtin_elementwise_fma(c3, s1, y[1][8 * i + 3]);
                            y[0][8 * i + 4] = __builtin_elementwise_fma(c4, s0, y[0][8 * i + 4]); y[1][8 * i + 4] = __builtin_elementwise_fma(c4, s1, y[1][8 * i + 4]);
                            y[0][8 * i + 5] = __builtin_elementwise_fma(c5, s0, y[0][8 * i + 5]); y[1][8 * i + 5] = __builtin_elementwise_fma(c5, s1, y[1][8 * i + 5]);
                            y[0][8 * i + 6] = __builtin_elementwise_fma(c6, s0, y[0][8 * i + 6]); y[1][8 * i + 6] = __builtin_elementwise_fma(c6, s1, y[1][8 * i + 6]);
                            y[0][8 * i + 7] = __builtin_elementwise_fma(c7, s0, y[0][8 * i + 7]); y[1][8 * i + 7] = __builtin_elementwise_fma(c7, s1, y[1][8 * i + 7]); }
                        { const int ix = 8 * g + 8 + u, ka = __builtin_amdgcn_readlane(kq[c], ix & 63), kb = __builtin_amdgcn_readlane(kq[c < 3 ? c + 1 : 3], ix & 63), kn = (ix < 64) ? ka : kb;
                            const GAS v4u* vp = (const GAS v4u*)(V8 + (size_t)((kn >> 10) & 0x3fff) * 2048) + lane; vb[u][0] = vp[0]; vb[u][1] = vp[64]; }
                    }
                }
            }
#pragma unroll
            for (int j = 0; j < 2; ++j) { const size_t t = (size_t)tb + (size_t)(2 * pp + j) * NGW;
                GAS f32x4* orw = (GAS f32x4*)(OUT + t * DM); float ss = 0.f;
#pragma unroll
                for (int i = 0; i < 2; ++i)
#pragma unroll
                    for (int hv = 0; hv < 2; ++hv) { const v4u w = *(const GAS v4u*)(X1B + t * DM + i * 1024 + lane * 16 + 8 * hv);
                        y[j][8 * i + 4 * hv + 0] += (f32x2){bflo(w.x), bfhi(w.x)}; y[j][8 * i + 4 * hv + 1] += (f32x2){bflo(w.y), bfhi(w.y)}; y[j][8 * i + 4 * hv + 2] += (f32x2){bflo(w.z), bfhi(w.z)}; y[j][8 * i + 4 * hv + 3] += (f32x2){bflo(w.w), bfhi(w.w)}; }
#pragma unroll
                for (int q = 0; q < 16; ++q) ss += y[j][q][0] * y[j][q][0] + y[j][q][1] * y[j][q][1];
                const float r3 = 1.0f / sqrtf(wave_sum_dpp(ss) * (1.0f / DM) + RMS_EPS);
#pragma unroll
                for (int i = 0; i < 2; ++i)
#pragma unroll
                    for (int q = 0; q < 4; ++q) { const f32x4 ga = *(const GAS f32x4*)(gfin + i * 1024 + lane * 16 + 4 * q);
                        orw[i * 256 + 4 * lane + q] = (f32x4){y[j][8 * i + 2 * q][0] * r3 * ga[0], y[j][8 * i + 2 * q][1] * r3 * ga[1], y[j][8 * i + 2 * q + 1][0] * r3 * ga[2], y[j][8 * i + 2 * q + 1][1] * r3 * ga[3]}; }
            }
        }
        asm volatile("s_waitcnt lgkmcnt(0)" ::: "memory");
    }
}

struct Args { const float* in[15]; float* out; unsigned char* ws; double invf[16]; int ph_lo, ph_hi, li, pad; };
__global__ void __launch_bounds__(NWAVES * 64, 2) mk_fwd(Args args) {
    extern __shared__ __attribute__((aligned(16))) unsigned char lds[];
    Ctx F;
    F.lds = (LAS unsigned char*)lds;
    volatile LAS unsigned* MISC = (volatile LAS unsigned*)(F.lds + MISC_OFF);
    F.tid = threadIdx.x; F.lane = F.tid & 63; F.wave = __builtin_amdgcn_readfirstlane(F.tid >> 6);
    F.G = gridDim.x; { const int bx = blockIdx.x; F.vcu = (F.G % 8 == 0) ? (bx % 8) * (F.G / 8) + bx / 8 : bx; }
    unsigned char* ws = args.ws;
    gu32* ctl = (gu32*)(ws + WS_CTL);
    for (int u = F.tid; u < (LDS_BYTES - LDSCTL_OFF) / 4; u += NWAVES * 64) ((LAS unsigned*)(F.lds + LDSCTL_OFF))[u] = 0u;
    __syncthreads();
    XcdBarrier bar; bar.bar = (unsigned*)(ctl + CW_BAR); bar.x = 0; bar.st = nullptr;
    if (N_LAUNCHES != PER_PHASE) bar = xcd_barrier_post((unsigned*)(ctl + CW_BAR), MISC + 8);
#define GRID_BAR() do { if (N_LAUNCHES != PER_PHASE) xcd_barrier(bar); } while (0)
    const int lo = args.ph_lo, hi = args.ph_hi;
#define IN(k) (lo <= (k) && (k) < hi)
#define BOTH(k) (IN(k) && IN((k) + 1))
    bf16* WinT = (bf16*)(ws + WS_WIN); bf16* WbcT = (bf16*)(ws + WS_WBC); bf16* WbaT = (bf16*)(ws + WS_WBA); bf16* WoutT = (bf16*)(ws + WS_WOUT); bf16* WpqT = (bf16*)(ws + WS_WPQ);
    bf16* KEYS = (bf16*)(ws + WS_KEYS); float* CS = (float*)(ws + WS_CS); const unsigned char* UB = ws + WS_UB; const unsigned char* VB = ws + WS_VB;
    bf16* XB = (bf16*)(ws + WS_XB); bf16* T6 = (bf16*)(ws + WS_T6); bf16* GAB = (bf16*)(ws + WS_GAB); bf16* UC = (bf16*)(ws + WS_UC); bf16* AO = (bf16*)(ws + WS_AO);
    bf16* TMP = (bf16*)(ws + WS_TMP); bf16* MB = (bf16*)(ws + WS_MB); bf16* X1B = (bf16*)(ws + WS_X1B); bf16* QP = (bf16*)(ws + WS_QP);
    int* EXP = (int*)(ws + WS_EXP); float* GATE = (float*)(ws + WS_GATE);
    unsigned long long* SS = (unsigned long long*)(ws + WS_SS); float* KSUM = (float*)(ws + WS_KSUM);
    constexpr size_t TS = (size_t)M * 1024;

    if (IN(0)) { for (int rep = 0; rep < NREP(0); ++rep) { p0_prologue(F, args.in, ws, args.invf); if (rep + 1 < NREP(0)) GRID_BAR(); } if (BOTH(0)) GRID_BAR(); }
    if (IN(1)) {
        for (int rep = 0; rep < NREP(1); ++rep) {
        pg8::Gemm g{XB, WinT, M, INW, DM}; pg8::StaticOrder S; S.init(M, INW, F.G, (int)blockIdx.x);
        pg8::EpiIn E{T6, GAB, args.in[4], CS, KSUM};
        pg8::gemm_phase<pg8::EpiIn, pg8::StaticOrder, true, true>(F.lds + RING_OFF, g, S, E);
        if (rep + 1 < NREP(1)) GRID_BAR(); }
        if (BOTH(1)) GRID_BAR();
    }
    if (IN(2)) {
        for (int rep = 0; rep < NREP(2); ++rep) {
        attn_mfma(F, T6 + 3 * TS, T6 + 4 * TS, T6 + 5 * TS, KSUM, AO);
        conv_phase(F, T6, T6 + TS, T6 + 2 * TS, args.in[5], UC);
        if (rep + 1 < NREP(2)) GRID_BAR(); }
        if (BOTH(2)) GRID_BAR();
    }
    if (IN(3)) {
        for (int rep = 0; rep < NREP(3); ++rep) {
        pg8::Gemm g{UC, WbcT, M, DM, 1024, AO, WbaT}; pg8::TwoSegOrder S; S.init(M, DM, F.G, (int)blockIdx.x);
        pg8::EpiMerge2 E{GAB, GAB + (size_t)M * DM, MB};
        pg8::gemm_phase<pg8::EpiMerge2, pg8::TwoSegOrder, true, true>(F.lds + RING_OFF, g, S, E);
        if (rep + 1 < NREP(3)) GRID_BAR(); }
        if (BOTH(3)) GRID_BAR();
    }
    if (IN(5)) {
        for (int rep = 0; rep < NREP(5); ++rep) {
        pg8::Gemm g{MB, WoutT, M, DM, DM}; pg8::StaticOrder S; S.init(M, DM, F.G, (int)blockIdx.x);
        pg8::EpiX1 E{args.in[0], args.out, X1B, (rep + 1 < NREP(5)) ? (unsigned long long*)(ws + 768 * 1024) : SS};
        pg8::gemm_phase<pg8::EpiX1, pg8::StaticOrder, true, true>(F.lds + RING_OFF, g, S, E);
        if (rep + 1 < NREP(5)) GRID_BAR(); }
        if (BOTH(5)) GRID_BAR();
    }
    if (IN(6)) {
        for (int rep = 0; rep < NREP(6); ++rep) {
        pg8::Gemm g{X1B, WpqT, M, DM, DM}; pg8::StaticOrder S; S.init(M, DM, F.G, (int)blockIdx.x);
        pg8::EpiQP E{SS, QP};
        pg8::gemm_phase<pg8::EpiQP, pg8::StaticOrder, true, true>(F.lds + RING_OFF, g, S, E);
        if (rep + 1 < NREP(6)) GRID_BAR(); }
        if (BOTH(6)) GRID_BAR();
    }
    if (IN(7)) { for (int rep = 0; rep < NREP(7); ++rep) {
        for (int bitem = F.vcu; bitem < 256; bitem += F.G) {
            topk_stage_keys(F, KEYS, bitem & 7);
            if (F.wave >= 4 && bitem == F.vcu) convert_tables(F, args.in[12], args.in[13], args.in[9], ws);
            topk_phase(F, bitem, QP, EXP, GATE);
            if (F.wave < 4 && bitem == F.vcu) convert_tables(F, args.in[12], args.in[13], args.in[9], ws);
            asm volatile("s_waitcnt lgkmcnt(0)" ::: "memory"); __builtin_amdgcn_s_barrier(); asm volatile("" ::: "memory");
        }
        if (rep + 1 < NREP(7)) GRID_BAR(); } if (BOTH(7)) GRID_BAR(); }
    if (IN(8)) { for (int rep = 0; rep < NREP(8); ++rep) { peer_phase(F, UB, VB, X1B, EXP, GATE, SS, args.in[14], args.out, (rep + 1 < NREP(8)) ? (float*)(ws + WS_END) : args.out); if (rep + 1 < NREP(8)) GRID_BAR(); } }
#undef IN
#undef BOTH
#undef GRID_BAR
}

extern "C" void kernel_launch(void* const* d_in, const int* in_sizes, int n_in, void* d_out, int out_size, void* d_ws, size_t ws_size, hipStream_t stream) {
    static int grid = 0;
    if (grid == 0) {
        if (n_in != 15 || in_sizes[0] != M * DM || out_size != M * DM || ws_size < WS_END) { fprintf(stderr, "kernel_launch: unexpected shapes (n_in %d, in0 %d, out %d, ws %zu)\n", n_in, n_in > 0 ? in_sizes[0] : -1, out_size, ws_size); grid = -1; return; }
        int dev = 0, cus = 0, per_cu = 0;
        if (hipGetDevice(&dev) != hipSuccess || hipDeviceGetAttribute(&cus, hipDeviceAttributeMultiprocessorCount, dev) != hipSuccess) { grid = -1; return; }
        if (hipFuncSetAttribute((const void*)mk_fwd, hipFuncAttributeMaxDynamicSharedMemorySize, LDS_BYTES) != hipSuccess) { fprintf(stderr, "kernel_launch: hipFuncSetAttribute failed\n"); grid = -1; return; }
        if (hipOccupancyMaxActiveBlocksPerMultiprocessor(&per_cu, (const void*)mk_fwd, NWAVES * 64, LDS_BYTES) != hipSuccess || per_cu < 1) fprintf(stderr, "kernel_launch: occupancy query reports %d\n", per_cu);
        (void)hipGetLastError();
        grid = cus;
        if (M % (4 * grid * NWAVES) != 0) { fprintf(stderr, "kernel_launch: the PEER phase needs M %% (32 * grid) == 0 (grid %d)\n", grid); grid = -1; return; }
    }
    if (grid < 0) return;
    if (hipMemsetAsync((char*)d_ws + WS_CTL, 0, CTL_ZERO_BYTES, stream) != hipSuccess) { fprintf(stderr, "kernel_launch: memset failed\n"); return; }
    Args a{};
    for (int i = 0; i < 15; ++i) a.in[i] = (const float*)d_in[i];
    a.out = (float*)d_out; a.ws = (unsigned char*)d_ws;
    for (int f = 0; f < 16; ++f) a.invf[f] = pow(500000.0, -(double)(2 * f) / 32.0);
    for (int li = 0; li < N_LAUNCHES; ++li) {
        a.ph_lo = (N_LAUNCHES == PER_PHASE) ? li : 0; a.ph_hi = (N_LAUNCHES == PER_PHASE) ? li + 1 : PER_PHASE; a.li = li;
        hipLaunchKernelGGL(mk_fwd, dim3(grid), dim3(NWAVES * 64), LDS_BYTES, stream, a);
        const hipError_t le = hipPeekAtLastError();
        if (le != hipSuccess) { fprintf(stderr, "kernel_launch: launch %d failed: %s\n", li, hipGetErrorName(le)); break; }
    }
}
```

```cpp
#include <hip/hip_runtime.h>
#include <cstdio>
#include <cstdint>
#include <cmath>
namespace pg8 {
#define PG8_LAS __attribute__((address_space(3)))
typedef unsigned short bf16_t;
typedef short bf16x8 __attribute__((ext_vector_type(8)));
typedef float f32x4 __attribute__((ext_vector_type(4)));
typedef unsigned u32x4 __attribute__((ext_vector_type(4)));
constexpr int BM = 256, BK = 64, HALF = 128, HTB = HALF * BK * 2  , STAGE_BYTES = 8 * HTB, NXCD = 8, WGM = 8;

__host__ __device__ __forceinline__ int lds_byte(int r, int c) { const int st = (r >> 4) * 2 + (c >> 5), rr = r & 15, cc = c & 31, ob = rr * 64 + cc * 2; return st * 1024 + (ob ^ (((ob >> 9) & 1) << 5)); }
__host__ __device__ __forceinline__ void stage_rc(int b, int& R, int& C) { const int st = b / 1024, sb = b % 1024, swz = sb ^ (((sb >> 9) & 1) << 5); R = (st >> 1) * 16 + swz / 64; C = (st & 1) * 32 + (swz % 64) / 2; }
__host__ __device__ __forceinline__ int perm32(int rho) { const int n = rho >> 4, i = rho & 15; return 8 * (i >> 2) + 4 * n + (i & 3); }

struct Unit { int pm, pn, seg; };
struct Gemm { const bf16_t* A; const bf16_t* Bt; int M, N, K; const bf16_t* A2; const bf16_t* Bt2; };

struct StaticOrder {
    int nM, nN, nwg, G, c;
    __host__ __device__ void init(int M, int N, int G_, int c_) { nM = M / BM; nN = N / BM; nwg = nM * nN; G = G_; c = c_; }
    __host__ __device__ bool next(int i, Unit& u) const {
        const long L = (long)i * G + c; if (L >= nwg) return false;
        int wgid = (int)L; { const int q = nwg / NXCD, r = nwg % NXCD, xcd = wgid % NXCD, off = wgid / NXCD; wgid = (xcd < r ? xcd * (q + 1) : r * (q + 1) + (xcd - r) * q) + off; }
        const int nig = WGM * nN, gid = wgid / nig, fm = gid * WGM, gsz = (nM - fm) < WGM ? (nM - fm) : WGM;
        u.pm = fm + ((wgid % nig) % gsz); u.pn = (wgid % nig) / gsz; u.seg = 0; return true;
    }
    __device__ __forceinline__ void a_ready(const Unit&) const {}
    __device__ __forceinline__ void done(const Unit&) const {}
};
struct TwoSegOrder {
    StaticOrder so;
    __host__ __device__ void init(int M, int N, int G_, int c_) { so.init(M, N, G_, c_); }
    __host__ __device__ bool next(int i, Unit& u) const { if (!so.next(i >> 1, u)) return false; u.seg = i & 1; return true; }
    __device__ __forceinline__ void a_ready(const Unit&) const {}
    __device__ __forceinline__ void done(const Unit&) const {}
};


typedef float f32x2c __attribute__((ext_vector_type(2))); typedef __bf16 bf16x2c __attribute__((ext_vector_type(2)));
__device__ __forceinline__ unsigned cvt_pk_bf16(float lo, float hi) { const f32x2c v = {lo, hi}; const bf16x2c b = __builtin_convertvector(v, bf16x2c); return __builtin_bit_cast(unsigned, b); }
__device__ __forceinline__ u32x4 pack8(f32x4 a, f32x4 b) { u32x4 w; w.x = cvt_pk_bf16(a[0], a[1]); w.y = cvt_pk_bf16(a[2], a[3]); w.z = cvt_pk_bf16(b[0], b[1]); w.w = cvt_pk_bf16(b[2], b[3]); return w; }
__device__ __forceinline__ f32x4 shx(f32x4 v, int o) { f32x4 r; r[0] = __shfl_xor(v[0], o); r[1] = __shfl_xor(v[1], o); r[2] = __shfl_xor(v[2], o); r[3] = __shfl_xor(v[3], o); return r; }
__device__ __forceinline__ f32x4 bf4lo(unsigned a, unsigned b) { f32x4 r; r[0] = __uint_as_float(a << 16); r[1] = __uint_as_float(a & 0xffff0000u); r[2] = __uint_as_float(b << 16); r[3] = __uint_as_float(b & 0xffff0000u); return r; }
__device__ __forceinline__ f32x4 sigm4(f32x4 v) { f32x4 r;
#pragma unroll
    for (int i = 0; i < 4; ++i) r[i] = __builtin_amdgcn_rcpf(1.0f + __expf(-v[i])); return r; }
constexpr float QSCALE = 0.08838834764831845f * 1.4426950408889634f;

struct EpiIn {
    static constexpr bool PERM = true, AFTER_DRAIN = false, KEEP_SEG0 = false;
    bf16_t* T6; bf16_t* GAB; const float* gbias; const float* cs; float* ksum;
    __device__ __forceinline__ void operator()(const f32x4 (&acc)[2][2][4][2], const Unit& u, int wr, int wc, int fr, int fq) const {
        const int row0 = u.pm * BM + wr * 64 + fr, pn = u.pn, colw = wc * 32 + 8 * fq;
        if (pn < 24) {
            const int t = pn >> 2;
            bf16_t* base = T6 + (size_t)t * ((size_t)8192 * 1024) + (pn & 3) * 256 + colw;
            const bool rot = (t == 3 || t == 4) && (wc == 0), isk = (t == 4);
            const float qs = (t == 3) ? QSCALE : 1.0f;
            f32x4 ks[2][2];
#pragma unroll
            for (int bj = 0; bj < 2; ++bj) { ks[bj][0] = (f32x4){0.f, 0.f, 0.f, 0.f}; ks[bj][1] = (f32x4){0.f, 0.f, 0.f, 0.f}; }
#pragma unroll
            for (int ai = 0; ai < 2; ++ai)
#pragma unroll
                for (int m = 0; m < 4; ++m) {
                    const int row = row0 + ai * HALF + m * 16;
                    f32x4 c0 = (f32x4){1.f, 1.f, 1.f, 1.f}, c1 = c0, s0 = (f32x4){0.f, 0.f, 0.f, 0.f}, s1 = s0;
                    if (rot) { const float* cp = cs + (size_t)row * 32 + 8 * (fq & 1); c0 = *(const f32x4*)cp; c1 = *(const f32x4*)(cp + 4); s0 = *(const f32x4*)(cp + 16); s1 = *(const f32x4*)(cp + 20);
                        if (fq < 2) { s0 = -s0; s1 = -s1; } }
#pragma unroll
                    for (int bj = 0; bj < 2; ++bj) {
                        f32x4 v0 = acc[ai][bj][m][0], v1 = acc[ai][bj][m][1];
                        if (rot) { const f32x4 p0 = shx(v0, 32), p1 = shx(v1, 32); v0 = v0 * c0 + p0 * s0; v1 = v1 * c1 + p1 * s1; }
                        if (isk) { ks[bj][0] += v0; ks[bj][1] += v1; }
                        v0 = v0 * qs; v1 = v1 * qs;
                        *(u32x4*)(base + (size_t)row * 1024 + bj * HALF) = pack8(v0, v1);
                    }
                }
            if (isk) {
#pragma unroll
                for (int bj = 0; bj < 2; ++bj)
#pragma unroll
                    for (int n = 0; n < 2; ++n) { f32x4 v = ks[bj][n]; v += shx(v, 1); v += shx(v, 2); v += shx(v, 4); v += shx(v, 8);
                        if (fr == 0) { float* kp = ksum + (size_t)u.pm * 1024 + (pn & 3) * 256 + bj * HALF + colw + 4 * n;
                            unsafeAtomicAdd(kp + 0, v[0]); unsafeAtomicAdd(kp + 1, v[1]); unsafeAtomicAdd(kp + 2, v[2]); unsafeAtomicAdd(kp + 3, v[3]); } }
            }
        } else {
            const int t = (pn - 24) >> 3, colg = ((pn - 24) & 7) * 256 + colw;
            bf16_t* base = GAB + (size_t)t * ((size_t)8192 * 2048) + colg;
            const float* bp = gbias + t * 2048 + colg;
            f32x4 bv[2][2];
#pragma unroll
            for (int bj = 0; bj < 2; ++bj) { bv[bj][0] = *(const f32x4*)(bp + bj * HALF); bv[bj][1] = *(const f32x4*)(bp + bj * HALF + 4); }
#pragma unroll
            for (int ai = 0; ai < 2; ++ai)
#pragma unroll
                for (int m = 0; m < 4; ++m) { const int row = row0 + ai * HALF + m * 16;
#pragma unroll
                    for (int bj = 0; bj < 2; ++bj) *(u32x4*)(base + (size_t)row * 2048 + bj * HALF) = pack8(sigm4(acc[ai][bj][m][0] + bv[bj][0]), sigm4(acc[ai][bj][m][1] + bv[bj][1])); }
        }
    }
};
struct EpiMerge2 {
    static constexpr bool PERM = true, AFTER_DRAIN = false, KEEP_SEG0 = true;
    const bf16_t* GA; const bf16_t* GB; bf16_t* O;
    __device__ __forceinline__ void operator()(f32x4 (&acc)[2][2][4][2], const Unit& u, int wr, int wc, int fr, int fq) const {
        const int row0 = u.pm * BM + wr * 64 + fr, col0 = u.pn * BM + wc * 32 + 8 * fq;
        if (u.seg == 0) {
#pragma unroll
            for (int ai = 0; ai < 2; ++ai)
#pragma unroll
                for (int m = 0; m < 4; ++m) { const size_t off = (size_t)(row0 + ai * HALF + m * 16) * 2048 + col0;
#pragma unroll
                    for (int bj = 0; bj < 2; ++bj) { const u32x4 a = *(const u32x4*)(GA + off + bj * HALF), b = *(const u32x4*)(GB + off + bj * HALF);
                        const f32x4 b0 = bf4lo(b.x, b.y), b1 = bf4lo(b.z, b.w); f32x4 r0, r1;
#pragma unroll
                        for (int e = 0; e < 4; ++e) { r0[e] = __builtin_amdgcn_rcpf(fmaxf(b0[e], 1e-20f)); r1[e] = __builtin_amdgcn_rcpf(fmaxf(b1[e], 1e-20f)); }
                        acc[ai][bj][m][0] = acc[ai][bj][m][0] * (bf4lo(a.x, a.y) * r0); acc[ai][bj][m][1] = acc[ai][bj][m][1] * (bf4lo(a.z, a.w) * r1); } }
        } else {
#pragma unroll
            for (int ai = 0; ai < 2; ++ai)
#pragma unroll
                for (int m = 0; m < 4; ++m) { const size_t off = (size_t)(row0 + ai * HALF + m * 16) * 2048 + col0;
#pragma unroll
                    for (int bj = 0; bj < 2; ++bj) { const u32x4 b = *(const u32x4*)(GB + off + bj * HALF);
                        f32x4 b0 = bf4lo(b.x, b.y), b1 = bf4lo(b.z, b.w);
#pragma unroll
                        for (int e = 0; e < 4; ++e) { b0[e] = fmaxf(b0[e], 1e-20f); b1[e] = fmaxf(b1[e], 1e-20f); }
                        *(u32x4*)(O + off + bj * HALF) = pack8(acc[ai][bj][m][0] * b0, acc[ai][bj][m][1] * b1); } }
        }
    }
};
struct EpiX1 {
    static constexpr bool PERM = true, AFTER_DRAIN = false, KEEP_SEG0 = false;
    const float* X; float* X1; bf16_t* X1B; unsigned long long* SS;
    __device__ __forceinline__ void operator()(const f32x4 (&acc)[2][2][4][2], const Unit& u, int wr, int wc, int fr, int fq) const {
        const int row0 = u.pm * BM + wr * 64 + fr, col0 = u.pn * BM + wc * 32 + 8 * fq;
#pragma unroll
        for (int ai = 0; ai < 2; ++ai)
#pragma unroll
            for (int m = 0; m < 4; ++m) { const int row = row0 + ai * HALF + m * 16; const size_t off = (size_t)row * 2048 + col0; float sq = 0.f;
#pragma unroll
                for (int bj = 0; bj < 2; ++bj) { const f32x4 v0 = acc[ai][bj][m][0] + *(const f32x4*)(X + off + bj * HALF), v1 = acc[ai][bj][m][1] + *(const f32x4*)(X + off + bj * HALF + 4);
                    *(u32x4*)(X1B + off + bj * HALF) = pack8(v0, v1);
                    sq += (v0[0] * v0[0] + v0[1] * v0[1]) + (v0[2] * v0[2] + v0[3] * v0[3]) + (v1[0] * v1[0] + v1[1] * v1[1]) + (v1[2] * v1[2] + v1[3] * v1[3]); }
                sq += __shfl_xor(sq, 16); sq += __shfl_xor(sq, 32);
                if (fq == 0) atomicAdd(SS + row, (unsigned long long)(sq * 4294967296.0f)); }
    }
};
__device__ __forceinline__ float rinv_from_ss(unsigned long long s) { return 1.0f / sqrtf((float)((double)s * (1.0 / 4294967296.0) * (1.0 / 2048.0)) + 1e-6f); }
struct EpiQP {
    static constexpr bool PERM = true, AFTER_DRAIN = false, KEEP_SEG0 = false;
    const unsigned long long* SS; bf16_t* O;
    __device__ __forceinline__ void operator()(const f32x4 (&acc)[2][2][4][2], const Unit& u, int wr, int wc, int fr, int fq) const {
        const int row0 = u.pm * BM + wr * 64 + fr, col0 = u.pn * BM + wc * 32 + 8 * fq;
#pragma unroll
        for (int ai = 0; ai < 2; ++ai)
#pragma unroll
            for (int m = 0; m < 4; ++m) { const int row = row0 + ai * HALF + m * 16; const size_t off = (size_t)row * 2048 + col0; const float rv = rinv_from_ss(SS[row]);
#pragma unroll
                for (int bj = 0; bj < 2; ++bj) *(u32x4*)(O + off + bj * HALF) = pack8(acc[ai][bj][m][0] * rv, acc[ai][bj][m][1] * rv); }
    }
};

template <class Epi, class Sched, bool ALIGN_EPI = false, bool SP2 = false>
__device__ __forceinline__ void gemm_phase(PG8_LAS unsigned char* lds, const Gemm g, const Sched& S, const Epi& E) {
    const int tid = threadIdx.x, wid = __builtin_amdgcn_readfirstlane(tid >> 6), lane = tid & 63, wr = wid >> 2, wc = wid & 3, fr = lane & 15, fq = lane >> 4;
    const int K = g.K, nt = K / BK;
    unsigned voffA[2], voffB[2];
#pragma unroll
    for (int i = 0; i < 2; ++i) { int R, C; stage_rc(tid * 16 + i * 8192, R, C); const int Rb = Epi::PERM ? ((R & ~31) + perm32(R & 31)) : R;
        voffA[i] = (unsigned)(R * K + C) * 2u; voffB[i] = (unsigned)(Rb * K + C) * 2u; }
    const size_t kstep = (size_t)(BK * 2);
    const size_t hstep = (size_t)HALF * K * 2;
    const size_t tstep = 2 * hstep;
    const unsigned ldsw = (unsigned)wid * 1024u;
    const int aoff = lds_byte(wr * 64 + fr, fq * 8), boff = lds_byte(wc * 32 + fr, fq * 8);
#define PG8_SA(b, h) (((b) * 2 + (h)) * HTB)
#define PG8_SB(b, h) ((4 + (b) * 2 + (h)) * HTB)
#define PG8_STAGE(bufoff, gbase, voff) do { _Pragma("unroll") for (int _i = 0; _i < 2; ++_i) \
        __builtin_amdgcn_global_load_lds((const unsigned*)((const char*)(gbase) + (voff)[_i]), (PG8_LAS unsigned*)(lds + (bufoff) + ldsw + _i * 8192), 16, 0, 0); } while (0)
#define PG8_LDA(dst, b, h) do { _Pragma("unroll") for (int m = 0; m < 4; ++m) _Pragma("unroll") for (int k = 0; k < 2; ++k) dst[m][k] = *(const PG8_LAS bf16x8*)(lds + PG8_SA(b, h) + aoff + m * 2048 + k * 1024); } while (0)
#define PG8_LDB(dst, b, h) do { _Pragma("unroll") for (int n = 0; n < 2; ++n) _Pragma("unroll") for (int k = 0; k < 2; ++k) dst[n][k] = *(const PG8_LAS bf16x8*)(lds + PG8_SB(b, h) + boff + n * 2048 + k * 1024); } while (0)
#define PG8_MMA(ai, bj, At, Bt) do { __builtin_amdgcn_s_setprio(1); _Pragma("unroll") for (int m = 0; m < 4; ++m) _Pragma("unroll") for (int n = 0; n < 2; ++n) _Pragma("unroll") for (int k = 0; k < 2; ++k) \
        acc[ai][bj][m][n] = __builtin_amdgcn_mfma_f32_16x16x32_bf16(Bt[n][k], At[m][k], acc[ai][bj][m][n], 0, 0, 0); __builtin_amdgcn_s_setprio(0); } while (0)
#define PG8_WAIT_V(n) asm volatile("s_waitcnt vmcnt(" #n ")" ::: "memory")
#define PG8_WAIT_L(n) asm volatile("s_waitcnt lgkmcnt(" #n ")" ::: "memory")
#define PG8_BAR __builtin_amdgcn_s_barrier()
#define PG8_SCHED __builtin_amdgcn_sched_barrier(0)
    Unit cur, nxt; int ui = 0;
    if (!S.next(0, cur)) return;
    f32x4 acc[2][2][4][2];
#pragma unroll
    for (int a = 0; a < 2; ++a)
#pragma unroll
        for (int b = 0; b < 2; ++b)
#pragma unroll
            for (int m = 0; m < 4; ++m)
#pragma unroll
                for (int n = 0; n < 2; ++n) acc[a][b][m][n] = (f32x4){0.f, 0.f, 0.f, 0.f};
    bf16x8 At[4][2], B0[2][2], B1[2][2];
    const char* cA = (const char*)(cur.seg ? g.A2 : g.A) + (size_t)cur.pm * tstep; const char* cB = (const char*)(cur.seg ? g.Bt2 : g.Bt) + (size_t)cur.pn * tstep;
    S.a_ready(cur);
    if constexpr (SP2) {
        PG8_STAGE(PG8_SB(0, 0), cB, voffB); PG8_STAGE(PG8_SB(0, 1), cB + hstep, voffB); PG8_STAGE(PG8_SA(0, 0), cA, voffA); PG8_STAGE(PG8_SA(0, 1), cA + hstep, voffA);
        if (wr == 1) PG8_BAR;
        PG8_WAIT_V(2); PG8_BAR;
        PG8_STAGE(PG8_SB(1, 0), cB + kstep, voffB); PG8_STAGE(PG8_SA(1, 0), cA + kstep, voffA); PG8_STAGE(PG8_SB(1, 1), cB + hstep + kstep, voffB);
        PG8_WAIT_V(6); PG8_BAR;
    } else {
        PG8_STAGE(PG8_SB(0, 0), cB, voffB); PG8_STAGE(PG8_SA(0, 0), cA, voffA); PG8_STAGE(PG8_SB(0, 1), cB + hstep, voffB); PG8_STAGE(PG8_SA(0, 1), cA + hstep, voffA);
        if (wr == 1) PG8_BAR;
        PG8_WAIT_V(4); PG8_BAR;
        PG8_STAGE(PG8_SB(1, 0), cB + kstep, voffB); PG8_STAGE(PG8_SA(1, 0), cA + kstep, voffA); PG8_STAGE(PG8_SB(1, 1), cB + hstep + kstep, voffB);
        PG8_WAIT_V(6); PG8_BAR;
    }
    for (;;) {
        const bool has_next = S.next(ui + 1, nxt);
        const char* nA = has_next ? (const char*)(nxt.seg ? g.A2 : g.A) + (size_t)nxt.pm * tstep : cA; const char* nB = has_next ? (const char*)(nxt.seg ? g.Bt2 : g.Bt) + (size_t)nxt.pn * tstep : cB;
        for (int t = 0; t < nt; t += 2) {
            const bool last = (t == nt - 2);
            const char* a1 = cA + (size_t)(t + 1) * kstep;
            const char* a2 = last ? nA : cA + (size_t)(t + 2) * kstep; const char* b2 = last ? nB : cB + (size_t)(t + 2) * kstep;
            const char* a3 = a2 + kstep; const char* b3 = b2 + kstep;
            if (last && has_next) S.a_ready(nxt);
            if constexpr (SP2) {
            PG8_LDB(B0, 0, 0); PG8_LDB(B1, 0, 1); PG8_SCHED; PG8_LDA(At, 0, 0); PG8_STAGE(PG8_SA(1, 1), a1 + hstep, voffA);
            PG8_WAIT_V(8); PG8_WAIT_L(0); PG8_BAR; PG8_MMA(0, 0, At, B0); PG8_MMA(0, 1, At, B1); PG8_BAR; PG8_SCHED;
            PG8_LDA(At, 0, 1); PG8_STAGE(PG8_SB(0, 0), b2, voffB); PG8_STAGE(PG8_SB(0, 1), b2 + hstep, voffB); PG8_STAGE(PG8_SA(0, 0), a2, voffA);
            PG8_WAIT_V(8); PG8_WAIT_L(0); PG8_BAR; PG8_MMA(1, 0, At, B0); PG8_MMA(1, 1, At, B1); PG8_BAR; PG8_SCHED;
            PG8_LDB(B0, 1, 0); PG8_LDB(B1, 1, 1); PG8_SCHED; PG8_LDA(At, 1, 0); PG8_STAGE(PG8_SA(0, 1), a2 + hstep, voffA);
            PG8_WAIT_V(8); PG8_WAIT_L(0); PG8_BAR; PG8_MMA(0, 0, At, B0); PG8_MMA(0, 1, At, B1); PG8_BAR; PG8_SCHED;
            PG8_LDA(At, 1, 1); PG8_STAGE(PG8_SB(1, 0), b3, voffB); PG8_STAGE(PG8_SB(1, 1), b3 + hstep, voffB); PG8_STAGE(PG8_SA(1, 0), a3, voffA);
            PG8_WAIT_V(8); PG8_WAIT_L(0); PG8_BAR; PG8_MMA(1, 0, At, B0); PG8_MMA(1, 1, At, B1); PG8_BAR; PG8_SCHED;
            } else {
            PG8_LDB(B0, 0, 0); PG8_SCHED; PG8_LDA(At, 0, 0); PG8_STAGE(PG8_SA(1, 1), a1 + hstep, voffA);
            PG8_WAIT_L(8); PG8_BAR; PG8_WAIT_L(0); PG8_MMA(0, 0, At, B0); PG8_BAR; PG8_SCHED;
            PG8_LDB(B1, 0, 1); PG8_STAGE(PG8_SB(0, 0), b2, voffB);
            PG8_BAR; PG8_WAIT_L(0); PG8_MMA(0, 1, At, B1); PG8_BAR;
            PG8_LDA(At, 0, 1); PG8_STAGE(PG8_SA(0, 0), a2, voffA);
            PG8_BAR; PG8_WAIT_L(0); PG8_MMA(1, 0, At, B0); PG8_BAR; PG8_SCHED;
            PG8_STAGE(PG8_SB(0, 1), b2 + hstep, voffB);
            PG8_WAIT_V(6); PG8_BAR; PG8_MMA(1, 1, At, B1); PG8_BAR;
            PG8_LDB(B0, 1, 0); PG8_SCHED; PG8_LDA(At, 1, 0); PG8_STAGE(PG8_SA(0, 1), a2 + hstep, voffA);
            PG8_WAIT_L(8); PG8_BAR; PG8_WAIT_L(0); PG8_MMA(0, 0, At, B0); PG8_BAR; PG8_SCHED;
            PG8_LDB(B1, 1, 1); PG8_STAGE(PG8_SB(1, 0), b3, voffB);
            PG8_BAR; PG8_WAIT_L(0); PG8_MMA(0, 1, At, B1); PG8_BAR;
            PG8_LDA(At, 1, 1); PG8_STAGE(PG8_SA(1, 0), a3, voffA);
            PG8_BAR; PG8_WAIT_L(0); PG8_MMA(1, 0, At, B0); PG8_BAR; PG8_SCHED;
            PG8_STAGE(PG8_SB(1, 1), b3 + hstep, voffB);
            PG8_WAIT_V(6); PG8_BAR; PG8_MMA(1, 1, At, B1); PG8_BAR;
            }
        }
        if constexpr (ALIGN_EPI) { if (wr == 0) PG8_BAR; }
        if constexpr (!Epi::AFTER_DRAIN) { E(acc, cur, wr, wc, fr, fq); S.done(cur); }
        if (!has_next) break;
        if (!(Epi::KEEP_SEG0 && cur.seg == 0)) {
#pragma unroll
        for (int a = 0; a < 2; ++a)
#pragma unroll
            for (int b = 0; b < 2; ++b)
#pragma unroll
                for (int m = 0; m < 4; ++m)
#pragma unroll
                    for (int n = 0; n < 2; ++n) acc[a][b][m][n] = (f32x4){0.f, 0.f, 0.f, 0.f};
        }
        cur = nxt; cA = nA; cB = nB; ++ui;
        if constexpr (ALIGN_EPI) { if (wr == 1) PG8_BAR; }
    }
    PG8_WAIT_V(0);
    if constexpr (!ALIGN_EPI) { if (wr == 0) PG8_BAR; }
    PG8_BAR;
    if constexpr (Epi::AFTER_DRAIN) { E.fused(acc, cur, wr, wc, fr, fq, lds, wid, lane); S.done(cur); }
#undef PG8_SA
#undef PG8_SB
#undef PG8_STAGE
#undef PG8_LDA
#undef PG8_LDB
#undef PG8_MMA
#undef PG8_WAIT_V
#undef PG8_WAIT_L
#undef PG8_BAR
#undef PG8_SCHED
}
}

constexpr int NWAVES = 8;
#ifndef MK_N_LAUNCHES
#define MK_N_LAUNCHES 1
#endif
constexpr int PER_PHASE = 9;
#ifndef MK_REP_PHASE
#define MK_REP_PHASE -1
#endif
#define NREP(k) (((k) == MK_REP_PHASE) ? 2 : 1)
constexpr int N_LAUNCHES = MK_N_LAUNCHES;
constexpr int M = 8192, SEQ = 4096, DM = 2048, INW = 10240, NEXP = 16384;
constexpr float RMS_EPS = 1e-6f;
constexpr size_t MiB = 1u << 20;
constexpr size_t WS_CTL = 0, CTL_ZERO_BYTES = 64 * 1024;
constexpr size_t WS_SS = 256 * 1024, WS_KSUM = 512 * 1024;
constexpr size_t WS_WIN = 2 * MiB, WS_WBC = 42 * MiB, WS_WBA = 46 * MiB, WS_WOUT = 50 * MiB, WS_WPQ = 58 * MiB, WS_KEYS = 66 * MiB, WS_CS = 67 * MiB;
constexpr size_t WS_UB = 70 * MiB, WS_VB = 102 * MiB;
constexpr size_t WS_XB = 198 * MiB;
constexpr size_t WS_T6 = 230 * MiB;
constexpr size_t WS_GAB = 326 * MiB;
constexpr size_t WS_UC = 390 * MiB, WS_AO = 406 * MiB;
constexpr size_t WS_EXP = 422 * MiB, WS_GATE = 426 * MiB;
constexpr size_t WS_END = 430 * MiB;
constexpr size_t WS_TMP = WS_XB, WS_MB = WS_T6, WS_X1B = WS_T6 + 48 * MiB, WS_QP = WS_GAB;
constexpr int CW_BAR = 4096;
constexpr int RING_OFF = 0, RING_BYTES = 131072;
constexpr int LDSCTL_OFF = RING_BYTES, MISC_OFF = LDSCTL_OFF + 320;
constexpr int LDS_BYTES = 147456;

#define GAS __attribute__((address_space(1)))
#define LAS __attribute__((address_space(3)))
typedef unsigned short bf16;
typedef unsigned v4u __attribute__((ext_vector_type(4)));
typedef float f32x4 __attribute__((ext_vector_type(4)));
typedef short bf16x8 __attribute__((ext_vector_type(8)));
typedef GAS unsigned gu32;
typedef GAS unsigned long long gu64;
#define RLX_AGENT __ATOMIC_RELAXED, __HIP_MEMORY_SCOPE_AGENT
#define LDS_WAIT() asm volatile("s_waitcnt lgkmcnt(0)" ::: "memory")
#define VM_WAIT() asm volatile("s_waitcnt vmcnt(0)" ::: "memory")
__device__ __forceinline__ unsigned long long rt() { return __builtin_amdgcn_s_memrealtime(); }
__device__ __forceinline__ unsigned f2bf(float f) { unsigned u = __builtin_bit_cast(unsigned, f); return (u + 0x7fffu + ((u >> 16) & 1u)) >> 16; }
__device__ __forceinline__ unsigned pk2(float lo, float hi) { return f2bf(lo) | (f2bf(hi) << 16); }

#define XB_TMO      128
#define XB_XCNT(j)  (256  + 64 * (j))
#define XB_XSUB(j)  (1280 + 64 * (j))
#define XB_XGEN(j)  (2304 + 64 * (j))
#define XB_TOP      3328
#define XB_TOPGEN   3392
#define XCD_BAR_WORDS 3456
#define XB_SPIN_CAP (1u << 18)

__device__ __forceinline__ unsigned xb_ld(unsigned* p)              { return __hip_atomic_load(p, __ATOMIC_RELAXED, __HIP_MEMORY_SCOPE_AGENT); }
__device__ __forceinline__ unsigned xb_add(unsigned* p, unsigned v) { return __hip_atomic_fetch_add(p, v, __ATOMIC_RELAXED, __HIP_MEMORY_SCOPE_AGENT); }
__device__ __forceinline__ unsigned xb_xcc_id() { return (unsigned)__builtin_amdgcn_s_getreg((3 << 11) | 20) & 0xFu; }
#define XB_SPIN(cond, bar) do { unsigned _sp = 0; while (cond) { __builtin_amdgcn_s_sleep(1); \
    if ((++_sp & 255u) == 0u) { if (xb_ld(&(bar)[XB_TMO])) break; if (_sp > XB_SPIN_CAP) { atomicAdd(&(bar)[XB_TMO], 1u); break; } } } } while (0)

struct XcdBarrier {
    unsigned* bar; unsigned x;
    volatile LAS unsigned* st;
};

__device__ __forceinline__ XcdBarrier xcd_barrier_post(unsigned* bar, volatile LAS unsigned* st) {
    XcdBarrier b; b.bar = bar; b.x = xb_xcc_id(); b.st = st;
    if (threadIdx.x == 0) (void)xb_add(&bar[XB_XCNT(b.x)], 1u);
    return b;
}
__device__ __forceinline__ void xcd_barrier_complete(unsigned* bar, unsigned x, unsigned& nloc, unsigned& nx) {
    const unsigned G = gridDim.x * gridDim.y * gridDim.z;
    unsigned sum, cnt, mine, sp = 0u;
    for (;;) {
        sum = 0u; cnt = 0u; mine = 0u;
#pragma unroll
        for (unsigned j = 0; j < 16; ++j) { const unsigned c = xb_ld(&bar[XB_XCNT(j)]); sum += c; cnt += (c > 0u) ? 1u : 0u; mine = (j == x) ? c : mine; }
        if (sum == G) break;
        __builtin_amdgcn_s_sleep(1);
        if ((++sp & 255u) == 0u) { if (xb_ld(&bar[XB_TMO])) break; if (sp > XB_SPIN_CAP) { atomicAdd(&bar[XB_TMO], 1u); break; } }
    }
    nloc = mine > 0u ? mine : 1u; nx = cnt > 0u ? cnt : 1u;
}

__device__ __forceinline__ void xcd_barrier(const XcdBarrier& b) {
    asm volatile("s_waitcnt vmcnt(0)" ::: "memory");
    __syncthreads();
    if (threadIdx.x == 0) {
        unsigned* bar = b.bar;
        __builtin_amdgcn_s_waitcnt(0);
        unsigned nloc = b.st[0], nx = b.st[1];
        if (nloc == 0u) { xcd_barrier_complete(bar, b.x, nloc, nx); b.st[0] = nloc; b.st[1] = nx; }
        const unsigned old = xb_add(&bar[XB_XSUB(b.x)], 1u);
        const unsigned gen = old / nloc;
        if (old + 1u == (gen + 1u) * nloc) {
            __builtin_amdgcn_fence(__ATOMIC_RELEASE, "agent");
            asm volatile("s_waitcnt vmcnt(0)" ::: "memory");
            const unsigned og = xb_add(&bar[XB_TOP], 1u);
            const unsigned tg = og / nx;
            if (og + 1u == (tg + 1u) * nx) xb_add(&bar[XB_TOPGEN], 1u);
            else XB_SPIN(xb_ld(&bar[XB_TOPGEN]) == tg, bar);
            __builtin_amdgcn_fence(__ATOMIC_ACQUIRE, "agent");
            xb_add(&bar[XB_XGEN(b.x)], 1u);
            asm volatile("s_waitcnt vmcnt(0)" ::: "memory");
        } else {
            XB_SPIN(xb_ld(&bar[XB_XGEN(b.x)]) == gen, bar);
            __builtin_amdgcn_fence(__ATOMIC_ACQUIRE, "agent");
            asm volatile("s_waitcnt vmcnt(0)" ::: "memory");
        }
    }
    __syncthreads();
}

typedef __bf16 bf16x2v __attribute__((ext_vector_type(2)));
typedef float f32x16 __attribute__((ext_vector_type(16)));
__device__ __forceinline__ float bflo(unsigned w) { return __uint_as_float(w << 16); }
__device__ __forceinline__ float bfhi(unsigned w) { return __uint_as_float(w & 0xffff0000u); }
__device__ __forceinline__ float dot2bf(unsigned a, unsigned b, float c) { return __builtin_amdgcn_fdot2_f32_bf16(__builtin_bit_cast(bf16x2v, a), __builtin_bit_cast(bf16x2v, b), c, false); }
__device__ __forceinline__ float wave_sum(float v) {
#pragma unroll
    for (int o = 1; o < 64; o <<= 1) v += __shfl_xor(v, o);
    return v; }
__device__ __forceinline__ float wave_max(float v) {
#pragma unroll
    for (int o = 1; o < 64; o <<= 1) v = fmaxf(v, __shfl_xor(v, o));
    return v; }
__device__ __forceinline__ float rdlane(float v, int l) { return __int_as_float(__builtin_amdgcn_readlane(__float_as_int(v), l)); }
__device__ __forceinline__ float gelu_tanh(float x) { const float z = 0.7978845608028654f * (x + 0.044715f * x * x * x); const float e = __expf(2.0f * z); const float th = 1.0f - 2.0f * __builtin_amdgcn_rcpf(1.0f + e); return 0.5f * x * (1.0f + th); }

struct Ctx { LAS unsigned char* lds; int tid, lane, wave, vcu, G; };

__device__ __forceinline__ void p0_transpose_item(const float* W, int K, int N, bf16* WT, const float* gk, LAS float* scr, int item, int lane) {
    const int nblk = N / 32, kb = item / nblk, nb = item % nblk, k0 = 64 * kb, n0 = 32 * nb;
#pragma unroll
    for (int i = 0; i < 8; ++i) { const int kk = 8 * i + (lane >> 3), nn = 4 * (lane & 7); f32x4 v = *(const GAS f32x4*)(W + (size_t)(k0 + kk) * N + n0 + nn); if (gk) v = v * gk[k0 + kk];
        scr[kk * 33 + nn] = v[0]; scr[kk * 33 + nn + 1] = v[1]; scr[kk * 33 + nn + 2] = v[2]; scr[kk * 33 + nn + 3] = v[3]; }
    LDS_WAIT(); asm volatile("" ::: "memory");
    const int c = lane & 7;
#pragma unroll
    for (int j = 0; j < 4; ++j) { const int n = (lane >> 3) + 8 * j; const LAS float* s = scr + (8 * c) * 33 + n;
        v4u o; o.x = pk2(s[0 * 33], s[1 * 33]); o.y = pk2(s[2 * 33], s[3 * 33]); o.z = pk2(s[4 * 33], s[5 * 33]); o.w = pk2(s[6 * 33], s[7 * 33]);
        *(GAS v4u*)(WT + (size_t)(n0 + n) * K + k0 + 8 * c) = o; }
    LDS_WAIT(); asm volatile("" ::: "memory");
}
__device__ __forceinline__ void convert_tables(const Ctx& F, const float* pu, const float* pv, const float* g2, unsigned char* ws) {
    const int gt = (F.vcu * NWAVES + F.wave) * 64 + F.lane, NT = F.G * NWAVES * 64;
    for (int i = gt; i < NEXP * 2048 / 16; i += NT) { const int c16 = (i & 127) * 16; v4u ou, ov;
#pragma unroll
        for (int q = 0; q < 4; ++q) { f32x4 a = ((const GAS f32x4*)pu)[4 * i + q]; a = a * *(const GAS f32x4*)(g2 + c16 + 4 * q) * 512.0f; const f32x4 b = ((const GAS f32x4*)pv)[4 * i + q] * 32.0f;
            int wu = 0, wv = 0; wu = __builtin_amdgcn_cvt_pk_fp8_f32(a[0], a[1], wu, false); wu = __builtin_amdgcn_cvt_pk_fp8_f32(a[2], a[3], wu, true);
            wv = __builtin_amdgcn_cvt_pk_fp8_f32(b[0], b[1], wv, false); wv = __builtin_amdgcn_cvt_pk_fp8_f32(b[2], b[3], wv, true); ou[q] = (unsigned)wu; ov[q] = (unsigned)wv; }
        ((GAS v4u*)(ws + WS_UB))[i] = ou; ((GAS v4u*)(ws + WS_VB))[i] = ov; }
}
__device__ __forceinline__ void p0_prologue(const Ctx& F, const float* const* in, unsigned char* ws, const double* invf) {
    const float* x = in[0]; const int* pos = (const int*)in[1]; const float* g1 = in[2]; const float* w_in = in[3];
    const float* w_bc = in[6]; const float* w_ba = in[7]; const float* w_out = in[8]; const float* g2 = in[9]; const float* w_pq = in[10];
    const float* keys = in[11]; const float* pu = in[12]; const float* pv = in[13];
    LAS float* scr = (LAS float*)(F.lds + RING_OFF + F.wave * 16384);
    const int gw = F.vcu * NWAVES + F.wave, NGW = F.G * NWAVES;
    const int gt = gw * 64 + F.lane, NT = NGW * 64;
    for (int i = gt; i < 8192; i += NT) ((GAS unsigned long long*)(ws + WS_SS))[i] = 0ull;
    for (int i = gt; i < 32 * 1024; i += NT) ((GAS float*)(ws + WS_KSUM))[i] = 0.f;
    constexpr int I_IN = 32 * 320, I_BC = 16 * 64, I_OUT = 32 * 64;
    constexpr int NITEMS = I_IN + 2 * I_BC + 2 * I_OUT;
    for (int it = gw; it < NITEMS; it += NGW) {
        int r = it;
        if (r < I_IN) { p0_transpose_item(w_in, 2048, INW, (bf16*)(ws + WS_WIN), g1, scr, r, F.lane); continue; } r -= I_IN;
        if (r < I_BC) { p0_transpose_item(w_bc, 1024, 2048, (bf16*)(ws + WS_WBC), nullptr, scr, r, F.lane); continue; } r -= I_BC;
        if (r < I_BC) { p0_transpose_item(w_ba, 1024, 2048, (bf16*)(ws + WS_WBA), nullptr, scr, r, F.lane); continue; } r -= I_BC;
        if (r < I_OUT) { p0_transpose_item(w_out, 2048, 2048, (bf16*)(ws + WS_WOUT), nullptr, scr, r, F.lane); continue; } r -= I_OUT;
        p0_transpose_item(w_pq, 2048, 2048, (bf16*)(ws + WS_WPQ), g2, scr, r, F.lane);
    }
    for (int i = gt; i < 16 * 128 * 128 / 8; i += NT) { const f32x4 a = ((const GAS f32x4*)keys)[2 * i], b = ((const GAS f32x4*)keys)[2 * i + 1];
        v4u o; o.x = pk2(a[0], a[1]); o.y = pk2(a[2], a[3]); o.z = pk2(b[0], b[1]); o.w = pk2(b[2], b[3]); ((GAS v4u*)(ws + WS_KEYS))[i] = o; }
    for (int m = gw; m < M; m += NGW) { const GAS f32x4* xr = (const GAS f32x4*)(x + (size_t)m * DM);
        f32x4 v[8]; float s = 0.f;
#pragma unroll
        for (int i = 0; i < 4; ++i) { v[2 * i] = xr[i * 128 + 2 * F.lane]; v[2 * i + 1] = xr[i * 128 + 2 * F.lane + 1]; }
#pragma unroll
        for (int i = 0; i < 8; ++i) s += (v[i][0] * v[i][0] + v[i][1] * v[i][1]) + (v[i][2] * v[i][2] + v[i][3] * v[i][3]);
        const float rinv = 1.0f / sqrtf(wave_sum(s) * (1.0f / DM) + RMS_EPS);
        GAS v4u* o = (GAS v4u*)(ws + WS_XB + (size_t)m * DM * 2);
#pragma unroll
        for (int i = 0; i < 4; ++i) { const f32x4 a = v[2 * i] * rinv, b = v[2 * i + 1] * rinv; v4u w; w.x = pk2(a[0], a[1]); w.y = pk2(a[2], a[3]); w.z = pk2(b[0], b[1]); w.w = pk2(b[2], b[3]); o[i * 64 + F.lane] = w; } }
    for (int i = gt; i < M * 16; i += NT) { const int row = i >> 4, f = i & 15; const double ang = (double)pos[row] * invf[f];
        const double k = __builtin_rint(ang * 0.15915494309189535); const float r = (float)(ang - k * 6.283185307179586);
        float* cs = (float*)(ws + WS_CS); cs[row * 32 + f] = __cosf(r); cs[row * 32 + 16 + f] = __sinf(r); }
}

__device__ __forceinline__ void attn_simple(const Ctx& F, const bf16* Q, const bf16* K, const bf16* V, const float* ksum, bf16* AO) {
    LAS float* qf = (LAS float*)(F.lds + RING_OFF + F.wave * 512);
    const int gw = F.vcu * NWAVES + F.wave, NGW = F.G * NWAVES, lane = F.lane;
    for (int item = gw; item < 16 * SEQ; item += NGW) {
        const int bh = item >> 12, t = item & 4095, b = bh >> 3, h = bh & 7, blk = t >> 8;
        const size_t row = (size_t)b * SEQ + t;
        { const unsigned qq = *(const GAS unsigned*)(Q + row * 1024 + h * 128 + 2 * lane); qf[2 * lane] = bflo(qq); qf[2 * lane + 1] = bfhi(qq); }
        LDS_WAIT(); asm volatile("" ::: "memory");
        float g = -INFINITY;
        if (lane < blk) { const GAS f32x4* km = (const GAS f32x4*)(ksum + (size_t)(b * 16 + lane) * 1024 + h * 128); float a = 0.f;
            for (int d = 0; d < 32; ++d) { const f32x4 kv = km[d]; const f32x4 qv = *(const LAS f32x4*)(qf + 4 * d); a += (kv[0] * qv[0] + kv[1] * qv[1]) + (kv[2] * qv[2] + kv[3] * qv[3]); }
            g = a; }
        int sel[3];
#pragma unroll
        for (int i = 0; i < 3; ++i) { const float mx = wave_max(g); const unsigned long long bal = __ballot(g == mx && lane < blk); const int idx = bal ? (__ffsll((long long)bal) - 1) : 0; sel[i] = idx; if (lane == idx) g = -INFINITY; }
        const int nsel = blk < 3 ? blk : 3;
        float sc[4][4]; float mx = -INFINITY;
#pragma unroll
        for (int slot = 0; slot < 4; ++slot) {
            const bool valid = (slot == 3) || (slot < nsel);
            const int kb = (slot == 3) ? blk : sel[slot < 3 ? slot : 0];
#pragma unroll
            for (int r = 0; r < 4; ++r) {
                float s = -INFINITY; const int key0 = kb * 256 + r * 64;
                if (valid && (slot < 3 || key0 <= t)) {
                    const int key = key0 + lane; const GAS v4u* kp = (const GAS v4u*)(K + ((size_t)b * SEQ + key) * 1024 + h * 128); float a = 0.f;
#pragma unroll 4
                    for (int d = 0; d < 16; ++d) { const v4u kk = kp[d]; const f32x4 q0 = *(const LAS f32x4*)(qf + 8 * d), q1 = *(const LAS f32x4*)(qf + 8 * d + 4);
                        a += (bflo(kk.x) * q0[0] + bfhi(kk.x) * q0[1]) + (bflo(kk.y) * q0[2] + bfhi(kk.y) * q0[3]) + (bflo(kk.z) * q1[0] + bfhi(kk.z) * q1[1]) + (bflo(kk.w) * q1[2] + bfhi(kk.w) * q1[3]); }
                    s = (slot < 3 || key <= t) ? a : -INFINITY; }
                sc[slot][r] = s; mx = fmaxf(mx, s); } }
        mx = wave_max(mx);
        float sum = 0.f;
#pragma unroll
        for (int slot = 0; slot < 4; ++slot)
#pragma unroll
            for (int r = 0; r < 4; ++r) { sc[slot][r] = exp2f(sc[slot][r] - mx); sum += sc[slot][r]; }
        sum = wave_sum(sum);
        float o0 = 0.f, o1 = 0.f;
#pragma unroll
        for (int slot = 0; slot < 4; ++slot) {
            const bool valid = (slot == 3) || (slot < nsel);
            const int kb = (slot == 3) ? blk : sel[slot < 3 ? slot : 0];
#pragma unroll
            for (int r = 0; r < 4; ++r) { const int key0 = kb * 256 + r * 64;
                if (valid && (slot < 3 || key0 <= t)) { const float pr = sc[slot][r]; const GAS unsigned* vp = (const GAS unsigned*)(V + ((size_t)b * SEQ + key0) * 1024 + h * 128) + lane;
                    for (int kk = 0; kk < 64; ++kk) { const float pk = rdlane(pr, kk); const unsigned vv = vp[(size_t)kk * 512]; o0 += pk * bflo(vv); o1 += pk * bfhi(vv); } } } }
        const float ri = 1.0f / sum;
        *(GAS unsigned*)(AO + row * 1024 + h * 128 + 2 * lane) = pk2(o0 * ri, o1 * ri);
    }
}
typedef short v4i16_t __attribute__((ext_vector_type(4))); typedef unsigned u32x2v __attribute__((ext_vector_type(2)));
__device__ __forceinline__ v4i16_t vtr16(unsigned addr) { return __builtin_amdgcn_ds_read_tr16_b64_v4i16((LAS v4i16_t*)(uintptr_t)addr); }
__device__ __forceinline__ int crow16(int r, int hh) { return (r & 3) + 8 * (r >> 2) + 4 * hh; }
__device__ __forceinline__ void attn_dma_step(const bf16* K, const bf16* V, LAS unsigned char* lds, int b, int h, int qb, int n_own, int st, int buf, int wave, int lane) {
#pragma unroll
    for (int img = 0; img < 4; ++img) {
        const int T = 2 * st + (img >> 1); const bool isV = img & 1;
        const int blk = (T < n_own) ? qb : ((T - n_own) >> 2), kt = (T < n_own) ? T : ((T - n_own) & 3);
        const bf16* base = (isV ? V : K) + ((size_t)b * SEQ + 256 * blk + 64 * kt) * 1024 + h * 128;
#pragma unroll
        for (int i = 0; i < 2; ++i) { const int pc = wave + 8 * i, row = 4 * pc + (lane >> 4), cp = lane & 15;
            const int c = isV ? ((((cp >> 2) ^ (row & 3)) << 2) | (cp & 3)) : (cp ^ (row & 15));
            __builtin_amdgcn_global_load_lds((const unsigned*)(base + (size_t)row * 1024 + 8 * c), (LAS unsigned*)(lds + buf * 65536 + img * 16384 + pc * 1024), 16, 0, 0); }
    }
}
__device__ __forceinline__ void attn_mfma(const Ctx& F, const bf16* Q, const bf16* K, const bf16* V, const float* ksum, bf16* AO) {
    const int lane = F.lane, wave = F.wave, q31 = lane & 31, hh = lane >> 5, wq = wave & 3, kvh = wave >> 2, l16 = lane & 15, G4 = lane >> 4;
    LAS unsigned char* lds = F.lds + RING_OFF;
    const unsigned lds0 = (unsigned)(uintptr_t)lds;
    for (int pr = F.vcu; pr < 256; pr += F.G)
#pragma unroll 1
    for (int pi = 0; pi < 2; ++pi) {
        const int bh = pr >> 4, s_ = pr & 15, u128 = pi ? 31 - s_ : s_, b = bh >> 3, h = bh & 7, qb = u128 >> 1, half = u128 & 1;
        const int n_own = half ? 4 : 2, nstep = (n_own + 4 * qb) >> 1;
        const size_t rowq = (size_t)b * SEQ + 256 * qb + 128 * half + 32 * wq + q31;
        asm volatile("s_waitcnt vmcnt(0) lgkmcnt(0)" ::: "memory"); __builtin_amdgcn_s_barrier(); asm volatile("" ::: "memory");
        attn_dma_step(K, V, lds, b, h, qb, n_own, 0, 0, wave, lane);
        bf16x8 qf[8];
#pragma unroll
        for (int s = 0; s < 8; ++s) qf[s] = *(const GAS bf16x8*)(Q + rowq * 1024 + h * 128 + 16 * s + 8 * hh);
        unsigned selmask;
        {
            f32x16 gt;
#pragma unroll
            for (int r = 0; r < 16; ++r) gt[r] = 0.f;
            const int jr = lane & 31; const bool jv = jr < qb;
            const GAS f32x4* kp = (const GAS f32x4*)(ksum + (size_t)(b * 16 + (jv ? jr : 0)) * 1024 + h * 128 + 8 * hh);
            f32x4 kf[16];
#pragma unroll
            for (int s = 0; s < 8; ++s) { kf[2 * s] = kp[4 * s]; kf[2 * s + 1] = kp[4 * s + 1]; }
#pragma unroll
            for (int s = 0; s < 8; ++s) { v4u w = pg8::pack8(kf[2 * s], kf[2 * s + 1]); if (!jv) { w.x = 0u; w.y = 0u; w.z = 0u; w.w = 0u; }
                gt = __builtin_amdgcn_mfma_f32_32x32x16_bf16(__builtin_bit_cast(bf16x8, w), qf[s], gt, 0, 0, 0); }
            float g16[16];
#pragma unroll
            for (int r = 0; r < 8; ++r) { const auto rr = __builtin_amdgcn_permlane32_swap(__float_as_uint(gt[r]), __float_as_uint(gt[r]), false, false);
                g16[(r & 3) + 8 * (r >> 2)] = __uint_as_float(rr[0]); g16[(r & 3) + 8 * (r >> 2) + 4] = __uint_as_float(rr[1]); }
            float v0 = -INFINITY, v1 = -INFINITY, v2 = -INFINITY; int i0 = 0, i1 = 0, i2 = 0;
#pragma unroll
            for (int j = 0; j < 16; ++j) { const float a = (j < qb) ? g16[j] : -INFINITY;
                if (a > v0) { v2 = v1; i2 = i1; v1 = v0; i1 = i0; v0 = a; i0 = j; } else if (a > v1) { v2 = v1; i2 = i1; v1 = a; i1 = j; } else if (a > v2) { v2 = a; i2 = j; } }
            selmask = (qb <= 3) ? ((1u << qb) - 1u) : ((1u << i0) | (1u << i1) | (1u << i2));
        }
        float m_run = -1e30f, l_run = 0.f; f32x16 o[4];
#pragma unroll
        for (int db = 0; db < 4; ++db)
#pragma unroll
            for (int r = 0; r < 16; ++r) o[db][r] = 0.f;
        const int qin = 128 * half + 32 * wq + q31;
#pragma unroll 1
        for (int st2 = 0; st2 < nstep; st2 += 2)
#pragma unroll
        for (int par = 0; par < 2; ++par) { const int st = st2 + par; if (st < nstep) {
            asm volatile("s_waitcnt vmcnt(0)" ::: "memory"); __builtin_amdgcn_s_barrier(); asm volatile("" ::: "memory");
            if (st + 1 < nstep) attn_dma_step(K, V, lds, b, h, qb, n_own, st + 1, par ^ 1, wave, lane);
            const int T = 2 * st + kvh; const bool own = T < n_own;
            const int blk = own ? qb : ((T - n_own) >> 2), kt = own ? T : ((T - n_own) & 3);
            const bool sel = own ? true : ((selmask >> blk) & 1u);
            const bool skip = own ? (64 * kt > 128 * half + 32 * wq + 31) : (__ballot(sel) == 0ull);
            if (!skip) {
                const unsigned kimg = lds0 + par * 65536 + kvh * 32768, vimg = kimg + 16384;
                f32x16 p[2];
#pragma unroll
                for (int kh = 0; kh < 2; ++kh) {
#pragma unroll
                    for (int r = 0; r < 16; ++r) p[kh][r] = 0.f;
                    const int row = 32 * kh + q31;
#pragma unroll
                    for (int s = 0; s < 8; ++s) { const bf16x8 a = *(const LAS bf16x8*)(uintptr_t)(kimg + row * 256 + (((2 * s + hh) ^ (row & 15)) << 4));
                        p[kh] = __builtin_amdgcn_mfma_f32_32x32x16_bf16(a, qf[s], p[kh], 0, 0, 0); }
                }
                if (own) { const int kbase = 64 * kt;
                    if (kbase + 63 > 128 * half + 32 * wq) {
#pragma unroll
                        for (int kh = 0; kh < 2; ++kh)
#pragma unroll
                            for (int r = 0; r < 16; ++r) if (kbase + 32 * kh + crow16(r, hh) > qin) p[kh][r] = -INFINITY; }
                }
                float mx = p[0][0];
#pragma unroll
                for (int r = 1; r < 16; ++r) mx = fmaxf(mx, p[0][r]);
#pragma unroll
                for (int r = 0; r < 16; ++r) mx = fmaxf(mx, p[1][r]);
                { const auto rr = __builtin_amdgcn_permlane32_swap(__float_as_uint(mx), __float_as_uint(mx), false, false); mx = fmaxf(__uint_as_float(rr[0]), __uint_as_float(rr[1])); }
                if (!sel) mx = -INFINITY;
                const float m_new = fmaxf(m_run, mx), scl = __builtin_amdgcn_exp2f(m_run - m_new); m_run = m_new;
                float rs = 0.f;
#pragma unroll
                for (int kh = 0; kh < 2; ++kh)
#pragma unroll
                    for (int r = 0; r < 16; ++r) { p[kh][r] = __builtin_amdgcn_exp2f(p[kh][r] - m_new); rs += p[kh][r]; }
                l_run = l_run * scl + (sel ? rs : 0.f);
                if (__ballot(scl != 1.0f) != 0ull) {
#pragma unroll
                    for (int db = 0; db < 4; ++db)
#pragma unroll
                        for (int r = 0; r < 16; ++r) o[db][r] *= scl; }
                const unsigned pmask = sel ? 0xffffffffu : 0u;
                bf16x8 pb[4];
#pragma unroll
                for (int gi = 0; gi < 4; ++gi) { const int kh = gi >> 1, s2 = gi & 1; v4u pw;
                    pw.x = pg8::cvt_pk_bf16(p[kh][8 * s2], p[kh][8 * s2 + 1]) & pmask; pw.y = pg8::cvt_pk_bf16(p[kh][8 * s2 + 2], p[kh][8 * s2 + 3]) & pmask;
                    pw.z = pg8::cvt_pk_bf16(p[kh][8 * s2 + 4], p[kh][8 * s2 + 5]) & pmask; pw.w = pg8::cvt_pk_bf16(p[kh][8 * s2 + 6], p[kh][8 * s2 + 7]) & pmask;
                    pb[gi] = __builtin_bit_cast(bf16x8, pw); }
                v4i16_t lo[2][2], hi_[2][2];
                const int dsub = 16 * (G4 & 1) + 4 * (l16 & 3);
#define ATTN_VREADS(u, S) { const int key0_ = 32 * ((u) >> 2) + 16 * (((u) >> 1) & 1) + 4 * (G4 >> 1) + (l16 >> 2); _Pragma("unroll") for (int d2 = 0; d2 < 2; ++d2) { const int db = 2 * ((u) & 1) + d2; \
                    const unsigned a0_ = vimg + key0_ * 256 + ((db ^ (key0_ & 3)) << 6) + dsub * 2; \
                    asm volatile("ds_read_b64_tr_b16 %0, %1" : "=&v"(lo[S][d2]) : "v"(a0_) : "memory"); \
                    asm volatile("ds_read_b64_tr_b16 %0, %1 offset:2048" : "=&v"(hi_[S][d2]) : "v"(a0_) : "memory"); } }
#define ATTN_VWAIT(S, N) asm volatile("s_waitcnt lgkmcnt(" #N ")" : "+v"(lo[S][0]), "+v"(lo[S][1]), "+v"(hi_[S][0]), "+v"(hi_[S][1]) :: "memory")
#define ATTN_PV(u, S) { _Pragma("unroll") for (int d2 = 0; d2 < 2; ++d2) { const int db = 2 * ((u) & 1) + d2; const bf16x8 av = {lo[S][d2][0], lo[S][d2][1], lo[S][d2][2], lo[S][d2][3], hi_[S][d2][0], hi_[S][d2][1], hi_[S][d2][2], hi_[S][d2][3]}; \
                    o[db] = __builtin_amdgcn_mfma_f32_32x32x16_bf16(av, pb[(u) >> 1], o[db], 0, 0, 0); } }
                ATTN_VREADS(0, 0)
                ATTN_VREADS(1, 1) ATTN_VWAIT(0, 4); ATTN_PV(0, 0)
                ATTN_VREADS(2, 0) ATTN_VWAIT(1, 4); ATTN_PV(1, 1)
                ATTN_VREADS(3, 1) ATTN_VWAIT(0, 4); ATTN_PV(2, 0)
                ATTN_VREADS(4, 0) ATTN_VWAIT(1, 4); ATTN_PV(3, 1)
                ATTN_VREADS(5, 1) ATTN_VWAIT(0, 4); ATTN_PV(4, 0)
                ATTN_VREADS(6, 0) ATTN_VWAIT(1, 4); ATTN_PV(5, 1)
                ATTN_VREADS(7, 1) ATTN_VWAIT(0, 4); ATTN_PV(6, 0)
                ATTN_VWAIT(1, 0); ATTN_PV(7, 1)
#undef ATTN_VREADS
#undef ATTN_VWAIT
#undef ATTN_PV
            }
        } }
        l_run += __shfl_xor(l_run, 32);
        asm volatile("s_waitcnt vmcnt(0) lgkmcnt(0)" ::: "memory"); __builtin_amdgcn_s_barrier(); asm volatile("" ::: "memory");
        LAS float* xs = (LAS float*)lds + (size_t)wq * 66 * 64 + lane;
        if (kvh == 1) {
            xs[0] = m_run; xs[64] = l_run;
#pragma unroll
            for (int db = 0; db < 4; ++db)
#pragma unroll
                for (int r = 0; r < 16; ++r) xs[(2 + 16 * db + r) * 64] = o[db][r];
        }
        asm volatile("s_waitcnt lgkmcnt(0)" ::: "memory"); __builtin_amdgcn_s_barrier(); asm volatile("" ::: "memory");
        if (kvh == 0) {
            const float m2 = xs[0], l2 = xs[64], mt = fmaxf(m_run, m2), a1 = __builtin_amdgcn_exp2f(m_run - mt), a2 = __builtin_amdgcn_exp2f(m2 - mt);
            const float inv = 1.0f / (l_run * a1 + l2 * a2), c1 = a1 * inv, c2 = a2 * inv;
            bf16* orow = AO + rowq * 1024 + h * 128 + 4 * hh;
#pragma unroll
            for (int db = 0; db < 4; ++db)
#pragma unroll
                for (int g = 0; g < 4; ++g) {
                    float t[4];
#pragma unroll
                    for (int e = 0; e < 4; ++e) t[e] = o[db][4 * g + e] * c1 + xs[(2 + 16 * db + 4 * g + e) * 64] * c2;
                    u32x2v w; w.x = pg8::cvt_pk_bf16(t[0], t[1]); w.y = pg8::cvt_pk_bf16(t[2], t[3]);
                    *(GAS u32x2v*)(orow + 32 * db + 8 * g) = w;
                }
        }
    }
    asm volatile("s_waitcnt vmcnt(0) lgkmcnt(0)" ::: "memory"); __builtin_amdgcn_s_barrier(); asm volatile("" ::: "memory");
}
__device__ __forceinline__ void up8(const v4u w, float (&f)[8]) { f[0] = bflo(w.x); f[1] = bfhi(w.x); f[2] = bflo(w.y); f[3] = bfhi(w.y); f[4] = bflo(w.z); f[5] = bfhi(w.z); f[6] = bflo(w.w); f[7] = bfhi(w.w); }
__device__ __forceinline__ void conv_phase(const Ctx& F, const bf16* CB, const bf16* CC, const bf16* CX, const float* cw, bf16* UC) {
    const int gt = (F.vcu * NWAVES + F.wave) * 64 + F.lane, NT = F.G * NWAVES * 64;
    for (int idx = gt; idx < M * 128; idx += NT) {
        const int row = idx >> 7, c8 = (idx & 127) << 3, t = row & (SEQ - 1); const size_t off = (size_t)row * 1024 + c8;
        float cb[8], a[8], x[8], z0[8], z1[8], z2[8];
        up8(*(const GAS v4u*)(CB + off), cb); up8(*(const GAS v4u*)(CC + off), a); up8(*(const GAS v4u*)(CX + off), x);
#pragma unroll
        for (int j = 0; j < 8; ++j) z0[j] = a[j] * x[j];
        if (t >= 1) { up8(*(const GAS v4u*)(CC + off - 1024), a); up8(*(const GAS v4u*)(CX + off - 1024), x);
#pragma unroll
            for (int j = 0; j < 8; ++j) z1[j] = a[j] * x[j]; } else {
#pragma unroll
            for (int j = 0; j < 8; ++j) z1[j] = 0.f; }
        if (t >= 2) { up8(*(const GAS v4u*)(CC + off - 2048), a); up8(*(const GAS v4u*)(CX + off - 2048), x);
#pragma unroll
            for (int j = 0; j < 8; ++j) z2[j] = a[j] * x[j]; } else {
#pragma unroll
            for (int j = 0; j < 8; ++j) z2[j] = 0.f; }
        float o[8];
#pragma unroll
        for (int j = 0; j < 8; ++j) o[j] = cb[j] * (cw[c8 + j] * z2[j] + cw[1024 + c8 + j] * z1[j] + cw[2048 + c8 + j] * z0[j]);
        v4u w; w.x = pk2(o[0], o[1]); w.y = pk2(o[2], o[3]); w.z = pk2(o[4], o[5]); w.w = pk2(o[6], o[7]); *(GAS v4u*)(UC + off) = w;
    }
}

__device__ __forceinline__ int imax(int a, int b) { return a > b ? a : b; }
__device__ __forceinline__ int imin(int a, int b) { return a < b ? a : b; }
__device__ __forceinline__ void ce(int& a, int& b) { const int t = imax(a, b); b = imin(a, b); a = t; }
__device__ __forceinline__ void sort16(int (&x)[16]) {
#pragma unroll
    for (int kk = 1; kk <= 4; ++kk)
#pragma unroll
        for (int jj = kk - 1; jj >= 0; --jj)
#pragma unroll
            for (int i = 0; i < 16; ++i) { const int k = 1 << kk, j = 1 << jj, l = i ^ j; if (l > i) { if ((i & k) == 0) ce(x[i], x[l]); else ce(x[l], x[i]); } }
}
__device__ __forceinline__ void bmerge16(int (&a)[16]) {
#pragma unroll
    for (int jj = 3; jj >= 0; --jj)
#pragma unroll
        for (int i = 0; i < 16; ++i) { const int j = 1 << jj, l = i ^ j; if (l > i) ce(a[i], a[l]); }
}
__device__ __forceinline__ void merge16(int (&a)[16], const int (&b)[16]) {
#pragma unroll
    for (int i = 0; i < 16; ++i) a[i] = imax(a[i], b[15 - i]);
    bmerge16(a);
}
__device__ __forceinline__ void xmerge16(int (&a)[16], int hh) {
    int pv[16];
#pragma unroll
    for (int i = 0; i < 16; ++i) { const auto r = __builtin_amdgcn_permlane32_swap((unsigned)a[15 - i], (unsigned)a[15 - i], false, false); pv[i] = hh ? (int)r[0] : (int)r[1]; }
#pragma unroll
    for (int i = 0; i < 16; ++i) a[i] = imax(a[i], pv[i]);
    bmerge16(a);
}
__device__ __forceinline__ int ord_key(float f) { const int u = __float_as_int(f); return u >= 0 ? u : (u ^ 0x7fffffff); }
__device__ __forceinline__ float ord_val(int k) { return __int_as_float(k >= 0 ? k : (k ^ 0x7fffffff)); }
__device__ __forceinline__ unsigned byte16(const unsigned (&t)[4], int idx) {
    const unsigned sel = 0x0c0c0c00u | (unsigned)(idx & 7);
    const unsigned lo = __builtin_amdgcn_perm(t[1], t[0], sel), hi_ = __builtin_amdgcn_perm(t[3], t[2], sel);
    return (idx & 8) ? hi_ : lo;
}
__device__ __forceinline__ void topk_stage_keys(const Ctx& F, const bf16* KEYS, int h) {
    for (int pc = F.wave; pc < 64; pc += 8) { const int pp = pc >> 5, row = 4 * (pc & 31) + (F.lane >> 4), cp = F.lane & 15, c = cp ^ (row & 15);
        __builtin_amdgcn_global_load_lds((const unsigned*)(KEYS + (size_t)((h * 2 + pp) * 128 + row) * 128 + 8 * c), (LAS unsigned*)(F.lds + RING_OFF + pc * 1024), 16, 0, 0); }
    asm volatile("s_waitcnt vmcnt(0)" ::: "memory"); __builtin_amdgcn_s_barrier(); asm volatile("" ::: "memory");
}
__device__ __forceinline__ void topk_phase(const Ctx& F, int bitem, const bf16* QP, int* EXP, float* GATE) {
    const int lane = F.lane, l31 = lane & 31, hh = lane >> 5;
    const int IMIN = (int)0x80000000;
    const unsigned lds0 = (unsigned)(uintptr_t)(F.lds + RING_OFF);
    {
        const int h = bitem & 7, tt = (bitem >> 3) * 8 + F.wave, tok0 = tt * 32;
        int top[2][16];
#pragma unroll
        for (int p = 0; p < 2; ++p) {
            bf16x8 qa[8];
#pragma unroll
            for (int s = 0; s < 8; ++s) qa[s] = *(const GAS bf16x8*)(QP + (size_t)(tok0 + l31) * 2048 + h * 256 + p * 128 + 16 * s + 8 * hh);
            int x[2][16];
#pragma unroll
            for (int pq = 0; pq < 2; ++pq) {
                f32x16 sc[2];
#pragma unroll
                for (int nt = 0; nt < 2; ++nt)
#pragma unroll
                    for (int r = 0; r < 16; ++r) sc[nt][r] = 0.f;
#pragma unroll
                for (int s = 0; s < 8; ++s) {
#pragma unroll
                    for (int nt = 0; nt < 2; ++nt) { const int n = 64 * pq + 32 * nt + l31; const bf16x8 kb = *(const LAS bf16x8*)(uintptr_t)(lds0 + p * 32768 + n * 256 + (((2 * s + hh) ^ (n & 15)) << 4));
                        sc[nt] = __builtin_amdgcn_mfma_f32_32x32x16_bf16(kb, qa[s], sc[nt], 0, 0, 0); }
                }
                int y[16];
#pragma unroll
                for (int r = 0; r < 16; ++r) { x[pq][r] = (ord_key(sc[0][r]) & ~127) | ((127 - 64 * pq - (r & 3) - 8 * (r >> 2)) - 4 * hh); y[r] = (ord_key(sc[1][r]) & ~127) | ((127 - 64 * pq - 32 - (r & 3) - 8 * (r >> 2)) - 4 * hh); }
                sort16(x[pq]); sort16(y); merge16(x[pq], y);
                asm volatile("" ::: "memory");
            }
            merge16(x[0], x[1]);
            xmerge16(x[0], hh);
#pragma unroll
            for (int i = 0; i < 16; ++i) top[p][i] = x[0][i];
        }
        float fa[16], fb[16];
#pragma unroll
        for (int i = 0; i < 16; ++i) { const int A = hh ? top[1][i] : top[0][i], B = hh ? top[0][i] : top[1][i]; fa[i] = ord_val(A & ~127); fb[i] = ord_val(B & ~127); }
        int c0[16], c1[16];
#pragma unroll
        for (int q = 0; q < 32; ++q) {
            int key = IMIN;
            if (q < 27) { const int i = (q < 16) ? 0 : (q < 23) ? 1 : (q < 26) ? 2 : 3, j = (q < 16) ? q : (q < 23) ? q - 15 : (q < 26) ? q - 21 : 3; const float sv = fa[i] + fb[j]; const int low = hh ? (255 - (j * 16 + i)) : (255 - (i * 16 + j));
                key = (ord_key(sv) & ~255) | low; if (i == j && hh) key = IMIN; }
            if (q < 16) c0[q] = key; else c1[q - 16] = key;
        }
        sort16(c0); sort16(c1); merge16(c0, c1); xmerge16(c0, hh);
        unsigned na[4], nb[4];
#pragma unroll
        for (int d = 0; d < 4; ++d) { na[d] = 0u; nb[d] = 0u;
#pragma unroll
            for (int e = 0; e < 4; ++e) { na[d] |= (unsigned)(127 - (top[0][4 * d + e] & 127)) << (8 * e); nb[d] |= (unsigned)(127 - (top[1][4 * d + e] & 127)) << (8 * e); } }
        int ex[16]; float ev[16]; float es = 0.f; const float smax = ord_val(c0[0] & ~255);
#pragma unroll
        for (int q = 0; q < 16; ++q) { const int posn = 255 - (c0[q] & 255); const unsigned n1 = byte16(na, posn >> 4) & 255u, n2 = byte16(nb, posn & 15) & 255u;
            ex[q] = (int)(n1 * 128u + n2); ev[q] = __expf(ord_val(c0[q] & ~255) - smax); es += ev[q]; }
        const float ri = 1.0f / es; const size_t ob = (size_t)(tok0 + l31) * 128 + h * 16;
        if (hh == 0) {
#pragma unroll
            for (int d = 0; d < 4; ++d) { v4u w; w.x = (unsigned)ex[4 * d]; w.y = (unsigned)ex[4 * d + 1]; w.z = (unsigned)ex[4 * d + 2]; w.w = (unsigned)ex[4 * d + 3]; *(GAS v4u*)(EXP + ob + 4 * d) = w; }
        } else {
#pragma unroll
            for (int d = 0; d < 4; ++d) *(GAS f32x4*)(GATE + ob + 4 * d) = (f32x4){ev[4 * d] * ri, ev[4 * d + 1] * ri, ev[4 * d + 2] * ri, ev[4 * d + 3] * ri};
        }
    }
}

typedef float f32x2 __attribute__((ext_vector_type(2)));
constexpr float PEER_SU = 512.0f, PEER_SV = 32.0f;
template <int CTRL> __device__ __forceinline__ int dpp_i(int v) { return __builtin_amdgcn_update_dpp(v, v, CTRL, 0xf, 0xf, false); }
template <int J> __device__ __forceinline__ int xor_lane(int v, int lane) {
    if constexpr (J == 1) return dpp_i<0xB1>(v);
    else if constexpr (J == 2) return dpp_i<0x4E>(v);
    else if constexpr (J == 16) { const auto r = __builtin_amdgcn_permlane16_swap((unsigned)v, (unsigned)v, false, false); return ((lane >> 4) & 1) ? (int)r[0] : (int)r[1]; }
    else if constexpr (J == 32) { const auto r = __builtin_amdgcn_permlane32_swap((unsigned)v, (unsigned)v, false, false); return (lane >> 5) ? (int)r[0] : (int)r[1]; }
    else return __shfl_xor(v, J);
}
__device__ __forceinline__ float wave_sum_dpp(float v) {
    v += __int_as_float(dpp_i<0xB1>(__float_as_int(v))); v += __int_as_float(dpp_i<0x4E>(__float_as_int(v))); v += __int_as_float(dpp_i<0x141>(__float_as_int(v))); v += __int_as_float(dpp_i<0x140>(__float_as_int(v)));
    { const auto r = __builtin_amdgcn_permlane16_swap(__float_as_uint(v), __float_as_uint(v), false, false); v = __uint_as_float(r[0]) + __uint_as_float(r[1]); }
    { const auto r = __builtin_amdgcn_permlane32_swap(__float_as_uint(v), __float_as_uint(v), false, false); v = __uint_as_float(r[0]) + __uint_as_float(r[1]); }
    return v; }
template <int KK, int JJ> __device__ __forceinline__ void sort512_step(int (&x)[8], int lane) {
    constexpr int k = 1 << KK, j = 1 << JJ;
    if constexpr (j >= 64) { constexpr int jr = j >> 6;
#pragma unroll
        for (int r = 0; r < 8; ++r) if ((r & jr) == 0) { const bool asc = (k >= 512) ? true : (((r << 6) & k) == 0); const int lo = imin(x[r], x[r | jr]), hi_ = imax(x[r], x[r | jr]); x[r] = asc ? lo : hi_; x[r | jr] = asc ? hi_ : lo; }
    } else {
        const bool lower = (lane & j) == 0;
#pragma unroll
        for (int r = 0; r < 8; ++r) { const int y = xor_lane<j>(x[r], lane);
            const bool asc = (k < 64) ? ((lane & k) == 0) : ((k >= 512) ? true : (((r << 6) & k) == 0));
            x[r] = (lower == asc) ? imin(x[r], y) : imax(x[r], y); }
    }
}
template <int KK, int JJ> __device__ __forceinline__ void sort512_stage(int (&x)[8], int lane) { sort512_step<KK, JJ>(x, lane); if constexpr (JJ > 0) sort512_stage<KK, JJ - 1>(x, lane); }
__device__ __forceinline__ void sort512(int (&x)[8], int lane) {
    sort512_stage<1, 0>(x, lane); sort512_stage<2, 1>(x, lane); sort512_stage<3, 2>(x, lane); sort512_stage<4, 3>(x, lane); sort512_stage<5, 4>(x, lane);
    sort512_stage<6, 5>(x, lane); sort512_stage<7, 6>(x, lane); sort512_stage<8, 7>(x, lane); sort512_stage<9, 8>(x, lane);
}
__device__ __forceinline__ void peer_phase(const Ctx& F, const unsigned char* U8, const unsigned char* V8, const bf16* X1B, const int* EXP, const float* GATE, const unsigned long long* SS, const float* gfin, const float* X1, float* OUT) {
    const int gw = F.vcu * NWAVES + F.wave, NGW = F.G * NWAVES, lane = F.lane;
    const unsigned xs0 = (unsigned)(uintptr_t)(F.lds + RING_OFF + F.wave * 16384) + lane * 16;
    for (int tb = gw; tb + 3 * NGW < M; tb += 4 * NGW) {
        int kreg[8]; float greg[8], rv[4];
#pragma unroll
        for (int j = 0; j < 4; ++j) { const size_t t = (size_t)tb + (size_t)j * NGW;
            kreg[2 * j] = (EXP[t * 128 + lane] << 9) | (j << 7) | lane; kreg[2 * j + 1] = (EXP[t * 128 + 64 + lane] << 9) | (j << 7) | (64 + lane);
            rv[j] = pg8::rinv_from_ss(SS[t]) * (1.0f / PEER_SU);
#pragma unroll
            for (int q = 0; q < 4; ++q) { const v4u w = *(const GAS v4u*)(X1B + t * DM + (q >> 1) * 1024 + lane * 16 + 8 * (q & 1)); *(LAS v4u*)(uintptr_t)(xs0 + j * 4096 + q * 1024) = w; } }
        sort512(kreg, lane);
        int pkey[8];
#pragma unroll
        for (int c = 0; c < 8; ++c) { pkey[c] = __shfl(kreg[c], 8 * (lane & 7) + (lane >> 3)); greg[c] = GATE[((size_t)tb + (size_t)((pkey[c] >> 7) & 3) * NGW) * 128 + (pkey[c] & 127)]; }
        asm volatile("s_waitcnt lgkmcnt(0)" ::: "memory");
        float actreg[8];
#ifndef MK_P8_REPU
#define MK_P8_REPU 1
#endif
#pragma unroll 1
        for (int repu = 0; repu < MK_P8_REPU; ++repu) {
            v4u ub[8][2];
#pragma unroll
            for (int u = 0; u < 8; ++u) { const GAS v4u* up = (const GAS v4u*)(U8 + (size_t)(__builtin_amdgcn_readlane(kreg[0], u) >> 9) * 2048) + lane; ub[u][0] = up[0]; ub[u][1] = up[64]; }
#pragma unroll
            for (int c = 0; c < 8; ++c) {
                float areg = 0.f;
#pragma unroll 1
                for (int g = 0; g < 8; ++g) {
                    float pt[8];
#pragma unroll
                    for (int u = 0; u < 8; ++u) {
                        const int key = __builtin_amdgcn_readlane(kreg[c], 8 * g + u);
                        const unsigned xa = xs0 + ((key >> 7) & 3) * 4096;
                        float p0 = 0.f, p1 = 0.f;
#pragma unroll
                        for (int i = 0; i < 2; ++i) { const v4u w = ub[u][i];
#pragma unroll
                            for (int hv = 0; hv < 2; ++hv) { const v4u xq = *(const LAS v4u*)(uintptr_t)(xa + (2 * i + hv) * 1024);
                                const unsigned w0 = hv ? w.z : w.x, w1 = hv ? w.w : w.y;
                                const f32x2 a0 = __builtin_amdgcn_cvt_pk_f32_fp8((int)w0, false), a1 = __builtin_amdgcn_cvt_pk_f32_fp8((int)w0, true), a2 = __builtin_amdgcn_cvt_pk_f32_fp8((int)w1, false), a3 = __builtin_amdgcn_cvt_pk_f32_fp8((int)w1, true);
                                p0 = dot2bf(pg8::cvt_pk_bf16(a0[0], a0[1]), xq.x, p0); p1 = dot2bf(pg8::cvt_pk_bf16(a1[0], a1[1]), xq.y, p1);
                                p0 = dot2bf(pg8::cvt_pk_bf16(a2[0], a2[1]), xq.z, p0); p1 = dot2bf(pg8::cvt_pk_bf16(a3[0], a3[1]), xq.w, p1); } }
                        pt[u] = p0 + p1;
                        { const int ix = 8 * g + 8 + u, ka = __builtin_amdgcn_readlane(kreg[c], ix & 63), kb = __builtin_amdgcn_readlane(kreg[c < 7 ? c + 1 : 7], ix & 63), kn = (ix < 64) ? ka : kb;
                            const GAS v4u* up = (const GAS v4u*)(U8 + (size_t)(kn >> 9) * 2048) + lane; ub[u][0] = up[0]; ub[u][1] = up[64]; }
                    }
                    { const bool b5 = (lane & 32) != 0, b4 = (lane & 16) != 0, b3 = (lane & 8) != 0;
#pragma unroll
                      for (int i = 0; i < 4; ++i) { const float a = pt[i], b = pt[i + 4]; pt[i] = (b5 ? b : a) + __int_as_float(xor_lane<32>(__float_as_int(b5 ? a : b), lane)); }
#pragma unroll
                      for (int i = 0; i < 2; ++i) { const float a = pt[i], b = pt[i + 2]; pt[i] = (b4 ? b : a) + __int_as_float(xor_lane<16>(__float_as_int(b4 ? a : b), lane)); }
                      { const float a = pt[0], b = pt[1]; pt[0] = (b3 ? b : a) + __shfl_xor(b3 ? a : b, 8); }
                      float r = pt[0]; r += __shfl_xor(r, 4); r += __int_as_float(dpp_i<0x4E>(__float_as_int(r))); r += __int_as_float(dpp_i<0xB1>(__float_as_int(r)));
                      areg = ((lane & 7) == g) ? r : areg; }
                }
                const int tk = (pkey[c] >> 7) & 3; const float rr = (tk == 0) ? rv[0] : (tk == 1) ? rv[1] : (tk == 2) ? rv[2] : rv[3];
                actreg[c] = gelu_tanh(areg * rr) * greg[c] * (1.0f / PEER_SV);
            }
        }
        LAS float* as = (LAS float*)(uintptr_t)(xs0 - lane * 16);
        asm volatile("s_waitcnt lgkmcnt(0)" ::: "memory");
#pragma unroll
        for (int c = 0; c < 8; ++c) as[64 * c + lane] = actreg[c];
        int k2[8];
#pragma unroll
        for (int c = 0; c < 8; ++c) { const int key = kreg[c], tok = (key >> 7) & 3, park = 64 * c + 8 * (lane & 7) + (lane >> 3);
            k2[c] = ((tok >> 1) << 24) | ((key >> 9) << 10) | ((tok & 1) << 9) | park; }
        sort512(k2, lane);
        asm volatile("s_waitcnt lgkmcnt(0)" ::: "memory");
        float a2[8];
#pragma unroll
        for (int c = 0; c < 8; ++c) a2[c] = as[k2[c] & 511];
#pragma unroll 1
        for (int pp = 0; pp < 2; ++pp) {
            int kq[4]; float aq[4];
#pragma unroll
            for (int c = 0; c < 4; ++c) { kq[c] = pp ? k2[4 + c] : k2[c]; aq[c] = pp ? a2[4 + c] : a2[c]; }
            f32x2 y[2][16];
#pragma unroll
            for (int j = 0; j < 2; ++j)
#pragma unroll
                for (int q = 0; q < 16; ++q) y[j][q] = (f32x2){0.f, 0.f};
            v4u vb[8][2];
#pragma unroll
            for (int u = 0; u < 8; ++u) { const GAS v4u* vp = (const GAS v4u*)(V8 + (size_t)((__builtin_amdgcn_readlane(kq[0], u) >> 10) & 0x3fff) * 2048) + lane; vb[u][0] = vp[0]; vb[u][1] = vp[64]; }
#pragma unroll
            for (int c = 0; c < 4; ++c) {
#pragma unroll 1
                for (int g = 0; g < 8; ++g) {
#pragma unroll
                    for (int u = 0; u < 8; ++u) {
                        const int key = __builtin_amdgcn_readlane(kq[c], 8 * g + u); const float s = rdlane(aq[c], 8 * g + u);
                        const float sa = (key & 512) ? 0.f : s, sb = (key & 512) ? s : 0.f; const f32x2 s0 = {sa, sa}, s1 = {sb, sb};
#pragma unroll
                        for (int i = 0; i < 2; ++i) { const v4u w = vb[u][i];
                            const f32x2 c0 = __builtin_amdgcn_cvt_pk_f32_fp8((int)w.x, false), c1 = __builtin_amdgcn_cvt_pk_f32_fp8((int)w.x, true), c2 = __builtin_amdgcn_cvt_pk_f32_fp8((int)w.y, false), c3 = __builtin_amdgcn_cvt_pk_f32_fp8((int)w.y, true);
                            const f32x2 c4 = __builtin_amdgcn_cvt_pk_f32_fp8((int)w.z, false), c5 = __builtin_amdgcn_cvt_pk_f32_fp8((int)w.z, true), c6 = __builtin_amdgcn_cvt_pk_f32_fp8((int)w.w, false), c7 = __builtin_amdgcn_cvt_pk_f32_fp8((int)w.w, true);
                            y[0][8 * i + 0] = __builtin_elementwise_fma(c0, s0, y[0][8 * i + 0]); y[1][8 * i + 0] = __builtin_elementwise_fma(c0, s1, y[1][8 * i + 0]);
                            y[0][8 * i + 1] = __builtin_elementwise_fma(c1, s0, y[0][8 * i + 1]); y[1][8 * i + 1] = __builtin_elementwise_fma(c1, s1, y[1][8 * i + 1]);
                            y[0][8 * i + 2] = __builtin_elementwise_fma(c2, s0, y[0][8 * i + 2]); y[1][8 * i + 2] = __builtin_elementwise_fma(c2, s1, y[1][8 * i + 2]);
                            y[0][8 * i + 3] = __builtin_elementwise_fma(c3, s0, y[0][8 * i + 3]); y[1][8 * i + 3] = __builtin_elementwise_fma(c3, s1, y[1][8 * i + 3]);
                            y[0][8 * i + 4] = __builtin_elementwise_fma(c4, s0, y[0][8 * i + 4]); y[1][8 * i + 4] = __builtin_elementwise_fma(c4, s1, y[1][8 * i + 4]);
                            y[0][8 * i + 5] = __builtin_elementwise_fma(c5, s0, y[0][8 * i + 5]); y[1][8 * i + 5] = __builtin_elementwise_fma(c5, s1, y[1][8 * i + 5]);
                            y[0][8 * i + 6] = __builtin_elementwise_fma(c6, s0, y[0][8 * i + 6]); y[1][8 * i + 6] = __builtin_elementwise_fma(c6, s1, y[1][8 * i + 6]);
                            y[0][8 * i + 7] = __builtin_elementwise_fma(c7, s0, y[0][8 * i + 7]); y[1][8 * i + 7] = __builtin_elementwise_fma(c7, s1, y[1][8 * i + 7]); }
                        { const int ix = 8 * g + 8 + u, ka = __builtin_amdgcn_readlane(kq[c], ix & 63), kb = __builtin_amdgcn_readlane(kq[c < 3 ? c + 1 : 3], ix & 63), kn = (ix < 64) ? ka : kb;
                            const GAS v4u* vp = (const GAS v4u*)(V8 + (size_t)((kn >> 10) & 0x3fff) * 2048) + lane; vb[u][0] = vp[0]; vb[u][1] = vp[64]; }
                    }
                }
            }
#pragma unroll
            for (int j = 0; j < 2; ++j) { const size_t t = (size_t)tb + (size_t)(2 * pp + j) * NGW;
                GAS f32x4* orw = (GAS f32x4*)(OUT + t * DM); float ss = 0.f;
#pragma unroll
                for (int i = 0; i < 2; ++i)
#pragma unroll
                    for (int hv = 0; hv < 2; ++hv) { const v4u w = *(const GAS v4u*)(X1B + t * DM + i * 1024 + lane * 16 + 8 * hv);
                        y[j][8 * i + 4 * hv + 0] += (f32x2){bflo(w.x), bfhi(w.x)}; y[j][8 * i + 4 * hv + 1] += (f32x2){bflo(w.y), bfhi(w.y)}; y[j][8 * i + 4 * hv + 2] += (f32x2){bflo(w.z), bfhi(w.z)}; y[j][8 * i + 4 * hv + 3] += (f32x2){bflo(w.w), bfhi(w.w)}; }
#pragma unroll
                for (int q = 0; q < 16; ++q) ss += y[j][q][0] * y[j][q][0] + y[j][q][1] * y[j][q][1];
                const float r3 = 1.0f / sqrtf(wave_sum_dpp(ss) * (1.0f / DM) + RMS_EPS);
#pragma unroll
                for (int i = 0; i < 2; ++i)
#pragma unroll
                    for (int q = 0; q < 4; ++q) { const f32x4 ga = *(const GAS f32x4*)(gfin + i * 1024 + lane * 16 + 4 * q);
                        orw[i * 256 + 4 * lane + q] = (f32x4){y[j][8 * i + 2 * q][0] * r3 * ga[0], y[j][8 * i + 2 * q][1] * r3 * ga[1], y[j][8 * i + 2 * q + 1][0] * r3 * ga[2], y[j][8 * i + 2 * q + 1][1] * r3 * ga[3]}; }
            }
        }
        asm volatile("s_waitcnt lgkmcnt(0)" ::: "memory");
    }
}

struct Args { const float* in[15]; float* out; unsigned char* ws; double invf[16]; int ph_lo, ph_hi, li, pad; };
__global__ void __launch_bounds__(NWAVES * 64, 2) mk_fwd(Args args) {
    extern __shared__ __attribute__((aligned(16))) unsigned char lds[];
    Ctx F;
    F.lds = (LAS unsigned char*)lds;
    volatile LAS unsigned* MISC = (volatile LAS unsigned*)(F.lds + MISC_OFF);
    F.tid = threadIdx.x; F.lane = F.tid & 63; F.wave = __builtin_amdgcn_readfirstlane(F.tid >> 6);
    F.G = gridDim.x; { const int bx = blockIdx.x; F.vcu = (F.G % 8 == 0) ? (bx % 8) * (F.G / 8) + bx / 8 : bx; }
    unsigned char* ws = args.ws;
    gu32* ctl = (gu32*)(ws + WS_CTL);
    for (int u = F.tid; u < (LDS_BYTES - LDSCTL_OFF) / 4; u += NWAVES * 64) ((LAS unsigned*)(F.lds + LDSCTL_OFF))[u] = 0u;
    __syncthreads();
    XcdBarrier bar; bar.bar = (unsigned*)(ctl + CW_BAR); bar.x = 0; bar.st = nullptr;
    if (N_LAUNCHES != PER_PHASE) bar = xcd_barrier_post((unsigned*)(ctl + CW_BAR), MISC + 8);
#define GRID_BAR() do { if (N_LAUNCHES != PER_PHASE) xcd_barrier(bar); } while (0)
    const int lo = args.ph_lo, hi = args.ph_hi;
#define IN(k) (lo <= (k) && (k) < hi)
#define BOTH(k) (IN(k) && IN((k) + 1))
    bf16* WinT = (bf16*)(ws + WS_WIN); bf16* WbcT = (bf16*)(ws + WS_WBC); bf16* WbaT = (bf16*)(ws + WS_WBA); bf16* WoutT = (bf16*)(ws + WS_WOUT); bf16* WpqT = (bf16*)(ws + WS_WPQ);
    bf16* KEYS = (bf16*)(ws + WS_KEYS); float* CS = (float*)(ws + WS_CS); const unsigned char* UB = ws + WS_UB; const unsigned char* VB = ws + WS_VB;
    bf16* XB = (bf16*)(ws + WS_XB); bf16* T6 = (bf16*)(ws + WS_T6); bf16* GAB = (bf16*)(ws + WS_GAB); bf16* UC = (bf16*)(ws + WS_UC); bf16* AO = (bf16*)(ws + WS_AO);
    bf16* TMP = (bf16*)(ws + WS_TMP); bf16* MB = (bf16*)(ws + WS_MB); bf16* X1B = (bf16*)(ws + WS_X1B); bf16* QP = (bf16*)(ws + WS_QP);
    int* EXP = (int*)(ws + WS_EXP); float* GATE = (float*)(ws + WS_GATE);
    unsigned long long* SS = (unsigned long long*)(ws + WS_SS); float* KSUM = (float*)(ws + WS_KSUM);
    constexpr size_t TS = (size_t)M * 1024;

    if (IN(0)) { for (int rep = 0; rep < NREP(0); ++rep) { p0_prologue(F, args.in, ws, args.invf); if (rep + 1 < NREP(0)) GRID_BAR(); } if (BOTH(0)) GRID_BAR(); }
    if (IN(1)) {
        for (int rep = 0; rep < NREP(1); ++rep) {
        pg8::Gemm g{XB, WinT, M, INW, DM}; pg8::StaticOrder S; S.init(M, INW, F.G, (int)blockIdx.x);
        pg8::EpiIn E{T6, GAB, args.in[4], CS, KSUM};
        pg8::gemm_phase<pg8::EpiIn, pg8::StaticOrder, true, true>(F.lds + RING_OFF, g, S, E);
        if (rep + 1 < NREP(1)) GRID_BAR(); }
        if (BOTH(1)) GRID_BAR();
    }
    if (IN(2)) {
        for (int rep = 0; rep < NREP(2); ++rep) {
        attn_mfma(F, T6 + 3 * TS, T6 + 4 * TS, T6 + 5 * TS, KSUM, AO);
        conv_phase(F, T6, T6 + TS, T6 + 2 * TS, args.in[5], UC);
        if (rep + 1 < NREP(2)) GRID_BAR(); }
        if (BOTH(2)) GRID_BAR();
    }
    if (IN(3)) {
        for (int rep = 0; rep < NREP(3); ++rep) {
        pg8::Gemm g{UC, WbcT, M, DM, 1024, AO, WbaT}; pg8::TwoSegOrder S; S.init(M, DM, F.G, (int)blockIdx.x);
        pg8::EpiMerge2 E{GAB, GAB + (size_t)M * DM, MB};
        pg8::gemm_phase<pg8::EpiMerge2, pg8::TwoSegOrder, true, true>(F.lds + RING_OFF, g, S, E);
        if (rep + 1 < NREP(3)) GRID_BAR(); }
        if (BOTH(3)) GRID_BAR();
    }
    if (IN(5)) {
        for (int rep = 0; rep < NREP(5); ++rep) {
        pg8::Gemm g{MB, WoutT, M, DM, DM}; pg8::StaticOrder S; S.init(M, DM, F.G, (int)blockIdx.x);
        pg8::EpiX1 E{args.in[0], args.out, X1B, (rep + 1 < NREP(5)) ? (unsigned long long*)(ws + 768 * 1024) : SS};
        pg8::gemm_phase<pg8::EpiX1, pg8::StaticOrder, true, true>(F.lds + RING_OFF, g, S, E);
        if (rep + 1 < NREP(5)) GRID_BAR(); }
        if (BOTH(5)) GRID_BAR();
    }
    if (IN(6)) {
        for (int rep = 0; rep < NREP(6); ++rep) {
        pg8::Gemm g{X1B, WpqT, M, DM, DM}; pg8::StaticOrder S; S.init(M, DM, F.G, (int)blockIdx.x);
        pg8::EpiQP E{SS, QP};
        pg8::gemm_phase<pg8::EpiQP, pg8::StaticOrder, true, true>(F.lds + RING_OFF, g, S, E);
        if (rep + 1 < NREP(6)) GRID_BAR(); }
        if (BOTH(6)) GRID_BAR();
    }
    if (IN(7)) { for (int rep = 0; rep < NREP(7); ++rep) {
        for (int bitem = F.vcu; bitem < 256; bitem += F.G) {
            topk_stage_keys(F, KEYS, bitem & 7);
            if (F.wave >= 4 && bitem == F.vcu) convert_tables(F, args.in[12], args.in[13], args.in[9], ws);
            topk_phase(F, bitem, QP, EXP, GATE);
            if (F.wave < 4 && bitem == F.vcu) convert_tables(F, args.in[12], args.in[13], args.in[9], ws);
            asm volatile("s_waitcnt lgkmcnt(0)" ::: "memory"); __builtin_amdgcn_s_barrier(); asm volatile("" ::: "memory");
        }
        if (rep + 1 < NREP(7)) GRID_BAR(); } if (BOTH(7)) GRID_BAR(); }
    if (IN(8)) { for (int rep = 0; rep < NREP(8); ++rep) { peer_phase(F, UB, VB, X1B, EXP, GATE, SS, args.in[14], args.out, (rep + 1 < NREP(8)) ? (float*)(ws + WS_END) : args.out); if (rep + 1 < NREP(8)) GRID_BAR(); } }
#undef IN
#undef BOTH
#undef GRID_BAR
}

extern "C" void kernel_launch(void* const* d_in, const int* in_sizes, int n_in, void* d_out, int out_size, void* d_ws, size_t ws_size, hipStream_t stream) {
    static int grid = 0;
    if (grid == 0) {
        if (n_in != 15 || in_sizes[0] != M * DM || out_size != M * DM || ws_size < WS_END) { fprintf(stderr, "kernel_launch: unexpected shapes (n_in %d, in0 %d, out %d, ws %zu)\n", n_in, n_in > 0 ? in_sizes[0] : -1, out_size, ws_size); grid = -1; return; }
        int dev = 0, cus = 0, per_cu = 0;
        if (hipGetDevice(&dev) != hipSuccess || hipDeviceGetAttribute(&cus, hipDeviceAttributeMultiprocessorCount, dev) != hipSuccess) { grid = -1; return; }
        if (hipFuncSetAttribute((const void*)mk_fwd, hipFuncAttributeMaxDynamicSharedMemorySize, LDS_BYTES) != hipSuccess) { fprintf(stderr, "kernel_launch: hipFuncSetAttribute failed\n"); grid = -1; return; }
        if (hipOccupancyMaxActiveBlocksPerMultiprocessor(&per_cu, (const void*)mk_fwd, NWAVES * 64, LDS_BYTES) != hipSuccess || per_cu < 1) fprintf(stderr, "kernel_launch: occupancy query reports %d\n", per_cu);
        (void)hipGetLastError();
        grid = cus;
        if (M % (4 * grid * NWAVES) != 0) { fprintf(stderr, "kernel_launch: the PEER phase needs M %% (32 * grid) == 0 (grid %d)\n", grid); grid = -1; return; }
    }
    if (grid < 0) return;
    if (hipMemsetAsync((char*)d_ws + WS_CTL, 0, CTL_ZERO_BYTES, stream) != hipSuccess) { fprintf(stderr, "kernel_launch: memset failed\n"); return; }
    Args a{};
    for (int i = 0; i < 15; ++i) a.in[i] = (const float*)d_in[i];
    a.out = (float*)d_out; a.ws = (unsigned char*)d_ws;
    for (int f = 0; f < 16; ++f) a.invf[f] = pow(500000.0, -(double)(2 * f) / 32.0);
    for (int li = 0; li < N_LAUNCHES; ++li) {
        a.ph_lo = (N_LAUNCHES == PER_PHASE) ? li : 0; a.ph_hi = (N_LAUNCHES == PER_PHASE) ? li + 1 : PER_PHASE; a.li = li;
        hipLaunchKernelGGL(mk_fwd, dim3(grid), dim3(NWAVES * 64), LDS_BYTES, stream, a);
        const hipError_t le = hipPeekAtLastError();
        if (le != hipSuccess) { fprintf(stderr, "kernel_launch: launch %d failed: %s\n", li, hipGetErrorName(le)); break; }
    }
}
```

```cpp
#include <hip/hip_runtime.h>
#include <cstdio>
#include <cstdint>
#include <cmath>
namespace pg8 {
#define PG8_LAS __attribute__((address_space(3)))
typedef unsigned short bf16_t;
typedef short bf16x8 __attribute__((ext_vector_type(8)));
typedef float f32x4 __attribute__((ext_vector_type(4)));
typedef unsigned u32x4 __attribute__((ext_vector_type(4)));
constexpr int BM = 256, BK = 64, HALF = 128, HTB = HALF * BK * 2  , STAGE_BYTES = 8 * HTB, NXCD = 8, WGM = 8;

__host__ __device__ __forceinline__ int lds_byte(int r, int c) { const int st = (r >> 4) * 2 + (c >> 5), rr = r & 15, cc = c & 31, ob = rr * 64 + cc * 2; return st * 1024 + (ob ^ (((ob >> 9) & 1) << 5)); }
__host__ __device__ __forceinline__ void stage_rc(int b, int& R, int& C) { const int st = b / 1024, sb = b % 1024, swz = sb ^ (((sb >> 9) & 1) << 5); R = (st >> 1) * 16 + swz / 64; C = (st & 1) * 32 + (swz % 64) / 2; }
__host__ __device__ __forceinline__ int perm32(int rho) { const int n = rho >> 4, i = rho & 15; return 8 * (i >> 2) + 4 * n + (i & 3); }

struct Unit { int pm, pn, seg; };
struct Gemm { const bf16_t* A; const bf16_t* Bt; int M, N, K; const bf16_t* A2; const bf16_t* Bt2; };

struct StaticOrder {
    int nM, nN, nwg, G, c;
    __host__ __device__ void init(int M, int N, int G_, int c_) { nM = M / BM; nN = N / BM; nwg = nM * nN; G = G_; c = c_; }
    __host__ __device__ bool next(int i, Unit& u) const {
        const long L = (long)i * G + c; if (L >= nwg) return false;
        int wgid = (int)L; { const int q = nwg / NXCD, r = nwg % NXCD, xcd = wgid % NXCD, off = wgid / NXCD; wgid = (xcd < r ? xcd * (q + 1) : r * (q + 1) + (xcd - r) * q) + off; }
        const int nig = WGM * nN, gid = wgid / nig, fm = gid * WGM, gsz = (nM - fm) < WGM ? (nM - fm) : WGM;
        u.pm = fm + ((wgid % nig) % gsz); u.pn = (wgid % nig) / gsz; u.seg = 0; return true;
    }
    __device__ __forceinline__ void a_ready(const Unit&) const {}
    __device__ __forceinline__ void done(const Unit&) const {}
};
struct TwoSegOrder {
    StaticOrder so;
    __host__ __device__ void init(int M, int N, int G_, int c_) { so.init(M, N, G_, c_); }
    __host__ __device__ bool next(int i, Unit& u) const { if (!so.next(i >> 1, u)) return false; u.seg = i & 1; return true; }
    __device__ __forceinline__ void a_ready(const Unit&) const {}
    __device__ __forceinline__ void done(const Unit&) const {}
};


typedef float f32x2c __attribute__((ext_vector_type(2))); typedef __bf16 bf16x2c __attribute__((ext_vector_type(2)));
__device__ __forceinline__ unsigned cvt_pk_bf16(float lo, float hi) { const f32x2c v = {lo, hi}; const bf16x2c b = __builtin_convertvector(v, bf16x2c); return __builtin_bit_cast(unsigned, b); }
__device__ __forceinline__ u32x4 pack8(f32x4 a, f32x4 b) { u32x4 w; w.x = cvt_pk_bf16(a[0], a[1]); w.y = cvt_pk_bf16(a[2], a[3]); w.z = cvt_pk_bf16(b[0], b[1]); w.w = cvt_pk_bf16(b[2], b[3]); return w; }
__device__ __forceinline__ f32x4 shx(f32x4 v, int o) { f32x4 r; r[0] = __shfl_xor(v[0], o); r[1] = __shfl_xor(v[1], o); r[2] = __shfl_xor(v[2], o); r[3] = __shfl_xor(v[3], o); return r; }
__device__ __forceinline__ f32x4 bf4lo(unsigned a, unsigned b) { f32x4 r; r[0] = __uint_as_float(a << 16); r[1] = __uint_as_float(a & 0xffff0000u); r[2] = __uint_as_float(b << 16); r[3] = __uint_as_float(b & 0xffff0000u); return r; }
__device__ __forceinline__ f32x4 sigm4(f32x4 v) { f32x4 r;
#pragma unroll
    for (int i = 0; i < 4; ++i) r[i] = __builtin_amdgcn_rcpf(1.0f + __expf(-v[i])); return r; }
constexpr float QSCALE = 0.08838834764831845f * 1.4426950408889634f;

struct EpiIn {
    static constexpr bool PERM = true, AFTER_DRAIN = false, KEEP_SEG0 = false;
    bf16_t* T6; bf16_t* GAB; const float* gbias; const float* cs; float* ksum;
    __device__ __forceinline__ void operator()(const f32x4 (&acc)[2][2][4][2], const Unit& u, int wr, int wc, int fr, int fq) const {
        const int row0 = u.pm * BM + wr * 64 + fr, pn = u.pn, colw = wc * 32 + 8 * fq;
        if (pn < 24) {
            const int t = pn >> 2;
            bf16_t* base = T6 + (size_t)t * ((size_t)8192 * 1024) + (pn & 3) * 256 + colw;
            const bool rot = (t == 3 || t == 4) && (wc == 0), isk = (t == 4);
            const float qs = (t == 3) ? QSCALE : 1.0f;
            f32x4 ks[2][2];
#pragma unroll
            for (int bj = 0; bj < 2; ++bj) { ks[bj][0] = (f32x4){0.f, 0.f, 0.f, 0.f}; ks[bj][1] = (f32x4){0.f, 0.f, 0.f, 0.f}; }
#pragma unroll
            for (int ai = 0; ai < 2; ++ai)
#pragma unroll
                for (int m = 0; m < 4; ++m) {
                    const int row = row0 + ai * HALF + m * 16;
                    f32x4 c0 = (f32x4){1.f, 1.f, 1.f, 1.f}, c1 = c0, s0 = (f32x4){0.f, 0.f, 0.f, 0.f}, s1 = s0;
                    if (rot) { const float* cp = cs + (size_t)row * 32 + 8 * (fq & 1); c0 = *(const f32x4*)cp; c1 = *(const f32x4*)(cp + 4); s0 = *(const f32x4*)(cp + 16); s1 = *(const f32x4*)(cp + 20);
                        if (fq < 2) { s0 = -s0; s1 = -s1; } }
#pragma unroll
                    for (int bj = 0; bj < 2; ++bj) {
                        f32x4 v0 = acc[ai][bj][m][0], v1 = acc[ai][bj][m][1];
                        if (rot) { const f32x4 p0 = shx(v0, 32), p1 = shx(v1, 32); v0 = v0 * c0 + p0 * s0; v1 = v1 * c1 + p1 * s1; }
                        if (isk) { ks[bj][0] += v0; ks[bj][1] += v1; }
                        v0 = v0 * qs; v1 = v1 * qs;
                        *(u32x4*)(base + (size_t)row * 1024 + bj * HALF) = pack8(v0, v1);
                    }
                }
            if (isk) {
#pragma unroll
                for (int bj = 0; bj < 2; ++bj)
#pragma unroll
                    for (int n = 0; n < 2; ++n) { f32x4 v = ks[bj][n]; v += shx(v, 1); v += shx(v, 2); v += shx(v, 4); v += shx(v, 8);
                        if (fr == 0) { float* kp = ksum + (size_t)u.pm * 1024 + (pn & 3) * 256 + bj * HALF + colw + 4 * n;
                            unsafeAtomicAdd(kp + 0, v[0]); unsafeAtomicAdd(kp + 1, v[1]); unsafeAtomicAdd(kp + 2, v[2]); unsafeAtomicAdd(kp + 3, v[3]); } }
            }
        } else {
            const int t = (pn - 24) >> 3, colg = ((pn - 24) & 7) * 256 + colw;
            bf16_t* base = GAB + (size_t)t * ((size_t)8192 * 2048) + colg;
            const float* bp = gbias + t * 2048 + colg;
            f32x4 bv[2][2];
#pragma unroll
            for (int bj = 0; bj < 2; ++bj) { bv[bj][0] = *(const f32x4*)(bp + bj * HALF); bv[bj][1] = *(const f32x4*)(bp + bj * HALF + 4); }
#pragma unroll
            for (int ai = 0; ai < 2; ++ai)
#pragma unroll
                for (int m = 0; m < 4; ++m) { const int row = row0 + ai * HALF + m * 16;
#pragma unroll
                    for (int bj = 0; bj < 2; ++bj) *(u32x4*)(base + (size_t)row * 2048 + bj * HALF) = pack8(sigm4(acc[ai][bj][m][0] + bv[bj][0]), sigm4(acc[ai][bj][m][1] + bv[bj][1])); }
        }
    }
};
struct EpiMerge2 {
    static constexpr bool PERM = true, AFTER_DRAIN = false, KEEP_SEG0 = true;
    const bf16_t* GA; const bf16_t* GB; bf16_t* O;
    __device__ __forceinline__ void operator()(f32x4 (&acc)[2][2][4][2], const Unit& u, int wr, int wc, int fr, int fq) const {
        const int row0 = u.pm * BM + wr * 64 + fr, col0 = u.pn * BM + wc * 32 + 8 * fq;
        if (u.seg == 0) {
#pragma unroll
            for (int ai = 0; ai < 2; ++ai)
#pragma unroll
                for (int m = 0; m < 4; ++m) { const size_t off = (size_t)(row0 + ai * HALF + m * 16) * 2048 + col0;
#pragma unroll
                    for (int bj = 0; bj < 2; ++bj) { const u32x4 a = *(const u32x4*)(GA + off + bj * HALF), b = *(const u32x4*)(GB + off + bj * HALF);
                        const f32x4 b0 = bf4lo(b.x, b.y), b1 = bf4lo(b.z, b.w); f32x4 r0, r1;
#pragma unroll
                        for (int e = 0; e < 4; ++e) { r0[e] = __builtin_amdgcn_rcpf(fmaxf(b0[e], 1e-20f)); r1[e] = __builtin_amdgcn_rcpf(fmaxf(b1[e], 1e-20f)); }
                        acc[ai][bj][m][0] = acc[ai][bj][m][0] * (bf4lo(a.x, a.y) * r0); acc[ai][bj][m][1] = acc[ai][bj][m][1] * (bf4lo(a.z, a.w) * r1); } }
        } else {
#pragma unroll
            for (int ai = 0; ai < 2; ++ai)
#pragma unroll
                for (int m = 0; m < 4; ++m) { const size_t off = (size_t)(row0 + ai * HALF + m * 16) * 2048 + col0;
#pragma unroll
                    for (int bj = 0; bj < 2; ++bj) { const u32x4 b = *(const u32x4*)(GB + off + bj * HALF);
                        f32x4 b0 = bf4lo(b.x, b.y), b1 = bf4lo(b.z, b.w);
#pragma unroll
                        for (int e = 0; e < 4; ++e) { b0[e] = fmaxf(b0[e], 1e-20f); b1[e] = fmaxf(b1[e], 1e-20f); }
                        *(u32x4*)(O + off + bj * HALF) = pack8(acc[ai][bj][m][0] * b0, acc[ai][bj][m][1] * b1); } }
        }
    }
};
struct EpiX1 {
    static constexpr bool PERM = true, AFTER_DRAIN = false, KEEP_SEG0 = false;
    const float* X; float* X1; bf16_t* X1B; unsigned long long* SS;
    __device__ __forceinline__ void operator()(const f32x4 (&acc)[2][2][4][2], const Unit& u, int wr, int wc, int fr, int fq) const {
        const int row0 = u.pm * BM + wr * 64 + fr, col0 = u.pn * BM + wc * 32 + 8 * fq;
#pragma unroll
        for (int ai = 0; ai < 2; ++ai)
#pragma unroll
            for (int m = 0; m < 4; ++m) { const int row = row0 + ai * HALF + m * 16; const size_t off = (size_t)row * 2048 + col0; float sq = 0.f;
#pragma unroll
                for (int bj = 0; bj < 2; ++bj) { const f32x4 v0 = acc[ai][bj][m][0] + *(const f32x4*)(X + off + bj * HALF), v1 = acc[ai][bj][m][1] + *(const f32x4*)(X + off + bj * HALF + 4);
                    *(u32x4*)(X1B + off + bj * HALF) = pack8(v0, v1);
                    sq += (v0[0] * v0[0] + v0[1] * v0[1]) + (v0[2] * v0[2] + v0[3] * v0[3]) + (v1[0] * v1[0] + v1[1] * v1[1]) + (v1[2] * v1[2] + v1[3] * v1[3]); }
                sq += __shfl_xor(sq, 16); sq += __shfl_xor(sq, 32);
                if (fq == 0) atomicAdd(SS + row, (unsigned long long)(sq * 4294967296.0f)); }
    }
};
__device__ __forceinline__ float rinv_from_ss(unsigned long long s) { return 1.0f / sqrtf((float)((double)s * (1.0 / 4294967296.0) * (1.0 / 2048.0)) + 1e-6f); }
struct EpiQP {
    static constexpr bool PERM = true, AFTER_DRAIN = false, KEEP_SEG0 = false;
    const unsigned long long* SS; bf16_t* O;
    __device__ __forceinline__ void operator()(const f32x4 (&acc)[2][2][4][2], const Unit& u, int wr, int wc, int fr, int fq) const {
        const int row0 = u.pm * BM + wr * 64 + fr, col0 = u.pn * BM + wc * 32 + 8 * fq;
#pragma unroll
        for (int ai = 0; ai < 2; ++ai)
#pragma unroll
            for (int m = 0; m < 4; ++m) { const int row = row0 + ai * HALF + m * 16; const size_t off = (size_t)row * 2048 + col0; const float rv = rinv_from_ss(SS[row]);
#pragma unroll
                for (int bj = 0; bj < 2; ++bj) *(u32x4*)(O + off + bj * HALF) = pack8(acc[ai][bj][m][0] * rv, acc[ai][bj][m][1] * rv); }
    }
};

template <class Epi, class Sched, bool ALIGN_EPI = false, bool SP2 = false>
__device__ __forceinline__ void gemm_phase(PG8_LAS unsigned char* lds, const Gemm g, const Sched& S, const Epi& E) {
    const int tid = threadIdx.x, wid = __builtin_amdgcn_readfirstlane(tid >> 6), lane = tid & 63, wr = wid >> 2, wc = wid & 3, fr = lane & 15, fq = lane >> 4;
    const int K = g.K, nt = K / BK;
    unsigned voffA[2], voffB[2];
#pragma unroll
    for (int i = 0; i < 2; ++i) { int R, C; stage_rc(tid * 16 + i * 8192, R, C); const int Rb = Epi::PERM ? ((R & ~31) + perm32(R & 31)) : R;
        voffA[i] = (unsigned)(R * K + C) * 2u; voffB[i] = (unsigned)(Rb * K + C) * 2u; }
    const size_t kstep = (size_t)(BK * 2);
    const size_t hstep = (size_t)HALF * K * 2;
    const size_t tstep = 2 * hstep;
    const unsigned ldsw = (unsigned)wid * 1024u;
    const int aoff = lds_byte(wr * 64 + fr, fq * 8), boff = lds_byte(wc * 32 + fr, fq * 8);
#define PG8_SA(b, h) (((b) * 2 + (h)) * HTB)
#define PG8_SB(b, h) ((4 + (b) * 2 + (h)) * HTB)
#define PG8_STAGE(bufoff, gbase, voff) do { _Pragma("unroll") for (int _i = 0; _i < 2; ++_i) \
        __builtin_amdgcn_global_load_lds((const unsigned*)((const char*)(gbase) + (voff)[_i]), (PG8_LAS unsigned*)(lds + (bufoff) + ldsw + _i * 8192), 16, 0, 0); } while (0)
#define PG8_LDA(dst, b, h) do { _Pragma("unroll") for (int m = 0; m < 4; ++m) _Pragma("unroll") for (int k = 0; k < 2; ++k) dst[m][k] = *(const PG8_LAS bf16x8*)(lds + PG8_SA(b, h) + aoff + m * 2048 + k * 1024); } while (0)
#define PG8_LDB(dst, b, h) do { _Pragma("unroll") for (int n = 0; n < 2; ++n) _Pragma("unroll") for (int k = 0; k < 2; ++k) dst[n][k] = *(const PG8_LAS bf16x8*)(lds + PG8_SB(b, h) + boff + n * 2048 + k * 1024); } while (0)
#define PG8_MMA(ai, bj, At, Bt) do { __builtin_amdgcn_s_setprio(1); _Pragma("unroll") for (int m = 0; m < 4; ++m) _Pragma("unroll") for (int n = 0; n < 2; ++n) _Pragma("unroll") for (int k = 0; k < 2; ++k) \
        acc[ai][bj][m][n] = __builtin_amdgcn_mfma_f32_16x16x32_bf16(Bt[n][k], At[m][k], acc[ai][bj][m][n], 0, 0, 0); __builtin_amdgcn_s_setprio(0); } while (0)
#define PG8_WAIT_V(n) asm volatile("s_waitcnt vmcnt(" #n ")" ::: "memory")
#define PG8_WAIT_L(n) asm volatile("s_waitcnt lgkmcnt(" #n ")" ::: "memory")
#define PG8_BAR __builtin_amdgcn_s_barrier()
#define PG8_SCHED __builtin_amdgcn_sched_barrier(0)
    Unit cur, nxt; int ui = 0;
    if (!S.next(0, cur)) return;
    f32x4 acc[2][2][4][2];
#pragma unroll
    for (int a = 0; a < 2; ++a)
#pragma unroll
        for (int b = 0; b < 2; ++b)
#pragma unroll
            for (int m = 0; m < 4; ++m)
#pragma unroll
                for (int n = 0; n < 2; ++n) acc[a][b][m][n] = (f32x4){0.f, 0.f, 0.f, 0.f};
    bf16x8 At[4][2], B0[2][2], B1[2][2];
    const char* cA = (const char*)(cur.seg ? g.A2 : g.A) + (size_t)cur.pm * tstep; const char* cB = (const char*)(cur.seg ? g.Bt2 : g.Bt) + (size_t)cur.pn * tstep;
    S.a_ready(cur);
    if constexpr (SP2) {
        PG8_STAGE(PG8_SB(0, 0), cB, voffB); PG8_STAGE(PG8_SB(0, 1), cB + hstep, voffB); PG8_STAGE(PG8_SA(0, 0), cA, voffA); PG8_STAGE(PG8_SA(0, 1), cA + hstep, voffA);
        if (wr == 1) PG8_BAR;
        PG8_WAIT_V(2); PG8_BAR;
        PG8_STAGE(PG8_SB(1, 0), cB + kstep, voffB); PG8_STAGE(PG8_SA(1, 0), cA + kstep, voffA); PG8_STAGE(PG8_SB(1, 1), cB + hstep + kstep, voffB);
        PG8_WAIT_V(6); PG8_BAR;
    } else {
        PG8_STAGE(PG8_SB(0, 0), cB, voffB); PG8_STAGE(PG8_SA(0, 0), cA, voffA); PG8_STAGE(PG8_SB(0, 1), cB + hstep, voffB); PG8_STAGE(PG8_SA(0, 1), cA + hstep, voffA);
        if (wr == 1) PG8_BAR;
        PG8_WAIT_V(4); PG8_BAR;
        PG8_STAGE(PG8_SB(1, 0), cB + kstep, voffB); PG8_STAGE(PG8_SA(1, 0), cA + kstep, voffA); PG8_STAGE(PG8_SB(1, 1), cB + hstep + kstep, voffB);
        PG8_WAIT_V(6); PG8_BAR;
    }
    for (;;) {
        const bool has_next = S.next(ui + 1, nxt);
        const char* nA = has_next ? (const char*)(nxt.seg ? g.A2 : g.A) + (size_t)nxt.pm * tstep : cA; const char* nB = has_next ? (const char*)(nxt.seg ? g.Bt2 : g.Bt) + (size_t)nxt.pn * tstep : cB;
        for (int t = 0; t < nt; t += 2) {
            const bool last = (t == nt - 2);
            const char* a1 = cA + (size_t)(t + 1) * kstep;
            const char* a2 = last ? nA : cA + (size_t)(t + 2) * kstep; const char* b2 = last ? nB : cB + (size_t)(t + 2) * kstep;
            const char* a3 = a2 + kstep; const char* b3 = b2 + kstep;
            if (last && has_next) S.a_ready(nxt);
            if constexpr (SP2) {
            PG8_LDB(B0, 0, 0); PG8_LDB(B1, 0, 1); PG8_SCHED; PG8_LDA(At, 0, 0); PG8_STAGE(PG8_SA(1, 1), a1 + hstep, voffA);
            PG8_WAIT_V(8); PG8_WAIT_L(0); PG8_BAR; PG8_MMA(0, 0, At, B0); PG8_MMA(0, 1, At, B1); PG8_BAR; PG8_SCHED;
            PG8_LDA(At, 0, 1); PG8_STAGE(PG8_SB(0, 0), b2, voffB); PG8_STAGE(PG8_SB(0, 1), b2 + hstep, voffB); PG8_STAGE(PG8_SA(0, 0), a2, voffA);
            PG8_WAIT_V(8); PG8_WAIT_L(0); PG8_BAR; PG8_MMA(1, 0, At, B0); PG8_MMA(1, 1, At, B1); PG8_BAR; PG8_SCHED;
            PG8_LDB(B0, 1, 0); PG8_LDB(B1, 1, 1); PG8_SCHED; PG8_LDA(At, 1, 0); PG8_STAGE(PG8_SA(0, 1), a2 + hstep, voffA);
            PG8_WAIT_V(8); PG8_WAIT_L(0); PG8_BAR; PG8_MMA(0, 0, At, B0); PG8_MMA(0, 1, At, B1); PG8_BAR; PG8_SCHED;
            PG8_LDA(At, 1, 1); PG8_STAGE(PG8_SB(1, 0), b3, voffB); PG8_STAGE(PG8_SB(1, 1), b3 + hstep, voffB); PG8_STAGE(PG8_SA(1, 0), a3, voffA);
            PG8_WAIT_V(8); PG8_WAIT_L(0); PG8_BAR; PG8_MMA(1, 0, At, B0); PG8_MMA(1, 1, At, B1); PG8_BAR; PG8_SCHED;
            } else {
            PG8_LDB(B0, 0, 0); PG8_SCHED; PG8_LDA(At, 0, 0); PG8_STAGE(PG8_SA(1, 1), a1 + hstep, voffA);
            PG8_WAIT_L(8); PG8_BAR; PG8_WAIT_L(0); PG8_MMA(0, 0, At, B0); PG8_BAR; PG8_SCHED;
            PG8_LDB(B1, 0, 1); PG8_STAGE(PG8_SB(0, 0), b2, voffB);
            PG8_BAR; PG8_WAIT_L(0); PG8_MMA(0, 1, At, B1); PG8_BAR;
            PG8_LDA(At, 0, 1); PG8_STAGE(PG8_SA(0, 0), a2, voffA);
            PG8_BAR; PG8_WAIT_L(0); PG8_MMA(1, 0, At, B0); PG8_BAR; PG8_SCHED;
            PG8_STAGE(PG8_SB(0, 1), b2 + hstep, voffB);
            PG8_WAIT_V(6); PG8_BAR; PG8_MMA(1, 1, At, B1); PG8_BAR;
            PG8_LDB(B0, 1, 0); PG8_SCHED; PG8_LDA(At, 1, 0); PG8_STAGE(PG8_SA(0, 1), a2 + hstep, voffA);
            PG8_WAIT_L(8); PG8_BAR; PG8_WAIT_L(0); PG8_MMA(0, 0, At, B0); PG8_BAR; PG8_SCHED;
            PG8_LDB(B1, 1, 1); PG8_STAGE(PG8_SB(1, 0), b3, voffB);
            PG8_BAR; PG8_WAIT_L(0); PG8_MMA(0, 1, At, B1); PG8_BAR;
            PG8_LDA(At, 1, 1); PG8_STAGE(PG8_SA(1, 0), a3, voffA);
            PG8_BAR; PG8_WAIT_L(0); PG8_MMA(1, 0, At, B0); PG8_BAR; PG8_SCHED;
            PG8_STAGE(PG8_SB(1, 1), b3 + hstep, voffB);
            PG8_WAIT_V(6); PG8_BAR; PG8_MMA(1, 1, At, B1); PG8_BAR;
            }
        }
        if constexpr (ALIGN_EPI) { if (wr == 0) PG8_BAR; }
        if constexpr (!Epi::AFTER_DRAIN) { E(acc, cur, wr, wc, fr, fq); S.done(cur); }
        if (!has_next) break;
        if (!(Epi::KEEP_SEG0 && cur.seg == 0)) {
#pragma unroll
        for (int a = 0; a < 2; ++a)
#pragma unroll
            for (int b = 0; b < 2; ++b)
#pragma unroll
                for (int m = 0; m < 4; ++m)
#pragma unroll
                    for (int n = 0; n < 2; ++n) acc[a][b][m][n] = (f32x4){0.f, 0.f, 0.f, 0.f};
        }
        cur = nxt; cA = nA; cB = nB; ++ui;
        if constexpr (ALIGN_EPI) { if (wr == 1) PG8_BAR; }
    }
    PG8_WAIT_V(0);
    if constexpr (!ALIGN_EPI) { if (wr == 0) PG8_BAR; }
    PG8_BAR;
    if constexpr (Epi::AFTER_DRAIN) { E.fused(acc, cur, wr, wc, fr, fq, lds, wid, lane); S.done(cur); }
#undef PG8_SA
#undef PG8_SB
#undef PG8_STAGE
#undef PG8_LDA
#undef PG8_LDB
#undef PG8_MMA
#undef PG8_WAIT_V
#undef PG8_WAIT_L
#undef PG8_BAR
#undef PG8_SCHED
}
}

constexpr int NWAVES = 8;
#ifndef MK_N_LAUNCHES
#define MK_N_LAUNCHES 1
#endif
constexpr int PER_PHASE = 9;
#ifndef MK_REP_PHASE
#define MK_REP_PHASE -1
#endif
#define NREP(k) (((k) == MK_REP_PHASE) ? 2 : 1)
constexpr int N_LAUNCHES = MK_N_LAUNCHES;
constexpr int M = 8192, SEQ = 4096, DM = 2048, INW = 10240, NEXP = 16384;
constexpr float RMS_EPS = 1e-6f;
constexpr size_t MiB = 1u << 20;
constexpr size_t WS_CTL = 0, CTL_ZERO_BYTES = 64 * 1024;
constexpr size_t WS_SS = 256 * 1024, WS_KSUM = 512 * 1024;
constexpr size_t WS_WIN = 2 * MiB, WS_WBC = 42 * MiB, WS_WBA = 46 * MiB, WS_WOUT = 50 * MiB, WS_WPQ = 58 * MiB, WS_KEYS = 66 * MiB, WS_CS = 67 * MiB;
constexpr size_t WS_UB = 70 * MiB, WS_VB = 102 * MiB;
constexpr size_t WS_XB = 198 * MiB;
constexpr size_t WS_T6 = 230 * MiB;
constexpr size_t WS_GAB = 326 * MiB;
constexpr size_t WS_UC = 390 * MiB, WS_AO = 406 * MiB;
constexpr size_t WS_EXP = 422 * MiB, WS_GATE = 426 * MiB;
constexpr size_t WS_END = 430 * MiB;
constexpr size_t WS_TMP = WS_XB, WS_MB = WS_T6, WS_X1B = WS_T6 + 48 * MiB, WS_QP = WS_GAB;
constexpr int CW_BAR = 4096;
constexpr int RING_OFF = 0, RING_BYTES = 131072;
constexpr int LDSCTL_OFF = RING_BYTES, MISC_OFF = LDSCTL_OFF + 320;
constexpr int LDS_BYTES = 147456;

#define GAS __attribute__((address_space(1)))
#define LAS __attribute__((address_space(3)))
typedef unsigned short bf16;
typedef unsigned v4u __attribute__((ext_vector_type(4)));
typedef float f32x4 __attribute__((ext_vector_type(4)));
typedef short bf16x8 __attribute__((ext_vector_type(8)));
typedef GAS unsigned gu32;
typedef GAS unsigned long long gu64;
#define RLX_AGENT __ATOMIC_RELAXED, __HIP_MEMORY_SCOPE_AGENT
#define LDS_WAIT() asm volatile("s_waitcnt lgkmcnt(0)" ::: "memory")
#define VM_WAIT() asm volatile("s_waitcnt vmcnt(0)" ::: "memory")
__device__ __forceinline__ unsigned long long rt() { return __builtin_amdgcn_s_memrealtime(); }
__device__ __forceinline__ unsigned f2bf(float f) { unsigned u = __builtin_bit_cast(unsigned, f); return (u + 0x7fffu + ((u >> 16) & 1u)) >> 16; }
__device__ __forceinline__ unsigned pk2(float lo, float hi) { return f2bf(lo) | (f2bf(hi) << 16); }

#define XB_TMO      128
#define XB_XCNT(j)  (256  + 64 * (j))
#define XB_XSUB(j)  (1280 + 64 * (j))
#define XB_XGEN(j)  (2304 + 64 * (j))
#define XB_TOP      3328
#define XB_TOPGEN   3392
#define XCD_BAR_WORDS 3456
#define XB_SPIN_CAP (1u << 18)

__device__ __forceinline__ unsigned xb_ld(unsigned* p)              { return __hip_atomic_load(p, __ATOMIC_RELAXED, __HIP_MEMORY_SCOPE_AGENT); }
__device__ __forceinline__ unsigned xb_add(unsigned* p, unsigned v) { return __hip_atomic_fetch_add(p, v, __ATOMIC_RELAXED, __HIP_MEMORY_SCOPE_AGENT); }
__device__ __forceinline__ unsigned xb_xcc_id() { return (unsigned)__builtin_amdgcn_s_getreg((3 << 11) | 20) & 0xFu; }
#define XB_SPIN(cond, bar) do { unsigned _sp = 0; while (cond) { __builtin_amdgcn_s_sleep(1); \
    if ((++_sp & 255u) == 0u) { if (xb_ld(&(bar)[XB_TMO])) break; if (_sp > XB_SPIN_CAP) { atomicAdd(&(bar)[XB_TMO], 1u); break; } } } } while (0)

struct XcdBarrier {
    unsigned* bar; unsigned x;
    volatile LAS unsigned* st;
};

__device__ __forceinline__ XcdBarrier xcd_barrier_post(unsigned* bar, volatile LAS unsigned* st) {
    XcdBarrier b; b.bar = bar; b.x = xb_xcc_id(); b.st = st;
    if (threadIdx.x == 0) (void)xb_add(&bar[XB_XCNT(b.x)], 1u);
    return b;
}
__device__ __forceinline__ void xcd_barrier_complete(unsigned* bar, unsigned x, unsigned& nloc, unsigned& nx) {
    const unsigned G = gridDim.x * gridDim.y * gridDim.z;
    unsigned sum, cnt, mine, sp = 0u;
    for (;;) {
        sum = 0u; cnt = 0u; mine = 0u;
#pragma unroll
        for (unsigned j = 0; j < 16; ++j) { const unsigned c = xb_ld(&bar[XB_XCNT(j)]); sum += c; cnt += (c > 0u) ? 1u : 0u; mine = (j == x) ? c : mine; }
        if (sum == G) break;
        __builtin_amdgcn_s_sleep(1);
        if ((++sp & 255u) == 0u) { if (xb_ld(&bar[XB_TMO])) break; if (sp > XB_SPIN_CAP) { atomicAdd(&bar[XB_TMO], 1u); break; } }
    }
    nloc = mine > 0u ? mine : 1u; nx = cnt > 0u ? cnt : 1u;
}

struct Ctx { LAS unsigned char* lds; int tid, lane, wave, vcu, G; };
struct BarWork { const float* pu; const float* pv; const float* g2; unsigned char* ws; int part, nparts; };
__device__ __forceinline__ void convert_tables(const Ctx& F, const float* pu, const float* pv, const float* g2, unsigned char* ws, int part, int nparts, int w0);
__device__ __forceinline__ void xcd_barrier(const XcdBarrier& b, const Ctx* F = nullptr, const BarWork* wk = nullptr) {
    asm volatile("s_waitcnt vmcnt(0)" ::: "memory");
    __syncthreads();
    if (wk && wk->part >= 0) convert_tables(*F, wk->pu, wk->pv, wk->g2, wk->ws, wk->part, wk->nparts, 1);
    if (threadIdx.x == 0) {
        unsigned* bar = b.bar;
        __builtin_amdgcn_s_waitcnt(0);
        unsigned nloc = b.st[0], nx = b.st[1];
        if (nloc == 0u) { xcd_barrier_complete(bar, b.x, nloc, nx); b.st[0] = nloc; b.st[1] = nx; }
        const unsigned old = xb_add(&bar[XB_XSUB(b.x)], 1u);
        const unsigned gen = old / nloc;
        if (old + 1u == (gen + 1u) * nloc) {
            __builtin_amdgcn_fence(__ATOMIC_RELEASE, "agent");
            asm volatile("s_waitcnt vmcnt(0)" ::: "memory");
            const unsigned og = xb_add(&bar[XB_TOP], 1u);
            const unsigned tg = og / nx;
            if (og + 1u == (tg + 1u) * nx) xb_add(&bar[XB_TOPGEN], 1u);
            else XB_SPIN(xb_ld(&bar[XB_TOPGEN]) == tg, bar);
            __builtin_amdgcn_fence(__ATOMIC_ACQUIRE, "agent");
            xb_add(&bar[XB_XGEN(b.x)], 1u);
            asm volatile("s_waitcnt vmcnt(0)" ::: "memory");
        } else {
            XB_SPIN(xb_ld(&bar[XB_XGEN(b.x)]) == gen, bar);
            __builtin_amdgcn_fence(__ATOMIC_ACQUIRE, "agent");
            asm volatile("s_waitcnt vmcnt(0)" ::: "memory");
        }
    }
    __syncthreads();
}

typedef __bf16 bf16x2v __attribute__((ext_vector_type(2)));
typedef float f32x16 __attribute__((ext_vector_type(16)));
__device__ __forceinline__ float bflo(unsigned w) { return __uint_as_float(w << 16); }
__device__ __forceinline__ float bfhi(unsigned w) { return __uint_as_float(w & 0xffff0000u); }
__device__ __forceinline__ float dot2bf(unsigned a, unsigned b, float c) { return __builtin_amdgcn_fdot2_f32_bf16(__builtin_bit_cast(bf16x2v, a), __builtin_bit_cast(bf16x2v, b), c, false); }
__device__ __forceinline__ float wave_sum(float v) {
#pragma unroll
    for (int o = 1; o < 64; o <<= 1) v += __shfl_xor(v, o);
    return v; }
__device__ __forceinline__ float wave_max(float v) {
#pragma unroll
    for (int o = 1; o < 64; o <<= 1) v = fmaxf(v, __shfl_xor(v, o));
    return v; }
__device__ __forceinline__ float rdlane(float v, int l) { return __int_as_float(__builtin_amdgcn_readlane(__float_as_int(v), l)); }
__device__ __forceinline__ float gelu_tanh(float x) { const float z = 0.7978845608028654f * (x + 0.044715f * x * x * x); const float e = __expf(2.0f * z); const float th = 1.0f - 2.0f * __builtin_amdgcn_rcpf(1.0f + e); return 0.5f * x * (1.0f + th); }


__device__ __forceinline__ void p0_transpose_item(const float* W, int K, int N, bf16* WT, const float* gk, LAS float* scr, int item, int lane) {
    const int nblk = N / 32, kb = item / nblk, nb = item % nblk, k0 = 64 * kb, n0 = 32 * nb;
#pragma unroll
    for (int i = 0; i < 8; ++i) { const int kk = 8 * i + (lane >> 3), nn = 4 * (lane & 7); f32x4 v = *(const GAS f32x4*)(W + (size_t)(k0 + kk) * N + n0 + nn); if (gk) v = v * gk[k0 + kk];
        scr[kk * 33 + nn] = v[0]; scr[kk * 33 + nn + 1] = v[1]; scr[kk * 33 + nn + 2] = v[2]; scr[kk * 33 + nn + 3] = v[3]; }
    LDS_WAIT(); asm volatile("" ::: "memory");
    const int c = lane & 7;
#pragma unroll
    for (int j = 0; j < 4; ++j) { const int n = (lane >> 3) + 8 * j; const LAS float* s = scr + (8 * c) * 33 + n;
        v4u o; o.x = pk2(s[0 * 33], s[1 * 33]); o.y = pk2(s[2 * 33], s[3 * 33]); o.z = pk2(s[4 * 33], s[5 * 33]); o.w = pk2(s[6 * 33], s[7 * 33]);
        *(GAS v4u*)(WT + (size_t)(n0 + n) * K + k0 + 8 * c) = o; }
    LDS_WAIT(); asm volatile("" ::: "memory");
}
__device__ __forceinline__ void convert_tables(const Ctx& F, const float* pu, const float* pv, const float* g2, unsigned char* ws, int part, int nparts, int w0) {
    if (F.wave < w0) return;
    const int nw = NWAVES - w0, gt = (F.vcu * nw + (F.wave - w0)) * 64 + F.lane, NT = F.G * nw * 64;
    const int per = (NEXP * 2048 / 16) / nparts, lo = part * per, hi = lo + per;
    for (int i = lo + gt; i < hi; i += NT) { const int c16 = (i & 127) * 16; v4u ou, ov;
#pragma unroll
        for (int q = 0; q < 4; ++q) { f32x4 a = ((const GAS f32x4*)pu)[4 * i + q]; a = a * *(const GAS f32x4*)(g2 + c16 + 4 * q) * 512.0f; const f32x4 b = ((const GAS f32x4*)pv)[4 * i + q] * 32.0f;
            int wu = 0, wv = 0; wu = __builtin_amdgcn_cvt_pk_fp8_f32(a[0], a[1], wu, false); wu = __builtin_amdgcn_cvt_pk_fp8_f32(a[2], a[3], wu, true);
            wv = __builtin_amdgcn_cvt_pk_fp8_f32(b[0], b[1], wv, false); wv = __builtin_amdgcn_cvt_pk_fp8_f32(b[2], b[3], wv, true); ou[q] = (unsigned)wu; ov[q] = (unsigned)wv; }
        ((GAS v4u*)(ws + WS_UB))[i] = ou; ((GAS v4u*)(ws + WS_VB))[i] = ov; }
}
__device__ __forceinline__ void p0_prologue(const Ctx& F, const float* const* in, unsigned char* ws, const double* invf) {
    const float* x = in[0]; const int* pos = (const int*)in[1]; const float* g1 = in[2]; const float* w_in = in[3];
    const float* w_bc = in[6]; const float* w_ba = in[7]; const float* w_out = in[8]; const float* g2 = in[9]; const float* w_pq = in[10];
    const float* keys = in[11]; const float* pu = in[12]; const float* pv = in[13];
    LAS float* scr = (LAS float*)(F.lds + RING_OFF + F.wave * 16384);
    const int gw = F.vcu * NWAVES + F.wave, NGW = F.G * NWAVES;
    const int gt = gw * 64 + F.lane, NT = NGW * 64;
    for (int i = gt; i < 8192; i += NT) ((GAS unsigned long long*)(ws + WS_SS))[i] = 0ull;
    for (int i = gt; i < 32 * 1024; i += NT) ((GAS float*)(ws + WS_KSUM))[i] = 0.f;
    constexpr int I_IN = 32 * 320, I_BC = 16 * 64, I_OUT = 32 * 64;
    constexpr int NITEMS = I_IN + 2 * I_BC + 2 * I_OUT;
    for (int it = gw; it < NITEMS; it += NGW) {
        int r = it;
        if (r < I_IN) { p0_transpose_item(w_in, 2048, INW, (bf16*)(ws + WS_WIN), g1, scr, r, F.lane); continue; } r -= I_IN;
        if (r < I_BC) { p0_transpose_item(w_bc, 1024, 2048, (bf16*)(ws + WS_WBC), nullptr, scr, r, F.lane); continue; } r -= I_BC;
        if (r < I_BC) { p0_transpose_item(w_ba, 1024, 2048, (bf16*)(ws + WS_WBA), nullptr, scr, r, F.lane); continue; } r -= I_BC;
        if (r < I_OUT) { p0_transpose_item(w_out, 2048, 2048, (bf16*)(ws + WS_WOUT), nullptr, scr, r, F.lane); continue; } r -= I_OUT;
        p0_transpose_item(w_pq, 2048, 2048, (bf16*)(ws + WS_WPQ), g2, scr, r, F.lane);
    }
    for (int i = gt; i < 16 * 128 * 128 / 8; i += NT) { const f32x4 a = ((const GAS f32x4*)keys)[2 * i], b = ((const GAS f32x4*)keys)[2 * i + 1];
        v4u o; o.x = pk2(a[0], a[1]); o.y = pk2(a[2], a[3]); o.z = pk2(b[0], b[1]); o.w = pk2(b[2], b[3]); ((GAS v4u*)(ws + WS_KEYS))[i] = o; }
    for (int m = gw; m < M; m += NGW) { const GAS f32x4* xr = (const GAS f32x4*)(x + (size_t)m * DM);
        f32x4 v[8]; float s = 0.f;
#pragma unroll
        for (int i = 0; i < 4; ++i) { v[2 * i] = xr[i * 128 + 2 * F.lane]; v[2 * i + 1] = xr[i * 128 + 2 * F.lane + 1]; }
#pragma unroll
        for (int i = 0; i < 8; ++i) s += (v[i][0] * v[i][0] + v[i][1] * v[i][1]) + (v[i][2] * v[i][2] + v[i][3] * v[i][3]);
        const float rinv = 1.0f / sqrtf(wave_sum(s) * (1.0f / DM) + RMS_EPS);
        GAS v4u* o = (GAS v4u*)(ws + WS_XB + (size_t)m * DM * 2);
#pragma unroll
        for (int i = 0; i < 4; ++i) { const f32x4 a = v[2 * i] * rinv, b = v[2 * i + 1] * rinv; v4u w; w.x = pk2(a[0], a[1]); w.y = pk2(a[2], a[3]); w.z = pk2(b[0], b[1]); w.w = pk2(b[2], b[3]); o[i * 64 + F.lane] = w; } }
    for (int i = gt; i < M * 16; i += NT) { const int row = i >> 4, f = i & 15; const double ang = (double)pos[row] * invf[f];
        const double k = __builtin_rint(ang * 0.15915494309189535); const float r = (float)(ang - k * 6.283185307179586);
        float* cs = (float*)(ws + WS_CS); cs[row * 32 + f] = __cosf(r); cs[row * 32 + 16 + f] = __sinf(r); }
}

__device__ __forceinline__ void attn_simple(const Ctx& F, const bf16* Q, const bf16* K, const bf16* V, const float* ksum, bf16* AO) {
    LAS float* qf = (LAS float*)(F.lds + RING_OFF + F.wave * 512);
    const int gw = F.vcu * NWAVES + F.wave, NGW = F.G * NWAVES, lane = F.lane;
    for (int item = gw; item < 16 * SEQ; item += NGW) {
        const int bh = item >> 12, t = item & 4095, b = bh >> 3, h = bh & 7, blk = t >> 8;
        const size_t row = (size_t)b * SEQ + t;
        { const unsigned qq = *(const GAS unsigned*)(Q + row * 1024 + h * 128 + 2 * lane); qf[2 * lane] = bflo(qq); qf[2 * lane + 1] = bfhi(qq); }
        LDS_WAIT(); asm volatile("" ::: "memory");
        float g = -INFINITY;
        if (lane < blk) { const GAS f32x4* km = (const GAS f32x4*)(ksum + (size_t)(b * 16 + lane) * 1024 + h * 128); float a = 0.f;
            for (int d = 0; d < 32; ++d) { const f32x4 kv = km[d]; const f32x4 qv = *(const LAS f32x4*)(qf + 4 * d); a += (kv[0] * qv[0] + kv[1] * qv[1]) + (kv[2] * qv[2] + kv[3] * qv[3]); }
            g = a; }
        int sel[3];
#pragma unroll
        for (int i = 0; i < 3; ++i) { const float mx = wave_max(g); const unsigned long long bal = __ballot(g == mx && lane < blk); const int idx = bal ? (__ffsll((long long)bal) - 1) : 0; sel[i] = idx; if (lane == idx) g = -INFINITY; }
        const int nsel = blk < 3 ? blk : 3;
        float sc[4][4]; float mx = -INFINITY;
#pragma unroll
        for (int slot = 0; slot < 4; ++slot) {
            const bool valid = (slot == 3) || (slot < nsel);
            const int kb = (slot == 3) ? blk : sel[slot < 3 ? slot : 0];
#pragma unroll
            for (int r = 0; r < 4; ++r) {
                float s = -INFINITY; const int key0 = kb * 256 + r * 64;
                if (valid && (slot < 3 || key0 <= t)) {
                    const int key = key0 + lane; const GAS v4u* kp = (const GAS v4u*)(K + ((size_t)b * SEQ + key) * 1024 + h * 128); float a = 0.f;
#pragma unroll 4
                    for (int d = 0; d < 16; ++d) { const v4u kk = kp[d]; const f32x4 q0 = *(const LAS f32x4*)(qf + 8 * d), q1 = *(const LAS f32x4*)(qf + 8 * d + 4);
                        a += (bflo(kk.x) * q0[0] + bfhi(kk.x) * q0[1]) + (bflo(kk.y) * q0[2] + bfhi(kk.y) * q0[3]) + (bflo(kk.z) * q1[0] + bfhi(kk.z) * q1[1]) + (bflo(kk.w) * q1[2] + bfhi(kk.w) * q1[3]); }
                    s = (slot < 3 || key <= t) ? a : -INFINITY; }
                sc[slot][r] = s; mx = fmaxf(mx, s); } }
        mx = wave_max(mx);
        float sum = 0.f;
#pragma unroll
        for (int slot = 0; slot < 4; ++slot)
#pragma unroll
            for (int r = 0; r < 4; ++r) { sc[slot][r] = exp2f(sc[slot][r] - mx); sum += sc[slot][r]; }
        sum = wave_sum(sum);
        float o0 = 0.f, o1 = 0.f;
#pragma unroll
        for (int slot = 0; slot < 4; ++slot) {
            const bool valid = (slot == 3) || (slot < nsel);
            const int kb = (slot == 3) ? blk : sel[slot < 3 ? slot : 0];
#pragma unroll
            for (int r = 0; r < 4; ++r) { const int key0 = kb * 256 + r * 64;
                if (valid && (slot < 3 || key0 <= t)) { const float pr = sc[slot][r]; const GAS unsigned* vp = (const GAS unsigned*)(V + ((size_t)b * SEQ + key0) * 1024 + h * 128) + lane;
                    for (int kk = 0; kk < 64; ++kk) { const float pk = rdlane(pr, kk); const unsigned vv = vp[(size_t)kk * 512]; o0 += pk * bflo(vv); o1 += pk * bfhi(vv); } } } }
        const float ri = 1.0f / sum;
        *(GAS unsigned*)(AO + row * 1024 + h * 128 + 2 * lane) = pk2(o0 * ri, o1 * ri);
    }
}
typedef short v4i16_t __attribute__((ext_vector_type(4))); typedef unsigned u32x2v __attribute__((ext_vector_type(2)));
__device__ __forceinline__ v4i16_t vtr16(unsigned addr) { return __builtin_amdgcn_ds_read_tr16_b64_v4i16((LAS v4i16_t*)(uintptr_t)addr); }
__device__ __forceinline__ int crow16(int r, int hh) { return (r & 3) + 8 * (r >> 2) + 4 * hh; }
__device__ __forceinline__ void attn_dma_step(const bf16* K, const bf16* V, LAS unsigned char* lds, int b, int h, int qb, int n_own, int st, int buf, int wave, int lane) {
#pragma unroll
    for (int img = 0; img < 4; ++img) {
        const int T = 2 * st + (img >> 1); const bool isV = img & 1;
        const int blk = (T < n_own) ? qb : ((T - n_own) >> 2), kt = (T < n_own) ? T : ((T - n_own) & 3);
        const bf16* base = (isV ? V : K) + ((size_t)b * SEQ + 256 * blk + 64 * kt) * 1024 + h * 128;
#pragma unroll
        for (int i = 0; i < 2; ++i) { const int pc = wave + 8 * i, row = 4 * pc + (lane >> 4), cp = lane & 15;
            const int c = isV ? ((((cp >> 2) ^ (row & 3)) << 2) | (cp & 3)) : (cp ^ (row & 15));
            __builtin_amdgcn_global_load_lds((const unsigned*)(base + (size_t)row * 1024 + 8 * c), (LAS unsigned*)(lds + buf * 65536 + img * 16384 + pc * 1024), 16, 0, 0); }
    }
}
__device__ __forceinline__ void attn_mfma(const Ctx& F, const bf16* Q, const bf16* K, const bf16* V, const float* ksum, bf16* AO) {
    const int lane = F.lane, wave = F.wave, q31 = lane & 31, hh = lane >> 5, wq = wave & 3, kvh = wave >> 2, l16 = lane & 15, G4 = lane >> 4;
    LAS unsigned char* lds = F.lds + RING_OFF;
    const unsigned lds0 = (unsigned)(uintptr_t)lds;
    for (int pr = F.vcu; pr < 256; pr += F.G)
#pragma unroll 1
    for (int pi = 0; pi < 2; ++pi) {
        const int bh = pr >> 4, s_ = pr & 15, u128 = pi ? 31 - s_ : s_, b = bh >> 3, h = bh & 7, qb = u128 >> 1, half = u128 & 1;
        const int n_own = half ? 4 : 2, nstep = (n_own + 4 * qb) >> 1;
        const size_t rowq = (size_t)b * SEQ + 256 * qb + 128 * half + 32 * wq + q31;
        asm volatile("s_waitcnt vmcnt(0) lgkmcnt(0)" ::: "memory"); __builtin_amdgcn_s_barrier(); asm volatile("" ::: "memory");
        attn_dma_step(K, V, lds, b, h, qb, n_own, 0, 0, wave, lane);
        bf16x8 qf[8];
#pragma unroll
        for (int s = 0; s < 8; ++s) qf[s] = *(const GAS bf16x8*)(Q + rowq * 1024 + h * 128 + 16 * s + 8 * hh);
        unsigned selmask;
        {
            f32x16 gt;
#pragma unroll
            for (int r = 0; r < 16; ++r) gt[r] = 0.f;
            const int jr = lane & 31; const bool jv = jr < qb;
            const GAS f32x4* kp = (const GAS f32x4*)(ksum + (size_t)(b * 16 + (jv ? jr : 0)) * 1024 + h * 128 + 8 * hh);
            f32x4 kf[16];
#pragma unroll
            for (int s = 0; s < 8; ++s) { kf[2 * s] = kp[4 * s]; kf[2 * s + 1] = kp[4 * s + 1]; }
#pragma unroll
            for (int s = 0; s < 8; ++s) { v4u w = pg8::pack8(kf[2 * s], kf[2 * s + 1]); if (!jv) { w.x = 0u; w.y = 0u; w.z = 0u; w.w = 0u; }
                gt = __builtin_amdgcn_mfma_f32_32x32x16_bf16(__builtin_bit_cast(bf16x8, w), qf[s], gt, 0, 0, 0); }
            float g16[16];
#pragma unroll
            for (int r = 0; r < 8; ++r) { const auto rr = __builtin_amdgcn_permlane32_swap(__float_as_uint(gt[r]), __float_as_uint(gt[r]), false, false);
                g16[(r & 3) + 8 * (r >> 2)] = __uint_as_float(rr[0]); g16[(r & 3) + 8 * (r >> 2) + 4] = __uint_as_float(rr[1]); }
            float v0 = -INFINITY, v1 = -INFINITY, v2 = -INFINITY; int i0 = 0, i1 = 0, i2 = 0;
#pragma unroll
            for (int j = 0; j < 16; ++j) { const float a = (j < qb) ? g16[j] : -INFINITY;
                if (a > v0) { v2 = v1; i2 = i1; v1 = v0; i1 = i0; v0 = a; i0 = j; } else if (a > v1) { v2 = v1; i2 = i1; v1 = a; i1 = j; } else if (a > v2) { v2 = a; i2 = j; } }
            selmask = (qb <= 3) ? ((1u << qb) - 1u) : ((1u << i0) | (1u << i1) | (1u << i2));
        }
        float m_run = -1e30f, l_run = 0.f; f32x16 o[4];
#pragma unroll
        for (int db = 0; db < 4; ++db)
#pragma unroll
            for (int r = 0; r < 16; ++r) o[db][r] = 0.f;
        const int qin = 128 * half + 32 * wq + q31;
#pragma unroll 1
        for (int st2 = 0; st2 < nstep; st2 += 2)
#pragma unroll
        for (int par = 0; par < 2; ++par) { const int st = st2 + par; if (st < nstep) {
            asm volatile("s_waitcnt vmcnt(0)" ::: "memory"); __builtin_amdgcn_s_barrier(); asm volatile("" ::: "memory");
            if (st + 1 < nstep) attn_dma_step(K, V, lds, b, h, qb, n_own, st + 1, par ^ 1, wave, lane);
            const int T = 2 * st + kvh; const bool own = T < n_own;
            const int blk = own ? qb : ((T - n_own) >> 2), kt = own ? T : ((T - n_own) & 3);
            const bool sel = own ? true : ((selmask >> blk) & 1u);
            const bool skip = own ? (64 * kt > 128 * half + 32 * wq + 31) : (__ballot(sel) == 0ull);
            if (!skip) {
                const unsigned kimg = lds0 + par * 65536 + kvh * 32768, vimg = kimg + 16384;
                f32x16 p[2];
#pragma unroll
                for (int kh = 0; kh < 2; ++kh) {
#pragma unroll
                    for (int r = 0; r < 16; ++r) p[kh][r] = 0.f;
                    const int row = 32 * kh + q31;
#pragma unroll
                    for (int s = 0; s < 8; ++s) { const bf16x8 a = *(const LAS bf16x8*)(uintptr_t)(kimg + row * 256 + (((2 * s + hh) ^ (row & 15)) << 4));
                        p[kh] = __builtin_amdgcn_mfma_f32_32x32x16_bf16(a, qf[s], p[kh], 0, 0, 0); }
                }
                if (own) { const int kbase = 64 * kt;
                    if (kbase + 63 > 128 * half + 32 * wq) {
#pragma unroll
                        for (int kh = 0; kh < 2; ++kh)
#pragma unroll
                            for (int r = 0; r < 16; ++r) if (kbase + 32 * kh + crow16(r, hh) > qin) p[kh][r] = -INFINITY; }
                }
                float mx = p[0][0];
#pragma unroll
                for (int r = 1; r < 16; ++r) mx = fmaxf(mx, p[0][r]);
#pragma unroll
                for (int r = 0; r < 16; ++r) mx = fmaxf(mx, p[1][r]);
                { const auto rr = __builtin_amdgcn_permlane32_swap(__float_as_uint(mx), __float_as_uint(mx), false, false); mx = fmaxf(__uint_as_float(rr[0]), __uint_as_float(rr[1])); }
                if (!sel) mx = -INFINITY;
                const float m_new = fmaxf(m_run, mx), scl = __builtin_amdgcn_exp2f(m_run - m_new); m_run = m_new;
                float rs = 0.f;
#pragma unroll
                for (int kh = 0; kh < 2; ++kh)
#pragma unroll
                    for (int r = 0; r < 16; ++r) { p[kh][r] = __builtin_amdgcn_exp2f(p[kh][r] - m_new); rs += p[kh][r]; }
                l_run = l_run * scl + (sel ? rs : 0.f);
                if (__ballot(scl != 1.0f) != 0ull) {
#pragma unroll
                    for (int db = 0; db < 4; ++db)
#pragma unroll
                        for (int r = 0; r < 16; ++r) o[db][r] *= scl; }
                const unsigned pmask = sel ? 0xffffffffu : 0u;
                bf16x8 pb[4];
#pragma unroll
                for (int gi = 0; gi < 4; ++gi) { const int kh = gi >> 1, s2 = gi & 1; v4u pw;
                    pw.x = pg8::cvt_pk_bf16(p[kh][8 * s2], p[kh][8 * s2 + 1]) & pmask; pw.y = pg8::cvt_pk_bf16(p[kh][8 * s2 + 2], p[kh][8 * s2 + 3]) & pmask;
                    pw.z = pg8::cvt_pk_bf16(p[kh][8 * s2 + 4], p[kh][8 * s2 + 5]) & pmask; pw.w = pg8::cvt_pk_bf16(p[kh][8 * s2 + 6], p[kh][8 * s2 + 7]) & pmask;
                    pb[gi] = __builtin_bit_cast(bf16x8, pw); }
                v4i16_t lo[2][2], hi_[2][2];
                const int dsub = 16 * (G4 & 1) + 4 * (l16 & 3);
#define ATTN_VREADS(u, S) { const int key0_ = 32 * ((u) >> 2) + 16 * (((u) >> 1) & 1) + 4 * (G4 >> 1) + (l16 >> 2); _Pragma("unroll") for (int d2 = 0; d2 < 2; ++d2) { const int db = 2 * ((u) & 1) + d2; \
                    const unsigned a0_ = vimg + key0_ * 256 + ((db ^ (key0_ & 3)) << 6) + dsub * 2; \
                    asm volatile("ds_read_b64_tr_b16 %0, %1" : "=&v"(lo[S][d2]) : "v"(a0_) : "memory"); \
                    asm volatile("ds_read_b64_tr_b16 %0, %1 offset:2048" : "=&v"(hi_[S][d2]) : "v"(a0_) : "memory"); } }
#define ATTN_VWAIT(S, N) asm volatile("s_waitcnt lgkmcnt(" #N ")" : "+v"(lo[S][0]), "+v"(lo[S][1]), "+v"(hi_[S][0]), "+v"(hi_[S][1]) :: "memory")
#define ATTN_PV(u, S) { _Pragma("unroll") for (int d2 = 0; d2 < 2; ++d2) { const int db = 2 * ((u) & 1) + d2; const bf16x8 av = {lo[S][d2][0], lo[S][d2][1], lo[S][d2][2], lo[S][d2][3], hi_[S][d2][0], hi_[S][d2][1], hi_[S][d2][2], hi_[S][d2][3]}; \
                    o[db] = __builtin_amdgcn_mfma_f32_32x32x16_bf16(av, pb[(u) >> 1], o[db], 0, 0, 0); } }
                ATTN_VREADS(0, 0)
                ATTN_VREADS(1, 1) ATTN_VWAIT(0, 4); ATTN_PV(0, 0)
                ATTN_VREADS(2, 0) ATTN_VWAIT(1, 4); ATTN_PV(1, 1)
                ATTN_VREADS(3, 1) ATTN_VWAIT(0, 4); ATTN_PV(2, 0)
                ATTN_VREADS(4, 0) ATTN_VWAIT(1, 4); ATTN_PV(3, 1)
                ATTN_VREADS(5, 1) ATTN_VWAIT(0, 4); ATTN_PV(4, 0)
                ATTN_VREADS(6, 0) ATTN_VWAIT(1, 4); ATTN_PV(5, 1)
                ATTN_VREADS(7, 1) ATTN_VWAIT(0, 4); ATTN_PV(6, 0)
                ATTN_VWAIT(1, 0); ATTN_PV(7, 1)
#undef ATTN_VREADS
#undef ATTN_VWAIT
#undef ATTN_PV
            }
        } }
        l_run += __shfl_xor(l_run, 32);
        asm volatile("s_waitcnt vmcnt(0) lgkmcnt(0)" ::: "memory"); __builtin_amdgcn_s_barrier(); asm volatile("" ::: "memory");
        LAS float* xs = (LAS float*)lds + (size_t)wq * 66 * 64 + lane;
        if (kvh == 1) {
            xs[0] = m_run; xs[64] = l_run;
#pragma unroll
            for (int db = 0; db < 4; ++db)
#pragma unroll
                for (int r = 0; r < 16; ++r) xs[(2 + 16 * db + r) * 64] = o[db][r];
        }
        asm volatile("s_waitcnt lgkmcnt(0)" ::: "memory"); __builtin_amdgcn_s_barrier(); asm volatile("" ::: "memory");
        if (kvh == 0) {
            const float m2 = xs[0], l2 = xs[64], mt = fmaxf(m_run, m2), a1 = __builtin_amdgcn_exp2f(m_run - mt), a2 = __builtin_amdgcn_exp2f(m2 - mt);
            const float inv = 1.0f / (l_run * a1 + l2 * a2), c1 = a1 * inv, c2 = a2 * inv;
            bf16* orow = AO + rowq * 1024 + h * 128 + 4 * hh;
#pragma unroll
            for (int db = 0; db < 4; ++db)
#pragma unroll
                for (int g = 0; g < 4; ++g) {
                    float t[4];
#pragma unroll
                    for (int e = 0; e < 4; ++e) t[e] = o[db][4 * g + e] * c1 + xs[(2 + 16 * db + 4 * g + e) * 64] * c2;
                    u32x2v w; w.x = pg8::cvt_pk_bf16(t[0], t[1]); w.y = pg8::cvt_pk_bf16(t[2], t[3]);
                    *(GAS u32x2v*)(orow + 32 * db + 8 * g) = w;
                }
        }
    }
    asm volatile("s_waitcnt vmcnt(0) lgkmcnt(0)" ::: "memory"); __builtin_amdgcn_s_barrier(); asm volatile("" ::: "memory");
}
__device__ __forceinline__ void up8(const v4u w, float (&f)[8]) { f[0] = bflo(w.x); f[1] = bfhi(w.x); f[2] = bflo(w.y); f[3] = bfhi(w.y); f[4] = bflo(w.z); f[5] = bfhi(w.z); f[6] = bflo(w.w); f[7] = bfhi(w.w); }
__device__ __forceinline__ void conv_phase(const Ctx& F, const bf16* CB, const bf16* CC, const bf16* CX, const float* cw, bf16* UC) {
    const int gt = (F.vcu * NWAVES + F.wave) * 64 + F.lane, NT = F.G * NWAVES * 64;
    for (int idx = gt; idx < M * 128; idx += NT) {
        const int row = idx >> 7, c8 = (idx & 127) << 3, t = row & (SEQ - 1); const size_t off = (size_t)row * 1024 + c8;
        float cb[8], a[8], x[8], z0[8], z1[8], z2[8];
        up8(*(const GAS v4u*)(CB + off), cb); up8(*(const GAS v4u*)(CC + off), a); up8(*(const GAS v4u*)(CX + off), x);
#pragma unroll
        for (int j = 0; j < 8; ++j) z0[j] = a[j] * x[j];
        if (t >= 1) { up8(*(const GAS v4u*)(CC + off - 1024), a); up8(*(const GAS v4u*)(CX + off - 1024), x);
#pragma unroll
            for (int j = 0; j < 8; ++j) z1[j] = a[j] * x[j]; } else {
#pragma unroll
            for (int j = 0; j < 8; ++j) z1[j] = 0.f; }
        if (t >= 2) { up8(*(const GAS v4u*)(CC + off - 2048), a); up8(*(const GAS v4u*)(CX + off - 2048), x);
#pragma unroll
            for (int j = 0; j < 8; ++j) z2[j] = a[j] * x[j]; } else {
#pragma unroll
            for (int j = 0; j < 8; ++j) z2[j] = 0.f; }
        float o[8];
#pragma unroll
        for (int j = 0; j < 8; ++j) o[j] = cb[j] * (cw[c8 + j] * z2[j] + cw[1024 + c8 + j] * z1[j] + cw[2048 + c8 + j] * z0[j]);
        v4u w; w.x = pk2(o[0], o[1]); w.y = pk2(o[2], o[3]); w.z = pk2(o[4], o[5]); w.w = pk2(o[6], o[7]); *(GAS v4u*)(UC + off) = w;
    }
}

__device__ __forceinline__ int imax(int a, int b) { return a > b ? a : b; }
__device__ __forceinline__ int imin(int a, int b) { return a < b ? a : b; }
__device__ __forceinline__ void ce(int& a, int& b) { const int t = imax(a, b); b = imin(a, b); a = t; }
__device__ __forceinline__ void sort16(int (&x)[16]) {
#pragma unroll
    for (int kk = 1; kk <= 4; ++kk)
#pragma unroll
        for (int jj = kk - 1; jj >= 0; --jj)
#pragma unroll
            for (int i = 0; i < 16; ++i) { const int k = 1 << kk, j = 1 << jj, l = i ^ j; if (l > i) { if ((i & k) == 0) ce(x[i], x[l]); else ce(x[l], x[i]); } }
}
__device__ __forceinline__ void bmerge16(int (&a)[16]) {
#pragma unroll
    for (int jj = 3; jj >= 0; --jj)
#pragma unroll
        for (int i = 0; i < 16; ++i) { const int j = 1 << jj, l = i ^ j; if (l > i) ce(a[i], a[l]); }
}
__device__ __forceinline__ void merge16(int (&a)[16], const int (&b)[16]) {
#pragma unroll
    for (int i = 0; i < 16; ++i) a[i] = imax(a[i], b[15 - i]);
    bmerge16(a);
}
__device__ __forceinline__ void xmerge16(int (&a)[16], int hh) {
    int pv[16];
#pragma unroll
    for (int i = 0; i < 16; ++i) { const auto r = __builtin_amdgcn_permlane32_swap((unsigned)a[15 - i], (unsigned)a[15 - i], false, false); pv[i] = hh ? (int)r[0] : (int)r[1]; }
#pragma unroll
    for (int i = 0; i < 16; ++i) a[i] = imax(a[i], pv[i]);
    bmerge16(a);
}
__device__ __forceinline__ int ord_key(float f) { const int u = __float_as_int(f); return u >= 0 ? u : (u ^ 0x7fffffff); }
__device__ __forceinline__ float ord_val(int k) { return __int_as_float(k >= 0 ? k : (k ^ 0x7fffffff)); }
__device__ __forceinline__ unsigned byte16(const unsigned (&t)[4], int idx) {
    const unsigned sel = 0x0c0c0c00u | (unsigned)(idx & 7);
    const unsigned lo = __builtin_amdgcn_perm(t[1], t[0], sel), hi_ = __builtin_amdgcn_perm(t[3], t[2], sel);
    return (idx & 8) ? hi_ : lo;
}
__device__ __forceinline__ void topk_stage_keys(const Ctx& F, const bf16* KEYS, int h) {
    for (int pc = F.wave; pc < 64; pc += 8) { const int pp = pc >> 5, row = 4 * (pc & 31) + (F.lane >> 4), cp = F.lane & 15, c = cp ^ (row & 15);
        __builtin_amdgcn_global_load_lds((const unsigned*)(KEYS + (size_t)((h * 2 + pp) * 128 + row) * 128 + 8 * c), (LAS unsigned*)(F.lds + RING_OFF + pc * 1024), 16, 0, 0); }
    asm volatile("s_waitcnt vmcnt(0)" ::: "memory"); __builtin_amdgcn_s_barrier(); asm volatile("" ::: "memory");
}
__device__ __forceinline__ void topk_phase(const Ctx& F, int bitem, const bf16* QP, int* EXP, float* GATE) {
    const int lane = F.lane, l31 = lane & 31, hh = lane >> 5;
    const int IMIN = (int)0x80000000;
    const unsigned lds0 = (unsigned)(uintptr_t)(F.lds + RING_OFF);
    {
        const int h = bitem & 7, tt = (bitem >> 3) * 8 + F.wave, tok0 = tt * 32;
        int top[2][16];
#pragma unroll
        for (int p = 0; p < 2; ++p) {
            bf16x8 qa[8];
#pragma unroll
            for (int s = 0; s < 8; ++s) qa[s] = *(const GAS bf16x8*)(QP + (size_t)(tok0 + l31) * 2048 + h * 256 + p * 128 + 16 * s + 8 * hh);
            int x[2][16];
#pragma unroll
            for (int pq = 0; pq < 2; ++pq) {
                f32x16 sc[2];
#pragma unroll
                for (int nt = 0; nt < 2; ++nt)
#pragma unroll
                    for (int r = 0; r < 16; ++r) sc[nt][r] = 0.f;
#pragma unroll
                for (int s = 0; s < 8; ++s) {
#pragma unroll
                    for (int nt = 0; nt < 2; ++nt) { const int n = 64 * pq + 32 * nt + l31; const bf16x8 kb = *(const LAS bf16x8*)(uintptr_t)(lds0 + p * 32768 + n * 256 + (((2 * s + hh) ^ (n & 15)) << 4));
                        sc[nt] = __builtin_amdgcn_mfma_f32_32x32x16_bf16(kb, qa[s], sc[nt], 0, 0, 0); }
                }
                int y[16];
#pragma unroll
                for (int r = 0; r < 16; ++r) { x[pq][r] = (ord_key(sc[0][r]) & ~127) | ((127 - 64 * pq - (r & 3) - 8 * (r >> 2)) - 4 * hh); y[r] = (ord_key(sc[1][r]) & ~127) | ((127 - 64 * pq - 32 - (r & 3) - 8 * (r >> 2)) - 4 * hh); }
                sort16(x[pq]); sort16(y); merge16(x[pq], y);
                asm volatile("" ::: "memory");
            }
            merge16(x[0], x[1]);
            xmerge16(x[0], hh);
#pragma unroll
            for (int i = 0; i < 16; ++i) top[p][i] = x[0][i];
        }
        float fa[16], fb[16];
#pragma unroll
        for (int i = 0; i < 16; ++i) { const int A = hh ? top[1][i] : top[0][i], B = hh ? top[0][i] : top[1][i]; fa[i] = ord_val(A & ~127); fb[i] = ord_val(B & ~127); }
        int c0[16], c1[16];
#pragma unroll
        for (int q = 0; q < 32; ++q) {
            int key = IMIN;
            if (q < 27) { const int i = (q < 16) ? 0 : (q < 23) ? 1 : (q < 26) ? 2 : 3, j = (q < 16) ? q : (q < 23) ? q - 15 : (q < 26) ? q - 21 : 3; const float sv = fa[i] + fb[j]; const int low = hh ? (255 - (j * 16 + i)) : (255 - (i * 16 + j));
                key = (ord_key(sv) & ~255) | low; if (i == j && hh) key = IMIN; }
            if (q < 16) c0[q] = key; else c1[q - 16] = key;
        }
        sort16(c0); sort16(c1); merge16(c0, c1); xmerge16(c0, hh);
        unsigned na[4], nb[4];
#pragma unroll
        for (int d = 0; d < 4; ++d) { na[d] = 0u; nb[d] = 0u;
#pragma unroll
            for (int e = 0; e < 4; ++e) { na[d] |= (unsigned)(127 - (top[0][4 * d + e] & 127)) << (8 * e); nb[d] |= (unsigned)(127 - (top[1][4 * d + e] & 127)) << (8 * e); } }
        int ex[16]; float ev[16]; float es = 0.f; const float smax = ord_val(c0[0] & ~255);
#pragma unroll
        for (int q = 0; q < 16; ++q) { const int posn = 255 - (c0[q] & 255); const unsigned n1 = byte16(na, posn >> 4) & 255u, n2 = byte16(nb, posn & 15) & 255u;
            ex[q] = (int)(n1 * 128u + n2); ev[q] = __expf(ord_val(c0[q] & ~255) - smax); es += ev[q]; }
        const float ri = 1.0f / es; const size_t ob = (size_t)(tok0 + l31) * 128 + h * 16;
        if (hh == 0) {
#pragma unroll
            for (int d = 0; d < 4; ++d) { v4u w; w.x = (unsigned)ex[4 * d]; w.y = (unsigned)ex[4 * d + 1]; w.z = (unsigned)ex[4 * d + 2]; w.w = (unsigned)ex[4 * d + 3]; *(GAS v4u*)(EXP + ob + 4 * d) = w; }
        } else {
#pragma unroll
            for (int d = 0; d < 4; ++d) *(GAS f32x4*)(GATE + ob + 4 * d) = (f32x4){ev[4 * d] * ri, ev[4 * d + 1] * ri, ev[4 * d + 2] * ri, ev[4 * d + 3] * ri};
        }
    }
}

typedef float f32x2 __attribute__((ext_vector_type(2)));
constexpr float PEER_SU = 512.0f, PEER_SV = 32.0f;
template <int CTRL> __device__ __forceinline__ int dpp_i(int v) { return __builtin_amdgcn_update_dpp(v, v, CTRL, 0xf, 0xf, false); }
template <int J> __device__ __forceinline__ int xor_lane(int v, int lane) {
    if constexpr (J == 1) return dpp_i<0xB1>(v);
    else if constexpr (J == 2) return dpp_i<0x4E>(v);
    else if constexpr (J == 16) { const auto r = __builtin_amdgcn_permlane16_swap((unsigned)v, (unsigned)v, false, false); return ((lane >> 4) & 1) ? (int)r[0] : (int)r[1]; }
    else if constexpr (J == 32) { const auto r = __builtin_amdgcn_permlane32_swap((unsigned)v, (unsigned)v, false, false); return (lane >> 5) ? (int)r[0] : (int)r[1]; }
    else return __shfl_xor(v, J);
}
__device__ __forceinline__ float wave_sum_dpp(float v) {
    v += __int_as_float(dpp_i<0xB1>(__float_as_int(v))); v += __int_as_float(dpp_i<0x4E>(__float_as_int(v))); v += __int_as_float(dpp_i<0x141>(__float_as_int(v))); v += __int_as_float(dpp_i<0x140>(__float_as_int(v)));
    { const auto r = __builtin_amdgcn_permlane16_swap(__float_as_uint(v), __float_as_uint(v), false, false); v = __uint_as_float(r[0]) + __uint_as_float(r[1]); }
    { const auto r = __builtin_amdgcn_permlane32_swap(__float_as_uint(v), __float_as_uint(v), false, false); v = __uint_as_float(r[0]) + __uint_as_float(r[1]); }
    return v; }
template <int KK, int JJ> __device__ __forceinline__ void sort512_step(int (&x)[8], int lane) {
    constexpr int k = 1 << KK, j = 1 << JJ;
    if constexpr (j >= 64) { constexpr int jr = j >> 6;
#pragma unroll
        for (int r = 0; r < 8; ++r) if ((r & jr) == 0) { const bool asc = (k >= 512) ? true : (((r << 6) & k) == 0); const int lo = imin(x[r], x[r | jr]), hi_ = imax(x[r], x[r | jr]); x[r] = asc ? lo : hi_; x[r | jr] = asc ? hi_ : lo; }
    } else {
        const bool lower = (lane & j) == 0;
#pragma unroll
        for (int r = 0; r < 8; ++r) { const int y = xor_lane<j>(x[r], lane);
            const bool asc = (k < 64) ? ((lane & k) == 0) : ((k >= 512) ? true : (((r << 6) & k) == 0));
            x[r] = (lower == asc) ? imin(x[r], y) : imax(x[r], y); }
    }
}
template <int KK, int JJ> __device__ __forceinline__ void sort512_stage(int (&x)[8], int lane) { sort512_step<KK, JJ>(x, lane); if constexpr (JJ > 0) sort512_stage<KK, JJ - 1>(x, lane); }
__device__ __forceinline__ void sort512(int (&x)[8], int lane) {
    sort512_stage<1, 0>(x, lane); sort512_stage<2, 1>(x, lane); sort512_stage<3, 2>(x, lane); sort512_stage<4, 3>(x, lane); sort512_stage<5, 4>(x, lane);
    sort512_stage<6, 5>(x, lane); sort512_stage<7, 6>(x, lane); sort512_stage<8, 7>(x, lane); sort512_stage<9, 8>(x, lane);
}
__device__ __forceinline__ void peer_phase(const Ctx& F, const unsigned char* U8, const unsigned char* V8, const bf16* X1B, const int* EXP, const float* GATE, const unsigned long long* SS, const float* gfin, const float* X1, float* OUT) {
    const int gw = F.vcu * NWAVES + F.wave, NGW = F.G * NWAVES, lane = F.lane;
    const unsigned xs0 = (unsigned)(uintptr_t)(F.lds + RING_OFF + F.wave * 16384) + lane * 16;
    for (int tb = gw; tb + 3 * NGW < M; tb += 4 * NGW) {
        int kreg[8]; float greg[8], rv[4];
#pragma unroll
        for (int j = 0; j < 4; ++j) { const size_t t = (size_t)tb + (size_t)j * NGW;
            kreg[2 * j] = (EXP[t * 128 + lane] << 9) | (j << 7) | lane; kreg[2 * j + 1] = (EXP[t * 128 + 64 + lane] << 9) | (j << 7) | (64 + lane);
            rv[j] = pg8::rinv_from_ss(SS[t]) * (1.0f / PEER_SU);
#pragma unroll
            for (int q = 0; q < 4; ++q) { const v4u w = *(const GAS v4u*)(X1B + t * DM + (q >> 1) * 1024 + lane * 16 + 8 * (q & 1)); *(LAS v4u*)(uintptr_t)(xs0 + j * 4096 + q * 1024) = w; } }
        sort512(kreg, lane);
        int pkey[8];
#pragma unroll
        for (int c = 0; c < 8; ++c) { pkey[c] = __shfl(kreg[c], 8 * (lane & 7) + (lane >> 3)); greg[c] = GATE[((size_t)tb + (size_t)((pkey[c] >> 7) & 3) * NGW) * 128 + (pkey[c] & 127)]; }
        asm volatile("s_waitcnt lgkmcnt(0)" ::: "memory");
        float actreg[8];
#ifndef MK_P8_REPU
#define MK_P8_REPU 1
#endif
#pragma unroll 1
        for (int repu = 0; repu < MK_P8_REPU; ++repu) {
            v4u ub[8][2];
#pragma unroll
            for (int u = 0; u < 8; ++u) { const GAS v4u* up = (const GAS v4u*)(U8 + (size_t)(__builtin_amdgcn_readlane(kreg[0], u) >> 9) * 2048) + lane; ub[u][0] = up[0]; ub[u][1] = up[64]; }
#pragma unroll
            for (int c = 0; c < 8; ++c) {
                float areg = 0.f;
#pragma unroll 1
                for (int g = 0; g < 8; ++g) {
                    float pt[8];
#pragma unroll
                    for (int u = 0; u < 8; ++u) {
                        const int key = __builtin_amdgcn_readlane(kreg[c], 8 * g + u);
                        const unsigned xa = xs0 + ((key >> 7) & 3) * 4096;
                        float p0 = 0.f, p1 = 0.f;
#pragma unroll
                        for (int i = 0; i < 2; ++i) { const v4u w = ub[u][i];
#pragma unroll
                            for (int hv = 0; hv < 2; ++hv) { const v4u xq = *(const LAS v4u*)(uintptr_t)(xa + (2 * i + hv) * 1024);
                                const unsigned w0 = hv ? w.z : w.x, w1 = hv ? w.w : w.y;
                                const f32x2 a0 = __builtin_amdgcn_cvt_pk_f32_fp8((int)w0, false), a1 = __builtin_amdgcn_cvt_pk_f32_fp8((int)w0, true), a2 = __builtin_amdgcn_cvt_pk_f32_fp8((int)w1, false), a3 = __builtin_amdgcn_cvt_pk_f32_fp8((int)w1, true);
                                p0 = dot2bf(pg8::cvt_pk_bf16(a0[0], a0[1]), xq.x, p0); p1 = dot2bf(pg8::cvt_pk_bf16(a1[0], a1[1]), xq.y, p1);
                                p0 = dot2bf(pg8::cvt_pk_bf16(a2[0], a2[1]), xq.z, p0); p1 = dot2bf(pg8::cvt_pk_bf16(a3[0], a3[1]), xq.w, p1); } }
                        pt[u] = p0 + p1;
                        { const int ix = 8 * g + 8 + u, ka = __builtin_amdgcn_readlane(kreg[c], ix & 63), kb = __builtin_amdgcn_readlane(kreg[c < 7 ? c + 1 : 7], ix & 63), kn = (ix < 64) ? ka : kb;
                            const GAS v4u* up = (const GAS v4u*)(U8 + (size_t)(kn >> 9) * 2048) + lane; ub[u][0] = up[0]; ub[u][1] = up[64]; }
                    }
                    { const bool b5 = (lane & 32) != 0, b4 = (lane & 16) != 0, b3 = (lane & 8) != 0;
#pragma unroll
                      for (int i = 0; i < 4; ++i) { const float a = pt[i], b = pt[i + 4]; pt[i] = (b5 ? b : a) + __int_as_float(xor_lane<32>(__float_as_int(b5 ? a : b), lane)); }
#pragma unroll
                      for (int i = 0; i < 2; ++i) { const float a = pt[i], b = pt[i + 2]; pt[i] = (b4 ? b : a) + __int_as_float(xor_lane<16>(__float_as_int(b4 ? a : b), lane)); }
                      { const float a = pt[0], b = pt[1]; pt[0] = (b3 ? b : a) + __shfl_xor(b3 ? a : b, 8); }
                      float r = pt[0]; r += __shfl_xor(r, 4); r += __int_as_float(dpp_i<0x4E>(__float_as_int(r))); r += __int_as_float(dpp_i<0xB1>(__float_as_int(r)));
                      areg = ((lane & 7) == g) ? r : areg; }
                }
                const int tk = (pkey[c] >> 7) & 3; const float rr = (tk == 0) ? rv[0] : (tk == 1) ? rv[1] : (tk == 2) ? rv[2] : rv[3];
                actreg[c] = gelu_tanh(areg * rr) * greg[c] * (1.0f / PEER_SV);
            }
        }
        LAS float* as = (LAS float*)(uintptr_t)(xs0 - lane * 16);
        asm volatile("s_waitcnt lgkmcnt(0)" ::: "memory");
#pragma unroll
        for (int c = 0; c < 8; ++c) as[64 * c + lane] = actreg[c];
        int k2[8];
#pragma unroll
        for (int c = 0; c < 8; ++c) { const int key = kreg[c], tok = (key >> 7) & 3, park = 64 * c + 8 * (lane & 7) + (lane >> 3);
            k2[c] = ((tok >> 1) << 24) | ((key >> 9) << 10) | ((tok & 1) << 9) | park; }
        sort512(k2, lane);
        asm volatile("s_waitcnt lgkmcnt(0)" ::: "memory");
        float a2[8];
#pragma unroll
        for (int c = 0; c < 8; ++c) a2[c] = as[k2[c] & 511];
#pragma unroll 1
        for (int pp = 0; pp < 2; ++pp) {
            int kq[4]; float aq[4];
#pragma unroll
            for (int c = 0; c < 4; ++c) { kq[c] = pp ? k2[4 + c] : k2[c]; aq[c] = pp ? a2[4 + c] : a2[c]; }
            f32x2 y[2][16];
#pragma unroll
            for (int j = 0; j < 2; ++j)
#pragma unroll
                for (int q = 0; q < 16; ++q) y[j][q] = (f32x2){0.f, 0.f};
            v4u vb[8][2];
#pragma unroll
            for (int u = 0; u < 8; ++u) { const GAS v4u* vp = (const GAS v4u*)(V8 + (size_t)((__builtin_amdgcn_readlane(kq[0], u) >> 10) & 0x3fff) * 2048) + lane; vb[u][0] = vp[0]; vb[u][1] = vp[64]; }
#pragma unroll
            for (int c = 0; c < 4; ++c) {
#pragma unroll 1
                for (int g = 0; g < 8; ++g) {
#pragma unroll
                    for (int u = 0; u < 8; ++u) {
                        const int key = __builtin_amdgcn_readlane(kq[c], 8 * g + u); const float s = rdlane(aq[c], 8 * g + u);
                        const float sa = (key & 512) ? 0.f : s, sb = (key & 512) ? s : 0.f; const f32x2 s0 = {sa, sa}, s1 = {sb, sb};
#pragma unroll
                        for (int i = 0; i < 2; ++i) { const v4u w = vb[u][i];
                            const f32x2 c0 = __builtin_amdgcn_cvt_pk_f32_fp8((int)w.x, false), c1 = __builtin_amdgcn_cvt_pk_f32_fp8((int)w.x, true), c2 = __builtin_amdgcn_cvt_pk_f32_fp8((int)w.y, false), c3 = __builtin_amdgcn_cvt_pk_f32_fp8((int)w.y, true);
                            const f32x2 c4 = __builtin_amdgcn_cvt_pk_f32_fp8((int)w.z, false), c5 = __builtin_amdgcn_cvt_pk_f32_fp8((int)w.z, true), c6 = __builtin_amdgcn_cvt_pk_f32_fp8((int)w.w, false), c7 = __builtin_amdgcn_cvt_pk_f32_fp8((int)w.w, true);
                            y[0][8 * i + 0] = __builtin_elementwise_fma(c0, s0, y[0][8 * i + 0]); y[1][8 * i + 0] = __builtin_elementwise_fma(c0, s1, y[1][8 * i + 0]);
                            y[0][8 * i + 1] = __builtin_elementwise_fma(c1, s0, y[0][8 * i + 1]); y[1][8 * i + 1] = __builtin_elementwise_fma(c1, s1, y[1][8 * i + 1]);
                            y[0][8 * i + 2] = __builtin_elementwise_fma(c2, s0, y[0][8 * i + 2]); y[1][8 * i + 2] = __builtin_elementwise_fma(c2, s1, y[1][8 * i + 2]);
                            y[0][8 * i + 3] = __builtin_elementwise_fma(c3, s0, y[0][8 * i + 3]); y[1][8 * i + 3] = __builtin_elementwise_fma(c3, s1, y[1][8 * i + 3]);
                            y[0][8 * i + 4] = __builtin_elementwise_fma(c4, s0, y[0][8 * i + 4]); y[1][8 * i + 4] = __builtin_elementwise_fma(c4, s1, y[1][8 * i + 4]);
                            y[0][8 * i + 5] = __builtin_elementwise_fma(c5, s0, y[0][8 * i + 5]); y[1][8 * i + 5] = __builtin_elementwise_fma(c5, s1, y[1][8 * i + 5]);
                            y[0][8 * i + 6] = __builtin_elementwise_fma(c6, s0, y[0][8 * i + 6]); y[1][8 * i + 6] = __builtin_elementwise_fma(c6, s1, y[1][8 * i + 6]);
                            y[0][8 * i + 7] = __builtin_elementwise_fma(c7, s0, y[0][8 * i + 7]); y[1][8 * i + 7] = __builtin_elementwise_fma(c7, s1, y[1][8 * i + 7]); }
                        { const int ix = 8 * g + 8 + u, ka = __builtin_amdgcn_readlane(kq[c], ix & 63), kb = __builtin_amdgcn_readlane(kq[c < 3 ? c + 1 : 3], ix & 63), kn = (ix < 64) ? ka : kb;
                            const GAS v4u* vp = (const GAS v4u*)(V8 + (size_t)((kn >> 10) & 0x3fff) * 2048) + lane; vb[u][0] = vp[0]; vb[u][1] = vp[64]; }
                    }
                }
            }
#pragma unroll
            for (int j = 0; j < 2; ++j) { const size_t t = (size_t)tb + (size_t)(2 * pp + j) * NGW;
                GAS f32x4* orw = (GAS f32x4*)(OUT + t * DM); float ss = 0.f;
#pragma unroll
                for (int i = 0; i < 2; ++i)
#pragma unroll
                    for (int hv = 0; hv < 2; ++hv) { const v4u w = *(const GAS v4u*)(X1B + t * DM + i * 1024 + lane * 16 + 8 * hv);
                        y[j][8 * i + 4 * hv + 0] += (f32x2){bflo(w.x), bfhi(w.x)}; y[j][8 * i + 4 * hv + 1] += (f32x2){bflo(w.y), bfhi(w.y)}; y[j][8 * i + 4 * hv + 2] += (f32x2){bflo(w.z), bfhi(w.z)}; y[j][8 * i + 4 * hv + 3] += (f32x2){bflo(w.w), bfhi(w.w)}; }
#pragma unroll
                for (int q = 0; q < 16; ++q) ss += y[j][q][0] * y[j][q][0] + y[j][q][1] * y[j][q][1];
                const float r3 = 1.0f / sqrtf(wave_sum_dpp(ss) * (1.0f / DM) + RMS_EPS);
#pragma unroll
                for (int i = 0; i < 2; ++i)
#pragma unroll
                    for (int q = 0; q < 4; ++q) { const f32x4 ga = *(const GAS f32x4*)(gfin + i * 1024 + lane * 16 + 4 * q);
                        orw[i * 256 + 4 * lane + q] = (f32x4){y[j][8 * i + 2 * q][0] * r3 * ga[0], y[j][8 * i + 2 * q][1] * r3 * ga[1], y[j][8 * i + 2 * q + 1][0] * r3 * ga[2], y[j][8 * i + 2 * q + 1][1] * r3 * ga[3]}; }
            }
        }
        asm volatile("s_waitcnt lgkmcnt(0)" ::: "memory");
    }
}

struct Args { const float* in[15]; float* out; unsigned char* ws; double invf[16]; int ph_lo, ph_hi, li, pad; };
__global__ void __launch_bounds__(NWAVES * 64, 2) mk_fwd(Args args) {
    extern __shared__ __attribute__((aligned(16))) unsigned char lds[];
    Ctx F;
    F.lds = (LAS unsigned char*)lds;
    volatile LAS unsigned* MISC = (volatile LAS unsigned*)(F.lds + MISC_OFF);
    F.tid = threadIdx.x; F.lane = F.tid & 63; F.wave = __builtin_amdgcn_readfirstlane(F.tid >> 6);
    F.G = gridDim.x; { const int bx = blockIdx.x; F.vcu = (F.G % 8 == 0) ? (bx % 8) * (F.G / 8) + bx / 8 : bx; }
    unsigned char* ws = args.ws;
    gu32* ctl = (gu32*)(ws + WS_CTL);
    for (int u = F.tid; u < (LDS_BYTES - LDSCTL_OFF) / 4; u += NWAVES * 64) ((LAS unsigned*)(F.lds + LDSCTL_OFF))[u] = 0u;
    __syncthreads();
    XcdBarrier bar; bar.bar = (unsigned*)(ctl + CW_BAR); bar.x = 0; bar.st = nullptr;
    if (N_LAUNCHES != PER_PHASE) bar = xcd_barrier_post((unsigned*)(ctl + CW_BAR), MISC + 8);
#define GRID_BAR() do { if (N_LAUNCHES != PER_PHASE) xcd_barrier(bar); } while (0)
#define GRID_BAR_W(q) do { if (N_LAUNCHES != PER_PHASE) { const BarWork wk_{args.in[12], args.in[13], args.in[9], ws, (q), 4}; xcd_barrier(bar, &F, &wk_); } } while (0)
    const int lo = args.ph_lo, hi = args.ph_hi;
#define IN(k) (lo <= (k) && (k) < hi)
#define BOTH(k) (IN(k) && IN((k) + 1))
    bf16* WinT = (bf16*)(ws + WS_WIN); bf16* WbcT = (bf16*)(ws + WS_WBC); bf16* WbaT = (bf16*)(ws + WS_WBA); bf16* WoutT = (bf16*)(ws + WS_WOUT); bf16* WpqT = (bf16*)(ws + WS_WPQ);
    bf16* KEYS = (bf16*)(ws + WS_KEYS); float* CS = (float*)(ws + WS_CS); const unsigned char* UB = ws + WS_UB; const unsigned char* VB = ws + WS_VB;
    bf16* XB = (bf16*)(ws + WS_XB); bf16* T6 = (bf16*)(ws + WS_T6); bf16* GAB = (bf16*)(ws + WS_GAB); bf16* UC = (bf16*)(ws + WS_UC); bf16* AO = (bf16*)(ws + WS_AO);
    bf16* TMP = (bf16*)(ws + WS_TMP); bf16* MB = (bf16*)(ws + WS_MB); bf16* X1B = (bf16*)(ws + WS_X1B); bf16* QP = (bf16*)(ws + WS_QP);
    int* EXP = (int*)(ws + WS_EXP); float* GATE = (float*)(ws + WS_GATE);
    unsigned long long* SS = (unsigned long long*)(ws + WS_SS); float* KSUM = (float*)(ws + WS_KSUM);
    constexpr size_t TS = (size_t)M * 1024;

    if (IN(0)) { for (int rep = 0; rep < NREP(0); ++rep) { p0_prologue(F, args.in, ws, args.invf); if (rep + 1 < NREP(0)) GRID_BAR(); } if (BOTH(0)) GRID_BAR(); }
    if (IN(1)) {
        for (int rep = 0; rep < NREP(1); ++rep) {
        pg8::Gemm g{XB, WinT, M, INW, DM}; pg8::StaticOrder S; S.init(M, INW, F.G, (int)blockIdx.x);
        pg8::EpiIn E{T6, GAB, args.in[4], CS, KSUM};
        pg8::gemm_phase<pg8::EpiIn, pg8::StaticOrder, true, true>(F.lds + RING_OFF, g, S, E);
        if (rep + 1 < NREP(1)) GRID_BAR(); }
        if (BOTH(1)) GRID_BAR();
    }
    if (IN(2)) {
        for (int rep = 0; rep < NREP(2); ++rep) {
        attn_mfma(F, T6 + 3 * TS, T6 + 4 * TS, T6 + 5 * TS, KSUM, AO);
        conv_phase(F, T6, T6 + TS, T6 + 2 * TS, args.in[5], UC);
        if (rep + 1 < NREP(2)) GRID_BAR(); }
        if (BOTH(2)) GRID_BAR_W(0);
    }
    if (IN(3)) {
        for (int rep = 0; rep < NREP(3); ++rep) {
        pg8::Gemm g{UC, WbcT, M, DM, 1024, AO, WbaT}; pg8::TwoSegOrder S; S.init(M, DM, F.G, (int)blockIdx.x);
        pg8::EpiMerge2 E{GAB, GAB + (size_t)M * DM, MB};
        pg8::gemm_phase<pg8::EpiMerge2, pg8::TwoSegOrder, true, true>(F.lds + RING_OFF, g, S, E);
        if (rep + 1 < NREP(3)) GRID_BAR(); }
        if (BOTH(3)) GRID_BAR_W(1);
    }
    if (IN(5)) {
        for (int rep = 0; rep < NREP(5); ++rep) {
        pg8::Gemm g{MB, WoutT, M, DM, DM}; pg8::StaticOrder S; S.init(M, DM, F.G, (int)blockIdx.x);
        pg8::EpiX1 E{args.in[0], args.out, X1B, (rep + 1 < NREP(5)) ? (unsigned long long*)(ws + 768 * 1024) : SS};
        pg8::gemm_phase<pg8::EpiX1, pg8::StaticOrder, true, true>(F.lds + RING_OFF, g, S, E);
        if (rep + 1 < NREP(5)) GRID_BAR(); }
        if (BOTH(5)) GRID_BAR_W(2);
    }
    if (IN(6)) {
        for (int rep = 0; rep < NREP(6); ++rep) {
        pg8::Gemm g{X1B, WpqT, M, DM, DM}; pg8::StaticOrder S; S.init(M, DM, F.G, (int)blockIdx.x);
        pg8::EpiQP E{SS, QP};
        pg8::gemm_phase<pg8::EpiQP, pg8::StaticOrder, true, true>(F.lds + RING_OFF, g, S, E);
        if (rep + 1 < NREP(6)) GRID_BAR(); }
        if (BOTH(6)) GRID_BAR_W(3);
    }
    if (IN(7)) { for (int rep = 0; rep < NREP(7); ++rep) {
        for (int bitem = F.vcu; bitem < 256; bitem += F.G) {
            topk_stage_keys(F, KEYS, bitem & 7);
            if (N_LAUNCHES == PER_PHASE && bitem == F.vcu) convert_tables(F, args.in[12], args.in[13], args.in[9], ws, 0, 1, 0);
            topk_phase(F, bitem, QP, EXP, GATE);
            asm volatile("s_waitcnt lgkmcnt(0)" ::: "memory"); __builtin_amdgcn_s_barrier(); asm volatile("" ::: "memory");
        }
        if (rep + 1 < NREP(7)) GRID_BAR(); } if (BOTH(7)) GRID_BAR(); }
    if (IN(8)) { for (int rep = 0; rep < NREP(8); ++rep) { peer_phase(F, UB, VB, X1B, EXP, GATE, SS, args.in[14], args.out, (rep + 1 < NREP(8)) ? (float*)(ws + WS_END) : args.out); if (rep + 1 < NREP(8)) GRID_BAR(); } }
#undef IN
#undef BOTH
#undef GRID_BAR
#undef GRID_BAR_W
}

extern "C" void kernel_launch(void* const* d_in, const int* in_sizes, int n_in, void* d_out, int out_size, void* d_ws, size_t ws_size, hipStream_t stream) {
    static int grid = 0;
    if (grid == 0) {
        if (n_in != 15 || in_sizes[0] != M * DM || out_size != M * DM || ws_size < WS_END) { fprintf(stderr, "kernel_launch: unexpected shapes (n_in %d, in0 %d, out %d, ws %zu)\n", n_in, n_in > 0 ? in_sizes[0] : -1, out_size, ws_size); grid = -1; return; }
        int dev = 0, cus = 0, per_cu = 0;
        if (hipGetDevice(&dev) != hipSuccess || hipDeviceGetAttribute(&cus, hipDeviceAttributeMultiprocessorCount, dev) != hipSuccess) { grid = -1; return; }
        if (hipFuncSetAttribute((const void*)mk_fwd, hipFuncAttributeMaxDynamicSharedMemorySize, LDS_BYTES) != hipSuccess) { fprintf(stderr, "kernel_launch: hipFuncSetAttribute failed\n"); grid = -1; return; }
        if (hipOccupancyMaxActiveBlocksPerMultiprocessor(&per_cu, (const void*)mk_fwd, NWAVES * 64, LDS_BYTES) != hipSuccess || per_cu < 1) fprintf(stderr, "kernel_launch: occupancy query reports %d\n", per_cu);
        (void)hipGetLastError();
        grid = cus;
        if (M % (4 * grid * NWAVES) != 0) { fprintf(stderr, "kernel_launch: the PEER phase needs M %% (32 * grid) == 0 (grid %d)\n", grid); grid = -1; return; }
    }
    if (grid < 0) return;
    if (hipMemsetAsync((char*)d_ws + WS_CTL, 0, CTL_ZERO_BYTES, stream) != hipSuccess) { fprintf(stderr, "kernel_launch: memset failed\n"); return; }
    Args a{};
    for (int i = 0; i < 15; ++i) a.in[i] = (const float*)d_in[i];
    a.out = (float*)d_out; a.ws = (unsigned char*)d_ws;
    for (int f = 0; f < 16; ++f) a.invf[f] = pow(500000.0, -(double)(2 * f) / 32.0);
    for (int li = 0; li < N_LAUNCHES; ++li) {
        a.ph_lo = (N_LAUNCHES == PER_PHASE) ? li : 0; a.ph_hi = (N_LAUNCHES == PER_PHASE) ? li + 1 : PER_PHASE; a.li = li;
        hipLaunchKernelGGL(mk_fwd, dim3(grid), dim3(NWAVES * 64), LDS_BYTES, stream, a);
        const hipError_t le = hipPeekAtLastError();
        if (le != hipSuccess) { fprintf(stderr, "kernel_launch: launch %d failed: %s\n", li, hipGetErrorName(le)); break; }
    }
}
```

```cpp
#include <hip/hip_runtime.h>
#include <cstdio>
#include <cstdint>
#include <cmath>
namespace pg8 {
#define PG8_LAS __attribute__((address_space(3)))
typedef unsigned short bf16_t;
typedef short bf16x8 __attribute__((ext_vector_type(8)));
typedef float f32x4 __attribute__((ext_vector_type(4)));
typedef unsigned u32x4 __attribute__((ext_vector_type(4)));
constexpr int BM = 256, BK = 64, HALF = 128, HTB = HALF * BK * 2  , STAGE_BYTES = 8 * HTB, NXCD = 8, WGM = 8;

__host__ __device__ __forceinline__ int lds_byte(int r, int c) { const int st = (r >> 4) * 2 + (c >> 5), rr = r & 15, cc = c & 31, ob = rr * 64 + cc * 2; return st * 1024 + (ob ^ (((ob >> 9) & 1) << 5)); }
__host__ __device__ __forceinline__ void stage_rc(int b, int& R, int& C) { const int st = b / 1024, sb = b % 1024, swz = sb ^ (((sb >> 9) & 1) << 5); R = (st >> 1) * 16 + swz / 64; C = (st & 1) * 32 + (swz % 64) / 2; }
__host__ __device__ __forceinline__ int perm32(int rho) { const int n = rho >> 4, i = rho & 15; return 8 * (i >> 2) + 4 * n + (i & 3); }

struct Unit { int pm, pn, seg; };
struct Gemm { const bf16_t* A; const bf16_t* Bt; int M, N, K; const bf16_t* A2; const bf16_t* Bt2; };

struct StaticOrder {
    int nM, nN, nwg, G, c;
    __host__ __device__ void init(int M, int N, int G_, int c_) { nM = M / BM; nN = N / BM; nwg = nM * nN; G = G_; c = c_; }
    __host__ __device__ bool next(int i, Unit& u) const {
        const long L = (long)i * G + c; if (L >= nwg) return false;
        int wgid = (int)L; { const int q = nwg / NXCD, r = nwg % NXCD, xcd = wgid % NXCD, off = wgid / NXCD; wgid = (xcd < r ? xcd * (q + 1) : r * (q + 1) + (xcd - r) * q) + off; }
        const int nig = WGM * nN, gid = wgid / nig, fm = gid * WGM, gsz = (nM - fm) < WGM ? (nM - fm) : WGM;
        u.pm = fm + ((wgid % nig) % gsz); u.pn = (wgid % nig) / gsz; u.seg = 0; return true;
    }
    __device__ __forceinline__ void a_ready(const Unit&) const {}
    __device__ __forceinline__ void done(const Unit&) const {}
};
struct TwoSegOrder {
    StaticOrder so;
    __host__ __device__ void init(int M, int N, int G_, int c_) { so.init(M, N, G_, c_); }
    __host__ __device__ bool next(int i, Unit& u) const { if (!so.next(i >> 1, u)) return false; u.seg = i & 1; return true; }
    __device__ __forceinline__ void a_ready(const Unit&) const {}
    __device__ __forceinline__ void done(const Unit&) const {}
};


typedef float f32x2c __attribute__((ext_vector_type(2))); typedef __bf16 bf16x2c __attribute__((ext_vector_type(2)));
__device__ __forceinline__ unsigned cvt_pk_bf16(float lo, float hi) { const f32x2c v = {lo, hi}; const bf16x2c b = __builtin_convertvector(v, bf16x2c); return __builtin_bit_cast(unsigned, b); }
__device__ __forceinline__ u32x4 pack8(f32x4 a, f32x4 b) { u32x4 w; w.x = cvt_pk_bf16(a[0], a[1]); w.y = cvt_pk_bf16(a[2], a[3]); w.z = cvt_pk_bf16(b[0], b[1]); w.w = cvt_pk_bf16(b[2], b[3]); return w; }
__device__ __forceinline__ f32x4 shx(f32x4 v, int o) { f32x4 r; r[0] = __shfl_xor(v[0], o); r[1] = __shfl_xor(v[1], o); r[2] = __shfl_xor(v[2], o); r[3] = __shfl_xor(v[3], o); return r; }
__device__ __forceinline__ f32x4 bf4lo(unsigned a, unsigned b) { f32x4 r; r[0] = __uint_as_float(a << 16); r[1] = __uint_as_float(a & 0xffff0000u); r[2] = __uint_as_float(b << 16); r[3] = __uint_as_float(b & 0xffff0000u); return r; }
__device__ __forceinline__ f32x4 sigm4(f32x4 v) { f32x4 r;
#pragma unroll
    for (int i = 0; i < 4; ++i) r[i] = __builtin_amdgcn_rcpf(1.0f + __expf(-v[i])); return r; }
constexpr float QSCALE = 0.08838834764831845f * 1.4426950408889634f;

struct EpiIn {
    static constexpr bool PERM = true, AFTER_DRAIN = false, KEEP_SEG0 = false;
    bf16_t* T6; bf16_t* GAB; const float* gbias; const float* cs; float* ksum;
    __device__ __forceinline__ void operator()(const f32x4 (&acc)[2][2][4][2], const Unit& u, int wr, int wc, int fr, int fq) const {
        const int row0 = u.pm * BM + wr * 64 + fr, pn = u.pn, colw = wc * 32 + 8 * fq;
        if (pn < 24) {
            const int t = pn >> 2;
            bf16_t* base = T6 + (size_t)t * ((size_t)8192 * 1024) + (pn & 3) * 256 + colw;
            const bool rot = (t == 3 || t == 4) && (wc == 0), isk = (t == 4);
            const float qs = (t == 3) ? QSCALE : 1.0f;
            f32x4 ks[2][2];
#pragma unroll
            for (int bj = 0; bj < 2; ++bj) { ks[bj][0] = (f32x4){0.f, 0.f, 0.f, 0.f}; ks[bj][1] = (f32x4){0.f, 0.f, 0.f, 0.f}; }
#pragma unroll
            for (int ai = 0; ai < 2; ++ai)
#pragma unroll
                for (int m = 0; m < 4; ++m) {
                    const int row = row0 + ai * HALF + m * 16;
                    f32x4 c0 = (f32x4){1.f, 1.f, 1.f, 1.f}, c1 = c0, s0 = (f32x4){0.f, 0.f, 0.f, 0.f}, s1 = s0;
                    if (rot) { const float* cp = cs + (size_t)row * 32 + 8 * (fq & 1); c0 = *(const f32x4*)cp; c1 = *(const f32x4*)(cp + 4); s0 = *(const f32x4*)(cp + 16); s1 = *(const f32x4*)(cp + 20);
                        if (fq < 2) { s0 = -s0; s1 = -s1; } }
#pragma unroll
                    for (int bj = 0; bj < 2; ++bj) {
                        f32x4 v0 = acc[ai][bj][m][0], v1 = acc[ai][bj][m][1];
                        if (rot) { const f32x4 p0 = shx(v0, 32), p1 = shx(v1, 32); v0 = v0 * c0 + p0 * s0; v1 = v1 * c1 + p1 * s1; }
                        if (isk) { ks[bj][0] += v0; ks[bj][1] += v1; }
                        v0 = v0 * qs; v1 = v1 * qs;
                        *(u32x4*)(base + (size_t)row * 1024 + bj * HALF) = pack8(v0, v1);
                    }
                }
            if (isk) {
#pragma unroll
                for (int bj = 0; bj < 2; ++bj)
#pragma unroll
                    for (int n = 0; n < 2; ++n) { f32x4 v = ks[bj][n]; v += shx(v, 1); v += shx(v, 2); v += shx(v, 4); v += shx(v, 8);
                        if (fr == 0) { float* kp = ksum + (size_t)u.pm * 1024 + (pn & 3) * 256 + bj * HALF + colw + 4 * n;
                            unsafeAtomicAdd(kp + 0, v[0]); unsafeAtomicAdd(kp + 1, v[1]); unsafeAtomicAdd(kp + 2, v[2]); unsafeAtomicAdd(kp + 3, v[3]); } }
            }
        } else {
            const int t = (pn - 24) >> 3, colg = ((pn - 24) & 7) * 256 + colw;
            bf16_t* base = GAB + (size_t)t * ((size_t)8192 * 2048) + colg;
            const float* bp = gbias + t * 2048 + colg;
            f32x4 bv[2][2];
#pragma unroll
            for (int bj = 0; bj < 2; ++bj) { bv[bj][0] = *(const f32x4*)(bp + bj * HALF); bv[bj][1] = *(const f32x4*)(bp + bj * HALF + 4); }
#pragma unroll
            for (int ai = 0; ai < 2; ++ai)
#pragma unroll
                for (int m = 0; m < 4; ++m) { const int row = row0 + ai * HALF + m * 16;
#pragma unroll
                    for (int bj = 0; bj < 2; ++bj) *(u32x4*)(base + (size_t)row * 2048 + bj * HALF) = pack8(sigm4(acc[ai][bj][m][0] + bv[bj][0]), sigm4(acc[ai][bj][m][1] + bv[bj][1])); }
        }
    }
};
struct EpiMerge2 {
    static constexpr bool PERM = true, AFTER_DRAIN = false, KEEP_SEG0 = true;
    const bf16_t* GA; const bf16_t* GB; bf16_t* O;
    __device__ __forceinline__ void operator()(f32x4 (&acc)[2][2][4][2], const Unit& u, int wr, int wc, int fr, int fq) const {
        const int row0 = u.pm * BM + wr * 64 + fr, col0 = u.pn * BM + wc * 32 + 8 * fq;
        if (u.seg == 0) {
#pragma unroll
            for (int ai = 0; ai < 2; ++ai)
#pragma unroll
                for (int m = 0; m < 4; ++m) { const size_t off = (size_t)(row0 + ai * HALF + m * 16) * 2048 + col0;
#pragma unroll
                    for (int bj = 0; bj < 2; ++bj) { const u32x4 a = *(const u32x4*)(GA + off + bj * HALF), b = *(const u32x4*)(GB + off + bj * HALF);
                        const f32x4 b0 = bf4lo(b.x, b.y), b1 = bf4lo(b.z, b.w); f32x4 r0, r1;
#pragma unroll
                        for (int e = 0; e < 4; ++e) { r0[e] = __builtin_amdgcn_rcpf(fmaxf(b0[e], 1e-20f)); r1[e] = __builtin_amdgcn_rcpf(fmaxf(b1[e], 1e-20f)); }
                        acc[ai][bj][m][0] = acc[ai][bj][m][0] * (bf4lo(a.x, a.y) * r0); acc[ai][bj][m][1] = acc[ai][bj][m][1] * (bf4lo(a.z, a.w) * r1); } }
        } else {
#pragma unroll
            for (int ai = 0; ai < 2; ++ai)
#pragma unroll
                for (int m = 0; m < 4; ++m) { const size_t off = (size_t)(row0 + ai * HALF + m * 16) * 2048 + col0;
#pragma unroll
                    for (int bj = 0; bj < 2; ++bj) { const u32x4 b = *(const u32x4*)(GB + off + bj * HALF);
                        f32x4 b0 = bf4lo(b.x, b.y), b1 = bf4lo(b.z, b.w);
#pragma unroll
                        for (int e = 0; e < 4; ++e) { b0[e] = fmaxf(b0[e], 1e-20f); b1[e] = fmaxf(b1[e], 1e-20f); }
                        *(u32x4*)(O + off + bj * HALF) = pack8(acc[ai][bj][m][0] * b0, acc[ai][bj][m][1] * b1); } }
        }
    }
};
struct EpiX1 {
    static constexpr bool PERM = true, AFTER_DRAIN = false, KEEP_SEG0 = false;
    const bf16_t* XH; const float* RMS; bf16_t* X1B; unsigned long long* SS;
    __device__ __forceinline__ void operator()(const f32x4 (&acc)[2][2][4][2], const Unit& u, int wr, int wc, int fr, int fq) const {
        const int row0 = u.pm * BM + wr * 64 + fr, col0 = u.pn * BM + wc * 32 + 8 * fq;
#pragma unroll
        for (int ai = 0; ai < 2; ++ai)
#pragma unroll
            for (int m = 0; m < 4; ++m) { const int row = row0 + ai * HALF + m * 16; const size_t off = (size_t)row * 2048 + col0; float sq = 0.f; const float rm = RMS[row];
#pragma unroll
                for (int bj = 0; bj < 2; ++bj) { const u32x4 hx = *(const u32x4*)(XH + off + bj * HALF); const f32x4 v0 = acc[ai][bj][m][0] + bf4lo(hx.x, hx.y) * rm, v1 = acc[ai][bj][m][1] + bf4lo(hx.z, hx.w) * rm;
                    *(u32x4*)(X1B + off + bj * HALF) = pack8(v0, v1);
                    sq += (v0[0] * v0[0] + v0[1] * v0[1]) + (v0[2] * v0[2] + v0[3] * v0[3]) + (v1[0] * v1[0] + v1[1] * v1[1]) + (v1[2] * v1[2] + v1[3] * v1[3]); }
                sq += __shfl_xor(sq, 16); sq += __shfl_xor(sq, 32);
                if (fq == 0) atomicAdd(SS + row, (unsigned long long)(sq * 4294967296.0f)); }
    }
};
__device__ __forceinline__ float rinv_from_ss(unsigned long long s) { return 1.0f / sqrtf((float)((double)s * (1.0 / 4294967296.0) * (1.0 / 2048.0)) + 1e-6f); }
struct EpiQP {
    static constexpr bool PERM = true, AFTER_DRAIN = false, KEEP_SEG0 = false;
    const unsigned long long* SS; bf16_t* O;
    __device__ __forceinline__ void operator()(const f32x4 (&acc)[2][2][4][2], const Unit& u, int wr, int wc, int fr, int fq) const {
        const int row0 = u.pm * BM + wr * 64 + fr, col0 = u.pn * BM + wc * 32 + 8 * fq;
#pragma unroll
        for (int ai = 0; ai < 2; ++ai)
#pragma unroll
            for (int m = 0; m < 4; ++m) { const int row = row0 + ai * HALF + m * 16; const size_t off = (size_t)row * 2048 + col0; const float rv = rinv_from_ss(SS[row]);
#pragma unroll
                for (int bj = 0; bj < 2; ++bj) *(u32x4*)(O + off + bj * HALF) = pack8(acc[ai][bj][m][0] * rv, acc[ai][bj][m][1] * rv); }
    }
};

template <class Epi, class Sched, bool ALIGN_EPI = false, bool SP2 = false>
__device__ __forceinline__ void gemm_phase(PG8_LAS unsigned char* lds, const Gemm g, const Sched& S, const Epi& E) {
    const int tid = threadIdx.x, wid = __builtin_amdgcn_readfirstlane(tid >> 6), lane = tid & 63, wr = wid >> 2, wc = wid & 3, fr = lane & 15, fq = lane >> 4;
    const int K = g.K, nt = K / BK;
    unsigned voffA[2], voffB[2];
#pragma unroll
    for (int i = 0; i < 2; ++i) { int R, C; stage_rc(tid * 16 + i * 8192, R, C); const int Rb = Epi::PERM ? ((R & ~31) + perm32(R & 31)) : R;
        voffA[i] = (unsigned)(R * K + C) * 2u; voffB[i] = (unsigned)(Rb * K + C) * 2u; }
    const size_t kstep = (size_t)(BK * 2);
    const size_t hstep = (size_t)HALF * K * 2;
    const size_t tstep = 2 * hstep;
    const unsigned ldsw = (unsigned)wid * 1024u;
    const int aoff = lds_byte(wr * 64 + fr, fq * 8), boff = lds_byte(wc * 32 + fr, fq * 8);
#define PG8_SA(b, h) (((b) * 2 + (h)) * HTB)
#define PG8_SB(b, h) ((4 + (b) * 2 + (h)) * HTB)
#define PG8_STAGE(bufoff, gbase, voff) do { _Pragma("unroll") for (int _i = 0; _i < 2; ++_i) \
        __builtin_amdgcn_global_load_lds((const unsigned*)((const char*)(gbase) + (voff)[_i]), (PG8_LAS unsigned*)(lds + (bufoff) + ldsw + _i * 8192), 16, 0, 0); } while (0)
#define PG8_LDA(dst, b, h) do { _Pragma("unroll") for (int m = 0; m < 4; ++m) _Pragma("unroll") for (int k = 0; k < 2; ++k) dst[m][k] = *(const PG8_LAS bf16x8*)(lds + PG8_SA(b, h) + aoff + m * 2048 + k * 1024); } while (0)
#define PG8_LDB(dst, b, h) do { _Pragma("unroll") for (int n = 0; n < 2; ++n) _Pragma("unroll") for (int k = 0; k < 2; ++k) dst[n][k] = *(const PG8_LAS bf16x8*)(lds + PG8_SB(b, h) + boff + n * 2048 + k * 1024); } while (0)
#define PG8_MMA(ai, bj, At, Bt) do { __builtin_amdgcn_s_setprio(1); _Pragma("unroll") for (int m = 0; m < 4; ++m) _Pragma("unroll") for (int n = 0; n < 2; ++n) _Pragma("unroll") for (int k = 0; k < 2; ++k) \
        acc[ai][bj][m][n] = __builtin_amdgcn_mfma_f32_16x16x32_bf16(Bt[n][k], At[m][k], acc[ai][bj][m][n], 0, 0, 0); __builtin_amdgcn_s_setprio(0); } while (0)
#define PG8_WAIT_V(n) asm volatile("s_waitcnt vmcnt(" #n ")" ::: "memory")
#define PG8_WAIT_L(n) asm volatile("s_waitcnt lgkmcnt(" #n ")" ::: "memory")
#define PG8_BAR __builtin_amdgcn_s_barrier()
#define PG8_SCHED __builtin_amdgcn_sched_barrier(0)
    Unit cur, nxt; int ui = 0;
    if (!S.next(0, cur)) return;
    f32x4 acc[2][2][4][2];
#pragma unroll
    for (int a = 0; a < 2; ++a)
#pragma unroll
        for (int b = 0; b < 2; ++b)
#pragma unroll
            for (int m = 0; m < 4; ++m)
#pragma unroll
                for (int n = 0; n < 2; ++n) acc[a][b][m][n] = (f32x4){0.f, 0.f, 0.f, 0.f};
    bf16x8 At[4][2], B0[2][2], B1[2][2];
    const char* cA = (const char*)(cur.seg ? g.A2 : g.A) + (size_t)cur.pm * tstep; const char* cB = (const char*)(cur.seg ? g.Bt2 : g.Bt) + (size_t)cur.pn * tstep;
    S.a_ready(cur);
    if constexpr (SP2) {
        PG8_STAGE(PG8_SB(0, 0), cB, voffB); PG8_STAGE(PG8_SB(0, 1), cB + hstep, voffB); PG8_STAGE(PG8_SA(0, 0), cA, voffA); PG8_STAGE(PG8_SA(0, 1), cA + hstep, voffA);
        if (wr == 1) PG8_BAR;
        PG8_WAIT_V(2); PG8_BAR;
        PG8_STAGE(PG8_SB(1, 0), cB + kstep, voffB); PG8_STAGE(PG8_SA(1, 0), cA + kstep, voffA); PG8_STAGE(PG8_SB(1, 1), cB + hstep + kstep, voffB);
        PG8_WAIT_V(6); PG8_BAR;
    } else {
        PG8_STAGE(PG8_SB(0, 0), cB, voffB); PG8_STAGE(PG8_SA(0, 0), cA, voffA); PG8_STAGE(PG8_SB(0, 1), cB + hstep, voffB); PG8_STAGE(PG8_SA(0, 1), cA + hstep, voffA);
        if (wr == 1) PG8_BAR;
        PG8_WAIT_V(4); PG8_BAR;
        PG8_STAGE(PG8_SB(1, 0), cB + kstep, voffB); PG8_STAGE(PG8_SA(1, 0), cA + kstep, voffA); PG8_STAGE(PG8_SB(1, 1), cB + hstep + kstep, voffB);
        PG8_WAIT_V(6); PG8_BAR;
    }
    for (;;) {
        const bool has_next = S.next(ui + 1, nxt);
        const char* nA = has_next ? (const char*)(nxt.seg ? g.A2 : g.A) + (size_t)nxt.pm * tstep : cA; const char* nB = has_next ? (const char*)(nxt.seg ? g.Bt2 : g.Bt) + (size_t)nxt.pn * tstep : cB;
        for (int t = 0; t < nt; t += 2) {
            const bool last = (t == nt - 2);
            const char* a1 = cA + (size_t)(t + 1) * kstep;
            const char* a2 = last ? nA : cA + (size_t)(t + 2) * kstep; const char* b2 = last ? nB : cB + (size_t)(t + 2) * kstep;
            const char* a3 = a2 + kstep; const char* b3 = b2 + kstep;
            if (last && has_next) S.a_ready(nxt);
            if constexpr (SP2) {
            PG8_LDB(B0, 0, 0); PG8_LDB(B1, 0, 1); PG8_SCHED; PG8_LDA(At, 0, 0); PG8_STAGE(PG8_SA(1, 1), a1 + hstep, voffA);
            PG8_WAIT_V(8); PG8_WAIT_L(0); PG8_BAR; PG8_MMA(0, 0, At, B0); PG8_MMA(0, 1, At, B1); PG8_BAR; PG8_SCHED;
            PG8_LDA(At, 0, 1); PG8_STAGE(PG8_SB(0, 0), b2, voffB); PG8_STAGE(PG8_SB(0, 1), b2 + hstep, voffB); PG8_STAGE(PG8_SA(0, 0), a2, voffA);
            PG8_WAIT_V(8); PG8_WAIT_L(0); PG8_BAR; PG8_MMA(1, 0, At, B0); PG8_MMA(1, 1, At, B1); PG8_BAR; PG8_SCHED;
            PG8_LDB(B0, 1, 0); PG8_LDB(B1, 1, 1); PG8_SCHED; PG8_LDA(At, 1, 0); PG8_STAGE(PG8_SA(0, 1), a2 + hstep, voffA);
            PG8_WAIT_V(8); PG8_WAIT_L(0); PG8_BAR; PG8_MMA(0, 0, At, B0); PG8_MMA(0, 1, At, B1); PG8_BAR; PG8_SCHED;
            PG8_LDA(At, 1, 1); PG8_STAGE(PG8_SB(1, 0), b3, voffB); PG8_STAGE(PG8_SB(1, 1), b3 + hstep, voffB); PG8_STAGE(PG8_SA(1, 0), a3, voffA);
            PG8_WAIT_V(8); PG8_WAIT_L(0); PG8_BAR; PG8_MMA(1, 0, At, B0); PG8_MMA(1, 1, At, B1); PG8_BAR; PG8_SCHED;
            } else {
            PG8_LDB(B0, 0, 0); PG8_SCHED; PG8_LDA(At, 0, 0); PG8_STAGE(PG8_SA(1, 1), a1 + hstep, voffA);
            PG8_WAIT_L(8); PG8_BAR; PG8_WAIT_L(0); PG8_MMA(0, 0, At, B0); PG8_BAR; PG8_SCHED;
            PG8_LDB(B1, 0, 1); PG8_STAGE(PG8_SB(0, 0), b2, voffB);
            PG8_BAR; PG8_WAIT_L(0); PG8_MMA(0, 1, At, B1); PG8_BAR;
            PG8_LDA(At, 0, 1); PG8_STAGE(PG8_SA(0, 0), a2, voffA);
            PG8_BAR; PG8_WAIT_L(0); PG8_MMA(1, 0, At, B0); PG8_BAR; PG8_SCHED;
            PG8_STAGE(PG8_SB(0, 1), b2 + hstep, voffB);
            PG8_WAIT_V(6); PG8_BAR; PG8_MMA(1, 1, At, B1); PG8_BAR;
            PG8_LDB(B0, 1, 0); PG8_SCHED; PG8_LDA(At, 1, 0); PG8_STAGE(PG8_SA(0, 1), a2 + hstep, voffA);
            PG8_WAIT_L(8); PG8_BAR; PG8_WAIT_L(0); PG8_MMA(0, 0, At, B0); PG8_BAR; PG8_SCHED;
            PG8_LDB(B1, 1, 1); PG8_STAGE(PG8_SB(1, 0), b3, voffB);
            PG8_BAR; PG8_WAIT_L(0); PG8_MMA(0, 1, At, B1); PG8_BAR;
            PG8_LDA(At, 1, 1); PG8_STAGE(PG8_SA(1, 0), a3, voffA);
            PG8_BAR; PG8_WAIT_L(0); PG8_MMA(1, 0, At, B0); PG8_BAR; PG8_SCHED;
            PG8_STAGE(PG8_SB(1, 1), b3 + hstep, voffB);
            PG8_WAIT_V(6); PG8_BAR; PG8_MMA(1, 1, At, B1); PG8_BAR;
            }
        }
        if constexpr (ALIGN_EPI) { if (wr == 0) PG8_BAR; }
        if constexpr (!Epi::AFTER_DRAIN) { E(acc, cur, wr, wc, fr, fq); S.done(cur); }
        if (!has_next) break;
        if (!(Epi::KEEP_SEG0 && cur.seg == 0)) {
#pragma unroll
        for (int a = 0; a < 2; ++a)
#pragma unroll
            for (int b = 0; b < 2; ++b)
#pragma unroll
                for (int m = 0; m < 4; ++m)
#pragma unroll
                    for (int n = 0; n < 2; ++n) acc[a][b][m][n] = (f32x4){0.f, 0.f, 0.f, 0.f};
        }
        cur = nxt; cA = nA; cB = nB; ++ui;
        if constexpr (ALIGN_EPI) { if (wr == 1) PG8_BAR; }
    }
    PG8_WAIT_V(0);
    if constexpr (!ALIGN_EPI) { if (wr == 0) PG8_BAR; }
    PG8_BAR;
    if constexpr (Epi::AFTER_DRAIN) { E.fused(acc, cur, wr, wc, fr, fq, lds, wid, lane); S.done(cur); }
#undef PG8_SA
#undef PG8_SB
#undef PG8_STAGE
#undef PG8_LDA
#undef PG8_LDB
#undef PG8_MMA
#undef PG8_WAIT_V
#undef PG8_WAIT_L
#undef PG8_BAR
#undef PG8_SCHED
}
}

constexpr int NWAVES = 8;
#ifndef MK_N_LAUNCHES
#define MK_N_LAUNCHES 1
#endif
constexpr int PER_PHASE = 9;
#ifndef MK_REP_PHASE
#define MK_REP_PHASE -1
#endif
#define NREP(k) (((k) == MK_REP_PHASE) ? 2 : 1)
constexpr int N_LAUNCHES = MK_N_LAUNCHES;
constexpr int M = 8192, SEQ = 4096, DM = 2048, INW = 10240, NEXP = 16384;
constexpr float RMS_EPS = 1e-6f;
constexpr size_t MiB = 1u << 20;
constexpr size_t WS_CTL = 0, CTL_ZERO_BYTES = 64 * 1024;
constexpr size_t WS_SS = 256 * 1024, WS_KSUM = 512 * 1024;
constexpr size_t WS_WIN = 2 * MiB, WS_WBC = 42 * MiB, WS_WBA = 46 * MiB, WS_WOUT = 50 * MiB, WS_WPQ = 58 * MiB, WS_KEYS = 66 * MiB, WS_CS = 67 * MiB;
constexpr size_t WS_RMS = 68 * MiB;
constexpr size_t WS_UB = 70 * MiB, WS_VB = 102 * MiB;
constexpr size_t WS_XB = 198 * MiB;
constexpr size_t WS_T6 = 230 * MiB;
constexpr size_t WS_GAB = 326 * MiB;
constexpr size_t WS_UC = 390 * MiB, WS_AO = 406 * MiB;
constexpr size_t WS_EXP = 422 * MiB, WS_GATE = 426 * MiB;
constexpr size_t WS_END = 430 * MiB;
constexpr size_t WS_TMP = WS_XB, WS_MB = WS_T6, WS_X1B = WS_T6 + 48 * MiB, WS_QP = WS_GAB;
constexpr int CW_BAR = 4096;
constexpr int RING_OFF = 0, RING_BYTES = 131072;
constexpr int LDSCTL_OFF = RING_BYTES, MISC_OFF = LDSCTL_OFF + 320;
constexpr int LDS_BYTES = 147456;

#define GAS __attribute__((address_space(1)))
#define LAS __attribute__((address_space(3)))
typedef unsigned short bf16;
typedef unsigned v4u __attribute__((ext_vector_type(4)));
typedef float f32x4 __attribute__((ext_vector_type(4)));
typedef short bf16x8 __attribute__((ext_vector_type(8)));
typedef GAS unsigned gu32;
typedef GAS unsigned long long gu64;
#define RLX_AGENT __ATOMIC_RELAXED, __HIP_MEMORY_SCOPE_AGENT
#define LDS_WAIT() asm volatile("s_waitcnt lgkmcnt(0)" ::: "memory")
#define VM_WAIT() asm volatile("s_waitcnt vmcnt(0)" ::: "memory")
__device__ __forceinline__ unsigned long long rt() { return __builtin_amdgcn_s_memrealtime(); }
__device__ __forceinline__ unsigned f2bf(float f) { unsigned u = __builtin_bit_cast(unsigned, f); return (u + 0x7fffu + ((u >> 16) & 1u)) >> 16; }
__device__ __forceinline__ unsigned pk2(float lo, float hi) { return f2bf(lo) | (f2bf(hi) << 16); }

#define XB_TMO      128
#define XB_XCNT(j)  (256  + 64 * (j))
#define XB_XSUB(j)  (1280 + 64 * (j))
#define XB_XGEN(j)  (2304 + 64 * (j))
#define XB_TOP      3328
#define XB_TOPGEN   3392
#define XCD_BAR_WORDS 3456
#define XB_SPIN_CAP (1u << 18)

__device__ __forceinline__ unsigned xb_ld(unsigned* p)              { return __hip_atomic_load(p, __ATOMIC_RELAXED, __HIP_MEMORY_SCOPE_AGENT); }
__device__ __forceinline__ unsigned xb_add(unsigned* p, unsigned v) { return __hip_atomic_fetch_add(p, v, __ATOMIC_RELAXED, __HIP_MEMORY_SCOPE_AGENT); }
__device__ __forceinline__ unsigned xb_xcc_id() { return (unsigned)__builtin_amdgcn_s_getreg((3 << 11) | 20) & 0xFu; }
#define XB_SPIN(cond, bar) do { unsigned _sp = 0; while (cond) { __builtin_amdgcn_s_sleep(1); \
    if ((++_sp & 255u) == 0u) { if (xb_ld(&(bar)[XB_TMO])) break; if (_sp > XB_SPIN_CAP) { atomicAdd(&(bar)[XB_TMO], 1u); break; } } } } while (0)

struct XcdBarrier {
    unsigned* bar; unsigned x;
    volatile LAS unsigned* st;
};

__device__ __forceinline__ XcdBarrier xcd_barrier_post(unsigned* bar, volatile LAS unsigned* st) {
    XcdBarrier b; b.bar = bar; b.x = xb_xcc_id(); b.st = st;
    if (threadIdx.x == 0) (void)xb_add(&bar[XB_XCNT(b.x)], 1u);
    return b;
}
__device__ __forceinline__ void xcd_barrier_complete(unsigned* bar, unsigned x, unsigned& nloc, unsigned& nx) {
    const unsigned G = gridDim.x * gridDim.y * gridDim.z;
    unsigned sum, cnt, mine, sp = 0u;
    for (;;) {
        sum = 0u; cnt = 0u; mine = 0u;
#pragma unroll
        for (unsigned j = 0; j < 16; ++j) { const unsigned c = xb_ld(&bar[XB_XCNT(j)]); sum += c; cnt += (c > 0u) ? 1u : 0u; mine = (j == x) ? c : mine; }
        if (sum == G) break;
        __builtin_amdgcn_s_sleep(1);
        if ((++sp & 255u) == 0u) { if (xb_ld(&bar[XB_TMO])) break; if (sp > XB_SPIN_CAP) { atomicAdd(&bar[XB_TMO], 1u); break; } }
    }
    nloc = mine > 0u ? mine : 1u; nx = cnt > 0u ? cnt : 1u;
}

struct Ctx { LAS unsigned char* lds; int tid, lane, wave, vcu, G; };
struct BarWork { const float* pu; const float* pv; const float* g2; unsigned char* ws; int part, nparts; };
__device__ __forceinline__ void convert_tables(const Ctx& F, const float* pu, const float* pv, const float* g2, unsigned char* ws, int part, int nparts, int w0);
__device__ __forceinline__ void xcd_barrier(const XcdBarrier& b, const Ctx* F = nullptr, const BarWork* wk = nullptr) {
    asm volatile("s_waitcnt vmcnt(0)" ::: "memory");
    __syncthreads();
    if (wk && wk->part >= 0) convert_tables(*F, wk->pu, wk->pv, wk->g2, wk->ws, wk->part, wk->nparts, 1);
    if (threadIdx.x == 0) {
        unsigned* bar = b.bar;
        __builtin_amdgcn_s_waitcnt(0);
        unsigned nloc = b.st[0], nx = b.st[1];
        if (nloc == 0u) { xcd_barrier_complete(bar, b.x, nloc, nx); b.st[0] = nloc; b.st[1] = nx; }
        const unsigned old = xb_add(&bar[XB_XSUB(b.x)], 1u);
        const unsigned gen = old / nloc;
        if (old + 1u == (gen + 1u) * nloc) {
            __builtin_amdgcn_fence(__ATOMIC_RELEASE, "agent");
            asm volatile("s_waitcnt vmcnt(0)" ::: "memory");
            const unsigned og = xb_add(&bar[XB_TOP], 1u);
            const unsigned tg = og / nx;
            if (og + 1u == (tg + 1u) * nx) xb_add(&bar[XB_TOPGEN], 1u);
            else XB_SPIN(xb_ld(&bar[XB_TOPGEN]) == tg, bar);
            __builtin_amdgcn_fence(__ATOMIC_ACQUIRE, "agent");
            xb_add(&bar[XB_XGEN(b.x)], 1u);
            asm volatile("s_waitcnt vmcnt(0)" ::: "memory");
        } else {
            XB_SPIN(xb_ld(&bar[XB_XGEN(b.x)]) == gen, bar);
            __builtin_amdgcn_fence(__ATOMIC_ACQUIRE, "agent");
            asm volatile("s_waitcnt vmcnt(0)" ::: "memory");
        }
    }
    __syncthreads();
}

typedef __bf16 bf16x2v __attribute__((ext_vector_type(2)));
typedef float f32x16 __attribute__((ext_vector_type(16)));
__device__ __forceinline__ float bflo(unsigned w) { return __uint_as_float(w << 16); }
__device__ __forceinline__ float bfhi(unsigned w) { return __uint_as_float(w & 0xffff0000u); }
__device__ __forceinline__ float dot2bf(unsigned a, unsigned b, float c) { return __builtin_amdgcn_fdot2_f32_bf16(__builtin_bit_cast(bf16x2v, a), __builtin_bit_cast(bf16x2v, b), c, false); }
__device__ __forceinline__ float wave_sum(float v) {
#pragma unroll
    for (int o = 1; o < 64; o <<= 1) v += __shfl_xor(v, o);
    return v; }
__device__ __forceinline__ float wave_max(float v) {
#pragma unroll
    for (int o = 1; o < 64; o <<= 1) v = fmaxf(v, __shfl_xor(v, o));
    return v; }
__device__ __forceinline__ float rdlane(float v, int l) { return __int_as_float(__builtin_amdgcn_readlane(__float_as_int(v), l)); }
__device__ __forceinline__ float gelu_tanh(float x) { const float z = 0.7978845608028654f * (x + 0.044715f * x * x * x); const float e = __expf(2.0f * z); const float th = 1.0f - 2.0f * __builtin_amdgcn_rcpf(1.0f + e); return 0.5f * x * (1.0f + th); }


__device__ __forceinline__ void p0_transpose_item(const float* W, int K, int N, bf16* WT, const float* gk, LAS float* scr, int item, int lane) {
    const int nblk = N / 32, kb = item / nblk, nb = item % nblk, k0 = 64 * kb, n0 = 32 * nb;
#pragma unroll
    for (int i = 0; i < 8; ++i) { const int kk = 8 * i + (lane >> 3), nn = 4 * (lane & 7); f32x4 v = *(const GAS f32x4*)(W + (size_t)(k0 + kk) * N + n0 + nn); if (gk) v = v * gk[k0 + kk];
        scr[kk * 33 + nn] = v[0]; scr[kk * 33 + nn + 1] = v[1]; scr[kk * 33 + nn + 2] = v[2]; scr[kk * 33 + nn + 3] = v[3]; }
    LDS_WAIT(); asm volatile("" ::: "memory");
    const int c = lane & 7;
#pragma unroll
    for (int j = 0; j < 4; ++j) { const int n = (lane >> 3) + 8 * j; const LAS float* s = scr + (8 * c) * 33 + n;
        v4u o; o.x = pk2(s[0 * 33], s[1 * 33]); o.y = pk2(s[2 * 33], s[3 * 33]); o.z = pk2(s[4 * 33], s[5 * 33]); o.w = pk2(s[6 * 33], s[7 * 33]);
        *(GAS v4u*)(WT + (size_t)(n0 + n) * K + k0 + 8 * c) = o; }
    LDS_WAIT(); asm volatile("" ::: "memory");
}
__device__ __forceinline__ void convert_tables(const Ctx& F, const float* pu, const float* pv, const float* g2, unsigned char* ws, int part, int nparts, int w0) {
    if (F.wave < w0) return;
    const int nw = NWAVES - w0, gt = (F.vcu * nw + (F.wave - w0)) * 64 + F.lane, NT = F.G * nw * 64;
    const int per = (NEXP * 2048 / 16) / nparts, lo = part * per, hi = lo + per;
    for (int i = lo + gt; i < hi; i += NT) { const int c16 = (i & 127) * 16; v4u ou, ov;
#pragma unroll
        for (int q = 0; q < 4; ++q) { f32x4 a = ((const GAS f32x4*)pu)[4 * i + q]; a = a * *(const GAS f32x4*)(g2 + c16 + 4 * q) * 512.0f; const f32x4 b = ((const GAS f32x4*)pv)[4 * i + q] * 32.0f;
            int wu = 0, wv = 0; wu = __builtin_amdgcn_cvt_pk_fp8_f32(a[0], a[1], wu, false); wu = __builtin_amdgcn_cvt_pk_fp8_f32(a[2], a[3], wu, true);
            wv = __builtin_amdgcn_cvt_pk_fp8_f32(b[0], b[1], wv, false); wv = __builtin_amdgcn_cvt_pk_fp8_f32(b[2], b[3], wv, true); ou[q] = (unsigned)wu; ov[q] = (unsigned)wv; }
        ((GAS v4u*)(ws + WS_UB))[i] = ou; ((GAS v4u*)(ws + WS_VB))[i] = ov; }
}
__device__ __forceinline__ void p0_prologue(const Ctx& F, const float* const* in, unsigned char* ws, const double* invf) {
    const float* x = in[0]; const int* pos = (const int*)in[1]; const float* g1 = in[2]; const float* w_in = in[3];
    const float* w_bc = in[6]; const float* w_ba = in[7]; const float* w_out = in[8]; const float* g2 = in[9]; const float* w_pq = in[10];
    const float* keys = in[11]; const float* pu = in[12]; const float* pv = in[13];
    LAS float* scr = (LAS float*)(F.lds + RING_OFF + F.wave * 16384);
    const int gw = F.vcu * NWAVES + F.wave, NGW = F.G * NWAVES;
    const int gt = gw * 64 + F.lane, NT = NGW * 64;
    for (int i = gt; i < 8192; i += NT) ((GAS unsigned long long*)(ws + WS_SS))[i] = 0ull;
    for (int i = gt; i < 32 * 1024; i += NT) ((GAS float*)(ws + WS_KSUM))[i] = 0.f;
    constexpr int I_IN = 32 * 320, I_BC = 16 * 64, I_OUT = 32 * 64;
    constexpr int NITEMS = I_IN + 2 * I_BC + 2 * I_OUT;
    for (int it = gw; it < NITEMS; it += NGW) {
        int r = it;
        if (r < I_IN) { p0_transpose_item(w_in, 2048, INW, (bf16*)(ws + WS_WIN), g1, scr, r, F.lane); continue; } r -= I_IN;
        if (r < I_BC) { p0_transpose_item(w_bc, 1024, 2048, (bf16*)(ws + WS_WBC), nullptr, scr, r, F.lane); continue; } r -= I_BC;
        if (r < I_BC) { p0_transpose_item(w_ba, 1024, 2048, (bf16*)(ws + WS_WBA), nullptr, scr, r, F.lane); continue; } r -= I_BC;
        if (r < I_OUT) { p0_transpose_item(w_out, 2048, 2048, (bf16*)(ws + WS_WOUT), nullptr, scr, r, F.lane); continue; } r -= I_OUT;
        p0_transpose_item(w_pq, 2048, 2048, (bf16*)(ws + WS_WPQ), g2, scr, r, F.lane);
    }
    for (int i = gt; i < 16 * 128 * 128 / 8; i += NT) { const f32x4 a = ((const GAS f32x4*)keys)[2 * i], b = ((const GAS f32x4*)keys)[2 * i + 1];
        v4u o; o.x = pk2(a[0], a[1]); o.y = pk2(a[2], a[3]); o.z = pk2(b[0], b[1]); o.w = pk2(b[2], b[3]); ((GAS v4u*)(ws + WS_KEYS))[i] = o; }
    for (int m = gw; m < M; m += NGW) { const GAS f32x4* xr = (const GAS f32x4*)(x + (size_t)m * DM);
        f32x4 v[8]; float s = 0.f;
#pragma unroll
        for (int i = 0; i < 4; ++i) { v[2 * i] = xr[i * 128 + 2 * F.lane]; v[2 * i + 1] = xr[i * 128 + 2 * F.lane + 1]; }
#pragma unroll
        for (int i = 0; i < 8; ++i) s += (v[i][0] * v[i][0] + v[i][1] * v[i][1]) + (v[i][2] * v[i][2] + v[i][3] * v[i][3]);
        const float rms = sqrtf(wave_sum(s) * (1.0f / DM) + RMS_EPS), rinv = 1.0f / rms;
        if (F.lane == 0) ((GAS float*)(ws + WS_RMS))[m] = rms;
        GAS v4u* o = (GAS v4u*)(ws + WS_XB + (size_t)m * DM * 2);
#pragma unroll
        for (int i = 0; i < 4; ++i) { const f32x4 a = v[2 * i] * rinv, b = v[2 * i + 1] * rinv; v4u w; w.x = pk2(a[0], a[1]); w.y = pk2(a[2], a[3]); w.z = pk2(b[0], b[1]); w.w = pk2(b[2], b[3]); o[i * 64 + F.lane] = w; } }
    for (int i = gt; i < M * 16; i += NT) { const int row = i >> 4, f = i & 15; const double ang = (double)pos[row] * invf[f];
        const double k = __builtin_rint(ang * 0.15915494309189535); const float r = (float)(ang - k * 6.283185307179586);
        float* cs = (float*)(ws + WS_CS); cs[row * 32 + f] = __cosf(r); cs[row * 32 + 16 + f] = __sinf(r); }
}

__device__ __forceinline__ void attn_simple(const Ctx& F, const bf16* Q, const bf16* K, const bf16* V, const float* ksum, bf16* AO) {
    LAS float* qf = (LAS float*)(F.lds + RING_OFF + F.wave * 512);
    const int gw = F.vcu * NWAVES + F.wave, NGW = F.G * NWAVES, lane = F.lane;
    for (int item = gw; item < 16 * SEQ; item += NGW) {
        const int bh = item >> 12, t = item & 4095, b = bh >> 3, h = bh & 7, blk = t >> 8;
        const size_t row = (size_t)b * SEQ + t;
        { const unsigned qq = *(const GAS unsigned*)(Q + row * 1024 + h * 128 + 2 * lane); qf[2 * lane] = bflo(qq); qf[2 * lane + 1] = bfhi(qq); }
        LDS_WAIT(); asm volatile("" ::: "memory");
        float g = -INFINITY;
        if (lane < blk) { const GAS f32x4* km = (const GAS f32x4*)(ksum + (size_t)(b * 16 + lane) * 1024 + h * 128); float a = 0.f;
            for (int d = 0; d < 32; ++d) { const f32x4 kv = km[d]; const f32x4 qv = *(const LAS f32x4*)(qf + 4 * d); a += (kv[0] * qv[0] + kv[1] * qv[1]) + (kv[2] * qv[2] + kv[3] * qv[3]); }
            g = a; }
        int sel[3];
#pragma unroll
        for (int i = 0; i < 3; ++i) { const float mx = wave_max(g); const unsigned long long bal = __ballot(g == mx && lane < blk); const int idx = bal ? (__ffsll((long long)bal) - 1) : 0; sel[i] = idx; if (lane == idx) g = -INFINITY; }
        const int nsel = blk < 3 ? blk : 3;
        float sc[4][4]; float mx = -INFINITY;
#pragma unroll
        for (int slot = 0; slot < 4; ++slot) {
            const bool valid = (slot == 3) || (slot < nsel);
            const int kb = (slot == 3) ? blk : sel[slot < 3 ? slot : 0];
#pragma unroll
            for (int r = 0; r < 4; ++r) {
                float s = -INFINITY; const int key0 = kb * 256 + r * 64;
                if (valid && (slot < 3 || key0 <= t)) {
                    const int key = key0 + lane; const GAS v4u* kp = (const GAS v4u*)(K + ((size_t)b * SEQ + key) * 1024 + h * 128); float a = 0.f;
#pragma unroll 4
                    for (int d = 0; d < 16; ++d) { const v4u kk = kp[d]; const f32x4 q0 = *(const LAS f32x4*)(qf + 8 * d), q1 = *(const LAS f32x4*)(qf + 8 * d + 4);
                        a += (bflo(kk.x) * q0[0] + bfhi(kk.x) * q0[1]) + (bflo(kk.y) * q0[2] + bfhi(kk.y) * q0[3]) + (bflo(kk.z) * q1[0] + bfhi(kk.z) * q1[1]) + (bflo(kk.w) * q1[2] + bfhi(kk.w) * q1[3]); }
                    s = (slot < 3 || key <= t) ? a : -INFINITY; }
                sc[slot][r] = s; mx = fmaxf(mx, s); } }
        mx = wave_max(mx);
        float sum = 0.f;
#pragma unroll
        for (int slot = 0; slot < 4; ++slot)
#pragma unroll
            for (int r = 0; r < 4; ++r) { sc[slot][r] = exp2f(sc[slot][r] - mx); sum += sc[slot][r]; }
        sum = wave_sum(sum);
        float o0 = 0.f, o1 = 0.f;
#pragma unroll
        for (int slot = 0; slot < 4; ++slot) {
            const bool valid = (slot == 3) || (slot < nsel);
            const int kb = (slot == 3) ? blk : sel[slot < 3 ? slot : 0];
#pragma unroll
            for (int r = 0; r < 4; ++r) { const int key0 = kb * 256 + r * 64;
                if (valid && (slot < 3 || key0 <= t)) { const float pr = sc[slot][r]; const GAS unsigned* vp = (const GAS unsigned*)(V + ((size_t)b * SEQ + key0) * 1024 + h * 128) + lane;
                    for (int kk = 0; kk < 64; ++kk) { const float pk = rdlane(pr, kk); const unsigned vv = vp[(size_t)kk * 512]; o0 += pk * bflo(vv); o1 += pk * bfhi(vv); } } } }
        const float ri = 1.0f / sum;
        *(GAS unsigned*)(AO + row * 1024 + h * 128 + 2 * lane) = pk2(o0 * ri, o1 * ri);
    }
}
typedef short v4i16_t __attribute__((ext_vector_type(4))); typedef unsigned u32x2v __attribute__((ext_vector_type(2)));
__device__ __forceinline__ v4i16_t vtr16(unsigned addr) { return __builtin_amdgcn_ds_read_tr16_b64_v4i16((LAS v4i16_t*)(uintptr_t)addr); }
__device__ __forceinline__ int crow16(int r, int hh) { return (r & 3) + 8 * (r >> 2) + 4 * hh; }
__device__ __forceinline__ void attn_dma_step(const bf16* K, const bf16* V, LAS unsigned char* lds, int b, int h, int qb, int n_own, int st, int buf, int wave, int lane) {
#pragma unroll
    for (int img = 0; img < 4; ++img) {
        const int T = 2 * st + (img >> 1); const bool isV = img & 1;
        const int blk = (T < n_own) ? qb : ((T - n_own) >> 2), kt = (T < n_own) ? T : ((T - n_own) & 3);
        const bf16* base = (isV ? V : K) + ((size_t)b * SEQ + 256 * blk + 64 * kt) * 1024 + h * 128;
#pragma unroll
        for (int i = 0; i < 2; ++i) { const int pc = wave + 8 * i, row = 4 * pc + (lane >> 4), cp = lane & 15;
            const int c = isV ? ((((cp >> 2) ^ (row & 3)) << 2) | (cp & 3)) : (cp ^ (row & 15));
            __builtin_amdgcn_global_load_lds((const unsigned*)(base + (size_t)row * 1024 + 8 * c), (LAS unsigned*)(lds + buf * 65536 + img * 16384 + pc * 1024), 16, 0, 0); }
    }
}
__device__ __forceinline__ void attn_mfma(const Ctx& F, const bf16* Q, const bf16* K, const bf16* V, const float* ksum, bf16* AO) {
    const int lane = F.lane, wave = F.wave, q31 = lane & 31, hh = lane >> 5, wq = wave & 3, kvh = wave >> 2, l16 = lane & 15, G4 = lane >> 4;
    LAS unsigned char* lds = F.lds + RING_OFF;
    const unsigned lds0 = (unsigned)(uintptr_t)lds;
    for (int pr = F.vcu; pr < 256; pr += F.G)
#pragma unroll 1
    for (int pi = 0; pi < 2; ++pi) {
        const int bh = pr >> 4, s_ = pr & 15, u128 = pi ? 31 - s_ : s_, b = bh >> 3, h = bh & 7, qb = u128 >> 1, half = u128 & 1;
        const int n_own = half ? 4 : 2, nstep = (n_own + 4 * qb) >> 1;
        const size_t rowq = (size_t)b * SEQ + 256 * qb + 128 * half + 32 * wq + q31;
        asm volatile("s_waitcnt vmcnt(0) lgkmcnt(0)" ::: "memory"); __builtin_amdgcn_s_barrier(); asm volatile("" ::: "memory");
        attn_dma_step(K, V, lds, b, h, qb, n_own, 0, 0, wave, lane);
        bf16x8 qf[8];
#pragma unroll
        for (int s = 0; s < 8; ++s) qf[s] = *(const GAS bf16x8*)(Q + rowq * 1024 + h * 128 + 16 * s + 8 * hh);
        unsigned selmask;
        {
            f32x16 gt;
#pragma unroll
            for (int r = 0; r < 16; ++r) gt[r] = 0.f;
            const int jr = lane & 31; const bool jv = jr < qb;
            const GAS f32x4* kp = (const GAS f32x4*)(ksum + (size_t)(b * 16 + (jv ? jr : 0)) * 1024 + h * 128 + 8 * hh);
            f32x4 kf[16];
#pragma unroll
            for (int s = 0; s < 8; ++s) { kf[2 * s] = kp[4 * s]; kf[2 * s + 1] = kp[4 * s + 1]; }
#pragma unroll
            for (int s = 0; s < 8; ++s) { v4u w = pg8::pack8(kf[2 * s], kf[2 * s + 1]); if (!jv) { w.x = 0u; w.y = 0u; w.z = 0u; w.w = 0u; }
                gt = __builtin_amdgcn_mfma_f32_32x32x16_bf16(__builtin_bit_cast(bf16x8, w), qf[s], gt, 0, 0, 0); }
            float g16[16];
#pragma unroll
            for (int r = 0; r < 8; ++r) { const auto rr = __builtin_amdgcn_permlane32_swap(__float_as_uint(gt[r]), __float_as_uint(gt[r]), false, false);
                g16[(r & 3) + 8 * (r >> 2)] = __uint_as_float(rr[0]); g16[(r & 3) + 8 * (r >> 2) + 4] = __uint_as_float(rr[1]); }
            float v0 = -INFINITY, v1 = -INFINITY, v2 = -INFINITY; int i0 = 0, i1 = 0, i2 = 0;
#pragma unroll
            for (int j = 0; j < 16; ++j) { const float a = (j < qb) ? g16[j] : -INFINITY;
                if (a > v0) { v2 = v1; i2 = i1; v1 = v0; i1 = i0; v0 = a; i0 = j; } else if (a > v1) { v2 = v1; i2 = i1; v1 = a; i1 = j; } else if (a > v2) { v2 = a; i2 = j; } }
            selmask = (qb <= 3) ? ((1u << qb) - 1u) : ((1u << i0) | (1u << i1) | (1u << i2));
        }
        float m_run = -1e30f, l_run = 0.f; f32x16 o[4];
#pragma unroll
        for (int db = 0; db < 4; ++db)
#pragma unroll
            for (int r = 0; r < 16; ++r) o[db][r] = 0.f;
        const int qin = 128 * half + 32 * wq + q31;
#pragma unroll 1
        for (int st2 = 0; st2 < nstep; st2 += 2)
#pragma unroll
        for (int par = 0; par < 2; ++par) { const int st = st2 + par; if (st < nstep) {
            asm volatile("s_waitcnt vmcnt(0)" ::: "memory"); __builtin_amdgcn_s_barrier(); asm volatile("" ::: "memory");
            if (st + 1 < nstep) attn_dma_step(K, V, lds, b, h, qb, n_own, st + 1, par ^ 1, wave, lane);
            const int T = 2 * st + kvh; const bool own = T < n_own;
            const int blk = own ? qb : ((T - n_own) >> 2), kt = own ? T : ((T - n_own) & 3);
            const bool sel = own ? true : ((selmask >> blk) & 1u);
            const bool skip = own ? (64 * kt > 128 * half + 32 * wq + 31) : (__ballot(sel) == 0ull);
            if (!skip) {
                const unsigned kimg = lds0 + par * 65536 + kvh * 32768, vimg = kimg + 16384;
                f32x16 p[2];
#pragma unroll
                for (int kh = 0; kh < 2; ++kh) {
#pragma unroll
                    for (int r = 0; r < 16; ++r) p[kh][r] = 0.f;
                    const int row = 32 * kh + q31;
#pragma unroll
                    for (int s = 0; s < 8; ++s) { const bf16x8 a = *(const LAS bf16x8*)(uintptr_t)(kimg + row * 256 + (((2 * s + hh) ^ (row & 15)) << 4));
                        p[kh] = __builtin_amdgcn_mfma_f32_32x32x16_bf16(a, qf[s], p[kh], 0, 0, 0); }
                }
                if (own) { const int kbase = 64 * kt;
                    if (kbase + 63 > 128 * half + 32 * wq) {
#pragma unroll
                        for (int kh = 0; kh < 2; ++kh)
#pragma unroll
                            for (int r = 0; r < 16; ++r) if (kbase + 32 * kh + crow16(r, hh) > qin) p[kh][r] = -INFINITY; }
                }
                float mx = p[0][0];
#pragma unroll
                for (int r = 1; r < 16; ++r) mx = fmaxf(mx, p[0][r]);
#pragma unroll
                for (int r = 0; r < 16; ++r) mx = fmaxf(mx, p[1][r]);
                { const auto rr = __builtin_amdgcn_permlane32_swap(__float_as_uint(mx), __float_as_uint(mx), false, false); mx = fmaxf(__uint_as_float(rr[0]), __uint_as_float(rr[1])); }
                if (!sel) mx = -INFINITY;
                const float m_new = fmaxf(m_run, mx), scl = __builtin_amdgcn_exp2f(m_run - m_new); m_run = m_new;
                float rs = 0.f;
#pragma unroll
                for (int kh = 0; kh < 2; ++kh)
#pragma unroll
                    for (int r = 0; r < 16; ++r) { p[kh][r] = __builtin_amdgcn_exp2f(p[kh][r] - m_new); rs += p[kh][r]; }
                l_run = l_run * scl + (sel ? rs : 0.f);
                if (__ballot(scl != 1.0f) != 0ull) {
#pragma unroll
                    for (int db = 0; db < 4; ++db)
#pragma unroll
                        for (int r = 0; r < 16; ++r) o[db][r] *= scl; }
                const unsigned pmask = sel ? 0xffffffffu : 0u;
                bf16x8 pb[4];
#pragma unroll
                for (int gi = 0; gi < 4; ++gi) { const int kh = gi >> 1, s2 = gi & 1; v4u pw;
                    pw.x = pg8::cvt_pk_bf16(p[kh][8 * s2], p[kh][8 * s2 + 1]) & pmask; pw.y = pg8::cvt_pk_bf16(p[kh][8 * s2 + 2], p[kh][8 * s2 + 3]) & pmask;
                    pw.z = pg8::cvt_pk_bf16(p[kh][8 * s2 + 4], p[kh][8 * s2 + 5]) & pmask; pw.w = pg8::cvt_pk_bf16(p[kh][8 * s2 + 6], p[kh][8 * s2 + 7]) & pmask;
                    pb[gi] = __builtin_bit_cast(bf16x8, pw); }
                v4i16_t lo[2][2], hi_[2][2];
                const int dsub = 16 * (G4 & 1) + 4 * (l16 & 3);
#define ATTN_VREADS(u, S) { const int key0_ = 32 * ((u) >> 2) + 16 * (((u) >> 1) & 1) + 4 * (G4 >> 1) + (l16 >> 2); _Pragma("unroll") for (int d2 = 0; d2 < 2; ++d2) { const int db = 2 * ((u) & 1) + d2; \
                    const unsigned a0_ = vimg + key0_ * 256 + ((db ^ (key0_ & 3)) << 6) + dsub * 2; \
                    asm volatile("ds_read_b64_tr_b16 %0, %1" : "=&v"(lo[S][d2]) : "v"(a0_) : "memory"); \
                    asm volatile("ds_read_b64_tr_b16 %0, %1 offset:2048" : "=&v"(hi_[S][d2]) : "v"(a0_) : "memory"); } }
#define ATTN_VWAIT(S, N) asm volatile("s_waitcnt lgkmcnt(" #N ")" : "+v"(lo[S][0]), "+v"(lo[S][1]), "+v"(hi_[S][0]), "+v"(hi_[S][1]) :: "memory")
#define ATTN_PV(u, S) { _Pragma("unroll") for (int d2 = 0; d2 < 2; ++d2) { const int db = 2 * ((u) & 1) + d2; const bf16x8 av = {lo[S][d2][0], lo[S][d2][1], lo[S][d2][2], lo[S][d2][3], hi_[S][d2][0], hi_[S][d2][1], hi_[S][d2][2], hi_[S][d2][3]}; \
                    o[db] = __builtin_amdgcn_mfma_f32_32x32x16_bf16(av, pb[(u) >> 1], o[db], 0, 0, 0); } }
                ATTN_VREADS(0, 0)
                ATTN_VREADS(1, 1) ATTN_VWAIT(0, 4); ATTN_PV(0, 0)
                ATTN_VREADS(2, 0) ATTN_VWAIT(1, 4); ATTN_PV(1, 1)
                ATTN_VREADS(3, 1) ATTN_VWAIT(0, 4); ATTN_PV(2, 0)
                ATTN_VREADS(4, 0) ATTN_VWAIT(1, 4); ATTN_PV(3, 1)
                ATTN_VREADS(5, 1) ATTN_VWAIT(0, 4); ATTN_PV(4, 0)
                ATTN_VREADS(6, 0) ATTN_VWAIT(1, 4); ATTN_PV(5, 1)
                ATTN_VREADS(7, 1) ATTN_VWAIT(0, 4); ATTN_PV(6, 0)
                ATTN_VWAIT(1, 0); ATTN_PV(7, 1)
#undef ATTN_VREADS
#undef ATTN_VWAIT
#undef ATTN_PV
            }
        } }
        l_run += __shfl_xor(l_run, 32);
        asm volatile("s_waitcnt vmcnt(0) lgkmcnt(0)" ::: "memory"); __builtin_amdgcn_s_barrier(); asm volatile("" ::: "memory");
        LAS float* xs = (LAS float*)lds + (size_t)wq * 66 * 64 + lane;
        if (kvh == 1) {
            xs[0] = m_run; xs[64] = l_run;
#pragma unroll
            for (int db = 0; db < 4; ++db)
#pragma unroll
                for (int r = 0; r < 16; ++r) xs[(2 + 16 * db + r) * 64] = o[db][r];
        }
        asm volatile("s_waitcnt lgkmcnt(0)" ::: "memory"); __builtin_amdgcn_s_barrier(); asm volatile("" ::: "memory");
        if (kvh == 0) {
            const float m2 = xs[0], l2 = xs[64], mt = fmaxf(m_run, m2), a1 = __builtin_amdgcn_exp2f(m_run - mt), a2 = __builtin_amdgcn_exp2f(m2 - mt);
            const float inv = 1.0f / (l_run * a1 + l2 * a2), c1 = a1 * inv, c2 = a2 * inv;
            bf16* orow = AO + rowq * 1024 + h * 128 + 4 * hh;
#pragma unroll
            for (int db = 0; db < 4; ++db)
#pragma unroll
                for (int g = 0; g < 4; ++g) {
                    float t[4];
#pragma unroll
                    for (int e = 0; e < 4; ++e) t[e] = o[db][4 * g + e] * c1 + xs[(2 + 16 * db + 4 * g + e) * 64] * c2;
                    u32x2v w; w.x = pg8::cvt_pk_bf16(t[0], t[1]); w.y = pg8::cvt_pk_bf16(t[2], t[3]);
                    *(GAS u32x2v*)(orow + 32 * db + 8 * g) = w;
                }
        }
    }
    asm volatile("s_waitcnt vmcnt(0) lgkmcnt(0)" ::: "memory"); __builtin_amdgcn_s_barrier(); asm volatile("" ::: "memory");
}
__device__ __forceinline__ void up8(const v4u w, float (&f)[8]) { f[0] = bflo(w.x); f[1] = bfhi(w.x); f[2] = bflo(w.y); f[3] = bfhi(w.y); f[4] = bflo(w.z); f[5] = bfhi(w.z); f[6] = bflo(w.w); f[7] = bfhi(w.w); }
__device__ __forceinline__ void conv_phase(const Ctx& F, const bf16* CB, const bf16* CC, const bf16* CX, const float* cw, bf16* UC) {
    const int gt = (F.vcu * NWAVES + F.wave) * 64 + F.lane, NT = F.G * NWAVES * 64;
    for (int idx = gt; idx < M * 128; idx += NT) {
        const int row = idx >> 7, c8 = (idx & 127) << 3, t = row & (SEQ - 1); const size_t off = (size_t)row * 1024 + c8;
        float cb[8], a[8], x[8], z0[8], z1[8], z2[8];
        up8(*(const GAS v4u*)(CB + off), cb); up8(*(const GAS v4u*)(CC + off), a); up8(*(const GAS v4u*)(CX + off), x);
#pragma unroll
        for (int j = 0; j < 8; ++j) z0[j] = a[j] * x[j];
        if (t >= 1) { up8(*(const GAS v4u*)(CC + off - 1024), a); up8(*(const GAS v4u*)(CX + off - 1024), x);
#pragma unroll
            for (int j = 0; j < 8; ++j) z1[j] = a[j] * x[j]; } else {
#pragma unroll
            for (int j = 0; j < 8; ++j) z1[j] = 0.f; }
        if (t >= 2) { up8(*(const GAS v4u*)(CC + off - 2048), a); up8(*(const GAS v4u*)(CX + off - 2048), x);
#pragma unroll
            for (int j = 0; j < 8; ++j) z2[j] = a[j] * x[j]; } else {
#pragma unroll
            for (int j = 0; j < 8; ++j) z2[j] = 0.f; }
        float o[8];
#pragma unroll
        for (int j = 0; j < 8; ++j) o[j] = cb[j] * (cw[c8 + j] * z2[j] + cw[1024 + c8 + j] * z1[j] + cw[2048 + c8 + j] * z0[j]);
        v4u w; w.x = pk2(o[0], o[1]); w.y = pk2(o[2], o[3]); w.z = pk2(o[4], o[5]); w.w = pk2(o[6], o[7]); *(GAS v4u*)(UC + off) = w;
    }
}

__device__ __forceinline__ int imax(int a, int b) { return a > b ? a : b; }
__device__ __forceinline__ int imin(int a, int b) { return a < b ? a : b; }
__device__ __forceinline__ void ce(int& a, int& b) { const int t = imax(a, b); b = imin(a, b); a = t; }
__device__ __forceinline__ void sort16(int (&x)[16]) {
#pragma unroll
    for (int kk = 1; kk <= 4; ++kk)
#pragma unroll
        for (int jj = kk - 1; jj >= 0; --jj)
#pragma unroll
            for (int i = 0; i < 16; ++i) { const int k = 1 << kk, j = 1 << jj, l = i ^ j; if (l > i) { if ((i & k) == 0) ce(x[i], x[l]); else ce(x[l], x[i]); } }
}
__device__ __forceinline__ void bmerge16(int (&a)[16]) {
#pragma unroll
    for (int jj = 3; jj >= 0; --jj)
#pragma unroll
        for (int i = 0; i < 16; ++i) { const int j = 1 << jj, l = i ^ j; if (l > i) ce(a[i], a[l]); }
}
__device__ __forceinline__ void merge16(int (&a)[16], const int (&b)[16]) {
#pragma unroll
    for (int i = 0; i < 16; ++i) a[i] = imax(a[i], b[15 - i]);
    bmerge16(a);
}
__device__ __forceinline__ void xmerge16(int (&a)[16], int hh) {
    int pv[16];
#pragma unroll
    for (int i = 0; i < 16; ++i) { const auto r = __builtin_amdgcn_permlane32_swap((unsigned)a[15 - i], (unsigned)a[15 - i], false, false); pv[i] = hh ? (int)r[0] : (int)r[1]; }
#pragma unroll
    for (int i = 0; i < 16; ++i) a[i] = imax(a[i], pv[i]);
    bmerge16(a);
}
__device__ __forceinline__ int ord_key(float f) { const int u = __float_as_int(f); return u >= 0 ? u : (u ^ 0x7fffffff); }
__device__ __forceinline__ float ord_val(int k) { return __int_as_float(k >= 0 ? k : (k ^ 0x7fffffff)); }
__device__ __forceinline__ unsigned byte16(const unsigned (&t)[4], int idx) {
    const unsigned sel = 0x0c0c0c00u | (unsigned)(idx & 7);
    const unsigned lo = __builtin_amdgcn_perm(t[1], t[0], sel), hi_ = __builtin_amdgcn_perm(t[3], t[2], sel);
    return (idx & 8) ? hi_ : lo;
}
__device__ __forceinline__ void topk_stage_keys(const Ctx& F, const bf16* KEYS, int h) {
    for (int pc = F.wave; pc < 64; pc += 8) { const int pp = pc >> 5, row = 4 * (pc & 31) + (F.lane >> 4), cp = F.lane & 15, c = cp ^ (row & 15);
        __builtin_amdgcn_global_load_lds((const unsigned*)(KEYS + (size_t)((h * 2 + pp) * 128 + row) * 128 + 8 * c), (LAS unsigned*)(F.lds + RING_OFF + pc * 1024), 16, 0, 0); }
    asm volatile("s_waitcnt vmcnt(0)" ::: "memory"); __builtin_amdgcn_s_barrier(); asm volatile("" ::: "memory");
}
__device__ __forceinline__ void topk_phase(const Ctx& F, int bitem, const bf16* QP, int* EXP, float* GATE) {
    const int lane = F.lane, l31 = lane & 31, hh = lane >> 5;
    const int IMIN = (int)0x80000000;
    const unsigned lds0 = (unsigned)(uintptr_t)(F.lds + RING_OFF);
    {
        const int h = bitem & 7, tt = (bitem >> 3) * 8 + F.wave, tok0 = tt * 32;
        int top[2][16];
#pragma unroll
        for (int p = 0; p < 2; ++p) {
            bf16x8 qa[8];
#pragma unroll
            for (int s = 0; s < 8; ++s) qa[s] = *(const GAS bf16x8*)(QP + (size_t)(tok0 + l31) * 2048 + h * 256 + p * 128 + 16 * s + 8 * hh);
            int x[2][16];
#pragma unroll
            for (int pq = 0; pq < 2; ++pq) {
                f32x16 sc[2];
#pragma unroll
                for (int nt = 0; nt < 2; ++nt)
#pragma unroll
                    for (int r = 0; r < 16; ++r) sc[nt][r] = 0.f;
#pragma unroll
                for (int s = 0; s < 8; ++s) {
#pragma unroll
                    for (int nt = 0; nt < 2; ++nt) { const int n = 64 * pq + 32 * nt + l31; const bf16x8 kb = *(const LAS bf16x8*)(uintptr_t)(lds0 + p * 32768 + n * 256 + (((2 * s + hh) ^ (n & 15)) << 4));
                        sc[nt] = __builtin_amdgcn_mfma_f32_32x32x16_bf16(kb, qa[s], sc[nt], 0, 0, 0); }
                }
                int y[16];
#pragma unroll
                for (int r = 0; r < 16; ++r) { x[pq][r] = (ord_key(sc[0][r]) & ~127) | ((127 - 64 * pq - (r & 3) - 8 * (r >> 2)) - 4 * hh); y[r] = (ord_key(sc[1][r]) & ~127) | ((127 - 64 * pq - 32 - (r & 3) - 8 * (r >> 2)) - 4 * hh); }
                sort16(x[pq]); sort16(y); merge16(x[pq], y);
                asm volatile("" ::: "memory");
            }
            merge16(x[0], x[1]);
            xmerge16(x[0], hh);
#pragma unroll
            for (int i = 0; i < 16; ++i) top[p][i] = x[0][i];
        }
        float fa[16], fb[16];
#pragma unroll
        for (int i = 0; i < 16; ++i) { const int A = hh ? top[1][i] : top[0][i], B = hh ? top[0][i] : top[1][i]; fa[i] = ord_val(A & ~127); fb[i] = ord_val(B & ~127); }
        int c0[16], c1[16];
#pragma unroll
        for (int q = 0; q < 32; ++q) {
            int key = IMIN;
            if (q < 27) { const int i = (q < 16) ? 0 : (q < 23) ? 1 : (q < 26) ? 2 : 3, j = (q < 16) ? q : (q < 23) ? q - 15 : (q < 26) ? q - 21 : 3; const float sv = fa[i] + fb[j]; const int low = hh ? (255 - (j * 16 + i)) : (255 - (i * 16 + j));
                key = (ord_key(sv) & ~255) | low; if (i == j && hh) key = IMIN; }
            if (q < 16) c0[q] = key; else c1[q - 16] = key;
        }
        sort16(c0); sort16(c1); merge16(c0, c1); xmerge16(c0, hh);
        unsigned na[4], nb[4];
#pragma unroll
        for (int d = 0; d < 4; ++d) { na[d] = 0u; nb[d] = 0u;
#pragma unroll
            for (int e = 0; e < 4; ++e) { na[d] |= (unsigned)(127 - (top[0][4 * d + e] & 127)) << (8 * e); nb[d] |= (unsigned)(127 - (top[1][4 * d + e] & 127)) << (8 * e); } }
        int ex[16]; float ev[16]; float es = 0.f; const float smax = ord_val(c0[0] & ~255);
#pragma unroll
        for (int q = 0; q < 16; ++q) { const int posn = 255 - (c0[q] & 255); const unsigned n1 = byte16(na, posn >> 4) & 255u, n2 = byte16(nb, posn & 15) & 255u;
            ex[q] = (int)(n1 * 128u + n2); ev[q] = __expf(ord_val(c0[q] & ~255) - smax); es += ev[q]; }
        const float ri = 1.0f / es; const size_t ob = (size_t)(tok0 + l31) * 128 + h * 16;
        if (hh == 0) {
#pragma unroll
            for (int d = 0; d < 4; ++d) { v4u w; w.x = (unsigned)ex[4 * d]; w.y = (unsigned)ex[4 * d + 1]; w.z = (unsigned)ex[4 * d + 2]; w.w = (unsigned)ex[4 * d + 3]; *(GAS v4u*)(EXP + ob + 4 * d) = w; }
        } else {
#pragma unroll
            for (int d = 0; d < 4; ++d) *(GAS f32x4*)(GATE + ob + 4 * d) = (f32x4){ev[4 * d] * ri, ev[4 * d + 1] * ri, ev[4 * d + 2] * ri, ev[4 * d + 3] * ri};
        }
    }
}

typedef float f32x2 __attribute__((ext_vector_type(2)));
constexpr float PEER_SU = 512.0f, PEER_SV = 32.0f;
template <int CTRL> __device__ __forceinline__ int dpp_i(int v) { return __builtin_amdgcn_update_dpp(v, v, CTRL, 0xf, 0xf, false); }
template <int J> __device__ __forceinline__ int xor_lane(int v, int lane) {
    if constexpr (J == 1) return dpp_i<0xB1>(v);
    else if constexpr (J == 2) return dpp_i<0x4E>(v);
    else if constexpr (J == 16) { const auto r = __builtin_amdgcn_permlane16_swap((unsigned)v, (unsigned)v, false, false); return ((lane >> 4) & 1) ? (int)r[0] : (int)r[1]; }
    else if constexpr (J == 32) { const auto r = __builtin_amdgcn_permlane32_swap((unsigned)v, (unsigned)v, false, false); return (lane >> 5) ? (int)r[0] : (int)r[1]; }
    else return __shfl_xor(v, J);
}
__device__ __forceinline__ float wave_sum_dpp(float v) {
    v += __int_as_float(dpp_i<0xB1>(__float_as_int(v))); v += __int_as_float(dpp_i<0x4E>(__float_as_int(v))); v += __int_as_float(dpp_i<0x141>(__float_as_int(v))); v += __int_as_float(dpp_i<0x140>(__float_as_int(v)));
    { const auto r = __builtin_amdgcn_permlane16_swap(__float_as_uint(v), __float_as_uint(v), false, false); v = __uint_as_float(r[0]) + __uint_as_float(r[1]); }
    { const auto r = __builtin_amdgcn_permlane32_swap(__float_as_uint(v), __float_as_uint(v), false, false); v = __uint_as_float(r[0]) + __uint_as_float(r[1]); }
    return v; }
template <int KK, int JJ> __device__ __forceinline__ void sort512_step(int (&x)[8], int lane) {
    constexpr int k = 1 << KK, j = 1 << JJ;
    if constexpr (j >= 64) { constexpr int jr = j >> 6;
#pragma unroll
        for (int r = 0; r < 8; ++r) if ((r & jr) == 0) { const bool asc = (k >= 512) ? true : (((r << 6) & k) == 0); const int lo = imin(x[r], x[r | jr]), hi_ = imax(x[r], x[r | jr]); x[r] = asc ? lo : hi_; x[r | jr] = asc ? hi_ : lo; }
    } else {
        const bool lower = (lane & j) == 0;
#pragma unroll
        for (int r = 0; r < 8; ++r) { const int y = xor_lane<j>(x[r], lane);
            const bool asc = (k < 64) ? ((lane & k) == 0) : ((k >= 512) ? true : (((r << 6) & k) == 0));
            x[r] = (lower == asc) ? imin(x[r], y) : imax(x[r], y); }
    }
}
template <int KK, int JJ> __device__ __forceinline__ void sort512_stage(int (&x)[8], int lane) { sort512_step<KK, JJ>(x, lane); if constexpr (JJ > 0) sort512_stage<KK, JJ - 1>(x, lane); }
__device__ __forceinline__ void sort512(int (&x)[8], int lane) {
    sort512_stage<1, 0>(x, lane); sort512_stage<2, 1>(x, lane); sort512_stage<3, 2>(x, lane); sort512_stage<4, 3>(x, lane); sort512_stage<5, 4>(x, lane);
    sort512_stage<6, 5>(x, lane); sort512_stage<7, 6>(x, lane); sort512_stage<8, 7>(x, lane); sort512_stage<9, 8>(x, lane);
}
__device__ __forceinline__ void peer_phase(const Ctx& F, const unsigned char* U8, const unsigned char* V8, const bf16* X1B, const int* EXP, const float* GATE, const unsigned long long* SS, const float* gfin, const float* X1, float* OUT) {
    const int gw = F.vcu * NWAVES + F.wave, NGW = F.G * NWAVES, lane = F.lane;
    const unsigned xs0 = (unsigned)(uintptr_t)(F.lds + RING_OFF + F.wave * 16384) + lane * 16;
    for (int tb = gw; tb + 3 * NGW < M; tb += 4 * NGW) {
        int kreg[8]; float greg[8], rv[4];
#pragma unroll
        for (int j = 0; j < 4; ++j) { const size_t t = (size_t)tb + (size_t)j * NGW;
            kreg[2 * j] = (EXP[t * 128 + lane] << 9) | (j << 7) | lane; kreg[2 * j + 1] = (EXP[t * 128 + 64 + lane] << 9) | (j << 7) | (64 + lane);
            rv[j] = pg8::rinv_from_ss(SS[t]) * (1.0f / PEER_SU);
#pragma unroll
            for (int q = 0; q < 4; ++q) { const v4u w = *(const GAS v4u*)(X1B + t * DM + (q >> 1) * 1024 + lane * 16 + 8 * (q & 1)); *(LAS v4u*)(uintptr_t)(xs0 + j * 4096 + q * 1024) = w; } }
        sort512(kreg, lane);
        int pkey[8];
#pragma unroll
        for (int c = 0; c < 8; ++c) { pkey[c] = __shfl(kreg[c], 8 * (lane & 7) + (lane >> 3)); greg[c] = GATE[((size_t)tb + (size_t)((pkey[c] >> 7) & 3) * NGW) * 128 + (pkey[c] & 127)]; }
        asm volatile("s_waitcnt lgkmcnt(0)" ::: "memory");
        float actreg[8];
#ifndef MK_P8_REPU
#define MK_P8_REPU 1
#endif
#pragma unroll 1
        for (int repu = 0; repu < MK_P8_REPU; ++repu) {
            v4u ub[8][2];
#pragma unroll
            for (int u = 0; u < 8; ++u) { const GAS v4u* up = (const GAS v4u*)(U8 + (size_t)(__builtin_amdgcn_readlane(kreg[0], u) >> 9) * 2048) + lane; ub[u][0] = up[0]; ub[u][1] = up[64]; }
#pragma unroll
            for (int c = 0; c < 8; ++c) {
                float areg = 0.f;
#pragma unroll 1
                for (int g = 0; g < 8; ++g) {
                    float pt[8];
#pragma unroll
                    for (int u = 0; u < 8; ++u) {
                        const int key = __builtin_amdgcn_readlane(kreg[c], 8 * g + u);
                        const unsigned xa = xs0 + ((key >> 7) & 3) * 4096;
                        float p0 = 0.f, p1 = 0.f;
#pragma unroll
                        for (int i = 0; i < 2; ++i) { const v4u w = ub[u][i];
#pragma unroll
                            for (int hv = 0; hv < 2; ++hv) { const v4u xq = *(const LAS v4u*)(uintptr_t)(xa + (2 * i + hv) * 1024);
                                const unsigned w0 = hv ? w.z : w.x, w1 = hv ? w.w : w.y;
                                const f32x2 a0 = __builtin_amdgcn_cvt_pk_f32_fp8((int)w0, false), a1 = __builtin_amdgcn_cvt_pk_f32_fp8((int)w0, true), a2 = __builtin_amdgcn_cvt_pk_f32_fp8((int)w1, false), a3 = __builtin_amdgcn_cvt_pk_f32_fp8((int)w1, true);
                                p0 = dot2bf(pg8::cvt_pk_bf16(a0[0], a0[1]), xq.x, p0); p1 = dot2bf(pg8::cvt_pk_bf16(a1[0], a1[1]), xq.y, p1);
                                p0 = dot2bf(pg8::cvt_pk_bf16(a2[0], a2[1]), xq.z, p0); p1 = dot2bf(pg8::cvt_pk_bf16(a3[0], a3[1]), xq.w, p1); } }
                        pt[u] = p0 + p1;
                        { const int ix = 8 * g + 8 + u, ka = __builtin_amdgcn_readlane(kreg[c], ix & 63), kb = __builtin_amdgcn_readlane(kreg[c < 7 ? c + 1 : 7], ix & 63), kn = (ix < 64) ? ka : kb;
                            const GAS v4u* up = (const GAS v4u*)(U8 + (size_t)(kn >> 9) * 2048) + lane; ub[u][0] = up[0]; ub[u][1] = up[64]; }
                    }
                    { const bool b5 = (lane & 32) != 0, b4 = (lane & 16) != 0, b3 = (lane & 8) != 0;
#pragma unroll
                      for (int i = 0; i < 4; ++i) { const float a = pt[i], b = pt[i + 4]; pt[i] = (b5 ? b : a) + __int_as_float(xor_lane<32>(__float_as_int(b5 ? a : b), lane)); }
#pragma unroll
                      for (int i = 0; i < 2; ++i) { const float a = pt[i], b = pt[i + 2]; pt[i] = (b4 ? b : a) + __int_as_float(xor_lane<16>(__float_as_int(b4 ? a : b), lane)); }
                      { const float a = pt[0], b = pt[1]; pt[0] = (b3 ? b : a) + __shfl_xor(b3 ? a : b, 8); }
                      float r = pt[0]; r += __shfl_xor(r, 4); r += __int_as_float(dpp_i<0x4E>(__float_as_int(r))); r += __int_as_float(dpp_i<0xB1>(__float_as_int(r)));
                      areg = ((lane & 7) == g) ? r : areg; }
                }
                const int tk = (pkey[c] >> 7) & 3; const float rr = (tk == 0) ? rv[0] : (tk == 1) ? rv[1] : (tk == 2) ? rv[2] : rv[3];
                actreg[c] = gelu_tanh(areg * rr) * greg[c] * (1.0f / PEER_SV);
            }
        }
        LAS float* as = (LAS float*)(uintptr_t)(xs0 - lane * 16);
        asm volatile("s_waitcnt lgkmcnt(0)" ::: "memory");
#pragma unroll
        for (int c = 0; c < 8; ++c) as[64 * c + lane] = actreg[c];
        int k2[8];
#pragma unroll
        for (int c = 0; c < 8; ++c) { const int key = kreg[c], tok = (key >> 7) & 3, park = 64 * c + 8 * (lane & 7) + (lane >> 3);
            k2[c] = ((tok >> 1) << 24) | ((key >> 9) << 10) | ((tok & 1) << 9) | park; }
        sort512(k2, lane);
        asm volatile("s_waitcnt lgkmcnt(0)" ::: "memory");
        float a2[8];
#pragma unroll
        for (int c = 0; c < 8; ++c) a2[c] = as[k2[c] & 511];
#pragma unroll 1
        for (int pp = 0; pp < 2; ++pp) {
            int kq[4]; float aq[4];
#pragma unroll
            for (int c = 0; c < 4; ++c) { kq[c] = pp ? k2[4 + c] : k2[c]; aq[c] = pp ? a2[4 + c] : a2[c]; }
            f32x2 y[2][16];
#pragma unroll
            for (int j = 0; j < 2; ++j)
#pragma unroll
                for (int q = 0; q < 16; ++q) y[j][q] = (f32x2){0.f, 0.f};
            v4u vb[8][2];
#pragma unroll
            for (int u = 0; u < 8; ++u) { const GAS v4u* vp = (const GAS v4u*)(V8 + (size_t)((__builtin_amdgcn_readlane(kq[0], u) >> 10) & 0x3fff) * 2048) + lane; vb[u][0] = vp[0]; vb[u][1] = vp[64]; }
#pragma unroll
            for (int c = 0; c < 4; ++c) {
#pragma unroll 1
                for (int g = 0; g < 8; ++g) {
#pragma unroll
                    for (int u = 0; u < 8; ++u) {
                        const int key = __builtin_amdgcn_readlane(kq[c], 8 * g + u); const float s = rdlane(aq[c], 8 * g + u);
                        const float sa = (key & 512) ? 0.f : s, sb = (key & 512) ? s : 0.f; const f32x2 s0 = {sa, sa}, s1 = {sb, sb};
#pragma unroll
                        for (int i = 0; i < 2; ++i) { const v4u w = vb[u][i];
                            const f32x2 c0 = __builtin_amdgcn_cvt_pk_f32_fp8((int)w.x, false), c1 = __builtin_amdgcn_cvt_pk_f32_fp8((int)w.x, true), c2 = __builtin_amdgcn_cvt_pk_f32_fp8((int)w.y, false), c3 = __builtin_amdgcn_cvt_pk_f32_fp8((int)w.y, true);
                            const f32x2 c4 = __builtin_amdgcn_cvt_pk_f32_fp8((int)w.z, false), c5 = __builtin_amdgcn_cvt_pk_f32_fp8((int)w.z, true), c6 = __builtin_amdgcn_cvt_pk_f32_fp8((int)w.w, false), c7 = __builtin_amdgcn_cvt_pk_f32_fp8((int)w.w, true);
                            y[0][8 * i + 0] = __builtin_elementwise_fma(c0, s0, y[0][8 * i + 0]); y[1][8 * i + 0] = __builtin_elementwise_fma(c0, s1, y[1][8 * i + 0]);
                            y[0][8 * i + 1] = __builtin_elementwise_fma(c1, s0, y[0][8 * i + 1]); y[1][8 * i + 1] = __builtin_elementwise_fma(c1, s1, y[1][8 * i + 1]);
                            y[0][8 * i + 2] = __builtin_elementwise_fma(c2, s0, y[0][8 * i + 2]); y[1][8 * i + 2] = __builtin_elementwise_fma(c2, s1, y[1][8 * i + 2]);
                            y[0][8 * i + 3] = __builtin_elementwise_fma(c3, s0, y[0][8 * i + 3]); y[1][8 * i + 3] = __builtin_elementwise_fma(c3, s1, y[1][8 * i + 3]);
                            y[0][8 * i + 4] = __builtin_elementwise_fma(c4, s0, y[0][8 * i + 4]); y[1][8 * i + 4] = __builtin_elementwise_fma(c4, s1, y[1][8 * i + 4]);
                            y[0][8 * i + 5] = __builtin_elementwise_fma(c5, s0, y[0][8 * i + 5]); y[1][8 * i + 5] = __builtin_elementwise_fma(c5, s1, y[1][8 * i + 5]);
                            y[0][8 * i + 6] = __builtin_elementwise_fma(c6, s0, y[0][8 * i + 6]); y[1][8 * i + 6] = __builtin_elementwise_fma(c6, s1, y[1][8 * i + 6]);
                            y[0][8 * i + 7] = __builtin_elementwise_fma(c7, s0, y[0][8 * i + 7]); y[1][8 * i + 7] = __builtin_elementwise_fma(c7, s1, y[1][8 * i + 7]); }
                        { const int ix = 8 * g + 8 + u, ka = __builtin_amdgcn_readlane(kq[c], ix & 63), kb = __builtin_amdgcn_readlane(kq[c < 3 ? c + 1 : 3], ix & 63), kn = (ix < 64) ? ka : kb;
                            const GAS v4u* vp = (const GAS v4u*)(V8 + (size_t)((kn >> 10) & 0x3fff) * 2048) + lane; vb[u][0] = vp[0]; vb[u][1] = vp[64]; }
                    }
                }
            }
#pragma unroll
            for (int j = 0; j < 2; ++j) { const size_t t = (size_t)tb + (size_t)(2 * pp + j) * NGW;
                GAS f32x4* orw = (GAS f32x4*)(OUT + t * DM); float ss = 0.f;
#pragma unroll
                for (int i = 0; i < 2; ++i)
#pragma unroll
                    for (int hv = 0; hv < 2; ++hv) { const v4u w = *(const GAS v4u*)(X1B + t * DM + i * 1024 + lane * 16 + 8 * hv);
                        y[j][8 * i + 4 * hv + 0] += (f32x2){bflo(w.x), bfhi(w.x)}; y[j][8 * i + 4 * hv + 1] += (f32x2){bflo(w.y), bfhi(w.y)}; y[j][8 * i + 4 * hv + 2] += (f32x2){bflo(w.z), bfhi(w.z)}; y[j][8 * i + 4 * hv + 3] += (f32x2){bflo(w.w), bfhi(w.w)}; }
#pragma unroll
                for (int q = 0; q < 16; ++q) ss += y[j][q][0] * y[j][q][0] + y[j][q][1] * y[j][q][1];
                const float r3 = 1.0f / sqrtf(wave_sum_dpp(ss) * (1.0f / DM) + RMS_EPS);
#pragma unroll
                for (int i = 0; i < 2; ++i)
#pragma unroll
                    for (int q = 0; q < 4; ++q) { const f32x4 ga = *(const GAS f32x4*)(gfin + i * 1024 + lane * 16 + 4 * q);
                        orw[i * 256 + 4 * lane + q] = (f32x4){y[j][8 * i + 2 * q][0] * r3 * ga[0], y[j][8 * i + 2 * q][1] * r3 * ga[1], y[j][8 * i + 2 * q + 1][0] * r3 * ga[2], y[j][8 * i + 2 * q + 1][1] * r3 * ga[3]}; }
            }
        }
        asm volatile("s_waitcnt lgkmcnt(0)" ::: "memory");
    }
}

struct Args { const float* in[15]; float* out; unsigned char* ws; double invf[16]; int ph_lo, ph_hi, li, pad; };
__global__ void __launch_bounds__(NWAVES * 64, 2) mk_fwd(Args args) {
    extern __shared__ __attribute__((aligned(16))) unsigned char lds[];
    Ctx F;
    F.lds = (LAS unsigned char*)lds;
    volatile LAS unsigned* MISC = (volatile LAS unsigned*)(F.lds + MISC_OFF);
    F.tid = threadIdx.x; F.lane = F.tid & 63; F.wave = __builtin_amdgcn_readfirstlane(F.tid >> 6);
    F.G = gridDim.x; { const int bx = blockIdx.x; F.vcu = (F.G % 8 == 0) ? (bx % 8) * (F.G / 8) + bx / 8 : bx; }
    unsigned char* ws = args.ws;
    gu32* ctl = (gu32*)(ws + WS_CTL);
    for (int u = F.tid; u < (LDS_BYTES - LDSCTL_OFF) / 4; u += NWAVES * 64) ((LAS unsigned*)(F.lds + LDSCTL_OFF))[u] = 0u;
    __syncthreads();
    XcdBarrier bar; bar.bar = (unsigned*)(ctl + CW_BAR); bar.x = 0; bar.st = nullptr;
    if (N_LAUNCHES != PER_PHASE) bar = xcd_barrier_post((unsigned*)(ctl + CW_BAR), MISC + 8);
#define GRID_BAR() do { if (N_LAUNCHES != PER_PHASE) xcd_barrier(bar); } while (0)
#define GRID_BAR_W(q) do { if (N_LAUNCHES != PER_PHASE) { const BarWork wk_{args.in[12], args.in[13], args.in[9], ws, (q), 4}; xcd_barrier(bar, &F, &wk_); } } while (0)
    const int lo = args.ph_lo, hi = args.ph_hi;
#define IN(k) (lo <= (k) && (k) < hi)
#define BOTH(k) (IN(k) && IN((k) + 1))
    bf16* WinT = (bf16*)(ws + WS_WIN); bf16* WbcT = (bf16*)(ws + WS_WBC); bf16* WbaT = (bf16*)(ws + WS_WBA); bf16* WoutT = (bf16*)(ws + WS_WOUT); bf16* WpqT = (bf16*)(ws + WS_WPQ);
    bf16* KEYS = (bf16*)(ws + WS_KEYS); float* CS = (float*)(ws + WS_CS); const unsigned char* UB = ws + WS_UB; const unsigned char* VB = ws + WS_VB;
    bf16* XB = (bf16*)(ws + WS_XB); bf16* T6 = (bf16*)(ws + WS_T6); bf16* GAB = (bf16*)(ws + WS_GAB); bf16* UC = (bf16*)(ws + WS_UC); bf16* AO = (bf16*)(ws + WS_AO);
    bf16* TMP = (bf16*)(ws + WS_TMP); bf16* MB = (bf16*)(ws + WS_MB); bf16* X1B = (bf16*)(ws + WS_X1B); bf16* QP = (bf16*)(ws + WS_QP);
    int* EXP = (int*)(ws + WS_EXP); float* GATE = (float*)(ws + WS_GATE);
    unsigned long long* SS = (unsigned long long*)(ws + WS_SS); float* KSUM = (float*)(ws + WS_KSUM);
    constexpr size_t TS = (size_t)M * 1024;

    if (IN(0)) { for (int rep = 0; rep < NREP(0); ++rep) { p0_prologue(F, args.in, ws, args.invf); if (rep + 1 < NREP(0)) GRID_BAR(); } if (BOTH(0)) GRID_BAR(); }
    if (IN(1)) {
        for (int rep = 0; rep < NREP(1); ++rep) {
        pg8::Gemm g{XB, WinT, M, INW, DM}; pg8::StaticOrder S; S.init(M, INW, F.G, (int)blockIdx.x);
        pg8::EpiIn E{T6, GAB, args.in[4], CS, KSUM};
        pg8::gemm_phase<pg8::EpiIn, pg8::StaticOrder, true, true>(F.lds + RING_OFF, g, S, E);
        if (rep + 1 < NREP(1)) GRID_BAR(); }
        if (BOTH(1)) GRID_BAR();
    }
    if (IN(2)) {
        for (int rep = 0; rep < NREP(2); ++rep) {
        attn_mfma(F, T6 + 3 * TS, T6 + 4 * TS, T6 + 5 * TS, KSUM, AO);
        conv_phase(F, T6, T6 + TS, T6 + 2 * TS, args.in[5], UC);
        if (rep + 1 < NREP(2)) GRID_BAR(); }
        if (BOTH(2)) GRID_BAR_W(0);
    }
    if (IN(3)) {
        for (int rep = 0; rep < NREP(3); ++rep) {
        pg8::Gemm g{UC, WbcT, M, DM, 1024, AO, WbaT}; pg8::TwoSegOrder S; S.init(M, DM, F.G, (int)blockIdx.x);
        pg8::EpiMerge2 E{GAB, GAB + (size_t)M * DM, MB};
        pg8::gemm_phase<pg8::EpiMerge2, pg8::TwoSegOrder, true, true>(F.lds + RING_OFF, g, S, E);
        if (rep + 1 < NREP(3)) GRID_BAR(); }
        if (BOTH(3)) GRID_BAR_W(1);
    }
    if (IN(5)) {
        for (int rep = 0; rep < NREP(5); ++rep) {
        pg8::Gemm g{MB, WoutT, M, DM, DM}; pg8::StaticOrder S; S.init(M, DM, F.G, (int)blockIdx.x);
        pg8::EpiX1 E{XB, (const float*)(ws + WS_RMS), X1B, (rep + 1 < NREP(5)) ? (unsigned long long*)(ws + 768 * 1024) : SS};
        pg8::gemm_phase<pg8::EpiX1, pg8::StaticOrder, true, true>(F.lds + RING_OFF, g, S, E);
        if (rep + 1 < NREP(5)) GRID_BAR(); }
        if (BOTH(5)) GRID_BAR_W(2);
    }
    if (IN(6)) {
        for (int rep = 0; rep < NREP(6); ++rep) {
        pg8::Gemm g{X1B, WpqT, M, DM, DM}; pg8::StaticOrder S; S.init(M, DM, F.G, (int)blockIdx.x);
        pg8::EpiQP E{SS, QP};
        pg8::gemm_phase<pg8::EpiQP, pg8::StaticOrder, true, true>(F.lds + RING_OFF, g, S, E);
        if (rep + 1 < NREP(6)) GRID_BAR(); }
        if (BOTH(6)) GRID_BAR_W(3);
    }
    if (IN(7)) { for (int rep = 0; rep < NREP(7); ++rep) {
        for (int bitem = F.vcu; bitem < 256; bitem += F.G) {
            topk_stage_keys(F, KEYS, bitem & 7);
            if (N_LAUNCHES == PER_PHASE && bitem == F.vcu) convert_tables(F, args.in[12], args.in[13], args.in[9], ws, 0, 1, 0);
            topk_phase(F, bitem, QP, EXP, GATE);
            asm volatile("s_waitcnt lgkmcnt(0)" ::: "memory"); __builtin_amdgcn_s_barrier(); asm volatile("" ::: "memory");
        }
        if (rep + 1 < NREP(7)) GRID_BAR(); } if (BOTH(7)) GRID_BAR(); }
    if (IN(8)) { for (int rep = 0; rep < NREP(8); ++rep) { peer_phase(F, UB, VB, X1B, EXP, GATE, SS, args.in[14], args.out, (rep + 1 < NREP(8)) ? (float*)(ws + WS_END) : args.out); if (rep + 1 < NREP(8)) GRID_BAR(); } }
#undef IN
#undef BOTH
#undef GRID_BAR
#undef GRID_BAR_W
}

extern "C" void kernel_launch(void* const* d_in, const int* in_sizes, int n_in, void* d_out, int out_size, void* d_ws, size_t ws_size, hipStream_t stream) {
    static int grid = 0;
    if (grid == 0) {
        if (n_in != 15 || in_sizes[0] != M * DM || out_size != M * DM || ws_size < WS_END) { fprintf(stderr, "kernel_launch: unexpected shapes (n_in %d, in0 %d, out %d, ws %zu)\n", n_in, n_in > 0 ? in_sizes[0] : -1, out_size, ws_size); grid = -1; return; }
        int dev = 0, cus = 0, per_cu = 0;
        if (hipGetDevice(&dev) != hipSuccess || hipDeviceGetAttribute(&cus, hipDeviceAttributeMultiprocessorCount, dev) != hipSuccess) { grid = -1; return; }
        if (hipFuncSetAttribute((const void*)mk_fwd, hipFuncAttributeMaxDynamicSharedMemorySize, LDS_BYTES) != hipSuccess) { fprintf(stderr, "kernel_launch: hipFuncSetAttribute failed\n"); grid = -1; return; }
        if (hipOccupancyMaxActiveBlocksPerMultiprocessor(&per_cu, (const void*)mk_fwd, NWAVES * 64, LDS_BYTES) != hipSuccess || per_cu < 1) fprintf(stderr, "kernel_launch: occupancy query reports %d\n", per_cu);
        (void)hipGetLastError();
        grid = cus;
        if (M % (4 * grid * NWAVES) != 0) { fprintf(stderr, "kernel_launch: the PEER phase needs M %% (32 * grid) == 0 (grid %d)\n", grid); grid = -1; return; }
    }
    if (grid < 0) return;
    if (hipMemsetAsync((char*)d_ws + WS_CTL, 0, CTL_ZERO_BYTES, stream) != hipSuccess) { fprintf(stderr, "kernel_launch: memset failed\n"); return; }
    Args a{};
    for (int i = 0; i < 15; ++i) a.in[i] = (const float*)d_in[i];
    a.out = (float*)d_out; a.ws = (unsigned char*)d_ws;
    for (int f = 0; f < 16; ++f) a.invf[f] = pow(500000.0, -(double)(2 * f) / 32.0);
    for (int li = 0; li < N_LAUNCHES; ++li) {
        a.ph_lo = (N_LAUNCHES == PER_PHASE) ? li : 0; a.ph_hi = (N_LAUNCHES == PER_PHASE) ? li + 1 : PER_PHASE; a.li = li;
        hipLaunchKernelGGL(mk_fwd, dim3(grid), dim3(NWAVES * 64), LDS_BYTES, stream, a);
        const hipError_t le = hipPeekAtLastError();
        if (le != hipSuccess) { fprintf(stderr, "kernel_launch: launch %d failed: %s\n", li, hipGetErrorName(le)); break; }
    }
}
```

```cpp
#include <hip/hip_runtime.h>
#include <cstdio>
#include <cstdint>
#include <cmath>
namespace pg8 {
#define PG8_LAS __attribute__((address_space(3)))
typedef unsigned short bf16_t;
typedef short bf16x8 __attribute__((ext_vector_type(8)));
typedef float f32x4 __attribute__((ext_vector_type(4)));
typedef unsigned u32x4 __attribute__((ext_vector_type(4)));
constexpr int BM = 256, BK = 64, HALF = 128, HTB = HALF * BK * 2  , STAGE_BYTES = 8 * HTB, NXCD = 8, WGM = 8;

__host__ __device__ __forceinline__ int lds_byte(int r, int c) { const int st = (r >> 4) * 2 + (c >> 5), rr = r & 15, cc = c & 31, ob = rr * 64 + cc * 2; return st * 1024 + (ob ^ (((ob >> 9) & 1) << 5)); }
__host__ __device__ __forceinline__ void stage_rc(int b, int& R, int& C) { const int st = b / 1024, sb = b % 1024, swz = sb ^ (((sb >> 9) & 1) << 5); R = (st >> 1) * 16 + swz / 64; C = (st & 1) * 32 + (swz % 64) / 2; }
__host__ __device__ __forceinline__ int perm32(int rho) { const int n = rho >> 4, i = rho & 15; return 8 * (i >> 2) + 4 * n + (i & 3); }

struct Unit { int pm, pn, seg; };
struct Gemm { const bf16_t* A; const bf16_t* Bt; int M, N, K; const bf16_t* A2; const bf16_t* Bt2; };

struct StaticOrder {
    int nM, nN, nwg, G, c;
    __host__ __device__ void init(int M, int N, int G_, int c_) { nM = M / BM; nN = N / BM; nwg = nM * nN; G = G_; c = c_; }
    __host__ __device__ bool next(int i, Unit& u) const {
        const long L = (long)i * G + c; if (L >= nwg) return false;
        int wgid = (int)L; { const int q = nwg / NXCD, r = nwg % NXCD, xcd = wgid % NXCD, off = wgid / NXCD; wgid = (xcd < r ? xcd * (q + 1) : r * (q + 1) + (xcd - r) * q) + off; }
        const int nig = WGM * nN, gid = wgid / nig, fm = gid * WGM, gsz = (nM - fm) < WGM ? (nM - fm) : WGM;
        u.pm = fm + ((wgid % nig) % gsz); u.pn = (wgid % nig) / gsz; u.seg = 0; return true;
    }
    __device__ __forceinline__ void a_ready(const Unit&) const {}
    __device__ __forceinline__ void done(const Unit&) const {}
};
struct TwoSegOrder {
    StaticOrder so;
    __host__ __device__ void init(int M, int N, int G_, int c_) { so.init(M, N, G_, c_); }
    __host__ __device__ bool next(int i, Unit& u) const { if (!so.next(i >> 1, u)) return false; u.seg = i & 1; return true; }
    __device__ __forceinline__ void a_ready(const Unit&) const {}
    __device__ __forceinline__ void done(const Unit&) const {}
};


typedef float f32x2c __attribute__((ext_vector_type(2))); typedef __bf16 bf16x2c __attribute__((ext_vector_type(2)));
__device__ __forceinline__ unsigned cvt_pk_bf16(float lo, float hi) { const f32x2c v = {lo, hi}; const bf16x2c b = __builtin_convertvector(v, bf16x2c); return __builtin_bit_cast(unsigned, b); }
__device__ __forceinline__ u32x4 pack8(f32x4 a, f32x4 b) { u32x4 w; w.x = cvt_pk_bf16(a[0], a[1]); w.y = cvt_pk_bf16(a[2], a[3]); w.z = cvt_pk_bf16(b[0], b[1]); w.w = cvt_pk_bf16(b[2], b[3]); return w; }
__device__ __forceinline__ f32x4 shx(f32x4 v, int o) { f32x4 r; r[0] = __shfl_xor(v[0], o); r[1] = __shfl_xor(v[1], o); r[2] = __shfl_xor(v[2], o); r[3] = __shfl_xor(v[3], o); return r; }
__device__ __forceinline__ f32x4 bf4lo(unsigned a, unsigned b) { f32x4 r; r[0] = __uint_as_float(a << 16); r[1] = __uint_as_float(a & 0xffff0000u); r[2] = __uint_as_float(b << 16); r[3] = __uint_as_float(b & 0xffff0000u); return r; }
__device__ __forceinline__ f32x4 sigm4(f32x4 v) { f32x4 r;
#pragma unroll
    for (int i = 0; i < 4; ++i) r[i] = __builtin_amdgcn_rcpf(1.0f + __expf(-v[i])); return r; }
constexpr float QSCALE = 0.08838834764831845f * 1.4426950408889634f;

struct EpiIn {
    static constexpr bool PERM = true, AFTER_DRAIN = false, KEEP_SEG0 = false;
    bf16_t* T6; bf16_t* GAB; const float* gbias; const float* cs; float* ksum;
    __device__ __forceinline__ void operator()(const f32x4 (&acc)[2][2][4][2], const Unit& u, int wr, int wc, int fr, int fq) const {
        const int row0 = u.pm * BM + wr * 64 + fr, pn = u.pn, colw = wc * 32 + 8 * fq;
        if (pn < 24) {
            const int t = pn >> 2;
            bf16_t* base = T6 + (size_t)t * ((size_t)8192 * 1024) + (pn & 3) * 256 + colw;
            const bool rot = (t == 3 || t == 4) && (wc == 0), isk = (t == 4), zt = (pn >= 4 && pn < 12);
            const float qs = (t == 3) ? QSCALE : 1.0f;
            f32x4 ks[2][2];
#pragma unroll
            for (int bj = 0; bj < 2; ++bj) { ks[bj][0] = (f32x4){0.f, 0.f, 0.f, 0.f}; ks[bj][1] = (f32x4){0.f, 0.f, 0.f, 0.f}; }
#pragma unroll
            for (int ai = 0; ai < 2; ++ai)
#pragma unroll
                for (int m = 0; m < 4; ++m) {
                    const int row = row0 + ai * HALF + m * 16;
                    f32x4 c0 = (f32x4){1.f, 1.f, 1.f, 1.f}, c1 = c0, s0 = (f32x4){0.f, 0.f, 0.f, 0.f}, s1 = s0;
                    if (rot) { const float* cp = cs + (size_t)row * 32 + 8 * (fq & 1); c0 = *(const f32x4*)cp; c1 = *(const f32x4*)(cp + 4); s0 = *(const f32x4*)(cp + 16); s1 = *(const f32x4*)(cp + 20);
                        if (fq < 2) { s0 = -s0; s1 = -s1; } }
                    if (zt) {
                        *(u32x4*)(T6 + (size_t)8192 * 1024 + (size_t)row * 1024 + (pn - 4) * 128 + colw) = pack8(acc[ai][0][m][0] * acc[ai][1][m][0], acc[ai][0][m][1] * acc[ai][1][m][1]);
                    } else {
#pragma unroll
                    for (int bj = 0; bj < 2; ++bj) {
                        f32x4 v0 = acc[ai][bj][m][0], v1 = acc[ai][bj][m][1];
                        if (rot) { const f32x4 p0 = shx(v0, 32), p1 = shx(v1, 32); v0 = v0 * c0 + p0 * s0; v1 = v1 * c1 + p1 * s1; }
                        if (isk) { ks[bj][0] += v0; ks[bj][1] += v1; }
                        v0 = v0 * qs; v1 = v1 * qs;
                        *(u32x4*)(base + (size_t)row * 1024 + bj * HALF) = pack8(v0, v1);
                    } }
                }
            if (isk) {
#pragma unroll
                for (int bj = 0; bj < 2; ++bj)
#pragma unroll
                    for (int n = 0; n < 2; ++n) { f32x4 v = ks[bj][n]; v += shx(v, 1); v += shx(v, 2); v += shx(v, 4); v += shx(v, 8);
                        if (fr == 0) { float* kp = ksum + (size_t)u.pm * 1024 + (pn & 3) * 256 + bj * HALF + colw + 4 * n;
                            unsafeAtomicAdd(kp + 0, v[0]); unsafeAtomicAdd(kp + 1, v[1]); unsafeAtomicAdd(kp + 2, v[2]); unsafeAtomicAdd(kp + 3, v[3]); } }
            }
        } else {
            const int t = (pn - 24) >> 3, colg = ((pn - 24) & 7) * 256 + colw;
            bf16_t* base = GAB + (size_t)t * ((size_t)8192 * 2048) + colg;
            const float* bp = gbias + t * 2048 + colg;
            f32x4 bv[2][2];
#pragma unroll
            for (int bj = 0; bj < 2; ++bj) { bv[bj][0] = *(const f32x4*)(bp + bj * HALF); bv[bj][1] = *(const f32x4*)(bp + bj * HALF + 4); }
#pragma unroll
            for (int ai = 0; ai < 2; ++ai)
#pragma unroll
                for (int m = 0; m < 4; ++m) { const int row = row0 + ai * HALF + m * 16;
#pragma unroll
                    for (int bj = 0; bj < 2; ++bj) *(u32x4*)(base + (size_t)row * 2048 + bj * HALF) = pack8(sigm4(acc[ai][bj][m][0] + bv[bj][0]), sigm4(acc[ai][bj][m][1] + bv[bj][1])); }
        }
    }
};
struct EpiMerge2 {
    static constexpr bool PERM = true, AFTER_DRAIN = false, KEEP_SEG0 = true;
    const bf16_t* GA; const bf16_t* GB; bf16_t* O;
    __device__ __forceinline__ void operator()(f32x4 (&acc)[2][2][4][2], const Unit& u, int wr, int wc, int fr, int fq) const {
        const int row0 = u.pm * BM + wr * 64 + fr, col0 = u.pn * BM + wc * 32 + 8 * fq;
        if (u.seg == 0) {
#pragma unroll
            for (int ai = 0; ai < 2; ++ai)
#pragma unroll
                for (int m = 0; m < 4; ++m) { const size_t off = (size_t)(row0 + ai * HALF + m * 16) * 2048 + col0;
#pragma unroll
                    for (int bj = 0; bj < 2; ++bj) { const u32x4 a = *(const u32x4*)(GA + off + bj * HALF), b = *(const u32x4*)(GB + off + bj * HALF);
                        const f32x4 b0 = bf4lo(b.x, b.y), b1 = bf4lo(b.z, b.w); f32x4 r0, r1;
#pragma unroll
                        for (int e = 0; e < 4; ++e) { r0[e] = __builtin_amdgcn_rcpf(fmaxf(b0[e], 1e-20f)); r1[e] = __builtin_amdgcn_rcpf(fmaxf(b1[e], 1e-20f)); }
                        acc[ai][bj][m][0] = acc[ai][bj][m][0] * (bf4lo(a.x, a.y) * r0); acc[ai][bj][m][1] = acc[ai][bj][m][1] * (bf4lo(a.z, a.w) * r1); } }
        } else {
#pragma unroll
            for (int ai = 0; ai < 2; ++ai)
#pragma unroll
                for (int m = 0; m < 4; ++m) { const size_t off = (size_t)(row0 + ai * HALF + m * 16) * 2048 + col0;
#pragma unroll
                    for (int bj = 0; bj < 2; ++bj) { const u32x4 b = *(const u32x4*)(GB + off + bj * HALF);
                        f32x4 b0 = bf4lo(b.x, b.y), b1 = bf4lo(b.z, b.w);
#pragma unroll
                        for (int e = 0; e < 4; ++e) { b0[e] = fmaxf(b0[e], 1e-20f); b1[e] = fmaxf(b1[e], 1e-20f); }
                        *(u32x4*)(O + off + bj * HALF) = pack8(acc[ai][bj][m][0] * b0, acc[ai][bj][m][1] * b1); } }
        }
    }
};
struct EpiX1 {
    static constexpr bool PERM = true, AFTER_DRAIN = false, KEEP_SEG0 = false;
    const bf16_t* XH; const float* RMS; bf16_t* X1B; unsigned long long* SS;
    __device__ __forceinline__ void operator()(const f32x4 (&acc)[2][2][4][2], const Unit& u, int wr, int wc, int fr, int fq) const {
        const int row0 = u.pm * BM + wr * 64 + fr, col0 = u.pn * BM + wc * 32 + 8 * fq;
#pragma unroll
        for (int ai = 0; ai < 2; ++ai)
#pragma unroll
            for (int m = 0; m < 4; ++m) { const int row = row0 + ai * HALF + m * 16; const size_t off = (size_t)row * 2048 + col0; float sq = 0.f; const float rm = RMS[row];
#pragma unroll
                for (int bj = 0; bj < 2; ++bj) { const u32x4 hx = *(const u32x4*)(XH + off + bj * HALF); const f32x4 v0 = acc[ai][bj][m][0] + bf4lo(hx.x, hx.y) * rm, v1 = acc[ai][bj][m][1] + bf4lo(hx.z, hx.w) * rm;
                    *(u32x4*)(X1B + off + bj * HALF) = pack8(v0, v1);
                    sq += (v0[0] * v0[0] + v0[1] * v0[1]) + (v0[2] * v0[2] + v0[3] * v0[3]) + (v1[0] * v1[0] + v1[1] * v1[1]) + (v1[2] * v1[2] + v1[3] * v1[3]); }
                sq += __shfl_xor(sq, 16); sq += __shfl_xor(sq, 32);
                if (fq == 0) atomicAdd(SS + row, (unsigned long long)(sq * 4294967296.0f)); }
    }
};
__device__ __forceinline__ float rinv_from_ss(unsigned long long s) { return 1.0f / sqrtf((float)((double)s * (1.0 / 4294967296.0) * (1.0 / 2048.0)) + 1e-6f); }
struct EpiQP {
    static constexpr bool PERM = true, AFTER_DRAIN = false, KEEP_SEG0 = false;
    const unsigned long long* SS; bf16_t* O;
    __device__ __forceinline__ void operator()(const f32x4 (&acc)[2][2][4][2], const Unit& u, int wr, int wc, int fr, int fq) const {
        const int row0 = u.pm * BM + wr * 64 + fr, col0 = u.pn * BM + wc * 32 + 8 * fq;
#pragma unroll
        for (int ai = 0; ai < 2; ++ai)
#pragma unroll
            for (int m = 0; m < 4; ++m) { const int row = row0 + ai * HALF + m * 16; const size_t off = (size_t)row * 2048 + col0; const float rv = rinv_from_ss(SS[row]);
#pragma unroll
                for (int bj = 0; bj < 2; ++bj) *(u32x4*)(O + off + bj * HALF) = pack8(acc[ai][bj][m][0] * rv, acc[ai][bj][m][1] * rv); }
    }
};

template <class Epi, class Sched, bool ALIGN_EPI = false, bool SP2 = false>
__device__ __forceinline__ void gemm_phase(PG8_LAS unsigned char* lds, const Gemm g, const Sched& S, const Epi& E) {
    const int tid = threadIdx.x, wid = __builtin_amdgcn_readfirstlane(tid >> 6), lane = tid & 63, wr = wid >> 2, wc = wid & 3, fr = lane & 15, fq = lane >> 4;
    const int K = g.K, nt = K / BK;
    unsigned voffA[2], voffB[2];
#pragma unroll
    for (int i = 0; i < 2; ++i) { int R, C; stage_rc(tid * 16 + i * 8192, R, C); const int Rb = Epi::PERM ? ((R & ~31) + perm32(R & 31)) : R;
        voffA[i] = (unsigned)(R * K + C) * 2u; voffB[i] = (unsigned)(Rb * K + C) * 2u; }
    const size_t kstep = (size_t)(BK * 2);
    const size_t hstep = (size_t)HALF * K * 2;
    const size_t tstep = 2 * hstep;
    const unsigned ldsw = (unsigned)wid * 1024u;
    const int aoff = lds_byte(wr * 64 + fr, fq * 8), boff = lds_byte(wc * 32 + fr, fq * 8);
#define PG8_SA(b, h) (((b) * 2 + (h)) * HTB)
#define PG8_SB(b, h) ((4 + (b) * 2 + (h)) * HTB)
#define PG8_STAGE(bufoff, gbase, voff) do { _Pragma("unroll") for (int _i = 0; _i < 2; ++_i) \
        __builtin_amdgcn_global_load_lds((const unsigned*)((const char*)(gbase) + (voff)[_i]), (PG8_LAS unsigned*)(lds + (bufoff) + ldsw + _i * 8192), 16, 0, 0); } while (0)
#define PG8_LDA(dst, b, h) do { _Pragma("unroll") for (int m = 0; m < 4; ++m) _Pragma("unroll") for (int k = 0; k < 2; ++k) dst[m][k] = *(const PG8_LAS bf16x8*)(lds + PG8_SA(b, h) + aoff + m * 2048 + k * 1024); } while (0)
#define PG8_LDB(dst, b, h) do { _Pragma("unroll") for (int n = 0; n < 2; ++n) _Pragma("unroll") for (int k = 0; k < 2; ++k) dst[n][k] = *(const PG8_LAS bf16x8*)(lds + PG8_SB(b, h) + boff + n * 2048 + k * 1024); } while (0)
#define PG8_MMA(ai, bj, At, Bt) do { __builtin_amdgcn_s_setprio(1); _Pragma("unroll") for (int m = 0; m < 4; ++m) _Pragma("unroll") for (int n = 0; n < 2; ++n) _Pragma("unroll") for (int k = 0; k < 2; ++k) \
        acc[ai][bj][m][n] = __builtin_amdgcn_mfma_f32_16x16x32_bf16(Bt[n][k], At[m][k], acc[ai][bj][m][n], 0, 0, 0); __builtin_amdgcn_s_setprio(0); } while (0)
#define PG8_WAIT_V(n) asm volatile("s_waitcnt vmcnt(" #n ")" ::: "memory")
#define PG8_WAIT_L(n) asm volatile("s_waitcnt lgkmcnt(" #n ")" ::: "memory")
#define PG8_BAR __builtin_amdgcn_s_barrier()
#define PG8_SCHED __builtin_amdgcn_sched_barrier(0)
    Unit cur, nxt; int ui = 0;
    if (!S.next(0, cur)) return;
    f32x4 acc[2][2][4][2];
#pragma unroll
    for (int a = 0; a < 2; ++a)
#pragma unroll
        for (int b = 0; b < 2; ++b)
#pragma unroll
            for (int m = 0; m < 4; ++m)
#pragma unroll
                for (int n = 0; n < 2; ++n) acc[a][b][m][n] = (f32x4){0.f, 0.f, 0.f, 0.f};
    bf16x8 At[4][2], B0[2][2], B1[2][2];
    const char* cA = (const char*)(cur.seg ? g.A2 : g.A) + (size_t)cur.pm * tstep; const char* cB = (const char*)(cur.seg ? g.Bt2 : g.Bt) + (size_t)cur.pn * tstep;
    S.a_ready(cur);
    if constexpr (SP2) {
        PG8_STAGE(PG8_SB(0, 0), cB, voffB); PG8_STAGE(PG8_SB(0, 1), cB + hstep, voffB); PG8_STAGE(PG8_SA(0, 0), cA, voffA); PG8_STAGE(PG8_SA(0, 1), cA + hstep, voffA);
        if (wr == 1) PG8_BAR;
        PG8_WAIT_V(2); PG8_BAR;
        PG8_STAGE(PG8_SB(1, 0), cB + kstep, voffB); PG8_STAGE(PG8_SA(1, 0), cA + kstep, voffA); PG8_STAGE(PG8_SB(1, 1), cB + hstep + kstep, voffB);
        PG8_WAIT_V(6); PG8_BAR;
    } else {
        PG8_STAGE(PG8_SB(0, 0), cB, voffB); PG8_STAGE(PG8_SA(0, 0), cA, voffA); PG8_STAGE(PG8_SB(0, 1), cB + hstep, voffB); PG8_STAGE(PG8_SA(0, 1), cA + hstep, voffA);
        if (wr == 1) PG8_BAR;
        PG8_WAIT_V(4); PG8_BAR;
        PG8_STAGE(PG8_SB(1, 0), cB + kstep, voffB); PG8_STAGE(PG8_SA(1, 0), cA + kstep, voffA); PG8_STAGE(PG8_SB(1, 1), cB + hstep + kstep, voffB);
        PG8_WAIT_V(6); PG8_BAR;
    }
    for (;;) {
        const bool has_next = S.next(ui + 1, nxt);
        const char* nA = has_next ? (const char*)(nxt.seg ? g.A2 : g.A) + (size_t)nxt.pm * tstep : cA; const char* nB = has_next ? (const char*)(nxt.seg ? g.Bt2 : g.Bt) + (size_t)nxt.pn * tstep : cB;
        for (int t = 0; t < nt; t += 2) {
            const bool last = (t == nt - 2);
            const char* a1 = cA + (size_t)(t + 1) * kstep;
            const char* a2 = last ? nA : cA + (size_t)(t + 2) * kstep; const char* b2 = last ? nB : cB + (size_t)(t + 2) * kstep;
            const char* a3 = a2 + kstep; const char* b3 = b2 + kstep;
            if (last && has_next) S.a_ready(nxt);
            if constexpr (SP2) {
            PG8_LDB(B0, 0, 0); PG8_LDB(B1, 0, 1); PG8_SCHED; PG8_LDA(At, 0, 0); PG8_STAGE(PG8_SA(1, 1), a1 + hstep, voffA);
            PG8_WAIT_V(8); PG8_WAIT_L(0); PG8_BAR; PG8_MMA(0, 0, At, B0); PG8_MMA(0, 1, At, B1); PG8_BAR; PG8_SCHED;
            PG8_LDA(At, 0, 1); PG8_STAGE(PG8_SB(0, 0), b2, voffB); PG8_STAGE(PG8_SB(0, 1), b2 + hstep, voffB); PG8_STAGE(PG8_SA(0, 0), a2, voffA);
            PG8_WAIT_V(8); PG8_WAIT_L(0); PG8_BAR; PG8_MMA(1, 0, At, B0); PG8_MMA(1, 1, At, B1); PG8_BAR; PG8_SCHED;
            PG8_LDB(B0, 1, 0); PG8_LDB(B1, 1, 1); PG8_SCHED; PG8_LDA(At, 1, 0); PG8_STAGE(PG8_SA(0, 1), a2 + hstep, voffA);
            PG8_WAIT_V(8); PG8_WAIT_L(0); PG8_BAR; PG8_MMA(0, 0, At, B0); PG8_MMA(0, 1, At, B1); PG8_BAR; PG8_SCHED;
            PG8_LDA(At, 1, 1); PG8_STAGE(PG8_SB(1, 0), b3, voffB); PG8_STAGE(PG8_SB(1, 1), b3 + hstep, voffB); PG8_STAGE(PG8_SA(1, 0), a3, voffA);
            PG8_WAIT_V(8); PG8_WAIT_L(0); PG8_BAR; PG8_MMA(1, 0, At, B0); PG8_MMA(1, 1, At, B1); PG8_BAR; PG8_SCHED;
            } else {
            PG8_LDB(B0, 0, 0); PG8_SCHED; PG8_LDA(At, 0, 0); PG8_STAGE(PG8_SA(1, 1), a1 + hstep, voffA);
            PG8_WAIT_L(8); PG8_BAR; PG8_WAIT_L(0); PG8_MMA(0, 0, At, B0); PG8_BAR; PG8_SCHED;
            PG8_LDB(B1, 0, 1); PG8_STAGE(PG8_SB(0, 0), b2, voffB);
            PG8_BAR; PG8_WAIT_L(0); PG8_MMA(0, 1, At, B1); PG8_BAR;
            PG8_LDA(At, 0, 1); PG8_STAGE(PG8_SA(0, 0), a2, voffA);
            PG8_BAR; PG8_WAIT_L(0); PG8_MMA(1, 0, At, B0); PG8_BAR; PG8_SCHED;
            PG8_STAGE(PG8_SB(0, 1), b2 + hstep, voffB);
            PG8_WAIT_V(6); PG8_BAR; PG8_MMA(1, 1, At, B1); PG8_BAR;
            PG8_LDB(B0, 1, 0); PG8_SCHED; PG8_LDA(At, 1, 0); PG8_STAGE(PG8_SA(0, 1), a2 + hstep, voffA);
            PG8_WAIT_L(8); PG8_BAR; PG8_WAIT_L(0); PG8_MMA(0, 0, At, B0); PG8_BAR; PG8_SCHED;
            PG8_LDB(B1, 1, 1); PG8_STAGE(PG8_SB(1, 0), b3, voffB);
            PG8_BAR; PG8_WAIT_L(0); PG8_MMA(0, 1, At, B1); PG8_BAR;
            PG8_LDA(At, 1, 1); PG8_STAGE(PG8_SA(1, 0), a3, voffA);
            PG8_BAR; PG8_WAIT_L(0); PG8_MMA(1, 0, At, B0); PG8_BAR; PG8_SCHED;
            PG8_STAGE(PG8_SB(1, 1), b3 + hstep, voffB);
            PG8_WAIT_V(6); PG8_BAR; PG8_MMA(1, 1, At, B1); PG8_BAR;
            }
        }
        if constexpr (ALIGN_EPI) { if (wr == 0) PG8_BAR; }
        if constexpr (!Epi::AFTER_DRAIN) { E(acc, cur, wr, wc, fr, fq); S.done(cur); }
        if (!has_next) break;
        if (!(Epi::KEEP_SEG0 && cur.seg == 0)) {
#pragma unroll
        for (int a = 0; a < 2; ++a)
#pragma unroll
            for (int b = 0; b < 2; ++b)
#pragma unroll
                for (int m = 0; m < 4; ++m)
#pragma unroll
                    for (int n = 0; n < 2; ++n) acc[a][b][m][n] = (f32x4){0.f, 0.f, 0.f, 0.f};
        }
        cur = nxt; cA = nA; cB = nB; ++ui;
        if constexpr (ALIGN_EPI) { if (wr == 1) PG8_BAR; }
    }
    PG8_WAIT_V(0);
    if constexpr (!ALIGN_EPI) { if (wr == 0) PG8_BAR; }
    PG8_BAR;
    if constexpr (Epi::AFTER_DRAIN) { E.fused(acc, cur, wr, wc, fr, fq, lds, wid, lane); S.done(cur); }
#undef PG8_SA
#undef PG8_SB
#undef PG8_STAGE
#undef PG8_LDA
#undef PG8_LDB
#undef PG8_MMA
#undef PG8_WAIT_V
#undef PG8_WAIT_L
#undef PG8_BAR
#undef PG8_SCHED
}
}

constexpr int NWAVES = 8;
#ifndef MK_N_LAUNCHES
#define MK_N_LAUNCHES 1
#endif
constexpr int PER_PHASE = 9;
#ifndef MK_REP_PHASE
#define MK_REP_PHASE -1
#endif
#define NREP(k) (((k) == MK_REP_PHASE) ? 2 : 1)
constexpr int N_LAUNCHES = MK_N_LAUNCHES;
constexpr int M = 8192, SEQ = 4096, DM = 2048, INW = 10240, NEXP = 16384;
constexpr float RMS_EPS = 1e-6f;
constexpr size_t MiB = 1u << 20;
constexpr size_t WS_CTL = 0, CTL_ZERO_BYTES = 64 * 1024;
constexpr size_t WS_SS = 256 * 1024, WS_KSUM = 512 * 1024;
constexpr size_t WS_WIN = 2 * MiB, WS_WBC = 42 * MiB, WS_WBA = 46 * MiB, WS_WOUT = 50 * MiB, WS_WPQ = 58 * MiB, WS_KEYS = 66 * MiB, WS_CS = 67 * MiB;
constexpr size_t WS_RMS = 68 * MiB;
constexpr size_t WS_UB = 70 * MiB, WS_VB = 102 * MiB;
constexpr size_t WS_XB = 198 * MiB;
constexpr size_t WS_T6 = 230 * MiB;
constexpr size_t WS_GAB = 326 * MiB;
constexpr size_t WS_UC = 390 * MiB, WS_AO = 406 * MiB;
constexpr size_t WS_EXP = 422 * MiB, WS_GATE = 426 * MiB;
constexpr size_t WS_END = 430 * MiB;
constexpr size_t WS_TMP = WS_XB, WS_MB = WS_T6, WS_X1B = WS_T6 + 48 * MiB, WS_QP = WS_GAB;
constexpr int CW_BAR = 4096;
constexpr int RING_OFF = 0, RING_BYTES = 131072;
constexpr int LDSCTL_OFF = RING_BYTES, MISC_OFF = LDSCTL_OFF + 320;
constexpr int LDS_BYTES = 147456;

#define GAS __attribute__((address_space(1)))
#define LAS __attribute__((address_space(3)))
typedef unsigned short bf16;
typedef unsigned v4u __attribute__((ext_vector_type(4)));
typedef float f32x4 __attribute__((ext_vector_type(4)));
typedef short bf16x8 __attribute__((ext_vector_type(8)));
typedef GAS unsigned gu32;
typedef GAS unsigned long long gu64;
#define RLX_AGENT __ATOMIC_RELAXED, __HIP_MEMORY_SCOPE_AGENT
#define LDS_WAIT() asm volatile("s_waitcnt lgkmcnt(0)" ::: "memory")
#define VM_WAIT() asm volatile("s_waitcnt vmcnt(0)" ::: "memory")
__device__ __forceinline__ unsigned long long rt() { return __builtin_amdgcn_s_memrealtime(); }
__device__ __forceinline__ unsigned f2bf(float f) { unsigned u = __builtin_bit_cast(unsigned, f); return (u + 0x7fffu + ((u >> 16) & 1u)) >> 16; }
__device__ __forceinline__ unsigned pk2(float lo, float hi) { return f2bf(lo) | (f2bf(hi) << 16); }

#define XB_TMO      128
#define XB_XCNT(j)  (256  + 64 * (j))
#define XB_XSUB(j)  (1280 + 64 * (j))
#define XB_XGEN(j)  (2304 + 64 * (j))
#define XB_TOP      3328
#define XB_TOPGEN   3392
#define XCD_BAR_WORDS 3456
#define XB_SPIN_CAP (1u << 18)

__device__ __forceinline__ unsigned xb_ld(unsigned* p)              { return __hip_atomic_load(p, __ATOMIC_RELAXED, __HIP_MEMORY_SCOPE_AGENT); }
__device__ __forceinline__ unsigned xb_add(unsigned* p, unsigned v) { return __hip_atomic_fetch_add(p, v, __ATOMIC_RELAXED, __HIP_MEMORY_SCOPE_AGENT); }
__device__ __forceinline__ unsigned xb_xcc_id() { return (unsigned)__builtin_amdgcn_s_getreg((3 << 11) | 20) & 0xFu; }
#define XB_SPIN(cond, bar) do { unsigned _sp = 0; while (cond) { __builtin_amdgcn_s_sleep(1); \
    if ((++_sp & 255u) == 0u) { if (xb_ld(&(bar)[XB_TMO])) break; if (_sp > XB_SPIN_CAP) { atomicAdd(&(bar)[XB_TMO], 1u); break; } } } } while (0)

struct XcdBarrier {
    unsigned* bar; unsigned x;
    volatile LAS unsigned* st;
};

__device__ __forceinline__ XcdBarrier xcd_barrier_post(unsigned* bar, volatile LAS unsigned* st) {
    XcdBarrier b; b.bar = bar; b.x = xb_xcc_id(); b.st = st;
    if (threadIdx.x == 0) (void)xb_add(&bar[XB_XCNT(b.x)], 1u);
    return b;
}
__device__ __forceinline__ void xcd_barrier_complete(unsigned* bar, unsigned x, unsigned& nloc, unsigned& nx) {
    const unsigned G = gridDim.x * gridDim.y * gridDim.z;
    unsigned sum, cnt, mine, sp = 0u;
    for (;;) {
        sum = 0u; cnt = 0u; mine = 0u;
#pragma unroll
        for (unsigned j = 0; j < 16; ++j) { const unsigned c = xb_ld(&bar[XB_XCNT(j)]); sum += c; cnt += (c > 0u) ? 1u : 0u; mine = (j == x) ? c : mine; }
        if (sum == G) break;
        __builtin_amdgcn_s_sleep(1);
        if ((++sp & 255u) == 0u) { if (xb_ld(&bar[XB_TMO])) break; if (sp > XB_SPIN_CAP) { atomicAdd(&bar[XB_TMO], 1u); break; } }
    }
    nloc = mine > 0u ? mine : 1u; nx = cnt > 0u ? cnt : 1u;
}

struct Ctx { LAS unsigned char* lds; int tid, lane, wave, vcu, G; };
struct BarWork { const float* pu; const float* pv; const float* g2; unsigned char* ws; int part, nparts; };
__device__ __forceinline__ void convert_tables(const Ctx& F, const float* pu, const float* pv, const float* g2, unsigned char* ws, int part, int nparts, int w0);
__device__ __forceinline__ void xcd_barrier(const XcdBarrier& b, const Ctx* F = nullptr, const BarWork* wk = nullptr) {
    asm volatile("s_waitcnt vmcnt(0)" ::: "memory");
    __syncthreads();
    if (wk && wk->part >= 0) convert_tables(*F, wk->pu, wk->pv, wk->g2, wk->ws, wk->part, wk->nparts, 1);
    if (threadIdx.x == 0) {
        unsigned* bar = b.bar;
        __builtin_amdgcn_s_waitcnt(0);
        unsigned nloc = b.st[0], nx = b.st[1];
        if (nloc == 0u) { xcd_barrier_complete(bar, b.x, nloc, nx); b.st[0] = nloc; b.st[1] = nx; }
        const unsigned old = xb_add(&bar[XB_XSUB(b.x)], 1u);
        const unsigned gen = old / nloc;
        if (old + 1u == (gen + 1u) * nloc) {
            __builtin_amdgcn_fence(__ATOMIC_RELEASE, "agent");
            asm volatile("s_waitcnt vmcnt(0)" ::: "memory");
            const unsigned og = xb_add(&bar[XB_TOP], 1u);
            const unsigned tg = og / nx;
            if (og + 1u == (tg + 1u) * nx) xb_add(&bar[XB_TOPGEN], 1u);
            else XB_SPIN(xb_ld(&bar[XB_TOPGEN]) == tg, bar);
            __builtin_amdgcn_fence(__ATOMIC_ACQUIRE, "agent");
            xb_add(&bar[XB_XGEN(b.x)], 1u);
            asm volatile("s_waitcnt vmcnt(0)" ::: "memory");
        } else {
            XB_SPIN(xb_ld(&bar[XB_XGEN(b.x)]) == gen, bar);
            __builtin_amdgcn_fence(__ATOMIC_ACQUIRE, "agent");
            asm volatile("s_waitcnt vmcnt(0)" ::: "memory");
        }
    }
    __syncthreads();
}

typedef __bf16 bf16x2v __attribute__((ext_vector_type(2)));
typedef float f32x16 __attribute__((ext_vector_type(16)));
__device__ __forceinline__ float bflo(unsigned w) { return __uint_as_float(w << 16); }
__device__ __forceinline__ float bfhi(unsigned w) { return __uint_as_float(w & 0xffff0000u); }
__device__ __forceinline__ float dot2bf(unsigned a, unsigned b, float c) { return __builtin_amdgcn_fdot2_f32_bf16(__builtin_bit_cast(bf16x2v, a), __builtin_bit_cast(bf16x2v, b), c, false); }
__device__ __forceinline__ float wave_sum(float v) {
#pragma unroll
    for (int o = 1; o < 64; o <<= 1) v += __shfl_xor(v, o);
    return v; }
__device__ __forceinline__ float wave_max(float v) {
#pragma unroll
    for (int o = 1; o < 64; o <<= 1) v = fmaxf(v, __shfl_xor(v, o));
    return v; }
__device__ __forceinline__ float rdlane(float v, int l) { return __int_as_float(__builtin_amdgcn_readlane(__float_as_int(v), l)); }
__device__ __forceinline__ float gelu_tanh(float x) { const float z = 0.7978845608028654f * (x + 0.044715f * x * x * x); const float e = __expf(2.0f * z); const float th = 1.0f - 2.0f * __builtin_amdgcn_rcpf(1.0f + e); return 0.5f * x * (1.0f + th); }


__device__ __forceinline__ void p0_transpose_item(const float* W, int K, int N, bf16* WT, const float* gk, LAS float* scr, int item, int lane, bool remap = false) {
    const int nblk = N / 32, kb = item / nblk, nb = item % nblk, k0 = 64 * kb, n0 = 32 * nb;
    int dn0 = n0; if (remap && n0 >= 1024 && n0 < 3072) { const int c = (n0 - 1024) & 1023, isx = (n0 >= 2048); dn0 = 1024 + (c >> 7) * 256 + isx * 128 + (c & 127); }
#pragma unroll
    for (int i = 0; i < 8; ++i) { const int kk = 8 * i + (lane >> 3), nn = 4 * (lane & 7); f32x4 v = *(const GAS f32x4*)(W + (size_t)(k0 + kk) * N + n0 + nn); if (gk) v = v * gk[k0 + kk];
        scr[kk * 33 + nn] = v[0]; scr[kk * 33 + nn + 1] = v[1]; scr[kk * 33 + nn + 2] = v[2]; scr[kk * 33 + nn + 3] = v[3]; }
    LDS_WAIT(); asm volatile("" ::: "memory");
    const int c = lane & 7;
#pragma unroll
    for (int j = 0; j < 4; ++j) { const int n = (lane >> 3) + 8 * j; const LAS float* s = scr + (8 * c) * 33 + n;
        v4u o; o.x = pk2(s[0 * 33], s[1 * 33]); o.y = pk2(s[2 * 33], s[3 * 33]); o.z = pk2(s[4 * 33], s[5 * 33]); o.w = pk2(s[6 * 33], s[7 * 33]);
        *(GAS v4u*)(WT + (size_t)(dn0 + n) * K + k0 + 8 * c) = o; }
    LDS_WAIT(); asm volatile("" ::: "memory");
}
__device__ __forceinline__ void convert_tables(const Ctx& F, const float* pu, const float* pv, const float* g2, unsigned char* ws, int part, int nparts, int w0) {
    if (F.wave < w0) return;
    const int nw = NWAVES - w0, gt = (F.vcu * nw + (F.wave - w0)) * 64 + F.lane, NT = F.G * nw * 64;
    const int per = (NEXP * 2048 / 16) / nparts, lo = part * per, hi = lo + per;
    for (int i = lo + gt; i < hi; i += NT) { const int c16 = (i & 127) * 16; v4u ou, ov;
#pragma unroll
        for (int q = 0; q < 4; ++q) { f32x4 a = ((const GAS f32x4*)pu)[4 * i + q]; a = a * *(const GAS f32x4*)(g2 + c16 + 4 * q) * 512.0f; const f32x4 b = ((const GAS f32x4*)pv)[4 * i + q] * 32.0f;
            int wu = 0, wv = 0; wu = __builtin_amdgcn_cvt_pk_fp8_f32(a[0], a[1], wu, false); wu = __builtin_amdgcn_cvt_pk_fp8_f32(a[2], a[3], wu, true);
            wv = __builtin_amdgcn_cvt_pk_fp8_f32(b[0], b[1], wv, false); wv = __builtin_amdgcn_cvt_pk_fp8_f32(b[2], b[3], wv, true); ou[q] = (unsigned)wu; ov[q] = (unsigned)wv; }
        ((GAS v4u*)(ws + WS_UB))[i] = ou; ((GAS v4u*)(ws + WS_VB))[i] = ov; }
}
__device__ __forceinline__ void p0_prologue(const Ctx& F, const float* const* in, unsigned char* ws, const double* invf) {
    const float* x = in[0]; const int* pos = (const int*)in[1]; const float* g1 = in[2]; const float* w_in = in[3];
    const float* w_bc = in[6]; const float* w_ba = in[7]; const float* w_out = in[8]; const float* g2 = in[9]; const float* w_pq = in[10];
    const float* keys = in[11]; const float* pu = in[12]; const float* pv = in[13];
    LAS float* scr = (LAS float*)(F.lds + RING_OFF + F.wave * 16384);
    const int gw = F.vcu * NWAVES + F.wave, NGW = F.G * NWAVES;
    const int gt = gw * 64 + F.lane, NT = NGW * 64;
    for (int i = gt; i < 8192; i += NT) ((GAS unsigned long long*)(ws + WS_SS))[i] = 0ull;
    for (int i = gt; i < 32 * 1024; i += NT) ((GAS float*)(ws + WS_KSUM))[i] = 0.f;
    constexpr int I_IN = 32 * 320, I_BC = 16 * 64, I_OUT = 32 * 64;
    constexpr int NITEMS = I_IN + 2 * I_BC + 2 * I_OUT;
    for (int it = gw; it < NITEMS; it += NGW) {
        int r = it;
        if (r < I_IN) { p0_transpose_item(w_in, 2048, INW, (bf16*)(ws + WS_WIN), g1, scr, r, F.lane, true); continue; } r -= I_IN;
        if (r < I_BC) { p0_transpose_item(w_bc, 1024, 2048, (bf16*)(ws + WS_WBC), nullptr, scr, r, F.lane); continue; } r -= I_BC;
        if (r < I_BC) { p0_transpose_item(w_ba, 1024, 2048, (bf16*)(ws + WS_WBA), nullptr, scr, r, F.lane); continue; } r -= I_BC;
        if (r < I_OUT) { p0_transpose_item(w_out, 2048, 2048, (bf16*)(ws + WS_WOUT), nullptr, scr, r, F.lane); continue; } r -= I_OUT;
        p0_transpose_item(w_pq, 2048, 2048, (bf16*)(ws + WS_WPQ), g2, scr, r, F.lane);
    }
    for (int i = gt; i < 16 * 128 * 128 / 8; i += NT) { const f32x4 a = ((const GAS f32x4*)keys)[2 * i], b = ((const GAS f32x4*)keys)[2 * i + 1];
        v4u o; o.x = pk2(a[0], a[1]); o.y = pk2(a[2], a[3]); o.z = pk2(b[0], b[1]); o.w = pk2(b[2], b[3]); ((GAS v4u*)(ws + WS_KEYS))[i] = o; }
    for (int m = gw; m < M; m += NGW) { const GAS f32x4* xr = (const GAS f32x4*)(x + (size_t)m * DM);
        f32x4 v[8]; float s = 0.f;
#pragma unroll
        for (int i = 0; i < 4; ++i) { v[2 * i] = xr[i * 128 + 2 * F.lane]; v[2 * i + 1] = xr[i * 128 + 2 * F.lane + 1]; }
#pragma unroll
        for (int i = 0; i < 8; ++i) s += (v[i][0] * v[i][0] + v[i][1] * v[i][1]) + (v[i][2] * v[i][2] + v[i][3] * v[i][3]);
        const float rms = sqrtf(wave_sum(s) * (1.0f / DM) + RMS_EPS), rinv = 1.0f / rms;
        if (F.lane == 0) ((GAS float*)(ws + WS_RMS))[m] = rms;
        GAS v4u* o = (GAS v4u*)(ws + WS_XB + (size_t)m * DM * 2);
#pragma unroll
        for (int i = 0; i < 4; ++i) { const f32x4 a = v[2 * i] * rinv, b = v[2 * i + 1] * rinv; v4u w; w.x = pk2(a[0], a[1]); w.y = pk2(a[2], a[3]); w.z = pk2(b[0], b[1]); w.w = pk2(b[2], b[3]); o[i * 64 + F.lane] = w; } }
    for (int i = gt; i < M * 16; i += NT) { const int row = i >> 4, f = i & 15; const double ang = (double)pos[row] * invf[f];
        const double k = __builtin_rint(ang * 0.15915494309189535); const float r = (float)(ang - k * 6.283185307179586);
        float* cs = (float*)(ws + WS_CS); cs[row * 32 + f] = __cosf(r); cs[row * 32 + 16 + f] = __sinf(r); }
}

__device__ __forceinline__ void attn_simple(const Ctx& F, const bf16* Q, const bf16* K, const bf16* V, const float* ksum, bf16* AO) {
    LAS float* qf = (LAS float*)(F.lds + RING_OFF + F.wave * 512);
    const int gw = F.vcu * NWAVES + F.wave, NGW = F.G * NWAVES, lane = F.lane;
    for (int item = gw; item < 16 * SEQ; item += NGW) {
        const int bh = item >> 12, t = item & 4095, b = bh >> 3, h = bh & 7, blk = t >> 8;
        const size_t row = (size_t)b * SEQ + t;
        { const unsigned qq = *(const GAS unsigned*)(Q + row * 1024 + h * 128 + 2 * lane); qf[2 * lane] = bflo(qq); qf[2 * lane + 1] = bfhi(qq); }
        LDS_WAIT(); asm volatile("" ::: "memory");
        float g = -INFINITY;
        if (lane < blk) { const GAS f32x4* km = (const GAS f32x4*)(ksum + (size_t)(b * 16 + lane) * 1024 + h * 128); float a = 0.f;
            for (int d = 0; d < 32; ++d) { const f32x4 kv = km[d]; const f32x4 qv = *(const LAS f32x4*)(qf + 4 * d); a += (kv[0] * qv[0] + kv[1] * qv[1]) + (kv[2] * qv[2] + kv[3] * qv[3]); }
            g = a; }
        int sel[3];
#pragma unroll
        for (int i = 0; i < 3; ++i) { const float mx = wave_max(g); const unsigned long long bal = __ballot(g == mx && lane < blk); const int idx = bal ? (__ffsll((long long)bal) - 1) : 0; sel[i] = idx; if (lane == idx) g = -INFINITY; }
        const int nsel = blk < 3 ? blk : 3;
        float sc[4][4]; float mx = -INFINITY;
#pragma unroll
        for (int slot = 0; slot < 4; ++slot) {
            const bool valid = (slot == 3) || (slot < nsel);
            const int kb = (slot == 3) ? blk : sel[slot < 3 ? slot : 0];
#pragma unroll
            for (int r = 0; r < 4; ++r) {
                float s = -INFINITY; const int key0 = kb * 256 + r * 64;
                if (valid && (slot < 3 || key0 <= t)) {
                    const int key = key0 + lane; const GAS v4u* kp = (const GAS v4u*)(K + ((size_t)b * SEQ + key) * 1024 + h * 128); float a = 0.f;
#pragma unroll 4
                    for (int d = 0; d < 16; ++d) { const v4u kk = kp[d]; const f32x4 q0 = *(const LAS f32x4*)(qf + 8 * d), q1 = *(const LAS f32x4*)(qf + 8 * d + 4);
                        a += (bflo(kk.x) * q0[0] + bfhi(kk.x) * q0[1]) + (bflo(kk.y) * q0[2] + bfhi(kk.y) * q0[3]) + (bflo(kk.z) * q1[0] + bfhi(kk.z) * q1[1]) + (bflo(kk.w) * q1[2] + bfhi(kk.w) * q1[3]); }
                    s = (slot < 3 || key <= t) ? a : -INFINITY; }
                sc[slot][r] = s; mx = fmaxf(mx, s); } }
        mx = wave_max(mx);
        float sum = 0.f;
#pragma unroll
        for (int slot = 0; slot < 4; ++slot)
#pragma unroll
            for (int r = 0; r < 4; ++r) { sc[slot][r] = exp2f(sc[slot][r] - mx); sum += sc[slot][r]; }
        sum = wave_sum(sum);
        float o0 = 0.f, o1 = 0.f;
#pragma unroll
        for (int slot = 0; slot < 4; ++slot) {
            const bool valid = (slot == 3) || (slot < nsel);
            const int kb = (slot == 3) ? blk : sel[slot < 3 ? slot : 0];
#pragma unroll
            for (int r = 0; r < 4; ++r) { const int key0 = kb * 256 + r * 64;
                if (valid && (slot < 3 || key0 <= t)) { const float pr = sc[slot][r]; const GAS unsigned* vp = (const GAS unsigned*)(V + ((size_t)b * SEQ + key0) * 1024 + h * 128) + lane;
                    for (int kk = 0; kk < 64; ++kk) { const float pk = rdlane(pr, kk); const unsigned vv = vp[(size_t)kk * 512]; o0 += pk * bflo(vv); o1 += pk * bfhi(vv); } } } }
        const float ri = 1.0f / sum;
        *(GAS unsigned*)(AO + row * 1024 + h * 128 + 2 * lane) = pk2(o0 * ri, o1 * ri);
    }
}
typedef short v4i16_t __attribute__((ext_vector_type(4))); typedef unsigned u32x2v __attribute__((ext_vector_type(2)));
__device__ __forceinline__ v4i16_t vtr16(unsigned addr) { return __builtin_amdgcn_ds_read_tr16_b64_v4i16((LAS v4i16_t*)(uintptr_t)addr); }
__device__ __forceinline__ int crow16(int r, int hh) { return (r & 3) + 8 * (r >> 2) + 4 * hh; }
__device__ __forceinline__ void attn_dma_step(const bf16* K, const bf16* V, LAS unsigned char* lds, int b, int h, int qb, int n_own, int st, int buf, int wave, int lane) {
#pragma unroll
    for (int img = 0; img < 4; ++img) {
        const int T = 2 * st + (img >> 1); const bool isV = img & 1;
        const int blk = (T < n_own) ? qb : ((T - n_own) >> 2), kt = (T < n_own) ? T : ((T - n_own) & 3);
        const bf16* base = (isV ? V : K) + ((size_t)b * SEQ + 256 * blk + 64 * kt) * 1024 + h * 128;
#pragma unroll
        for (int i = 0; i < 2; ++i) { const int pc = wave + 8 * i, row = 4 * pc + (lane >> 4), cp = lane & 15;
            const int c = isV ? ((((cp >> 2) ^ (row & 3)) << 2) | (cp & 3)) : (cp ^ (row & 15));
            __builtin_amdgcn_global_load_lds((const unsigned*)(base + (size_t)row * 1024 + 8 * c), (LAS unsigned*)(lds + buf * 65536 + img * 16384 + pc * 1024), 16, 0, 0); }
    }
}
__device__ __forceinline__ void attn_mfma(const Ctx& F, const bf16* Q, const bf16* K, const bf16* V, const float* ksum, bf16* AO) {
    const int lane = F.lane, wave = F.wave, q31 = lane & 31, hh = lane >> 5, wq = wave & 3, kvh = wave >> 2, l16 = lane & 15, G4 = lane >> 4;
    LAS unsigned char* lds = F.lds + RING_OFF;
    const unsigned lds0 = (unsigned)(uintptr_t)lds;
    for (int pr = F.vcu; pr < 256; pr += F.G)
#pragma unroll 1
    for (int pi = 0; pi < 2; ++pi) {
        const int bh = pr >> 4, s_ = pr & 15, u128 = pi ? 31 - s_ : s_, b = bh >> 3, h = bh & 7, qb = u128 >> 1, half = u128 & 1;
        const int n_own = half ? 4 : 2, nstep = (n_own + 4 * qb) >> 1;
        const size_t rowq = (size_t)b * SEQ + 256 * qb + 128 * half + 32 * wq + q31;
        asm volatile("s_waitcnt vmcnt(0) lgkmcnt(0)" ::: "memory"); __builtin_amdgcn_s_barrier(); asm volatile("" ::: "memory");
        attn_dma_step(K, V, lds, b, h, qb, n_own, 0, 0, wave, lane);
        bf16x8 qf[8];
#pragma unroll
        for (int s = 0; s < 8; ++s) qf[s] = *(const GAS bf16x8*)(Q + rowq * 1024 + h * 128 + 16 * s + 8 * hh);
        unsigned selmask;
        {
            f32x16 gt;
#pragma unroll
            for (int r = 0; r < 16; ++r) gt[r] = 0.f;
            const int jr = lane & 31; const bool jv = jr < qb;
            const GAS f32x4* kp = (const GAS f32x4*)(ksum + (size_t)(b * 16 + (jv ? jr : 0)) * 1024 + h * 128 + 8 * hh);
            f32x4 kf[16];
#pragma unroll
            for (int s = 0; s < 8; ++s) { kf[2 * s] = kp[4 * s]; kf[2 * s + 1] = kp[4 * s + 1]; }
#pragma unroll
            for (int s = 0; s < 8; ++s) { v4u w = pg8::pack8(kf[2 * s], kf[2 * s + 1]); if (!jv) { w.x = 0u; w.y = 0u; w.z = 0u; w.w = 0u; }
                gt = __builtin_amdgcn_mfma_f32_32x32x16_bf16(__builtin_bit_cast(bf16x8, w), qf[s], gt, 0, 0, 0); }
            float g16[16];
#pragma unroll
            for (int r = 0; r < 8; ++r) { const auto rr = __builtin_amdgcn_permlane32_swap(__float_as_uint(gt[r]), __float_as_uint(gt[r]), false, false);
                g16[(r & 3) + 8 * (r >> 2)] = __uint_as_float(rr[0]); g16[(r & 3) + 8 * (r >> 2) + 4] = __uint_as_float(rr[1]); }
            float v0 = -INFINITY, v1 = -INFINITY, v2 = -INFINITY; int i0 = 0, i1 = 0, i2 = 0;
#pragma unroll
            for (int j = 0; j < 16; ++j) { const float a = (j < qb) ? g16[j] : -INFINITY;
                if (a > v0) { v2 = v1; i2 = i1; v1 = v0; i1 = i0; v0 = a; i0 = j; } else if (a > v1) { v2 = v1; i2 = i1; v1 = a; i1 = j; } else if (a > v2) { v2 = a; i2 = j; } }
            selmask = (qb <= 3) ? ((1u << qb) - 1u) : ((1u << i0) | (1u << i1) | (1u << i2));
        }
        float m_run = -1e30f, l_run = 0.f; f32x16 o[4];
#pragma unroll
        for (int db = 0; db < 4; ++db)
#pragma unroll
            for (int r = 0; r < 16; ++r) o[db][r] = 0.f;
        const int qin = 128 * half + 32 * wq + q31;
#pragma unroll 1
        for (int st2 = 0; st2 < nstep; st2 += 2)
#pragma unroll
        for (int par = 0; par < 2; ++par) { const int st = st2 + par; if (st < nstep) {
            asm volatile("s_waitcnt vmcnt(0)" ::: "memory"); __builtin_amdgcn_s_barrier(); asm volatile("" ::: "memory");
            if (st + 1 < nstep) attn_dma_step(K, V, lds, b, h, qb, n_own, st + 1, par ^ 1, wave, lane);
            const int T = 2 * st + kvh; const bool own = T < n_own;
            const int blk = own ? qb : ((T - n_own) >> 2), kt = own ? T : ((T - n_own) & 3);
            const bool sel = own ? true : ((selmask >> blk) & 1u);
            const bool skip = own ? (64 * kt > 128 * half + 32 * wq + 31) : (__ballot(sel) == 0ull);
            if (!skip) {
                const unsigned kimg = lds0 + par * 65536 + kvh * 32768, vimg = kimg + 16384;
                f32x16 p[2];
#pragma unroll
                for (int kh = 0; kh < 2; ++kh) {
#pragma unroll
                    for (int r = 0; r < 16; ++r) p[kh][r] = 0.f;
                    const int row = 32 * kh + q31;
#pragma unroll
                    for (int s = 0; s < 8; ++s) { const bf16x8 a = *(const LAS bf16x8*)(uintptr_t)(kimg + row * 256 + (((2 * s + hh) ^ (row & 15)) << 4));
                        p[kh] = __builtin_amdgcn_mfma_f32_32x32x16_bf16(a, qf[s], p[kh], 0, 0, 0); }
                }
                if (own) { const int kbase = 64 * kt;
                    if (kbase + 63 > 128 * half + 32 * wq) {
#pragma unroll
                        for (int kh = 0; kh < 2; ++kh)
#pragma unroll
                            for (int r = 0; r < 16; ++r) if (kbase + 32 * kh + crow16(r, hh) > qin) p[kh][r] = -INFINITY; }
                }
                float mx = p[0][0];
#pragma unroll
                for (int r = 1; r < 16; ++r) mx = fmaxf(mx, p[0][r]);
#pragma unroll
                for (int r = 0; r < 16; ++r) mx = fmaxf(mx, p[1][r]);
                { const auto rr = __builtin_amdgcn_permlane32_swap(__float_as_uint(mx), __float_as_uint(mx), false, false); mx = fmaxf(__uint_as_float(rr[0]), __uint_as_float(rr[1])); }
                if (!sel) mx = -INFINITY;
                const float m_new = fmaxf(m_run, mx), scl = __builtin_amdgcn_exp2f(m_run - m_new); m_run = m_new;
                float rs = 0.f;
#pragma unroll
                for (int kh = 0; kh < 2; ++kh)
#pragma unroll
                    for (int r = 0; r < 16; ++r) { p[kh][r] = __builtin_amdgcn_exp2f(p[kh][r] - m_new); rs += p[kh][r]; }
                l_run = l_run * scl + (sel ? rs : 0.f);
                if (__ballot(scl != 1.0f) != 0ull) {
#pragma unroll
                    for (int db = 0; db < 4; ++db)
#pragma unroll
                        for (int r = 0; r < 16; ++r) o[db][r] *= scl; }
                const unsigned pmask = sel ? 0xffffffffu : 0u;
                bf16x8 pb[4];
#pragma unroll
                for (int gi = 0; gi < 4; ++gi) { const int kh = gi >> 1, s2 = gi & 1; v4u pw;
                    pw.x = pg8::cvt_pk_bf16(p[kh][8 * s2], p[kh][8 * s2 + 1]) & pmask; pw.y = pg8::cvt_pk_bf16(p[kh][8 * s2 + 2], p[kh][8 * s2 + 3]) & pmask;
                    pw.z = pg8::cvt_pk_bf16(p[kh][8 * s2 + 4], p[kh][8 * s2 + 5]) & pmask; pw.w = pg8::cvt_pk_bf16(p[kh][8 * s2 + 6], p[kh][8 * s2 + 7]) & pmask;
                    pb[gi] = __builtin_bit_cast(bf16x8, pw); }
                v4i16_t lo[2][2], hi_[2][2];
                const int dsub = 16 * (G4 & 1) + 4 * (l16 & 3);
#define ATTN_VREADS(u, S) { const int key0_ = 32 * ((u) >> 2) + 16 * (((u) >> 1) & 1) + 4 * (G4 >> 1) + (l16 >> 2); _Pragma("unroll") for (int d2 = 0; d2 < 2; ++d2) { const int db = 2 * ((u) & 1) + d2; \
                    const unsigned a0_ = vimg + key0_ * 256 + ((db ^ (key0_ & 3)) << 6) + dsub * 2; \
                    asm volatile("ds_read_b64_tr_b16 %0, %1" : "=&v"(lo[S][d2]) : "v"(a0_) : "memory"); \
                    asm volatile("ds_read_b64_tr_b16 %0, %1 offset:2048" : "=&v"(hi_[S][d2]) : "v"(a0_) : "memory"); } }
#define ATTN_VWAIT(S, N) asm volatile("s_waitcnt lgkmcnt(" #N ")" : "+v"(lo[S][0]), "+v"(lo[S][1]), "+v"(hi_[S][0]), "+v"(hi_[S][1]) :: "memory")
#define ATTN_PV(u, S) { _Pragma("unroll") for (int d2 = 0; d2 < 2; ++d2) { const int db = 2 * ((u) & 1) + d2; const bf16x8 av = {lo[S][d2][0], lo[S][d2][1], lo[S][d2][2], lo[S][d2][3], hi_[S][d2][0], hi_[S][d2][1], hi_[S][d2][2], hi_[S][d2][3]}; \
                    o[db] = __builtin_amdgcn_mfma_f32_32x32x16_bf16(av, pb[(u) >> 1], o[db], 0, 0, 0); } }
                ATTN_VREADS(0, 0)
                ATTN_VREADS(1, 1) ATTN_VWAIT(0, 4); ATTN_PV(0, 0)
                ATTN_VREADS(2, 0) ATTN_VWAIT(1, 4); ATTN_PV(1, 1)
                ATTN_VREADS(3, 1) ATTN_VWAIT(0, 4); ATTN_PV(2, 0)
                ATTN_VREADS(4, 0) ATTN_VWAIT(1, 4); ATTN_PV(3, 1)
                ATTN_VREADS(5, 1) ATTN_VWAIT(0, 4); ATTN_PV(4, 0)
                ATTN_VREADS(6, 0) ATTN_VWAIT(1, 4); ATTN_PV(5, 1)
                ATTN_VREADS(7, 1) ATTN_VWAIT(0, 4); ATTN_PV(6, 0)
                ATTN_VWAIT(1, 0); ATTN_PV(7, 1)
#undef ATTN_VREADS
#undef ATTN_VWAIT
#undef ATTN_PV
            }
        } }
        l_run += __shfl_xor(l_run, 32);
        asm volatile("s_waitcnt vmcnt(0) lgkmcnt(0)" ::: "memory"); __builtin_amdgcn_s_barrier(); asm volatile("" ::: "memory");
        LAS float* xs = (LAS float*)lds + (size_t)wq * 66 * 64 + lane;
        if (kvh == 1) {
            xs[0] = m_run; xs[64] = l_run;
#pragma unroll
            for (int db = 0; db < 4; ++db)
#pragma unroll
                for (int r = 0; r < 16; ++r) xs[(2 + 16 * db + r) * 64] = o[db][r];
        }
        asm volatile("s_waitcnt lgkmcnt(0)" ::: "memory"); __builtin_amdgcn_s_barrier(); asm volatile("" ::: "memory");
        if (kvh == 0) {
            const float m2 = xs[0], l2 = xs[64], mt = fmaxf(m_run, m2), a1 = __builtin_amdgcn_exp2f(m_run - mt), a2 = __builtin_amdgcn_exp2f(m2 - mt);
            const float inv = 1.0f / (l_run * a1 + l2 * a2), c1 = a1 * inv, c2 = a2 * inv;
            bf16* orow = AO + rowq * 1024 + h * 128 + 4 * hh;
#pragma unroll
            for (int db = 0; db < 4; ++db)
#pragma unroll
                for (int g = 0; g < 4; ++g) {
                    float t[4];
#pragma unroll
                    for (int e = 0; e < 4; ++e) t[e] = o[db][4 * g + e] * c1 + xs[(2 + 16 * db + 4 * g + e) * 64] * c2;
                    u32x2v w; w.x = pg8::cvt_pk_bf16(t[0], t[1]); w.y = pg8::cvt_pk_bf16(t[2], t[3]);
                    *(GAS u32x2v*)(orow + 32 * db + 8 * g) = w;
                }
        }
    }
    asm volatile("s_waitcnt vmcnt(0) lgkmcnt(0)" ::: "memory"); __builtin_amdgcn_s_barrier(); asm volatile("" ::: "memory");
}
__device__ __forceinline__ void up8(const v4u w, float (&f)[8]) { f[0] = bflo(w.x); f[1] = bfhi(w.x); f[2] = bflo(w.y); f[3] = bfhi(w.y); f[4] = bflo(w.z); f[5] = bfhi(w.z); f[6] = bflo(w.w); f[7] = bfhi(w.w); }
__device__ __forceinline__ void conv_phase(const Ctx& F, const bf16* CB, const bf16* Z, const float* cw, bf16* UC) {
    const int gt = (F.vcu * NWAVES + F.wave) * 64 + F.lane, NT = F.G * NWAVES * 64;
    for (int idx = gt; idx < M * 128; idx += NT) {
        const int row = idx >> 7, c8 = (idx & 127) << 3, t = row & (SEQ - 1); const size_t off = (size_t)row * 1024 + c8;
        float cb[8], z0[8], z1[8], z2[8];
        up8(*(const GAS v4u*)(CB + off), cb); up8(*(const GAS v4u*)(Z + off), z0);
        if (t >= 1) up8(*(const GAS v4u*)(Z + off - 1024), z1); else {
#pragma unroll
            for (int j = 0; j < 8; ++j) z1[j] = 0.f; }
        if (t >= 2) up8(*(const GAS v4u*)(Z + off - 2048), z2); else {
#pragma unroll
            for (int j = 0; j < 8; ++j) z2[j] = 0.f; }
        float o[8];
#pragma unroll
        for (int j = 0; j < 8; ++j) o[j] = cb[j] * (cw[c8 + j] * z2[j] + cw[1024 + c8 + j] * z1[j] + cw[2048 + c8 + j] * z0[j]);
        v4u w; w.x = pk2(o[0], o[1]); w.y = pk2(o[2], o[3]); w.z = pk2(o[4], o[5]); w.w = pk2(o[6], o[7]); *(GAS v4u*)(UC + off) = w;
    }
}

__device__ __forceinline__ int imax(int a, int b) { return a > b ? a : b; }
__device__ __forceinline__ int imin(int a, int b) { return a < b ? a : b; }
__device__ __forceinline__ void ce(int& a, int& b) { const int t = imax(a, b); b = imin(a, b); a = t; }
__device__ __forceinline__ void sort16(int (&x)[16]) {
#pragma unroll
    for (int kk = 1; kk <= 4; ++kk)
#pragma unroll
        for (int jj = kk - 1; jj >= 0; --jj)
#pragma unroll
            for (int i = 0; i < 16; ++i) { const int k = 1 << kk, j = 1 << jj, l = i ^ j; if (l > i) { if ((i & k) == 0) ce(x[i], x[l]); else ce(x[l], x[i]); } }
}
__device__ __forceinline__ void bmerge16(int (&a)[16]) {
#pragma unroll
    for (int jj = 3; jj >= 0; --jj)
#pragma unroll
        for (int i = 0; i < 16; ++i) { const int j = 1 << jj, l = i ^ j; if (l > i) ce(a[i], a[l]); }
}
__device__ __forceinline__ void merge16(int (&a)[16], const int (&b)[16]) {
#pragma unroll
    for (int i = 0; i < 16; ++i) a[i] = imax(a[i], b[15 - i]);
    bmerge16(a);
}
__device__ __forceinline__ void xmerge16(int (&a)[16], int hh) {
    int pv[16];
#pragma unroll
    for (int i = 0; i < 16; ++i) { const auto r = __builtin_amdgcn_permlane32_swap((unsigned)a[15 - i], (unsigned)a[15 - i], false, false); pv[i] = hh ? (int)r[0] : (int)r[1]; }
#pragma unroll
    for (int i = 0; i < 16; ++i) a[i] = imax(a[i], pv[i]);
    bmerge16(a);
}
__device__ __forceinline__ int ord_key(float f) { const int u = __float_as_int(f); return u >= 0 ? u : (u ^ 0x7fffffff); }
__device__ __forceinline__ float ord_val(int k) { return __int_as_float(k >= 0 ? k : (k ^ 0x7fffffff)); }
__device__ __forceinline__ unsigned byte16(const unsigned (&t)[4], int idx) {
    const unsigned sel = 0x0c0c0c00u | (unsigned)(idx & 7);
    const unsigned lo = __builtin_amdgcn_perm(t[1], t[0], sel), hi_ = __builtin_amdgcn_perm(t[3], t[2], sel);
    return (idx & 8) ? hi_ : lo;
}
__device__ __forceinline__ void topk_stage_keys(const Ctx& F, const bf16* KEYS, int h) {
    for (int pc = F.wave; pc < 64; pc += 8) { const int pp = pc >> 5, row = 4 * (pc & 31) + (F.lane >> 4), cp = F.lane & 15, c = cp ^ (row & 15);
        __builtin_amdgcn_global_load_lds((const unsigned*)(KEYS + (size_t)((h * 2 + pp) * 128 + row) * 128 + 8 * c), (LAS unsigned*)(F.lds + RING_OFF + pc * 1024), 16, 0, 0); }
    asm volatile("s_waitcnt vmcnt(0)" ::: "memory"); __builtin_amdgcn_s_barrier(); asm volatile("" ::: "memory");
}
__device__ __forceinline__ void topk_phase(const Ctx& F, int bitem, const bf16* QP, int* EXP, float* GATE) {
    const int lane = F.lane, l31 = lane & 31, hh = lane >> 5;
    const int IMIN = (int)0x80000000;
    const unsigned lds0 = (unsigned)(uintptr_t)(F.lds + RING_OFF);
    {
        const int h = bitem & 7, tt = (bitem >> 3) * 8 + F.wave, tok0 = tt * 32;
        int top[2][16];
#pragma unroll
        for (int p = 0; p < 2; ++p) {
            bf16x8 qa[8];
#pragma unroll
            for (int s = 0; s < 8; ++s) qa[s] = *(const GAS bf16x8*)(QP + (size_t)(tok0 + l31) * 2048 + h * 256 + p * 128 + 16 * s + 8 * hh);
            int x[2][16];
#pragma unroll
            for (int pq = 0; pq < 2; ++pq) {
                f32x16 sc[2];
#pragma unroll
                for (int nt = 0; nt < 2; ++nt)
#pragma unroll
                    for (int r = 0; r < 16; ++r) sc[nt][r] = 0.f;
#pragma unroll
                for (int s = 0; s < 8; ++s) {
#pragma unroll
                    for (int nt = 0; nt < 2; ++nt) { const int n = 64 * pq + 32 * nt + l31; const bf16x8 kb = *(const LAS bf16x8*)(uintptr_t)(lds0 + p * 32768 + n * 256 + (((2 * s + hh) ^ (n & 15)) << 4));
                        sc[nt] = __builtin_amdgcn_mfma_f32_32x32x16_bf16(kb, qa[s], sc[nt], 0, 0, 0); }
                }
                int y[16];
#pragma unroll
                for (int r = 0; r < 16; ++r) { x[pq][r] = (ord_key(sc[0][r]) & ~127) | ((127 - 64 * pq - (r & 3) - 8 * (r >> 2)) - 4 * hh); y[r] = (ord_key(sc[1][r]) & ~127) | ((127 - 64 * pq - 32 - (r & 3) - 8 * (r >> 2)) - 4 * hh); }
                sort16(x[pq]); sort16(y); merge16(x[pq], y);
                asm volatile("" ::: "memory");
            }
            merge16(x[0], x[1]);
            xmerge16(x[0], hh);
#pragma unroll
            for (int i = 0; i < 16; ++i) top[p][i] = x[0][i];
        }
        float fa[16], fb[16];
#pragma unroll
        for (int i = 0; i < 16; ++i) { const int A = hh ? top[1][i] : top[0][i], B = hh ? top[0][i] : top[1][i]; fa[i] = ord_val(A & ~127); fb[i] = ord_val(B & ~127); }
        int c0[16], c1[16];
#pragma unroll
        for (int q = 0; q < 32; ++q) {
            int key = IMIN;
            if (q < 27) { const int i = (q < 16) ? 0 : (q < 23) ? 1 : (q < 26) ? 2 : 3, j = (q < 16) ? q : (q < 23) ? q - 15 : (q < 26) ? q - 21 : 3; const float sv = fa[i] + fb[j]; const int low = hh ? (255 - (j * 16 + i)) : (255 - (i * 16 + j));
                key = (ord_key(sv) & ~255) | low; if (i == j && hh) key = IMIN; }
            if (q < 16) c0[q] = key; else c1[q - 16] = key;
        }
        sort16(c0); sort16(c1); merge16(c0, c1); xmerge16(c0, hh);
        unsigned na[4], nb[4];
#pragma unroll
        for (int d = 0; d < 4; ++d) { na[d] = 0u; nb[d] = 0u;
#pragma unroll
            for (int e = 0; e < 4; ++e) { na[d] |= (unsigned)(127 - (top[0][4 * d + e] & 127)) << (8 * e); nb[d] |= (unsigned)(127 - (top[1][4 * d + e] & 127)) << (8 * e); } }
        int ex[16]; float ev[16]; float es = 0.f; const float smax = ord_val(c0[0] & ~255);
#pragma unroll
        for (int q = 0; q < 16; ++q) { const int posn = 255 - (c0[q] & 255); const unsigned n1 = byte16(na, posn >> 4) & 255u, n2 = byte16(nb, posn & 15) & 255u;
            ex[q] = (int)(n1 * 128u + n2); ev[q] = __expf(ord_val(c0[q] & ~255) - smax); es += ev[q]; }
        const float ri = 1.0f / es; const size_t ob = (size_t)(tok0 + l31) * 128 + h * 16;
        if (hh == 0) {
#pragma unroll
            for (int d = 0; d < 4; ++d) { v4u w; w.x = (unsigned)ex[4 * d]; w.y = (unsigned)ex[4 * d + 1]; w.z = (unsigned)ex[4 * d + 2]; w.w = (unsigned)ex[4 * d + 3]; *(GAS v4u*)(EXP + ob + 4 * d) = w; }
        } else {
#pragma unroll
            for (int d = 0; d < 4; ++d) *(GAS f32x4*)(GATE + ob + 4 * d) = (f32x4){ev[4 * d] * ri, ev[4 * d + 1] * ri, ev[4 * d + 2] * ri, ev[4 * d + 3] * ri};
        }
    }
}

typedef float f32x2 __attribute__((ext_vector_type(2)));
constexpr float PEER_SU = 512.0f, PEER_SV = 32.0f;
template <int CTRL> __device__ __forceinline__ int dpp_i(int v) { return __builtin_amdgcn_update_dpp(v, v, CTRL, 0xf, 0xf, false); }
template <int J> __device__ __forceinline__ int xor_lane(int v, int lane) {
    if constexpr (J == 1) return dpp_i<0xB1>(v);
    else if constexpr (J == 2) return dpp_i<0x4E>(v);
    else if constexpr (J == 16) { const auto r = __builtin_amdgcn_permlane16_swap((unsigned)v, (unsigned)v, false, false); return ((lane >> 4) & 1) ? (int)r[0] : (int)r[1]; }
    else if constexpr (J == 32) { const auto r = __builtin_amdgcn_permlane32_swap((unsigned)v, (unsigned)v, false, false); return (lane >> 5) ? (int)r[0] : (int)r[1]; }
    else return __shfl_xor(v, J);
}
__device__ __forceinline__ float wave_sum_dpp(float v) {
    v += __int_as_float(dpp_i<0xB1>(__float_as_int(v))); v += __int_as_float(dpp_i<0x4E>(__float_as_int(v))); v += __int_as_float(dpp_i<0x141>(__float_as_int(v))); v += __int_as_float(dpp_i<0x140>(__float_as_int(v)));
    { const auto r = __builtin_amdgcn_permlane16_swap(__float_as_uint(v), __float_as_uint(v), false, false); v = __uint_as_float(r[0]) + __uint_as_float(r[1]); }
    { const auto r = __builtin_amdgcn_permlane32_swap(__float_as_uint(v), __float_as_uint(v), false, false); v = __uint_as_float(r[0]) + __uint_as_float(r[1]); }
    return v; }
template <int KK, int JJ> __device__ __forceinline__ void sort512_step(int (&x)[8], int lane) {
    constexpr int k = 1 << KK, j = 1 << JJ;
    if constexpr (j >= 64) { constexpr int jr = j >> 6;
#pragma unroll
        for (int r = 0; r < 8; ++r) if ((r & jr) == 0) { const bool asc = (k >= 512) ? true : (((r << 6) & k) == 0); const int lo = imin(x[r], x[r | jr]), hi_ = imax(x[r], x[r | jr]); x[r] = asc ? lo : hi_; x[r | jr] = asc ? hi_ : lo; }
    } else {
        const bool lower = (lane & j) == 0;
#pragma unroll
        for (int r = 0; r < 8; ++r) { const int y = xor_lane<j>(x[r], lane);
            const bool asc = (k < 64) ? ((lane & k) == 0) : ((k >= 512) ? true : (((r << 6) & k) == 0));
            x[r] = (lower == asc) ? imin(x[r], y) : imax(x[r], y); }
    }
}
template <int KK, int JJ> __device__ __forceinline__ void sort512_stage(int (&x)[8], int lane) { sort512_step<KK, JJ>(x, lane); if constexpr (JJ > 0) sort512_stage<KK, JJ - 1>(x, lane); }
__device__ __forceinline__ void sort512(int (&x)[8], int lane) {
    sort512_stage<1, 0>(x, lane); sort512_stage<2, 1>(x, lane); sort512_stage<3, 2>(x, lane); sort512_stage<4, 3>(x, lane); sort512_stage<5, 4>(x, lane);
    sort512_stage<6, 5>(x, lane); sort512_stage<7, 6>(x, lane); sort512_stage<8, 7>(x, lane); sort512_stage<9, 8>(x, lane);
}
__device__ __forceinline__ void peer_phase(const Ctx& F, const unsigned char* U8, const unsigned char* V8, const bf16* X1B, const int* EXP, const float* GATE, const unsigned long long* SS, const float* gfin, const float* X1, float* OUT) {
    const int gw = F.vcu * NWAVES + F.wave, NGW = F.G * NWAVES, lane = F.lane;
    const unsigned xs0 = (unsigned)(uintptr_t)(F.lds + RING_OFF + F.wave * 16384) + lane * 16;
    for (int tb = gw; tb + 3 * NGW < M; tb += 4 * NGW) {
        int kreg[8]; float greg[8], rv[4];
#pragma unroll
        for (int j = 0; j < 4; ++j) { const size_t t = (size_t)tb + (size_t)j * NGW;
            kreg[2 * j] = (EXP[t * 128 + lane] << 9) | (j << 7) | lane; kreg[2 * j + 1] = (EXP[t * 128 + 64 + lane] << 9) | (j << 7) | (64 + lane);
            rv[j] = pg8::rinv_from_ss(SS[t]) * (1.0f / PEER_SU);
#pragma unroll
            for (int q = 0; q < 4; ++q) { const v4u w = *(const GAS v4u*)(X1B + t * DM + (q >> 1) * 1024 + lane * 16 + 8 * (q & 1)); *(LAS v4u*)(uintptr_t)(xs0 + j * 4096 + q * 1024) = w; } }
        sort512(kreg, lane);
        int pkey[8];
#pragma unroll
        for (int c = 0; c < 8; ++c) { pkey[c] = __shfl(kreg[c], 8 * (lane & 7) + (lane >> 3)); greg[c] = GATE[((size_t)tb + (size_t)((pkey[c] >> 7) & 3) * NGW) * 128 + (pkey[c] & 127)]; }
        asm volatile("s_waitcnt lgkmcnt(0)" ::: "memory");
        float actreg[8];
#ifndef MK_P8_REPU
#define MK_P8_REPU 1
#endif
#pragma unroll 1
        for (int repu = 0; repu < MK_P8_REPU; ++repu) {
            v4u ub[8][2];
#pragma unroll
            for (int u = 0; u < 8; ++u) { const GAS v4u* up = (const GAS v4u*)(U8 + (size_t)(__builtin_amdgcn_readlane(kreg[0], u) >> 9) * 2048) + lane; ub[u][0] = up[0]; ub[u][1] = up[64]; }
#pragma unroll
            for (int c = 0; c < 8; ++c) {
                float areg = 0.f;
#pragma unroll 1
                for (int g = 0; g < 8; ++g) {
                    float pt[8];
#pragma unroll
                    for (int u = 0; u < 8; ++u) {
                        const int key = __builtin_amdgcn_readlane(kreg[c], 8 * g + u);
                        const unsigned xa = xs0 + ((key >> 7) & 3) * 4096;
                        float p0 = 0.f, p1 = 0.f;
#pragma unroll
                        for (int i = 0; i < 2; ++i) { const v4u w = ub[u][i];
#pragma unroll
                            for (int hv = 0; hv < 2; ++hv) { const v4u xq = *(const LAS v4u*)(uintptr_t)(xa + (2 * i + hv) * 1024);
                                const unsigned w0 = hv ? w.z : w.x, w1 = hv ? w.w : w.y;
                                const f32x2 a0 = __builtin_amdgcn_cvt_pk_f32_fp8((int)w0, false), a1 = __builtin_amdgcn_cvt_pk_f32_fp8((int)w0, true), a2 = __builtin_amdgcn_cvt_pk_f32_fp8((int)w1, false), a3 = __builtin_amdgcn_cvt_pk_f32_fp8((int)w1, true);
                                p0 = dot2bf(pg8::cvt_pk_bf16(a0[0], a0[1]), xq.x, p0); p1 = dot2bf(pg8::cvt_pk_bf16(a1[0], a1[1]), xq.y, p1);
                                p0 = dot2bf(pg8::cvt_pk_bf16(a2[0], a2[1]), xq.z, p0); p1 = dot2bf(pg8::cvt_pk_bf16(a3[0], a3[1]), xq.w, p1); } }
                        pt[u] = p0 + p1;
                        { const int ix = 8 * g + 8 + u, ka = __builtin_amdgcn_readlane(kreg[c], ix & 63), kb = __builtin_amdgcn_readlane(kreg[c < 7 ? c + 1 : 7], ix & 63), kn = (ix < 64) ? ka : kb;
                            const GAS v4u* up = (const GAS v4u*)(U8 + (size_t)(kn >> 9) * 2048) + lane; ub[u][0] = up[0]; ub[u][1] = up[64]; }
                    }
                    { const bool b5 = (lane & 32) != 0, b4 = (lane & 16) != 0, b3 = (lane & 8) != 0;
#pragma unroll
                      for (int i = 0; i < 4; ++i) { const float a = pt[i], b = pt[i + 4]; pt[i] = (b5 ? b : a) + __int_as_float(xor_lane<32>(__float_as_int(b5 ? a : b), lane)); }
#pragma unroll
                      for (int i = 0; i < 2; ++i) { const float a = pt[i], b = pt[i + 2]; pt[i] = (b4 ? b : a) + __int_as_float(xor_lane<16>(__float_as_int(b4 ? a : b), lane)); }
                      { const float a = pt[0], b = pt[1]; pt[0] = (b3 ? b : a) + __shfl_xor(b3 ? a : b, 8); }
                      float r = pt[0]; r += __shfl_xor(r, 4); r += __int_as_float(dpp_i<0x4E>(__float_as_int(r))); r += __int_as_float(dpp_i<0xB1>(__float_as_int(r)));
                      areg = ((lane & 7) == g) ? r : areg; }
                }
                const int tk = (pkey[c] >> 7) & 3; const float rr = (tk == 0) ? rv[0] : (tk == 1) ? rv[1] : (tk == 2) ? rv[2] : rv[3];
                actreg[c] = gelu_tanh(areg * rr) * greg[c] * (1.0f / PEER_SV);
            }
        }
        LAS float* as = (LAS float*)(uintptr_t)(xs0 - lane * 16);
        asm volatile("s_waitcnt lgkmcnt(0)" ::: "memory");
#pragma unroll
        for (int c = 0; c < 8; ++c) as[64 * c + lane] = actreg[c];
        int k2[8];
#pragma unroll
        for (int c = 0; c < 8; ++c) { const int key = kreg[c], tok = (key >> 7) & 3, park = 64 * c + 8 * (lane & 7) + (lane >> 3);
            k2[c] = ((tok >> 1) << 24) | ((key >> 9) << 10) | ((tok & 1) << 9) | park; }
        sort512(k2, lane);
        asm volatile("s_waitcnt lgkmcnt(0)" ::: "memory");
        float a2[8];
#pragma unroll
        for (int c = 0; c < 8; ++c) a2[c] = as[k2[c] & 511];
#pragma unroll 1
        for (int pp = 0; pp < 2; ++pp) {
            int kq[4]; float aq[4];
#pragma unroll
            for (int c = 0; c < 4; ++c) { kq[c] = pp ? k2[4 + c] : k2[c]; aq[c] = pp ? a2[4 + c] : a2[c]; }
            f32x2 y[2][16];
#pragma unroll
            for (int j = 0; j < 2; ++j)
#pragma unroll
                for (int q = 0; q < 16; ++q) y[j][q] = (f32x2){0.f, 0.f};
            v4u vb[8][2];
#pragma unroll
            for (int u = 0; u < 8; ++u) { const GAS v4u* vp = (const GAS v4u*)(V8 + (size_t)((__builtin_amdgcn_readlane(kq[0], u) >> 10) & 0x3fff) * 2048) + lane; vb[u][0] = vp[0]; vb[u][1] = vp[64]; }
#pragma unroll
            for (int c = 0; c < 4; ++c) {
#pragma unroll 1
                for (int g = 0; g < 8; ++g) {
#pragma unroll
                    for (int u = 0; u < 8; ++u) {
                        const int key = __builtin_amdgcn_readlane(kq[c], 8 * g + u); const float s = rdlane(aq[c], 8 * g + u);
                        const float sa = (key & 512) ? 0.f : s, sb = (key & 512) ? s : 0.f; const f32x2 s0 = {sa, sa}, s1 = {sb, sb};
#pragma unroll
                        for (int i = 0; i < 2; ++i) { const v4u w = vb[u][i];
                            const f32x2 c0 = __builtin_amdgcn_cvt_pk_f32_fp8((int)w.x, false), c1 = __builtin_amdgcn_cvt_pk_f32_fp8((int)w.x, true), c2 = __builtin_amdgcn_cvt_pk_f32_fp8((int)w.y, false), c3 = __builtin_amdgcn_cvt_pk_f32_fp8((int)w.y, true);
                            const f32x2 c4 = __builtin_amdgcn_cvt_pk_f32_fp8((int)w.z, false), c5 = __builtin_amdgcn_cvt_pk_f32_fp8((int)w.z, true), c6 = __builtin_amdgcn_cvt_pk_f32_fp8((int)w.w, false), c7 = __builtin_amdgcn_cvt_pk_f32_fp8((int)w.w, true);
                            y[0][8 * i + 0] = __builtin_elementwise_fma(c0, s0, y[0][8 * i + 0]); y[1][8 * i + 0] = __builtin_elementwise_fma(c0, s1, y[1][8 * i + 0]);
                            y[0][8 * i + 1] = __builtin_elementwise_fma(c1, s0, y[0][8 * i + 1]); y[1][8 * i + 1] = __builtin_elementwise_fma(c1, s1, y[1][8 * i + 1]);
                            y[0][8 * i + 2] = __builtin_elementwise_fma(c2, s0, y[0][8 * i + 2]); y[1][8 * i + 2] = __builtin_elementwise_fma(c2, s1, y[1][8 * i + 2]);
                            y[0][8 * i + 3] = __builtin_elementwise_fma(c3, s0, y[0][8 * i + 3]); y[1][8 * i + 3] = __builtin_elementwise_fma(c3, s1, y[1][8 * i + 3]);
                            y[0][8 * i + 4] = __builtin_elementwise_fma(c4, s0, y[0][8 * i + 4]); y[1][8 * i + 4] = __builtin_elementwise_fma(c4, s1, y[1][8 * i + 4]);
                            y[0][8 * i + 5] = __builtin_elementwise_fma(c5, s0, y[0][8 * i + 5]); y[1][8 * i + 5] = __builtin_elementwise_fma(c5, s1, y[1][8 * i + 5]);
                            y[0][8 * i + 6] = __builtin_elementwise_fma(c6, s0, y[0][8 * i + 6]); y[1][8 * i + 6] = __builtin_elementwise_fma(c6, s1, y[1][8 * i + 6]);
                            y[0][8 * i + 7] = __builtin_elementwise_fma(c7, s0, y[0][8 * i + 7]); y[1][8 * i + 7] = __builtin_elementwise_fma(c7, s1, y[1][8 * i + 7]); }
                        { const int ix = 8 * g + 8 + u, ka = __builtin_amdgcn_readlane(kq[c], ix & 63), kb = __builtin_amdgcn_readlane(kq[c < 3 ? c + 1 : 3], ix & 63), kn = (ix < 64) ? ka : kb;
                            const GAS v4u* vp = (const GAS v4u*)(V8 + (size_t)((kn >> 10) & 0x3fff) * 2048) + lane; vb[u][0] = vp[0]; vb[u][1] = vp[64]; }
                    }
                }
            }
#pragma unroll
            for (int j = 0; j < 2; ++j) { const size_t t = (size_t)tb + (size_t)(2 * pp + j) * NGW;
                GAS f32x4* orw = (GAS f32x4*)(OUT + t * DM); float ss = 0.f;
#pragma unroll
                for (int i = 0; i < 2; ++i)
#pragma unroll
                    for (int hv = 0; hv < 2; ++hv) { const v4u w = *(const GAS v4u*)(X1B + t * DM + i * 1024 + lane * 16 + 8 * hv);
                        y[j][8 * i + 4 * hv + 0] += (f32x2){bflo(w.x), bfhi(w.x)}; y[j][8 * i + 4 * hv + 1] += (f32x2){bflo(w.y), bfhi(w.y)}; y[j][8 * i + 4 * hv + 2] += (f32x2){bflo(w.z), bfhi(w.z)}; y[j][8 * i + 4 * hv + 3] += (f32x2){bflo(w.w), bfhi(w.w)}; }
#pragma unroll
                for (int q = 0; q < 16; ++q) ss += y[j][q][0] * y[j][q][0] + y[j][q][1] * y[j][q][1];
                const float r3 = 1.0f / sqrtf(wave_sum_dpp(ss) * (1.0f / DM) + RMS_EPS);
#pragma unroll
                for (int i = 0; i < 2; ++i)
#pragma unroll
                    for (int q = 0; q < 4; ++q) { const f32x4 ga = *(const GAS f32x4*)(gfin + i * 1024 + lane * 16 + 4 * q);
                        orw[i * 256 + 4 * lane + q] = (f32x4){y[j][8 * i + 2 * q][0] * r3 * ga[0], y[j][8 * i + 2 * q][1] * r3 * ga[1], y[j][8 * i + 2 * q + 1][0] * r3 * ga[2], y[j][8 * i + 2 * q + 1][1] * r3 * ga[3]}; }
            }
        }
        asm volatile("s_waitcnt lgkmcnt(0)" ::: "memory");
    }
}

struct Args { const float* in[15]; float* out; unsigned char* ws; double invf[16]; int ph_lo, ph_hi, li, pad; };
__global__ void __launch_bounds__(NWAVES * 64, 2) mk_fwd(Args args) {
    extern __shared__ __attribute__((aligned(16))) unsigned char lds[];
    Ctx F;
    F.lds = (LAS unsigned char*)lds;
    volatile LAS unsigned* MISC = (volatile LAS unsigned*)(F.lds + MISC_OFF);
    F.tid = threadIdx.x; F.lane = F.tid & 63; F.wave = __builtin_amdgcn_readfirstlane(F.tid >> 6);
    F.G = gridDim.x; { const int bx = blockIdx.x; F.vcu = (F.G % 8 == 0) ? (bx % 8) * (F.G / 8) + bx / 8 : bx; }
    unsigned char* ws = args.ws;
    gu32* ctl = (gu32*)(ws + WS_CTL);
    for (int u = F.tid; u < (LDS_BYTES - LDSCTL_OFF) / 4; u += NWAVES * 64) ((LAS unsigned*)(F.lds + LDSCTL_OFF))[u] = 0u;
    __syncthreads();
    XcdBarrier bar; bar.bar = (unsigned*)(ctl + CW_BAR); bar.x = 0; bar.st = nullptr;
    if (N_LAUNCHES != PER_PHASE) bar = xcd_barrier_post((unsigned*)(ctl + CW_BAR), MISC + 8);
#define GRID_BAR() do { if (N_LAUNCHES != PER_PHASE) xcd_barrier(bar); } while (0)
#define GRID_BAR_W(q) do { if (N_LAUNCHES != PER_PHASE) { const BarWork wk_{args.in[12], args.in[13], args.in[9], ws, (q), 4}; xcd_barrier(bar, &F, &wk_); } } while (0)
    const int lo = args.ph_lo, hi = args.ph_hi;
#define IN(k) (lo <= (k) && (k) < hi)
#define BOTH(k) (IN(k) && IN((k) + 1))
    bf16* WinT = (bf16*)(ws + WS_WIN); bf16* WbcT = (bf16*)(ws + WS_WBC); bf16* WbaT = (bf16*)(ws + WS_WBA); bf16* WoutT = (bf16*)(ws + WS_WOUT); bf16* WpqT = (bf16*)(ws + WS_WPQ);
    bf16* KEYS = (bf16*)(ws + WS_KEYS); float* CS = (float*)(ws + WS_CS); const unsigned char* UB = ws + WS_UB; const unsigned char* VB = ws + WS_VB;
    bf16* XB = (bf16*)(ws + WS_XB); bf16* T6 = (bf16*)(ws + WS_T6); bf16* GAB = (bf16*)(ws + WS_GAB); bf16* UC = (bf16*)(ws + WS_UC); bf16* AO = (bf16*)(ws + WS_AO);
    bf16* TMP = (bf16*)(ws + WS_TMP); bf16* MB = (bf16*)(ws + WS_MB); bf16* X1B = (bf16*)(ws + WS_X1B); bf16* QP = (bf16*)(ws + WS_QP);
    int* EXP = (int*)(ws + WS_EXP); float* GATE = (float*)(ws + WS_GATE);
    unsigned long long* SS = (unsigned long long*)(ws + WS_SS); float* KSUM = (float*)(ws + WS_KSUM);
    constexpr size_t TS = (size_t)M * 1024;

    if (IN(0)) { for (int rep = 0; rep < NREP(0); ++rep) { p0_prologue(F, args.in, ws, args.invf); if (rep + 1 < NREP(0)) GRID_BAR(); } if (BOTH(0)) GRID_BAR(); }
    if (IN(1)) {
        for (int rep = 0; rep < NREP(1); ++rep) {
        pg8::Gemm g{XB, WinT, M, INW, DM}; pg8::StaticOrder S; S.init(M, INW, F.G, (int)blockIdx.x);
        pg8::EpiIn E{T6, GAB, args.in[4], CS, KSUM};
        pg8::gemm_phase<pg8::EpiIn, pg8::StaticOrder, true, true>(F.lds + RING_OFF, g, S, E);
        if (rep + 1 < NREP(1)) GRID_BAR(); }
        if (BOTH(1)) GRID_BAR();
    }
    if (IN(2)) {
        for (int rep = 0; rep < NREP(2); ++rep) {
        attn_mfma(F, T6 + 3 * TS, T6 + 4 * TS, T6 + 5 * TS, KSUM, AO);
        conv_phase(F, T6, T6 + TS, args.in[5], UC);
        if (rep + 1 < NREP(2)) GRID_BAR(); }
        if (BOTH(2)) GRID_BAR_W(0);
    }
    if (IN(3)) {
        for (int rep = 0; rep < NREP(3); ++rep) {
        pg8::Gemm g{UC, WbcT, M, DM, 1024, AO, WbaT}; pg8::TwoSegOrder S; S.init(M, DM, F.G, (int)blockIdx.x);
        pg8::EpiMerge2 E{GAB, GAB + (size_t)M * DM, MB};
        pg8::gemm_phase<pg8::EpiMerge2, pg8::TwoSegOrder, true, true>(F.lds + RING_OFF, g, S, E);
        if (rep + 1 < NREP(3)) GRID_BAR(); }
        if (BOTH(3)) GRID_BAR_W(1);
    }
    if (IN(5)) {
        for (int rep = 0; rep < NREP(5); ++rep) {
        pg8::Gemm g{MB, WoutT, M, DM, DM}; pg8::StaticOrder S; S.init(M, DM, F.G, (int)blockIdx.x);
        pg8::EpiX1 E{XB, (const float*)(ws + WS_RMS), X1B, (rep + 1 < NREP(5)) ? (unsigned long long*)(ws + 768 * 1024) : SS};
        pg8::gemm_phase<pg8::EpiX1, pg8::StaticOrder, true, true>(F.lds + RING_OFF, g, S, E);
        if (rep + 1 < NREP(5)) GRID_BAR(); }
        if (BOTH(5)) GRID_BAR_W(2);
    }
    if (IN(6)) {
        for (int rep = 0; rep < NREP(6); ++rep) {
        pg8::Gemm g{X1B, WpqT, M, DM, DM}; pg8::StaticOrder S; S.init(M, DM, F.G, (int)blockIdx.x);
        pg8::EpiQP E{SS, QP};
        pg8::gemm_phase<pg8::EpiQP, pg8::StaticOrder, true, true>(F.lds + RING_OFF, g, S, E);
        if (rep + 1 < NREP(6)) GRID_BAR(); }
        if (BOTH(6)) GRID_BAR_W(3);
    }
    if (IN(7)) { for (int rep = 0; rep < NREP(7); ++rep) {
        for (int bitem = F.vcu; bitem < 256; bitem += F.G) {
            topk_stage_keys(F, KEYS, bitem & 7);
            if (N_LAUNCHES == PER_PHASE && bitem == F.vcu) convert_tables(F, args.in[12], args.in[13], args.in[9], ws, 0, 1, 0);
            topk_phase(F, bitem, QP, EXP, GATE);
            asm volatile("s_waitcnt lgkmcnt(0)" ::: "memory"); __builtin_amdgcn_s_barrier(); asm volatile("" ::: "memory");
        }
        if (rep + 1 < NREP(7)) GRID_BAR(); } if (BOTH(7)) GRID_BAR(); }
    if (IN(8)) { for (int rep = 0; rep < NREP(8); ++rep) { peer_phase(F, UB, VB, X1B, EXP, GATE, SS, args.in[14], args.out, (rep + 1 < NREP(8)) ? (float*)(ws + WS_END) : args.out); if (rep + 1 < NREP(8)) GRID_BAR(); } }
#undef IN
#undef BOTH
#undef GRID_BAR
#undef GRID_BAR_W
}

extern "C" void kernel_launch(void* const* d_in, const int* in_sizes, int n_in, void* d_out, int out_size, void* d_ws, size_t ws_size, hipStream_t stream) {
    static int grid = 0;
    if (grid == 0) {
        if (n_in != 15 || in_sizes[0] != M * DM || out_size != M * DM || ws_size < WS_END) { fprintf(stderr, "kernel_launch: unexpected shapes (n_in %d, in0 %d, out %d, ws %zu)\n", n_in, n_in > 0 ? in_sizes[0] : -1, out_size, ws_size); grid = -1; return; }
        int dev = 0, cus = 0, per_cu = 0;
        if (hipGetDevice(&dev) != hipSuccess || hipDeviceGetAttribute(&cus, hipDeviceAttributeMultiprocessorCount, dev) != hipSuccess) { grid = -1; return; }
        if (hipFuncSetAttribute((const void*)mk_fwd, hipFuncAttributeMaxDynamicSharedMemorySize, LDS_BYTES) != hipSuccess) { fprintf(stderr, "kernel_launch: hipFuncSetAttribute failed\n"); grid = -1; return; }
        if (hipOccupancyMaxActiveBlocksPerMultiprocessor(&per_cu, (const void*)mk_fwd, NWAVES * 64, LDS_BYTES) != hipSuccess || per_cu < 1) fprintf(stderr, "kernel_launch: occupancy query reports %d\n", per_cu);
        (void)hipGetLastError();
        grid = cus;
        if (M % (4 * grid * NWAVES) != 0) { fprintf(stderr, "kernel_launch: the PEER phase needs M %% (32 * grid) == 0 (grid %d)\n", grid); grid = -1; return; }
    }
    if (grid < 0) return;
    if (hipMemsetAsync((char*)d_ws + WS_CTL, 0, CTL_ZERO_BYTES, stream) != hipSuccess) { fprintf(stderr, "kernel_launch: memset failed\n"); return; }
    Args a{};
    for (int i = 0; i < 15; ++i) a.in[i] = (const float*)d_in[i];
    a.out = (float*)d_out; a.ws = (unsigned char*)d_ws;
    for (int f = 0; f < 16; ++f) a.invf[f] = pow(500000.0, -(double)(2 * f) / 32.0);
    for (int li = 0; li < N_LAUNCHES; ++li) {
        a.ph_lo = (N_LAUNCHES == PER_PHASE) ? li : 0; a.ph_hi = (N_LAUNCHES == PER_PHASE) ? li + 1 : PER_PHASE; a.li = li;
        hipLaunchKernelGGL(mk_fwd, dim3(grid), dim3(NWAVES * 64), LDS_BYTES, stream, a);
        const hipError_t le = hipPeekAtLastError();
        if (le != hipSuccess) { fprintf(stderr, "kernel_launch: launch %d failed: %s\n", li, hipGetErrorName(le)); break; }
    }
}
```

```cpp
#include <hip/hip_runtime.h>
#include <cstdio>
#include <cstdint>
#include <cmath>
namespace pg8 {
#define PG8_LAS __attribute__((address_space(3)))
typedef unsigned short bf16_t;
typedef short bf16x8 __attribute__((ext_vector_type(8)));
typedef float f32x4 __attribute__((ext_vector_type(4)));
typedef unsigned u32x4 __attribute__((ext_vector_type(4)));
constexpr int BM = 256, BK = 64, HALF = 128, HTB = HALF * BK * 2  , STAGE_BYTES = 8 * HTB, NXCD = 8, WGM = 8;

__host__ __device__ __forceinline__ int lds_byte(int r, int c) { const int st = (r >> 4) * 2 + (c >> 5), rr = r & 15, cc = c & 31, ob = rr * 64 + cc * 2; return st * 1024 + (ob ^ (((ob >> 9) & 1) << 5)); }
__host__ __device__ __forceinline__ void stage_rc(int b, int& R, int& C) { const int st = b / 1024, sb = b % 1024, swz = sb ^ (((sb >> 9) & 1) << 5); R = (st >> 1) * 16 + swz / 64; C = (st & 1) * 32 + (swz % 64) / 2; }
__host__ __device__ __forceinline__ int perm32(int rho) { const int n = rho >> 4, i = rho & 15; return 8 * (i >> 2) + 4 * n + (i & 3); }

struct Unit { int pm, pn, seg; };
struct Gemm { const bf16_t* A; const bf16_t* Bt; int M, N, K; const bf16_t* A2; const bf16_t* Bt2; };

struct StaticOrder {
    int nM, nN, nwg, G, c;
    __host__ __device__ void init(int M, int N, int G_, int c_) { nM = M / BM; nN = N / BM; nwg = nM * nN; G = G_; c = c_; }
    __host__ __device__ bool next(int i, Unit& u) const {
        const long L = (long)i * G + c; if (L >= nwg) return false;
        int wgid = (int)L; { const int q = nwg / NXCD, r = nwg % NXCD, xcd = wgid % NXCD, off = wgid / NXCD; wgid = (xcd < r ? xcd * (q + 1) : r * (q + 1) + (xcd - r) * q) + off; }
        const int nig = WGM * nN, gid = wgid / nig, fm = gid * WGM, gsz = (nM - fm) < WGM ? (nM - fm) : WGM;
        u.pm = fm + ((wgid % nig) % gsz); u.pn = (wgid % nig) / gsz; u.seg = 0; return true;
    }
    __device__ __forceinline__ void a_ready(const Unit&) const {}
    __device__ __forceinline__ void done(const Unit&) const {}
};
struct TwoSegOrder {
    StaticOrder so;
    __host__ __device__ void init(int M, int N, int G_, int c_) { so.init(M, N, G_, c_); }
    __host__ __device__ bool next(int i, Unit& u) const { if (!so.next(i >> 1, u)) return false; u.seg = i & 1; return true; }
    __device__ __forceinline__ void a_ready(const Unit&) const {}
    __device__ __forceinline__ void done(const Unit&) const {}
};


typedef float f32x2c __attribute__((ext_vector_type(2))); typedef __bf16 bf16x2c __attribute__((ext_vector_type(2)));
__device__ __forceinline__ unsigned cvt_pk_bf16(float lo, float hi) { const f32x2c v = {lo, hi}; const bf16x2c b = __builtin_convertvector(v, bf16x2c); return __builtin_bit_cast(unsigned, b); }
__device__ __forceinline__ u32x4 pack8(f32x4 a, f32x4 b) { u32x4 w; w.x = cvt_pk_bf16(a[0], a[1]); w.y = cvt_pk_bf16(a[2], a[3]); w.z = cvt_pk_bf16(b[0], b[1]); w.w = cvt_pk_bf16(b[2], b[3]); return w; }
__device__ __forceinline__ f32x4 shx(f32x4 v, int o) { f32x4 r; r[0] = __shfl_xor(v[0], o); r[1] = __shfl_xor(v[1], o); r[2] = __shfl_xor(v[2], o); r[3] = __shfl_xor(v[3], o); return r; }
__device__ __forceinline__ f32x4 bf4lo(unsigned a, unsigned b) { f32x4 r; r[0] = __uint_as_float(a << 16); r[1] = __uint_as_float(a & 0xffff0000u); r[2] = __uint_as_float(b << 16); r[3] = __uint_as_float(b & 0xffff0000u); return r; }
__device__ __forceinline__ f32x4 sigm4(f32x4 v) { f32x4 r;
#pragma unroll
    for (int i = 0; i < 4; ++i) r[i] = __builtin_amdgcn_rcpf(1.0f + __expf(-v[i])); return r; }
constexpr float QSCALE = 0.08838834764831845f * 1.4426950408889634f;

struct EpiIn {
    static constexpr bool PERM = true, AFTER_DRAIN = false, KEEP_SEG0 = false;
    bf16_t* T6; bf16_t* GAB; const float* gbias; const float* cs; float* ksum;
    __device__ __forceinline__ void operator()(const f32x4 (&acc)[2][2][4][2], const Unit& u, int wr, int wc, int fr, int fq) const {
        const int row0 = u.pm * BM + wr * 64 + fr, pn = u.pn, colw = wc * 32 + 8 * fq;
        if (pn < 24) {
            const int t = pn >> 2;
            bf16_t* base = T6 + (size_t)t * ((size_t)8192 * 1024) + (pn & 3) * 256 + colw;
            const bool rot = (t == 3 || t == 4) && (wc == 0), isk = (t == 4), zt = (pn >= 4 && pn < 12);
            const float qs = (t == 3) ? QSCALE : 1.0f;
            f32x4 ks[2][2];
#pragma unroll
            for (int bj = 0; bj < 2; ++bj) { ks[bj][0] = (f32x4){0.f, 0.f, 0.f, 0.f}; ks[bj][1] = (f32x4){0.f, 0.f, 0.f, 0.f}; }
#pragma unroll
            for (int ai = 0; ai < 2; ++ai)
#pragma unroll
                for (int m = 0; m < 4; ++m) {
                    const int row = row0 + ai * HALF + m * 16;
                    f32x4 c0 = (f32x4){1.f, 1.f, 1.f, 1.f}, c1 = c0, s0 = (f32x4){0.f, 0.f, 0.f, 0.f}, s1 = s0;
                    if (rot) { const float* cp = cs + (size_t)row * 32 + 8 * (fq & 1); c0 = *(const f32x4*)cp; c1 = *(const f32x4*)(cp + 4); s0 = *(const f32x4*)(cp + 16); s1 = *(const f32x4*)(cp + 20);
                        if (fq < 2) { s0 = -s0; s1 = -s1; } }
                    if (zt) {
                        *(u32x4*)(T6 + (size_t)8192 * 1024 + (size_t)row * 1024 + (pn - 4) * 128 + colw) = pack8(acc[ai][0][m][0] * acc[ai][1][m][0], acc[ai][0][m][1] * acc[ai][1][m][1]);
                    } else {
#pragma unroll
                    for (int bj = 0; bj < 2; ++bj) {
                        f32x4 v0 = acc[ai][bj][m][0], v1 = acc[ai][bj][m][1];
                        if (rot) { const f32x4 p0 = shx(v0, 32), p1 = shx(v1, 32); v0 = v0 * c0 + p0 * s0; v1 = v1 * c1 + p1 * s1; }
                        if (isk) { ks[bj][0] += v0; ks[bj][1] += v1; }
                        v0 = v0 * qs; v1 = v1 * qs;
                        *(u32x4*)(base + (size_t)row * 1024 + bj * HALF) = pack8(v0, v1);
                    } }
                }
            if (isk) {
#pragma unroll
                for (int bj = 0; bj < 2; ++bj)
#pragma unroll
                    for (int n = 0; n < 2; ++n) { f32x4 v = ks[bj][n]; v += shx(v, 1); v += shx(v, 2); v += shx(v, 4); v += shx(v, 8);
                        if (fr == 0) { float* kp = ksum + (size_t)u.pm * 1024 + (pn & 3) * 256 + bj * HALF + colw + 4 * n;
                            unsafeAtomicAdd(kp + 0, v[0]); unsafeAtomicAdd(kp + 1, v[1]); unsafeAtomicAdd(kp + 2, v[2]); unsafeAtomicAdd(kp + 3, v[3]); } }
            }
        } else {
            const int colg = (pn - 24) * 128 + colw;
            bf16_t* baseR = GAB + colg; bf16_t* baseB = GAB + (size_t)8192 * 2048 + colg;
            const f32x4 ba0 = *(const f32x4*)(gbias + colg), ba1 = *(const f32x4*)(gbias + colg + 4), bb0 = *(const f32x4*)(gbias + 2048 + colg), bb1 = *(const f32x4*)(gbias + 2048 + colg + 4);
#pragma unroll
            for (int ai = 0; ai < 2; ++ai)
#pragma unroll
                for (int m = 0; m < 4; ++m) { const int row = row0 + ai * HALF + m * 16;
                    const f32x4 a0 = sigm4(acc[ai][0][m][0] + ba0), a1 = sigm4(acc[ai][0][m][1] + ba1); f32x4 b0 = sigm4(acc[ai][1][m][0] + bb0), b1 = sigm4(acc[ai][1][m][1] + bb1), r0, r1;
#pragma unroll
                    for (int e = 0; e < 4; ++e) { b0[e] = fmaxf(b0[e], 1e-20f); b1[e] = fmaxf(b1[e], 1e-20f); r0[e] = a0[e] * __builtin_amdgcn_rcpf(b0[e]); r1[e] = a1[e] * __builtin_amdgcn_rcpf(b1[e]); }
                    *(u32x4*)(baseR + (size_t)row * 2048) = pack8(r0, r1); *(u32x4*)(baseB + (size_t)row * 2048) = pack8(b0, b1); }
        }
    }
};
struct EpiMerge2 {
    static constexpr bool PERM = true, AFTER_DRAIN = false, KEEP_SEG0 = true;
    const bf16_t* R; const bf16_t* GB; bf16_t* O;
    __device__ __forceinline__ void operator()(f32x4 (&acc)[2][2][4][2], const Unit& u, int wr, int wc, int fr, int fq) const {
        const int row0 = u.pm * BM + wr * 64 + fr, col0 = u.pn * BM + wc * 32 + 8 * fq;
        const bf16_t* G = u.seg == 0 ? R : GB;
#pragma unroll
        for (int ai = 0; ai < 2; ++ai)
#pragma unroll
            for (int m = 0; m < 4; ++m) { const size_t off = (size_t)(row0 + ai * HALF + m * 16) * 2048 + col0;
#pragma unroll
                for (int bj = 0; bj < 2; ++bj) { const u32x4 g = *(const u32x4*)(G + off + bj * HALF);
                    acc[ai][bj][m][0] = acc[ai][bj][m][0] * bf4lo(g.x, g.y); acc[ai][bj][m][1] = acc[ai][bj][m][1] * bf4lo(g.z, g.w);
                    if (u.seg != 0) *(u32x4*)(O + off + bj * HALF) = pack8(acc[ai][bj][m][0], acc[ai][bj][m][1]); } }
    }
};
struct EpiX1 {
    static constexpr bool PERM = true, AFTER_DRAIN = false, KEEP_SEG0 = false;
    const bf16_t* XH; const float* RMS; bf16_t* X1B; unsigned long long* SS;
    __device__ __forceinline__ void operator()(const f32x4 (&acc)[2][2][4][2], const Unit& u, int wr, int wc, int fr, int fq) const {
        const int row0 = u.pm * BM + wr * 64 + fr, col0 = u.pn * BM + wc * 32 + 8 * fq;
#pragma unroll
        for (int ai = 0; ai < 2; ++ai)
#pragma unroll
            for (int m = 0; m < 4; ++m) { const int row = row0 + ai * HALF + m * 16; const size_t off = (size_t)row * 2048 + col0; float sq = 0.f; const float rm = RMS[row];
#pragma unroll
                for (int bj = 0; bj < 2; ++bj) { const u32x4 hx = *(const u32x4*)(XH + off + bj * HALF); const f32x4 v0 = acc[ai][bj][m][0] + bf4lo(hx.x, hx.y) * rm, v1 = acc[ai][bj][m][1] + bf4lo(hx.z, hx.w) * rm;
                    *(u32x4*)(X1B + off + bj * HALF) = pack8(v0, v1);
                    sq += (v0[0] * v0[0] + v0[1] * v0[1]) + (v0[2] * v0[2] + v0[3] * v0[3]) + (v1[0] * v1[0] + v1[1] * v1[1]) + (v1[2] * v1[2] + v1[3] * v1[3]); }
                sq += __shfl_xor(sq, 16); sq += __shfl_xor(sq, 32);
                if (fq == 0) atomicAdd(SS + row, (unsigned long long)(sq * 4294967296.0f)); }
    }
};
__device__ __forceinline__ float rinv_from_ss(unsigned long long s) { return 1.0f / sqrtf((float)((double)s * (1.0 / 4294967296.0) * (1.0 / 2048.0)) + 1e-6f); }
struct EpiQP {
    static constexpr bool PERM = true, AFTER_DRAIN = false, KEEP_SEG0 = false;
    const unsigned long long* SS; bf16_t* O;
    __device__ __forceinline__ void operator()(const f32x4 (&acc)[2][2][4][2], const Unit& u, int wr, int wc, int fr, int fq) const {
        const int row0 = u.pm * BM + wr * 64 + fr, col0 = u.pn * BM + wc * 32 + 8 * fq;
#pragma unroll
        for (int ai = 0; ai < 2; ++ai)
#pragma unroll
            for (int m = 0; m < 4; ++m) { const int row = row0 + ai * HALF + m * 16; const size_t off = (size_t)row * 2048 + col0; const float rv = rinv_from_ss(SS[row]);
#pragma unroll
                for (int bj = 0; bj < 2; ++bj) *(u32x4*)(O + off + bj * HALF) = pack8(acc[ai][bj][m][0] * rv, acc[ai][bj][m][1] * rv); }
    }
};

template <class Epi, class Sched, bool ALIGN_EPI = false, bool SP2 = false>
__device__ __forceinline__ void gemm_phase(PG8_LAS unsigned char* lds, const Gemm g, const Sched& S, const Epi& E) {
    const int tid = threadIdx.x, wid = __builtin_amdgcn_readfirstlane(tid >> 6), lane = tid & 63, wr = wid >> 2, wc = wid & 3, fr = lane & 15, fq = lane >> 4;
    const int K = g.K, nt = K / BK;
    unsigned voffA[2], voffB[2];
#pragma unroll
    for (int i = 0; i < 2; ++i) { int R, C; stage_rc(tid * 16 + i * 8192, R, C); const int Rb = Epi::PERM ? ((R & ~31) + perm32(R & 31)) : R;
        voffA[i] = (unsigned)(R * K + C) * 2u; voffB[i] = (unsigned)(Rb * K + C) * 2u; }
    const size_t kstep = (size_t)(BK * 2);
    const size_t hstep = (size_t)HALF * K * 2;
    const size_t tstep = 2 * hstep;
    const unsigned ldsw = (unsigned)wid * 1024u;
    const int aoff = lds_byte(wr * 64 + fr, fq * 8), boff = lds_byte(wc * 32 + fr, fq * 8);
#define PG8_SA(b, h) (((b) * 2 + (h)) * HTB)
#define PG8_SB(b, h) ((4 + (b) * 2 + (h)) * HTB)
#define PG8_STAGE(bufoff, gbase, voff) do { _Pragma("unroll") for (int _i = 0; _i < 2; ++_i) \
        __builtin_amdgcn_global_load_lds((const unsigned*)((const char*)(gbase) + (voff)[_i]), (PG8_LAS unsigned*)(lds + (bufoff) + ldsw + _i * 8192), 16, 0, 0); } while (0)
#define PG8_LDA(dst, b, h) do { _Pragma("unroll") for (int m = 0; m < 4; ++m) _Pragma("unroll") for (int k = 0; k < 2; ++k) dst[m][k] = *(const PG8_LAS bf16x8*)(lds + PG8_SA(b, h) + aoff + m * 2048 + k * 1024); } while (0)
#define PG8_LDB(dst, b, h) do { _Pragma("unroll") for (int n = 0; n < 2; ++n) _Pragma("unroll") for (int k = 0; k < 2; ++k) dst[n][k] = *(const PG8_LAS bf16x8*)(lds + PG8_SB(b, h) + boff + n * 2048 + k * 1024); } while (0)
#define PG8_MMA(ai, bj, At, Bt) do { __builtin_amdgcn_s_setprio(1); _Pragma("unroll") for (int m = 0; m < 4; ++m) _Pragma("unroll") for (int n = 0; n < 2; ++n) _Pragma("unroll") for (int k = 0; k < 2; ++k) \
        acc[ai][bj][m][n] = __builtin_amdgcn_mfma_f32_16x16x32_bf16(Bt[n][k], At[m][k], acc[ai][bj][m][n], 0, 0, 0); __builtin_amdgcn_s_setprio(0); } while (0)
#define PG8_WAIT_V(n) asm volatile("s_waitcnt vmcnt(" #n ")" ::: "memory")
#define PG8_WAIT_L(n) asm volatile("s_waitcnt lgkmcnt(" #n ")" ::: "memory")
#define PG8_BAR __builtin_amdgcn_s_barrier()
#define PG8_SCHED __builtin_amdgcn_sched_barrier(0)
    Unit cur, nxt; int ui = 0;
    if (!S.next(0, cur)) return;
    f32x4 acc[2][2][4][2];
#pragma unroll
    for (int a = 0; a < 2; ++a)
#pragma unroll
        for (int b = 0; b < 2; ++b)
#pragma unroll
            for (int m = 0; m < 4; ++m)
#pragma unroll
                for (int n = 0; n < 2; ++n) acc[a][b][m][n] = (f32x4){0.f, 0.f, 0.f, 0.f};
    bf16x8 At[4][2], B0[2][2], B1[2][2];
    const char* cA = (const char*)(cur.seg ? g.A2 : g.A) + (size_t)cur.pm * tstep; const char* cB = (const char*)(cur.seg ? g.Bt2 : g.Bt) + (size_t)cur.pn * tstep;
    S.a_ready(cur);
    if constexpr (SP2) {
        PG8_STAGE(PG8_SB(0, 0), cB, voffB); PG8_STAGE(PG8_SB(0, 1), cB + hstep, voffB); PG8_STAGE(PG8_SA(0, 0), cA, voffA); PG8_STAGE(PG8_SA(0, 1), cA + hstep, voffA);
        if (wr == 1) PG8_BAR;
        PG8_WAIT_V(2); PG8_BAR;
        PG8_STAGE(PG8_SB(1, 0), cB + kstep, voffB); PG8_STAGE(PG8_SA(1, 0), cA + kstep, voffA); PG8_STAGE(PG8_SB(1, 1), cB + hstep + kstep, voffB);
        PG8_WAIT_V(6); PG8_BAR;
    } else {
        PG8_STAGE(PG8_SB(0, 0), cB, voffB); PG8_STAGE(PG8_SA(0, 0), cA, voffA); PG8_STAGE(PG8_SB(0, 1), cB + hstep, voffB); PG8_STAGE(PG8_SA(0, 1), cA + hstep, voffA);
        if (wr == 1) PG8_BAR;
        PG8_WAIT_V(4); PG8_BAR;
        PG8_STAGE(PG8_SB(1, 0), cB + kstep, voffB); PG8_STAGE(PG8_SA(1, 0), cA + kstep, voffA); PG8_STAGE(PG8_SB(1, 1), cB + hstep + kstep, voffB);
        PG8_WAIT_V(6); PG8_BAR;
    }
    for (;;) {
        const bool has_next = S.next(ui + 1, nxt);
        const char* nA = has_next ? (const char*)(nxt.seg ? g.A2 : g.A) + (size_t)nxt.pm * tstep : cA; const char* nB = has_next ? (const char*)(nxt.seg ? g.Bt2 : g.Bt) + (size_t)nxt.pn * tstep : cB;
        for (int t = 0; t < nt; t += 2) {
            const bool last = (t == nt - 2);
            const char* a1 = cA + (size_t)(t + 1) * kstep;
            const char* a2 = last ? nA : cA + (size_t)(t + 2) * kstep; const char* b2 = last ? nB : cB + (size_t)(t + 2) * kstep;
            const char* a3 = a2 + kstep; const char* b3 = b2 + kstep;
            if (last && has_next) S.a_ready(nxt);
            if constexpr (SP2) {
            PG8_LDB(B0, 0, 0); PG8_LDB(B1, 0, 1); PG8_SCHED; PG8_LDA(At, 0, 0); PG8_STAGE(PG8_SA(1, 1), a1 + hstep, voffA);
            PG8_WAIT_V(8); PG8_WAIT_L(0); PG8_BAR; PG8_MMA(0, 0, At, B0); PG8_MMA(0, 1, At, B1); PG8_BAR; PG8_SCHED;
            PG8_LDA(At, 0, 1); PG8_STAGE(PG8_SB(0, 0), b2, voffB); PG8_STAGE(PG8_SB(0, 1), b2 + hstep, voffB); PG8_STAGE(PG8_SA(0, 0), a2, voffA);
            PG8_WAIT_V(8); PG8_WAIT_L(0); PG8_BAR; PG8_MMA(1, 0, At, B0); PG8_MMA(1, 1, At, B1); PG8_BAR; PG8_SCHED;
            PG8_LDB(B0, 1, 0); PG8_LDB(B1, 1, 1); PG8_SCHED; PG8_LDA(At, 1, 0); PG8_STAGE(PG8_SA(0, 1), a2 + hstep, voffA);
            PG8_WAIT_V(8); PG8_WAIT_L(0); PG8_BAR; PG8_MMA(0, 0, At, B0); PG8_MMA(0, 1, At, B1); PG8_BAR; PG8_SCHED;
            PG8_LDA(At, 1, 1); PG8_STAGE(PG8_SB(1, 0), b3, voffB); PG8_STAGE(PG8_SB(1, 1), b3 + hstep, voffB); PG8_STAGE(PG8_SA(1, 0), a3, voffA);
            PG8_WAIT_V(8); PG8_WAIT_L(0); PG8_BAR; PG8_MMA(1, 0, At, B0); PG8_MMA(1, 1, At, B1); PG8_BAR; PG8_SCHED;
            } else {
            PG8_LDB(B0, 0, 0); PG8_SCHED; PG8_LDA(At, 0, 0); PG8_STAGE(PG8_SA(1, 1), a1 + hstep, voffA);
            PG8_WAIT_L(8); PG8_BAR; PG8_WAIT_L(0); PG8_MMA(0, 0, At, B0); PG8_BAR; PG8_SCHED;
            PG8_LDB(B1, 0, 1); PG8_STAGE(PG8_SB(0, 0), b2, voffB);
            PG8_BAR; PG8_WAIT_L(0); PG8_MMA(0, 1, At, B1); PG8_BAR;
            PG8_LDA(At, 0, 1); PG8_STAGE(PG8_SA(0, 0), a2, voffA);
            PG8_BAR; PG8_WAIT_L(0); PG8_MMA(1, 0, At, B0); PG8_BAR; PG8_SCHED;
            PG8_STAGE(PG8_SB(0, 1), b2 + hstep, voffB);
            PG8_WAIT_V(6); PG8_BAR; PG8_MMA(1, 1, At, B1); PG8_BAR;
            PG8_LDB(B0, 1, 0); PG8_SCHED; PG8_LDA(At, 1, 0); PG8_STAGE(PG8_SA(0, 1), a2 + hstep, voffA);
            PG8_WAIT_L(8); PG8_BAR; PG8_WAIT_L(0); PG8_MMA(0, 0, At, B0); PG8_BAR; PG8_SCHED;
            PG8_LDB(B1, 1, 1); PG8_STAGE(PG8_SB(1, 0), b3, voffB);
            PG8_BAR; PG8_WAIT_L(0); PG8_MMA(0, 1, At, B1); PG8_BAR;
            PG8_LDA(At, 1, 1); PG8_STAGE(PG8_SA(1, 0), a3, voffA);
            PG8_BAR; PG8_WAIT_L(0); PG8_MMA(1, 0, At, B0); PG8_BAR; PG8_SCHED;
            PG8_STAGE(PG8_SB(1, 1), b3 + hstep, voffB);
            PG8_WAIT_V(6); PG8_BAR; PG8_MMA(1, 1, At, B1); PG8_BAR;
            }
        }
        if constexpr (ALIGN_EPI) { if (wr == 0) PG8_BAR; }
        if constexpr (!Epi::AFTER_DRAIN) { E(acc, cur, wr, wc, fr, fq); S.done(cur); }
        if (!has_next) break;
        if (!(Epi::KEEP_SEG0 && cur.seg == 0)) {
#pragma unroll
        for (int a = 0; a < 2; ++a)
#pragma unroll
            for (int b = 0; b < 2; ++b)
#pragma unroll
                for (int m = 0; m < 4; ++m)
#pragma unroll
                    for (int n = 0; n < 2; ++n) acc[a][b][m][n] = (f32x4){0.f, 0.f, 0.f, 0.f};
        }
        cur = nxt; cA = nA; cB = nB; ++ui;
        if constexpr (ALIGN_EPI) { if (wr == 1) PG8_BAR; }
    }
    PG8_WAIT_V(0);
    if constexpr (!ALIGN_EPI) { if (wr == 0) PG8_BAR; }
    PG8_BAR;
    if constexpr (Epi::AFTER_DRAIN) { E.fused(acc, cur, wr, wc, fr, fq, lds, wid, lane); S.done(cur); }
#undef PG8_SA
#undef PG8_SB
#undef PG8_STAGE
#undef PG8_LDA
#undef PG8_LDB
#undef PG8_MMA
#undef PG8_WAIT_V
#undef PG8_WAIT_L
#undef PG8_BAR
#undef PG8_SCHED
}
}

constexpr int NWAVES = 8;
#ifndef MK_N_LAUNCHES
#define MK_N_LAUNCHES 1
#endif
constexpr int PER_PHASE = 9;
#ifndef MK_REP_PHASE
#define MK_REP_PHASE -1
#endif
#define NREP(k) (((k) == MK_REP_PHASE) ? 2 : 1)
constexpr int N_LAUNCHES = MK_N_LAUNCHES;
constexpr int M = 8192, SEQ = 4096, DM = 2048, INW = 10240, NEXP = 16384;
constexpr float RMS_EPS = 1e-6f;
constexpr size_t MiB = 1u << 20;
constexpr size_t WS_CTL = 0, CTL_ZERO_BYTES = 64 * 1024;
constexpr size_t WS_SS = 256 * 1024, WS_KSUM = 512 * 1024;
constexpr size_t WS_WIN = 2 * MiB, WS_WBC = 42 * MiB, WS_WBA = 46 * MiB, WS_WOUT = 50 * MiB, WS_WPQ = 58 * MiB, WS_KEYS = 66 * MiB, WS_CS = 67 * MiB;
constexpr size_t WS_RMS = 68 * MiB;
constexpr size_t WS_UB = 70 * MiB, WS_VB = 102 * MiB;
constexpr size_t WS_XB = 198 * MiB;
constexpr size_t WS_T6 = 230 * MiB;
constexpr size_t WS_GAB = 326 * MiB;
constexpr size_t WS_UC = 390 * MiB, WS_AO = 406 * MiB;
constexpr size_t WS_EXP = 422 * MiB, WS_GATE = 426 * MiB;
constexpr size_t WS_END = 430 * MiB;
constexpr size_t WS_TMP = WS_XB, WS_MB = WS_T6, WS_X1B = WS_T6 + 48 * MiB, WS_QP = WS_GAB;
constexpr int CW_BAR = 4096;
constexpr int RING_OFF = 0, RING_BYTES = 131072;
constexpr int LDSCTL_OFF = RING_BYTES, MISC_OFF = LDSCTL_OFF + 320;
constexpr int LDS_BYTES = 147456;

#define GAS __attribute__((address_space(1)))
#define LAS __attribute__((address_space(3)))
typedef unsigned short bf16;
typedef unsigned v4u __attribute__((ext_vector_type(4)));
typedef float f32x4 __attribute__((ext_vector_type(4)));
typedef short bf16x8 __attribute__((ext_vector_type(8)));
typedef GAS unsigned gu32;
typedef GAS unsigned long long gu64;
#define RLX_AGENT __ATOMIC_RELAXED, __HIP_MEMORY_SCOPE_AGENT
#define LDS_WAIT() asm volatile("s_waitcnt lgkmcnt(0)" ::: "memory")
#define VM_WAIT() asm volatile("s_waitcnt vmcnt(0)" ::: "memory")
__device__ __forceinline__ unsigned long long rt() { return __builtin_amdgcn_s_memrealtime(); }
__device__ __forceinline__ unsigned f2bf(float f) { unsigned u = __builtin_bit_cast(unsigned, f); return (u + 0x7fffu + ((u >> 16) & 1u)) >> 16; }
__device__ __forceinline__ unsigned pk2(float lo, float hi) { return f2bf(lo) | (f2bf(hi) << 16); }

#define XB_TMO      128
#define XB_XCNT(j)  (256  + 64 * (j))
#define XB_XSUB(j)  (1280 + 64 * (j))
#define XB_XGEN(j)  (2304 + 64 * (j))
#define XB_TOP      3328
#define XB_TOPGEN   3392
#define XCD_BAR_WORDS 3456
#define XB_SPIN_CAP (1u << 18)

__device__ __forceinline__ unsigned xb_ld(unsigned* p)              { return __hip_atomic_load(p, __ATOMIC_RELAXED, __HIP_MEMORY_SCOPE_AGENT); }
__device__ __forceinline__ unsigned xb_add(unsigned* p, unsigned v) { return __hip_atomic_fetch_add(p, v, __ATOMIC_RELAXED, __HIP_MEMORY_SCOPE_AGENT); }
__device__ __forceinline__ unsigned xb_xcc_id() { return (unsigned)__builtin_amdgcn_s_getreg((3 << 11) | 20) & 0xFu; }
#define XB_SPIN(cond, bar) do { unsigned _sp = 0; while (cond) { __builtin_amdgcn_s_sleep(1); \
    if ((++_sp & 255u) == 0u) { if (xb_ld(&(bar)[XB_TMO])) break; if (_sp > XB_SPIN_CAP) { atomicAdd(&(bar)[XB_TMO], 1u); break; } } } } while (0)

struct XcdBarrier {
    unsigned* bar; unsigned x;
    volatile LAS unsigned* st;
};

__device__ __forceinline__ XcdBarrier xcd_barrier_post(unsigned* bar, volatile LAS unsigned* st) {
    XcdBarrier b; b.bar = bar; b.x = xb_xcc_id(); b.st = st;
    if (threadIdx.x == 0) (void)xb_add(&bar[XB_XCNT(b.x)], 1u);
    return b;
}
__device__ __forceinline__ void xcd_barrier_complete(unsigned* bar, unsigned x, unsigned& nloc, unsigned& nx) {
    const unsigned G = gridDim.x * gridDim.y * gridDim.z;
    unsigned sum, cnt, mine, sp = 0u;
    for (;;) {
        sum = 0u; cnt = 0u; mine = 0u;
#pragma unroll
        for (unsigned j = 0; j < 16; ++j) { const unsigned c = xb_ld(&bar[XB_XCNT(j)]); sum += c; cnt += (c > 0u) ? 1u : 0u; mine = (j == x) ? c : mine; }
        if (sum == G) break;
        __builtin_amdgcn_s_sleep(1);
        if ((++sp & 255u) == 0u) { if (xb_ld(&bar[XB_TMO])) break; if (sp > XB_SPIN_CAP) { atomicAdd(&bar[XB_TMO], 1u); break; } }
    }
    nloc = mine > 0u ? mine : 1u; nx = cnt > 0u ? cnt : 1u;
}

struct Ctx { LAS unsigned char* lds; int tid, lane, wave, vcu, G; };
struct BarWork { const float* pu; const float* pv; const float* g2; unsigned char* ws; int part, nparts; };
__device__ __forceinline__ void convert_tables(const Ctx& F, const float* pu, const float* pv, const float* g2, unsigned char* ws, int part, int nparts, int w0);
__device__ __forceinline__ void xcd_barrier(const XcdBarrier& b, const Ctx* F = nullptr, const BarWork* wk = nullptr) {
    asm volatile("s_waitcnt vmcnt(0)" ::: "memory");
    __syncthreads();
    if (wk && wk->part >= 0) convert_tables(*F, wk->pu, wk->pv, wk->g2, wk->ws, wk->part, wk->nparts, 1);
    if (threadIdx.x == 0) {
        unsigned* bar = b.bar;
        __builtin_amdgcn_s_waitcnt(0);
        unsigned nloc = b.st[0], nx = b.st[1];
        if (nloc == 0u) { xcd_barrier_complete(bar, b.x, nloc, nx); b.st[0] = nloc; b.st[1] = nx; }
        const unsigned old = xb_add(&bar[XB_XSUB(b.x)], 1u);
        const unsigned gen = old / nloc;
        if (old + 1u == (gen + 1u) * nloc) {
            __builtin_amdgcn_fence(__ATOMIC_RELEASE, "agent");
            asm volatile("s_waitcnt vmcnt(0)" ::: "memory");
            const unsigned og = xb_add(&bar[XB_TOP], 1u);
            const unsigned tg = og / nx;
            if (og + 1u == (tg + 1u) * nx) xb_add(&bar[XB_TOPGEN], 1u);
            else XB_SPIN(xb_ld(&bar[XB_TOPGEN]) == tg, bar);
            __builtin_amdgcn_fence(__ATOMIC_ACQUIRE, "agent");
            xb_add(&bar[XB_XGEN(b.x)], 1u);
            asm volatile("s_waitcnt vmcnt(0)" ::: "memory");
        } else {
            XB_SPIN(xb_ld(&bar[XB_XGEN(b.x)]) == gen, bar);
            __builtin_amdgcn_fence(__ATOMIC_ACQUIRE, "agent");
            asm volatile("s_waitcnt vmcnt(0)" ::: "memory");
        }
    }
    __syncthreads();
}

typedef __bf16 bf16x2v __attribute__((ext_vector_type(2)));
typedef float f32x16 __attribute__((ext_vector_type(16)));
__device__ __forceinline__ float bflo(unsigned w) { return __uint_as_float(w << 16); }
__device__ __forceinline__ float bfhi(unsigned w) { return __uint_as_float(w & 0xffff0000u); }
__device__ __forceinline__ float dot2bf(unsigned a, unsigned b, float c) { return __builtin_amdgcn_fdot2_f32_bf16(__builtin_bit_cast(bf16x2v, a), __builtin_bit_cast(bf16x2v, b), c, false); }
__device__ __forceinline__ float wave_sum(float v) {
#pragma unroll
    for (int o = 1; o < 64; o <<= 1) v += __shfl_xor(v, o);
    return v; }
__device__ __forceinline__ float wave_max(float v) {
#pragma unroll
    for (int o = 1; o < 64; o <<= 1) v = fmaxf(v, __shfl_xor(v, o));
    return v; }
__device__ __forceinline__ float rdlane(float v, int l) { return __int_as_float(__builtin_amdgcn_readlane(__float_as_int(v), l)); }
__device__ __forceinline__ float gelu_tanh(float x) { const float z = 0.7978845608028654f * (x + 0.044715f * x * x * x); const float e = __expf(2.0f * z); const float th = 1.0f - 2.0f * __builtin_amdgcn_rcpf(1.0f + e); return 0.5f * x * (1.0f + th); }


__device__ __forceinline__ void p0_transpose_item(const float* W, int K, int N, bf16* WT, const float* gk, LAS float* scr, int item, int lane, bool remap = false) {
    const int nblk = N / 32, kb = item / nblk, nb = item % nblk, k0 = 64 * kb, n0 = 32 * nb;
    int dn0 = n0; if (remap && n0 >= 1024 && n0 < 3072) { const int c = (n0 - 1024) & 1023, isx = (n0 >= 2048); dn0 = 1024 + (c >> 7) * 256 + isx * 128 + (c & 127); }
    if (remap && n0 >= 6144) { const int c = (n0 - 6144) & 2047, isb = (n0 >= 8192); dn0 = 6144 + (c >> 7) * 256 + isb * 128 + (c & 127); }
#pragma unroll
    for (int i = 0; i < 8; ++i) { const int kk = 8 * i + (lane >> 3), nn = 4 * (lane & 7); f32x4 v = *(const GAS f32x4*)(W + (size_t)(k0 + kk) * N + n0 + nn); if (gk) v = v * gk[k0 + kk];
        scr[kk * 33 + nn] = v[0]; scr[kk * 33 + nn + 1] = v[1]; scr[kk * 33 + nn + 2] = v[2]; scr[kk * 33 + nn + 3] = v[3]; }
    LDS_WAIT(); asm volatile("" ::: "memory");
    const int c = lane & 7;
#pragma unroll
    for (int j = 0; j < 4; ++j) { const int n = (lane >> 3) + 8 * j; const LAS float* s = scr + (8 * c) * 33 + n;
        v4u o; o.x = pk2(s[0 * 33], s[1 * 33]); o.y = pk2(s[2 * 33], s[3 * 33]); o.z = pk2(s[4 * 33], s[5 * 33]); o.w = pk2(s[6 * 33], s[7 * 33]);
        *(GAS v4u*)(WT + (size_t)(dn0 + n) * K + k0 + 8 * c) = o; }
    LDS_WAIT(); asm volatile("" ::: "memory");
}
__device__ __forceinline__ void convert_tables(const Ctx& F, const float* pu, const float* pv, const float* g2, unsigned char* ws, int part, int nparts, int w0) {
    if (F.wave < w0) return;
    const int nw = NWAVES - w0, gt = (F.vcu * nw + (F.wave - w0)) * 64 + F.lane, NT = F.G * nw * 64;
    const int per = (NEXP * 2048 / 16) / nparts, lo = part * per, hi = lo + per;
    for (int i = lo + gt; i < hi; i += NT) { const int c16 = (i & 127) * 16; v4u ou, ov;
#pragma unroll
        for (int q = 0; q < 4; ++q) { f32x4 a = ((const GAS f32x4*)pu)[4 * i + q]; a = a * *(const GAS f32x4*)(g2 + c16 + 4 * q) * 512.0f; const f32x4 b = ((const GAS f32x4*)pv)[4 * i + q] * 32.0f;
            int wu = 0, wv = 0; wu = __builtin_amdgcn_cvt_pk_fp8_f32(a[0], a[1], wu, false); wu = __builtin_amdgcn_cvt_pk_fp8_f32(a[2], a[3], wu, true);
            wv = __builtin_amdgcn_cvt_pk_fp8_f32(b[0], b[1], wv, false); wv = __builtin_amdgcn_cvt_pk_fp8_f32(b[2], b[3], wv, true); ou[q] = (unsigned)wu; ov[q] = (unsigned)wv; }
        ((GAS v4u*)(ws + WS_UB))[i] = ou; ((GAS v4u*)(ws + WS_VB))[i] = ov; }
}
__device__ __forceinline__ void p0_prologue(const Ctx& F, const float* const* in, unsigned char* ws, const double* invf) {
    const float* x = in[0]; const int* pos = (const int*)in[1]; const float* g1 = in[2]; const float* w_in = in[3];
    const float* w_bc = in[6]; const float* w_ba = in[7]; const float* w_out = in[8]; const float* g2 = in[9]; const float* w_pq = in[10];
    const float* keys = in[11]; const float* pu = in[12]; const float* pv = in[13];
    LAS float* scr = (LAS float*)(F.lds + RING_OFF + F.wave * 16384);
    const int gw = F.vcu * NWAVES + F.wave, NGW = F.G * NWAVES;
    const int gt = gw * 64 + F.lane, NT = NGW * 64;
    for (int i = gt; i < 8192; i += NT) ((GAS unsigned long long*)(ws + WS_SS))[i] = 0ull;
    for (int i = gt; i < 32 * 1024; i += NT) ((GAS float*)(ws + WS_KSUM))[i] = 0.f;
    constexpr int I_IN = 32 * 320, I_BC = 16 * 64, I_OUT = 32 * 64;
    constexpr int NITEMS = I_IN + 2 * I_BC + 2 * I_OUT;
    for (int it = gw; it < NITEMS; it += NGW) {
        int r = it;
        if (r < I_IN) { p0_transpose_item(w_in, 2048, INW, (bf16*)(ws + WS_WIN), g1, scr, r, F.lane, true); continue; } r -= I_IN;
        if (r < I_BC) { p0_transpose_item(w_bc, 1024, 2048, (bf16*)(ws + WS_WBC), nullptr, scr, r, F.lane); continue; } r -= I_BC;
        if (r < I_BC) { p0_transpose_item(w_ba, 1024, 2048, (bf16*)(ws + WS_WBA), nullptr, scr, r, F.lane); continue; } r -= I_BC;
        if (r < I_OUT) { p0_transpose_item(w_out, 2048, 2048, (bf16*)(ws + WS_WOUT), nullptr, scr, r, F.lane); continue; } r -= I_OUT;
        p0_transpose_item(w_pq, 2048, 2048, (bf16*)(ws + WS_WPQ), g2, scr, r, F.lane);
    }
    for (int i = gt; i < 16 * 128 * 128 / 8; i += NT) { const f32x4 a = ((const GAS f32x4*)keys)[2 * i], b = ((const GAS f32x4*)keys)[2 * i + 1];
        v4u o; o.x = pk2(a[0], a[1]); o.y = pk2(a[2], a[3]); o.z = pk2(b[0], b[1]); o.w = pk2(b[2], b[3]); ((GAS v4u*)(ws + WS_KEYS))[i] = o; }
    for (int m = gw; m < M; m += NGW) { const GAS f32x4* xr = (const GAS f32x4*)(x + (size_t)m * DM);
        f32x4 v[8]; float s = 0.f;
#pragma unroll
        for (int i = 0; i < 4; ++i) { v[2 * i] = xr[i * 128 + 2 * F.lane]; v[2 * i + 1] = xr[i * 128 + 2 * F.lane + 1]; }
#pragma unroll
        for (int i = 0; i < 8; ++i) s += (v[i][0] * v[i][0] + v[i][1] * v[i][1]) + (v[i][2] * v[i][2] + v[i][3] * v[i][3]);
        const float rms = sqrtf(wave_sum(s) * (1.0f / DM) + RMS_EPS), rinv = 1.0f / rms;
        if (F.lane == 0) ((GAS float*)(ws + WS_RMS))[m] = rms;
        GAS v4u* o = (GAS v4u*)(ws + WS_XB + (size_t)m * DM * 2);
#pragma unroll
        for (int i = 0; i < 4; ++i) { const f32x4 a = v[2 * i] * rinv, b = v[2 * i + 1] * rinv; v4u w; w.x = pk2(a[0], a[1]); w.y = pk2(a[2], a[3]); w.z = pk2(b[0], b[1]); w.w = pk2(b[2], b[3]); o[i * 64 + F.lane] = w; } }
    for (int i = gt; i < M * 16; i += NT) { const int row = i >> 4, f = i & 15; const double ang = (double)pos[row] * invf[f];
        const double k = __builtin_rint(ang * 0.15915494309189535); const float r = (float)(ang - k * 6.283185307179586);
        float* cs = (float*)(ws + WS_CS); cs[row * 32 + f] = __cosf(r); cs[row * 32 + 16 + f] = __sinf(r); }
}

__device__ __forceinline__ void attn_simple(const Ctx& F, const bf16* Q, const bf16* K, const bf16* V, const float* ksum, bf16* AO) {
    LAS float* qf = (LAS float*)(F.lds + RING_OFF + F.wave * 512);
    const int gw = F.vcu * NWAVES + F.wave, NGW = F.G * NWAVES, lane = F.lane;
    for (int item = gw; item < 16 * SEQ; item += NGW) {
        const int bh = item >> 12, t = item & 4095, b = bh >> 3, h = bh & 7, blk = t >> 8;
        const size_t row = (size_t)b * SEQ + t;
        { const unsigned qq = *(const GAS unsigned*)(Q + row * 1024 + h * 128 + 2 * lane); qf[2 * lane] = bflo(qq); qf[2 * lane + 1] = bfhi(qq); }
        LDS_WAIT(); asm volatile("" ::: "memory");
        float g = -INFINITY;
        if (lane < blk) { const GAS f32x4* km = (const GAS f32x4*)(ksum + (size_t)(b * 16 + lane) * 1024 + h * 128); float a = 0.f;
            for (int d = 0; d < 32; ++d) { const f32x4 kv = km[d]; const f32x4 qv = *(const LAS f32x4*)(qf + 4 * d); a += (kv[0] * qv[0] + kv[1] * qv[1]) + (kv[2] * qv[2] + kv[3] * qv[3]); }
            g = a; }
        int sel[3];
#pragma unroll
        for (int i = 0; i < 3; ++i) { const float mx = wave_max(g); const unsigned long long bal = __ballot(g == mx && lane < blk); const int idx = bal ? (__ffsll((long long)bal) - 1) : 0; sel[i] = idx; if (lane == idx) g = -INFINITY; }
        const int nsel = blk < 3 ? blk : 3;
        float sc[4][4]; float mx = -INFINITY;
#pragma unroll
        for (int slot = 0; slot < 4; ++slot) {
            const bool valid = (slot == 3) || (slot < nsel);
            const int kb = (slot == 3) ? blk : sel[slot < 3 ? slot : 0];
#pragma unroll
            for (int r = 0; r < 4; ++r) {
                float s = -INFINITY; const int key0 = kb * 256 + r * 64;
                if (valid && (slot < 3 || key0 <= t)) {
                    const int key = key0 + lane; const GAS v4u* kp = (const GAS v4u*)(K + ((size_t)b * SEQ + key) * 1024 + h * 128); float a = 0.f;
#pragma unroll 4
                    for (int d = 0; d < 16; ++d) { const v4u kk = kp[d]; const f32x4 q0 = *(const LAS f32x4*)(qf + 8 * d), q1 = *(const LAS f32x4*)(qf + 8 * d + 4);
                        a += (bflo(kk.x) * q0[0] + bfhi(kk.x) * q0[1]) + (bflo(kk.y) * q0[2] + bfhi(kk.y) * q0[3]) + (bflo(kk.z) * q1[0] + bfhi(kk.z) * q1[1]) + (bflo(kk.w) * q1[2] + bfhi(kk.w) * q1[3]); }
                    s = (slot < 3 || key <= t) ? a : -INFINITY; }
                sc[slot][r] = s; mx = fmaxf(mx, s); } }
        mx = wave_max(mx);
        float sum = 0.f;
#pragma unroll
        for (int slot = 0; slot < 4; ++slot)
#pragma unroll
            for (int r = 0; r < 4; ++r) { sc[slot][r] = exp2f(sc[slot][r] - mx); sum += sc[slot][r]; }
        sum = wave_sum(sum);
        float o0 = 0.f, o1 = 0.f;
#pragma unroll
        for (int slot = 0; slot < 4; ++slot) {
            const bool valid = (slot == 3) || (slot < nsel);
            const int kb = (slot == 3) ? blk : sel[slot < 3 ? slot : 0];
#pragma unroll
            for (int r = 0; r < 4; ++r) { const int key0 = kb * 256 + r * 64;
                if (valid && (slot < 3 || key0 <= t)) { const float pr = sc[slot][r]; const GAS unsigned* vp = (const GAS unsigned*)(V + ((size_t)b * SEQ + key0) * 1024 + h * 128) + lane;
                    for (int kk = 0; kk < 64; ++kk) { const float pk = rdlane(pr, kk); const unsigned vv = vp[(size_t)kk * 512]; o0 += pk * bflo(vv); o1 += pk * bfhi(vv); } } } }
        const float ri = 1.0f / sum;
        *(GAS unsigned*)(AO + row * 1024 + h * 128 + 2 * lane) = pk2(o0 * ri, o1 * ri);
    }
}
typedef short v4i16_t __attribute__((ext_vector_type(4))); typedef unsigned u32x2v __attribute__((ext_vector_type(2)));
__device__ __forceinline__ v4i16_t vtr16(unsigned addr) { return __builtin_amdgcn_ds_read_tr16_b64_v4i16((LAS v4i16_t*)(uintptr_t)addr); }
__device__ __forceinline__ int crow16(int r, int hh) { return (r & 3) + 8 * (r >> 2) + 4 * hh; }
__device__ __forceinline__ void attn_dma_step(const bf16* K, const bf16* V, LAS unsigned char* lds, int b, int h, int qb, int n_own, int st, int buf, int wave, int lane) {
#pragma unroll
    for (int img = 0; img < 4; ++img) {
        const int T = 2 * st + (img >> 1); const bool isV = img & 1;
        const int blk = (T < n_own) ? qb : ((T - n_own) >> 2), kt = (T < n_own) ? T : ((T - n_own) & 3);
        const bf16* base = (isV ? V : K) + ((size_t)b * SEQ + 256 * blk + 64 * kt) * 1024 + h * 128;
#pragma unroll
        for (int i = 0; i < 2; ++i) { const int pc = wave + 8 * i, row = 4 * pc + (lane >> 4), cp = lane & 15;
            const int c = isV ? ((((cp >> 2) ^ (row & 3)) << 2) | (cp & 3)) : (cp ^ (row & 15));
            __builtin_amdgcn_global_load_lds((const unsigned*)(base + (size_t)row * 1024 + 8 * c), (LAS unsigned*)(lds + buf * 65536 + img * 16384 + pc * 1024), 16, 0, 0); }
    }
}
__device__ __forceinline__ void attn_mfma(const Ctx& F, const bf16* Q, const bf16* K, const bf16* V, const float* ksum, bf16* AO) {
    const int lane = F.lane, wave = F.wave, q31 = lane & 31, hh = lane >> 5, wq = wave & 3, kvh = wave >> 2, l16 = lane & 15, G4 = lane >> 4;
    LAS unsigned char* lds = F.lds + RING_OFF;
    const unsigned lds0 = (unsigned)(uintptr_t)lds;
    for (int pr = F.vcu; pr < 256; pr += F.G)
#pragma unroll 1
    for (int pi = 0; pi < 2; ++pi) {
        const int bh = pr >> 4, s_ = pr & 15, u128 = pi ? 31 - s_ : s_, b = bh >> 3, h = bh & 7, qb = u128 >> 1, half = u128 & 1;
        const int n_own = half ? 4 : 2, nstep = (n_own + 4 * qb) >> 1;
        const size_t rowq = (size_t)b * SEQ + 256 * qb + 128 * half + 32 * wq + q31;
        asm volatile("s_waitcnt vmcnt(0) lgkmcnt(0)" ::: "memory"); __builtin_amdgcn_s_barrier(); asm volatile("" ::: "memory");
        attn_dma_step(K, V, lds, b, h, qb, n_own, 0, 0, wave, lane);
        bf16x8 qf[8];
#pragma unroll
        for (int s = 0; s < 8; ++s) qf[s] = *(const GAS bf16x8*)(Q + rowq * 1024 + h * 128 + 16 * s + 8 * hh);
        unsigned selmask;
        {
            f32x16 gt;
#pragma unroll
            for (int r = 0; r < 16; ++r) gt[r] = 0.f;
            const int jr = lane & 31; const bool jv = jr < qb;
            const GAS f32x4* kp = (const GAS f32x4*)(ksum + (size_t)(b * 16 + (jv ? jr : 0)) * 1024 + h * 128 + 8 * hh);
            f32x4 kf[16];
#pragma unroll
            for (int s = 0; s < 8; ++s) { kf[2 * s] = kp[4 * s]; kf[2 * s + 1] = kp[4 * s + 1]; }
#pragma unroll
            for (int s = 0; s < 8; ++s) { v4u w = pg8::pack8(kf[2 * s], kf[2 * s + 1]); if (!jv) { w.x = 0u; w.y = 0u; w.z = 0u; w.w = 0u; }
                gt = __builtin_amdgcn_mfma_f32_32x32x16_bf16(__builtin_bit_cast(bf16x8, w), qf[s], gt, 0, 0, 0); }
            float g16[16];
#pragma unroll
            for (int r = 0; r < 8; ++r) { const auto rr = __builtin_amdgcn_permlane32_swap(__float_as_uint(gt[r]), __float_as_uint(gt[r]), false, false);
                g16[(r & 3) + 8 * (r >> 2)] = __uint_as_float(rr[0]); g16[(r & 3) + 8 * (r >> 2) + 4] = __uint_as_float(rr[1]); }
            float v0 = -INFINITY, v1 = -INFINITY, v2 = -INFINITY; int i0 = 0, i1 = 0, i2 = 0;
#pragma unroll
            for (int j = 0; j < 16; ++j) { const float a = (j < qb) ? g16[j] : -INFINITY;
                if (a > v0) { v2 = v1; i2 = i1; v1 = v0; i1 = i0; v0 = a; i0 = j; } else if (a > v1) { v2 = v1; i2 = i1; v1 = a; i1 = j; } else if (a > v2) { v2 = a; i2 = j; } }
            selmask = (qb <= 3) ? ((1u << qb) - 1u) : ((1u << i0) | (1u << i1) | (1u << i2));
        }
        float m_run = -1e30f, l_run = 0.f; f32x16 o[4];
#pragma unroll
        for (int db = 0; db < 4; ++db)
#pragma unroll
            for (int r = 0; r < 16; ++r) o[db][r] = 0.f;
        const int qin = 128 * half + 32 * wq + q31;
#pragma unroll 1
        for (int st2 = 0; st2 < nstep; st2 += 2)
#pragma unroll
        for (int par = 0; par < 2; ++par) { const int st = st2 + par; if (st < nstep) {
            asm volatile("s_waitcnt vmcnt(0)" ::: "memory"); __builtin_amdgcn_s_barrier(); asm volatile("" ::: "memory");
            if (st + 1 < nstep) attn_dma_step(K, V, lds, b, h, qb, n_own, st + 1, par ^ 1, wave, lane);
            const int T = 2 * st + kvh; const bool own = T < n_own;
            const int blk = own ? qb : ((T - n_own) >> 2), kt = own ? T : ((T - n_own) & 3);
            const bool sel = own ? true : ((selmask >> blk) & 1u);
            const bool skip = own ? (64 * kt > 128 * half + 32 * wq + 31) : (__ballot(sel) == 0ull);
            if (!skip) {
                const unsigned kimg = lds0 + par * 65536 + kvh * 32768, vimg = kimg + 16384;
                f32x16 p[2];
#pragma unroll
                for (int kh = 0; kh < 2; ++kh) {
#pragma unroll
                    for (int r = 0; r < 16; ++r) p[kh][r] = 0.f;
                    const int row = 32 * kh + q31;
#pragma unroll
                    for (int s = 0; s < 8; ++s) { const bf16x8 a = *(const LAS bf16x8*)(uintptr_t)(kimg + row * 256 + (((2 * s + hh) ^ (row & 15)) << 4));
                        p[kh] = __builtin_amdgcn_mfma_f32_32x32x16_bf16(a, qf[s], p[kh], 0, 0, 0); }
                }
                if (own) { const int kbase = 64 * kt;
                    if (kbase + 63 > 128 * half + 32 * wq) {
#pragma unroll
                        for (int kh = 0; kh < 2; ++kh)
#pragma unroll
                            for (int r = 0; r < 16; ++r) if (kbase + 32 * kh + crow16(r, hh) > qin) p[kh][r] = -INFINITY; }
                }
                float mx = p[0][0];
#pragma unroll
                for (int r = 1; r < 16; ++r) mx = fmaxf(mx, p[0][r]);
#pragma unroll
                for (int r = 0; r < 16; ++r) mx = fmaxf(mx, p[1][r]);
                { const auto rr = __builtin_amdgcn_permlane32_swap(__float_as_uint(mx), __float_as_uint(mx), false, false); mx = fmaxf(__uint_as_float(rr[0]), __uint_as_float(rr[1])); }
                if (!sel) mx = -INFINITY;
                const float m_new = fmaxf(m_run, mx), scl = __builtin_amdgcn_exp2f(m_run - m_new); m_run = m_new;
                float rs = 0.f;
#pragma unroll
                for (int kh = 0; kh < 2; ++kh)
#pragma unroll
                    for (int r = 0; r < 16; ++r) { p[kh][r] = __builtin_amdgcn_exp2f(p[kh][r] - m_new); rs += p[kh][r]; }
                l_run = l_run * scl + (sel ? rs : 0.f);
                if (__ballot(scl != 1.0f) != 0ull) {
#pragma unroll
                    for (int db = 0; db < 4; ++db)
#pragma unroll
                        for (int r = 0; r < 16; ++r) o[db][r] *= scl; }
                const unsigned pmask = sel ? 0xffffffffu : 0u;
                bf16x8 pb[4];
#pragma unroll
                for (int gi = 0; gi < 4; ++gi) { const int kh = gi >> 1, s2 = gi & 1; v4u pw;
                    pw.x = pg8::cvt_pk_bf16(p[kh][8 * s2], p[kh][8 * s2 + 1]) & pmask; pw.y = pg8::cvt_pk_bf16(p[kh][8 * s2 + 2], p[kh][8 * s2 + 3]) & pmask;
                    pw.z = pg8::cvt_pk_bf16(p[kh][8 * s2 + 4], p[kh][8 * s2 + 5]) & pmask; pw.w = pg8::cvt_pk_bf16(p[kh][8 * s2 + 6], p[kh][8 * s2 + 7]) & pmask;
                    pb[gi] = __builtin_bit_cast(bf16x8, pw); }
                v4i16_t lo[2][2], hi_[2][2];
                const int dsub = 16 * (G4 & 1) + 4 * (l16 & 3);
#define ATTN_VREADS(u, S) { const int key0_ = 32 * ((u) >> 2) + 16 * (((u) >> 1) & 1) + 4 * (G4 >> 1) + (l16 >> 2); _Pragma("unroll") for (int d2 = 0; d2 < 2; ++d2) { const int db = 2 * ((u) & 1) + d2; \
                    const unsigned a0_ = vimg + key0_ * 256 + ((db ^ (key0_ & 3)) << 6) + dsub * 2; \
                    asm volatile("ds_read_b64_tr_b16 %0, %1" : "=&v"(lo[S][d2]) : "v"(a0_) : "memory"); \
                    asm volatile("ds_read_b64_tr_b16 %0, %1 offset:2048" : "=&v"(hi_[S][d2]) : "v"(a0_) : "memory"); } }
#define ATTN_VWAIT(S, N) asm volatile("s_waitcnt lgkmcnt(" #N ")" : "+v"(lo[S][0]), "+v"(lo[S][1]), "+v"(hi_[S][0]), "+v"(hi_[S][1]) :: "memory")
#define ATTN_PV(u, S) { _Pragma("unroll") for (int d2 = 0; d2 < 2; ++d2) { const int db = 2 * ((u) & 1) + d2; const bf16x8 av = {lo[S][d2][0], lo[S][d2][1], lo[S][d2][2], lo[S][d2][3], hi_[S][d2][0], hi_[S][d2][1], hi_[S][d2][2], hi_[S][d2][3]}; \
                    o[db] = __builtin_amdgcn_mfma_f32_32x32x16_bf16(av, pb[(u) >> 1], o[db], 0, 0, 0); } }
                ATTN_VREADS(0, 0)
                ATTN_VREADS(1, 1) ATTN_VWAIT(0, 4); ATTN_PV(0, 0)
                ATTN_VREADS(2, 0) ATTN_VWAIT(1, 4); ATTN_PV(1, 1)
                ATTN_VREADS(3, 1) ATTN_VWAIT(0, 4); ATTN_PV(2, 0)
                ATTN_VREADS(4, 0) ATTN_VWAIT(1, 4); ATTN_PV(3, 1)
                ATTN_VREADS(5, 1) ATTN_VWAIT(0, 4); ATTN_PV(4, 0)
                ATTN_VREADS(6, 0) ATTN_VWAIT(1, 4); ATTN_PV(5, 1)
                ATTN_VREADS(7, 1) ATTN_VWAIT(0, 4); ATTN_PV(6, 0)
                ATTN_VWAIT(1, 0); ATTN_PV(7, 1)
#undef ATTN_VREADS
#undef ATTN_VWAIT
#undef ATTN_PV
            }
        } }
        l_run += __shfl_xor(l_run, 32);
        asm volatile("s_waitcnt vmcnt(0) lgkmcnt(0)" ::: "memory"); __builtin_amdgcn_s_barrier(); asm volatile("" ::: "memory");
        LAS float* xs = (LAS float*)lds + (size_t)wq * 66 * 64 + lane;
        if (kvh == 1) {
            xs[0] = m_run; xs[64] = l_run;
#pragma unroll
            for (int db = 0; db < 4; ++db)
#pragma unroll
                for (int r = 0; r < 16; ++r) xs[(2 + 16 * db + r) * 64] = o[db][r];
        }
        asm volatile("s_waitcnt lgkmcnt(0)" ::: "memory"); __builtin_amdgcn_s_barrier(); asm volatile("" ::: "memory");
        if (kvh == 0) {
            const float m2 = xs[0], l2 = xs[64], mt = fmaxf(m_run, m2), a1 = __builtin_amdgcn_exp2f(m_run - mt), a2 = __builtin_amdgcn_exp2f(m2 - mt);
            const float inv = 1.0f / (l_run * a1 + l2 * a2), c1 = a1 * inv, c2 = a2 * inv;
            bf16* orow = AO + rowq * 1024 + h * 128 + 4 * hh;
#pragma unroll
            for (int db = 0; db < 4; ++db)
#pragma unroll
                for (int g = 0; g < 4; ++g) {
                    float t[4];
#pragma unroll
                    for (int e = 0; e < 4; ++e) t[e] = o[db][4 * g + e] * c1 + xs[(2 + 16 * db + 4 * g + e) * 64] * c2;
                    u32x2v w; w.x = pg8::cvt_pk_bf16(t[0], t[1]); w.y = pg8::cvt_pk_bf16(t[2], t[3]);
                    *(GAS u32x2v*)(orow + 32 * db + 8 * g) = w;
                }
        }
    }
    asm volatile("s_waitcnt vmcnt(0) lgkmcnt(0)" ::: "memory"); __builtin_amdgcn_s_barrier(); asm volatile("" ::: "memory");
}
__device__ __forceinline__ void up8(const v4u w, float (&f)[8]) { f[0] = bflo(w.x); f[1] = bfhi(w.x); f[2] = bflo(w.y); f[3] = bfhi(w.y); f[4] = bflo(w.z); f[5] = bfhi(w.z); f[6] = bflo(w.w); f[7] = bfhi(w.w); }
__device__ __forceinline__ void conv_phase(const Ctx& F, const bf16* CB, const bf16* Z, const float* cw, bf16* UC) {
    const int gt = (F.vcu * NWAVES + F.wave) * 64 + F.lane, NT = F.G * NWAVES * 64;
    for (int idx = gt; idx < M * 128; idx += NT) {
        const int row = idx >> 7, c8 = (idx & 127) << 3, t = row & (SEQ - 1); const size_t off = (size_t)row * 1024 + c8;
        float cb[8], z0[8], z1[8], z2[8];
        up8(*(const GAS v4u*)(CB + off), cb); up8(*(const GAS v4u*)(Z + off), z0);
        if (t >= 1) up8(*(const GAS v4u*)(Z + off - 1024), z1); else {
#pragma unroll
            for (int j = 0; j < 8; ++j) z1[j] = 0.f; }
        if (t >= 2) up8(*(const GAS v4u*)(Z + off - 2048), z2); else {
#pragma unroll
            for (int j = 0; j < 8; ++j) z2[j] = 0.f; }
        float o[8];
#pragma unroll
        for (int j = 0; j < 8; ++j) o[j] = cb[j] * (cw[c8 + j] * z2[j] + cw[1024 + c8 + j] * z1[j] + cw[2048 + c8 + j] * z0[j]);
        v4u w; w.x = pk2(o[0], o[1]); w.y = pk2(o[2], o[3]); w.z = pk2(o[4], o[5]); w.w = pk2(o[6], o[7]); *(GAS v4u*)(UC + off) = w;
    }
}

__device__ __forceinline__ int imax(int a, int b) { return a > b ? a : b; }
__device__ __forceinline__ int imin(int a, int b) { return a < b ? a : b; }
__device__ __forceinline__ void ce(int& a, int& b) { const int t = imax(a, b); b = imin(a, b); a = t; }
__device__ __forceinline__ void sort16(int (&x)[16]) {
#pragma unroll
    for (int kk = 1; kk <= 4; ++kk)
#pragma unroll
        for (int jj = kk - 1; jj >= 0; --jj)
#pragma unroll
            for (int i = 0; i < 16; ++i) { const int k = 1 << kk, j = 1 << jj, l = i ^ j; if (l > i) { if ((i & k) == 0) ce(x[i], x[l]); else ce(x[l], x[i]); } }
}
__device__ __forceinline__ void bmerge16(int (&a)[16]) {
#pragma unroll
    for (int jj = 3; jj >= 0; --jj)
#pragma unroll
        for (int i = 0; i < 16; ++i) { const int j = 1 << jj, l = i ^ j; if (l > i) ce(a[i], a[l]); }
}
__device__ __forceinline__ void merge16(int (&a)[16], const int (&b)[16]) {
#pragma unroll
    for (int i = 0; i < 16; ++i) a[i] = imax(a[i], b[15 - i]);
    bmerge16(a);
}
__device__ __forceinline__ void xmerge16(int (&a)[16], int hh) {
    int pv[16];
#pragma unroll
    for (int i = 0; i < 16; ++i) { const auto r = __builtin_amdgcn_permlane32_swap((unsigned)a[15 - i], (unsigned)a[15 - i], false, false); pv[i] = hh ? (int)r[0] : (int)r[1]; }
#pragma unroll
    for (int i = 0; i < 16; ++i) a[i] = imax(a[i], pv[i]);
    bmerge16(a);
}
__device__ __forceinline__ int ord_key(float f) { const int u = __float_as_int(f); return u >= 0 ? u : (u ^ 0x7fffffff); }
__device__ __forceinline__ float ord_val(int k) { return __int_as_float(k >= 0 ? k : (k ^ 0x7fffffff)); }
__device__ __forceinline__ unsigned byte16(const unsigned (&t)[4], int idx) {
    const unsigned sel = 0x0c0c0c00u | (unsigned)(idx & 7);
    const unsigned lo = __builtin_amdgcn_perm(t[1], t[0], sel), hi_ = __builtin_amdgcn_perm(t[3], t[2], sel);
    return (idx & 8) ? hi_ : lo;
}
__device__ __forceinline__ void topk_stage_keys(const Ctx& F, const bf16* KEYS, int h) {
    for (int pc = F.wave; pc < 64; pc += 8) { const int pp = pc >> 5, row = 4 * (pc & 31) + (F.lane >> 4), cp = F.lane & 15, c = cp ^ (row & 15);
        __builtin_amdgcn_global_load_lds((const unsigned*)(KEYS + (size_t)((h * 2 + pp) * 128 + row) * 128 + 8 * c), (LAS unsigned*)(F.lds + RING_OFF + pc * 1024), 16, 0, 0); }
    asm volatile("s_waitcnt vmcnt(0)" ::: "memory"); __builtin_amdgcn_s_barrier(); asm volatile("" ::: "memory");
}
__device__ __forceinline__ void topk_phase(const Ctx& F, int bitem, const bf16* QP, int* EXP, float* GATE) {
    const int lane = F.lane, l31 = lane & 31, hh = lane >> 5;
    const int IMIN = (int)0x80000000;
    const unsigned lds0 = (unsigned)(uintptr_t)(F.lds + RING_OFF);
    {
        const int h = bitem & 7, tt = (bitem >> 3) * 8 + F.wave, tok0 = tt * 32;
        int top[2][16];
#pragma unroll
        for (int p = 0; p < 2; ++p) {
            bf16x8 qa[8];
#pragma unroll
            for (int s = 0; s < 8; ++s) qa[s] = *(const GAS bf16x8*)(QP + (size_t)(tok0 + l31) * 2048 + h * 256 + p * 128 + 16 * s + 8 * hh);
            int x[2][16];
#pragma unroll
            for (int pq = 0; pq < 2; ++pq) {
                f32x16 sc[2];
#pragma unroll
                for (int nt = 0; nt < 2; ++nt)
#pragma unroll
                    for (int r = 0; r < 16; ++r) sc[nt][r] = 0.f;
#pragma unroll
                for (int s = 0; s < 8; ++s) {
#pragma unroll
                    for (int nt = 0; nt < 2; ++nt) { const int n = 64 * pq + 32 * nt + l31; const bf16x8 kb = *(const LAS bf16x8*)(uintptr_t)(lds0 + p * 32768 + n * 256 + (((2 * s + hh) ^ (n & 15)) << 4));
                        sc[nt] = __builtin_amdgcn_mfma_f32_32x32x16_bf16(kb, qa[s], sc[nt], 0, 0, 0); }
                }
                int y[16];
#pragma unroll
                for (int r = 0; r < 16; ++r) { x[pq][r] = (ord_key(sc[0][r]) & ~127) | ((127 - 64 * pq - (r & 3) - 8 * (r >> 2)) - 4 * hh); y[r] = (ord_key(sc[1][r]) & ~127) | ((127 - 64 * pq - 32 - (r & 3) - 8 * (r >> 2)) - 4 * hh); }
                sort16(x[pq]); sort16(y); merge16(x[pq], y);
                asm volatile("" ::: "memory");
            }
            merge16(x[0], x[1]);
            xmerge16(x[0], hh);
#pragma unroll
            for (int i = 0; i < 16; ++i) top[p][i] = x[0][i];
        }
        float fa[16], fb[16];
#pragma unroll
        for (int i = 0; i < 16; ++i) { const int A = hh ? top[1][i] : top[0][i], B = hh ? top[0][i] : top[1][i]; fa[i] = ord_val(A & ~127); fb[i] = ord_val(B & ~127); }
        int c0[16], c1[16];
#pragma unroll
        for (int q = 0; q < 32; ++q) {
            int key = IMIN;
            if (q < 27) { const int i = (q < 16) ? 0 : (q < 23) ? 1 : (q < 26) ? 2 : 3, j = (q < 16) ? q : (q < 23) ? q - 15 : (q < 26) ? q - 21 : 3; const float sv = fa[i] + fb[j]; const int low = hh ? (255 - (j * 16 + i)) : (255 - (i * 16 + j));
                key = (ord_key(sv) & ~255) | low; if (i == j && hh) key = IMIN; }
            if (q < 16) c0[q] = key; else c1[q - 16] = key;
        }
        sort16(c0); sort16(c1); merge16(c0, c1); xmerge16(c0, hh);
        unsigned na[4], nb[4];
#pragma unroll
        for (int d = 0; d < 4; ++d) { na[d] = 0u; nb[d] = 0u;
#pragma unroll
            for (int e = 0; e < 4; ++e) { na[d] |= (unsigned)(127 - (top[0][4 * d + e] & 127)) << (8 * e); nb[d] |= (unsigned)(127 - (top[1][4 * d + e] & 127)) << (8 * e); } }
        int ex[16]; float ev[16]; float es = 0.f; const float smax = ord_val(c0[0] & ~255);
#pragma unroll
        for (int q = 0; q < 16; ++q) { const int posn = 255 - (c0[q] & 255); const unsigned n1 = byte16(na, posn >> 4) & 255u, n2 = byte16(nb, posn & 15) & 255u;
            ex[q] = (int)(n1 * 128u + n2); ev[q] = __expf(ord_val(c0[q] & ~255) - smax); es += ev[q]; }
        const float ri = 1.0f / es; const size_t ob = (size_t)(tok0 + l31) * 128 + h * 16;
        if (hh == 0) {
#pragma unroll
            for (int d = 0; d < 4; ++d) { v4u w; w.x = (unsigned)ex[4 * d]; w.y = (unsigned)ex[4 * d + 1]; w.z = (unsigned)ex[4 * d + 2]; w.w = (unsigned)ex[4 * d + 3]; *(GAS v4u*)(EXP + ob + 4 * d) = w; }
        } else {
#pragma unroll
            for (int d = 0; d < 4; ++d) *(GAS f32x4*)(GATE + ob + 4 * d) = (f32x4){ev[4 * d] * ri, ev[4 * d + 1] * ri, ev[4 * d + 2] * ri, ev[4 * d + 3] * ri};
        }
    }
}

typedef float f32x2 __attribute__((ext_vector_type(2)));
constexpr float PEER_SU = 512.0f, PEER_SV = 32.0f;
template <int CTRL> __device__ __forceinline__ int dpp_i(int v) { return __builtin_amdgcn_update_dpp(v, v, CTRL, 0xf, 0xf, false); }
template <int J> __device__ __forceinline__ int xor_lane(int v, int lane) {
    if constexpr (J == 1) return dpp_i<0xB1>(v);
    else if constexpr (J == 2) return dpp_i<0x4E>(v);
    else if constexpr (J == 16) { const auto r = __builtin_amdgcn_permlane16_swap((unsigned)v, (unsigned)v, false, false); return ((lane >> 4) & 1) ? (int)r[0] : (int)r[1]; }
    else if constexpr (J == 32) { const auto r = __builtin_amdgcn_permlane32_swap((unsigned)v, (unsigned)v, false, false); return (lane >> 5) ? (int)r[0] : (int)r[1]; }
    else return __shfl_xor(v, J);
}
__device__ __forceinline__ float wave_sum_dpp(float v) {
    v += __int_as_float(dpp_i<0xB1>(__float_as_int(v))); v += __int_as_float(dpp_i<0x4E>(__float_as_int(v))); v += __int_as_float(dpp_i<0x141>(__float_as_int(v))); v += __int_as_float(dpp_i<0x140>(__float_as_int(v)));
    { const auto r = __builtin_amdgcn_permlane16_swap(__float_as_uint(v), __float_as_uint(v), false, false); v = __uint_as_float(r[0]) + __uint_as_float(r[1]); }
    { const auto r = __builtin_amdgcn_permlane32_swap(__float_as_uint(v), __float_as_uint(v), false, false); v = __uint_as_float(r[0]) + __uint_as_float(r[1]); }
    return v; }
template <int KK, int JJ> __device__ __forceinline__ void sort512_step(int (&x)[8], int lane) {
    constexpr int k = 1 << KK, j = 1 << JJ;
    if constexpr (j >= 64) { constexpr int jr = j >> 6;
#pragma unroll
        for (int r = 0; r < 8; ++r) if ((r & jr) == 0) { const bool asc = (k >= 512) ? true : (((r << 6) & k) == 0); const int lo = imin(x[r], x[r | jr]), hi_ = imax(x[r], x[r | jr]); x[r] = asc ? lo : hi_; x[r | jr] = asc ? hi_ : lo; }
    } else {
        const bool lower = (lane & j) == 0;
#pragma unroll
        for (int r = 0; r < 8; ++r) { const int y = xor_lane<j>(x[r], lane);
            const bool asc = (k < 64) ? ((lane & k) == 0) : ((k >= 512) ? true : (((r << 6) & k) == 0));
            x[r] = (lower == asc) ? imin(x[r], y) : imax(x[r], y); }
    }
}
template <int KK, int JJ> __device__ __forceinline__ void sort512_stage(int (&x)[8], int lane) { sort512_step<KK, JJ>(x, lane); if constexpr (JJ > 0) sort512_stage<KK, JJ - 1>(x, lane); }
__device__ __forceinline__ void sort512(int (&x)[8], int lane) {
    sort512_stage<1, 0>(x, lane); sort512_stage<2, 1>(x, lane); sort512_stage<3, 2>(x, lane); sort512_stage<4, 3>(x, lane); sort512_stage<5, 4>(x, lane);
    sort512_stage<6, 5>(x, lane); sort512_stage<7, 6>(x, lane); sort512_stage<8, 7>(x, lane); sort512_stage<9, 8>(x, lane);
}
__device__ __forceinline__ void peer_phase(const Ctx& F, const unsigned char* U8, const unsigned char* V8, const bf16* X1B, const int* EXP, const float* GATE, const unsigned long long* SS, const float* gfin, const float* X1, float* OUT) {
    const int gw = F.vcu * NWAVES + F.wave, NGW = F.G * NWAVES, lane = F.lane;
    const unsigned xs0 = (unsigned)(uintptr_t)(F.lds + RING_OFF + F.wave * 16384) + lane * 16;
    for (int tb = gw; tb + 3 * NGW < M; tb += 4 * NGW) {
        int kreg[8]; float greg[8], rv[4];
#pragma unroll
        for (int j = 0; j < 4; ++j) { const size_t t = (size_t)tb + (size_t)j * NGW;
            kreg[2 * j] = (EXP[t * 128 + lane] << 9) | (j << 7) | lane; kreg[2 * j + 1] = (EXP[t * 128 + 64 + lane] << 9) | (j << 7) | (64 + lane);
            rv[j] = pg8::rinv_from_ss(SS[t]) * (1.0f / PEER_SU);
#pragma unroll
            for (int q = 0; q < 4; ++q) { const v4u w = *(const GAS v4u*)(X1B + t * DM + (q >> 1) * 1024 + lane * 16 + 8 * (q & 1)); *(LAS v4u*)(uintptr_t)(xs0 + j * 4096 + q * 1024) = w; } }
        sort512(kreg, lane);
        int pkey[8];
#pragma unroll
        for (int c = 0; c < 8; ++c) { pkey[c] = __shfl(kreg[c], 8 * (lane & 7) + (lane >> 3)); greg[c] = GATE[((size_t)tb + (size_t)((pkey[c] >> 7) & 3) * NGW) * 128 + (pkey[c] & 127)]; }
        asm volatile("s_waitcnt lgkmcnt(0)" ::: "memory");
        float actreg[8];
#ifndef MK_P8_REPU
#define MK_P8_REPU 1
#endif
#pragma unroll 1
        for (int repu = 0; repu < MK_P8_REPU; ++repu) {
            v4u ub[8][2];
#pragma unroll
            for (int u = 0; u < 8; ++u) { const GAS v4u* up = (const GAS v4u*)(U8 + (size_t)(__builtin_amdgcn_readlane(kreg[0], u) >> 9) * 2048) + lane; ub[u][0] = up[0]; ub[u][1] = up[64]; }
#pragma unroll
            for (int c = 0; c < 8; ++c) {
                float areg = 0.f;
#pragma unroll 1
                for (int g = 0; g < 8; ++g) {
                    float pt[8];
#pragma unroll
                    for (int u = 0; u < 8; ++u) {
                        const int key = __builtin_amdgcn_readlane(kreg[c], 8 * g + u);
                        const unsigned xa = xs0 + ((key >> 7) & 3) * 4096;
                        float p0 = 0.f, p1 = 0.f;
#pragma unroll
                        for (int i = 0; i < 2; ++i) { const v4u w = ub[u][i];
#pragma unroll
                            for (int hv = 0; hv < 2; ++hv) { const v4u xq = *(const LAS v4u*)(uintptr_t)(xa + (2 * i + hv) * 1024);
                                const unsigned w0 = hv ? w.z : w.x, w1 = hv ? w.w : w.y;
                                const f32x2 a0 = __builtin_amdgcn_cvt_pk_f32_fp8((int)w0, false), a1 = __builtin_amdgcn_cvt_pk_f32_fp8((int)w0, true), a2 = __builtin_amdgcn_cvt_pk_f32_fp8((int)w1, false), a3 = __builtin_amdgcn_cvt_pk_f32_fp8((int)w1, true);
                                p0 = dot2bf(pg8::cvt_pk_bf16(a0[0], a0[1]), xq.x, p0); p1 = dot2bf(pg8::cvt_pk_bf16(a1[0], a1[1]), xq.y, p1);
                                p0 = dot2bf(pg8::cvt_pk_bf16(a2[0], a2[1]), xq.z, p0); p1 = dot2bf(pg8::cvt_pk_bf16(a3[0], a3[1]), xq.w, p1); } }
                        pt[u] = p0 + p1;
                        { const int ix = 8 * g + 8 + u, ka = __builtin_amdgcn_readlane(kreg[c], ix & 63), kb = __builtin_amdgcn_readlane(kreg[c < 7 ? c + 1 : 7], ix & 63), kn = (ix < 64) ? ka : kb;
                            const GAS v4u* up = (const GAS v4u*)(U8 + (size_t)(kn >> 9) * 2048) + lane; ub[u][0] = up[0]; ub[u][1] = up[64]; }
                    }
                    { const bool b5 = (lane & 32) != 0, b4 = (lane & 16) != 0, b3 = (lane & 8) != 0;
#pragma unroll
                      for (int i = 0; i < 4; ++i) { const float a = pt[i], b = pt[i + 4]; pt[i] = (b5 ? b : a) + __int_as_float(xor_lane<32>(__float_as_int(b5 ? a : b), lane)); }
#pragma unroll
                      for (int i = 0; i < 2; ++i) { const float a = pt[i], b = pt[i + 2]; pt[i] = (b4 ? b : a) + __int_as_float(xor_lane<16>(__float_as_int(b4 ? a : b), lane)); }
                      { const float a = pt[0], b = pt[1]; pt[0] = (b3 ? b : a) + __shfl_xor(b3 ? a : b, 8); }
                      float r = pt[0]; r += __shfl_xor(r, 4); r += __int_as_float(dpp_i<0x4E>(__float_as_int(r))); r += __int_as_float(dpp_i<0xB1>(__float_as_int(r)));
                      areg = ((lane & 7) == g) ? r : areg; }
                }
                const int tk = (pkey[c] >> 7) & 3; const float rr = (tk == 0) ? rv[0] : (tk == 1) ? rv[1] : (tk == 2) ? rv[2] : rv[3];
                actreg[c] = gelu_tanh(areg * rr) * greg[c] * (1.0f / PEER_SV);
            }
        }
        LAS float* as = (LAS float*)(uintptr_t)(xs0 - lane * 16);
        asm volatile("s_waitcnt lgkmcnt(0)" ::: "memory");
#pragma unroll
        for (int c = 0; c < 8; ++c) as[64 * c + lane] = actreg[c];
        int k2[8];
#pragma unroll
        for (int c = 0; c < 8; ++c) { const int key = kreg[c], tok = (key >> 7) & 3, park = 64 * c + 8 * (lane & 7) + (lane >> 3);
            k2[c] = ((tok >> 1) << 24) | ((key >> 9) << 10) | ((tok & 1) << 9) | park; }
        sort512(k2, lane);
        asm volatile("s_waitcnt lgkmcnt(0)" ::: "memory");
        float a2[8];
#pragma unroll
        for (int c = 0; c < 8; ++c) a2[c] = as[k2[c] & 511];
#pragma unroll 1
        for (int pp = 0; pp < 2; ++pp) {
            int kq[4]; float aq[4];
#pragma unroll
            for (int c = 0; c < 4; ++c) { kq[c] = pp ? k2[4 + c] : k2[c]; aq[c] = pp ? a2[4 + c] : a2[c]; }
            f32x2 y[2][16];
#pragma unroll
            for (int j = 0; j < 2; ++j)
#pragma unroll
                for (int q = 0; q < 16; ++q) y[j][q] = (f32x2){0.f, 0.f};
            v4u vb[8][2];
#pragma unroll
            for (int u = 0; u < 8; ++u) { const GAS v4u* vp = (const GAS v4u*)(V8 + (size_t)((__builtin_amdgcn_readlane(kq[0], u) >> 10) & 0x3fff) * 2048) + lane; vb[u][0] = vp[0]; vb[u][1] = vp[64]; }
#pragma unroll
            for (int c = 0; c < 4; ++c) {
#pragma unroll 1
                for (int g = 0; g < 8; ++g) {
#pragma unroll
                    for (int u = 0; u < 8; ++u) {
                        const int key = __builtin_amdgcn_readlane(kq[c], 8 * g + u); const float s = rdlane(aq[c], 8 * g + u);
                        const float sa = (key & 512) ? 0.f : s, sb = (key & 512) ? s : 0.f; const f32x2 s0 = {sa, sa}, s1 = {sb, sb};
#pragma unroll
                        for (int i = 0; i < 2; ++i) { const v4u w = vb[u][i];
                            const f32x2 c0 = __builtin_amdgcn_cvt_pk_f32_fp8((int)w.x, false), c1 = __builtin_amdgcn_cvt_pk_f32_fp8((int)w.x, true), c2 = __builtin_amdgcn_cvt_pk_f32_fp8((int)w.y, false), c3 = __builtin_amdgcn_cvt_pk_f32_fp8((int)w.y, true);
                            const f32x2 c4 = __builtin_amdgcn_cvt_pk_f32_fp8((int)w.z, false), c5 = __builtin_amdgcn_cvt_pk_f32_fp8((int)w.z, true), c6 = __builtin_amdgcn_cvt_pk_f32_fp8((int)w.w, false), c7 = __builtin_amdgcn_cvt_pk_f32_fp8((int)w.w, true);
                            y[0][8 * i + 0] = __builtin_elementwise_fma(c0, s0, y[0][8 * i + 0]); y[1][8 * i + 0] = __builtin_elementwise_fma(c0, s1, y[1][8 * i + 0]);
                            y[0][8 * i + 1] = __builtin_elementwise_fma(c1, s0, y[0][8 * i + 1]); y[1][8 * i + 1] = __builtin_elementwise_fma(c1, s1, y[1][8 * i + 1]);
                            y[0][8 * i + 2] = __builtin_elementwise_fma(c2, s0, y[0][8 * i + 2]); y[1][8 * i + 2] = __builtin_elementwise_fma(c2, s1, y[1][8 * i + 2]);
                            y[0][8 * i + 3] = __builtin_elementwise_fma(c3, s0, y[0][8 * i + 3]); y[1][8 * i + 3] = __builtin_elementwise_fma(c3, s1, y[1][8 * i + 3]);
                            y[0][8 * i + 4] = __builtin_elementwise_fma(c4, s0, y[0][8 * i + 4]); y[1][8 * i + 4] = __builtin_elementwise_fma(c4, s1, y[1][8 * i + 4]);
                            y[0][8 * i + 5] = __builtin_elementwise_fma(c5, s0, y[0][8 * i + 5]); y[1][8 * i + 5] = __builtin_elementwise_fma(c5, s1, y[1][8 * i + 5]);
                            y[0][8 * i + 6] = __builtin_elementwise_fma(c6, s0, y[0][8 * i + 6]); y[1][8 * i + 6] = __builtin_elementwise_fma(c6, s1, y[1][8 * i + 6]);
                            y[0][8 * i + 7] = __builtin_elementwise_fma(c7, s0, y[0][8 * i + 7]); y[1][8 * i + 7] = __builtin_elementwise_fma(c7, s1, y[1][8 * i + 7]); }
                        { const int ix = 8 * g + 8 + u, ka = __builtin_amdgcn_readlane(kq[c], ix & 63), kb = __builtin_amdgcn_readlane(kq[c < 3 ? c + 1 : 3], ix & 63), kn = (ix < 64) ? ka : kb;
                            const GAS v4u* vp = (const GAS v4u*)(V8 + (size_t)((kn >> 10) & 0x3fff) * 2048) + lane; vb[u][0] = vp[0]; vb[u][1] = vp[64]; }
                    }
                }
            }
#pragma unroll
            for (int j = 0; j < 2; ++j) { const size_t t = (size_t)tb + (size_t)(2 * pp + j) * NGW;
                GAS f32x4* orw = (GAS f32x4*)(OUT + t * DM); float ss = 0.f;
#pragma unroll
                for (int i = 0; i < 2; ++i)
#pragma unroll
                    for (int hv = 0; hv < 2; ++hv) { const v4u w = *(const GAS v4u*)(X1B + t * DM + i * 1024 + lane * 16 + 8 * hv);
                        y[j][8 * i + 4 * hv + 0] += (f32x2){bflo(w.x), bfhi(w.x)}; y[j][8 * i + 4 * hv + 1] += (f32x2){bflo(w.y), bfhi(w.y)}; y[j][8 * i + 4 * hv + 2] += (f32x2){bflo(w.z), bfhi(w.z)}; y[j][8 * i + 4 * hv + 3] += (f32x2){bflo(w.w), bfhi(w.w)}; }
#pragma unroll
                for (int q = 0; q < 16; ++q) ss += y[j][q][0] * y[j][q][0] + y[j][q][1] * y[j][q][1];
                const float r3 = 1.0f / sqrtf(wave_sum_dpp(ss) * (1.0f / DM) + RMS_EPS);
#pragma unroll
                for (int i = 0; i < 2; ++i)
#pragma unroll
                    for (int q = 0; q < 4; ++q) { const f32x4 ga = *(const GAS f32x4*)(gfin + i * 1024 + lane * 16 + 4 * q);
                        orw[i * 256 + 4 * lane + q] = (f32x4){y[j][8 * i + 2 * q][0] * r3 * ga[0], y[j][8 * i + 2 * q][1] * r3 * ga[1], y[j][8 * i + 2 * q + 1][0] * r3 * ga[2], y[j][8 * i + 2 * q + 1][1] * r3 * ga[3]}; }
            }
        }
        asm volatile("s_waitcnt lgkmcnt(0)" ::: "memory");
    }
}

struct Args { const float* in[15]; float* out; unsigned char* ws; double invf[16]; int ph_lo, ph_hi, li, pad; };
__global__ void __launch_bounds__(NWAVES * 64, 2) mk_fwd(Args args) {
    extern __shared__ __attribute__((aligned(16))) unsigned char lds[];
    Ctx F;
    F.lds = (LAS unsigned char*)lds;
    volatile LAS unsigned* MISC = (volatile LAS unsigned*)(F.lds + MISC_OFF);
    F.tid = threadIdx.x; F.lane = F.tid & 63; F.wave = __builtin_amdgcn_readfirstlane(F.tid >> 6);
    F.G = gridDim.x; { const int bx = blockIdx.x; F.vcu = (F.G % 8 == 0) ? (bx % 8) * (F.G / 8) + bx / 8 : bx; }
    unsigned char* ws = args.ws;
    gu32* ctl = (gu32*)(ws + WS_CTL);
    for (int u = F.tid; u < (LDS_BYTES - LDSCTL_OFF) / 4; u += NWAVES * 64) ((LAS unsigned*)(F.lds + LDSCTL_OFF))[u] = 0u;
    __syncthreads();
    XcdBarrier bar; bar.bar = (unsigned*)(ctl + CW_BAR); bar.x = 0; bar.st = nullptr;
    if (N_LAUNCHES != PER_PHASE) bar = xcd_barrier_post((unsigned*)(ctl + CW_BAR), MISC + 8);
#define GRID_BAR() do { if (N_LAUNCHES != PER_PHASE) xcd_barrier(bar); } while (0)
#define GRID_BAR_W(q) do { if (N_LAUNCHES != PER_PHASE) { const BarWork wk_{args.in[12], args.in[13], args.in[9], ws, (q), 4}; xcd_barrier(bar, &F, &wk_); } } while (0)
    const int lo = args.ph_lo, hi = args.ph_hi;
#define IN(k) (lo <= (k) && (k) < hi)
#define BOTH(k) (IN(k) && IN((k) + 1))
    bf16* WinT = (bf16*)(ws + WS_WIN); bf16* WbcT = (bf16*)(ws + WS_WBC); bf16* WbaT = (bf16*)(ws + WS_WBA); bf16* WoutT = (bf16*)(ws + WS_WOUT); bf16* WpqT = (bf16*)(ws + WS_WPQ);
    bf16* KEYS = (bf16*)(ws + WS_KEYS); float* CS = (float*)(ws + WS_CS); const unsigned char* UB = ws + WS_UB; const unsigned char* VB = ws + WS_VB;
    bf16* XB = (bf16*)(ws + WS_XB); bf16* T6 = (bf16*)(ws + WS_T6); bf16* GAB = (bf16*)(ws + WS_GAB); bf16* UC = (bf16*)(ws + WS_UC); bf16* AO = (bf16*)(ws + WS_AO);
    bf16* TMP = (bf16*)(ws + WS_TMP); bf16* MB = (bf16*)(ws + WS_MB); bf16* X1B = (bf16*)(ws + WS_X1B); bf16* QP = (bf16*)(ws + WS_QP);
    int* EXP = (int*)(ws + WS_EXP); float* GATE = (float*)(ws + WS_GATE);
    unsigned long long* SS = (unsigned long long*)(ws + WS_SS); float* KSUM = (float*)(ws + WS_KSUM);
    constexpr size_t TS = (size_t)M * 1024;

    if (IN(0)) { for (int rep = 0; rep < NREP(0); ++rep) { p0_prologue(F, args.in, ws, args.invf); if (rep + 1 < NREP(0)) GRID_BAR(); } if (BOTH(0)) GRID_BAR(); }
    if (IN(1)) {
        for (int rep = 0; rep < NREP(1); ++rep) {
        pg8::Gemm g{XB, WinT, M, INW, DM}; pg8::StaticOrder S; S.init(M, INW, F.G, (int)blockIdx.x);
        pg8::EpiIn E{T6, GAB, args.in[4], CS, KSUM};
        pg8::gemm_phase<pg8::EpiIn, pg8::StaticOrder, true, true>(F.lds + RING_OFF, g, S, E);
        if (rep + 1 < NREP(1)) GRID_BAR(); }
        if (BOTH(1)) GRID_BAR();
    }
    if (IN(2)) {
        for (int rep = 0; rep < NREP(2); ++rep) {
        attn_mfma(F, T6 + 3 * TS, T6 + 4 * TS, T6 + 5 * TS, KSUM, AO);
        conv_phase(F, T6, T6 + TS, args.in[5], UC);
        if (rep + 1 < NREP(2)) GRID_BAR(); }
        if (BOTH(2)) GRID_BAR_W(0);
    }
    if (IN(3)) {
        for (int rep = 0; rep < NREP(3); ++rep) {
        pg8::Gemm g{UC, WbcT, M, DM, 1024, AO, WbaT}; pg8::TwoSegOrder S; S.init(M, DM, F.G, (int)blockIdx.x);
        pg8::EpiMerge2 E{GAB, GAB + (size_t)M * DM, MB};
        pg8::gemm_phase<pg8::EpiMerge2, pg8::TwoSegOrder, true, true>(F.lds + RING_OFF, g, S, E);
        if (rep + 1 < NREP(3)) GRID_BAR(); }
        if (BOTH(3)) GRID_BAR_W(1);
    }
    if (IN(5)) {
        for (int rep = 0; rep < NREP(5); ++rep) {
        pg8::Gemm g{MB, WoutT, M, DM, DM}; pg8::StaticOrder S; S.init(M, DM, F.G, (int)blockIdx.x);
        pg8::EpiX1 E{XB, (const float*)(ws + WS_RMS), X1B, (rep + 1 < NREP(5)) ? (unsigned long long*)(ws + 768 * 1024) : SS};
        pg8::gemm_phase<pg8::EpiX1, pg8::StaticOrder, true, true>(F.lds + RING_OFF, g, S, E);
        if (rep + 1 < NREP(5)) GRID_BAR(); }
        if (BOTH(5)) GRID_BAR_W(2);
    }
    if (IN(6)) {
        for (int rep = 0; rep < NREP(6); ++rep) {
        pg8::Gemm g{X1B, WpqT, M, DM, DM}; pg8::StaticOrder S; S.init(M, DM, F.G, (int)blockIdx.x);
        pg8::EpiQP E{SS, QP};
        pg8::gemm_phase<pg8::EpiQP, pg8::StaticOrder, true, true>(F.lds + RING_OFF, g, S, E);
        if (rep + 1 < NREP(6)) GRID_BAR(); }
        if (BOTH(6)) GRID_BAR_W(3);
    }
    if (IN(7)) { for (int rep = 0; rep < NREP(7); ++rep) {
        for (int bitem = F.vcu; bitem < 256; bitem += F.G) {
            topk_stage_keys(F, KEYS, bitem & 7);
            if (N_LAUNCHES == PER_PHASE && bitem == F.vcu) convert_tables(F, args.in[12], args.in[13], args.in[9], ws, 0, 1, 0);
            topk_phase(F, bitem, QP, EXP, GATE);
            asm volatile("s_waitcnt lgkmcnt(0)" ::: "memory"); __builtin_amdgcn_s_barrier(); asm volatile("" ::: "memory");
        }
        if (rep + 1 < NREP(7)) GRID_BAR(); } if (BOTH(7)) GRID_BAR(); }
    if (IN(8)) { for (int rep = 0; rep < NREP(8); ++rep) { peer_phase(F, UB, VB, X1B, EXP, GATE, SS, args.in[14], args.out, (rep + 1 < NREP(8)) ? (float*)(ws + WS_END) : args.out); if (rep + 1 < NREP(8)) GRID_BAR(); } }
#undef IN
#undef BOTH
#undef GRID_BAR
#undef GRID_BAR_W
}

extern "C" void kernel_launch(void* const* d_in, const int* in_sizes, int n_in, void* d_out, int out_size, void* d_ws, size_t ws_size, hipStream_t stream) {
    static int grid = 0;
    if (grid == 0) {
        if (n_in != 15 || in_sizes[0] != M * DM || out_size != M * DM || ws_size < WS_END) { fprintf(stderr, "kernel_launch: unexpected shapes (n_in %d, in0 %d, out %d, ws %zu)\n", n_in, n_in > 0 ? in_sizes[0] : -1, out_size, ws_size); grid = -1; return; }
        int dev = 0, cus = 0, per_cu = 0;
        if (hipGetDevice(&dev) != hipSuccess || hipDeviceGetAttribute(&cus, hipDeviceAttributeMultiprocessorCount, dev) != hipSuccess) { grid = -1; return; }
        if (hipFuncSetAttribute((const void*)mk_fwd, hipFuncAttributeMaxDynamicSharedMemorySize, LDS_BYTES) != hipSuccess) { fprintf(stderr, "kernel_launch: hipFuncSetAttribute failed\n"); grid = -1; return; }
        if (hipOccupancyMaxActiveBlocksPerMultiprocessor(&per_cu, (const void*)mk_fwd, NWAVES * 64, LDS_BYTES) != hipSuccess || per_cu < 1) fprintf(stderr, "kernel_launch: occupancy query reports %d\n", per_cu);
        (void)hipGetLastError();
        grid = cus;
        if (M % (4 * grid * NWAVES) != 0) { fprintf(stderr, "kernel_launch: the PEER phase needs M %% (32 * grid) == 0 (grid %d)\n", grid); grid = -1; return; }
    }
    if (grid < 0) return;
    if (hipMemsetAsync((char*)d_ws + WS_CTL, 0, CTL_ZERO_BYTES, stream) != hipSuccess) { fprintf(stderr, "kernel_launch: memset failed\n"); return; }
    Args a{};
    for (int i = 0; i < 15; ++i) a.in[i] = (const float*)d_in[i];
    a.out = (float*)d_out; a.ws = (unsigned char*)d_ws;
    for (int f = 0; f < 16; ++f) a.invf[f] = pow(500000.0, -(double)(2 * f) / 32.0);
    for (int li = 0; li < N_LAUNCHES; ++li) {
        a.ph_lo = (N_LAUNCHES == PER_PHASE) ? li : 0; a.ph_hi = (N_LAUNCHES == PER_PHASE) ? li + 1 : PER_PHASE; a.li = li;
        hipLaunchKernelGGL(mk_fwd, dim3(grid), dim3(NWAVES * 64), LDS_BYTES, stream, a);
        const hipError_t le = hipPeekAtLastError();
        if (le != hipSuccess) { fprintf(stderr, "kernel_launch: launch %d failed: %s\n", li, hipGetErrorName(le)); break; }
    }
}
```

```cpp
#include <hip/hip_runtime.h>
#include <cstdio>
#include <cstdint>
#include <cmath>
namespace pg8 {
#define PG8_LAS __attribute__((address_space(3)))
typedef unsigned short bf16_t;
typedef short bf16x8 __attribute__((ext_vector_type(8)));
typedef float f32x4 __attribute__((ext_vector_type(4)));
typedef unsigned u32x4 __attribute__((ext_vector_type(4)));
constexpr int BM = 256, BK = 64, HALF = 128, HTB = HALF * BK * 2  , STAGE_BYTES = 8 * HTB, NXCD = 8, WGM = 8;

__host__ __device__ __forceinline__ int lds_byte(int r, int c) { const int st = (r >> 4) * 2 + (c >> 5), rr = r & 15, cc = c & 31, ob = rr * 64 + cc * 2; return st * 1024 + (ob ^ (((ob >> 9) & 1) << 5)); }
__host__ __device__ __forceinline__ void stage_rc(int b, int& R, int& C) { const int st = b / 1024, sb = b % 1024, swz = sb ^ (((sb >> 9) & 1) << 5); R = (st >> 1) * 16 + swz / 64; C = (st & 1) * 32 + (swz % 64) / 2; }
__host__ __device__ __forceinline__ int perm32(int rho) { const int n = rho >> 4, i = rho & 15; return 8 * (i >> 2) + 4 * n + (i & 3); }

struct Unit { int pm, pn, seg; };
struct Gemm { const bf16_t* A; const bf16_t* Bt; int M, N, K; const bf16_t* A2; const bf16_t* Bt2; };

struct StaticOrder {
    int nM, nN, nwg, G, c;
    __host__ __device__ void init(int M, int N, int G_, int c_) { nM = M / BM; nN = N / BM; nwg = nM * nN; G = G_; c = c_; }
    __host__ __device__ bool next(int i, Unit& u) const {
        const long L = (long)i * G + c; if (L >= nwg) return false;
        int wgid = (int)L; { const int q = nwg / NXCD, r = nwg % NXCD, xcd = wgid % NXCD, off = wgid / NXCD; wgid = (xcd < r ? xcd * (q + 1) : r * (q + 1) + (xcd - r) * q) + off; }
        const int nig = WGM * nN, gid = wgid / nig, fm = gid * WGM, gsz = (nM - fm) < WGM ? (nM - fm) : WGM;
        u.pm = fm + ((wgid % nig) % gsz); u.pn = (wgid % nig) / gsz; u.seg = 0; return true;
    }
    __device__ __forceinline__ void a_ready(const Unit&) const {}
    __device__ __forceinline__ void done(const Unit&) const {}
};
struct TwoSegOrder {
    StaticOrder so;
    __host__ __device__ void init(int M, int N, int G_, int c_) { so.init(M, N, G_, c_); }
    __host__ __device__ bool next(int i, Unit& u) const { if (!so.next(i >> 1, u)) return false; u.seg = i & 1; return true; }
    __device__ __forceinline__ void a_ready(const Unit&) const {}
    __device__ __forceinline__ void done(const Unit&) const {}
};


typedef float f32x2c __attribute__((ext_vector_type(2))); typedef __bf16 bf16x2c __attribute__((ext_vector_type(2)));
__device__ __forceinline__ unsigned cvt_pk_bf16(float lo, float hi) { const f32x2c v = {lo, hi}; const bf16x2c b = __builtin_convertvector(v, bf16x2c); return __builtin_bit_cast(unsigned, b); }
__device__ __forceinline__ u32x4 pack8(f32x4 a, f32x4 b) { u32x4 w; w.x = cvt_pk_bf16(a[0], a[1]); w.y = cvt_pk_bf16(a[2], a[3]); w.z = cvt_pk_bf16(b[0], b[1]); w.w = cvt_pk_bf16(b[2], b[3]); return w; }
__device__ __forceinline__ f32x4 shx(f32x4 v, int o) { f32x4 r; r[0] = __shfl_xor(v[0], o); r[1] = __shfl_xor(v[1], o); r[2] = __shfl_xor(v[2], o); r[3] = __shfl_xor(v[3], o); return r; }
__device__ __forceinline__ f32x4 bf4lo(unsigned a, unsigned b) { f32x4 r; r[0] = __uint_as_float(a << 16); r[1] = __uint_as_float(a & 0xffff0000u); r[2] = __uint_as_float(b << 16); r[3] = __uint_as_float(b & 0xffff0000u); return r; }
__device__ __forceinline__ f32x4 sigm4(f32x4 v) { f32x4 r;
#pragma unroll
    for (int i = 0; i < 4; ++i) r[i] = __builtin_amdgcn_rcpf(1.0f + __expf(-v[i])); return r; }
constexpr float QSCALE = 0.08838834764831845f * 1.4426950408889634f;

struct EpiIn {
    static constexpr bool PERM = true, AFTER_DRAIN = false, KEEP_SEG0 = false;
    bf16_t* T6; bf16_t* GAB; const float* gbias; const float* cs; float* ksum;
    __device__ __forceinline__ void operator()(const f32x4 (&acc)[2][2][4][2], const Unit& u, int wr, int wc, int fr, int fq) const {
        const int row0 = u.pm * BM + wr * 64 + fr, pn = u.pn, colw = wc * 32 + 8 * fq;
        if (pn < 24) {
            const int t = pn >> 2;
            bf16_t* base = T6 + (size_t)t * ((size_t)8192 * 1024) + (pn & 3) * 256 + colw;
            const bool rot = (t == 3 || t == 4) && (wc == 0), isk = (t == 4), zt = (pn >= 4 && pn < 12);
            const float qs = (t == 3) ? QSCALE : 1.0f;
            f32x4 ks[2][2];
#pragma unroll
            for (int bj = 0; bj < 2; ++bj) { ks[bj][0] = (f32x4){0.f, 0.f, 0.f, 0.f}; ks[bj][1] = (f32x4){0.f, 0.f, 0.f, 0.f}; }
#pragma unroll
            for (int ai = 0; ai < 2; ++ai)
#pragma unroll
                for (int m = 0; m < 4; ++m) {
                    const int row = row0 + ai * HALF + m * 16;
                    f32x4 c0 = (f32x4){1.f, 1.f, 1.f, 1.f}, c1 = c0, s0 = (f32x4){0.f, 0.f, 0.f, 0.f}, s1 = s0;
                    if (rot) { const float* cp = cs + (size_t)row * 32 + 8 * (fq & 1); c0 = *(const f32x4*)cp; c1 = *(const f32x4*)(cp + 4); s0 = *(const f32x4*)(cp + 16); s1 = *(const f32x4*)(cp + 20);
                        if (fq < 2) { s0 = -s0; s1 = -s1; } }
                    if (zt) {
                        *(u32x4*)(T6 + (size_t)8192 * 1024 + (size_t)row * 1024 + (pn - 4) * 128 + colw) = pack8(acc[ai][0][m][0] * acc[ai][1][m][0], acc[ai][0][m][1] * acc[ai][1][m][1]);
                    } else {
#pragma unroll
                    for (int bj = 0; bj < 2; ++bj) {
                        f32x4 v0 = acc[ai][bj][m][0], v1 = acc[ai][bj][m][1];
                        if (rot) { const f32x4 p0 = shx(v0, 32), p1 = shx(v1, 32); v0 = v0 * c0 + p0 * s0; v1 = v1 * c1 + p1 * s1; }
                        if (isk) { ks[bj][0] += v0; ks[bj][1] += v1; }
                        v0 = v0 * qs; v1 = v1 * qs;
                        *(u32x4*)(base + (size_t)row * 1024 + bj * HALF) = pack8(v0, v1);
                    } }
                }
            if (isk) {
#pragma unroll
                for (int bj = 0; bj < 2; ++bj)
#pragma unroll
                    for (int n = 0; n < 2; ++n) { f32x4 v = ks[bj][n]; v += shx(v, 1); v += shx(v, 2); v += shx(v, 4); v += shx(v, 8);
                        if (fr == 0) { float* kp = ksum + (size_t)u.pm * 1024 + (pn & 3) * 256 + bj * HALF + colw + 4 * n;
                            unsafeAtomicAdd(kp + 0, v[0]); unsafeAtomicAdd(kp + 1, v[1]); unsafeAtomicAdd(kp + 2, v[2]); unsafeAtomicAdd(kp + 3, v[3]); } }
            }
        } else {
            const int colg = (pn - 24) * 128 + colw;
            bf16_t* baseR = GAB + colg; bf16_t* baseB = GAB + (size_t)8192 * 2048 + colg;
            const f32x4 ba0 = *(const f32x4*)(gbias + colg), ba1 = *(const f32x4*)(gbias + colg + 4), bb0 = *(const f32x4*)(gbias + 2048 + colg), bb1 = *(const f32x4*)(gbias + 2048 + colg + 4);
#pragma unroll
            for (int ai = 0; ai < 2; ++ai)
#pragma unroll
                for (int m = 0; m < 4; ++m) { const int row = row0 + ai * HALF + m * 16;
                    const f32x4 a0 = sigm4(acc[ai][0][m][0] + ba0), a1 = sigm4(acc[ai][0][m][1] + ba1); f32x4 b0 = sigm4(acc[ai][1][m][0] + bb0), b1 = sigm4(acc[ai][1][m][1] + bb1), r0, r1;
#pragma unroll
                    for (int e = 0; e < 4; ++e) { b0[e] = fmaxf(b0[e], 1e-20f); b1[e] = fmaxf(b1[e], 1e-20f); r0[e] = a0[e] * __builtin_amdgcn_rcpf(b0[e]); r1[e] = a1[e] * __builtin_amdgcn_rcpf(b1[e]); }
                    *(u32x4*)(baseR + (size_t)row * 2048) = pack8(r0, r1); *(u32x4*)(baseB + (size_t)row * 2048) = pack8(b0, b1); }
        }
    }
};
struct EpiMerge2 {
    static constexpr bool PERM = true, AFTER_DRAIN = false, KEEP_SEG0 = true;
    const bf16_t* R; const bf16_t* GB; bf16_t* O;
    __device__ __forceinline__ void operator()(f32x4 (&acc)[2][2][4][2], const Unit& u, int wr, int wc, int fr, int fq) const {
        const int row0 = u.pm * BM + wr * 64 + fr, col0 = u.pn * BM + wc * 32 + 8 * fq;
        const bf16_t* G = u.seg == 0 ? R : GB;
#pragma unroll
        for (int ai = 0; ai < 2; ++ai)
#pragma unroll
            for (int m = 0; m < 4; ++m) { const size_t off = (size_t)(row0 + ai * HALF + m * 16) * 2048 + col0;
#pragma unroll
                for (int bj = 0; bj < 2; ++bj) { const u32x4 g = *(const u32x4*)(G + off + bj * HALF);
                    acc[ai][bj][m][0] = acc[ai][bj][m][0] * bf4lo(g.x, g.y); acc[ai][bj][m][1] = acc[ai][bj][m][1] * bf4lo(g.z, g.w);
                    if (u.seg != 0) *(u32x4*)(O + off + bj * HALF) = pack8(acc[ai][bj][m][0], acc[ai][bj][m][1]); } }
    }
};
struct EpiX1 {
    static constexpr bool PERM = true, AFTER_DRAIN = false, KEEP_SEG0 = false;
    const bf16_t* XH; const float* RMS; bf16_t* X1B; unsigned long long* SS;
    __device__ __forceinline__ void operator()(const f32x4 (&acc)[2][2][4][2], const Unit& u, int wr, int wc, int fr, int fq) const {
        const int row0 = u.pm * BM + wr * 64 + fr, col0 = u.pn * BM + wc * 32 + 8 * fq;
#pragma unroll
        for (int ai = 0; ai < 2; ++ai)
#pragma unroll
            for (int m = 0; m < 4; ++m) { const int row = row0 + ai * HALF + m * 16; const size_t off = (size_t)row * 2048 + col0; float sq = 0.f; const float rm = RMS[row];
#pragma unroll
                for (int bj = 0; bj < 2; ++bj) { const u32x4 hx = *(const u32x4*)(XH + off + bj * HALF); const f32x4 v0 = acc[ai][bj][m][0] + bf4lo(hx.x, hx.y) * rm, v1 = acc[ai][bj][m][1] + bf4lo(hx.z, hx.w) * rm;
                    *(u32x4*)(X1B + off + bj * HALF) = pack8(v0, v1);
                    sq += (v0[0] * v0[0] + v0[1] * v0[1]) + (v0[2] * v0[2] + v0[3] * v0[3]) + (v1[0] * v1[0] + v1[1] * v1[1]) + (v1[2] * v1[2] + v1[3] * v1[3]); }
                sq += __shfl_xor(sq, 16); sq += __shfl_xor(sq, 32);
                if (fq == 0) atomicAdd(SS + row, (unsigned long long)(sq * 4294967296.0f)); }
    }
};
__device__ __forceinline__ float rinv_from_ss(unsigned long long s) { return 1.0f / sqrtf((float)((double)s * (1.0 / 4294967296.0) * (1.0 / 2048.0)) + 1e-6f); }
struct EpiQP {
    static constexpr bool PERM = true, AFTER_DRAIN = false, KEEP_SEG0 = false;
    const unsigned long long* SS; bf16_t* O;
    __device__ __forceinline__ void operator()(const f32x4 (&acc)[2][2][4][2], const Unit& u, int wr, int wc, int fr, int fq) const {
        const int row0 = u.pm * BM + wr * 64 + fr, col0 = u.pn * BM + wc * 32 + 8 * fq;
#pragma unroll
        for (int ai = 0; ai < 2; ++ai)
#pragma unroll
            for (int m = 0; m < 4; ++m) { const int row = row0 + ai * HALF + m * 16; const size_t off = (size_t)row * 2048 + col0; const float rv = rinv_from_ss(SS[row]);
#pragma unroll
                for (int bj = 0; bj < 2; ++bj) *(u32x4*)(O + off + bj * HALF) = pack8(acc[ai][bj][m][0] * rv, acc[ai][bj][m][1] * rv); }
    }
};

template <class Epi, class Sched, bool ALIGN_EPI = false, bool SP2 = false>
__device__ __forceinline__ void gemm_phase(PG8_LAS unsigned char* lds, const Gemm g, const Sched& S, const Epi& E) {
    const int tid = threadIdx.x, wid = __builtin_amdgcn_readfirstlane(tid >> 6), lane = tid & 63, wr = wid >> 2, wc = wid & 3, fr = lane & 15, fq = lane >> 4;
    const int K = g.K, nt = K / BK;
    unsigned voffA[2], voffB[2];
#pragma unroll
    for (int i = 0; i < 2; ++i) { int R, C; stage_rc(tid * 16 + i * 8192, R, C); const int Rb = Epi::PERM ? ((R & ~31) + perm32(R & 31)) : R;
        voffA[i] = (unsigned)(R * K + C) * 2u; voffB[i] = (unsigned)(Rb * K + C) * 2u; }
    const size_t kstep = (size_t)(BK * 2);
    const size_t hstep = (size_t)HALF * K * 2;
    const size_t tstep = 2 * hstep;
    const unsigned ldsw = (unsigned)wid * 1024u;
    const int aoff = lds_byte(wr * 64 + fr, fq * 8), boff = lds_byte(wc * 32 + fr, fq * 8);
#define PG8_SA(b, h) (((b) * 2 + (h)) * HTB)
#define PG8_SB(b, h) ((4 + (b) * 2 + (h)) * HTB)
#define PG8_STAGE(bufoff, gbase, voff) do { _Pragma("unroll") for (int _i = 0; _i < 2; ++_i) \
        __builtin_amdgcn_global_load_lds((const unsigned*)((const char*)(gbase) + (voff)[_i]), (PG8_LAS unsigned*)(lds + (bufoff) + ldsw + _i * 8192), 16, 0, 0); } while (0)
#define PG8_LDA(dst, b, h) do { _Pragma("unroll") for (int m = 0; m < 4; ++m) _Pragma("unroll") for (int k = 0; k < 2; ++k) dst[m][k] = *(const PG8_LAS bf16x8*)(lds + PG8_SA(b, h) + aoff + m * 2048 + k * 1024); } while (0)
#define PG8_LDB(dst, b, h) do { _Pragma("unroll") for (int n = 0; n < 2; ++n) _Pragma("unroll") for (int k = 0; k < 2; ++k) dst[n][k] = *(const PG8_LAS bf16x8*)(lds + PG8_SB(b, h) + boff + n * 2048 + k * 1024); } while (0)
#define PG8_MMA(ai, bj, At, Bt) do { __builtin_amdgcn_s_setprio(1); _Pragma("unroll") for (int m = 0; m < 4; ++m) _Pragma("unroll") for (int n = 0; n < 2; ++n) _Pragma("unroll") for (int k = 0; k < 2; ++k) \
        acc[ai][bj][m][n] = __builtin_amdgcn_mfma_f32_16x16x32_bf16(Bt[n][k], At[m][k], acc[ai][bj][m][n], 0, 0, 0); __builtin_amdgcn_s_setprio(0); } while (0)
#define PG8_WAIT_V(n) asm volatile("s_waitcnt vmcnt(" #n ")" ::: "memory")
#define PG8_WAIT_L(n) asm volatile("s_waitcnt lgkmcnt(" #n ")" ::: "memory")
#define PG8_BAR __builtin_amdgcn_s_barrier()
#define PG8_SCHED __builtin_amdgcn_sched_barrier(0)
    Unit cur, nxt; int ui = 0;
    if (!S.next(0, cur)) return;
    f32x4 acc[2][2][4][2];
#pragma unroll
    for (int a = 0; a < 2; ++a)
#pragma unroll
        for (int b = 0; b < 2; ++b)
#pragma unroll
            for (int m = 0; m < 4; ++m)
#pragma unroll
                for (int n = 0; n < 2; ++n) acc[a][b][m][n] = (f32x4){0.f, 0.f, 0.f, 0.f};
    bf16x8 At[4][2], B0[2][2], B1[2][2];
    const char* cA = (const char*)(cur.seg ? g.A2 : g.A) + (size_t)cur.pm * tstep; const char* cB = (const char*)(cur.seg ? g.Bt2 : g.Bt) + (size_t)cur.pn * tstep;
    S.a_ready(cur);
    if constexpr (SP2) {
        PG8_STAGE(PG8_SB(0, 0), cB, voffB); PG8_STAGE(PG8_SB(0, 1), cB + hstep, voffB); PG8_STAGE(PG8_SA(0, 0), cA, voffA); PG8_STAGE(PG8_SA(0, 1), cA + hstep, voffA);
        if (wr == 1) PG8_BAR;
        PG8_WAIT_V(2); PG8_BAR;
        PG8_STAGE(PG8_SB(1, 0), cB + kstep, voffB); PG8_STAGE(PG8_SA(1, 0), cA + kstep, voffA); PG8_STAGE(PG8_SB(1, 1), cB + hstep + kstep, voffB);
        PG8_WAIT_V(6); PG8_BAR;
    } else {
        PG8_STAGE(PG8_SB(0, 0), cB, voffB); PG8_STAGE(PG8_SA(0, 0), cA, voffA); PG8_STAGE(PG8_SB(0, 1), cB + hstep, voffB); PG8_STAGE(PG8_SA(0, 1), cA + hstep, voffA);
        if (wr == 1) PG8_BAR;
        PG8_WAIT_V(4); PG8_BAR;
        PG8_STAGE(PG8_SB(1, 0), cB + kstep, voffB); PG8_STAGE(PG8_SA(1, 0), cA + kstep, voffA); PG8_STAGE(PG8_SB(1, 1), cB + hstep + kstep, voffB);
        PG8_WAIT_V(6); PG8_BAR;
    }
    for (;;) {
        const bool has_next = S.next(ui + 1, nxt);
        const char* nA = has_next ? (const char*)(nxt.seg ? g.A2 : g.A) + (size_t)nxt.pm * tstep : cA; const char* nB = has_next ? (const char*)(nxt.seg ? g.Bt2 : g.Bt) + (size_t)nxt.pn * tstep : cB;
        for (int t = 0; t < nt; t += 2) {
            const bool last = (t == nt - 2);
            const char* a1 = cA + (size_t)(t + 1) * kstep;
            const char* a2 = last ? nA : cA + (size_t)(t + 2) * kstep; const char* b2 = last ? nB : cB + (size_t)(t + 2) * kstep;
            const char* a3 = a2 + kstep; const char* b3 = b2 + kstep;
            if (last && has_next) S.a_ready(nxt);
            if constexpr (SP2) {
            PG8_LDB(B0, 0, 0); PG8_LDB(B1, 0, 1); PG8_SCHED; PG8_LDA(At, 0, 0); PG8_STAGE(PG8_SA(1, 1), a1 + hstep, voffA);
            PG8_WAIT_V(8); PG8_WAIT_L(0); PG8_BAR; PG8_MMA(0, 0, At, B0); PG8_MMA(0, 1, At, B1); PG8_BAR; PG8_SCHED;
            PG8_LDA(At, 0, 1); PG8_STAGE(PG8_SB(0, 0), b2, voffB); PG8_STAGE(PG8_SB(0, 1), b2 + hstep, voffB); PG8_STAGE(PG8_SA(0, 0), a2, voffA);
            PG8_WAIT_V(8); PG8_WAIT_L(0); PG8_BAR; PG8_MMA(1, 0, At, B0); PG8_MMA(1, 1, At, B1); PG8_BAR; PG8_SCHED;
            PG8_LDB(B0, 1, 0); PG8_LDB(B1, 1, 1); PG8_SCHED; PG8_LDA(At, 1, 0); PG8_STAGE(PG8_SA(0, 1), a2 + hstep, voffA);
            PG8_WAIT_V(8); PG8_WAIT_L(0); PG8_BAR; PG8_MMA(0, 0, At, B0); PG8_MMA(0, 1, At, B1); PG8_BAR; PG8_SCHED;
            PG8_LDA(At, 1, 1); PG8_STAGE(PG8_SB(1, 0), b3, voffB); PG8_STAGE(PG8_SB(1, 1), b3 + hstep, voffB); PG8_STAGE(PG8_SA(1, 0), a3, voffA);
            PG8_WAIT_V(8); PG8_WAIT_L(0); PG8_BAR; PG8_MMA(1, 0, At, B0); PG8_MMA(1, 1, At, B1); PG8_BAR; PG8_SCHED;
            } else {
            PG8_LDB(B0, 0, 0); PG8_SCHED; PG8_LDA(At, 0, 0); PG8_STAGE(PG8_SA(1, 1), a1 + hstep, voffA);
            PG8_WAIT_L(8); PG8_BAR; PG8_WAIT_L(0); PG8_MMA(0, 0, At, B0); PG8_BAR; PG8_SCHED;
            PG8_LDB(B1, 0, 1); PG8_STAGE(PG8_SB(0, 0), b2, voffB);
            PG8_BAR; PG8_WAIT_L(0); PG8_MMA(0, 1, At, B1); PG8_BAR;
            PG8_LDA(At, 0, 1); PG8_STAGE(PG8_SA(0, 0), a2, voffA);
            PG8_BAR; PG8_WAIT_L(0); PG8_MMA(1, 0, At, B0); PG8_BAR; PG8_SCHED;
            PG8_STAGE(PG8_SB(0, 1), b2 + hstep, voffB);
            PG8_WAIT_V(6); PG8_BAR; PG8_MMA(1, 1, At, B1); PG8_BAR;
            PG8_LDB(B0, 1, 0); PG8_SCHED; PG8_LDA(At, 1, 0); PG8_STAGE(PG8_SA(0, 1), a2 + hstep, voffA);
            PG8_WAIT_L(8); PG8_BAR; PG8_WAIT_L(0); PG8_MMA(0, 0, At, B0); PG8_BAR; PG8_SCHED;
            PG8_LDB(B1, 1, 1); PG8_STAGE(PG8_SB(1, 0), b3, voffB);
            PG8_BAR; PG8_WAIT_L(0); PG8_MMA(0, 1, At, B1); PG8_BAR;
            PG8_LDA(At, 1, 1); PG8_STAGE(PG8_SA(1, 0), a3, voffA);
            PG8_BAR; PG8_WAIT_L(0); PG8_MMA(1, 0, At, B0); PG8_BAR; PG8_SCHED;
            PG8_STAGE(PG8_SB(1, 1), b3 + hstep, voffB);
            PG8_WAIT_V(6); PG8_BAR; PG8_MMA(1, 1, At, B1); PG8_BAR;
            }
        }
        if constexpr (ALIGN_EPI) { if (wr == 0) PG8_BAR; }
        if constexpr (!Epi::AFTER_DRAIN) { E(acc, cur, wr, wc, fr, fq); S.done(cur); }
        if (!has_next) break;
        if (!(Epi::KEEP_SEG0 && cur.seg == 0)) {
#pragma unroll
        for (int a = 0; a < 2; ++a)
#pragma unroll
            for (int b = 0; b < 2; ++b)
#pragma unroll
                for (int m = 0; m < 4; ++m)
#pragma unroll
                    for (int n = 0; n < 2; ++n) acc[a][b][m][n] = (f32x4){0.f, 0.f, 0.f, 0.f};
        }
        cur = nxt; cA = nA; cB = nB; ++ui;
        if constexpr (ALIGN_EPI) { if (wr == 1) PG8_BAR; }
    }
    PG8_WAIT_V(0);
    if constexpr (!ALIGN_EPI) { if (wr == 0) PG8_BAR; }
    PG8_BAR;
    if constexpr (Epi::AFTER_DRAIN) { E.fused(acc, cur, wr, wc, fr, fq, lds, wid, lane); S.done(cur); }
#undef PG8_SA
#undef PG8_SB
#undef PG8_STAGE
#undef PG8_LDA
#undef PG8_LDB
#undef PG8_MMA
#undef PG8_WAIT_V
#undef PG8_WAIT_L
#undef PG8_BAR
#undef PG8_SCHED
}
}

constexpr int NWAVES = 8;
#ifndef MK_N_LAUNCHES
#define MK_N_LAUNCHES 1
#endif
constexpr int PER_PHASE = 9;
#ifndef MK_REP_PHASE
#define MK_REP_PHASE -1
#endif
#define NREP(k) (((k) == MK_REP_PHASE) ? 2 : 1)
constexpr int N_LAUNCHES = MK_N_LAUNCHES;
constexpr int M = 8192, SEQ = 4096, DM = 2048, INW = 10240, NEXP = 16384;
constexpr float RMS_EPS = 1e-6f;
constexpr size_t MiB = 1u << 20;
constexpr size_t WS_CTL = 0, CTL_ZERO_BYTES = 64 * 1024;
constexpr size_t WS_SS = 256 * 1024, WS_KSUM = 512 * 1024;
constexpr size_t WS_WIN = 2 * MiB, WS_WBC = 42 * MiB, WS_WBA = 46 * MiB, WS_WOUT = 50 * MiB, WS_WPQ = 58 * MiB, WS_KEYS = 66 * MiB, WS_CS = 67 * MiB;
constexpr size_t WS_RMS = 68 * MiB;
constexpr size_t WS_UB = 70 * MiB, WS_VB = 102 * MiB;
constexpr size_t WS_XB = 198 * MiB;
constexpr size_t WS_T6 = 230 * MiB;
constexpr size_t WS_GAB = 326 * MiB;
constexpr size_t WS_UC = 390 * MiB, WS_AO = 406 * MiB;
constexpr size_t WS_EXP = 422 * MiB, WS_GATE = 426 * MiB;
constexpr size_t WS_END = 430 * MiB;
constexpr size_t WS_TMP = WS_XB, WS_MB = WS_T6, WS_X1B = WS_T6 + 48 * MiB, WS_QP = WS_GAB;
constexpr int CW_BAR = 4096;
constexpr int RING_OFF = 0, RING_BYTES = 131072;
constexpr int LDSCTL_OFF = RING_BYTES, MISC_OFF = LDSCTL_OFF + 320;
constexpr int LDS_BYTES = 147456;

#define GAS __attribute__((address_space(1)))
#define LAS __attribute__((address_space(3)))
typedef unsigned short bf16;
typedef unsigned v4u __attribute__((ext_vector_type(4)));
typedef float f32x4 __attribute__((ext_vector_type(4)));
typedef short bf16x8 __attribute__((ext_vector_type(8)));
typedef GAS unsigned gu32;
typedef GAS unsigned long long gu64;
#define RLX_AGENT __ATOMIC_RELAXED, __HIP_MEMORY_SCOPE_AGENT
#define LDS_WAIT() asm volatile("s_waitcnt lgkmcnt(0)" ::: "memory")
#define VM_WAIT() asm volatile("s_waitcnt vmcnt(0)" ::: "memory")
__device__ __forceinline__ unsigned long long rt() { return __builtin_amdgcn_s_memrealtime(); }
__device__ __forceinline__ unsigned f2bf(float f) { unsigned u = __builtin_bit_cast(unsigned, f); return (u + 0x7fffu + ((u >> 16) & 1u)) >> 16; }
__device__ __forceinline__ unsigned pk2(float lo, float hi) { return f2bf(lo) | (f2bf(hi) << 16); }

#define XB_TMO      128
#define XB_XCNT(j)  (256  + 64 * (j))
#define XB_XSUB(j)  (1280 + 64 * (j))
#define XB_XGEN(j)  (2304 + 64 * (j))
#define XB_TOP      3328
#define XB_TOPGEN   3392
#define XCD_BAR_WORDS 3456
#define XB_SPIN_CAP (1u << 18)

__device__ __forceinline__ unsigned xb_ld(unsigned* p)              { return __hip_atomic_load(p, __ATOMIC_RELAXED, __HIP_MEMORY_SCOPE_AGENT); }
__device__ __forceinline__ unsigned xb_add(unsigned* p, unsigned v) { return __hip_atomic_fetch_add(p, v, __ATOMIC_RELAXED, __HIP_MEMORY_SCOPE_AGENT); }
__device__ __forceinline__ unsigned xb_xcc_id() { return (unsigned)__builtin_amdgcn_s_getreg((3 << 11) | 20) & 0xFu; }
#define XB_SPIN(cond, bar) do { unsigned _sp = 0; while (cond) { __builtin_amdgcn_s_sleep(1); \
    if ((++_sp & 255u) == 0u) { if (xb_ld(&(bar)[XB_TMO])) break; if (_sp > XB_SPIN_CAP) { atomicAdd(&(bar)[XB_TMO], 1u); break; } } } } while (0)

struct XcdBarrier {
    unsigned* bar; unsigned x;
    volatile LAS unsigned* st;
};

__device__ __forceinline__ XcdBarrier xcd_barrier_post(unsigned* bar, volatile LAS unsigned* st) {
    XcdBarrier b; b.bar = bar; b.x = xb_xcc_id(); b.st = st;
    if (threadIdx.x == 0) (void)xb_add(&bar[XB_XCNT(b.x)], 1u);
    return b;
}
__device__ __forceinline__ void xcd_barrier_complete(unsigned* bar, unsigned x, unsigned& nloc, unsigned& nx) {
    const unsigned G = gridDim.x * gridDim.y * gridDim.z;
    unsigned sum, cnt, mine, sp = 0u;
    for (;;) {
        sum = 0u; cnt = 0u; mine = 0u;
#pragma unroll
        for (unsigned j = 0; j < 16; ++j) { const unsigned c = xb_ld(&bar[XB_XCNT(j)]); sum += c; cnt += (c > 0u) ? 1u : 0u; mine = (j == x) ? c : mine; }
        if (sum == G) break;
        __builtin_amdgcn_s_sleep(1);
        if ((++sp & 255u) == 0u) { if (xb_ld(&bar[XB_TMO])) break; if (sp > XB_SPIN_CAP) { atomicAdd(&bar[XB_TMO], 1u); break; } }
    }
    nloc = mine > 0u ? mine : 1u; nx = cnt > 0u ? cnt : 1u;
}

struct Ctx { LAS unsigned char* lds; int tid, lane, wave, vcu, G; };
struct BarWork { const float* pu; const float* pv; const float* g2; unsigned char* ws; int part, nparts; };
__device__ __forceinline__ void convert_tables(const Ctx& F, const float* pu, const float* pv, const float* g2, unsigned char* ws, int part, int nparts, int w0);
__device__ __forceinline__ void xcd_barrier(const XcdBarrier& b, const Ctx* F = nullptr, const BarWork* wk = nullptr) {
    asm volatile("s_waitcnt vmcnt(0)" ::: "memory");
    __syncthreads();
    if (wk && wk->part >= 0) convert_tables(*F, wk->pu, wk->pv, wk->g2, wk->ws, wk->part, wk->nparts, 1);
    if (threadIdx.x == 0) {
        unsigned* bar = b.bar;
        __builtin_amdgcn_s_waitcnt(0);
        unsigned nloc = b.st[0], nx = b.st[1];
        if (nloc == 0u) { xcd_barrier_complete(bar, b.x, nloc, nx); b.st[0] = nloc; b.st[1] = nx; }
        const unsigned old = xb_add(&bar[XB_XSUB(b.x)], 1u);
        const unsigned gen = old / nloc;
        if (old + 1u == (gen + 1u) * nloc) {
            __builtin_amdgcn_fence(__ATOMIC_RELEASE, "agent");
            asm volatile("s_waitcnt vmcnt(0)" ::: "memory");
            const unsigned og = xb_add(&bar[XB_TOP], 1u);
            const unsigned tg = og / nx;
            if (og + 1u == (tg + 1u) * nx) xb_add(&bar[XB_TOPGEN], 1u);
            else XB_SPIN(xb_ld(&bar[XB_TOPGEN]) == tg, bar);
            __builtin_amdgcn_fence(__ATOMIC_ACQUIRE, "agent");
            xb_add(&bar[XB_XGEN(b.x)], 1u);
            asm volatile("s_waitcnt vmcnt(0)" ::: "memory");
        } else {
            XB_SPIN(xb_ld(&bar[XB_XGEN(b.x)]) == gen, bar);
            __builtin_amdgcn_fence(__ATOMIC_ACQUIRE, "agent");
            asm volatile("s_waitcnt vmcnt(0)" ::: "memory");
        }
    }
    __syncthreads();
}

typedef __bf16 bf16x2v __attribute__((ext_vector_type(2)));
typedef float f32x16 __attribute__((ext_vector_type(16)));
__device__ __forceinline__ float bflo(unsigned w) { return __uint_as_float(w << 16); }
__device__ __forceinline__ float bfhi(unsigned w) { return __uint_as_float(w & 0xffff0000u); }
__device__ __forceinline__ float dot2bf(unsigned a, unsigned b, float c) { return __builtin_amdgcn_fdot2_f32_bf16(__builtin_bit_cast(bf16x2v, a), __builtin_bit_cast(bf16x2v, b), c, false); }
__device__ __forceinline__ float wave_sum(float v) {
#pragma unroll
    for (int o = 1; o < 64; o <<= 1) v += __shfl_xor(v, o);
    return v; }
__device__ __forceinline__ float wave_max(float v) {
#pragma unroll
    for (int o = 1; o < 64; o <<= 1) v = fmaxf(v, __shfl_xor(v, o));
    return v; }
__device__ __forceinline__ float rdlane(float v, int l) { return __int_as_float(__builtin_amdgcn_readlane(__float_as_int(v), l)); }
__device__ __forceinline__ float gelu_tanh(float x) { const float z = 0.7978845608028654f * (x + 0.044715f * x * x * x); const float e = __expf(2.0f * z); const float th = 1.0f - 2.0f * __builtin_amdgcn_rcpf(1.0f + e); return 0.5f * x * (1.0f + th); }


struct TItem { const float* W; bf16* WT; const float* gk; int K, N, k0, n0, dn0; };
__device__ __forceinline__ TItem p0_titem(const float* W, int K, int N, bf16* WT, const float* gk, int item, bool remap) {
    const int nblk = N / 32, kb = item / nblk, nb = item % nblk, k0 = 64 * kb, n0 = 32 * nb;
    int dn0 = n0; if (remap && n0 >= 1024 && n0 < 3072) { const int c = (n0 - 1024) & 1023, isx = (n0 >= 2048); dn0 = 1024 + (c >> 7) * 256 + isx * 128 + (c & 127); }
    if (remap && n0 >= 6144) { const int c = (n0 - 6144) & 2047, isb = (n0 >= 8192); dn0 = 6144 + (c >> 7) * 256 + isb * 128 + (c & 127); }
    return TItem{W, WT, gk, K, N, k0, n0, dn0};
}
__device__ __forceinline__ void p0_tload(const TItem& t, f32x4 (&v)[8], int lane) {
#pragma unroll
    for (int i = 0; i < 8; ++i) { const int kk = 8 * i + (lane >> 3), nn = 4 * (lane & 7); v[i] = *(const GAS f32x4*)(t.W + (size_t)(t.k0 + kk) * t.N + t.n0 + nn); if (t.gk) v[i] = v[i] * t.gk[t.k0 + kk]; }
}
__device__ __forceinline__ void p0_tfinish(const TItem& t, const f32x4 (&v)[8], LAS float* scr, int lane) {
#pragma unroll
    for (int i = 0; i < 8; ++i) { const int kk = 8 * i + (lane >> 3), nn = 4 * (lane & 7); scr[kk * 33 + nn] = v[i][0]; scr[kk * 33 + nn + 1] = v[i][1]; scr[kk * 33 + nn + 2] = v[i][2]; scr[kk * 33 + nn + 3] = v[i][3]; }
    LDS_WAIT(); asm volatile("" ::: "memory");
    const int c = lane & 7;
#pragma unroll
    for (int j = 0; j < 4; ++j) { const int n = (lane >> 3) + 8 * j; const LAS float* s = scr + (8 * c) * 33 + n;
        v4u o; o.x = pk2(s[0 * 33], s[1 * 33]); o.y = pk2(s[2 * 33], s[3 * 33]); o.z = pk2(s[4 * 33], s[5 * 33]); o.w = pk2(s[6 * 33], s[7 * 33]);
        *(GAS v4u*)(t.WT + (size_t)(t.dn0 + n) * t.K + t.k0 + 8 * c) = o; }
    LDS_WAIT(); asm volatile("" ::: "memory");
}
__device__ __forceinline__ void convert_tables(const Ctx& F, const float* pu, const float* pv, const float* g2, unsigned char* ws, int part, int nparts, int w0) {
    if (F.wave < w0) return;
    const int nw = NWAVES - w0, gt = (F.vcu * nw + (F.wave - w0)) * 64 + F.lane, NT = F.G * nw * 64;
    const int per = (NEXP * 2048 / 16) / nparts, lo = part * per, hi = lo + per;
    for (int i = lo + gt; i < hi; i += NT) { const int c16 = (i & 127) * 16; v4u ou, ov;
#pragma unroll
        for (int q = 0; q < 4; ++q) { f32x4 a = ((const GAS f32x4*)pu)[4 * i + q]; a = a * *(const GAS f32x4*)(g2 + c16 + 4 * q) * 512.0f; const f32x4 b = ((const GAS f32x4*)pv)[4 * i + q] * 32.0f;
            int wu = 0, wv = 0; wu = __builtin_amdgcn_cvt_pk_fp8_f32(a[0], a[1], wu, false); wu = __builtin_amdgcn_cvt_pk_fp8_f32(a[2], a[3], wu, true);
            wv = __builtin_amdgcn_cvt_pk_fp8_f32(b[0], b[1], wv, false); wv = __builtin_amdgcn_cvt_pk_fp8_f32(b[2], b[3], wv, true); ou[q] = (unsigned)wu; ov[q] = (unsigned)wv; }
        ((GAS v4u*)(ws + WS_UB))[i] = ou; ((GAS v4u*)(ws + WS_VB))[i] = ov; }
}
__device__ __forceinline__ void p0_prologue(const Ctx& F, const float* const* in, unsigned char* ws, const double* invf) {
    const float* x = in[0]; const int* pos = (const int*)in[1]; const float* g1 = in[2]; const float* w_in = in[3];
    const float* w_bc = in[6]; const float* w_ba = in[7]; const float* w_out = in[8]; const float* g2 = in[9]; const float* w_pq = in[10];
    const float* keys = in[11]; const float* pu = in[12]; const float* pv = in[13];
    LAS float* scr = (LAS float*)(F.lds + RING_OFF + F.wave * 16384);
    const int gw = F.vcu * NWAVES + F.wave, NGW = F.G * NWAVES;
    const int gt = gw * 64 + F.lane, NT = NGW * 64;
    for (int i = gt; i < 8192; i += NT) ((GAS unsigned long long*)(ws + WS_SS))[i] = 0ull;
    for (int i = gt; i < 32 * 1024; i += NT) ((GAS float*)(ws + WS_KSUM))[i] = 0.f;
    constexpr int I_IN = 32 * 320, I_BC = 16 * 64, I_OUT = 32 * 64;
    constexpr int NITEMS = I_IN + 2 * I_BC + 2 * I_OUT;
    auto decode = [&](int it) -> TItem { int r = it;
        if (r < I_IN) return p0_titem(w_in, 2048, INW, (bf16*)(ws + WS_WIN), g1, r, true); r -= I_IN;
        if (r < I_BC) return p0_titem(w_bc, 1024, 2048, (bf16*)(ws + WS_WBC), nullptr, r, false); r -= I_BC;
        if (r < I_BC) return p0_titem(w_ba, 1024, 2048, (bf16*)(ws + WS_WBA), nullptr, r, false); r -= I_BC;
        if (r < I_OUT) return p0_titem(w_out, 2048, 2048, (bf16*)(ws + WS_WOUT), nullptr, r, false); r -= I_OUT;
        return p0_titem(w_pq, 2048, 2048, (bf16*)(ws + WS_WPQ), g2, r, false); };
    {
        int it = gw; TItem A, B; f32x4 va[8], vb[8];
        bool hasA = it < NITEMS; if (hasA) { A = decode(it); p0_tload(A, va, F.lane); }
        while (hasA) {
            const int it2 = it + NGW; const bool hasB = it2 < NITEMS; if (hasB) { B = decode(it2); p0_tload(B, vb, F.lane); }
            p0_tfinish(A, va, scr, F.lane);
            if (!hasB) break;
            const int it3 = it2 + NGW; hasA = it3 < NITEMS; if (hasA) { A = decode(it3); p0_tload(A, va, F.lane); }
            p0_tfinish(B, vb, scr, F.lane);
            it = it3;
        }
    }
    for (int i = gt; i < 16 * 128 * 128 / 8; i += NT) { const f32x4 a = ((const GAS f32x4*)keys)[2 * i], b = ((const GAS f32x4*)keys)[2 * i + 1];
        v4u o; o.x = pk2(a[0], a[1]); o.y = pk2(a[2], a[3]); o.z = pk2(b[0], b[1]); o.w = pk2(b[2], b[3]); ((GAS v4u*)(ws + WS_KEYS))[i] = o; }
    for (int m = gw; m < M; m += NGW) { const GAS f32x4* xr = (const GAS f32x4*)(x + (size_t)m * DM);
        f32x4 v[8]; float s = 0.f;
#pragma unroll
        for (int i = 0; i < 4; ++i) { v[2 * i] = xr[i * 128 + 2 * F.lane]; v[2 * i + 1] = xr[i * 128 + 2 * F.lane + 1]; }
#pragma unroll
        for (int i = 0; i < 8; ++i) s += (v[i][0] * v[i][0] + v[i][1] * v[i][1]) + (v[i][2] * v[i][2] + v[i][3] * v[i][3]);
        const float rms = sqrtf(wave_sum(s) * (1.0f / DM) + RMS_EPS), rinv = 1.0f / rms;
        if (F.lane == 0) ((GAS float*)(ws + WS_RMS))[m] = rms;
        GAS v4u* o = (GAS v4u*)(ws + WS_XB + (size_t)m * DM * 2);
#pragma unroll
        for (int i = 0; i < 4; ++i) { const f32x4 a = v[2 * i] * rinv, b = v[2 * i + 1] * rinv; v4u w; w.x = pk2(a[0], a[1]); w.y = pk2(a[2], a[3]); w.z = pk2(b[0], b[1]); w.w = pk2(b[2], b[3]); o[i * 64 + F.lane] = w; } }
    for (int i = gt; i < M * 16; i += NT) { const int row = i >> 4, f = i & 15; const double ang = (double)pos[row] * invf[f];
        const double k = __builtin_rint(ang * 0.15915494309189535); const float r = (float)(ang - k * 6.283185307179586);
        float* cs = (float*)(ws + WS_CS); cs[row * 32 + f] = __cosf(r); cs[row * 32 + 16 + f] = __sinf(r); }
}

__device__ __forceinline__ void attn_simple(const Ctx& F, const bf16* Q, const bf16* K, const bf16* V, const float* ksum, bf16* AO) {
    LAS float* qf = (LAS float*)(F.lds + RING_OFF + F.wave * 512);
    const int gw = F.vcu * NWAVES + F.wave, NGW = F.G * NWAVES, lane = F.lane;
    for (int item = gw; item < 16 * SEQ; item += NGW) {
        const int bh = item >> 12, t = item & 4095, b = bh >> 3, h = bh & 7, blk = t >> 8;
        const size_t row = (size_t)b * SEQ + t;
        { const unsigned qq = *(const GAS unsigned*)(Q + row * 1024 + h * 128 + 2 * lane); qf[2 * lane] = bflo(qq); qf[2 * lane + 1] = bfhi(qq); }
        LDS_WAIT(); asm volatile("" ::: "memory");
        float g = -INFINITY;
        if (lane < blk) { const GAS f32x4* km = (const GAS f32x4*)(ksum + (size_t)(b * 16 + lane) * 1024 + h * 128); float a = 0.f;
            for (int d = 0; d < 32; ++d) { const f32x4 kv = km[d]; const f32x4 qv = *(const LAS f32x4*)(qf + 4 * d); a += (kv[0] * qv[0] + kv[1] * qv[1]) + (kv[2] * qv[2] + kv[3] * qv[3]); }
            g = a; }
        int sel[3];
#pragma unroll
        for (int i = 0; i < 3; ++i) { const float mx = wave_max(g); const unsigned long long bal = __ballot(g == mx && lane < blk); const int idx = bal ? (__ffsll((long long)bal) - 1) : 0; sel[i] = idx; if (lane == idx) g = -INFINITY; }
        const int nsel = blk < 3 ? blk : 3;
        float sc[4][4]; float mx = -INFINITY;
#pragma unroll
        for (int slot = 0; slot < 4; ++slot) {
            const bool valid = (slot == 3) || (slot < nsel);
            const int kb = (slot == 3) ? blk : sel[slot < 3 ? slot : 0];
#pragma unroll
            for (int r = 0; r < 4; ++r) {
                float s = -INFINITY; const int key0 = kb * 256 + r * 64;
                if (valid && (slot < 3 || key0 <= t)) {
                    const int key = key0 + lane; const GAS v4u* kp = (const GAS v4u*)(K + ((size_t)b * SEQ + key) * 1024 + h * 128); float a = 0.f;
#pragma unroll 4
                    for (int d = 0; d < 16; ++d) { const v4u kk = kp[d]; const f32x4 q0 = *(const LAS f32x4*)(qf + 8 * d), q1 = *(const LAS f32x4*)(qf + 8 * d + 4);
                        a += (bflo(kk.x) * q0[0] + bfhi(kk.x) * q0[1]) + (bflo(kk.y) * q0[2] + bfhi(kk.y) * q0[3]) + (bflo(kk.z) * q1[0] + bfhi(kk.z) * q1[1]) + (bflo(kk.w) * q1[2] + bfhi(kk.w) * q1[3]); }
                    s = (slot < 3 || key <= t) ? a : -INFINITY; }
                sc[slot][r] = s; mx = fmaxf(mx, s); } }
        mx = wave_max(mx);
        float sum = 0.f;
#pragma unroll
        for (int slot = 0; slot < 4; ++slot)
#pragma unroll
            for (int r = 0; r < 4; ++r) { sc[slot][r] = exp2f(sc[slot][r] - mx); sum += sc[slot][r]; }
        sum = wave_sum(sum);
        float o0 = 0.f, o1 = 0.f;
#pragma unroll
        for (int slot = 0; slot < 4; ++slot) {
            const bool valid = (slot == 3) || (slot < nsel);
            const int kb = (slot == 3) ? blk : sel[slot < 3 ? slot : 0];
#pragma unroll
            for (int r = 0; r < 4; ++r) { const int key0 = kb * 256 + r * 64;
                if (valid && (slot < 3 || key0 <= t)) { const float pr = sc[slot][r]; const GAS unsigned* vp = (const GAS unsigned*)(V + ((size_t)b * SEQ + key0) * 1024 + h * 128) + lane;
                    for (int kk = 0; kk < 64; ++kk) { const float pk = rdlane(pr, kk); const unsigned vv = vp[(size_t)kk * 512]; o0 += pk * bflo(vv); o1 += pk * bfhi(vv); } } } }
        const float ri = 1.0f / sum;
        *(GAS unsigned*)(AO + row * 1024 + h * 128 + 2 * lane) = pk2(o0 * ri, o1 * ri);
    }
}
typedef short v4i16_t __attribute__((ext_vector_type(4))); typedef unsigned u32x2v __attribute__((ext_vector_type(2)));
__device__ __forceinline__ v4i16_t vtr16(unsigned addr) { return __builtin_amdgcn_ds_read_tr16_b64_v4i16((LAS v4i16_t*)(uintptr_t)addr); }
__device__ __forceinline__ int crow16(int r, int hh) { return (r & 3) + 8 * (r >> 2) + 4 * hh; }
__device__ __forceinline__ void attn_dma_step(const bf16* K, const bf16* V, LAS unsigned char* lds, int b, int h, int qb, int n_own, int st, int buf, int wave, int lane) {
#pragma unroll
    for (int img = 0; img < 4; ++img) {
        const int T = 2 * st + (img >> 1); const bool isV = img & 1;
        const int blk = (T < n_own) ? qb : ((T - n_own) >> 2), kt = (T < n_own) ? T : ((T - n_own) & 3);
        const bf16* base = (isV ? V : K) + ((size_t)b * SEQ + 256 * blk + 64 * kt) * 1024 + h * 128;
#pragma unroll
        for (int i = 0; i < 2; ++i) { const int pc = wave + 8 * i, row = 4 * pc + (lane >> 4), cp = lane & 15;
            const int c = isV ? ((((cp >> 2) ^ (row & 3)) << 2) | (cp & 3)) : (cp ^ (row & 15));
            __builtin_amdgcn_global_load_lds((const unsigned*)(base + (size_t)row * 1024 + 8 * c), (LAS unsigned*)(lds + buf * 65536 + img * 16384 + pc * 1024), 16, 0, 0); }
    }
}
__device__ __forceinline__ void attn_mfma(const Ctx& F, const bf16* Q, const bf16* K, const bf16* V, const float* ksum, bf16* AO) {
    const int lane = F.lane, wave = F.wave, q31 = lane & 31, hh = lane >> 5, wq = wave & 3, kvh = wave >> 2, l16 = lane & 15, G4 = lane >> 4;
    LAS unsigned char* lds = F.lds + RING_OFF;
    const unsigned lds0 = (unsigned)(uintptr_t)lds;
    for (int pr = F.vcu; pr < 256; pr += F.G)
#pragma unroll 1
    for (int pi = 0; pi < 2; ++pi) {
        const int bh = pr >> 4, s_ = pr & 15, u128 = pi ? 31 - s_ : s_, b = bh >> 3, h = bh & 7, qb = u128 >> 1, half = u128 & 1;
        const int n_own = half ? 4 : 2, nstep = (n_own + 4 * qb) >> 1;
        const size_t rowq = (size_t)b * SEQ + 256 * qb + 128 * half + 32 * wq + q31;
        asm volatile("s_waitcnt vmcnt(0) lgkmcnt(0)" ::: "memory"); __builtin_amdgcn_s_barrier(); asm volatile("" ::: "memory");
        attn_dma_step(K, V, lds, b, h, qb, n_own, 0, 0, wave, lane);
        bf16x8 qf[8];
#pragma unroll
        for (int s = 0; s < 8; ++s) qf[s] = *(const GAS bf16x8*)(Q + rowq * 1024 + h * 128 + 16 * s + 8 * hh);
        unsigned selmask;
        {
            f32x16 gt;
#pragma unroll
            for (int r = 0; r < 16; ++r) gt[r] = 0.f;
            const int jr = lane & 31; const bool jv = jr < qb;
            const GAS f32x4* kp = (const GAS f32x4*)(ksum + (size_t)(b * 16 + (jv ? jr : 0)) * 1024 + h * 128 + 8 * hh);
            f32x4 kf[16];
#pragma unroll
            for (int s = 0; s < 8; ++s) { kf[2 * s] = kp[4 * s]; kf[2 * s + 1] = kp[4 * s + 1]; }
#pragma unroll
            for (int s = 0; s < 8; ++s) { v4u w = pg8::pack8(kf[2 * s], kf[2 * s + 1]); if (!jv) { w.x = 0u; w.y = 0u; w.z = 0u; w.w = 0u; }
                gt = __builtin_amdgcn_mfma_f32_32x32x16_bf16(__builtin_bit_cast(bf16x8, w), qf[s], gt, 0, 0, 0); }
            float g16[16];
#pragma unroll
            for (int r = 0; r < 8; ++r) { const auto rr = __builtin_amdgcn_permlane32_swap(__float_as_uint(gt[r]), __float_as_uint(gt[r]), false, false);
                g16[(r & 3) + 8 * (r >> 2)] = __uint_as_float(rr[0]); g16[(r & 3) + 8 * (r >> 2) + 4] = __uint_as_float(rr[1]); }
            float v0 = -INFINITY, v1 = -INFINITY, v2 = -INFINITY; int i0 = 0, i1 = 0, i2 = 0;
#pragma unroll
            for (int j = 0; j < 16; ++j) { const float a = (j < qb) ? g16[j] : -INFINITY;
                if (a > v0) { v2 = v1; i2 = i1; v1 = v0; i1 = i0; v0 = a; i0 = j; } else if (a > v1) { v2 = v1; i2 = i1; v1 = a; i1 = j; } else if (a > v2) { v2 = a; i2 = j; } }
            selmask = (qb <= 3) ? ((1u << qb) - 1u) : ((1u << i0) | (1u << i1) | (1u << i2));
        }
        float m_run = -1e30f, l_run = 0.f; f32x16 o[4];
#pragma unroll
        for (int db = 0; db < 4; ++db)
#pragma unroll
            for (int r = 0; r < 16; ++r) o[db][r] = 0.f;
        const int qin = 128 * half + 32 * wq + q31;
#pragma unroll 1
        for (int st2 = 0; st2 < nstep; st2 += 2)
#pragma unroll
        for (int par = 0; par < 2; ++par) { const int st = st2 + par; if (st < nstep) {
            asm volatile("s_waitcnt vmcnt(0)" ::: "memory"); __builtin_amdgcn_s_barrier(); asm volatile("" ::: "memory");
            if (st + 1 < nstep) attn_dma_step(K, V, lds, b, h, qb, n_own, st + 1, par ^ 1, wave, lane);
            const int T = 2 * st + kvh; const bool own = T < n_own;
            const int blk = own ? qb : ((T - n_own) >> 2), kt = own ? T : ((T - n_own) & 3);
            const bool sel = own ? true : ((selmask >> blk) & 1u);
            const bool skip = own ? (64 * kt > 128 * half + 32 * wq + 31) : (__ballot(sel) == 0ull);
            if (!skip) {
                const unsigned kimg = lds0 + par * 65536 + kvh * 32768, vimg = kimg + 16384;
                f32x16 p[2];
#pragma unroll
                for (int kh = 0; kh < 2; ++kh) {
#pragma unroll
                    for (int r = 0; r < 16; ++r) p[kh][r] = 0.f;
                    const int row = 32 * kh + q31;
#pragma unroll
                    for (int s = 0; s < 8; ++s) { const bf16x8 a = *(const LAS bf16x8*)(uintptr_t)(kimg + row * 256 + (((2 * s + hh) ^ (row & 15)) << 4));
                        p[kh] = __builtin_amdgcn_mfma_f32_32x32x16_bf16(a, qf[s], p[kh], 0, 0, 0); }
                }
                if (own) { const int kbase = 64 * kt;
                    if (kbase + 63 > 128 * half + 32 * wq) {
#pragma unroll
                        for (int kh = 0; kh < 2; ++kh)
#pragma unroll
                            for (int r = 0; r < 16; ++r) if (kbase + 32 * kh + crow16(r, hh) > qin) p[kh][r] = -INFINITY; }
                }
                float mx = p[0][0];
#pragma unroll
                for (int r = 1; r < 16; ++r) mx = fmaxf(mx, p[0][r]);
#pragma unroll
                for (int r = 0; r < 16; ++r) mx = fmaxf(mx, p[1][r]);
                { const auto rr = __builtin_amdgcn_permlane32_swap(__float_as_uint(mx), __float_as_uint(mx), false, false); mx = fmaxf(__uint_as_float(rr[0]), __uint_as_float(rr[1])); }
                if (!sel) mx = -INFINITY;
                const float m_new = fmaxf(m_run, mx), scl = __builtin_amdgcn_exp2f(m_run - m_new); m_run = m_new;
                float rs = 0.f;
#pragma unroll
                for (int kh = 0; kh < 2; ++kh)
#pragma unroll
                    for (int r = 0; r < 16; ++r) { p[kh][r] = __builtin_amdgcn_exp2f(p[kh][r] - m_new); rs += p[kh][r]; }
                l_run = l_run * scl + (sel ? rs : 0.f);
                if (__ballot(scl != 1.0f) != 0ull) {
#pragma unroll
                    for (int db = 0; db < 4; ++db)
#pragma unroll
                        for (int r = 0; r < 16; ++r) o[db][r] *= scl; }
                const unsigned pmask = sel ? 0xffffffffu : 0u;
                bf16x8 pb[4];
#pragma unroll
                for (int gi = 0; gi < 4; ++gi) { const int kh = gi >> 1, s2 = gi & 1; v4u pw;
                    pw.x = pg8::cvt_pk_bf16(p[kh][8 * s2], p[kh][8 * s2 + 1]) & pmask; pw.y = pg8::cvt_pk_bf16(p[kh][8 * s2 + 2], p[kh][8 * s2 + 3]) & pmask;
                    pw.z = pg8::cvt_pk_bf16(p[kh][8 * s2 + 4], p[kh][8 * s2 + 5]) & pmask; pw.w = pg8::cvt_pk_bf16(p[kh][8 * s2 + 6], p[kh][8 * s2 + 7]) & pmask;
                    pb[gi] = __builtin_bit_cast(bf16x8, pw); }
                v4i16_t lo[2][2], hi_[2][2];
                const int dsub = 16 * (G4 & 1) + 4 * (l16 & 3);
#define ATTN_VREADS(u, S) { const int key0_ = 32 * ((u) >> 2) + 16 * (((u) >> 1) & 1) + 4 * (G4 >> 1) + (l16 >> 2); _Pragma("unroll") for (int d2 = 0; d2 < 2; ++d2) { const int db = 2 * ((u) & 1) + d2; \
                    const unsigned a0_ = vimg + key0_ * 256 + ((db ^ (key0_ & 3)) << 6) + dsub * 2; \
                    asm volatile("ds_read_b64_tr_b16 %0, %1" : "=&v"(lo[S][d2]) : "v"(a0_) : "memory"); \
                    asm volatile("ds_read_b64_tr_b16 %0, %1 offset:2048" : "=&v"(hi_[S][d2]) : "v"(a0_) : "memory"); } }
#define ATTN_VWAIT(S, N) asm volatile("s_waitcnt lgkmcnt(" #N ")" : "+v"(lo[S][0]), "+v"(lo[S][1]), "+v"(hi_[S][0]), "+v"(hi_[S][1]) :: "memory")
#define ATTN_PV(u, S) { _Pragma("unroll") for (int d2 = 0; d2 < 2; ++d2) { const int db = 2 * ((u) & 1) + d2; const bf16x8 av = {lo[S][d2][0], lo[S][d2][1], lo[S][d2][2], lo[S][d2][3], hi_[S][d2][0], hi_[S][d2][1], hi_[S][d2][2], hi_[S][d2][3]}; \
                    o[db] = __builtin_amdgcn_mfma_f32_32x32x16_bf16(av, pb[(u) >> 1], o[db], 0, 0, 0); } }
                ATTN_VREADS(0, 0)
                ATTN_VREADS(1, 1) ATTN_VWAIT(0, 4); ATTN_PV(0, 0)
                ATTN_VREADS(2, 0) ATTN_VWAIT(1, 4); ATTN_PV(1, 1)
                ATTN_VREADS(3, 1) ATTN_VWAIT(0, 4); ATTN_PV(2, 0)
                ATTN_VREADS(4, 0) ATTN_VWAIT(1, 4); ATTN_PV(3, 1)
                ATTN_VREADS(5, 1) ATTN_VWAIT(0, 4); ATTN_PV(4, 0)
                ATTN_VREADS(6, 0) ATTN_VWAIT(1, 4); ATTN_PV(5, 1)
                ATTN_VREADS(7, 1) ATTN_VWAIT(0, 4); ATTN_PV(6, 0)
                ATTN_VWAIT(1, 0); ATTN_PV(7, 1)
#undef ATTN_VREADS
#undef ATTN_VWAIT
#undef ATTN_PV
            }
        } }
        l_run += __shfl_xor(l_run, 32);
        asm volatile("s_waitcnt vmcnt(0) lgkmcnt(0)" ::: "memory"); __builtin_amdgcn_s_barrier(); asm volatile("" ::: "memory");
        LAS float* xs = (LAS float*)lds + (size_t)wq * 66 * 64 + lane;
        if (kvh == 1) {
            xs[0] = m_run; xs[64] = l_run;
#pragma unroll
            for (int db = 0; db < 4; ++db)
#pragma unroll
                for (int r = 0; r < 16; ++r) xs[(2 + 16 * db + r) * 64] = o[db][r];
        }
        asm volatile("s_waitcnt lgkmcnt(0)" ::: "memory"); __builtin_amdgcn_s_barrier(); asm volatile("" ::: "memory");
        if (kvh == 0) {
            const float m2 = xs[0], l2 = xs[64], mt = fmaxf(m_run, m2), a1 = __builtin_amdgcn_exp2f(m_run - mt), a2 = __builtin_amdgcn_exp2f(m2 - mt);
            const float inv = 1.0f / (l_run * a1 + l2 * a2), c1 = a1 * inv, c2 = a2 * inv;
            bf16* orow = AO + rowq * 1024 + h * 128 + 4 * hh;
#pragma unroll
            for (int db = 0; db < 4; ++db)
#pragma unroll
                for (int g = 0; g < 4; ++g) {
                    float t[4];
#pragma unroll
                    for (int e = 0; e < 4; ++e) t[e] = o[db][4 * g + e] * c1 + xs[(2 + 16 * db + 4 * g + e) * 64] * c2;
                    u32x2v w; w.x = pg8::cvt_pk_bf16(t[0], t[1]); w.y = pg8::cvt_pk_bf16(t[2], t[3]);
                    *(GAS u32x2v*)(orow + 32 * db + 8 * g) = w;
                }
        }
    }
    asm volatile("s_waitcnt vmcnt(0) lgkmcnt(0)" ::: "memory"); __builtin_amdgcn_s_barrier(); asm volatile("" ::: "memory");
}
__device__ __forceinline__ void up8(const v4u w, float (&f)[8]) { f[0] = bflo(w.x); f[1] = bfhi(w.x); f[2] = bflo(w.y); f[3] = bfhi(w.y); f[4] = bflo(w.z); f[5] = bfhi(w.z); f[6] = bflo(w.w); f[7] = bfhi(w.w); }
__device__ __forceinline__ void conv_phase(const Ctx& F, const bf16* CB, const bf16* Z, const float* cw, bf16* UC) {
    const int gt = (F.vcu * NWAVES + F.wave) * 64 + F.lane, NT = F.G * NWAVES * 64;
    for (int idx = gt; idx < M * 128; idx += NT) {
        const int row = idx >> 7, c8 = (idx & 127) << 3, t = row & (SEQ - 1); const size_t off = (size_t)row * 1024 + c8;
        float cb[8], z0[8], z1[8], z2[8];
        up8(*(const GAS v4u*)(CB + off), cb); up8(*(const GAS v4u*)(Z + off), z0);
        if (t >= 1) up8(*(const GAS v4u*)(Z + off - 1024), z1); else {
#pragma unroll
            for (int j = 0; j < 8; ++j) z1[j] = 0.f; }
        if (t >= 2) up8(*(const GAS v4u*)(Z + off - 2048), z2); else {
#pragma unroll
            for (int j = 0; j < 8; ++j) z2[j] = 0.f; }
        float o[8];
#pragma unroll
        for (int j = 0; j < 8; ++j) o[j] = cb[j] * (cw[c8 + j] * z2[j] + cw[1024 + c8 + j] * z1[j] + cw[2048 + c8 + j] * z0[j]);
        v4u w; w.x = pk2(o[0], o[1]); w.y = pk2(o[2], o[3]); w.z = pk2(o[4], o[5]); w.w = pk2(o[6], o[7]); *(GAS v4u*)(UC + off) = w;
    }
}

__device__ __forceinline__ int imax(int a, int b) { return a > b ? a : b; }
__device__ __forceinline__ int imin(int a, int b) { return a < b ? a : b; }
__device__ __forceinline__ void ce(int& a, int& b) { const int t = imax(a, b); b = imin(a, b); a = t; }
__device__ __forceinline__ void sort16(int (&x)[16]) {
#pragma unroll
    for (int kk = 1; kk <= 4; ++kk)
#pragma unroll
        for (int jj = kk - 1; jj >= 0; --jj)
#pragma unroll
            for (int i = 0; i < 16; ++i) { const int k = 1 << kk, j = 1 << jj, l = i ^ j; if (l > i) { if ((i & k) == 0) ce(x[i], x[l]); else ce(x[l], x[i]); } }
}
__device__ __forceinline__ void bmerge16(int (&a)[16]) {
#pragma unroll
    for (int jj = 3; jj >= 0; --jj)
#pragma unroll
        for (int i = 0; i < 16; ++i) { const int j = 1 << jj, l = i ^ j; if (l > i) ce(a[i], a[l]); }
}
__device__ __forceinline__ void merge16(int (&a)[16], const int (&b)[16]) {
#pragma unroll
    for (int i = 0; i < 16; ++i) a[i] = imax(a[i], b[15 - i]);
    bmerge16(a);
}
__device__ __forceinline__ void xmerge16(int (&a)[16], int hh) {
    int pv[16];
#pragma unroll
    for (int i = 0; i < 16; ++i) { const auto r = __builtin_amdgcn_permlane32_swap((unsigned)a[15 - i], (unsigned)a[15 - i], false, false); pv[i] = hh ? (int)r[0] : (int)r[1]; }
#pragma unroll
    for (int i = 0; i < 16; ++i) a[i] = imax(a[i], pv[i]);
    bmerge16(a);
}
__device__ __forceinline__ int ord_key(float f) { const int u = __float_as_int(f); return u >= 0 ? u : (u ^ 0x7fffffff); }
__device__ __forceinline__ float ord_val(int k) { return __int_as_float(k >= 0 ? k : (k ^ 0x7fffffff)); }
__device__ __forceinline__ unsigned byte16(const unsigned (&t)[4], int idx) {
    const unsigned sel = 0x0c0c0c00u | (unsigned)(idx & 7);
    const unsigned lo = __builtin_amdgcn_perm(t[1], t[0], sel), hi_ = __builtin_amdgcn_perm(t[3], t[2], sel);
    return (idx & 8) ? hi_ : lo;
}
__device__ __forceinline__ void topk_stage_keys(const Ctx& F, const bf16* KEYS, int h) {
    for (int pc = F.wave; pc < 64; pc += 8) { const int pp = pc >> 5, row = 4 * (pc & 31) + (F.lane >> 4), cp = F.lane & 15, c = cp ^ (row & 15);
        __builtin_amdgcn_global_load_lds((const unsigned*)(KEYS + (size_t)((h * 2 + pp) * 128 + row) * 128 + 8 * c), (LAS unsigned*)(F.lds + RING_OFF + pc * 1024), 16, 0, 0); }
    asm volatile("s_waitcnt vmcnt(0)" ::: "memory"); __builtin_amdgcn_s_barrier(); asm volatile("" ::: "memory");
}
__device__ __forceinline__ void topk_phase(const Ctx& F, int bitem, const bf16* QP, int* EXP, float* GATE) {
    const int lane = F.lane, l31 = lane & 31, hh = lane >> 5;
    const int IMIN = (int)0x80000000;
    const unsigned lds0 = (unsigned)(uintptr_t)(F.lds + RING_OFF);
    {
        const int h = bitem & 7, tt = (bitem >> 3) * 8 + F.wave, tok0 = tt * 32;
        int top[2][16];
#pragma unroll
        for (int p = 0; p < 2; ++p) {
            bf16x8 qa[8];
#pragma unroll
            for (int s = 0; s < 8; ++s) qa[s] = *(const GAS bf16x8*)(QP + (size_t)(tok0 + l31) * 2048 + h * 256 + p * 128 + 16 * s + 8 * hh);
            int x[2][16];
#pragma unroll
            for (int pq = 0; pq < 2; ++pq) {
                f32x16 sc[2];
#pragma unroll
                for (int nt = 0; nt < 2; ++nt)
#pragma unroll
                    for (int r = 0; r < 16; ++r) sc[nt][r] = 0.f;
#pragma unroll
                for (int s = 0; s < 8; ++s) {
#pragma unroll
                    for (int nt = 0; nt < 2; ++nt) { const int n = 64 * pq + 32 * nt + l31; const bf16x8 kb = *(const LAS bf16x8*)(uintptr_t)(lds0 + p * 32768 + n * 256 + (((2 * s + hh) ^ (n & 15)) << 4));
                        sc[nt] = __builtin_amdgcn_mfma_f32_32x32x16_bf16(kb, qa[s], sc[nt], 0, 0, 0); }
                }
                int y[16];
#pragma unroll
                for (int r = 0; r < 16; ++r) { x[pq][r] = (ord_key(sc[0][r]) & ~127) | ((127 - 64 * pq - (r & 3) - 8 * (r >> 2)) - 4 * hh); y[r] = (ord_key(sc[1][r]) & ~127) | ((127 - 64 * pq - 32 - (r & 3) - 8 * (r >> 2)) - 4 * hh); }
                sort16(x[pq]); sort16(y); merge16(x[pq], y);
                asm volatile("" ::: "memory");
            }
            merge16(x[0], x[1]);
            xmerge16(x[0], hh);
#pragma unroll
            for (int i = 0; i < 16; ++i) top[p][i] = x[0][i];
        }
        float fa[16], fb[16];
#pragma unroll
        for (int i = 0; i < 16; ++i) { const int A = hh ? top[1][i] : top[0][i], B = hh ? top[0][i] : top[1][i]; fa[i] = ord_val(A & ~127); fb[i] = ord_val(B & ~127); }
        int c0[16], c1[16];
#pragma unroll
        for (int q = 0; q < 32; ++q) {
            int key = IMIN;
            if (q < 27) { const int i = (q < 16) ? 0 : (q < 23) ? 1 : (q < 26) ? 2 : 3, j = (q < 16) ? q : (q < 23) ? q - 15 : (q < 26) ? q - 21 : 3; const float sv = fa[i] + fb[j]; const int low = hh ? (255 - (j * 16 + i)) : (255 - (i * 16 + j));
                key = (ord_key(sv) & ~255) | low; if (i == j && hh) key = IMIN; }
            if (q < 16) c0[q] = key; else c1[q - 16] = key;
        }
        sort16(c0); sort16(c1); merge16(c0, c1); xmerge16(c0, hh);
        unsigned na[4], nb[4];
#pragma unroll
        for (int d = 0; d < 4; ++d) { na[d] = 0u; nb[d] = 0u;
#pragma unroll
            for (int e = 0; e < 4; ++e) { na[d] |= (unsigned)(127 - (top[0][4 * d + e] & 127)) << (8 * e); nb[d] |= (unsigned)(127 - (top[1][4 * d + e] & 127)) << (8 * e); } }
        int ex[16]; float ev[16]; float es = 0.f; const float smax = ord_val(c0[0] & ~255);
#pragma unroll
        for (int q = 0; q < 16; ++q) { const int posn = 255 - (c0[q] & 255); const unsigned n1 = byte16(na, posn >> 4) & 255u, n2 = byte16(nb, posn & 15) & 255u;
            ex[q] = (int)(n1 * 128u + n2); ev[q] = __expf(ord_val(c0[q] & ~255) - smax); es += ev[q]; }
        const float ri = 1.0f / es; const size_t ob = (size_t)(tok0 + l31) * 128 + h * 16;
        if (hh == 0) {
#pragma unroll
            for (int d = 0; d < 4; ++d) { v4u w; w.x = (unsigned)ex[4 * d]; w.y = (unsigned)ex[4 * d + 1]; w.z = (unsigned)ex[4 * d + 2]; w.w = (unsigned)ex[4 * d + 3]; *(GAS v4u*)(EXP + ob + 4 * d) = w; }
        } else {
#pragma unroll
            for (int d = 0; d < 4; ++d) *(GAS f32x4*)(GATE + ob + 4 * d) = (f32x4){ev[4 * d] * ri, ev[4 * d + 1] * ri, ev[4 * d + 2] * ri, ev[4 * d + 3] * ri};
        }
    }
}

typedef float f32x2 __attribute__((ext_vector_type(2)));
constexpr float PEER_SU = 512.0f, PEER_SV = 32.0f;
template <int CTRL> __device__ __forceinline__ int dpp_i(int v) { return __builtin_amdgcn_update_dpp(v, v, CTRL, 0xf, 0xf, false); }
template <int J> __device__ __forceinline__ int xor_lane(int v, int lane) {
    if constexpr (J == 1) return dpp_i<0xB1>(v);
    else if constexpr (J == 2) return dpp_i<0x4E>(v);
    else if constexpr (J == 16) { const auto r = __builtin_amdgcn_permlane16_swap((unsigned)v, (unsigned)v, false, false); return ((lane >> 4) & 1) ? (int)r[0] : (int)r[1]; }
    else if constexpr (J == 32) { const auto r = __builtin_amdgcn_permlane32_swap((unsigned)v, (unsigned)v, false, false); return (lane >> 5) ? (int)r[0] : (int)r[1]; }
    else return __shfl_xor(v, J);
}
__device__ __forceinline__ float wave_sum_dpp(float v) {
    v += __int_as_float(dpp_i<0xB1>(__float_as_int(v))); v += __int_as_float(dpp_i<0x4E>(__float_as_int(v))); v += __int_as_float(dpp_i<0x141>(__float_as_int(v))); v += __int_as_float(dpp_i<0x140>(__float_as_int(v)));
    { const auto r = __builtin_amdgcn_permlane16_swap(__float_as_uint(v), __float_as_uint(v), false, false); v = __uint_as_float(r[0]) + __uint_as_float(r[1]); }
    { const auto r = __builtin_amdgcn_permlane32_swap(__float_as_uint(v), __float_as_uint(v), false, false); v = __uint_as_float(r[0]) + __uint_as_float(r[1]); }
    return v; }
template <int KK, int JJ> __device__ __forceinline__ void sort512_step(int (&x)[8], int lane) {
    constexpr int k = 1 << KK, j = 1 << JJ;
    if constexpr (j >= 64) { constexpr int jr = j >> 6;
#pragma unroll
        for (int r = 0; r < 8; ++r) if ((r & jr) == 0) { const bool asc = (k >= 512) ? true : (((r << 6) & k) == 0); const int lo = imin(x[r], x[r | jr]), hi_ = imax(x[r], x[r | jr]); x[r] = asc ? lo : hi_; x[r | jr] = asc ? hi_ : lo; }
    } else {
        const bool lower = (lane & j) == 0;
#pragma unroll
        for (int r = 0; r < 8; ++r) { const int y = xor_lane<j>(x[r], lane);
            const bool asc = (k < 64) ? ((lane & k) == 0) : ((k >= 512) ? true : (((r << 6) & k) == 0));
            x[r] = (lower == asc) ? imin(x[r], y) : imax(x[r], y); }
    }
}
template <int KK, int JJ> __device__ __forceinline__ void sort512_stage(int (&x)[8], int lane) { sort512_step<KK, JJ>(x, lane); if constexpr (JJ > 0) sort512_stage<KK, JJ - 1>(x, lane); }
__device__ __forceinline__ void sort512(int (&x)[8], int lane) {
    sort512_stage<1, 0>(x, lane); sort512_stage<2, 1>(x, lane); sort512_stage<3, 2>(x, lane); sort512_stage<4, 3>(x, lane); sort512_stage<5, 4>(x, lane);
    sort512_stage<6, 5>(x, lane); sort512_stage<7, 6>(x, lane); sort512_stage<8, 7>(x, lane); sort512_stage<9, 8>(x, lane);
}
__device__ __forceinline__ void peer_phase(const Ctx& F, const unsigned char* U8, const unsigned char* V8, const bf16* X1B, const int* EXP, const float* GATE, const unsigned long long* SS, const float* gfin, const float* X1, float* OUT) {
    const int gw = F.vcu * NWAVES + F.wave, NGW = F.G * NWAVES, lane = F.lane;
    const unsigned xs0 = (unsigned)(uintptr_t)(F.lds + RING_OFF + F.wave * 16384) + lane * 16;
    for (int tb = gw; tb + 3 * NGW < M; tb += 4 * NGW) {
        int kreg[8]; float greg[8], rv[4];
#pragma unroll
        for (int j = 0; j < 4; ++j) { const size_t t = (size_t)tb + (size_t)j * NGW;
            kreg[2 * j] = (EXP[t * 128 + lane] << 9) | (j << 7) | lane; kreg[2 * j + 1] = (EXP[t * 128 + 64 + lane] << 9) | (j << 7) | (64 + lane);
            rv[j] = pg8::rinv_from_ss(SS[t]) * (1.0f / PEER_SU);
#pragma unroll
            for (int q = 0; q < 4; ++q) { const v4u w = *(const GAS v4u*)(X1B + t * DM + (q >> 1) * 1024 + lane * 16 + 8 * (q & 1)); *(LAS v4u*)(uintptr_t)(xs0 + j * 4096 + q * 1024) = w; } }
        sort512(kreg, lane);
        int pkey[8];
#pragma unroll
        for (int c = 0; c < 8; ++c) { pkey[c] = __shfl(kreg[c], 8 * (lane & 7) + (lane >> 3)); greg[c] = GATE[((size_t)tb + (size_t)((pkey[c] >> 7) & 3) * NGW) * 128 + (pkey[c] & 127)]; }
        asm volatile("s_waitcnt lgkmcnt(0)" ::: "memory");
        float actreg[8];
#ifndef MK_P8_REPU
#define MK_P8_REPU 1
#endif
#pragma unroll 1
        for (int repu = 0; repu < MK_P8_REPU; ++repu) {
            v4u ub[8][2];
#pragma unroll
            for (int u = 0; u < 8; ++u) { const GAS v4u* up = (const GAS v4u*)(U8 + (size_t)(__builtin_amdgcn_readlane(kreg[0], u) >> 9) * 2048) + lane; ub[u][0] = up[0]; ub[u][1] = up[64]; }
#pragma unroll
            for (int c = 0; c < 8; ++c) {
                float areg = 0.f;
#pragma unroll 1
                for (int g = 0; g < 8; ++g) {
                    float pt[8];
#pragma unroll
                    for (int u = 0; u < 8; ++u) {
                        const int key = __builtin_amdgcn_readlane(kreg[c], 8 * g + u);
                        const unsigned xa = xs0 + ((key >> 7) & 3) * 4096;
                        float p0 = 0.f, p1 = 0.f;
#pragma unroll
                        for (int i = 0; i < 2; ++i) { const v4u w = ub[u][i];
#pragma unroll
                            for (int hv = 0; hv < 2; ++hv) { const v4u xq = *(const LAS v4u*)(uintptr_t)(xa + (2 * i + hv) * 1024);
                                const unsigned w0 = hv ? w.z : w.x, w1 = hv ? w.w : w.y;
                                const f32x2 a0 = __builtin_amdgcn_cvt_pk_f32_fp8((int)w0, false), a1 = __builtin_amdgcn_cvt_pk_f32_fp8((int)w0, true), a2 = __builtin_amdgcn_cvt_pk_f32_fp8((int)w1, false), a3 = __builtin_amdgcn_cvt_pk_f32_fp8((int)w1, true);
                                p0 = dot2bf(pg8::cvt_pk_bf16(a0[0], a0[1]), xq.x, p0); p1 = dot2bf(pg8::cvt_pk_bf16(a1[0], a1[1]), xq.y, p1);
                                p0 = dot2bf(pg8::cvt_pk_bf16(a2[0], a2[1]), xq.z, p0); p1 = dot2bf(pg8::cvt_pk_bf16(a3[0], a3[1]), xq.w, p1); } }
                        pt[u] = p0 + p1;
                        { const int ix = 8 * g + 8 + u, ka = __builtin_amdgcn_readlane(kreg[c], ix & 63), kb = __builtin_amdgcn_readlane(kreg[c < 7 ? c + 1 : 7], ix & 63), kn = (ix < 64) ? ka : kb;
                            const GAS v4u* up = (const GAS v4u*)(U8 + (size_t)(kn >> 9) * 2048) + lane; ub[u][0] = up[0]; ub[u][1] = up[64]; }
                    }
                    { const bool b5 = (lane & 32) != 0, b4 = (lane & 16) != 0, b3 = (lane & 8) != 0;
#pragma unroll
                      for (int i = 0; i < 4; ++i) { const float a = pt[i], b = pt[i + 4]; pt[i] = (b5 ? b : a) + __int_as_float(xor_lane<32>(__float_as_int(b5 ? a : b), lane)); }
#pragma unroll
                      for (int i = 0; i < 2; ++i) { const float a = pt[i], b = pt[i + 2]; pt[i] = (b4 ? b : a) + __int_as_float(xor_lane<16>(__float_as_int(b4 ? a : b), lane)); }
                      { const float a = pt[0], b = pt[1]; pt[0] = (b3 ? b : a) + __shfl_xor(b3 ? a : b, 8); }
                      float r = pt[0]; r += __shfl_xor(r, 4); r += __int_as_float(dpp_i<0x4E>(__float_as_int(r))); r += __int_as_float(dpp_i<0xB1>(__float_as_int(r)));
                      areg = ((lane & 7) == g) ? r : areg; }
                }
                const int tk = (pkey[c] >> 7) & 3; const float rr = (tk == 0) ? rv[0] : (tk == 1) ? rv[1] : (tk == 2) ? rv[2] : rv[3];
                actreg[c] = gelu_tanh(areg * rr) * greg[c] * (1.0f / PEER_SV);
            }
        }
        LAS float* as = (LAS float*)(uintptr_t)(xs0 - lane * 16);
        asm volatile("s_waitcnt lgkmcnt(0)" ::: "memory");
#pragma unroll
        for (int c = 0; c < 8; ++c) as[64 * c + lane] = actreg[c];
        int k2[8];
#pragma unroll
        for (int c = 0; c < 8; ++c) { const int key = kreg[c], tok = (key >> 7) & 3, park = 64 * c + 8 * (lane & 7) + (lane >> 3);
            k2[c] = ((tok >> 1) << 24) | ((key >> 9) << 10) | ((tok & 1) << 9) | park; }
        sort512(k2, lane);
        asm volatile("s_waitcnt lgkmcnt(0)" ::: "memory");
        float a2[8];
#pragma unroll
        for (int c = 0; c < 8; ++c) a2[c] = as[k2[c] & 511];
#pragma unroll 1
        for (int pp = 0; pp < 2; ++pp) {
            int kq[4]; float aq[4];
#pragma unroll
            for (int c = 0; c < 4; ++c) { kq[c] = pp ? k2[4 + c] : k2[c]; aq[c] = pp ? a2[4 + c] : a2[c]; }
            f32x2 y[2][16];
#pragma unroll
            for (int j = 0; j < 2; ++j)
#pragma unroll
                for (int q = 0; q < 16; ++q) y[j][q] = (f32x2){0.f, 0.f};
            v4u vb[8][2];
#pragma unroll
            for (int u = 0; u < 8; ++u) { const GAS v4u* vp = (const GAS v4u*)(V8 + (size_t)((__builtin_amdgcn_readlane(kq[0], u) >> 10) & 0x3fff) * 2048) + lane; vb[u][0] = vp[0]; vb[u][1] = vp[64]; }
#pragma unroll
            for (int c = 0; c < 4; ++c) {
#pragma unroll 1
                for (int g = 0; g < 8; ++g) {
#pragma unroll
                    for (int u = 0; u < 8; ++u) {
                        const int key = __builtin_amdgcn_readlane(kq[c], 8 * g + u); const float s = rdlane(aq[c], 8 * g + u);
                        const float sa = (key & 512) ? 0.f : s, sb = (key & 512) ? s : 0.f; const f32x2 s0 = {sa, sa}, s1 = {sb, sb};
#pragma unroll
                        for (int i = 0; i < 2; ++i) { const v4u w = vb[u][i];
                            const f32x2 c0 = __builtin_amdgcn_cvt_pk_f32_fp8((int)w.x, false), c1 = __builtin_amdgcn_cvt_pk_f32_fp8((int)w.x, true), c2 = __builtin_amdgcn_cvt_pk_f32_fp8((int)w.y, false), c3 = __builtin_amdgcn_cvt_pk_f32_fp8((int)w.y, true);
                            const f32x2 c4 = __builtin_amdgcn_cvt_pk_f32_fp8((int)w.z, false), c5 = __builtin_amdgcn_cvt_pk_f32_fp8((int)w.z, true), c6 = __builtin_amdgcn_cvt_pk_f32_fp8((int)w.w, false), c7 = __builtin_amdgcn_cvt_pk_f32_fp8((int)w.w, true);
                            y[0][8 * i + 0] = __builtin_elementwise_fma(c0, s0, y[0][8 * i + 0]); y[1][8 * i + 0] = __builtin_elementwise_fma(c0, s1, y[1][8 * i + 0]);
                            y[0][8 * i + 1] = __builtin_elementwise_fma(c1, s0, y[0][8 * i + 1]); y[1][8 * i + 1] = __builtin_elementwise_fma(c1, s1, y[1][8 * i + 1]);
                            y[0][8 * i + 2] = __builtin_elementwise_fma(c2, s0, y[0][8 * i + 2]); y[1][8 * i + 2] = __builtin_elementwise_fma(c2, s1, y[1][8 * i + 2]);
                            y[0][8 * i + 3] = __builtin_elementwise_fma(c3, s0, y[0][8 * i + 3]); y[1][8 * i + 3] = __builtin_elementwise_fma(c3, s1, y[1][8 * i + 3]);
                            y[0][8 * i + 4] = __builtin_elementwise_fma(c4, s0, y[0][8 * i + 4]); y[1][8 * i + 4] = __builtin_elementwise_fma(c4, s1, y[1][8 * i + 4]);
                            y[0][8 * i + 5] = __builtin_elementwise_fma(c5, s0, y[0][8 * i + 5]); y[1][8 * i + 5] = __builtin_elementwise_fma(c5, s1, y[1][8 * i + 5]);
                            y[0][8 * i + 6] = __builtin_elementwise_fma(c6, s0, y[0][8 * i + 6]); y[1][8 * i + 6] = __builtin_elementwise_fma(c6, s1, y[1][8 * i + 6]);
                            y[0][8 * i + 7] = __builtin_elementwise_fma(c7, s0, y[0][8 * i + 7]); y[1][8 * i + 7] = __builtin_elementwise_fma(c7, s1, y[1][8 * i + 7]); }
                        { const int ix = 8 * g + 8 + u, ka = __builtin_amdgcn_readlane(kq[c], ix & 63), kb = __builtin_amdgcn_readlane(kq[c < 3 ? c + 1 : 3], ix & 63), kn = (ix < 64) ? ka : kb;
                            const GAS v4u* vp = (const GAS v4u*)(V8 + (size_t)((kn >> 10) & 0x3fff) * 2048) + lane; vb[u][0] = vp[0]; vb[u][1] = vp[64]; }
                    }
                }
            }
#pragma unroll
            for (int j = 0; j < 2; ++j) { const size_t t = (size_t)tb + (size_t)(2 * pp + j) * NGW;
                GAS f32x4* orw = (GAS f32x4*)(OUT + t * DM); float ss = 0.f;
#pragma unroll
                for (int i = 0; i < 2; ++i)
#pragma unroll
                    for (int hv = 0; hv < 2; ++hv) { const v4u w = *(const GAS v4u*)(X1B + t * DM + i * 1024 + lane * 16 + 8 * hv);
                        y[j][8 * i + 4 * hv + 0] += (f32x2){bflo(w.x), bfhi(w.x)}; y[j][8 * i + 4 * hv + 1] += (f32x2){bflo(w.y), bfhi(w.y)}; y[j][8 * i + 4 * hv + 2] += (f32x2){bflo(w.z), bfhi(w.z)}; y[j][8 * i + 4 * hv + 3] += (f32x2){bflo(w.w), bfhi(w.w)}; }
#pragma unroll
                for (int q = 0; q < 16; ++q) ss += y[j][q][0] * y[j][q][0] + y[j][q][1] * y[j][q][1];
                const float r3 = 1.0f / sqrtf(wave_sum_dpp(ss) * (1.0f / DM) + RMS_EPS);
#pragma unroll
                for (int i = 0; i < 2; ++i)
#pragma unroll
                    for (int q = 0; q < 4; ++q) { const f32x4 ga = *(const GAS f32x4*)(gfin + i * 1024 + lane * 16 + 4 * q);
                        orw[i * 256 + 4 * lane + q] = (f32x4){y[j][8 * i + 2 * q][0] * r3 * ga[0], y[j][8 * i + 2 * q][1] * r3 * ga[1], y[j][8 * i + 2 * q + 1][0] * r3 * ga[2], y[j][8 * i + 2 * q + 1][1] * r3 * ga[3]}; }
            }
        }
        asm volatile("s_waitcnt lgkmcnt(0)" ::: "memory");
    }
}

struct Args { const float* in[15]; float* out; unsigned char* ws; double invf[16]; int ph_lo, ph_hi, li, pad; };
__global__ void __launch_bounds__(NWAVES * 64, 2) mk_fwd(Args args) {
    extern __shared__ __attribute__((aligned(16))) unsigned char lds[];
    Ctx F;
    F.lds = (LAS unsigned char*)lds;
    volatile LAS unsigned* MISC = (volatile LAS unsigned*)(F.lds + MISC_OFF);
    F.tid = threadIdx.x; F.lane = F.tid & 63; F.wave = __builtin_amdgcn_readfirstlane(F.tid >> 6);
    F.G = gridDim.x; { const int bx = blockIdx.x; F.vcu = (F.G % 8 == 0) ? (bx % 8) * (F.G / 8) + bx / 8 : bx; }
    unsigned char* ws = args.ws;
    gu32* ctl = (gu32*)(ws + WS_CTL);
    for (int u = F.tid; u < (LDS_BYTES - LDSCTL_OFF) / 4; u += NWAVES * 64) ((LAS unsigned*)(F.lds + LDSCTL_OFF))[u] = 0u;
    __syncthreads();
    XcdBarrier bar; bar.bar = (unsigned*)(ctl + CW_BAR); bar.x = 0; bar.st = nullptr;
    if (N_LAUNCHES != PER_PHASE) bar = xcd_barrier_post((unsigned*)(ctl + CW_BAR), MISC + 8);
#define GRID_BAR() do { if (N_LAUNCHES != PER_PHASE) xcd_barrier(bar); } while (0)
#define GRID_BAR_W(q) do { if (N_LAUNCHES != PER_PHASE) { const BarWork wk_{args.in[12], args.in[13], args.in[9], ws, (q), 4}; xcd_barrier(bar, &F, &wk_); } } while (0)
    const int lo = args.ph_lo, hi = args.ph_hi;
#define IN(k) (lo <= (k) && (k) < hi)
#define BOTH(k) (IN(k) && IN((k) + 1))
    bf16* WinT = (bf16*)(ws + WS_WIN); bf16* WbcT = (bf16*)(ws + WS_WBC); bf16* WbaT = (bf16*)(ws + WS_WBA); bf16* WoutT = (bf16*)(ws + WS_WOUT); bf16* WpqT = (bf16*)(ws + WS_WPQ);
    bf16* KEYS = (bf16*)(ws + WS_KEYS); float* CS = (float*)(ws + WS_CS); const unsigned char* UB = ws + WS_UB; const unsigned char* VB = ws + WS_VB;
    bf16* XB = (bf16*)(ws + WS_XB); bf16* T6 = (bf16*)(ws + WS_T6); bf16* GAB = (bf16*)(ws + WS_GAB); bf16* UC = (bf16*)(ws + WS_UC); bf16* AO = (bf16*)(ws + WS_AO);
    bf16* TMP = (bf16*)(ws + WS_TMP); bf16* MB = (bf16*)(ws + WS_MB); bf16* X1B = (bf16*)(ws + WS_X1B); bf16* QP = (bf16*)(ws + WS_QP);
    int* EXP = (int*)(ws + WS_EXP); float* GATE = (float*)(ws + WS_GATE);
    unsigned long long* SS = (unsigned long long*)(ws + WS_SS); float* KSUM = (float*)(ws + WS_KSUM);
    constexpr size_t TS = (size_t)M * 1024;

    if (IN(0)) { for (int rep = 0; rep < NREP(0); ++rep) { p0_prologue(F, args.in, ws, args.invf); if (rep + 1 < NREP(0)) GRID_BAR(); } if (BOTH(0)) GRID_BAR(); }
    if (IN(1)) {
        for (int rep = 0; rep < NREP(1); ++rep) {
        pg8::Gemm g{XB, WinT, M, INW, DM}; pg8::StaticOrder S; S.init(M, INW, F.G, (int)blockIdx.x);
        pg8::EpiIn E{T6, GAB, args.in[4], CS, KSUM};
        pg8::gemm_phase<pg8::EpiIn, pg8::StaticOrder, true, true>(F.lds + RING_OFF, g, S, E);
        if (rep + 1 < NREP(1)) GRID_BAR(); }
        if (BOTH(1)) GRID_BAR();
    }
    if (IN(2)) {
        for (int rep = 0; rep < NREP(2); ++rep) {
        attn_mfma(F, T6 + 3 * TS, T6 + 4 * TS, T6 + 5 * TS, KSUM, AO);
        conv_phase(F, T6, T6 + TS, args.in[5], UC);
        if (rep + 1 < NREP(2)) GRID_BAR(); }
        if (BOTH(2)) GRID_BAR_W(0);
    }
    if (IN(3)) {
        for (int rep = 0; rep < NREP(3); ++rep) {
        pg8::Gemm g{UC, WbcT, M, DM, 1024, AO, WbaT}; pg8::TwoSegOrder S; S.init(M, DM, F.G, (int)blockIdx.x);
        pg8::EpiMerge2 E{GAB, GAB + (size_t)M * DM, MB};
        pg8::gemm_phase<pg8::EpiMerge2, pg8::TwoSegOrder, true, true>(F.lds + RING_OFF, g, S, E);
        if (rep + 1 < NREP(3)) GRID_BAR(); }
        if (BOTH(3)) GRID_BAR_W(1);
    }
    if (IN(5)) {
        for (int rep = 0; rep < NREP(5); ++rep) {
        pg8::Gemm g{MB, WoutT, M, DM, DM}; pg8::StaticOrder S; S.init(M, DM, F.G, (int)blockIdx.x);
        pg8::EpiX1 E{XB, (const float*)(ws + WS_RMS), X1B, (rep + 1 < NREP(5)) ? (unsigned long long*)(ws + 768 * 1024) : SS};
        pg8::gemm_phase<pg8::EpiX1, pg8::StaticOrder, true, true>(F.lds + RING_OFF, g, S, E);
        if (rep + 1 < NREP(5)) GRID_BAR(); }
        if (BOTH(5)) GRID_BAR_W(2);
    }
    if (IN(6)) {
        for (int rep = 0; rep < NREP(6); ++rep) {
        pg8::Gemm g{X1B, WpqT, M, DM, DM}; pg8::StaticOrder S; S.init(M, DM, F.G, (int)blockIdx.x);
        pg8::EpiQP E{SS, QP};
        pg8::gemm_phase<pg8::EpiQP, pg8::StaticOrder, true, true>(F.lds + RING_OFF, g, S, E);
        if (rep + 1 < NREP(6)) GRID_BAR(); }
        if (BOTH(6)) GRID_BAR_W(3);
    }
    if (IN(7)) { for (int rep = 0; rep < NREP(7); ++rep) {
        for (int bitem = F.vcu; bitem < 256; bitem += F.G) {
            topk_stage_keys(F, KEYS, bitem & 7);
            if (N_LAUNCHES == PER_PHASE && bitem == F.vcu) convert_tables(F, args.in[12], args.in[13], args.in[9], ws, 0, 1, 0);
            topk_phase(F, bitem, QP, EXP, GATE);
            asm volatile("s_waitcnt lgkmcnt(0)" ::: "memory"); __builtin_amdgcn_s_barrier(); asm volatile("" ::: "memory");
        }
        if (rep + 1 < NREP(7)) GRID_BAR(); } if (BOTH(7)) GRID_BAR(); }
    if (IN(8)) { for (int rep = 0; rep < NREP(8); ++rep) { peer_phase(F, UB, VB, X1B, EXP, GATE, SS, args.in[14], args.out, (rep + 1 < NREP(8)) ? (float*)(ws + WS_END) : args.out); if (rep + 1 < NREP(8)) GRID_BAR(); } }
#undef IN
#undef BOTH
#undef GRID_BAR
#undef GRID_BAR_W
}

extern "C" void kernel_launch(void* const* d_in, const int* in_sizes, int n_in, void* d_out, int out_size, void* d_ws, size_t ws_size, hipStream_t stream) {
    static int grid = 0;
    if (grid == 0) {
        if (n_in != 15 || in_sizes[0] != M * DM || out_size != M * DM || ws_size < WS_END) { fprintf(stderr, "kernel_launch: unexpected shapes (n_in %d, in0 %d, out %d, ws %zu)\n", n_in, n_in > 0 ? in_sizes[0] : -1, out_size, ws_size); grid = -1; return; }
        int dev = 0, cus = 0, per_cu = 0;
        if (hipGetDevice(&dev) != hipSuccess || hipDeviceGetAttribute(&cus, hipDeviceAttributeMultiprocessorCount, dev) != hipSuccess) { grid = -1; return; }
        if (hipFuncSetAttribute((const void*)mk_fwd, hipFuncAttributeMaxDynamicSharedMemorySize, LDS_BYTES) != hipSuccess) { fprintf(stderr, "kernel_launch: hipFuncSetAttribute failed\n"); grid = -1; return; }
        if (hipOccupancyMaxActiveBlocksPerMultiprocessor(&per_cu, (const void*)mk_fwd, NWAVES * 64, LDS_BYTES) != hipSuccess || per_cu < 1) fprintf(stderr, "kernel_launch: occupancy query reports %d\n", per_cu);
        (void)hipGetLastError();
        grid = cus;
        if (M % (4 * grid * NWAVES) != 0) { fprintf(stderr, "kernel_launch: the PEER phase needs M %% (32 * grid) == 0 (grid %d)\n", grid); grid = -1; return; }
    }
    if (grid < 0) return;
    if (hipMemsetAsync((char*)d_ws + WS_CTL, 0, CTL_ZERO_BYTES, stream) != hipSuccess) { fprintf(stderr, "kernel_launch: memset failed\n"); return; }
    Args a{};
    for (int i = 0; i < 15; ++i) a.in[i] = (const float*)d_in[i];
    a.out = (float*)d_out; a.ws = (unsigned char*)d_ws;
    for (int f = 0; f < 16; ++f) a.invf[f] = pow(500000.0, -(double)(2 * f) / 32.0);
    for (int li = 0; li < N_LAUNCHES; ++li) {
        a.ph_lo = (N_LAUNCHES == PER_PHASE) ? li : 0; a.ph_hi = (N_LAUNCHES == PER_PHASE) ? li + 1 : PER_PHASE; a.li = li;
        hipLaunchKernelGGL(mk_fwd, dim3(grid), dim3(NWAVES * 64), LDS_BYTES, stream, a);
        const hipError_t le = hipPeekAtLastError();
        if (le != hipSuccess) { fprintf(stderr, "kernel_launch: launch %d failed: %s\n", li, hipGetErrorName(le)); break; }
    }
}
```

```cpp
#include <hip/hip_runtime.h>
#include <cstdio>
#include <cstdint>
#include <cmath>
namespace pg8 {
#define PG8_LAS __attribute__((address_space(3)))
typedef unsigned short bf16_t;
typedef short bf16x8 __attribute__((ext_vector_type(8)));
typedef float f32x4 __attribute__((ext_vector_type(4)));
typedef int i32x4 __attribute__((ext_vector_type(4)));
typedef unsigned u32x4 __attribute__((ext_vector_type(4)));
constexpr int BM = 256, BK = 64, HALF = 128, HTB = HALF * BK * 2  , STAGE_BYTES = 8 * HTB, NXCD = 8, WGM = 2;

__host__ __device__ __forceinline__ int lds_byte(int r, int c) { const int st = (r >> 4) * 2 + (c >> 5), rr = r & 15, cc = c & 31, ob = rr * 64 + cc * 2; return st * 1024 + (ob ^ (((ob >> 9) & 1) << 5)); }
__host__ __device__ __forceinline__ void stage_rc(int b, int& R, int& C) { const int st = b / 1024, sb = b % 1024, swz = sb ^ (((sb >> 9) & 1) << 5); R = (st >> 1) * 16 + swz / 64; C = (st & 1) * 32 + (swz % 64) / 2; }
__host__ __device__ __forceinline__ int perm32(int rho) { const int n = rho >> 4, i = rho & 15; return 8 * (i >> 2) + 4 * n + (i & 3); }

struct Unit { int pm, pn, seg; };
struct Gemm { const bf16_t* A; const bf16_t* Bt; int M, N, K; const bf16_t* A2; const bf16_t* Bt2; };

struct StaticOrder {
    int nM, nN, nwg, G, c;
    __host__ __device__ void init(int M, int N, int G_, int c_) { nM = M / BM; nN = N / BM; nwg = nM * nN; G = G_; c = c_; }
    __host__ __device__ bool next(int i, Unit& u) const {
        const long L = (long)i * G + c; if (L >= nwg) return false;
        int wgid = (int)L;
        const int nig = WGM * nN, gid = wgid / nig, fm = gid * WGM, gsz = (nM - fm) < WGM ? (nM - fm) : WGM;
        u.pm = fm + ((wgid % nig) % gsz); u.pn = (wgid % nig) / gsz; u.seg = 0; return true;
    }
    __device__ __forceinline__ void a_ready(const Unit&) const {}
    __device__ __forceinline__ void done(const Unit&) const {}
};
struct TwoSegOrder {
    StaticOrder so;
    __host__ __device__ void init(int M, int N, int G_, int c_) { so.init(M, N, G_, c_); }
    __host__ __device__ bool next(int i, Unit& u) const { if (!so.next(i >> 1, u)) return false; u.seg = i & 1; return true; }
    __device__ __forceinline__ void a_ready(const Unit&) const {}
    __device__ __forceinline__ void done(const Unit&) const {}
};


typedef float f32x2c __attribute__((ext_vector_type(2))); typedef __bf16 bf16x2c __attribute__((ext_vector_type(2)));
__device__ __forceinline__ unsigned cvt_pk_bf16(float lo, float hi) { const f32x2c v = {lo, hi}; const bf16x2c b = __builtin_convertvector(v, bf16x2c); return __builtin_bit_cast(unsigned, b); }
__device__ __forceinline__ u32x4 pack8(f32x4 a, f32x4 b) { u32x4 w; w.x = cvt_pk_bf16(a[0], a[1]); w.y = cvt_pk_bf16(a[2], a[3]); w.z = cvt_pk_bf16(b[0], b[1]); w.w = cvt_pk_bf16(b[2], b[3]); return w; }
__device__ __forceinline__ f32x4 shx(f32x4 v, int o) { f32x4 r; r[0] = __shfl_xor(v[0], o); r[1] = __shfl_xor(v[1], o); r[2] = __shfl_xor(v[2], o); r[3] = __shfl_xor(v[3], o); return r; }
__device__ __forceinline__ f32x4 bf4lo(unsigned a, unsigned b) { f32x4 r; r[0] = __uint_as_float(a << 16); r[1] = __uint_as_float(a & 0xffff0000u); r[2] = __uint_as_float(b << 16); r[3] = __uint_as_float(b & 0xffff0000u); return r; }
__device__ __forceinline__ f32x4 sigm4(f32x4 v) { f32x4 r;
#pragma unroll
    for (int i = 0; i < 4; ++i) r[i] = __builtin_amdgcn_rcpf(1.0f + __expf(-v[i])); return r; }
__device__ __forceinline__ unsigned pk4_i8(float a, float b, float c, float d) {
    const int ia = (int)rintf(fminf(fmaxf(a, -127.f), 127.f)), ib = (int)rintf(fminf(fmaxf(b, -127.f), 127.f)), ic = (int)rintf(fminf(fmaxf(c, -127.f), 127.f)), id = (int)rintf(fminf(fmaxf(d, -127.f), 127.f));
    return (unsigned)(ia & 255) | ((unsigned)(ib & 255) << 8) | ((unsigned)(ic & 255) << 16) | ((unsigned)id << 24); }
constexpr float X1Q_SCALE = 28.0f;
constexpr float MB8_SCALE = 48.0f;
constexpr float HI8_SCALE = 32.0f, WI8_SCALE = 1408.0f;
constexpr float H8_SCALE = 16.0f, W8_SCALE = 64.0f;
constexpr float QSCALE = 0.08838834764831845f * 1.4426950408889634f;

template <int QM> struct EpiIn {
    static constexpr bool PERM = true, AFTER_DRAIN = false, KEEP_SEG0 = false, SEG1_F8 = false;
    static constexpr bool F8 = QM != 0;
    static constexpr float OSC = QM == 1 ? 1.0f / (H8_SCALE * W8_SCALE) : QM == 2 ? 1.0f / (HI8_SCALE * WI8_SCALE) : 1.0f;
    static __device__ __forceinline__ f32x4 cva(f32x4 a) { if constexpr (QM == 2) return __builtin_convertvector(__builtin_bit_cast(i32x4, a), f32x4); else return a; }
    bf16_t* T6; bf16_t* GAB; const float* gbias; const float* cs; float* ksum;
    __device__ __forceinline__ void operator()(const f32x4 (&acc)[2][2][4][2], const Unit& u, int wr, int wc, int fr, int fq) const {
        const int row0 = u.pm * BM + wr * 64 + fr, pn = u.pn + (QM == 1 ? 12 : 0), colw = wc * 32 + 8 * fq;
        if (QM == 0 || pn < 24) {
            const int t = pn >> 2;
            bf16_t* base = T6 + (size_t)t * ((size_t)8192 * 1024) + (pn & 3) * 256 + colw;
            const bool rot = F8 && (t == 3 || t == 4) && (wc == 0), isk = F8 && (t == 4), zt = (QM != 1) && (pn >= 4 && pn < 12);
            const float qs = (F8 && t == 3) ? QSCALE : 1.0f;
            f32x4 ks[2][2];
#pragma unroll
            for (int bj = 0; bj < 2; ++bj) { ks[bj][0] = (f32x4){0.f, 0.f, 0.f, 0.f}; ks[bj][1] = (f32x4){0.f, 0.f, 0.f, 0.f}; }
#pragma unroll
            for (int ai = 0; ai < 2; ++ai)
#pragma unroll
                for (int m = 0; m < 4; ++m) {
                    const int row = row0 + ai * HALF + m * 16;
                    f32x4 c0 = (f32x4){1.f, 1.f, 1.f, 1.f}, c1 = c0, s0 = (f32x4){0.f, 0.f, 0.f, 0.f}, s1 = s0;
                    if (rot) { const float* cp = cs + (size_t)row * 32 + 8 * (fq & 1); c0 = *(const f32x4*)cp; c1 = *(const f32x4*)(cp + 4); s0 = *(const f32x4*)(cp + 16); s1 = *(const f32x4*)(cp + 20);
                        if (fq < 2) { s0 = -s0; s1 = -s1; } }
                    if (zt) {
                        *(u32x4*)(T6 + (size_t)8192 * 1024 + (size_t)row * 1024 + (pn - 4) * 128 + colw) = pack8(cva(acc[ai][0][m][0]) * cva(acc[ai][1][m][0]) * (OSC * OSC), cva(acc[ai][0][m][1]) * cva(acc[ai][1][m][1]) * (OSC * OSC));
                    } else {
#pragma unroll
                    for (int bj = 0; bj < 2; ++bj) {
                        f32x4 v0 = cva(acc[ai][bj][m][0]) * OSC, v1 = cva(acc[ai][bj][m][1]) * OSC;
                        if (rot) { const f32x4 p0 = shx(v0, 32), p1 = shx(v1, 32); v0 = v0 * c0 + p0 * s0; v1 = v1 * c1 + p1 * s1; }
                        if (isk) { ks[bj][0] += v0; ks[bj][1] += v1; }
                        v0 = v0 * qs; v1 = v1 * qs;
                        *(u32x4*)(base + (size_t)row * 1024 + bj * HALF) = pack8(v0, v1);
                    } }
                }
            if (isk) {
#pragma unroll
                for (int bj = 0; bj < 2; ++bj)
#pragma unroll
                    for (int n = 0; n < 2; ++n) { f32x4 v = ks[bj][n]; v += shx(v, 1); v += shx(v, 2); v += shx(v, 4); v += shx(v, 8);
                        if (fr == 0) { float* kp = ksum + (size_t)u.pm * 1024 + (pn & 3) * 256 + bj * HALF + colw + 4 * n;
                            unsafeAtomicAdd(kp + 0, v[0]); unsafeAtomicAdd(kp + 1, v[1]); unsafeAtomicAdd(kp + 2, v[2]); unsafeAtomicAdd(kp + 3, v[3]); } }
            }
        } else {
            const int colg = (pn - 24) * 128 + colw;
            bf16_t* baseR = GAB + colg; bf16_t* baseB = GAB + (size_t)8192 * 2048 + colg;
            const f32x4 ba0 = *(const f32x4*)(gbias + colg), ba1 = *(const f32x4*)(gbias + colg + 4), bb0 = *(const f32x4*)(gbias + 2048 + colg), bb1 = *(const f32x4*)(gbias + 2048 + colg + 4);
#pragma unroll
            for (int ai = 0; ai < 2; ++ai)
#pragma unroll
                for (int m = 0; m < 4; ++m) { const int row = row0 + ai * HALF + m * 16;
                    const f32x4 a0 = sigm4(cva(acc[ai][0][m][0]) * OSC + ba0), a1 = sigm4(cva(acc[ai][0][m][1]) * OSC + ba1); f32x4 b0 = sigm4(cva(acc[ai][1][m][0]) * OSC + bb0), b1 = sigm4(cva(acc[ai][1][m][1]) * OSC + bb1), r0, r1;
#pragma unroll
                    for (int e = 0; e < 4; ++e) { b0[e] = fmaxf(b0[e], 1e-20f); b1[e] = fmaxf(b1[e], 1e-20f); r0[e] = a0[e] * __builtin_amdgcn_rcpf(b0[e]); r1[e] = a1[e] * __builtin_amdgcn_rcpf(b1[e]); }
                    *(u32x4*)(baseR + (size_t)row * 2048) = pack8(r0, r1); *(u32x4*)(baseB + (size_t)row * 2048) = pack8(b0, b1); }
        }
    }
};
typedef unsigned u32x2e __attribute__((ext_vector_type(2)));
struct EpiMerge2 {
    static constexpr bool PERM = true, AFTER_DRAIN = false, KEEP_SEG0 = true, SEG1_F8 = true;
    const bf16_t* R; const bf16_t* GB; bf16_t* O;
    __device__ __forceinline__ void operator()(f32x4 (&acc)[2][2][4][2], const Unit& u, int wr, int wc, int fr, int fq) const {
        const int row0 = u.pm * BM + wr * 64 + fr, col0 = u.pn * BM + wc * 32 + 8 * fq;
        const bf16_t* G = u.seg == 0 ? R : GB; const float sc = u.seg == 0 ? (H8_SCALE * W8_SCALE) : 1.0f / (H8_SCALE * W8_SCALE);
#pragma unroll
        for (int ai = 0; ai < 2; ++ai)
#pragma unroll
            for (int m = 0; m < 4; ++m) { const size_t off = (size_t)(row0 + ai * HALF + m * 16) * 2048 + col0;
#pragma unroll
                for (int bj = 0; bj < 2; ++bj) { const u32x4 g = *(const u32x4*)(G + off + bj * HALF);
                    acc[ai][bj][m][0] = acc[ai][bj][m][0] * (bf4lo(g.x, g.y) * sc); acc[ai][bj][m][1] = acc[ai][bj][m][1] * (bf4lo(g.z, g.w) * sc);
                    if (u.seg != 0) { const f32x4 a = acc[ai][bj][m][0] * MB8_SCALE, b = acc[ai][bj][m][1] * MB8_SCALE; u32x2e w; w.x = pk4_i8(a[0], a[1], a[2], a[3]); w.y = pk4_i8(b[0], b[1], b[2], b[3]);
                        *(u32x2e*)((unsigned char*)O + off + bj * HALF) = w; } } }
    }
};
struct EpiX1 {
    static constexpr bool PERM = true, AFTER_DRAIN = false, KEEP_SEG0 = false, SEG1_F8 = false;
    static constexpr float OSC = 1.0f / (MB8_SCALE * WI8_SCALE);
    const float* X; bf16_t* X1B; unsigned long long* SS; unsigned char* X1Q;
    __device__ __forceinline__ void operator()(const f32x4 (&acc)[2][2][4][2], const Unit& u, int wr, int wc, int fr, int fq) const {
        const int row0 = u.pm * BM + wr * 64 + fr, col0 = u.pn * BM + wc * 32 + 8 * fq;
#pragma unroll
        for (int ai = 0; ai < 2; ++ai)
#pragma unroll
            for (int m = 0; m < 4; ++m) { const int row = row0 + ai * HALF + m * 16; const size_t off = (size_t)row * 2048 + col0; float sq = 0.f;
#pragma unroll
                for (int bj = 0; bj < 2; ++bj) { const f32x4 x0 = *(const f32x4*)(X + off + bj * HALF), x1v = *(const f32x4*)(X + off + bj * HALF + 4); const f32x4 v0 = __builtin_convertvector(__builtin_bit_cast(i32x4, acc[ai][bj][m][0]), f32x4) * OSC + x0, v1 = __builtin_convertvector(__builtin_bit_cast(i32x4, acc[ai][bj][m][1]), f32x4) * OSC + x1v;
                    *(u32x4*)(X1B + off + bj * HALF) = pack8(v0, v1);
                    { const f32x4 a = v0 * X1Q_SCALE, b = v1 * X1Q_SCALE; u32x2e w; w.x = pk4_i8(a[0], a[1], a[2], a[3]); w.y = pk4_i8(b[0], b[1], b[2], b[3]); *(u32x2e*)(X1Q + off + bj * HALF) = w; }
                    sq += (v0[0] * v0[0] + v0[1] * v0[1]) + (v0[2] * v0[2] + v0[3] * v0[3]) + (v1[0] * v1[0] + v1[1] * v1[1]) + (v1[2] * v1[2] + v1[3] * v1[3]); }
                sq += __shfl_xor(sq, 16); sq += __shfl_xor(sq, 32);
                if (fq == 0) atomicAdd(SS + row, (unsigned long long)(sq * 4294967296.0f)); }
    }
};
__device__ __forceinline__ float rinv_from_ss(unsigned long long s) { return 1.0f / sqrtf((float)((double)s * (1.0 / 4294967296.0) * (1.0 / 2048.0)) + 1e-6f); }
struct EpiQP {
    static constexpr bool PERM = true, AFTER_DRAIN = false, KEEP_SEG0 = false, SEG1_F8 = false;
    const unsigned long long* SS; bf16_t* O;
    __device__ __forceinline__ void operator()(const f32x4 (&acc)[2][2][4][2], const Unit& u, int wr, int wc, int fr, int fq) const {
        const int row0 = u.pm * BM + wr * 64 + fr, col0 = u.pn * BM + wc * 32 + 8 * fq;
#pragma unroll
        for (int ai = 0; ai < 2; ++ai)
#pragma unroll
            for (int m = 0; m < 4; ++m) { const int row = row0 + ai * HALF + m * 16; const size_t off = (size_t)row * 2048 + col0; const float rv = rinv_from_ss(SS[row]) * (1.0f / (X1Q_SCALE * WI8_SCALE));
#pragma unroll
                for (int bj = 0; bj < 2; ++bj) *(u32x4*)(O + off + bj * HALF) = pack8(__builtin_convertvector(__builtin_bit_cast(i32x4, acc[ai][bj][m][0]), f32x4) * rv, __builtin_convertvector(__builtin_bit_cast(i32x4, acc[ai][bj][m][1]), f32x4) * rv); }
    }
};

typedef int i32x8 __attribute__((ext_vector_type(8)));
__device__ __forceinline__ i32x8 cat8(bf16x8 a, bf16x8 b) { return __builtin_bit_cast(i32x8, __builtin_shufflevector(a, b, 0, 1, 2, 3, 4, 5, 6, 7, 8, 9, 10, 11, 12, 13, 14, 15)); }
template <class Epi, class Sched, bool ALIGN_EPI = false, bool SP2 = false, int QM = 0>
__device__ __forceinline__ void gemm_phase(PG8_LAS unsigned char* lds, const Gemm g, const Sched& S, const Epi& E) {
    const int tid = threadIdx.x, wid = __builtin_amdgcn_readfirstlane(tid >> 6), lane = tid & 63, wr = wid >> 2, wc = wid & 3, fr = lane & 15, fq = lane >> 4;
    const int K = g.K, nt = K / BK;
    unsigned voffA[2], voffB[2];
#pragma unroll
    for (int i = 0; i < 2; ++i) { int R, C; stage_rc(tid * 16 + i * 8192, R, C); const int Rb = Epi::PERM ? ((R & ~31) + perm32(R & 31)) : R;
        voffA[i] = (unsigned)(R * K + C) * 2u; voffB[i] = (unsigned)(Rb * K + C) * 2u; }
    const size_t kstep = (size_t)(BK * 2);
    const size_t hstep = (size_t)HALF * K * 2;
    const size_t tstep = 2 * hstep;
    const unsigned ldsw = (unsigned)wid * 1024u;
    const int aoff = lds_byte(wr * 64 + fr, fq * 8), boff = lds_byte(wc * 32 + fr, fq * 8);
#define PG8_SA(b, h) (((b) * 2 + (h)) * HTB)
#define PG8_SB(b, h) ((4 + (b) * 2 + (h)) * HTB)
#define PG8_STAGE(bufoff, gbase, voff) do { asm volatile("" : "+v"((voff)[0]), "+v"((voff)[1])); _Pragma("unroll") for (int _i = 0; _i < 2; ++_i) \
        __builtin_amdgcn_global_load_lds((const unsigned*)((const char*)(gbase) + (voff)[_i]), (PG8_LAS unsigned*)(lds + (bufoff) + ldsw + _i * 8192), 16, 0, 0); } while (0)
#define PG8_LDA(dst, b, h) do { _Pragma("unroll") for (int m = 0; m < 4; ++m) _Pragma("unroll") for (int k = 0; k < 2; ++k) dst[m][k] = *(const PG8_LAS bf16x8*)(lds + PG8_SA(b, h) + aoff + m * 2048 + k * 1024); } while (0)
#define PG8_LDB(dst, b, h) do { _Pragma("unroll") for (int n = 0; n < 2; ++n) _Pragma("unroll") for (int k = 0; k < 2; ++k) dst[n][k] = *(const PG8_LAS bf16x8*)(lds + PG8_SB(b, h) + boff + n * 2048 + k * 1024); } while (0)
#define PG8_MMA8(ai, bj, At, Bt) do { _Pragma("unroll") for (int m = 0; m < 4; ++m) _Pragma("unroll") for (int n = 0; n < 2; ++n) \
            acc[ai][bj][m][n] = __builtin_amdgcn_mfma_scale_f32_16x16x128_f8f6f4(cat8(Bt[n][0], Bt[n][1]), cat8(At[m][0], At[m][1]), acc[ai][bj][m][n], 0, 0, 0, 0, 0, 0); } while (0)
#define PG8_MMAI8(ai, bj, At, Bt) do { _Pragma("unroll") for (int m = 0; m < 4; ++m) _Pragma("unroll") for (int n = 0; n < 2; ++n) _Pragma("unroll") for (int k = 0; k < 2; ++k) \
            acc[ai][bj][m][n] = __builtin_bit_cast(f32x4, __builtin_amdgcn_mfma_i32_16x16x64_i8(__builtin_bit_cast(i32x4, Bt[n][k]), __builtin_bit_cast(i32x4, At[m][k]), __builtin_bit_cast(i32x4, acc[ai][bj][m][n]), 0, 0, 0)); } while (0)
#define PG8_MMA16(ai, bj, At, Bt) do { _Pragma("unroll") for (int m = 0; m < 4; ++m) _Pragma("unroll") for (int n = 0; n < 2; ++n) _Pragma("unroll") for (int k = 0; k < 2; ++k) \
            acc[ai][bj][m][n] = __builtin_amdgcn_mfma_f32_16x16x32_bf16(Bt[n][k], At[m][k], acc[ai][bj][m][n], 0, 0, 0); } while (0)
#define PG8_MMA(ai, bj, At, Bt) do { __builtin_amdgcn_s_setprio(1); \
        if constexpr (QM == 1) PG8_MMA8(ai, bj, At, Bt); \
        else if constexpr (QM == 2) PG8_MMAI8(ai, bj, At, Bt); \
        else if constexpr (Epi::SEG1_F8) { if (fl16) PG8_MMA16(ai, bj, At, Bt); if (fl8) PG8_MMA8(ai, bj, At, Bt); } \
        else PG8_MMA16(ai, bj, At, Bt); \
        __builtin_amdgcn_s_setprio(0); } while (0)
#define PG8_WAIT_V(n) asm volatile("s_waitcnt vmcnt(" #n ")" ::: "memory")
#define PG8_WAIT_L(n) asm volatile("s_waitcnt lgkmcnt(" #n ")" ::: "memory")
#define PG8_BAR __builtin_amdgcn_s_barrier()
#define PG8_SCHED __builtin_amdgcn_sched_barrier(0)
    Unit cur, nxt; int ui = 0;
    if (!S.next(0, cur)) return;
    f32x4 acc[2][2][4][2];
#pragma unroll
    for (int a = 0; a < 2; ++a)
#pragma unroll
        for (int b = 0; b < 2; ++b)
#pragma unroll
            for (int m = 0; m < 4; ++m)
#pragma unroll
                for (int n = 0; n < 2; ++n) acc[a][b][m][n] = (f32x4){0.f, 0.f, 0.f, 0.f};
    bf16x8 At[4][2], B0[2][2], B1[2][2];
    const char* cA = (const char*)(cur.seg ? g.A2 : g.A) + (size_t)cur.pm * tstep; const char* cB = (const char*)(cur.seg ? g.Bt2 : g.Bt) + (size_t)cur.pn * tstep;
    S.a_ready(cur);
    if constexpr (SP2) {
        PG8_STAGE(PG8_SB(0, 0), cB, voffB); PG8_STAGE(PG8_SB(0, 1), cB + hstep, voffB); PG8_STAGE(PG8_SA(0, 0), cA, voffA); PG8_STAGE(PG8_SA(0, 1), cA + hstep, voffA);
        if (wr == 1) PG8_BAR;
        PG8_WAIT_V(2); PG8_BAR;
        PG8_STAGE(PG8_SB(1, 0), cB + kstep, voffB); PG8_STAGE(PG8_SA(1, 0), cA + kstep, voffA); PG8_STAGE(PG8_SB(1, 1), cB + hstep + kstep, voffB);
        PG8_WAIT_V(6); PG8_BAR;
    } else {
        PG8_STAGE(PG8_SB(0, 0), cB, voffB); PG8_STAGE(PG8_SA(0, 0), cA, voffA); PG8_STAGE(PG8_SB(0, 1), cB + hstep, voffB); PG8_STAGE(PG8_SA(0, 1), cA + hstep, voffA);
        if (wr == 1) PG8_BAR;
        PG8_WAIT_V(4); PG8_BAR;
        PG8_STAGE(PG8_SB(1, 0), cB + kstep, voffB); PG8_STAGE(PG8_SA(1, 0), cA + kstep, voffA); PG8_STAGE(PG8_SB(1, 1), cB + hstep + kstep, voffB);
        PG8_WAIT_V(6); PG8_BAR;
    }
    for (;;) {
        const bool has_next = S.next(ui + 1, nxt);
        const char* nA = has_next ? (const char*)(nxt.seg ? g.A2 : g.A) + (size_t)nxt.pm * tstep : cA; const char* nB = has_next ? (const char*)(nxt.seg ? g.Bt2 : g.Bt) + (size_t)nxt.pn * tstep : cB;
        const bool f8u = Epi::SEG1_F8 && cur.seg != 0; const int ntu = f8u ? nt / 2 : nt;
        int fl8 = cur.seg, fl16 = cur.seg ^ 1; if constexpr (Epi::SEG1_F8) { asm volatile("" : "+s"(fl8)); asm volatile("" : "+s"(fl16)); }
        for (int t = 0; t < ntu; t += 2) {
            const bool last = (t == ntu - 2);
            const char* a1 = cA + (size_t)(t + 1) * kstep;
            const char* a2 = last ? nA : cA + (size_t)(t + 2) * kstep; const char* b2 = last ? nB : cB + (size_t)(t + 2) * kstep;
            const char* a3 = a2 + kstep; const char* b3 = b2 + kstep;
            if (last && has_next) S.a_ready(nxt);
            if constexpr (SP2) {
            PG8_LDB(B0, 0, 0); PG8_LDB(B1, 0, 1); PG8_SCHED; PG8_LDA(At, 0, 0); PG8_STAGE(PG8_SA(1, 1), a1 + hstep, voffA);
            PG8_WAIT_V(8); PG8_WAIT_L(0); PG8_BAR; PG8_MMA(0, 0, At, B0); PG8_MMA(0, 1, At, B1); PG8_BAR; PG8_SCHED;
            PG8_LDA(At, 0, 1); PG8_STAGE(PG8_SB(0, 0), b2, voffB); PG8_STAGE(PG8_SB(0, 1), b2 + hstep, voffB); PG8_STAGE(PG8_SA(0, 0), a2, voffA);
            PG8_WAIT_V(8); PG8_WAIT_L(0); PG8_BAR; PG8_MMA(1, 0, At, B0); PG8_MMA(1, 1, At, B1); PG8_BAR; PG8_SCHED;
            PG8_LDB(B0, 1, 0); PG8_LDB(B1, 1, 1); PG8_SCHED; PG8_LDA(At, 1, 0); PG8_STAGE(PG8_SA(0, 1), a2 + hstep, voffA);
            PG8_WAIT_V(8); PG8_WAIT_L(0); PG8_BAR; PG8_MMA(0, 0, At, B0); PG8_MMA(0, 1, At, B1); PG8_BAR; PG8_SCHED;
            PG8_LDA(At, 1, 1); PG8_STAGE(PG8_SB(1, 0), b3, voffB); PG8_STAGE(PG8_SB(1, 1), b3 + hstep, voffB); PG8_STAGE(PG8_SA(1, 0), a3, voffA);
            PG8_WAIT_V(8); PG8_WAIT_L(0); PG8_BAR; PG8_MMA(1, 0, At, B0); PG8_MMA(1, 1, At, B1); PG8_BAR; PG8_SCHED;
            } else {
            PG8_LDB(B0, 0, 0); PG8_SCHED; PG8_LDA(At, 0, 0); PG8_STAGE(PG8_SA(1, 1), a1 + hstep, voffA);
            PG8_WAIT_L(8); PG8_BAR; PG8_WAIT_L(0); PG8_MMA(0, 0, At, B0); PG8_BAR; PG8_SCHED;
            PG8_LDB(B1, 0, 1); PG8_STAGE(PG8_SB(0, 0), b2, voffB);
            PG8_BAR; PG8_WAIT_L(0); PG8_MMA(0, 1, At, B1); PG8_BAR;
            PG8_LDA(At, 0, 1); PG8_STAGE(PG8_SA(0, 0), a2, voffA);
            PG8_BAR; PG8_WAIT_L(0); PG8_MMA(1, 0, At, B0); PG8_BAR; PG8_SCHED;
            PG8_STAGE(PG8_SB(0, 1), b2 + hstep, voffB);
            PG8_WAIT_V(6); PG8_BAR; PG8_MMA(1, 1, At, B1); PG8_BAR;
            PG8_LDB(B0, 1, 0); PG8_SCHED; PG8_LDA(At, 1, 0); PG8_STAGE(PG8_SA(0, 1), a2 + hstep, voffA);
            PG8_WAIT_L(8); PG8_BAR; PG8_WAIT_L(0); PG8_MMA(0, 0, At, B0); PG8_BAR; PG8_SCHED;
            PG8_LDB(B1, 1, 1); PG8_STAGE(PG8_SB(1, 0), b3, voffB);
            PG8_BAR; PG8_WAIT_L(0); PG8_MMA(0, 1, At, B1); PG8_BAR;
            PG8_LDA(At, 1, 1); PG8_STAGE(PG8_SA(1, 0), a3, voffA);
            PG8_BAR; PG8_WAIT_L(0); PG8_MMA(1, 0, At, B0); PG8_BAR; PG8_SCHED;
            PG8_STAGE(PG8_SB(1, 1), b3 + hstep, voffB);
            PG8_WAIT_V(6); PG8_BAR; PG8_MMA(1, 1, At, B1); PG8_BAR;
            }
        }
        if constexpr (ALIGN_EPI) { if (wr == 0) PG8_BAR; }
        if constexpr (!Epi::AFTER_DRAIN) { int l_ = tid; asm volatile("" : "+v"(l_));
            E(acc, cur, wr, wc, l_ & 15, (l_ >> 4) & 3); S.done(cur); }
        if (!has_next) break;
        if (!(Epi::KEEP_SEG0 && cur.seg == 0)) {
#pragma unroll
        for (int a = 0; a < 2; ++a)
#pragma unroll
            for (int b = 0; b < 2; ++b)
#pragma unroll
                for (int m = 0; m < 4; ++m)
#pragma unroll
                    for (int n = 0; n < 2; ++n) acc[a][b][m][n] = (f32x4){0.f, 0.f, 0.f, 0.f};
        }
        cur = nxt; cA = nA; cB = nB; ++ui;
        if constexpr (ALIGN_EPI) { if (wr == 1) PG8_BAR; }
    }
    PG8_WAIT_V(0);
    if constexpr (!ALIGN_EPI) { if (wr == 0) PG8_BAR; }
    PG8_BAR;
    if constexpr (Epi::AFTER_DRAIN) { E.fused(acc, cur, wr, wc, fr, fq, lds, wid, lane); S.done(cur); }
#undef PG8_SA
#undef PG8_SB
#undef PG8_STAGE
#undef PG8_LDA
#undef PG8_LDB
#undef PG8_MMA
#undef PG8_MMA8
#undef PG8_MMAI8
#undef PG8_MMA16
#undef PG8_WAIT_V
#undef PG8_WAIT_L
#undef PG8_BAR
#undef PG8_SCHED
}
}

constexpr int NWAVES = 8;
#ifndef MK_N_LAUNCHES
#define MK_N_LAUNCHES 1
#endif
constexpr int PER_PHASE = 9;
#ifndef MK_REP_PHASE
#define MK_REP_PHASE -1
#endif
#define NREP(k) (((k) == MK_REP_PHASE) ? 2 : 1)
constexpr int N_LAUNCHES = MK_N_LAUNCHES;
constexpr int M = 8192, SEQ = 4096, DM = 2048, INW = 10240, NEXP = 16384;
constexpr float RMS_EPS = 1e-6f;
constexpr size_t MiB = 1u << 20;
constexpr size_t WS_CTL = 0, CTL_ZERO_BYTES = 64 * 1024;
constexpr size_t WS_SS = 256 * 1024, WS_KSUM = 512 * 1024;
constexpr size_t WS_WIN = 2 * MiB, WS_WBC = 42 * MiB, WS_WBA = 46 * MiB, WS_WOUT = 50 * MiB, WS_WPQ = 58 * MiB, WS_KEYS = 66 * MiB, WS_CS = 67 * MiB;
constexpr size_t WS_RMS = 68 * MiB;
constexpr size_t WS_UB = 70 * MiB, WS_VB = 102 * MiB;
constexpr size_t WS_XB = 198 * MiB;
constexpr size_t WS_T6 = 230 * MiB;
constexpr size_t WS_GAB = 326 * MiB;
constexpr size_t WS_UC = 390 * MiB, WS_AO = 406 * MiB;
constexpr size_t WS_EXP = 422 * MiB, WS_GATE = 426 * MiB;
constexpr int IN_N16 = 3072;
constexpr size_t WS_WIN8 = WS_WIN + 12 * MiB;
constexpr size_t WS_H8 = 430 * MiB;
constexpr size_t WS_X1Q = 446 * MiB;
constexpr size_t WS_END = 462 * MiB;
constexpr size_t WS_TMP = WS_XB, WS_MB = WS_T6, WS_X1B = WS_T6 + 48 * MiB, WS_QP = WS_GAB;
constexpr int CW_BAR = 4096;
constexpr int RING_OFF = 0, RING_BYTES = 131072;
constexpr int LDSCTL_OFF = RING_BYTES, MISC_OFF = LDSCTL_OFF + 320;
constexpr int LDS_BYTES = 147456;

#define GAS __attribute__((address_space(1)))
#define LAS __attribute__((address_space(3)))
typedef unsigned short bf16;
typedef unsigned v4u __attribute__((ext_vector_type(4)));
typedef float f32x4 __attribute__((ext_vector_type(4)));
typedef short bf16x8 __attribute__((ext_vector_type(8)));
typedef GAS unsigned gu32;
typedef GAS unsigned long long gu64;
#define RLX_AGENT __ATOMIC_RELAXED, __HIP_MEMORY_SCOPE_AGENT
#define LDS_WAIT() asm volatile("s_waitcnt lgkmcnt(0)" ::: "memory")
#define VM_WAIT() asm volatile("s_waitcnt vmcnt(0)" ::: "memory")
__device__ __forceinline__ unsigned long long rt() { return __builtin_amdgcn_s_memrealtime(); }
__device__ __forceinline__ unsigned f2bf(float f) { unsigned u = __builtin_bit_cast(unsigned, f); return (u + 0x7fffu + ((u >> 16) & 1u)) >> 16; }
__device__ __forceinline__ unsigned pk2(float lo, float hi) { return f2bf(lo) | (f2bf(hi) << 16); }

#define XB_TMO      128
#define XB_XCNT(j)  (256  + 64 * (j))
#define XB_XSUB(j)  (1280 + 64 * (j))
#define XB_XGEN(j)  (2304 + 64 * (j))
#define XB_TOP      3328
#define XB_TOPGEN   3392
#define XCD_BAR_WORDS 3456
#define XB_SPIN_CAP (1u << 18)

__device__ __forceinline__ unsigned xb_ld(unsigned* p)              { return __hip_atomic_load(p, __ATOMIC_RELAXED, __HIP_MEMORY_SCOPE_AGENT); }
__device__ __forceinline__ unsigned xb_add(unsigned* p, unsigned v) { return __hip_atomic_fetch_add(p, v, __ATOMIC_RELAXED, __HIP_MEMORY_SCOPE_AGENT); }
__device__ __forceinline__ unsigned xb_xcc_id() { return (unsigned)__builtin_amdgcn_s_getreg((3 << 11) | 20) & 0xFu; }
#define XB_SPIN(cond, bar) do { unsigned _sp = 0; while (cond) { __builtin_amdgcn_s_sleep(1); \
    if ((++_sp & 255u) == 0u) { if (xb_ld(&(bar)[XB_TMO])) break; if (_sp > XB_SPIN_CAP) { atomicAdd(&(bar)[XB_TMO], 1u); break; } } } } while (0)

struct XcdBarrier {
    unsigned* bar; unsigned x;
    volatile LAS unsigned* st;
};

__device__ __forceinline__ XcdBarrier xcd_barrier_post(unsigned* bar, volatile LAS unsigned* st) {
    XcdBarrier b; b.bar = bar; b.x = xb_xcc_id(); b.st = st;
    if (threadIdx.x == 0) (void)xb_add(&bar[XB_XCNT(b.x)], 1u);
    return b;
}
__device__ __forceinline__ void xcd_barrier_complete(unsigned* bar, unsigned x, unsigned& nloc, unsigned& nx) {
    const unsigned G = gridDim.x * gridDim.y * gridDim.z;
    unsigned sum, cnt, mine, sp = 0u;
    for (;;) {
        sum = 0u; cnt = 0u; mine = 0u;
#pragma unroll
        for (unsigned j = 0; j < 16; ++j) { const unsigned c = xb_ld(&bar[XB_XCNT(j)]); sum += c; cnt += (c > 0u) ? 1u : 0u; mine = (j == x) ? c : mine; }
        if (sum == G) break;
        __builtin_amdgcn_s_sleep(1);
        if ((++sp & 255u) == 0u) { if (xb_ld(&bar[XB_TMO])) break; if (sp > XB_SPIN_CAP) { atomicAdd(&bar[XB_TMO], 1u); break; } }
    }
    nloc = mine > 0u ? mine : 1u; nx = cnt > 0u ? cnt : 1u;
}

struct Ctx { LAS unsigned char* lds; int tid, lane, wave, vcu, G; };
struct BarWork { const float* pu; const float* pv; const float* g2; unsigned char* ws; int part, nparts; };
__device__ __forceinline__ void convert_tables(const Ctx& F, const float* pu, const float* pv, const float* g2, unsigned char* ws, int part, int nparts, int w0);
__device__ __forceinline__ void xcd_barrier(const XcdBarrier& b, const Ctx* F = nullptr, const BarWork* wk = nullptr) {
    asm volatile("s_waitcnt vmcnt(0)" ::: "memory");
    __syncthreads();
    if (wk && wk->part >= 0) convert_tables(*F, wk->pu, wk->pv, wk->g2, wk->ws, wk->part, wk->nparts, 1);
    if (threadIdx.x == 0) {
        unsigned* bar = b.bar;
        __builtin_amdgcn_s_waitcnt(0);
        unsigned nloc = b.st[0], nx = b.st[1];
        if (nloc == 0u) { xcd_barrier_complete(bar, b.x, nloc, nx); b.st[0] = nloc; b.st[1] = nx; }
        const unsigned old = xb_add(&bar[XB_XSUB(b.x)], 1u);
        const unsigned gen = old / nloc;
        if (old + 1u == (gen + 1u) * nloc) {
            __builtin_amdgcn_fence(__ATOMIC_RELEASE, "agent");
            asm volatile("s_waitcnt vmcnt(0)" ::: "memory");
            const unsigned og = xb_add(&bar[XB_TOP], 1u);
            const unsigned tg = og / nx;
            if (og + 1u == (tg + 1u) * nx) xb_add(&bar[XB_TOPGEN], 1u);
            else XB_SPIN(xb_ld(&bar[XB_TOPGEN]) == tg, bar);
            __builtin_amdgcn_fence(__ATOMIC_ACQUIRE, "agent");
            xb_add(&bar[XB_XGEN(b.x)], 1u);
            asm volatile("s_waitcnt vmcnt(0)" ::: "memory");
        } else {
            XB_SPIN(xb_ld(&bar[XB_XGEN(b.x)]) == gen, bar);
            __builtin_amdgcn_fence(__ATOMIC_ACQUIRE, "agent");
            asm volatile("s_waitcnt vmcnt(0)" ::: "memory");
        }
    }
    __syncthreads();
}

typedef __bf16 bf16x2v __attribute__((ext_vector_type(2)));
typedef float f32x16 __attribute__((ext_vector_type(16)));
__device__ __forceinline__ float bflo(unsigned w) { return __uint_as_float(w << 16); }
__device__ __forceinline__ float bfhi(unsigned w) { return __uint_as_float(w & 0xffff0000u); }
__device__ __forceinline__ float dot2bf(unsigned a, unsigned b, float c) { return __builtin_amdgcn_fdot2_f32_bf16(__builtin_bit_cast(bf16x2v, a), __builtin_bit_cast(bf16x2v, b), c, false); }
__device__ __forceinline__ float wave_sum(float v) {
#pragma unroll
    for (int o = 1; o < 64; o <<= 1) v += __shfl_xor(v, o);
    return v; }
__device__ __forceinline__ float wave_max(float v) {
#pragma unroll
    for (int o = 1; o < 64; o <<= 1) v = fmaxf(v, __shfl_xor(v, o));
    return v; }
__device__ __forceinline__ float rdlane(float v, int l) { return __int_as_float(__builtin_amdgcn_readlane(__float_as_int(v), l)); }
__device__ __forceinline__ float gelu_tanh(float x) { const float z = 0.7978845608028654f * (x + 0.044715f * x * x * x); const float e = __expf(2.0f * z); const float th = 1.0f - 2.0f * __builtin_amdgcn_rcpf(1.0f + e); return 0.5f * x * (1.0f + th); }


typedef unsigned u32x2v __attribute__((ext_vector_type(2)));
struct TItem { const float* W; bf16* WT; const float* gk; int K, N, k0, n0, dn0; int f8; int ld; };
__device__ __forceinline__ TItem p0_titem(const float* W, int K, int N, bf16* WT, const float* gk, int item, bool remap, int f8_from = 1 << 30, unsigned char* WT8 = nullptr, int ld8 = 0, int qmode = 1) {
    const int nblk = N / 32, kb = 2 * (item / (2 * nblk)) + (item & 1), nb = (item >> 1) % nblk, k0 = 64 * kb, n0 = 32 * nb;
    int dn0 = n0; if (remap && n0 >= 1024 && n0 < 3072) { const int c = (n0 - 1024) & 1023, isx = (n0 >= 2048); dn0 = 1024 + (c >> 7) * 256 + isx * 128 + (c & 127); }
    if (remap && n0 >= 6144) { const int c = (n0 - 6144) & 2047, isb = (n0 >= 8192); dn0 = 6144 + (c >> 7) * 256 + isb * 128 + (c & 127); }
    const int f8 = dn0 >= f8_from ? qmode : 0; if (f8) { WT = (bf16*)WT8; dn0 -= f8_from; }
    return TItem{W, WT, gk, K, N, k0, n0, dn0, f8, f8 ? (ld8 ? ld8 : K) : K};
}
__device__ __forceinline__ void p0_tload(const TItem& t, f32x4 (&v)[8], int lane) {
#pragma unroll
    for (int i = 0; i < 8; ++i) { const int kk = 8 * i + (lane >> 3), nn = 4 * (lane & 7); v[i] = *(const GAS f32x4*)(t.W + (size_t)(t.k0 + kk) * t.N + t.n0 + nn); if (t.gk) v[i] = v[i] * t.gk[t.k0 + kk]; }
}
__device__ __forceinline__ void p0_tfinish(const TItem& t, const f32x4 (&v)[8], LAS float* scr, int lane) {
#pragma unroll
    for (int i = 0; i < 8; ++i) { const int kk = 8 * i + (lane >> 3), nn = 4 * (lane & 7); scr[kk * 33 + nn] = v[i][0]; scr[kk * 33 + nn + 1] = v[i][1]; scr[kk * 33 + nn + 2] = v[i][2]; scr[kk * 33 + nn + 3] = v[i][3]; }
    LDS_WAIT(); asm volatile("" ::: "memory");
    const int c = lane & 7;
    if (t.f8) {
#pragma unroll
        for (int j = 0; j < 4; ++j) { const int n = (lane >> 3) + 8 * j; const LAS float* s = scr + (8 * c) * 33 + n; int w0 = 0, w1 = 0;
            if (t.f8 == 1) {
            w0 = __builtin_amdgcn_cvt_pk_fp8_f32(s[0 * 33] * pg8::W8_SCALE, s[1 * 33] * pg8::W8_SCALE, w0, false); w0 = __builtin_amdgcn_cvt_pk_fp8_f32(s[2 * 33] * pg8::W8_SCALE, s[3 * 33] * pg8::W8_SCALE, w0, true);
            w1 = __builtin_amdgcn_cvt_pk_fp8_f32(s[4 * 33] * pg8::W8_SCALE, s[5 * 33] * pg8::W8_SCALE, w1, false); w1 = __builtin_amdgcn_cvt_pk_fp8_f32(s[6 * 33] * pg8::W8_SCALE, s[7 * 33] * pg8::W8_SCALE, w1, true);
            } else { w0 = (int)pg8::pk4_i8(s[0 * 33] * pg8::WI8_SCALE, s[1 * 33] * pg8::WI8_SCALE, s[2 * 33] * pg8::WI8_SCALE, s[3 * 33] * pg8::WI8_SCALE); w1 = (int)pg8::pk4_i8(s[4 * 33] * pg8::WI8_SCALE, s[5 * 33] * pg8::WI8_SCALE, s[6 * 33] * pg8::WI8_SCALE, s[7 * 33] * pg8::WI8_SCALE); }
            u32x2v o; o.x = (unsigned)w0; o.y = (unsigned)w1;
            *(GAS u32x2v*)((GAS unsigned char*)t.WT + (size_t)(t.dn0 + n) * t.ld + t.k0 + 8 * c) = o; }
        LDS_WAIT(); asm volatile("" ::: "memory");
        return; }
#pragma unroll
    for (int j = 0; j < 4; ++j) { const int n = (lane >> 3) + 8 * j; const LAS float* s = scr + (8 * c) * 33 + n;
        v4u o; o.x = pk2(s[0 * 33], s[1 * 33]); o.y = pk2(s[2 * 33], s[3 * 33]); o.z = pk2(s[4 * 33], s[5 * 33]); o.w = pk2(s[6 * 33], s[7 * 33]);
        *(GAS v4u*)(t.WT + (size_t)(t.dn0 + n) * t.K + t.k0 + 8 * c) = o; }
    LDS_WAIT(); asm volatile("" ::: "memory");
}
typedef unsigned u32x6 __attribute__((ext_vector_type(6))); typedef __bf16 bf16x2v __attribute__((ext_vector_type(2))); typedef __bf16 bf16x32v __attribute__((ext_vector_type(32))); typedef float f32x16v __attribute__((ext_vector_type(16))); typedef float f32x32v __attribute__((ext_vector_type(32)));
constexpr float PEER_SU = 90.5f, PEER_SV = 5.66f;
constexpr int PEER_ROWB = 1536;
__device__ __forceinline__ void convert_tables(const Ctx& F, const float* pu, const float* pv, const float* g2, unsigned char* ws, int part, int nparts, int w0) {
    if (F.wave < w0) return;
    const int nw = NWAVES - w0, gt = (F.vcu * nw + (F.wave - w0)) * 64 + F.lane, NT = F.G * nw * 64;
    constexpr int TOT = NEXP * 64; const int per = (TOT + nparts - 1) / nparts, lo = part * per, hi = (lo + per < TOT) ? lo + per : TOT;
    for (int i = lo + gt; i < hi; i += NT) { const int e = i >> 6, l = i & 63;
        const GAS f32x4* ur = (const GAS f32x4*)(pu + (size_t)e * 2048 + 16 * l); const GAS f32x4* vr = (const GAS f32x4*)(pv + (size_t)e * 2048 + 16 * l); const GAS f32x4* gr = (const GAS f32x4*)(g2 + 16 * l);
        f32x32v uf, vf;
#pragma unroll
        for (int q = 0; q < 4; ++q) { const f32x4 a = ur[q] * gr[q] * PEER_SU, b = ur[256 + q] * gr[256 + q] * PEER_SU, c = vr[q] * PEER_SV, d = vr[256 + q] * PEER_SV;
#pragma unroll
            for (int t = 0; t < 4; ++t) { uf[4 * q + t] = a[t]; uf[16 + 4 * q + t] = b[t]; vf[4 * q + t] = c[t]; vf[16 + 4 * q + t] = d[t]; } }
        const u32x6 wu = __builtin_amdgcn_cvt_scalef32_pk32_fp6_bf16(__builtin_convertvector(uf, bf16x32v), 1.0f), wv = __builtin_amdgcn_cvt_scalef32_pk32_fp6_bf16(__builtin_convertvector(vf, bf16x32v), 1.0f);
        GAS unsigned char* du = (GAS unsigned char*)(ws + WS_UB + (size_t)e * PEER_ROWB); GAS unsigned char* dv = (GAS unsigned char*)(ws + WS_VB + (size_t)e * PEER_ROWB);
        v4u o; u32x2v o2;
        o.x = wu[0]; o.y = wu[1]; o.z = wu[2]; o.w = wu[3]; o2.x = wu[4]; o2.y = wu[5]; *(GAS v4u*)(du + 16 * l) = o; *(GAS u32x2v*)(du + 1024 + 8 * l) = o2;
        o.x = wv[0]; o.y = wv[1]; o.z = wv[2]; o.w = wv[3]; o2.x = wv[4]; o2.y = wv[5]; *(GAS v4u*)(dv + 16 * l) = o; *(GAS u32x2v*)(dv + 1024 + 8 * l) = o2; }
}
__device__ __forceinline__ void p0_prologue(const Ctx& F, const float* const* in, unsigned char* ws, const double* invf) {
    const float* x = in[0]; const int* pos = (const int*)in[1]; const float* g1 = in[2]; const float* w_in = in[3];
    const float* w_bc = in[6]; const float* w_ba = in[7]; const float* w_out = in[8]; const float* g2 = in[9]; const float* w_pq = in[10];
    const float* keys = in[11]; const float* pu = in[12]; const float* pv = in[13];
    LAS float* scr = (LAS float*)(F.lds + RING_OFF + F.wave * 16384);
    const int gw = F.vcu * NWAVES + F.wave, NGW = F.G * NWAVES;
    const int gt = gw * 64 + F.lane, NT = NGW * 64;
    for (int i = gt; i < 8192; i += NT) ((GAS unsigned long long*)(ws + WS_SS))[i] = 0ull;
    for (int i = gt; i < 32 * 1024; i += NT) ((GAS float*)(ws + WS_KSUM))[i] = 0.f;
    constexpr int I_IN = 32 * 320, I_BC = 16 * 64, I_OUT = 32 * 64;
    constexpr int NITEMS = I_IN + 2 * I_BC + 2 * I_OUT;
    auto decode = [&](int it) -> TItem { int r = it;
        if (r < I_IN) return p0_titem(w_in, 2048, INW, (bf16*)(ws + WS_WIN), g1, r, true, 0, ws + WS_WIN, 0, 2); r -= I_IN;
        if (r < I_BC) return p0_titem(w_bc, 1024, 2048, (bf16*)(ws + WS_WBC), nullptr, r, false); r -= I_BC;
        if (r < I_BC) return p0_titem(w_ba, 1024, 2048, (bf16*)(ws + WS_WBA), nullptr, r, false, 0, ws + WS_WBA, 2048); r -= I_BC;
        if (r < I_OUT) return p0_titem(w_out, 2048, 2048, (bf16*)(ws + WS_WOUT), nullptr, r, false, 0, ws + WS_WOUT, 0, 2); r -= I_OUT;
        return p0_titem(w_pq, 2048, 2048, (bf16*)(ws + WS_WPQ), g2, r, false, 0, ws + WS_WPQ, 0, 2); };
    {
        int it = gw; TItem A, B; f32x4 va[8], vb[8];
        bool hasA = it < NITEMS; if (hasA) { A = decode(it); p0_tload(A, va, F.lane); }
        while (hasA) {
            const int it2 = it + NGW; const bool hasB = it2 < NITEMS; if (hasB) { B = decode(it2); p0_tload(B, vb, F.lane); }
            p0_tfinish(A, va, scr, F.lane);
            if (!hasB) break;
            const int it3 = it2 + NGW; hasA = it3 < NITEMS; if (hasA) { A = decode(it3); p0_tload(A, va, F.lane); }
            p0_tfinish(B, vb, scr, F.lane);
            it = it3;
        }
    }
    for (int i = gt; i < 16 * 128 * 128 / 8; i += NT) { const f32x4 a = ((const GAS f32x4*)keys)[2 * i], b = ((const GAS f32x4*)keys)[2 * i + 1];
        v4u o; o.x = pk2(a[0], a[1]); o.y = pk2(a[2], a[3]); o.z = pk2(b[0], b[1]); o.w = pk2(b[2], b[3]); ((GAS v4u*)(ws + WS_KEYS))[i] = o; }
    for (int m = gw; m < M; m += NGW) { const GAS f32x4* xr = (const GAS f32x4*)(x + (size_t)m * DM);
        f32x4 v[8]; float s = 0.f;
#pragma unroll
        for (int i = 0; i < 4; ++i) { v[2 * i] = xr[i * 128 + 2 * F.lane]; v[2 * i + 1] = xr[i * 128 + 2 * F.lane + 1]; }
#pragma unroll
        for (int i = 0; i < 8; ++i) s += (v[i][0] * v[i][0] + v[i][1] * v[i][1]) + (v[i][2] * v[i][2] + v[i][3] * v[i][3]);
        const float rms = sqrtf(wave_sum(s) * (1.0f / DM) + RMS_EPS), rinv = 1.0f / rms;
#pragma unroll
        for (int i = 0; i < 4; ++i) { const f32x4 a = v[2 * i] * rinv, b = v[2 * i + 1] * rinv;
            const f32x4 a8 = a * pg8::HI8_SCALE, b8 = b * pg8::HI8_SCALE;
            const unsigned w0 = pg8::pk4_i8(a8[0], a8[1], a8[2], a8[3]), w1 = pg8::pk4_i8(b8[0], b8[1], b8[2], b8[3]);
            u32x2v o8; o8.x = (unsigned)w0; o8.y = (unsigned)w1; ((GAS u32x2v*)(ws + WS_H8 + (size_t)m * DM))[i * 64 + F.lane] = o8; } }
    for (int i = gt; i < M * 16; i += NT) { const int row = i >> 4, f = i & 15; const double ang = (double)pos[row] * invf[f];
        const double k = __builtin_rint(ang * 0.15915494309189535); const float r = (float)(ang - k * 6.283185307179586);
        float* cs = (float*)(ws + WS_CS); cs[row * 32 + f] = __cosf(r); cs[row * 32 + 16 + f] = __sinf(r); }
}

__device__ __forceinline__ void attn_simple(const Ctx& F, const bf16* Q, const bf16* K, const bf16* V, const float* ksum, bf16* AO) {
    LAS float* qf = (LAS float*)(F.lds + RING_OFF + F.wave * 512);
    const int gw = F.vcu * NWAVES + F.wave, NGW = F.G * NWAVES, lane = F.lane;
    for (int item = gw; item < 16 * SEQ; item += NGW) {
        const int bh = item >> 12, t = item & 4095, b = bh >> 3, h = bh & 7, blk = t >> 8;
        const size_t row = (size_t)b * SEQ + t;
        { const unsigned qq = *(const GAS unsigned*)(Q + row * 1024 + h * 128 + 2 * lane); qf[2 * lane] = bflo(qq); qf[2 * lane + 1] = bfhi(qq); }
        LDS_WAIT(); asm volatile("" ::: "memory");
        float g = -INFINITY;
        if (lane < blk) { const GAS f32x4* km = (const GAS f32x4*)(ksum + (size_t)(b * 16 + lane) * 1024 + h * 128); float a = 0.f;
            for (int d = 0; d < 32; ++d) { const f32x4 kv = km[d]; const f32x4 qv = *(const LAS f32x4*)(qf + 4 * d); a += (kv[0] * qv[0] + kv[1] * qv[1]) + (kv[2] * qv[2] + kv[3] * qv[3]); }
            g = a; }
        int sel[3];
#pragma unroll
        for (int i = 0; i < 3; ++i) { const float mx = wave_max(g); const unsigned long long bal = __ballot(g == mx && lane < blk); const int idx = bal ? (__ffsll((long long)bal) - 1) : 0; sel[i] = idx; if (lane == idx) g = -INFINITY; }
        const int nsel = blk < 3 ? blk : 3;
        float sc[4][4]; float mx = -INFINITY;
#pragma unroll
        for (int slot = 0; slot < 4; ++slot) {
            const bool valid = (slot == 3) || (slot < nsel);
            const int kb = (slot == 3) ? blk : sel[slot < 3 ? slot : 0];
#pragma unroll
            for (int r = 0; r < 4; ++r) {
                float s = -INFINITY; const int key0 = kb * 256 + r * 64;
                if (valid && (slot < 3 || key0 <= t)) {
                    const int key = key0 + lane; const GAS v4u* kp = (const GAS v4u*)(K + ((size_t)b * SEQ + key) * 1024 + h * 128); float a = 0.f;
#pragma unroll 4
                    for (int d = 0; d < 16; ++d) { const v4u kk = kp[d]; const f32x4 q0 = *(const LAS f32x4*)(qf + 8 * d), q1 = *(const LAS f32x4*)(qf + 8 * d + 4);
                        a += (bflo(kk.x) * q0[0] + bfhi(kk.x) * q0[1]) + (bflo(kk.y) * q0[2] + bfhi(kk.y) * q0[3]) + (bflo(kk.z) * q1[0] + bfhi(kk.z) * q1[1]) + (bflo(kk.w) * q1[2] + bfhi(kk.w) * q1[3]); }
                    s = (slot < 3 || key <= t) ? a : -INFINITY; }
                sc[slot][r] = s; mx = fmaxf(mx, s); } }
        mx = wave_max(mx);
        float sum = 0.f;
#pragma unroll
        for (int slot = 0; slot < 4; ++slot)
#pragma unroll
            for (int r = 0; r < 4; ++r) { sc[slot][r] = exp2f(sc[slot][r] - mx); sum += sc[slot][r]; }
        sum = wave_sum(sum);
        float o0 = 0.f, o1 = 0.f;
#pragma unroll
        for (int slot = 0; slot < 4; ++slot) {
            const bool valid = (slot == 3) || (slot < nsel);
            const int kb = (slot == 3) ? blk : sel[slot < 3 ? slot : 0];
#pragma unroll
            for (int r = 0; r < 4; ++r) { const int key0 = kb * 256 + r * 64;
                if (valid && (slot < 3 || key0 <= t)) { const float pr = sc[slot][r]; const GAS unsigned* vp = (const GAS unsigned*)(V + ((size_t)b * SEQ + key0) * 1024 + h * 128) + lane;
                    for (int kk = 0; kk < 64; ++kk) { const float pk = rdlane(pr, kk); const unsigned vv = vp[(size_t)kk * 512]; o0 += pk * bflo(vv); o1 += pk * bfhi(vv); } } } }
        const float ri = 1.0f / sum;
        *(GAS unsigned*)(AO + row * 1024 + h * 128 + 2 * lane) = pk2(o0 * ri, o1 * ri);
    }
}
constexpr float ATTN_THR = 8.0f;
typedef short v4i16_t __attribute__((ext_vector_type(4)));
__device__ __forceinline__ v4i16_t vtr16(unsigned addr) { return __builtin_amdgcn_ds_read_tr16_b64_v4i16((LAS v4i16_t*)(uintptr_t)addr); }
__device__ __forceinline__ int crow16(int r, int hh) { return (r & 3) + 8 * (r >> 2) + 4 * hh; }
__device__ __forceinline__ void attn_dma_step(const bf16* K, const bf16* V, LAS unsigned char* lds, int b, int h, int qb, int n_own, int st, int buf, int wave, int lane) {
    int lq = lane; asm volatile("" : "+v"(lq));
#pragma unroll
    for (int img = 0; img < 4; ++img) {
        const int T = 2 * st + (img >> 1); const bool isV = img & 1;
        const int blk = (T < n_own) ? qb : ((T - n_own) >> 2), kt = (T < n_own) ? T : ((T - n_own) & 3);
        const char* base = (const char*)((isV ? V : K) + ((size_t)b * SEQ + 256 * blk + 64 * kt) * 1024 + h * 128);
#pragma unroll
        for (int i = 0; i < 2; ++i) { const int pc = wave + 8 * i, row = 4 * pc + (lq >> 4), cp = lq & 15;
            const int c = isV ? ((((cp >> 2) ^ (row & 3)) << 2) | (cp & 3)) : (cp ^ (row & 15));
            const unsigned off = (unsigned)(row * 2048 + 16 * c);
            __builtin_amdgcn_global_load_lds((const unsigned*)(base + off), (LAS unsigned*)(lds + buf * 65536 + img * 16384 + pc * 1024), 16, 0, 0); }
    }
}
__device__ __forceinline__ void attn_mfma(const Ctx& F, const bf16* Q, const bf16* K, const bf16* V, const float* ksum, bf16* AO) {
    const int lane = F.lane, wave = F.wave, q31 = lane & 31, hh = lane >> 5, wq = wave & 3, kvh = wave >> 2, l16 = lane & 15, G4 = lane >> 4;
    LAS unsigned char* lds = F.lds + RING_OFF;
    const unsigned lds0 = (unsigned)(uintptr_t)lds;
    for (int pr = F.vcu; pr < 256; pr += F.G)
#pragma unroll 1
    for (int pi = 0; pi < 2; ++pi) {
        const int bh = pr >> 4, s_ = pr & 15, u128 = pi ? 31 - s_ : s_, b = bh >> 3, h = bh & 7, qb = u128 >> 1, half = u128 & 1;
        const int n_own = half ? 4 : 2, nstep = (n_own + 4 * qb) >> 1;
        const size_t rowq = (size_t)b * SEQ + 256 * qb + 128 * half + 32 * wq + q31;
        asm volatile("s_waitcnt vmcnt(0) lgkmcnt(0)" ::: "memory"); __builtin_amdgcn_s_barrier(); asm volatile("" ::: "memory");
        attn_dma_step(K, V, lds, b, h, qb, n_own, 0, 0, wave, lane);
        bf16x8 qf[8];
#pragma unroll
        for (int s = 0; s < 8; ++s) qf[s] = *(const GAS bf16x8*)(Q + rowq * 1024 + h * 128 + 16 * s + 8 * hh);
        unsigned selmask;
        {
            f32x16 gt;
#pragma unroll
            for (int r = 0; r < 16; ++r) gt[r] = 0.f;
            const int jr = lane & 31; const bool jv = jr < qb;
            const GAS f32x4* kp = (const GAS f32x4*)(ksum + (size_t)(b * 16 + (jv ? jr : 0)) * 1024 + h * 128 + 8 * hh);
            f32x4 kf[16];
#pragma unroll
            for (int s = 0; s < 8; ++s) { kf[2 * s] = kp[4 * s]; kf[2 * s + 1] = kp[4 * s + 1]; }
#pragma unroll
            for (int s = 0; s < 8; ++s) { v4u w = pg8::pack8(kf[2 * s], kf[2 * s + 1]); if (!jv) { w.x = 0u; w.y = 0u; w.z = 0u; w.w = 0u; }
                gt = __builtin_amdgcn_mfma_f32_32x32x16_bf16(__builtin_bit_cast(bf16x8, w), qf[s], gt, 0, 0, 0); }
            float g16[16];
#pragma unroll
            for (int r = 0; r < 8; ++r) { const auto rr = __builtin_amdgcn_permlane32_swap(__float_as_uint(gt[r]), __float_as_uint(gt[r]), false, false);
                g16[(r & 3) + 8 * (r >> 2)] = __uint_as_float(rr[0]); g16[(r & 3) + 8 * (r >> 2) + 4] = __uint_as_float(rr[1]); }
            float v0 = -INFINITY, v1 = -INFINITY, v2 = -INFINITY; int i0 = 0, i1 = 0, i2 = 0;
#pragma unroll
            for (int j = 0; j < 16; ++j) { const float a = (j < qb) ? g16[j] : -INFINITY;
                if (a > v0) { v2 = v1; i2 = i1; v1 = v0; i1 = i0; v0 = a; i0 = j; } else if (a > v1) { v2 = v1; i2 = i1; v1 = a; i1 = j; } else if (a > v2) { v2 = a; i2 = j; } }
            selmask = (qb <= 3) ? ((1u << qb) - 1u) : ((1u << i0) | (1u << i1) | (1u << i2));
        }
        float m_run = -1e30f, l_run = 0.f; f32x16 o[4];
#pragma unroll
        for (int db = 0; db < 4; ++db)
#pragma unroll
            for (int r = 0; r < 16; ++r) o[db][r] = 0.f;
        const int qin = 128 * half + 32 * wq + q31;
#pragma unroll 1
        for (int st2 = 0; st2 < nstep; st2 += 2)
#pragma unroll
        for (int par = 0; par < 2; ++par) { const int st = st2 + par; if (st < nstep) {
            asm volatile("s_waitcnt vmcnt(0)" ::: "memory"); __builtin_amdgcn_s_barrier(); asm volatile("" ::: "memory");
            if (st + 1 < nstep) attn_dma_step(K, V, lds, b, h, qb, n_own, st + 1, par ^ 1, wave, lane);
            const int T = 2 * st + kvh; const bool own = T < n_own;
            const int blk = own ? qb : ((T - n_own) >> 2), kt = own ? T : ((T - n_own) & 3);
            const bool sel = own ? true : ((selmask >> blk) & 1u);
            const bool skip = own ? (64 * kt > 128 * half + 32 * wq + 31) : (__ballot(sel) == 0ull);
            if (!skip) {
                const unsigned kimg = lds0 + par * 65536 + kvh * 32768, vimg = kimg + 16384;
                f32x16 p[2];
                __builtin_amdgcn_s_setprio(1);
#pragma unroll
                for (int kh = 0; kh < 2; ++kh) {
#pragma unroll
                    for (int r = 0; r < 16; ++r) p[kh][r] = 0.f;
                    const int row = 32 * kh + q31;
#pragma unroll
                    for (int s = 0; s < 8; ++s) { const bf16x8 a = *(const LAS bf16x8*)(uintptr_t)(kimg + row * 256 + (((2 * s + hh) ^ (row & 15)) << 4));
                        p[kh] = __builtin_amdgcn_mfma_f32_32x32x16_bf16(a, qf[s], p[kh], 0, 0, 0); }
                }
                __builtin_amdgcn_s_setprio(0);
                if (own) { const int kbase = 64 * kt;
                    if (kbase + 63 > 128 * half + 32 * wq) {
#pragma unroll
                        for (int kh = 0; kh < 2; ++kh)
#pragma unroll
                            for (int r = 0; r < 16; ++r) if (kbase + 32 * kh + crow16(r, hh) > qin) p[kh][r] = -INFINITY; }
                }
                float mx = p[0][0];
#pragma unroll
                for (int r = 1; r < 16; ++r) mx = fmaxf(mx, p[0][r]);
#pragma unroll
                for (int r = 0; r < 16; ++r) mx = fmaxf(mx, p[1][r]);
                { const auto rr = __builtin_amdgcn_permlane32_swap(__float_as_uint(mx), __float_as_uint(mx), false, false); mx = fmaxf(__uint_as_float(rr[0]), __uint_as_float(rr[1])); }
                if (!sel) mx = -INFINITY;
                float scl = 1.0f;
                if (__ballot(mx > m_run + ATTN_THR) != 0ull) { const float m_new = fmaxf(m_run, mx); scl = __builtin_amdgcn_exp2f(m_run - m_new); m_run = m_new;
#pragma unroll
                    for (int db = 0; db < 4; ++db)
#pragma unroll
                        for (int r = 0; r < 16; ++r) o[db][r] *= scl; }
                float rs = 0.f;
#pragma unroll
                for (int kh = 0; kh < 2; ++kh)
#pragma unroll
                    for (int r = 0; r < 16; ++r) { p[kh][r] = __builtin_amdgcn_exp2f(p[kh][r] - m_run); rs += p[kh][r]; }
                l_run = l_run * scl + (sel ? rs : 0.f);
                const unsigned pmask = sel ? 0xffffffffu : 0u;
                bf16x8 pb[4];
#pragma unroll
                for (int gi = 0; gi < 4; ++gi) { const int kh = gi >> 1, s2 = gi & 1; v4u pw;
                    pw.x = pg8::cvt_pk_bf16(p[kh][8 * s2], p[kh][8 * s2 + 1]) & pmask; pw.y = pg8::cvt_pk_bf16(p[kh][8 * s2 + 2], p[kh][8 * s2 + 3]) & pmask;
                    pw.z = pg8::cvt_pk_bf16(p[kh][8 * s2 + 4], p[kh][8 * s2 + 5]) & pmask; pw.w = pg8::cvt_pk_bf16(p[kh][8 * s2 + 6], p[kh][8 * s2 + 7]) & pmask;
                    pb[gi] = __builtin_bit_cast(bf16x8, pw); }
                v4i16_t lo[2][2], hi_[2][2];
                const int dsub = 16 * (G4 & 1) + 4 * (l16 & 3);
#define ATTN_VREADS(u, S) { const int key0_ = 32 * ((u) >> 2) + 16 * (((u) >> 1) & 1) + 4 * (G4 >> 1) + (l16 >> 2); _Pragma("unroll") for (int d2 = 0; d2 < 2; ++d2) { const int db = 2 * ((u) & 1) + d2; \
                    const unsigned a0_ = vimg + key0_ * 256 + ((db ^ (key0_ & 3)) << 6) + dsub * 2; \
                    asm volatile("ds_read_b64_tr_b16 %0, %1" : "=&v"(lo[S][d2]) : "v"(a0_) : "memory"); \
                    asm volatile("ds_read_b64_tr_b16 %0, %1 offset:2048" : "=&v"(hi_[S][d2]) : "v"(a0_) : "memory"); } }
#define ATTN_VWAIT(S, N) asm volatile("s_waitcnt lgkmcnt(" #N ")" : "+v"(lo[S][0]), "+v"(lo[S][1]), "+v"(hi_[S][0]), "+v"(hi_[S][1]) :: "memory")
#define ATTN_PV(u, S) { _Pragma("unroll") for (int d2 = 0; d2 < 2; ++d2) { const int db = 2 * ((u) & 1) + d2; const bf16x8 av = {lo[S][d2][0], lo[S][d2][1], lo[S][d2][2], lo[S][d2][3], hi_[S][d2][0], hi_[S][d2][1], hi_[S][d2][2], hi_[S][d2][3]}; \
                    o[db] = __builtin_amdgcn_mfma_f32_32x32x16_bf16(av, pb[(u) >> 1], o[db], 0, 0, 0); } }
                __builtin_amdgcn_s_setprio(1);
                ATTN_VREADS(0, 0)
                ATTN_VREADS(1, 1) ATTN_VWAIT(0, 4); ATTN_PV(0, 0)
                ATTN_VREADS(2, 0) ATTN_VWAIT(1, 4); ATTN_PV(1, 1)
                ATTN_VREADS(3, 1) ATTN_VWAIT(0, 4); ATTN_PV(2, 0)
                ATTN_VREADS(4, 0) ATTN_VWAIT(1, 4); ATTN_PV(3, 1)
                ATTN_VREADS(5, 1) ATTN_VWAIT(0, 4); ATTN_PV(4, 0)
                ATTN_VREADS(6, 0) ATTN_VWAIT(1, 4); ATTN_PV(5, 1)
                ATTN_VREADS(7, 1) ATTN_VWAIT(0, 4); ATTN_PV(6, 0)
                ATTN_VWAIT(1, 0); ATTN_PV(7, 1)
                __builtin_amdgcn_s_setprio(0);
#undef ATTN_VREADS
#undef ATTN_VWAIT
#undef ATTN_PV
            }
        } }
        l_run += __shfl_xor(l_run, 32);
        asm volatile("s_waitcnt vmcnt(0) lgkmcnt(0)" ::: "memory"); __builtin_amdgcn_s_barrier(); asm volatile("" ::: "memory");
        LAS float* xs = (LAS float*)lds + (size_t)wq * 66 * 64 + lane;
        if (kvh == 1) {
            xs[0] = m_run; xs[64] = l_run;
#pragma unroll
            for (int db = 0; db < 4; ++db)
#pragma unroll
                for (int r = 0; r < 16; ++r) xs[(2 + 16 * db + r) * 64] = o[db][r];
        }
        asm volatile("s_waitcnt lgkmcnt(0)" ::: "memory"); __builtin_amdgcn_s_barrier(); asm volatile("" ::: "memory");
        if (kvh == 0) {
            const float m2 = xs[0], l2 = xs[64], mt = fmaxf(m_run, m2), a1 = __builtin_amdgcn_exp2f(m_run - mt), a2 = __builtin_amdgcn_exp2f(m2 - mt);
            const float inv = 1.0f / (l_run * a1 + l2 * a2), c1 = a1 * inv, c2 = a2 * inv;
            GAS unsigned char* orow = (GAS unsigned char*)AO + rowq * 2048 + h * 128 + 4 * hh;
#pragma unroll
            for (int db = 0; db < 4; ++db)
#pragma unroll
                for (int g = 0; g < 4; ++g) {
                    float t[4];
#pragma unroll
                    for (int e = 0; e < 4; ++e) t[e] = o[db][4 * g + e] * c1 + xs[(2 + 16 * db + 4 * g + e) * 64] * c2;
                    int w = 0; w = __builtin_amdgcn_cvt_pk_fp8_f32(t[0] * pg8::H8_SCALE, t[1] * pg8::H8_SCALE, w, false); w = __builtin_amdgcn_cvt_pk_fp8_f32(t[2] * pg8::H8_SCALE, t[3] * pg8::H8_SCALE, w, true);
                    *(GAS int*)(orow + 32 * db + 8 * g) = w;
                }
        }
    }
    asm volatile("s_waitcnt vmcnt(0) lgkmcnt(0)" ::: "memory"); __builtin_amdgcn_s_barrier(); asm volatile("" ::: "memory");
}
__device__ __forceinline__ void up8(const v4u w, float (&f)[8]) { f[0] = bflo(w.x); f[1] = bfhi(w.x); f[2] = bflo(w.y); f[3] = bfhi(w.y); f[4] = bflo(w.z); f[5] = bfhi(w.z); f[6] = bflo(w.w); f[7] = bfhi(w.w); }
__device__ __forceinline__ void conv_phase(const Ctx& F, const bf16* CB, const bf16* Z, const float* cw, bf16* UC) {
    const int gt = (F.vcu * NWAVES + F.wave) * 64 + F.lane, NT = F.G * NWAVES * 64;
    for (int idx = gt; idx < M * 128; idx += NT) {
        const int row = idx >> 7, c8 = (idx & 127) << 3, t = row & (SEQ - 1); const size_t off = (size_t)row * 1024 + c8;
        float cb[8], z0[8], z1[8], z2[8];
        up8(*(const GAS v4u*)(CB + off), cb); up8(*(const GAS v4u*)(Z + off), z0);
        if (t >= 1) up8(*(const GAS v4u*)(Z + off - 1024), z1); else {
#pragma unroll
            for (int j = 0; j < 8; ++j) z1[j] = 0.f; }
        if (t >= 2) up8(*(const GAS v4u*)(Z + off - 2048), z2); else {
#pragma unroll
            for (int j = 0; j < 8; ++j) z2[j] = 0.f; }
        float o[8];
#pragma unroll
        for (int j = 0; j < 8; ++j) o[j] = cb[j] * (cw[c8 + j] * z2[j] + cw[1024 + c8 + j] * z1[j] + cw[2048 + c8 + j] * z0[j]);
        v4u w; w.x = pk2(o[0], o[1]); w.y = pk2(o[2], o[3]); w.z = pk2(o[4], o[5]); w.w = pk2(o[6], o[7]); *(GAS v4u*)(UC + off) = w;
    }
}

__device__ __forceinline__ int imax(int a, int b) { return a > b ? a : b; }
__device__ __forceinline__ int imin(int a, int b) { return a < b ? a : b; }
__device__ __forceinline__ void ce(int& a, int& b) { const int t = imax(a, b); b = imin(a, b); a = t; }
__device__ __forceinline__ void sort16(int (&x)[16]) {
#pragma unroll
    for (int kk = 1; kk <= 4; ++kk)
#pragma unroll
        for (int jj = kk - 1; jj >= 0; --jj)
#pragma unroll
            for (int i = 0; i < 16; ++i) { const int k = 1 << kk, j = 1 << jj, l = i ^ j; if (l > i) { if ((i & k) == 0) ce(x[i], x[l]); else ce(x[l], x[i]); } }
}
__device__ __forceinline__ void bmerge16(int (&a)[16]) {
#pragma unroll
    for (int jj = 3; jj >= 0; --jj)
#pragma unroll
        for (int i = 0; i < 16; ++i) { const int j = 1 << jj, l = i ^ j; if (l > i) ce(a[i], a[l]); }
}
__device__ __forceinline__ void merge16(int (&a)[16], const int (&b)[16]) {
#pragma unroll
    for (int i = 0; i < 16; ++i) a[i] = imax(a[i], b[15 - i]);
    bmerge16(a);
}
__device__ __forceinline__ void xmerge16(int (&a)[16], int hh) {
    int pv[16];
#pragma unroll
    for (int i = 0; i < 16; ++i) { const auto r = __builtin_amdgcn_permlane32_swap((unsigned)a[15 - i], (unsigned)a[15 - i], false, false); pv[i] = hh ? (int)r[0] : (int)r[1]; }
#pragma unroll
    for (int i = 0; i < 16; ++i) a[i] = imax(a[i], pv[i]);
    bmerge16(a);
}
__device__ __forceinline__ int ord_key(float f) { const int u = __float_as_int(f); return u >= 0 ? u : (u ^ 0x7fffffff); }
__device__ __forceinline__ float ord_val(int k) { return __int_as_float(k >= 0 ? k : (k ^ 0x7fffffff)); }
__device__ __forceinline__ unsigned byte16(const unsigned (&t)[4], int idx) {
    const unsigned sel = 0x0c0c0c00u | (unsigned)(idx & 7);
    const unsigned lo = __builtin_amdgcn_perm(t[1], t[0], sel), hi_ = __builtin_amdgcn_perm(t[3], t[2], sel);
    return (idx & 8) ? hi_ : lo;
}
__device__ __forceinline__ void topk_stage_keys(const Ctx& F, const bf16* KEYS, int h) {
    int lq = F.lane; asm volatile("" : "+v"(lq));
#pragma unroll
    for (int i = 0; i < 8; ++i) { const int pc = F.wave + 8 * i, pp = pc >> 5, row = 4 * (pc & 31) + (lq >> 4), cp = lq & 15, c = cp ^ (row & 15);
        const char* base = (const char*)(KEYS + (size_t)((h * 2 + pp) * 128) * 128); const unsigned off = (unsigned)(row * 256 + 16 * c);
        __builtin_amdgcn_global_load_lds((const unsigned*)(base + off), (LAS unsigned*)(F.lds + RING_OFF + pc * 1024), 16, 0, 0); }
    asm volatile("s_waitcnt vmcnt(0)" ::: "memory"); __builtin_amdgcn_s_barrier(); asm volatile("" ::: "memory");
}
__device__ __forceinline__ void topk_phase(const Ctx& F, int bitem, const bf16* QP, int* EXP, float* GATE) {
    const int lane = F.lane, l31 = lane & 31, hh = lane >> 5;
    const int IMIN = (int)0x80000000;
    const unsigned lds0 = (unsigned)(uintptr_t)(F.lds + RING_OFF);
    {
        const int h = bitem & 7, tt = (bitem >> 3) * 8 + F.wave, tok0 = tt * 32;
        int top[2][16];
#pragma unroll
        for (int p = 0; p < 2; ++p) {
            bf16x8 qa[8];
#pragma unroll
            for (int s = 0; s < 8; ++s) qa[s] = *(const GAS bf16x8*)(QP + (size_t)(tok0 + l31) * 2048 + h * 256 + p * 128 + 16 * s + 8 * hh);
            int x[2][16];
#pragma unroll
            for (int pq = 0; pq < 2; ++pq) {
                f32x16 sc[2];
#pragma unroll
                for (int nt = 0; nt < 2; ++nt)
#pragma unroll
                    for (int r = 0; r < 16; ++r) sc[nt][r] = 0.f;
#pragma unroll
                for (int s = 0; s < 8; ++s) {
#pragma unroll
                    for (int nt = 0; nt < 2; ++nt) { const int n = 64 * pq + 32 * nt + l31; const bf16x8 kb = *(const LAS bf16x8*)(uintptr_t)(lds0 + p * 32768 + n * 256 + (((2 * s + hh) ^ (n & 15)) << 4));
                        sc[nt] = __builtin_amdgcn_mfma_f32_32x32x16_bf16(kb, qa[s], sc[nt], 0, 0, 0); }
                }
                int y[16];
#pragma unroll
                for (int r = 0; r < 16; ++r) { x[pq][r] = (ord_key(sc[0][r]) & ~127) | ((127 - 64 * pq - (r & 3) - 8 * (r >> 2)) - 4 * hh); y[r] = (ord_key(sc[1][r]) & ~127) | ((127 - 64 * pq - 32 - (r & 3) - 8 * (r >> 2)) - 4 * hh); }
                sort16(x[pq]); sort16(y); merge16(x[pq], y);
                asm volatile("" ::: "memory");
            }
            merge16(x[0], x[1]);
            xmerge16(x[0], hh);
#pragma unroll
            for (int i = 0; i < 16; ++i) top[p][i] = x[0][i];
        }
        float fa[16], fb[16];
#pragma unroll
        for (int i = 0; i < 16; ++i) { const int A = hh ? top[1][i] : top[0][i], B = hh ? top[0][i] : top[1][i]; fa[i] = ord_val(A & ~127); fb[i] = ord_val(B & ~127); }
        int c0[16], c1[16];
#pragma unroll
        for (int q = 0; q < 32; ++q) {
            int key = IMIN;
            if (q < 27) { const int i = (q < 16) ? 0 : (q < 23) ? 1 : (q < 26) ? 2 : 3, j = (q < 16) ? q : (q < 23) ? q - 15 : (q < 26) ? q - 21 : 3; const float sv = fa[i] + fb[j]; const int low = hh ? (255 - (j * 16 + i)) : (255 - (i * 16 + j));
                key = (ord_key(sv) & ~255) | low; if (i == j && hh) key = IMIN; }
            if (q < 16) c0[q] = key; else c1[q - 16] = key;
        }
        sort16(c0); sort16(c1); merge16(c0, c1); xmerge16(c0, hh);
        unsigned na[4], nb[4];
#pragma unroll
        for (int d = 0; d < 4; ++d) { na[d] = 0u; nb[d] = 0u;
#pragma unroll
            for (int e = 0; e < 4; ++e) { na[d] |= (unsigned)(127 - (top[0][4 * d + e] & 127)) << (8 * e); nb[d] |= (unsigned)(127 - (top[1][4 * d + e] & 127)) << (8 * e); } }
        int ex[16]; float ev[16]; float es = 0.f; const float smax = ord_val(c0[0] & ~255);
#pragma unroll
        for (int q = 0; q < 16; ++q) { const int posn = 255 - (c0[q] & 255); const unsigned n1 = byte16(na, posn >> 4) & 255u, n2 = byte16(nb, posn & 15) & 255u;
            ex[q] = (int)(n1 * 128u + n2); ev[q] = __expf(ord_val(c0[q] & ~255) - smax); es += ev[q]; }
        const float ri = 1.0f / es; const size_t ob = (size_t)(tok0 + l31) * 128 + h * 16;
        if (hh == 0) {
#pragma unroll
            for (int d = 0; d < 4; ++d) { v4u w; w.x = (unsigned)ex[4 * d]; w.y = (unsigned)ex[4 * d + 1]; w.z = (unsigned)ex[4 * d + 2]; w.w = (unsigned)ex[4 * d + 3]; *(GAS v4u*)(EXP + ob + 4 * d) = w; }
        } else {
#pragma unroll
            for (int d = 0; d < 4; ++d) *(GAS f32x4*)(GATE + ob + 4 * d) = (f32x4){ev[4 * d] * ri, ev[4 * d + 1] * ri, ev[4 * d + 2] * ri, ev[4 * d + 3] * ri};
        }
    }
}

typedef float f32x2 __attribute__((ext_vector_type(2)));
#ifndef MK_PEER_RD
#define MK_PEER_RD 4
#endif
#ifndef MK_PEER_ALIGN
#define MK_PEER_ALIGN 4
#endif
constexpr int PEER_ALIGN = MK_PEER_ALIGN;
constexpr int PEER_RDU = 4;
constexpr int PEER_RD = MK_PEER_RD;
template <int CTRL> __device__ __forceinline__ int dpp_i(int v) { return __builtin_amdgcn_update_dpp(v, v, CTRL, 0xf, 0xf, false); }
template <int J> __device__ __forceinline__ int xor_lane(int v, int lane) {
    if constexpr (J == 1) return dpp_i<0xB1>(v);
    else if constexpr (J == 2) return dpp_i<0x4E>(v);
    else if constexpr (J == 16) { const auto r = __builtin_amdgcn_permlane16_swap((unsigned)v, (unsigned)v, false, false); return ((lane >> 4) & 1) ? (int)r[0] : (int)r[1]; }
    else if constexpr (J == 32) { const auto r = __builtin_amdgcn_permlane32_swap((unsigned)v, (unsigned)v, false, false); return (lane >> 5) ? (int)r[0] : (int)r[1]; }
    else return __shfl_xor(v, J);
}
__device__ __forceinline__ float wave_sum_dpp(float v) {
    v += __int_as_float(dpp_i<0xB1>(__float_as_int(v))); v += __int_as_float(dpp_i<0x4E>(__float_as_int(v))); v += __int_as_float(dpp_i<0x141>(__float_as_int(v))); v += __int_as_float(dpp_i<0x140>(__float_as_int(v)));
    { const auto r = __builtin_amdgcn_permlane16_swap(__float_as_uint(v), __float_as_uint(v), false, false); v = __uint_as_float(r[0]) + __uint_as_float(r[1]); }
    { const auto r = __builtin_amdgcn_permlane32_swap(__float_as_uint(v), __float_as_uint(v), false, false); v = __uint_as_float(r[0]) + __uint_as_float(r[1]); }
    return v; }
template <int KK, int JJ> __device__ __forceinline__ void sort512_step(int (&x)[8], int lane) {
    constexpr int k = 1 << KK, j = 1 << JJ;
    if constexpr (j >= 64) { constexpr int jr = j >> 6;
#pragma unroll
        for (int r = 0; r < 8; ++r) if ((r & jr) == 0) { const bool asc = (k >= 512) ? true : (((r << 6) & k) == 0); const int lo = imin(x[r], x[r | jr]), hi_ = imax(x[r], x[r | jr]); x[r] = asc ? lo : hi_; x[r | jr] = asc ? hi_ : lo; }
    } else {
        const bool lower = (lane & j) == 0;
#pragma unroll
        for (int r = 0; r < 8; ++r) { const int y = xor_lane<j>(x[r], lane);
            const bool asc = (k < 64) ? ((lane & k) == 0) : ((k >= 512) ? true : (((r << 6) & k) == 0));
            x[r] = (lower == asc) ? imin(x[r], y) : imax(x[r], y); }
    }
}
template <int KK, int JJ> __device__ __forceinline__ void sort512_stage(int (&x)[8], int lane) { sort512_step<KK, JJ>(x, lane); if constexpr (JJ > 0) sort512_stage<KK, JJ - 1>(x, lane); }
__device__ __forceinline__ void sort512(int (&x)[8], int lane) {
    sort512_stage<1, 0>(x, lane); sort512_stage<2, 1>(x, lane); sort512_stage<3, 2>(x, lane); sort512_stage<4, 3>(x, lane); sort512_stage<5, 4>(x, lane);
    sort512_stage<6, 5>(x, lane); sort512_stage<7, 6>(x, lane); sort512_stage<8, 7>(x, lane); sort512_stage<9, 8>(x, lane);
}
__device__ __forceinline__ u32x6 peer_row(const unsigned char* T, int e, int lane) { const GAS unsigned char* rp = (const GAS unsigned char*)(T + (size_t)e * PEER_ROWB);
    const v4u a = *(const GAS v4u*)(rp + 16 * lane); const u32x2v b = *(const GAS u32x2v*)(rp + 1024 + 8 * lane); return (u32x6){a.x, a.y, a.z, a.w, b.x, b.y}; }
__device__ __forceinline__ void peer_phase(const Ctx& F, const unsigned char* U8, const unsigned char* V8, const bf16* X1B, const int* EXP, const float* GATE, const unsigned long long* SS, const float* gfin, const float* X1, float* OUT) {
    const int gw = F.vcu * NWAVES + F.wave, NGW = F.G * NWAVES, lane = F.lane;
    const unsigned xs0 = (unsigned)(uintptr_t)(F.lds + RING_OFF + F.wave * 16384) + lane * 16;
    for (int tb = gw; tb + 3 * NGW < M; tb += 4 * NGW) {
        int kreg[8]; float rv[4];
        int lk = lane; asm volatile("" : "+v"(lk));
#pragma unroll
        for (int j = 0; j < 4; ++j) { const size_t t = (size_t)tb + (size_t)j * NGW;
            kreg[2 * j] = (EXP[t * 128 + lk] << 9) | (j << 7) | lk; kreg[2 * j + 1] = (EXP[t * 128 + 64 + lk] << 9) | (j << 7) | (64 + lk);
        }
        sort512(kreg, lane);
#pragma unroll
        for (int j = 0; j < 4; ++j) rv[j] = pg8::rinv_from_ss(SS[(size_t)tb + (size_t)j * NGW]) * (1.0f / PEER_SU);
        float actreg[8];
        {
            bf16x2v xv[4][16];
            int lx = lane; asm volatile("" : "+v"(lx));
#pragma unroll
            for (int j = 0; j < 4; ++j) { const size_t t = (size_t)tb + (size_t)j * NGW;
#pragma unroll
                for (int i = 0; i < 2; ++i)
#pragma unroll
                    for (int hv = 0; hv < 2; ++hv) { const v4u w = *(const GAS v4u*)(X1B + t * DM + i * 1024 + lx * 16 + 8 * hv);
                        const unsigned w0 = w.x, w1 = w.y, w2 = w.z, w3 = w.w;
                        xv[j][8 * i + 4 * hv + 0] = __builtin_bit_cast(bf16x2v, w0); xv[j][8 * i + 4 * hv + 1] = __builtin_bit_cast(bf16x2v, w1); xv[j][8 * i + 4 * hv + 2] = __builtin_bit_cast(bf16x2v, w2); xv[j][8 * i + 4 * hv + 3] = __builtin_bit_cast(bf16x2v, w3); } }
            u32x6 ub[PEER_RDU];
#pragma unroll
            for (int u = 0; u < PEER_RDU; ++u) ub[u] = peer_row(U8, __builtin_amdgcn_readlane(kreg[0], u) >> 9, lane);
#pragma unroll
            for (int c = 0; c < 8; ++c) {
                float areg = 0.f;
#pragma unroll 1
                for (int g = 0; g < 8; ++g) {
                    if ((g & (PEER_ALIGN - 1)) == 0) __builtin_amdgcn_s_barrier();
                    float pt[8];
#pragma unroll
                    for (int u = 0; u < 8; ++u) {
                        const int key = __builtin_amdgcn_readlane(kreg[c], 8 * g + u), tk = (key >> 7) & 3;
                        const bf16x32v cv = __builtin_amdgcn_cvt_scalef32_pk32_bf16_fp6(ub[u % PEER_RDU], 1.0f);
                        int f0, f1, f2, f3;
                        asm volatile("s_cmp_eq_u32 %1, 0\n\ts_cselect_b32 %0, 1, 0" : "=s"(f0) : "s"(tk) : "scc"); asm volatile("s_cmp_eq_u32 %1, 1\n\ts_cselect_b32 %0, 1, 0" : "=s"(f1) : "s"(tk) : "scc");
                        asm volatile("s_cmp_eq_u32 %1, 2\n\ts_cselect_b32 %0, 1, 0" : "=s"(f2) : "s"(tk) : "scc"); asm volatile("s_cmp_eq_u32 %1, 3\n\ts_cselect_b32 %0, 1, 0" : "=s"(f3) : "s"(tk) : "scc");
                        float pa = 0.f, pb = 0.f, pc = 0.f, pd = 0.f;
#define PEER_DOT(J) { _Pragma("unroll") for (int q = 0; q < 4; ++q) { \
                            pa = __builtin_amdgcn_fdot2_f32_bf16((bf16x2v){cv[8 * q + 0], cv[8 * q + 1]}, xv[J][4 * q + 0], pa, false); pb = __builtin_amdgcn_fdot2_f32_bf16((bf16x2v){cv[8 * q + 2], cv[8 * q + 3]}, xv[J][4 * q + 1], pb, false); \
                            pc = __builtin_amdgcn_fdot2_f32_bf16((bf16x2v){cv[8 * q + 4], cv[8 * q + 5]}, xv[J][4 * q + 2], pc, false); pd = __builtin_amdgcn_fdot2_f32_bf16((bf16x2v){cv[8 * q + 6], cv[8 * q + 7]}, xv[J][4 * q + 3], pd, false); } }
                        if (f0) PEER_DOT(0)
                        if (f1) PEER_DOT(1)
                        if (f2) PEER_DOT(2)
                        if (f3) PEER_DOT(3)
#undef PEER_DOT
                        pt[u] = (pa + pb) + (pc + pd);
                        { const int ix = 8 * g + PEER_RDU + u, ka = __builtin_amdgcn_readlane(kreg[c], ix & 63), kb = __builtin_amdgcn_readlane(kreg[c < 7 ? c + 1 : 7], ix & 63), kn = (ix < 64) ? ka : kb;
                            ub[u % PEER_RDU] = peer_row(U8, kn >> 9, lane); }
                    }
                    { const bool b5 = (lane & 32) != 0, b4 = (lane & 16) != 0, b3 = (lane & 8) != 0;
#pragma unroll
                      for (int i = 0; i < 4; ++i) { const float a = pt[i], b = pt[i + 4]; pt[i] = (b5 ? b : a) + __int_as_float(xor_lane<32>(__float_as_int(b5 ? a : b), lane)); }
#pragma unroll
                      for (int i = 0; i < 2; ++i) { const float a = pt[i], b = pt[i + 2]; pt[i] = (b4 ? b : a) + __int_as_float(xor_lane<16>(__float_as_int(b4 ? a : b), lane)); }
                      { const float a = pt[0], b = pt[1]; pt[0] = (b3 ? b : a) + __int_as_float(dpp_i<0x128>(__float_as_int(b3 ? a : b))); }
                      float r = pt[0]; r += __int_as_float(dpp_i<0x141>(__float_as_int(r))); r += __int_as_float(dpp_i<0x4E>(__float_as_int(r))); r += __int_as_float(dpp_i<0xB1>(__float_as_int(r)));
                      areg = ((lane & 7) == g) ? r : areg; }
                }
                actreg[c] = areg;
            }
        }
#pragma unroll
        for (int c = 0; c < 8; ++c) { const int pk = __shfl(kreg[c], 8 * (lane & 7) + (lane >> 3)), tk = (pk >> 7) & 3;
            const float gate = GATE[((size_t)tb + (size_t)tk * NGW) * 128 + (pk & 127)], rr = (tk == 0) ? rv[0] : (tk == 1) ? rv[1] : (tk == 2) ? rv[2] : rv[3];
            actreg[c] = gelu_tanh(actreg[c] * rr) * gate * (1.0f / PEER_SV); }
        {
            f32x2 y[4][16];
#pragma unroll
            for (int j = 0; j < 4; ++j)
#pragma unroll
                for (int q = 0; q < 16; ++q) y[j][q] = (f32x2){0.f, 0.f};
            u32x6 vb[PEER_RD];
#pragma unroll
            for (int u = 0; u < PEER_RD; ++u) vb[u] = peer_row(V8, __builtin_amdgcn_readlane(kreg[0], u) >> 9, lane);
#pragma unroll
            for (int c = 0; c < 8; ++c) {
#pragma unroll 1
                for (int g = 0; g < 8; ++g) {
                    if ((g & (PEER_ALIGN - 1)) == 0) __builtin_amdgcn_s_barrier();
#pragma unroll
                    for (int u = 0; u < 8; ++u) {
                        const int key = __builtin_amdgcn_readlane(kreg[c], 8 * g + u), tk = (key >> 7) & 3;
                        const float s = rdlane(actreg[c], 8 * u + g); const f32x2 s2 = {s, s};
                        f32x2 cv[16];
                        { const f32x32v r = __builtin_amdgcn_cvt_scalef32_pk32_f32_fp6(vb[u % PEER_RD], 1.0f);
#pragma unroll
                          for (int q = 0; q < 16; ++q) cv[q] = (f32x2){r[2 * q], r[2 * q + 1]}; }
                        int f0, f1, f2, f3;
                        asm volatile("s_cmp_eq_u32 %1, 0\n\ts_cselect_b32 %0, 1, 0" : "=s"(f0) : "s"(tk) : "scc"); asm volatile("s_cmp_eq_u32 %1, 1\n\ts_cselect_b32 %0, 1, 0" : "=s"(f1) : "s"(tk) : "scc");
                        asm volatile("s_cmp_eq_u32 %1, 2\n\ts_cselect_b32 %0, 1, 0" : "=s"(f2) : "s"(tk) : "scc"); asm volatile("s_cmp_eq_u32 %1, 3\n\ts_cselect_b32 %0, 1, 0" : "=s"(f3) : "s"(tk) : "scc");
                        if (f0) { _Pragma("unroll") for (int q = 0; q < 16; ++q) y[0][q] = __builtin_elementwise_fma(cv[q], s2, y[0][q]); }
                        if (f1) { _Pragma("unroll") for (int q = 0; q < 16; ++q) y[1][q] = __builtin_elementwise_fma(cv[q], s2, y[1][q]); }
                        if (f2) { _Pragma("unroll") for (int q = 0; q < 16; ++q) y[2][q] = __builtin_elementwise_fma(cv[q], s2, y[2][q]); }
                        if (f3) { _Pragma("unroll") for (int q = 0; q < 16; ++q) y[3][q] = __builtin_elementwise_fma(cv[q], s2, y[3][q]); }
                        { const int ix = 8 * g + PEER_RD + u, ka = __builtin_amdgcn_readlane(kreg[c], ix & 63), kb = __builtin_amdgcn_readlane(kreg[c < 7 ? c + 1 : 7], ix & 63), kn = (ix < 64) ? ka : kb;
                            vb[u % PEER_RD] = peer_row(V8, kn >> 9, lane); }
                    }
                }
            }
            int lq = lane; asm volatile("" : "+v"(lq));
#pragma unroll
            for (int j = 0; j < 4; ++j) { const size_t t = (size_t)tb + (size_t)j * NGW;
                GAS f32x4* orw = (GAS f32x4*)(OUT + t * DM); float ss = 0.f;
#pragma unroll
                for (int i = 0; i < 2; ++i)
#pragma unroll
                    for (int hv = 0; hv < 2; ++hv) { const v4u w = *(const GAS v4u*)(X1B + t * DM + i * 1024 + lq * 16 + 8 * hv);
                        y[j][8 * i + 4 * hv + 0] += (f32x2){bflo(w.x), bfhi(w.x)}; y[j][8 * i + 4 * hv + 1] += (f32x2){bflo(w.y), bfhi(w.y)}; y[j][8 * i + 4 * hv + 2] += (f32x2){bflo(w.z), bfhi(w.z)}; y[j][8 * i + 4 * hv + 3] += (f32x2){bflo(w.w), bfhi(w.w)}; }
#pragma unroll
                for (int q = 0; q < 16; ++q) ss += y[j][q][0] * y[j][q][0] + y[j][q][1] * y[j][q][1];
                const float r3 = 1.0f / sqrtf(wave_sum_dpp(ss) * (1.0f / DM) + RMS_EPS);
#pragma unroll
                for (int i = 0; i < 2; ++i)
#pragma unroll
                    for (int q = 0; q < 4; ++q) { const f32x4 ga = *(const GAS f32x4*)(gfin + i * 1024 + lq * 16 + 4 * q);
                        orw[i * 256 + 4 * lq + q] = (f32x4){y[j][8 * i + 2 * q][0] * r3 * ga[0], y[j][8 * i + 2 * q][1] * r3 * ga[1], y[j][8 * i + 2 * q + 1][0] * r3 * ga[2], y[j][8 * i + 2 * q + 1][1] * r3 * ga[3]}; }
            }
        }
        asm volatile("s_waitcnt lgkmcnt(0)" ::: "memory");
    }
}

struct Args { const float* in[15]; float* out; unsigned char* ws; double invf[16]; int ph_lo, ph_hi, li, pad; };
__global__ void __launch_bounds__(NWAVES * 64, 2) mk_fwd(Args args) {
    extern __shared__ __attribute__((aligned(16))) unsigned char lds[];
    Ctx F;
    F.lds = (LAS unsigned char*)lds;
    volatile LAS unsigned* MISC = (volatile LAS unsigned*)(F.lds + MISC_OFF);
    F.tid = threadIdx.x; F.lane = F.tid & 63; F.wave = __builtin_amdgcn_readfirstlane(F.tid >> 6);
    F.G = gridDim.x; { const int bx = blockIdx.x; F.vcu = (F.G % 8 == 0) ? (bx % 8) * (F.G / 8) + bx / 8 : bx; }
    unsigned char* ws = args.ws;
    gu32* ctl = (gu32*)(ws + WS_CTL);
    for (int u = F.tid; u < (LDS_BYTES - LDSCTL_OFF) / 4; u += NWAVES * 64) ((LAS unsigned*)(F.lds + LDSCTL_OFF))[u] = 0u;
    __syncthreads();
    XcdBarrier bar; bar.bar = (unsigned*)(ctl + CW_BAR); bar.x = 0; bar.st = nullptr;
    if (N_LAUNCHES != PER_PHASE) bar = xcd_barrier_post((unsigned*)(ctl + CW_BAR), MISC + 8);
#define GRID_BAR() do { if (N_LAUNCHES != PER_PHASE) xcd_barrier(bar); } while (0)
#define GRID_BAR_W(q) do { if (N_LAUNCHES != PER_PHASE) { const BarWork wk_{args.in[12], args.in[13], args.in[9], ws, (q), 5}; xcd_barrier(bar, &F, &wk_); } } while (0)
    const int lo = args.ph_lo, hi = args.ph_hi;
#define IN(k) (lo <= (k) && (k) < hi)
#define BOTH(k) (IN(k) && IN((k) + 1))
    bf16* WinT = (bf16*)(ws + WS_WIN); bf16* WbcT = (bf16*)(ws + WS_WBC); bf16* WbaT = (bf16*)(ws + WS_WBA); bf16* WoutT = (bf16*)(ws + WS_WOUT); bf16* WpqT = (bf16*)(ws + WS_WPQ);
    bf16* KEYS = (bf16*)(ws + WS_KEYS); float* CS = (float*)(ws + WS_CS); const unsigned char* UB = ws + WS_UB; const unsigned char* VB = ws + WS_VB;
    bf16* XB = (bf16*)(ws + WS_XB); bf16* T6 = (bf16*)(ws + WS_T6); bf16* GAB = (bf16*)(ws + WS_GAB); bf16* UC = (bf16*)(ws + WS_UC); bf16* AO = (bf16*)(ws + WS_AO);
    bf16* TMP = (bf16*)(ws + WS_TMP); bf16* MB = (bf16*)(ws + WS_MB); bf16* X1B = (bf16*)(ws + WS_X1B); bf16* QP = (bf16*)(ws + WS_QP);
    int* EXP = (int*)(ws + WS_EXP); float* GATE = (float*)(ws + WS_GATE);
    unsigned long long* SS = (unsigned long long*)(ws + WS_SS); float* KSUM = (float*)(ws + WS_KSUM);
    constexpr size_t TS = (size_t)M * 1024;

    if (IN(0)) { for (int rep = 0; rep < NREP(0); ++rep) { p0_prologue(F, args.in, ws, args.invf); if (rep + 1 < NREP(0)) GRID_BAR(); } if (BOTH(0)) GRID_BAR(); }
    if (IN(1)) {
        for (int rep = 0; rep < NREP(1); ++rep) {
        {
            pg8::Gemm g{(const bf16*)(ws + WS_H8), WinT, M, INW, DM / 2}; pg8::StaticOrder S; S.init(M, INW, F.G, (int)blockIdx.x);
            pg8::EpiIn<2> E{T6, GAB, args.in[4], CS, KSUM};
            pg8::gemm_phase<pg8::EpiIn<2>, pg8::StaticOrder, true, true, 2>(F.lds + RING_OFF, g, S, E); }
        if (rep + 1 < NREP(1)) GRID_BAR(); }
        if (BOTH(1)) GRID_BAR();
    }
    if (IN(2)) {
        for (int rep = 0; rep < NREP(2); ++rep) {
        attn_mfma(F, T6 + 3 * TS, T6 + 4 * TS, T6 + 5 * TS, KSUM, AO);
        conv_phase(F, T6, T6 + TS, args.in[5], UC);
        if (rep + 1 < NREP(2)) GRID_BAR(); }
        if (BOTH(2)) GRID_BAR_W(0);
    }
    if (IN(3)) {
        for (int rep = 0; rep < NREP(3); ++rep) {
        pg8::Gemm g{UC, WbcT, M, DM, 1024, AO, WbaT}; pg8::TwoSegOrder S; S.init(M, DM, F.G, (int)blockIdx.x);
        pg8::EpiMerge2 E{GAB, GAB + (size_t)M * DM, MB};
        pg8::gemm_phase<pg8::EpiMerge2, pg8::TwoSegOrder, true, true>(F.lds + RING_OFF, g, S, E);
        if (rep + 1 < NREP(3)) GRID_BAR(); }
        if (BOTH(3)) GRID_BAR_W(1);
    }
    if (IN(5)) {
        for (int rep = 0; rep < NREP(5); ++rep) {
        pg8::Gemm g{MB, WoutT, M, DM, DM / 2}; pg8::StaticOrder S; S.init(M, DM, F.G, (int)blockIdx.x);
        pg8::EpiX1 E{args.in[0], X1B, (rep + 1 < NREP(5)) ? (unsigned long long*)(ws + 768 * 1024) : SS, ws + WS_X1Q};
        pg8::gemm_phase<pg8::EpiX1, pg8::StaticOrder, true, true, 2>(F.lds + RING_OFF, g, S, E);
        if (rep + 1 < NREP(5)) GRID_BAR(); }
        if (BOTH(5)) GRID_BAR_W(2);
    }
    if (IN(6)) {
        for (int rep = 0; rep < NREP(6); ++rep) {
        pg8::Gemm g{(const bf16*)(ws + WS_X1Q), WpqT, M, DM, DM / 2}; pg8::StaticOrder S; S.init(M, DM, F.G, (int)blockIdx.x);
        pg8::EpiQP E{SS, QP};
        pg8::gemm_phase<pg8::EpiQP, pg8::StaticOrder, true, true, 2>(F.lds + RING_OFF, g, S, E);
        if (rep + 1 < NREP(6)) GRID_BAR(); }
        if (BOTH(6)) GRID_BAR_W(3);
    }
    if (IN(7)) { for (int rep = 0; rep < NREP(7); ++rep) {
        for (int bitem = F.vcu; bitem < 256; bitem += F.G) {
            topk_stage_keys(F, KEYS, bitem & 7);
            if (N_LAUNCHES == PER_PHASE && bitem == F.vcu) convert_tables(F, args.in[12], args.in[13], args.in[9], ws, 0, 1, 0);
            if (N_LAUNCHES != PER_PHASE && bitem == F.vcu && F.wave >= 4) convert_tables(F, args.in[12], args.in[13], args.in[9], ws, 4, 5, 4);
            topk_phase(F, bitem, QP, EXP, GATE);
            asm volatile("s_waitcnt lgkmcnt(0)" ::: "memory"); __builtin_amdgcn_s_barrier(); asm volatile("" ::: "memory");
        }
        if (rep + 1 < NREP(7)) GRID_BAR(); } if (BOTH(7)) GRID_BAR(); }
    if (IN(8)) { for (int rep = 0; rep < NREP(8); ++rep) { peer_phase(F, UB, VB, X1B, EXP, GATE, SS, args.in[14], args.out, (rep + 1 < NREP(8)) ? (float*)(ws + WS_END) : args.out); if (rep + 1 < NREP(8)) GRID_BAR(); } }
#undef IN
#undef BOTH
#undef GRID_BAR
#undef GRID_BAR_W
}

extern "C" void kernel_launch(void* const* d_in, const int* in_sizes, int n_in, void* d_out, int out_size, void* d_ws, size_t ws_size, hipStream_t stream) {
    static int grid = 0;
    if (grid == 0) {
        if (n_in != 15 || in_sizes[0] != M * DM || out_size != M * DM || ws_size < WS_END) { fprintf(stderr, "kernel_launch: unexpected shapes (n_in %d, in0 %d, out %d, ws %zu)\n", n_in, n_in > 0 ? in_sizes[0] : -1, out_size, ws_size); grid = -1; return; }
        int dev = 0, cus = 0, per_cu = 0;
        if (hipGetDevice(&dev) != hipSuccess || hipDeviceGetAttribute(&cus, hipDeviceAttributeMultiprocessorCount, dev) != hipSuccess) { grid = -1; return; }
        if (hipFuncSetAttribute((const void*)mk_fwd, hipFuncAttributeMaxDynamicSharedMemorySize, LDS_BYTES) != hipSuccess) { fprintf(stderr, "kernel_launch: hipFuncSetAttribute failed\n"); grid = -1; return; }
        if (hipOccupancyMaxActiveBlocksPerMultiprocessor(&per_cu, (const void*)mk_fwd, NWAVES * 64, LDS_BYTES) != hipSuccess || per_cu < 1) fprintf(stderr, "kernel_launch: occupancy query reports %d\n", per_cu);
        (void)hipGetLastError();
        grid = cus;
        if (M % (4 * grid * NWAVES) != 0) { fprintf(stderr, "kernel_launch: the PEER phase needs M %% (32 * grid) == 0 (grid %d)\n", grid); grid = -1; return; }
    }
    if (grid < 0) return;
    if (hipMemsetAsync((char*)d_ws + WS_CTL, 0, CTL_ZERO_BYTES, stream) != hipSuccess) { fprintf(stderr, "kernel_launch: memset failed\n"); return; }
    Args a{};
    for (int i = 0; i < 15; ++i) a.in[i] = (const float*)d_in[i];
    a.out = (float*)d_out; a.ws = (unsigned char*)d_ws;
    for (int f = 0; f < 16; ++f) a.invf[f] = pow(500000.0, -(double)(2 * f) / 32.0);
    for (int li = 0; li < N_LAUNCHES; ++li) {
        a.ph_lo = (N_LAUNCHES == PER_PHASE) ? li : 0; a.ph_hi = (N_LAUNCHES == PER_PHASE) ? li + 1 : PER_PHASE; a.li = li;
        hipLaunchKernelGGL(mk_fwd, dim3(grid), dim3(NWAVES * 64), LDS_BYTES, stream, a);
        const hipError_t le = hipPeekAtLastError();
        if (le != hipSuccess) { fprintf(stderr, "kernel_launch: launch %d failed: %s\n", li, hipGetErrorName(le)); break; }
    }
}
```

```cpp
#include <hip/hip_runtime.h>
#include <cstdio>
#include <cstdint>
#include <cmath>
namespace pg8 {
#define PG8_LAS __attribute__((address_space(3)))
typedef unsigned short bf16_t;
typedef short bf16x8 __attribute__((ext_vector_type(8)));
typedef float f32x4 __attribute__((ext_vector_type(4)));
typedef int i32x4 __attribute__((ext_vector_type(4)));
typedef unsigned u32x4 __attribute__((ext_vector_type(4)));
constexpr int BM = 256, BK = 64, HALF = 128, HTB = HALF * BK * 2  , STAGE_BYTES = 8 * HTB, NXCD = 8, WGM = 2;

__host__ __device__ __forceinline__ int lds_byte(int r, int c) { const int st = (r >> 4) * 2 + (c >> 5), rr = r & 15, cc = c & 31, ob = rr * 64 + cc * 2; return st * 1024 + (ob ^ (((ob >> 9) & 1) << 5)); }
__host__ __device__ __forceinline__ void stage_rc(int b, int& R, int& C) { const int st = b / 1024, sb = b % 1024, swz = sb ^ (((sb >> 9) & 1) << 5); R = (st >> 1) * 16 + swz / 64; C = (st & 1) * 32 + (swz % 64) / 2; }
__host__ __device__ __forceinline__ int perm32(int rho) { const int n = rho >> 4, i = rho & 15; return 8 * (i >> 2) + 4 * n + (i & 3); }

struct Unit { int pm, pn, seg; };
struct Gemm { const bf16_t* A; const bf16_t* Bt; int M, N, K; const bf16_t* A2; const bf16_t* Bt2; };

struct StaticOrder {
    int nM, nN, nwg, G, c;
    __host__ __device__ void init(int M, int N, int G_, int c_) { nM = M / BM; nN = N / BM; nwg = nM * nN; G = G_; c = c_; }
    __host__ __device__ bool next(int i, Unit& u) const {
        const long L = (long)i * G + c; if (L >= nwg) return false;
        int wgid = (int)L;
        const int nig = WGM * nN, gid = wgid / nig, fm = gid * WGM, gsz = (nM - fm) < WGM ? (nM - fm) : WGM;
        u.pm = fm + ((wgid % nig) % gsz); u.pn = (wgid % nig) / gsz; u.seg = 0; return true;
    }
    __device__ __forceinline__ void a_ready(const Unit&) const {}
    __device__ __forceinline__ void done(const Unit&) const {}
};
struct TwoSegOrder {
    StaticOrder so;
    __host__ __device__ void init(int M, int N, int G_, int c_) { so.init(M, N, G_, c_); }
    __host__ __device__ bool next(int i, Unit& u) const { if (!so.next(i >> 1, u)) return false; u.seg = i & 1; return true; }
    __device__ __forceinline__ void a_ready(const Unit&) const {}
    __device__ __forceinline__ void done(const Unit&) const {}
};


typedef float f32x2c __attribute__((ext_vector_type(2))); typedef __bf16 bf16x2c __attribute__((ext_vector_type(2)));
__device__ __forceinline__ unsigned cvt_pk_bf16(float lo, float hi) { const f32x2c v = {lo, hi}; const bf16x2c b = __builtin_convertvector(v, bf16x2c); return __builtin_bit_cast(unsigned, b); }
__device__ __forceinline__ u32x4 pack8(f32x4 a, f32x4 b) { u32x4 w; w.x = cvt_pk_bf16(a[0], a[1]); w.y = cvt_pk_bf16(a[2], a[3]); w.z = cvt_pk_bf16(b[0], b[1]); w.w = cvt_pk_bf16(b[2], b[3]); return w; }
__device__ __forceinline__ f32x4 shx(f32x4 v, int o) { f32x4 r; r[0] = __shfl_xor(v[0], o); r[1] = __shfl_xor(v[1], o); r[2] = __shfl_xor(v[2], o); r[3] = __shfl_xor(v[3], o); return r; }
__device__ __forceinline__ f32x4 bf4lo(unsigned a, unsigned b) { f32x4 r; r[0] = __uint_as_float(a << 16); r[1] = __uint_as_float(a & 0xffff0000u); r[2] = __uint_as_float(b << 16); r[3] = __uint_as_float(b & 0xffff0000u); return r; }
__device__ __forceinline__ f32x4 sigm4(f32x4 v) { f32x4 r;
#pragma unroll
    for (int i = 0; i < 4; ++i) r[i] = __builtin_amdgcn_rcpf(1.0f + __expf(-v[i])); return r; }
__device__ __forceinline__ unsigned pk4_i8(float a, float b, float c, float d) {
    const int ia = (int)rintf(fminf(fmaxf(a, -127.f), 127.f)), ib = (int)rintf(fminf(fmaxf(b, -127.f), 127.f)), ic = (int)rintf(fminf(fmaxf(c, -127.f), 127.f)), id = (int)rintf(fminf(fmaxf(d, -127.f), 127.f));
    return (unsigned)(ia & 255) | ((unsigned)(ib & 255) << 8) | ((unsigned)(ic & 255) << 16) | ((unsigned)id << 24); }
__device__ __forceinline__ unsigned pk4_u8(f32x4 v, float lo) {
    const unsigned a = (unsigned)rintf(fminf(fmaxf(v[0], lo), 255.f)), b = (unsigned)rintf(fminf(fmaxf(v[1], lo), 255.f)), c = (unsigned)rintf(fminf(fmaxf(v[2], lo), 255.f)), d = (unsigned)rintf(fminf(fmaxf(v[3], lo), 255.f));
    return a | (b << 8) | (c << 16) | (d << 24); }
__device__ __forceinline__ f32x4 ub4(unsigned w) { f32x4 r; r[0] = (float)(w & 255u); r[1] = (float)((w >> 8) & 255u); r[2] = (float)((w >> 16) & 255u); r[3] = (float)(w >> 24); return r; }
constexpr float X1Q_SCALE = 28.0f;
constexpr float MB8_SCALE = 48.0f;
constexpr float HI8_SCALE = 32.0f, WI8_SCALE = 1408.0f;
constexpr float H8_SCALE = 16.0f, W8_SCALE = 64.0f;
constexpr float QSCALE = 0.08838834764831845f * 1.4426950408889634f;

typedef unsigned u32x2q __attribute__((ext_vector_type(2)));
constexpr float Q8_SCALE = 128.0f, K8_SCALE = 16.0f;
template <int QM> struct EpiIn {
    static constexpr bool PERM = true, AFTER_DRAIN = false, KEEP_SEG0 = false, SEG1_F8 = false;
    static constexpr bool F8 = QM != 0;
    static constexpr float OSC = QM == 1 ? 1.0f / (H8_SCALE * W8_SCALE) : QM == 2 ? 1.0f / (HI8_SCALE * WI8_SCALE) : 1.0f;
    static __device__ __forceinline__ f32x4 cva(f32x4 a) { if constexpr (QM == 2) return __builtin_convertvector(__builtin_bit_cast(i32x4, a), f32x4); else return a; }
    bf16_t* T6; bf16_t* GAB; const float* gbias; const float* cs; float* ksum;
    __device__ __forceinline__ void operator()(const f32x4 (&acc)[2][2][4][2], const Unit& u, int wr, int wc, int fr, int fq) const {
        const int row0 = u.pm * BM + wr * 64 + fr, pn = u.pn + (QM == 1 ? 12 : 0), colw = wc * 32 + 8 * fq;
        if (QM == 0 || pn < 24) {
            const int t = pn >> 2;
            bf16_t* base = T6 + (size_t)t * ((size_t)8192 * 1024) + (pn & 3) * 256 + colw;
            const bool rot = F8 && (t == 3 || t == 4) && (wc == 0), isk = F8 && (t == 4), zt = (QM != 1) && (pn >= 4 && pn < 12);
            const float qs = (F8 && t == 3) ? QSCALE : 1.0f;
            f32x4 ks[2][2];
#pragma unroll
            for (int bj = 0; bj < 2; ++bj) { ks[bj][0] = (f32x4){0.f, 0.f, 0.f, 0.f}; ks[bj][1] = (f32x4){0.f, 0.f, 0.f, 0.f}; }
#pragma unroll
            for (int ai = 0; ai < 2; ++ai)
#pragma unroll
                for (int m = 0; m < 4; ++m) {
                    const int row = row0 + ai * HALF + m * 16;
                    f32x4 c0 = (f32x4){1.f, 1.f, 1.f, 1.f}, c1 = c0, s0 = (f32x4){0.f, 0.f, 0.f, 0.f}, s1 = s0;
                    if (rot) { const float* cp = cs + (size_t)row * 32 + 8 * (fq & 1); c0 = *(const f32x4*)cp; c1 = *(const f32x4*)(cp + 4); s0 = *(const f32x4*)(cp + 16); s1 = *(const f32x4*)(cp + 20);
                        if (fq < 2) { s0 = -s0; s1 = -s1; } }
                    if (zt) {
                        *(u32x4*)(T6 + (size_t)8192 * 1024 + (size_t)row * 1024 + (pn - 4) * 128 + colw) = pack8(cva(acc[ai][0][m][0]) * cva(acc[ai][1][m][0]) * (OSC * OSC), cva(acc[ai][0][m][1]) * cva(acc[ai][1][m][1]) * (OSC * OSC));
                    } else {
#pragma unroll
                    for (int bj = 0; bj < 2; ++bj) {
                        f32x4 v0 = cva(acc[ai][bj][m][0]) * OSC, v1 = cva(acc[ai][bj][m][1]) * OSC;
                        if (rot) { const f32x4 p0 = shx(v0, 32), p1 = shx(v1, 32); v0 = v0 * c0 + p0 * s0; v1 = v1 * c1 + p1 * s1; }
                        if (isk) { ks[bj][0] += v0; ks[bj][1] += v1; }
                        v0 = v0 * qs; v1 = v1 * qs;
                        if (t != 4) *(u32x4*)(base + (size_t)row * 1024 + bj * HALF) = pack8(v0, v1);
                        if (F8 && (t == 3 || t == 4)) {
                            const float s8 = (t == 3) ? Q8_SCALE : K8_SCALE; const f32x4 a = v0 * s8, b = v1 * s8; int w0 = 0, w1 = 0; u32x2q w;
                            w0 = __builtin_amdgcn_cvt_pk_fp8_f32(a[0], a[1], w0, false); w0 = __builtin_amdgcn_cvt_pk_fp8_f32(a[2], a[3], w0, true); w1 = __builtin_amdgcn_cvt_pk_fp8_f32(b[0], b[1], w1, false); w1 = __builtin_amdgcn_cvt_pk_fp8_f32(b[2], b[3], w1, true); w.x = (unsigned)w0; w.y = (unsigned)w1;
                            *(u32x2q*)((unsigned char*)(T6 + (size_t)4 * ((size_t)8192 * 1024)) + (t == 3 ? (size_t)8192 * 1024 : (size_t)0) + (size_t)row * 1024 + (pn & 3) * 256 + bj * HALF + colw) = w; }
                    } }
                }
            if (isk) {
#pragma unroll
                for (int bj = 0; bj < 2; ++bj)
#pragma unroll
                    for (int n = 0; n < 2; ++n) { f32x4 v = ks[bj][n]; v += shx(v, 1); v += shx(v, 2); v += shx(v, 4); v += shx(v, 8);
                        if (fr == 0) { float* kp = ksum + (size_t)u.pm * 1024 + (pn & 3) * 256 + bj * HALF + colw + 4 * n;
                            unsafeAtomicAdd(kp + 0, v[0]); unsafeAtomicAdd(kp + 1, v[1]); unsafeAtomicAdd(kp + 2, v[2]); unsafeAtomicAdd(kp + 3, v[3]); } }
            }
        } else {
            const int colg = (pn - 24) * 128 + colw;
            unsigned char* baseA = (unsigned char*)GAB + colg; unsigned char* baseB = (unsigned char*)GAB + (size_t)8192 * 2048 + colg;
            const f32x4 ba0 = *(const f32x4*)(gbias + colg), ba1 = *(const f32x4*)(gbias + colg + 4), bb0 = *(const f32x4*)(gbias + 2048 + colg), bb1 = *(const f32x4*)(gbias + 2048 + colg + 4);
#pragma unroll
            for (int ai = 0; ai < 2; ++ai)
#pragma unroll
                for (int m = 0; m < 4; ++m) { const int row = row0 + ai * HALF + m * 16;
                    const f32x4 a0 = sigm4(cva(acc[ai][0][m][0]) * OSC + ba0), a1 = sigm4(cva(acc[ai][0][m][1]) * OSC + ba1); const f32x4 b0 = sigm4(cva(acc[ai][1][m][0]) * OSC + bb0), b1 = sigm4(cva(acc[ai][1][m][1]) * OSC + bb1);
                    u32x2q wa, wb; wa.x = pk4_u8(a0 * 255.0f, 0.f); wa.y = pk4_u8(a1 * 255.0f, 0.f); wb.x = pk4_u8(b0 * 255.0f, 1.f); wb.y = pk4_u8(b1 * 255.0f, 1.f);
                    *(u32x2q*)(baseA + (size_t)row * 2048) = wa; *(u32x2q*)(baseB + (size_t)row * 2048) = wb; }
        }
    }
};
typedef unsigned u32x2e __attribute__((ext_vector_type(2)));
struct EpiMerge2 {
    static constexpr bool PERM = true, AFTER_DRAIN = false, KEEP_SEG0 = true, SEG1_F8 = true;
    const unsigned char* GA; const unsigned char* GB; bf16_t* O;
    __device__ __forceinline__ void operator()(f32x4 (&acc)[2][2][4][2], const Unit& u, int wr, int wc, int fr, int fq) const {
        const int row0 = u.pm * BM + wr * 64 + fr, col0 = u.pn * BM + wc * 32 + 8 * fq;
#pragma unroll
        for (int ai = 0; ai < 2; ++ai)
#pragma unroll
            for (int m = 0; m < 4; ++m) { const size_t off = (size_t)(row0 + ai * HALF + m * 16) * 2048 + col0;
#pragma unroll
                for (int bj = 0; bj < 2; ++bj) { const u32x2e gb = *(const u32x2e*)(GB + off + bj * HALF); const f32x4 b0 = ub4(gb.x), b1 = ub4(gb.y);
                    if (u.seg == 0) {
                        const u32x2e ga = *(const u32x2e*)(GA + off + bj * HALF); const f32x4 a0 = ub4(ga.x), a1 = ub4(ga.y); f32x4 r0, r1;
#pragma unroll
                        for (int e = 0; e < 4; ++e) { r0[e] = a0[e] * __builtin_amdgcn_rcpf(b0[e]) * (H8_SCALE * W8_SCALE); r1[e] = a1[e] * __builtin_amdgcn_rcpf(b1[e]) * (H8_SCALE * W8_SCALE); }
                        acc[ai][bj][m][0] = acc[ai][bj][m][0] * r0; acc[ai][bj][m][1] = acc[ai][bj][m][1] * r1;
                    } else {
                        constexpr float sc = MB8_SCALE / (255.0f * H8_SCALE * W8_SCALE);
                        const f32x4 a = acc[ai][bj][m][0] * (b0 * sc), b = acc[ai][bj][m][1] * (b1 * sc); u32x2e w; w.x = pk4_i8(a[0], a[1], a[2], a[3]); w.y = pk4_i8(b[0], b[1], b[2], b[3]);
                        *(u32x2e*)((unsigned char*)O + off + bj * HALF) = w; } } }
    }
};
struct EpiX1 {
    static constexpr bool PERM = true, AFTER_DRAIN = false, KEEP_SEG0 = false, SEG1_F8 = false;
    static constexpr float OSC = 1.0f / (MB8_SCALE * WI8_SCALE);
    const float* X; bf16_t* X1B; unsigned long long* SS; unsigned char* X1Q;
    __device__ __forceinline__ void operator()(const f32x4 (&acc)[2][2][4][2], const Unit& u, int wr, int wc, int fr, int fq) const {
        const int row0 = u.pm * BM + wr * 64 + fr, col0 = u.pn * BM + wc * 32 + 8 * fq;
#pragma unroll
        for (int ai = 0; ai < 2; ++ai)
#pragma unroll
            for (int m = 0; m < 4; ++m) { const int row = row0 + ai * HALF + m * 16; const size_t off = (size_t)row * 2048 + col0; float sq = 0.f;
#pragma unroll
                for (int bj = 0; bj < 2; ++bj) { const f32x4 x0 = *(const f32x4*)(X + off + bj * HALF), x1v = *(const f32x4*)(X + off + bj * HALF + 4); const f32x4 v0 = __builtin_convertvector(__builtin_bit_cast(i32x4, acc[ai][bj][m][0]), f32x4) * OSC + x0, v1 = __builtin_convertvector(__builtin_bit_cast(i32x4, acc[ai][bj][m][1]), f32x4) * OSC + x1v;
                    *(u32x4*)(X1B + off + bj * HALF) = pack8(v0, v1);
                    { const f32x4 a = v0 * X1Q_SCALE, b = v1 * X1Q_SCALE; u32x2e w; w.x = pk4_i8(a[0], a[1], a[2], a[3]); w.y = pk4_i8(b[0], b[1], b[2], b[3]); *(u32x2e*)(X1Q + off + bj * HALF) = w; }
                    sq += (v0[0] * v0[0] + v0[1] * v0[1]) + (v0[2] * v0[2] + v0[3] * v0[3]) + (v1[0] * v1[0] + v1[1] * v1[1]) + (v1[2] * v1[2] + v1[3] * v1[3]); }
                sq += __shfl_xor(sq, 16); sq += __shfl_xor(sq, 32);
                if (fq == 0) atomicAdd(SS + row, (unsigned long long)(sq * 4294967296.0f)); }
    }
};
__device__ __forceinline__ float rinv_from_ss(unsigned long long s) { return 1.0f / sqrtf((float)((double)s * (1.0 / 4294967296.0) * (1.0 / 2048.0)) + 1e-6f); }
struct EpiQP {
    static constexpr bool PERM = true, AFTER_DRAIN = false, KEEP_SEG0 = false, SEG1_F8 = false;
    const unsigned long long* SS; bf16_t* O;
    __device__ __forceinline__ void operator()(const f32x4 (&acc)[2][2][4][2], const Unit& u, int wr, int wc, int fr, int fq) const {
        const int row0 = u.pm * BM + wr * 64 + fr, col0 = u.pn * BM + wc * 32 + 8 * fq;
#pragma unroll
        for (int ai = 0; ai < 2; ++ai)
#pragma unroll
            for (int m = 0; m < 4; ++m) { const int row = row0 + ai * HALF + m * 16; const size_t off = (size_t)row * 2048 + col0; const float rv = rinv_from_ss(SS[row]) * (1.0f / (X1Q_SCALE * WI8_SCALE));
#pragma unroll
                for (int bj = 0; bj < 2; ++bj) *(u32x4*)(O + off + bj * HALF) = pack8(__builtin_convertvector(__builtin_bit_cast(i32x4, acc[ai][bj][m][0]), f32x4) * rv, __builtin_convertvector(__builtin_bit_cast(i32x4, acc[ai][bj][m][1]), f32x4) * rv); }
    }
};

typedef int i32x8 __attribute__((ext_vector_type(8)));
__device__ __forceinline__ i32x8 cat8(bf16x8 a, bf16x8 b) { return __builtin_bit_cast(i32x8, __builtin_shufflevector(a, b, 0, 1, 2, 3, 4, 5, 6, 7, 8, 9, 10, 11, 12, 13, 14, 15)); }
template <class Epi, class Sched, bool ALIGN_EPI = false, bool SP2 = false, int QM = 0>
__device__ __forceinline__ void gemm_phase(PG8_LAS unsigned char* lds, const Gemm g, const Sched& S, const Epi& E) {
    const int tid = threadIdx.x, wid = __builtin_amdgcn_readfirstlane(tid >> 6), lane = tid & 63, wr = wid >> 2, wc = wid & 3, fr = lane & 15, fq = lane >> 4;
    const int K = g.K, nt = K / BK;
    unsigned voffA[2], voffB[2];
#pragma unroll
    for (int i = 0; i < 2; ++i) { int R, C; stage_rc(tid * 16 + i * 8192, R, C); const int Rb = Epi::PERM ? ((R & ~31) + perm32(R & 31)) : R;
        voffA[i] = (unsigned)(R * K + C) * 2u; voffB[i] = (unsigned)(Rb * K + C) * 2u; }
    const size_t kstep = (size_t)(BK * 2);
    const size_t hstep = (size_t)HALF * K * 2;
    const size_t tstep = 2 * hstep;
    const unsigned ldsw = (unsigned)wid * 1024u;
    const int aoff = lds_byte(wr * 64 + fr, fq * 8), boff = lds_byte(wc * 32 + fr, fq * 8);
#define PG8_SA(b, h) (((b) * 2 + (h)) * HTB)
#define PG8_SB(b, h) ((4 + (b) * 2 + (h)) * HTB)
#define PG8_STAGE(bufoff, gbase, voff) do { asm volatile("" : "+v"((voff)[0]), "+v"((voff)[1])); _Pragma("unroll") for (int _i = 0; _i < 2; ++_i) \
        __builtin_amdgcn_global_load_lds((const unsigned*)((const char*)(gbase) + (voff)[_i]), (PG8_LAS unsigned*)(lds + (bufoff) + ldsw + _i * 8192), 16, 0, 0); } while (0)
#define PG8_LDA(dst, b, h) do { _Pragma("unroll") for (int m = 0; m < 4; ++m) _Pragma("unroll") for (int k = 0; k < 2; ++k) dst[m][k] = *(const PG8_LAS bf16x8*)(lds + PG8_SA(b, h) + aoff + m * 2048 + k * 1024); } while (0)
#define PG8_LDB(dst, b, h) do { _Pragma("unroll") for (int n = 0; n < 2; ++n) _Pragma("unroll") for (int k = 0; k < 2; ++k) dst[n][k] = *(const PG8_LAS bf16x8*)(lds + PG8_SB(b, h) + boff + n * 2048 + k * 1024); } while (0)
#define PG8_MMA8(ai, bj, At, Bt) do { _Pragma("unroll") for (int m = 0; m < 4; ++m) _Pragma("unroll") for (int n = 0; n < 2; ++n) \
            acc[ai][bj][m][n] = __builtin_amdgcn_mfma_scale_f32_16x16x128_f8f6f4(cat8(Bt[n][0], Bt[n][1]), cat8(At[m][0], At[m][1]), acc[ai][bj][m][n], 0, 0, 0, 0, 0, 0); } while (0)
#define PG8_MMAI8(ai, bj, At, Bt) do { _Pragma("unroll") for (int m = 0; m < 4; ++m) _Pragma("unroll") for (int n = 0; n < 2; ++n) _Pragma("unroll") for (int k = 0; k < 2; ++k) \
            acc[ai][bj][m][n] = __builtin_bit_cast(f32x4, __builtin_amdgcn_mfma_i32_16x16x64_i8(__builtin_bit_cast(i32x4, Bt[n][k]), __builtin_bit_cast(i32x4, At[m][k]), __builtin_bit_cast(i32x4, acc[ai][bj][m][n]), 0, 0, 0)); } while (0)
#define PG8_MMA16(ai, bj, At, Bt) do { _Pragma("unroll") for (int m = 0; m < 4; ++m) _Pragma("unroll") for (int n = 0; n < 2; ++n) _Pragma("unroll") for (int k = 0; k < 2; ++k) \
            acc[ai][bj][m][n] = __builtin_amdgcn_mfma_f32_16x16x32_bf16(Bt[n][k], At[m][k], acc[ai][bj][m][n], 0, 0, 0); } while (0)
#define PG8_MMA(ai, bj, At, Bt) do { __builtin_amdgcn_s_setprio(1); \
        if constexpr (QM == 1) PG8_MMA8(ai, bj, At, Bt); \
        else if constexpr (QM == 2) PG8_MMAI8(ai, bj, At, Bt); \
        else if constexpr (Epi::SEG1_F8) { if (fl16) PG8_MMA16(ai, bj, At, Bt); if (fl8) PG8_MMA8(ai, bj, At, Bt); } \
        else PG8_MMA16(ai, bj, At, Bt); \
        __builtin_amdgcn_s_setprio(0); } while (0)
#define PG8_WAIT_V(n) asm volatile("s_waitcnt vmcnt(" #n ")" ::: "memory")
#define PG8_WAIT_L(n) asm volatile("s_waitcnt lgkmcnt(" #n ")" ::: "memory")
#define PG8_BAR __builtin_amdgcn_s_barrier()
#define PG8_SCHED __builtin_amdgcn_sched_barrier(0)
    Unit cur, nxt; int ui = 0;
    if (!S.next(0, cur)) return;
    f32x4 acc[2][2][4][2];
#pragma unroll
    for (int a = 0; a < 2; ++a)
#pragma unroll
        for (int b = 0; b < 2; ++b)
#pragma unroll
            for (int m = 0; m < 4; ++m)
#pragma unroll
                for (int n = 0; n < 2; ++n) acc[a][b][m][n] = (f32x4){0.f, 0.f, 0.f, 0.f};
    bf16x8 At[4][2], B0[2][2], B1[2][2];
    const char* cA = (const char*)(cur.seg ? g.A2 : g.A) + (size_t)cur.pm * tstep; const char* cB = (const char*)(cur.seg ? g.Bt2 : g.Bt) + (size_t)cur.pn * tstep;
    S.a_ready(cur);
    if constexpr (SP2) {
        PG8_STAGE(PG8_SB(0, 0), cB, voffB); PG8_STAGE(PG8_SB(0, 1), cB + hstep, voffB); PG8_STAGE(PG8_SA(0, 0), cA, voffA); PG8_STAGE(PG8_SA(0, 1), cA + hstep, voffA);
        if (wr == 1) PG8_BAR;
        PG8_WAIT_V(2); PG8_BAR;
        PG8_STAGE(PG8_SB(1, 0), cB + kstep, voffB); PG8_STAGE(PG8_SA(1, 0), cA + kstep, voffA); PG8_STAGE(PG8_SB(1, 1), cB + hstep + kstep, voffB);
        PG8_WAIT_V(6); PG8_BAR;
    } else {
        PG8_STAGE(PG8_SB(0, 0), cB, voffB); PG8_STAGE(PG8_SA(0, 0), cA, voffA); PG8_STAGE(PG8_SB(0, 1), cB + hstep, voffB); PG8_STAGE(PG8_SA(0, 1), cA + hstep, voffA);
        if (wr == 1) PG8_BAR;
        PG8_WAIT_V(4); PG8_BAR;
        PG8_STAGE(PG8_SB(1, 0), cB + kstep, voffB); PG8_STAGE(PG8_SA(1, 0), cA + kstep, voffA); PG8_STAGE(PG8_SB(1, 1), cB + hstep + kstep, voffB);
        PG8_WAIT_V(6); PG8_BAR;
    }
    for (;;) {
        const bool has_next = S.next(ui + 1, nxt);
        const char* nA = has_next ? (const char*)(nxt.seg ? g.A2 : g.A) + (size_t)nxt.pm * tstep : cA; const char* nB = has_next ? (const char*)(nxt.seg ? g.Bt2 : g.Bt) + (size_t)nxt.pn * tstep : cB;
        const bool f8u = Epi::SEG1_F8 && cur.seg != 0; const int ntu = f8u ? nt / 2 : nt;
        int fl8 = cur.seg, fl16 = cur.seg ^ 1; if constexpr (Epi::SEG1_F8) { asm volatile("" : "+s"(fl8)); asm volatile("" : "+s"(fl16)); }
        for (int t = 0; t < ntu; t += 2) {
            const bool last = (t == ntu - 2);
            const char* a1 = cA + (size_t)(t + 1) * kstep;
            const char* a2 = last ? nA : cA + (size_t)(t + 2) * kstep; const char* b2 = last ? nB : cB + (size_t)(t + 2) * kstep;
            const char* a3 = a2 + kstep; const char* b3 = b2 + kstep;
            if (last && has_next) S.a_ready(nxt);
            if constexpr (SP2) {
            PG8_LDB(B0, 0, 0); PG8_LDB(B1, 0, 1); PG8_SCHED; PG8_LDA(At, 0, 0); PG8_STAGE(PG8_SA(1, 1), a1 + hstep, voffA);
            PG8_WAIT_V(8); PG8_WAIT_L(0); PG8_BAR; PG8_MMA(0, 0, At, B0); PG8_MMA(0, 1, At, B1); PG8_BAR; PG8_SCHED;
            PG8_LDA(At, 0, 1); PG8_STAGE(PG8_SB(0, 0), b2, voffB); PG8_STAGE(PG8_SB(0, 1), b2 + hstep, voffB); PG8_STAGE(PG8_SA(0, 0), a2, voffA);
            PG8_WAIT_V(8); PG8_WAIT_L(0); PG8_BAR; PG8_MMA(1, 0, At, B0); PG8_MMA(1, 1, At, B1); PG8_BAR; PG8_SCHED;
            PG8_LDB(B0, 1, 0); PG8_LDB(B1, 1, 1); PG8_SCHED; PG8_LDA(At, 1, 0); PG8_STAGE(PG8_SA(0, 1), a2 + hstep, voffA);
            PG8_WAIT_V(8); PG8_WAIT_L(0); PG8_BAR; PG8_MMA(0, 0, At, B0); PG8_MMA(0, 1, At, B1); PG8_BAR; PG8_SCHED;
            PG8_LDA(At, 1, 1); PG8_STAGE(PG8_SB(1, 0), b3, voffB); PG8_STAGE(PG8_SB(1, 1), b3 + hstep, voffB); PG8_STAGE(PG8_SA(1, 0), a3, voffA);
            PG8_WAIT_V(8); PG8_WAIT_L(0); PG8_BAR; PG8_MMA(1, 0, At, B0); PG8_MMA(1, 1, At, B1); PG8_BAR; PG8_SCHED;
            } else {
            PG8_LDB(B0, 0, 0); PG8_SCHED; PG8_LDA(At, 0, 0); PG8_STAGE(PG8_SA(1, 1), a1 + hstep, voffA);
            PG8_WAIT_L(8); PG8_BAR; PG8_WAIT_L(0); PG8_MMA(0, 0, At, B0); PG8_BAR; PG8_SCHED;
            PG8_LDB(B1, 0, 1); PG8_STAGE(PG8_SB(0, 0), b2, voffB);
            PG8_BAR; PG8_WAIT_L(0); PG8_MMA(0, 1, At, B1); PG8_BAR;
            PG8_LDA(At, 0, 1); PG8_STAGE(PG8_SA(0, 0), a2, voffA);
            PG8_BAR; PG8_WAIT_L(0); PG8_MMA(1, 0, At, B0); PG8_BAR; PG8_SCHED;
            PG8_STAGE(PG8_SB(0, 1), b2 + hstep, voffB);
            PG8_WAIT_V(6); PG8_BAR; PG8_MMA(1, 1, At, B1); PG8_BAR;
            PG8_LDB(B0, 1, 0); PG8_SCHED; PG8_LDA(At, 1, 0); PG8_STAGE(PG8_SA(0, 1), a2 + hstep, voffA);
            PG8_WAIT_L(8); PG8_BAR; PG8_WAIT_L(0); PG8_MMA(0, 0, At, B0); PG8_BAR; PG8_SCHED;
            PG8_LDB(B1, 1, 1); PG8_STAGE(PG8_SB(1, 0), b3, voffB);
            PG8_BAR; PG8_WAIT_L(0); PG8_MMA(0, 1, At, B1); PG8_BAR;
            PG8_LDA(At, 1, 1); PG8_STAGE(PG8_SA(1, 0), a3, voffA);
            PG8_BAR; PG8_WAIT_L(0); PG8_MMA(1, 0, At, B0); PG8_BAR; PG8_SCHED;
            PG8_STAGE(PG8_SB(1, 1), b3 + hstep, voffB);
            PG8_WAIT_V(6); PG8_BAR; PG8_MMA(1, 1, At, B1); PG8_BAR;
            }
        }
        if constexpr (ALIGN_EPI) { if (wr == 0) PG8_BAR; }
        if constexpr (!Epi::AFTER_DRAIN) { int l_ = tid; asm volatile("" : "+v"(l_));
            E(acc, cur, wr, wc, l_ & 15, (l_ >> 4) & 3); S.done(cur); }
        if (!has_next) break;
        if (!(Epi::KEEP_SEG0 && cur.seg == 0)) {
#pragma unroll
        for (int a = 0; a < 2; ++a)
#pragma unroll
            for (int b = 0; b < 2; ++b)
#pragma unroll
                for (int m = 0; m < 4; ++m)
#pragma unroll
                    for (int n = 0; n < 2; ++n) acc[a][b][m][n] = (f32x4){0.f, 0.f, 0.f, 0.f};
        }
        cur = nxt; cA = nA; cB = nB; ++ui;
        if constexpr (ALIGN_EPI) { if (wr == 1) PG8_BAR; }
    }
    PG8_WAIT_V(0);
    if constexpr (!ALIGN_EPI) { if (wr == 0) PG8_BAR; }
    PG8_BAR;
    if constexpr (Epi::AFTER_DRAIN) { E.fused(acc, cur, wr, wc, fr, fq, lds, wid, lane); S.done(cur); }
#undef PG8_SA
#undef PG8_SB
#undef PG8_STAGE
#undef PG8_LDA
#undef PG8_LDB
#undef PG8_MMA
#undef PG8_MMA8
#undef PG8_MMAI8
#undef PG8_MMA16
#undef PG8_WAIT_V
#undef PG8_WAIT_L
#undef PG8_BAR
#undef PG8_SCHED
}
}

constexpr int NWAVES = 8;
#ifndef MK_N_LAUNCHES
#define MK_N_LAUNCHES 1
#endif
constexpr int PER_PHASE = 9;
#ifndef MK_REP_PHASE
#define MK_REP_PHASE -1
#endif
#define NREP(k) (((k) == MK_REP_PHASE) ? 2 : 1)
constexpr int N_LAUNCHES = MK_N_LAUNCHES;
constexpr int M = 8192, SEQ = 4096, DM = 2048, INW = 10240, NEXP = 16384;
constexpr float RMS_EPS = 1e-6f;
constexpr size_t MiB = 1u << 20;
constexpr size_t WS_CTL = 0, CTL_ZERO_BYTES = 64 * 1024;
constexpr size_t WS_SS = 256 * 1024, WS_KSUM = 512 * 1024;
constexpr size_t WS_WIN = 2 * MiB, WS_WBC = 42 * MiB, WS_WBA = 46 * MiB, WS_WOUT = 50 * MiB, WS_WPQ = 58 * MiB, WS_KEYS = 66 * MiB, WS_CS = 67 * MiB;
constexpr size_t WS_RMS = 68 * MiB;
constexpr size_t WS_UB = 70 * MiB, WS_VB = 102 * MiB;
constexpr size_t WS_XB = 198 * MiB;
constexpr size_t WS_T6 = 230 * MiB;
constexpr size_t WS_GAB = 326 * MiB;
constexpr size_t WS_UC = 390 * MiB, WS_AO = 406 * MiB;
constexpr size_t WS_EXP = 422 * MiB, WS_GATE = 426 * MiB;
constexpr int IN_N16 = 3072;
constexpr size_t WS_WIN8 = WS_WIN + 12 * MiB;
constexpr size_t WS_H8 = 430 * MiB;
constexpr size_t WS_X1Q = 446 * MiB;
constexpr size_t WS_END = 462 * MiB;
constexpr size_t WS_TMP = WS_XB, WS_MB = WS_T6, WS_X1B = WS_T6 + 48 * MiB, WS_QP = WS_GAB;
constexpr int CW_BAR = 4096;
constexpr int RING_OFF = 0, RING_BYTES = 131072;
constexpr int LDSCTL_OFF = RING_BYTES, MISC_OFF = LDSCTL_OFF + 320;
constexpr int LDS_BYTES = 147456;

#define GAS __attribute__((address_space(1)))
#define LAS __attribute__((address_space(3)))
typedef unsigned short bf16;
typedef unsigned v4u __attribute__((ext_vector_type(4)));
typedef float f32x4 __attribute__((ext_vector_type(4)));
typedef short bf16x8 __attribute__((ext_vector_type(8)));
typedef GAS unsigned gu32;
typedef GAS unsigned long long gu64;
#define RLX_AGENT __ATOMIC_RELAXED, __HIP_MEMORY_SCOPE_AGENT
#define LDS_WAIT() asm volatile("s_waitcnt lgkmcnt(0)" ::: "memory")
#define VM_WAIT() asm volatile("s_waitcnt vmcnt(0)" ::: "memory")
__device__ __forceinline__ unsigned long long rt() { return __builtin_amdgcn_s_memrealtime(); }
__device__ __forceinline__ unsigned f2bf(float f) { unsigned u = __builtin_bit_cast(unsigned, f); return (u + 0x7fffu + ((u >> 16) & 1u)) >> 16; }
__device__ __forceinline__ unsigned pk2(float lo, float hi) { return f2bf(lo) | (f2bf(hi) << 16); }

#define XB_TMO      128
#define XB_XCNT(j)  (256  + 64 * (j))
#define XB_XSUB(j)  (1280 + 64 * (j))
#define XB_XGEN(j)  (2304 + 64 * (j))
#define XB_TOP      3328
#define XB_TOPGEN   3392
#define XCD_BAR_WORDS 3456
#define XB_SPIN_CAP (1u << 18)

__device__ __forceinline__ unsigned xb_ld(unsigned* p)              { return __hip_atomic_load(p, __ATOMIC_RELAXED, __HIP_MEMORY_SCOPE_AGENT); }
__device__ __forceinline__ unsigned xb_add(unsigned* p, unsigned v) { return __hip_atomic_fetch_add(p, v, __ATOMIC_RELAXED, __HIP_MEMORY_SCOPE_AGENT); }
__device__ __forceinline__ unsigned xb_xcc_id() { return (unsigned)__builtin_amdgcn_s_getreg((3 << 11) | 20) & 0xFu; }
#define XB_SPIN(cond, bar) do { unsigned _sp = 0; while (cond) { __builtin_amdgcn_s_sleep(1); \
    if ((++_sp & 255u) == 0u) { if (xb_ld(&(bar)[XB_TMO])) break; if (_sp > XB_SPIN_CAP) { atomicAdd(&(bar)[XB_TMO], 1u); break; } } } } while (0)

struct XcdBarrier {
    unsigned* bar; unsigned x;
    volatile LAS unsigned* st;
};

__device__ __forceinline__ XcdBarrier xcd_barrier_post(unsigned* bar, volatile LAS unsigned* st) {
    XcdBarrier b; b.bar = bar; b.x = xb_xcc_id(); b.st = st;
    if (threadIdx.x == 0) (void)xb_add(&bar[XB_XCNT(b.x)], 1u);
    return b;
}
__device__ __forceinline__ void xcd_barrier_complete(unsigned* bar, unsigned x, unsigned& nloc, unsigned& nx) {
    const unsigned G = gridDim.x * gridDim.y * gridDim.z;
    unsigned sum, cnt, mine, sp = 0u;
    for (;;) {
        sum = 0u; cnt = 0u; mine = 0u;
#pragma unroll
        for (unsigned j = 0; j < 16; ++j) { const unsigned c = xb_ld(&bar[XB_XCNT(j)]); sum += c; cnt += (c > 0u) ? 1u : 0u; mine = (j == x) ? c : mine; }
        if (sum == G) break;
        __builtin_amdgcn_s_sleep(1);
        if ((++sp & 255u) == 0u) { if (xb_ld(&bar[XB_TMO])) break; if (sp > XB_SPIN_CAP) { atomicAdd(&bar[XB_TMO], 1u); break; } }
    }
    nloc = mine > 0u ? mine : 1u; nx = cnt > 0u ? cnt : 1u;
}

struct Ctx { LAS unsigned char* lds; int tid, lane, wave, vcu, G; };
struct BarWork { const float* pu; const float* pv; const float* g2; unsigned char* ws; int part, nparts; };
__device__ __forceinline__ void convert_tables(const Ctx& F, const float* pu, const float* pv, const float* g2, unsigned char* ws, int part, int nparts, int w0);
__device__ __forceinline__ void xcd_barrier(const XcdBarrier& b, const Ctx* F = nullptr, const BarWork* wk = nullptr) {
    asm volatile("s_waitcnt vmcnt(0)" ::: "memory");
    __syncthreads();
    if (wk && wk->part >= 0) convert_tables(*F, wk->pu, wk->pv, wk->g2, wk->ws, wk->part, wk->nparts, 1);
    if (threadIdx.x == 0) {
        unsigned* bar = b.bar;
        __builtin_amdgcn_s_waitcnt(0);
        unsigned nloc = b.st[0], nx = b.st[1];
        if (nloc == 0u) { xcd_barrier_complete(bar, b.x, nloc, nx); b.st[0] = nloc; b.st[1] = nx; }
        const unsigned old = xb_add(&bar[XB_XSUB(b.x)], 1u);
        const unsigned gen = old / nloc;
        if (old + 1u == (gen + 1u) * nloc) {
            __builtin_amdgcn_fence(__ATOMIC_RELEASE, "agent");
            asm volatile("s_waitcnt vmcnt(0)" ::: "memory");
            const unsigned og = xb_add(&bar[XB_TOP], 1u);
            const unsigned tg = og / nx;
            if (og + 1u == (tg + 1u) * nx) xb_add(&bar[XB_TOPGEN], 1u);
            else XB_SPIN(xb_ld(&bar[XB_TOPGEN]) == tg, bar);
            __builtin_amdgcn_fence(__ATOMIC_ACQUIRE, "agent");
            xb_add(&bar[XB_XGEN(b.x)], 1u);
            asm volatile("s_waitcnt vmcnt(0)" ::: "memory");
        } else {
            XB_SPIN(xb_ld(&bar[XB_XGEN(b.x)]) == gen, bar);
            __builtin_amdgcn_fence(__ATOMIC_ACQUIRE, "agent");
            asm volatile("s_waitcnt vmcnt(0)" ::: "memory");
        }
    }
    __syncthreads();
}

typedef __bf16 bf16x2v __attribute__((ext_vector_type(2)));
typedef float f32x16 __attribute__((ext_vector_type(16)));
__device__ __forceinline__ float bflo(unsigned w) { return __uint_as_float(w << 16); }
__device__ __forceinline__ float bfhi(unsigned w) { return __uint_as_float(w & 0xffff0000u); }
__device__ __forceinline__ float dot2bf(unsigned a, unsigned b, float c) { return __builtin_amdgcn_fdot2_f32_bf16(__builtin_bit_cast(bf16x2v, a), __builtin_bit_cast(bf16x2v, b), c, false); }
__device__ __forceinline__ float wave_sum(float v) {
#pragma unroll
    for (int o = 1; o < 64; o <<= 1) v += __shfl_xor(v, o);
    return v; }
__device__ __forceinline__ float wave_max(float v) {
#pragma unroll
    for (int o = 1; o < 64; o <<= 1) v = fmaxf(v, __shfl_xor(v, o));
    return v; }
__device__ __forceinline__ float rdlane(float v, int l) { return __int_as_float(__builtin_amdgcn_readlane(__float_as_int(v), l)); }
__device__ __forceinline__ float gelu_tanh(float x) { const float z = 0.7978845608028654f * (x + 0.044715f * x * x * x); const float e = __expf(2.0f * z); const float th = 1.0f - 2.0f * __builtin_amdgcn_rcpf(1.0f + e); return 0.5f * x * (1.0f + th); }


typedef unsigned u32x2v __attribute__((ext_vector_type(2)));
struct TItem { const float* W; bf16* WT; const float* gk; int K, N, k0, n0, dn0; int f8; int ld; };
__device__ __forceinline__ TItem p0_titem(const float* W, int K, int N, bf16* WT, const float* gk, int item, bool remap, int f8_from = 1 << 30, unsigned char* WT8 = nullptr, int ld8 = 0, int qmode = 1) {
    const int nblk = N / 32, kb = 2 * (item / (2 * nblk)) + (item & 1), nb = (item >> 1) % nblk, k0 = 64 * kb, n0 = 32 * nb;
    int dn0 = n0; if (remap && n0 >= 1024 && n0 < 3072) { const int c = (n0 - 1024) & 1023, isx = (n0 >= 2048); dn0 = 1024 + (c >> 7) * 256 + isx * 128 + (c & 127); }
    if (remap && n0 >= 6144) { const int c = (n0 - 6144) & 2047, isb = (n0 >= 8192); dn0 = 6144 + (c >> 7) * 256 + isb * 128 + (c & 127); }
    const int f8 = dn0 >= f8_from ? qmode : 0; if (f8) { WT = (bf16*)WT8; dn0 -= f8_from; }
    return TItem{W, WT, gk, K, N, k0, n0, dn0, f8, f8 ? (ld8 ? ld8 : K) : K};
}
__device__ __forceinline__ void p0_tload(const TItem& t, f32x4 (&v)[8], int lane) {
#pragma unroll
    for (int i = 0; i < 8; ++i) { const int kk = 8 * i + (lane >> 3), nn = 4 * (lane & 7); v[i] = *(const GAS f32x4*)(t.W + (size_t)(t.k0 + kk) * t.N + t.n0 + nn); if (t.gk) v[i] = v[i] * t.gk[t.k0 + kk]; }
}
__device__ __forceinline__ void p0_tfinish(const TItem& t, const f32x4 (&v)[8], LAS float* scr, int lane) {
#pragma unroll
    for (int i = 0; i < 8; ++i) { const int kk = 8 * i + (lane >> 3), nn = 4 * (lane & 7); scr[kk * 33 + nn] = v[i][0]; scr[kk * 33 + nn + 1] = v[i][1]; scr[kk * 33 + nn + 2] = v[i][2]; scr[kk * 33 + nn + 3] = v[i][3]; }
    LDS_WAIT(); asm volatile("" ::: "memory");
    const int c = lane & 7;
    if (t.f8) {
#pragma unroll
        for (int j = 0; j < 4; ++j) { const int n = (lane >> 3) + 8 * j; const LAS float* s = scr + (8 * c) * 33 + n; int w0 = 0, w1 = 0;
            if (t.f8 == 1) {
            w0 = __builtin_amdgcn_cvt_pk_fp8_f32(s[0 * 33] * pg8::W8_SCALE, s[1 * 33] * pg8::W8_SCALE, w0, false); w0 = __builtin_amdgcn_cvt_pk_fp8_f32(s[2 * 33] * pg8::W8_SCALE, s[3 * 33] * pg8::W8_SCALE, w0, true);
            w1 = __builtin_amdgcn_cvt_pk_fp8_f32(s[4 * 33] * pg8::W8_SCALE, s[5 * 33] * pg8::W8_SCALE, w1, false); w1 = __builtin_amdgcn_cvt_pk_fp8_f32(s[6 * 33] * pg8::W8_SCALE, s[7 * 33] * pg8::W8_SCALE, w1, true);
            } else { w0 = (int)pg8::pk4_i8(s[0 * 33] * pg8::WI8_SCALE, s[1 * 33] * pg8::WI8_SCALE, s[2 * 33] * pg8::WI8_SCALE, s[3 * 33] * pg8::WI8_SCALE); w1 = (int)pg8::pk4_i8(s[4 * 33] * pg8::WI8_SCALE, s[5 * 33] * pg8::WI8_SCALE, s[6 * 33] * pg8::WI8_SCALE, s[7 * 33] * pg8::WI8_SCALE); }
            u32x2v o; o.x = (unsigned)w0; o.y = (unsigned)w1;
            *(GAS u32x2v*)((GAS unsigned char*)t.WT + (size_t)(t.dn0 + n) * t.ld + t.k0 + 8 * c) = o; }
        LDS_WAIT(); asm volatile("" ::: "memory");
        return; }
#pragma unroll
    for (int j = 0; j < 4; ++j) { const int n = (lane >> 3) + 8 * j; const LAS float* s = scr + (8 * c) * 33 + n;
        v4u o; o.x = pk2(s[0 * 33], s[1 * 33]); o.y = pk2(s[2 * 33], s[3 * 33]); o.z = pk2(s[4 * 33], s[5 * 33]); o.w = pk2(s[6 * 33], s[7 * 33]);
        *(GAS v4u*)(t.WT + (size_t)(t.dn0 + n) * t.K + t.k0 + 8 * c) = o; }
    LDS_WAIT(); asm volatile("" ::: "memory");
}
typedef unsigned u32x6 __attribute__((ext_vector_type(6))); typedef __bf16 bf16x2v __attribute__((ext_vector_type(2))); typedef __bf16 bf16x32v __attribute__((ext_vector_type(32))); typedef float f32x16v __attribute__((ext_vector_type(16))); typedef float f32x32v __attribute__((ext_vector_type(32)));
constexpr float PEER_SU = 90.5f, PEER_SV = 5.66f;
constexpr int PEER_ROWB = 1536;
__device__ __forceinline__ void convert_tables(const Ctx& F, const float* pu, const float* pv, const float* g2, unsigned char* ws, int part, int nparts, int w0) {
    if (F.wave < w0) return;
    const int nw = NWAVES - w0, gt = (F.vcu * nw + (F.wave - w0)) * 64 + F.lane, NT = F.G * nw * 64;
    constexpr int TOT = NEXP * 64; const int per = (TOT + nparts - 1) / nparts, lo = part * per, hi = (lo + per < TOT) ? lo + per : TOT;
    for (int i = lo + gt; i < hi; i += NT) { const int e = i >> 6, l = i & 63;
        const GAS f32x4* ur = (const GAS f32x4*)(pu + (size_t)e * 2048 + 16 * l); const GAS f32x4* vr = (const GAS f32x4*)(pv + (size_t)e * 2048 + 16 * l); const GAS f32x4* gr = (const GAS f32x4*)(g2 + 16 * l);
        f32x32v uf, vf;
#pragma unroll
        for (int q = 0; q < 4; ++q) { const f32x4 a = ur[q] * gr[q] * PEER_SU, b = ur[256 + q] * gr[256 + q] * PEER_SU, c = vr[q] * PEER_SV, d = vr[256 + q] * PEER_SV;
#pragma unroll
            for (int t = 0; t < 4; ++t) { uf[4 * q + t] = a[t]; uf[16 + 4 * q + t] = b[t]; vf[4 * q + t] = c[t]; vf[16 + 4 * q + t] = d[t]; } }
        const u32x6 wu = __builtin_amdgcn_cvt_scalef32_pk32_fp6_bf16(__builtin_convertvector(uf, bf16x32v), 1.0f), wv = __builtin_amdgcn_cvt_scalef32_pk32_fp6_bf16(__builtin_convertvector(vf, bf16x32v), 1.0f);
        GAS unsigned char* du = (GAS unsigned char*)(ws + WS_UB + (size_t)e * PEER_ROWB); GAS unsigned char* dv = (GAS unsigned char*)(ws + WS_VB + (size_t)e * PEER_ROWB);
        v4u o; u32x2v o2;
        o.x = wu[0]; o.y = wu[1]; o.z = wu[2]; o.w = wu[3]; o2.x = wu[4]; o2.y = wu[5]; *(GAS v4u*)(du + 16 * l) = o; *(GAS u32x2v*)(du + 1024 + 8 * l) = o2;
        o.x = wv[0]; o.y = wv[1]; o.z = wv[2]; o.w = wv[3]; o2.x = wv[4]; o2.y = wv[5]; *(GAS v4u*)(dv + 16 * l) = o; *(GAS u32x2v*)(dv + 1024 + 8 * l) = o2; }
}
__device__ __forceinline__ void p0_prologue(const Ctx& F, const float* const* in, unsigned char* ws, const double* invf) {
    const float* x = in[0]; const int* pos = (const int*)in[1]; const float* g1 = in[2]; const float* w_in = in[3];
    const float* w_bc = in[6]; const float* w_ba = in[7]; const float* w_out = in[8]; const float* g2 = in[9]; const float* w_pq = in[10];
    const float* keys = in[11]; const float* pu = in[12]; const float* pv = in[13];
    LAS float* scr = (LAS float*)(F.lds + RING_OFF + F.wave * 16384);
    const int gw = F.vcu * NWAVES + F.wave, NGW = F.G * NWAVES;
    const int gt = gw * 64 + F.lane, NT = NGW * 64;
    for (int i = gt; i < 8192; i += NT) ((GAS unsigned long long*)(ws + WS_SS))[i] = 0ull;
    for (int i = gt; i < 32 * 1024; i += NT) ((GAS float*)(ws + WS_KSUM))[i] = 0.f;
    constexpr int I_IN = 32 * 320, I_BC = 16 * 64, I_OUT = 32 * 64;
    constexpr int NITEMS = I_IN + 2 * I_BC + 2 * I_OUT;
    auto decode = [&](int it) -> TItem { int r = it;
        if (r < I_IN) return p0_titem(w_in, 2048, INW, (bf16*)(ws + WS_WIN), g1, r, true, 0, ws + WS_WIN, 0, 2); r -= I_IN;
        if (r < I_BC) return p0_titem(w_bc, 1024, 2048, (bf16*)(ws + WS_WBC), nullptr, r, false); r -= I_BC;
        if (r < I_BC) return p0_titem(w_ba, 1024, 2048, (bf16*)(ws + WS_WBA), nullptr, r, false, 0, ws + WS_WBA, 2048); r -= I_BC;
        if (r < I_OUT) return p0_titem(w_out, 2048, 2048, (bf16*)(ws + WS_WOUT), nullptr, r, false, 0, ws + WS_WOUT, 0, 2); r -= I_OUT;
        return p0_titem(w_pq, 2048, 2048, (bf16*)(ws + WS_WPQ), g2, r, false, 0, ws + WS_WPQ, 0, 2); };
    {
        int it = gw; TItem A, B; f32x4 va[8], vb[8];
        bool hasA = it < NITEMS; if (hasA) { A = decode(it); p0_tload(A, va, F.lane); }
        while (hasA) {
            const int it2 = it + NGW; const bool hasB = it2 < NITEMS; if (hasB) { B = decode(it2); p0_tload(B, vb, F.lane); }
            p0_tfinish(A, va, scr, F.lane);
            if (!hasB) break;
            const int it3 = it2 + NGW; hasA = it3 < NITEMS; if (hasA) { A = decode(it3); p0_tload(A, va, F.lane); }
            p0_tfinish(B, vb, scr, F.lane);
            it = it3;
        }
    }
    for (int i = gt; i < 16 * 128 * 128 / 8; i += NT) { const f32x4 a = ((const GAS f32x4*)keys)[2 * i], b = ((const GAS f32x4*)keys)[2 * i + 1];
        v4u o; o.x = pk2(a[0], a[1]); o.y = pk2(a[2], a[3]); o.z = pk2(b[0], b[1]); o.w = pk2(b[2], b[3]); ((GAS v4u*)(ws + WS_KEYS))[i] = o; }
    for (int m = gw; m < M; m += NGW) { const GAS f32x4* xr = (const GAS f32x4*)(x + (size_t)m * DM);
        f32x4 v[8]; float s = 0.f;
#pragma unroll
        for (int i = 0; i < 4; ++i) { v[2 * i] = xr[i * 128 + 2 * F.lane]; v[2 * i + 1] = xr[i * 128 + 2 * F.lane + 1]; }
#pragma unroll
        for (int i = 0; i < 8; ++i) s += (v[i][0] * v[i][0] + v[i][1] * v[i][1]) + (v[i][2] * v[i][2] + v[i][3] * v[i][3]);
        const float rms = sqrtf(wave_sum(s) * (1.0f / DM) + RMS_EPS), rinv = 1.0f / rms;
#pragma unroll
        for (int i = 0; i < 4; ++i) { const f32x4 a = v[2 * i] * rinv, b = v[2 * i + 1] * rinv;
            const f32x4 a8 = a * pg8::HI8_SCALE, b8 = b * pg8::HI8_SCALE;
            const unsigned w0 = pg8::pk4_i8(a8[0], a8[1], a8[2], a8[3]), w1 = pg8::pk4_i8(b8[0], b8[1], b8[2], b8[3]);
            u32x2v o8; o8.x = (unsigned)w0; o8.y = (unsigned)w1; ((GAS u32x2v*)(ws + WS_H8 + (size_t)m * DM))[i * 64 + F.lane] = o8; } }
    for (int i = gt; i < M * 16; i += NT) { const int row = i >> 4, f = i & 15; const double ang = (double)pos[row] * invf[f];
        const double k = __builtin_rint(ang * 0.15915494309189535); const float r = (float)(ang - k * 6.283185307179586);
        float* cs = (float*)(ws + WS_CS); cs[row * 32 + f] = __cosf(r); cs[row * 32 + 16 + f] = __sinf(r); }
}

__device__ __forceinline__ void attn_simple(const Ctx& F, const bf16* Q, const bf16* K, const bf16* V, const float* ksum, bf16* AO) {
    LAS float* qf = (LAS float*)(F.lds + RING_OFF + F.wave * 512);
    const int gw = F.vcu * NWAVES + F.wave, NGW = F.G * NWAVES, lane = F.lane;
    for (int item = gw; item < 16 * SEQ; item += NGW) {
        const int bh = item >> 12, t = item & 4095, b = bh >> 3, h = bh & 7, blk = t >> 8;
        const size_t row = (size_t)b * SEQ + t;
        { const unsigned qq = *(const GAS unsigned*)(Q + row * 1024 + h * 128 + 2 * lane); qf[2 * lane] = bflo(qq); qf[2 * lane + 1] = bfhi(qq); }
        LDS_WAIT(); asm volatile("" ::: "memory");
        float g = -INFINITY;
        if (lane < blk) { const GAS f32x4* km = (const GAS f32x4*)(ksum + (size_t)(b * 16 + lane) * 1024 + h * 128); float a = 0.f;
            for (int d = 0; d < 32; ++d) { const f32x4 kv = km[d]; const f32x4 qv = *(const LAS f32x4*)(qf + 4 * d); a += (kv[0] * qv[0] + kv[1] * qv[1]) + (kv[2] * qv[2] + kv[3] * qv[3]); }
            g = a; }
        int sel[3];
#pragma unroll
        for (int i = 0; i < 3; ++i) { const float mx = wave_max(g); const unsigned long long bal = __ballot(g == mx && lane < blk); const int idx = bal ? (__ffsll((long long)bal) - 1) : 0; sel[i] = idx; if (lane == idx) g = -INFINITY; }
        const int nsel = blk < 3 ? blk : 3;
        float sc[4][4]; float mx = -INFINITY;
#pragma unroll
        for (int slot = 0; slot < 4; ++slot) {
            const bool valid = (slot == 3) || (slot < nsel);
            const int kb = (slot == 3) ? blk : sel[slot < 3 ? slot : 0];
#pragma unroll
            for (int r = 0; r < 4; ++r) {
                float s = -INFINITY; const int key0 = kb * 256 + r * 64;
                if (valid && (slot < 3 || key0 <= t)) {
                    const int key = key0 + lane; const GAS v4u* kp = (const GAS v4u*)(K + ((size_t)b * SEQ + key) * 1024 + h * 128); float a = 0.f;
#pragma unroll 4
                    for (int d = 0; d < 16; ++d) { const v4u kk = kp[d]; const f32x4 q0 = *(const LAS f32x4*)(qf + 8 * d), q1 = *(const LAS f32x4*)(qf + 8 * d + 4);
                        a += (bflo(kk.x) * q0[0] + bfhi(kk.x) * q0[1]) + (bflo(kk.y) * q0[2] + bfhi(kk.y) * q0[3]) + (bflo(kk.z) * q1[0] + bfhi(kk.z) * q1[1]) + (bflo(kk.w) * q1[2] + bfhi(kk.w) * q1[3]); }
                    s = (slot < 3 || key <= t) ? a : -INFINITY; }
                sc[slot][r] = s; mx = fmaxf(mx, s); } }
        mx = wave_max(mx);
        float sum = 0.f;
#pragma unroll
        for (int slot = 0; slot < 4; ++slot)
#pragma unroll
            for (int r = 0; r < 4; ++r) { sc[slot][r] = exp2f(sc[slot][r] - mx); sum += sc[slot][r]; }
        sum = wave_sum(sum);
        float o0 = 0.f, o1 = 0.f;
#pragma unroll
        for (int slot = 0; slot < 4; ++slot) {
            const bool valid = (slot == 3) || (slot < nsel);
            const int kb = (slot == 3) ? blk : sel[slot < 3 ? slot : 0];
#pragma unroll
            for (int r = 0; r < 4; ++r) { const int key0 = kb * 256 + r * 64;
                if (valid && (slot < 3 || key0 <= t)) { const float pr = sc[slot][r]; const GAS unsigned* vp = (const GAS unsigned*)(V + ((size_t)b * SEQ + key0) * 1024 + h * 128) + lane;
                    for (int kk = 0; kk < 64; ++kk) { const float pk = rdlane(pr, kk); const unsigned vv = vp[(size_t)kk * 512]; o0 += pk * bflo(vv); o1 += pk * bfhi(vv); } } } }
        const float ri = 1.0f / sum;
        *(GAS unsigned*)(AO + row * 1024 + h * 128 + 2 * lane) = pk2(o0 * ri, o1 * ri);
    }
}
constexpr float ATTN_SC = 1.0f / (pg8::Q8_SCALE * pg8::K8_SCALE);
constexpr float ATTN_THR = 8.0f;
typedef short v4i16_t __attribute__((ext_vector_type(4))); typedef int i32x16 __attribute__((ext_vector_type(16)));
__device__ __forceinline__ v4i16_t vtr16(unsigned addr) { return __builtin_amdgcn_ds_read_tr16_b64_v4i16((LAS v4i16_t*)(uintptr_t)addr); }
__device__ __forceinline__ int crow16(int r, int hh) { return (r & 3) + 8 * (r >> 2) + 4 * hh; }
__device__ __forceinline__ void attn_dma_step(const unsigned char* K8, const bf16* V, LAS unsigned char* lds, int b, int h, int qb, int n_own, int st, int buf, int wave, int lane) {
    int lq = lane; asm volatile("" : "+v"(lq));
#pragma unroll
    for (int img = 0; img < 4; ++img) {
        const int T = 2 * st + (img >> 1); const bool isV = img & 1;
        const int blk = (T < n_own) ? qb : ((T - n_own) >> 2), kt = (T < n_own) ? T : ((T - n_own) & 3);
        const size_t r0 = (size_t)b * SEQ + 256 * blk + 64 * kt;
        if (isV) { const char* base = (const char*)(V + r0 * 1024 + h * 128);
#pragma unroll
            for (int i = 0; i < 2; ++i) { const int pc = wave + 8 * i, row = 4 * pc + (lq >> 4), cp = lq & 15;
                const int c = (((cp >> 2) ^ (row & 3)) << 2) | (cp & 3);
                const unsigned off = (unsigned)(row * 2048 + 16 * c);
                __builtin_amdgcn_global_load_lds((const unsigned*)(base + off), (LAS unsigned*)(lds + buf * 65536 + img * 16384 + pc * 1024), 16, 0, 0); }
        } else {
            const char* base = (const char*)(K8 + r0 * 1024 + h * 128);
            const int row = 8 * wave + (lq >> 3), c = (lq & 7) ^ (row & 7);
            const unsigned off = (unsigned)(row * 1024 + 16 * c);
            __builtin_amdgcn_global_load_lds((const unsigned*)(base + off), (LAS unsigned*)(lds + buf * 65536 + img * 16384 + wave * 1024), 16, 0, 0); }
    }
}
__device__ __forceinline__ void attn_mfma(const Ctx& F, const bf16* Q, const unsigned char* K, const unsigned char* Q8, const bf16* V, const float* ksum, bf16* AO) {
    const int lane = F.lane, wave = F.wave, q31 = lane & 31, hh = lane >> 5, wq = wave & 3, kvh = wave >> 2, l16 = lane & 15, G4 = lane >> 4;
    LAS unsigned char* lds = F.lds + RING_OFF;
    const unsigned lds0 = (unsigned)(uintptr_t)lds;
    for (int pr = F.vcu; pr < 256; pr += F.G)
#pragma unroll 1
    for (int pi = 0; pi < 2; ++pi) {
        const int bh = pr >> 4, s_ = pr & 15, u128 = pi ? 31 - s_ : s_, b = bh >> 3, h = bh & 7, qb = u128 >> 1, half = u128 & 1;
        const int n_own = half ? 4 : 2, nstep = (n_own + 4 * qb) >> 1;
        const size_t rowq = (size_t)b * SEQ + 256 * qb + 128 * half + 32 * wq + q31;
        asm volatile("s_waitcnt vmcnt(0) lgkmcnt(0)" ::: "memory"); __builtin_amdgcn_s_barrier(); asm volatile("" ::: "memory");
        attn_dma_step(K, V, lds, b, h, qb, n_own, 0, 0, wave, lane);
        bf16x8 qf[8];
#pragma unroll
        for (int s = 0; s < 8; ++s) qf[s] = *(const GAS bf16x8*)(Q + rowq * 1024 + h * 128 + 16 * s + 8 * hh);
        unsigned selmask;
        {
            f32x16 gt;
#pragma unroll
            for (int r = 0; r < 16; ++r) gt[r] = 0.f;
            const int jr = lane & 31; const bool jv = jr < qb;
            const GAS f32x4* kp = (const GAS f32x4*)(ksum + (size_t)(b * 16 + (jv ? jr : 0)) * 1024 + h * 128 + 8 * hh);
            f32x4 kf[16];
#pragma unroll
            for (int s = 0; s < 8; ++s) { kf[2 * s] = kp[4 * s]; kf[2 * s + 1] = kp[4 * s + 1]; }
#pragma unroll
            for (int s = 0; s < 8; ++s) { v4u w = pg8::pack8(kf[2 * s], kf[2 * s + 1]); if (!jv) { w.x = 0u; w.y = 0u; w.z = 0u; w.w = 0u; }
                gt = __builtin_amdgcn_mfma_f32_32x32x16_bf16(__builtin_bit_cast(bf16x8, w), qf[s], gt, 0, 0, 0); }
            float g16[16];
#pragma unroll
            for (int r = 0; r < 8; ++r) { const auto rr = __builtin_amdgcn_permlane32_swap(__float_as_uint(gt[r]), __float_as_uint(gt[r]), false, false);
                g16[(r & 3) + 8 * (r >> 2)] = __uint_as_float(rr[0]); g16[(r & 3) + 8 * (r >> 2) + 4] = __uint_as_float(rr[1]); }
            float v0 = -INFINITY, v1 = -INFINITY, v2 = -INFINITY; int i0 = 0, i1 = 0, i2 = 0;
#pragma unroll
            for (int j = 0; j < 16; ++j) { const float a = (j < qb) ? g16[j] : -INFINITY;
                if (a > v0) { v2 = v1; i2 = i1; v1 = v0; i1 = i0; v0 = a; i0 = j; } else if (a > v1) { v2 = v1; i2 = i1; v1 = a; i1 = j; } else if (a > v2) { v2 = a; i2 = j; } }
            selmask = (qb <= 3) ? ((1u << qb) - 1u) : ((1u << i0) | (1u << i1) | (1u << i2));
        }
        pg8::i32x8 q8f[2];
#pragma unroll
        for (int s = 0; s < 2; ++s) { const pg8::i32x4 lo_ = *(const GAS pg8::i32x4*)(Q8 + rowq * 1024 + h * 128 + 64 * s + 32 * hh), hi2_ = *(const GAS pg8::i32x4*)(Q8 + rowq * 1024 + h * 128 + 64 * s + 32 * hh + 16);
            q8f[s] = __builtin_shufflevector(lo_, hi2_, 0, 1, 2, 3, 4, 5, 6, 7); }
        float m_run = -1e30f, l_run = 0.f; f32x16 o[4];
#pragma unroll
        for (int db = 0; db < 4; ++db)
#pragma unroll
            for (int r = 0; r < 16; ++r) o[db][r] = 0.f;
        const int qin = 128 * half + 32 * wq + q31;
#pragma unroll 1
        for (int st2 = 0; st2 < nstep; st2 += 2)
#pragma unroll
        for (int par = 0; par < 2; ++par) { const int st = st2 + par; if (st < nstep) {
            asm volatile("s_waitcnt vmcnt(0)" ::: "memory"); __builtin_amdgcn_s_barrier(); asm volatile("" ::: "memory");
            if (st + 1 < nstep) attn_dma_step(K, V, lds, b, h, qb, n_own, st + 1, par ^ 1, wave, lane);
            const int T = 2 * st + kvh; const bool own = T < n_own;
            const int blk = own ? qb : ((T - n_own) >> 2), kt = own ? T : ((T - n_own) & 3);
            const bool sel = own ? true : ((selmask >> blk) & 1u);
            const bool skip = own ? (64 * kt > 128 * half + 32 * wq + 31) : (__ballot(sel) == 0ull);
            if (!skip) {
                const unsigned kimg = lds0 + par * 65536 + kvh * 32768, vimg = kimg + 16384;
                f32x16 p[2];
                __builtin_amdgcn_s_setprio(1);
#pragma unroll
                for (int kh = 0; kh < 2; ++kh) {
#pragma unroll
                    for (int r = 0; r < 16; ++r) p[kh][r] = 0.f;
                    const int row = 32 * kh + q31;
#pragma unroll
                    for (int s = 0; s < 2; ++s) { const pg8::i32x4 a0 = *(const LAS pg8::i32x4*)(uintptr_t)(kimg + row * 128 + (((4 * s + 2 * hh) ^ (row & 7)) << 4)), a1 = *(const LAS pg8::i32x4*)(uintptr_t)(kimg + row * 128 + (((4 * s + 2 * hh + 1) ^ (row & 7)) << 4));
                        p[kh] = __builtin_amdgcn_mfma_scale_f32_32x32x64_f8f6f4(__builtin_shufflevector(a0, a1, 0, 1, 2, 3, 4, 5, 6, 7), q8f[s], p[kh], 0, 0, 0, 0, 0, 0); }
                }
                __builtin_amdgcn_s_setprio(0);
                if (own) { const int kbase = 64 * kt;
                    if (kbase + 63 > 128 * half + 32 * wq) {
#pragma unroll
                        for (int kh = 0; kh < 2; ++kh)
#pragma unroll
                            for (int r = 0; r < 16; ++r) if (kbase + 32 * kh + crow16(r, hh) > qin) p[kh][r] = -INFINITY; }
                }
                float mx = p[0][0];
#pragma unroll
                for (int r = 1; r < 16; ++r) mx = fmaxf(mx, p[0][r]);
#pragma unroll
                for (int r = 0; r < 16; ++r) mx = fmaxf(mx, p[1][r]);
                { const auto rr = __builtin_amdgcn_permlane32_swap(__float_as_uint(mx), __float_as_uint(mx), false, false); mx = fmaxf(__uint_as_float(rr[0]), __uint_as_float(rr[1])); }
                mx = sel ? mx * ATTN_SC : -INFINITY;
                float scl = 1.0f;
                if (__ballot(mx > m_run + ATTN_THR) != 0ull) { const float m_new = fmaxf(m_run, mx); scl = __builtin_amdgcn_exp2f(m_run - m_new); m_run = m_new;
#pragma unroll
                    for (int db = 0; db < 4; ++db)
#pragma unroll
                        for (int r = 0; r < 16; ++r) o[db][r] *= scl; }
                float rs = 0.f; const float m_neg = sel ? -m_run : -INFINITY;
#pragma unroll
                for (int kh = 0; kh < 2; ++kh)
#pragma unroll
                    for (int r = 0; r < 16; ++r) { p[kh][r] = __builtin_amdgcn_exp2f(__builtin_fmaf(p[kh][r], ATTN_SC, m_neg)); rs += p[kh][r]; }
                l_run = l_run * scl + rs;
                bf16x8 pb[4];
#pragma unroll
                for (int gi = 0; gi < 4; ++gi) { const int kh = gi >> 1, s2 = gi & 1; v4u pw;
                    pw.x = pg8::cvt_pk_bf16(p[kh][8 * s2], p[kh][8 * s2 + 1]); pw.y = pg8::cvt_pk_bf16(p[kh][8 * s2 + 2], p[kh][8 * s2 + 3]);
                    pw.z = pg8::cvt_pk_bf16(p[kh][8 * s2 + 4], p[kh][8 * s2 + 5]); pw.w = pg8::cvt_pk_bf16(p[kh][8 * s2 + 6], p[kh][8 * s2 + 7]);
                    pb[gi] = __builtin_bit_cast(bf16x8, pw); }
                v4i16_t lo[2][2], hi_[2][2];
                const int dsub = 16 * (G4 & 1) + 4 * (l16 & 3);
#define ATTN_VREADS(u, S) { const int key0_ = 32 * ((u) >> 2) + 16 * (((u) >> 1) & 1) + 4 * (G4 >> 1) + (l16 >> 2); _Pragma("unroll") for (int d2 = 0; d2 < 2; ++d2) { const int db = 2 * ((u) & 1) + d2; \
                    const unsigned a0_ = vimg + key0_ * 256 + ((db ^ (key0_ & 3)) << 6) + dsub * 2; \
                    asm volatile("ds_read_b64_tr_b16 %0, %1" : "=&v"(lo[S][d2]) : "v"(a0_) : "memory"); \
                    asm volatile("ds_read_b64_tr_b16 %0, %1 offset:2048" : "=&v"(hi_[S][d2]) : "v"(a0_) : "memory"); } }
#define ATTN_VWAIT(S, N) asm volatile("s_waitcnt lgkmcnt(" #N ")" : "+v"(lo[S][0]), "+v"(lo[S][1]), "+v"(hi_[S][0]), "+v"(hi_[S][1]) :: "memory")
#define ATTN_PV(u, S) { _Pragma("unroll") for (int d2 = 0; d2 < 2; ++d2) { const int db = 2 * ((u) & 1) + d2; const bf16x8 av = {lo[S][d2][0], lo[S][d2][1], lo[S][d2][2], lo[S][d2][3], hi_[S][d2][0], hi_[S][d2][1], hi_[S][d2][2], hi_[S][d2][3]}; \
                    o[db] = __builtin_amdgcn_mfma_f32_32x32x16_bf16(av, pb[(u) >> 1], o[db], 0, 0, 0); } }
                __builtin_amdgcn_s_setprio(1);
                ATTN_VREADS(0, 0)
                ATTN_VREADS(1, 1) ATTN_VWAIT(0, 4); ATTN_PV(0, 0)
                ATTN_VREADS(2, 0) ATTN_VWAIT(1, 4); ATTN_PV(1, 1)
                ATTN_VREADS(3, 1) ATTN_VWAIT(0, 4); ATTN_PV(2, 0)
                ATTN_VREADS(4, 0) ATTN_VWAIT(1, 4); ATTN_PV(3, 1)
                ATTN_VREADS(5, 1) ATTN_VWAIT(0, 4); ATTN_PV(4, 0)
                ATTN_VREADS(6, 0) ATTN_VWAIT(1, 4); ATTN_PV(5, 1)
                ATTN_VREADS(7, 1) ATTN_VWAIT(0, 4); ATTN_PV(6, 0)
                ATTN_VWAIT(1, 0); ATTN_PV(7, 1)
                __builtin_amdgcn_s_setprio(0);
#undef ATTN_VREADS
#undef ATTN_VWAIT
#undef ATTN_PV
            }
        } }
        l_run += __shfl_xor(l_run, 32);
        asm volatile("s_waitcnt vmcnt(0) lgkmcnt(0)" ::: "memory"); __builtin_amdgcn_s_barrier(); asm volatile("" ::: "memory");
        LAS float* xs = (LAS float*)lds + (size_t)wq * 66 * 64 + lane;
        if (kvh == 1) {
            xs[0] = m_run; xs[64] = l_run;
#pragma unroll
            for (int db = 0; db < 4; ++db)
#pragma unroll
                for (int r = 0; r < 16; ++r) xs[(2 + 16 * db + r) * 64] = o[db][r];
        }
        asm volatile("s_waitcnt lgkmcnt(0)" ::: "memory"); __builtin_amdgcn_s_barrier(); asm volatile("" ::: "memory");
        if (kvh == 0) {
            const float m2 = xs[0], l2 = xs[64], mt = fmaxf(m_run, m2), a1 = __builtin_amdgcn_exp2f(m_run - mt), a2 = __builtin_amdgcn_exp2f(m2 - mt);
            const float inv = 1.0f / (l_run * a1 + l2 * a2), c1 = a1 * inv, c2 = a2 * inv;
            GAS unsigned char* orow = (GAS unsigned char*)AO + rowq * 2048 + h * 128 + 4 * hh;
#pragma unroll
            for (int db = 0; db < 4; ++db)
#pragma unroll
                for (int g = 0; g < 4; ++g) {
                    float t[4];
#pragma unroll
                    for (int e = 0; e < 4; ++e) t[e] = o[db][4 * g + e] * c1 + xs[(2 + 16 * db + 4 * g + e) * 64] * c2;
                    int w = 0; w = __builtin_amdgcn_cvt_pk_fp8_f32(t[0] * pg8::H8_SCALE, t[1] * pg8::H8_SCALE, w, false); w = __builtin_amdgcn_cvt_pk_fp8_f32(t[2] * pg8::H8_SCALE, t[3] * pg8::H8_SCALE, w, true);
                    *(GAS int*)(orow + 32 * db + 8 * g) = w;
                }
        }
    }
    asm volatile("s_waitcnt vmcnt(0) lgkmcnt(0)" ::: "memory"); __builtin_amdgcn_s_barrier(); asm volatile("" ::: "memory");
}
__device__ __forceinline__ void up8(const v4u w, float (&f)[8]) { f[0] = bflo(w.x); f[1] = bfhi(w.x); f[2] = bflo(w.y); f[3] = bfhi(w.y); f[4] = bflo(w.z); f[5] = bfhi(w.z); f[6] = bflo(w.w); f[7] = bfhi(w.w); }
__device__ __forceinline__ void conv_phase(const Ctx& F, const bf16* CB, const bf16* Z, const float* cw, bf16* UC) {
    const int gt = (F.vcu * NWAVES + F.wave) * 64 + F.lane, NT = F.G * NWAVES * 64;
    for (int idx = gt; idx < M * 128; idx += NT) {
        const int row = idx >> 7, c8 = (idx & 127) << 3, t = row & (SEQ - 1); const size_t off = (size_t)row * 1024 + c8;
        float cb[8], z0[8], z1[8], z2[8];
        up8(*(const GAS v4u*)(CB + off), cb); up8(*(const GAS v4u*)(Z + off), z0);
        if (t >= 1) up8(*(const GAS v4u*)(Z + off - 1024), z1); else {
#pragma unroll
            for (int j = 0; j < 8; ++j) z1[j] = 0.f; }
        if (t >= 2) up8(*(const GAS v4u*)(Z + off - 2048), z2); else {
#pragma unroll
            for (int j = 0; j < 8; ++j) z2[j] = 0.f; }
        float o[8];
#pragma unroll
        for (int j = 0; j < 8; ++j) o[j] = cb[j] * (cw[c8 + j] * z2[j] + cw[1024 + c8 + j] * z1[j] + cw[2048 + c8 + j] * z0[j]);
        v4u w; w.x = pk2(o[0], o[1]); w.y = pk2(o[2], o[3]); w.z = pk2(o[4], o[5]); w.w = pk2(o[6], o[7]); *(GAS v4u*)(UC + off) = w;
    }
}

__device__ __forceinline__ int imax(int a, int b) { return a > b ? a : b; }
__device__ __forceinline__ int imin(int a, int b) { return a < b ? a : b; }
__device__ __forceinline__ void ce(int& a, int& b) { const int t = imax(a, b); b = imin(a, b); a = t; }
__device__ __forceinline__ void sort16(int (&x)[16]) {
#pragma unroll
    for (int kk = 1; kk <= 4; ++kk)
#pragma unroll
        for (int jj = kk - 1; jj >= 0; --jj)
#pragma unroll
            for (int i = 0; i < 16; ++i) { const int k = 1 << kk, j = 1 << jj, l = i ^ j; if (l > i) { if ((i & k) == 0) ce(x[i], x[l]); else ce(x[l], x[i]); } }
}
__device__ __forceinline__ void bmerge16(int (&a)[16]) {
#pragma unroll
    for (int jj = 3; jj >= 0; --jj)
#pragma unroll
        for (int i = 0; i < 16; ++i) { const int j = 1 << jj, l = i ^ j; if (l > i) ce(a[i], a[l]); }
}
__device__ __forceinline__ void merge16(int (&a)[16], const int (&b)[16]) {
#pragma unroll
    for (int i = 0; i < 16; ++i) a[i] = imax(a[i], b[15 - i]);
    bmerge16(a);
}
__device__ __forceinline__ void xmerge16(int (&a)[16], int hh) {
    int pv[16];
#pragma unroll
    for (int i = 0; i < 16; ++i) { const auto r = __builtin_amdgcn_permlane32_swap((unsigned)a[15 - i], (unsigned)a[15 - i], false, false); pv[i] = hh ? (int)r[0] : (int)r[1]; }
#pragma unroll
    for (int i = 0; i < 16; ++i) a[i] = imax(a[i], pv[i]);
    bmerge16(a);
}
__device__ __forceinline__ int ord_key(float f) { const int u = __float_as_int(f); return u >= 0 ? u : (u ^ 0x7fffffff); }
__device__ __forceinline__ float ord_val(int k) { return __int_as_float(k >= 0 ? k : (k ^ 0x7fffffff)); }
__device__ __forceinline__ unsigned byte16(const unsigned (&t)[4], int idx) {
    const unsigned sel = 0x0c0c0c00u | (unsigned)(idx & 7);
    const unsigned lo = __builtin_amdgcn_perm(t[1], t[0], sel), hi_ = __builtin_amdgcn_perm(t[3], t[2], sel);
    return (idx & 8) ? hi_ : lo;
}
__device__ __forceinline__ void topk_stage_keys(const Ctx& F, const bf16* KEYS, int h) {
    int lq = F.lane; asm volatile("" : "+v"(lq));
#pragma unroll
    for (int i = 0; i < 8; ++i) { const int pc = F.wave + 8 * i, pp = pc >> 5, row = 4 * (pc & 31) + (lq >> 4), cp = lq & 15, c = cp ^ (row & 15);
        const char* base = (const char*)(KEYS + (size_t)((h * 2 + pp) * 128) * 128); const unsigned off = (unsigned)(row * 256 + 16 * c);
        __builtin_amdgcn_global_load_lds((const unsigned*)(base + off), (LAS unsigned*)(F.lds + RING_OFF + pc * 1024), 16, 0, 0); }
    asm volatile("s_waitcnt vmcnt(0)" ::: "memory"); __builtin_amdgcn_s_barrier(); asm volatile("" ::: "memory");
}
__device__ __forceinline__ void topk_phase(const Ctx& F, int bitem, const bf16* QP, int* EXP, float* GATE) {
    const int lane = F.lane, l31 = lane & 31, hh = lane >> 5;
    const int IMIN = (int)0x80000000;
    const unsigned lds0 = (unsigned)(uintptr_t)(F.lds + RING_OFF);
    {
        const int h = bitem & 7, tt = (bitem >> 3) * 8 + F.wave, tok0 = tt * 32;
        int top[2][16];
#pragma unroll
        for (int p = 0; p < 2; ++p) {
            bf16x8 qa[8];
#pragma unroll
            for (int s = 0; s < 8; ++s) qa[s] = *(const GAS bf16x8*)(QP + (size_t)(tok0 + l31) * 2048 + h * 256 + p * 128 + 16 * s + 8 * hh);
            int x[2][16];
#pragma unroll
            for (int pq = 0; pq < 2; ++pq) {
                f32x16 sc[2];
#pragma unroll
                for (int nt = 0; nt < 2; ++nt)
#pragma unroll
                    for (int r = 0; r < 16; ++r) sc[nt][r] = 0.f;
#pragma unroll
                for (int s = 0; s < 8; ++s) {
#pragma unroll
                    for (int nt = 0; nt < 2; ++nt) { const int n = 64 * pq + 32 * nt + l31; const bf16x8 kb = *(const LAS bf16x8*)(uintptr_t)(lds0 + p * 32768 + n * 256 + (((2 * s + hh) ^ (n & 15)) << 4));
                        sc[nt] = __builtin_amdgcn_mfma_f32_32x32x16_bf16(kb, qa[s], sc[nt], 0, 0, 0); }
                }
                int y[16];
#pragma unroll
                for (int r = 0; r < 16; ++r) { x[pq][r] = (ord_key(sc[0][r]) & ~127) | ((127 - 64 * pq - (r & 3) - 8 * (r >> 2)) - 4 * hh); y[r] = (ord_key(sc[1][r]) & ~127) | ((127 - 64 * pq - 32 - (r & 3) - 8 * (r >> 2)) - 4 * hh); }
                sort16(x[pq]); sort16(y); merge16(x[pq], y);
                asm volatile("" ::: "memory");
            }
            merge16(x[0], x[1]);
            xmerge16(x[0], hh);
#pragma unroll
            for (int i = 0; i < 16; ++i) top[p][i] = x[0][i];
        }
        float fa[16], fb[16];
#pragma unroll
        for (int i = 0; i < 16; ++i) { const int A = hh ? top[1][i] : top[0][i], B = hh ? top[0][i] : top[1][i]; fa[i] = ord_val(A & ~127); fb[i] = ord_val(B & ~127); }
        int c0[16], c1[16];
#pragma unroll
        for (int q = 0; q < 32; ++q) {
            int key = IMIN;
            if (q < 27) { const int i = (q < 16) ? 0 : (q < 23) ? 1 : (q < 26) ? 2 : 3, j = (q < 16) ? q : (q < 23) ? q - 15 : (q < 26) ? q - 21 : 3; const float sv = fa[i] + fb[j]; const int low = hh ? (255 - (j * 16 + i)) : (255 - (i * 16 + j));
                key = (ord_key(sv) & ~255) | low; if (i == j && hh) key = IMIN; }
            if (q < 16) c0[q] = key; else c1[q - 16] = key;
        }
        sort16(c0); sort16(c1); merge16(c0, c1); xmerge16(c0, hh);
        unsigned na[4], nb[4];
#pragma unroll
        for (int d = 0; d < 4; ++d) { na[d] = 0u; nb[d] = 0u;
#pragma unroll
            for (int e = 0; e < 4; ++e) { na[d] |= (unsigned)(127 - (top[0][4 * d + e] & 127)) << (8 * e); nb[d] |= (unsigned)(127 - (top[1][4 * d + e] & 127)) << (8 * e); } }
        int ex[16]; float ev[16]; float es = 0.f; const float smax = ord_val(c0[0] & ~255);
#pragma unroll
        for (int q = 0; q < 16; ++q) { const int posn = 255 - (c0[q] & 255); const unsigned n1 = byte16(na, posn >> 4) & 255u, n2 = byte16(nb, posn & 15) & 255u;
            ex[q] = (int)(n1 * 128u + n2); ev[q] = __expf(ord_val(c0[q] & ~255) - smax); es += ev[q]; }
        const float ri = 1.0f / es; const size_t ob = (size_t)(tok0 + l31) * 128 + h * 16;
        if (hh == 0) {
#pragma unroll
            for (int d = 0; d < 4; ++d) { v4u w; w.x = (unsigned)ex[4 * d]; w.y = (unsigned)ex[4 * d + 1]; w.z = (unsigned)ex[4 * d + 2]; w.w = (unsigned)ex[4 * d + 3]; *(GAS v4u*)(EXP + ob + 4 * d) = w; }
        } else {
#pragma unroll
            for (int d = 0; d < 4; ++d) *(GAS f32x4*)(GATE + ob + 4 * d) = (f32x4){ev[4 * d] * ri, ev[4 * d + 1] * ri, ev[4 * d + 2] * ri, ev[4 * d + 3] * ri};
        }
    }
}

typedef float f32x2 __attribute__((ext_vector_type(2)));
#ifndef MK_PEER_RD
#define MK_PEER_RD 4
#endif
#ifndef MK_PEER_ALIGN
#define MK_PEER_ALIGN 0
#endif
constexpr int PEER_ALIGN = MK_PEER_ALIGN;
constexpr int PEER_RDU = 4;
constexpr int PEER_RD = MK_PEER_RD;
template <int CTRL> __device__ __forceinline__ int dpp_i(int v) { return __builtin_amdgcn_update_dpp(v, v, CTRL, 0xf, 0xf, false); }
template <int J> __device__ __forceinline__ int xor_lane(int v, int lane) {
    if constexpr (J == 1) return dpp_i<0xB1>(v);
    else if constexpr (J == 2) return dpp_i<0x4E>(v);
    else if constexpr (J == 16) { const auto r = __builtin_amdgcn_permlane16_swap((unsigned)v, (unsigned)v, false, false); return ((lane >> 4) & 1) ? (int)r[0] : (int)r[1]; }
    else if constexpr (J == 32) { const auto r = __builtin_amdgcn_permlane32_swap((unsigned)v, (unsigned)v, false, false); return (lane >> 5) ? (int)r[0] : (int)r[1]; }
    else return __shfl_xor(v, J);
}
__device__ __forceinline__ float wave_sum_dpp(float v) {
    v += __int_as_float(dpp_i<0xB1>(__float_as_int(v))); v += __int_as_float(dpp_i<0x4E>(__float_as_int(v))); v += __int_as_float(dpp_i<0x141>(__float_as_int(v))); v += __int_as_float(dpp_i<0x140>(__float_as_int(v)));
    { const auto r = __builtin_amdgcn_permlane16_swap(__float_as_uint(v), __float_as_uint(v), false, false); v = __uint_as_float(r[0]) + __uint_as_float(r[1]); }
    { const auto r = __builtin_amdgcn_permlane32_swap(__float_as_uint(v), __float_as_uint(v), false, false); v = __uint_as_float(r[0]) + __uint_as_float(r[1]); }
    return v; }
template <int KK, int JJ> __device__ __forceinline__ void sort512_step(int (&x)[8], int lane) {
    constexpr int k = 1 << KK, j = 1 << JJ;
    if constexpr (j >= 64) { constexpr int jr = j >> 6;
#pragma unroll
        for (int r = 0; r < 8; ++r) if ((r & jr) == 0) { const bool asc = (k >= 512) ? true : (((r << 6) & k) == 0); const int lo = imin(x[r], x[r | jr]), hi_ = imax(x[r], x[r | jr]); x[r] = asc ? lo : hi_; x[r | jr] = asc ? hi_ : lo; }
    } else {
        const bool lower = (lane & j) == 0;
#pragma unroll
        for (int r = 0; r < 8; ++r) { const int y = xor_lane<j>(x[r], lane);
            const bool asc = (k < 64) ? ((lane & k) == 0) : ((k >= 512) ? true : (((r << 6) & k) == 0));
            x[r] = (lower == asc) ? imin(x[r], y) : imax(x[r], y); }
    }
}
template <int KK, int JJ> __device__ __forceinline__ void sort512_stage(int (&x)[8], int lane) { sort512_step<KK, JJ>(x, lane); if constexpr (JJ > 0) sort512_stage<KK, JJ - 1>(x, lane); }
__device__ __forceinline__ void sort512(int (&x)[8], int lane) {
    sort512_stage<1, 0>(x, lane); sort512_stage<2, 1>(x, lane); sort512_stage<3, 2>(x, lane); sort512_stage<4, 3>(x, lane); sort512_stage<5, 4>(x, lane);
    sort512_stage<6, 5>(x, lane); sort512_stage<7, 6>(x, lane); sort512_stage<8, 7>(x, lane); sort512_stage<9, 8>(x, lane);
}
__device__ __forceinline__ u32x6 peer_row(const unsigned char* T, int e, int lane) {
    const __amdgpu_buffer_rsrc_t r = __builtin_amdgcn_make_buffer_rsrc((void*)T, 0, NEXP * PEER_ROWB, 0x00020000);
    const int so = e * PEER_ROWB;
    const v4u a = __builtin_amdgcn_raw_buffer_load_b128(r, lane * 16, so, 1); const u32x2v b = __builtin_amdgcn_raw_buffer_load_b64(r, 1024 + lane * 8, so, 1);
    return (u32x6){a.x, a.y, a.z, a.w, b.x, b.y}; }
__device__ __forceinline__ void peer_phase(const Ctx& F, const unsigned char* U8, const unsigned char* V8, const bf16* X1B, const int* EXP, const float* GATE, const unsigned long long* SS, const float* gfin, const float* X1, float* OUT) {
    const int gw = F.vcu * NWAVES + F.wave, NGW = F.G * NWAVES, lane = F.lane;
    const unsigned xs0 = (unsigned)(uintptr_t)(F.lds + RING_OFF + F.wave * 16384) + lane * 16;
    for (int tb = gw; tb + 3 * NGW < M; tb += 4 * NGW) {
        int kreg[8]; float rv[4];
        int lk = lane; asm volatile("" : "+v"(lk));
#pragma unroll
        for (int j = 0; j < 4; ++j) { const size_t t = (size_t)tb + (size_t)j * NGW;
            kreg[2 * j] = (EXP[t * 128 + lk] << 9) | (j << 7) | lk; kreg[2 * j + 1] = (EXP[t * 128 + 64 + lk] << 9) | (j << 7) | (64 + lk);
        }
        sort512(kreg, lane);
#pragma unroll
        for (int j = 0; j < 4; ++j) rv[j] = pg8::rinv_from_ss(SS[(size_t)tb + (size_t)j * NGW]) * (1.0f / PEER_SU);
        float actreg[8];
        {
            bf16x2v xv[4][16];
            int lx = lane; asm volatile("" : "+v"(lx));
#pragma unroll
            for (int j = 0; j < 4; ++j) { const size_t t = (size_t)tb + (size_t)j * NGW;
#pragma unroll
                for (int i = 0; i < 2; ++i)
#pragma unroll
                    for (int hv = 0; hv < 2; ++hv) { const v4u w = *(const GAS v4u*)(X1B + t * DM + i * 1024 + lx * 16 + 8 * hv);
                        const unsigned w0 = w.x, w1 = w.y, w2 = w.z, w3 = w.w;
                        xv[j][8 * i + 4 * hv + 0] = __builtin_bit_cast(bf16x2v, w0); xv[j][8 * i + 4 * hv + 1] = __builtin_bit_cast(bf16x2v, w1); xv[j][8 * i + 4 * hv + 2] = __builtin_bit_cast(bf16x2v, w2); xv[j][8 * i + 4 * hv + 3] = __builtin_bit_cast(bf16x2v, w3); } }
            u32x6 ub[PEER_RDU];
#pragma unroll
            for (int u = 0; u < PEER_RDU; ++u) ub[u] = peer_row(U8, __builtin_amdgcn_readlane(kreg[0], u) >> 9, lane);
#pragma unroll
            for (int c = 0; c < 8; ++c) {
                float areg = 0.f;
#pragma unroll 1
                for (int g = 0; g < 8; ++g) {
                    if (PEER_ALIGN > 0 && (g & (PEER_ALIGN - 1)) == 0 && (PEER_ALIGN <= 8 || (c & (PEER_ALIGN / 8 - 1)) == 0)) __builtin_amdgcn_s_barrier();
                    float pt[8];
#pragma unroll
                    for (int u = 0; u < 8; ++u) {
                        const int key = __builtin_amdgcn_readlane(kreg[c], 8 * g + u), tk = (key >> 7) & 3;
                        const bf16x32v cv = __builtin_amdgcn_cvt_scalef32_pk32_bf16_fp6(ub[u % PEER_RDU], 1.0f);
                        int f0, f1, f2, f3;
                        asm volatile("s_cmp_eq_u32 %1, 0\n\ts_cselect_b32 %0, 1, 0" : "=s"(f0) : "s"(tk) : "scc"); asm volatile("s_cmp_eq_u32 %1, 1\n\ts_cselect_b32 %0, 1, 0" : "=s"(f1) : "s"(tk) : "scc");
                        asm volatile("s_cmp_eq_u32 %1, 2\n\ts_cselect_b32 %0, 1, 0" : "=s"(f2) : "s"(tk) : "scc"); asm volatile("s_cmp_eq_u32 %1, 3\n\ts_cselect_b32 %0, 1, 0" : "=s"(f3) : "s"(tk) : "scc");
                        float pa = 0.f, pb = 0.f, pc = 0.f, pd = 0.f;
#define PEER_DOT(J) { _Pragma("unroll") for (int q = 0; q < 4; ++q) { \
                            pa = __builtin_amdgcn_fdot2_f32_bf16((bf16x2v){cv[8 * q + 0], cv[8 * q + 1]}, xv[J][4 * q + 0], pa, false); pb = __builtin_amdgcn_fdot2_f32_bf16((bf16x2v){cv[8 * q + 2], cv[8 * q + 3]}, xv[J][4 * q + 1], pb, false); \
                            pc = __builtin_amdgcn_fdot2_f32_bf16((bf16x2v){cv[8 * q + 4], cv[8 * q + 5]}, xv[J][4 * q + 2], pc, false); pd = __builtin_amdgcn_fdot2_f32_bf16((bf16x2v){cv[8 * q + 6], cv[8 * q + 7]}, xv[J][4 * q + 3], pd, false); } }
                        if (f0) PEER_DOT(0)
                        if (f1) PEER_DOT(1)
                        if (f2) PEER_DOT(2)
                        if (f3) PEER_DOT(3)
#undef PEER_DOT
                        pt[u] = (pa + pb) + (pc + pd);
                        { const int ix = 8 * g + PEER_RDU + u, ka = __builtin_amdgcn_readlane(kreg[c], ix & 63), kb = __builtin_amdgcn_readlane(kreg[c < 7 ? c + 1 : 7], ix & 63), kn = (ix < 64) ? ka : kb;
                            ub[u % PEER_RDU] = peer_row(U8, kn >> 9, lane); }
                    }
                    { const bool b5 = (lane & 32) != 0, b4 = (lane & 16) != 0, b3 = (lane & 8) != 0;
#pragma unroll
                      for (int i = 0; i < 4; ++i) { const float a = pt[i], b = pt[i + 4]; pt[i] = (b5 ? b : a) + __int_as_float(xor_lane<32>(__float_as_int(b5 ? a : b), lane)); }
#pragma unroll
                      for (int i = 0; i < 2; ++i) { const float a = pt[i], b = pt[i + 2]; pt[i] = (b4 ? b : a) + __int_as_float(xor_lane<16>(__float_as_int(b4 ? a : b), lane)); }
                      { const float a = pt[0], b = pt[1]; pt[0] = (b3 ? b : a) + __int_as_float(dpp_i<0x128>(__float_as_int(b3 ? a : b))); }
                      float r = pt[0]; r += __int_as_float(dpp_i<0x141>(__float_as_int(r))); r += __int_as_float(dpp_i<0x4E>(__float_as_int(r))); r += __int_as_float(dpp_i<0xB1>(__float_as_int(r)));
                      areg = ((lane & 7) == g) ? r : areg; }
                }
                actreg[c] = areg;
            }
        }
#pragma unroll
        for (int c = 0; c < 8; ++c) { const int pk = __shfl(kreg[c], 8 * (lane & 7) + (lane >> 3)), tk = (pk >> 7) & 3;
            const float gate = GATE[((size_t)tb + (size_t)tk * NGW) * 128 + (pk & 127)], rr = (tk == 0) ? rv[0] : (tk == 1) ? rv[1] : (tk == 2) ? rv[2] : rv[3];
            actreg[c] = gelu_tanh(actreg[c] * rr) * gate * (1.0f / PEER_SV); }
        {
            f32x2 y[4][16];
#pragma unroll
            for (int j = 0; j < 4; ++j)
#pragma unroll
                for (int q = 0; q < 16; ++q) y[j][q] = (f32x2){0.f, 0.f};
            u32x6 vb[PEER_RD];
#pragma unroll
            for (int u = 0; u < PEER_RD; ++u) vb[u] = peer_row(V8, __builtin_amdgcn_readlane(kreg[0], u) >> 9, lane);
#pragma unroll
            for (int c = 0; c < 8; ++c) {
#pragma unroll 1
                for (int g = 0; g < 8; ++g) {
                    if (PEER_ALIGN > 0 && (g & (PEER_ALIGN - 1)) == 0 && (PEER_ALIGN <= 8 || (c & (PEER_ALIGN / 8 - 1)) == 0)) __builtin_amdgcn_s_barrier();
#pragma unroll
                    for (int u = 0; u < 8; ++u) {
                        const int key = __builtin_amdgcn_readlane(kreg[c], 8 * g + u), tk = (key >> 7) & 3;
                        const float s = rdlane(actreg[c], 8 * u + g); const f32x2 s2 = {s, s};
                        f32x2 cv[16];
                        { const f32x32v r = __builtin_amdgcn_cvt_scalef32_pk32_f32_fp6(vb[u % PEER_RD], 1.0f);
#pragma unroll
                          for (int q = 0; q < 16; ++q) cv[q] = (f32x2){r[2 * q], r[2 * q + 1]}; }
                        int f0, f1, f2, f3;
                        asm volatile("s_cmp_eq_u32 %1, 0\n\ts_cselect_b32 %0, 1, 0" : "=s"(f0) : "s"(tk) : "scc"); asm volatile("s_cmp_eq_u32 %1, 1\n\ts_cselect_b32 %0, 1, 0" : "=s"(f1) : "s"(tk) : "scc");
                        asm volatile("s_cmp_eq_u32 %1, 2\n\ts_cselect_b32 %0, 1, 0" : "=s"(f2) : "s"(tk) : "scc"); asm volatile("s_cmp_eq_u32 %1, 3\n\ts_cselect_b32 %0, 1, 0" : "=s"(f3) : "s"(tk) : "scc");
                        if (f0) { _Pragma("unroll") for (int q = 0; q < 16; ++q) y[0][q] = __builtin_elementwise_fma(cv[q], s2, y[0][q]); }
                        if (f1) { _Pragma("unroll") for (int q = 0; q < 16; ++q) y[1][q] = __builtin_elementwise_fma(cv[q], s2, y[1][q]); }
                        if (f2) { _Pragma("unroll") for (int q = 0; q < 16; ++q) y[2][q] = __builtin_elementwise_fma(cv[q], s2, y[2][q]); }
                        if (f3) { _Pragma("unroll") for (int q = 0; q < 16; ++q) y[3][q] = __builtin_elementwise_fma(cv[q], s2, y[3][q]); }
                        { const int ix = 8 * g + PEER_RD + u, ka = __builtin_amdgcn_readlane(kreg[c], ix & 63), kb = __builtin_amdgcn_readlane(kreg[c < 7 ? c + 1 : 7], ix & 63), kn = (ix < 64) ? ka : kb;
                            vb[u % PEER_RD] = peer_row(V8, kn >> 9, lane); }
                    }
                }
            }
            int lq = lane; asm volatile("" : "+v"(lq));
#pragma unroll
            for (int j = 0; j < 4; ++j) { const size_t t = (size_t)tb + (size_t)j * NGW;
                GAS f32x4* orw = (GAS f32x4*)(OUT + t * DM); float ss = 0.f;
#pragma unroll
                for (int i = 0; i < 2; ++i)
#pragma unroll
                    for (int hv = 0; hv < 2; ++hv) { const v4u w = *(const GAS v4u*)(X1B + t * DM + i * 1024 + lq * 16 + 8 * hv);
                        y[j][8 * i + 4 * hv + 0] += (f32x2){bflo(w.x), bfhi(w.x)}; y[j][8 * i + 4 * hv + 1] += (f32x2){bflo(w.y), bfhi(w.y)}; y[j][8 * i + 4 * hv + 2] += (f32x2){bflo(w.z), bfhi(w.z)}; y[j][8 * i + 4 * hv + 3] += (f32x2){bflo(w.w), bfhi(w.w)}; }
#pragma unroll
                for (int q = 0; q < 16; ++q) ss += y[j][q][0] * y[j][q][0] + y[j][q][1] * y[j][q][1];
                const float r3 = 1.0f / sqrtf(wave_sum_dpp(ss) * (1.0f / DM) + RMS_EPS);
#pragma unroll
                for (int i = 0; i < 2; ++i)
#pragma unroll
                    for (int q = 0; q < 4; ++q) { const f32x4 ga = *(const GAS f32x4*)(gfin + i * 1024 + lq * 16 + 4 * q);
                        orw[i * 256 + 4 * lq + q] = (f32x4){y[j][8 * i + 2 * q][0] * r3 * ga[0], y[j][8 * i + 2 * q][1] * r3 * ga[1], y[j][8 * i + 2 * q + 1][0] * r3 * ga[2], y[j][8 * i + 2 * q + 1][1] * r3 * ga[3]}; }
            }
        }
        asm volatile("s_waitcnt lgkmcnt(0)" ::: "memory");
    }
}

struct Args { const float* in[15]; float* out; unsigned char* ws; double invf[16]; int ph_lo, ph_hi, li, pad; };
__global__ void __launch_bounds__(NWAVES * 64, 2) mk_fwd(Args args) {
    extern __shared__ __attribute__((aligned(16))) unsigned char lds[];
    Ctx F;
    F.lds = (LAS unsigned char*)lds;
    volatile LAS unsigned* MISC = (volatile LAS unsigned*)(F.lds + MISC_OFF);
    F.tid = threadIdx.x; F.lane = F.tid & 63; F.wave = __builtin_amdgcn_readfirstlane(F.tid >> 6);
    F.G = gridDim.x; { const int bx = blockIdx.x; F.vcu = (F.G % 8 == 0) ? (bx % 8) * (F.G / 8) + bx / 8 : bx; }
    unsigned char* ws = args.ws;
    gu32* ctl = (gu32*)(ws + WS_CTL);
    for (int u = F.tid; u < (LDS_BYTES - LDSCTL_OFF) / 4; u += NWAVES * 64) ((LAS unsigned*)(F.lds + LDSCTL_OFF))[u] = 0u;
    __syncthreads();
    XcdBarrier bar; bar.bar = (unsigned*)(ctl + CW_BAR); bar.x = 0; bar.st = nullptr;
    if (N_LAUNCHES != PER_PHASE) bar = xcd_barrier_post((unsigned*)(ctl + CW_BAR), MISC + 8);
#define GRID_BAR() do { if (N_LAUNCHES != PER_PHASE) xcd_barrier(bar); } while (0)
#define GRID_BAR_W(q) do { if (N_LAUNCHES != PER_PHASE) { const BarWork wk_{args.in[12], args.in[13], args.in[9], ws, (q), 5}; xcd_barrier(bar, &F, &wk_); } } while (0)
    const int lo = args.ph_lo, hi = args.ph_hi;
#define IN(k) (lo <= (k) && (k) < hi)
#define BOTH(k) (IN(k) && IN((k) + 1))
    bf16* WinT = (bf16*)(ws + WS_WIN); bf16* WbcT = (bf16*)(ws + WS_WBC); bf16* WbaT = (bf16*)(ws + WS_WBA); bf16* WoutT = (bf16*)(ws + WS_WOUT); bf16* WpqT = (bf16*)(ws + WS_WPQ);
    bf16* KEYS = (bf16*)(ws + WS_KEYS); float* CS = (float*)(ws + WS_CS); const unsigned char* UB = ws + WS_UB; const unsigned char* VB = ws + WS_VB;
    bf16* XB = (bf16*)(ws + WS_XB); bf16* T6 = (bf16*)(ws + WS_T6); bf16* GAB = (bf16*)(ws + WS_GAB); bf16* UC = (bf16*)(ws + WS_UC); bf16* AO = (bf16*)(ws + WS_AO);
    bf16* TMP = (bf16*)(ws + WS_TMP); bf16* MB = (bf16*)(ws + WS_MB); bf16* X1B = (bf16*)(ws + WS_X1B); bf16* QP = (bf16*)(ws + WS_QP);
    int* EXP = (int*)(ws + WS_EXP); float* GATE = (float*)(ws + WS_GATE);
    unsigned long long* SS = (unsigned long long*)(ws + WS_SS); float* KSUM = (float*)(ws + WS_KSUM);
    constexpr size_t TS = (size_t)M * 1024;

    if (IN(0)) { for (int rep = 0; rep < NREP(0); ++rep) { p0_prologue(F, args.in, ws, args.invf); if (rep + 1 < NREP(0)) GRID_BAR(); } if (BOTH(0)) GRID_BAR(); }
    if (IN(1)) {
        for (int rep = 0; rep < NREP(1); ++rep) {
        {
            pg8::Gemm g{(const bf16*)(ws + WS_H8), WinT, M, INW, DM / 2}; pg8::StaticOrder S; S.init(M, INW, F.G, (int)blockIdx.x);
            pg8::EpiIn<2> E{T6, GAB, args.in[4], CS, KSUM};
            pg8::gemm_phase<pg8::EpiIn<2>, pg8::StaticOrder, true, true, 2>(F.lds + RING_OFF, g, S, E); }
        if (rep + 1 < NREP(1)) GRID_BAR(); }
        if (BOTH(1)) GRID_BAR();
    }
    if (IN(2)) {
        for (int rep = 0; rep < NREP(2); ++rep) {
        attn_mfma(F, T6 + 3 * TS, (const unsigned char*)(T6 + 4 * TS), (const unsigned char*)(T6 + 4 * TS) + (size_t)M * 1024, T6 + 5 * TS, KSUM, AO);
        conv_phase(F, T6, T6 + TS, args.in[5], UC);
        if (rep + 1 < NREP(2)) GRID_BAR(); }
        if (BOTH(2)) GRID_BAR_W(0);
    }
    if (IN(3)) {
        for (int rep = 0; rep < NREP(3); ++rep) {
        pg8::Gemm g{UC, WbcT, M, DM, 1024, AO, WbaT}; pg8::TwoSegOrder S; S.init(M, DM, F.G, (int)blockIdx.x);
        pg8::EpiMerge2 E{(const unsigned char*)GAB, (const unsigned char*)GAB + (size_t)M * DM, MB};
        pg8::gemm_phase<pg8::EpiMerge2, pg8::TwoSegOrder, true, true>(F.lds + RING_OFF, g, S, E);
        if (rep + 1 < NREP(3)) GRID_BAR(); }
        if (BOTH(3)) GRID_BAR_W(1);
    }
    if (IN(5)) {
        for (int rep = 0; rep < NREP(5); ++rep) {
        pg8::Gemm g{MB, WoutT, M, DM, DM / 2}; pg8::StaticOrder S; S.init(M, DM, F.G, (int)blockIdx.x);
        pg8::EpiX1 E{args.in[0], X1B, (rep + 1 < NREP(5)) ? (unsigned long long*)(ws + 768 * 1024) : SS, ws + WS_X1Q};
        pg8::gemm_phase<pg8::EpiX1, pg8::StaticOrder, true, true, 2>(F.lds + RING_OFF, g, S, E);
        if (rep + 1 < NREP(5)) GRID_BAR(); }
        if (BOTH(5)) GRID_BAR_W(2);
    }
    if (IN(6)) {
        for (int rep = 0; rep < NREP(6); ++rep) {
        pg8::Gemm g{(const bf16*)(ws + WS_X1Q), WpqT, M, DM, DM / 2}; pg8::StaticOrder S; S.init(M, DM, F.G, (int)blockIdx.x);
        pg8::EpiQP E{SS, QP};
        pg8::gemm_phase<pg8::EpiQP, pg8::StaticOrder, true, true, 2>(F.lds + RING_OFF, g, S, E);
        if (rep + 1 < NREP(6)) GRID_BAR(); }
        if (BOTH(6)) GRID_BAR_W(3);
    }
    if (IN(7)) { for (int rep = 0; rep < NREP(7); ++rep) {
        for (int bitem = F.vcu; bitem < 256; bitem += F.G) {
            topk_stage_keys(F, KEYS, bitem & 7);
            if (N_LAUNCHES == PER_PHASE && bitem == F.vcu) convert_tables(F, args.in[12], args.in[13], args.in[9], ws, 0, 1, 0);
            if (N_LAUNCHES != PER_PHASE && bitem == F.vcu && F.wave >= 4) convert_tables(F, args.in[12], args.in[13], args.in[9], ws, 4, 5, 4);
            topk_phase(F, bitem, QP, EXP, GATE);
            asm volatile("s_waitcnt lgkmcnt(0)" ::: "memory"); __builtin_amdgcn_s_barrier(); asm volatile("" ::: "memory");
        }
        if (rep + 1 < NREP(7)) GRID_BAR(); } if (BOTH(7)) GRID_BAR(); }
    if (IN(8)) { for (int rep = 0; rep < NREP(8); ++rep) { peer_phase(F, UB, VB, X1B, EXP, GATE, SS, args.in[14], args.out, (rep + 1 < NREP(8)) ? (float*)(ws + WS_END) : args.out); if (rep + 1 < NREP(8)) GRID_BAR(); } }
#undef IN
#undef BOTH
#undef GRID_BAR
#undef GRID_BAR_W
}

extern "C" void kernel_launch(void* const* d_in, const int* in_sizes, int n_in, void* d_out, int out_size, void* d_ws, size_t ws_size, hipStream_t stream) {
    static int grid = 0;
    if (grid == 0) {
        if (n_in != 15 || in_sizes[0] != M * DM || out_size != M * DM || ws_size < WS_END) { fprintf(stderr, "kernel_launch: unexpected shapes (n_in %d, in0 %d, out %d, ws %zu)\n", n_in, n_in > 0 ? in_sizes[0] : -1, out_size, ws_size); grid = -1; return; }
        int dev = 0, cus = 0, per_cu = 0;
        if (hipGetDevice(&dev) != hipSuccess || hipDeviceGetAttribute(&cus, hipDeviceAttributeMultiprocessorCount, dev) != hipSuccess) { grid = -1; return; }
        if (hipFuncSetAttribute((const void*)mk_fwd, hipFuncAttributeMaxDynamicSharedMemorySize, LDS_BYTES) != hipSuccess) { fprintf(stderr, "kernel_launch: hipFuncSetAttribute failed\n"); grid = -1; return; }
        if (hipOccupancyMaxActiveBlocksPerMultiprocessor(&per_cu, (const void*)mk_fwd, NWAVES * 64, LDS_BYTES) != hipSuccess || per_cu < 1) fprintf(stderr, "kernel_launch: occupancy query reports %d\n", per_cu);
        (void)hipGetLastError();
        grid = cus;
        if (M % (4 * grid * NWAVES) != 0) { fprintf(stderr, "kernel_launch: the PEER phase needs M %% (32 * grid) == 0 (grid %d)\n", grid); grid = -1; return; }
    }
    if (grid < 0) return;
    if (hipMemsetAsync((char*)d_ws + WS_CTL, 0, CTL_ZERO_BYTES, stream) != hipSuccess) { fprintf(stderr, "kernel_launch: memset failed\n"); return; }
    Args a{};
    for (int i = 0; i < 15; ++i) a.in[i] = (const float*)d_in[i];
    a.out = (float*)d_out; a.ws = (unsigned char*)d_ws;
    for (int f = 0; f < 16; ++f) a.invf[f] = pow(500000.0, -(double)(2 * f) / 32.0);
    for (int li = 0; li < N_LAUNCHES; ++li) {
        a.ph_lo = (N_LAUNCHES == PER_PHASE) ? li : 0; a.ph_hi = (N_LAUNCHES == PER_PHASE) ? li + 1 : PER_PHASE; a.li = li;
        hipLaunchKernelGGL(mk_fwd, dim3(grid), dim3(NWAVES * 64), LDS_BYTES, stream, a);
        const hipError_t le = hipPeekAtLastError();
        if (le != hipSuccess) { fprintf(stderr, "kernel_launch: launch %d failed: %s\n", li, hipGetErrorName(le)); break; }
    }
}
```
